# Optimizing an MI355X kernel written in HIP

```python
import jax, jax.numpy as jnp
from jax import lax
import numpy as np

D_MODEL = 1024
BATCH = 4
SEQ = 8192
DEPTH = 1

CHUNK = 64
MIX_WIDTH = D_MODEL
LRU_WIDTH = MIX_WIDTH // 2
LRU_HEADS = 8
LRU_HEAD_DIM = LRU_WIDTH // LRU_HEADS
CONV_WIDTH = 4
LRU_C = 8.0
ATTN_WIDTH = MIX_WIDTH - LRU_WIDTH
FOX_HEADS = 8
FOX_HEAD_DIM = ATTN_WIDTH // FOX_HEADS
Q_BLOCK = 128
IN_COLS = 2 * LRU_WIDTH + 3 * ATTN_WIDTH + FOX_HEADS
PEER_HEADS = 8
PEER_NKEYS = 128
PEER_N_EXPERTS = PEER_NKEYS * PEER_NKEYS
PEER_QDIM = 256
PEER_HALF = PEER_QDIM // 2
PEER_TOPK = 16
PEER_TOKEN_BLOCK = 128
RMS_EPS = 1e-6

kernel_name = 'hymba_rglru_fox_peer_block'


def rms_norm(x, g):
    xf = x.astype(jnp.float32)
    y = xf * lax.rsqrt(jnp.mean(xf * xf, axis=-1, keepdims=True) + RMS_EPS)
    return (y * g.astype(jnp.float32)).astype(x.dtype)


def causal_depthwise_conv(x, w, b):
    y = lax.conv_general_dilated(
        x, w[:, None, :].astype(x.dtype), window_strides=(1,),
        padding=[(CONV_WIDTH - 1, 0)],
        dimension_numbers=('NWC', 'WIO', 'NWC'),
        feature_group_count=x.shape[-1])
    return y + b.astype(x.dtype)


def rg_lru(x, w_a, b_a, w_x, b_x, lam):
    bsz, s, _ = x.shape
    xf = x.astype(jnp.float32)
    xh = xf.reshape(bsz, s, LRU_HEADS, LRU_HEAD_DIM)
    r = jax.nn.sigmoid(jnp.einsum('bshi,hij->bshj', xh, w_a.astype(jnp.float32)).reshape(bsz, s, LRU_WIDTH) + b_a.astype(jnp.float32))
    i = jax.nn.sigmoid(jnp.einsum('bshi,hij->bshj', xh, w_x.astype(jnp.float32)).reshape(bsz, s, LRU_WIDTH) + b_x.astype(jnp.float32))
    log_a = -LRU_C * r * jax.nn.softplus(-lam.astype(jnp.float32))
    a = jnp.exp(log_a)
    u = jnp.sqrt(-jnp.expm1(2.0 * log_a)) * (i * xf)

    def combine(left, right):
        a1, b1 = left
        a2, b2 = right
        return a1 * a2, a2 * b1 + b2

    _, h = lax.associative_scan(combine, (a, u), axis=1)
    return h


def forgetting_attention(q, k, v, log_f):
    bsz, s, nh, dh = q.shape
    F = jnp.cumsum(log_f.astype(jnp.float32), axis=1).transpose(0, 2, 1)
    qh = q.astype(jnp.float32).transpose(0, 2, 1, 3) * (dh ** -0.5)
    kh = k.astype(jnp.float32).transpose(0, 2, 1, 3)
    vh = v.astype(jnp.float32).transpose(0, 2, 1, 3)
    kpos = jnp.arange(s)

    def block(bi):
        start = bi * Q_BLOCK
        qb = lax.dynamic_slice_in_dim(qh, start, Q_BLOCK, axis=2)
        fq = lax.dynamic_slice_in_dim(F, start, Q_BLOCK, axis=2)
        qpos = start + jnp.arange(Q_BLOCK)
        logits = jnp.einsum('bhqd,bhkd->bhqk', qb, kh) + fq[..., :, None] - F[..., None, :]
        logits = jnp.where(kpos[None, :] <= qpos[:, None], logits, -jnp.inf)
        p = jax.nn.softmax(logits, axis=-1)
        return jnp.einsum('bhqk,bhkd->bhqd', p, vh)

    out = lax.map(block, jnp.arange(s // Q_BLOCK))
    return out.transpose(1, 0, 3, 2, 4).reshape(bsz, s, nh * dh)


def peer(h, w_q, subkeys, u_tab, v_tab):
    bsz, s, d = h.shape
    t = bsz * s
    hf = h.reshape(t, d)
    q = (hf @ w_q).astype(jnp.float32).reshape(t, PEER_HEADS, 2, PEER_HALF)
    sc = jnp.einsum('thpc,hpnc->thpn', q, subkeys.astype(jnp.float32))
    s1, i1 = lax.top_k(sc[:, :, 0], PEER_TOPK)
    s2, i2 = lax.top_k(sc[:, :, 1], PEER_TOPK)
    cand = (s1[..., :, None] + s2[..., None, :]).reshape(t, PEER_HEADS, PEER_TOPK * PEER_TOPK)
    top_s, top_p = lax.top_k(cand, PEER_TOPK)
    e1 = jnp.take_along_axis(i1, top_p // PEER_TOPK, axis=-1)
    e2 = jnp.take_along_axis(i2, top_p % PEER_TOPK, axis=-1)
    hk = PEER_HEADS * PEER_TOPK
    experts = (e1 * PEER_NKEYS + e2).reshape(t, hk)
    gates = jax.nn.softmax(top_s, axis=-1).reshape(t, hk)
    nb = t // PEER_TOKEN_BLOCK

    def block(args):
        xb, eb, gb = args
        pre = jnp.einsum('td,tkd->tk', xb.astype(jnp.float32), u_tab[eb].astype(jnp.float32))
        act = jax.nn.gelu(pre) * gb
        return jnp.einsum('tk,tkd->td', act, v_tab[eb].astype(jnp.float32))

    y = lax.map(block, (hf.reshape(nb, PEER_TOKEN_BLOCK, d),
                        experts.reshape(nb, PEER_TOKEN_BLOCK, hk),
                        gates.reshape(nb, PEER_TOKEN_BLOCK, hk)))
    return y.reshape(bsz, s, d).astype(h.dtype)


def setup_inputs(seed: int = 0) -> dict:
    key = jax.random.key(seed)
    ks = jax.random.split(key, 24)
    f32 = jnp.float32

    def nrm(k, shape, scale):
        return jax.random.normal(k, shape, f32) * scale

    a0 = jax.random.uniform(ks[9], (DEPTH, LRU_WIDTH), f32, 0.9, 0.999)
    return {
        'x': nrm(ks[0], (BATCH, SEQ, D_MODEL), 1.0),
        'norm1_g': 1.0 + nrm(ks[1], (DEPTH, D_MODEL), 0.01),
        'w_in': nrm(ks[2], (DEPTH, D_MODEL, IN_COLS), D_MODEL ** -0.5),
        'conv_w': nrm(ks[3], (DEPTH, CONV_WIDTH, LRU_WIDTH), CONV_WIDTH ** -0.5),
        'conv_b': nrm(ks[4], (DEPTH, LRU_WIDTH), 0.01),
        'lru_wa': nrm(ks[5], (DEPTH, LRU_HEADS, LRU_HEAD_DIM, LRU_HEAD_DIM), LRU_HEAD_DIM ** -0.5),
        'lru_ba': nrm(ks[6], (DEPTH, LRU_WIDTH), 0.01),
        'lru_wx': nrm(ks[7], (DEPTH, LRU_HEADS, LRU_HEAD_DIM, LRU_HEAD_DIM), LRU_HEAD_DIM ** -0.5),
        'lru_bx': nrm(ks[8], (DEPTH, LRU_WIDTH), 0.01),
        'lru_lambda': jnp.log(a0) - jnp.log1p(-a0),
        'fox_bf': jax.random.uniform(ks[10], (DEPTH, FOX_HEADS), f32, 1.0, 4.0),
        'gn_lru_g': 1.0 + nrm(ks[11], (DEPTH, LRU_WIDTH), 0.01),
        'gn_fox_g': 1.0 + nrm(ks[12], (DEPTH, ATTN_WIDTH), 0.01),
        'w_out': nrm(ks[13], (DEPTH, MIX_WIDTH, D_MODEL), MIX_WIDTH ** -0.5),
        'norm2_g': 1.0 + nrm(ks[14], (DEPTH, D_MODEL), 0.01),
        'peer_wq': nrm(ks[15], (DEPTH, D_MODEL, PEER_HEADS * PEER_QDIM), D_MODEL ** -0.5),
        'peer_subkeys': nrm(ks[16], (DEPTH, PEER_HEADS, 2, PEER_NKEYS, PEER_HALF), PEER_HALF ** -0.5),
        'peer_u': nrm(ks[17], (DEPTH, PEER_N_EXPERTS, D_MODEL), D_MODEL ** -0.5),
        'peer_v': nrm(ks[18], (DEPTH, PEER_N_EXPERTS, D_MODEL), 0.25),
        'final_g': 1.0 + nrm(ks[19], (D_MODEL,), 0.01),
    }


def reference(x, norm1_g, w_in, conv_w, conv_b, lru_wa, lru_ba, lru_wx, lru_bx,
              lru_lambda, fox_bf, gn_lru_g, gn_fox_g, w_out, norm2_g, peer_wq,
              peer_subkeys, peer_u, peer_v, final_g):
    bsz, s, _ = x.shape
    cuts = [LRU_WIDTH, 2 * LRU_WIDTH, 2 * LRU_WIDTH + ATTN_WIDTH,
            2 * LRU_WIDTH + 2 * ATTN_WIDTH, 2 * LRU_WIDTH + 3 * ATTN_WIDTH]
    for l in range(DEPTH):
        h = rms_norm(x, norm1_g[l])
        proj = h @ w_in[l]
        xr, gr, q, k, v, fl = jnp.split(proj, cuts, axis=-1)
        xr = causal_depthwise_conv(xr, conv_w[l], conv_b[l])
        y_lru = rg_lru(xr, lru_wa[l], lru_ba[l], lru_wx[l], lru_bx[l], lru_lambda[l])
        y_lru = y_lru * jax.nn.gelu(gr.astype(jnp.float32))
        log_f = jax.nn.log_sigmoid(fl.astype(jnp.float32) + fox_bf[l].astype(jnp.float32))
        y_fox = forgetting_attention(
            q.reshape(bsz, s, FOX_HEADS, FOX_HEAD_DIM),
            k.reshape(bsz, s, FOX_HEADS, FOX_HEAD_DIM),
            v.reshape(bsz, s, FOX_HEADS, FOX_HEAD_DIM), log_f)
        y_mix = jnp.concatenate([rms_norm(y_lru, gn_lru_g[l]),
                                 rms_norm(y_fox, gn_fox_g[l])], axis=-1).astype(x.dtype)
        x = x + y_mix @ w_out[l]
        h2 = rms_norm(x, norm2_g[l])
        x = x + peer(h2, peer_wq[l], peer_subkeys[l], peer_u[l], peer_v[l])
    return rms_norm(x, final_g)
```

```cpp
#include <hip/hip_runtime.h>
#include <stdint.h>
#include <math.h>

namespace {
constexpr int BATCH = 4, SEQ = 8192, DM = 1024, T = BATCH * SEQ;
constexpr int LW = 512, AW = 512, NH = 8, HD = 64, INC = 2568, NG1 = 2560;
constexpr int PH = 8, NKEY = 128, QD = 256, HALF = 128, TOPK = 16, NEXP = NKEY * NKEY;
constexpr float EPS = 1e-6f;
constexpr float LOG2E = 1.4426950408889634f;
constexpr float C2 = 0.125f * LOG2E;

typedef unsigned short bf16;
constexpr size_t MiB = 1u << 20;
constexpr size_t WS_CTL = 0, WS_WIN = 2 * MiB, WS_WOUT = 8 * MiB, WS_WQ = 10 * MiB, WS_SKB = 14 * MiB, WS_WFL = 15 * MiB,
                 WS_LOGF = 16 * MiB, WS_FCUM = 17 * MiB, WS_CARRY = 18 * MiB, WS_SUMSQ = 19 * MiB,
                 WS_H = 32 * MiB, WS_XR = 96 * MiB, WS_GR = 128 * MiB, WS_Q = 160 * MiB, WS_K = 192 * MiB, WS_V = 224 * MiB,
                 WS_X1B = 256 * MiB, WS_QP = 96 * MiB, WS_UT = 320 * MiB, WS_VT = 352 * MiB, WS_LA = 384 * MiB, WS_LU = 448 * MiB, WS_END = 512 * MiB;

__device__ __forceinline__ unsigned f2bf(float f) { unsigned u = __builtin_bit_cast(unsigned, f); return (u + 0x7fffu + ((u >> 16) & 1u)) >> 16; }
__device__ __forceinline__ float bf2f(unsigned short h) { return __builtin_bit_cast(float, (unsigned)h << 16); }
__device__ __forceinline__ float gelu_tanh(float x) { const float u = 0.7978845608028654f * (x + 0.044715f * x * x * x); return 0.5f * x * (1.f + tanhf(u)); }
__device__ __forceinline__ float sigmoidf_(float x) { return 1.f / (1.f + expf(-x)); }
__device__ __forceinline__ float wave_sum(float v) {
#pragma unroll
    for (int o = 1; o < 64; o <<= 1) v += __shfl_xor(v, o);
    return v;
}

__global__ void k_prep_w(const float* w_in, const float* w_out, const float* gn_l, const float* gn_f, const float* w_q, const float* g2, const float* sk,
                         bf16* win_t, float* wfl, bf16* wout_t, bf16* wq_t, bf16* skb) {
    const size_t gid = (size_t)blockIdx.x * blockDim.x + threadIdx.x, gsz = (size_t)gridDim.x * blockDim.x;
    for (size_t i = gid; i < (size_t)NG1 * DM; i += gsz) { const int n = (int)(i / DM), k = (int)(i % DM); win_t[i] = (bf16)f2bf(w_in[(size_t)k * INC + n]); }
    for (size_t i = gid; i < (size_t)8 * DM; i += gsz) { const int j = (int)(i / DM), k = (int)(i % DM); wfl[i] = w_in[(size_t)k * INC + NG1 + j]; }
    for (size_t i = gid; i < (size_t)DM * DM; i += gsz) { const int n = (int)(i / DM), k = (int)(i % DM); const float g = k < LW ? gn_l[k] : gn_f[k - LW]; wout_t[i] = (bf16)f2bf(g * w_out[(size_t)k * DM + n]); }
    for (size_t i = gid; i < (size_t)2048 * DM; i += gsz) { const int n = (int)(i / DM), k = (int)(i % DM); wq_t[i] = (bf16)f2bf(g2[k] * w_q[(size_t)k * 2048 + n]); }
    for (size_t i = gid; i < (size_t)PH * 2 * NKEY * HALF; i += gsz) skb[i] = (bf16)f2bf(sk[i]);
}
__global__ void k_prep_tab(const float* u, const float* v, const float* g2, bf16* ut, bf16* vt) {
    const size_t gid = (size_t)blockIdx.x * blockDim.x + threadIdx.x, gsz = (size_t)gridDim.x * blockDim.x;
    for (size_t i = gid; i < (size_t)NEXP * DM; i += gsz) { const int d = (int)(i % DM); ut[i] = (bf16)f2bf(g2[d] * u[i]); vt[i] = (bf16)f2bf(v[i]); }
}
__global__ void k_prep_x(const float* x, const float* g1, const float* wfl, const float* bfv, bf16* h, float* logf) {
    const int lane = threadIdx.x & 63, wv = (blockIdx.x * blockDim.x + threadIdx.x) >> 6, nw = (gridDim.x * blockDim.x) >> 6;
    for (int t = wv; t < T; t += nw) {
        float xv[16]; float ss = 0.f;
#pragma unroll
        for (int j = 0; j < 4; ++j) { const float4 v = *(const float4*)(x + (size_t)t * DM + j * 256 + lane * 4); xv[4 * j] = v.x; xv[4 * j + 1] = v.y; xv[4 * j + 2] = v.z; xv[4 * j + 3] = v.w; ss += v.x * v.x + v.y * v.y + v.z * v.z + v.w * v.w; }
        const float rstd = rsqrtf(wave_sum(ss) * (1.f / DM) + EPS);
#pragma unroll
        for (int j = 0; j < 4; ++j) { const float4 g = *(const float4*)(g1 + j * 256 + lane * 4); xv[4 * j] *= rstd * g.x; xv[4 * j + 1] *= rstd * g.y; xv[4 * j + 2] *= rstd * g.z; xv[4 * j + 3] *= rstd * g.w;
            uint2 o; o.x = f2bf(xv[4 * j]) | (f2bf(xv[4 * j + 1]) << 16); o.y = f2bf(xv[4 * j + 2]) | (f2bf(xv[4 * j + 3]) << 16); *(uint2*)(h + (size_t)t * DM + j * 256 + lane * 4) = o; }
#pragma unroll
        for (int hh = 0; hh < 8; ++hh) { float a = 0.f;
#pragma unroll
            for (int j = 0; j < 4; ++j) { const float4 w = *(const float4*)(wfl + hh * DM + j * 256 + lane * 4); a += xv[4 * j] * w.x + xv[4 * j + 1] * w.y + xv[4 * j + 2] * w.z + xv[4 * j + 3] * w.w; }
            a = wave_sum(a);
            if (lane == 0) { const float z = a + bfv[hh]; logf[(size_t)t * 8 + hh] = fminf(z, 0.f) - log1pf(expf(-fabsf(z))); } }
    }
}
__global__ void k_fcum(const float* logf, float* fcum) {
    const int lane = threadIdx.x & 63, bh = blockIdx.x, b = bh / NH, hh = bh % NH;
    float loc = 0.f;
    for (int i = 0; i < 128; ++i) loc += logf[((size_t)b * SEQ + lane * 128 + i) * 8 + hh];
    float inc = loc;
#pragma unroll
    for (int o = 1; o < 64; o <<= 1) { const float n = __shfl_up(inc, o); if (lane >= o) inc += n; }
    float run = inc - loc;
    for (int i = 0; i < 128; ++i) { run += logf[((size_t)b * SEQ + lane * 128 + i) * 8 + hh]; fcum[(size_t)bh * SEQ + lane * 128 + i] = run; }
}

struct EpiArgs { bf16* o0; bf16* o1; bf16* o2; bf16* o3; bf16* o4; const float* resid; float* outf; };
template <int EPI> __global__ void __launch_bounds__(256) k_gemm(const bf16* A, const bf16* Bt, int M, int N, int K, EpiArgs e) {
    __shared__ float As[32][65], Bs[32][65];
    const int tid = threadIdx.x, tx = tid & 15, ty = tid >> 4, m0 = blockIdx.y * 64, n0 = blockIdx.x * 64;
    float acc[4][4] = {};
    const int lr = tid >> 2, lc = (tid & 3) * 8;
    for (int k0 = 0; k0 < K; k0 += 32) {
        const uint4 av = *(const uint4*)(A + (size_t)(m0 + lr) * K + k0 + lc), bv = *(const uint4*)(Bt + (size_t)(n0 + lr) * K + k0 + lc);
        const unsigned aw[4] = {av.x, av.y, av.z, av.w}, bw[4] = {bv.x, bv.y, bv.z, bv.w};
#pragma unroll
        for (int i = 0; i < 4; ++i) { As[lc + 2 * i][lr] = bf2f(aw[i] & 0xffff); As[lc + 2 * i + 1][lr] = bf2f(aw[i] >> 16); Bs[lc + 2 * i][lr] = bf2f(bw[i] & 0xffff); Bs[lc + 2 * i + 1][lr] = bf2f(bw[i] >> 16); }
        __syncthreads();
#pragma unroll 8
        for (int k = 0; k < 32; ++k) { float a[4], b[4];
#pragma unroll
            for (int i = 0; i < 4; ++i) { a[i] = As[k][ty * 4 + i]; b[i] = Bs[k][tx * 4 + i]; }
#pragma unroll
            for (int i = 0; i < 4; ++i)
#pragma unroll
                for (int j = 0; j < 4; ++j) acc[i][j] += a[i] * b[j]; }
        __syncthreads();
    }
#pragma unroll
    for (int i = 0; i < 4; ++i)
#pragma unroll
        for (int j = 0; j < 4; ++j) { const int m = m0 + ty * 4 + i, n = n0 + tx * 4 + j; const float v = acc[i][j];
            if (EPI == 1) { const int s = n >> 9, c = n & 511; bf16* o = s == 0 ? e.o0 : s == 1 ? e.o1 : s == 2 ? e.o2 : s == 3 ? e.o3 : e.o4;
                const float w = s == 1 ? gelu_tanh(v) : s == 2 ? v * C2 : v; o[(size_t)m * 512 + c] = (bf16)f2bf(w); }
            else if (EPI == 2) { const float r = e.resid[(size_t)m * DM + n] + v; e.outf[(size_t)m * DM + n] = r; e.o0[(size_t)m * DM + n] = (bf16)f2bf(r); }
            else { e.o0[(size_t)m * N + n] = (bf16)f2bf(v); } }
}
__global__ void k_sumsq(const float* x1, float* sumsq) {
    const int lane = threadIdx.x & 63, wv = (blockIdx.x * blockDim.x + threadIdx.x) >> 6, nw = (gridDim.x * blockDim.x) >> 6;
    for (int t = wv; t < T; t += nw) { float ss = 0.f;
#pragma unroll
        for (int j = 0; j < 4; ++j) { const float4 v = *(const float4*)(x1 + (size_t)t * DM + j * 256 + lane * 4); ss += v.x * v.x + v.y * v.y + v.z * v.z + v.w * v.w; }
        ss = wave_sum(ss); if (lane == 0) sumsq[t] = ss; }
}

__global__ void k_lru_gates(const bf16* xr, const float* cw, const float* cb, const float* wa, const float* ba, const float* wx, const float* bx, const float* lam, float* la, float* lu) {
    __shared__ float xc[64];
    const int j = threadIdx.x, t = blockIdx.x / NH, hh = blockIdx.x % NH, ch = hh * 64 + j, s = t % SEQ;
    float c = cb[ch];
#pragma unroll
    for (int k = 0; k < 4; ++k) { const int ss = s - 3 + k; if (ss >= 0) c += cw[k * LW + ch] * bf2f(xr[(size_t)(t - 3 + k) * LW + ch]); }
    xc[j] = c; __syncthreads();
    float r = ba[ch], ii = bx[ch];
    for (int i = 0; i < 64; ++i) { const float xv = xc[i]; r += xv * wa[(size_t)(hh * 64 + i) * 64 + j]; ii += xv * wx[(size_t)(hh * 64 + i) * 64 + j]; }
    r = sigmoidf_(r); ii = sigmoidf_(ii);
    const float l = lam[ch], sp = fmaxf(-l, 0.f) + log1pf(expf(-fabsf(l)));
    const float log_a = -8.f * r * sp, a = expf(log_a), u = sqrtf(-expm1f(2.f * log_a)) * (ii * c);
    la[(size_t)t * LW + ch] = a; lu[(size_t)t * LW + ch] = u;
}
__global__ void k_lru_scan(const float* la, float* lu, const bf16* gr) {
    const int id = blockIdx.x * blockDim.x + threadIdx.x; if (id >= BATCH * LW) return;
    const int b = id / LW, ch = id % LW; float h = 0.f;
    for (int s = 0; s < SEQ; ++s) { const size_t o = ((size_t)b * SEQ + s) * LW + ch; h = la[o] * h + lu[o]; lu[o] = h * bf2f(gr[o]); }
}
__global__ void k_ymix(const float* ylru, const bf16* o, bf16* ymix) {
    const int lane = threadIdx.x & 63, wv = (blockIdx.x * blockDim.x + threadIdx.x) >> 6, nw = (gridDim.x * blockDim.x) >> 6;
    for (int t = wv; t < T; t += nw) {
        float a[8], f[8]; float sa = 0.f, sf = 0.f;
#pragma unroll
        for (int i = 0; i < 8; ++i) { a[i] = ylru[(size_t)t * LW + i * 64 + lane]; f[i] = bf2f(o[(size_t)t * AW + i * 64 + lane]); sa += a[i] * a[i]; sf += f[i] * f[i]; }
        const float ra = rsqrtf(wave_sum(sa) * (1.f / LW) + EPS), rf = rsqrtf(wave_sum(sf) * (1.f / AW) + EPS);
#pragma unroll
        for (int i = 0; i < 8; ++i) { ymix[(size_t)t * DM + i * 64 + lane] = (bf16)f2bf(a[i] * ra); ymix[(size_t)t * DM + LW + i * 64 + lane] = (bf16)f2bf(f[i] * rf); }
    }
}

__global__ void __launch_bounds__(256) k_attn(const bf16* Q, const bf16* K, const bf16* V, const float* fcum, bf16* O) {
    const int lane = threadIdx.x & 63, wv = (blockIdx.x * blockDim.x + threadIdx.x) >> 6;
    const int q = wv % SEQ, bh = wv / SEQ, b = bh / NH, hh = bh % NH;
    const size_t rowq = (size_t)b * SEQ + q;
    float qv[64];
#pragma unroll
    for (int i = 0; i < 8; ++i) { const uint4 w = *(const uint4*)(Q + rowq * AW + hh * 64 + i * 8); const unsigned ww[4] = {w.x, w.y, w.z, w.w};
#pragma unroll
        for (int c = 0; c < 4; ++c) { qv[i * 8 + 2 * c] = bf2f(ww[c] & 0xffff); qv[i * 8 + 2 * c + 1] = bf2f(ww[c] >> 16); } }
    const float fq = fcum[(size_t)bh * SEQ + q];
    float m = -INFINITY, l = 0.f; float o[64];
#pragma unroll
    for (int d = 0; d < 64; ++d) o[d] = 0.f;
    for (int j = lane; j <= q; j += 64) {
        const size_t rowk = (size_t)b * SEQ + j; float s = 0.f;
#pragma unroll
        for (int i = 0; i < 8; ++i) { const uint4 w = *(const uint4*)(K + rowk * AW + hh * 64 + i * 8); const unsigned ww[4] = {w.x, w.y, w.z, w.w};
#pragma unroll
            for (int c = 0; c < 4; ++c) { s += qv[i * 8 + 2 * c] * bf2f(ww[c] & 0xffff) + qv[i * 8 + 2 * c + 1] * bf2f(ww[c] >> 16); } }
        s += (fq - fcum[(size_t)bh * SEQ + j]) * LOG2E;
        const float mn = fmaxf(m, s), sc = exp2f(m - mn), p = exp2f(s - mn);
        l = l * sc + p; m = mn;
#pragma unroll
        for (int i = 0; i < 8; ++i) { const uint4 w = *(const uint4*)(V + rowk * AW + hh * 64 + i * 8); const unsigned ww[4] = {w.x, w.y, w.z, w.w};
#pragma unroll
            for (int c = 0; c < 4; ++c) { o[i * 8 + 2 * c] = o[i * 8 + 2 * c] * sc + p * bf2f(ww[c] & 0xffff); o[i * 8 + 2 * c + 1] = o[i * 8 + 2 * c + 1] * sc + p * bf2f(ww[c] >> 16); } }
    }
    float mall = m;
#pragma unroll
    for (int of = 1; of < 64; of <<= 1) mall = fmaxf(mall, __shfl_xor(mall, of));
    const float sc = (m == -INFINITY) ? 0.f : exp2f(m - mall);
    const float lt = wave_sum(l * sc); const float inv = 1.f / lt;
    float mine = 0.f;
#pragma unroll
    for (int d = 0; d < 64; ++d) { const float v = wave_sum(o[d] * sc); if (lane == d) mine = v; }
    O[rowq * AW + hh * 64 + lane] = (bf16)f2bf(mine * inv);
}

__device__ __forceinline__ void wave_argmax(float v, int idx, float& bv, int& bi) {
#pragma unroll
    for (int o = 1; o < 64; o <<= 1) { const float ov = __shfl_xor(v, o); const int oi = __shfl_xor(idx, o); if (ov > v || (ov == v && oi < idx)) { v = ov; idx = oi; } }
    bv = v; bi = idx;
}
__global__ void __launch_bounds__(64) k_peer(const bf16* qp, const bf16* skb, const float* sumsq, const bf16* ut, const bf16* vt, const float* fg, float* out) {
    __shared__ float qs[2048]; __shared__ float sc[256]; __shared__ float s1[16], s2[16]; __shared__ int i1[16], i2[16]; __shared__ int ex[128]; __shared__ float gt[128];
    const int lane = threadIdx.x, t = blockIdx.x;
    const float rstd2 = rsqrtf(sumsq[t] * (1.f / DM) + EPS);
    for (int i = lane; i < 2048; i += 64) qs[i] = bf2f(qp[(size_t)t * 2048 + i]) * rstd2;
    __syncthreads();
    for (int hh = 0; hh < PH; ++hh) {
        for (int r = 0; r < 4; ++r) { const int idx = r * 64 + lane, p = idx >> 7, n = idx & 127; const bf16* kr = skb + ((size_t)(hh * 2 + p) * NKEY + n) * HALF; const float* qq = qs + hh * 256 + p * 128;
            float a = 0.f; for (int c = 0; c < 128; ++c) a += qq[c] * bf2f(kr[c]); sc[idx] = a; }
        __syncthreads();
        for (int p = 0; p < 2; ++p) {
            float v0 = sc[p * 128 + lane], v1 = sc[p * 128 + 64 + lane];
            for (int k = 0; k < 16; ++k) { float v; int id; if (v0 >= v1) { v = v0; id = lane; } else { v = v1; id = lane + 64; }
                float bv; int bi; wave_argmax(v, id, bv, bi);
                if (lane == 0) { if (p == 0) { s1[k] = bv; i1[k] = bi; } else { s2[k] = bv; i2[k] = bi; } }
                if (bi == lane) v0 = -INFINITY; if (bi == lane + 64) v1 = -INFINITY; }
        }
        __syncthreads();
        float cv[4];
#pragma unroll
        for (int r = 0; r < 4; ++r) { const int idx = r * 64 + lane; cv[r] = s1[idx >> 4] + s2[idx & 15]; }
        float tops = 0.f; int topp = 0;
        for (int k = 0; k < 16; ++k) { float v = cv[0]; int id = lane;
#pragma unroll
            for (int r = 1; r < 4; ++r) if (cv[r] > v) { v = cv[r]; id = r * 64 + lane; }
            float bv; int bi; wave_argmax(v, id, bv, bi);
            if (lane == k) { tops = bv; topp = bi; }
#pragma unroll
            for (int r = 0; r < 4; ++r) if (bi == r * 64 + lane) cv[r] = -INFINITY; }
        float mx = lane < 16 ? tops : -INFINITY;
#pragma unroll
        for (int o = 1; o < 64; o <<= 1) mx = fmaxf(mx, __shfl_xor(mx, o));
        const float ev = lane < 16 ? expf(tops - mx) : 0.f; const float den = wave_sum(ev);
        if (lane < 16) { ex[hh * 16 + lane] = i1[topp >> 4] * NKEY + i2[topp & 15]; gt[hh * 16 + lane] = ev / den; }
        __syncthreads();
    }
    float hv[16], y[16];
    const float* x1 = out + (size_t)t * DM;
#pragma unroll
    for (int j = 0; j < 4; ++j) { const float4 v = *(const float4*)(x1 + j * 256 + lane * 4); hv[4 * j] = v.x * rstd2; hv[4 * j + 1] = v.y * rstd2; hv[4 * j + 2] = v.z * rstd2; hv[4 * j + 3] = v.w * rstd2; }
#pragma unroll
    for (int i = 0; i < 16; ++i) y[i] = 0.f;
    for (int k = 0; k < 128; ++k) { const int e = ex[k]; const float g = gt[k]; float a = 0.f;
#pragma unroll
        for (int j = 0; j < 4; ++j) { const uint2 w = *(const uint2*)(ut + (size_t)e * DM + j * 256 + lane * 4);
            a += hv[4 * j] * bf2f(w.x & 0xffff) + hv[4 * j + 1] * bf2f(w.x >> 16) + hv[4 * j + 2] * bf2f(w.y & 0xffff) + hv[4 * j + 3] * bf2f(w.y >> 16); }
        a = wave_sum(a); const float act = gelu_tanh(a) * g;
#pragma unroll
        for (int j = 0; j < 4; ++j) { const uint2 w = *(const uint2*)(vt + (size_t)e * DM + j * 256 + lane * 4);
            y[4 * j] += act * bf2f(w.x & 0xffff); y[4 * j + 1] += act * bf2f(w.x >> 16); y[4 * j + 2] += act * bf2f(w.y & 0xffff); y[4 * j + 3] += act * bf2f(w.y >> 16); } }
    float ss = 0.f;
#pragma unroll
    for (int j = 0; j < 4; ++j) { const float4 v = *(const float4*)(x1 + j * 256 + lane * 4); y[4 * j] += v.x; y[4 * j + 1] += v.y; y[4 * j + 2] += v.z; y[4 * j + 3] += v.w; }
#pragma unroll
    for (int i = 0; i < 16; ++i) ss += y[i] * y[i];
    const float rs = rsqrtf(wave_sum(ss) * (1.f / DM) + EPS);
#pragma unroll
    for (int j = 0; j < 4; ++j) { const float4 g = *(const float4*)(fg + j * 256 + lane * 4); float4 o; o.x = y[4 * j] * rs * g.x; o.y = y[4 * j + 1] * rs * g.y; o.z = y[4 * j + 2] * rs * g.z; o.w = y[4 * j + 3] * rs * g.w;
        *(float4*)(out + (size_t)t * DM + j * 256 + lane * 4) = o; }
}
}

extern "C" void kernel_launch(void* const* d_in, const int* in_sizes, int n_in, void* d_out, int out_size, void* d_ws, size_t ws_size, hipStream_t stream) {
    const float* x = (const float*)d_in[0]; const float* g1 = (const float*)d_in[1]; const float* w_in = (const float*)d_in[2];
    const float* cw = (const float*)d_in[3]; const float* cb = (const float*)d_in[4]; const float* wa = (const float*)d_in[5]; const float* ba = (const float*)d_in[6];
    const float* wx = (const float*)d_in[7]; const float* bx = (const float*)d_in[8]; const float* lam = (const float*)d_in[9]; const float* bfv = (const float*)d_in[10];
    const float* gn_l = (const float*)d_in[11]; const float* gn_f = (const float*)d_in[12]; const float* w_out = (const float*)d_in[13]; const float* g2 = (const float*)d_in[14];
    const float* w_q = (const float*)d_in[15]; const float* sk = (const float*)d_in[16]; const float* pu = (const float*)d_in[17]; const float* pv = (const float*)d_in[18]; const float* fg = (const float*)d_in[19];
    char* ws = (char*)d_ws; float* out = (float*)d_out;
    bf16* win_t = (bf16*)(ws + WS_WIN); bf16* wout_t = (bf16*)(ws + WS_WOUT); bf16* wq_t = (bf16*)(ws + WS_WQ); bf16* skb = (bf16*)(ws + WS_SKB); float* wfl = (float*)(ws + WS_WFL);
    float* logf = (float*)(ws + WS_LOGF); float* fcum = (float*)(ws + WS_FCUM); float* sumsq = (float*)(ws + WS_SUMSQ);
    bf16* h = (bf16*)(ws + WS_H); bf16* xr = (bf16*)(ws + WS_XR); bf16* gr = (bf16*)(ws + WS_GR); bf16* q = (bf16*)(ws + WS_Q); bf16* k = (bf16*)(ws + WS_K); bf16* v = (bf16*)(ws + WS_V);
    bf16* x1b = (bf16*)(ws + WS_X1B); bf16* qp = (bf16*)(ws + WS_QP); bf16* ut = (bf16*)(ws + WS_UT); bf16* vt = (bf16*)(ws + WS_VT); float* la = (float*)(ws + WS_LA); float* lu = (float*)(ws + WS_LU);
    bf16* ymix = h;
    if (ws_size < WS_END) return;
    k_prep_w<<<2048, 256, 0, stream>>>(w_in, w_out, gn_l, gn_f, w_q, g2, sk, win_t, wfl, wout_t, wq_t, skb);
    k_prep_tab<<<4096, 256, 0, stream>>>(pu, pv, g2, ut, vt);
    k_prep_x<<<2048, 256, 0, stream>>>(x, g1, wfl, bfv, h, logf);
    k_fcum<<<BATCH * NH, 64, 0, stream>>>(logf, fcum);
    { EpiArgs e{xr, gr, q, k, v, nullptr, nullptr}; k_gemm<1><<<dim3(NG1 / 64, T / 64), 256, 0, stream>>>(h, win_t, T, NG1, DM, e); }
    k_lru_gates<<<T * NH, 64, 0, stream>>>(xr, cw, cb, wa, ba, wx, bx, lam, la, lu);
    k_lru_scan<<<(BATCH * LW + 63) / 64, 64, 0, stream>>>(la, lu, gr);
    k_attn<<<(BATCH * NH * SEQ) / 4, 256, 0, stream>>>(q, k, v, fcum, q);
    k_ymix<<<2048, 256, 0, stream>>>(lu, q, ymix);
    { EpiArgs e{x1b, nullptr, nullptr, nullptr, nullptr, x, out}; k_gemm<2><<<dim3(DM / 64, T / 64), 256, 0, stream>>>(ymix, wout_t, T, DM, DM, e); }
    k_sumsq<<<2048, 256, 0, stream>>>(out, sumsq);
    { EpiArgs e{qp, nullptr, nullptr, nullptr, nullptr, nullptr, nullptr}; k_gemm<3><<<dim3(2048 / 64, T / 64), 256, 0, stream>>>(x1b, wq_t, T, 2048, DM, e); }
    k_peer<<<T, 64, 0, stream>>>(qp, skb, sumsq, ut, vt, fg, out);
}
```

```cpp
#include <hip/hip_runtime.h>
#include <hip/hip_bf16.h>
#include <cstdio>
#include <cstdint>
#include <cmath>

constexpr int BATCH = 4, SEQ = 8192, DMODEL = 1024, T = BATCH * SEQ;
constexpr int LW = 512, AW = 512, NHEADS = 8, HD = 64, INC = 2568, NG1 = 2560;
constexpr int PH = 8, NKEY = 128, PHALF = 128, TOPK = 16, NEXP = NKEY * NKEY, QPW = 2048;
constexpr float RMS_EPS = 1e-6f;
constexpr float LOG2E = 1.4426950408889634f;
constexpr float QSCALE = 0.125f * LOG2E;
constexpr size_t MiB = 1u << 20;
constexpr size_t WS_CTL = 0, CTL_ZERO_BYTES = 1 * MiB;
constexpr size_t WS_WIN = 2 * MiB, WS_WOUT = 8 * MiB, WS_WQ = 10 * MiB, WS_SKB = 14 * MiB, WS_WFL = 15 * MiB,
                 WS_LOGF = 16 * MiB, WS_FCUM = 17 * MiB, WS_CARRY = 18 * MiB, WS_SUMSQ = 19 * MiB, WS_WAX = 20 * MiB,
                 WS_H = 32 * MiB, WS_XR = 96 * MiB, WS_GR = 128 * MiB, WS_Q = 160 * MiB, WS_K = 192 * MiB, WS_V = 224 * MiB,
                 WS_X1B = 256 * MiB, WS_QP = 96 * MiB, WS_UT = 320 * MiB, WS_VT = 352 * MiB, WS_LA = 384 * MiB, WS_LU = 448 * MiB, WS_END = 512 * MiB;
constexpr size_t SPLIT_STRIDE = (WS_GR - WS_XR) / 2;
constexpr int CW_TMO = 0, CW_BAR = 4096;

namespace naive {
typedef unsigned short bf16;
__device__ __forceinline__ unsigned f2bf(float f) { unsigned u = __builtin_bit_cast(unsigned, f); return (u + 0x7fffu + ((u >> 16) & 1u)) >> 16; }
__device__ __forceinline__ float bf2f(unsigned short h) { return __builtin_bit_cast(float, (unsigned)h << 16); }
__device__ __forceinline__ float gelu_tanh(float x) { const float u = 0.7978845608028654f * (x + 0.044715f * x * x * x); return 0.5f * x * (1.f + tanhf(u)); }
__device__ __forceinline__ float sigmoidf_(float x) { return 1.f / (1.f + expf(-x)); }
__device__ __forceinline__ float wave_sum(float v) {
#pragma unroll
    for (int o = 1; o < 64; o <<= 1) v += __shfl_xor(v, o);
    return v;
}
__global__ void k_prep_w(const float* w_in, const float* w_out, const float* gn_l, const float* gn_f, const float* w_q, const float* g2, const float* sk,
                         bf16* win_t, float* wfl, bf16* wout_t, bf16* wq_t, bf16* skb) {
    const size_t gid = (size_t)blockIdx.x * blockDim.x + threadIdx.x, gsz = (size_t)gridDim.x * blockDim.x;
    for (size_t i = gid; i < (size_t)NG1 * DMODEL; i += gsz) { const int n = (int)(i / DMODEL), k = (int)(i % DMODEL); win_t[i] = (bf16)f2bf(w_in[(size_t)k * INC + n]); }
    for (size_t i = gid; i < (size_t)8 * DMODEL; i += gsz) { const int j = (int)(i / DMODEL), k = (int)(i % DMODEL); wfl[i] = w_in[(size_t)k * INC + NG1 + j]; }
    for (size_t i = gid; i < (size_t)DMODEL * DMODEL; i += gsz) { const int n = (int)(i / DMODEL), k = (int)(i % DMODEL); const float g = k < LW ? gn_l[k] : gn_f[k - LW]; wout_t[i] = (bf16)f2bf(g * w_out[(size_t)k * DMODEL + n]); }
    for (size_t i = gid; i < (size_t)QPW * DMODEL; i += gsz) { const int n = (int)(i / DMODEL), k = (int)(i % DMODEL); wq_t[i] = (bf16)f2bf(g2[k] * w_q[(size_t)k * QPW + n]); }
    for (size_t i = gid; i < (size_t)PH * 2 * NKEY * PHALF; i += gsz) skb[i] = (bf16)f2bf(sk[i]);
}
__global__ void k_prep_tab(const float* u, const float* v, const float* g2, bf16* ut, bf16* vt) {
    const size_t gid = (size_t)blockIdx.x * blockDim.x + threadIdx.x, gsz = (size_t)gridDim.x * blockDim.x;
    for (size_t i = gid; i < (size_t)NEXP * DMODEL; i += gsz) { const int d = (int)(i % DMODEL); ut[i] = (bf16)f2bf(g2[d] * u[i]); vt[i] = (bf16)f2bf(v[i]); }
}
__global__ void k_prep_x(const float* x, const float* g1, const float* wfl, const float* bfv, bf16* h, float* logf) {
    const int lane = threadIdx.x & 63, wv = (blockIdx.x * blockDim.x + threadIdx.x) >> 6, nw = (gridDim.x * blockDim.x) >> 6;
    for (int t = wv; t < T; t += nw) {
        float xv[16]; float ss = 0.f;
#pragma unroll
        for (int j = 0; j < 4; ++j) { const float4 v = *(const float4*)(x + (size_t)t * DMODEL + j * 256 + lane * 4); xv[4 * j] = v.x; xv[4 * j + 1] = v.y; xv[4 * j + 2] = v.z; xv[4 * j + 3] = v.w; ss += v.x * v.x + v.y * v.y + v.z * v.z + v.w * v.w; }
        const float rstd = rsqrtf(wave_sum(ss) * (1.f / DMODEL) + RMS_EPS);
#pragma unroll
        for (int j = 0; j < 4; ++j) { const float4 g = *(const float4*)(g1 + j * 256 + lane * 4); xv[4 * j] *= rstd * g.x; xv[4 * j + 1] *= rstd * g.y; xv[4 * j + 2] *= rstd * g.z; xv[4 * j + 3] *= rstd * g.w;
            uint2 o; o.x = f2bf(xv[4 * j]) | (f2bf(xv[4 * j + 1]) << 16); o.y = f2bf(xv[4 * j + 2]) | (f2bf(xv[4 * j + 3]) << 16); *(uint2*)(h + (size_t)t * DMODEL + j * 256 + lane * 4) = o; }
#pragma unroll
        for (int hh = 0; hh < 8; ++hh) { float a = 0.f;
#pragma unroll
            for (int j = 0; j < 4; ++j) { const float4 w = *(const float4*)(wfl + hh * DMODEL + j * 256 + lane * 4); a += xv[4 * j] * w.x + xv[4 * j + 1] * w.y + xv[4 * j + 2] * w.z + xv[4 * j + 3] * w.w; }
            a = wave_sum(a);
            if (lane == 0) { const float z = a + bfv[hh]; logf[(size_t)t * 8 + hh] = fminf(z, 0.f) - log1pf(expf(-fabsf(z))); } }
    }
}
__global__ void k_fcum(const float* logf, float* fcum) {
    const int lane = threadIdx.x & 63, bh = blockIdx.x, b = bh / NHEADS, hh = bh % NHEADS;
    float loc = 0.f;
    for (int i = 0; i < 128; ++i) loc += logf[((size_t)b * SEQ + lane * 128 + i) * 8 + hh];
    float inc = loc;
#pragma unroll
    for (int o = 1; o < 64; o <<= 1) { const float n = __shfl_up(inc, o); if (lane >= o) inc += n; }
    float run = inc - loc;
    for (int i = 0; i < 128; ++i) { run += logf[((size_t)b * SEQ + lane * 128 + i) * 8 + hh]; fcum[(size_t)bh * SEQ + lane * 128 + i] = run; }
}
struct EpiArgs { bf16* o0; bf16* o1; bf16* o2; bf16* o3; bf16* o4; const float* resid; float* outf; };
template <int EPI> __global__ void __launch_bounds__(256) k_gemm(const bf16* A, const bf16* Bt, int M, int N, int K, EpiArgs e) {
    __shared__ float As[32][65], Bs[32][65];
    const int tid = threadIdx.x, tx = tid & 15, ty = tid >> 4, m0 = blockIdx.y * 64, n0 = blockIdx.x * 64;
    float acc[4][4] = {};
    const int lr = tid >> 2, lc = (tid & 3) * 8;
    for (int k0 = 0; k0 < K; k0 += 32) {
        const uint4 av = *(const uint4*)(A + (size_t)(m0 + lr) * K + k0 + lc), bv = *(const uint4*)(Bt + (size_t)(n0 + lr) * K + k0 + lc);
        const unsigned aw[4] = {av.x, av.y, av.z, av.w}, bw[4] = {bv.x, bv.y, bv.z, bv.w};
#pragma unroll
        for (int i = 0; i < 4; ++i) { As[lc + 2 * i][lr] = bf2f(aw[i] & 0xffff); As[lc + 2 * i + 1][lr] = bf2f(aw[i] >> 16); Bs[lc + 2 * i][lr] = bf2f(bw[i] & 0xffff); Bs[lc + 2 * i + 1][lr] = bf2f(bw[i] >> 16); }
        __syncthreads();
#pragma unroll 8
        for (int k = 0; k < 32; ++k) { float a[4], b[4];
#pragma unroll
            for (int i = 0; i < 4; ++i) { a[i] = As[k][ty * 4 + i]; b[i] = Bs[k][tx * 4 + i]; }
#pragma unroll
            for (int i = 0; i < 4; ++i)
#pragma unroll
                for (int j = 0; j < 4; ++j) acc[i][j] += a[i] * b[j]; }
        __syncthreads();
    }
#pragma unroll
    for (int i = 0; i < 4; ++i)
#pragma unroll
        for (int j = 0; j < 4; ++j) { const int m = m0 + ty * 4 + i, n = n0 + tx * 4 + j; const float v = acc[i][j];
            if (EPI == 1) { const int s = n >> 9, c = n & 511; bf16* o = s == 0 ? e.o0 : s == 1 ? e.o1 : s == 2 ? e.o2 : s == 3 ? e.o3 : e.o4;
                const float w = s == 1 ? gelu_tanh(v) : s == 2 ? v * QSCALE : v; o[(size_t)m * 512 + c] = (bf16)f2bf(w); }
            else if (EPI == 2) { const float r = e.resid[(size_t)m * DMODEL + n] + v; e.outf[(size_t)m * DMODEL + n] = r; e.o0[(size_t)m * DMODEL + n] = (bf16)f2bf(r); }
            else { e.o0[(size_t)m * N + n] = (bf16)f2bf(v); } }
}
__global__ void k_sumsq(const float* x1, float* sumsq) {
    const int lane = threadIdx.x & 63, wv = (blockIdx.x * blockDim.x + threadIdx.x) >> 6, nw = (gridDim.x * blockDim.x) >> 6;
    for (int t = wv; t < T; t += nw) { float ss = 0.f;
#pragma unroll
        for (int j = 0; j < 4; ++j) { const float4 v = *(const float4*)(x1 + (size_t)t * DMODEL + j * 256 + lane * 4); ss += v.x * v.x + v.y * v.y + v.z * v.z + v.w * v.w; }
        ss = wave_sum(ss); if (lane == 0) sumsq[t] = ss; }
}
__global__ void k_lru_gates(const bf16* xr, const float* cw, const float* cb, const float* wa, const float* ba, const float* wx, const float* bx, const float* lam, float* la, float* lu) {
    __shared__ float xc[64];
    const int j = threadIdx.x, t = blockIdx.x / NHEADS, hh = blockIdx.x % NHEADS, ch = hh * 64 + j, s = t % SEQ;
    float c = cb[ch];
#pragma unroll
    for (int k = 0; k < 4; ++k) { const int ss = s - 3 + k; if (ss >= 0) c += cw[k * LW + ch] * bf2f(xr[(size_t)(t - 3 + k) * LW + ch]); }
    xc[j] = c; __syncthreads();
    float r = ba[ch], ii = bx[ch];
    for (int i = 0; i < 64; ++i) { const float xv = xc[i]; r += xv * wa[(size_t)(hh * 64 + i) * 64 + j]; ii += xv * wx[(size_t)(hh * 64 + i) * 64 + j]; }
    r = sigmoidf_(r); ii = sigmoidf_(ii);
    const float l = lam[ch], sp = fmaxf(-l, 0.f) + log1pf(expf(-fabsf(l)));
    const float log_a = -8.f * r * sp, a = expf(log_a), u = sqrtf(-expm1f(2.f * log_a)) * (ii * c);
    la[(size_t)t * LW + ch] = a; lu[(size_t)t * LW + ch] = u;
}
__global__ void k_lru_scan(const float* la, float* lu, const bf16* gr) {
    const int id = blockIdx.x * blockDim.x + threadIdx.x; if (id >= BATCH * LW) return;
    const int b = id / LW, ch = id % LW; float h = 0.f;
    for (int s = 0; s < SEQ; ++s) { const size_t o = ((size_t)b * SEQ + s) * LW + ch; h = la[o] * h + lu[o]; lu[o] = h * bf2f(gr[o]); }
}
__global__ void k_ymix(const float* ylru, const bf16* o, bf16* ymix) {
    const int lane = threadIdx.x & 63, wv = (blockIdx.x * blockDim.x + threadIdx.x) >> 6, nw = (gridDim.x * blockDim.x) >> 6;
    for (int t = wv; t < T; t += nw) {
        float a[8], f[8]; float sa = 0.f, sf = 0.f;
#pragma unroll
        for (int i = 0; i < 8; ++i) { a[i] = ylru[(size_t)t * LW + i * 64 + lane]; f[i] = bf2f(o[(size_t)t * AW + i * 64 + lane]); sa += a[i] * a[i]; sf += f[i] * f[i]; }
        const float ra = rsqrtf(wave_sum(sa) * (1.f / LW) + RMS_EPS), rf = rsqrtf(wave_sum(sf) * (1.f / AW) + RMS_EPS);
#pragma unroll
        for (int i = 0; i < 8; ++i) { ymix[(size_t)t * DMODEL + i * 64 + lane] = (bf16)f2bf(a[i] * ra); ymix[(size_t)t * DMODEL + LW + i * 64 + lane] = (bf16)f2bf(f[i] * rf); }
    }
}
__global__ void __launch_bounds__(256) k_attn(const bf16* Q, const bf16* K, const bf16* V, const float* fcum, bf16* O) {
    const int lane = threadIdx.x & 63, wv = (blockIdx.x * blockDim.x + threadIdx.x) >> 6;
    const int q = wv % SEQ, bh = wv / SEQ, b = bh / NHEADS, hh = bh % NHEADS;
    const size_t rowq = (size_t)b * SEQ + q;
    float qv[64];
#pragma unroll
    for (int i = 0; i < 8; ++i) { const uint4 w = *(const uint4*)(Q + rowq * AW + hh * 64 + i * 8); const unsigned ww[4] = {w.x, w.y, w.z, w.w};
#pragma unroll
        for (int c = 0; c < 4; ++c) { qv[i * 8 + 2 * c] = bf2f(ww[c] & 0xffff); qv[i * 8 + 2 * c + 1] = bf2f(ww[c] >> 16); } }
    const float fq = fcum[(size_t)bh * SEQ + q];
    float m = -INFINITY, l = 0.f; float o[64];
#pragma unroll
    for (int d = 0; d < 64; ++d) o[d] = 0.f;
    for (int j = lane; j <= q; j += 64) {
        const size_t rowk = (size_t)b * SEQ + j; float s = 0.f;
#pragma unroll
        for (int i = 0; i < 8; ++i) { const uint4 w = *(const uint4*)(K + rowk * AW + hh * 64 + i * 8); const unsigned ww[4] = {w.x, w.y, w.z, w.w};
#pragma unroll
            for (int c = 0; c < 4; ++c) { s += qv[i * 8 + 2 * c] * bf2f(ww[c] & 0xffff) + qv[i * 8 + 2 * c + 1] * bf2f(ww[c] >> 16); } }
        s += (fq - fcum[(size_t)bh * SEQ + j]) * LOG2E;
        const float mn = fmaxf(m, s), sc = exp2f(m - mn), p = exp2f(s - mn);
        l = l * sc + p; m = mn;
#pragma unroll
        for (int i = 0; i < 8; ++i) { const uint4 w = *(const uint4*)(V + rowk * AW + hh * 64 + i * 8); const unsigned ww[4] = {w.x, w.y, w.z, w.w};
#pragma unroll
            for (int c = 0; c < 4; ++c) { o[i * 8 + 2 * c] = o[i * 8 + 2 * c] * sc + p * bf2f(ww[c] & 0xffff); o[i * 8 + 2 * c + 1] = o[i * 8 + 2 * c + 1] * sc + p * bf2f(ww[c] >> 16); } }
    }
    float mall = m;
#pragma unroll
    for (int of = 1; of < 64; of <<= 1) mall = fmaxf(mall, __shfl_xor(mall, of));
    const float sc = (m == -INFINITY) ? 0.f : exp2f(m - mall);
    const float lt = wave_sum(l * sc); const float inv = 1.f / lt;
    float mine = 0.f;
#pragma unroll
    for (int d = 0; d < 64; ++d) { const float v = wave_sum(o[d] * sc); if (lane == d) mine = v; }
    O[rowq * AW + hh * 64 + lane] = (bf16)f2bf(mine * inv);
}
__device__ __forceinline__ void wave_argmax(float v, int idx, float& bv, int& bi) {
#pragma unroll
    for (int o = 1; o < 64; o <<= 1) { const float ov = __shfl_xor(v, o); const int oi = __shfl_xor(idx, o); if (ov > v || (ov == v && oi < idx)) { v = ov; idx = oi; } }
    bv = v; bi = idx;
}
__global__ void __launch_bounds__(64) k_peer(const bf16* qp, const bf16* skb, const float* sumsq, const bf16* ut, const bf16* vt, const float* fg, float* out) {
    __shared__ float qs[2048]; __shared__ float sc[256]; __shared__ float s1[16], s2[16]; __shared__ int i1[16], i2[16]; __shared__ int ex[128]; __shared__ float gt[128];
    const int lane = threadIdx.x, t = blockIdx.x;
    const float rstd2 = rsqrtf(sumsq[t] * (1.f / DMODEL) + RMS_EPS);
    for (int i = lane; i < 2048; i += 64) qs[i] = bf2f(qp[(size_t)t * 2048 + i]) * rstd2;
    __syncthreads();
    for (int hh = 0; hh < PH; ++hh) {
        for (int r = 0; r < 4; ++r) { const int idx = r * 64 + lane, p = idx >> 7, n = idx & 127; const bf16* kr = skb + ((size_t)(hh * 2 + p) * NKEY + n) * PHALF; const float* qq = qs + hh * 256 + p * 128;
            float a = 0.f; for (int c = 0; c < 128; ++c) a += qq[c] * bf2f(kr[c]); sc[idx] = a; }
        __syncthreads();
        for (int p = 0; p < 2; ++p) {
            float v0 = sc[p * 128 + lane], v1 = sc[p * 128 + 64 + lane];
            for (int k = 0; k < 16; ++k) { float v; int id; if (v0 >= v1) { v = v0; id = lane; } else { v = v1; id = lane + 64; }
                float bv; int bi; wave_argmax(v, id, bv, bi);
                if (lane == 0) { if (p == 0) { s1[k] = bv; i1[k] = bi; } else { s2[k] = bv; i2[k] = bi; } }
                if (bi == lane) v0 = -INFINITY; if (bi == lane + 64) v1 = -INFINITY; }
        }
        __syncthreads();
        float cv[4];
#pragma unroll
        for (int r = 0; r < 4; ++r) { const int idx = r * 64 + lane; cv[r] = s1[idx >> 4] + s2[idx & 15]; }
        float tops = 0.f; int topp = 0;
        for (int k = 0; k < 16; ++k) { float v = cv[0]; int id = lane;
#pragma unroll
            for (int r = 1; r < 4; ++r) if (cv[r] > v) { v = cv[r]; id = r * 64 + lane; }
            float bv; int bi; wave_argmax(v, id, bv, bi);
            if (lane == k) { tops = bv; topp = bi; }
#pragma unroll
            for (int r = 0; r < 4; ++r) if (bi == r * 64 + lane) cv[r] = -INFINITY; }
        float mx = lane < 16 ? tops : -INFINITY;
#pragma unroll
        for (int o = 1; o < 64; o <<= 1) mx = fmaxf(mx, __shfl_xor(mx, o));
        const float ev = lane < 16 ? expf(tops - mx) : 0.f; const float den = wave_sum(ev);
        if (lane < 16) { ex[hh * 16 + lane] = i1[topp >> 4] * NKEY + i2[topp & 15]; gt[hh * 16 + lane] = ev / den; }
        __syncthreads();
    }
    float hv[16], y[16];
    const float* x1 = out + (size_t)t * DMODEL;
#pragma unroll
    for (int j = 0; j < 4; ++j) { const float4 v = *(const float4*)(x1 + j * 256 + lane * 4); hv[4 * j] = v.x * rstd2; hv[4 * j + 1] = v.y * rstd2; hv[4 * j + 2] = v.z * rstd2; hv[4 * j + 3] = v.w * rstd2; }
#pragma unroll
    for (int i = 0; i < 16; ++i) y[i] = 0.f;
    for (int k = 0; k < 128; ++k) { const int e = ex[k]; const float g = gt[k]; float a = 0.f;
#pragma unroll
        for (int j = 0; j < 4; ++j) { const uint2 w = *(const uint2*)(ut + (size_t)e * DMODEL + j * 256 + lane * 4);
            a += hv[4 * j] * bf2f(w.x & 0xffff) + hv[4 * j + 1] * bf2f(w.x >> 16) + hv[4 * j + 2] * bf2f(w.y & 0xffff) + hv[4 * j + 3] * bf2f(w.y >> 16); }
        a = wave_sum(a); const float act = gelu_tanh(a) * g;
#pragma unroll
        for (int j = 0; j < 4; ++j) { const uint2 w = *(const uint2*)(vt + (size_t)e * DMODEL + j * 256 + lane * 4);
            y[4 * j] += act * bf2f(w.x & 0xffff); y[4 * j + 1] += act * bf2f(w.x >> 16); y[4 * j + 2] += act * bf2f(w.y & 0xffff); y[4 * j + 3] += act * bf2f(w.y >> 16); } }
    float ss = 0.f;
#pragma unroll
    for (int j = 0; j < 4; ++j) { const float4 v = *(const float4*)(x1 + j * 256 + lane * 4); y[4 * j] += v.x; y[4 * j + 1] += v.y; y[4 * j + 2] += v.z; y[4 * j + 3] += v.w; }
#pragma unroll
    for (int i = 0; i < 16; ++i) ss += y[i] * y[i];
    const float rs = rsqrtf(wave_sum(ss) * (1.f / DMODEL) + RMS_EPS);
#pragma unroll
    for (int j = 0; j < 4; ++j) { const float4 g = *(const float4*)(fg + j * 256 + lane * 4); float4 o; o.x = y[4 * j] * rs * g.x; o.y = y[4 * j + 1] * rs * g.y; o.z = y[4 * j + 2] * rs * g.z; o.w = y[4 * j + 3] * rs * g.w;
        *(float4*)(out + (size_t)t * DMODEL + j * 256 + lane * 4) = o; }
}
}

namespace pg8 {
#define PG8_LAS __attribute__((address_space(3)))
typedef unsigned short bf16_t;
typedef short bf16x8 __attribute__((ext_vector_type(8)));
typedef float f32x4 __attribute__((ext_vector_type(4)));
typedef unsigned u32x4 __attribute__((ext_vector_type(4)));
constexpr int BM = 256, BK = 64, HALF = 128, HTB = HALF * BK * 2  , STAGE_BYTES = 8 * HTB, NXCD = 8, WGM = 8;

__host__ __device__ __forceinline__ int lds_byte(int r, int c) { const int st = (r >> 4) * 2 + (c >> 5), rr = r & 15, cc = c & 31, ob = rr * 64 + cc * 2; return st * 1024 + (ob ^ (((ob >> 9) & 1) << 5)); }
__host__ __device__ __forceinline__ void stage_rc(int b, int& R, int& C) { const int st = b / 1024, sb = b % 1024, swz = sb ^ (((sb >> 9) & 1) << 5); R = (st >> 1) * 16 + swz / 64; C = (st & 1) * 32 + (swz % 64) / 2; }
__host__ __device__ __forceinline__ int perm32(int rho) { const int n = rho >> 4, i = rho & 15; return 8 * (i >> 2) + 4 * n + (i & 3); }

struct Unit { int pm, pn; };
struct Gemm { const bf16_t* A; const bf16_t* Bt; int M, N, K; };

struct StaticOrder {
    int nM, nN, nwg, G, c;
    __host__ __device__ void init(int M, int N, int G_, int c_) { nM = M / BM; nN = N / BM; nwg = nM * nN; G = G_; c = c_; }
    __host__ __device__ bool next(int i, Unit& u) const {
        const long L = (long)i * G + c; if (L >= nwg) return false;
        int wgid = (int)L; { const int q = nwg / NXCD, r = nwg % NXCD, xcd = wgid % NXCD, off = wgid / NXCD; wgid = (xcd < r ? xcd * (q + 1) : r * (q + 1) + (xcd - r) * q) + off; }
        const int nig = WGM * nN, gid = wgid / nig, fm = gid * WGM, gsz = (nM - fm) < WGM ? (nM - fm) : WGM;
        u.pm = fm + ((wgid % nig) % gsz); u.pn = (wgid % nig) / gsz; return true;
    }
    __device__ __forceinline__ void a_ready(const Unit&) const {}
    __device__ __forceinline__ void done(const Unit&) const {}
};

__device__ __forceinline__ unsigned cvt_pk_bf16(float lo, float hi) { unsigned r; asm volatile("v_cvt_pk_bf16_f32 %0, %1, %2" : "=v"(r) : "v"(lo), "v"(hi)); return r; }
typedef unsigned u32x2 __attribute__((ext_vector_type(2)));
__device__ __forceinline__ float gelu_fast(float x) {
    const float u2 = x * (1.5957691216057308f + 0.07135481627f * x * x);
    return x * __builtin_amdgcn_rcpf(1.f + __builtin_amdgcn_exp2f(-1.4426950408889634f * u2));
}
struct EpiG1 {
    static constexpr bool PERM = true, AFTER_DRAIN = false;
    bf16_t* base0; size_t split_stride; float qscale;
    __device__ __forceinline__ void operator()(const f32x4 (&acc)[2][2][4][2], const Unit& u, int wr, int wc, int fr, int fq) const {
        const int s = u.pn >> 1; bf16_t* base = base0 + (size_t)s * split_stride;
        const int row0 = u.pm * BM + wr * 64 + fr, col0 = (u.pn & 1) * 256 + wc * 32 + 8 * fq;
#pragma unroll
        for (int ai = 0; ai < 2; ++ai)
#pragma unroll
            for (int m = 0; m < 4; ++m) { bf16_t* rowp = base + (size_t)(row0 + ai * HALF + m * 16) * 512 + col0;
#pragma unroll
                for (int bj = 0; bj < 2; ++bj) { f32x4 v0 = acc[ai][bj][m][0], v1 = acc[ai][bj][m][1];
                    if (s == 1) {
#pragma unroll
                        for (int e = 0; e < 4; ++e) { v0[e] = gelu_fast(v0[e]); v1[e] = gelu_fast(v1[e]); } }
                    else if (s == 2) { v0 = v0 * qscale; v1 = v1 * qscale; }
                    u32x4 w; w.x = cvt_pk_bf16(v0[0], v0[1]); w.y = cvt_pk_bf16(v0[2], v0[3]); w.z = cvt_pk_bf16(v1[0], v1[1]); w.w = cvt_pk_bf16(v1[2], v1[3]);
                    *(u32x4*)(rowp + bj * HALF) = w; } }
    }
};
struct EpiG2 {
    static constexpr bool PERM = false, AFTER_DRAIN = false;
    const float* resid; float* out; bf16_t* xb; float* sumsq; int ldc;
    __device__ __forceinline__ void operator()(const f32x4 (&acc)[2][2][4][2], const Unit& u, int wr, int wc, int fr, int fq) const {
        const int row0 = u.pm * BM + wr * 64 + fr, col0 = u.pn * BM + wc * 32 + 4 * fq;
#pragma unroll
        for (int ai = 0; ai < 2; ++ai)
#pragma unroll
            for (int m = 0; m < 4; ++m) { const int r = row0 + ai * HALF + m * 16; const size_t off = (size_t)r * ldc + col0; float ss = 0.f;
#pragma unroll
                for (int bj = 0; bj < 2; ++bj)
#pragma unroll
                    for (int n = 0; n < 2; ++n) { const f32x4 x = *(const f32x4*)(resid + off + bj * HALF + n * 16) + acc[ai][bj][m][n];
                        *(f32x4*)(out + off + bj * HALF + n * 16) = x; ss += (x[0] * x[0] + x[1] * x[1]) + (x[2] * x[2] + x[3] * x[3]);
                        u32x2 w; w.x = cvt_pk_bf16(x[0], x[1]); w.y = cvt_pk_bf16(x[2], x[3]); *(u32x2*)(xb + off + bj * HALF + n * 16) = w; }
                ss += __shfl_xor(ss, 16); ss += __shfl_xor(ss, 32);
                if (fq == 0) atomicAdd(sumsq + r, ss);
                asm volatile("" ::: "memory"); }
    }
};
struct EpiG3 {
    static constexpr bool PERM = true, AFTER_DRAIN = false;
    bf16_t* O; int ldc;
    __device__ __forceinline__ void operator()(const f32x4 (&acc)[2][2][4][2], const Unit& u, int wr, int wc, int fr, int fq) const {
        const int row0 = u.pm * BM + wr * 64 + fr, col0 = u.pn * BM + wc * 32 + 8 * fq;
#pragma unroll
        for (int ai = 0; ai < 2; ++ai)
#pragma unroll
            for (int m = 0; m < 4; ++m) { bf16_t* rowp = O + (size_t)(row0 + ai * HALF + m * 16) * ldc + col0;
#pragma unroll
                for (int bj = 0; bj < 2; ++bj) { const f32x4 v0 = acc[ai][bj][m][0], v1 = acc[ai][bj][m][1];
                    u32x4 w; w.x = cvt_pk_bf16(v0[0], v0[1]); w.y = cvt_pk_bf16(v0[2], v0[3]); w.z = cvt_pk_bf16(v1[0], v1[1]); w.w = cvt_pk_bf16(v1[2], v1[3]);
                    *(u32x4*)(rowp + bj * HALF) = w; } }
    }
};

template <class Epi, class Sched, bool ALIGN_EPI = false, bool SP2 = false>
__device__ __forceinline__ void gemm_phase(PG8_LAS unsigned char* lds, const Gemm g, const Sched& S, const Epi& E, int wid_in) {
    const int wid = __builtin_amdgcn_readfirstlane(wid_in), lane = (int)__builtin_amdgcn_mbcnt_hi(~0u, __builtin_amdgcn_mbcnt_lo(~0u, 0u)), tid = wid * 64 + lane, wr = wid >> 2, wc = wid & 3, fr = lane & 15, fq = lane >> 4;
    const int K = g.K, nt = K / BK;
    unsigned voffA[2], voffB[2];
#pragma unroll
    for (int i = 0; i < 2; ++i) { int R, C; stage_rc(tid * 16 + i * 8192, R, C); const int Rb = Epi::PERM ? ((R & ~31) + perm32(R & 31)) : R;
        voffA[i] = (unsigned)(R * K + C) * 2u; voffB[i] = (unsigned)(Rb * K + C) * 2u; }
    const size_t kstep = (size_t)(BK * 2);
    const size_t hstep = (size_t)HALF * K * 2;
    const size_t tstep = 2 * hstep;
    const unsigned ldsw = (unsigned)wid * 1024u;
    const int aoff = lds_byte(wr * 64 + fr, fq * 8), boff = lds_byte(wc * 32 + fr, fq * 8);
#define PG8_SA(b, h) (((b) * 2 + (h)) * HTB)
#define PG8_SB(b, h) ((4 + (b) * 2 + (h)) * HTB)
#define PG8_STAGE(bufoff, gbase, voff) do { _Pragma("unroll") for (int _i = 0; _i < 2; ++_i) \
        __builtin_amdgcn_global_load_lds((const unsigned*)((const char*)(gbase) + (voff)[_i]), (PG8_LAS unsigned*)(lds + (bufoff) + ldsw + _i * 8192), 16, 0, 0); } while (0)
#define PG8_LDA(dst, b, h) do { _Pragma("unroll") for (int m = 0; m < 4; ++m) _Pragma("unroll") for (int k = 0; k < 2; ++k) dst[m][k] = *(const PG8_LAS bf16x8*)(lds + PG8_SA(b, h) + aoff + m * 2048 + k * 1024); } while (0)
#define PG8_LDB(dst, b, h) do { _Pragma("unroll") for (int n = 0; n < 2; ++n) _Pragma("unroll") for (int k = 0; k < 2; ++k) dst[n][k] = *(const PG8_LAS bf16x8*)(lds + PG8_SB(b, h) + boff + n * 2048 + k * 1024); } while (0)
#define PG8_MMA(ai, bj, At, Bt) do { __builtin_amdgcn_s_setprio(1); _Pragma("unroll") for (int m = 0; m < 4; ++m) _Pragma("unroll") for (int n = 0; n < 2; ++n) _Pragma("unroll") for (int k = 0; k < 2; ++k) \
        acc[ai][bj][m][n] = __builtin_amdgcn_mfma_f32_16x16x32_bf16(Bt[n][k], At[m][k], acc[ai][bj][m][n], 0, 0, 0); __builtin_amdgcn_s_setprio(0); } while (0)
#define PG8_WAIT_V(n) asm volatile("s_waitcnt vmcnt(" #n ")" ::: "memory")
#define PG8_WAIT_L(n) asm volatile("s_waitcnt lgkmcnt(" #n ")" ::: "memory")
#define PG8_BAR __builtin_amdgcn_s_barrier()
#define PG8_SCHED __builtin_amdgcn_sched_barrier(0)
    Unit cur, nxt; int ui = 0;
    if (!S.next(0, cur)) return;
    f32x4 acc[2][2][4][2];
#pragma unroll
    for (int a = 0; a < 2; ++a)
#pragma unroll
        for (int b = 0; b < 2; ++b)
#pragma unroll
            for (int m = 0; m < 4; ++m)
#pragma unroll
                for (int n = 0; n < 2; ++n) acc[a][b][m][n] = (f32x4){0.f, 0.f, 0.f, 0.f};
    bf16x8 At[4][2], B0[2][2], B1[2][2];
    const char* cA = (const char*)g.A + (size_t)cur.pm * tstep; const char* cB = (const char*)g.Bt + (size_t)cur.pn * tstep;
    S.a_ready(cur);
    if constexpr (SP2) {
        PG8_STAGE(PG8_SB(0, 0), cB, voffB); PG8_STAGE(PG8_SB(0, 1), cB + hstep, voffB); PG8_STAGE(PG8_SA(0, 0), cA, voffA); PG8_STAGE(PG8_SA(0, 1), cA + hstep, voffA);
        if (wr == 1) PG8_BAR;
        PG8_WAIT_V(2); PG8_BAR;
        PG8_STAGE(PG8_SB(1, 0), cB + kstep, voffB); PG8_STAGE(PG8_SA(1, 0), cA + kstep, voffA); PG8_STAGE(PG8_SB(1, 1), cB + hstep + kstep, voffB);
        PG8_WAIT_V(6); PG8_BAR;
    } else {
        PG8_STAGE(PG8_SB(0, 0), cB, voffB); PG8_STAGE(PG8_SA(0, 0), cA, voffA); PG8_STAGE(PG8_SB(0, 1), cB + hstep, voffB); PG8_STAGE(PG8_SA(0, 1), cA + hstep, voffA);
        if (wr == 1) PG8_BAR;
        PG8_WAIT_V(4); PG8_BAR;
        PG8_STAGE(PG8_SB(1, 0), cB + kstep, voffB); PG8_STAGE(PG8_SA(1, 0), cA + kstep, voffA); PG8_STAGE(PG8_SB(1, 1), cB + hstep + kstep, voffB);
        PG8_WAIT_V(6); PG8_BAR;
    }
    for (;;) {
        const bool has_next = S.next(ui + 1, nxt);
        const char* nA = has_next ? (const char*)g.A + (size_t)nxt.pm * tstep : cA; const char* nB = has_next ? (const char*)g.Bt + (size_t)nxt.pn * tstep : cB;
        for (int t = 0; t < nt; t += 2) {
            const bool last = (t == nt - 2);
            const char* a1 = cA + (size_t)(t + 1) * kstep;
            const char* a2 = last ? nA : cA + (size_t)(t + 2) * kstep; const char* b2 = last ? nB : cB + (size_t)(t + 2) * kstep;
            const char* a3 = a2 + kstep; const char* b3 = b2 + kstep;
            if (last && has_next) S.a_ready(nxt);
            if constexpr (SP2) {
            PG8_LDB(B0, 0, 0); PG8_LDB(B1, 0, 1); PG8_SCHED; PG8_LDA(At, 0, 0); PG8_STAGE(PG8_SA(1, 1), a1 + hstep, voffA);
            PG8_WAIT_V(8); PG8_WAIT_L(0); PG8_BAR; PG8_MMA(0, 0, At, B0); PG8_MMA(0, 1, At, B1); PG8_BAR; PG8_SCHED;
            PG8_LDA(At, 0, 1); PG8_STAGE(PG8_SB(0, 0), b2, voffB); PG8_STAGE(PG8_SB(0, 1), b2 + hstep, voffB); PG8_STAGE(PG8_SA(0, 0), a2, voffA);
            PG8_WAIT_V(8); PG8_WAIT_L(0); PG8_BAR; PG8_MMA(1, 0, At, B0); PG8_MMA(1, 1, At, B1); PG8_BAR; PG8_SCHED;
            PG8_LDB(B0, 1, 0); PG8_LDB(B1, 1, 1); PG8_SCHED; PG8_LDA(At, 1, 0); PG8_STAGE(PG8_SA(0, 1), a2 + hstep, voffA);
            PG8_WAIT_V(8); PG8_WAIT_L(0); PG8_BAR; PG8_MMA(0, 0, At, B0); PG8_MMA(0, 1, At, B1); PG8_BAR; PG8_SCHED;
            PG8_LDA(At, 1, 1); PG8_STAGE(PG8_SB(1, 0), b3, voffB); PG8_STAGE(PG8_SB(1, 1), b3 + hstep, voffB); PG8_STAGE(PG8_SA(1, 0), a3, voffA);
            PG8_WAIT_V(8); PG8_WAIT_L(0); PG8_BAR; PG8_MMA(1, 0, At, B0); PG8_MMA(1, 1, At, B1); PG8_BAR; PG8_SCHED;
            } else {
            PG8_LDB(B0, 0, 0); PG8_SCHED; PG8_LDA(At, 0, 0); PG8_STAGE(PG8_SA(1, 1), a1 + hstep, voffA);
            PG8_WAIT_L(8); PG8_BAR; PG8_WAIT_L(0); PG8_MMA(0, 0, At, B0); PG8_BAR; PG8_SCHED;
            PG8_LDB(B1, 0, 1); PG8_STAGE(PG8_SB(0, 0), b2, voffB);
            PG8_BAR; PG8_WAIT_L(0); PG8_MMA(0, 1, At, B1); PG8_BAR;
            PG8_LDA(At, 0, 1); PG8_STAGE(PG8_SA(0, 0), a2, voffA);
            PG8_BAR; PG8_WAIT_L(0); PG8_MMA(1, 0, At, B0); PG8_BAR; PG8_SCHED;
            PG8_STAGE(PG8_SB(0, 1), b2 + hstep, voffB);
            PG8_WAIT_V(6); PG8_BAR; PG8_MMA(1, 1, At, B1); PG8_BAR;
            PG8_LDB(B0, 1, 0); PG8_SCHED; PG8_LDA(At, 1, 0); PG8_STAGE(PG8_SA(0, 1), a2 + hstep, voffA);
            PG8_WAIT_L(8); PG8_BAR; PG8_WAIT_L(0); PG8_MMA(0, 0, At, B0); PG8_BAR; PG8_SCHED;
            PG8_LDB(B1, 1, 1); PG8_STAGE(PG8_SB(1, 0), b3, voffB);
            PG8_BAR; PG8_WAIT_L(0); PG8_MMA(0, 1, At, B1); PG8_BAR;
            PG8_LDA(At, 1, 1); PG8_STAGE(PG8_SA(1, 0), a3, voffA);
            PG8_BAR; PG8_WAIT_L(0); PG8_MMA(1, 0, At, B0); PG8_BAR; PG8_SCHED;
            PG8_STAGE(PG8_SB(1, 1), b3 + hstep, voffB);
            PG8_WAIT_V(6); PG8_BAR; PG8_MMA(1, 1, At, B1); PG8_BAR;
            }
        }
        if constexpr (ALIGN_EPI) { if (wr == 0) PG8_BAR; }
        if constexpr (!Epi::AFTER_DRAIN) { E(acc, cur, wr, wc, fr, fq); S.done(cur); }
        if (!has_next) break;
#pragma unroll
        for (int a = 0; a < 2; ++a)
#pragma unroll
            for (int b = 0; b < 2; ++b)
#pragma unroll
                for (int m = 0; m < 4; ++m)
#pragma unroll
                    for (int n = 0; n < 2; ++n) acc[a][b][m][n] = (f32x4){0.f, 0.f, 0.f, 0.f};
        cur = nxt; cA = nA; cB = nB; ++ui;
        if constexpr (ALIGN_EPI) { if (wr == 1) PG8_BAR; }
    }
    PG8_WAIT_V(0);
    if constexpr (!ALIGN_EPI) { if (wr == 0) PG8_BAR; }
    PG8_BAR;
    if constexpr (Epi::AFTER_DRAIN) { E.fused(acc, cur, wr, wc, fr, fq, lds, wid, lane); S.done(cur); }
#undef PG8_SA
#undef PG8_SB
#undef PG8_STAGE
#undef PG8_LDA
#undef PG8_LDB
#undef PG8_MMA
#undef PG8_WAIT_V
#undef PG8_WAIT_L
#undef PG8_BAR
#undef PG8_SCHED
}
}
#include <hip/hip_bf16.h>
#include <cmath>
namespace attn_body {
using bf16=__hip_bfloat16;
using bf16x8=__attribute__((ext_vector_type(8)))short;
using s16x4=__attribute__((ext_vector_type(4)))short;
using f32x16=__attribute__((ext_vector_type(16)))float;
using u32x4=__attribute__((ext_vector_type(4)))unsigned;
constexpr int BATCH=4,NHEAD=8,SEQ=8192,D=64,DM=NHEAD*D;
constexpr int NW=8,QBLK=32,QB=QBLK*NW,KVBLK=64,NQB=SEQ/QB;
constexpr int ATTN_PITCH=DM, ATTN_UNIT_ROWS=QB;
__device__ __forceinline__ int crow(int r,int hi){return (r&3)+8*(r>>2)+4*hi;}
#define SBAR() __builtin_amdgcn_sched_barrier(0)
__device__ __forceinline__ void cmask(f32x16&p0,f32x16&p1,int jb,int qrel,int hi){
  const float NEG=-INFINITY; int kb=64*jb+4*hi;
  #pragma unroll
  for(int r=0;r<16;++r){int kv=kb+(r&3)+8*(r>>2); if(kv>qrel)p0[r]=NEG; if(kv+32>qrel)p1[r]=NEG;}
}

constexpr int NSLOT=3, SLOTB=8192;
constexpr int LDS_K=0, LDS_V=NSLOT*SLOTB, LDS_WS=2*NSLOT*SLOTB, LDS_OST=LDS_WS+NW*64*4, LDS_FK=LDS_OST+NW*4096, LDS_BYTES=LDS_FK+SEQ*4;
constexpr float C2=0.125f*1.4426950408889634f;
__device__ __forceinline__ void glds16(const void*gsrc,unsigned lds_dst){unsigned keep;
  asm volatile("s_mov_b32 %0, m0\n\ts_mov_b32 m0, %2\n\ts_nop 0\n\tglobal_load_lds_dwordx4 %1, off\n\ts_mov_b32 m0, %0":"=&s"(keep):"v"(gsrc),"s"(lds_dst):"memory");}
__device__ __forceinline__ float max3f(float a,float b,float c){float r;asm("v_max3_f32 %0, %1, %2, %3":"=v"(r):"v"(a),"v"(b),"v"(c));return r;}
__device__ __forceinline__ float max2f(float a,float b){float r;asm("v_max_f32_e32 %0, %1, %2":"=v"(r):"v"(a),"v"(b));return r;}
__device__ __forceinline__ float fadd_s(float a,float b){float r;asm("v_add_f32_e32 %0, %1, %2":"=v"(r):"v"(a),"v"(b));return r;}
__device__ __forceinline__ float fsub_s(float a,float b){float r;asm("v_sub_f32_e32 %0, %1, %2":"=v"(r):"v"(a),"v"(b));return r;}
typedef float f32x2_t __attribute__((ext_vector_type(2))); typedef __bf16 bf16x2_t __attribute__((ext_vector_type(2)));
__device__ __forceinline__ unsigned cvtpk_s(float lo,float hi){f32x2_t v={lo,hi};bf16x2_t b=__builtin_convertvector(v,bf16x2_t);return __builtin_bit_cast(unsigned,b);}
#define WAIT_BAR(N) asm volatile("s_waitcnt vmcnt(" #N ") lgkmcnt(0)\n\ts_barrier":::"memory")

__device__ __forceinline__ void qkt(f32x16&p0,f32x16&p1,const char*Kslot,const bf16x8*qr,int r32,int hi){
  const char*kb=Kslot+hi*1024+r32*16;
  #pragma unroll
  for(int d0=0;d0<4;++d0){
    const bf16x8 b0=*reinterpret_cast<const bf16x8*>(kb+d0*2048);
    const bf16x8 b1=*reinterpret_cast<const bf16x8*>(kb+d0*2048+512);
    p0=__builtin_amdgcn_mfma_f32_32x32x16_bf16(b0,qr[d0],p0,0,0,0);p1=__builtin_amdgcn_mfma_f32_32x32x16_bf16(b1,qr[d0],p1,0,0,0);}
}
typedef __attribute__((address_space(3))) const char* lds_cptr;
typedef short v4i16_t __attribute__((ext_vector_type(4)));
__device__ __forceinline__ void kload8(bf16x8*kf,lds_cptr kp){
  kf[0]=*(const __attribute__((address_space(3))) bf16x8*)(kp);      kf[1]=*(const __attribute__((address_space(3))) bf16x8*)(kp+512);
  kf[2]=*(const __attribute__((address_space(3))) bf16x8*)(kp+2048); kf[3]=*(const __attribute__((address_space(3))) bf16x8*)(kp+2560);
  kf[4]=*(const __attribute__((address_space(3))) bf16x8*)(kp+4096); kf[5]=*(const __attribute__((address_space(3))) bf16x8*)(kp+4608);
  kf[6]=*(const __attribute__((address_space(3))) bf16x8*)(kp+6144); kf[7]=*(const __attribute__((address_space(3))) bf16x8*)(kp+6656);
}
__device__ __forceinline__ void kload2(bf16x8*kf,lds_cptr kp,int j){ kf[2*j]=*(const __attribute__((address_space(3))) bf16x8*)(kp+j*2048); kf[2*j+1]=*(const __attribute__((address_space(3))) bf16x8*)(kp+j*2048+512); }
__device__ __forceinline__ s16x4 vtr(lds_cptr p){ return __builtin_bit_cast(s16x4,__builtin_amdgcn_ds_read_tr16_b64_v4i16((__attribute__((address_space(3))) v4i16_t*)p)); }
__device__ __forceinline__ float rowmax(const f32x16&p0,const f32x16&p1){
  float a=max3f(p0[0],p0[1],p1[0]),b=max3f(p0[2],p0[3],p1[1]);a=max3f(a,p1[2],p1[3]);
  #pragma unroll
  for(int r=4;r<16;r+=4){a=max3f(a,p0[r],p0[r+1]);b=max3f(b,p0[r+2],p0[r+3]);a=max3f(a,p1[r],p1[r+1]);b=max3f(b,p1[r+2],p1[r+3]);}
  const float m=max2f(a,b);
  auto rr=__builtin_amdgcn_permlane32_swap(__float_as_uint(m),__float_as_uint(m),false,false);
  return max2f(__uint_as_float(rr[0]),__uint_as_float(rr[1]));
}
__device__ __forceinline__ void pv(f32x16*o,int vb,bf16x8 pa0,bf16x8 pa1,bf16x8 pa2,bf16x8 pa3){
  #pragma unroll
  for(int d0=0;d0<2;++d0){s16x4 lo[4],hi[4];
    #pragma unroll
    for(int ks=0;ks<4;++ks){
      asm volatile("ds_read_b64_tr_b16 %0,%1 offset:%c2":"=&v"(lo[ks]):"v"(vb),"i"(d0*4096+ks*1024):"memory");
      asm volatile("ds_read_b64_tr_b16 %0,%1 offset:%c2":"=&v"(hi[ks]):"v"(vb),"i"(d0*4096+ks*1024+512):"memory");}
    asm volatile("s_waitcnt lgkmcnt(0)":::"memory");SBAR();
    #define PK(k) (bf16x8){lo[k][0],lo[k][1],lo[k][2],lo[k][3],hi[k][0],hi[k][1],hi[k][2],hi[k][3]}
    o[d0]=__builtin_amdgcn_mfma_f32_32x32x16_bf16(pa0,PK(0),o[d0],0,0,0);
    o[d0]=__builtin_amdgcn_mfma_f32_32x32x16_bf16(pa1,PK(1),o[d0],0,0,0);
    o[d0]=__builtin_amdgcn_mfma_f32_32x32x16_bf16(pa2,PK(2),o[d0],0,0,0);
    o[d0]=__builtin_amdgcn_mfma_f32_32x32x16_bf16(pa3,PK(3),o[d0],0,0,0);
    #undef PK
  }
}

#ifndef ATTN_STORE16
#define ATTN_STORE16(p,v) (*(u32x4*)(p)=(v))
#endif
template<int THRL> __device__ __forceinline__ void attn_unit(int b,int h,int qb,const bf16*Q,const bf16*__restrict__ K,const bf16*__restrict__ V,bf16*O,const float*__restrict__ Fc,char*shm,int wid_in){
  const int wid=__builtin_amdgcn_readfirstlane(wid_in); int lane_=(int)__builtin_amdgcn_mbcnt_hi(~0u,__builtin_amdgcn_mbcnt_lo(~0u,0u)); asm volatile("":"+v"(lane_));
  const int lane=lane_,tid=wid*64+lane,r32=lane&31,hi=lane>>5;
  const long rowbase=(long)b*SEQ; const int q0=qb*QB;
  const float*Fbh=Fc+(long)(b*NHEAD+h)*SEQ;
  { typedef float f32x4_t __attribute__((ext_vector_type(4))); __attribute__((address_space(3))) float*fk=(__attribute__((address_space(3))) float*)((__attribute__((address_space(3))) char*)shm+LDS_FK); const int n4=(q0+QB)/4;
    for(int i=tid;i<n4;i+=NW*64){ f32x4_t v=*(const f32x4_t*)(Fbh+4*i); v=v*(-1.4426950408889634f); *(__attribute__((address_space(3))) f32x4_t*)(fk+4*i)=v; } }
  float fq2=Fbh[q0+wid*QBLK+r32]*1.4426950408889634f; asm volatile("":"+v"(fq2));
  const bf16*Qw=Q+(rowbase+q0+wid*QBLK)*DM+h*D;
  const bf16*Kh=K+rowbase*DM+h*D,*Vh=V+rowbase*DM+h*D;
  const lds_cptr shm3=(lds_cptr)shm;
  const unsigned lds0=(unsigned)(uintptr_t)shm;
  float*wsf=(float*)(shm+LDS_WS)+wid*64;
  const bf16*ksrc=Kh+(long)lane*DM+wid*8;
  const bf16*vsrc=Vh+(long)(16*(wid&3)+(lane>>2))*DM+(wid>>2)*32+(lane&3)*8;
  const unsigned kdst=lds0+LDS_K+wid*1024, vdst=lds0+LDS_V+wid*1024;
  #define DMA_K(t,slot) glds16(ksrc+(long)(t)*KVBLK*DM,(unsigned)__builtin_amdgcn_readfirstlane(kdst+(slot)))
  #define DMA_V(t,slot) glds16(vsrc+(long)(t)*KVBLK*DM,(unsigned)__builtin_amdgcn_readfirstlane(vdst+(slot)))
  const int vb0=(int)(lds0+LDS_V)+((lane>>4)&1)*32+(lane&3)*8+(4*hi+((lane&15)>>2))*64;
  const char*Kbase=shm+LDS_K; bf16x8 kf[8];
  const lds_cptr kp0=shm3+LDS_K+hi*1024+r32*16; const lds_cptr vp0=shm3+LDS_V+((lane>>4)&1)*32+(lane&3)*8+(4*hi+((lane&15)>>2))*64;
  const int NT=(q0+QB)/KVBLK;
  DMA_K(0,0);DMA_V(0,0);DMA_K(1,SLOTB);
  bf16x8 qr[4];
  #pragma unroll
  for(int d0=0;d0<4;++d0)qr[d0]=*reinterpret_cast<const bf16x8*>(&Qw[(long)r32*DM+d0*16+hi*8]);
  float mhat=0.f,l_reg=0.f;f32x16 o[2];o[0]=f32x16{};o[1]=f32x16{};
  const __attribute__((address_space(3))) float*fkl=(const __attribute__((address_space(3))) float*)(shm3+LDS_FK)+4*hi;
  #define INITC(C0,C1,t) do{ const float nsc_=fq2-mhat; typedef float f32x4_t __attribute__((ext_vector_type(4))); const __attribute__((address_space(3))) float*kb_=fkl+64*(t); \
    _Pragma("unroll") for(int g_=0;g_<4;++g_){ const f32x4_t a_=*(const __attribute__((address_space(3))) f32x4_t*)(kb_+8*g_), b_=*(const __attribute__((address_space(3))) f32x4_t*)(kb_+32+8*g_); \
      _Pragma("unroll") for(int e_=0;e_<4;++e_){ C0[4*g_+e_]=nsc_+a_[e_]; C1[4*g_+e_]=nsc_+b_[e_]; } } }while(0)
  const int qrel=wid*QBLK+r32;
  #define CMASK(P0,P1,t) do{int jb_=(t)-(NT-4); if(jb_>=0)cmask(P0,P1,jb_,qrel,hi);}while(0)
  bool resc=false;
  #define START(P0,P1) do{ const float rm=rowmax(P0,P1); resc=false; \
    { const float dl=rm; mhat=fadd_s(mhat,dl); \
      _Pragma("unroll") for(int r=0;r<16;++r){P0[r]=fsub_s(P0[r],dl);P1[r]=fsub_s(P1[r],dl);} \
      } \
    _Pragma("unroll") for(int r=0;r<16;++r)P0[r]=__builtin_amdgcn_exp2f(P0[r]); }while(0)
  #define RESC() do{ if(resc){ asm volatile("s_waitcnt lgkmcnt(0)":::"memory"); \
      _Pragma("unroll") for(int d_=0;d_<2;++d_) _Pragma("unroll") for(int r=0;r<16;++r)o[d_][r]*=wsf[crow(r,hi)]; } }while(0)
  f32x16 pA0,pA1,pB0,pB1;
  int sl_prev=0,sl_cur=0,sl_next=SLOTB;
  #define ROT() do{sl_prev=sl_cur;sl_cur=sl_next;sl_next=(sl_next==(NSLOT-1)*SLOTB)?0:sl_next+SLOTB;}while(0)
  DMA_K(2,2*SLOTB);
  WAIT_BAR(3);
  INITC(pA0,pA1,0); qkt(pA0,pA1,Kbase,qr,r32,hi);asm volatile("s_nop 15\n\ts_nop 7":"+v"(pA0),"+v"(pA1));CMASK(pA0,pA1,0);
  START(pA0,pA1);
  _Pragma("unroll") for(int r=0;r<16;++r)pA1[r]=__builtin_amdgcn_exp2f(pA1[r]);
  WAIT_BAR(0);
  DMA_K(3,0);DMA_V(1,SLOTB);
  ROT();
  kload8(kf,kp0+sl_cur);
  WAIT_BAR(2);
  s16x4 vlo[8],vhi[8]; u32x4 pw0,pw1,pw2,pw3;
  #define PKW(P,B) cvtpk_s(P[B],P[B+1])
  #define PAF(k) __builtin_bit_cast(bf16x8,pw##k)
  #define VFR(i) (bf16x8){vlo[i][0],vlo[i][1],vlo[i][2],vlo[i][3],vhi[i][0],vhi[i][1],vhi[i][2],vhi[i][3]}
  #define PIN(x) asm volatile("":"+v"(x))
  #define MX3(a,b,c) __builtin_fmaxf(__builtin_fmaxf((a),(b)),(c))
  #define GAPA(MF,A0,A1,A2,A3,W0,W1,PW) do{ MF; sacc+=A0; sacc+=A1; sacc+=A2; sacc+=A3; PIN(sacc); W0; W1; PIN(PW); SBAR(); }while(0)
  #define EX(v) __builtin_amdgcn_exp2f(v)
  #define GAPB(MF,X,B) do{ MF; X[B]=EX(X[B]); X[B+1]=EX(X[B+1]); X[B+2]=EX(X[B+2]); X[B+3]=EX(X[B+3]); PIN(X); SBAR(); }while(0)
  #define VRD(i) do{ vlo[i]=vtr(vp_+(((i)>>2)*4096+((i)&3)*1024)); vhi[i]=vtr(vp_+(((i)>>2)*4096+((i)&3)*1024+512)); }while(0)
  #define KRD(G,j) do{ if(G){ kload2(kf,kp0+sl_next,j); SBAR(); } }while(0)
  #define STEP(C0,C1,P0,P1,t,GK,GV,GL) do{ SBAR(); INITC(C0,C1,t); PIN(C0); PIN(C1); SBAR(); \
    const lds_cptr vp_=vp0+sl_prev; \
    VRD(0); SBAR(); float sacc=(P0[0]+P0[1]); \
    GAPA(C0=__builtin_amdgcn_mfma_f32_32x32x16_bf16(kf[0],qr[0],C0,0,0,0), P0[2],P0[3],P0[4],P0[5],     pw0[0]=PKW(P0,0), pw0[1]=PKW(P0,2), pw0); \
    VRD(4); SBAR(); GAPA(C1=__builtin_amdgcn_mfma_f32_32x32x16_bf16(kf[1],qr[0],C1,0,0,0), P0[6],P0[7],P0[8],P0[9],     pw0[2]=PKW(P0,4), pw0[3]=PKW(P0,6), pw0); \
    VRD(1); SBAR(); GAPA(C0=__builtin_amdgcn_mfma_f32_32x32x16_bf16(kf[2],qr[1],C0,0,0,0),   P0[10],P0[11],P0[12],P0[13], pw1[0]=PKW(P0,8), pw1[1]=PKW(P0,10), pw1); \
    VRD(5); SBAR(); GAPA(C1=__builtin_amdgcn_mfma_f32_32x32x16_bf16(kf[3],qr[1],C1,0,0,0),   P0[14],P0[15],P1[0],P1[1],   pw1[2]=PKW(P0,12),pw1[3]=PKW(P0,14), pw1); \
    VRD(2); SBAR(); GAPA(C0=__builtin_amdgcn_mfma_f32_32x32x16_bf16(kf[4],qr[2],C0,0,0,0),   P1[2],P1[3],P1[4],P1[5],     pw2[0]=PKW(P1,0), pw2[1]=PKW(P1,2), pw2); \
    VRD(6); SBAR(); GAPA(C1=__builtin_amdgcn_mfma_f32_32x32x16_bf16(kf[5],qr[2],C1,0,0,0),   P1[6],P1[7],P1[8],P1[9],     pw2[2]=PKW(P1,4), pw2[3]=PKW(P1,6), pw2); \
    VRD(3); SBAR(); GAPA(C0=__builtin_amdgcn_mfma_f32_32x32x16_bf16(kf[6],qr[3],C0,0,0,0),   P1[10],P1[11],P1[12],P1[13], pw3[0]=PKW(P1,8), pw3[1]=PKW(P1,10), pw3); \
    VRD(7); SBAR(); GAPA(C1=__builtin_amdgcn_mfma_f32_32x32x16_bf16(kf[7],qr[3],C1,0,0,0),   P1[14],P1[15],0.f,0.f,       pw3[2]=PKW(P1,12),pw3[3]=PKW(P1,14), pw3); \
    l_reg+=sacc; \
    if(GK){DMA_K((t)+3,sl_cur);} if(GV){DMA_V((t)+1,sl_next);} \
    CMASK(C0,C1,t); \
    { float a=MX3(C0[0],C0[1],C1[0]),b=MX3(C0[2],C0[3],C1[1]); a=MX3(a,C1[2],C1[3]); \
      _Pragma("unroll") for(int r=4;r<16;r+=4){a=MX3(a,C0[r],C0[r+1]);b=MX3(b,C0[r+2],C0[r+3]);a=MX3(a,C1[r],C1[r+1]);b=MX3(b,C1[r+2],C1[r+3]);} \
      float rm=__builtin_fmaxf(a,b); { auto rr=__builtin_amdgcn_permlane32_swap(__float_as_uint(rm),__float_as_uint(rm),false,false); rm=__builtin_fmaxf(__uint_as_float(rr[0]),__uint_as_float(rr[1])); } \
      resc=false; \
      if(__builtin_expect(__any(rm>(float)THRL),0)){ const float dl=__builtin_fmaxf(rm,0.f); mhat+=dl; \
        _Pragma("unroll") for(int r=0;r<16;++r){C0[r]-=dl;C1[r]-=dl;} \
        const float f=__builtin_amdgcn_exp2f(-dl); l_reg*=f; if(hi==0)wsf[r32]=f; resc=true; } } \
    SBAR(); \
    GAPB(o[0]=__builtin_amdgcn_mfma_f32_32x32x16_bf16(PAF(0),VFR(0),o[0],0,0,0), C0,0); \
    GAPB(o[1]=__builtin_amdgcn_mfma_f32_32x32x16_bf16(PAF(0),VFR(4),o[1],0,0,0), C0,4); \
    KRD(GL,0); GAPB(o[0]=__builtin_amdgcn_mfma_f32_32x32x16_bf16(PAF(1),VFR(1),o[0],0,0,0), C0,8); \
    KRD(GL,1); GAPB(o[1]=__builtin_amdgcn_mfma_f32_32x32x16_bf16(PAF(1),VFR(5),o[1],0,0,0), C0,12); \
    KRD(GL,2); GAPB(o[0]=__builtin_amdgcn_mfma_f32_32x32x16_bf16(PAF(2),VFR(2),o[0],0,0,0), C1,0); \
    KRD(GL,3); GAPB(o[1]=__builtin_amdgcn_mfma_f32_32x32x16_bf16(PAF(2),VFR(6),o[1],0,0,0), C1,4); \
    GAPB(o[0]=__builtin_amdgcn_mfma_f32_32x32x16_bf16(PAF(3),VFR(3),o[0],0,0,0), C1,8); \
    GAPB(o[1]=__builtin_amdgcn_mfma_f32_32x32x16_bf16(PAF(3),VFR(7),o[1],0,0,0), C1,12); \
    }while(0)
  int t=1;
  #undef CMASK
  #define CMASK(P0,P1,t) do{}while(0)
  for(;t+5<NT;t+=2){
    STEP(pB0,pB1,pA0,pA1,t,true,true,true);     WAIT_BAR(2); RESC(); ROT();
    STEP(pA0,pA1,pB0,pB1,t+1,true,true,true);   WAIT_BAR(2); RESC(); ROT();
  }
  #undef CMASK
  #define CMASK(P0,P1,t) do{int jb_=(t)-(NT-4); if(jb_>=0)cmask(P0,P1,jb_,qrel,hi);}while(0)
  #define ENDW(tt) do{ if((tt)+3<NT){WAIT_BAR(2);} else if((tt)+2<NT){WAIT_BAR(1);} else {WAIT_BAR(0);} }while(0)
  for(;t+1<NT;t+=2){
    STEP(pB0,pB1,pA0,pA1,t,(t+3<NT),(t+1<NT),(t+1<NT));       ENDW(t);   RESC(); ROT();
    STEP(pA0,pA1,pB0,pB1,t+1,(t+4<NT),(t+2<NT),(t+2<NT));     ENDW(t+1); RESC(); ROT();
  }
  STEP(pB0,pB1,pA0,pA1,NT-1,false,false,false); RESC();
  { float sacc=pB0[0]+pB0[1]; _Pragma("unroll") for(int r=2;r<16;++r)sacc+=pB0[r]; _Pragma("unroll") for(int r=0;r<16;++r)sacc+=pB1[r]; l_reg+=sacc;
    pw0=(u32x4){PKW(pB0,0),PKW(pB0,2),PKW(pB0,4),PKW(pB0,6)};pw1=(u32x4){PKW(pB0,8),PKW(pB0,10),PKW(pB0,12),PKW(pB0,14)};pw2=(u32x4){PKW(pB1,0),PKW(pB1,2),PKW(pB1,4),PKW(pB1,6)};pw3=(u32x4){PKW(pB1,8),PKW(pB1,10),PKW(pB1,12),PKW(pB1,14)};
    SBAR(); pv(o,vb0+sl_cur,PAF(0),PAF(1),PAF(2),PAF(3)); }
  #undef PKW
  #undef PAF
  #undef VFR
  #undef PIN
  #undef MX3
  #undef GAPA
  #undef GAPB
  #undef EX
  #undef VRD
  #undef KRD
  #undef STEP
  #undef ENDW
  {auto rr=__builtin_amdgcn_permlane32_swap(__float_as_uint(l_reg),__float_as_uint(l_reg),false,false);l_reg=__uint_as_float(rr[0])+__uint_as_float(rr[1]);}
  if(hi==0)wsf[32+r32]=l_reg;asm volatile("s_waitcnt lgkmcnt(0)":::"memory");
  float rli[16];
  #pragma unroll
  for(int r=0;r<16;++r)rli[r]=__builtin_amdgcn_rcpf(wsf[32+crow(r,hi)]);
  bf16*Ow=O+(rowbase+q0+wid*QBLK)*DM+h*D;
  { bf16*stg=(bf16*)(shm+LDS_OST)+wid*2048;
    #pragma unroll
    for(int r=0;r<16;++r){const int orow=crow(r,hi);
      #pragma unroll
      for(int d0=0;d0<2;++d0)stg[orow*64+d0*32+r32]=__float2bfloat16(o[d0][r]*rli[r]);}
    asm volatile("s_waitcnt lgkmcnt(0)":::"memory");
    #pragma unroll
    for(int i=0;i<4;++i){const int row=i*8+(lane>>3),ch=lane&7; const u32x4 v=*(const u32x4*)(stg+row*64+ch*8); ATTN_STORE16(Ow+(long)row*DM+ch*8,v);} }
  asm volatile("s_waitcnt lgkmcnt(0)\n\ts_barrier":::"memory");
  #undef DMA_K
  #undef DMA_V
  #undef INITC
  #undef CMASK
  #undef START
  #undef RESC
  #undef ROT
}
constexpr int ATTN_LDS_BYTES=LDS_BYTES;
struct AttnTensors { const bf16* Q; const bf16* K; const bf16* V; bf16* O; const float* F; };
struct AttnUnit { int bh; int qb; };
struct StaticOrder {
  int vcu;
  __device__ __forceinline__ explicit StaticOrder(int grid,int block):vcu((block%8)*(grid/8)+block/8){}
  __device__ __forceinline__ bool next(int i,AttnUnit&u)const{ if(i>=4)return false; const int s=vcu&7; u.bh=vcu>>3; u.qb=(i==0)?s:(i==1)?15-s:(i==2)?16+s:31-s; return true; }
  __device__ __forceinline__ void a_ready(const AttnUnit&)const{}
  __device__ __forceinline__ void done(const AttnUnit&)const{}
};
template<class Sched,int THRL=8> __device__ __forceinline__ void attn_phase(char*lds,const AttnTensors&T,const Sched&S,int wid_in){
  AttnUnit u;
  for(int i=0;S.next(i,u);++i){ S.a_ready(u); attn_unit<THRL>(u.bh/NHEAD,u.bh%NHEAD,u.qb,T.Q,T.K,T.V,T.O,T.F,lds,wid_in); S.done(u); }
}
#undef SBAR
#undef WAIT_BAR
}
#define GAS __attribute__((address_space(1)))
#define LAS __attribute__((address_space(3)))
typedef unsigned short bf16;
typedef unsigned v4u __attribute__((ext_vector_type(4)));
typedef float f32x4 __attribute__((ext_vector_type(4)));
typedef short bf16x8 __attribute__((ext_vector_type(8)));
typedef GAS unsigned gu32;
typedef GAS unsigned long long gu64;
#define RLX_AGENT __ATOMIC_RELAXED, __HIP_MEMORY_SCOPE_AGENT
#define LDS_WAIT() asm volatile("s_waitcnt lgkmcnt(0)" ::: "memory")
#define VM_WAIT() asm volatile("s_waitcnt vmcnt(0)" ::: "memory")
__device__ __forceinline__ unsigned long long rt() { return __builtin_amdgcn_s_memrealtime(); }
__device__ __forceinline__ unsigned f2bf(float f) { unsigned u = __builtin_bit_cast(unsigned, f); return (u + 0x7fffu + ((u >> 16) & 1u)) >> 16; }
__device__ __forceinline__ unsigned pk2(float lo, float hi) { return f2bf(lo) | (f2bf(hi) << 16); }

#define XB_TMO      128
#define XB_XCNT(j)  (256  + 64 * (j))
#define XB_XSUB(j)  (1280 + 64 * (j))
#define XB_XGEN(j)  (2304 + 64 * (j))
#define XB_TOP      3328
#define XB_TOPGEN   3392
#define XCD_BAR_WORDS 3456
#define XB_SPIN_CAP (1u << 18)

__device__ __forceinline__ unsigned xb_ld(unsigned* p)              { return __hip_atomic_load(p, __ATOMIC_RELAXED, __HIP_MEMORY_SCOPE_AGENT); }
__device__ __forceinline__ unsigned xb_add(unsigned* p, unsigned v) { return __hip_atomic_fetch_add(p, v, __ATOMIC_RELAXED, __HIP_MEMORY_SCOPE_AGENT); }
__device__ __forceinline__ unsigned xb_xcc_id() { return (unsigned)__builtin_amdgcn_s_getreg((3 << 11) | 20) & 0xFu; }
#define XB_SPIN(cond, bar) do { unsigned _sp = 0; while (cond) { __builtin_amdgcn_s_sleep(1); \
    if ((++_sp & 255u) == 0u) { if (xb_ld(&(bar)[XB_TMO])) break; if (_sp > XB_SPIN_CAP) { atomicAdd(&(bar)[XB_TMO], 1u); break; } } } } while (0)

struct XcdBarrier {
    unsigned* bar; unsigned x; int wv;
    volatile LAS unsigned* st;
};

__device__ __forceinline__ bool xb_t0(int wv) { return wv == 0 && __builtin_amdgcn_mbcnt_hi(~0u, __builtin_amdgcn_mbcnt_lo(~0u, 0u)) == 0u; }
__device__ __forceinline__ XcdBarrier xcd_barrier_post(unsigned* bar, volatile LAS unsigned* st, int wv) {
    XcdBarrier b; b.bar = bar; b.x = xb_xcc_id(); b.st = st; b.wv = wv;
    if (xb_t0(wv)) (void)xb_add(&bar[XB_XCNT(b.x)], 1u);
    return b;
}
__device__ __forceinline__ void xcd_barrier_complete(unsigned* bar, unsigned x, unsigned& nloc, unsigned& nx) {
    const unsigned G = gridDim.x * gridDim.y * gridDim.z;
    unsigned sum, cnt, mine, sp = 0u;
    for (;;) {
        sum = 0u; cnt = 0u; mine = 0u;
#pragma unroll
        for (unsigned j = 0; j < 16; ++j) { const unsigned c = xb_ld(&bar[XB_XCNT(j)]); sum += c; cnt += (c > 0u) ? 1u : 0u; mine = (j == x) ? c : mine; }
        if (sum == G) break;
        __builtin_amdgcn_s_sleep(1);
        if ((++sp & 255u) == 0u) { if (xb_ld(&bar[XB_TMO])) break; if (sp > XB_SPIN_CAP) { atomicAdd(&bar[XB_TMO], 1u); break; } }
    }
    nloc = mine > 0u ? mine : 1u; nx = cnt > 0u ? cnt : 1u;
}

__device__ __forceinline__ void xcd_barrier(const XcdBarrier& b) {
    asm volatile("s_waitcnt vmcnt(0)" ::: "memory");
    __syncthreads();
    if (xb_t0(b.wv)) {
        unsigned* bar = b.bar;
        __builtin_amdgcn_s_waitcnt(0);
        unsigned nloc = b.st[0], nx = b.st[1];
        if (nloc == 0u) { xcd_barrier_complete(bar, b.x, nloc, nx); b.st[0] = nloc; b.st[1] = nx; }
        const unsigned old = xb_add(&bar[XB_XSUB(b.x)], 1u);
        const unsigned gen = old / nloc;
        if (old + 1u == (gen + 1u) * nloc) {
            __builtin_amdgcn_fence(__ATOMIC_RELEASE, "agent");
            asm volatile("s_waitcnt vmcnt(0)" ::: "memory");
            const unsigned og = xb_add(&bar[XB_TOP], 1u);
            const unsigned tg = og / nx;
            if (og + 1u == (tg + 1u) * nx) xb_add(&bar[XB_TOPGEN], 1u);
            else XB_SPIN(xb_ld(&bar[XB_TOPGEN]) == tg, bar);
            __builtin_amdgcn_fence(__ATOMIC_ACQUIRE, "agent");
            xb_add(&bar[XB_XGEN(b.x)], 1u);
            asm volatile("s_waitcnt vmcnt(0)" ::: "memory");
        } else {
            XB_SPIN(xb_ld(&bar[XB_XGEN(b.x)]) == gen, bar);
            __builtin_amdgcn_fence(__ATOMIC_ACQUIRE, "agent");
            asm volatile("s_waitcnt vmcnt(0)" ::: "memory");
        }
    }
    __syncthreads();
}

constexpr int NWAVES = 8;
constexpr int RING_OFF = 0, RING_BYTES = 131072;
constexpr int LDSCTL_OFF = RING_BYTES, MISC_OFF = LDSCTL_OFF + 320;
constexpr int LDS_BYTES = 147456;
constexpr int N_PHASES = 8;

struct Frame {
    LAS unsigned char* lds;
    volatile LAS unsigned* MISC;
    gu32* ctl;
    int tid, lane, wave, vcu, G;
};
__device__ __forceinline__ float wave_sum(float v) {
#pragma unroll
    for (int o = 1; o < 64; o <<= 1) v += __shfl_xor(v, o);
    return v;
}
struct Args { const float* in[20]; float* out; unsigned char* ws; int ph_lo, ph_hi, li, pad; };

__device__ __forceinline__ void p0_transpose_item(const float* W, int ld, int nblk, const float* glo, const float* ghi, int K, bf16* WT, LAS float* scr, int item, int lane) {
    const int kb = item / nblk, nb = item % nblk, k0 = 64 * kb, n0 = 32 * nb;
#pragma unroll 8
    for (int i = 0; i < 32; ++i) { const int kk = 2 * i + (lane >> 5), k = k0 + kk; float w = W[(size_t)k * ld + n0 + (lane & 31)];
        if (glo) w *= (k < K / 2) ? glo[k] : ghi[k - K / 2];
        scr[kk * 33 + (lane & 31)] = w; }
    LDS_WAIT(); asm volatile("" ::: "memory");
    const int c = lane & 7;
#pragma unroll
    for (int j = 0; j < 4; ++j) { const int n = (lane >> 3) + 8 * j; const LAS float* s = scr + (8 * c) * 33 + n;
        v4u o; o.x = pk2(s[0 * 33], s[1 * 33]); o.y = pk2(s[2 * 33], s[3 * 33]); o.z = pk2(s[4 * 33], s[5 * 33]); o.w = pk2(s[6 * 33], s[7 * 33]);
        *(GAS v4u*)(WT + (size_t)(n0 + n) * K + k0 + 8 * c) = o; }
    LDS_WAIT(); asm volatile("" ::: "memory");
}
__device__ __forceinline__ float log_sigmoid(float z) { return fminf(z, 0.f) - log1pf(expf(-fabsf(z))); }

__device__ __forceinline__ void p0_prologue(Frame& F, const Args& a) {
    LAS float* scr = (LAS float*)(F.lds + RING_OFF + F.wave * 16384);
    unsigned char* ws = a.ws;
    const float* x = a.in[0]; const float* g1 = a.in[1]; const float* w_in = a.in[2]; const float* bfv = a.in[10];
    const float* gn_l = a.in[11]; const float* gn_f = a.in[12]; const float* w_out = a.in[13]; const float* g2 = a.in[14];
    const float* w_q = a.in[15]; const float* sk = a.in[16]; const float* pu = a.in[17]; const float* pv = a.in[18];
    bf16* win_t = (bf16*)(ws + WS_WIN); bf16* wout_t = (bf16*)(ws + WS_WOUT); bf16* wq_t = (bf16*)(ws + WS_WQ); bf16* skb = (bf16*)(ws + WS_SKB); float* wfl = (float*)(ws + WS_WFL);
    float* logf = (float*)(ws + WS_LOGF); float* sumsq = (float*)(ws + WS_SUMSQ); bf16* h = (bf16*)(ws + WS_H); bf16* ut = (bf16*)(ws + WS_UT); bf16* vt = (bf16*)(ws + WS_VT);
    const int gw = F.vcu * NWAVES + F.wave, NGW = F.G * NWAVES, lane = F.lane;
    constexpr int I_IN = (DMODEL / 64) * (NG1 / 32), I_OUT = (DMODEL / 64) * (DMODEL / 32), I_Q = (DMODEL / 64) * (QPW / 32);
    constexpr int I_FL = 8 * DMODEL / 64, I_SK = PH * 2 * NKEY * PHALF / 512, I_SS = T / 64, I_WAX = 8 * 2 * 2 * 4;
    constexpr int E0 = I_IN, E1 = E0 + I_OUT, E2 = E1 + I_Q, E3 = E2 + I_FL, E4 = E3 + I_SK, E5 = E4 + I_SS, E6 = E5 + I_WAX;
    for (int it = gw; it < E6; it += NGW) {
        if (it < E0) { p0_transpose_item(w_in, INC, NG1 / 32, nullptr, nullptr, DMODEL, win_t, scr, it, lane); continue; }
        if (it < E1) { p0_transpose_item(w_out, DMODEL, DMODEL / 32, gn_l, gn_f, DMODEL, wout_t, scr, it - E0, lane); continue; }
        if (it < E2) { p0_transpose_item(w_q, QPW, QPW / 32, g2, g2 + DMODEL / 2, DMODEL, wq_t, scr, it - E1, lane); continue; }
        if (it < E3) { const int i = (it - E2) * 64 + lane, j = i / DMODEL, k = i % DMODEL; wfl[i] = w_in[(size_t)k * INC + NG1 + j]; continue; }
        if (it < E4) { const size_t i = (size_t)(it - E3) * 512 + lane * 8; const f32x4 s0 = *(const GAS f32x4*)(sk + i), s1 = *(const GAS f32x4*)(sk + i + 4);
            v4u o; o.x = pk2(s0[0], s0[1]); o.y = pk2(s0[2], s0[3]); o.z = pk2(s1[0], s1[1]); o.w = pk2(s1[2], s1[3]); *(GAS v4u*)(skb + i) = o; continue; }
        if (it < E5) { sumsq[(it - E4) * 64 + lane] = 0.f; continue; }
        { const int f = it - E5, ks = f & 3, n = (f >> 2) & 1, mat = (f >> 3) & 1, hh = f >> 4; const float* wsrc = mat ? a.in[7] : a.in[5];
          const size_t o = ((size_t)(hh * 64 + 16 * ks + 8 * (lane >> 5))) * 64 + 32 * n + (lane & 31);
          v4u pw; pw.x = pk2(wsrc[o], wsrc[o + 64]); pw.y = pk2(wsrc[o + 128], wsrc[o + 192]); pw.z = pk2(wsrc[o + 256], wsrc[o + 320]); pw.w = pk2(wsrc[o + 384], wsrc[o + 448]);
          *(GAS v4u*)((bf16*)(ws + WS_WAX) + (size_t)f * 512 + lane * 8) = pw; }
    }
    { f32x4 gg[4];
#pragma unroll
      for (int j = 0; j < 4; ++j) gg[j] = *(const GAS f32x4*)(g2 + 256 * j + 4 * lane);
      for (int e = gw; e < NEXP; e += NGW) {
        const GAS f32x4* ur = (const GAS f32x4*)(pu + (size_t)e * DMODEL) + lane; const GAS f32x4* vr = (const GAS f32x4*)(pv + (size_t)e * DMODEL) + lane;
        f32x4 uu[4], vv[4];
#pragma unroll
        for (int j = 0; j < 4; ++j) { uu[j] = ur[64 * j]; vv[j] = vr[64 * j]; }
        GAS unsigned long long* uo = (GAS unsigned long long*)(ut + (size_t)e * DMODEL) + lane; GAS unsigned long long* vo = (GAS unsigned long long*)(vt + (size_t)e * DMODEL) + lane;
#pragma unroll
        for (int j = 0; j < 4; ++j) { const f32x4 q = uu[j] * gg[j];
            uo[64 * j] = (unsigned long long)pk2(q[0], q[1]) | ((unsigned long long)pk2(q[2], q[3]) << 32);
            vo[64 * j] = (unsigned long long)pk2(vv[j][0], vv[j][1]) | ((unsigned long long)pk2(vv[j][2], vv[j][3]) << 32); }
      } }
    { f32x4 gg[4];
#pragma unroll
      for (int j = 0; j < 4; ++j) gg[j] = *(const GAS f32x4*)(g1 + 256 * j + 4 * lane);
      float fw[4][4][8];
#pragma unroll
      for (int j = 0; j < 4; ++j)
#pragma unroll
          for (int c = 0; c < 4; ++c) { const int k = 256 * j + 4 * lane + c; const GAS f32x4* wr = (const GAS f32x4*)(w_in + (size_t)k * INC + NG1); const f32x4 w0 = wr[0], w1 = wr[1];
#pragma unroll
              for (int e = 0; e < 4; ++e) { fw[j][c][e] = w0[e]; fw[j][c][4 + e] = w1[e]; } }
      for (int t = gw; t < T; t += NGW) {
        const GAS f32x4* xr = (const GAS f32x4*)(x + (size_t)t * DMODEL) + lane;
        f32x4 v[4]; float ss = 0.f;
#pragma unroll
        for (int j = 0; j < 4; ++j) { v[j] = xr[64 * j]; ss += (v[j][0] * v[j][0] + v[j][1] * v[j][1]) + (v[j][2] * v[j][2] + v[j][3] * v[j][3]); }
        const float rstd = rsqrtf(wave_sum(ss) * (1.f / DMODEL) + RMS_EPS);
        GAS unsigned long long* ho = (GAS unsigned long long*)(h + (size_t)t * DMODEL) + lane;
#pragma unroll
        for (int j = 0; j < 4; ++j) { v[j] = v[j] * rstd * gg[j]; ho[64 * j] = (unsigned long long)pk2(v[j][0], v[j][1]) | ((unsigned long long)pk2(v[j][2], v[j][3]) << 32); }
        float fl[8];
#pragma unroll
        for (int hh = 0; hh < 8; ++hh) fl[hh] = 0.f;
#pragma unroll
        for (int j = 0; j < 4; ++j)
#pragma unroll
            for (int c = 0; c < 4; ++c) {
#pragma unroll
                for (int hh = 0; hh < 8; ++hh) fl[hh] += v[j][c] * fw[j][c][hh]; }
        float res = 0.f;
#pragma unroll
        for (int hh = 0; hh < 8; ++hh) { const float s = wave_sum(fl[hh]); if (lane == hh) res = s; }
        if (lane < 8) logf[(size_t)t * 8 + lane] = log_sigmoid(res + bfv[lane]);
      } }
}

__device__ __forceinline__ void fcum_unit(Frame& F, int bh, const float* logf, float* fcum) {
    const int b = bh / NHEADS, hh = bh % NHEADS, s0 = F.tid * 16;
    float v[16]; float loc = 0.f;
#pragma unroll
    for (int i = 0; i < 16; ++i) { v[i] = logf[((size_t)b * SEQ + s0 + i) * 8 + hh]; loc += v[i]; }
    float inc = loc;
#pragma unroll
    for (int o = 1; o < 64; o <<= 1) { const float n = __shfl_up(inc, o); if (F.lane >= o) inc += n; }
    if (F.lane == 63) F.MISC[16 + F.wave] = __float_as_uint(inc);
    __syncthreads();
    float run = inc - loc;
    for (int w = 0; w < F.wave; ++w) run += __uint_as_float(F.MISC[16 + w]);
#pragma unroll
    for (int i = 0; i < 16; ++i) { run += v[i]; fcum[(size_t)bh * SEQ + s0 + i] = run; }
    __syncthreads();
}


namespace peer {
typedef unsigned u32;
typedef float f32x16 __attribute__((ext_vector_type(16)));
constexpr int TOK = 128;
constexpr int EX_STRIDE = 136, GT_STRIDE = 132;
constexpr int L_EX = 0, L_GT = L_EX + TOK * EX_STRIDE * 2, L_IDX = L_GT + TOK * GT_STRIDE * 4, IDX_STRIDE = 36, L_RST = L_IDX + 512 * IDX_STRIDE, L_END = L_RST + TOK * 4;
static_assert(L_END <= RING_BYTES && L_GT % 16 == 0 && L_IDX % 16 == 0, "PEER LDS map");
__device__ __forceinline__ u32 ordmap(float f) { const u32 u = __float_as_uint(f); return u ^ ((u32)((int)u >> 31) | 0x80000000u); }
__device__ __forceinline__ float unordmap(u32 k) { const u32 u = (k & 0x80000000u) ? (k ^ 0x80000000u) : ~k; return __uint_as_float(u); }
__device__ __forceinline__ u32 umin_(u32 a, u32 b) { return a < b ? a : b; }
__device__ __forceinline__ u32 umax_(u32 a, u32 b) { return a > b ? a : b; }
template <bool DESC> __device__ __forceinline__ void sort16(u32 (&k)[16]) {
#pragma unroll
    for (int size = 2; size <= 16; size <<= 1)
#pragma unroll
        for (int stride = size >> 1; stride > 0; stride >>= 1)
#pragma unroll
            for (int i = 0; i < 16; ++i) { const int j = i ^ stride;
                if (j > i) { const bool asc = (((i & size) == 0) != DESC); const u32 a = k[i], b = k[j], lo = umin_(a, b), hi = umax_(a, b); k[i] = asc ? lo : hi; k[j] = asc ? hi : lo; } }
}
template <bool DESC> __device__ __forceinline__ void merge16(u32 (&k)[16]) {
#pragma unroll
    for (int stride = 8; stride > 0; stride >>= 1)
#pragma unroll
        for (int i = 0; i < 16; ++i) { const int j = i ^ stride;
            if (j > i) { const u32 a = k[i], b = k[j], lo = umin_(a, b), hi = umax_(a, b); k[i] = DESC ? hi : lo; k[j] = DESC ? lo : hi; } }
}
__host__ __device__ constexpr int ccnt(int a) { return 16 / (a + 1); }
__host__ __device__ constexpr int cbase(int a) { int s = 0; for (int i = 0; i < a; ++i) s += ccnt(i); return s; }
static_assert(cbase(16) == 50, "hyperbola candidate count");
__device__ __forceinline__ int crow16(int r) { return (r & 3) + 8 * (r >> 2); }

__device__ __forceinline__ void route_tile(Frame& F, const bf16* qp, const bf16* skb, const float* sumsq, int t0) {
    int lane = F.lane; asm volatile("" : "+v"(lane));
    const int r32 = lane & 31, hi = lane >> 5, w = F.wave;
    LAS unsigned short* EXL = (LAS unsigned short*)(F.lds + RING_OFF + L_EX);
    LAS float* GTL = (LAS float*)(F.lds + RING_OFF + L_GT);
    LAS unsigned char* IDXB = F.lds + RING_OFF + L_IDX + (w * 64 + lane) * IDX_STRIDE;
    LAS float* RST = (LAS float*)(F.lds + RING_OFF + L_RST);
    for (int g = 0; g < 4; ++g) {
        const int tok = 32 * g + r32; const size_t trow = (size_t)(t0 + tok);
        const float rstd2 = rsqrtf(sumsq[trow] * (1.f / DMODEL) + RMS_EPS);
        if (w == 0 && hi == 0) RST[tok] = rstd2;
        u32 s0[16], s1[16];
#pragma unroll
        for (int p = 0; p < 2; ++p) {
            bf16x8 qf[8];
#pragma unroll
            for (int ks = 0; ks < 8; ++ks) qf[ks] = *(const GAS bf16x8*)(qp + trow * QPW + w * 256 + p * 128 + ks * 16 + hi * 8);
            u32 run[16];
#pragma unroll
            for (int nb = 0; nb < 4; ++nb) {
                f32x16 acc = {};
                const bf16* kr = skb + ((size_t)((w * 2 + p) * NKEY + 32 * nb + r32)) * PHALF + hi * 8;
#pragma unroll
                for (int ks = 0; ks < 8; ++ks) acc = __builtin_amdgcn_mfma_f32_32x32x16_bf16(*(const GAS bf16x8*)(kr + ks * 16), qf[ks], acc, 0, 0, 0);
                asm volatile("" ::: "memory");
                u32 blk[16];
#pragma unroll
                for (int r = 0; r < 16; ++r) blk[r] = (ordmap(acc[r]) & ~0x7Fu) | (u32)(127 - 32 * nb - crow16(r) - 4 * hi);
                if (nb == 0) { sort16<true>(blk);
#pragma unroll
                    for (int i = 0; i < 16; ++i) run[i] = blk[i]; }
                else { sort16<false>(blk);
#pragma unroll
                    for (int i = 0; i < 16; ++i) run[i] = umax_(run[i], blk[i]);
                    merge16<true>(run); }
            }
            u32 oth[16];
#pragma unroll
            for (int i = 0; i < 16; ++i) oth[i] = (u32)__shfl_xor((int)run[15 - i], 32);
#pragma unroll
            for (int i = 0; i < 16; ++i) run[i] = umax_(run[i], oth[i]);
            merge16<true>(run);
#pragma unroll
            for (int i = 0; i < 16; ++i) { if (p == 0) s0[i] = run[i]; else s1[i] = run[i]; }
        }
        { LAS u32* iw = (LAS u32*)IDXB;
#pragma unroll
          for (int j = 0; j < 4; ++j) {
              iw[j] = (127u - (s0[4 * j] & 127u)) | ((127u - (s0[4 * j + 1] & 127u)) << 8) | ((127u - (s0[4 * j + 2] & 127u)) << 16) | ((127u - (s0[4 * j + 3] & 127u)) << 24);
              iw[4 + j] = (127u - (s1[4 * j] & 127u)) | ((127u - (s1[4 * j + 1] & 127u)) << 8) | ((127u - (s1[4 * j + 2] & 127u)) << 16) | ((127u - (s1[4 * j + 3] & 127u)) << 24); } }
        float v1[16], v2[16];
#pragma unroll
        for (int i = 0; i < 16; ++i) { v1[i] = unordmap(s0[i] & ~0x7Fu); v2[i] = unordmap(s1[i] & ~0x7Fu); }
        u32 c0[16], c1[16], c2[16], c3[16];
#pragma unroll
        for (int a = 0; a < 16; ++a)
#pragma unroll
            for (int b = 0; b < ccnt(a); ++b) { const int pos = cbase(a) + b; const u32 key = (ordmap(v1[a] + v2[b]) & ~0xFFu) | (u32)(255 - (a * 16 + b));
                if (pos < 16) c0[pos] = key; else if (pos < 32) c1[pos - 16] = key; else if (pos < 48) c2[pos - 32] = key; else c3[pos - 48] = key; }
#pragma unroll
        for (int i = 2; i < 16; ++i) c3[i] = 0u;
        sort16<false>(c1);
#pragma unroll
        for (int i = 0; i < 16; ++i) c0[i] = umax_(c0[i], c1[i]);
        merge16<true>(c0);
        sort16<false>(c2);
#pragma unroll
        for (int i = 0; i < 16; ++i) c0[i] = umax_(c0[i], c2[i]);
        merge16<true>(c0);
        sort16<false>(c3);
#pragma unroll
        for (int i = 0; i < 16; ++i) c0[i] = umax_(c0[i], c3[i]);
        merge16<true>(c0);
        const float m = unordmap(c0[0] & ~0xFFu) * rstd2;
        float e[8]; float sum = 0.f; u32 ex[8];
#pragma unroll
        for (int k = 0; k < 8; ++k) { const u32 key = hi ? c0[k + 8] : c0[k]; const float ts = unordmap(key & ~0xFFu);
            e[k] = __builtin_amdgcn_exp2f((ts * rstd2 - m) * LOG2E); sum += e[k];
            const u32 flat = 255u - (key & 255u); ex[k] = (u32)IDXB[flat >> 4] * NKEY + (u32)IDXB[16 + (flat & 15u)]; }
        sum += __shfl_xor(sum, 32);
        const float inv = 1.f / sum;
        v4u exw; exw.x = ex[0] | (ex[1] << 16); exw.y = ex[2] | (ex[3] << 16); exw.z = ex[4] | (ex[5] << 16); exw.w = ex[6] | (ex[7] << 16);
        *(LAS v4u*)(EXL + tok * EX_STRIDE + w * 16 + hi * 8) = exw;
        *(LAS f32x4*)(GTL + tok * GT_STRIDE + w * 16 + hi * 8) = (f32x4){e[0] * inv, e[1] * inv, e[2] * inv, e[3] * inv};
        *(LAS f32x4*)(GTL + tok * GT_STRIDE + w * 16 + hi * 8 + 4) = (f32x4){e[4] * inv, e[5] * inv, e[6] * inv, e[7] * inv};
    }
}
__device__ __forceinline__ float gelu_fast(float x) {
    const float u2 = x * (1.5957691216057308f + 0.07135481627f * x * x);
    return x * __builtin_amdgcn_rcpf(1.f + __builtin_amdgcn_exp2f(-1.4426950408889634f * u2));
}
__device__ __forceinline__ float bflo(u32 w) { return __uint_as_float(w << 16); }
__device__ __forceinline__ float bfhi(u32 w) { return __uint_as_float(w & 0xffff0000u); }
__device__ __forceinline__ void eval_tile(Frame& F, const bf16* ut, const bf16* vt, const float* fg, float* out, int t0) {
    int lane = F.lane; asm volatile("" : "+v"(lane));
    const LAS unsigned short* EXL = (const LAS unsigned short*)(F.lds + RING_OFF + L_EX);
    const LAS float* GTL = (const LAS float*)(F.lds + RING_OFF + L_GT);
    const LAS float* RST = (const LAS float*)(F.lds + RING_OFF + L_RST);
    f32x4 fgv[4];
#pragma unroll
    for (int q = 0; q < 4; ++q) fgv[q] = *(const GAS f32x4*)(fg + (q >> 1) * 512 + 8 * lane + (q & 1) * 4);
    const int h5 = lane >> 5, h4 = (lane >> 4) & 1, h3 = (lane >> 3) & 1, jj = 4 * h3 + 2 * h4 + h5;
    for (int i = 0; i < 16; ++i) {
        const int tok = F.wave * 16 + i; const size_t trow = (size_t)(t0 + tok);
        const float rstd2 = RST[tok];
        float* xrow = out + trow * DMODEL;
        f32x4 xa[4];
#pragma unroll
        for (int q = 0; q < 4; ++q) xa[q] = *(const GAS f32x4*)(xrow + (q >> 1) * 512 + 8 * lane + (q & 1) * 4);
        float hv[16], y[16];
#pragma unroll
        for (int q = 0; q < 16; ++q) { hv[q] = xa[q >> 2][q & 3] * rstd2; y[q] = 0.f; }
        const LAS unsigned short* exr = EXL + tok * EX_STRIDE; const LAS float* gtr = GTL + tok * GT_STRIDE;
        for (int kb = 0; kb < 16; ++kb) {
            v4u ub[8][2], vb[8][2];
#pragma unroll
            for (int j = 0; j < 8; ++j) { const int e = __builtin_amdgcn_readfirstlane((int)exr[kb * 8 + j]);
                const bf16* up = ut + (size_t)e * DMODEL + 8 * lane; const bf16* vp = vt + (size_t)e * DMODEL + 8 * lane;
                ub[j][0] = *(const GAS v4u*)up; ub[j][1] = *(const GAS v4u*)(up + 512); vb[j][0] = *(const GAS v4u*)vp; vb[j][1] = *(const GAS v4u*)(vp + 512); }
            float p[8];
#pragma unroll
            for (int j = 0; j < 8; ++j) { float a = 0.f;
#pragma unroll
                for (int hf = 0; hf < 2; ++hf)
#pragma unroll
                    for (int c = 0; c < 4; ++c) { const u32 wd = ub[j][hf][c]; a += hv[hf * 8 + 2 * c] * bflo(wd); a += hv[hf * 8 + 2 * c + 1] * bfhi(wd); }
                p[j] = a; }
            float q4[4], q2[2];
#pragma unroll
            for (int n = 0; n < 4; ++n) { const float keep = h5 ? p[2 * n + 1] : p[2 * n], send = h5 ? p[2 * n] : p[2 * n + 1]; q4[n] = keep + __shfl_xor(send, 32); }
#pragma unroll
            for (int n = 0; n < 2; ++n) { const float keep = h4 ? q4[2 * n + 1] : q4[2 * n], send = h4 ? q4[2 * n] : q4[2 * n + 1]; q2[n] = keep + __shfl_xor(send, 16); }
            float tot; { const float keep = h3 ? q2[1] : q2[0], send = h3 ? q2[0] : q2[1]; tot = keep + __shfl_xor(send, 8); }
            tot += __shfl_xor(tot, 4); tot += __shfl_xor(tot, 2); tot += __shfl_xor(tot, 1);
            const float act = gelu_fast(tot) * gtr[kb * 8 + jj];
#pragma unroll
            for (int j = 0; j < 8; ++j) { const float aj = __uint_as_float((unsigned)__builtin_amdgcn_readlane((int)__float_as_uint(act), ((j >> 2) & 1) * 8 + ((j >> 1) & 1) * 16 + (j & 1) * 32));
#pragma unroll
                for (int hf = 0; hf < 2; ++hf)
#pragma unroll
                    for (int c = 0; c < 4; ++c) { const u32 wd = vb[j][hf][c]; y[hf * 8 + 2 * c] += aj * bflo(wd); y[hf * 8 + 2 * c + 1] += aj * bfhi(wd); } }
        }
        float ss = 0.f;
#pragma unroll
        for (int q = 0; q < 16; ++q) { y[q] += xa[q >> 2][q & 3]; ss += y[q] * y[q]; }
        const float rs = rsqrtf(wave_sum(ss) * (1.f / DMODEL) + RMS_EPS);
#pragma unroll
        for (int q = 0; q < 4; ++q) { f32x4 o; o[0] = y[4 * q] * rs * fgv[q][0]; o[1] = y[4 * q + 1] * rs * fgv[q][1]; o[2] = y[4 * q + 2] * rs * fgv[q][2]; o[3] = y[4 * q + 3] * rs * fgv[q][3];
            *(GAS f32x4*)(xrow + (q >> 1) * 512 + 8 * lane + (q & 1) * 4) = o; }
    }
}
__device__ __forceinline__ void peer_phase(Frame& F, const Args& a) {
    unsigned char* ws = a.ws;
    for (int tile = F.vcu; tile < T / TOK; tile += F.G) {
        route_tile(F, (const bf16*)(ws + WS_QP), (const bf16*)(ws + WS_SKB), (const float*)(ws + WS_SUMSQ), tile * TOK);
        __syncthreads();
        eval_tile(F, (const bf16*)(ws + WS_UT), (const bf16*)(ws + WS_VT), a.in[19], a.out, tile * TOK);
        __syncthreads();
    }
}
}

namespace lru {
typedef float f32x16 __attribute__((ext_vector_type(16)));
constexpr int TOKT = 128, NTILE = SEQ / TOKT;
constexpr int WAVE_LDS = 14336, L_XS = 0, L_XC = 4608, L_GS = 9216, XC_STRIDE = 72  , L_SS = 8 * WAVE_LDS;
static_assert(L_SS + 32 * 8 * 4 <= RING_BYTES, "LRU LDS map");
__device__ __forceinline__ float bf2f(unsigned short h) { return __uint_as_float((unsigned)h << 16); }
__device__ __forceinline__ int crow16(int r) { return (r & 3) + 8 * (r >> 2); }
__device__ __forceinline__ float sigm(float x) { return __builtin_amdgcn_rcpf(1.f + __builtin_amdgcn_exp2f(-LOG2E * x)); }

template <bool FINAL> __device__ __forceinline__ void lru_tile(Frame& F, const Args& args, int tile) {
    int lane = F.lane; asm volatile("" : "+v"(lane));
    const int w = F.wave, j32 = lane & 31, hi = lane >> 5;
    unsigned char* ws = args.ws;
    const bf16* xr = (const bf16*)(ws + WS_XR); const bf16* gr = (const bf16*)(ws + WS_GR); float* carry = (float*)(ws + WS_CARRY);
    const float* cw = args.in[3]; const float* cb = args.in[4]; const float* ba = args.in[6]; const float* bx = args.in[8]; const float* lam = args.in[9];
    const int b = tile / NTILE, jt = tile % NTILE; const size_t trow0 = (size_t)b * SEQ + (size_t)jt * TOKT;
    LAS unsigned char* wl = F.lds + RING_OFF + w * WAVE_LDS;
    LAS unsigned short* XS = (LAS unsigned short*)(wl + L_XS); LAS unsigned short* XC = (LAS unsigned short*)(wl + L_XC); LAS unsigned short* GS = (LAS unsigned short*)(wl + L_GS);
    LAS float* SS = (LAS float*)(F.lds + RING_OFF + L_SS);
    float c_ba[2], c_bx[2], c_sp[2], c_cb[2], c_cw[2][4];
#pragma unroll
    for (int n = 0; n < 2; ++n) { const int c = 64 * w + 32 * n + j32; c_ba[n] = ba[c]; c_bx[n] = bx[c]; c_cb[n] = cb[c];
        const float l = lam[c]; c_sp[n] = 8.f * LOG2E * (fmaxf(-l, 0.f) + log1pf(expf(-fabsf(l))));
#pragma unroll
        for (int k = 0; k < 4; ++k) c_cw[n][k] = cw[k * LW + c]; }
    const bf16* wax = (const bf16*)(ws + WS_WAX);
    float hc[2] = {0.f, 0.f}, ap[2] = {1.f, 1.f};
    if (FINAL) {
        for (int jp = 0; jp < jt; ++jp) { const float* cp = carry + ((size_t)(b * NTILE + jp) * 2) * LW + 64 * w + j32;
#pragma unroll
            for (int n = 0; n < 2; ++n) hc[n] = cp[32 * n] * hc[n] + cp[LW + 32 * n]; }
    }
    for (int blk = 0; blk < 4; ++blk) {
        const size_t tb = trow0 + blk * 32;
        int ln = lane; asm volatile("" : "+v"(ln));
        const int k32 = ln & 31;
        for (int pc = ln; pc < 35 * 8; pc += 64) { const int row = pc >> 3, c8 = pc & 7; v4u v = (v4u){0u, 0u, 0u, 0u};
            if (!(jt == 0 && blk == 0 && row < 3)) v = *(const GAS v4u*)(xr + (tb + row - 3) * LW + w * 64 + c8 * 8);
            *(LAS v4u*)((LAS unsigned char*)XS + row * 128 + c8 * 16) = v; }
        if (FINAL) {
#pragma unroll
            for (int q = 0; q < 4; ++q) { const int pc = ln + 64 * q, row = pc >> 3, c8 = pc & 7;
                *(LAS v4u*)((LAS unsigned char*)GS + row * 128 + c8 * 16) = *(const GAS v4u*)(gr + (tb + row) * LW + w * 64 + c8 * 8); } }
        asm volatile("" ::: "memory");
        float xc[2][16];
#pragma unroll
        for (int n = 0; n < 2; ++n)
#pragma unroll
            for (int g = 0; g < 4; ++g) { float xv[7];
#pragma unroll
                for (int q = 0; q < 7; ++q) xv[q] = bf2f(XS[(8 * g + 4 * hi + q) * 64 + 32 * n + j32]);
#pragma unroll
                for (int e = 0; e < 4; ++e) xc[n][4 * g + e] = c_cb[n] + ((c_cw[n][0] * xv[e] + c_cw[n][1] * xv[e + 1]) + (c_cw[n][2] * xv[e + 2] + c_cw[n][3] * xv[e + 3])); }
#pragma unroll
        for (int n = 0; n < 2; ++n)
#pragma unroll
            for (int r = 0; r < 16; ++r) XC[(crow16(r) + 4 * hi) * XC_STRIDE + 32 * n + j32] = (unsigned short)f2bf(xc[n][r]);
        asm volatile("" ::: "memory");
        bf16x8 af[4];
#pragma unroll
        for (int ks = 0; ks < 4; ++ks) af[ks] = *(const LAS bf16x8*)(XC + j32 * XC_STRIDE + 16 * ks + 8 * hi);
        asm volatile("" ::: "memory");
        float yv[2][16];
#pragma unroll
        for (int n = 0; n < 2; ++n) {
            f32x16 R = {}, I = {};
            bf16x8 fa[4], fx[4];
#pragma unroll
            for (int ks = 0; ks < 4; ++ks) { fa[ks] = *(const GAS bf16x8*)(wax + (size_t)(((w * 2 + 0) * 2 + n) * 4 + ks) * 512 + lane * 8); fx[ks] = *(const GAS bf16x8*)(wax + (size_t)(((w * 2 + 1) * 2 + n) * 4 + ks) * 512 + lane * 8); }
#pragma unroll
            for (int ks = 0; ks < 4; ++ks) { R = __builtin_amdgcn_mfma_f32_32x32x16_bf16(af[ks], fa[ks], R, 0, 0, 0); I = __builtin_amdgcn_mfma_f32_32x32x16_bf16(af[ks], fx[ks], I, 0, 0, 0); }
            float av[16], uv[16];
#pragma unroll
            for (int r = 0; r < 16; ++r) { const float rg = sigm(R[r] + c_ba[n]), ig = sigm(I[r] + c_bx[n]); const float a_ = __builtin_amdgcn_exp2f(-rg * c_sp[n]);
                av[r] = a_; uv[r] = __builtin_amdgcn_sqrtf(fmaxf(1.f - a_ * a_, 0.f)) * (ig * xc[n][r]); }
            float Ar[4], Hr[4], hst[4];
#pragma unroll
            for (int g = 0; g < 4; ++g) { Ar[g] = (av[4 * g] * av[4 * g + 1]) * (av[4 * g + 2] * av[4 * g + 3]);
                Hr[g] = ((uv[4 * g] * av[4 * g + 1] + uv[4 * g + 1]) * av[4 * g + 2] + uv[4 * g + 2]) * av[4 * g + 3] + uv[4 * g + 3]; }
            float hin = hc[n];
#pragma unroll
            for (int g = 0; g < 4; ++g) { float o1 = Ar[g] * hin + Hr[g]; const float x = __shfl_xor(o1, 32); const float hg = hi ? x : hin; o1 = Ar[g] * hg + Hr[g]; hst[g] = hg;
                const float y = __shfl_xor(o1, 32); hin = hi ? o1 : y;
                if (!FINAL) ap[n] *= Ar[g] * __shfl_xor(Ar[g], 32); }
            hc[n] = hin;
            if (FINAL) {
#pragma unroll
                for (int g = 0; g < 4; ++g) { float h = hst[g];
#pragma unroll
                    for (int e = 0; e < 4; ++e) { const int r = 4 * g + e; h = av[r] * h + uv[r]; yv[n][r] = h * bf2f(GS[(crow16(r) + 4 * hi) * 64 + 32 * n + j32]); } } }
        }
        if (FINAL) {
#pragma unroll
            for (int r = 0; r < 16; ++r) { float s = yv[0][r] * yv[0][r] + yv[1][r] * yv[1][r];
                s += __shfl_xor(s, 1); s += __shfl_xor(s, 2); s += __shfl_xor(s, 4); s += __shfl_xor(s, 8); s += __shfl_xor(s, 16);
                if (j32 == 0) SS[(crow16(r) + 4 * hi) * 8 + w] = s; }
            __syncthreads();
            bf16* ymix = (bf16*)(ws + WS_H);
#pragma unroll
            for (int r = 0; r < 16; ++r) { const int tk = crow16(r) + 4 * hi; const f32x4 s0 = *(const LAS f32x4*)(SS + tk * 8), s1 = *(const LAS f32x4*)(SS + tk * 8 + 4);
                const float rstd = rsqrtf(((s0[0] + s0[1]) + (s0[2] + s0[3]) + (s1[0] + s1[1]) + (s1[2] + s1[3])) * (1.f / LW) + RMS_EPS);
                bf16* yp = ymix + (tb + tk) * DMODEL + 64 * w + k32;
                yp[0] = (bf16)f2bf(yv[0][r] * rstd); yp[32] = (bf16)f2bf(yv[1][r] * rstd); }
            __syncthreads();
        }
    }
    if (!FINAL) { if (hi == 0) { float* cp = carry + ((size_t)(b * NTILE + jt) * 2) * LW + 64 * w + j32;
#pragma unroll
        for (int n = 0; n < 2; ++n) { cp[32 * n] = ap[n]; cp[LW + 32 * n] = hc[n]; } } }
    else {
        const bf16* ob = (const bf16*)(ws + WS_Q); bf16* ymix = (bf16*)(ws + WS_H);
        for (int i = 0; i < 16; ++i) { const size_t row = trow0 + 16 * w + i; const v4u v = *(const GAS v4u*)(ob + row * AW + 8 * lane);
            float f[8]; f[0] = __uint_as_float(v.x << 16); f[1] = __uint_as_float(v.x & 0xffff0000u); f[2] = __uint_as_float(v.y << 16); f[3] = __uint_as_float(v.y & 0xffff0000u);
            f[4] = __uint_as_float(v.z << 16); f[5] = __uint_as_float(v.z & 0xffff0000u); f[6] = __uint_as_float(v.w << 16); f[7] = __uint_as_float(v.w & 0xffff0000u);
            float ss = 0.f;
#pragma unroll
            for (int e = 0; e < 8; ++e) ss += f[e] * f[e];
            const float rstd = rsqrtf(wave_sum(ss) * (1.f / AW) + RMS_EPS);
            v4u o; o.x = pk2(f[0] * rstd, f[1] * rstd); o.y = pk2(f[2] * rstd, f[3] * rstd); o.z = pk2(f[4] * rstd, f[5] * rstd); o.w = pk2(f[6] * rstd, f[7] * rstd);
            *(GAS v4u*)(ymix + row * DMODEL + LW + 8 * lane) = o; }
    }
}
template <bool FINAL> __device__ __forceinline__ void lru_phase(Frame& F, const Args& a) {
    for (int tile = F.vcu; tile < BATCH * NTILE; tile += F.G) { lru_tile<FINAL>(F, a, tile); __syncthreads(); }
}
}
__global__ void __launch_bounds__(NWAVES * 64, 2) mk_fwd(Args args) {
    extern __shared__ __attribute__((aligned(16))) unsigned char lds[];
    Frame F;
    F.lds = (LAS unsigned char*)lds;
    F.MISC = (volatile LAS unsigned*)(F.lds + MISC_OFF);
    F.wave = __builtin_amdgcn_readfirstlane((int)threadIdx.x >> 6); F.lane = (int)__builtin_amdgcn_mbcnt_hi(~0u, __builtin_amdgcn_mbcnt_lo(~0u, 0u)); F.tid = F.wave * 64 + F.lane;
    F.G = gridDim.x; { const int bx = blockIdx.x; F.vcu = (F.G % 8 == 0) ? (bx % 8) * (F.G / 8) + bx / 8 : bx; }
    unsigned char* ws = args.ws;
    F.ctl = (gu32*)(ws + WS_CTL);
    for (int u = F.tid; u < (LDS_BYTES - LDSCTL_OFF) / 4; u += NWAVES * 64) ((LAS unsigned*)(F.lds + LDSCTL_OFF))[u] = 0u;
    __syncthreads();
    XcdBarrier bar = xcd_barrier_post((unsigned*)(F.ctl + CW_BAR) + args.li * XCD_BAR_WORDS, F.MISC + 8, F.wave);
    const int lo = args.ph_lo, hi = args.ph_hi;
#define IN(k) (lo <= (k) && (k) < hi)
#define BOTH(k) (IN(k) && IN((k) + 1))
#define GRID_BAR() xcd_barrier(bar)

    if (IN(0)) { p0_prologue(F, args); if (BOTH(0)) GRID_BAR(); }

    if (IN(1)) {
        if (F.vcu < BATCH * NHEADS) fcum_unit(F, F.vcu, (const float*)(ws + WS_LOGF), (float*)(ws + WS_FCUM));
        pg8::Gemm g{(const pg8::bf16_t*)(ws + WS_H), (const pg8::bf16_t*)(ws + WS_WIN), T, NG1, DMODEL}; pg8::StaticOrder S; S.init(T, NG1, F.G, (int)blockIdx.x);
        pg8::EpiG1 E{(pg8::bf16_t*)(ws + WS_XR), SPLIT_STRIDE, QSCALE};
        pg8::gemm_phase<pg8::EpiG1, pg8::StaticOrder, true, true>(F.lds + RING_OFF, g, S, E, F.wave);
        if (BOTH(1)) GRID_BAR();
    }
    if (IN(2)) {
        static_assert(attn_body::ATTN_LDS_BYTES <= RING_BYTES, "attention LDS vs frame");
        const attn_body::AttnTensors AT{(const attn_body::bf16*)(ws + WS_Q), (const attn_body::bf16*)(ws + WS_K), (const attn_body::bf16*)(ws + WS_V), (attn_body::bf16*)(ws + WS_Q), (const float*)(ws + WS_FCUM)};
        const attn_body::StaticOrder S((int)F.G, (int)blockIdx.x);
        attn_body::attn_phase<attn_body::StaticOrder>((char*)lds + RING_OFF, AT, S, F.wave);
    }
    if (IN(3)) { lru::lru_phase<false>(F, args); if (BOTH(3)) GRID_BAR(); }
    if (IN(4)) { lru::lru_phase<true>(F, args); if (BOTH(4)) GRID_BAR(); }
    if (IN(5)) {
        pg8::Gemm g{(const pg8::bf16_t*)(ws + WS_H), (const pg8::bf16_t*)(ws + WS_WOUT), T, DMODEL, DMODEL}; pg8::StaticOrder S; S.init(T, DMODEL, F.G, (int)blockIdx.x);
        pg8::EpiG2 E{args.in[0], args.out, (pg8::bf16_t*)(ws + WS_X1B), (float*)(ws + WS_SUMSQ), DMODEL};
        pg8::gemm_phase<pg8::EpiG2, pg8::StaticOrder, true, true>(F.lds + RING_OFF, g, S, E, F.wave);
        if (BOTH(5)) GRID_BAR();
    }
    if (IN(6)) {
        pg8::Gemm g{(const pg8::bf16_t*)(ws + WS_X1B), (const pg8::bf16_t*)(ws + WS_WQ), T, QPW, DMODEL}; pg8::StaticOrder S; S.init(T, QPW, F.G, (int)blockIdx.x);
        pg8::EpiG3 E{(pg8::bf16_t*)(ws + WS_QP), QPW};
        pg8::gemm_phase<pg8::EpiG3, pg8::StaticOrder, true, true>(F.lds + RING_OFF, g, S, E, F.wave);
        if (BOTH(6)) GRID_BAR();
    }
    if (IN(7)) { peer::peer_phase(F, args); }
#undef IN
#undef BOTH
#undef GRID_BAR
}

#ifndef MK_FRAME_MASK
#define MK_FRAME_MASK 0xFF
#endif
extern "C" void kernel_launch(void* const* d_in, const int* in_sizes, int n_in, void* d_out, int out_size, void* d_ws, size_t ws_size, hipStream_t stream) {
    static int grid = 0;
    if (grid == 0) {
        if (n_in != 20 || in_sizes[0] != T * DMODEL || out_size != T * DMODEL || ws_size < WS_END) { fprintf(stderr, "kernel_launch: unexpected shapes (n_in %d, ws %zu)\n", n_in, ws_size); grid = -1; return; }
        int dev = 0, cus = 0;
        if (hipGetDevice(&dev) != hipSuccess || hipDeviceGetAttribute(&cus, hipDeviceAttributeMultiprocessorCount, dev) != hipSuccess) { grid = -1; return; }
        if (hipFuncSetAttribute((const void*)mk_fwd, hipFuncAttributeMaxDynamicSharedMemorySize, LDS_BYTES) != hipSuccess) { fprintf(stderr, "kernel_launch: hipFuncSetAttribute failed\n"); grid = -1; return; }
        (void)hipGetLastError();
        grid = cus;
    }
    if (grid < 0) return;
    using namespace naive;
    const float* x = (const float*)d_in[0]; const float* g1 = (const float*)d_in[1]; const float* w_in = (const float*)d_in[2];
    const float* cw = (const float*)d_in[3]; const float* cb = (const float*)d_in[4]; const float* wa = (const float*)d_in[5]; const float* ba = (const float*)d_in[6];
    const float* wx = (const float*)d_in[7]; const float* bx = (const float*)d_in[8]; const float* lam = (const float*)d_in[9]; const float* bfv = (const float*)d_in[10];
    const float* gn_l = (const float*)d_in[11]; const float* gn_f = (const float*)d_in[12]; const float* w_out = (const float*)d_in[13]; const float* g2 = (const float*)d_in[14];
    const float* w_q = (const float*)d_in[15]; const float* sk = (const float*)d_in[16]; const float* pu = (const float*)d_in[17]; const float* pv = (const float*)d_in[18]; const float* fg = (const float*)d_in[19];
    char* ws = (char*)d_ws; float* out = (float*)d_out;
    naive::bf16* win_t = (naive::bf16*)(ws + WS_WIN); naive::bf16* wout_t = (naive::bf16*)(ws + WS_WOUT); naive::bf16* wq_t = (naive::bf16*)(ws + WS_WQ); naive::bf16* skb = (naive::bf16*)(ws + WS_SKB); float* wfl = (float*)(ws + WS_WFL);
    float* logf = (float*)(ws + WS_LOGF); float* fcum = (float*)(ws + WS_FCUM); float* sumsq = (float*)(ws + WS_SUMSQ);
    naive::bf16* h = (naive::bf16*)(ws + WS_H); naive::bf16* xr = (naive::bf16*)(ws + WS_XR); naive::bf16* gr = (naive::bf16*)(ws + WS_GR); naive::bf16* q = (naive::bf16*)(ws + WS_Q); naive::bf16* k = (naive::bf16*)(ws + WS_K); naive::bf16* v = (naive::bf16*)(ws + WS_V);
    naive::bf16* x1b = (naive::bf16*)(ws + WS_X1B); naive::bf16* qp = (naive::bf16*)(ws + WS_QP); naive::bf16* ut = (naive::bf16*)(ws + WS_UT); naive::bf16* vt = (naive::bf16*)(ws + WS_VT); float* la = (float*)(ws + WS_LA); float* lu = (float*)(ws + WS_LU);
    naive::bf16* ymix = h;
    if (hipMemsetAsync((char*)d_ws + WS_CTL, 0, CTL_ZERO_BYTES, stream) != hipSuccess) return;
    Args a{};
    for (int i = 0; i < 20; ++i) a.in[i] = (const float*)d_in[i];
    a.out = out; a.ws = (unsigned char*)d_ws;
    int li = 0;
    for (int p = 0; p < N_PHASES;) {
        if ((MK_FRAME_MASK >> p) & 1) {
            int e = p; while (e < N_PHASES && ((MK_FRAME_MASK >> e) & 1)) ++e;
            a.ph_lo = p; a.ph_hi = e; a.li = li++;
            hipLaunchKernelGGL(mk_fwd, dim3(grid), dim3(NWAVES * 64), LDS_BYTES, stream, a);
            p = e; continue;
        }
        switch (p) {
        case 0: k_prep_w<<<2048, 256, 0, stream>>>(w_in, w_out, gn_l, gn_f, w_q, g2, sk, win_t, wfl, wout_t, wq_t, skb);
                k_prep_tab<<<4096, 256, 0, stream>>>(pu, pv, g2, ut, vt);
                k_prep_x<<<2048, 256, 0, stream>>>(x, g1, wfl, bfv, h, logf); break;
        case 1: k_fcum<<<BATCH * NHEADS, 64, 0, stream>>>(logf, fcum);
                { EpiArgs e{xr, gr, q, k, v, nullptr, nullptr}; k_gemm<1><<<dim3(NG1 / 64, T / 64), 256, 0, stream>>>(h, win_t, T, NG1, DMODEL, e); } break;
        case 2: k_attn<<<(BATCH * NHEADS * SEQ) / 4, 256, 0, stream>>>(q, k, v, fcum, q); break;
        case 3: break;
        case 4: k_lru_gates<<<T * NHEADS, 64, 0, stream>>>(xr, cw, cb, wa, ba, wx, bx, lam, la, lu);
                k_lru_scan<<<(BATCH * LW + 63) / 64, 64, 0, stream>>>(la, lu, gr);
                k_ymix<<<2048, 256, 0, stream>>>(lu, q, ymix); break;
        case 5: { EpiArgs e{x1b, nullptr, nullptr, nullptr, nullptr, x, out}; k_gemm<2><<<dim3(DMODEL / 64, T / 64), 256, 0, stream>>>(ymix, wout_t, T, DMODEL, DMODEL, e); }
                k_sumsq<<<2048, 256, 0, stream>>>(out, sumsq); break;
        case 6: { EpiArgs e{qp, nullptr, nullptr, nullptr, nullptr, nullptr, nullptr}; k_gemm<3><<<dim3(QPW / 64, T / 64), 256, 0, stream>>>(x1b, wq_t, T, QPW, DMODEL, e); } break;
        case 7: k_peer<<<T, 64, 0, stream>>>(qp, skb, sumsq, ut, vt, fg, out); break;
        }
        ++p;
    }
}
```

```cpp
#include <hip/hip_runtime.h>
#include <hip/hip_bf16.h>
#include <cstdio>
#include <cstdint>
#include <cmath>

constexpr int BATCH = 4, SEQ = 8192, DMODEL = 1024, T = BATCH * SEQ;
constexpr int LW = 512, AW = 512, NHEADS = 8, HD = 64, INC = 2568, NG1 = 2560;
constexpr int PH = 8, NKEY = 128, PHALF = 128, TOPK = 16, NEXP = NKEY * NKEY, QPW = 2048;
constexpr float RMS_EPS = 1e-6f;
constexpr float LOG2E = 1.4426950408889634f;
constexpr float QSCALE = 0.125f * LOG2E;
constexpr size_t MiB = 1u << 20;
constexpr size_t WS_CTL = 0, CTL_ZERO_BYTES = 1 * MiB;
constexpr size_t WS_WIN = 2 * MiB, WS_WOUT = 8 * MiB, WS_WQ = 10 * MiB, WS_SKB = 14 * MiB, WS_WFL = 15 * MiB,
                 WS_LOGF = 16 * MiB, WS_FCUM = 17 * MiB, WS_CARRY = 18 * MiB, WS_SUMSQ = 19 * MiB, WS_WAX = 20 * MiB,
                 WS_H = 32 * MiB, WS_XR = 96 * MiB, WS_GR = 128 * MiB, WS_Q = 160 * MiB, WS_K = 192 * MiB, WS_V = 224 * MiB,
                 WS_X1B = 256 * MiB, WS_QP = 96 * MiB, WS_UT = 320 * MiB, WS_VT = 352 * MiB, WS_U8 = 320 * MiB, WS_V8 = 336 * MiB, WS_SU = 21 * MiB, WS_SV = 21 * MiB + 65536, WS_LA = 384 * MiB, WS_LU = 448 * MiB, WS_END = 512 * MiB;
constexpr size_t SPLIT_STRIDE = (WS_GR - WS_XR) / 2;
constexpr int CW_TMO = 0, CW_BAR = 4096;

namespace naive {
typedef unsigned short bf16;
__device__ __forceinline__ unsigned f2bf(float f) { unsigned u = __builtin_bit_cast(unsigned, f); return (u + 0x7fffu + ((u >> 16) & 1u)) >> 16; }
__device__ __forceinline__ float bf2f(unsigned short h) { return __builtin_bit_cast(float, (unsigned)h << 16); }
__device__ __forceinline__ float gelu_tanh(float x) { const float u = 0.7978845608028654f * (x + 0.044715f * x * x * x); return 0.5f * x * (1.f + tanhf(u)); }
__device__ __forceinline__ float sigmoidf_(float x) { return 1.f / (1.f + expf(-x)); }
__device__ __forceinline__ float wave_sum(float v) {
#pragma unroll
    for (int o = 1; o < 64; o <<= 1) v += __shfl_xor(v, o);
    return v;
}
__global__ void k_prep_w(const float* w_in, const float* w_out, const float* gn_l, const float* gn_f, const float* w_q, const float* g2, const float* sk,
                         bf16* win_t, float* wfl, bf16* wout_t, bf16* wq_t, bf16* skb) {
    const size_t gid = (size_t)blockIdx.x * blockDim.x + threadIdx.x, gsz = (size_t)gridDim.x * blockDim.x;
    for (size_t i = gid; i < (size_t)NG1 * DMODEL; i += gsz) { const int n = (int)(i / DMODEL), k = (int)(i % DMODEL); win_t[i] = (bf16)f2bf(w_in[(size_t)k * INC + n]); }
    for (size_t i = gid; i < (size_t)8 * DMODEL; i += gsz) { const int j = (int)(i / DMODEL), k = (int)(i % DMODEL); wfl[i] = w_in[(size_t)k * INC + NG1 + j]; }
    for (size_t i = gid; i < (size_t)DMODEL * DMODEL; i += gsz) { const int n = (int)(i / DMODEL), k = (int)(i % DMODEL); const float g = k < LW ? gn_l[k] : gn_f[k - LW]; wout_t[i] = (bf16)f2bf(g * w_out[(size_t)k * DMODEL + n]); }
    for (size_t i = gid; i < (size_t)QPW * DMODEL; i += gsz) { const int n = (int)(i / DMODEL), k = (int)(i % DMODEL); wq_t[i] = (bf16)f2bf(g2[k] * w_q[(size_t)k * QPW + n]); }
    for (size_t i = gid; i < (size_t)PH * 2 * NKEY * PHALF; i += gsz) skb[i] = (bf16)f2bf(sk[i]);
}
__global__ void k_prep_tab(const float* u, const float* v, const float* g2, bf16* ut, bf16* vt) {
    const size_t gid = (size_t)blockIdx.x * blockDim.x + threadIdx.x, gsz = (size_t)gridDim.x * blockDim.x;
    for (size_t i = gid; i < (size_t)NEXP * DMODEL; i += gsz) { const int d = (int)(i % DMODEL); ut[i] = (bf16)f2bf(g2[d] * u[i]); vt[i] = (bf16)f2bf(v[i]); }
}
__global__ void k_prep_x(const float* x, const float* g1, const float* wfl, const float* bfv, bf16* h, float* logf) {
    const int lane = threadIdx.x & 63, wv = (blockIdx.x * blockDim.x + threadIdx.x) >> 6, nw = (gridDim.x * blockDim.x) >> 6;
    for (int t = wv; t < T; t += nw) {
        float xv[16]; float ss = 0.f;
#pragma unroll
        for (int j = 0; j < 4; ++j) { const float4 v = *(const float4*)(x + (size_t)t * DMODEL + j * 256 + lane * 4); xv[4 * j] = v.x; xv[4 * j + 1] = v.y; xv[4 * j + 2] = v.z; xv[4 * j + 3] = v.w; ss += v.x * v.x + v.y * v.y + v.z * v.z + v.w * v.w; }
        const float rstd = rsqrtf(wave_sum(ss) * (1.f / DMODEL) + RMS_EPS);
#pragma unroll
        for (int j = 0; j < 4; ++j) { const float4 g = *(const float4*)(g1 + j * 256 + lane * 4); xv[4 * j] *= rstd * g.x; xv[4 * j + 1] *= rstd * g.y; xv[4 * j + 2] *= rstd * g.z; xv[4 * j + 3] *= rstd * g.w;
            uint2 o; o.x = f2bf(xv[4 * j]) | (f2bf(xv[4 * j + 1]) << 16); o.y = f2bf(xv[4 * j + 2]) | (f2bf(xv[4 * j + 3]) << 16); *(uint2*)(h + (size_t)t * DMODEL + j * 256 + lane * 4) = o; }
#pragma unroll
        for (int hh = 0; hh < 8; ++hh) { float a = 0.f;
#pragma unroll
            for (int j = 0; j < 4; ++j) { const float4 w = *(const float4*)(wfl + hh * DMODEL + j * 256 + lane * 4); a += xv[4 * j] * w.x + xv[4 * j + 1] * w.y + xv[4 * j + 2] * w.z + xv[4 * j + 3] * w.w; }
            a = wave_sum(a);
            if (lane == 0) { const float z = a + bfv[hh]; logf[(size_t)t * 8 + hh] = fminf(z, 0.f) - log1pf(expf(-fabsf(z))); } }
    }
}
__global__ void k_fcum(const float* logf, float* fcum) {
    const int lane = threadIdx.x & 63, bh = blockIdx.x, b = bh / NHEADS, hh = bh % NHEADS;
    float loc = 0.f;
    for (int i = 0; i < 128; ++i) loc += logf[((size_t)b * SEQ + lane * 128 + i) * 8 + hh];
    float inc = loc;
#pragma unroll
    for (int o = 1; o < 64; o <<= 1) { const float n = __shfl_up(inc, o); if (lane >= o) inc += n; }
    float run = inc - loc;
    for (int i = 0; i < 128; ++i) { run += logf[((size_t)b * SEQ + lane * 128 + i) * 8 + hh]; fcum[(size_t)bh * SEQ + lane * 128 + i] = run; }
}
struct EpiArgs { bf16* o0; bf16* o1; bf16* o2; bf16* o3; bf16* o4; const float* resid; float* outf; };
template <int EPI> __global__ void __launch_bounds__(256) k_gemm(const bf16* A, const bf16* Bt, int M, int N, int K, EpiArgs e) {
    __shared__ float As[32][65], Bs[32][65];
    const int tid = threadIdx.x, tx = tid & 15, ty = tid >> 4, m0 = blockIdx.y * 64, n0 = blockIdx.x * 64;
    float acc[4][4] = {};
    const int lr = tid >> 2, lc = (tid & 3) * 8;
    for (int k0 = 0; k0 < K; k0 += 32) {
        const uint4 av = *(const uint4*)(A + (size_t)(m0 + lr) * K + k0 + lc), bv = *(const uint4*)(Bt + (size_t)(n0 + lr) * K + k0 + lc);
        const unsigned aw[4] = {av.x, av.y, av.z, av.w}, bw[4] = {bv.x, bv.y, bv.z, bv.w};
#pragma unroll
        for (int i = 0; i < 4; ++i) { As[lc + 2 * i][lr] = bf2f(aw[i] & 0xffff); As[lc + 2 * i + 1][lr] = bf2f(aw[i] >> 16); Bs[lc + 2 * i][lr] = bf2f(bw[i] & 0xffff); Bs[lc + 2 * i + 1][lr] = bf2f(bw[i] >> 16); }
        __syncthreads();
#pragma unroll 8
        for (int k = 0; k < 32; ++k) { float a[4], b[4];
#pragma unroll
            for (int i = 0; i < 4; ++i) { a[i] = As[k][ty * 4 + i]; b[i] = Bs[k][tx * 4 + i]; }
#pragma unroll
            for (int i = 0; i < 4; ++i)
#pragma unroll
                for (int j = 0; j < 4; ++j) acc[i][j] += a[i] * b[j]; }
        __syncthreads();
    }
#pragma unroll
    for (int i = 0; i < 4; ++i)
#pragma unroll
        for (int j = 0; j < 4; ++j) { const int m = m0 + ty * 4 + i, n = n0 + tx * 4 + j; const float v = acc[i][j];
            if (EPI == 1) { const int s = n >> 9, c = n & 511; bf16* o = s == 0 ? e.o0 : s == 1 ? e.o1 : s == 2 ? e.o2 : s == 3 ? e.o3 : e.o4;
                const float w = s == 1 ? gelu_tanh(v) : s == 2 ? v * QSCALE : v; o[(size_t)m * 512 + c] = (bf16)f2bf(w); }
            else if (EPI == 2) { const float r = e.resid[(size_t)m * DMODEL + n] + v; e.outf[(size_t)m * DMODEL + n] = r; e.o0[(size_t)m * DMODEL + n] = (bf16)f2bf(r); }
            else { e.o0[(size_t)m * N + n] = (bf16)f2bf(v); } }
}
__global__ void k_sumsq(const float* x1, float* sumsq) {
    const int lane = threadIdx.x & 63, wv = (blockIdx.x * blockDim.x + threadIdx.x) >> 6, nw = (gridDim.x * blockDim.x) >> 6;
    for (int t = wv; t < T; t += nw) { float ss = 0.f;
#pragma unroll
        for (int j = 0; j < 4; ++j) { const float4 v = *(const float4*)(x1 + (size_t)t * DMODEL + j * 256 + lane * 4); ss += v.x * v.x + v.y * v.y + v.z * v.z + v.w * v.w; }
        ss = wave_sum(ss); if (lane == 0) sumsq[t] = ss; }
}
__global__ void k_lru_gates(const bf16* xr, const float* cw, const float* cb, const float* wa, const float* ba, const float* wx, const float* bx, const float* lam, float* la, float* lu) {
    __shared__ float xc[64];
    const int j = threadIdx.x, t = blockIdx.x / NHEADS, hh = blockIdx.x % NHEADS, ch = hh * 64 + j, s = t % SEQ;
    float c = cb[ch];
#pragma unroll
    for (int k = 0; k < 4; ++k) { const int ss = s - 3 + k; if (ss >= 0) c += cw[k * LW + ch] * bf2f(xr[(size_t)(t - 3 + k) * LW + ch]); }
    xc[j] = c; __syncthreads();
    float r = ba[ch], ii = bx[ch];
    for (int i = 0; i < 64; ++i) { const float xv = xc[i]; r += xv * wa[(size_t)(hh * 64 + i) * 64 + j]; ii += xv * wx[(size_t)(hh * 64 + i) * 64 + j]; }
    r = sigmoidf_(r); ii = sigmoidf_(ii);
    const float l = lam[ch], sp = fmaxf(-l, 0.f) + log1pf(expf(-fabsf(l)));
    const float log_a = -8.f * r * sp, a = expf(log_a), u = sqrtf(-expm1f(2.f * log_a)) * (ii * c);
    la[(size_t)t * LW + ch] = a; lu[(size_t)t * LW + ch] = u;
}
__global__ void k_lru_scan(const float* la, float* lu, const bf16* gr) {
    const int id = blockIdx.x * blockDim.x + threadIdx.x; if (id >= BATCH * LW) return;
    const int b = id / LW, ch = id % LW; float h = 0.f;
    for (int s = 0; s < SEQ; ++s) { const size_t o = ((size_t)b * SEQ + s) * LW + ch; h = la[o] * h + lu[o]; lu[o] = h * bf2f(gr[o]); }
}
__global__ void k_ymix(const float* ylru, const bf16* o, bf16* ymix) {
    const int lane = threadIdx.x & 63, wv = (blockIdx.x * blockDim.x + threadIdx.x) >> 6, nw = (gridDim.x * blockDim.x) >> 6;
    for (int t = wv; t < T; t += nw) {
        float a[8], f[8]; float sa = 0.f, sf = 0.f;
#pragma unroll
        for (int i = 0; i < 8; ++i) { a[i] = ylru[(size_t)t * LW + i * 64 + lane]; f[i] = bf2f(o[(size_t)t * AW + i * 64 + lane]); sa += a[i] * a[i]; sf += f[i] * f[i]; }
        const float ra = rsqrtf(wave_sum(sa) * (1.f / LW) + RMS_EPS), rf = rsqrtf(wave_sum(sf) * (1.f / AW) + RMS_EPS);
#pragma unroll
        for (int i = 0; i < 8; ++i) { ymix[(size_t)t * DMODEL + i * 64 + lane] = (bf16)f2bf(a[i] * ra); ymix[(size_t)t * DMODEL + LW + i * 64 + lane] = (bf16)f2bf(f[i] * rf); }
    }
}
__global__ void __launch_bounds__(256) k_attn(const bf16* Q, const bf16* K, const bf16* V, const float* fcum, bf16* O) {
    const int lane = threadIdx.x & 63, wv = (blockIdx.x * blockDim.x + threadIdx.x) >> 6;
    const int q = wv % SEQ, bh = wv / SEQ, b = bh / NHEADS, hh = bh % NHEADS;
    const size_t rowq = (size_t)b * SEQ + q;
    float qv[64];
#pragma unroll
    for (int i = 0; i < 8; ++i) { const uint4 w = *(const uint4*)(Q + rowq * AW + hh * 64 + i * 8); const unsigned ww[4] = {w.x, w.y, w.z, w.w};
#pragma unroll
        for (int c = 0; c < 4; ++c) { qv[i * 8 + 2 * c] = bf2f(ww[c] & 0xffff); qv[i * 8 + 2 * c + 1] = bf2f(ww[c] >> 16); } }
    const float fq = fcum[(size_t)bh * SEQ + q];
    float m = -INFINITY, l = 0.f; float o[64];
#pragma unroll
    for (int d = 0; d < 64; ++d) o[d] = 0.f;
    for (int j = lane; j <= q; j += 64) {
        const size_t rowk = (size_t)b * SEQ + j; float s = 0.f;
#pragma unroll
        for (int i = 0; i < 8; ++i) { const uint4 w = *(const uint4*)(K + rowk * AW + hh * 64 + i * 8); const unsigned ww[4] = {w.x, w.y, w.z, w.w};
#pragma unroll
            for (int c = 0; c < 4; ++c) { s += qv[i * 8 + 2 * c] * bf2f(ww[c] & 0xffff) + qv[i * 8 + 2 * c + 1] * bf2f(ww[c] >> 16); } }
        s += (fq - fcum[(size_t)bh * SEQ + j]) * LOG2E;
        const float mn = fmaxf(m, s), sc = exp2f(m - mn), p = exp2f(s - mn);
        l = l * sc + p; m = mn;
#pragma unroll
        for (int i = 0; i < 8; ++i) { const uint4 w = *(const uint4*)(V + rowk * AW + hh * 64 + i * 8); const unsigned ww[4] = {w.x, w.y, w.z, w.w};
#pragma unroll
            for (int c = 0; c < 4; ++c) { o[i * 8 + 2 * c] = o[i * 8 + 2 * c] * sc + p * bf2f(ww[c] & 0xffff); o[i * 8 + 2 * c + 1] = o[i * 8 + 2 * c + 1] * sc + p * bf2f(ww[c] >> 16); } }
    }
    float mall = m;
#pragma unroll
    for (int of = 1; of < 64; of <<= 1) mall = fmaxf(mall, __shfl_xor(mall, of));
    const float sc = (m == -INFINITY) ? 0.f : exp2f(m - mall);
    const float lt = wave_sum(l * sc); const float inv = 1.f / lt;
    float mine = 0.f;
#pragma unroll
    for (int d = 0; d < 64; ++d) { const float v = wave_sum(o[d] * sc); if (lane == d) mine = v; }
    O[rowq * AW + hh * 64 + lane] = (bf16)f2bf(mine * inv);
}
__device__ __forceinline__ void wave_argmax(float v, int idx, float& bv, int& bi) {
#pragma unroll
    for (int o = 1; o < 64; o <<= 1) { const float ov = __shfl_xor(v, o); const int oi = __shfl_xor(idx, o); if (ov > v || (ov == v && oi < idx)) { v = ov; idx = oi; } }
    bv = v; bi = idx;
}
__global__ void __launch_bounds__(64) k_peer(const bf16* qp, const bf16* skb, const float* sumsq, const bf16* ut, const bf16* vt, const float* fg, float* out) {
    __shared__ float qs[2048]; __shared__ float sc[256]; __shared__ float s1[16], s2[16]; __shared__ int i1[16], i2[16]; __shared__ int ex[128]; __shared__ float gt[128];
    const int lane = threadIdx.x, t = blockIdx.x;
    const float rstd2 = rsqrtf(sumsq[t] * (1.f / DMODEL) + RMS_EPS);
    for (int i = lane; i < 2048; i += 64) qs[i] = bf2f(qp[(size_t)t * 2048 + i]) * rstd2;
    __syncthreads();
    for (int hh = 0; hh < PH; ++hh) {
        for (int r = 0; r < 4; ++r) { const int idx = r * 64 + lane, p = idx >> 7, n = idx & 127; const bf16* kr = skb + ((size_t)(hh * 2 + p) * NKEY + n) * PHALF; const float* qq = qs + hh * 256 + p * 128;
            float a = 0.f; for (int c = 0; c < 128; ++c) a += qq[c] * bf2f(kr[c]); sc[idx] = a; }
        __syncthreads();
        for (int p = 0; p < 2; ++p) {
            float v0 = sc[p * 128 + lane], v1 = sc[p * 128 + 64 + lane];
            for (int k = 0; k < 16; ++k) { float v; int id; if (v0 >= v1) { v = v0; id = lane; } else { v = v1; id = lane + 64; }
                float bv; int bi; wave_argmax(v, id, bv, bi);
                if (lane == 0) { if (p == 0) { s1[k] = bv; i1[k] = bi; } else { s2[k] = bv; i2[k] = bi; } }
                if (bi == lane) v0 = -INFINITY; if (bi == lane + 64) v1 = -INFINITY; }
        }
        __syncthreads();
        float cv[4];
#pragma unroll
        for (int r = 0; r < 4; ++r) { const int idx = r * 64 + lane; cv[r] = s1[idx >> 4] + s2[idx & 15]; }
        float tops = 0.f; int topp = 0;
        for (int k = 0; k < 16; ++k) { float v = cv[0]; int id = lane;
#pragma unroll
            for (int r = 1; r < 4; ++r) if (cv[r] > v) { v = cv[r]; id = r * 64 + lane; }
            float bv; int bi; wave_argmax(v, id, bv, bi);
            if (lane == k) { tops = bv; topp = bi; }
#pragma unroll
            for (int r = 0; r < 4; ++r) if (bi == r * 64 + lane) cv[r] = -INFINITY; }
        float mx = lane < 16 ? tops : -INFINITY;
#pragma unroll
        for (int o = 1; o < 64; o <<= 1) mx = fmaxf(mx, __shfl_xor(mx, o));
        const float ev = lane < 16 ? expf(tops - mx) : 0.f; const float den = wave_sum(ev);
        if (lane < 16) { ex[hh * 16 + lane] = i1[topp >> 4] * NKEY + i2[topp & 15]; gt[hh * 16 + lane] = ev / den; }
        __syncthreads();
    }
    float hv[16], y[16];
    const float* x1 = out + (size_t)t * DMODEL;
#pragma unroll
    for (int j = 0; j < 4; ++j) { const float4 v = *(const float4*)(x1 + j * 256 + lane * 4); hv[4 * j] = v.x * rstd2; hv[4 * j + 1] = v.y * rstd2; hv[4 * j + 2] = v.z * rstd2; hv[4 * j + 3] = v.w * rstd2; }
#pragma unroll
    for (int i = 0; i < 16; ++i) y[i] = 0.f;
    for (int k = 0; k < 128; ++k) { const int e = ex[k]; const float g = gt[k]; float a = 0.f;
#pragma unroll
        for (int j = 0; j < 4; ++j) { const uint2 w = *(const uint2*)(ut + (size_t)e * DMODEL + j * 256 + lane * 4);
            a += hv[4 * j] * bf2f(w.x & 0xffff) + hv[4 * j + 1] * bf2f(w.x >> 16) + hv[4 * j + 2] * bf2f(w.y & 0xffff) + hv[4 * j + 3] * bf2f(w.y >> 16); }
        a = wave_sum(a); const float act = gelu_tanh(a) * g;
#pragma unroll
        for (int j = 0; j < 4; ++j) { const uint2 w = *(const uint2*)(vt + (size_t)e * DMODEL + j * 256 + lane * 4);
            y[4 * j] += act * bf2f(w.x & 0xffff); y[4 * j + 1] += act * bf2f(w.x >> 16); y[4 * j + 2] += act * bf2f(w.y & 0xffff); y[4 * j + 3] += act * bf2f(w.y >> 16); } }
    float ss = 0.f;
#pragma unroll
    for (int j = 0; j < 4; ++j) { const float4 v = *(const float4*)(x1 + j * 256 + lane * 4); y[4 * j] += v.x; y[4 * j + 1] += v.y; y[4 * j + 2] += v.z; y[4 * j + 3] += v.w; }
#pragma unroll
    for (int i = 0; i < 16; ++i) ss += y[i] * y[i];
    const float rs = rsqrtf(wave_sum(ss) * (1.f / DMODEL) + RMS_EPS);
#pragma unroll
    for (int j = 0; j < 4; ++j) { const float4 g = *(const float4*)(fg + j * 256 + lane * 4); float4 o; o.x = y[4 * j] * rs * g.x; o.y = y[4 * j + 1] * rs * g.y; o.z = y[4 * j + 2] * rs * g.z; o.w = y[4 * j + 3] * rs * g.w;
        *(float4*)(out + (size_t)t * DMODEL + j * 256 + lane * 4) = o; }
}
}

namespace pg8 {
#define PG8_LAS __attribute__((address_space(3)))
typedef unsigned short bf16_t;
typedef short bf16x8 __attribute__((ext_vector_type(8)));
typedef float f32x4 __attribute__((ext_vector_type(4)));
typedef unsigned u32x4 __attribute__((ext_vector_type(4)));
constexpr int BM = 256, BK = 64, HALF = 128, HTB = HALF * BK * 2  , STAGE_BYTES = 8 * HTB, NXCD = 8, WGM = 8;

__host__ __device__ __forceinline__ int lds_byte(int r, int c) { const int st = (r >> 4) * 2 + (c >> 5), rr = r & 15, cc = c & 31, ob = rr * 64 + cc * 2; return st * 1024 + (ob ^ (((ob >> 9) & 1) << 5)); }
__host__ __device__ __forceinline__ void stage_rc(int b, int& R, int& C) { const int st = b / 1024, sb = b % 1024, swz = sb ^ (((sb >> 9) & 1) << 5); R = (st >> 1) * 16 + swz / 64; C = (st & 1) * 32 + (swz % 64) / 2; }
__host__ __device__ __forceinline__ int perm32(int rho) { const int n = rho >> 4, i = rho & 15; return 8 * (i >> 2) + 4 * n + (i & 3); }

struct Unit { int pm, pn; };
struct Gemm { const bf16_t* A; const bf16_t* Bt; int M, N, K; };

struct StaticOrder {
    int nM, nN, nwg, G, c;
    __host__ __device__ void init(int M, int N, int G_, int c_) { nM = M / BM; nN = N / BM; nwg = nM * nN; G = G_; c = c_; }
    __host__ __device__ bool next(int i, Unit& u) const {
        const long L = (long)i * G + c; if (L >= nwg) return false;
        int wgid = (int)L; { const int q = nwg / NXCD, r = nwg % NXCD, xcd = wgid % NXCD, off = wgid / NXCD; wgid = (xcd < r ? xcd * (q + 1) : r * (q + 1) + (xcd - r) * q) + off; }
        const int nig = WGM * nN, gid = wgid / nig, fm = gid * WGM, gsz = (nM - fm) < WGM ? (nM - fm) : WGM;
        u.pm = fm + ((wgid % nig) % gsz); u.pn = (wgid % nig) / gsz; return true;
    }
    __device__ __forceinline__ void a_ready(const Unit&) const {}
    __device__ __forceinline__ void done(const Unit&) const {}
};

__device__ __forceinline__ unsigned cvt_pk_bf16(float lo, float hi) { unsigned r; asm volatile("v_cvt_pk_bf16_f32 %0, %1, %2" : "=v"(r) : "v"(lo), "v"(hi)); return r; }
typedef unsigned u32x2 __attribute__((ext_vector_type(2)));
__device__ __forceinline__ float gelu_fast(float x) {
    const float u2 = x * (1.5957691216057308f + 0.07135481627f * x * x);
    return x * __builtin_amdgcn_rcpf(1.f + __builtin_amdgcn_exp2f(-1.4426950408889634f * u2));
}
struct EpiG1 {
    static constexpr bool PERM = true, AFTER_DRAIN = false;
    bf16_t* base0; size_t split_stride; float qscale;
    __device__ __forceinline__ void operator()(const f32x4 (&acc)[2][2][4][2], const Unit& u, int wr, int wc, int fr, int fq) const {
        const int s = u.pn >> 1; bf16_t* base = base0 + (size_t)s * split_stride;
        const int row0 = u.pm * BM + wr * 64 + fr, col0 = (u.pn & 1) * 256 + wc * 32 + 8 * fq;
#pragma unroll
        for (int ai = 0; ai < 2; ++ai)
#pragma unroll
            for (int m = 0; m < 4; ++m) { bf16_t* rowp = base + (size_t)(row0 + ai * HALF + m * 16) * 512 + col0;
#pragma unroll
                for (int bj = 0; bj < 2; ++bj) { f32x4 v0 = acc[ai][bj][m][0], v1 = acc[ai][bj][m][1];
                    if (s == 1) {
#pragma unroll
                        for (int e = 0; e < 4; ++e) { v0[e] = gelu_fast(v0[e]); v1[e] = gelu_fast(v1[e]); } }
                    else if (s == 2) { v0 = v0 * qscale; v1 = v1 * qscale; }
                    u32x4 w; w.x = cvt_pk_bf16(v0[0], v0[1]); w.y = cvt_pk_bf16(v0[2], v0[3]); w.z = cvt_pk_bf16(v1[0], v1[1]); w.w = cvt_pk_bf16(v1[2], v1[3]);
                    *(u32x4*)(rowp + bj * HALF) = w; } }
    }
};
struct EpiG2 {
    static constexpr bool PERM = false, AFTER_DRAIN = false;
    const float* resid; float* out; bf16_t* xb; float* sumsq; int ldc;
    __device__ __forceinline__ void operator()(const f32x4 (&acc)[2][2][4][2], const Unit& u, int wr, int wc, int fr, int fq) const {
        const int row0 = u.pm * BM + wr * 64 + fr, col0 = u.pn * BM + wc * 32 + 4 * fq;
#pragma unroll
        for (int ai = 0; ai < 2; ++ai)
#pragma unroll
            for (int m = 0; m < 4; ++m) { const int r = row0 + ai * HALF + m * 16; const size_t off = (size_t)r * ldc + col0; float ss = 0.f;
#pragma unroll
                for (int bj = 0; bj < 2; ++bj)
#pragma unroll
                    for (int n = 0; n < 2; ++n) { const f32x4 x = *(const f32x4*)(resid + off + bj * HALF + n * 16) + acc[ai][bj][m][n];
                        *(f32x4*)(out + off + bj * HALF + n * 16) = x; ss += (x[0] * x[0] + x[1] * x[1]) + (x[2] * x[2] + x[3] * x[3]);
                        u32x2 w; w.x = cvt_pk_bf16(x[0], x[1]); w.y = cvt_pk_bf16(x[2], x[3]); *(u32x2*)(xb + off + bj * HALF + n * 16) = w; }
                ss += __shfl_xor(ss, 16); ss += __shfl_xor(ss, 32);
                if (fq == 0) atomicAdd(sumsq + r, ss);
                asm volatile("" ::: "memory"); }
    }
};
struct EpiG3 {
    static constexpr bool PERM = true, AFTER_DRAIN = false;
    bf16_t* O; int ldc;
    __device__ __forceinline__ void operator()(const f32x4 (&acc)[2][2][4][2], const Unit& u, int wr, int wc, int fr, int fq) const {
        const int row0 = u.pm * BM + wr * 64 + fr, col0 = u.pn * BM + wc * 32 + 8 * fq;
#pragma unroll
        for (int ai = 0; ai < 2; ++ai)
#pragma unroll
            for (int m = 0; m < 4; ++m) { bf16_t* rowp = O + (size_t)(row0 + ai * HALF + m * 16) * ldc + col0;
#pragma unroll
                for (int bj = 0; bj < 2; ++bj) { const f32x4 v0 = acc[ai][bj][m][0], v1 = acc[ai][bj][m][1];
                    u32x4 w; w.x = cvt_pk_bf16(v0[0], v0[1]); w.y = cvt_pk_bf16(v0[2], v0[3]); w.z = cvt_pk_bf16(v1[0], v1[1]); w.w = cvt_pk_bf16(v1[2], v1[3]);
                    *(u32x4*)(rowp + bj * HALF) = w; } }
    }
};

template <class Epi, class Sched, bool ALIGN_EPI = false, bool SP2 = false>
__device__ __forceinline__ void gemm_phase(PG8_LAS unsigned char* lds, const Gemm g, const Sched& S, const Epi& E, int wid_in) {
    const int wid = __builtin_amdgcn_readfirstlane(wid_in), lane = (int)__builtin_amdgcn_mbcnt_hi(~0u, __builtin_amdgcn_mbcnt_lo(~0u, 0u)), tid = wid * 64 + lane, wr = wid >> 2, wc = wid & 3, fr = lane & 15, fq = lane >> 4;
    const int K = g.K, nt = K / BK;
    unsigned voffA[2], voffB[2];
#pragma unroll
    for (int i = 0; i < 2; ++i) { int R, C; stage_rc(tid * 16 + i * 8192, R, C); const int Rb = Epi::PERM ? ((R & ~31) + perm32(R & 31)) : R;
        voffA[i] = (unsigned)(R * K + C) * 2u; voffB[i] = (unsigned)(Rb * K + C) * 2u; }
    const size_t kstep = (size_t)(BK * 2);
    const size_t hstep = (size_t)HALF * K * 2;
    const size_t tstep = 2 * hstep;
    const unsigned ldsw = (unsigned)wid * 1024u;
    const int aoff = lds_byte(wr * 64 + fr, fq * 8), boff = lds_byte(wc * 32 + fr, fq * 8);
#define PG8_SA(b, h) (((b) * 2 + (h)) * HTB)
#define PG8_SB(b, h) ((4 + (b) * 2 + (h)) * HTB)
#define PG8_STAGE(bufoff, gbase, voff) do { _Pragma("unroll") for (int _i = 0; _i < 2; ++_i) \
        __builtin_amdgcn_global_load_lds((const unsigned*)((const char*)(gbase) + (voff)[_i]), (PG8_LAS unsigned*)(lds + (bufoff) + ldsw + _i * 8192), 16, 0, 0); } while (0)
#define PG8_LDA(dst, b, h) do { _Pragma("unroll") for (int m = 0; m < 4; ++m) _Pragma("unroll") for (int k = 0; k < 2; ++k) dst[m][k] = *(const PG8_LAS bf16x8*)(lds + PG8_SA(b, h) + aoff + m * 2048 + k * 1024); } while (0)
#define PG8_LDB(dst, b, h) do { _Pragma("unroll") for (int n = 0; n < 2; ++n) _Pragma("unroll") for (int k = 0; k < 2; ++k) dst[n][k] = *(const PG8_LAS bf16x8*)(lds + PG8_SB(b, h) + boff + n * 2048 + k * 1024); } while (0)
#define PG8_MMA(ai, bj, At, Bt) do { __builtin_amdgcn_s_setprio(1); _Pragma("unroll") for (int m = 0; m < 4; ++m) _Pragma("unroll") for (int n = 0; n < 2; ++n) _Pragma("unroll") for (int k = 0; k < 2; ++k) \
        acc[ai][bj][m][n] = __builtin_amdgcn_mfma_f32_16x16x32_bf16(Bt[n][k], At[m][k], acc[ai][bj][m][n], 0, 0, 0); __builtin_amdgcn_s_setprio(0); } while (0)
#define PG8_WAIT_V(n) asm volatile("s_waitcnt vmcnt(" #n ")" ::: "memory")
#define PG8_WAIT_L(n) asm volatile("s_waitcnt lgkmcnt(" #n ")" ::: "memory")
#define PG8_BAR __builtin_amdgcn_s_barrier()
#define PG8_SCHED __builtin_amdgcn_sched_barrier(0)
    Unit cur, nxt; int ui = 0;
    if (!S.next(0, cur)) return;
    f32x4 acc[2][2][4][2];
#pragma unroll
    for (int a = 0; a < 2; ++a)
#pragma unroll
        for (int b = 0; b < 2; ++b)
#pragma unroll
            for (int m = 0; m < 4; ++m)
#pragma unroll
                for (int n = 0; n < 2; ++n) acc[a][b][m][n] = (f32x4){0.f, 0.f, 0.f, 0.f};
    bf16x8 At[4][2], B0[2][2], B1[2][2];
    const char* cA = (const char*)g.A + (size_t)cur.pm * tstep; const char* cB = (const char*)g.Bt + (size_t)cur.pn * tstep;
    S.a_ready(cur);
    if constexpr (SP2) {
        PG8_STAGE(PG8_SB(0, 0), cB, voffB); PG8_STAGE(PG8_SB(0, 1), cB + hstep, voffB); PG8_STAGE(PG8_SA(0, 0), cA, voffA); PG8_STAGE(PG8_SA(0, 1), cA + hstep, voffA);
        if (wr == 1) PG8_BAR;
        PG8_WAIT_V(2); PG8_BAR;
        PG8_STAGE(PG8_SB(1, 0), cB + kstep, voffB); PG8_STAGE(PG8_SA(1, 0), cA + kstep, voffA); PG8_STAGE(PG8_SB(1, 1), cB + hstep + kstep, voffB);
        PG8_WAIT_V(6); PG8_BAR;
    } else {
        PG8_STAGE(PG8_SB(0, 0), cB, voffB); PG8_STAGE(PG8_SA(0, 0), cA, voffA); PG8_STAGE(PG8_SB(0, 1), cB + hstep, voffB); PG8_STAGE(PG8_SA(0, 1), cA + hstep, voffA);
        if (wr == 1) PG8_BAR;
        PG8_WAIT_V(4); PG8_BAR;
        PG8_STAGE(PG8_SB(1, 0), cB + kstep, voffB); PG8_STAGE(PG8_SA(1, 0), cA + kstep, voffA); PG8_STAGE(PG8_SB(1, 1), cB + hstep + kstep, voffB);
        PG8_WAIT_V(6); PG8_BAR;
    }
    for (;;) {
        const bool has_next = S.next(ui + 1, nxt);
        const char* nA = has_next ? (const char*)g.A + (size_t)nxt.pm * tstep : cA; const char* nB = has_next ? (const char*)g.Bt + (size_t)nxt.pn * tstep : cB;
        for (int t = 0; t < nt; t += 2) {
            const bool last = (t == nt - 2);
            const char* a1 = cA + (size_t)(t + 1) * kstep;
            const char* a2 = last ? nA : cA + (size_t)(t + 2) * kstep; const char* b2 = last ? nB : cB + (size_t)(t + 2) * kstep;
            const char* a3 = a2 + kstep; const char* b3 = b2 + kstep;
            if (last && has_next) S.a_ready(nxt);
            if constexpr (SP2) {
            PG8_LDB(B0, 0, 0); PG8_LDB(B1, 0, 1); PG8_SCHED; PG8_LDA(At, 0, 0); PG8_STAGE(PG8_SA(1, 1), a1 + hstep, voffA);
            PG8_WAIT_V(8); PG8_WAIT_L(0); PG8_BAR; PG8_MMA(0, 0, At, B0); PG8_MMA(0, 1, At, B1); PG8_BAR; PG8_SCHED;
            PG8_LDA(At, 0, 1); PG8_STAGE(PG8_SB(0, 0), b2, voffB); PG8_STAGE(PG8_SB(0, 1), b2 + hstep, voffB); PG8_STAGE(PG8_SA(0, 0), a2, voffA);
            PG8_WAIT_V(8); PG8_WAIT_L(0); PG8_BAR; PG8_MMA(1, 0, At, B0); PG8_MMA(1, 1, At, B1); PG8_BAR; PG8_SCHED;
            PG8_LDB(B0, 1, 0); PG8_LDB(B1, 1, 1); PG8_SCHED; PG8_LDA(At, 1, 0); PG8_STAGE(PG8_SA(0, 1), a2 + hstep, voffA);
            PG8_WAIT_V(8); PG8_WAIT_L(0); PG8_BAR; PG8_MMA(0, 0, At, B0); PG8_MMA(0, 1, At, B1); PG8_BAR; PG8_SCHED;
            PG8_LDA(At, 1, 1); PG8_STAGE(PG8_SB(1, 0), b3, voffB); PG8_STAGE(PG8_SB(1, 1), b3 + hstep, voffB); PG8_STAGE(PG8_SA(1, 0), a3, voffA);
            PG8_WAIT_V(8); PG8_WAIT_L(0); PG8_BAR; PG8_MMA(1, 0, At, B0); PG8_MMA(1, 1, At, B1); PG8_BAR; PG8_SCHED;
            } else {
            PG8_LDB(B0, 0, 0); PG8_SCHED; PG8_LDA(At, 0, 0); PG8_STAGE(PG8_SA(1, 1), a1 + hstep, voffA);
            PG8_WAIT_L(8); PG8_BAR; PG8_WAIT_L(0); PG8_MMA(0, 0, At, B0); PG8_BAR; PG8_SCHED;
            PG8_LDB(B1, 0, 1); PG8_STAGE(PG8_SB(0, 0), b2, voffB);
            PG8_BAR; PG8_WAIT_L(0); PG8_MMA(0, 1, At, B1); PG8_BAR;
            PG8_LDA(At, 0, 1); PG8_STAGE(PG8_SA(0, 0), a2, voffA);
            PG8_BAR; PG8_WAIT_L(0); PG8_MMA(1, 0, At, B0); PG8_BAR; PG8_SCHED;
            PG8_STAGE(PG8_SB(0, 1), b2 + hstep, voffB);
            PG8_WAIT_V(6); PG8_BAR; PG8_MMA(1, 1, At, B1); PG8_BAR;
            PG8_LDB(B0, 1, 0); PG8_SCHED; PG8_LDA(At, 1, 0); PG8_STAGE(PG8_SA(0, 1), a2 + hstep, voffA);
            PG8_WAIT_L(8); PG8_BAR; PG8_WAIT_L(0); PG8_MMA(0, 0, At, B0); PG8_BAR; PG8_SCHED;
            PG8_LDB(B1, 1, 1); PG8_STAGE(PG8_SB(1, 0), b3, voffB);
            PG8_BAR; PG8_WAIT_L(0); PG8_MMA(0, 1, At, B1); PG8_BAR;
            PG8_LDA(At, 1, 1); PG8_STAGE(PG8_SA(1, 0), a3, voffA);
            PG8_BAR; PG8_WAIT_L(0); PG8_MMA(1, 0, At, B0); PG8_BAR; PG8_SCHED;
            PG8_STAGE(PG8_SB(1, 1), b3 + hstep, voffB);
            PG8_WAIT_V(6); PG8_BAR; PG8_MMA(1, 1, At, B1); PG8_BAR;
            }
        }
        if constexpr (ALIGN_EPI) { if (wr == 0) PG8_BAR; }
        if constexpr (!Epi::AFTER_DRAIN) { E(acc, cur, wr, wc, fr, fq); S.done(cur); }
        if (!has_next) break;
#pragma unroll
        for (int a = 0; a < 2; ++a)
#pragma unroll
            for (int b = 0; b < 2; ++b)
#pragma unroll
                for (int m = 0; m < 4; ++m)
#pragma unroll
                    for (int n = 0; n < 2; ++n) acc[a][b][m][n] = (f32x4){0.f, 0.f, 0.f, 0.f};
        cur = nxt; cA = nA; cB = nB; ++ui;
        if constexpr (ALIGN_EPI) { if (wr == 1) PG8_BAR; }
    }
    PG8_WAIT_V(0);
    if constexpr (!ALIGN_EPI) { if (wr == 0) PG8_BAR; }
    PG8_BAR;
    if constexpr (Epi::AFTER_DRAIN) { E.fused(acc, cur, wr, wc, fr, fq, lds, wid, lane); S.done(cur); }
#undef PG8_SA
#undef PG8_SB
#undef PG8_STAGE
#undef PG8_LDA
#undef PG8_LDB
#undef PG8_MMA
#undef PG8_WAIT_V
#undef PG8_WAIT_L
#undef PG8_BAR
#undef PG8_SCHED
}
}
#include <hip/hip_bf16.h>
#include <cmath>
namespace attn_body {
using bf16=__hip_bfloat16;
using bf16x8=__attribute__((ext_vector_type(8)))short;
using s16x4=__attribute__((ext_vector_type(4)))short;
using f32x16=__attribute__((ext_vector_type(16)))float;
using u32x4=__attribute__((ext_vector_type(4)))unsigned;
constexpr int BATCH=4,NHEAD=8,SEQ=8192,D=64,DM=NHEAD*D;
constexpr int NW=8,QBLK=32,QB=QBLK*NW,KVBLK=64,NQB=SEQ/QB;
constexpr int ATTN_PITCH=DM, ATTN_UNIT_ROWS=QB;
__device__ __forceinline__ int crow(int r,int hi){return (r&3)+8*(r>>2)+4*hi;}
#define SBAR() __builtin_amdgcn_sched_barrier(0)
__device__ __forceinline__ void cmask(f32x16&p0,f32x16&p1,int jb,int qrel,int hi){
  const float NEG=-INFINITY; int kb=64*jb+4*hi;
  #pragma unroll
  for(int r=0;r<16;++r){int kv=kb+(r&3)+8*(r>>2); if(kv>qrel)p0[r]=NEG; if(kv+32>qrel)p1[r]=NEG;}
}

constexpr int NSLOT=3, SLOTB=8192;
constexpr int LDS_K=0, LDS_V=NSLOT*SLOTB, LDS_WS=2*NSLOT*SLOTB, LDS_OST=LDS_WS+NW*64*4, LDS_FK=LDS_OST+NW*4096, LDS_BYTES=LDS_FK+SEQ*4;
constexpr float C2=0.125f*1.4426950408889634f;
__device__ __forceinline__ void glds16(const void*gsrc,unsigned lds_dst){unsigned keep;
  asm volatile("s_mov_b32 %0, m0\n\ts_mov_b32 m0, %2\n\ts_nop 0\n\tglobal_load_lds_dwordx4 %1, off\n\ts_mov_b32 m0, %0":"=&s"(keep):"v"(gsrc),"s"(lds_dst):"memory");}
__device__ __forceinline__ float max3f(float a,float b,float c){float r;asm("v_max3_f32 %0, %1, %2, %3":"=v"(r):"v"(a),"v"(b),"v"(c));return r;}
__device__ __forceinline__ float max2f(float a,float b){float r;asm("v_max_f32_e32 %0, %1, %2":"=v"(r):"v"(a),"v"(b));return r;}
__device__ __forceinline__ float fadd_s(float a,float b){float r;asm("v_add_f32_e32 %0, %1, %2":"=v"(r):"v"(a),"v"(b));return r;}
__device__ __forceinline__ float fsub_s(float a,float b){float r;asm("v_sub_f32_e32 %0, %1, %2":"=v"(r):"v"(a),"v"(b));return r;}
typedef float f32x2_t __attribute__((ext_vector_type(2))); typedef __bf16 bf16x2_t __attribute__((ext_vector_type(2)));
__device__ __forceinline__ unsigned cvtpk_s(float lo,float hi){f32x2_t v={lo,hi};bf16x2_t b=__builtin_convertvector(v,bf16x2_t);return __builtin_bit_cast(unsigned,b);}
#define WAIT_BAR(N) asm volatile("s_waitcnt vmcnt(" #N ") lgkmcnt(0)\n\ts_barrier":::"memory")

__device__ __forceinline__ void qkt(f32x16&p0,f32x16&p1,const char*Kslot,const bf16x8*qr,int r32,int hi){
  const char*kb=Kslot+hi*1024+r32*16;
  #pragma unroll
  for(int d0=0;d0<4;++d0){
    const bf16x8 b0=*reinterpret_cast<const bf16x8*>(kb+d0*2048);
    const bf16x8 b1=*reinterpret_cast<const bf16x8*>(kb+d0*2048+512);
    p0=__builtin_amdgcn_mfma_f32_32x32x16_bf16(b0,qr[d0],p0,0,0,0);p1=__builtin_amdgcn_mfma_f32_32x32x16_bf16(b1,qr[d0],p1,0,0,0);}
}
typedef __attribute__((address_space(3))) const char* lds_cptr;
typedef short v4i16_t __attribute__((ext_vector_type(4)));
__device__ __forceinline__ void kload8(bf16x8*kf,lds_cptr kp){
  kf[0]=*(const __attribute__((address_space(3))) bf16x8*)(kp);      kf[1]=*(const __attribute__((address_space(3))) bf16x8*)(kp+512);
  kf[2]=*(const __attribute__((address_space(3))) bf16x8*)(kp+2048); kf[3]=*(const __attribute__((address_space(3))) bf16x8*)(kp+2560);
  kf[4]=*(const __attribute__((address_space(3))) bf16x8*)(kp+4096); kf[5]=*(const __attribute__((address_space(3))) bf16x8*)(kp+4608);
  kf[6]=*(const __attribute__((address_space(3))) bf16x8*)(kp+6144); kf[7]=*(const __attribute__((address_space(3))) bf16x8*)(kp+6656);
}
__device__ __forceinline__ void kload2(bf16x8*kf,lds_cptr kp,int j){ kf[2*j]=*(const __attribute__((address_space(3))) bf16x8*)(kp+j*2048); kf[2*j+1]=*(const __attribute__((address_space(3))) bf16x8*)(kp+j*2048+512); }
__device__ __forceinline__ s16x4 vtr(lds_cptr p){ return __builtin_bit_cast(s16x4,__builtin_amdgcn_ds_read_tr16_b64_v4i16((__attribute__((address_space(3))) v4i16_t*)p)); }
__device__ __forceinline__ float rowmax(const f32x16&p0,const f32x16&p1){
  float a=max3f(p0[0],p0[1],p1[0]),b=max3f(p0[2],p0[3],p1[1]);a=max3f(a,p1[2],p1[3]);
  #pragma unroll
  for(int r=4;r<16;r+=4){a=max3f(a,p0[r],p0[r+1]);b=max3f(b,p0[r+2],p0[r+3]);a=max3f(a,p1[r],p1[r+1]);b=max3f(b,p1[r+2],p1[r+3]);}
  const float m=max2f(a,b);
  auto rr=__builtin_amdgcn_permlane32_swap(__float_as_uint(m),__float_as_uint(m),false,false);
  return max2f(__uint_as_float(rr[0]),__uint_as_float(rr[1]));
}
__device__ __forceinline__ void pv(f32x16*o,int vb,bf16x8 pa0,bf16x8 pa1,bf16x8 pa2,bf16x8 pa3){
  #pragma unroll
  for(int d0=0;d0<2;++d0){s16x4 lo[4],hi[4];
    #pragma unroll
    for(int ks=0;ks<4;++ks){
      asm volatile("ds_read_b64_tr_b16 %0,%1 offset:%c2":"=&v"(lo[ks]):"v"(vb),"i"(d0*4096+ks*1024):"memory");
      asm volatile("ds_read_b64_tr_b16 %0,%1 offset:%c2":"=&v"(hi[ks]):"v"(vb),"i"(d0*4096+ks*1024+512):"memory");}
    asm volatile("s_waitcnt lgkmcnt(0)":::"memory");SBAR();
    #define PK(k) (bf16x8){lo[k][0],lo[k][1],lo[k][2],lo[k][3],hi[k][0],hi[k][1],hi[k][2],hi[k][3]}
    o[d0]=__builtin_amdgcn_mfma_f32_32x32x16_bf16(pa0,PK(0),o[d0],0,0,0);
    o[d0]=__builtin_amdgcn_mfma_f32_32x32x16_bf16(pa1,PK(1),o[d0],0,0,0);
    o[d0]=__builtin_amdgcn_mfma_f32_32x32x16_bf16(pa2,PK(2),o[d0],0,0,0);
    o[d0]=__builtin_amdgcn_mfma_f32_32x32x16_bf16(pa3,PK(3),o[d0],0,0,0);
    #undef PK
  }
}

#ifndef ATTN_STORE16
#define ATTN_STORE16(p,v) (*(u32x4*)(p)=(v))
#endif
template<int THRL> __device__ __forceinline__ void attn_unit(int b,int h,int qb,const bf16*Q,const bf16*__restrict__ K,const bf16*__restrict__ V,bf16*O,const float*__restrict__ Fc,char*shm,int wid_in){
  const int wid=__builtin_amdgcn_readfirstlane(wid_in); int lane_=(int)__builtin_amdgcn_mbcnt_hi(~0u,__builtin_amdgcn_mbcnt_lo(~0u,0u)); asm volatile("":"+v"(lane_));
  const int lane=lane_,tid=wid*64+lane,r32=lane&31,hi=lane>>5;
  const long rowbase=(long)b*SEQ; const int q0=qb*QB;
  const float*Fbh=Fc+(long)(b*NHEAD+h)*SEQ;
  { typedef float f32x4_t __attribute__((ext_vector_type(4))); __attribute__((address_space(3))) float*fk=(__attribute__((address_space(3))) float*)((__attribute__((address_space(3))) char*)shm+LDS_FK); const int n4=(q0+QB)/4;
    for(int i=tid;i<n4;i+=NW*64){ f32x4_t v=*(const f32x4_t*)(Fbh+4*i); v=v*(-1.4426950408889634f); *(__attribute__((address_space(3))) f32x4_t*)(fk+4*i)=v; } }
  float fq2=Fbh[q0+wid*QBLK+r32]*1.4426950408889634f; asm volatile("":"+v"(fq2));
  const bf16*Qw=Q+(rowbase+q0+wid*QBLK)*DM+h*D;
  const bf16*Kh=K+rowbase*DM+h*D,*Vh=V+rowbase*DM+h*D;
  const lds_cptr shm3=(lds_cptr)shm;
  const unsigned lds0=(unsigned)(uintptr_t)shm;
  float*wsf=(float*)(shm+LDS_WS)+wid*64;
  const bf16*ksrc=Kh+(long)lane*DM+wid*8;
  const bf16*vsrc=Vh+(long)(16*(wid&3)+(lane>>2))*DM+(wid>>2)*32+(lane&3)*8;
  const unsigned kdst=lds0+LDS_K+wid*1024, vdst=lds0+LDS_V+wid*1024;
  #define DMA_K(t,slot) glds16(ksrc+(long)(t)*KVBLK*DM,(unsigned)__builtin_amdgcn_readfirstlane(kdst+(slot)))
  #define DMA_V(t,slot) glds16(vsrc+(long)(t)*KVBLK*DM,(unsigned)__builtin_amdgcn_readfirstlane(vdst+(slot)))
  const int vb0=(int)(lds0+LDS_V)+((lane>>4)&1)*32+(lane&3)*8+(4*hi+((lane&15)>>2))*64;
  const char*Kbase=shm+LDS_K; bf16x8 kf[8];
  const lds_cptr kp0=shm3+LDS_K+hi*1024+r32*16; const lds_cptr vp0=shm3+LDS_V+((lane>>4)&1)*32+(lane&3)*8+(4*hi+((lane&15)>>2))*64;
  const int NT=(q0+QB)/KVBLK;
  DMA_K(0,0);DMA_V(0,0);DMA_K(1,SLOTB);
  bf16x8 qr[4];
  #pragma unroll
  for(int d0=0;d0<4;++d0)qr[d0]=*reinterpret_cast<const bf16x8*>(&Qw[(long)r32*DM+d0*16+hi*8]);
  float mhat=0.f,l_reg=0.f;f32x16 o[2];o[0]=f32x16{};o[1]=f32x16{};
  const __attribute__((address_space(3))) float*fkl=(const __attribute__((address_space(3))) float*)(shm3+LDS_FK)+4*hi;
  #define INITC(C0,C1,t) do{ const float nsc_=fq2-mhat; typedef float f32x4_t __attribute__((ext_vector_type(4))); const __attribute__((address_space(3))) float*kb_=fkl+64*(t); \
    _Pragma("unroll") for(int g_=0;g_<4;++g_){ const f32x4_t a_=*(const __attribute__((address_space(3))) f32x4_t*)(kb_+8*g_), b_=*(const __attribute__((address_space(3))) f32x4_t*)(kb_+32+8*g_); \
      _Pragma("unroll") for(int e_=0;e_<4;++e_){ C0[4*g_+e_]=nsc_+a_[e_]; C1[4*g_+e_]=nsc_+b_[e_]; } } }while(0)
  const int qrel=wid*QBLK+r32;
  #define CMASK(P0,P1,t) do{int jb_=(t)-(NT-4); if(jb_>=0)cmask(P0,P1,jb_,qrel,hi);}while(0)
  bool resc=false;
  #define START(P0,P1) do{ const float rm=rowmax(P0,P1); resc=false; \
    { const float dl=rm; mhat=fadd_s(mhat,dl); \
      _Pragma("unroll") for(int r=0;r<16;++r){P0[r]=fsub_s(P0[r],dl);P1[r]=fsub_s(P1[r],dl);} \
      } \
    _Pragma("unroll") for(int r=0;r<16;++r)P0[r]=__builtin_amdgcn_exp2f(P0[r]); }while(0)
  #define RESC() do{ if(resc){ asm volatile("s_waitcnt lgkmcnt(0)":::"memory"); \
      _Pragma("unroll") for(int d_=0;d_<2;++d_) _Pragma("unroll") for(int r=0;r<16;++r)o[d_][r]*=wsf[crow(r,hi)]; } }while(0)
  f32x16 pA0,pA1,pB0,pB1;
  int sl_prev=0,sl_cur=0,sl_next=SLOTB;
  #define ROT() do{sl_prev=sl_cur;sl_cur=sl_next;sl_next=(sl_next==(NSLOT-1)*SLOTB)?0:sl_next+SLOTB;}while(0)
  DMA_K(2,2*SLOTB);
  WAIT_BAR(3);
  INITC(pA0,pA1,0); qkt(pA0,pA1,Kbase,qr,r32,hi);asm volatile("s_nop 15\n\ts_nop 7":"+v"(pA0),"+v"(pA1));CMASK(pA0,pA1,0);
  START(pA0,pA1);
  _Pragma("unroll") for(int r=0;r<16;++r)pA1[r]=__builtin_amdgcn_exp2f(pA1[r]);
  WAIT_BAR(0);
  DMA_K(3,0);DMA_V(1,SLOTB);
  ROT();
  kload8(kf,kp0+sl_cur);
  WAIT_BAR(2);
  s16x4 vlo[8],vhi[8]; u32x4 pw0,pw1,pw2,pw3;
  #define PKW(P,B) cvtpk_s(P[B],P[B+1])
  #define PAF(k) __builtin_bit_cast(bf16x8,pw##k)
  #define VFR(i) (bf16x8){vlo[i][0],vlo[i][1],vlo[i][2],vlo[i][3],vhi[i][0],vhi[i][1],vhi[i][2],vhi[i][3]}
  #define PIN(x) asm volatile("":"+v"(x))
  #define MX3(a,b,c) __builtin_fmaxf(__builtin_fmaxf((a),(b)),(c))
  #define GAPA(MF,A0,A1,A2,A3,W0,W1,PW) do{ MF; sacc+=A0; sacc+=A1; sacc+=A2; sacc+=A3; PIN(sacc); W0; W1; PIN(PW); SBAR(); }while(0)
  #define EX(v) __builtin_amdgcn_exp2f(v)
  #define GAPB(MF,X,B) do{ MF; X[B]=EX(X[B]); X[B+1]=EX(X[B+1]); X[B+2]=EX(X[B+2]); X[B+3]=EX(X[B+3]); PIN(X); SBAR(); }while(0)
  #define VRD(i) do{ vlo[i]=vtr(vp_+(((i)>>2)*4096+((i)&3)*1024)); vhi[i]=vtr(vp_+(((i)>>2)*4096+((i)&3)*1024+512)); }while(0)
  #define KRD(G,j) do{ if(G){ kload2(kf,kp0+sl_next,j); SBAR(); } }while(0)
  #define STEP(C0,C1,P0,P1,t,GK,GV,GL) do{ SBAR(); INITC(C0,C1,t); PIN(C0); PIN(C1); SBAR(); \
    const lds_cptr vp_=vp0+sl_prev; \
    VRD(0); SBAR(); float sacc=(P0[0]+P0[1]); \
    GAPA(C0=__builtin_amdgcn_mfma_f32_32x32x16_bf16(kf[0],qr[0],C0,0,0,0), P0[2],P0[3],P0[4],P0[5],     pw0[0]=PKW(P0,0), pw0[1]=PKW(P0,2), pw0); \
    VRD(4); SBAR(); GAPA(C1=__builtin_amdgcn_mfma_f32_32x32x16_bf16(kf[1],qr[0],C1,0,0,0), P0[6],P0[7],P0[8],P0[9],     pw0[2]=PKW(P0,4), pw0[3]=PKW(P0,6), pw0); \
    VRD(1); SBAR(); GAPA(C0=__builtin_amdgcn_mfma_f32_32x32x16_bf16(kf[2],qr[1],C0,0,0,0),   P0[10],P0[11],P0[12],P0[13], pw1[0]=PKW(P0,8), pw1[1]=PKW(P0,10), pw1); \
    VRD(5); SBAR(); GAPA(C1=__builtin_amdgcn_mfma_f32_32x32x16_bf16(kf[3],qr[1],C1,0,0,0),   P0[14],P0[15],P1[0],P1[1],   pw1[2]=PKW(P0,12),pw1[3]=PKW(P0,14), pw1); \
    VRD(2); SBAR(); GAPA(C0=__builtin_amdgcn_mfma_f32_32x32x16_bf16(kf[4],qr[2],C0,0,0,0),   P1[2],P1[3],P1[4],P1[5],     pw2[0]=PKW(P1,0), pw2[1]=PKW(P1,2), pw2); \
    VRD(6); SBAR(); GAPA(C1=__builtin_amdgcn_mfma_f32_32x32x16_bf16(kf[5],qr[2],C1,0,0,0),   P1[6],P1[7],P1[8],P1[9],     pw2[2]=PKW(P1,4), pw2[3]=PKW(P1,6), pw2); \
    VRD(3); SBAR(); GAPA(C0=__builtin_amdgcn_mfma_f32_32x32x16_bf16(kf[6],qr[3],C0,0,0,0),   P1[10],P1[11],P1[12],P1[13], pw3[0]=PKW(P1,8), pw3[1]=PKW(P1,10), pw3); \
    VRD(7); SBAR(); GAPA(C1=__builtin_amdgcn_mfma_f32_32x32x16_bf16(kf[7],qr[3],C1,0,0,0),   P1[14],P1[15],0.f,0.f,       pw3[2]=PKW(P1,12),pw3[3]=PKW(P1,14), pw3); \
    l_reg+=sacc; \
    if(GK){DMA_K((t)+3,sl_cur);} if(GV){DMA_V((t)+1,sl_next);} \
    CMASK(C0,C1,t); \
    { float a=MX3(C0[0],C0[1],C1[0]),b=MX3(C0[2],C0[3],C1[1]); a=MX3(a,C1[2],C1[3]); \
      _Pragma("unroll") for(int r=4;r<16;r+=4){a=MX3(a,C0[r],C0[r+1]);b=MX3(b,C0[r+2],C0[r+3]);a=MX3(a,C1[r],C1[r+1]);b=MX3(b,C1[r+2],C1[r+3]);} \
      float rm=__builtin_fmaxf(a,b); { auto rr=__builtin_amdgcn_permlane32_swap(__float_as_uint(rm),__float_as_uint(rm),false,false); rm=__builtin_fmaxf(__uint_as_float(rr[0]),__uint_as_float(rr[1])); } \
      resc=false; \
      if(__builtin_expect(__any(rm>(float)THRL),0)){ const float dl=__builtin_fmaxf(rm,0.f); mhat+=dl; \
        _Pragma("unroll") for(int r=0;r<16;++r){C0[r]-=dl;C1[r]-=dl;} \
        const float f=__builtin_amdgcn_exp2f(-dl); l_reg*=f; if(hi==0)wsf[r32]=f; resc=true; } } \
    SBAR(); \
    GAPB(o[0]=__builtin_amdgcn_mfma_f32_32x32x16_bf16(PAF(0),VFR(0),o[0],0,0,0), C0,0); \
    GAPB(o[1]=__builtin_amdgcn_mfma_f32_32x32x16_bf16(PAF(0),VFR(4),o[1],0,0,0), C0,4); \
    KRD(GL,0); GAPB(o[0]=__builtin_amdgcn_mfma_f32_32x32x16_bf16(PAF(1),VFR(1),o[0],0,0,0), C0,8); \
    KRD(GL,1); GAPB(o[1]=__builtin_amdgcn_mfma_f32_32x32x16_bf16(PAF(1),VFR(5),o[1],0,0,0), C0,12); \
    KRD(GL,2); GAPB(o[0]=__builtin_amdgcn_mfma_f32_32x32x16_bf16(PAF(2),VFR(2),o[0],0,0,0), C1,0); \
    KRD(GL,3); GAPB(o[1]=__builtin_amdgcn_mfma_f32_32x32x16_bf16(PAF(2),VFR(6),o[1],0,0,0), C1,4); \
    GAPB(o[0]=__builtin_amdgcn_mfma_f32_32x32x16_bf16(PAF(3),VFR(3),o[0],0,0,0), C1,8); \
    GAPB(o[1]=__builtin_amdgcn_mfma_f32_32x32x16_bf16(PAF(3),VFR(7),o[1],0,0,0), C1,12); \
    }while(0)
  int t=1;
  #undef CMASK
  #define CMASK(P0,P1,t) do{}while(0)
  for(;t+5<NT;t+=2){
    STEP(pB0,pB1,pA0,pA1,t,true,true,true);     WAIT_BAR(2); RESC(); ROT();
    STEP(pA0,pA1,pB0,pB1,t+1,true,true,true);   WAIT_BAR(2); RESC(); ROT();
  }
  #undef CMASK
  #define CMASK(P0,P1,t) do{int jb_=(t)-(NT-4); if(jb_>=0)cmask(P0,P1,jb_,qrel,hi);}while(0)
  #define ENDW(tt) do{ if((tt)+3<NT){WAIT_BAR(2);} else if((tt)+2<NT){WAIT_BAR(1);} else {WAIT_BAR(0);} }while(0)
  for(;t+1<NT;t+=2){
    STEP(pB0,pB1,pA0,pA1,t,(t+3<NT),(t+1<NT),(t+1<NT));       ENDW(t);   RESC(); ROT();
    STEP(pA0,pA1,pB0,pB1,t+1,(t+4<NT),(t+2<NT),(t+2<NT));     ENDW(t+1); RESC(); ROT();
  }
  STEP(pB0,pB1,pA0,pA1,NT-1,false,false,false); RESC();
  { float sacc=pB0[0]+pB0[1]; _Pragma("unroll") for(int r=2;r<16;++r)sacc+=pB0[r]; _Pragma("unroll") for(int r=0;r<16;++r)sacc+=pB1[r]; l_reg+=sacc;
    pw0=(u32x4){PKW(pB0,0),PKW(pB0,2),PKW(pB0,4),PKW(pB0,6)};pw1=(u32x4){PKW(pB0,8),PKW(pB0,10),PKW(pB0,12),PKW(pB0,14)};pw2=(u32x4){PKW(pB1,0),PKW(pB1,2),PKW(pB1,4),PKW(pB1,6)};pw3=(u32x4){PKW(pB1,8),PKW(pB1,10),PKW(pB1,12),PKW(pB1,14)};
    SBAR(); pv(o,vb0+sl_cur,PAF(0),PAF(1),PAF(2),PAF(3)); }
  #undef PKW
  #undef PAF
  #undef VFR
  #undef PIN
  #undef MX3
  #undef GAPA
  #undef GAPB
  #undef EX
  #undef VRD
  #undef KRD
  #undef STEP
  #undef ENDW
  {auto rr=__builtin_amdgcn_permlane32_swap(__float_as_uint(l_reg),__float_as_uint(l_reg),false,false);l_reg=__uint_as_float(rr[0])+__uint_as_float(rr[1]);}
  if(hi==0)wsf[32+r32]=l_reg;asm volatile("s_waitcnt lgkmcnt(0)":::"memory");
  float rli[16];
  #pragma unroll
  for(int r=0;r<16;++r)rli[r]=__builtin_amdgcn_rcpf(wsf[32+crow(r,hi)]);
  bf16*Ow=O+(rowbase+q0+wid*QBLK)*DM+h*D;
  { bf16*stg=(bf16*)(shm+LDS_OST)+wid*2048;
    #pragma unroll
    for(int r=0;r<16;++r){const int orow=crow(r,hi);
      #pragma unroll
      for(int d0=0;d0<2;++d0)stg[orow*64+d0*32+r32]=__float2bfloat16(o[d0][r]*rli[r]);}
    asm volatile("s_waitcnt lgkmcnt(0)":::"memory");
    #pragma unroll
    for(int i=0;i<4;++i){const int row=i*8+(lane>>3),ch=lane&7; const u32x4 v=*(const u32x4*)(stg+row*64+ch*8); ATTN_STORE16(Ow+(long)row*DM+ch*8,v);} }
  asm volatile("s_waitcnt lgkmcnt(0)\n\ts_barrier":::"memory");
  #undef DMA_K
  #undef DMA_V
  #undef INITC
  #undef CMASK
  #undef START
  #undef RESC
  #undef ROT
}
constexpr int ATTN_LDS_BYTES=LDS_BYTES;
struct AttnTensors { const bf16* Q; const bf16* K; const bf16* V; bf16* O; const float* F; };
struct AttnUnit { int bh; int qb; };
struct StaticOrder {
  int vcu;
  __device__ __forceinline__ explicit StaticOrder(int grid,int block):vcu((block%8)*(grid/8)+block/8){}
  __device__ __forceinline__ bool next(int i,AttnUnit&u)const{ if(i>=4)return false; const int s=vcu&7; u.bh=vcu>>3; u.qb=(i==0)?s:(i==1)?15-s:(i==2)?16+s:31-s; return true; }
  __device__ __forceinline__ void a_ready(const AttnUnit&)const{}
  __device__ __forceinline__ void done(const AttnUnit&)const{}
};
template<class Sched,int THRL=8> __device__ __forceinline__ void attn_phase(char*lds,const AttnTensors&T,const Sched&S,int wid_in){
  AttnUnit u;
  for(int i=0;S.next(i,u);++i){ S.a_ready(u); attn_unit<THRL>(u.bh/NHEAD,u.bh%NHEAD,u.qb,T.Q,T.K,T.V,T.O,T.F,lds,wid_in); S.done(u); }
}
#undef SBAR
#undef WAIT_BAR
}
#define GAS __attribute__((address_space(1)))
#define LAS __attribute__((address_space(3)))
typedef unsigned short bf16;
typedef unsigned v4u __attribute__((ext_vector_type(4)));
typedef float f32x4 __attribute__((ext_vector_type(4)));
typedef short bf16x8 __attribute__((ext_vector_type(8)));
typedef GAS unsigned gu32;
typedef GAS unsigned long long gu64;
#define RLX_AGENT __ATOMIC_RELAXED, __HIP_MEMORY_SCOPE_AGENT
#define LDS_WAIT() asm volatile("s_waitcnt lgkmcnt(0)" ::: "memory")
#define VM_WAIT() asm volatile("s_waitcnt vmcnt(0)" ::: "memory")
__device__ __forceinline__ unsigned long long rt() { return __builtin_amdgcn_s_memrealtime(); }
__device__ __forceinline__ unsigned f2bf(float f) { unsigned u = __builtin_bit_cast(unsigned, f); return (u + 0x7fffu + ((u >> 16) & 1u)) >> 16; }
__device__ __forceinline__ unsigned pk2(float lo, float hi) { return f2bf(lo) | (f2bf(hi) << 16); }

#define XB_TMO      128
#define XB_XCNT(j)  (256  + 64 * (j))
#define XB_XSUB(j)  (1280 + 64 * (j))
#define XB_XGEN(j)  (2304 + 64 * (j))
#define XB_TOP      3328
#define XB_TOPGEN   3392
#define XCD_BAR_WORDS 3456
#define XB_SPIN_CAP (1u << 18)

__device__ __forceinline__ unsigned xb_ld(unsigned* p)              { return __hip_atomic_load(p, __ATOMIC_RELAXED, __HIP_MEMORY_SCOPE_AGENT); }
__device__ __forceinline__ unsigned xb_add(unsigned* p, unsigned v) { return __hip_atomic_fetch_add(p, v, __ATOMIC_RELAXED, __HIP_MEMORY_SCOPE_AGENT); }
__device__ __forceinline__ unsigned xb_xcc_id() { return (unsigned)__builtin_amdgcn_s_getreg((3 << 11) | 20) & 0xFu; }
#define XB_SPIN(cond, bar) do { unsigned _sp = 0; while (cond) { __builtin_amdgcn_s_sleep(1); \
    if ((++_sp & 255u) == 0u) { if (xb_ld(&(bar)[XB_TMO])) break; if (_sp > XB_SPIN_CAP) { atomicAdd(&(bar)[XB_TMO], 1u); break; } } } } while (0)

struct XcdBarrier {
    unsigned* bar; unsigned x; int wv;
    volatile LAS unsigned* st;
};

__device__ __forceinline__ bool xb_t0(int wv) { return wv == 0 && __builtin_amdgcn_mbcnt_hi(~0u, __builtin_amdgcn_mbcnt_lo(~0u, 0u)) == 0u; }
__device__ __forceinline__ XcdBarrier xcd_barrier_post(unsigned* bar, volatile LAS unsigned* st, int wv) {
    XcdBarrier b; b.bar = bar; b.x = xb_xcc_id(); b.st = st; b.wv = wv;
    if (xb_t0(wv)) (void)xb_add(&bar[XB_XCNT(b.x)], 1u);
    return b;
}
__device__ __forceinline__ void xcd_barrier_complete(unsigned* bar, unsigned x, unsigned& nloc, unsigned& nx) {
    const unsigned G = gridDim.x * gridDim.y * gridDim.z;
    unsigned sum, cnt, mine, sp = 0u;
    for (;;) {
        sum = 0u; cnt = 0u; mine = 0u;
#pragma unroll
        for (unsigned j = 0; j < 16; ++j) { const unsigned c = xb_ld(&bar[XB_XCNT(j)]); sum += c; cnt += (c > 0u) ? 1u : 0u; mine = (j == x) ? c : mine; }
        if (sum == G) break;
        __builtin_amdgcn_s_sleep(1);
        if ((++sp & 255u) == 0u) { if (xb_ld(&bar[XB_TMO])) break; if (sp > XB_SPIN_CAP) { atomicAdd(&bar[XB_TMO], 1u); break; } }
    }
    nloc = mine > 0u ? mine : 1u; nx = cnt > 0u ? cnt : 1u;
}

__device__ __forceinline__ void xcd_barrier(const XcdBarrier& b) {
    asm volatile("s_waitcnt vmcnt(0)" ::: "memory");
    __syncthreads();
    if (xb_t0(b.wv)) {
        unsigned* bar = b.bar;
        __builtin_amdgcn_s_waitcnt(0);
        unsigned nloc = b.st[0], nx = b.st[1];
        if (nloc == 0u) { xcd_barrier_complete(bar, b.x, nloc, nx); b.st[0] = nloc; b.st[1] = nx; }
        const unsigned old = xb_add(&bar[XB_XSUB(b.x)], 1u);
        const unsigned gen = old / nloc;
        if (old + 1u == (gen + 1u) * nloc) {
            __builtin_amdgcn_fence(__ATOMIC_RELEASE, "agent");
            asm volatile("s_waitcnt vmcnt(0)" ::: "memory");
            const unsigned og = xb_add(&bar[XB_TOP], 1u);
            const unsigned tg = og / nx;
            if (og + 1u == (tg + 1u) * nx) xb_add(&bar[XB_TOPGEN], 1u);
            else XB_SPIN(xb_ld(&bar[XB_TOPGEN]) == tg, bar);
            __builtin_amdgcn_fence(__ATOMIC_ACQUIRE, "agent");
            xb_add(&bar[XB_XGEN(b.x)], 1u);
            asm volatile("s_waitcnt vmcnt(0)" ::: "memory");
        } else {
            XB_SPIN(xb_ld(&bar[XB_XGEN(b.x)]) == gen, bar);
            __builtin_amdgcn_fence(__ATOMIC_ACQUIRE, "agent");
            asm volatile("s_waitcnt vmcnt(0)" ::: "memory");
        }
    }
    __syncthreads();
}

constexpr int NWAVES = 8;
constexpr int RING_OFF = 0, RING_BYTES = 131072;
constexpr int LDSCTL_OFF = RING_BYTES, MISC_OFF = LDSCTL_OFF + 320;
constexpr int LDS_BYTES = 147456;
constexpr int N_PHASES = 8;

struct Frame {
    LAS unsigned char* lds;
    volatile LAS unsigned* MISC;
    gu32* ctl;
    int tid, lane, wave, vcu, G;
};
__device__ __forceinline__ float wave_sum(float v) {
#pragma unroll
    for (int o = 1; o < 64; o <<= 1) v += __shfl_xor(v, o);
    return v;
}
struct Args { const float* in[20]; float* out; unsigned char* ws; int ph_lo, ph_hi, li, pad; };

__device__ __forceinline__ void p0_transpose_item(const float* W, int ld, int nblk, const float* glo, const float* ghi, int K, bf16* WT, LAS float* scr, int item, int lane) {
    const int kb = item / nblk, nb = item % nblk, k0 = 64 * kb, n0 = 32 * nb;
#pragma unroll 8
    for (int i = 0; i < 32; ++i) { const int kk = 2 * i + (lane >> 5), k = k0 + kk; float w = W[(size_t)k * ld + n0 + (lane & 31)];
        if (glo) w *= (k < K / 2) ? glo[k] : ghi[k - K / 2];
        scr[kk * 33 + (lane & 31)] = w; }
    LDS_WAIT(); asm volatile("" ::: "memory");
    const int c = lane & 7;
#pragma unroll
    for (int j = 0; j < 4; ++j) { const int n = (lane >> 3) + 8 * j; const LAS float* s = scr + (8 * c) * 33 + n;
        v4u o; o.x = pk2(s[0 * 33], s[1 * 33]); o.y = pk2(s[2 * 33], s[3 * 33]); o.z = pk2(s[4 * 33], s[5 * 33]); o.w = pk2(s[6 * 33], s[7 * 33]);
        *(GAS v4u*)(WT + (size_t)(n0 + n) * K + k0 + 8 * c) = o; }
    LDS_WAIT(); asm volatile("" ::: "memory");
}
__device__ __forceinline__ float log_sigmoid(float z) { return fminf(z, 0.f) - log1pf(expf(-fabsf(z))); }

__device__ __forceinline__ void p0_prologue(Frame& F, const Args& a) {
    LAS float* scr = (LAS float*)(F.lds + RING_OFF + F.wave * 16384);
    unsigned char* ws = a.ws;
    const float* x = a.in[0]; const float* g1 = a.in[1]; const float* w_in = a.in[2]; const float* bfv = a.in[10];
    const float* gn_l = a.in[11]; const float* gn_f = a.in[12]; const float* w_out = a.in[13]; const float* g2 = a.in[14];
    const float* w_q = a.in[15]; const float* sk = a.in[16]; const float* pu = a.in[17]; const float* pv = a.in[18];
    bf16* win_t = (bf16*)(ws + WS_WIN); bf16* wout_t = (bf16*)(ws + WS_WOUT); bf16* wq_t = (bf16*)(ws + WS_WQ); bf16* skb = (bf16*)(ws + WS_SKB); float* wfl = (float*)(ws + WS_WFL);
    float* logf = (float*)(ws + WS_LOGF); float* sumsq = (float*)(ws + WS_SUMSQ); bf16* h = (bf16*)(ws + WS_H);
    const int gw = F.vcu * NWAVES + F.wave, NGW = F.G * NWAVES, lane = F.lane;
    constexpr int I_IN = (DMODEL / 64) * (NG1 / 32), I_OUT = (DMODEL / 64) * (DMODEL / 32), I_Q = (DMODEL / 64) * (QPW / 32);
    constexpr int I_FL = 8 * DMODEL / 64, I_SK = PH * 2 * NKEY * PHALF / 512, I_SS = T / 64, I_WAX = 8 * 2 * 2 * 4;
    constexpr int E0 = I_IN, E1 = E0 + I_OUT, E2 = E1 + I_Q, E3 = E2 + I_FL, E4 = E3 + I_SK, E5 = E4 + I_SS, E6 = E5 + I_WAX;
    for (int it = gw; it < E6; it += NGW) {
        if (it < E0) { p0_transpose_item(w_in, INC, NG1 / 32, nullptr, nullptr, DMODEL, win_t, scr, it, lane); continue; }
        if (it < E1) { p0_transpose_item(w_out, DMODEL, DMODEL / 32, gn_l, gn_f, DMODEL, wout_t, scr, it - E0, lane); continue; }
        if (it < E2) { p0_transpose_item(w_q, QPW, QPW / 32, g2, g2 + DMODEL / 2, DMODEL, wq_t, scr, it - E1, lane); continue; }
        if (it < E3) { const int i = (it - E2) * 64 + lane, j = i / DMODEL, k = i % DMODEL; wfl[i] = w_in[(size_t)k * INC + NG1 + j]; continue; }
        if (it < E4) { const size_t i = (size_t)(it - E3) * 512 + lane * 8; const f32x4 s0 = *(const GAS f32x4*)(sk + i), s1 = *(const GAS f32x4*)(sk + i + 4);
            v4u o; o.x = pk2(s0[0], s0[1]); o.y = pk2(s0[2], s0[3]); o.z = pk2(s1[0], s1[1]); o.w = pk2(s1[2], s1[3]); *(GAS v4u*)(skb + i) = o; continue; }
        if (it < E5) { sumsq[(it - E4) * 64 + lane] = 0.f; continue; }
        { const int f = it - E5, ks = f & 3, n = (f >> 2) & 1, mat = (f >> 3) & 1, hh = f >> 4; const float* wsrc = mat ? a.in[7] : a.in[5];
          const size_t o = ((size_t)(hh * 64 + 16 * ks + 8 * (lane >> 5))) * 64 + 32 * n + (lane & 31);
          v4u pw; pw.x = pk2(wsrc[o], wsrc[o + 64]); pw.y = pk2(wsrc[o + 128], wsrc[o + 192]); pw.z = pk2(wsrc[o + 256], wsrc[o + 320]); pw.w = pk2(wsrc[o + 384], wsrc[o + 448]);
          *(GAS v4u*)((bf16*)(ws + WS_WAX) + (size_t)f * 512 + lane * 8) = pw; }
    }
    { f32x4 gg[4];
#pragma unroll
      for (int j = 0; j < 4; ++j) gg[j] = *(const GAS f32x4*)(g2 + 16 * lane + 4 * j);
      unsigned char* u8 = ws + WS_U8; unsigned char* v8 = ws + WS_V8; float* su = (float*)(ws + WS_SU); float* sv = (float*)(ws + WS_SV);
      for (int e = gw; e < NEXP; e += NGW) {
        const GAS f32x4* ur = (const GAS f32x4*)(pu + (size_t)e * DMODEL + 16 * lane); const GAS f32x4* vr = (const GAS f32x4*)(pv + (size_t)e * DMODEL + 16 * lane);
        f32x4 uu[4], vv[4]; float mu = 0.f, mv = 0.f;
#pragma unroll
        for (int j = 0; j < 4; ++j) { uu[j] = ur[j] * gg[j]; vv[j] = vr[j];
#pragma unroll
            for (int c = 0; c < 4; ++c) { mu = fmaxf(mu, fabsf(uu[j][c])); mv = fmaxf(mv, fabsf(vv[j][c])); } }
#pragma unroll
        for (int o = 1; o < 64; o <<= 1) { mu = fmaxf(mu, __shfl_xor(mu, o)); mv = fmaxf(mv, __shfl_xor(mv, o)); }
        const float scu = mu > 0.f ? mu * (1.f / 440.f) : 1.f, scv = mv > 0.f ? mv * (1.f / 440.f) : 1.f, iu = 1.f / scu, iv = 1.f / scv;
        v4u qu, qv;
#pragma unroll
        for (int j = 0; j < 4; ++j) { int wu = 0, wv = 0;
            wu = __builtin_amdgcn_cvt_pk_fp8_f32(uu[j][0] * iu, uu[j][1] * iu, wu, false); wu = __builtin_amdgcn_cvt_pk_fp8_f32(uu[j][2] * iu, uu[j][3] * iu, wu, true);
            wv = __builtin_amdgcn_cvt_pk_fp8_f32(vv[j][0] * iv, vv[j][1] * iv, wv, false); wv = __builtin_amdgcn_cvt_pk_fp8_f32(vv[j][2] * iv, vv[j][3] * iv, wv, true);
            qu[j] = (unsigned)wu; qv[j] = (unsigned)wv; }
        *(GAS v4u*)(u8 + (size_t)e * DMODEL + 16 * lane) = qu; *(GAS v4u*)(v8 + (size_t)e * DMODEL + 16 * lane) = qv;
        if (lane == 0) { su[e] = scu; sv[e] = scv; }
      } }
    { f32x4 gg[4];
#pragma unroll
      for (int j = 0; j < 4; ++j) gg[j] = *(const GAS f32x4*)(g1 + 256 * j + 4 * lane);
      float fw[4][4][8];
#pragma unroll
      for (int j = 0; j < 4; ++j)
#pragma unroll
          for (int c = 0; c < 4; ++c) { const int k = 256 * j + 4 * lane + c; const GAS f32x4* wr = (const GAS f32x4*)(w_in + (size_t)k * INC + NG1); const f32x4 w0 = wr[0], w1 = wr[1];
#pragma unroll
              for (int e = 0; e < 4; ++e) { fw[j][c][e] = w0[e]; fw[j][c][4 + e] = w1[e]; } }
      for (int t = gw; t < T; t += NGW) {
        const GAS f32x4* xr = (const GAS f32x4*)(x + (size_t)t * DMODEL) + lane;
        f32x4 v[4]; float ss = 0.f;
#pragma unroll
        for (int j = 0; j < 4; ++j) { v[j] = xr[64 * j]; ss += (v[j][0] * v[j][0] + v[j][1] * v[j][1]) + (v[j][2] * v[j][2] + v[j][3] * v[j][3]); }
        const float rstd = rsqrtf(wave_sum(ss) * (1.f / DMODEL) + RMS_EPS);
        GAS unsigned long long* ho = (GAS unsigned long long*)(h + (size_t)t * DMODEL) + lane;
#pragma unroll
        for (int j = 0; j < 4; ++j) { v[j] = v[j] * rstd * gg[j]; ho[64 * j] = (unsigned long long)pk2(v[j][0], v[j][1]) | ((unsigned long long)pk2(v[j][2], v[j][3]) << 32); }
        float fl[8];
#pragma unroll
        for (int hh = 0; hh < 8; ++hh) fl[hh] = 0.f;
#pragma unroll
        for (int j = 0; j < 4; ++j)
#pragma unroll
            for (int c = 0; c < 4; ++c) {
#pragma unroll
                for (int hh = 0; hh < 8; ++hh) fl[hh] += v[j][c] * fw[j][c][hh]; }
        float res = 0.f;
#pragma unroll
        for (int hh = 0; hh < 8; ++hh) { const float s = wave_sum(fl[hh]); if (lane == hh) res = s; }
        if (lane < 8) logf[(size_t)t * 8 + lane] = log_sigmoid(res + bfv[lane]);
      } }
}

__device__ __forceinline__ void fcum_unit(Frame& F, int bh, const float* logf, float* fcum) {
    const int b = bh / NHEADS, hh = bh % NHEADS, s0 = F.tid * 16;
    float v[16]; float loc = 0.f;
#pragma unroll
    for (int i = 0; i < 16; ++i) { v[i] = logf[((size_t)b * SEQ + s0 + i) * 8 + hh]; loc += v[i]; }
    float inc = loc;
#pragma unroll
    for (int o = 1; o < 64; o <<= 1) { const float n = __shfl_up(inc, o); if (F.lane >= o) inc += n; }
    if (F.lane == 63) F.MISC[16 + F.wave] = __float_as_uint(inc);
    __syncthreads();
    float run = inc - loc;
    for (int w = 0; w < F.wave; ++w) run += __uint_as_float(F.MISC[16 + w]);
#pragma unroll
    for (int i = 0; i < 16; ++i) { run += v[i]; fcum[(size_t)bh * SEQ + s0 + i] = run; }
    __syncthreads();
}


namespace peer {
typedef unsigned u32;
typedef float f32x16 __attribute__((ext_vector_type(16)));
constexpr int TOK = 128;
constexpr int EX_STRIDE = 136, GT_STRIDE = 132;
constexpr int L_EX = 0, L_GT = L_EX + TOK * EX_STRIDE * 2, L_IDX = L_GT + TOK * GT_STRIDE * 4, IDX_STRIDE = 36, L_RST = L_IDX + 512 * IDX_STRIDE, L_END = L_RST + TOK * 4;
static_assert(L_END <= RING_BYTES && L_GT % 16 == 0 && L_IDX % 16 == 0, "PEER LDS map");
__device__ __forceinline__ u32 ordmap(float f) { const u32 u = __float_as_uint(f); return u ^ ((u32)((int)u >> 31) | 0x80000000u); }
__device__ __forceinline__ float unordmap(u32 k) { const u32 u = (k & 0x80000000u) ? (k ^ 0x80000000u) : ~k; return __uint_as_float(u); }
__device__ __forceinline__ u32 umin_(u32 a, u32 b) { return a < b ? a : b; }
__device__ __forceinline__ u32 umax_(u32 a, u32 b) { return a > b ? a : b; }
template <bool DESC> __device__ __forceinline__ void sort16(u32 (&k)[16]) {
#pragma unroll
    for (int size = 2; size <= 16; size <<= 1)
#pragma unroll
        for (int stride = size >> 1; stride > 0; stride >>= 1)
#pragma unroll
            for (int i = 0; i < 16; ++i) { const int j = i ^ stride;
                if (j > i) { const bool asc = (((i & size) == 0) != DESC); const u32 a = k[i], b = k[j], lo = umin_(a, b), hi = umax_(a, b); k[i] = asc ? lo : hi; k[j] = asc ? hi : lo; } }
}
template <bool DESC> __device__ __forceinline__ void merge16(u32 (&k)[16]) {
#pragma unroll
    for (int stride = 8; stride > 0; stride >>= 1)
#pragma unroll
        for (int i = 0; i < 16; ++i) { const int j = i ^ stride;
            if (j > i) { const u32 a = k[i], b = k[j], lo = umin_(a, b), hi = umax_(a, b); k[i] = DESC ? hi : lo; k[j] = DESC ? lo : hi; } }
}
__host__ __device__ constexpr int ccnt(int a) { return 16 / (a + 1); }
__host__ __device__ constexpr int cbase(int a) { int s = 0; for (int i = 0; i < a; ++i) s += ccnt(i); return s; }
static_assert(cbase(16) == 50, "hyperbola candidate count");
__device__ __forceinline__ int crow16(int r) { return (r & 3) + 8 * (r >> 2); }

__device__ __forceinline__ void route_tile(Frame& F, const bf16* qp, const bf16* skb, const float* sumsq, int t0) {
    int lane = F.lane; asm volatile("" : "+v"(lane));
    const int r32 = lane & 31, hi = lane >> 5, w = F.wave;
    LAS unsigned short* EXL = (LAS unsigned short*)(F.lds + RING_OFF + L_EX);
    LAS float* GTL = (LAS float*)(F.lds + RING_OFF + L_GT);
    LAS unsigned char* IDXB = F.lds + RING_OFF + L_IDX + (w * 64 + lane) * IDX_STRIDE;
    LAS float* RST = (LAS float*)(F.lds + RING_OFF + L_RST);
    for (int g = 0; g < 4; ++g) {
        const int tok = 32 * g + r32; const size_t trow = (size_t)(t0 + tok);
        const float rstd2 = rsqrtf(sumsq[trow] * (1.f / DMODEL) + RMS_EPS);
        if (w == 0 && hi == 0) RST[tok] = rstd2;
        u32 s0[16], s1[16];
#pragma unroll
        for (int p = 0; p < 2; ++p) {
            bf16x8 qf[8];
#pragma unroll
            for (int ks = 0; ks < 8; ++ks) qf[ks] = *(const GAS bf16x8*)(qp + trow * QPW + w * 256 + p * 128 + ks * 16 + hi * 8);
            u32 run[16];
#pragma unroll
            for (int nb = 0; nb < 4; ++nb) {
                f32x16 acc = {};
                const bf16* kr = skb + ((size_t)((w * 2 + p) * NKEY + 32 * nb + r32)) * PHALF + hi * 8;
#pragma unroll
                for (int ks = 0; ks < 8; ++ks) acc = __builtin_amdgcn_mfma_f32_32x32x16_bf16(*(const GAS bf16x8*)(kr + ks * 16), qf[ks], acc, 0, 0, 0);
                asm volatile("" ::: "memory");
                u32 blk[16];
#pragma unroll
                for (int r = 0; r < 16; ++r) blk[r] = (ordmap(acc[r]) & ~0x7Fu) | (u32)(127 - 32 * nb - crow16(r) - 4 * hi);
                if (nb == 0) { sort16<true>(blk);
#pragma unroll
                    for (int i = 0; i < 16; ++i) run[i] = blk[i]; }
                else { sort16<false>(blk);
#pragma unroll
                    for (int i = 0; i < 16; ++i) run[i] = umax_(run[i], blk[i]);
                    merge16<true>(run); }
            }
            u32 oth[16];
#pragma unroll
            for (int i = 0; i < 16; ++i) oth[i] = (u32)__shfl_xor((int)run[15 - i], 32);
#pragma unroll
            for (int i = 0; i < 16; ++i) run[i] = umax_(run[i], oth[i]);
            merge16<true>(run);
#pragma unroll
            for (int i = 0; i < 16; ++i) { if (p == 0) s0[i] = run[i]; else s1[i] = run[i]; }
        }
        { LAS u32* iw = (LAS u32*)IDXB;
#pragma unroll
          for (int j = 0; j < 4; ++j) {
              iw[j] = (127u - (s0[4 * j] & 127u)) | ((127u - (s0[4 * j + 1] & 127u)) << 8) | ((127u - (s0[4 * j + 2] & 127u)) << 16) | ((127u - (s0[4 * j + 3] & 127u)) << 24);
              iw[4 + j] = (127u - (s1[4 * j] & 127u)) | ((127u - (s1[4 * j + 1] & 127u)) << 8) | ((127u - (s1[4 * j + 2] & 127u)) << 16) | ((127u - (s1[4 * j + 3] & 127u)) << 24); } }
        float v1[16], v2[16];
#pragma unroll
        for (int i = 0; i < 16; ++i) { v1[i] = unordmap(s0[i] & ~0x7Fu); v2[i] = unordmap(s1[i] & ~0x7Fu); }
        u32 c0[16], c1[16], c2[16], c3[16];
#pragma unroll
        for (int a = 0; a < 16; ++a)
#pragma unroll
            for (int b = 0; b < ccnt(a); ++b) { const int pos = cbase(a) + b; const u32 key = (ordmap(v1[a] + v2[b]) & ~0xFFu) | (u32)(255 - (a * 16 + b));
                if (pos < 16) c0[pos] = key; else if (pos < 32) c1[pos - 16] = key; else if (pos < 48) c2[pos - 32] = key; else c3[pos - 48] = key; }
#pragma unroll
        for (int i = 2; i < 16; ++i) c3[i] = 0u;
        sort16<false>(c1);
#pragma unroll
        for (int i = 0; i < 16; ++i) c0[i] = umax_(c0[i], c1[i]);
        merge16<true>(c0);
        sort16<false>(c2);
#pragma unroll
        for (int i = 0; i < 16; ++i) c0[i] = umax_(c0[i], c2[i]);
        merge16<true>(c0);
        sort16<false>(c3);
#pragma unroll
        for (int i = 0; i < 16; ++i) c0[i] = umax_(c0[i], c3[i]);
        merge16<true>(c0);
        const float m = unordmap(c0[0] & ~0xFFu) * rstd2;
        float e[8]; float sum = 0.f; u32 ex[8];
#pragma unroll
        for (int k = 0; k < 8; ++k) { const u32 key = hi ? c0[k + 8] : c0[k]; const float ts = unordmap(key & ~0xFFu);
            e[k] = __builtin_amdgcn_exp2f((ts * rstd2 - m) * LOG2E); sum += e[k];
            const u32 flat = 255u - (key & 255u); ex[k] = (u32)IDXB[flat >> 4] * NKEY + (u32)IDXB[16 + (flat & 15u)]; }
        sum += __shfl_xor(sum, 32);
        const float inv = 1.f / sum;
        v4u exw; exw.x = ex[0] | (ex[1] << 16); exw.y = ex[2] | (ex[3] << 16); exw.z = ex[4] | (ex[5] << 16); exw.w = ex[6] | (ex[7] << 16);
        *(LAS v4u*)(EXL + tok * EX_STRIDE + w * 16 + hi * 8) = exw;
        *(LAS f32x4*)(GTL + tok * GT_STRIDE + w * 16 + hi * 8) = (f32x4){e[0] * inv, e[1] * inv, e[2] * inv, e[3] * inv};
        *(LAS f32x4*)(GTL + tok * GT_STRIDE + w * 16 + hi * 8 + 4) = (f32x4){e[4] * inv, e[5] * inv, e[6] * inv, e[7] * inv};
    }
}
__device__ __forceinline__ float gelu_fast(float x) {
    const float u2 = x * (1.5957691216057308f + 0.07135481627f * x * x);
    return x * __builtin_amdgcn_rcpf(1.f + __builtin_amdgcn_exp2f(-1.4426950408889634f * u2));
}
typedef float f32x2 __attribute__((ext_vector_type(2)));
__device__ __forceinline__ void eval_tile(Frame& F, const unsigned char* u8, const unsigned char* v8, const float* su, const float* sv, const float* fg, float* out, int t0) {
    int lane = F.lane; asm volatile("" : "+v"(lane));
    const LAS unsigned short* EXL = (const LAS unsigned short*)(F.lds + RING_OFF + L_EX);
    const LAS float* GTL = (const LAS float*)(F.lds + RING_OFF + L_GT);
    const LAS float* RST = (const LAS float*)(F.lds + RING_OFF + L_RST);
    f32x4 fgv[4];
#pragma unroll
    for (int q = 0; q < 4; ++q) fgv[q] = *(const GAS f32x4*)(fg + 16 * lane + 4 * q);
    const int h5 = lane >> 5, h4 = (lane >> 4) & 1, h3 = (lane >> 3) & 1, jj = 4 * h3 + 2 * h4 + h5;
    for (int i = 0; i < 16; ++i) {
        const int tok = F.wave * 16 + i; const size_t trow = (size_t)(t0 + tok);
        const float rstd2 = RST[tok];
        float* xrow = out + trow * DMODEL + 16 * lane;
        f32x4 xa[4];
#pragma unroll
        for (int q = 0; q < 4; ++q) xa[q] = *(const GAS f32x4*)(xrow + 4 * q);
        f32x2 hv[8], y[8];
#pragma unroll
        for (int q = 0; q < 8; ++q) { hv[q] = (f32x2){xa[q >> 1][2 * (q & 1)] * rstd2, xa[q >> 1][2 * (q & 1) + 1] * rstd2}; y[q] = (f32x2){0.f, 0.f}; }
        const LAS unsigned short* exr = EXL + tok * EX_STRIDE; const LAS float* gtr = GTL + tok * GT_STRIDE;
        for (int kb = 0; kb < 16; ++kb) {
            v4u ub[8], vb[8]; float scu[8], scv[8];
#pragma unroll
            for (int j = 0; j < 8; ++j) { const int e = __builtin_amdgcn_readfirstlane((int)exr[kb * 8 + j]);
                ub[j] = *(const GAS v4u*)(u8 + (size_t)e * DMODEL + 16 * lane); vb[j] = *(const GAS v4u*)(v8 + (size_t)e * DMODEL + 16 * lane); scu[j] = su[e]; scv[j] = sv[e]; }
            float p[8];
#pragma unroll
            for (int j = 0; j < 8; ++j) { f32x2 acc = (f32x2){0.f, 0.f};
#pragma unroll
                for (int c = 0; c < 4; ++c) { const int wd = (int)ub[j][c];
                    acc = __builtin_elementwise_fma(__builtin_amdgcn_cvt_pk_f32_fp8(wd, false), hv[2 * c], acc); acc = __builtin_elementwise_fma(__builtin_amdgcn_cvt_pk_f32_fp8(wd, true), hv[2 * c + 1], acc); }
                p[j] = (acc[0] + acc[1]) * scu[j]; }
            float q4[4], q2[2];
#pragma unroll
            for (int n = 0; n < 4; ++n) { const float keep = h5 ? p[2 * n + 1] : p[2 * n], send = h5 ? p[2 * n] : p[2 * n + 1]; q4[n] = keep + __shfl_xor(send, 32); }
#pragma unroll
            for (int n = 0; n < 2; ++n) { const float keep = h4 ? q4[2 * n + 1] : q4[2 * n], send = h4 ? q4[2 * n] : q4[2 * n + 1]; q2[n] = keep + __shfl_xor(send, 16); }
            float tot; { const float keep = h3 ? q2[1] : q2[0], send = h3 ? q2[0] : q2[1]; tot = keep + __shfl_xor(send, 8); }
            tot += __shfl_xor(tot, 4); tot += __shfl_xor(tot, 2); tot += __shfl_xor(tot, 1);
            const float act = gelu_fast(tot) * gtr[kb * 8 + jj];
#pragma unroll
            for (int j = 0; j < 8; ++j) { const float aj = scv[j] * __uint_as_float((unsigned)__builtin_amdgcn_readlane((int)__float_as_uint(act), ((j >> 2) & 1) * 8 + ((j >> 1) & 1) * 16 + (j & 1) * 32));
                const f32x2 a2 = (f32x2){aj, aj};
#pragma unroll
                for (int c = 0; c < 4; ++c) { const int wd = (int)vb[j][c];
                    y[2 * c] = __builtin_elementwise_fma(__builtin_amdgcn_cvt_pk_f32_fp8(wd, false), a2, y[2 * c]); y[2 * c + 1] = __builtin_elementwise_fma(__builtin_amdgcn_cvt_pk_f32_fp8(wd, true), a2, y[2 * c + 1]); } }
        }
        float ss = 0.f; float yo[16];
#pragma unroll
        for (int q = 0; q < 16; ++q) { yo[q] = y[q >> 1][q & 1] + xa[q >> 2][q & 3]; ss += yo[q] * yo[q]; }
        const float rs = rsqrtf(wave_sum(ss) * (1.f / DMODEL) + RMS_EPS);
#pragma unroll
        for (int q = 0; q < 4; ++q) { f32x4 o; o[0] = yo[4 * q] * rs * fgv[q][0]; o[1] = yo[4 * q + 1] * rs * fgv[q][1]; o[2] = yo[4 * q + 2] * rs * fgv[q][2]; o[3] = yo[4 * q + 3] * rs * fgv[q][3];
            *(GAS f32x4*)(xrow + 4 * q) = o; }
    }
}
__device__ __forceinline__ void peer_phase(Frame& F, const Args& a) {
    unsigned char* ws = a.ws;
    for (int tile = F.vcu; tile < T / TOK; tile += F.G) {
        route_tile(F, (const bf16*)(ws + WS_QP), (const bf16*)(ws + WS_SKB), (const float*)(ws + WS_SUMSQ), tile * TOK);
        __syncthreads();
        eval_tile(F, ws + WS_U8, ws + WS_V8, (const float*)(ws + WS_SU), (const float*)(ws + WS_SV), a.in[19], a.out, tile * TOK);
        __syncthreads();
    }
}
}

namespace lru {
typedef float f32x16 __attribute__((ext_vector_type(16)));
constexpr int TOKT = 128, NTILE = SEQ / TOKT;
constexpr int WAVE_LDS = 14336, L_XS = 0, L_XC = 4608, L_GS = 9216, XC_STRIDE = 72  , L_SS = 8 * WAVE_LDS;
static_assert(L_SS + 32 * 8 * 4 <= RING_BYTES, "LRU LDS map");
__device__ __forceinline__ float bf2f(unsigned short h) { return __uint_as_float((unsigned)h << 16); }
__device__ __forceinline__ int crow16(int r) { return (r & 3) + 8 * (r >> 2); }
__device__ __forceinline__ float sigm(float x) { return __builtin_amdgcn_rcpf(1.f + __builtin_amdgcn_exp2f(-LOG2E * x)); }

template <bool FINAL> __device__ __forceinline__ void lru_tile(Frame& F, const Args& args, int tile) {
    int lane = F.lane; asm volatile("" : "+v"(lane));
    const int w = F.wave, j32 = lane & 31, hi = lane >> 5;
    unsigned char* ws = args.ws;
    const bf16* xr = (const bf16*)(ws + WS_XR); const bf16* gr = (const bf16*)(ws + WS_GR); float* carry = (float*)(ws + WS_CARRY);
    const float* cw = args.in[3]; const float* cb = args.in[4]; const float* ba = args.in[6]; const float* bx = args.in[8]; const float* lam = args.in[9];
    const int b = tile / NTILE, jt = tile % NTILE; const size_t trow0 = (size_t)b * SEQ + (size_t)jt * TOKT;
    LAS unsigned char* wl = F.lds + RING_OFF + w * WAVE_LDS;
    LAS unsigned short* XS = (LAS unsigned short*)(wl + L_XS); LAS unsigned short* XC = (LAS unsigned short*)(wl + L_XC); LAS unsigned short* GS = (LAS unsigned short*)(wl + L_GS);
    LAS float* SS = (LAS float*)(F.lds + RING_OFF + L_SS);
    float c_ba[2], c_bx[2], c_sp[2], c_cb[2], c_cw[2][4];
#pragma unroll
    for (int n = 0; n < 2; ++n) { const int c = 64 * w + 32 * n + j32; c_ba[n] = ba[c]; c_bx[n] = bx[c]; c_cb[n] = cb[c];
        const float l = lam[c]; c_sp[n] = 8.f * LOG2E * (fmaxf(-l, 0.f) + log1pf(expf(-fabsf(l))));
#pragma unroll
        for (int k = 0; k < 4; ++k) c_cw[n][k] = cw[k * LW + c]; }
    const bf16* wax = (const bf16*)(ws + WS_WAX);
    float hc[2] = {0.f, 0.f}, ap[2] = {1.f, 1.f};
    if (FINAL) {
        for (int jp = 0; jp < jt; ++jp) { const float* cp = carry + ((size_t)(b * NTILE + jp) * 2) * LW + 64 * w + j32;
#pragma unroll
            for (int n = 0; n < 2; ++n) hc[n] = cp[32 * n] * hc[n] + cp[LW + 32 * n]; }
    }
    for (int blk = 0; blk < 4; ++blk) {
        const size_t tb = trow0 + blk * 32;
        int ln = lane; asm volatile("" : "+v"(ln));
        const int k32 = ln & 31;
        for (int pc = ln; pc < 35 * 8; pc += 64) { const int row = pc >> 3, c8 = pc & 7; v4u v = (v4u){0u, 0u, 0u, 0u};
            if (!(jt == 0 && blk == 0 && row < 3)) v = *(const GAS v4u*)(xr + (tb + row - 3) * LW + w * 64 + c8 * 8);
            *(LAS v4u*)((LAS unsigned char*)XS + row * 128 + c8 * 16) = v; }
        if (FINAL) {
#pragma unroll
            for (int q = 0; q < 4; ++q) { const int pc = ln + 64 * q, row = pc >> 3, c8 = pc & 7;
                *(LAS v4u*)((LAS unsigned char*)GS + row * 128 + c8 * 16) = *(const GAS v4u*)(gr + (tb + row) * LW + w * 64 + c8 * 8); } }
        asm volatile("" ::: "memory");
        float xc[2][16];
#pragma unroll
        for (int n = 0; n < 2; ++n)
#pragma unroll
            for (int g = 0; g < 4; ++g) { float xv[7];
#pragma unroll
                for (int q = 0; q < 7; ++q) xv[q] = bf2f(XS[(8 * g + 4 * hi + q) * 64 + 32 * n + j32]);
#pragma unroll
                for (int e = 0; e < 4; ++e) xc[n][4 * g + e] = c_cb[n] + ((c_cw[n][0] * xv[e] + c_cw[n][1] * xv[e + 1]) + (c_cw[n][2] * xv[e + 2] + c_cw[n][3] * xv[e + 3])); }
#pragma unroll
        for (int n = 0; n < 2; ++n)
#pragma unroll
            for (int r = 0; r < 16; ++r) XC[(crow16(r) + 4 * hi) * XC_STRIDE + 32 * n + j32] = (unsigned short)f2bf(xc[n][r]);
        asm volatile("" ::: "memory");
        bf16x8 af[4];
#pragma unroll
        for (int ks = 0; ks < 4; ++ks) af[ks] = *(const LAS bf16x8*)(XC + j32 * XC_STRIDE + 16 * ks + 8 * hi);
        asm volatile("" ::: "memory");
        float yv[2][16];
#pragma unroll
        for (int n = 0; n < 2; ++n) {
            f32x16 R = {}, I = {};
            bf16x8 fa[4], fx[4];
#pragma unroll
            for (int ks = 0; ks < 4; ++ks) { fa[ks] = *(const GAS bf16x8*)(wax + (size_t)(((w * 2 + 0) * 2 + n) * 4 + ks) * 512 + lane * 8); fx[ks] = *(const GAS bf16x8*)(wax + (size_t)(((w * 2 + 1) * 2 + n) * 4 + ks) * 512 + lane * 8); }
#pragma unroll
            for (int ks = 0; ks < 4; ++ks) { R = __builtin_amdgcn_mfma_f32_32x32x16_bf16(af[ks], fa[ks], R, 0, 0, 0); I = __builtin_amdgcn_mfma_f32_32x32x16_bf16(af[ks], fx[ks], I, 0, 0, 0); }
            float av[16], uv[16];
#pragma unroll
            for (int r = 0; r < 16; ++r) { const float rg = sigm(R[r] + c_ba[n]), ig = sigm(I[r] + c_bx[n]); const float a_ = __builtin_amdgcn_exp2f(-rg * c_sp[n]);
                av[r] = a_; uv[r] = __builtin_amdgcn_sqrtf(fmaxf(1.f - a_ * a_, 0.f)) * (ig * xc[n][r]); }
            float Ar[4], Hr[4], hst[4];
#pragma unroll
            for (int g = 0; g < 4; ++g) { Ar[g] = (av[4 * g] * av[4 * g + 1]) * (av[4 * g + 2] * av[4 * g + 3]);
                Hr[g] = ((uv[4 * g] * av[4 * g + 1] + uv[4 * g + 1]) * av[4 * g + 2] + uv[4 * g + 2]) * av[4 * g + 3] + uv[4 * g + 3]; }
            float hin = hc[n];
#pragma unroll
            for (int g = 0; g < 4; ++g) { float o1 = Ar[g] * hin + Hr[g]; const float x = __shfl_xor(o1, 32); const float hg = hi ? x : hin; o1 = Ar[g] * hg + Hr[g]; hst[g] = hg;
                const float y = __shfl_xor(o1, 32); hin = hi ? o1 : y;
                if (!FINAL) ap[n] *= Ar[g] * __shfl_xor(Ar[g], 32); }
            hc[n] = hin;
            if (FINAL) {
#pragma unroll
                for (int g = 0; g < 4; ++g) { float h = hst[g];
#pragma unroll
                    for (int e = 0; e < 4; ++e) { const int r = 4 * g + e; h = av[r] * h + uv[r]; yv[n][r] = h * bf2f(GS[(crow16(r) + 4 * hi) * 64 + 32 * n + j32]); } } }
        }
        if (FINAL) {
#pragma unroll
            for (int r = 0; r < 16; ++r) { float s = yv[0][r] * yv[0][r] + yv[1][r] * yv[1][r];
                s += __shfl_xor(s, 1); s += __shfl_xor(s, 2); s += __shfl_xor(s, 4); s += __shfl_xor(s, 8); s += __shfl_xor(s, 16);
                if (j32 == 0) SS[(crow16(r) + 4 * hi) * 8 + w] = s; }
            __syncthreads();
            bf16* ymix = (bf16*)(ws + WS_H);
#pragma unroll
            for (int r = 0; r < 16; ++r) { const int tk = crow16(r) + 4 * hi; const f32x4 s0 = *(const LAS f32x4*)(SS + tk * 8), s1 = *(const LAS f32x4*)(SS + tk * 8 + 4);
                const float rstd = rsqrtf(((s0[0] + s0[1]) + (s0[2] + s0[3]) + (s1[0] + s1[1]) + (s1[2] + s1[3])) * (1.f / LW) + RMS_EPS);
                bf16* yp = ymix + (tb + tk) * DMODEL + 64 * w + k32;
                yp[0] = (bf16)f2bf(yv[0][r] * rstd); yp[32] = (bf16)f2bf(yv[1][r] * rstd); }
            __syncthreads();
        }
    }
    if (!FINAL) { if (hi == 0) { float* cp = carry + ((size_t)(b * NTILE + jt) * 2) * LW + 64 * w + j32;
#pragma unroll
        for (int n = 0; n < 2; ++n) { cp[32 * n] = ap[n]; cp[LW + 32 * n] = hc[n]; } } }
    else {
        const bf16* ob = (const bf16*)(ws + WS_Q); bf16* ymix = (bf16*)(ws + WS_H);
        for (int i = 0; i < 16; ++i) { const size_t row = trow0 + 16 * w + i; const v4u v = *(const GAS v4u*)(ob + row * AW + 8 * lane);
            float f[8]; f[0] = __uint_as_float(v.x << 16); f[1] = __uint_as_float(v.x & 0xffff0000u); f[2] = __uint_as_float(v.y << 16); f[3] = __uint_as_float(v.y & 0xffff0000u);
            f[4] = __uint_as_float(v.z << 16); f[5] = __uint_as_float(v.z & 0xffff0000u); f[6] = __uint_as_float(v.w << 16); f[7] = __uint_as_float(v.w & 0xffff0000u);
            float ss = 0.f;
#pragma unroll
            for (int e = 0; e < 8; ++e) ss += f[e] * f[e];
            const float rstd = rsqrtf(wave_sum(ss) * (1.f / AW) + RMS_EPS);
            v4u o; o.x = pk2(f[0] * rstd, f[1] * rstd); o.y = pk2(f[2] * rstd, f[3] * rstd); o.z = pk2(f[4] * rstd, f[5] * rstd); o.w = pk2(f[6] * rstd, f[7] * rstd);
            *(GAS v4u*)(ymix + row * DMODEL + LW + 8 * lane) = o; }
    }
}
template <bool FINAL> __device__ __forceinline__ void lru_phase(Frame& F, const Args& a) {
    for (int tile = F.vcu; tile < BATCH * NTILE; tile += F.G) { lru_tile<FINAL>(F, a, tile); __syncthreads(); }
}
}
__global__ void __launch_bounds__(NWAVES * 64, 2) mk_fwd(Args args) {
    extern __shared__ __attribute__((aligned(16))) unsigned char lds[];
    Frame F;
    F.lds = (LAS unsigned char*)lds;
    F.MISC = (volatile LAS unsigned*)(F.lds + MISC_OFF);
    F.wave = __builtin_amdgcn_readfirstlane((int)threadIdx.x >> 6); F.lane = (int)__builtin_amdgcn_mbcnt_hi(~0u, __builtin_amdgcn_mbcnt_lo(~0u, 0u)); F.tid = F.wave * 64 + F.lane;
    F.G = gridDim.x; { const int bx = blockIdx.x; F.vcu = (F.G % 8 == 0) ? (bx % 8) * (F.G / 8) + bx / 8 : bx; }
    unsigned char* ws = args.ws;
    F.ctl = (gu32*)(ws + WS_CTL);
    for (int u = F.tid; u < (LDS_BYTES - LDSCTL_OFF) / 4; u += NWAVES * 64) ((LAS unsigned*)(F.lds + LDSCTL_OFF))[u] = 0u;
    __syncthreads();
    XcdBarrier bar = xcd_barrier_post((unsigned*)(F.ctl + CW_BAR) + args.li * XCD_BAR_WORDS, F.MISC + 8, F.wave);
    const int lo = args.ph_lo, hi = args.ph_hi;
#define IN(k) (lo <= (k) && (k) < hi)
#define BOTH(k) (IN(k) && IN((k) + 1))
#define GRID_BAR() xcd_barrier(bar)

    if (IN(0)) { p0_prologue(F, args); if (BOTH(0)) GRID_BAR(); }

    if (IN(1)) {
        if (F.vcu < BATCH * NHEADS) fcum_unit(F, F.vcu, (const float*)(ws + WS_LOGF), (float*)(ws + WS_FCUM));
        pg8::Gemm g{(const pg8::bf16_t*)(ws + WS_H), (const pg8::bf16_t*)(ws + WS_WIN), T, NG1, DMODEL}; pg8::StaticOrder S; S.init(T, NG1, F.G, (int)blockIdx.x);
        pg8::EpiG1 E{(pg8::bf16_t*)(ws + WS_XR), SPLIT_STRIDE, QSCALE};
        pg8::gemm_phase<pg8::EpiG1, pg8::StaticOrder, true, true>(F.lds + RING_OFF, g, S, E, F.wave);
        if (BOTH(1)) GRID_BAR();
    }
    if (IN(2)) {
        static_assert(attn_body::ATTN_LDS_BYTES <= RING_BYTES, "attention LDS vs frame");
        const attn_body::AttnTensors AT{(const attn_body::bf16*)(ws + WS_Q), (const attn_body::bf16*)(ws + WS_K), (const attn_body::bf16*)(ws + WS_V), (attn_body::bf16*)(ws + WS_Q), (const float*)(ws + WS_FCUM)};
        const attn_body::StaticOrder S((int)F.G, (int)blockIdx.x);
        attn_body::attn_phase<attn_body::StaticOrder>((char*)lds + RING_OFF, AT, S, F.wave);
    }
    if (IN(3)) { lru::lru_phase<false>(F, args); if (BOTH(3)) GRID_BAR(); }
    if (IN(4)) { lru::lru_phase<true>(F, args); if (BOTH(4)) GRID_BAR(); }
    if (IN(5)) {
        pg8::Gemm g{(const pg8::bf16_t*)(ws + WS_H), (const pg8::bf16_t*)(ws + WS_WOUT), T, DMODEL, DMODEL}; pg8::StaticOrder S; S.init(T, DMODEL, F.G, (int)blockIdx.x);
        pg8::EpiG2 E{args.in[0], args.out, (pg8::bf16_t*)(ws + WS_X1B), (float*)(ws + WS_SUMSQ), DMODEL};
        pg8::gemm_phase<pg8::EpiG2, pg8::StaticOrder, true, true>(F.lds + RING_OFF, g, S, E, F.wave);
        if (BOTH(5)) GRID_BAR();
    }
    if (IN(6)) {
        pg8::Gemm g{(const pg8::bf16_t*)(ws + WS_X1B), (const pg8::bf16_t*)(ws + WS_WQ), T, QPW, DMODEL}; pg8::StaticOrder S; S.init(T, QPW, F.G, (int)blockIdx.x);
        pg8::EpiG3 E{(pg8::bf16_t*)(ws + WS_QP), QPW};
        pg8::gemm_phase<pg8::EpiG3, pg8::StaticOrder, true, true>(F.lds + RING_OFF, g, S, E, F.wave);
        if (BOTH(6)) GRID_BAR();
    }
    if (IN(7)) { peer::peer_phase(F, args); }
#undef IN
#undef BOTH
#undef GRID_BAR
}

#ifndef MK_FRAME_MASK
#define MK_FRAME_MASK 0xFF
#endif
extern "C" void kernel_launch(void* const* d_in, const int* in_sizes, int n_in, void* d_out, int out_size, void* d_ws, size_t ws_size, hipStream_t stream) {
    static int grid = 0;
    if (grid == 0) {
        if (n_in != 20 || in_sizes[0] != T * DMODEL || out_size != T * DMODEL || ws_size < WS_END) { fprintf(stderr, "kernel_launch: unexpected shapes (n_in %d, ws %zu)\n", n_in, ws_size); grid = -1; return; }
        int dev = 0, cus = 0;
        if (hipGetDevice(&dev) != hipSuccess || hipDeviceGetAttribute(&cus, hipDeviceAttributeMultiprocessorCount, dev) != hipSuccess) { grid = -1; return; }
        if (hipFuncSetAttribute((const void*)mk_fwd, hipFuncAttributeMaxDynamicSharedMemorySize, LDS_BYTES) != hipSuccess) { fprintf(stderr, "kernel_launch: hipFuncSetAttribute failed\n"); grid = -1; return; }
        (void)hipGetLastError();
        grid = cus;
    }
    if (grid < 0) return;
    using namespace naive;
    const float* x = (const float*)d_in[0]; const float* g1 = (const float*)d_in[1]; const float* w_in = (const float*)d_in[2];
    const float* cw = (const float*)d_in[3]; const float* cb = (const float*)d_in[4]; const float* wa = (const float*)d_in[5]; const float* ba = (const float*)d_in[6];
    const float* wx = (const float*)d_in[7]; const float* bx = (const float*)d_in[8]; const float* lam = (const float*)d_in[9]; const float* bfv = (const float*)d_in[10];
    const float* gn_l = (const float*)d_in[11]; const float* gn_f = (const float*)d_in[12]; const float* w_out = (const float*)d_in[13]; const float* g2 = (const float*)d_in[14];
    const float* w_q = (const float*)d_in[15]; const float* sk = (const float*)d_in[16]; const float* pu = (const float*)d_in[17]; const float* pv = (const float*)d_in[18]; const float* fg = (const float*)d_in[19];
    char* ws = (char*)d_ws; float* out = (float*)d_out;
    naive::bf16* win_t = (naive::bf16*)(ws + WS_WIN); naive::bf16* wout_t = (naive::bf16*)(ws + WS_WOUT); naive::bf16* wq_t = (naive::bf16*)(ws + WS_WQ); naive::bf16* skb = (naive::bf16*)(ws + WS_SKB); float* wfl = (float*)(ws + WS_WFL);
    float* logf = (float*)(ws + WS_LOGF); float* fcum = (float*)(ws + WS_FCUM); float* sumsq = (float*)(ws + WS_SUMSQ);
    naive::bf16* h = (naive::bf16*)(ws + WS_H); naive::bf16* xr = (naive::bf16*)(ws + WS_XR); naive::bf16* gr = (naive::bf16*)(ws + WS_GR); naive::bf16* q = (naive::bf16*)(ws + WS_Q); naive::bf16* k = (naive::bf16*)(ws + WS_K); naive::bf16* v = (naive::bf16*)(ws + WS_V);
    naive::bf16* x1b = (naive::bf16*)(ws + WS_X1B); naive::bf16* qp = (naive::bf16*)(ws + WS_QP); naive::bf16* ut = (naive::bf16*)(ws + WS_UT); naive::bf16* vt = (naive::bf16*)(ws + WS_VT); float* la = (float*)(ws + WS_LA); float* lu = (float*)(ws + WS_LU);
    naive::bf16* ymix = h;
    if (hipMemsetAsync((char*)d_ws + WS_CTL, 0, CTL_ZERO_BYTES, stream) != hipSuccess) return;
    Args a{};
    for (int i = 0; i < 20; ++i) a.in[i] = (const float*)d_in[i];
    a.out = out; a.ws = (unsigned char*)d_ws;
    int li = 0;
    for (int p = 0; p < N_PHASES;) {
        if ((MK_FRAME_MASK >> p) & 1) {
            int e = p; while (e < N_PHASES && ((MK_FRAME_MASK >> e) & 1)) ++e;
            a.ph_lo = p; a.ph_hi = e; a.li = li++;
            hipLaunchKernelGGL(mk_fwd, dim3(grid), dim3(NWAVES * 64), LDS_BYTES, stream, a);
            p = e; continue;
        }
        switch (p) {
        case 0: k_prep_w<<<2048, 256, 0, stream>>>(w_in, w_out, gn_l, gn_f, w_q, g2, sk, win_t, wfl, wout_t, wq_t, skb);
                k_prep_tab<<<4096, 256, 0, stream>>>(pu, pv, g2, ut, vt);
                k_prep_x<<<2048, 256, 0, stream>>>(x, g1, wfl, bfv, h, logf); break;
        case 1: k_fcum<<<BATCH * NHEADS, 64, 0, stream>>>(logf, fcum);
                { EpiArgs e{xr, gr, q, k, v, nullptr, nullptr}; k_gemm<1><<<dim3(NG1 / 64, T / 64), 256, 0, stream>>>(h, win_t, T, NG1, DMODEL, e); } break;
        case 2: k_attn<<<(BATCH * NHEADS * SEQ) / 4, 256, 0, stream>>>(q, k, v, fcum, q); break;
        case 3: break;
        case 4: k_lru_gates<<<T * NHEADS, 64, 0, stream>>>(xr, cw, cb, wa, ba, wx, bx, lam, la, lu);
                k_lru_scan<<<(BATCH * LW + 63) / 64, 64, 0, stream>>>(la, lu, gr);
                k_ymix<<<2048, 256, 0, stream>>>(lu, q, ymix); break;
        case 5: { EpiArgs e{x1b, nullptr, nullptr, nullptr, nullptr, x, out}; k_gemm<2><<<dim3(DMODEL / 64, T / 64), 256, 0, stream>>>(ymix, wout_t, T, DMODEL, DMODEL, e); }
                k_sumsq<<<2048, 256, 0, stream>>>(out, sumsq); break;
        case 6: { EpiArgs e{qp, nullptr, nullptr, nullptr, nullptr, nullptr, nullptr}; k_gemm<3><<<dim3(QPW / 64, T / 64), 256, 0, stream>>>(x1b, wq_t, T, QPW, DMODEL, e); } break;
        case 7: k_peer<<<T, 64, 0, stream>>>(qp, skb, sumsq, ut, vt, fg, out); break;
        }
        ++p;
    }
}
```

```cpp
#include <hip/hip_runtime.h>
#include <hip/hip_bf16.h>
#include <cstdio>
#include <cstdint>
#include <cmath>

constexpr int BATCH = 4, SEQ = 8192, DMODEL = 1024, T = BATCH * SEQ;
constexpr int LW = 512, AW = 512, NHEADS = 8, HD = 64, INC = 2568, NG1 = 2560;
constexpr int PH = 8, NKEY = 128, PHALF = 128, TOPK = 16, NEXP = NKEY * NKEY, QPW = 2048;
constexpr float RMS_EPS = 1e-6f;
constexpr float LOG2E = 1.4426950408889634f;
constexpr float QSCALE = 0.125f * LOG2E;
constexpr size_t MiB = 1u << 20;
constexpr size_t WS_CTL = 0, CTL_ZERO_BYTES = 1 * MiB;
constexpr size_t WS_WIN = 2 * MiB, WS_WOUT = 8 * MiB, WS_WQ = 10 * MiB, WS_SKB = 14 * MiB, WS_WFL = 15 * MiB,
                 WS_LOGF = 16 * MiB, WS_FCUM = 17 * MiB, WS_CARRY = 18 * MiB, WS_SUMSQ = 19 * MiB, WS_WAX = 20 * MiB,
                 WS_H = 32 * MiB, WS_XR = 96 * MiB, WS_GR = 128 * MiB, WS_Q = 160 * MiB, WS_K = 192 * MiB, WS_V = 224 * MiB,
                 WS_X1B = 256 * MiB, WS_O = 256 * MiB  , WS_QP = 96 * MiB, WS_UT = 320 * MiB, WS_VT = 352 * MiB, WS_U8 = 320 * MiB, WS_V8 = 336 * MiB, WS_SU = 21 * MiB, WS_SV = 21 * MiB + 65536, WS_LA = 384 * MiB, WS_LU = 448 * MiB, WS_END = 512 * MiB;
constexpr size_t SPLIT_STRIDE = (WS_GR - WS_XR) / 2;
constexpr int CW_TMO = 0, CW_BAR = 4096;

namespace naive {
typedef unsigned short bf16;
__device__ __forceinline__ unsigned f2bf(float f) { unsigned u = __builtin_bit_cast(unsigned, f); return (u + 0x7fffu + ((u >> 16) & 1u)) >> 16; }
__device__ __forceinline__ float bf2f(unsigned short h) { return __builtin_bit_cast(float, (unsigned)h << 16); }
__device__ __forceinline__ float gelu_tanh(float x) { const float u = 0.7978845608028654f * (x + 0.044715f * x * x * x); return 0.5f * x * (1.f + tanhf(u)); }
__device__ __forceinline__ float sigmoidf_(float x) { return 1.f / (1.f + expf(-x)); }
__device__ __forceinline__ float wave_sum(float v) {
#pragma unroll
    for (int o = 1; o < 64; o <<= 1) v += __shfl_xor(v, o);
    return v;
}
__global__ void k_prep_w(const float* w_in, const float* w_out, const float* gn_l, const float* gn_f, const float* w_q, const float* g2, const float* sk,
                         bf16* win_t, float* wfl, bf16* wout_t, bf16* wq_t, bf16* skb) {
    const size_t gid = (size_t)blockIdx.x * blockDim.x + threadIdx.x, gsz = (size_t)gridDim.x * blockDim.x;
    for (size_t i = gid; i < (size_t)NG1 * DMODEL; i += gsz) { const int n = (int)(i / DMODEL), k = (int)(i % DMODEL); win_t[i] = (bf16)f2bf(w_in[(size_t)k * INC + n]); }
    for (size_t i = gid; i < (size_t)8 * DMODEL; i += gsz) { const int j = (int)(i / DMODEL), k = (int)(i % DMODEL); wfl[i] = w_in[(size_t)k * INC + NG1 + j]; }
    for (size_t i = gid; i < (size_t)DMODEL * DMODEL; i += gsz) { const int n = (int)(i / DMODEL), k = (int)(i % DMODEL); const float g = k < LW ? gn_l[k] : gn_f[k - LW]; wout_t[i] = (bf16)f2bf(g * w_out[(size_t)k * DMODEL + n]); }
    for (size_t i = gid; i < (size_t)QPW * DMODEL; i += gsz) { const int n = (int)(i / DMODEL), k = (int)(i % DMODEL); wq_t[i] = (bf16)f2bf(g2[k] * w_q[(size_t)k * QPW + n]); }
    for (size_t i = gid; i < (size_t)PH * 2 * NKEY * PHALF; i += gsz) skb[i] = (bf16)f2bf(sk[i]);
}
__global__ void k_prep_tab(const float* u, const float* v, const float* g2, bf16* ut, bf16* vt) {
    const size_t gid = (size_t)blockIdx.x * blockDim.x + threadIdx.x, gsz = (size_t)gridDim.x * blockDim.x;
    for (size_t i = gid; i < (size_t)NEXP * DMODEL; i += gsz) { const int d = (int)(i % DMODEL); ut[i] = (bf16)f2bf(g2[d] * u[i]); vt[i] = (bf16)f2bf(v[i]); }
}
__global__ void k_prep_x(const float* x, const float* g1, const float* wfl, const float* bfv, bf16* h, float* logf) {
    const int lane = threadIdx.x & 63, wv = (blockIdx.x * blockDim.x + threadIdx.x) >> 6, nw = (gridDim.x * blockDim.x) >> 6;
    for (int t = wv; t < T; t += nw) {
        float xv[16]; float ss = 0.f;
#pragma unroll
        for (int j = 0; j < 4; ++j) { const float4 v = *(const float4*)(x + (size_t)t * DMODEL + j * 256 + lane * 4); xv[4 * j] = v.x; xv[4 * j + 1] = v.y; xv[4 * j + 2] = v.z; xv[4 * j + 3] = v.w; ss += v.x * v.x + v.y * v.y + v.z * v.z + v.w * v.w; }
        const float rstd = rsqrtf(wave_sum(ss) * (1.f / DMODEL) + RMS_EPS);
#pragma unroll
        for (int j = 0; j < 4; ++j) { const float4 g = *(const float4*)(g1 + j * 256 + lane * 4); xv[4 * j] *= rstd * g.x; xv[4 * j + 1] *= rstd * g.y; xv[4 * j + 2] *= rstd * g.z; xv[4 * j + 3] *= rstd * g.w;
            uint2 o; o.x = f2bf(xv[4 * j]) | (f2bf(xv[4 * j + 1]) << 16); o.y = f2bf(xv[4 * j + 2]) | (f2bf(xv[4 * j + 3]) << 16); *(uint2*)(h + (size_t)t * DMODEL + j * 256 + lane * 4) = o; }
#pragma unroll
        for (int hh = 0; hh < 8; ++hh) { float a = 0.f;
#pragma unroll
            for (int j = 0; j < 4; ++j) { const float4 w = *(const float4*)(wfl + hh * DMODEL + j * 256 + lane * 4); a += xv[4 * j] * w.x + xv[4 * j + 1] * w.y + xv[4 * j + 2] * w.z + xv[4 * j + 3] * w.w; }
            a = wave_sum(a);
            if (lane == 0) { const float z = a + bfv[hh]; logf[(size_t)t * 8 + hh] = fminf(z, 0.f) - log1pf(expf(-fabsf(z))); } }
    }
}
__global__ void k_fcum(const float* logf, float* fcum) {
    const int lane = threadIdx.x & 63, bh = blockIdx.x, b = bh / NHEADS, hh = bh % NHEADS;
    float loc = 0.f;
    for (int i = 0; i < 128; ++i) loc += logf[((size_t)b * SEQ + lane * 128 + i) * 8 + hh];
    float inc = loc;
#pragma unroll
    for (int o = 1; o < 64; o <<= 1) { const float n = __shfl_up(inc, o); if (lane >= o) inc += n; }
    float run = inc - loc;
    for (int i = 0; i < 128; ++i) { run += logf[((size_t)b * SEQ + lane * 128 + i) * 8 + hh]; fcum[(size_t)bh * SEQ + lane * 128 + i] = run; }
}
struct EpiArgs { bf16* o0; bf16* o1; bf16* o2; bf16* o3; bf16* o4; const float* resid; float* outf; };
template <int EPI> __global__ void __launch_bounds__(256) k_gemm(const bf16* A, const bf16* Bt, int M, int N, int K, EpiArgs e) {
    __shared__ float As[32][65], Bs[32][65];
    const int tid = threadIdx.x, tx = tid & 15, ty = tid >> 4, m0 = blockIdx.y * 64, n0 = blockIdx.x * 64;
    float acc[4][4] = {};
    const int lr = tid >> 2, lc = (tid & 3) * 8;
    for (int k0 = 0; k0 < K; k0 += 32) {
        const uint4 av = *(const uint4*)(A + (size_t)(m0 + lr) * K + k0 + lc), bv = *(const uint4*)(Bt + (size_t)(n0 + lr) * K + k0 + lc);
        const unsigned aw[4] = {av.x, av.y, av.z, av.w}, bw[4] = {bv.x, bv.y, bv.z, bv.w};
#pragma unroll
        for (int i = 0; i < 4; ++i) { As[lc + 2 * i][lr] = bf2f(aw[i] & 0xffff); As[lc + 2 * i + 1][lr] = bf2f(aw[i] >> 16); Bs[lc + 2 * i][lr] = bf2f(bw[i] & 0xffff); Bs[lc + 2 * i + 1][lr] = bf2f(bw[i] >> 16); }
        __syncthreads();
#pragma unroll 8
        for (int k = 0; k < 32; ++k) { float a[4], b[4];
#pragma unroll
            for (int i = 0; i < 4; ++i) { a[i] = As[k][ty * 4 + i]; b[i] = Bs[k][tx * 4 + i]; }
#pragma unroll
            for (int i = 0; i < 4; ++i)
#pragma unroll
                for (int j = 0; j < 4; ++j) acc[i][j] += a[i] * b[j]; }
        __syncthreads();
    }
#pragma unroll
    for (int i = 0; i < 4; ++i)
#pragma unroll
        for (int j = 0; j < 4; ++j) { const int m = m0 + ty * 4 + i, n = n0 + tx * 4 + j; const float v = acc[i][j];
            if (EPI == 1) { const int s = n >> 9, c = n & 511; bf16* o = s == 0 ? e.o0 : s == 1 ? e.o1 : s == 2 ? e.o2 : s == 3 ? e.o3 : e.o4;
                const float w = s == 1 ? gelu_tanh(v) : s == 2 ? v * QSCALE : v; o[(size_t)m * 512 + c] = (bf16)f2bf(w); }
            else if (EPI == 2) { const float r = e.resid[(size_t)m * DMODEL + n] + v; e.outf[(size_t)m * DMODEL + n] = r; e.o0[(size_t)m * DMODEL + n] = (bf16)f2bf(r); }
            else { e.o0[(size_t)m * N + n] = (bf16)f2bf(v); } }
}
__global__ void k_sumsq(const float* x1, float* sumsq) {
    const int lane = threadIdx.x & 63, wv = (blockIdx.x * blockDim.x + threadIdx.x) >> 6, nw = (gridDim.x * blockDim.x) >> 6;
    for (int t = wv; t < T; t += nw) { float ss = 0.f;
#pragma unroll
        for (int j = 0; j < 4; ++j) { const float4 v = *(const float4*)(x1 + (size_t)t * DMODEL + j * 256 + lane * 4); ss += v.x * v.x + v.y * v.y + v.z * v.z + v.w * v.w; }
        ss = wave_sum(ss); if (lane == 0) sumsq[t] = ss; }
}
__global__ void k_lru_gates(const bf16* xr, const float* cw, const float* cb, const float* wa, const float* ba, const float* wx, const float* bx, const float* lam, float* la, float* lu) {
    __shared__ float xc[64];
    const int j = threadIdx.x, t = blockIdx.x / NHEADS, hh = blockIdx.x % NHEADS, ch = hh * 64 + j, s = t % SEQ;
    float c = cb[ch];
#pragma unroll
    for (int k = 0; k < 4; ++k) { const int ss = s - 3 + k; if (ss >= 0) c += cw[k * LW + ch] * bf2f(xr[(size_t)(t - 3 + k) * LW + ch]); }
    xc[j] = c; __syncthreads();
    float r = ba[ch], ii = bx[ch];
    for (int i = 0; i < 64; ++i) { const float xv = xc[i]; r += xv * wa[(size_t)(hh * 64 + i) * 64 + j]; ii += xv * wx[(size_t)(hh * 64 + i) * 64 + j]; }
    r = sigmoidf_(r); ii = sigmoidf_(ii);
    const float l = lam[ch], sp = fmaxf(-l, 0.f) + log1pf(expf(-fabsf(l)));
    const float log_a = -8.f * r * sp, a = expf(log_a), u = sqrtf(-expm1f(2.f * log_a)) * (ii * c);
    la[(size_t)t * LW + ch] = a; lu[(size_t)t * LW + ch] = u;
}
__global__ void k_lru_scan(const float* la, float* lu, const bf16* gr) {
    const int id = blockIdx.x * blockDim.x + threadIdx.x; if (id >= BATCH * LW) return;
    const int b = id / LW, ch = id % LW; float h = 0.f;
    for (int s = 0; s < SEQ; ++s) { const size_t o = ((size_t)b * SEQ + s) * LW + ch; h = la[o] * h + lu[o]; lu[o] = h * bf2f(gr[o]); }
}
__global__ void k_ymix(const float* ylru, const bf16* o, bf16* ymix) {
    const int lane = threadIdx.x & 63, wv = (blockIdx.x * blockDim.x + threadIdx.x) >> 6, nw = (gridDim.x * blockDim.x) >> 6;
    for (int t = wv; t < T; t += nw) {
        float a[8], f[8]; float sa = 0.f, sf = 0.f;
#pragma unroll
        for (int i = 0; i < 8; ++i) { a[i] = ylru[(size_t)t * LW + i * 64 + lane]; f[i] = bf2f(o[(size_t)t * AW + i * 64 + lane]); sa += a[i] * a[i]; sf += f[i] * f[i]; }
        const float ra = rsqrtf(wave_sum(sa) * (1.f / LW) + RMS_EPS), rf = rsqrtf(wave_sum(sf) * (1.f / AW) + RMS_EPS);
#pragma unroll
        for (int i = 0; i < 8; ++i) { ymix[(size_t)t * DMODEL + i * 64 + lane] = (bf16)f2bf(a[i] * ra); ymix[(size_t)t * DMODEL + LW + i * 64 + lane] = (bf16)f2bf(f[i] * rf); }
    }
}
__global__ void __launch_bounds__(256) k_attn(const bf16* Q, const bf16* K, const bf16* V, const float* fcum, bf16* O) {
    const int lane = threadIdx.x & 63, wv = (blockIdx.x * blockDim.x + threadIdx.x) >> 6;
    const int q = wv % SEQ, bh = wv / SEQ, b = bh / NHEADS, hh = bh % NHEADS;
    const size_t rowq = (size_t)b * SEQ + q;
    float qv[64];
#pragma unroll
    for (int i = 0; i < 8; ++i) { const uint4 w = *(const uint4*)(Q + rowq * AW + hh * 64 + i * 8); const unsigned ww[4] = {w.x, w.y, w.z, w.w};
#pragma unroll
        for (int c = 0; c < 4; ++c) { qv[i * 8 + 2 * c] = bf2f(ww[c] & 0xffff); qv[i * 8 + 2 * c + 1] = bf2f(ww[c] >> 16); } }
    const float fq = fcum[(size_t)bh * SEQ + q];
    float m = -INFINITY, l = 0.f; float o[64];
#pragma unroll
    for (int d = 0; d < 64; ++d) o[d] = 0.f;
    for (int j = lane; j <= q; j += 64) {
        const size_t rowk = (size_t)b * SEQ + j; float s = 0.f;
#pragma unroll
        for (int i = 0; i < 8; ++i) { const uint4 w = *(const uint4*)(K + rowk * AW + hh * 64 + i * 8); const unsigned ww[4] = {w.x, w.y, w.z, w.w};
#pragma unroll
            for (int c = 0; c < 4; ++c) { s += qv[i * 8 + 2 * c] * bf2f(ww[c] & 0xffff) + qv[i * 8 + 2 * c + 1] * bf2f(ww[c] >> 16); } }
        s += (fq - fcum[(size_t)bh * SEQ + j]) * LOG2E;
        const float mn = fmaxf(m, s), sc = exp2f(m - mn), p = exp2f(s - mn);
        l = l * sc + p; m = mn;
#pragma unroll
        for (int i = 0; i < 8; ++i) { const uint4 w = *(const uint4*)(V + rowk * AW + hh * 64 + i * 8); const unsigned ww[4] = {w.x, w.y, w.z, w.w};
#pragma unroll
            for (int c = 0; c < 4; ++c) { o[i * 8 + 2 * c] = o[i * 8 + 2 * c] * sc + p * bf2f(ww[c] & 0xffff); o[i * 8 + 2 * c + 1] = o[i * 8 + 2 * c + 1] * sc + p * bf2f(ww[c] >> 16); } }
    }
    float mall = m;
#pragma unroll
    for (int of = 1; of < 64; of <<= 1) mall = fmaxf(mall, __shfl_xor(mall, of));
    const float sc = (m == -INFINITY) ? 0.f : exp2f(m - mall);
    const float lt = wave_sum(l * sc); const float inv = 1.f / lt;
    float mine = 0.f;
#pragma unroll
    for (int d = 0; d < 64; ++d) { const float v = wave_sum(o[d] * sc); if (lane == d) mine = v; }
    O[rowq * AW + hh * 64 + lane] = (bf16)f2bf(mine * inv);
}
__device__ __forceinline__ void wave_argmax(float v, int idx, float& bv, int& bi) {
#pragma unroll
    for (int o = 1; o < 64; o <<= 1) { const float ov = __shfl_xor(v, o); const int oi = __shfl_xor(idx, o); if (ov > v || (ov == v && oi < idx)) { v = ov; idx = oi; } }
    bv = v; bi = idx;
}
__global__ void __launch_bounds__(64) k_peer(const bf16* qp, const bf16* skb, const float* sumsq, const bf16* ut, const bf16* vt, const float* fg, float* out) {
    __shared__ float qs[2048]; __shared__ float sc[256]; __shared__ float s1[16], s2[16]; __shared__ int i1[16], i2[16]; __shared__ int ex[128]; __shared__ float gt[128];
    const int lane = threadIdx.x, t = blockIdx.x;
    const float rstd2 = rsqrtf(sumsq[t] * (1.f / DMODEL) + RMS_EPS);
    for (int i = lane; i < 2048; i += 64) qs[i] = bf2f(qp[(size_t)t * 2048 + i]) * rstd2;
    __syncthreads();
    for (int hh = 0; hh < PH; ++hh) {
        for (int r = 0; r < 4; ++r) { const int idx = r * 64 + lane, p = idx >> 7, n = idx & 127; const bf16* kr = skb + ((size_t)(hh * 2 + p) * NKEY + n) * PHALF; const float* qq = qs + hh * 256 + p * 128;
            float a = 0.f; for (int c = 0; c < 128; ++c) a += qq[c] * bf2f(kr[c]); sc[idx] = a; }
        __syncthreads();
        for (int p = 0; p < 2; ++p) {
            float v0 = sc[p * 128 + lane], v1 = sc[p * 128 + 64 + lane];
            for (int k = 0; k < 16; ++k) { float v; int id; if (v0 >= v1) { v = v0; id = lane; } else { v = v1; id = lane + 64; }
                float bv; int bi; wave_argmax(v, id, bv, bi);
                if (lane == 0) { if (p == 0) { s1[k] = bv; i1[k] = bi; } else { s2[k] = bv; i2[k] = bi; } }
                if (bi == lane) v0 = -INFINITY; if (bi == lane + 64) v1 = -INFINITY; }
        }
        __syncthreads();
        float cv[4];
#pragma unroll
        for (int r = 0; r < 4; ++r) { const int idx = r * 64 + lane; cv[r] = s1[idx >> 4] + s2[idx & 15]; }
        float tops = 0.f; int topp = 0;
        for (int k = 0; k < 16; ++k) { float v = cv[0]; int id = lane;
#pragma unroll
            for (int r = 1; r < 4; ++r) if (cv[r] > v) { v = cv[r]; id = r * 64 + lane; }
            float bv; int bi; wave_argmax(v, id, bv, bi);
            if (lane == k) { tops = bv; topp = bi; }
#pragma unroll
            for (int r = 0; r < 4; ++r) if (bi == r * 64 + lane) cv[r] = -INFINITY; }
        float mx = lane < 16 ? tops : -INFINITY;
#pragma unroll
        for (int o = 1; o < 64; o <<= 1) mx = fmaxf(mx, __shfl_xor(mx, o));
        const float ev = lane < 16 ? expf(tops - mx) : 0.f; const float den = wave_sum(ev);
        if (lane < 16) { ex[hh * 16 + lane] = i1[topp >> 4] * NKEY + i2[topp & 15]; gt[hh * 16 + lane] = ev / den; }
        __syncthreads();
    }
    float hv[16], y[16];
    const float* x1 = out + (size_t)t * DMODEL;
#pragma unroll
    for (int j = 0; j < 4; ++j) { const float4 v = *(const float4*)(x1 + j * 256 + lane * 4); hv[4 * j] = v.x * rstd2; hv[4 * j + 1] = v.y * rstd2; hv[4 * j + 2] = v.z * rstd2; hv[4 * j + 3] = v.w * rstd2; }
#pragma unroll
    for (int i = 0; i < 16; ++i) y[i] = 0.f;
    for (int k = 0; k < 128; ++k) { const int e = ex[k]; const float g = gt[k]; float a = 0.f;
#pragma unroll
        for (int j = 0; j < 4; ++j) { const uint2 w = *(const uint2*)(ut + (size_t)e * DMODEL + j * 256 + lane * 4);
            a += hv[4 * j] * bf2f(w.x & 0xffff) + hv[4 * j + 1] * bf2f(w.x >> 16) + hv[4 * j + 2] * bf2f(w.y & 0xffff) + hv[4 * j + 3] * bf2f(w.y >> 16); }
        a = wave_sum(a); const float act = gelu_tanh(a) * g;
#pragma unroll
        for (int j = 0; j < 4; ++j) { const uint2 w = *(const uint2*)(vt + (size_t)e * DMODEL + j * 256 + lane * 4);
            y[4 * j] += act * bf2f(w.x & 0xffff); y[4 * j + 1] += act * bf2f(w.x >> 16); y[4 * j + 2] += act * bf2f(w.y & 0xffff); y[4 * j + 3] += act * bf2f(w.y >> 16); } }
    float ss = 0.f;
#pragma unroll
    for (int j = 0; j < 4; ++j) { const float4 v = *(const float4*)(x1 + j * 256 + lane * 4); y[4 * j] += v.x; y[4 * j + 1] += v.y; y[4 * j + 2] += v.z; y[4 * j + 3] += v.w; }
#pragma unroll
    for (int i = 0; i < 16; ++i) ss += y[i] * y[i];
    const float rs = rsqrtf(wave_sum(ss) * (1.f / DMODEL) + RMS_EPS);
#pragma unroll
    for (int j = 0; j < 4; ++j) { const float4 g = *(const float4*)(fg + j * 256 + lane * 4); float4 o; o.x = y[4 * j] * rs * g.x; o.y = y[4 * j + 1] * rs * g.y; o.z = y[4 * j + 2] * rs * g.z; o.w = y[4 * j + 3] * rs * g.w;
        *(float4*)(out + (size_t)t * DMODEL + j * 256 + lane * 4) = o; }
}
}

namespace pg8 {
#define PG8_LAS __attribute__((address_space(3)))
typedef unsigned short bf16_t;
typedef short bf16x8 __attribute__((ext_vector_type(8)));
typedef float f32x4 __attribute__((ext_vector_type(4)));
typedef unsigned u32x4 __attribute__((ext_vector_type(4)));
constexpr int BM = 256, BK = 64, HALF = 128, HTB = HALF * BK * 2  , STAGE_BYTES = 8 * HTB, NXCD = 8, WGM = 8;

__host__ __device__ __forceinline__ int lds_byte(int r, int c) { const int st = (r >> 4) * 2 + (c >> 5), rr = r & 15, cc = c & 31, ob = rr * 64 + cc * 2; return st * 1024 + (ob ^ (((ob >> 9) & 1) << 5)); }
__host__ __device__ __forceinline__ void stage_rc(int b, int& R, int& C) { const int st = b / 1024, sb = b % 1024, swz = sb ^ (((sb >> 9) & 1) << 5); R = (st >> 1) * 16 + swz / 64; C = (st & 1) * 32 + (swz % 64) / 2; }
__host__ __device__ __forceinline__ int perm32(int rho) { const int n = rho >> 4, i = rho & 15; return 8 * (i >> 2) + 4 * n + (i & 3); }

struct Unit { int pm, pn; };
struct Gemm { const bf16_t* A; const bf16_t* Bt; int M, N, K; };

struct StaticOrder {
    int nM, nN, nwg, G, c;
    __host__ __device__ void init(int M, int N, int G_, int c_) { nM = M / BM; nN = N / BM; nwg = nM * nN; G = G_; c = c_; }
    __host__ __device__ bool next(int i, Unit& u) const {
        const long L = (long)i * G + c; if (L >= nwg) return false;
        int wgid = (int)L; { const int q = nwg / NXCD, r = nwg % NXCD, xcd = wgid % NXCD, off = wgid / NXCD; wgid = (xcd < r ? xcd * (q + 1) : r * (q + 1) + (xcd - r) * q) + off; }
        const int nig = WGM * nN, gid = wgid / nig, fm = gid * WGM, gsz = (nM - fm) < WGM ? (nM - fm) : WGM;
        u.pm = fm + ((wgid % nig) % gsz); u.pn = (wgid % nig) / gsz; return true;
    }
    __device__ __forceinline__ void a_ready(const Unit&) const {}
    __device__ __forceinline__ void done(const Unit&) const {}
};

__device__ __forceinline__ unsigned cvt_pk_bf16(float lo, float hi) { unsigned r; asm volatile("v_cvt_pk_bf16_f32 %0, %1, %2" : "=v"(r) : "v"(lo), "v"(hi)); return r; }
typedef unsigned u32x2 __attribute__((ext_vector_type(2)));
__device__ __forceinline__ float gelu_fast(float x) {
    const float u2 = x * (1.5957691216057308f + 0.07135481627f * x * x);
    return x * __builtin_amdgcn_rcpf(1.f + __builtin_amdgcn_exp2f(-1.4426950408889634f * u2));
}
struct EpiG1 {
    static constexpr bool PERM = true, AFTER_DRAIN = false;
    bf16_t* base0; size_t split_stride; float qscale;
    __device__ __forceinline__ void operator()(const f32x4 (&acc)[2][2][4][2], const Unit& u, int wr, int wc, int fr, int fq) const {
        const int s = u.pn >> 1; bf16_t* base = base0 + (size_t)s * split_stride;
        const int row0 = u.pm * BM + wr * 64 + fr, col0 = (u.pn & 1) * 256 + wc * 32 + 8 * fq;
#pragma unroll
        for (int ai = 0; ai < 2; ++ai)
#pragma unroll
            for (int m = 0; m < 4; ++m) { bf16_t* rowp = base + (size_t)(row0 + ai * HALF + m * 16) * 512 + col0;
#pragma unroll
                for (int bj = 0; bj < 2; ++bj) { f32x4 v0 = acc[ai][bj][m][0], v1 = acc[ai][bj][m][1];
                    if (s == 1) {
#pragma unroll
                        for (int e = 0; e < 4; ++e) { v0[e] = gelu_fast(v0[e]); v1[e] = gelu_fast(v1[e]); } }
                    else if (s == 2) { v0 = v0 * qscale; v1 = v1 * qscale; }
                    u32x4 w; w.x = cvt_pk_bf16(v0[0], v0[1]); w.y = cvt_pk_bf16(v0[2], v0[3]); w.z = cvt_pk_bf16(v1[0], v1[1]); w.w = cvt_pk_bf16(v1[2], v1[3]);
                    *(u32x4*)(rowp + bj * HALF) = w; } }
    }
};
struct EpiG2 {
    static constexpr bool PERM = false, AFTER_DRAIN = false;
    const float* resid; float* out; bf16_t* xb; float* sumsq; int ldc;
    __device__ __forceinline__ void operator()(const f32x4 (&acc)[2][2][4][2], const Unit& u, int wr, int wc, int fr, int fq) const {
        const int row0 = u.pm * BM + wr * 64 + fr, col0 = u.pn * BM + wc * 32 + 4 * fq;
#pragma unroll
        for (int ai = 0; ai < 2; ++ai)
#pragma unroll
            for (int m = 0; m < 4; ++m) { const int r = row0 + ai * HALF + m * 16; const size_t off = (size_t)r * ldc + col0; float ss = 0.f;
#pragma unroll
                for (int bj = 0; bj < 2; ++bj)
#pragma unroll
                    for (int n = 0; n < 2; ++n) { const f32x4 x = *(const f32x4*)(resid + off + bj * HALF + n * 16) + acc[ai][bj][m][n];
                        *(f32x4*)(out + off + bj * HALF + n * 16) = x; ss += (x[0] * x[0] + x[1] * x[1]) + (x[2] * x[2] + x[3] * x[3]);
                        u32x2 w; w.x = cvt_pk_bf16(x[0], x[1]); w.y = cvt_pk_bf16(x[2], x[3]); *(u32x2*)(xb + off + bj * HALF + n * 16) = w; }
                ss += __shfl_xor(ss, 16); ss += __shfl_xor(ss, 32);
                if (fq == 0) atomicAdd(sumsq + r, ss);
                asm volatile("" ::: "memory"); }
    }
};
struct EpiG3 {
    static constexpr bool PERM = true, AFTER_DRAIN = false;
    bf16_t* O; int ldc;
    __device__ __forceinline__ void operator()(const f32x4 (&acc)[2][2][4][2], const Unit& u, int wr, int wc, int fr, int fq) const {
        const int row0 = u.pm * BM + wr * 64 + fr, col0 = u.pn * BM + wc * 32 + 8 * fq;
#pragma unroll
        for (int ai = 0; ai < 2; ++ai)
#pragma unroll
            for (int m = 0; m < 4; ++m) { bf16_t* rowp = O + (size_t)(row0 + ai * HALF + m * 16) * ldc + col0;
#pragma unroll
                for (int bj = 0; bj < 2; ++bj) { const f32x4 v0 = acc[ai][bj][m][0], v1 = acc[ai][bj][m][1];
                    u32x4 w; w.x = cvt_pk_bf16(v0[0], v0[1]); w.y = cvt_pk_bf16(v0[2], v0[3]); w.z = cvt_pk_bf16(v1[0], v1[1]); w.w = cvt_pk_bf16(v1[2], v1[3]);
                    *(u32x4*)(rowp + bj * HALF) = w; } }
    }
};

template <class Epi, class Sched, bool ALIGN_EPI = false, bool SP2 = false>
__device__ __forceinline__ void gemm_phase(PG8_LAS unsigned char* lds, const Gemm g, const Sched& S, const Epi& E, int wid_in) {
    const int wid = __builtin_amdgcn_readfirstlane(wid_in), lane = (int)__builtin_amdgcn_mbcnt_hi(~0u, __builtin_amdgcn_mbcnt_lo(~0u, 0u)), tid = wid * 64 + lane, wr = wid >> 2, wc = wid & 3, fr = lane & 15, fq = lane >> 4;
    const int K = g.K, nt = K / BK;
    unsigned voffA[2], voffB[2];
#pragma unroll
    for (int i = 0; i < 2; ++i) { int R, C; stage_rc(tid * 16 + i * 8192, R, C); const int Rb = Epi::PERM ? ((R & ~31) + perm32(R & 31)) : R;
        voffA[i] = (unsigned)(R * K + C) * 2u; voffB[i] = (unsigned)(Rb * K + C) * 2u; }
    const size_t kstep = (size_t)(BK * 2);
    const size_t hstep = (size_t)HALF * K * 2;
    const size_t tstep = 2 * hstep;
    const unsigned ldsw = (unsigned)wid * 1024u;
    const int aoff = lds_byte(wr * 64 + fr, fq * 8), boff = lds_byte(wc * 32 + fr, fq * 8);
#define PG8_SA(b, h) (((b) * 2 + (h)) * HTB)
#define PG8_SB(b, h) ((4 + (b) * 2 + (h)) * HTB)
#define PG8_STAGE(bufoff, gbase, voff) do { _Pragma("unroll") for (int _i = 0; _i < 2; ++_i) \
        __builtin_amdgcn_global_load_lds((const unsigned*)((const char*)(gbase) + (voff)[_i]), (PG8_LAS unsigned*)(lds + (bufoff) + ldsw + _i * 8192), 16, 0, 0); } while (0)
#define PG8_LDA(dst, b, h) do { _Pragma("unroll") for (int m = 0; m < 4; ++m) _Pragma("unroll") for (int k = 0; k < 2; ++k) dst[m][k] = *(const PG8_LAS bf16x8*)(lds + PG8_SA(b, h) + aoff + m * 2048 + k * 1024); } while (0)
#define PG8_LDB(dst, b, h) do { _Pragma("unroll") for (int n = 0; n < 2; ++n) _Pragma("unroll") for (int k = 0; k < 2; ++k) dst[n][k] = *(const PG8_LAS bf16x8*)(lds + PG8_SB(b, h) + boff + n * 2048 + k * 1024); } while (0)
#define PG8_MMA(ai, bj, At, Bt) do { __builtin_amdgcn_s_setprio(1); _Pragma("unroll") for (int m = 0; m < 4; ++m) _Pragma("unroll") for (int n = 0; n < 2; ++n) _Pragma("unroll") for (int k = 0; k < 2; ++k) \
        acc[ai][bj][m][n] = __builtin_amdgcn_mfma_f32_16x16x32_bf16(Bt[n][k], At[m][k], acc[ai][bj][m][n], 0, 0, 0); __builtin_amdgcn_s_setprio(0); } while (0)
#define PG8_WAIT_V(n) asm volatile("s_waitcnt vmcnt(" #n ")" ::: "memory")
#define PG8_WAIT_L(n) asm volatile("s_waitcnt lgkmcnt(" #n ")" ::: "memory")
#define PG8_BAR __builtin_amdgcn_s_barrier()
#define PG8_SCHED __builtin_amdgcn_sched_barrier(0)
    Unit cur, nxt; int ui = 0;
    if (!S.next(0, cur)) return;
    f32x4 acc[2][2][4][2];
#pragma unroll
    for (int a = 0; a < 2; ++a)
#pragma unroll
        for (int b = 0; b < 2; ++b)
#pragma unroll
            for (int m = 0; m < 4; ++m)
#pragma unroll
                for (int n = 0; n < 2; ++n) acc[a][b][m][n] = (f32x4){0.f, 0.f, 0.f, 0.f};
    bf16x8 At[4][2], B0[2][2], B1[2][2];
    const char* cA = (const char*)g.A + (size_t)cur.pm * tstep; const char* cB = (const char*)g.Bt + (size_t)cur.pn * tstep;
    S.a_ready(cur);
    if constexpr (SP2) {
        PG8_STAGE(PG8_SB(0, 0), cB, voffB); PG8_STAGE(PG8_SB(0, 1), cB + hstep, voffB); PG8_STAGE(PG8_SA(0, 0), cA, voffA); PG8_STAGE(PG8_SA(0, 1), cA + hstep, voffA);
        if (wr == 1) PG8_BAR;
        PG8_WAIT_V(2); PG8_BAR;
        PG8_STAGE(PG8_SB(1, 0), cB + kstep, voffB); PG8_STAGE(PG8_SA(1, 0), cA + kstep, voffA); PG8_STAGE(PG8_SB(1, 1), cB + hstep + kstep, voffB);
        PG8_WAIT_V(6); PG8_BAR;
    } else {
        PG8_STAGE(PG8_SB(0, 0), cB, voffB); PG8_STAGE(PG8_SA(0, 0), cA, voffA); PG8_STAGE(PG8_SB(0, 1), cB + hstep, voffB); PG8_STAGE(PG8_SA(0, 1), cA + hstep, voffA);
        if (wr == 1) PG8_BAR;
        PG8_WAIT_V(4); PG8_BAR;
        PG8_STAGE(PG8_SB(1, 0), cB + kstep, voffB); PG8_STAGE(PG8_SA(1, 0), cA + kstep, voffA); PG8_STAGE(PG8_SB(1, 1), cB + hstep + kstep, voffB);
        PG8_WAIT_V(6); PG8_BAR;
    }
    for (;;) {
        const bool has_next = S.next(ui + 1, nxt);
        const char* nA = has_next ? (const char*)g.A + (size_t)nxt.pm * tstep : cA; const char* nB = has_next ? (const char*)g.Bt + (size_t)nxt.pn * tstep : cB;
        for (int t = 0; t < nt; t += 2) {
            const bool last = (t == nt - 2);
            const char* a1 = cA + (size_t)(t + 1) * kstep;
            const char* a2 = last ? nA : cA + (size_t)(t + 2) * kstep; const char* b2 = last ? nB : cB + (size_t)(t + 2) * kstep;
            const char* a3 = a2 + kstep; const char* b3 = b2 + kstep;
            if (last && has_next) S.a_ready(nxt);
            if constexpr (SP2) {
            PG8_LDB(B0, 0, 0); PG8_LDB(B1, 0, 1); PG8_SCHED; PG8_LDA(At, 0, 0); PG8_STAGE(PG8_SA(1, 1), a1 + hstep, voffA);
            PG8_WAIT_V(8); PG8_WAIT_L(0); PG8_BAR; PG8_MMA(0, 0, At, B0); PG8_MMA(0, 1, At, B1); PG8_BAR; PG8_SCHED;
            PG8_LDA(At, 0, 1); PG8_STAGE(PG8_SB(0, 0), b2, voffB); PG8_STAGE(PG8_SB(0, 1), b2 + hstep, voffB); PG8_STAGE(PG8_SA(0, 0), a2, voffA);
            PG8_WAIT_V(8); PG8_WAIT_L(0); PG8_BAR; PG8_MMA(1, 0, At, B0); PG8_MMA(1, 1, At, B1); PG8_BAR; PG8_SCHED;
            PG8_LDB(B0, 1, 0); PG8_LDB(B1, 1, 1); PG8_SCHED; PG8_LDA(At, 1, 0); PG8_STAGE(PG8_SA(0, 1), a2 + hstep, voffA);
            PG8_WAIT_V(8); PG8_WAIT_L(0); PG8_BAR; PG8_MMA(0, 0, At, B0); PG8_MMA(0, 1, At, B1); PG8_BAR; PG8_SCHED;
            PG8_LDA(At, 1, 1); PG8_STAGE(PG8_SB(1, 0), b3, voffB); PG8_STAGE(PG8_SB(1, 1), b3 + hstep, voffB); PG8_STAGE(PG8_SA(1, 0), a3, voffA);
            PG8_WAIT_V(8); PG8_WAIT_L(0); PG8_BAR; PG8_MMA(1, 0, At, B0); PG8_MMA(1, 1, At, B1); PG8_BAR; PG8_SCHED;
            } else {
            PG8_LDB(B0, 0, 0); PG8_SCHED; PG8_LDA(At, 0, 0); PG8_STAGE(PG8_SA(1, 1), a1 + hstep, voffA);
            PG8_WAIT_L(8); PG8_BAR; PG8_WAIT_L(0); PG8_MMA(0, 0, At, B0); PG8_BAR; PG8_SCHED;
            PG8_LDB(B1, 0, 1); PG8_STAGE(PG8_SB(0, 0), b2, voffB);
            PG8_BAR; PG8_WAIT_L(0); PG8_MMA(0, 1, At, B1); PG8_BAR;
            PG8_LDA(At, 0, 1); PG8_STAGE(PG8_SA(0, 0), a2, voffA);
            PG8_BAR; PG8_WAIT_L(0); PG8_MMA(1, 0, At, B0); PG8_BAR; PG8_SCHED;
            PG8_STAGE(PG8_SB(0, 1), b2 + hstep, voffB);
            PG8_WAIT_V(6); PG8_BAR; PG8_MMA(1, 1, At, B1); PG8_BAR;
            PG8_LDB(B0, 1, 0); PG8_SCHED; PG8_LDA(At, 1, 0); PG8_STAGE(PG8_SA(0, 1), a2 + hstep, voffA);
            PG8_WAIT_L(8); PG8_BAR; PG8_WAIT_L(0); PG8_MMA(0, 0, At, B0); PG8_BAR; PG8_SCHED;
            PG8_LDB(B1, 1, 1); PG8_STAGE(PG8_SB(1, 0), b3, voffB);
            PG8_BAR; PG8_WAIT_L(0); PG8_MMA(0, 1, At, B1); PG8_BAR;
            PG8_LDA(At, 1, 1); PG8_STAGE(PG8_SA(1, 0), a3, voffA);
            PG8_BAR; PG8_WAIT_L(0); PG8_MMA(1, 0, At, B0); PG8_BAR; PG8_SCHED;
            PG8_STAGE(PG8_SB(1, 1), b3 + hstep, voffB);
            PG8_WAIT_V(6); PG8_BAR; PG8_MMA(1, 1, At, B1); PG8_BAR;
            }
        }
        if constexpr (ALIGN_EPI) { if (wr == 0) PG8_BAR; }
        if constexpr (!Epi::AFTER_DRAIN) { E(acc, cur, wr, wc, fr, fq); S.done(cur); }
        if (!has_next) break;
#pragma unroll
        for (int a = 0; a < 2; ++a)
#pragma unroll
            for (int b = 0; b < 2; ++b)
#pragma unroll
                for (int m = 0; m < 4; ++m)
#pragma unroll
                    for (int n = 0; n < 2; ++n) acc[a][b][m][n] = (f32x4){0.f, 0.f, 0.f, 0.f};
        cur = nxt; cA = nA; cB = nB; ++ui;
        if constexpr (ALIGN_EPI) { if (wr == 1) PG8_BAR; }
    }
    PG8_WAIT_V(0);
    if constexpr (!ALIGN_EPI) { if (wr == 0) PG8_BAR; }
    PG8_BAR;
    if constexpr (Epi::AFTER_DRAIN) { E.fused(acc, cur, wr, wc, fr, fq, lds, wid, lane); S.done(cur); }
#undef PG8_SA
#undef PG8_SB
#undef PG8_STAGE
#undef PG8_LDA
#undef PG8_LDB
#undef PG8_MMA
#undef PG8_WAIT_V
#undef PG8_WAIT_L
#undef PG8_BAR
#undef PG8_SCHED
}
}
#include <hip/hip_bf16.h>
#include <cmath>
namespace attn_body {
using bf16=__hip_bfloat16;
using bf16x8=__attribute__((ext_vector_type(8)))short;
using s16x4=__attribute__((ext_vector_type(4)))short;
using f32x16=__attribute__((ext_vector_type(16)))float;
using u32x4=__attribute__((ext_vector_type(4)))unsigned;
constexpr int BATCH=4,NHEAD=8,SEQ=8192,D=64,DM=NHEAD*D;
constexpr int NW=8,QBLK=32,QB=QBLK*NW,KVBLK=64,NQB=SEQ/QB;
constexpr int ATTN_PITCH=DM, ATTN_UNIT_ROWS=QB;
__device__ __forceinline__ int crow(int r,int hi){return (r&3)+8*(r>>2)+4*hi;}
#define SBAR() __builtin_amdgcn_sched_barrier(0)
__device__ __forceinline__ void cmask(f32x16&p0,f32x16&p1,int jb,int qrel,int hi){
  const float NEG=-INFINITY; int kb=64*jb+4*hi;
  #pragma unroll
  for(int r=0;r<16;++r){int kv=kb+(r&3)+8*(r>>2); if(kv>qrel)p0[r]=NEG; if(kv+32>qrel)p1[r]=NEG;}
}

constexpr int NSLOT=3, SLOTB=8192;
constexpr int LDS_K=0, LDS_V=NSLOT*SLOTB, LDS_WS=2*NSLOT*SLOTB, LDS_OST=LDS_WS+NW*64*4, LDS_FK=LDS_OST+NW*4096, LDS_BYTES=LDS_FK+SEQ*4;
constexpr float C2=0.125f*1.4426950408889634f;
__device__ __forceinline__ void glds16(const void*gsrc,unsigned lds_dst){unsigned keep;
  asm volatile("s_mov_b32 %0, m0\n\ts_mov_b32 m0, %2\n\ts_nop 0\n\tglobal_load_lds_dwordx4 %1, off\n\ts_mov_b32 m0, %0":"=&s"(keep):"v"(gsrc),"s"(lds_dst):"memory");}
__device__ __forceinline__ float max3f(float a,float b,float c){float r;asm("v_max3_f32 %0, %1, %2, %3":"=v"(r):"v"(a),"v"(b),"v"(c));return r;}
__device__ __forceinline__ float max2f(float a,float b){float r;asm("v_max_f32_e32 %0, %1, %2":"=v"(r):"v"(a),"v"(b));return r;}
__device__ __forceinline__ float fadd_s(float a,float b){float r;asm("v_add_f32_e32 %0, %1, %2":"=v"(r):"v"(a),"v"(b));return r;}
__device__ __forceinline__ float fsub_s(float a,float b){float r;asm("v_sub_f32_e32 %0, %1, %2":"=v"(r):"v"(a),"v"(b));return r;}
typedef float f32x2_t __attribute__((ext_vector_type(2))); typedef __bf16 bf16x2_t __attribute__((ext_vector_type(2)));
__device__ __forceinline__ unsigned cvtpk_s(float lo,float hi){f32x2_t v={lo,hi};bf16x2_t b=__builtin_convertvector(v,bf16x2_t);return __builtin_bit_cast(unsigned,b);}
#define WAIT_BAR(N) asm volatile("s_waitcnt vmcnt(" #N ") lgkmcnt(0)\n\ts_barrier":::"memory")

__device__ __forceinline__ void qkt(f32x16&p0,f32x16&p1,const char*Kslot,const bf16x8*qr,int r32,int hi){
  const char*kb=Kslot+hi*1024+r32*16;
  #pragma unroll
  for(int d0=0;d0<4;++d0){
    const bf16x8 b0=*reinterpret_cast<const bf16x8*>(kb+d0*2048);
    const bf16x8 b1=*reinterpret_cast<const bf16x8*>(kb+d0*2048+512);
    p0=__builtin_amdgcn_mfma_f32_32x32x16_bf16(b0,qr[d0],p0,0,0,0);p1=__builtin_amdgcn_mfma_f32_32x32x16_bf16(b1,qr[d0],p1,0,0,0);}
}
typedef __attribute__((address_space(3))) const char* lds_cptr;
typedef short v4i16_t __attribute__((ext_vector_type(4)));
__device__ __forceinline__ void kload8(bf16x8*kf,lds_cptr kp){
  kf[0]=*(const __attribute__((address_space(3))) bf16x8*)(kp);      kf[1]=*(const __attribute__((address_space(3))) bf16x8*)(kp+512);
  kf[2]=*(const __attribute__((address_space(3))) bf16x8*)(kp+2048); kf[3]=*(const __attribute__((address_space(3))) bf16x8*)(kp+2560);
  kf[4]=*(const __attribute__((address_space(3))) bf16x8*)(kp+4096); kf[5]=*(const __attribute__((address_space(3))) bf16x8*)(kp+4608);
  kf[6]=*(const __attribute__((address_space(3))) bf16x8*)(kp+6144); kf[7]=*(const __attribute__((address_space(3))) bf16x8*)(kp+6656);
}
__device__ __forceinline__ void kload2(bf16x8*kf,lds_cptr kp,int j){ kf[2*j]=*(const __attribute__((address_space(3))) bf16x8*)(kp+j*2048); kf[2*j+1]=*(const __attribute__((address_space(3))) bf16x8*)(kp+j*2048+512); }
__device__ __forceinline__ s16x4 vtr(lds_cptr p){ return __builtin_bit_cast(s16x4,__builtin_amdgcn_ds_read_tr16_b64_v4i16((__attribute__((address_space(3))) v4i16_t*)p)); }
__device__ __forceinline__ float rowmax(const f32x16&p0,const f32x16&p1){
  float a=max3f(p0[0],p0[1],p1[0]),b=max3f(p0[2],p0[3],p1[1]);a=max3f(a,p1[2],p1[3]);
  #pragma unroll
  for(int r=4;r<16;r+=4){a=max3f(a,p0[r],p0[r+1]);b=max3f(b,p0[r+2],p0[r+3]);a=max3f(a,p1[r],p1[r+1]);b=max3f(b,p1[r+2],p1[r+3]);}
  const float m=max2f(a,b);
  auto rr=__builtin_amdgcn_permlane32_swap(__float_as_uint(m),__float_as_uint(m),false,false);
  return max2f(__uint_as_float(rr[0]),__uint_as_float(rr[1]));
}
__device__ __forceinline__ void pv(f32x16*o,int vb,bf16x8 pa0,bf16x8 pa1,bf16x8 pa2,bf16x8 pa3){
  #pragma unroll
  for(int d0=0;d0<2;++d0){s16x4 lo[4],hi[4];
    #pragma unroll
    for(int ks=0;ks<4;++ks){
      asm volatile("ds_read_b64_tr_b16 %0,%1 offset:%c2":"=&v"(lo[ks]):"v"(vb),"i"(d0*4096+ks*1024):"memory");
      asm volatile("ds_read_b64_tr_b16 %0,%1 offset:%c2":"=&v"(hi[ks]):"v"(vb),"i"(d0*4096+ks*1024+512):"memory");}
    asm volatile("s_waitcnt lgkmcnt(0)":::"memory");SBAR();
    #define PK(k) (bf16x8){lo[k][0],lo[k][1],lo[k][2],lo[k][3],hi[k][0],hi[k][1],hi[k][2],hi[k][3]}
    o[d0]=__builtin_amdgcn_mfma_f32_32x32x16_bf16(pa0,PK(0),o[d0],0,0,0);
    o[d0]=__builtin_amdgcn_mfma_f32_32x32x16_bf16(pa1,PK(1),o[d0],0,0,0);
    o[d0]=__builtin_amdgcn_mfma_f32_32x32x16_bf16(pa2,PK(2),o[d0],0,0,0);
    o[d0]=__builtin_amdgcn_mfma_f32_32x32x16_bf16(pa3,PK(3),o[d0],0,0,0);
    #undef PK
  }
}

#ifndef ATTN_STORE16
#define ATTN_STORE16(p,v) (*(u32x4*)(p)=(v))
#endif
template<int THRL> __device__ __forceinline__ void attn_unit(int b,int h,int qb,const bf16*Q,const bf16*__restrict__ K,const bf16*__restrict__ V,bf16*O,const float*__restrict__ Fc,char*shm,int wid_in){
  const int wid=__builtin_amdgcn_readfirstlane(wid_in); int lane_=(int)__builtin_amdgcn_mbcnt_hi(~0u,__builtin_amdgcn_mbcnt_lo(~0u,0u)); asm volatile("":"+v"(lane_));
  const int lane=lane_,tid=wid*64+lane,r32=lane&31,hi=lane>>5;
  const long rowbase=(long)b*SEQ; const int q0=qb*QB;
  const float*Fbh=Fc+(long)(b*NHEAD+h)*SEQ;
  { typedef float f32x4_t __attribute__((ext_vector_type(4))); __attribute__((address_space(3))) float*fk=(__attribute__((address_space(3))) float*)((__attribute__((address_space(3))) char*)shm+LDS_FK); const int n4=(q0+QB)/4;
    for(int i=tid;i<n4;i+=NW*64){ f32x4_t v=*(const f32x4_t*)(Fbh+4*i); v=v*(-1.4426950408889634f); *(__attribute__((address_space(3))) f32x4_t*)(fk+4*i)=v; } }
  float fq2=Fbh[q0+wid*QBLK+r32]*1.4426950408889634f; asm volatile("":"+v"(fq2));
  const bf16*Qw=Q+(rowbase+q0+wid*QBLK)*DM+h*D;
  const bf16*Kh=K+rowbase*DM+h*D,*Vh=V+rowbase*DM+h*D;
  const lds_cptr shm3=(lds_cptr)shm;
  const unsigned lds0=(unsigned)(uintptr_t)shm;
  float*wsf=(float*)(shm+LDS_WS)+wid*64;
  const bf16*ksrc=Kh+(long)lane*DM+wid*8;
  const bf16*vsrc=Vh+(long)(16*(wid&3)+(lane>>2))*DM+(wid>>2)*32+(lane&3)*8;
  const unsigned kdst=lds0+LDS_K+wid*1024, vdst=lds0+LDS_V+wid*1024;
  #define DMA_K(t,slot) glds16(ksrc+(long)(t)*KVBLK*DM,(unsigned)__builtin_amdgcn_readfirstlane(kdst+(slot)))
  #define DMA_V(t,slot) glds16(vsrc+(long)(t)*KVBLK*DM,(unsigned)__builtin_amdgcn_readfirstlane(vdst+(slot)))
  const int vb0=(int)(lds0+LDS_V)+((lane>>4)&1)*32+(lane&3)*8+(4*hi+((lane&15)>>2))*64;
  const char*Kbase=shm+LDS_K; bf16x8 kf[8];
  const lds_cptr kp0=shm3+LDS_K+hi*1024+r32*16; const lds_cptr vp0=shm3+LDS_V+((lane>>4)&1)*32+(lane&3)*8+(4*hi+((lane&15)>>2))*64;
  const int NT=(q0+QB)/KVBLK;
  DMA_K(0,0);DMA_V(0,0);DMA_K(1,SLOTB);
  bf16x8 qr[4];
  #pragma unroll
  for(int d0=0;d0<4;++d0)qr[d0]=*reinterpret_cast<const bf16x8*>(&Qw[(long)r32*DM+d0*16+hi*8]);
  float mhat=0.f,l_reg=0.f;f32x16 o[2];o[0]=f32x16{};o[1]=f32x16{};
  const __attribute__((address_space(3))) float*fkl=(const __attribute__((address_space(3))) float*)(shm3+LDS_FK)+4*hi;
  #define INITC(C0,C1,t) do{ const float nsc_=fq2-mhat; typedef float f32x4_t __attribute__((ext_vector_type(4))); const __attribute__((address_space(3))) float*kb_=fkl+64*(t); \
    _Pragma("unroll") for(int g_=0;g_<4;++g_){ const f32x4_t a_=*(const __attribute__((address_space(3))) f32x4_t*)(kb_+8*g_), b_=*(const __attribute__((address_space(3))) f32x4_t*)(kb_+32+8*g_); \
      _Pragma("unroll") for(int e_=0;e_<4;++e_){ C0[4*g_+e_]=nsc_+a_[e_]; C1[4*g_+e_]=nsc_+b_[e_]; } } }while(0)
  const int qrel=wid*QBLK+r32;
  #define CMASK(P0,P1,t) do{int jb_=(t)-(NT-4); if(jb_>=0)cmask(P0,P1,jb_,qrel,hi);}while(0)
  bool resc=false;
  #define START(P0,P1) do{ const float rm=rowmax(P0,P1); resc=false; \
    { const float dl=rm; mhat=fadd_s(mhat,dl); \
      _Pragma("unroll") for(int r=0;r<16;++r){P0[r]=fsub_s(P0[r],dl);P1[r]=fsub_s(P1[r],dl);} \
      } \
    _Pragma("unroll") for(int r=0;r<16;++r)P0[r]=__builtin_amdgcn_exp2f(P0[r]); }while(0)
  #define RESC() do{ if(resc){ asm volatile("s_waitcnt lgkmcnt(0)":::"memory"); \
      _Pragma("unroll") for(int d_=0;d_<2;++d_) _Pragma("unroll") for(int r=0;r<16;++r)o[d_][r]*=wsf[crow(r,hi)]; } }while(0)
  f32x16 pA0,pA1,pB0,pB1;
  int sl_prev=0,sl_cur=0,sl_next=SLOTB;
  #define ROT() do{sl_prev=sl_cur;sl_cur=sl_next;sl_next=(sl_next==(NSLOT-1)*SLOTB)?0:sl_next+SLOTB;}while(0)
  DMA_K(2,2*SLOTB);
  WAIT_BAR(3);
  INITC(pA0,pA1,0); qkt(pA0,pA1,Kbase,qr,r32,hi);asm volatile("s_nop 15\n\ts_nop 7":"+v"(pA0),"+v"(pA1));CMASK(pA0,pA1,0);
  START(pA0,pA1);
  _Pragma("unroll") for(int r=0;r<16;++r)pA1[r]=__builtin_amdgcn_exp2f(pA1[r]);
  WAIT_BAR(0);
  DMA_K(3,0);DMA_V(1,SLOTB);
  ROT();
  kload8(kf,kp0+sl_cur);
  WAIT_BAR(2);
  s16x4 vlo[8],vhi[8]; u32x4 pw0,pw1,pw2,pw3;
  #define PKW(P,B) cvtpk_s(P[B],P[B+1])
  #define PAF(k) __builtin_bit_cast(bf16x8,pw##k)
  #define VFR(i) (bf16x8){vlo[i][0],vlo[i][1],vlo[i][2],vlo[i][3],vhi[i][0],vhi[i][1],vhi[i][2],vhi[i][3]}
  #define PIN(x) asm volatile("":"+v"(x))
  #define MX3(a,b,c) __builtin_fmaxf(__builtin_fmaxf((a),(b)),(c))
  #define GAPA(MF,A0,A1,A2,A3,W0,W1,PW) do{ MF; sacc+=A0; sacc+=A1; sacc+=A2; sacc+=A3; PIN(sacc); W0; W1; PIN(PW); SBAR(); }while(0)
  #define EX(v) __builtin_amdgcn_exp2f(v)
  #define GAPB(MF,X,B) do{ MF; X[B]=EX(X[B]); X[B+1]=EX(X[B+1]); X[B+2]=EX(X[B+2]); X[B+3]=EX(X[B+3]); PIN(X); SBAR(); }while(0)
  #define VRD(i) do{ vlo[i]=vtr(vp_+(((i)>>2)*4096+((i)&3)*1024)); vhi[i]=vtr(vp_+(((i)>>2)*4096+((i)&3)*1024+512)); }while(0)
  #define KRD(G,j) do{ if(G){ kload2(kf,kp0+sl_next,j); SBAR(); } }while(0)
  #define STEP(C0,C1,P0,P1,t,GK,GV,GL) do{ SBAR(); INITC(C0,C1,t); PIN(C0); PIN(C1); SBAR(); \
    const lds_cptr vp_=vp0+sl_prev; \
    VRD(0); SBAR(); float sacc=(P0[0]+P0[1]); \
    GAPA(C0=__builtin_amdgcn_mfma_f32_32x32x16_bf16(kf[0],qr[0],C0,0,0,0), P0[2],P0[3],P0[4],P0[5],     pw0[0]=PKW(P0,0), pw0[1]=PKW(P0,2), pw0); \
    VRD(4); SBAR(); GAPA(C1=__builtin_amdgcn_mfma_f32_32x32x16_bf16(kf[1],qr[0],C1,0,0,0), P0[6],P0[7],P0[8],P0[9],     pw0[2]=PKW(P0,4), pw0[3]=PKW(P0,6), pw0); \
    VRD(1); SBAR(); GAPA(C0=__builtin_amdgcn_mfma_f32_32x32x16_bf16(kf[2],qr[1],C0,0,0,0),   P0[10],P0[11],P0[12],P0[13], pw1[0]=PKW(P0,8), pw1[1]=PKW(P0,10), pw1); \
    VRD(5); SBAR(); GAPA(C1=__builtin_amdgcn_mfma_f32_32x32x16_bf16(kf[3],qr[1],C1,0,0,0),   P0[14],P0[15],P1[0],P1[1],   pw1[2]=PKW(P0,12),pw1[3]=PKW(P0,14), pw1); \
    VRD(2); SBAR(); GAPA(C0=__builtin_amdgcn_mfma_f32_32x32x16_bf16(kf[4],qr[2],C0,0,0,0),   P1[2],P1[3],P1[4],P1[5],     pw2[0]=PKW(P1,0), pw2[1]=PKW(P1,2), pw2); \
    VRD(6); SBAR(); GAPA(C1=__builtin_amdgcn_mfma_f32_32x32x16_bf16(kf[5],qr[2],C1,0,0,0),   P1[6],P1[7],P1[8],P1[9],     pw2[2]=PKW(P1,4), pw2[3]=PKW(P1,6), pw2); \
    VRD(3); SBAR(); GAPA(C0=__builtin_amdgcn_mfma_f32_32x32x16_bf16(kf[6],qr[3],C0,0,0,0),   P1[10],P1[11],P1[12],P1[13], pw3[0]=PKW(P1,8), pw3[1]=PKW(P1,10), pw3); \
    VRD(7); SBAR(); GAPA(C1=__builtin_amdgcn_mfma_f32_32x32x16_bf16(kf[7],qr[3],C1,0,0,0),   P1[14],P1[15],0.f,0.f,       pw3[2]=PKW(P1,12),pw3[3]=PKW(P1,14), pw3); \
    l_reg+=sacc; \
    if(GK){DMA_K((t)+3,sl_cur);} if(GV){DMA_V((t)+1,sl_next);} \
    CMASK(C0,C1,t); \
    { float a=MX3(C0[0],C0[1],C1[0]),b=MX3(C0[2],C0[3],C1[1]); a=MX3(a,C1[2],C1[3]); \
      _Pragma("unroll") for(int r=4;r<16;r+=4){a=MX3(a,C0[r],C0[r+1]);b=MX3(b,C0[r+2],C0[r+3]);a=MX3(a,C1[r],C1[r+1]);b=MX3(b,C1[r+2],C1[r+3]);} \
      float rm=__builtin_fmaxf(a,b); { auto rr=__builtin_amdgcn_permlane32_swap(__float_as_uint(rm),__float_as_uint(rm),false,false); rm=__builtin_fmaxf(__uint_as_float(rr[0]),__uint_as_float(rr[1])); } \
      resc=false; \
      if(__builtin_expect(__any(rm>(float)THRL),0)){ const float dl=__builtin_fmaxf(rm,0.f); mhat+=dl; \
        _Pragma("unroll") for(int r=0;r<16;++r){C0[r]-=dl;C1[r]-=dl;} \
        const float f=__builtin_amdgcn_exp2f(-dl); l_reg*=f; if(hi==0)wsf[r32]=f; resc=true; } } \
    SBAR(); \
    GAPB(o[0]=__builtin_amdgcn_mfma_f32_32x32x16_bf16(PAF(0),VFR(0),o[0],0,0,0), C0,0); \
    GAPB(o[1]=__builtin_amdgcn_mfma_f32_32x32x16_bf16(PAF(0),VFR(4),o[1],0,0,0), C0,4); \
    KRD(GL,0); GAPB(o[0]=__builtin_amdgcn_mfma_f32_32x32x16_bf16(PAF(1),VFR(1),o[0],0,0,0), C0,8); \
    KRD(GL,1); GAPB(o[1]=__builtin_amdgcn_mfma_f32_32x32x16_bf16(PAF(1),VFR(5),o[1],0,0,0), C0,12); \
    KRD(GL,2); GAPB(o[0]=__builtin_amdgcn_mfma_f32_32x32x16_bf16(PAF(2),VFR(2),o[0],0,0,0), C1,0); \
    KRD(GL,3); GAPB(o[1]=__builtin_amdgcn_mfma_f32_32x32x16_bf16(PAF(2),VFR(6),o[1],0,0,0), C1,4); \
    GAPB(o[0]=__builtin_amdgcn_mfma_f32_32x32x16_bf16(PAF(3),VFR(3),o[0],0,0,0), C1,8); \
    GAPB(o[1]=__builtin_amdgcn_mfma_f32_32x32x16_bf16(PAF(3),VFR(7),o[1],0,0,0), C1,12); \
    }while(0)
  int t=1;
  #undef CMASK
  #define CMASK(P0,P1,t) do{}while(0)
  for(;t+5<NT;t+=2){
    STEP(pB0,pB1,pA0,pA1,t,true,true,true);     WAIT_BAR(2); RESC(); ROT();
    STEP(pA0,pA1,pB0,pB1,t+1,true,true,true);   WAIT_BAR(2); RESC(); ROT();
  }
  #undef CMASK
  #define CMASK(P0,P1,t) do{int jb_=(t)-(NT-4); if(jb_>=0)cmask(P0,P1,jb_,qrel,hi);}while(0)
  #define ENDW(tt) do{ if((tt)+3<NT){WAIT_BAR(2);} else if((tt)+2<NT){WAIT_BAR(1);} else {WAIT_BAR(0);} }while(0)
  for(;t+1<NT;t+=2){
    STEP(pB0,pB1,pA0,pA1,t,(t+3<NT),(t+1<NT),(t+1<NT));       ENDW(t);   RESC(); ROT();
    STEP(pA0,pA1,pB0,pB1,t+1,(t+4<NT),(t+2<NT),(t+2<NT));     ENDW(t+1); RESC(); ROT();
  }
  STEP(pB0,pB1,pA0,pA1,NT-1,false,false,false); RESC();
  { float sacc=pB0[0]+pB0[1]; _Pragma("unroll") for(int r=2;r<16;++r)sacc+=pB0[r]; _Pragma("unroll") for(int r=0;r<16;++r)sacc+=pB1[r]; l_reg+=sacc;
    pw0=(u32x4){PKW(pB0,0),PKW(pB0,2),PKW(pB0,4),PKW(pB0,6)};pw1=(u32x4){PKW(pB0,8),PKW(pB0,10),PKW(pB0,12),PKW(pB0,14)};pw2=(u32x4){PKW(pB1,0),PKW(pB1,2),PKW(pB1,4),PKW(pB1,6)};pw3=(u32x4){PKW(pB1,8),PKW(pB1,10),PKW(pB1,12),PKW(pB1,14)};
    SBAR(); pv(o,vb0+sl_cur,PAF(0),PAF(1),PAF(2),PAF(3)); }
  #undef PKW
  #undef PAF
  #undef VFR
  #undef PIN
  #undef MX3
  #undef GAPA
  #undef GAPB
  #undef EX
  #undef VRD
  #undef KRD
  #undef STEP
  #undef ENDW
  {auto rr=__builtin_amdgcn_permlane32_swap(__float_as_uint(l_reg),__float_as_uint(l_reg),false,false);l_reg=__uint_as_float(rr[0])+__uint_as_float(rr[1]);}
  if(hi==0)wsf[32+r32]=l_reg;asm volatile("s_waitcnt lgkmcnt(0)":::"memory");
  float rli[16];
  #pragma unroll
  for(int r=0;r<16;++r)rli[r]=__builtin_amdgcn_rcpf(wsf[32+crow(r,hi)]);
  bf16*Ow=O+(rowbase+q0+wid*QBLK)*DM+h*D;
  { bf16*stg=(bf16*)(shm+LDS_OST)+wid*2048;
    #pragma unroll
    for(int r=0;r<16;++r){const int orow=crow(r,hi);
      #pragma unroll
      for(int d0=0;d0<2;++d0)stg[orow*64+d0*32+r32]=__float2bfloat16(o[d0][r]*rli[r]);}
    asm volatile("s_waitcnt lgkmcnt(0)":::"memory");
    #pragma unroll
    for(int i=0;i<4;++i){const int row=i*8+(lane>>3),ch=lane&7; const u32x4 v=*(const u32x4*)(stg+row*64+ch*8); ATTN_STORE16(Ow+(long)row*DM+ch*8,v);} }
  asm volatile("s_waitcnt lgkmcnt(0)\n\ts_barrier":::"memory");
  #undef DMA_K
  #undef DMA_V
  #undef INITC
  #undef CMASK
  #undef START
  #undef RESC
  #undef ROT
}
constexpr int ATTN_LDS_BYTES=LDS_BYTES;
struct AttnTensors { const bf16* Q; const bf16* K; const bf16* V; bf16* O; const float* F; };
struct AttnUnit { int bh; int qb; };
struct StaticOrder {
  int vcu;
  __device__ __forceinline__ explicit StaticOrder(int grid,int block):vcu((block%8)*(grid/8)+block/8){}
  __device__ __forceinline__ bool next(int i,AttnUnit&u)const{ if(i>=4)return false; const int s=vcu&7; u.bh=vcu>>3; u.qb=(i==0)?s:(i==1)?15-s:(i==2)?16+s:31-s; return true; }
  __device__ __forceinline__ void a_ready(const AttnUnit&)const{}
  __device__ __forceinline__ void done(const AttnUnit&)const{}
};
template<class Sched,int THRL=8> __device__ __forceinline__ void attn_phase(char*lds,const AttnTensors&T,const Sched&S,int wid_in){
  AttnUnit u;
  for(int i=0;S.next(i,u);++i){ S.a_ready(u); attn_unit<THRL>(u.bh/NHEAD,u.bh%NHEAD,u.qb,T.Q,T.K,T.V,T.O,T.F,lds,wid_in); S.done(u); }
}
#undef SBAR
#undef WAIT_BAR
}
#define GAS __attribute__((address_space(1)))
#define LAS __attribute__((address_space(3)))
typedef unsigned short bf16;
typedef unsigned v4u __attribute__((ext_vector_type(4)));
typedef float f32x4 __attribute__((ext_vector_type(4)));
typedef short bf16x8 __attribute__((ext_vector_type(8)));
typedef GAS unsigned gu32;
typedef GAS unsigned long long gu64;
#define RLX_AGENT __ATOMIC_RELAXED, __HIP_MEMORY_SCOPE_AGENT
#define LDS_WAIT() asm volatile("s_waitcnt lgkmcnt(0)" ::: "memory")
#define VM_WAIT() asm volatile("s_waitcnt vmcnt(0)" ::: "memory")
__device__ __forceinline__ unsigned long long rt() { return __builtin_amdgcn_s_memrealtime(); }
__device__ __forceinline__ unsigned f2bf(float f) { unsigned u = __builtin_bit_cast(unsigned, f); return (u + 0x7fffu + ((u >> 16) & 1u)) >> 16; }
__device__ __forceinline__ unsigned pk2(float lo, float hi) { return f2bf(lo) | (f2bf(hi) << 16); }

#define XB_TMO      128
#define XB_XCNT(j)  (256  + 64 * (j))
#define XB_XSUB(j)  (1280 + 64 * (j))
#define XB_XGEN(j)  (2304 + 64 * (j))
#define XB_TOP      3328
#define XB_TOPGEN   3392
#define XCD_BAR_WORDS 3456
#define XB_SPIN_CAP (1u << 18)

__device__ __forceinline__ unsigned xb_ld(unsigned* p)              { return __hip_atomic_load(p, __ATOMIC_RELAXED, __HIP_MEMORY_SCOPE_AGENT); }
__device__ __forceinline__ unsigned xb_add(unsigned* p, unsigned v) { return __hip_atomic_fetch_add(p, v, __ATOMIC_RELAXED, __HIP_MEMORY_SCOPE_AGENT); }
__device__ __forceinline__ unsigned xb_xcc_id() { return (unsigned)__builtin_amdgcn_s_getreg((3 << 11) | 20) & 0xFu; }
#define XB_SPIN(cond, bar) do { unsigned _sp = 0; while (cond) { __builtin_amdgcn_s_sleep(1); \
    if ((++_sp & 255u) == 0u) { if (xb_ld(&(bar)[XB_TMO])) break; if (_sp > XB_SPIN_CAP) { atomicAdd(&(bar)[XB_TMO], 1u); break; } } } } while (0)

struct XcdBarrier {
    unsigned* bar; unsigned x; int wv;
    volatile LAS unsigned* st;
};

__device__ __forceinline__ bool xb_t0(int wv) { return wv == 0 && __builtin_amdgcn_mbcnt_hi(~0u, __builtin_amdgcn_mbcnt_lo(~0u, 0u)) == 0u; }
__device__ __forceinline__ XcdBarrier xcd_barrier_post(unsigned* bar, volatile LAS unsigned* st, int wv) {
    XcdBarrier b; b.bar = bar; b.x = xb_xcc_id(); b.st = st; b.wv = wv;
    if (xb_t0(wv)) (void)xb_add(&bar[XB_XCNT(b.x)], 1u);
    return b;
}
__device__ __forceinline__ void xcd_barrier_complete(unsigned* bar, unsigned x, unsigned& nloc, unsigned& nx) {
    const unsigned G = gridDim.x * gridDim.y * gridDim.z;
    unsigned sum, cnt, mine, sp = 0u;
    for (;;) {
        sum = 0u; cnt = 0u; mine = 0u;
#pragma unroll
        for (unsigned j = 0; j < 16; ++j) { const unsigned c = xb_ld(&bar[XB_XCNT(j)]); sum += c; cnt += (c > 0u) ? 1u : 0u; mine = (j == x) ? c : mine; }
        if (sum == G) break;
        __builtin_amdgcn_s_sleep(1);
        if ((++sp & 255u) == 0u) { if (xb_ld(&bar[XB_TMO])) break; if (sp > XB_SPIN_CAP) { atomicAdd(&bar[XB_TMO], 1u); break; } }
    }
    nloc = mine > 0u ? mine : 1u; nx = cnt > 0u ? cnt : 1u;
}

__device__ __forceinline__ void xcd_barrier(const XcdBarrier& b) {
    asm volatile("s_waitcnt vmcnt(0)" ::: "memory");
    __syncthreads();
    if (xb_t0(b.wv)) {
        unsigned* bar = b.bar;
        __builtin_amdgcn_s_waitcnt(0);
        unsigned nloc = b.st[0], nx = b.st[1];
        if (nloc == 0u) { xcd_barrier_complete(bar, b.x, nloc, nx); b.st[0] = nloc; b.st[1] = nx; }
        const unsigned old = xb_add(&bar[XB_XSUB(b.x)], 1u);
        const unsigned gen = old / nloc;
        if (old + 1u == (gen + 1u) * nloc) {
            __builtin_amdgcn_fence(__ATOMIC_RELEASE, "agent");
            asm volatile("s_waitcnt vmcnt(0)" ::: "memory");
            const unsigned og = xb_add(&bar[XB_TOP], 1u);
            const unsigned tg = og / nx;
            if (og + 1u == (tg + 1u) * nx) xb_add(&bar[XB_TOPGEN], 1u);
            else XB_SPIN(xb_ld(&bar[XB_TOPGEN]) == tg, bar);
            __builtin_amdgcn_fence(__ATOMIC_ACQUIRE, "agent");
            xb_add(&bar[XB_XGEN(b.x)], 1u);
            asm volatile("s_waitcnt vmcnt(0)" ::: "memory");
        } else {
            XB_SPIN(xb_ld(&bar[XB_XGEN(b.x)]) == gen, bar);
            __builtin_amdgcn_fence(__ATOMIC_ACQUIRE, "agent");
            asm volatile("s_waitcnt vmcnt(0)" ::: "memory");
        }
    }
    __syncthreads();
}

constexpr int NWAVES = 8;
constexpr int RING_OFF = 0, RING_BYTES = 131072;
constexpr int LDSCTL_OFF = RING_BYTES, MISC_OFF = LDSCTL_OFF + 320;
constexpr int LDS_BYTES = 147456;
constexpr int N_PHASES = 8;

struct Frame {
    LAS unsigned char* lds;
    volatile LAS unsigned* MISC;
    gu32* ctl;
    int tid, lane, wave, vcu, G;
};
__device__ __forceinline__ float wave_sum(float v) {
#pragma unroll
    for (int o = 1; o < 64; o <<= 1) v += __shfl_xor(v, o);
    return v;
}
struct Args { const float* in[20]; float* out; unsigned char* ws; int ph_lo, ph_hi, li, pad; };

__device__ __forceinline__ void p0_transpose_item(const float* W, int ld, int nblk, const float* glo, const float* ghi, int K, bf16* WT, LAS float* scr, int item, int lane) {
    const int kb = item / nblk, nb = item % nblk, k0 = 64 * kb, n0 = 32 * nb;
#pragma unroll 8
    for (int i = 0; i < 32; ++i) { const int kk = 2 * i + (lane >> 5), k = k0 + kk; float w = W[(size_t)k * ld + n0 + (lane & 31)];
        if (glo) w *= (k < K / 2) ? glo[k] : ghi[k - K / 2];
        scr[kk * 33 + (lane & 31)] = w; }
    LDS_WAIT(); asm volatile("" ::: "memory");
    const int c = lane & 7;
#pragma unroll
    for (int j = 0; j < 4; ++j) { const int n = (lane >> 3) + 8 * j; const LAS float* s = scr + (8 * c) * 33 + n;
        v4u o; o.x = pk2(s[0 * 33], s[1 * 33]); o.y = pk2(s[2 * 33], s[3 * 33]); o.z = pk2(s[4 * 33], s[5 * 33]); o.w = pk2(s[6 * 33], s[7 * 33]);
        *(GAS v4u*)(WT + (size_t)(n0 + n) * K + k0 + 8 * c) = o; }
    LDS_WAIT(); asm volatile("" ::: "memory");
}
__device__ __forceinline__ float log_sigmoid(float z) { return fminf(z, 0.f) - log1pf(expf(-fabsf(z))); }

__device__ __forceinline__ void p0_prologue(Frame& F, const Args& a) {
    LAS float* scr = (LAS float*)(F.lds + RING_OFF + F.wave * 16384);
    unsigned char* ws = a.ws;
    const float* x = a.in[0]; const float* g1 = a.in[1]; const float* w_in = a.in[2]; const float* bfv = a.in[10];
    const float* gn_l = a.in[11]; const float* gn_f = a.in[12]; const float* w_out = a.in[13]; const float* g2 = a.in[14];
    const float* w_q = a.in[15]; const float* sk = a.in[16]; const float* pu = a.in[17]; const float* pv = a.in[18];
    bf16* win_t = (bf16*)(ws + WS_WIN); bf16* wout_t = (bf16*)(ws + WS_WOUT); bf16* wq_t = (bf16*)(ws + WS_WQ); bf16* skb = (bf16*)(ws + WS_SKB); float* wfl = (float*)(ws + WS_WFL);
    float* logf = (float*)(ws + WS_LOGF); float* sumsq = (float*)(ws + WS_SUMSQ); bf16* h = (bf16*)(ws + WS_H);
    const int gw = F.vcu * NWAVES + F.wave, NGW = F.G * NWAVES, lane = F.lane;
    constexpr int I_IN = (DMODEL / 64) * (NG1 / 32), I_OUT = (DMODEL / 64) * (DMODEL / 32), I_Q = (DMODEL / 64) * (QPW / 32);
    constexpr int I_FL = 8 * DMODEL / 64, I_SK = PH * 2 * NKEY * PHALF / 512, I_SS = T / 64, I_WAX = 8 * 2 * 2 * 4;
    constexpr int E0 = I_IN, E1 = E0 + I_OUT, E2 = E1 + I_Q, E3 = E2 + I_FL, E4 = E3 + I_SK, E5 = E4 + I_SS, E6 = E5 + I_WAX;
    for (int it = gw; it < E6; it += NGW) {
        if (it < E0) { p0_transpose_item(w_in, INC, NG1 / 32, nullptr, nullptr, DMODEL, win_t, scr, it, lane); continue; }
        if (it < E1) { p0_transpose_item(w_out, DMODEL, DMODEL / 32, gn_l, gn_f, DMODEL, wout_t, scr, it - E0, lane); continue; }
        if (it < E2) { p0_transpose_item(w_q, QPW, QPW / 32, g2, g2 + DMODEL / 2, DMODEL, wq_t, scr, it - E1, lane); continue; }
        if (it < E3) { const int i = (it - E2) * 64 + lane, j = i / DMODEL, k = i % DMODEL; wfl[i] = w_in[(size_t)k * INC + NG1 + j]; continue; }
        if (it < E4) { const size_t i = (size_t)(it - E3) * 512 + lane * 8; const f32x4 s0 = *(const GAS f32x4*)(sk + i), s1 = *(const GAS f32x4*)(sk + i + 4);
            v4u o; o.x = pk2(s0[0], s0[1]); o.y = pk2(s0[2], s0[3]); o.z = pk2(s1[0], s1[1]); o.w = pk2(s1[2], s1[3]); *(GAS v4u*)(skb + i) = o; continue; }
        if (it < E5) { sumsq[(it - E4) * 64 + lane] = 0.f; continue; }
        { const int f = it - E5, ks = f & 3, n = (f >> 2) & 1, mat = (f >> 3) & 1, hh = f >> 4; const float* wsrc = mat ? a.in[7] : a.in[5];
          const size_t o = ((size_t)(hh * 64 + 16 * ks + 8 * (lane >> 5))) * 64 + 32 * n + (lane & 31);
          v4u pw; pw.x = pk2(wsrc[o], wsrc[o + 64]); pw.y = pk2(wsrc[o + 128], wsrc[o + 192]); pw.z = pk2(wsrc[o + 256], wsrc[o + 320]); pw.w = pk2(wsrc[o + 384], wsrc[o + 448]);
          *(GAS v4u*)((bf16*)(ws + WS_WAX) + (size_t)f * 512 + lane * 8) = pw; }
    }
    { f32x4 gg[4];
#pragma unroll
      for (int j = 0; j < 4; ++j) gg[j] = *(const GAS f32x4*)(g2 + 16 * lane + 4 * j);
      unsigned char* u8 = ws + WS_U8; unsigned char* v8 = ws + WS_V8; float* su = (float*)(ws + WS_SU);
      for (int e = gw; e < NEXP; e += NGW) {
        const GAS f32x4* ur = (const GAS f32x4*)(pu + (size_t)e * DMODEL + 16 * lane); const GAS f32x4* vr = (const GAS f32x4*)(pv + (size_t)e * DMODEL + 16 * lane);
        f32x4 uu[4], vv[4]; float mu = 0.f, mv = 0.f;
#pragma unroll
        for (int j = 0; j < 4; ++j) { uu[j] = ur[j] * gg[j]; vv[j] = vr[j];
#pragma unroll
            for (int c = 0; c < 4; ++c) { mu = fmaxf(mu, fabsf(uu[j][c])); mv = fmaxf(mv, fabsf(vv[j][c])); } }
#pragma unroll
        for (int o = 1; o < 64; o <<= 1) { mu = fmaxf(mu, __shfl_xor(mu, o)); mv = fmaxf(mv, __shfl_xor(mv, o)); }
        const float scu = mu > 0.f ? mu * (1.f / 440.f) : 1.f, scv = mv > 0.f ? mv * (1.f / 440.f) : 1.f, iu = 1.f / scu, iv = 1.f / scv;
        v4u qu, qv;
#pragma unroll
        for (int j = 0; j < 4; ++j) { int wu = 0, wv = 0;
            wu = __builtin_amdgcn_cvt_pk_fp8_f32(uu[j][0] * iu, uu[j][1] * iu, wu, false); wu = __builtin_amdgcn_cvt_pk_fp8_f32(uu[j][2] * iu, uu[j][3] * iu, wu, true);
            wv = __builtin_amdgcn_cvt_pk_fp8_f32(vv[j][0] * iv, vv[j][1] * iv, wv, false); wv = __builtin_amdgcn_cvt_pk_fp8_f32(vv[j][2] * iv, vv[j][3] * iv, wv, true);
            qu[j] = (unsigned)wu; qv[j] = (unsigned)wv; }
        *(GAS v4u*)(u8 + (size_t)e * DMODEL + 16 * lane) = qu; *(GAS v4u*)(v8 + (size_t)e * DMODEL + 16 * lane) = qv;
        if (lane == 0) { su[2 * e] = scu; su[2 * e + 1] = scv; }
      } }
    { f32x4 gg[4];
#pragma unroll
      for (int j = 0; j < 4; ++j) gg[j] = *(const GAS f32x4*)(g1 + 256 * j + 4 * lane);
      float fw[4][4][8];
#pragma unroll
      for (int j = 0; j < 4; ++j)
#pragma unroll
          for (int c = 0; c < 4; ++c) { const int k = 256 * j + 4 * lane + c; const GAS f32x4* wr = (const GAS f32x4*)(w_in + (size_t)k * INC + NG1); const f32x4 w0 = wr[0], w1 = wr[1];
#pragma unroll
              for (int e = 0; e < 4; ++e) { fw[j][c][e] = w0[e]; fw[j][c][4 + e] = w1[e]; } }
      for (int t = gw; t < T; t += NGW) {
        const GAS f32x4* xr = (const GAS f32x4*)(x + (size_t)t * DMODEL) + lane;
        f32x4 v[4]; float ss = 0.f;
#pragma unroll
        for (int j = 0; j < 4; ++j) { v[j] = xr[64 * j]; ss += (v[j][0] * v[j][0] + v[j][1] * v[j][1]) + (v[j][2] * v[j][2] + v[j][3] * v[j][3]); }
        const float rstd = rsqrtf(wave_sum(ss) * (1.f / DMODEL) + RMS_EPS);
        GAS unsigned long long* ho = (GAS unsigned long long*)(h + (size_t)t * DMODEL) + lane;
#pragma unroll
        for (int j = 0; j < 4; ++j) { v[j] = v[j] * rstd * gg[j]; ho[64 * j] = (unsigned long long)pk2(v[j][0], v[j][1]) | ((unsigned long long)pk2(v[j][2], v[j][3]) << 32); }
        float fl[8];
#pragma unroll
        for (int hh = 0; hh < 8; ++hh) fl[hh] = 0.f;
#pragma unroll
        for (int j = 0; j < 4; ++j)
#pragma unroll
            for (int c = 0; c < 4; ++c) {
#pragma unroll
                for (int hh = 0; hh < 8; ++hh) fl[hh] += v[j][c] * fw[j][c][hh]; }
        float res = 0.f;
#pragma unroll
        for (int hh = 0; hh < 8; ++hh) { const float s = wave_sum(fl[hh]); if (lane == hh) res = s; }
        if (lane < 8) logf[(size_t)t * 8 + lane] = log_sigmoid(res + bfv[lane]);
      } }
}

__device__ __forceinline__ void fcum_unit(Frame& F, int bh, const float* logf, float* fcum) {
    const int b = bh / NHEADS, hh = bh % NHEADS, s0 = F.tid * 16;
    float v[16]; float loc = 0.f;
#pragma unroll
    for (int i = 0; i < 16; ++i) { v[i] = logf[((size_t)b * SEQ + s0 + i) * 8 + hh]; loc += v[i]; }
    float inc = loc;
#pragma unroll
    for (int o = 1; o < 64; o <<= 1) { const float n = __shfl_up(inc, o); if (F.lane >= o) inc += n; }
    if (F.lane == 63) F.MISC[16 + F.wave] = __float_as_uint(inc);
    __syncthreads();
    float run = inc - loc;
    for (int w = 0; w < F.wave; ++w) run += __uint_as_float(F.MISC[16 + w]);
#pragma unroll
    for (int i = 0; i < 16; ++i) { run += v[i]; fcum[(size_t)bh * SEQ + s0 + i] = run; }
    __syncthreads();
}


namespace peer {
typedef unsigned u32;
typedef float f32x16 __attribute__((ext_vector_type(16)));
constexpr int TOK = 128;
constexpr int EX_STRIDE = 136, GT_STRIDE = 132;
constexpr int L_EX = 0, L_GT = L_EX + TOK * EX_STRIDE * 2, L_IDX = L_GT + TOK * GT_STRIDE * 4, IDX_STRIDE = 36, L_RST = L_IDX + 512 * IDX_STRIDE, L_END = L_RST + TOK * 4;
static_assert(L_END <= RING_BYTES && L_GT % 16 == 0 && L_IDX % 16 == 0, "PEER LDS map");
__device__ __forceinline__ u32 ordmap(float f) { const u32 u = __float_as_uint(f); return u ^ ((u32)((int)u >> 31) | 0x80000000u); }
__device__ __forceinline__ float unordmap(u32 k) { const u32 u = (k & 0x80000000u) ? (k ^ 0x80000000u) : ~k; return __uint_as_float(u); }
__device__ __forceinline__ u32 umin_(u32 a, u32 b) { return a < b ? a : b; }
__device__ __forceinline__ u32 umax_(u32 a, u32 b) { return a > b ? a : b; }
template <bool DESC> __device__ __forceinline__ void sort16(u32 (&k)[16]) {
#pragma unroll
    for (int size = 2; size <= 16; size <<= 1)
#pragma unroll
        for (int stride = size >> 1; stride > 0; stride >>= 1)
#pragma unroll
            for (int i = 0; i < 16; ++i) { const int j = i ^ stride;
                if (j > i) { const bool asc = (((i & size) == 0) != DESC); const u32 a = k[i], b = k[j], lo = umin_(a, b), hi = umax_(a, b); k[i] = asc ? lo : hi; k[j] = asc ? hi : lo; } }
}
template <bool DESC> __device__ __forceinline__ void merge16(u32 (&k)[16]) {
#pragma unroll
    for (int stride = 8; stride > 0; stride >>= 1)
#pragma unroll
        for (int i = 0; i < 16; ++i) { const int j = i ^ stride;
            if (j > i) { const u32 a = k[i], b = k[j], lo = umin_(a, b), hi = umax_(a, b); k[i] = DESC ? hi : lo; k[j] = DESC ? lo : hi; } }
}
__host__ __device__ constexpr int ccnt(int a) { return 16 / (a + 1); }
__host__ __device__ constexpr int cbase(int a) { int s = 0; for (int i = 0; i < a; ++i) s += ccnt(i); return s; }
static_assert(cbase(16) == 50, "hyperbola candidate count");
__device__ __forceinline__ int crow16(int r) { return (r & 3) + 8 * (r >> 2); }

__device__ __forceinline__ void route_tile(Frame& F, const bf16* qp, const bf16* skb, const float* sumsq, int t0) {
    int lane = F.lane; asm volatile("" : "+v"(lane));
    const int r32 = lane & 31, hi = lane >> 5, w = F.wave;
    LAS unsigned short* EXL = (LAS unsigned short*)(F.lds + RING_OFF + L_EX);
    LAS float* GTL = (LAS float*)(F.lds + RING_OFF + L_GT);
    LAS unsigned char* IDXB = F.lds + RING_OFF + L_IDX + (w * 64 + lane) * IDX_STRIDE;
    LAS float* RST = (LAS float*)(F.lds + RING_OFF + L_RST);
    for (int g = 0; g < 4; ++g) {
        const int tok = 32 * g + r32; const size_t trow = (size_t)(t0 + tok);
        const float rstd2 = rsqrtf(sumsq[trow] * (1.f / DMODEL) + RMS_EPS);
        if (w == 0 && hi == 0) RST[tok] = rstd2;
        u32 s0[16], s1[16];
#pragma unroll
        for (int p = 0; p < 2; ++p) {
            bf16x8 qf[8];
#pragma unroll
            for (int ks = 0; ks < 8; ++ks) qf[ks] = *(const GAS bf16x8*)(qp + trow * QPW + w * 256 + p * 128 + ks * 16 + hi * 8);
            u32 run[16];
#pragma unroll
            for (int nb = 0; nb < 4; ++nb) {
                f32x16 acc = {};
                const bf16* kr = skb + ((size_t)((w * 2 + p) * NKEY + 32 * nb + r32)) * PHALF + hi * 8;
#pragma unroll
                for (int ks = 0; ks < 8; ++ks) acc = __builtin_amdgcn_mfma_f32_32x32x16_bf16(*(const GAS bf16x8*)(kr + ks * 16), qf[ks], acc, 0, 0, 0);
                asm volatile("" ::: "memory");
                u32 blk[16];
#pragma unroll
                for (int r = 0; r < 16; ++r) blk[r] = (ordmap(acc[r]) & ~0x7Fu) | (u32)(127 - 32 * nb - crow16(r) - 4 * hi);
                if (nb == 0) { sort16<true>(blk);
#pragma unroll
                    for (int i = 0; i < 16; ++i) run[i] = blk[i]; }
                else { sort16<false>(blk);
#pragma unroll
                    for (int i = 0; i < 16; ++i) run[i] = umax_(run[i], blk[i]);
                    merge16<true>(run); }
            }
            u32 oth[16];
#pragma unroll
            for (int i = 0; i < 16; ++i) oth[i] = (u32)__shfl_xor((int)run[15 - i], 32);
#pragma unroll
            for (int i = 0; i < 16; ++i) run[i] = umax_(run[i], oth[i]);
            merge16<true>(run);
#pragma unroll
            for (int i = 0; i < 16; ++i) { if (p == 0) s0[i] = run[i]; else s1[i] = run[i]; }
        }
        { LAS u32* iw = (LAS u32*)IDXB;
#pragma unroll
          for (int j = 0; j < 4; ++j) {
              iw[j] = (127u - (s0[4 * j] & 127u)) | ((127u - (s0[4 * j + 1] & 127u)) << 8) | ((127u - (s0[4 * j + 2] & 127u)) << 16) | ((127u - (s0[4 * j + 3] & 127u)) << 24);
              iw[4 + j] = (127u - (s1[4 * j] & 127u)) | ((127u - (s1[4 * j + 1] & 127u)) << 8) | ((127u - (s1[4 * j + 2] & 127u)) << 16) | ((127u - (s1[4 * j + 3] & 127u)) << 24); } }
        float v1[16], v2[16];
#pragma unroll
        for (int i = 0; i < 16; ++i) { v1[i] = unordmap(s0[i] & ~0x7Fu); v2[i] = unordmap(s1[i] & ~0x7Fu); }
        u32 c0[16], c1[16], c2[16], c3[16];
#pragma unroll
        for (int a = 0; a < 16; ++a)
#pragma unroll
            for (int b = 0; b < ccnt(a); ++b) { const int pos = cbase(a) + b; const u32 key = (ordmap(v1[a] + v2[b]) & ~0xFFu) | (u32)(255 - (a * 16 + b));
                if (pos < 16) c0[pos] = key; else if (pos < 32) c1[pos - 16] = key; else if (pos < 48) c2[pos - 32] = key; else c3[pos - 48] = key; }
#pragma unroll
        for (int i = 2; i < 16; ++i) c3[i] = 0u;
        sort16<false>(c1);
#pragma unroll
        for (int i = 0; i < 16; ++i) c0[i] = umax_(c0[i], c1[i]);
        merge16<true>(c0);
        sort16<false>(c2);
#pragma unroll
        for (int i = 0; i < 16; ++i) c0[i] = umax_(c0[i], c2[i]);
        merge16<true>(c0);
        sort16<false>(c3);
#pragma unroll
        for (int i = 0; i < 16; ++i) c0[i] = umax_(c0[i], c3[i]);
        merge16<true>(c0);
        const float m = unordmap(c0[0] & ~0xFFu) * rstd2;
        float e[8]; float sum = 0.f; u32 ex[8];
#pragma unroll
        for (int k = 0; k < 8; ++k) { const u32 key = hi ? c0[k + 8] : c0[k]; const float ts = unordmap(key & ~0xFFu);
            e[k] = __builtin_amdgcn_exp2f((ts * rstd2 - m) * LOG2E); sum += e[k];
            const u32 flat = 255u - (key & 255u); ex[k] = (u32)IDXB[flat >> 4] * NKEY + (u32)IDXB[16 + (flat & 15u)]; }
        sum += __shfl_xor(sum, 32);
        const float inv = 1.f / sum;
        v4u exw; exw.x = ex[0] | (ex[1] << 16); exw.y = ex[2] | (ex[3] << 16); exw.z = ex[4] | (ex[5] << 16); exw.w = ex[6] | (ex[7] << 16);
        *(LAS v4u*)(EXL + tok * EX_STRIDE + w * 16 + hi * 8) = exw;
        *(LAS f32x4*)(GTL + tok * GT_STRIDE + w * 16 + hi * 8) = (f32x4){e[0] * inv, e[1] * inv, e[2] * inv, e[3] * inv};
        *(LAS f32x4*)(GTL + tok * GT_STRIDE + w * 16 + hi * 8 + 4) = (f32x4){e[4] * inv, e[5] * inv, e[6] * inv, e[7] * inv};
    }
}
__device__ __forceinline__ float gelu_fast(float x) {
    const float u2 = x * (1.5957691216057308f + 0.07135481627f * x * x);
    return x * __builtin_amdgcn_rcpf(1.f + __builtin_amdgcn_exp2f(-1.4426950408889634f * u2));
}
typedef float f32x2 __attribute__((ext_vector_type(2)));

__device__ __forceinline__ void sort512(u32 (&k)[8], int lane) {
#pragma unroll
    for (int K = 2; K <= 512; K <<= 1) {
#pragma unroll
        for (int S = K >> 1; S > 0; S >>= 1) {
            if (S >= 8) {
                const int m = S >> 3; const bool lower = (lane & m) == 0, up = (K == 512) ? true : ((lane & (K >> 3)) == 0), keepmin = (lower == up);
#pragma unroll
                for (int r = 0; r < 8; ++r) { const u32 o = (u32)__shfl_xor((int)k[r], m); const u32 mn = umin_(k[r], o), mx = umax_(k[r], o); k[r] = keepmin ? mn : mx; }
            } else {
#pragma unroll
                for (int r = 0; r < 8; ++r) { const int r2 = r ^ S;
                    if (r2 > r) { const u32 a = k[r], b = k[r2], mn = umin_(a, b), mx = umax_(a, b);
                        if (K < 8) { const bool up = (r & K) == 0; k[r] = up ? mn : mx; k[r2] = up ? mx : mn; }
                        else { const bool up = (K == 512) ? true : ((lane & (K >> 3)) == 0); k[r] = up ? mn : mx; k[r2] = up ? mx : mn; } } }
            }
        }
    }
}
__device__ __forceinline__ void eval_sweep(Frame& F, const unsigned char* u8, const unsigned char* v8, const float* suv, const float* fg, float* out, int t0) {
    int lane = F.lane; asm volatile("" : "+v"(lane));
    const LAS unsigned short* EXL = (const LAS unsigned short*)(F.lds + RING_OFF + L_EX);
    const LAS float* GTL = (const LAS float*)(F.lds + RING_OFF + L_GT);
    const LAS float* RST = (const LAS float*)(F.lds + RING_OFF + L_RST);
    LAS u32* SK = (LAS u32*)(F.lds + RING_OFF + L_IDX) + F.wave * 576;
    LAS u32* GS = SK + 512;
    const int h5 = lane >> 5, h4 = (lane >> 4) & 1, h3 = (lane >> 3) & 1, jj = 4 * h3 + 2 * h4 + h5;
    for (int pass = 0; pass < 4; ++pass) {
        const int tb = 32 * pass + 4 * F.wave;
        { u32 k[8]; const int tk = lane >> 4, s0 = (lane & 15) * 8; const v4u ev = *(const LAS v4u*)(EXL + (tb + tk) * EX_STRIDE + s0);
          const u32 ee[8] = {ev.x & 0xffffu, ev.x >> 16, ev.y & 0xffffu, ev.y >> 16, ev.z & 0xffffu, ev.z >> 16, ev.w & 0xffffu, ev.w >> 16};
#pragma unroll
          for (int r = 0; r < 8; ++r) k[r] = ((ee[r] >> 10) << 23) | ((u32)tk << 21) | ((ee[r] & 1023u) << 7) | (u32)(s0 + r);
          sort512(k, lane);
          *(LAS v4u*)(SK + lane * 8) = (v4u){k[0], k[1], k[2], k[3]}; *(LAS v4u*)(SK + lane * 8 + 4) = (v4u){k[4], k[5], k[6], k[7]}; }
        asm volatile("" ::: "memory");
        {
          const u32 tgt = (u32)lane << 21; int lo = 0;
#pragma unroll
          for (int st = 256; st > 0; st >>= 1) { if (SK[lo + st - 1] < tgt) lo += st; }
          GS[lane] = (u32)lo; }
        asm volatile("" ::: "memory");
        f32x2 hv[4][8], y[4][8];
#pragma unroll
        for (int tk = 0; tk < 4; ++tk) { const float rstd2 = RST[tb + tk]; const float* xrow = out + (size_t)(t0 + tb + tk) * DMODEL + 16 * lane;
#pragma unroll
            for (int q = 0; q < 4; ++q) { const f32x4 xa = *(const GAS f32x4*)(xrow + 4 * q); hv[tk][2 * q] = (f32x2){xa[0] * rstd2, xa[1] * rstd2}; hv[tk][2 * q + 1] = (f32x2){xa[2] * rstd2, xa[3] * rstd2};
                y[tk][2 * q] = (f32x2){0.f, 0.f}; y[tk][2 * q + 1] = (f32x2){0.f, 0.f}; } }
        for (int bkt = 0; bkt < 16; ++bkt) {
#pragma unroll
            for (int tk = 0; tk < 4; ++tk) {
                const int g = bkt * 4 + tk;
                const int s = __builtin_amdgcn_readfirstlane((int)GS[g]), en = (g == 63) ? 512 : __builtin_amdgcn_readfirstlane((int)GS[(g + 1) & 63]);
                for (int i = s; i < en; i += 8) {
                    const int nrem = en - i;
                    const u32 kmine = SK[(i + (lane & 7)) & 511];
                    v4u ub[8]; int ej[8];
#pragma unroll
                    for (int j = 0; j < 8; ++j) { const int kj = __builtin_amdgcn_readlane((int)kmine, j); ej[j] = (bkt << 10) | ((kj >> 7) & 1023);
                        if (j < nrem) ub[j] = *(const GAS v4u*)(u8 + (size_t)ej[j] * DMODEL + 16 * lane); else ub[j] = (v4u){0u, 0u, 0u, 0u}; }
                    const u32 kx = SK[(i + jj) & 511]; const bool okx = jj < nrem;
                    f32x2 sc = (f32x2){0.f, 0.f}; float gate = 0.f;
                    if (okx) { sc = *(const GAS f32x2*)(suv + 2 * ((bkt << 10) | ((kx >> 7) & 1023u))); gate = GTL[(tb + tk) * GT_STRIDE + (kx & 127u)]; }
                    float p[8];
#pragma unroll
                    for (int j = 0; j < 8; ++j) { f32x2 acc = (f32x2){0.f, 0.f};
#pragma unroll
                        for (int c = 0; c < 4; ++c) { const int wd = (int)ub[j][c];
                            acc = __builtin_elementwise_fma(__builtin_amdgcn_cvt_pk_f32_fp8(wd, false), hv[tk][2 * c], acc); acc = __builtin_elementwise_fma(__builtin_amdgcn_cvt_pk_f32_fp8(wd, true), hv[tk][2 * c + 1], acc); }
                        p[j] = acc[0] + acc[1]; }
                    asm volatile("" ::: "memory");
                    v4u vb[8];
#pragma unroll
                    for (int j = 0; j < 8; ++j) { if (j < nrem) vb[j] = *(const GAS v4u*)(v8 + (size_t)ej[j] * DMODEL + 16 * lane); else vb[j] = (v4u){0u, 0u, 0u, 0u}; }
                    float q4[4], q2[2];
#pragma unroll
                    for (int n = 0; n < 4; ++n) { const float keep = h5 ? p[2 * n + 1] : p[2 * n], send = h5 ? p[2 * n] : p[2 * n + 1]; q4[n] = keep + __shfl_xor(send, 32); }
#pragma unroll
                    for (int n = 0; n < 2; ++n) { const float keep = h4 ? q4[2 * n + 1] : q4[2 * n], send = h4 ? q4[2 * n] : q4[2 * n + 1]; q2[n] = keep + __shfl_xor(send, 16); }
                    float tot; { const float keep = h3 ? q2[1] : q2[0], send = h3 ? q2[0] : q2[1]; tot = keep + __shfl_xor(send, 8); }
                    tot += __shfl_xor(tot, 4); tot += __shfl_xor(tot, 2); tot += __shfl_xor(tot, 1);
                    const float act = gelu_fast(tot * sc[0]) * (gate * sc[1]);
#pragma unroll
                    for (int j = 0; j < 8; ++j) { const float aj = __uint_as_float((unsigned)__builtin_amdgcn_readlane((int)__float_as_uint(act), ((j >> 2) & 1) * 8 + ((j >> 1) & 1) * 16 + (j & 1) * 32));
                        const f32x2 a2 = (f32x2){aj, aj};
#pragma unroll
                        for (int c = 0; c < 4; ++c) { const int wd = (int)vb[j][c];
                            y[tk][2 * c] = __builtin_elementwise_fma(__builtin_amdgcn_cvt_pk_f32_fp8(wd, false), a2, y[tk][2 * c]); y[tk][2 * c + 1] = __builtin_elementwise_fma(__builtin_amdgcn_cvt_pk_f32_fp8(wd, true), a2, y[tk][2 * c + 1]); } }
                }
            }
        }
#pragma unroll
        for (int tk = 0; tk < 4; ++tk) { float* xrow = out + (size_t)(t0 + tb + tk) * DMODEL + 16 * lane; float yo[16]; float ss = 0.f;
#pragma unroll
            for (int q = 0; q < 4; ++q) { const f32x4 xa = *(const GAS f32x4*)(xrow + 4 * q);
                yo[4 * q] = y[tk][2 * q][0] + xa[0]; yo[4 * q + 1] = y[tk][2 * q][1] + xa[1]; yo[4 * q + 2] = y[tk][2 * q + 1][0] + xa[2]; yo[4 * q + 3] = y[tk][2 * q + 1][1] + xa[3]; }
#pragma unroll
            for (int q = 0; q < 16; ++q) ss += yo[q] * yo[q];
            const float rs = rsqrtf(wave_sum(ss) * (1.f / DMODEL) + RMS_EPS);
#pragma unroll
            for (int q = 0; q < 4; ++q) { const f32x4 g = *(const GAS f32x4*)(fg + 16 * lane + 4 * q); f32x4 o; o[0] = yo[4 * q] * rs * g[0]; o[1] = yo[4 * q + 1] * rs * g[1]; o[2] = yo[4 * q + 2] * rs * g[2]; o[3] = yo[4 * q + 3] * rs * g[3];
                *(GAS f32x4*)(xrow + 4 * q) = o; } }
    }
}
__device__ __forceinline__ void peer_phase(Frame& F, const Args& a) {
    unsigned char* ws = a.ws;
    for (int tile = F.vcu; tile < T / TOK; tile += F.G) {
        route_tile(F, (const bf16*)(ws + WS_QP), (const bf16*)(ws + WS_SKB), (const float*)(ws + WS_SUMSQ), tile * TOK);
        __syncthreads();
        eval_sweep(F, ws + WS_U8, ws + WS_V8, (const float*)(ws + WS_SU), a.in[19], a.out, tile * TOK);
        __syncthreads();
    }
}
}

namespace lru {
typedef float f32x16 __attribute__((ext_vector_type(16)));
constexpr int TOKT = 128, NTILE = SEQ / TOKT;
constexpr int WAVE_LDS = 14336, L_XS = 0, L_XC = 4608, L_GS = 9216, XC_STRIDE = 72  , L_SS = 8 * WAVE_LDS;
static_assert(L_SS + 32 * 8 * 4 <= RING_BYTES, "LRU LDS map");
__device__ __forceinline__ float bf2f(unsigned short h) { return __uint_as_float((unsigned)h << 16); }
__device__ __forceinline__ int crow16(int r) { return (r & 3) + 8 * (r >> 2); }
__device__ __forceinline__ float sigm(float x) { return __builtin_amdgcn_rcpf(1.f + __builtin_amdgcn_exp2f(-LOG2E * x)); }

template <bool FINAL> __device__ __forceinline__ void lru_tile(Frame& F, const Args& args, int tile) {
    int lane = F.lane; asm volatile("" : "+v"(lane));
    const int w = F.wave, j32 = lane & 31, hi = lane >> 5;
    unsigned char* ws = args.ws;
    const bf16* xr = (const bf16*)(ws + WS_XR); const bf16* gr = (const bf16*)(ws + WS_GR); float* carry = (float*)(ws + WS_CARRY);
    const float* cw = args.in[3]; const float* cb = args.in[4]; const float* ba = args.in[6]; const float* bx = args.in[8]; const float* lam = args.in[9];
    const int b = tile / NTILE, jt = tile % NTILE; const size_t trow0 = (size_t)b * SEQ + (size_t)jt * TOKT;
    LAS unsigned char* wl = F.lds + RING_OFF + w * WAVE_LDS;
    LAS unsigned short* XS = (LAS unsigned short*)(wl + L_XS); LAS unsigned short* XC = (LAS unsigned short*)(wl + L_XC); LAS unsigned short* GS = (LAS unsigned short*)(wl + L_GS);
    LAS float* SS = (LAS float*)(F.lds + RING_OFF + L_SS);
    float c_ba[2], c_bx[2], c_sp[2], c_cb[2], c_cw[2][4];
#pragma unroll
    for (int n = 0; n < 2; ++n) { const int c = 64 * w + 32 * n + j32; c_ba[n] = ba[c]; c_bx[n] = bx[c]; c_cb[n] = cb[c];
        const float l = lam[c]; c_sp[n] = 8.f * LOG2E * (fmaxf(-l, 0.f) + log1pf(expf(-fabsf(l))));
#pragma unroll
        for (int k = 0; k < 4; ++k) c_cw[n][k] = cw[k * LW + c]; }
    const bf16* wax = (const bf16*)(ws + WS_WAX);
    float hc[2] = {0.f, 0.f}, ap[2] = {1.f, 1.f};
    if (FINAL) {
        for (int jp = 0; jp < jt; ++jp) { const float* cp = carry + ((size_t)(b * NTILE + jp) * 2) * LW + 64 * w + j32;
#pragma unroll
            for (int n = 0; n < 2; ++n) hc[n] = cp[32 * n] * hc[n] + cp[LW + 32 * n]; }
    }
    for (int blk = 0; blk < 4; ++blk) {
        const size_t tb = trow0 + blk * 32;
        int ln = lane; asm volatile("" : "+v"(ln));
        const int k32 = ln & 31;
        for (int pc = ln; pc < 35 * 8; pc += 64) { const int row = pc >> 3, c8 = pc & 7; v4u v = (v4u){0u, 0u, 0u, 0u};
            if (!(jt == 0 && blk == 0 && row < 3)) v = *(const GAS v4u*)(xr + (tb + row - 3) * LW + w * 64 + c8 * 8);
            *(LAS v4u*)((LAS unsigned char*)XS + row * 128 + c8 * 16) = v; }
        if (FINAL) {
#pragma unroll
            for (int q = 0; q < 4; ++q) { const int pc = ln + 64 * q, row = pc >> 3, c8 = pc & 7;
                *(LAS v4u*)((LAS unsigned char*)GS + row * 128 + c8 * 16) = *(const GAS v4u*)(gr + (tb + row) * LW + w * 64 + c8 * 8); } }
        asm volatile("" ::: "memory");
        float xc[2][16];
#pragma unroll
        for (int n = 0; n < 2; ++n)
#pragma unroll
            for (int g = 0; g < 4; ++g) { float xv[7];
#pragma unroll
                for (int q = 0; q < 7; ++q) xv[q] = bf2f(XS[(8 * g + 4 * hi + q) * 64 + 32 * n + j32]);
#pragma unroll
                for (int e = 0; e < 4; ++e) xc[n][4 * g + e] = c_cb[n] + ((c_cw[n][0] * xv[e] + c_cw[n][1] * xv[e + 1]) + (c_cw[n][2] * xv[e + 2] + c_cw[n][3] * xv[e + 3])); }
#pragma unroll
        for (int n = 0; n < 2; ++n)
#pragma unroll
            for (int r = 0; r < 16; ++r) XC[(crow16(r) + 4 * hi) * XC_STRIDE + 32 * n + j32] = (unsigned short)f2bf(xc[n][r]);
        asm volatile("" ::: "memory");
        bf16x8 af[4];
#pragma unroll
        for (int ks = 0; ks < 4; ++ks) af[ks] = *(const LAS bf16x8*)(XC + j32 * XC_STRIDE + 16 * ks + 8 * hi);
        asm volatile("" ::: "memory");
        float yv[2][16];
#pragma unroll
        for (int n = 0; n < 2; ++n) {
            f32x16 R = {}, I = {};
            bf16x8 fa[4], fx[4];
#pragma unroll
            for (int ks = 0; ks < 4; ++ks) { fa[ks] = *(const GAS bf16x8*)(wax + (size_t)(((w * 2 + 0) * 2 + n) * 4 + ks) * 512 + lane * 8); fx[ks] = *(const GAS bf16x8*)(wax + (size_t)(((w * 2 + 1) * 2 + n) * 4 + ks) * 512 + lane * 8); }
#pragma unroll
            for (int ks = 0; ks < 4; ++ks) { R = __builtin_amdgcn_mfma_f32_32x32x16_bf16(af[ks], fa[ks], R, 0, 0, 0); I = __builtin_amdgcn_mfma_f32_32x32x16_bf16(af[ks], fx[ks], I, 0, 0, 0); }
            float av[16], uv[16];
#pragma unroll
            for (int r = 0; r < 16; ++r) { const float rg = sigm(R[r] + c_ba[n]), ig = sigm(I[r] + c_bx[n]); const float a_ = __builtin_amdgcn_exp2f(-rg * c_sp[n]);
                av[r] = a_; uv[r] = __builtin_amdgcn_sqrtf(fmaxf(1.f - a_ * a_, 0.f)) * (ig * xc[n][r]); }
            float Ar[4], Hr[4], hst[4];
#pragma unroll
            for (int g = 0; g < 4; ++g) { Ar[g] = (av[4 * g] * av[4 * g + 1]) * (av[4 * g + 2] * av[4 * g + 3]);
                Hr[g] = ((uv[4 * g] * av[4 * g + 1] + uv[4 * g + 1]) * av[4 * g + 2] + uv[4 * g + 2]) * av[4 * g + 3] + uv[4 * g + 3]; }
            float hin = hc[n];
#pragma unroll
            for (int g = 0; g < 4; ++g) { float o1 = Ar[g] * hin + Hr[g]; const float x = __shfl_xor(o1, 32); const float hg = hi ? x : hin; o1 = Ar[g] * hg + Hr[g]; hst[g] = hg;
                const float y = __shfl_xor(o1, 32); hin = hi ? o1 : y;
                if (!FINAL) ap[n] *= Ar[g] * __shfl_xor(Ar[g], 32); }
            hc[n] = hin;
            if (FINAL) {
#pragma unroll
                for (int g = 0; g < 4; ++g) { float h = hst[g];
#pragma unroll
                    for (int e = 0; e < 4; ++e) { const int r = 4 * g + e; h = av[r] * h + uv[r]; yv[n][r] = h * bf2f(GS[(crow16(r) + 4 * hi) * 64 + 32 * n + j32]); } } }
        }
        if (FINAL) {
#pragma unroll
            for (int r = 0; r < 16; ++r) { float s = yv[0][r] * yv[0][r] + yv[1][r] * yv[1][r];
                s += __shfl_xor(s, 1); s += __shfl_xor(s, 2); s += __shfl_xor(s, 4); s += __shfl_xor(s, 8); s += __shfl_xor(s, 16);
                if (j32 == 0) SS[(crow16(r) + 4 * hi) * 8 + w] = s; }
            __syncthreads();
            bf16* ymix = (bf16*)(ws + WS_H);
#pragma unroll
            for (int r = 0; r < 16; ++r) { const int tk = crow16(r) + 4 * hi; const f32x4 s0 = *(const LAS f32x4*)(SS + tk * 8), s1 = *(const LAS f32x4*)(SS + tk * 8 + 4);
                const float rstd = rsqrtf(((s0[0] + s0[1]) + (s0[2] + s0[3]) + (s1[0] + s1[1]) + (s1[2] + s1[3])) * (1.f / LW) + RMS_EPS);
                bf16* yp = ymix + (tb + tk) * DMODEL + 64 * w + k32;
                yp[0] = (bf16)f2bf(yv[0][r] * rstd); yp[32] = (bf16)f2bf(yv[1][r] * rstd); }
            __syncthreads();
        }
    }
    if (!FINAL) { if (hi == 0) { float* cp = carry + ((size_t)(b * NTILE + jt) * 2) * LW + 64 * w + j32;
#pragma unroll
        for (int n = 0; n < 2; ++n) { cp[32 * n] = ap[n]; cp[LW + 32 * n] = hc[n]; } } }
    else {
        const bf16* ob = (const bf16*)(ws + WS_O); bf16* ymix = (bf16*)(ws + WS_H);
        for (int i = 0; i < 16; ++i) { const size_t row = trow0 + 16 * w + i; const v4u v = *(const GAS v4u*)(ob + row * AW + 8 * lane);
            float f[8]; f[0] = __uint_as_float(v.x << 16); f[1] = __uint_as_float(v.x & 0xffff0000u); f[2] = __uint_as_float(v.y << 16); f[3] = __uint_as_float(v.y & 0xffff0000u);
            f[4] = __uint_as_float(v.z << 16); f[5] = __uint_as_float(v.z & 0xffff0000u); f[6] = __uint_as_float(v.w << 16); f[7] = __uint_as_float(v.w & 0xffff0000u);
            float ss = 0.f;
#pragma unroll
            for (int e = 0; e < 8; ++e) ss += f[e] * f[e];
            const float rstd = rsqrtf(wave_sum(ss) * (1.f / AW) + RMS_EPS);
            v4u o; o.x = pk2(f[0] * rstd, f[1] * rstd); o.y = pk2(f[2] * rstd, f[3] * rstd); o.z = pk2(f[4] * rstd, f[5] * rstd); o.w = pk2(f[6] * rstd, f[7] * rstd);
            *(GAS v4u*)(ymix + row * DMODEL + LW + 8 * lane) = o; }
    }
}
template <bool FINAL> __device__ __forceinline__ void lru_phase(Frame& F, const Args& a) {
    for (int tile = F.vcu; tile < BATCH * NTILE; tile += F.G) { lru_tile<FINAL>(F, a, tile); __syncthreads(); }
}
}
__global__ void __launch_bounds__(NWAVES * 64, 2) mk_fwd(Args args) {
    extern __shared__ __attribute__((aligned(16))) unsigned char lds[];
    Frame F;
    F.lds = (LAS unsigned char*)lds;
    F.MISC = (volatile LAS unsigned*)(F.lds + MISC_OFF);
    F.wave = __builtin_amdgcn_readfirstlane((int)threadIdx.x >> 6); F.lane = (int)__builtin_amdgcn_mbcnt_hi(~0u, __builtin_amdgcn_mbcnt_lo(~0u, 0u)); F.tid = F.wave * 64 + F.lane;
    F.G = gridDim.x; { const int bx = blockIdx.x; F.vcu = (F.G % 8 == 0) ? (bx % 8) * (F.G / 8) + bx / 8 : bx; }
    unsigned char* ws = args.ws;
    F.ctl = (gu32*)(ws + WS_CTL);
    for (int u = F.tid; u < (LDS_BYTES - LDSCTL_OFF) / 4; u += NWAVES * 64) ((LAS unsigned*)(F.lds + LDSCTL_OFF))[u] = 0u;
    __syncthreads();
    XcdBarrier bar = xcd_barrier_post((unsigned*)(F.ctl + CW_BAR) + args.li * XCD_BAR_WORDS, F.MISC + 8, F.wave);
    const int lo = args.ph_lo, hi = args.ph_hi;
#ifndef MK_REP_MASK
#define MK_REP_MASK 0
#endif
#define REPS(k) (((MK_REP_MASK >> (k)) & 1) ? 2 : 1)
#define IN(k) (lo <= (k) && (k) < hi)
#define BOTH(k) (IN(k) && IN((k) + 1))
#define GRID_BAR() xcd_barrier(bar)

    if (IN(0)) { for (int rp = 0; rp < REPS(0); ++rp) { if (rp) GRID_BAR(); p0_prologue(F, args); } if (BOTH(0)) GRID_BAR(); }

    if (IN(1)) for (int rp = 0; rp < REPS(1); ++rp) {
        if (rp) GRID_BAR();
        if (F.vcu < BATCH * NHEADS) fcum_unit(F, F.vcu, (const float*)(ws + WS_LOGF), (float*)(ws + WS_FCUM));
        pg8::Gemm g{(const pg8::bf16_t*)(ws + WS_H), (const pg8::bf16_t*)(ws + WS_WIN), T, NG1, DMODEL}; pg8::StaticOrder S; S.init(T, NG1, F.G, (int)blockIdx.x);
        pg8::EpiG1 E{(pg8::bf16_t*)(ws + WS_XR), SPLIT_STRIDE, QSCALE};
        pg8::gemm_phase<pg8::EpiG1, pg8::StaticOrder, true, true>(F.lds + RING_OFF, g, S, E, F.wave);
        if (BOTH(1) && rp == REPS(1) - 1) GRID_BAR();
    }
    if (IN(2)) for (int rp = 0; rp < REPS(2); ++rp) {
        if (rp) GRID_BAR();
        static_assert(attn_body::ATTN_LDS_BYTES <= RING_BYTES, "attention LDS vs frame");
        const attn_body::AttnTensors AT{(const attn_body::bf16*)(ws + WS_Q), (const attn_body::bf16*)(ws + WS_K), (const attn_body::bf16*)(ws + WS_V), (attn_body::bf16*)(ws + WS_O), (const float*)(ws + WS_FCUM)};
        const attn_body::StaticOrder S((int)F.G, (int)blockIdx.x);
        attn_body::attn_phase<attn_body::StaticOrder>((char*)lds + RING_OFF, AT, S, F.wave);
    }
    if (IN(3)) { for (int rp = 0; rp < REPS(3); ++rp) { if (rp) GRID_BAR(); lru::lru_phase<false>(F, args); } if (BOTH(3)) GRID_BAR(); }
    if (IN(4)) { for (int rp = 0; rp < REPS(4); ++rp) { if (rp) GRID_BAR(); lru::lru_phase<true>(F, args); } if (BOTH(4)) GRID_BAR(); }
    if (IN(5)) {
        pg8::Gemm g{(const pg8::bf16_t*)(ws + WS_H), (const pg8::bf16_t*)(ws + WS_WOUT), T, DMODEL, DMODEL}; pg8::StaticOrder S; S.init(T, DMODEL, F.G, (int)blockIdx.x);
        pg8::EpiG2 E{args.in[0], args.out, (pg8::bf16_t*)(ws + WS_X1B), (float*)(ws + WS_SUMSQ), DMODEL};
        pg8::gemm_phase<pg8::EpiG2, pg8::StaticOrder, true, true>(F.lds + RING_OFF, g, S, E, F.wave);
        if (BOTH(5)) GRID_BAR();
    }
    if (IN(6)) for (int rp = 0; rp < REPS(6); ++rp) {
        if (rp) GRID_BAR();
        pg8::Gemm g{(const pg8::bf16_t*)(ws + WS_X1B), (const pg8::bf16_t*)(ws + WS_WQ), T, QPW, DMODEL}; pg8::StaticOrder S; S.init(T, QPW, F.G, (int)blockIdx.x);
        pg8::EpiG3 E{(pg8::bf16_t*)(ws + WS_QP), QPW};
        pg8::gemm_phase<pg8::EpiG3, pg8::StaticOrder, true, true>(F.lds + RING_OFF, g, S, E, F.wave);
        if (BOTH(6) && rp == REPS(6) - 1) GRID_BAR();
    }
    if (IN(7)) { peer::peer_phase(F, args); }
#undef IN
#undef BOTH
#undef GRID_BAR
}

#ifndef MK_FRAME_MASK
#define MK_FRAME_MASK 0xFF
#endif
extern "C" void kernel_launch(void* const* d_in, const int* in_sizes, int n_in, void* d_out, int out_size, void* d_ws, size_t ws_size, hipStream_t stream) {
    static int grid = 0;
    if (grid == 0) {
        if (n_in != 20 || in_sizes[0] != T * DMODEL || out_size != T * DMODEL || ws_size < WS_END) { fprintf(stderr, "kernel_launch: unexpected shapes (n_in %d, ws %zu)\n", n_in, ws_size); grid = -1; return; }
        int dev = 0, cus = 0;
        if (hipGetDevice(&dev) != hipSuccess || hipDeviceGetAttribute(&cus, hipDeviceAttributeMultiprocessorCount, dev) != hipSuccess) { grid = -1; return; }
        if (hipFuncSetAttribute((const void*)mk_fwd, hipFuncAttributeMaxDynamicSharedMemorySize, LDS_BYTES) != hipSuccess) { fprintf(stderr, "kernel_launch: hipFuncSetAttribute failed\n"); grid = -1; return; }
        (void)hipGetLastError();
        grid = cus;
    }
    if (grid < 0) return;
    using namespace naive;
    const float* x = (const float*)d_in[0]; const float* g1 = (const float*)d_in[1]; const float* w_in = (const float*)d_in[2];
    const float* cw = (const float*)d_in[3]; const float* cb = (const float*)d_in[4]; const float* wa = (const float*)d_in[5]; const float* ba = (const float*)d_in[6];
    const float* wx = (const float*)d_in[7]; const float* bx = (const float*)d_in[8]; const float* lam = (const float*)d_in[9]; const float* bfv = (const float*)d_in[10];
    const float* gn_l = (const float*)d_in[11]; const float* gn_f = (const float*)d_in[12]; const float* w_out = (const float*)d_in[13]; const float* g2 = (const float*)d_in[14];
    const float* w_q = (const float*)d_in[15]; const float* sk = (const float*)d_in[16]; const float* pu = (const float*)d_in[17]; const float* pv = (const float*)d_in[18]; const float* fg = (const float*)d_in[19];
    char* ws = (char*)d_ws; float* out = (float*)d_out;
    naive::bf16* win_t = (naive::bf16*)(ws + WS_WIN); naive::bf16* wout_t = (naive::bf16*)(ws + WS_WOUT); naive::bf16* wq_t = (naive::bf16*)(ws + WS_WQ); naive::bf16* skb = (naive::bf16*)(ws + WS_SKB); float* wfl = (float*)(ws + WS_WFL);
    float* logf = (float*)(ws + WS_LOGF); float* fcum = (float*)(ws + WS_FCUM); float* sumsq = (float*)(ws + WS_SUMSQ);
    naive::bf16* h = (naive::bf16*)(ws + WS_H); naive::bf16* xr = (naive::bf16*)(ws + WS_XR); naive::bf16* gr = (naive::bf16*)(ws + WS_GR); naive::bf16* q = (naive::bf16*)(ws + WS_Q); naive::bf16* k = (naive::bf16*)(ws + WS_K); naive::bf16* v = (naive::bf16*)(ws + WS_V);
    naive::bf16* x1b = (naive::bf16*)(ws + WS_X1B); naive::bf16* qp = (naive::bf16*)(ws + WS_QP); naive::bf16* ut = (naive::bf16*)(ws + WS_UT); naive::bf16* vt = (naive::bf16*)(ws + WS_VT); float* la = (float*)(ws + WS_LA); float* lu = (float*)(ws + WS_LU);
    naive::bf16* ymix = h;
    if (hipMemsetAsync((char*)d_ws + WS_CTL, 0, CTL_ZERO_BYTES, stream) != hipSuccess) return;
    Args a{};
    for (int i = 0; i < 20; ++i) a.in[i] = (const float*)d_in[i];
    a.out = out; a.ws = (unsigned char*)d_ws;
    int li = 0;
    for (int p = 0; p < N_PHASES;) {
        if ((MK_FRAME_MASK >> p) & 1) {
            int e = p; while (e < N_PHASES && ((MK_FRAME_MASK >> e) & 1)) ++e;
            a.ph_lo = p; a.ph_hi = e; a.li = li++;
            hipLaunchKernelGGL(mk_fwd, dim3(grid), dim3(NWAVES * 64), LDS_BYTES, stream, a);
            p = e; continue;
        }
        switch (p) {
        case 0: k_prep_w<<<2048, 256, 0, stream>>>(w_in, w_out, gn_l, gn_f, w_q, g2, sk, win_t, wfl, wout_t, wq_t, skb);
                k_prep_tab<<<4096, 256, 0, stream>>>(pu, pv, g2, ut, vt);
                k_prep_x<<<2048, 256, 0, stream>>>(x, g1, wfl, bfv, h, logf); break;
        case 1: k_fcum<<<BATCH * NHEADS, 64, 0, stream>>>(logf, fcum);
                { EpiArgs e{xr, gr, q, k, v, nullptr, nullptr}; k_gemm<1><<<dim3(NG1 / 64, T / 64), 256, 0, stream>>>(h, win_t, T, NG1, DMODEL, e); } break;
        case 2: k_attn<<<(BATCH * NHEADS * SEQ) / 4, 256, 0, stream>>>(q, k, v, fcum, q); break;
        case 3: break;
        case 4: k_lru_gates<<<T * NHEADS, 64, 0, stream>>>(xr, cw, cb, wa, ba, wx, bx, lam, la, lu);
                k_lru_scan<<<(BATCH * LW + 63) / 64, 64, 0, stream>>>(la, lu, gr);
                k_ymix<<<2048, 256, 0, stream>>>(lu, q, ymix); break;
        case 5: { EpiArgs e{x1b, nullptr, nullptr, nullptr, nullptr, x, out}; k_gemm<2><<<dim3(DMODEL / 64, T / 64), 256, 0, stream>>>(ymix, wout_t, T, DMODEL, DMODEL, e); }
                k_sumsq<<<2048, 256, 0, stream>>>(out, sumsq); break;
        case 6: { EpiArgs e{qp, nullptr, nullptr, nullptr, nullptr, nullptr, nullptr}; k_gemm<3><<<dim3(QPW / 64, T / 64), 256, 0, stream>>>(x1b, wq_t, T, QPW, DMODEL, e); } break;
        case 7: k_peer<<<T, 64, 0, stream>>>(qp, skb, sumsq, ut, vt, fg, out); break;
        }
        ++p;
    }
}
```

```cpp
#include <hip/hip_runtime.h>
#include <hip/hip_bf16.h>
#include <cstdio>
#include <cstdint>
#include <cmath>

constexpr int BATCH = 4, SEQ = 8192, DMODEL = 1024, T = BATCH * SEQ;
constexpr int LW = 512, AW = 512, NHEADS = 8, HD = 64, INC = 2568, NG1 = 2560;
constexpr int PH = 8, NKEY = 128, PHALF = 128, TOPK = 16, NEXP = NKEY * NKEY, QPW = 2048;
constexpr float RMS_EPS = 1e-6f;
constexpr float LOG2E = 1.4426950408889634f;
constexpr float QSCALE = 0.125f * LOG2E;
constexpr size_t MiB = 1u << 20;
constexpr size_t WS_CTL = 0, CTL_ZERO_BYTES = 1 * MiB;
constexpr size_t WS_WIN = 2 * MiB, WS_WOUT = 8 * MiB, WS_WQ = 10 * MiB, WS_SKB = 14 * MiB, WS_WFL = 15 * MiB,
                 WS_LOGF = 16 * MiB, WS_FCUM = 17 * MiB, WS_CARRY = 18 * MiB, WS_SUMSQ = 19 * MiB, WS_WAX = 20 * MiB, WS_NRM = 22 * MiB  ,
                 WS_H = 32 * MiB, WS_XR = 96 * MiB, WS_GR = 128 * MiB, WS_Q = 160 * MiB, WS_K = 192 * MiB, WS_V = 224 * MiB,
                 WS_X1B = 256 * MiB, WS_O = 256 * MiB  , WS_QP = 96 * MiB, WS_UT = 320 * MiB, WS_VT = 352 * MiB, WS_U8 = 320 * MiB, WS_V8 = 336 * MiB, WS_SU = 21 * MiB, WS_SV = 21 * MiB + 65536, WS_LA = 384 * MiB, WS_LU = 448 * MiB, WS_END = 512 * MiB;
constexpr size_t SPLIT_STRIDE = (WS_GR - WS_XR) / 2;
constexpr int CW_TMO = 0, CW_ATTQ = 2048, CW_BAR = 4096;

namespace naive {
typedef unsigned short bf16;
__device__ __forceinline__ unsigned f2bf(float f) { unsigned u = __builtin_bit_cast(unsigned, f); return (u + 0x7fffu + ((u >> 16) & 1u)) >> 16; }
__device__ __forceinline__ float bf2f(unsigned short h) { return __builtin_bit_cast(float, (unsigned)h << 16); }
__device__ __forceinline__ float gelu_tanh(float x) { const float u = 0.7978845608028654f * (x + 0.044715f * x * x * x); return 0.5f * x * (1.f + tanhf(u)); }
__device__ __forceinline__ float sigmoidf_(float x) { return 1.f / (1.f + expf(-x)); }
__device__ __forceinline__ float wave_sum(float v) {
#pragma unroll
    for (int o = 1; o < 64; o <<= 1) v += __shfl_xor(v, o);
    return v;
}
__global__ void k_prep_w(const float* w_in, const float* w_out, const float* gn_l, const float* gn_f, const float* w_q, const float* g2, const float* sk,
                         bf16* win_t, float* wfl, bf16* wout_t, bf16* wq_t, bf16* skb) {
    const size_t gid = (size_t)blockIdx.x * blockDim.x + threadIdx.x, gsz = (size_t)gridDim.x * blockDim.x;
    for (size_t i = gid; i < (size_t)NG1 * DMODEL; i += gsz) { const int n = (int)(i / DMODEL), k = (int)(i % DMODEL); win_t[i] = (bf16)f2bf(w_in[(size_t)k * INC + n]); }
    for (size_t i = gid; i < (size_t)8 * DMODEL; i += gsz) { const int j = (int)(i / DMODEL), k = (int)(i % DMODEL); wfl[i] = w_in[(size_t)k * INC + NG1 + j]; }
    for (size_t i = gid; i < (size_t)DMODEL * DMODEL; i += gsz) { const int n = (int)(i / DMODEL), k = (int)(i % DMODEL); const float g = k < LW ? gn_l[k] : gn_f[k - LW]; wout_t[i] = (bf16)f2bf(g * w_out[(size_t)k * DMODEL + n]); }
    for (size_t i = gid; i < (size_t)QPW * DMODEL; i += gsz) { const int n = (int)(i / DMODEL), k = (int)(i % DMODEL); wq_t[i] = (bf16)f2bf(g2[k] * w_q[(size_t)k * QPW + n]); }
    for (size_t i = gid; i < (size_t)PH * 2 * NKEY * PHALF; i += gsz) skb[i] = (bf16)f2bf(sk[i]);
}
__global__ void k_prep_tab(const float* u, const float* v, const float* g2, bf16* ut, bf16* vt) {
    const size_t gid = (size_t)blockIdx.x * blockDim.x + threadIdx.x, gsz = (size_t)gridDim.x * blockDim.x;
    for (size_t i = gid; i < (size_t)NEXP * DMODEL; i += gsz) { const int d = (int)(i % DMODEL); ut[i] = (bf16)f2bf(g2[d] * u[i]); vt[i] = (bf16)f2bf(v[i]); }
}
__global__ void k_prep_x(const float* x, const float* g1, const float* wfl, const float* bfv, bf16* h, float* logf) {
    const int lane = threadIdx.x & 63, wv = (blockIdx.x * blockDim.x + threadIdx.x) >> 6, nw = (gridDim.x * blockDim.x) >> 6;
    for (int t = wv; t < T; t += nw) {
        float xv[16]; float ss = 0.f;
#pragma unroll
        for (int j = 0; j < 4; ++j) { const float4 v = *(const float4*)(x + (size_t)t * DMODEL + j * 256 + lane * 4); xv[4 * j] = v.x; xv[4 * j + 1] = v.y; xv[4 * j + 2] = v.z; xv[4 * j + 3] = v.w; ss += v.x * v.x + v.y * v.y + v.z * v.z + v.w * v.w; }
        const float rstd = rsqrtf(wave_sum(ss) * (1.f / DMODEL) + RMS_EPS);
#pragma unroll
        for (int j = 0; j < 4; ++j) { const float4 g = *(const float4*)(g1 + j * 256 + lane * 4); xv[4 * j] *= rstd * g.x; xv[4 * j + 1] *= rstd * g.y; xv[4 * j + 2] *= rstd * g.z; xv[4 * j + 3] *= rstd * g.w;
            uint2 o; o.x = f2bf(xv[4 * j]) | (f2bf(xv[4 * j + 1]) << 16); o.y = f2bf(xv[4 * j + 2]) | (f2bf(xv[4 * j + 3]) << 16); *(uint2*)(h + (size_t)t * DMODEL + j * 256 + lane * 4) = o; }
#pragma unroll
        for (int hh = 0; hh < 8; ++hh) { float a = 0.f;
#pragma unroll
            for (int j = 0; j < 4; ++j) { const float4 w = *(const float4*)(wfl + hh * DMODEL + j * 256 + lane * 4); a += xv[4 * j] * w.x + xv[4 * j + 1] * w.y + xv[4 * j + 2] * w.z + xv[4 * j + 3] * w.w; }
            a = wave_sum(a);
            if (lane == 0) { const float z = a + bfv[hh]; logf[(size_t)t * 8 + hh] = fminf(z, 0.f) - log1pf(expf(-fabsf(z))); } }
    }
}
__global__ void k_fcum(const float* logf, float* fcum) {
    const int lane = threadIdx.x & 63, bh = blockIdx.x, b = bh / NHEADS, hh = bh % NHEADS;
    float loc = 0.f;
    for (int i = 0; i < 128; ++i) loc += logf[((size_t)b * SEQ + lane * 128 + i) * 8 + hh];
    float inc = loc;
#pragma unroll
    for (int o = 1; o < 64; o <<= 1) { const float n = __shfl_up(inc, o); if (lane >= o) inc += n; }
    float run = inc - loc;
    for (int i = 0; i < 128; ++i) { run += logf[((size_t)b * SEQ + lane * 128 + i) * 8 + hh]; fcum[(size_t)bh * SEQ + lane * 128 + i] = run; }
}
struct EpiArgs { bf16* o0; bf16* o1; bf16* o2; bf16* o3; bf16* o4; const float* resid; float* outf; };
template <int EPI> __global__ void __launch_bounds__(256) k_gemm(const bf16* A, const bf16* Bt, int M, int N, int K, EpiArgs e) {
    __shared__ float As[32][65], Bs[32][65];
    const int tid = threadIdx.x, tx = tid & 15, ty = tid >> 4, m0 = blockIdx.y * 64, n0 = blockIdx.x * 64;
    float acc[4][4] = {};
    const int lr = tid >> 2, lc = (tid & 3) * 8;
    for (int k0 = 0; k0 < K; k0 += 32) {
        const uint4 av = *(const uint4*)(A + (size_t)(m0 + lr) * K + k0 + lc), bv = *(const uint4*)(Bt + (size_t)(n0 + lr) * K + k0 + lc);
        const unsigned aw[4] = {av.x, av.y, av.z, av.w}, bw[4] = {bv.x, bv.y, bv.z, bv.w};
#pragma unroll
        for (int i = 0; i < 4; ++i) { As[lc + 2 * i][lr] = bf2f(aw[i] & 0xffff); As[lc + 2 * i + 1][lr] = bf2f(aw[i] >> 16); Bs[lc + 2 * i][lr] = bf2f(bw[i] & 0xffff); Bs[lc + 2 * i + 1][lr] = bf2f(bw[i] >> 16); }
        __syncthreads();
#pragma unroll 8
        for (int k = 0; k < 32; ++k) { float a[4], b[4];
#pragma unroll
            for (int i = 0; i < 4; ++i) { a[i] = As[k][ty * 4 + i]; b[i] = Bs[k][tx * 4 + i]; }
#pragma unroll
            for (int i = 0; i < 4; ++i)
#pragma unroll
                for (int j = 0; j < 4; ++j) acc[i][j] += a[i] * b[j]; }
        __syncthreads();
    }
#pragma unroll
    for (int i = 0; i < 4; ++i)
#pragma unroll
        for (int j = 0; j < 4; ++j) { const int m = m0 + ty * 4 + i, n = n0 + tx * 4 + j; const float v = acc[i][j];
            if (EPI == 1) { const int s = n >> 9, c = n & 511; bf16* o = s == 0 ? e.o0 : s == 1 ? e.o1 : s == 2 ? e.o2 : s == 3 ? e.o3 : e.o4;
                const float w = s == 1 ? gelu_tanh(v) : s == 2 ? v * QSCALE : v; o[(size_t)m * 512 + c] = (bf16)f2bf(w); }
            else if (EPI == 2) { const float r = e.resid[(size_t)m * DMODEL + n] + v; e.outf[(size_t)m * DMODEL + n] = r; e.o0[(size_t)m * DMODEL + n] = (bf16)f2bf(r); }
            else { e.o0[(size_t)m * N + n] = (bf16)f2bf(v); } }
}
__global__ void k_sumsq(const float* x1, float* sumsq) {
    const int lane = threadIdx.x & 63, wv = (blockIdx.x * blockDim.x + threadIdx.x) >> 6, nw = (gridDim.x * blockDim.x) >> 6;
    for (int t = wv; t < T; t += nw) { float ss = 0.f;
#pragma unroll
        for (int j = 0; j < 4; ++j) { const float4 v = *(const float4*)(x1 + (size_t)t * DMODEL + j * 256 + lane * 4); ss += v.x * v.x + v.y * v.y + v.z * v.z + v.w * v.w; }
        ss = wave_sum(ss); if (lane == 0) sumsq[t] = ss; }
}
__global__ void k_lru_gates(const bf16* xr, const float* cw, const float* cb, const float* wa, const float* ba, const float* wx, const float* bx, const float* lam, float* la, float* lu) {
    __shared__ float xc[64];
    const int j = threadIdx.x, t = blockIdx.x / NHEADS, hh = blockIdx.x % NHEADS, ch = hh * 64 + j, s = t % SEQ;
    float c = cb[ch];
#pragma unroll
    for (int k = 0; k < 4; ++k) { const int ss = s - 3 + k; if (ss >= 0) c += cw[k * LW + ch] * bf2f(xr[(size_t)(t - 3 + k) * LW + ch]); }
    xc[j] = c; __syncthreads();
    float r = ba[ch], ii = bx[ch];
    for (int i = 0; i < 64; ++i) { const float xv = xc[i]; r += xv * wa[(size_t)(hh * 64 + i) * 64 + j]; ii += xv * wx[(size_t)(hh * 64 + i) * 64 + j]; }
    r = sigmoidf_(r); ii = sigmoidf_(ii);
    const float l = lam[ch], sp = fmaxf(-l, 0.f) + log1pf(expf(-fabsf(l)));
    const float log_a = -8.f * r * sp, a = expf(log_a), u = sqrtf(-expm1f(2.f * log_a)) * (ii * c);
    la[(size_t)t * LW + ch] = a; lu[(size_t)t * LW + ch] = u;
}
__global__ void k_lru_scan(const float* la, float* lu, const bf16* gr) {
    const int id = blockIdx.x * blockDim.x + threadIdx.x; if (id >= BATCH * LW) return;
    const int b = id / LW, ch = id % LW; float h = 0.f;
    for (int s = 0; s < SEQ; ++s) { const size_t o = ((size_t)b * SEQ + s) * LW + ch; h = la[o] * h + lu[o]; lu[o] = h * bf2f(gr[o]); }
}
__global__ void k_ymix(const float* ylru, const bf16* o, bf16* ymix) {
    const int lane = threadIdx.x & 63, wv = (blockIdx.x * blockDim.x + threadIdx.x) >> 6, nw = (gridDim.x * blockDim.x) >> 6;
    for (int t = wv; t < T; t += nw) {
        float a[8], f[8]; float sa = 0.f, sf = 0.f;
#pragma unroll
        for (int i = 0; i < 8; ++i) { a[i] = ylru[(size_t)t * LW + i * 64 + lane]; f[i] = bf2f(o[(size_t)t * AW + i * 64 + lane]); sa += a[i] * a[i]; sf += f[i] * f[i]; }
        const float ra = rsqrtf(wave_sum(sa) * (1.f / LW) + RMS_EPS), rf = rsqrtf(wave_sum(sf) * (1.f / AW) + RMS_EPS);
#pragma unroll
        for (int i = 0; i < 8; ++i) { ymix[(size_t)t * DMODEL + i * 64 + lane] = (bf16)f2bf(a[i] * ra); ymix[(size_t)t * DMODEL + LW + i * 64 + lane] = (bf16)f2bf(f[i] * rf); }
    }
}
__global__ void __launch_bounds__(256) k_attn(const bf16* Q, const bf16* K, const bf16* V, const float* fcum, bf16* O) {
    const int lane = threadIdx.x & 63, wv = (blockIdx.x * blockDim.x + threadIdx.x) >> 6;
    const int q = wv % SEQ, bh = wv / SEQ, b = bh / NHEADS, hh = bh % NHEADS;
    const size_t rowq = (size_t)b * SEQ + q;
    float qv[64];
#pragma unroll
    for (int i = 0; i < 8; ++i) { const uint4 w = *(const uint4*)(Q + rowq * AW + hh * 64 + i * 8); const unsigned ww[4] = {w.x, w.y, w.z, w.w};
#pragma unroll
        for (int c = 0; c < 4; ++c) { qv[i * 8 + 2 * c] = bf2f(ww[c] & 0xffff); qv[i * 8 + 2 * c + 1] = bf2f(ww[c] >> 16); } }
    const float fq = fcum[(size_t)bh * SEQ + q];
    float m = -INFINITY, l = 0.f; float o[64];
#pragma unroll
    for (int d = 0; d < 64; ++d) o[d] = 0.f;
    for (int j = lane; j <= q; j += 64) {
        const size_t rowk = (size_t)b * SEQ + j; float s = 0.f;
#pragma unroll
        for (int i = 0; i < 8; ++i) { const uint4 w = *(const uint4*)(K + rowk * AW + hh * 64 + i * 8); const unsigned ww[4] = {w.x, w.y, w.z, w.w};
#pragma unroll
            for (int c = 0; c < 4; ++c) { s += qv[i * 8 + 2 * c] * bf2f(ww[c] & 0xffff) + qv[i * 8 + 2 * c + 1] * bf2f(ww[c] >> 16); } }
        s += (fq - fcum[(size_t)bh * SEQ + j]) * LOG2E;
        const float mn = fmaxf(m, s), sc = exp2f(m - mn), p = exp2f(s - mn);
        l = l * sc + p; m = mn;
#pragma unroll
        for (int i = 0; i < 8; ++i) { const uint4 w = *(const uint4*)(V + rowk * AW + hh * 64 + i * 8); const unsigned ww[4] = {w.x, w.y, w.z, w.w};
#pragma unroll
            for (int c = 0; c < 4; ++c) { o[i * 8 + 2 * c] = o[i * 8 + 2 * c] * sc + p * bf2f(ww[c] & 0xffff); o[i * 8 + 2 * c + 1] = o[i * 8 + 2 * c + 1] * sc + p * bf2f(ww[c] >> 16); } }
    }
    float mall = m;
#pragma unroll
    for (int of = 1; of < 64; of <<= 1) mall = fmaxf(mall, __shfl_xor(mall, of));
    const float sc = (m == -INFINITY) ? 0.f : exp2f(m - mall);
    const float lt = wave_sum(l * sc); const float inv = 1.f / lt;
    float mine = 0.f;
#pragma unroll
    for (int d = 0; d < 64; ++d) { const float v = wave_sum(o[d] * sc); if (lane == d) mine = v; }
    O[rowq * AW + hh * 64 + lane] = (bf16)f2bf(mine * inv);
}
__device__ __forceinline__ void wave_argmax(float v, int idx, float& bv, int& bi) {
#pragma unroll
    for (int o = 1; o < 64; o <<= 1) { const float ov = __shfl_xor(v, o); const int oi = __shfl_xor(idx, o); if (ov > v || (ov == v && oi < idx)) { v = ov; idx = oi; } }
    bv = v; bi = idx;
}
__global__ void __launch_bounds__(64) k_peer(const bf16* qp, const bf16* skb, const float* sumsq, const bf16* ut, const bf16* vt, const float* fg, float* out) {
    __shared__ float qs[2048]; __shared__ float sc[256]; __shared__ float s1[16], s2[16]; __shared__ int i1[16], i2[16]; __shared__ int ex[128]; __shared__ float gt[128];
    const int lane = threadIdx.x, t = blockIdx.x;
    const float rstd2 = rsqrtf(sumsq[t] * (1.f / DMODEL) + RMS_EPS);
    for (int i = lane; i < 2048; i += 64) qs[i] = bf2f(qp[(size_t)t * 2048 + i]) * rstd2;
    __syncthreads();
    for (int hh = 0; hh < PH; ++hh) {
        for (int r = 0; r < 4; ++r) { const int idx = r * 64 + lane, p = idx >> 7, n = idx & 127; const bf16* kr = skb + ((size_t)(hh * 2 + p) * NKEY + n) * PHALF; const float* qq = qs + hh * 256 + p * 128;
            float a = 0.f; for (int c = 0; c < 128; ++c) a += qq[c] * bf2f(kr[c]); sc[idx] = a; }
        __syncthreads();
        for (int p = 0; p < 2; ++p) {
            float v0 = sc[p * 128 + lane], v1 = sc[p * 128 + 64 + lane];
            for (int k = 0; k < 16; ++k) { float v; int id; if (v0 >= v1) { v = v0; id = lane; } else { v = v1; id = lane + 64; }
                float bv; int bi; wave_argmax(v, id, bv, bi);
                if (lane == 0) { if (p == 0) { s1[k] = bv; i1[k] = bi; } else { s2[k] = bv; i2[k] = bi; } }
                if (bi == lane) v0 = -INFINITY; if (bi == lane + 64) v1 = -INFINITY; }
        }
        __syncthreads();
        float cv[4];
#pragma unroll
        for (int r = 0; r < 4; ++r) { const int idx = r * 64 + lane; cv[r] = s1[idx >> 4] + s2[idx & 15]; }
        float tops = 0.f; int topp = 0;
        for (int k = 0; k < 16; ++k) { float v = cv[0]; int id = lane;
#pragma unroll
            for (int r = 1; r < 4; ++r) if (cv[r] > v) { v = cv[r]; id = r * 64 + lane; }
            float bv; int bi; wave_argmax(v, id, bv, bi);
            if (lane == k) { tops = bv; topp = bi; }
#pragma unroll
            for (int r = 0; r < 4; ++r) if (bi == r * 64 + lane) cv[r] = -INFINITY; }
        float mx = lane < 16 ? tops : -INFINITY;
#pragma unroll
        for (int o = 1; o < 64; o <<= 1) mx = fmaxf(mx, __shfl_xor(mx, o));
        const float ev = lane < 16 ? expf(tops - mx) : 0.f; const float den = wave_sum(ev);
        if (lane < 16) { ex[hh * 16 + lane] = i1[topp >> 4] * NKEY + i2[topp & 15]; gt[hh * 16 + lane] = ev / den; }
        __syncthreads();
    }
    float hv[16], y[16];
    const float* x1 = out + (size_t)t * DMODEL;
#pragma unroll
    for (int j = 0; j < 4; ++j) { const float4 v = *(const float4*)(x1 + j * 256 + lane * 4); hv[4 * j] = v.x * rstd2; hv[4 * j + 1] = v.y * rstd2; hv[4 * j + 2] = v.z * rstd2; hv[4 * j + 3] = v.w * rstd2; }
#pragma unroll
    for (int i = 0; i < 16; ++i) y[i] = 0.f;
    for (int k = 0; k < 128; ++k) { const int e = ex[k]; const float g = gt[k]; float a = 0.f;
#pragma unroll
        for (int j = 0; j < 4; ++j) { const uint2 w = *(const uint2*)(ut + (size_t)e * DMODEL + j * 256 + lane * 4);
            a += hv[4 * j] * bf2f(w.x & 0xffff) + hv[4 * j + 1] * bf2f(w.x >> 16) + hv[4 * j + 2] * bf2f(w.y & 0xffff) + hv[4 * j + 3] * bf2f(w.y >> 16); }
        a = wave_sum(a); const float act = gelu_tanh(a) * g;
#pragma unroll
        for (int j = 0; j < 4; ++j) { const uint2 w = *(const uint2*)(vt + (size_t)e * DMODEL + j * 256 + lane * 4);
            y[4 * j] += act * bf2f(w.x & 0xffff); y[4 * j + 1] += act * bf2f(w.x >> 16); y[4 * j + 2] += act * bf2f(w.y & 0xffff); y[4 * j + 3] += act * bf2f(w.y >> 16); } }
    float ss = 0.f;
#pragma unroll
    for (int j = 0; j < 4; ++j) { const float4 v = *(const float4*)(x1 + j * 256 + lane * 4); y[4 * j] += v.x; y[4 * j + 1] += v.y; y[4 * j + 2] += v.z; y[4 * j + 3] += v.w; }
#pragma unroll
    for (int i = 0; i < 16; ++i) ss += y[i] * y[i];
    const float rs = rsqrtf(wave_sum(ss) * (1.f / DMODEL) + RMS_EPS);
#pragma unroll
    for (int j = 0; j < 4; ++j) { const float4 g = *(const float4*)(fg + j * 256 + lane * 4); float4 o; o.x = y[4 * j] * rs * g.x; o.y = y[4 * j + 1] * rs * g.y; o.z = y[4 * j + 2] * rs * g.z; o.w = y[4 * j + 3] * rs * g.w;
        *(float4*)(out + (size_t)t * DMODEL + j * 256 + lane * 4) = o; }
}
}

namespace pg8 {
#define PG8_LAS __attribute__((address_space(3)))
typedef unsigned short bf16_t;
typedef short bf16x8 __attribute__((ext_vector_type(8)));
typedef float f32x4 __attribute__((ext_vector_type(4)));
typedef unsigned u32x4 __attribute__((ext_vector_type(4)));
constexpr int BM = 256, BK = 64, HALF = 128, HTB = HALF * BK * 2  , STAGE_BYTES = 8 * HTB, NXCD = 8, WGM = 8;

__host__ __device__ __forceinline__ int lds_byte(int r, int c) { const int st = (r >> 4) * 2 + (c >> 5), rr = r & 15, cc = c & 31, ob = rr * 64 + cc * 2; return st * 1024 + (ob ^ (((ob >> 9) & 1) << 5)); }
__host__ __device__ __forceinline__ void stage_rc(int b, int& R, int& C) { const int st = b / 1024, sb = b % 1024, swz = sb ^ (((sb >> 9) & 1) << 5); R = (st >> 1) * 16 + swz / 64; C = (st & 1) * 32 + (swz % 64) / 2; }
__host__ __device__ __forceinline__ int perm32(int rho) { const int n = rho >> 4, i = rho & 15; return 8 * (i >> 2) + 4 * n + (i & 3); }

struct Unit { int pm, pn; };
struct Gemm { const bf16_t* A; const bf16_t* Bt; int M, N, K; };

struct StaticOrder {
    int nM, nN, nwg, G, c;
    __host__ __device__ void init(int M, int N, int G_, int c_) { nM = M / BM; nN = N / BM; nwg = nM * nN; G = G_; c = c_; }
    __host__ __device__ bool next(int i, Unit& u) const {
        const long L = (long)i * G + c; if (L >= nwg) return false;
        int wgid = (int)L; { const int q = nwg / NXCD, r = nwg % NXCD, xcd = wgid % NXCD, off = wgid / NXCD; wgid = (xcd < r ? xcd * (q + 1) : r * (q + 1) + (xcd - r) * q) + off; }
        const int nig = WGM * nN, gid = wgid / nig, fm = gid * WGM, gsz = (nM - fm) < WGM ? (nM - fm) : WGM;
        u.pm = fm + ((wgid % nig) % gsz); u.pn = (wgid % nig) / gsz; return true;
    }
    __device__ __forceinline__ void a_ready(const Unit&) const {}
    __device__ __forceinline__ void done(const Unit&) const {}
};

__device__ __forceinline__ unsigned cvt_pk_bf16(float lo, float hi) { unsigned r; asm volatile("v_cvt_pk_bf16_f32 %0, %1, %2" : "=v"(r) : "v"(lo), "v"(hi)); return r; }
typedef unsigned u32x2 __attribute__((ext_vector_type(2)));
__device__ __forceinline__ float gelu_fast(float x) {
    const float u2 = x * (1.5957691216057308f + 0.07135481627f * x * x);
    return x * __builtin_amdgcn_rcpf(1.f + __builtin_amdgcn_exp2f(-1.4426950408889634f * u2));
}
struct EpiG1 {
    static constexpr bool PERM = true, AFTER_DRAIN = false;
    bf16_t* base0; size_t split_stride; float qscale;
    __device__ __forceinline__ void operator()(const f32x4 (&acc)[2][2][4][2], const Unit& u, int wr, int wc, int fr, int fq) const {
        const int s = u.pn >> 1; bf16_t* base = base0 + (size_t)s * split_stride;
        const int row0 = u.pm * BM + wr * 64 + fr, col0 = (u.pn & 1) * 256 + wc * 32 + 8 * fq;
#pragma unroll
        for (int ai = 0; ai < 2; ++ai)
#pragma unroll
            for (int m = 0; m < 4; ++m) { bf16_t* rowp = base + (size_t)(row0 + ai * HALF + m * 16) * 512 + col0;
#pragma unroll
                for (int bj = 0; bj < 2; ++bj) { f32x4 v0 = acc[ai][bj][m][0], v1 = acc[ai][bj][m][1];
                    if (s == 1) {
#pragma unroll
                        for (int e = 0; e < 4; ++e) { v0[e] = gelu_fast(v0[e]); v1[e] = gelu_fast(v1[e]); } }
                    else if (s == 2) { v0 = v0 * qscale; v1 = v1 * qscale; }
                    u32x4 w; w.x = cvt_pk_bf16(v0[0], v0[1]); w.y = cvt_pk_bf16(v0[2], v0[3]); w.z = cvt_pk_bf16(v1[0], v1[1]); w.w = cvt_pk_bf16(v1[2], v1[3]);
                    *(u32x4*)(rowp + bj * HALF) = w; } }
    }
};
struct EpiG2 {
    static constexpr bool PERM = false, AFTER_DRAIN = false;
    const float* resid; float* out; bf16_t* xb; float* sumsq; int ldc;
    __device__ __forceinline__ void operator()(const f32x4 (&acc)[2][2][4][2], const Unit& u, int wr, int wc, int fr, int fq) const {
        const int row0 = u.pm * BM + wr * 64 + fr, col0 = u.pn * BM + wc * 32 + 4 * fq;
#pragma unroll
        for (int ai = 0; ai < 2; ++ai)
#pragma unroll
            for (int m = 0; m < 4; ++m) { const int r = row0 + ai * HALF + m * 16; const size_t off = (size_t)r * ldc + col0; float ss = 0.f;
#pragma unroll
                for (int bj = 0; bj < 2; ++bj)
#pragma unroll
                    for (int n = 0; n < 2; ++n) { const f32x4 x = *(const f32x4*)(resid + off + bj * HALF + n * 16) + acc[ai][bj][m][n];
                        *(f32x4*)(out + off + bj * HALF + n * 16) = x; ss += (x[0] * x[0] + x[1] * x[1]) + (x[2] * x[2] + x[3] * x[3]);
                        u32x2 w; w.x = cvt_pk_bf16(x[0], x[1]); w.y = cvt_pk_bf16(x[2], x[3]); *(u32x2*)(xb + off + bj * HALF + n * 16) = w; }
                ss += __shfl_xor(ss, 16); ss += __shfl_xor(ss, 32);
                if (fq == 0) atomicAdd(sumsq + r, ss);
                asm volatile("" ::: "memory"); }
    }
};
struct EpiG3 {
    static constexpr bool PERM = true, AFTER_DRAIN = false;
    bf16_t* O; int ldc;
    __device__ __forceinline__ void operator()(const f32x4 (&acc)[2][2][4][2], const Unit& u, int wr, int wc, int fr, int fq) const {
        const int row0 = u.pm * BM + wr * 64 + fr, col0 = u.pn * BM + wc * 32 + 8 * fq;
#pragma unroll
        for (int ai = 0; ai < 2; ++ai)
#pragma unroll
            for (int m = 0; m < 4; ++m) { bf16_t* rowp = O + (size_t)(row0 + ai * HALF + m * 16) * ldc + col0;
#pragma unroll
                for (int bj = 0; bj < 2; ++bj) { const f32x4 v0 = acc[ai][bj][m][0], v1 = acc[ai][bj][m][1];
                    u32x4 w; w.x = cvt_pk_bf16(v0[0], v0[1]); w.y = cvt_pk_bf16(v0[2], v0[3]); w.z = cvt_pk_bf16(v1[0], v1[1]); w.w = cvt_pk_bf16(v1[2], v1[3]);
                    *(u32x4*)(rowp + bj * HALF) = w; } }
    }
};

template <class Epi, class Sched, bool ALIGN_EPI = false, bool SP2 = false>
__device__ __forceinline__ void gemm_phase(PG8_LAS unsigned char* lds, const Gemm g, const Sched& S, const Epi& E, int wid_in) {
    const int wid = __builtin_amdgcn_readfirstlane(wid_in), lane = (int)__builtin_amdgcn_mbcnt_hi(~0u, __builtin_amdgcn_mbcnt_lo(~0u, 0u)), tid = wid * 64 + lane, wr = wid >> 2, wc = wid & 3, fr = lane & 15, fq = lane >> 4;
    const int K = g.K, nt = K / BK;
    unsigned voffA[2], voffB[2];
#pragma unroll
    for (int i = 0; i < 2; ++i) { int R, C; stage_rc(tid * 16 + i * 8192, R, C); const int Rb = Epi::PERM ? ((R & ~31) + perm32(R & 31)) : R;
        voffA[i] = (unsigned)(R * K + C) * 2u; voffB[i] = (unsigned)(Rb * K + C) * 2u; }
    const size_t kstep = (size_t)(BK * 2);
    const size_t hstep = (size_t)HALF * K * 2;
    const size_t tstep = 2 * hstep;
    const unsigned ldsw = (unsigned)wid * 1024u;
    const int aoff = lds_byte(wr * 64 + fr, fq * 8), boff = lds_byte(wc * 32 + fr, fq * 8);
#define PG8_SA(b, h) (((b) * 2 + (h)) * HTB)
#define PG8_SB(b, h) ((4 + (b) * 2 + (h)) * HTB)
#define PG8_STAGE(bufoff, gbase, voff) do { _Pragma("unroll") for (int _i = 0; _i < 2; ++_i) \
        __builtin_amdgcn_global_load_lds((const unsigned*)((const char*)(gbase) + (voff)[_i]), (PG8_LAS unsigned*)(lds + (bufoff) + ldsw + _i * 8192), 16, 0, 0); } while (0)
#define PG8_LDA(dst, b, h) do { _Pragma("unroll") for (int m = 0; m < 4; ++m) _Pragma("unroll") for (int k = 0; k < 2; ++k) dst[m][k] = *(const PG8_LAS bf16x8*)(lds + PG8_SA(b, h) + aoff + m * 2048 + k * 1024); } while (0)
#define PG8_LDB(dst, b, h) do { _Pragma("unroll") for (int n = 0; n < 2; ++n) _Pragma("unroll") for (int k = 0; k < 2; ++k) dst[n][k] = *(const PG8_LAS bf16x8*)(lds + PG8_SB(b, h) + boff + n * 2048 + k * 1024); } while (0)
#define PG8_MMA(ai, bj, At, Bt) do { __builtin_amdgcn_s_setprio(1); _Pragma("unroll") for (int m = 0; m < 4; ++m) _Pragma("unroll") for (int n = 0; n < 2; ++n) _Pragma("unroll") for (int k = 0; k < 2; ++k) \
        acc[ai][bj][m][n] = __builtin_amdgcn_mfma_f32_16x16x32_bf16(Bt[n][k], At[m][k], acc[ai][bj][m][n], 0, 0, 0); __builtin_amdgcn_s_setprio(0); } while (0)
#define PG8_WAIT_V(n) asm volatile("s_waitcnt vmcnt(" #n ")" ::: "memory")
#define PG8_WAIT_L(n) asm volatile("s_waitcnt lgkmcnt(" #n ")" ::: "memory")
#define PG8_BAR __builtin_amdgcn_s_barrier()
#define PG8_SCHED __builtin_amdgcn_sched_barrier(0)
    Unit cur, nxt; int ui = 0;
    if (!S.next(0, cur)) return;
    f32x4 acc[2][2][4][2];
#pragma unroll
    for (int a = 0; a < 2; ++a)
#pragma unroll
        for (int b = 0; b < 2; ++b)
#pragma unroll
            for (int m = 0; m < 4; ++m)
#pragma unroll
                for (int n = 0; n < 2; ++n) acc[a][b][m][n] = (f32x4){0.f, 0.f, 0.f, 0.f};
    bf16x8 At[4][2], B0[2][2], B1[2][2];
    const char* cA = (const char*)g.A + (size_t)cur.pm * tstep; const char* cB = (const char*)g.Bt + (size_t)cur.pn * tstep;
    S.a_ready(cur);
    if constexpr (SP2) {
        PG8_STAGE(PG8_SB(0, 0), cB, voffB); PG8_STAGE(PG8_SB(0, 1), cB + hstep, voffB); PG8_STAGE(PG8_SA(0, 0), cA, voffA); PG8_STAGE(PG8_SA(0, 1), cA + hstep, voffA);
        if (wr == 1) PG8_BAR;
        PG8_WAIT_V(2); PG8_BAR;
        PG8_STAGE(PG8_SB(1, 0), cB + kstep, voffB); PG8_STAGE(PG8_SA(1, 0), cA + kstep, voffA); PG8_STAGE(PG8_SB(1, 1), cB + hstep + kstep, voffB);
        PG8_WAIT_V(6); PG8_BAR;
    } else {
        PG8_STAGE(PG8_SB(0, 0), cB, voffB); PG8_STAGE(PG8_SA(0, 0), cA, voffA); PG8_STAGE(PG8_SB(0, 1), cB + hstep, voffB); PG8_STAGE(PG8_SA(0, 1), cA + hstep, voffA);
        if (wr == 1) PG8_BAR;
        PG8_WAIT_V(4); PG8_BAR;
        PG8_STAGE(PG8_SB(1, 0), cB + kstep, voffB); PG8_STAGE(PG8_SA(1, 0), cA + kstep, voffA); PG8_STAGE(PG8_SB(1, 1), cB + hstep + kstep, voffB);
        PG8_WAIT_V(6); PG8_BAR;
    }
    for (;;) {
        const bool has_next = S.next(ui + 1, nxt);
        const char* nA = has_next ? (const char*)g.A + (size_t)nxt.pm * tstep : cA; const char* nB = has_next ? (const char*)g.Bt + (size_t)nxt.pn * tstep : cB;
        for (int t = 0; t < nt; t += 2) {
            const bool last = (t == nt - 2);
            const char* a1 = cA + (size_t)(t + 1) * kstep;
            const char* a2 = last ? nA : cA + (size_t)(t + 2) * kstep; const char* b2 = last ? nB : cB + (size_t)(t + 2) * kstep;
            const char* a3 = a2 + kstep; const char* b3 = b2 + kstep;
            if (last && has_next) S.a_ready(nxt);
            if constexpr (SP2) {
            PG8_LDB(B0, 0, 0); PG8_LDB(B1, 0, 1); PG8_SCHED; PG8_LDA(At, 0, 0); PG8_STAGE(PG8_SA(1, 1), a1 + hstep, voffA);
            PG8_WAIT_V(8); PG8_WAIT_L(0); PG8_BAR; PG8_MMA(0, 0, At, B0); PG8_MMA(0, 1, At, B1); PG8_BAR; PG8_SCHED;
            PG8_LDA(At, 0, 1); PG8_STAGE(PG8_SB(0, 0), b2, voffB); PG8_STAGE(PG8_SB(0, 1), b2 + hstep, voffB); PG8_STAGE(PG8_SA(0, 0), a2, voffA);
            PG8_WAIT_V(8); PG8_WAIT_L(0); PG8_BAR; PG8_MMA(1, 0, At, B0); PG8_MMA(1, 1, At, B1); PG8_BAR; PG8_SCHED;
            PG8_LDB(B0, 1, 0); PG8_LDB(B1, 1, 1); PG8_SCHED; PG8_LDA(At, 1, 0); PG8_STAGE(PG8_SA(0, 1), a2 + hstep, voffA);
            PG8_WAIT_V(8); PG8_WAIT_L(0); PG8_BAR; PG8_MMA(0, 0, At, B0); PG8_MMA(0, 1, At, B1); PG8_BAR; PG8_SCHED;
            PG8_LDA(At, 1, 1); PG8_STAGE(PG8_SB(1, 0), b3, voffB); PG8_STAGE(PG8_SB(1, 1), b3 + hstep, voffB); PG8_STAGE(PG8_SA(1, 0), a3, voffA);
            PG8_WAIT_V(8); PG8_WAIT_L(0); PG8_BAR; PG8_MMA(1, 0, At, B0); PG8_MMA(1, 1, At, B1); PG8_BAR; PG8_SCHED;
            } else {
            PG8_LDB(B0, 0, 0); PG8_SCHED; PG8_LDA(At, 0, 0); PG8_STAGE(PG8_SA(1, 1), a1 + hstep, voffA);
            PG8_WAIT_L(8); PG8_BAR; PG8_WAIT_L(0); PG8_MMA(0, 0, At, B0); PG8_BAR; PG8_SCHED;
            PG8_LDB(B1, 0, 1); PG8_STAGE(PG8_SB(0, 0), b2, voffB);
            PG8_BAR; PG8_WAIT_L(0); PG8_MMA(0, 1, At, B1); PG8_BAR;
            PG8_LDA(At, 0, 1); PG8_STAGE(PG8_SA(0, 0), a2, voffA);
            PG8_BAR; PG8_WAIT_L(0); PG8_MMA(1, 0, At, B0); PG8_BAR; PG8_SCHED;
            PG8_STAGE(PG8_SB(0, 1), b2 + hstep, voffB);
            PG8_WAIT_V(6); PG8_BAR; PG8_MMA(1, 1, At, B1); PG8_BAR;
            PG8_LDB(B0, 1, 0); PG8_SCHED; PG8_LDA(At, 1, 0); PG8_STAGE(PG8_SA(0, 1), a2 + hstep, voffA);
            PG8_WAIT_L(8); PG8_BAR; PG8_WAIT_L(0); PG8_MMA(0, 0, At, B0); PG8_BAR; PG8_SCHED;
            PG8_LDB(B1, 1, 1); PG8_STAGE(PG8_SB(1, 0), b3, voffB);
            PG8_BAR; PG8_WAIT_L(0); PG8_MMA(0, 1, At, B1); PG8_BAR;
            PG8_LDA(At, 1, 1); PG8_STAGE(PG8_SA(1, 0), a3, voffA);
            PG8_BAR; PG8_WAIT_L(0); PG8_MMA(1, 0, At, B0); PG8_BAR; PG8_SCHED;
            PG8_STAGE(PG8_SB(1, 1), b3 + hstep, voffB);
            PG8_WAIT_V(6); PG8_BAR; PG8_MMA(1, 1, At, B1); PG8_BAR;
            }
        }
        if constexpr (ALIGN_EPI) { if (wr == 0) PG8_BAR; }
        if constexpr (!Epi::AFTER_DRAIN) { E(acc, cur, wr, wc, fr, fq); S.done(cur); }
        if (!has_next) break;
#pragma unroll
        for (int a = 0; a < 2; ++a)
#pragma unroll
            for (int b = 0; b < 2; ++b)
#pragma unroll
                for (int m = 0; m < 4; ++m)
#pragma unroll
                    for (int n = 0; n < 2; ++n) acc[a][b][m][n] = (f32x4){0.f, 0.f, 0.f, 0.f};
        cur = nxt; cA = nA; cB = nB; ++ui;
        if constexpr (ALIGN_EPI) { if (wr == 1) PG8_BAR; }
    }
    PG8_WAIT_V(0);
    if constexpr (!ALIGN_EPI) { if (wr == 0) PG8_BAR; }
    PG8_BAR;
    if constexpr (Epi::AFTER_DRAIN) { E.fused(acc, cur, wr, wc, fr, fq, lds, wid, lane); S.done(cur); }
#undef PG8_SA
#undef PG8_SB
#undef PG8_STAGE
#undef PG8_LDA
#undef PG8_LDB
#undef PG8_MMA
#undef PG8_WAIT_V
#undef PG8_WAIT_L
#undef PG8_BAR
#undef PG8_SCHED
}
}
#include <hip/hip_bf16.h>
#include <cmath>
namespace attn_body {
using bf16=__hip_bfloat16;
using bf16x8=__attribute__((ext_vector_type(8)))short;
using s16x4=__attribute__((ext_vector_type(4)))short;
using f32x16=__attribute__((ext_vector_type(16)))float;
using u32x4=__attribute__((ext_vector_type(4)))unsigned;
constexpr int BATCH=4,NHEAD=8,SEQ=8192,D=64,DM=NHEAD*D;
constexpr int NW=8,QBLK=32,QB=QBLK*NW,KVBLK=64,NQB=SEQ/QB;
constexpr int ATTN_PITCH=DM, ATTN_UNIT_ROWS=QB;
__device__ __forceinline__ int crow(int r,int hi){return (r&3)+8*(r>>2)+4*hi;}
#define SBAR() __builtin_amdgcn_sched_barrier(0)
__device__ __forceinline__ void cmask(f32x16&p0,f32x16&p1,int jb,int qrel,int hi){
  const float NEG=-INFINITY; int kb=64*jb+4*hi;
  #pragma unroll
  for(int r=0;r<16;++r){int kv=kb+(r&3)+8*(r>>2); if(kv>qrel)p0[r]=NEG; if(kv+32>qrel)p1[r]=NEG;}
}

constexpr int NSLOT=3, SLOTB=8192;
constexpr int LDS_K=0, LDS_V=NSLOT*SLOTB, LDS_WS=2*NSLOT*SLOTB, LDS_OST=LDS_WS+NW*64*4, LDS_FK=LDS_OST+NW*4096, LDS_BYTES=LDS_FK+SEQ*4;
constexpr float C2=0.125f*1.4426950408889634f;
__device__ __forceinline__ void glds16(const void*gsrc,unsigned lds_dst){unsigned keep;
  asm volatile("s_mov_b32 %0, m0\n\ts_mov_b32 m0, %2\n\ts_nop 0\n\tglobal_load_lds_dwordx4 %1, off\n\ts_mov_b32 m0, %0":"=&s"(keep):"v"(gsrc),"s"(lds_dst):"memory");}
__device__ __forceinline__ float max3f(float a,float b,float c){float r;asm("v_max3_f32 %0, %1, %2, %3":"=v"(r):"v"(a),"v"(b),"v"(c));return r;}
__device__ __forceinline__ float max2f(float a,float b){float r;asm("v_max_f32_e32 %0, %1, %2":"=v"(r):"v"(a),"v"(b));return r;}
__device__ __forceinline__ float fadd_s(float a,float b){float r;asm("v_add_f32_e32 %0, %1, %2":"=v"(r):"v"(a),"v"(b));return r;}
__device__ __forceinline__ float fsub_s(float a,float b){float r;asm("v_sub_f32_e32 %0, %1, %2":"=v"(r):"v"(a),"v"(b));return r;}
typedef float f32x2_t __attribute__((ext_vector_type(2))); typedef __bf16 bf16x2_t __attribute__((ext_vector_type(2)));
__device__ __forceinline__ unsigned cvtpk_s(float lo,float hi){f32x2_t v={lo,hi};bf16x2_t b=__builtin_convertvector(v,bf16x2_t);return __builtin_bit_cast(unsigned,b);}
#define WAIT_BAR(N) asm volatile("s_waitcnt vmcnt(" #N ") lgkmcnt(0)\n\ts_barrier":::"memory")

__device__ __forceinline__ void qkt(f32x16&p0,f32x16&p1,const char*Kslot,const bf16x8*qr,int r32,int hi){
  const char*kb=Kslot+hi*1024+r32*16;
  #pragma unroll
  for(int d0=0;d0<4;++d0){
    const bf16x8 b0=*reinterpret_cast<const bf16x8*>(kb+d0*2048);
    const bf16x8 b1=*reinterpret_cast<const bf16x8*>(kb+d0*2048+512);
    p0=__builtin_amdgcn_mfma_f32_32x32x16_bf16(b0,qr[d0],p0,0,0,0);p1=__builtin_amdgcn_mfma_f32_32x32x16_bf16(b1,qr[d0],p1,0,0,0);}
}
typedef __attribute__((address_space(3))) const char* lds_cptr;
typedef short v4i16_t __attribute__((ext_vector_type(4)));
__device__ __forceinline__ void kload8(bf16x8*kf,lds_cptr kp){
  kf[0]=*(const __attribute__((address_space(3))) bf16x8*)(kp);      kf[1]=*(const __attribute__((address_space(3))) bf16x8*)(kp+512);
  kf[2]=*(const __attribute__((address_space(3))) bf16x8*)(kp+2048); kf[3]=*(const __attribute__((address_space(3))) bf16x8*)(kp+2560);
  kf[4]=*(const __attribute__((address_space(3))) bf16x8*)(kp+4096); kf[5]=*(const __attribute__((address_space(3))) bf16x8*)(kp+4608);
  kf[6]=*(const __attribute__((address_space(3))) bf16x8*)(kp+6144); kf[7]=*(const __attribute__((address_space(3))) bf16x8*)(kp+6656);
}
__device__ __forceinline__ void kload2(bf16x8*kf,lds_cptr kp,int j){ kf[2*j]=*(const __attribute__((address_space(3))) bf16x8*)(kp+j*2048); kf[2*j+1]=*(const __attribute__((address_space(3))) bf16x8*)(kp+j*2048+512); }
__device__ __forceinline__ s16x4 vtr(lds_cptr p){ return __builtin_bit_cast(s16x4,__builtin_amdgcn_ds_read_tr16_b64_v4i16((__attribute__((address_space(3))) v4i16_t*)p)); }
__device__ __forceinline__ float rowmax(const f32x16&p0,const f32x16&p1){
  float a=max3f(p0[0],p0[1],p1[0]),b=max3f(p0[2],p0[3],p1[1]);a=max3f(a,p1[2],p1[3]);
  #pragma unroll
  for(int r=4;r<16;r+=4){a=max3f(a,p0[r],p0[r+1]);b=max3f(b,p0[r+2],p0[r+3]);a=max3f(a,p1[r],p1[r+1]);b=max3f(b,p1[r+2],p1[r+3]);}
  const float m=max2f(a,b);
  auto rr=__builtin_amdgcn_permlane32_swap(__float_as_uint(m),__float_as_uint(m),false,false);
  return max2f(__uint_as_float(rr[0]),__uint_as_float(rr[1]));
}
__device__ __forceinline__ void pv(f32x16*o,int vb,bf16x8 pa0,bf16x8 pa1,bf16x8 pa2,bf16x8 pa3){
  #pragma unroll
  for(int d0=0;d0<2;++d0){s16x4 lo[4],hi[4];
    #pragma unroll
    for(int ks=0;ks<4;++ks){
      asm volatile("ds_read_b64_tr_b16 %0,%1 offset:%c2":"=&v"(lo[ks]):"v"(vb),"i"(d0*4096+ks*1024):"memory");
      asm volatile("ds_read_b64_tr_b16 %0,%1 offset:%c2":"=&v"(hi[ks]):"v"(vb),"i"(d0*4096+ks*1024+512):"memory");}
    asm volatile("s_waitcnt lgkmcnt(0)":::"memory");SBAR();
    #define PK(k) (bf16x8){lo[k][0],lo[k][1],lo[k][2],lo[k][3],hi[k][0],hi[k][1],hi[k][2],hi[k][3]}
    o[d0]=__builtin_amdgcn_mfma_f32_32x32x16_bf16(pa0,PK(0),o[d0],0,0,0);
    o[d0]=__builtin_amdgcn_mfma_f32_32x32x16_bf16(pa1,PK(1),o[d0],0,0,0);
    o[d0]=__builtin_amdgcn_mfma_f32_32x32x16_bf16(pa2,PK(2),o[d0],0,0,0);
    o[d0]=__builtin_amdgcn_mfma_f32_32x32x16_bf16(pa3,PK(3),o[d0],0,0,0);
    #undef PK
  }
}

#ifndef ATTN_STORE16
#define ATTN_STORE16(p,v) (*(u32x4*)(p)=(v))
#endif
template<int THRL> __device__ __forceinline__ void attn_unit(int b,int h,int qb,const bf16*Q,const bf16*__restrict__ K,const bf16*__restrict__ V,bf16*O,const float*__restrict__ Fc,const float*__restrict__ NRM,char*shm,int wid_in){
  const int wid=__builtin_amdgcn_readfirstlane(wid_in); int lane_=(int)__builtin_amdgcn_mbcnt_hi(~0u,__builtin_amdgcn_mbcnt_lo(~0u,0u)); asm volatile("":"+v"(lane_));
  const int lane=lane_,tid=wid*64+lane,r32=lane&31,hi=lane>>5;
  const long rowbase=(long)b*SEQ; const int q0=qb*QB;
  const float*Fbh=Fc+(long)(b*NHEAD+h)*SEQ;
  const int NTF=(q0+QB)/KVBLK; int t_start;
  { const float*QNb=NRM+(b*NHEAD+h)*128,*KNb=NRM+4096+(b*NHEAD+h)*128;
    const float qn=fmaxf(fmaxf(QNb[4*qb],QNb[4*qb+1]),fmaxf(QNb[4*qb+2],QNb[4*qb+3])),knb=fmaxf(fmaxf(KNb[4*qb],KNb[4*qb+1]),fmaxf(KNb[4*qb+2],KNb[4*qb+3]));
    const float fq0=Fbh[q0]*1.4426950408889634f; bool k0=true,k1=true;
    if(lane<NTF-4)k0=!(qn*(KNb[lane]+knb)+(fq0-Fbh[64*lane+63]*1.4426950408889634f)<-40.f);
    if(lane+64<NTF-4)k1=!(qn*(KNb[lane+64]+knb)+(fq0-Fbh[64*(lane+64)+63]*1.4426950408889634f)<-40.f);
    const unsigned long long m0=__ballot(k0),m1=__ballot(k1);
    int tf=m0?(int)__builtin_ctzll(m0):64+(m1?(int)__builtin_ctzll(m1):64);
    tf=tf<NTF-4?tf:NTF-4; t_start=__builtin_amdgcn_readfirstlane(tf&~1); }
  { typedef float f32x4_t __attribute__((ext_vector_type(4))); __attribute__((address_space(3))) float*fk=(__attribute__((address_space(3))) float*)((__attribute__((address_space(3))) char*)shm+LDS_FK); const int n4=(q0+QB)/4;
    for(int i=16*t_start+tid;i<n4;i+=NW*64){ f32x4_t v=*(const f32x4_t*)(Fbh+4*i); v=v*(-1.4426950408889634f); *(__attribute__((address_space(3))) f32x4_t*)(fk+4*i)=v; } }
  float fq2=Fbh[q0+wid*QBLK+r32]*1.4426950408889634f; asm volatile("":"+v"(fq2));
  const bf16*Qw=Q+(rowbase+q0+wid*QBLK)*DM+h*D;
  const bf16*Kh=K+(rowbase+(long)t_start*KVBLK)*DM+h*D,*Vh=V+(rowbase+(long)t_start*KVBLK)*DM+h*D;
  const lds_cptr shm3=(lds_cptr)shm;
  const unsigned lds0=(unsigned)(uintptr_t)shm;
  float*wsf=(float*)(shm+LDS_WS)+wid*64;
  const bf16*ksrc=Kh+(long)lane*DM+wid*8;
  const bf16*vsrc=Vh+(long)(16*(wid&3)+(lane>>2))*DM+(wid>>2)*32+(lane&3)*8;
  const unsigned kdst=lds0+LDS_K+wid*1024, vdst=lds0+LDS_V+wid*1024;
  #define DMA_K(t,slot) glds16(ksrc+(long)(t)*KVBLK*DM,(unsigned)__builtin_amdgcn_readfirstlane(kdst+(slot)))
  #define DMA_V(t,slot) glds16(vsrc+(long)(t)*KVBLK*DM,(unsigned)__builtin_amdgcn_readfirstlane(vdst+(slot)))
  const int vb0=(int)(lds0+LDS_V)+((lane>>4)&1)*32+(lane&3)*8+(4*hi+((lane&15)>>2))*64;
  const char*Kbase=shm+LDS_K; bf16x8 kf[8];
  const lds_cptr kp0=shm3+LDS_K+hi*1024+r32*16; const lds_cptr vp0=shm3+LDS_V+((lane>>4)&1)*32+(lane&3)*8+(4*hi+((lane&15)>>2))*64;
  const int NT=NTF-t_start;
  DMA_K(0,0);DMA_V(0,0);DMA_K(1,SLOTB);
  bf16x8 qr[4];
  #pragma unroll
  for(int d0=0;d0<4;++d0)qr[d0]=*reinterpret_cast<const bf16x8*>(&Qw[(long)r32*DM+d0*16+hi*8]);
  float mhat=0.f,l_reg=0.f;f32x16 o[2];o[0]=f32x16{};o[1]=f32x16{};
  const __attribute__((address_space(3))) float*fkl=(const __attribute__((address_space(3))) float*)(shm3+LDS_FK)+64*t_start+4*hi;
  #define INITC(C0,C1,t) do{ const float nsc_=fq2-mhat; typedef float f32x4_t __attribute__((ext_vector_type(4))); const __attribute__((address_space(3))) float*kb_=fkl+64*(t); \
    _Pragma("unroll") for(int g_=0;g_<4;++g_){ const f32x4_t a_=*(const __attribute__((address_space(3))) f32x4_t*)(kb_+8*g_), b_=*(const __attribute__((address_space(3))) f32x4_t*)(kb_+32+8*g_); \
      _Pragma("unroll") for(int e_=0;e_<4;++e_){ C0[4*g_+e_]=nsc_+a_[e_]; C1[4*g_+e_]=nsc_+b_[e_]; } } }while(0)
  const int qrel=wid*QBLK+r32;
  #define CMASK(P0,P1,t) do{int jb_=(t)-(NT-4); if(jb_>=0)cmask(P0,P1,jb_,qrel,hi);}while(0)
  bool resc=false;
  #define START(P0,P1) do{ const float rm=rowmax(P0,P1); resc=false; \
    { const float dl=rm; mhat=fadd_s(mhat,dl); \
      _Pragma("unroll") for(int r=0;r<16;++r){P0[r]=fsub_s(P0[r],dl);P1[r]=fsub_s(P1[r],dl);} \
      } \
    _Pragma("unroll") for(int r=0;r<16;++r)P0[r]=__builtin_amdgcn_exp2f(P0[r]); }while(0)
  #define RESC() do{ if(resc){ asm volatile("s_waitcnt lgkmcnt(0)":::"memory"); \
      _Pragma("unroll") for(int d_=0;d_<2;++d_) _Pragma("unroll") for(int r=0;r<16;++r)o[d_][r]*=wsf[crow(r,hi)]; } }while(0)
  f32x16 pA0,pA1,pB0,pB1;
  int sl_prev=0,sl_cur=0,sl_next=SLOTB;
  #define ROT() do{sl_prev=sl_cur;sl_cur=sl_next;sl_next=(sl_next==(NSLOT-1)*SLOTB)?0:sl_next+SLOTB;}while(0)
  DMA_K(2,2*SLOTB);
  WAIT_BAR(3);
  INITC(pA0,pA1,0); qkt(pA0,pA1,Kbase,qr,r32,hi);asm volatile("s_nop 15\n\ts_nop 7":"+v"(pA0),"+v"(pA1));CMASK(pA0,pA1,0);
  START(pA0,pA1);
  _Pragma("unroll") for(int r=0;r<16;++r)pA1[r]=__builtin_amdgcn_exp2f(pA1[r]);
  WAIT_BAR(0);
  DMA_K(3,0);DMA_V(1,SLOTB);
  ROT();
  kload8(kf,kp0+sl_cur);
  WAIT_BAR(2);
  s16x4 vlo[8],vhi[8]; u32x4 pw0,pw1,pw2,pw3;
  #define PKW(P,B) cvtpk_s(P[B],P[B+1])
  #define PAF(k) __builtin_bit_cast(bf16x8,pw##k)
  #define VFR(i) (bf16x8){vlo[i][0],vlo[i][1],vlo[i][2],vlo[i][3],vhi[i][0],vhi[i][1],vhi[i][2],vhi[i][3]}
  #define PIN(x) asm volatile("":"+v"(x))
  #define MX3(a,b,c) __builtin_fmaxf(__builtin_fmaxf((a),(b)),(c))
  #define GAPA(MF,A0,A1,A2,A3,W0,W1,PW) do{ MF; sacc+=A0; sacc+=A1; sacc+=A2; sacc+=A3; PIN(sacc); W0; W1; PIN(PW); SBAR(); }while(0)
  #define EX(v) __builtin_amdgcn_exp2f(v)
  #define GAPB(MF,X,B) do{ MF; X[B]=EX(X[B]); X[B+1]=EX(X[B+1]); X[B+2]=EX(X[B+2]); X[B+3]=EX(X[B+3]); PIN(X); SBAR(); }while(0)
  #define VRD(i) do{ vlo[i]=vtr(vp_+(((i)>>2)*4096+((i)&3)*1024)); vhi[i]=vtr(vp_+(((i)>>2)*4096+((i)&3)*1024+512)); }while(0)
  #define KRD(G,j) do{ if(G){ kload2(kf,kp0+sl_next,j); SBAR(); } }while(0)
  #define STEP(C0,C1,P0,P1,t,GK,GV,GL) do{ SBAR(); INITC(C0,C1,t); PIN(C0); PIN(C1); SBAR(); \
    const lds_cptr vp_=vp0+sl_prev; \
    VRD(0); SBAR(); float sacc=(P0[0]+P0[1]); \
    GAPA(C0=__builtin_amdgcn_mfma_f32_32x32x16_bf16(kf[0],qr[0],C0,0,0,0), P0[2],P0[3],P0[4],P0[5],     pw0[0]=PKW(P0,0), pw0[1]=PKW(P0,2), pw0); \
    VRD(4); SBAR(); GAPA(C1=__builtin_amdgcn_mfma_f32_32x32x16_bf16(kf[1],qr[0],C1,0,0,0), P0[6],P0[7],P0[8],P0[9],     pw0[2]=PKW(P0,4), pw0[3]=PKW(P0,6), pw0); \
    VRD(1); SBAR(); GAPA(C0=__builtin_amdgcn_mfma_f32_32x32x16_bf16(kf[2],qr[1],C0,0,0,0),   P0[10],P0[11],P0[12],P0[13], pw1[0]=PKW(P0,8), pw1[1]=PKW(P0,10), pw1); \
    VRD(5); SBAR(); GAPA(C1=__builtin_amdgcn_mfma_f32_32x32x16_bf16(kf[3],qr[1],C1,0,0,0),   P0[14],P0[15],P1[0],P1[1],   pw1[2]=PKW(P0,12),pw1[3]=PKW(P0,14), pw1); \
    VRD(2); SBAR(); GAPA(C0=__builtin_amdgcn_mfma_f32_32x32x16_bf16(kf[4],qr[2],C0,0,0,0),   P1[2],P1[3],P1[4],P1[5],     pw2[0]=PKW(P1,0), pw2[1]=PKW(P1,2), pw2); \
    VRD(6); SBAR(); GAPA(C1=__builtin_amdgcn_mfma_f32_32x32x16_bf16(kf[5],qr[2],C1,0,0,0),   P1[6],P1[7],P1[8],P1[9],     pw2[2]=PKW(P1,4), pw2[3]=PKW(P1,6), pw2); \
    VRD(3); SBAR(); GAPA(C0=__builtin_amdgcn_mfma_f32_32x32x16_bf16(kf[6],qr[3],C0,0,0,0),   P1[10],P1[11],P1[12],P1[13], pw3[0]=PKW(P1,8), pw3[1]=PKW(P1,10), pw3); \
    VRD(7); SBAR(); GAPA(C1=__builtin_amdgcn_mfma_f32_32x32x16_bf16(kf[7],qr[3],C1,0,0,0),   P1[14],P1[15],0.f,0.f,       pw3[2]=PKW(P1,12),pw3[3]=PKW(P1,14), pw3); \
    l_reg+=sacc; \
    if(GK){DMA_K((t)+3,sl_cur);} if(GV){DMA_V((t)+1,sl_next);} \
    CMASK(C0,C1,t); \
    { float a=MX3(C0[0],C0[1],C1[0]),b=MX3(C0[2],C0[3],C1[1]); a=MX3(a,C1[2],C1[3]); \
      _Pragma("unroll") for(int r=4;r<16;r+=4){a=MX3(a,C0[r],C0[r+1]);b=MX3(b,C0[r+2],C0[r+3]);a=MX3(a,C1[r],C1[r+1]);b=MX3(b,C1[r+2],C1[r+3]);} \
      float rm=__builtin_fmaxf(a,b); { auto rr=__builtin_amdgcn_permlane32_swap(__float_as_uint(rm),__float_as_uint(rm),false,false); rm=__builtin_fmaxf(__uint_as_float(rr[0]),__uint_as_float(rr[1])); } \
      resc=false; \
      if(__builtin_expect(__any(rm>(float)THRL),0)){ const float dl=__builtin_fmaxf(rm,0.f); mhat+=dl; \
        _Pragma("unroll") for(int r=0;r<16;++r){C0[r]-=dl;C1[r]-=dl;} \
        const float f=__builtin_amdgcn_exp2f(-dl); l_reg*=f; if(hi==0)wsf[r32]=f; resc=true; } } \
    SBAR(); \
    GAPB(o[0]=__builtin_amdgcn_mfma_f32_32x32x16_bf16(PAF(0),VFR(0),o[0],0,0,0), C0,0); \
    GAPB(o[1]=__builtin_amdgcn_mfma_f32_32x32x16_bf16(PAF(0),VFR(4),o[1],0,0,0), C0,4); \
    KRD(GL,0); GAPB(o[0]=__builtin_amdgcn_mfma_f32_32x32x16_bf16(PAF(1),VFR(1),o[0],0,0,0), C0,8); \
    KRD(GL,1); GAPB(o[1]=__builtin_amdgcn_mfma_f32_32x32x16_bf16(PAF(1),VFR(5),o[1],0,0,0), C0,12); \
    KRD(GL,2); GAPB(o[0]=__builtin_amdgcn_mfma_f32_32x32x16_bf16(PAF(2),VFR(2),o[0],0,0,0), C1,0); \
    KRD(GL,3); GAPB(o[1]=__builtin_amdgcn_mfma_f32_32x32x16_bf16(PAF(2),VFR(6),o[1],0,0,0), C1,4); \
    GAPB(o[0]=__builtin_amdgcn_mfma_f32_32x32x16_bf16(PAF(3),VFR(3),o[0],0,0,0), C1,8); \
    GAPB(o[1]=__builtin_amdgcn_mfma_f32_32x32x16_bf16(PAF(3),VFR(7),o[1],0,0,0), C1,12); \
    }while(0)
  int t=1;
  #undef CMASK
  #define CMASK(P0,P1,t) do{}while(0)
  for(;t+5<NT;t+=2){
    STEP(pB0,pB1,pA0,pA1,t,true,true,true);     WAIT_BAR(2); RESC(); ROT();
    STEP(pA0,pA1,pB0,pB1,t+1,true,true,true);   WAIT_BAR(2); RESC(); ROT();
  }
  #undef CMASK
  #define CMASK(P0,P1,t) do{int jb_=(t)-(NT-4); if(jb_>=0)cmask(P0,P1,jb_,qrel,hi);}while(0)
  #define ENDW(tt) do{ if((tt)+3<NT){WAIT_BAR(2);} else if((tt)+2<NT){WAIT_BAR(1);} else {WAIT_BAR(0);} }while(0)
  for(;t+1<NT;t+=2){
    STEP(pB0,pB1,pA0,pA1,t,(t+3<NT),(t+1<NT),(t+1<NT));       ENDW(t);   RESC(); ROT();
    STEP(pA0,pA1,pB0,pB1,t+1,(t+4<NT),(t+2<NT),(t+2<NT));     ENDW(t+1); RESC(); ROT();
  }
  STEP(pB0,pB1,pA0,pA1,NT-1,false,false,false); RESC();
  { float sacc=pB0[0]+pB0[1]; _Pragma("unroll") for(int r=2;r<16;++r)sacc+=pB0[r]; _Pragma("unroll") for(int r=0;r<16;++r)sacc+=pB1[r]; l_reg+=sacc;
    pw0=(u32x4){PKW(pB0,0),PKW(pB0,2),PKW(pB0,4),PKW(pB0,6)};pw1=(u32x4){PKW(pB0,8),PKW(pB0,10),PKW(pB0,12),PKW(pB0,14)};pw2=(u32x4){PKW(pB1,0),PKW(pB1,2),PKW(pB1,4),PKW(pB1,6)};pw3=(u32x4){PKW(pB1,8),PKW(pB1,10),PKW(pB1,12),PKW(pB1,14)};
    SBAR(); pv(o,vb0+sl_cur,PAF(0),PAF(1),PAF(2),PAF(3)); }
  #undef PKW
  #undef PAF
  #undef VFR
  #undef PIN
  #undef MX3
  #undef GAPA
  #undef GAPB
  #undef EX
  #undef VRD
  #undef KRD
  #undef STEP
  #undef ENDW
  {auto rr=__builtin_amdgcn_permlane32_swap(__float_as_uint(l_reg),__float_as_uint(l_reg),false,false);l_reg=__uint_as_float(rr[0])+__uint_as_float(rr[1]);}
  if(hi==0)wsf[32+r32]=l_reg;asm volatile("s_waitcnt lgkmcnt(0)":::"memory");
  float rli[16];
  #pragma unroll
  for(int r=0;r<16;++r)rli[r]=__builtin_amdgcn_rcpf(wsf[32+crow(r,hi)]);
  bf16*Ow=O+(rowbase+q0+wid*QBLK)*DM+h*D;
  { bf16*stg=(bf16*)(shm+LDS_OST)+wid*2048;
    #pragma unroll
    for(int r=0;r<16;++r){const int orow=crow(r,hi);
      #pragma unroll
      for(int d0=0;d0<2;++d0)stg[orow*64+d0*32+r32]=__float2bfloat16(o[d0][r]*rli[r]);}
    asm volatile("s_waitcnt lgkmcnt(0)":::"memory");
    #pragma unroll
    for(int i=0;i<4;++i){const int row=i*8+(lane>>3),ch=lane&7; const u32x4 v=*(const u32x4*)(stg+row*64+ch*8); ATTN_STORE16(Ow+(long)row*DM+ch*8,v);} }
  asm volatile("s_waitcnt lgkmcnt(0)\n\ts_barrier":::"memory");
  #undef DMA_K
  #undef DMA_V
  #undef INITC
  #undef CMASK
  #undef START
  #undef RESC
  #undef ROT
}
constexpr int ATTN_LDS_BYTES=LDS_BYTES;
struct AttnTensors { const bf16* Q; const bf16* K; const bf16* V; bf16* O; const float* F; const float* NRM; };
struct AttnUnit { int bh; int qb; };
struct StaticOrder {
  int vcu;
  __device__ __forceinline__ explicit StaticOrder(int grid,int block):vcu((block%8)*(grid/8)+block/8){}
  __device__ __forceinline__ bool next(int i,AttnUnit&u)const{ if(i>=4)return false; const int s=vcu&7; u.bh=vcu>>3; u.qb=(i==0)?s:(i==1)?15-s:(i==2)?16+s:31-s; return true; }
  __device__ __forceinline__ void a_ready(const AttnUnit&)const{}
  __device__ __forceinline__ void done(const AttnUnit&)const{}
};
template<int THRL=8> __device__ __forceinline__ void attn_phase(char*lds,const AttnTensors&T,unsigned*qctr,volatile __attribute__((address_space(3))) unsigned*qword,int wid_in){
  const int lane0=(int)__builtin_amdgcn_mbcnt_hi(~0u,__builtin_amdgcn_mbcnt_lo(~0u,0u));
  for(;;){
    if(wid_in==0&&lane0==0){ const unsigned n=__hip_atomic_fetch_add(qctr,1u,__ATOMIC_RELAXED,__HIP_MEMORY_SCOPE_AGENT); *qword=n; }
    asm volatile("s_waitcnt vmcnt(0) lgkmcnt(0)\n\ts_barrier":::"memory");
    const int n=__builtin_amdgcn_readfirstlane((int)*qword);
    if(n>=BATCH*NHEAD*NQB)break;
    const int bh=n%(BATCH*NHEAD),qb=NQB-1-n/(BATCH*NHEAD);
    attn_unit<THRL>(bh/NHEAD,bh%NHEAD,qb,T.Q,T.K,T.V,T.O,T.F,T.NRM,lds,wid_in);
  }
}
#undef SBAR
#undef WAIT_BAR
}
#define GAS __attribute__((address_space(1)))
#define LAS __attribute__((address_space(3)))
typedef unsigned short bf16;
typedef unsigned v4u __attribute__((ext_vector_type(4)));
typedef float f32x4 __attribute__((ext_vector_type(4)));
typedef short bf16x8 __attribute__((ext_vector_type(8)));
typedef GAS unsigned gu32;
typedef GAS unsigned long long gu64;
#define RLX_AGENT __ATOMIC_RELAXED, __HIP_MEMORY_SCOPE_AGENT
#define LDS_WAIT() asm volatile("s_waitcnt lgkmcnt(0)" ::: "memory")
#define VM_WAIT() asm volatile("s_waitcnt vmcnt(0)" ::: "memory")
__device__ __forceinline__ unsigned long long rt() { return __builtin_amdgcn_s_memrealtime(); }
__device__ __forceinline__ unsigned f2bf(float f) { unsigned u = __builtin_bit_cast(unsigned, f); return (u + 0x7fffu + ((u >> 16) & 1u)) >> 16; }
__device__ __forceinline__ unsigned pk2(float lo, float hi) { return f2bf(lo) | (f2bf(hi) << 16); }

#define XB_TMO      128
#define XB_XCNT(j)  (256  + 64 * (j))
#define XB_XSUB(j)  (1280 + 64 * (j))
#define XB_XGEN(j)  (2304 + 64 * (j))
#define XB_TOP      3328
#define XB_TOPGEN   3392
#define XCD_BAR_WORDS 3456
#define XB_SPIN_CAP (1u << 18)

__device__ __forceinline__ unsigned xb_ld(unsigned* p)              { return __hip_atomic_load(p, __ATOMIC_RELAXED, __HIP_MEMORY_SCOPE_AGENT); }
__device__ __forceinline__ unsigned xb_add(unsigned* p, unsigned v) { return __hip_atomic_fetch_add(p, v, __ATOMIC_RELAXED, __HIP_MEMORY_SCOPE_AGENT); }
__device__ __forceinline__ unsigned xb_xcc_id() { return (unsigned)__builtin_amdgcn_s_getreg((3 << 11) | 20) & 0xFu; }
#define XB_SPIN(cond, bar) do { unsigned _sp = 0; while (cond) { __builtin_amdgcn_s_sleep(1); \
    if ((++_sp & 255u) == 0u) { if (xb_ld(&(bar)[XB_TMO])) break; if (_sp > XB_SPIN_CAP) { atomicAdd(&(bar)[XB_TMO], 1u); break; } } } } while (0)

struct XcdBarrier {
    unsigned* bar; unsigned x; int wv;
    volatile LAS unsigned* st;
};

__device__ __forceinline__ bool xb_t0(int wv) { return wv == 0 && __builtin_amdgcn_mbcnt_hi(~0u, __builtin_amdgcn_mbcnt_lo(~0u, 0u)) == 0u; }
__device__ __forceinline__ XcdBarrier xcd_barrier_post(unsigned* bar, volatile LAS unsigned* st, int wv) {
    XcdBarrier b; b.bar = bar; b.x = xb_xcc_id(); b.st = st; b.wv = wv;
    if (xb_t0(wv)) (void)xb_add(&bar[XB_XCNT(b.x)], 1u);
    return b;
}
__device__ __forceinline__ void xcd_barrier_complete(unsigned* bar, unsigned x, unsigned& nloc, unsigned& nx) {
    const unsigned G = gridDim.x * gridDim.y * gridDim.z;
    unsigned sum, cnt, mine, sp = 0u;
    for (;;) {
        sum = 0u; cnt = 0u; mine = 0u;
#pragma unroll
        for (unsigned j = 0; j < 16; ++j) { const unsigned c = xb_ld(&bar[XB_XCNT(j)]); sum += c; cnt += (c > 0u) ? 1u : 0u; mine = (j == x) ? c : mine; }
        if (sum == G) break;
        __builtin_amdgcn_s_sleep(1);
        if ((++sp & 255u) == 0u) { if (xb_ld(&bar[XB_TMO])) break; if (sp > XB_SPIN_CAP) { atomicAdd(&bar[XB_TMO], 1u); break; } }
    }
    nloc = mine > 0u ? mine : 1u; nx = cnt > 0u ? cnt : 1u;
}

__device__ __forceinline__ void xcd_barrier(const XcdBarrier& b) {
    asm volatile("s_waitcnt vmcnt(0)" ::: "memory");
    __syncthreads();
    if (xb_t0(b.wv)) {
        unsigned* bar = b.bar;
        __builtin_amdgcn_s_waitcnt(0);
        unsigned nloc = b.st[0], nx = b.st[1];
        if (nloc == 0u) { xcd_barrier_complete(bar, b.x, nloc, nx); b.st[0] = nloc; b.st[1] = nx; }
        const unsigned old = xb_add(&bar[XB_XSUB(b.x)], 1u);
        const unsigned gen = old / nloc;
        if (old + 1u == (gen + 1u) * nloc) {
            __builtin_amdgcn_fence(__ATOMIC_RELEASE, "agent");
            asm volatile("s_waitcnt vmcnt(0)" ::: "memory");
            const unsigned og = xb_add(&bar[XB_TOP], 1u);
            const unsigned tg = og / nx;
            if (og + 1u == (tg + 1u) * nx) xb_add(&bar[XB_TOPGEN], 1u);
            else XB_SPIN(xb_ld(&bar[XB_TOPGEN]) == tg, bar);
            __builtin_amdgcn_fence(__ATOMIC_ACQUIRE, "agent");
            xb_add(&bar[XB_XGEN(b.x)], 1u);
            asm volatile("s_waitcnt vmcnt(0)" ::: "memory");
        } else {
            XB_SPIN(xb_ld(&bar[XB_XGEN(b.x)]) == gen, bar);
            __builtin_amdgcn_fence(__ATOMIC_ACQUIRE, "agent");
            asm volatile("s_waitcnt vmcnt(0)" ::: "memory");
        }
    }
    __syncthreads();
}

constexpr int NWAVES = 8;
constexpr int RING_OFF = 0, RING_BYTES = 131072;
constexpr int LDSCTL_OFF = RING_BYTES, MISC_OFF = LDSCTL_OFF + 320;
constexpr int LDS_BYTES = 147456;
constexpr int N_PHASES = 8;

struct Frame {
    LAS unsigned char* lds;
    volatile LAS unsigned* MISC;
    gu32* ctl;
    int tid, lane, wave, vcu, G;
};
__device__ __forceinline__ float wave_sum(float v) {
#pragma unroll
    for (int o = 1; o < 64; o <<= 1) v += __shfl_xor(v, o);
    return v;
}
struct Args { const float* in[20]; float* out; unsigned char* ws; int ph_lo, ph_hi, li, pad; };

__device__ __forceinline__ void p0_transpose_item(const float* W, int ld, int nblk, const float* glo, const float* ghi, int K, bf16* WT, LAS float* scr, int item, int lane) {
    const int kb = item / nblk, nb = item % nblk, k0 = 64 * kb, n0 = 32 * nb;
#pragma unroll 8
    for (int i = 0; i < 32; ++i) { const int kk = 2 * i + (lane >> 5), k = k0 + kk; float w = W[(size_t)k * ld + n0 + (lane & 31)];
        if (glo) w *= (k < K / 2) ? glo[k] : ghi[k - K / 2];
        scr[kk * 33 + (lane & 31)] = w; }
    LDS_WAIT(); asm volatile("" ::: "memory");
    const int c = lane & 7;
#pragma unroll
    for (int j = 0; j < 4; ++j) { const int n = (lane >> 3) + 8 * j; const LAS float* s = scr + (8 * c) * 33 + n;
        v4u o; o.x = pk2(s[0 * 33], s[1 * 33]); o.y = pk2(s[2 * 33], s[3 * 33]); o.z = pk2(s[4 * 33], s[5 * 33]); o.w = pk2(s[6 * 33], s[7 * 33]);
        *(GAS v4u*)(WT + (size_t)(n0 + n) * K + k0 + 8 * c) = o; }
    LDS_WAIT(); asm volatile("" ::: "memory");
}
__device__ __forceinline__ float log_sigmoid(float z) { return fminf(z, 0.f) - log1pf(expf(-fabsf(z))); }

__device__ __forceinline__ void p0_prologue(Frame& F, const Args& a) {
    LAS float* scr = (LAS float*)(F.lds + RING_OFF + F.wave * 16384);
    unsigned char* ws = a.ws;
    const float* x = a.in[0]; const float* g1 = a.in[1]; const float* w_in = a.in[2]; const float* bfv = a.in[10];
    const float* gn_l = a.in[11]; const float* gn_f = a.in[12]; const float* w_out = a.in[13]; const float* g2 = a.in[14];
    const float* w_q = a.in[15]; const float* sk = a.in[16]; const float* pu = a.in[17]; const float* pv = a.in[18];
    bf16* win_t = (bf16*)(ws + WS_WIN); bf16* wout_t = (bf16*)(ws + WS_WOUT); bf16* wq_t = (bf16*)(ws + WS_WQ); bf16* skb = (bf16*)(ws + WS_SKB); float* wfl = (float*)(ws + WS_WFL);
    float* logf = (float*)(ws + WS_LOGF); float* sumsq = (float*)(ws + WS_SUMSQ); bf16* h = (bf16*)(ws + WS_H);
    const int gw = F.vcu * NWAVES + F.wave, NGW = F.G * NWAVES, lane = F.lane;
    constexpr int I_IN = (DMODEL / 64) * (NG1 / 32), I_OUT = (DMODEL / 64) * (DMODEL / 32), I_Q = (DMODEL / 64) * (QPW / 32);
    constexpr int I_FL = 8 * DMODEL / 64, I_SK = PH * 2 * NKEY * PHALF / 512, I_SS = T / 64, I_WAX = 8 * 2 * 2 * 4;
    constexpr int E0 = I_IN, E1 = E0 + I_OUT, E2 = E1 + I_Q, E3 = E2 + I_FL, E4 = E3 + I_SK, E5 = E4 + I_SS, E6 = E5 + I_WAX;
    for (int it = gw; it < E6; it += NGW) {
        if (it < E0) { p0_transpose_item(w_in, INC, NG1 / 32, nullptr, nullptr, DMODEL, win_t, scr, it, lane); continue; }
        if (it < E1) { p0_transpose_item(w_out, DMODEL, DMODEL / 32, gn_l, gn_f, DMODEL, wout_t, scr, it - E0, lane); continue; }
        if (it < E2) { p0_transpose_item(w_q, QPW, QPW / 32, g2, g2 + DMODEL / 2, DMODEL, wq_t, scr, it - E1, lane); continue; }
        if (it < E3) { const int i = (it - E2) * 64 + lane, j = i / DMODEL, k = i % DMODEL; wfl[i] = w_in[(size_t)k * INC + NG1 + j]; continue; }
        if (it < E4) { const size_t i = (size_t)(it - E3) * 512 + lane * 8; const f32x4 s0 = *(const GAS f32x4*)(sk + i), s1 = *(const GAS f32x4*)(sk + i + 4);
            v4u o; o.x = pk2(s0[0], s0[1]); o.y = pk2(s0[2], s0[3]); o.z = pk2(s1[0], s1[1]); o.w = pk2(s1[2], s1[3]); *(GAS v4u*)(skb + i) = o; continue; }
        if (it < E5) { sumsq[(it - E4) * 64 + lane] = 0.f; continue; }
        { const int f = it - E5, ks = f & 3, n = (f >> 2) & 1, mat = (f >> 3) & 1, hh = f >> 4; const float* wsrc = mat ? a.in[7] : a.in[5];
          const size_t o = ((size_t)(hh * 64 + 16 * ks + 8 * (lane >> 5))) * 64 + 32 * n + (lane & 31);
          v4u pw; pw.x = pk2(wsrc[o], wsrc[o + 64]); pw.y = pk2(wsrc[o + 128], wsrc[o + 192]); pw.z = pk2(wsrc[o + 256], wsrc[o + 320]); pw.w = pk2(wsrc[o + 384], wsrc[o + 448]);
          *(GAS v4u*)((bf16*)(ws + WS_WAX) + (size_t)f * 512 + lane * 8) = pw; }
    }
    { f32x4 gg[4];
#pragma unroll
      for (int j = 0; j < 4; ++j) gg[j] = *(const GAS f32x4*)(g2 + 16 * lane + 4 * j);
      unsigned char* u8 = ws + WS_U8; unsigned char* v8 = ws + WS_V8; float* su = (float*)(ws + WS_SU);
      for (int e = gw; e < NEXP; e += NGW) {
        const GAS f32x4* ur = (const GAS f32x4*)(pu + (size_t)e * DMODEL + 16 * lane); const GAS f32x4* vr = (const GAS f32x4*)(pv + (size_t)e * DMODEL + 16 * lane);
        f32x4 uu[4], vv[4]; float mu = 0.f, mv = 0.f;
#pragma unroll
        for (int j = 0; j < 4; ++j) { uu[j] = ur[j] * gg[j]; vv[j] = vr[j];
#pragma unroll
            for (int c = 0; c < 4; ++c) { mu = fmaxf(mu, fabsf(uu[j][c])); mv = fmaxf(mv, fabsf(vv[j][c])); } }
#pragma unroll
        for (int o = 1; o < 64; o <<= 1) { mu = fmaxf(mu, __shfl_xor(mu, o)); mv = fmaxf(mv, __shfl_xor(mv, o)); }
        const float scu = mu > 0.f ? mu * (1.f / 440.f) : 1.f, scv = mv > 0.f ? mv * (1.f / 440.f) : 1.f, iu = 1.f / scu, iv = 1.f / scv;
        v4u qu, qv;
#pragma unroll
        for (int j = 0; j < 4; ++j) { int wu = 0, wv = 0;
            wu = __builtin_amdgcn_cvt_pk_fp8_f32(uu[j][0] * iu, uu[j][1] * iu, wu, false); wu = __builtin_amdgcn_cvt_pk_fp8_f32(uu[j][2] * iu, uu[j][3] * iu, wu, true);
            wv = __builtin_amdgcn_cvt_pk_fp8_f32(vv[j][0] * iv, vv[j][1] * iv, wv, false); wv = __builtin_amdgcn_cvt_pk_fp8_f32(vv[j][2] * iv, vv[j][3] * iv, wv, true);
            qu[j] = (unsigned)wu; qv[j] = (unsigned)wv; }
        *(GAS v4u*)(u8 + (size_t)e * DMODEL + 16 * lane) = qu; *(GAS v4u*)(v8 + (size_t)e * DMODEL + 16 * lane) = qv;
        if (lane == 0) { su[2 * e] = scu; su[2 * e + 1] = scv; }
      } }
    { f32x4 gg[4];
#pragma unroll
      for (int j = 0; j < 4; ++j) gg[j] = *(const GAS f32x4*)(g1 + 256 * j + 4 * lane);
      float fw[4][4][8];
#pragma unroll
      for (int j = 0; j < 4; ++j)
#pragma unroll
          for (int c = 0; c < 4; ++c) { const int k = 256 * j + 4 * lane + c; const GAS f32x4* wr = (const GAS f32x4*)(w_in + (size_t)k * INC + NG1); const f32x4 w0 = wr[0], w1 = wr[1];
#pragma unroll
              for (int e = 0; e < 4; ++e) { fw[j][c][e] = w0[e]; fw[j][c][4 + e] = w1[e]; } }
      for (int t = gw; t < T; t += NGW) {
        const GAS f32x4* xr = (const GAS f32x4*)(x + (size_t)t * DMODEL) + lane;
        f32x4 v[4]; float ss = 0.f;
#pragma unroll
        for (int j = 0; j < 4; ++j) { v[j] = xr[64 * j]; ss += (v[j][0] * v[j][0] + v[j][1] * v[j][1]) + (v[j][2] * v[j][2] + v[j][3] * v[j][3]); }
        const float rstd = rsqrtf(wave_sum(ss) * (1.f / DMODEL) + RMS_EPS);
        GAS unsigned long long* ho = (GAS unsigned long long*)(h + (size_t)t * DMODEL) + lane;
#pragma unroll
        for (int j = 0; j < 4; ++j) { v[j] = v[j] * rstd * gg[j]; ho[64 * j] = (unsigned long long)pk2(v[j][0], v[j][1]) | ((unsigned long long)pk2(v[j][2], v[j][3]) << 32); }
        float fl[8];
#pragma unroll
        for (int hh = 0; hh < 8; ++hh) fl[hh] = 0.f;
#pragma unroll
        for (int j = 0; j < 4; ++j)
#pragma unroll
            for (int c = 0; c < 4; ++c) {
#pragma unroll
                for (int hh = 0; hh < 8; ++hh) fl[hh] += v[j][c] * fw[j][c][hh]; }
        float res = 0.f;
#pragma unroll
        for (int hh = 0; hh < 8; ++hh) { const float s = wave_sum(fl[hh]); if (lane == hh) res = s; }
        if (lane < 8) logf[(size_t)t * 8 + lane] = log_sigmoid(res + bfv[lane]);
      } }
}

__device__ __forceinline__ void fcum_unit(Frame& F, int bh, const float* logf, float* fcum) {
    const int b = bh / NHEADS, hh = bh % NHEADS, s0 = F.tid * 16;
    float v[16]; float loc = 0.f;
#pragma unroll
    for (int i = 0; i < 16; ++i) { v[i] = logf[((size_t)b * SEQ + s0 + i) * 8 + hh]; loc += v[i]; }
    float inc = loc;
#pragma unroll
    for (int o = 1; o < 64; o <<= 1) { const float n = __shfl_up(inc, o); if (F.lane >= o) inc += n; }
    if (F.lane == 63) F.MISC[16 + F.wave] = __float_as_uint(inc);
    __syncthreads();
    float run = inc - loc;
    for (int w = 0; w < F.wave; ++w) run += __uint_as_float(F.MISC[16 + w]);
#pragma unroll
    for (int i = 0; i < 16; ++i) { run += v[i]; fcum[(size_t)bh * SEQ + s0 + i] = run; }
    __syncthreads();
}


namespace peer {
typedef unsigned u32;
typedef float f32x16 __attribute__((ext_vector_type(16)));
constexpr int TOK = 128;
constexpr int EX_STRIDE = 136, GT_STRIDE = 132;
constexpr int L_EX = 0, L_GT = L_EX + TOK * EX_STRIDE * 2, L_IDX = L_GT + TOK * GT_STRIDE * 4, IDX_STRIDE = 36, L_RST = L_IDX + 512 * IDX_STRIDE, L_END = L_RST + TOK * 4;
static_assert(L_END <= RING_BYTES && L_GT % 16 == 0 && L_IDX % 16 == 0, "PEER LDS map");
__device__ __forceinline__ u32 ordmap(float f) { const u32 u = __float_as_uint(f); return u ^ ((u32)((int)u >> 31) | 0x80000000u); }
__device__ __forceinline__ float unordmap(u32 k) { const u32 u = (k & 0x80000000u) ? (k ^ 0x80000000u) : ~k; return __uint_as_float(u); }
__device__ __forceinline__ u32 umin_(u32 a, u32 b) { return a < b ? a : b; }
__device__ __forceinline__ u32 umax_(u32 a, u32 b) { return a > b ? a : b; }
template <bool DESC> __device__ __forceinline__ void sort16(u32 (&k)[16]) {
#pragma unroll
    for (int size = 2; size <= 16; size <<= 1)
#pragma unroll
        for (int stride = size >> 1; stride > 0; stride >>= 1)
#pragma unroll
            for (int i = 0; i < 16; ++i) { const int j = i ^ stride;
                if (j > i) { const bool asc = (((i & size) == 0) != DESC); const u32 a = k[i], b = k[j], lo = umin_(a, b), hi = umax_(a, b); k[i] = asc ? lo : hi; k[j] = asc ? hi : lo; } }
}
template <bool DESC> __device__ __forceinline__ void merge16(u32 (&k)[16]) {
#pragma unroll
    for (int stride = 8; stride > 0; stride >>= 1)
#pragma unroll
        for (int i = 0; i < 16; ++i) { const int j = i ^ stride;
            if (j > i) { const u32 a = k[i], b = k[j], lo = umin_(a, b), hi = umax_(a, b); k[i] = DESC ? hi : lo; k[j] = DESC ? lo : hi; } }
}
__host__ __device__ constexpr int ccnt(int a) { return 16 / (a + 1); }
__host__ __device__ constexpr int cbase(int a) { int s = 0; for (int i = 0; i < a; ++i) s += ccnt(i); return s; }
static_assert(cbase(16) == 50, "hyperbola candidate count");
__device__ __forceinline__ int crow16(int r) { return (r & 3) + 8 * (r >> 2); }

__device__ __forceinline__ void route_tile(Frame& F, const bf16* qp, const bf16* skb, const float* sumsq, int t0) {
    int lane = F.lane; asm volatile("" : "+v"(lane));
    const int r32 = lane & 31, hi = lane >> 5, w = F.wave;
    LAS unsigned short* EXL = (LAS unsigned short*)(F.lds + RING_OFF + L_EX);
    LAS float* GTL = (LAS float*)(F.lds + RING_OFF + L_GT);
    LAS unsigned char* IDXB = F.lds + RING_OFF + L_IDX + (w * 64 + lane) * IDX_STRIDE;
    LAS float* RST = (LAS float*)(F.lds + RING_OFF + L_RST);
    for (int g = 0; g < 4; ++g) {
        const int tok = 32 * g + r32; const size_t trow = (size_t)(t0 + tok);
        const float rstd2 = rsqrtf(sumsq[trow] * (1.f / DMODEL) + RMS_EPS);
        if (w == 0 && hi == 0) RST[tok] = rstd2;
        u32 s0[16], s1[16];
#pragma unroll
        for (int p = 0; p < 2; ++p) {
            bf16x8 qf[8];
#pragma unroll
            for (int ks = 0; ks < 8; ++ks) qf[ks] = *(const GAS bf16x8*)(qp + trow * QPW + w * 256 + p * 128 + ks * 16 + hi * 8);
            u32 run[16];
#pragma unroll
            for (int nb = 0; nb < 4; ++nb) {
                f32x16 acc = {};
                const bf16* kr = skb + ((size_t)((w * 2 + p) * NKEY + 32 * nb + r32)) * PHALF + hi * 8;
#pragma unroll
                for (int ks = 0; ks < 8; ++ks) acc = __builtin_amdgcn_mfma_f32_32x32x16_bf16(*(const GAS bf16x8*)(kr + ks * 16), qf[ks], acc, 0, 0, 0);
                asm volatile("" ::: "memory");
                u32 blk[16];
#pragma unroll
                for (int r = 0; r < 16; ++r) blk[r] = (ordmap(acc[r]) & ~0x7Fu) | (u32)(127 - 32 * nb - crow16(r) - 4 * hi);
                if (nb == 0) { sort16<true>(blk);
#pragma unroll
                    for (int i = 0; i < 16; ++i) run[i] = blk[i]; }
                else { sort16<false>(blk);
#pragma unroll
                    for (int i = 0; i < 16; ++i) run[i] = umax_(run[i], blk[i]);
                    merge16<true>(run); }
            }
            u32 oth[16];
#pragma unroll
            for (int i = 0; i < 16; ++i) oth[i] = (u32)__shfl_xor((int)run[15 - i], 32);
#pragma unroll
            for (int i = 0; i < 16; ++i) run[i] = umax_(run[i], oth[i]);
            merge16<true>(run);
#pragma unroll
            for (int i = 0; i < 16; ++i) { if (p == 0) s0[i] = run[i]; else s1[i] = run[i]; }
        }
        { LAS u32* iw = (LAS u32*)IDXB;
#pragma unroll
          for (int j = 0; j < 4; ++j) {
              iw[j] = (127u - (s0[4 * j] & 127u)) | ((127u - (s0[4 * j + 1] & 127u)) << 8) | ((127u - (s0[4 * j + 2] & 127u)) << 16) | ((127u - (s0[4 * j + 3] & 127u)) << 24);
              iw[4 + j] = (127u - (s1[4 * j] & 127u)) | ((127u - (s1[4 * j + 1] & 127u)) << 8) | ((127u - (s1[4 * j + 2] & 127u)) << 16) | ((127u - (s1[4 * j + 3] & 127u)) << 24); } }
        float v1[16], v2[16];
#pragma unroll
        for (int i = 0; i < 16; ++i) { v1[i] = unordmap(s0[i] & ~0x7Fu); v2[i] = unordmap(s1[i] & ~0x7Fu); }
        u32 c0[16], c1[16], c2[16], c3[16];
#pragma unroll
        for (int a = 0; a < 16; ++a)
#pragma unroll
            for (int b = 0; b < ccnt(a); ++b) { const int pos = cbase(a) + b; const u32 key = (ordmap(v1[a] + v2[b]) & ~0xFFu) | (u32)(255 - (a * 16 + b));
                if (pos < 16) c0[pos] = key; else if (pos < 32) c1[pos - 16] = key; else if (pos < 48) c2[pos - 32] = key; else c3[pos - 48] = key; }
#pragma unroll
        for (int i = 2; i < 16; ++i) c3[i] = 0u;
        sort16<false>(c1);
#pragma unroll
        for (int i = 0; i < 16; ++i) c0[i] = umax_(c0[i], c1[i]);
        merge16<true>(c0);
        sort16<false>(c2);
#pragma unroll
        for (int i = 0; i < 16; ++i) c0[i] = umax_(c0[i], c2[i]);
        merge16<true>(c0);
        sort16<false>(c3);
#pragma unroll
        for (int i = 0; i < 16; ++i) c0[i] = umax_(c0[i], c3[i]);
        merge16<true>(c0);
        const float m = unordmap(c0[0] & ~0xFFu) * rstd2;
        float e[8]; float sum = 0.f; u32 ex[8];
#pragma unroll
        for (int k = 0; k < 8; ++k) { const u32 key = hi ? c0[k + 8] : c0[k]; const float ts = unordmap(key & ~0xFFu);
            e[k] = __builtin_amdgcn_exp2f((ts * rstd2 - m) * LOG2E); sum += e[k];
            const u32 flat = 255u - (key & 255u); ex[k] = (u32)IDXB[flat >> 4] * NKEY + (u32)IDXB[16 + (flat & 15u)]; }
        sum += __shfl_xor(sum, 32);
        const float inv = 1.f / sum;
        v4u exw; exw.x = ex[0] | (ex[1] << 16); exw.y = ex[2] | (ex[3] << 16); exw.z = ex[4] | (ex[5] << 16); exw.w = ex[6] | (ex[7] << 16);
        *(LAS v4u*)(EXL + tok * EX_STRIDE + w * 16 + hi * 8) = exw;
        *(LAS f32x4*)(GTL + tok * GT_STRIDE + w * 16 + hi * 8) = (f32x4){e[0] * inv, e[1] * inv, e[2] * inv, e[3] * inv};
        *(LAS f32x4*)(GTL + tok * GT_STRIDE + w * 16 + hi * 8 + 4) = (f32x4){e[4] * inv, e[5] * inv, e[6] * inv, e[7] * inv};
    }
}
__device__ __forceinline__ float gelu_fast(float x) {
    const float u2 = x * (1.5957691216057308f + 0.07135481627f * x * x);
    return x * __builtin_amdgcn_rcpf(1.f + __builtin_amdgcn_exp2f(-1.4426950408889634f * u2));
}
typedef float f32x2 __attribute__((ext_vector_type(2)));

__device__ __forceinline__ void sort512(u32 (&k)[8], int lane) {
#pragma unroll
    for (int K = 2; K <= 512; K <<= 1) {
#pragma unroll
        for (int S = K >> 1; S > 0; S >>= 1) {
            if (S >= 8) {
                const int m = S >> 3; const bool lower = (lane & m) == 0, up = (K == 512) ? true : ((lane & (K >> 3)) == 0), keepmin = (lower == up);
#pragma unroll
                for (int r = 0; r < 8; ++r) { const u32 o = (u32)__shfl_xor((int)k[r], m); const u32 mn = umin_(k[r], o), mx = umax_(k[r], o); k[r] = keepmin ? mn : mx; }
            } else {
#pragma unroll
                for (int r = 0; r < 8; ++r) { const int r2 = r ^ S;
                    if (r2 > r) { const u32 a = k[r], b = k[r2], mn = umin_(a, b), mx = umax_(a, b);
                        if (K < 8) { const bool up = (r & K) == 0; k[r] = up ? mn : mx; k[r2] = up ? mx : mn; }
                        else { const bool up = (K == 512) ? true : ((lane & (K >> 3)) == 0); k[r] = up ? mn : mx; k[r2] = up ? mx : mn; } } }
            }
        }
    }
}
__device__ __forceinline__ void eval_sweep(Frame& F, const unsigned char* u8, const unsigned char* v8, const float* suv, const float* fg, float* out, int t0) {
    int lane = F.lane; asm volatile("" : "+v"(lane));
    const LAS unsigned short* EXL = (const LAS unsigned short*)(F.lds + RING_OFF + L_EX);
    const LAS float* GTL = (const LAS float*)(F.lds + RING_OFF + L_GT);
    const LAS float* RST = (const LAS float*)(F.lds + RING_OFF + L_RST);
    LAS u32* SK = (LAS u32*)(F.lds + RING_OFF + L_IDX) + F.wave * 576;
    LAS u32* GS = SK + 512;
    const int h5 = lane >> 5, h4 = (lane >> 4) & 1, h3 = (lane >> 3) & 1, jj = 4 * h3 + 2 * h4 + h5;
    for (int pass = 0; pass < 4; ++pass) {
        const int tb = 32 * pass + 4 * F.wave;
        { u32 k[8]; const int tk = lane >> 4, s0 = (lane & 15) * 8; const v4u ev = *(const LAS v4u*)(EXL + (tb + tk) * EX_STRIDE + s0);
          const u32 ee[8] = {ev.x & 0xffffu, ev.x >> 16, ev.y & 0xffffu, ev.y >> 16, ev.z & 0xffffu, ev.z >> 16, ev.w & 0xffffu, ev.w >> 16};
#pragma unroll
          for (int r = 0; r < 8; ++r) k[r] = ((ee[r] >> 10) << 23) | ((u32)tk << 21) | ((ee[r] & 1023u) << 7) | (u32)(s0 + r);
          sort512(k, lane);
          *(LAS v4u*)(SK + lane * 8) = (v4u){k[0], k[1], k[2], k[3]}; *(LAS v4u*)(SK + lane * 8 + 4) = (v4u){k[4], k[5], k[6], k[7]}; }
        asm volatile("" ::: "memory");
        {
          const u32 tgt = (u32)lane << 21; int lo = 0;
#pragma unroll
          for (int st = 256; st > 0; st >>= 1) { if (SK[lo + st - 1] < tgt) lo += st; }
          GS[lane] = (u32)lo; }
        asm volatile("" ::: "memory");
        f32x2 hv[4][8], y[4][8];
#pragma unroll
        for (int tk = 0; tk < 4; ++tk) { const float rstd2 = RST[tb + tk]; const float* xrow = out + (size_t)(t0 + tb + tk) * DMODEL + 16 * lane;
#pragma unroll
            for (int q = 0; q < 4; ++q) { const f32x4 xa = *(const GAS f32x4*)(xrow + 4 * q); hv[tk][2 * q] = (f32x2){xa[0] * rstd2, xa[1] * rstd2}; hv[tk][2 * q + 1] = (f32x2){xa[2] * rstd2, xa[3] * rstd2};
                y[tk][2 * q] = (f32x2){0.f, 0.f}; y[tk][2 * q + 1] = (f32x2){0.f, 0.f}; } }
        for (int bkt = 0; bkt < 16; ++bkt) {
#pragma unroll
            for (int tk = 0; tk < 4; ++tk) {
                const int g = bkt * 4 + tk;
                const int s = __builtin_amdgcn_readfirstlane((int)GS[g]), en = (g == 63) ? 512 : __builtin_amdgcn_readfirstlane((int)GS[(g + 1) & 63]);
                for (int i = s; i < en; i += 8) {
                    const int nrem = en - i;
                    const u32 kmine = SK[(i + (lane & 7)) & 511];
                    v4u ub[8]; int ej[8];
#pragma unroll
                    for (int j = 0; j < 8; ++j) { const int kj = __builtin_amdgcn_readlane((int)kmine, j); ej[j] = (bkt << 10) | ((kj >> 7) & 1023);
                        if (j < nrem) ub[j] = *(const GAS v4u*)(u8 + (size_t)ej[j] * DMODEL + 16 * lane); else ub[j] = (v4u){0u, 0u, 0u, 0u}; }
                    const u32 kx = SK[(i + jj) & 511]; const bool okx = jj < nrem;
                    f32x2 sc = (f32x2){0.f, 0.f}; float gate = 0.f;
                    if (okx) { sc = *(const GAS f32x2*)(suv + 2 * ((bkt << 10) | ((kx >> 7) & 1023u))); gate = GTL[(tb + tk) * GT_STRIDE + (kx & 127u)]; }
                    float p[8];
#pragma unroll
                    for (int j = 0; j < 8; ++j) { f32x2 acc = (f32x2){0.f, 0.f};
#pragma unroll
                        for (int c = 0; c < 4; ++c) { const int wd = (int)ub[j][c];
                            acc = __builtin_elementwise_fma(__builtin_amdgcn_cvt_pk_f32_fp8(wd, false), hv[tk][2 * c], acc); acc = __builtin_elementwise_fma(__builtin_amdgcn_cvt_pk_f32_fp8(wd, true), hv[tk][2 * c + 1], acc); }
                        p[j] = acc[0] + acc[1]; }
                    asm volatile("" ::: "memory");
                    v4u vb[8];
#pragma unroll
                    for (int j = 0; j < 8; ++j) { if (j < nrem) vb[j] = *(const GAS v4u*)(v8 + (size_t)ej[j] * DMODEL + 16 * lane); else vb[j] = (v4u){0u, 0u, 0u, 0u}; }
                    float q4[4], q2[2];
#pragma unroll
                    for (int n = 0; n < 4; ++n) { const float keep = h5 ? p[2 * n + 1] : p[2 * n], send = h5 ? p[2 * n] : p[2 * n + 1]; q4[n] = keep + __shfl_xor(send, 32); }
#pragma unroll
                    for (int n = 0; n < 2; ++n) { const float keep = h4 ? q4[2 * n + 1] : q4[2 * n], send = h4 ? q4[2 * n] : q4[2 * n + 1]; q2[n] = keep + __shfl_xor(send, 16); }
                    float tot; { const float keep = h3 ? q2[1] : q2[0], send = h3 ? q2[0] : q2[1]; tot = keep + __shfl_xor(send, 8); }
                    tot += __shfl_xor(tot, 4); tot += __shfl_xor(tot, 2); tot += __shfl_xor(tot, 1);
                    const float act = gelu_fast(tot * sc[0]) * (gate * sc[1]);
#pragma unroll
                    for (int j = 0; j < 8; ++j) { const float aj = __uint_as_float((unsigned)__builtin_amdgcn_readlane((int)__float_as_uint(act), ((j >> 2) & 1) * 8 + ((j >> 1) & 1) * 16 + (j & 1) * 32));
                        const f32x2 a2 = (f32x2){aj, aj};
#pragma unroll
                        for (int c = 0; c < 4; ++c) { const int wd = (int)vb[j][c];
                            y[tk][2 * c] = __builtin_elementwise_fma(__builtin_amdgcn_cvt_pk_f32_fp8(wd, false), a2, y[tk][2 * c]); y[tk][2 * c + 1] = __builtin_elementwise_fma(__builtin_amdgcn_cvt_pk_f32_fp8(wd, true), a2, y[tk][2 * c + 1]); } }
                }
            }
        }
#pragma unroll
        for (int tk = 0; tk < 4; ++tk) { float* xrow = out + (size_t)(t0 + tb + tk) * DMODEL + 16 * lane; float yo[16]; float ss = 0.f;
#pragma unroll
            for (int q = 0; q < 4; ++q) { const f32x4 xa = *(const GAS f32x4*)(xrow + 4 * q);
                yo[4 * q] = y[tk][2 * q][0] + xa[0]; yo[4 * q + 1] = y[tk][2 * q][1] + xa[1]; yo[4 * q + 2] = y[tk][2 * q + 1][0] + xa[2]; yo[4 * q + 3] = y[tk][2 * q + 1][1] + xa[3]; }
#pragma unroll
            for (int q = 0; q < 16; ++q) ss += yo[q] * yo[q];
            const float rs = rsqrtf(wave_sum(ss) * (1.f / DMODEL) + RMS_EPS);
#pragma unroll
            for (int q = 0; q < 4; ++q) { const f32x4 g = *(const GAS f32x4*)(fg + 16 * lane + 4 * q); f32x4 o; o[0] = yo[4 * q] * rs * g[0]; o[1] = yo[4 * q + 1] * rs * g[1]; o[2] = yo[4 * q + 2] * rs * g[2]; o[3] = yo[4 * q + 3] * rs * g[3];
                *(GAS f32x4*)(xrow + 4 * q) = o; } }
    }
}
__device__ __forceinline__ void peer_phase(Frame& F, const Args& a) {
    unsigned char* ws = a.ws;
    for (int tile = F.vcu; tile < T / TOK; tile += F.G) {
        route_tile(F, (const bf16*)(ws + WS_QP), (const bf16*)(ws + WS_SKB), (const float*)(ws + WS_SUMSQ), tile * TOK);
        __syncthreads();
        eval_sweep(F, ws + WS_U8, ws + WS_V8, (const float*)(ws + WS_SU), a.in[19], a.out, tile * TOK);
        __syncthreads();
    }
}
}

namespace lru {
typedef float f32x16 __attribute__((ext_vector_type(16)));
constexpr int TOKT = 128, NTILE = SEQ / TOKT;
constexpr int WAVE_LDS = 14336, L_XS = 0, L_XC = 4608, L_GS = 9216, XC_STRIDE = 72  , L_SS = 8 * WAVE_LDS;
static_assert(L_SS + 32 * 8 * 4 <= RING_BYTES, "LRU LDS map");
__device__ __forceinline__ float bf2f(unsigned short h) { return __uint_as_float((unsigned)h << 16); }
__device__ __forceinline__ int crow16(int r) { return (r & 3) + 8 * (r >> 2); }
__device__ __forceinline__ float sigm(float x) { return __builtin_amdgcn_rcpf(1.f + __builtin_amdgcn_exp2f(-LOG2E * x)); }

template <bool FINAL> __device__ __forceinline__ void lru_tile(Frame& F, const Args& args, int tile) {
    int lane = F.lane; asm volatile("" : "+v"(lane));
    const int w = F.wave, j32 = lane & 31, hi = lane >> 5;
    unsigned char* ws = args.ws;
    const bf16* xr = (const bf16*)(ws + WS_XR); const bf16* gr = (const bf16*)(ws + WS_GR); float* carry = (float*)(ws + WS_CARRY);
    const float* cw = args.in[3]; const float* cb = args.in[4]; const float* ba = args.in[6]; const float* bx = args.in[8]; const float* lam = args.in[9];
    const int b = tile / NTILE, jt = tile % NTILE; const size_t trow0 = (size_t)b * SEQ + (size_t)jt * TOKT;
    LAS unsigned char* wl = F.lds + RING_OFF + w * WAVE_LDS;
    LAS unsigned short* XS = (LAS unsigned short*)(wl + L_XS); LAS unsigned short* XC = (LAS unsigned short*)(wl + L_XC); LAS unsigned short* GS = (LAS unsigned short*)(wl + L_GS);
    LAS float* SS = (LAS float*)(F.lds + RING_OFF + L_SS);
    float c_ba[2], c_bx[2], c_sp[2], c_cb[2], c_cw[2][4];
#pragma unroll
    for (int n = 0; n < 2; ++n) { const int c = 64 * w + 32 * n + j32; c_ba[n] = ba[c]; c_bx[n] = bx[c]; c_cb[n] = cb[c];
        const float l = lam[c]; c_sp[n] = 8.f * LOG2E * (fmaxf(-l, 0.f) + log1pf(expf(-fabsf(l))));
#pragma unroll
        for (int k = 0; k < 4; ++k) c_cw[n][k] = cw[k * LW + c]; }
    const bf16* wax = (const bf16*)(ws + WS_WAX);
    float hc[2] = {0.f, 0.f}, ap[2] = {1.f, 1.f};
    if (FINAL) {
        for (int jp = 0; jp < jt; ++jp) { const float* cp = carry + ((size_t)(b * NTILE + jp) * 2) * LW + 64 * w + j32;
#pragma unroll
            for (int n = 0; n < 2; ++n) hc[n] = cp[32 * n] * hc[n] + cp[LW + 32 * n]; }
    }
    for (int blk = 0; blk < 4; ++blk) {
        const size_t tb = trow0 + blk * 32;
        int ln = lane; asm volatile("" : "+v"(ln));
        const int k32 = ln & 31;
        for (int pc = ln; pc < 35 * 8; pc += 64) { const int row = pc >> 3, c8 = pc & 7; v4u v = (v4u){0u, 0u, 0u, 0u};
            if (!(jt == 0 && blk == 0 && row < 3)) v = *(const GAS v4u*)(xr + (tb + row - 3) * LW + w * 64 + c8 * 8);
            *(LAS v4u*)((LAS unsigned char*)XS + row * 128 + c8 * 16) = v; }
        if (FINAL) {
#pragma unroll
            for (int q = 0; q < 4; ++q) { const int pc = ln + 64 * q, row = pc >> 3, c8 = pc & 7;
                *(LAS v4u*)((LAS unsigned char*)GS + row * 128 + c8 * 16) = *(const GAS v4u*)(gr + (tb + row) * LW + w * 64 + c8 * 8); } }
        asm volatile("" ::: "memory");
        float xc[2][16];
#pragma unroll
        for (int n = 0; n < 2; ++n)
#pragma unroll
            for (int g = 0; g < 4; ++g) { float xv[7];
#pragma unroll
                for (int q = 0; q < 7; ++q) xv[q] = bf2f(XS[(8 * g + 4 * hi + q) * 64 + 32 * n + j32]);
#pragma unroll
                for (int e = 0; e < 4; ++e) xc[n][4 * g + e] = c_cb[n] + ((c_cw[n][0] * xv[e] + c_cw[n][1] * xv[e + 1]) + (c_cw[n][2] * xv[e + 2] + c_cw[n][3] * xv[e + 3])); }
#pragma unroll
        for (int n = 0; n < 2; ++n)
#pragma unroll
            for (int r = 0; r < 16; ++r) XC[(crow16(r) + 4 * hi) * XC_STRIDE + 32 * n + j32] = (unsigned short)f2bf(xc[n][r]);
        asm volatile("" ::: "memory");
        bf16x8 af[4];
#pragma unroll
        for (int ks = 0; ks < 4; ++ks) af[ks] = *(const LAS bf16x8*)(XC + j32 * XC_STRIDE + 16 * ks + 8 * hi);
        asm volatile("" ::: "memory");
        float yv[2][16];
#pragma unroll
        for (int n = 0; n < 2; ++n) {
            f32x16 R = {}, I = {};
            bf16x8 fa[4], fx[4];
#pragma unroll
            for (int ks = 0; ks < 4; ++ks) { fa[ks] = *(const GAS bf16x8*)(wax + (size_t)(((w * 2 + 0) * 2 + n) * 4 + ks) * 512 + lane * 8); fx[ks] = *(const GAS bf16x8*)(wax + (size_t)(((w * 2 + 1) * 2 + n) * 4 + ks) * 512 + lane * 8); }
#pragma unroll
            for (int ks = 0; ks < 4; ++ks) { R = __builtin_amdgcn_mfma_f32_32x32x16_bf16(af[ks], fa[ks], R, 0, 0, 0); I = __builtin_amdgcn_mfma_f32_32x32x16_bf16(af[ks], fx[ks], I, 0, 0, 0); }
            float av[16], uv[16];
#pragma unroll
            for (int r = 0; r < 16; ++r) { const float rg = sigm(R[r] + c_ba[n]), ig = sigm(I[r] + c_bx[n]); const float a_ = __builtin_amdgcn_exp2f(-rg * c_sp[n]);
                av[r] = a_; uv[r] = __builtin_amdgcn_sqrtf(fmaxf(1.f - a_ * a_, 0.f)) * (ig * xc[n][r]); }
            float Ar[4], Hr[4], hst[4];
#pragma unroll
            for (int g = 0; g < 4; ++g) { Ar[g] = (av[4 * g] * av[4 * g + 1]) * (av[4 * g + 2] * av[4 * g + 3]);
                Hr[g] = ((uv[4 * g] * av[4 * g + 1] + uv[4 * g + 1]) * av[4 * g + 2] + uv[4 * g + 2]) * av[4 * g + 3] + uv[4 * g + 3]; }
            float hin = hc[n];
#pragma unroll
            for (int g = 0; g < 4; ++g) { float o1 = Ar[g] * hin + Hr[g]; const float x = __shfl_xor(o1, 32); const float hg = hi ? x : hin; o1 = Ar[g] * hg + Hr[g]; hst[g] = hg;
                const float y = __shfl_xor(o1, 32); hin = hi ? o1 : y;
                if (!FINAL) ap[n] *= Ar[g] * __shfl_xor(Ar[g], 32); }
            hc[n] = hin;
            if (FINAL) {
#pragma unroll
                for (int g = 0; g < 4; ++g) { float h = hst[g];
#pragma unroll
                    for (int e = 0; e < 4; ++e) { const int r = 4 * g + e; h = av[r] * h + uv[r]; yv[n][r] = h * bf2f(GS[(crow16(r) + 4 * hi) * 64 + 32 * n + j32]); } } }
        }
        if (FINAL) {
#pragma unroll
            for (int r = 0; r < 16; ++r) { float s = yv[0][r] * yv[0][r] + yv[1][r] * yv[1][r];
                s += __shfl_xor(s, 1); s += __shfl_xor(s, 2); s += __shfl_xor(s, 4); s += __shfl_xor(s, 8); s += __shfl_xor(s, 16);
                if (j32 == 0) SS[(crow16(r) + 4 * hi) * 8 + w] = s; }
            __syncthreads();
            bf16* ymix = (bf16*)(ws + WS_H);
#pragma unroll
            for (int r = 0; r < 16; ++r) { const int tk = crow16(r) + 4 * hi; const f32x4 s0 = *(const LAS f32x4*)(SS + tk * 8), s1 = *(const LAS f32x4*)(SS + tk * 8 + 4);
                const float rstd = rsqrtf(((s0[0] + s0[1]) + (s0[2] + s0[3]) + (s1[0] + s1[1]) + (s1[2] + s1[3])) * (1.f / LW) + RMS_EPS);
                bf16* yp = ymix + (tb + tk) * DMODEL + 64 * w + k32;
                yp[0] = (bf16)f2bf(yv[0][r] * rstd); yp[32] = (bf16)f2bf(yv[1][r] * rstd); }
            __syncthreads();
        }
    }
    if (!FINAL) { if (hi == 0) { float* cp = carry + ((size_t)(b * NTILE + jt) * 2) * LW + 64 * w + j32;
#pragma unroll
        for (int n = 0; n < 2; ++n) { cp[32 * n] = ap[n]; cp[LW + 32 * n] = hc[n]; } } }
    else {
        const bf16* ob = (const bf16*)(ws + WS_O); bf16* ymix = (bf16*)(ws + WS_H);
        for (int i = 0; i < 16; ++i) { const size_t row = trow0 + 16 * w + i; const v4u v = *(const GAS v4u*)(ob + row * AW + 8 * lane);
            float f[8]; f[0] = __uint_as_float(v.x << 16); f[1] = __uint_as_float(v.x & 0xffff0000u); f[2] = __uint_as_float(v.y << 16); f[3] = __uint_as_float(v.y & 0xffff0000u);
            f[4] = __uint_as_float(v.z << 16); f[5] = __uint_as_float(v.z & 0xffff0000u); f[6] = __uint_as_float(v.w << 16); f[7] = __uint_as_float(v.w & 0xffff0000u);
            float ss = 0.f;
#pragma unroll
            for (int e = 0; e < 8; ++e) ss += f[e] * f[e];
            const float rstd = rsqrtf(wave_sum(ss) * (1.f / AW) + RMS_EPS);
            v4u o; o.x = pk2(f[0] * rstd, f[1] * rstd); o.y = pk2(f[2] * rstd, f[3] * rstd); o.z = pk2(f[4] * rstd, f[5] * rstd); o.w = pk2(f[6] * rstd, f[7] * rstd);
            *(GAS v4u*)(ymix + row * DMODEL + LW + 8 * lane) = o; }
    }
}
__device__ __forceinline__ void norm_pass(Frame& F, const Args& a) {
    unsigned char* ws = a.ws; float* nrm = (float*)(ws + WS_NRM);
    const int gw = F.vcu * NWAVES + F.wave, NGW = F.G * NWAVES, lane = F.lane;
    for (int it = gw; it < 2 * BATCH * (SEQ / 64); it += NGW) {
        const int which = it / (BATCH * (SEQ / 64)), r = it % (BATCH * (SEQ / 64)), b = r / (SEQ / 64), t = r % (SEQ / 64);
        const bf16* src = (const bf16*)(ws + (which ? WS_K : WS_Q)) + ((size_t)b * SEQ + 64 * t) * AW + 8 * lane;
        float mx = 0.f;
#pragma unroll 8
        for (int i = 0; i < 64; ++i) { const v4u v = *(const GAS v4u*)(src + (size_t)i * AW); float s = 0.f;
#pragma unroll
            for (int c = 0; c < 4; ++c) { const float lo = __uint_as_float(v[c] << 16), hi = __uint_as_float(v[c] & 0xffff0000u); s += lo * lo + hi * hi; }
            s += __shfl_xor(s, 1); s += __shfl_xor(s, 2); s += __shfl_xor(s, 4); mx = fmaxf(mx, s); }
        if ((lane & 7) == 0) nrm[which * 4096 + (b * NHEADS + (lane >> 3)) * 128 + t] = sqrtf(mx) * 1.0001f;
    }
}
template <bool FINAL> __device__ __forceinline__ void lru_phase(Frame& F, const Args& a) {
    for (int tile = F.vcu; tile < BATCH * NTILE; tile += F.G) { lru_tile<FINAL>(F, a, tile); __syncthreads(); }
}
}
__global__ void __launch_bounds__(NWAVES * 64, 2) mk_fwd(Args args) {
    extern __shared__ __attribute__((aligned(16))) unsigned char lds[];
    Frame F;
    F.lds = (LAS unsigned char*)lds;
    F.MISC = (volatile LAS unsigned*)(F.lds + MISC_OFF);
    F.wave = __builtin_amdgcn_readfirstlane((int)threadIdx.x >> 6); F.lane = (int)__builtin_amdgcn_mbcnt_hi(~0u, __builtin_amdgcn_mbcnt_lo(~0u, 0u)); F.tid = F.wave * 64 + F.lane;
    F.G = gridDim.x; { const int bx = blockIdx.x; F.vcu = (F.G % 8 == 0) ? (bx % 8) * (F.G / 8) + bx / 8 : bx; }
    unsigned char* ws = args.ws;
    F.ctl = (gu32*)(ws + WS_CTL);
    for (int u = F.tid; u < (LDS_BYTES - LDSCTL_OFF) / 4; u += NWAVES * 64) ((LAS unsigned*)(F.lds + LDSCTL_OFF))[u] = 0u;
    __syncthreads();
    XcdBarrier bar = xcd_barrier_post((unsigned*)(F.ctl + CW_BAR) + args.li * XCD_BAR_WORDS, F.MISC + 8, F.wave);
    const int lo = args.ph_lo, hi = args.ph_hi;
#ifndef MK_REP_MASK
#define MK_REP_MASK 0
#endif
#define REPS(k) (((MK_REP_MASK >> (k)) & 1) ? 2 : 1)
#define IN(k) (lo <= (k) && (k) < hi)
#define BOTH(k) (IN(k) && IN((k) + 1))
#define GRID_BAR() xcd_barrier(bar)

    if (IN(0)) { for (int rp = 0; rp < REPS(0); ++rp) { if (rp) GRID_BAR(); p0_prologue(F, args); } if (BOTH(0)) GRID_BAR(); }

    if (IN(1)) for (int rp = 0; rp < REPS(1); ++rp) {
        if (rp) GRID_BAR();
        if (F.vcu < BATCH * NHEADS) fcum_unit(F, F.vcu, (const float*)(ws + WS_LOGF), (float*)(ws + WS_FCUM));
        pg8::Gemm g{(const pg8::bf16_t*)(ws + WS_H), (const pg8::bf16_t*)(ws + WS_WIN), T, NG1, DMODEL}; pg8::StaticOrder S; S.init(T, NG1, F.G, (int)blockIdx.x);
        pg8::EpiG1 E{(pg8::bf16_t*)(ws + WS_XR), SPLIT_STRIDE, QSCALE};
        pg8::gemm_phase<pg8::EpiG1, pg8::StaticOrder, true, true>(F.lds + RING_OFF, g, S, E, F.wave);
        if (BOTH(1) && rp == REPS(1) - 1) GRID_BAR();
    }
    if (IN(2)) { lru::lru_phase<false>(F, args); lru::norm_pass(F, args); if (BOTH(2)) GRID_BAR(); }
    if (IN(3)) {
        static_assert(attn_body::ATTN_LDS_BYTES <= RING_BYTES, "attention LDS vs frame");
        const attn_body::AttnTensors AT{(const attn_body::bf16*)(ws + WS_Q), (const attn_body::bf16*)(ws + WS_K), (const attn_body::bf16*)(ws + WS_V), (attn_body::bf16*)(ws + WS_O), (const float*)(ws + WS_FCUM), (const float*)(ws + WS_NRM)};
        attn_body::attn_phase<8>((char*)lds + RING_OFF, AT, (unsigned*)(F.ctl + CW_ATTQ), F.MISC + 24, F.wave);
        if (BOTH(3)) GRID_BAR();
    }
    if (IN(4)) { lru::lru_phase<true>(F, args); if (BOTH(4)) GRID_BAR(); }
    if (IN(5)) {
        pg8::Gemm g{(const pg8::bf16_t*)(ws + WS_H), (const pg8::bf16_t*)(ws + WS_WOUT), T, DMODEL, DMODEL}; pg8::StaticOrder S; S.init(T, DMODEL, F.G, (int)blockIdx.x);
        pg8::EpiG2 E{args.in[0], args.out, (pg8::bf16_t*)(ws + WS_X1B), (float*)(ws + WS_SUMSQ), DMODEL};
        pg8::gemm_phase<pg8::EpiG2, pg8::StaticOrder, true, true>(F.lds + RING_OFF, g, S, E, F.wave);
        if (BOTH(5)) GRID_BAR();
    }
    if (IN(6)) for (int rp = 0; rp < REPS(6); ++rp) {
        if (rp) GRID_BAR();
        pg8::Gemm g{(const pg8::bf16_t*)(ws + WS_X1B), (const pg8::bf16_t*)(ws + WS_WQ), T, QPW, DMODEL}; pg8::StaticOrder S; S.init(T, QPW, F.G, (int)blockIdx.x);
        pg8::EpiG3 E{(pg8::bf16_t*)(ws + WS_QP), QPW};
        pg8::gemm_phase<pg8::EpiG3, pg8::StaticOrder, true, true>(F.lds + RING_OFF, g, S, E, F.wave);
        if (BOTH(6) && rp == REPS(6) - 1) GRID_BAR();
    }
    if (IN(7)) { peer::peer_phase(F, args); }
#undef IN
#undef BOTH
#undef GRID_BAR
}

#ifndef MK_FRAME_MASK
#define MK_FRAME_MASK 0xFF
#endif
extern "C" void kernel_launch(void* const* d_in, const int* in_sizes, int n_in, void* d_out, int out_size, void* d_ws, size_t ws_size, hipStream_t stream) {
    static int grid = 0;
    if (grid == 0) {
        if (n_in != 20 || in_sizes[0] != T * DMODEL || out_size != T * DMODEL || ws_size < WS_END) { fprintf(stderr, "kernel_launch: unexpected shapes (n_in %d, ws %zu)\n", n_in, ws_size); grid = -1; return; }
        int dev = 0, cus = 0;
        if (hipGetDevice(&dev) != hipSuccess || hipDeviceGetAttribute(&cus, hipDeviceAttributeMultiprocessorCount, dev) != hipSuccess) { grid = -1; return; }
        if (hipFuncSetAttribute((const void*)mk_fwd, hipFuncAttributeMaxDynamicSharedMemorySize, LDS_BYTES) != hipSuccess) { fprintf(stderr, "kernel_launch: hipFuncSetAttribute failed\n"); grid = -1; return; }
        (void)hipGetLastError();
        grid = cus;
    }
    if (grid < 0) return;
    using namespace naive;
    const float* x = (const float*)d_in[0]; const float* g1 = (const float*)d_in[1]; const float* w_in = (const float*)d_in[2];
    const float* cw = (const float*)d_in[3]; const float* cb = (const float*)d_in[4]; const float* wa = (const float*)d_in[5]; const float* ba = (const float*)d_in[6];
    const float* wx = (const float*)d_in[7]; const float* bx = (const float*)d_in[8]; const float* lam = (const float*)d_in[9]; const float* bfv = (const float*)d_in[10];
    const float* gn_l = (const float*)d_in[11]; const float* gn_f = (const float*)d_in[12]; const float* w_out = (const float*)d_in[13]; const float* g2 = (const float*)d_in[14];
    const float* w_q = (const float*)d_in[15]; const float* sk = (const float*)d_in[16]; const float* pu = (const float*)d_in[17]; const float* pv = (const float*)d_in[18]; const float* fg = (const float*)d_in[19];
    char* ws = (char*)d_ws; float* out = (float*)d_out;
    naive::bf16* win_t = (naive::bf16*)(ws + WS_WIN); naive::bf16* wout_t = (naive::bf16*)(ws + WS_WOUT); naive::bf16* wq_t = (naive::bf16*)(ws + WS_WQ); naive::bf16* skb = (naive::bf16*)(ws + WS_SKB); float* wfl = (float*)(ws + WS_WFL);
    float* logf = (float*)(ws + WS_LOGF); float* fcum = (float*)(ws + WS_FCUM); float* sumsq = (float*)(ws + WS_SUMSQ);
    naive::bf16* h = (naive::bf16*)(ws + WS_H); naive::bf16* xr = (naive::bf16*)(ws + WS_XR); naive::bf16* gr = (naive::bf16*)(ws + WS_GR); naive::bf16* q = (naive::bf16*)(ws + WS_Q); naive::bf16* k = (naive::bf16*)(ws + WS_K); naive::bf16* v = (naive::bf16*)(ws + WS_V);
    naive::bf16* x1b = (naive::bf16*)(ws + WS_X1B); naive::bf16* qp = (naive::bf16*)(ws + WS_QP); naive::bf16* ut = (naive::bf16*)(ws + WS_UT); naive::bf16* vt = (naive::bf16*)(ws + WS_VT); float* la = (float*)(ws + WS_LA); float* lu = (float*)(ws + WS_LU);
    naive::bf16* ymix = h;
    if (hipMemsetAsync((char*)d_ws + WS_CTL, 0, CTL_ZERO_BYTES, stream) != hipSuccess) return;
    Args a{};
    for (int i = 0; i < 20; ++i) a.in[i] = (const float*)d_in[i];
    a.out = out; a.ws = (unsigned char*)d_ws;
    int li = 0;
    for (int p = 0; p < N_PHASES;) {
        if ((MK_FRAME_MASK >> p) & 1) {
            int e = p; while (e < N_PHASES && ((MK_FRAME_MASK >> e) & 1)) ++e;
            a.ph_lo = p; a.ph_hi = e; a.li = li++;
            hipLaunchKernelGGL(mk_fwd, dim3(grid), dim3(NWAVES * 64), LDS_BYTES, stream, a);
            p = e; continue;
        }
        switch (p) {
        case 0: k_prep_w<<<2048, 256, 0, stream>>>(w_in, w_out, gn_l, gn_f, w_q, g2, sk, win_t, wfl, wout_t, wq_t, skb);
                k_prep_tab<<<4096, 256, 0, stream>>>(pu, pv, g2, ut, vt);
                k_prep_x<<<2048, 256, 0, stream>>>(x, g1, wfl, bfv, h, logf); break;
        case 1: k_fcum<<<BATCH * NHEADS, 64, 0, stream>>>(logf, fcum);
                { EpiArgs e{xr, gr, q, k, v, nullptr, nullptr}; k_gemm<1><<<dim3(NG1 / 64, T / 64), 256, 0, stream>>>(h, win_t, T, NG1, DMODEL, e); } break;
        case 2: break;
        case 3: k_attn<<<(BATCH * NHEADS * SEQ) / 4, 256, 0, stream>>>(q, k, v, fcum, (naive::bf16*)(ws + WS_O)); break;
        case 4: k_lru_gates<<<T * NHEADS, 64, 0, stream>>>(xr, cw, cb, wa, ba, wx, bx, lam, la, lu);
                k_lru_scan<<<(BATCH * LW + 63) / 64, 64, 0, stream>>>(la, lu, gr);
                k_ymix<<<2048, 256, 0, stream>>>(lu, (naive::bf16*)(ws + WS_O), ymix); break;
        case 5: { EpiArgs e{x1b, nullptr, nullptr, nullptr, nullptr, x, out}; k_gemm<2><<<dim3(DMODEL / 64, T / 64), 256, 0, stream>>>(ymix, wout_t, T, DMODEL, DMODEL, e); }
                k_sumsq<<<2048, 256, 0, stream>>>(out, sumsq); break;
        case 6: { EpiArgs e{qp, nullptr, nullptr, nullptr, nullptr, nullptr, nullptr}; k_gemm<3><<<dim3(QPW / 64, T / 64), 256, 0, stream>>>(x1b, wq_t, T, QPW, DMODEL, e); } break;
        case 7: k_peer<<<T, 64, 0, stream>>>(qp, skb, sumsq, ut, vt, fg, out); break;
        }
        ++p;
    }
}
```

```cpp
#include <hip/hip_runtime.h>
#include <hip/hip_bf16.h>
#include <cstdio>
#include <cstdint>
#include <cmath>

constexpr int BATCH = 4, SEQ = 8192, DMODEL = 1024, T = BATCH * SEQ;
constexpr int LW = 512, AW = 512, NHEADS = 8, HD = 64, INC = 2568, NG1 = 2560;
constexpr int PH = 8, NKEY = 128, PHALF = 128, TOPK = 16, NEXP = NKEY * NKEY, QPW = 2048;
constexpr float RMS_EPS = 1e-6f;
constexpr float LOG2E = 1.4426950408889634f;
constexpr float QSCALE = 0.125f * LOG2E;
constexpr size_t MiB = 1u << 20;
constexpr size_t WS_CTL = 0, CTL_ZERO_BYTES = 1 * MiB;
constexpr size_t WS_WIN = 2 * MiB, WS_WOUT = 8 * MiB, WS_WQ = 10 * MiB, WS_SKB = 14 * MiB, WS_WFL = 15 * MiB,
                 WS_LOGF = 16 * MiB, WS_FCUM = 17 * MiB, WS_CARRY = 18 * MiB, WS_SUMSQ = 19 * MiB, WS_WAX = 20 * MiB, WS_NRM = 22 * MiB  ,
                 WS_H = 32 * MiB, WS_XR = 96 * MiB, WS_GR = 128 * MiB, WS_Q = 160 * MiB, WS_K = 192 * MiB, WS_V = 224 * MiB,
                 WS_X1B = 256 * MiB, WS_O = 256 * MiB  , WS_QP = 96 * MiB, WS_UT = 320 * MiB, WS_VT = 352 * MiB, WS_U8 = 320 * MiB, WS_V8 = 336 * MiB, WS_SU = 21 * MiB, WS_SV = 21 * MiB + 65536, WS_LA = 384 * MiB, WS_LU = 448 * MiB, WS_END = 512 * MiB;
constexpr size_t SPLIT_STRIDE = (WS_GR - WS_XR) / 2;
constexpr int CW_TMO = 0, CW_ATTQ = 2048, CW_BAR = 4096;

namespace naive {
typedef unsigned short bf16;
__device__ __forceinline__ unsigned f2bf(float f) { unsigned u = __builtin_bit_cast(unsigned, f); return (u + 0x7fffu + ((u >> 16) & 1u)) >> 16; }
__device__ __forceinline__ float bf2f(unsigned short h) { return __builtin_bit_cast(float, (unsigned)h << 16); }
__device__ __forceinline__ float gelu_tanh(float x) { const float u = 0.7978845608028654f * (x + 0.044715f * x * x * x); return 0.5f * x * (1.f + tanhf(u)); }
__device__ __forceinline__ float sigmoidf_(float x) { return 1.f / (1.f + expf(-x)); }
__device__ __forceinline__ float wave_sum(float v) {
#pragma unroll
    for (int o = 1; o < 64; o <<= 1) v += __shfl_xor(v, o);
    return v;
}
__global__ void k_prep_w(const float* w_in, const float* w_out, const float* gn_l, const float* gn_f, const float* w_q, const float* g2, const float* sk,
                         bf16* win_t, float* wfl, bf16* wout_t, bf16* wq_t, bf16* skb) {
    const size_t gid = (size_t)blockIdx.x * blockDim.x + threadIdx.x, gsz = (size_t)gridDim.x * blockDim.x;
    for (size_t i = gid; i < (size_t)NG1 * DMODEL; i += gsz) { const int n = (int)(i / DMODEL), k = (int)(i % DMODEL); win_t[i] = (bf16)f2bf(w_in[(size_t)k * INC + n]); }
    for (size_t i = gid; i < (size_t)8 * DMODEL; i += gsz) { const int j = (int)(i / DMODEL), k = (int)(i % DMODEL); wfl[i] = w_in[(size_t)k * INC + NG1 + j]; }
    for (size_t i = gid; i < (size_t)DMODEL * DMODEL; i += gsz) { const int n = (int)(i / DMODEL), k = (int)(i % DMODEL); const float g = k < LW ? gn_l[k] : gn_f[k - LW]; wout_t[i] = (bf16)f2bf(g * w_out[(size_t)k * DMODEL + n]); }
    for (size_t i = gid; i < (size_t)QPW * DMODEL; i += gsz) { const int n = (int)(i / DMODEL), k = (int)(i % DMODEL); wq_t[i] = (bf16)f2bf(g2[k] * w_q[(size_t)k * QPW + n]); }
    for (size_t i = gid; i < (size_t)PH * 2 * NKEY * PHALF; i += gsz) skb[i] = (bf16)f2bf(sk[i]);
}
__global__ void k_prep_tab(const float* u, const float* v, const float* g2, bf16* ut, bf16* vt) {
    const size_t gid = (size_t)blockIdx.x * blockDim.x + threadIdx.x, gsz = (size_t)gridDim.x * blockDim.x;
    for (size_t i = gid; i < (size_t)NEXP * DMODEL; i += gsz) { const int d = (int)(i % DMODEL); ut[i] = (bf16)f2bf(g2[d] * u[i]); vt[i] = (bf16)f2bf(v[i]); }
}
__global__ void k_prep_x(const float* x, const float* g1, const float* wfl, const float* bfv, bf16* h, float* logf) {
    const int lane = threadIdx.x & 63, wv = (blockIdx.x * blockDim.x + threadIdx.x) >> 6, nw = (gridDim.x * blockDim.x) >> 6;
    for (int t = wv; t < T; t += nw) {
        float xv[16]; float ss = 0.f;
#pragma unroll
        for (int j = 0; j < 4; ++j) { const float4 v = *(const float4*)(x + (size_t)t * DMODEL + j * 256 + lane * 4); xv[4 * j] = v.x; xv[4 * j + 1] = v.y; xv[4 * j + 2] = v.z; xv[4 * j + 3] = v.w; ss += v.x * v.x + v.y * v.y + v.z * v.z + v.w * v.w; }
        const float rstd = rsqrtf(wave_sum(ss) * (1.f / DMODEL) + RMS_EPS);
#pragma unroll
        for (int j = 0; j < 4; ++j) { const float4 g = *(const float4*)(g1 + j * 256 + lane * 4); xv[4 * j] *= rstd * g.x; xv[4 * j + 1] *= rstd * g.y; xv[4 * j + 2] *= rstd * g.z; xv[4 * j + 3] *= rstd * g.w;
            uint2 o; o.x = f2bf(xv[4 * j]) | (f2bf(xv[4 * j + 1]) << 16); o.y = f2bf(xv[4 * j + 2]) | (f2bf(xv[4 * j + 3]) << 16); *(uint2*)(h + (size_t)t * DMODEL + j * 256 + lane * 4) = o; }
#pragma unroll
        for (int hh = 0; hh < 8; ++hh) { float a = 0.f;
#pragma unroll
            for (int j = 0; j < 4; ++j) { const float4 w = *(const float4*)(wfl + hh * DMODEL + j * 256 + lane * 4); a += xv[4 * j] * w.x + xv[4 * j + 1] * w.y + xv[4 * j + 2] * w.z + xv[4 * j + 3] * w.w; }
            a = wave_sum(a);
            if (lane == 0) { const float z = a + bfv[hh]; logf[(size_t)t * 8 + hh] = fminf(z, 0.f) - log1pf(expf(-fabsf(z))); } }
    }
}
__global__ void k_fcum(const float* logf, float* fcum) {
    const int lane = threadIdx.x & 63, bh = blockIdx.x, b = bh / NHEADS, hh = bh % NHEADS;
    float loc = 0.f;
    for (int i = 0; i < 128; ++i) loc += logf[((size_t)b * SEQ + lane * 128 + i) * 8 + hh];
    float inc = loc;
#pragma unroll
    for (int o = 1; o < 64; o <<= 1) { const float n = __shfl_up(inc, o); if (lane >= o) inc += n; }
    float run = inc - loc;
    for (int i = 0; i < 128; ++i) { run += logf[((size_t)b * SEQ + lane * 128 + i) * 8 + hh]; fcum[(size_t)bh * SEQ + lane * 128 + i] = run; }
}
struct EpiArgs { bf16* o0; bf16* o1; bf16* o2; bf16* o3; bf16* o4; const float* resid; float* outf; };
template <int EPI> __global__ void __launch_bounds__(256) k_gemm(const bf16* A, const bf16* Bt, int M, int N, int K, EpiArgs e) {
    __shared__ float As[32][65], Bs[32][65];
    const int tid = threadIdx.x, tx = tid & 15, ty = tid >> 4, m0 = blockIdx.y * 64, n0 = blockIdx.x * 64;
    float acc[4][4] = {};
    const int lr = tid >> 2, lc = (tid & 3) * 8;
    for (int k0 = 0; k0 < K; k0 += 32) {
        const uint4 av = *(const uint4*)(A + (size_t)(m0 + lr) * K + k0 + lc), bv = *(const uint4*)(Bt + (size_t)(n0 + lr) * K + k0 + lc);
        const unsigned aw[4] = {av.x, av.y, av.z, av.w}, bw[4] = {bv.x, bv.y, bv.z, bv.w};
#pragma unroll
        for (int i = 0; i < 4; ++i) { As[lc + 2 * i][lr] = bf2f(aw[i] & 0xffff); As[lc + 2 * i + 1][lr] = bf2f(aw[i] >> 16); Bs[lc + 2 * i][lr] = bf2f(bw[i] & 0xffff); Bs[lc + 2 * i + 1][lr] = bf2f(bw[i] >> 16); }
        __syncthreads();
#pragma unroll 8
        for (int k = 0; k < 32; ++k) { float a[4], b[4];
#pragma unroll
            for (int i = 0; i < 4; ++i) { a[i] = As[k][ty * 4 + i]; b[i] = Bs[k][tx * 4 + i]; }
#pragma unroll
            for (int i = 0; i < 4; ++i)
#pragma unroll
                for (int j = 0; j < 4; ++j) acc[i][j] += a[i] * b[j]; }
        __syncthreads();
    }
#pragma unroll
    for (int i = 0; i < 4; ++i)
#pragma unroll
        for (int j = 0; j < 4; ++j) { const int m = m0 + ty * 4 + i, n = n0 + tx * 4 + j; const float v = acc[i][j];
            if (EPI == 1) { const int s = n >> 9, c = n & 511; bf16* o = s == 0 ? e.o0 : s == 1 ? e.o1 : s == 2 ? e.o2 : s == 3 ? e.o3 : e.o4;
                const float w = s == 1 ? gelu_tanh(v) : s == 2 ? v * QSCALE : v; o[(size_t)m * 512 + c] = (bf16)f2bf(w); }
            else if (EPI == 2) { const float r = e.resid[(size_t)m * DMODEL + n] + v; e.outf[(size_t)m * DMODEL + n] = r; e.o0[(size_t)m * DMODEL + n] = (bf16)f2bf(r); }
            else { e.o0[(size_t)m * N + n] = (bf16)f2bf(v); } }
}
__global__ void k_sumsq(const float* x1, float* sumsq) {
    const int lane = threadIdx.x & 63, wv = (blockIdx.x * blockDim.x + threadIdx.x) >> 6, nw = (gridDim.x * blockDim.x) >> 6;
    for (int t = wv; t < T; t += nw) { float ss = 0.f;
#pragma unroll
        for (int j = 0; j < 4; ++j) { const float4 v = *(const float4*)(x1 + (size_t)t * DMODEL + j * 256 + lane * 4); ss += v.x * v.x + v.y * v.y + v.z * v.z + v.w * v.w; }
        ss = wave_sum(ss); if (lane == 0) sumsq[t] = ss; }
}
__global__ void k_lru_gates(const bf16* xr, const float* cw, const float* cb, const float* wa, const float* ba, const float* wx, const float* bx, const float* lam, float* la, float* lu) {
    __shared__ float xc[64];
    const int j = threadIdx.x, t = blockIdx.x / NHEADS, hh = blockIdx.x % NHEADS, ch = hh * 64 + j, s = t % SEQ;
    float c = cb[ch];
#pragma unroll
    for (int k = 0; k < 4; ++k) { const int ss = s - 3 + k; if (ss >= 0) c += cw[k * LW + ch] * bf2f(xr[(size_t)(t - 3 + k) * LW + ch]); }
    xc[j] = c; __syncthreads();
    float r = ba[ch], ii = bx[ch];
    for (int i = 0; i < 64; ++i) { const float xv = xc[i]; r += xv * wa[(size_t)(hh * 64 + i) * 64 + j]; ii += xv * wx[(size_t)(hh * 64 + i) * 64 + j]; }
    r = sigmoidf_(r); ii = sigmoidf_(ii);
    const float l = lam[ch], sp = fmaxf(-l, 0.f) + log1pf(expf(-fabsf(l)));
    const float log_a = -8.f * r * sp, a = expf(log_a), u = sqrtf(-expm1f(2.f * log_a)) * (ii * c);
    la[(size_t)t * LW + ch] = a; lu[(size_t)t * LW + ch] = u;
}
__global__ void k_lru_scan(const float* la, float* lu, const bf16* gr) {
    const int id = blockIdx.x * blockDim.x + threadIdx.x; if (id >= BATCH * LW) return;
    const int b = id / LW, ch = id % LW; float h = 0.f;
    for (int s = 0; s < SEQ; ++s) { const size_t o = ((size_t)b * SEQ + s) * LW + ch; h = la[o] * h + lu[o]; lu[o] = h * bf2f(gr[o]); }
}
__global__ void k_ymix(const float* ylru, const bf16* o, bf16* ymix) {
    const int lane = threadIdx.x & 63, wv = (blockIdx.x * blockDim.x + threadIdx.x) >> 6, nw = (gridDim.x * blockDim.x) >> 6;
    for (int t = wv; t < T; t += nw) {
        float a[8], f[8]; float sa = 0.f, sf = 0.f;
#pragma unroll
        for (int i = 0; i < 8; ++i) { a[i] = ylru[(size_t)t * LW + i * 64 + lane]; f[i] = bf2f(o[(size_t)t * AW + i * 64 + lane]); sa += a[i] * a[i]; sf += f[i] * f[i]; }
        const float ra = rsqrtf(wave_sum(sa) * (1.f / LW) + RMS_EPS), rf = rsqrtf(wave_sum(sf) * (1.f / AW) + RMS_EPS);
#pragma unroll
        for (int i = 0; i < 8; ++i) { ymix[(size_t)t * DMODEL + i * 64 + lane] = (bf16)f2bf(a[i] * ra); ymix[(size_t)t * DMODEL + LW + i * 64 + lane] = (bf16)f2bf(f[i] * rf); }
    }
}
__global__ void __launch_bounds__(256) k_attn(const bf16* Q, const bf16* K, const bf16* V, const float* fcum, bf16* O) {
    const int lane = threadIdx.x & 63, wv = (blockIdx.x * blockDim.x + threadIdx.x) >> 6;
    const int q = wv % SEQ, bh = wv / SEQ, b = bh / NHEADS, hh = bh % NHEADS;
    const size_t rowq = (size_t)b * SEQ + q;
    float qv[64];
#pragma unroll
    for (int i = 0; i < 8; ++i) { const uint4 w = *(const uint4*)(Q + rowq * AW + hh * 64 + i * 8); const unsigned ww[4] = {w.x, w.y, w.z, w.w};
#pragma unroll
        for (int c = 0; c < 4; ++c) { qv[i * 8 + 2 * c] = bf2f(ww[c] & 0xffff); qv[i * 8 + 2 * c + 1] = bf2f(ww[c] >> 16); } }
    const float fq = fcum[(size_t)bh * SEQ + q];
    float m = -INFINITY, l = 0.f; float o[64];
#pragma unroll
    for (int d = 0; d < 64; ++d) o[d] = 0.f;
    for (int j = lane; j <= q; j += 64) {
        const size_t rowk = (size_t)b * SEQ + j; float s = 0.f;
#pragma unroll
        for (int i = 0; i < 8; ++i) { const uint4 w = *(const uint4*)(K + rowk * AW + hh * 64 + i * 8); const unsigned ww[4] = {w.x, w.y, w.z, w.w};
#pragma unroll
            for (int c = 0; c < 4; ++c) { s += qv[i * 8 + 2 * c] * bf2f(ww[c] & 0xffff) + qv[i * 8 + 2 * c + 1] * bf2f(ww[c] >> 16); } }
        s += (fq - fcum[(size_t)bh * SEQ + j]) * LOG2E;
        const float mn = fmaxf(m, s), sc = exp2f(m - mn), p = exp2f(s - mn);
        l = l * sc + p; m = mn;
#pragma unroll
        for (int i = 0; i < 8; ++i) { const uint4 w = *(const uint4*)(V + rowk * AW + hh * 64 + i * 8); const unsigned ww[4] = {w.x, w.y, w.z, w.w};
#pragma unroll
            for (int c = 0; c < 4; ++c) { o[i * 8 + 2 * c] = o[i * 8 + 2 * c] * sc + p * bf2f(ww[c] & 0xffff); o[i * 8 + 2 * c + 1] = o[i * 8 + 2 * c + 1] * sc + p * bf2f(ww[c] >> 16); } }
    }
    float mall = m;
#pragma unroll
    for (int of = 1; of < 64; of <<= 1) mall = fmaxf(mall, __shfl_xor(mall, of));
    const float sc = (m == -INFINITY) ? 0.f : exp2f(m - mall);
    const float lt = wave_sum(l * sc); const float inv = 1.f / lt;
    float mine = 0.f;
#pragma unroll
    for (int d = 0; d < 64; ++d) { const float v = wave_sum(o[d] * sc); if (lane == d) mine = v; }
    O[rowq * AW + hh * 64 + lane] = (bf16)f2bf(mine * inv);
}
__device__ __forceinline__ void wave_argmax(float v, int idx, float& bv, int& bi) {
#pragma unroll
    for (int o = 1; o < 64; o <<= 1) { const float ov = __shfl_xor(v, o); const int oi = __shfl_xor(idx, o); if (ov > v || (ov == v && oi < idx)) { v = ov; idx = oi; } }
    bv = v; bi = idx;
}
__global__ void __launch_bounds__(64) k_peer(const bf16* qp, const bf16* skb, const float* sumsq, const bf16* ut, const bf16* vt, const float* fg, float* out) {
    __shared__ float qs[2048]; __shared__ float sc[256]; __shared__ float s1[16], s2[16]; __shared__ int i1[16], i2[16]; __shared__ int ex[128]; __shared__ float gt[128];
    const int lane = threadIdx.x, t = blockIdx.x;
    const float rstd2 = rsqrtf(sumsq[t] * (1.f / DMODEL) + RMS_EPS);
    for (int i = lane; i < 2048; i += 64) qs[i] = bf2f(qp[(size_t)t * 2048 + i]) * rstd2;
    __syncthreads();
    for (int hh = 0; hh < PH; ++hh) {
        for (int r = 0; r < 4; ++r) { const int idx = r * 64 + lane, p = idx >> 7, n = idx & 127; const bf16* kr = skb + ((size_t)(hh * 2 + p) * NKEY + n) * PHALF; const float* qq = qs + hh * 256 + p * 128;
            float a = 0.f; for (int c = 0; c < 128; ++c) a += qq[c] * bf2f(kr[c]); sc[idx] = a; }
        __syncthreads();
        for (int p = 0; p < 2; ++p) {
            float v0 = sc[p * 128 + lane], v1 = sc[p * 128 + 64 + lane];
            for (int k = 0; k < 16; ++k) { float v; int id; if (v0 >= v1) { v = v0; id = lane; } else { v = v1; id = lane + 64; }
                float bv; int bi; wave_argmax(v, id, bv, bi);
                if (lane == 0) { if (p == 0) { s1[k] = bv; i1[k] = bi; } else { s2[k] = bv; i2[k] = bi; } }
                if (bi == lane) v0 = -INFINITY; if (bi == lane + 64) v1 = -INFINITY; }
        }
        __syncthreads();
        float cv[4];
#pragma unroll
        for (int r = 0; r < 4; ++r) { const int idx = r * 64 + lane; cv[r] = s1[idx >> 4] + s2[idx & 15]; }
        float tops = 0.f; int topp = 0;
        for (int k = 0; k < 16; ++k) { float v = cv[0]; int id = lane;
#pragma unroll
            for (int r = 1; r < 4; ++r) if (cv[r] > v) { v = cv[r]; id = r * 64 + lane; }
            float bv; int bi; wave_argmax(v, id, bv, bi);
            if (lane == k) { tops = bv; topp = bi; }
#pragma unroll
            for (int r = 0; r < 4; ++r) if (bi == r * 64 + lane) cv[r] = -INFINITY; }
        float mx = lane < 16 ? tops : -INFINITY;
#pragma unroll
        for (int o = 1; o < 64; o <<= 1) mx = fmaxf(mx, __shfl_xor(mx, o));
        const float ev = lane < 16 ? expf(tops - mx) : 0.f; const float den = wave_sum(ev);
        if (lane < 16) { ex[hh * 16 + lane] = i1[topp >> 4] * NKEY + i2[topp & 15]; gt[hh * 16 + lane] = ev / den; }
        __syncthreads();
    }
    float hv[16], y[16];
    const float* x1 = out + (size_t)t * DMODEL;
#pragma unroll
    for (int j = 0; j < 4; ++j) { const float4 v = *(const float4*)(x1 + j * 256 + lane * 4); hv[4 * j] = v.x * rstd2; hv[4 * j + 1] = v.y * rstd2; hv[4 * j + 2] = v.z * rstd2; hv[4 * j + 3] = v.w * rstd2; }
#pragma unroll
    for (int i = 0; i < 16; ++i) y[i] = 0.f;
    for (int k = 0; k < 128; ++k) { const int e = ex[k]; const float g = gt[k]; float a = 0.f;
#pragma unroll
        for (int j = 0; j < 4; ++j) { const uint2 w = *(const uint2*)(ut + (size_t)e * DMODEL + j * 256 + lane * 4);
            a += hv[4 * j] * bf2f(w.x & 0xffff) + hv[4 * j + 1] * bf2f(w.x >> 16) + hv[4 * j + 2] * bf2f(w.y & 0xffff) + hv[4 * j + 3] * bf2f(w.y >> 16); }
        a = wave_sum(a); const float act = gelu_tanh(a) * g;
#pragma unroll
        for (int j = 0; j < 4; ++j) { const uint2 w = *(const uint2*)(vt + (size_t)e * DMODEL + j * 256 + lane * 4);
            y[4 * j] += act * bf2f(w.x & 0xffff); y[4 * j + 1] += act * bf2f(w.x >> 16); y[4 * j + 2] += act * bf2f(w.y & 0xffff); y[4 * j + 3] += act * bf2f(w.y >> 16); } }
    float ss = 0.f;
#pragma unroll
    for (int j = 0; j < 4; ++j) { const float4 v = *(const float4*)(x1 + j * 256 + lane * 4); y[4 * j] += v.x; y[4 * j + 1] += v.y; y[4 * j + 2] += v.z; y[4 * j + 3] += v.w; }
#pragma unroll
    for (int i = 0; i < 16; ++i) ss += y[i] * y[i];
    const float rs = rsqrtf(wave_sum(ss) * (1.f / DMODEL) + RMS_EPS);
#pragma unroll
    for (int j = 0; j < 4; ++j) { const float4 g = *(const float4*)(fg + j * 256 + lane * 4); float4 o; o.x = y[4 * j] * rs * g.x; o.y = y[4 * j + 1] * rs * g.y; o.z = y[4 * j + 2] * rs * g.z; o.w = y[4 * j + 3] * rs * g.w;
        *(float4*)(out + (size_t)t * DMODEL + j * 256 + lane * 4) = o; }
}
}

namespace pg8 {
#define PG8_LAS __attribute__((address_space(3)))
typedef unsigned short bf16_t;
typedef short bf16x8 __attribute__((ext_vector_type(8)));
typedef float f32x4 __attribute__((ext_vector_type(4)));
typedef unsigned u32x4 __attribute__((ext_vector_type(4)));
constexpr int BM = 256, BK = 64, HALF = 128, HTB = HALF * BK * 2  , STAGE_BYTES = 8 * HTB, NXCD = 8, WGM = 8;

__host__ __device__ __forceinline__ int lds_byte(int r, int c) { const int st = (r >> 4) * 2 + (c >> 5), rr = r & 15, cc = c & 31, ob = rr * 64 + cc * 2; return st * 1024 + (ob ^ (((ob >> 9) & 1) << 5)); }
__host__ __device__ __forceinline__ void stage_rc(int b, int& R, int& C) { const int st = b / 1024, sb = b % 1024, swz = sb ^ (((sb >> 9) & 1) << 5); R = (st >> 1) * 16 + swz / 64; C = (st & 1) * 32 + (swz % 64) / 2; }
__host__ __device__ __forceinline__ int perm32(int rho) { const int n = rho >> 4, i = rho & 15; return 8 * (i >> 2) + 4 * n + (i & 3); }

struct Unit { int pm, pn; };
struct Gemm { const bf16_t* A; const bf16_t* Bt; int M, N, K; };

struct StaticOrder {
    int nM, nN, nwg, G, c;
    __host__ __device__ void init(int M, int N, int G_, int c_) { nM = M / BM; nN = N / BM; nwg = nM * nN; G = G_; c = c_; }
    __host__ __device__ bool next(int i, Unit& u) const {
        const long L = (long)i * G + c; if (L >= nwg) return false;
        int wgid = (int)L; { const int q = nwg / NXCD, r = nwg % NXCD, xcd = wgid % NXCD, off = wgid / NXCD; wgid = (xcd < r ? xcd * (q + 1) : r * (q + 1) + (xcd - r) * q) + off; }
        const int nig = WGM * nN, gid = wgid / nig, fm = gid * WGM, gsz = (nM - fm) < WGM ? (nM - fm) : WGM;
        u.pm = fm + ((wgid % nig) % gsz); u.pn = (wgid % nig) / gsz; return true;
    }
    __device__ __forceinline__ void a_ready(const Unit&) const {}
    __device__ __forceinline__ void done(const Unit&) const {}
};

__device__ __forceinline__ unsigned cvt_pk_bf16(float lo, float hi) { unsigned r; asm volatile("v_cvt_pk_bf16_f32 %0, %1, %2" : "=v"(r) : "v"(lo), "v"(hi)); return r; }
typedef unsigned u32x2 __attribute__((ext_vector_type(2)));
__device__ __forceinline__ float gelu_fast(float x) {
    const float u2 = x * (1.5957691216057308f + 0.07135481627f * x * x);
    return x * __builtin_amdgcn_rcpf(1.f + __builtin_amdgcn_exp2f(-1.4426950408889634f * u2));
}
struct EpiG1 {
    static constexpr bool PERM = true, AFTER_DRAIN = false;
    bf16_t* base0; size_t split_stride; float qscale;
    __device__ __forceinline__ void operator()(const f32x4 (&acc)[2][2][4][2], const Unit& u, int wr, int wc, int fr, int fq) const {
        const int s = u.pn >> 1; bf16_t* base = base0 + (size_t)s * split_stride;
        const int row0 = u.pm * BM + wr * 64 + fr, col0 = (u.pn & 1) * 256 + wc * 32 + 8 * fq;
#pragma unroll
        for (int ai = 0; ai < 2; ++ai)
#pragma unroll
            for (int m = 0; m < 4; ++m) { bf16_t* rowp = base + (size_t)(row0 + ai * HALF + m * 16) * 512 + col0;
#pragma unroll
                for (int bj = 0; bj < 2; ++bj) { f32x4 v0 = acc[ai][bj][m][0], v1 = acc[ai][bj][m][1];
                    if (s == 1) {
#pragma unroll
                        for (int e = 0; e < 4; ++e) { v0[e] = gelu_fast(v0[e]); v1[e] = gelu_fast(v1[e]); } }
                    else if (s == 2) { v0 = v0 * qscale; v1 = v1 * qscale; }
                    u32x4 w; w.x = cvt_pk_bf16(v0[0], v0[1]); w.y = cvt_pk_bf16(v0[2], v0[3]); w.z = cvt_pk_bf16(v1[0], v1[1]); w.w = cvt_pk_bf16(v1[2], v1[3]);
                    *(u32x4*)(rowp + bj * HALF) = w; } }
    }
};
struct EpiG2 {
    static constexpr bool PERM = false, AFTER_DRAIN = false;
    const float* resid; float* out; bf16_t* xb; float* sumsq; int ldc;
    __device__ __forceinline__ void operator()(const f32x4 (&acc)[2][2][4][2], const Unit& u, int wr, int wc, int fr, int fq) const {
        const int row0 = u.pm * BM + wr * 64 + fr, col0 = u.pn * BM + wc * 32 + 4 * fq;
#pragma unroll
        for (int ai = 0; ai < 2; ++ai)
#pragma unroll
            for (int m = 0; m < 4; ++m) { const int r = row0 + ai * HALF + m * 16; const size_t off = (size_t)r * ldc + col0; float ss = 0.f;
#pragma unroll
                for (int bj = 0; bj < 2; ++bj)
#pragma unroll
                    for (int n = 0; n < 2; ++n) { const f32x4 x = *(const f32x4*)(resid + off + bj * HALF + n * 16) + acc[ai][bj][m][n];
                        *(f32x4*)(out + off + bj * HALF + n * 16) = x; ss += (x[0] * x[0] + x[1] * x[1]) + (x[2] * x[2] + x[3] * x[3]);
                        u32x2 w; w.x = cvt_pk_bf16(x[0], x[1]); w.y = cvt_pk_bf16(x[2], x[3]); *(u32x2*)(xb + off + bj * HALF + n * 16) = w; }
                ss += __shfl_xor(ss, 16); ss += __shfl_xor(ss, 32);
                if (fq == 0) atomicAdd(sumsq + r, ss);
                asm volatile("" ::: "memory"); }
    }
};
struct EpiG3 {
    static constexpr bool PERM = true, AFTER_DRAIN = false;
    bf16_t* O; int ldc;
    __device__ __forceinline__ void operator()(const f32x4 (&acc)[2][2][4][2], const Unit& u, int wr, int wc, int fr, int fq) const {
        const int row0 = u.pm * BM + wr * 64 + fr, col0 = u.pn * BM + wc * 32 + 8 * fq;
#pragma unroll
        for (int ai = 0; ai < 2; ++ai)
#pragma unroll
            for (int m = 0; m < 4; ++m) { bf16_t* rowp = O + (size_t)(row0 + ai * HALF + m * 16) * ldc + col0;
#pragma unroll
                for (int bj = 0; bj < 2; ++bj) { const f32x4 v0 = acc[ai][bj][m][0], v1 = acc[ai][bj][m][1];
                    u32x4 w; w.x = cvt_pk_bf16(v0[0], v0[1]); w.y = cvt_pk_bf16(v0[2], v0[3]); w.z = cvt_pk_bf16(v1[0], v1[1]); w.w = cvt_pk_bf16(v1[2], v1[3]);
                    *(u32x4*)(rowp + bj * HALF) = w; } }
    }
};

template <class Epi, class Sched, bool ALIGN_EPI = false, bool SP2 = false>
__device__ __forceinline__ void gemm_phase(PG8_LAS unsigned char* lds, const Gemm g, const Sched& S, const Epi& E, int wid_in) {
    const int wid = __builtin_amdgcn_readfirstlane(wid_in), lane = (int)__builtin_amdgcn_mbcnt_hi(~0u, __builtin_amdgcn_mbcnt_lo(~0u, 0u)), tid = wid * 64 + lane, wr = wid >> 2, wc = wid & 3, fr = lane & 15, fq = lane >> 4;
    const int K = g.K, nt = K / BK;
    unsigned voffA[2], voffB[2];
#pragma unroll
    for (int i = 0; i < 2; ++i) { int R, C; stage_rc(tid * 16 + i * 8192, R, C); const int Rb = Epi::PERM ? ((R & ~31) + perm32(R & 31)) : R;
        voffA[i] = (unsigned)(R * K + C) * 2u; voffB[i] = (unsigned)(Rb * K + C) * 2u; }
    const size_t kstep = (size_t)(BK * 2);
    const size_t hstep = (size_t)HALF * K * 2;
    const size_t tstep = 2 * hstep;
    const unsigned ldsw = (unsigned)wid * 1024u;
    const int aoff = lds_byte(wr * 64 + fr, fq * 8), boff = lds_byte(wc * 32 + fr, fq * 8);
#define PG8_SA(b, h) (((b) * 2 + (h)) * HTB)
#define PG8_SB(b, h) ((4 + (b) * 2 + (h)) * HTB)
#define PG8_STAGE(bufoff, gbase, voff) do { _Pragma("unroll") for (int _i = 0; _i < 2; ++_i) \
        __builtin_amdgcn_global_load_lds((const unsigned*)((const char*)(gbase) + (voff)[_i]), (PG8_LAS unsigned*)(lds + (bufoff) + ldsw + _i * 8192), 16, 0, 0); } while (0)
#define PG8_LDA(dst, b, h) do { _Pragma("unroll") for (int m = 0; m < 4; ++m) _Pragma("unroll") for (int k = 0; k < 2; ++k) dst[m][k] = *(const PG8_LAS bf16x8*)(lds + PG8_SA(b, h) + aoff + m * 2048 + k * 1024); } while (0)
#define PG8_LDB(dst, b, h) do { _Pragma("unroll") for (int n = 0; n < 2; ++n) _Pragma("unroll") for (int k = 0; k < 2; ++k) dst[n][k] = *(const PG8_LAS bf16x8*)(lds + PG8_SB(b, h) + boff + n * 2048 + k * 1024); } while (0)
#define PG8_MMA(ai, bj, At, Bt) do { __builtin_amdgcn_s_setprio(1); _Pragma("unroll") for (int m = 0; m < 4; ++m) _Pragma("unroll") for (int n = 0; n < 2; ++n) _Pragma("unroll") for (int k = 0; k < 2; ++k) \
        acc[ai][bj][m][n] = __builtin_amdgcn_mfma_f32_16x16x32_bf16(Bt[n][k], At[m][k], acc[ai][bj][m][n], 0, 0, 0); __builtin_amdgcn_s_setprio(0); } while (0)
#define PG8_WAIT_V(n) asm volatile("s_waitcnt vmcnt(" #n ")" ::: "memory")
#define PG8_WAIT_L(n) asm volatile("s_waitcnt lgkmcnt(" #n ")" ::: "memory")
#define PG8_BAR __builtin_amdgcn_s_barrier()
#define PG8_SCHED __builtin_amdgcn_sched_barrier(0)
    Unit cur, nxt; int ui = 0;
    if (!S.next(0, cur)) return;
    f32x4 acc[2][2][4][2];
#pragma unroll
    for (int a = 0; a < 2; ++a)
#pragma unroll
        for (int b = 0; b < 2; ++b)
#pragma unroll
            for (int m = 0; m < 4; ++m)
#pragma unroll
                for (int n = 0; n < 2; ++n) acc[a][b][m][n] = (f32x4){0.f, 0.f, 0.f, 0.f};
    bf16x8 At[4][2], B0[2][2], B1[2][2];
    const char* cA = (const char*)g.A + (size_t)cur.pm * tstep; const char* cB = (const char*)g.Bt + (size_t)cur.pn * tstep;
    S.a_ready(cur);
    if constexpr (SP2) {
        PG8_STAGE(PG8_SB(0, 0), cB, voffB); PG8_STAGE(PG8_SB(0, 1), cB + hstep, voffB); PG8_STAGE(PG8_SA(0, 0), cA, voffA); PG8_STAGE(PG8_SA(0, 1), cA + hstep, voffA);
        if (wr == 1) PG8_BAR;
        PG8_WAIT_V(2); PG8_BAR;
        PG8_STAGE(PG8_SB(1, 0), cB + kstep, voffB); PG8_STAGE(PG8_SA(1, 0), cA + kstep, voffA); PG8_STAGE(PG8_SB(1, 1), cB + hstep + kstep, voffB);
        PG8_WAIT_V(6); PG8_BAR;
    } else {
        PG8_STAGE(PG8_SB(0, 0), cB, voffB); PG8_STAGE(PG8_SA(0, 0), cA, voffA); PG8_STAGE(PG8_SB(0, 1), cB + hstep, voffB); PG8_STAGE(PG8_SA(0, 1), cA + hstep, voffA);
        if (wr == 1) PG8_BAR;
        PG8_WAIT_V(4); PG8_BAR;
        PG8_STAGE(PG8_SB(1, 0), cB + kstep, voffB); PG8_STAGE(PG8_SA(1, 0), cA + kstep, voffA); PG8_STAGE(PG8_SB(1, 1), cB + hstep + kstep, voffB);
        PG8_WAIT_V(6); PG8_BAR;
    }
    for (;;) {
        const bool has_next = S.next(ui + 1, nxt);
        const char* nA = has_next ? (const char*)g.A + (size_t)nxt.pm * tstep : cA; const char* nB = has_next ? (const char*)g.Bt + (size_t)nxt.pn * tstep : cB;
        for (int t = 0; t < nt; t += 2) {
            const bool last = (t == nt - 2);
            const char* a1 = cA + (size_t)(t + 1) * kstep;
            const char* a2 = last ? nA : cA + (size_t)(t + 2) * kstep; const char* b2 = last ? nB : cB + (size_t)(t + 2) * kstep;
            const char* a3 = a2 + kstep; const char* b3 = b2 + kstep;
            if (last && has_next) S.a_ready(nxt);
            if constexpr (SP2) {
            PG8_LDB(B0, 0, 0); PG8_LDB(B1, 0, 1); PG8_SCHED; PG8_LDA(At, 0, 0); PG8_STAGE(PG8_SA(1, 1), a1 + hstep, voffA);
            PG8_WAIT_V(8); PG8_WAIT_L(0); PG8_BAR; PG8_MMA(0, 0, At, B0); PG8_MMA(0, 1, At, B1); PG8_BAR; PG8_SCHED;
            PG8_LDA(At, 0, 1); PG8_STAGE(PG8_SB(0, 0), b2, voffB); PG8_STAGE(PG8_SB(0, 1), b2 + hstep, voffB); PG8_STAGE(PG8_SA(0, 0), a2, voffA);
            PG8_WAIT_V(8); PG8_WAIT_L(0); PG8_BAR; PG8_MMA(1, 0, At, B0); PG8_MMA(1, 1, At, B1); PG8_BAR; PG8_SCHED;
            PG8_LDB(B0, 1, 0); PG8_LDB(B1, 1, 1); PG8_SCHED; PG8_LDA(At, 1, 0); PG8_STAGE(PG8_SA(0, 1), a2 + hstep, voffA);
            PG8_WAIT_V(8); PG8_WAIT_L(0); PG8_BAR; PG8_MMA(0, 0, At, B0); PG8_MMA(0, 1, At, B1); PG8_BAR; PG8_SCHED;
            PG8_LDA(At, 1, 1); PG8_STAGE(PG8_SB(1, 0), b3, voffB); PG8_STAGE(PG8_SB(1, 1), b3 + hstep, voffB); PG8_STAGE(PG8_SA(1, 0), a3, voffA);
            PG8_WAIT_V(8); PG8_WAIT_L(0); PG8_BAR; PG8_MMA(1, 0, At, B0); PG8_MMA(1, 1, At, B1); PG8_BAR; PG8_SCHED;
            } else {
            PG8_LDB(B0, 0, 0); PG8_SCHED; PG8_LDA(At, 0, 0); PG8_STAGE(PG8_SA(1, 1), a1 + hstep, voffA);
            PG8_WAIT_L(8); PG8_BAR; PG8_WAIT_L(0); PG8_MMA(0, 0, At, B0); PG8_BAR; PG8_SCHED;
            PG8_LDB(B1, 0, 1); PG8_STAGE(PG8_SB(0, 0), b2, voffB);
            PG8_BAR; PG8_WAIT_L(0); PG8_MMA(0, 1, At, B1); PG8_BAR;
            PG8_LDA(At, 0, 1); PG8_STAGE(PG8_SA(0, 0), a2, voffA);
            PG8_BAR; PG8_WAIT_L(0); PG8_MMA(1, 0, At, B0); PG8_BAR; PG8_SCHED;
            PG8_STAGE(PG8_SB(0, 1), b2 + hstep, voffB);
            PG8_WAIT_V(6); PG8_BAR; PG8_MMA(1, 1, At, B1); PG8_BAR;
            PG8_LDB(B0, 1, 0); PG8_SCHED; PG8_LDA(At, 1, 0); PG8_STAGE(PG8_SA(0, 1), a2 + hstep, voffA);
            PG8_WAIT_L(8); PG8_BAR; PG8_WAIT_L(0); PG8_MMA(0, 0, At, B0); PG8_BAR; PG8_SCHED;
            PG8_LDB(B1, 1, 1); PG8_STAGE(PG8_SB(1, 0), b3, voffB);
            PG8_BAR; PG8_WAIT_L(0); PG8_MMA(0, 1, At, B1); PG8_BAR;
            PG8_LDA(At, 1, 1); PG8_STAGE(PG8_SA(1, 0), a3, voffA);
            PG8_BAR; PG8_WAIT_L(0); PG8_MMA(1, 0, At, B0); PG8_BAR; PG8_SCHED;
            PG8_STAGE(PG8_SB(1, 1), b3 + hstep, voffB);
            PG8_WAIT_V(6); PG8_BAR; PG8_MMA(1, 1, At, B1); PG8_BAR;
            }
        }
        if constexpr (ALIGN_EPI) { if (wr == 0) PG8_BAR; }
        if constexpr (!Epi::AFTER_DRAIN) { E(acc, cur, wr, wc, fr, fq); S.done(cur); }
        if (!has_next) break;
#pragma unroll
        for (int a = 0; a < 2; ++a)
#pragma unroll
            for (int b = 0; b < 2; ++b)
#pragma unroll
                for (int m = 0; m < 4; ++m)
#pragma unroll
                    for (int n = 0; n < 2; ++n) acc[a][b][m][n] = (f32x4){0.f, 0.f, 0.f, 0.f};
        cur = nxt; cA = nA; cB = nB; ++ui;
        if constexpr (ALIGN_EPI) { if (wr == 1) PG8_BAR; }
    }
    PG8_WAIT_V(0);
    if constexpr (!ALIGN_EPI) { if (wr == 0) PG8_BAR; }
    PG8_BAR;
    if constexpr (Epi::AFTER_DRAIN) { E.fused(acc, cur, wr, wc, fr, fq, lds, wid, lane); S.done(cur); }
#undef PG8_SA
#undef PG8_SB
#undef PG8_STAGE
#undef PG8_LDA
#undef PG8_LDB
#undef PG8_MMA
#undef PG8_WAIT_V
#undef PG8_WAIT_L
#undef PG8_BAR
#undef PG8_SCHED
}
}
#include <hip/hip_bf16.h>
#include <cmath>
namespace attn_body {
using bf16=__hip_bfloat16;
using bf16x8=__attribute__((ext_vector_type(8)))short;
using s16x4=__attribute__((ext_vector_type(4)))short;
using f32x16=__attribute__((ext_vector_type(16)))float;
using u32x4=__attribute__((ext_vector_type(4)))unsigned;
constexpr int BATCH=4,NHEAD=8,SEQ=8192,D=64,DM=NHEAD*D;
constexpr int NW=8,QBLK=32,QB=QBLK*NW,KVBLK=64,NQB=SEQ/QB;
constexpr int ATTN_PITCH=DM, ATTN_UNIT_ROWS=QB;
__device__ __forceinline__ int crow(int r,int hi){return (r&3)+8*(r>>2)+4*hi;}
#define SBAR() __builtin_amdgcn_sched_barrier(0)
__device__ __forceinline__ void cmask(f32x16&p0,f32x16&p1,int jb,int qrel,int hi){
  const float NEG=-INFINITY; int kb=64*jb+4*hi;
  #pragma unroll
  for(int r=0;r<16;++r){int kv=kb+(r&3)+8*(r>>2); if(kv>qrel)p0[r]=NEG; if(kv+32>qrel)p1[r]=NEG;}
}

constexpr int NSLOT=3, SLOTB=8192;
constexpr int LDS_K=0, LDS_V=NSLOT*SLOTB, LDS_WS=2*NSLOT*SLOTB, LDS_OST=LDS_WS+NW*64*4, LDS_FK=LDS_OST+NW*4096, LDS_BYTES=LDS_FK+SEQ*4;
constexpr float C2=0.125f*1.4426950408889634f;
__device__ __forceinline__ void glds16(const void*gsrc,unsigned lds_dst){unsigned keep;
  asm volatile("s_mov_b32 %0, m0\n\ts_mov_b32 m0, %2\n\ts_nop 0\n\tglobal_load_lds_dwordx4 %1, off\n\ts_mov_b32 m0, %0":"=&s"(keep):"v"(gsrc),"s"(lds_dst):"memory");}
__device__ __forceinline__ float max3f(float a,float b,float c){float r;asm("v_max3_f32 %0, %1, %2, %3":"=v"(r):"v"(a),"v"(b),"v"(c));return r;}
__device__ __forceinline__ float max2f(float a,float b){float r;asm("v_max_f32_e32 %0, %1, %2":"=v"(r):"v"(a),"v"(b));return r;}
__device__ __forceinline__ float fadd_s(float a,float b){float r;asm("v_add_f32_e32 %0, %1, %2":"=v"(r):"v"(a),"v"(b));return r;}
__device__ __forceinline__ float fsub_s(float a,float b){float r;asm("v_sub_f32_e32 %0, %1, %2":"=v"(r):"v"(a),"v"(b));return r;}
typedef float f32x2_t __attribute__((ext_vector_type(2))); typedef __bf16 bf16x2_t __attribute__((ext_vector_type(2)));
__device__ __forceinline__ unsigned cvtpk_s(float lo,float hi){f32x2_t v={lo,hi};bf16x2_t b=__builtin_convertvector(v,bf16x2_t);return __builtin_bit_cast(unsigned,b);}
#define WAIT_BAR(N) asm volatile("s_waitcnt vmcnt(" #N ") lgkmcnt(0)\n\ts_barrier":::"memory")

__device__ __forceinline__ void qkt(f32x16&p0,f32x16&p1,const char*Kslot,const bf16x8*qr,int r32,int hi){
  const char*kb=Kslot+hi*1024+r32*16;
  #pragma unroll
  for(int d0=0;d0<4;++d0){
    const bf16x8 b0=*reinterpret_cast<const bf16x8*>(kb+d0*2048);
    const bf16x8 b1=*reinterpret_cast<const bf16x8*>(kb+d0*2048+512);
    p0=__builtin_amdgcn_mfma_f32_32x32x16_bf16(b0,qr[d0],p0,0,0,0);p1=__builtin_amdgcn_mfma_f32_32x32x16_bf16(b1,qr[d0],p1,0,0,0);}
}
typedef __attribute__((address_space(3))) const char* lds_cptr;
typedef short v4i16_t __attribute__((ext_vector_type(4)));
__device__ __forceinline__ void kload8(bf16x8*kf,lds_cptr kp){
  kf[0]=*(const __attribute__((address_space(3))) bf16x8*)(kp);      kf[1]=*(const __attribute__((address_space(3))) bf16x8*)(kp+512);
  kf[2]=*(const __attribute__((address_space(3))) bf16x8*)(kp+2048); kf[3]=*(const __attribute__((address_space(3))) bf16x8*)(kp+2560);
  kf[4]=*(const __attribute__((address_space(3))) bf16x8*)(kp+4096); kf[5]=*(const __attribute__((address_space(3))) bf16x8*)(kp+4608);
  kf[6]=*(const __attribute__((address_space(3))) bf16x8*)(kp+6144); kf[7]=*(const __attribute__((address_space(3))) bf16x8*)(kp+6656);
}
__device__ __forceinline__ void kload2(bf16x8*kf,lds_cptr kp,int j){ kf[2*j]=*(const __attribute__((address_space(3))) bf16x8*)(kp+j*2048); kf[2*j+1]=*(const __attribute__((address_space(3))) bf16x8*)(kp+j*2048+512); }
__device__ __forceinline__ s16x4 vtr(lds_cptr p){ return __builtin_bit_cast(s16x4,__builtin_amdgcn_ds_read_tr16_b64_v4i16((__attribute__((address_space(3))) v4i16_t*)p)); }
__device__ __forceinline__ float rowmax(const f32x16&p0,const f32x16&p1){
  float a=max3f(p0[0],p0[1],p1[0]),b=max3f(p0[2],p0[3],p1[1]);a=max3f(a,p1[2],p1[3]);
  #pragma unroll
  for(int r=4;r<16;r+=4){a=max3f(a,p0[r],p0[r+1]);b=max3f(b,p0[r+2],p0[r+3]);a=max3f(a,p1[r],p1[r+1]);b=max3f(b,p1[r+2],p1[r+3]);}
  const float m=max2f(a,b);
  auto rr=__builtin_amdgcn_permlane32_swap(__float_as_uint(m),__float_as_uint(m),false,false);
  return max2f(__uint_as_float(rr[0]),__uint_as_float(rr[1]));
}
__device__ __forceinline__ void pv(f32x16*o,int vb,bf16x8 pa0,bf16x8 pa1,bf16x8 pa2,bf16x8 pa3){
  #pragma unroll
  for(int d0=0;d0<2;++d0){s16x4 lo[4],hi[4];
    #pragma unroll
    for(int ks=0;ks<4;++ks){
      asm volatile("ds_read_b64_tr_b16 %0,%1 offset:%c2":"=&v"(lo[ks]):"v"(vb),"i"(d0*4096+ks*1024):"memory");
      asm volatile("ds_read_b64_tr_b16 %0,%1 offset:%c2":"=&v"(hi[ks]):"v"(vb),"i"(d0*4096+ks*1024+512):"memory");}
    asm volatile("s_waitcnt lgkmcnt(0)":::"memory");SBAR();
    #define PK(k) (bf16x8){lo[k][0],lo[k][1],lo[k][2],lo[k][3],hi[k][0],hi[k][1],hi[k][2],hi[k][3]}
    o[d0]=__builtin_amdgcn_mfma_f32_32x32x16_bf16(pa0,PK(0),o[d0],0,0,0);
    o[d0]=__builtin_amdgcn_mfma_f32_32x32x16_bf16(pa1,PK(1),o[d0],0,0,0);
    o[d0]=__builtin_amdgcn_mfma_f32_32x32x16_bf16(pa2,PK(2),o[d0],0,0,0);
    o[d0]=__builtin_amdgcn_mfma_f32_32x32x16_bf16(pa3,PK(3),o[d0],0,0,0);
    #undef PK
  }
}

#ifndef ATTN_STORE16
#define ATTN_STORE16(p,v) (*(u32x4*)(p)=(v))
#endif
template<int THRL> __device__ __forceinline__ void attn_unit(int b,int h,int qb,const bf16*Q,const bf16*__restrict__ K,const bf16*__restrict__ V,bf16*O,const float*__restrict__ Fc,const float*__restrict__ NRM,char*shm,int wid_in){
  const int wid=__builtin_amdgcn_readfirstlane(wid_in); int lane_=(int)__builtin_amdgcn_mbcnt_hi(~0u,__builtin_amdgcn_mbcnt_lo(~0u,0u)); asm volatile("":"+v"(lane_));
  const int lane=lane_,tid=wid*64+lane,r32=lane&31,hi=lane>>5;
  const long rowbase=(long)b*SEQ; const int q0=qb*QB;
  const float*Fbh=Fc+(long)(b*NHEAD+h)*SEQ;
  const int NTF=(q0+QB)/KVBLK; int t_start;
  { const float*QNb=NRM+(b*NHEAD+h)*128,*KNb=NRM+4096+(b*NHEAD+h)*128;
    const float qn=fmaxf(fmaxf(QNb[4*qb],QNb[4*qb+1]),fmaxf(QNb[4*qb+2],QNb[4*qb+3])),knb=fmaxf(fmaxf(KNb[4*qb],KNb[4*qb+1]),fmaxf(KNb[4*qb+2],KNb[4*qb+3]));
    const float fq0=Fbh[q0]*1.4426950408889634f; bool k0=true,k1=true;
    if(lane<NTF-4)k0=!(qn*(KNb[lane]+knb)+(fq0-Fbh[64*lane+63]*1.4426950408889634f)<-40.f);
    if(lane+64<NTF-4)k1=!(qn*(KNb[lane+64]+knb)+(fq0-Fbh[64*(lane+64)+63]*1.4426950408889634f)<-40.f);
    const unsigned long long m0=__ballot(k0),m1=__ballot(k1);
    int tf=m0?(int)__builtin_ctzll(m0):64+(m1?(int)__builtin_ctzll(m1):64);
    tf=tf<NTF-4?tf:NTF-4; t_start=__builtin_amdgcn_readfirstlane(tf&~1); }
  { typedef float f32x4_t __attribute__((ext_vector_type(4))); __attribute__((address_space(3))) float*fk=(__attribute__((address_space(3))) float*)((__attribute__((address_space(3))) char*)shm+LDS_FK); const int n4=(q0+QB)/4;
    for(int i=16*t_start+tid;i<n4;i+=NW*64){ f32x4_t v=*(const f32x4_t*)(Fbh+4*i); v=v*(-1.4426950408889634f); *(__attribute__((address_space(3))) f32x4_t*)(fk+4*i)=v; } }
  float fq2=Fbh[q0+wid*QBLK+r32]*1.4426950408889634f; asm volatile("":"+v"(fq2));
  const bf16*Qw=Q+(rowbase+q0+wid*QBLK)*DM+h*D;
  const bf16*Kh=K+(rowbase+(long)t_start*KVBLK)*DM+h*D,*Vh=V+(rowbase+(long)t_start*KVBLK)*DM+h*D;
  const lds_cptr shm3=(lds_cptr)shm;
  const unsigned lds0=(unsigned)(uintptr_t)shm;
  float*wsf=(float*)(shm+LDS_WS)+wid*64;
  const bf16*ksrc=Kh+(long)lane*DM+wid*8;
  const bf16*vsrc=Vh+(long)(16*(wid&3)+(lane>>2))*DM+(wid>>2)*32+(lane&3)*8;
  const unsigned kdst=lds0+LDS_K+wid*1024, vdst=lds0+LDS_V+wid*1024;
  #define DMA_K(t,slot) glds16(ksrc+(long)(t)*KVBLK*DM,(unsigned)__builtin_amdgcn_readfirstlane(kdst+(slot)))
  #define DMA_V(t,slot) glds16(vsrc+(long)(t)*KVBLK*DM,(unsigned)__builtin_amdgcn_readfirstlane(vdst+(slot)))
  const int vb0=(int)(lds0+LDS_V)+((lane>>4)&1)*32+(lane&3)*8+(4*hi+((lane&15)>>2))*64;
  const char*Kbase=shm+LDS_K; bf16x8 kf[8];
  const lds_cptr kp0=shm3+LDS_K+hi*1024+r32*16; const lds_cptr vp0=shm3+LDS_V+((lane>>4)&1)*32+(lane&3)*8+(4*hi+((lane&15)>>2))*64;
  const int NT=NTF-t_start;
  DMA_K(0,0);DMA_V(0,0);DMA_K(1,SLOTB);
  bf16x8 qr[4];
  #pragma unroll
  for(int d0=0;d0<4;++d0)qr[d0]=*reinterpret_cast<const bf16x8*>(&Qw[(long)r32*DM+d0*16+hi*8]);
  float mhat=0.f,l_reg=0.f;f32x16 o[2];o[0]=f32x16{};o[1]=f32x16{};
  const __attribute__((address_space(3))) float*fkl=(const __attribute__((address_space(3))) float*)(shm3+LDS_FK)+64*t_start+4*hi;
  #define INITC(C0,C1,t) do{ const float nsc_=fq2-mhat; typedef float f32x4_t __attribute__((ext_vector_type(4))); const __attribute__((address_space(3))) float*kb_=fkl+64*(t); \
    _Pragma("unroll") for(int g_=0;g_<4;++g_){ const f32x4_t a_=*(const __attribute__((address_space(3))) f32x4_t*)(kb_+8*g_), b_=*(const __attribute__((address_space(3))) f32x4_t*)(kb_+32+8*g_); \
      _Pragma("unroll") for(int e_=0;e_<4;++e_){ C0[4*g_+e_]=nsc_+a_[e_]; C1[4*g_+e_]=nsc_+b_[e_]; } } }while(0)
  const int qrel=wid*QBLK+r32;
  #define CMASK(P0,P1,t) do{int jb_=(t)-(NT-4); if(jb_>=0)cmask(P0,P1,jb_,qrel,hi);}while(0)
  bool resc=false;
  #define START(P0,P1) do{ const float rm=rowmax(P0,P1); resc=false; \
    { const float dl=rm; mhat=fadd_s(mhat,dl); \
      _Pragma("unroll") for(int r=0;r<16;++r){P0[r]=fsub_s(P0[r],dl);P1[r]=fsub_s(P1[r],dl);} \
      } \
    _Pragma("unroll") for(int r=0;r<16;++r)P0[r]=__builtin_amdgcn_exp2f(P0[r]); }while(0)
  #define RESC() do{ if(resc){ asm volatile("s_waitcnt lgkmcnt(0)":::"memory"); \
      _Pragma("unroll") for(int d_=0;d_<2;++d_) _Pragma("unroll") for(int r=0;r<16;++r)o[d_][r]*=wsf[crow(r,hi)]; } }while(0)
  f32x16 pA0,pA1,pB0,pB1;
  int sl_prev=0,sl_cur=0,sl_next=SLOTB;
  #define ROT() do{sl_prev=sl_cur;sl_cur=sl_next;sl_next=(sl_next==(NSLOT-1)*SLOTB)?0:sl_next+SLOTB;}while(0)
  DMA_K(2,2*SLOTB);
  WAIT_BAR(3);
  INITC(pA0,pA1,0); qkt(pA0,pA1,Kbase,qr,r32,hi);asm volatile("s_nop 15\n\ts_nop 7":"+v"(pA0),"+v"(pA1));CMASK(pA0,pA1,0);
  START(pA0,pA1);
  _Pragma("unroll") for(int r=0;r<16;++r)pA1[r]=__builtin_amdgcn_exp2f(pA1[r]);
  WAIT_BAR(0);
  DMA_K(3,0);DMA_V(1,SLOTB);
  ROT();
  kload8(kf,kp0+sl_cur);
  WAIT_BAR(2);
  s16x4 vlo[8],vhi[8]; u32x4 pw0,pw1,pw2,pw3;
  #define PKW(P,B) cvtpk_s(P[B],P[B+1])
  #define PAF(k) __builtin_bit_cast(bf16x8,pw##k)
  #define VFR(i) (bf16x8){vlo[i][0],vlo[i][1],vlo[i][2],vlo[i][3],vhi[i][0],vhi[i][1],vhi[i][2],vhi[i][3]}
  #define PIN(x) asm volatile("":"+v"(x))
  #define MX3(a,b,c) __builtin_fmaxf(__builtin_fmaxf((a),(b)),(c))
  #define GAPA(MF,A0,A1,A2,A3,W0,W1,PW) do{ MF; sacc+=A0; sacc+=A1; sacc+=A2; sacc+=A3; PIN(sacc); W0; W1; PIN(PW); SBAR(); }while(0)
  #define EX(v) __builtin_amdgcn_exp2f(v)
  #define GAPB(MF,X,B) do{ MF; X[B]=EX(X[B]); X[B+1]=EX(X[B+1]); X[B+2]=EX(X[B+2]); X[B+3]=EX(X[B+3]); PIN(X); SBAR(); }while(0)
  #define VRD(i) do{ vlo[i]=vtr(vp_+(((i)>>2)*4096+((i)&3)*1024)); vhi[i]=vtr(vp_+(((i)>>2)*4096+((i)&3)*1024+512)); }while(0)
  #define KRD(G,j) do{ if(G){ kload2(kf,kp0+sl_next,j); SBAR(); } }while(0)
  #define STEP(C0,C1,P0,P1,t,GK,GV,GL) do{ SBAR(); INITC(C0,C1,t); PIN(C0); PIN(C1); SBAR(); \
    const lds_cptr vp_=vp0+sl_prev; \
    VRD(0); SBAR(); float sacc=(P0[0]+P0[1]); \
    GAPA(C0=__builtin_amdgcn_mfma_f32_32x32x16_bf16(kf[0],qr[0],C0,0,0,0), P0[2],P0[3],P0[4],P0[5],     pw0[0]=PKW(P0,0), pw0[1]=PKW(P0,2), pw0); \
    VRD(4); SBAR(); GAPA(C1=__builtin_amdgcn_mfma_f32_32x32x16_bf16(kf[1],qr[0],C1,0,0,0), P0[6],P0[7],P0[8],P0[9],     pw0[2]=PKW(P0,4), pw0[3]=PKW(P0,6), pw0); \
    VRD(1); SBAR(); GAPA(C0=__builtin_amdgcn_mfma_f32_32x32x16_bf16(kf[2],qr[1],C0,0,0,0),   P0[10],P0[11],P0[12],P0[13], pw1[0]=PKW(P0,8), pw1[1]=PKW(P0,10), pw1); \
    VRD(5); SBAR(); GAPA(C1=__builtin_amdgcn_mfma_f32_32x32x16_bf16(kf[3],qr[1],C1,0,0,0),   P0[14],P0[15],P1[0],P1[1],   pw1[2]=PKW(P0,12),pw1[3]=PKW(P0,14), pw1); \
    VRD(2); SBAR(); GAPA(C0=__builtin_amdgcn_mfma_f32_32x32x16_bf16(kf[4],qr[2],C0,0,0,0),   P1[2],P1[3],P1[4],P1[5],     pw2[0]=PKW(P1,0), pw2[1]=PKW(P1,2), pw2); \
    VRD(6); SBAR(); GAPA(C1=__builtin_amdgcn_mfma_f32_32x32x16_bf16(kf[5],qr[2],C1,0,0,0),   P1[6],P1[7],P1[8],P1[9],     pw2[2]=PKW(P1,4), pw2[3]=PKW(P1,6), pw2); \
    VRD(3); SBAR(); GAPA(C0=__builtin_amdgcn_mfma_f32_32x32x16_bf16(kf[6],qr[3],C0,0,0,0),   P1[10],P1[11],P1[12],P1[13], pw3[0]=PKW(P1,8), pw3[1]=PKW(P1,10), pw3); \
    VRD(7); SBAR(); GAPA(C1=__builtin_amdgcn_mfma_f32_32x32x16_bf16(kf[7],qr[3],C1,0,0,0),   P1[14],P1[15],0.f,0.f,       pw3[2]=PKW(P1,12),pw3[3]=PKW(P1,14), pw3); \
    l_reg+=sacc; \
    if(GK){DMA_K((t)+3,sl_cur);} if(GV){DMA_V((t)+1,sl_next);} \
    CMASK(C0,C1,t); \
    { float a=MX3(C0[0],C0[1],C1[0]),b=MX3(C0[2],C0[3],C1[1]); a=MX3(a,C1[2],C1[3]); \
      _Pragma("unroll") for(int r=4;r<16;r+=4){a=MX3(a,C0[r],C0[r+1]);b=MX3(b,C0[r+2],C0[r+3]);a=MX3(a,C1[r],C1[r+1]);b=MX3(b,C1[r+2],C1[r+3]);} \
      float rm=__builtin_fmaxf(a,b); { auto rr=__builtin_amdgcn_permlane32_swap(__float_as_uint(rm),__float_as_uint(rm),false,false); rm=__builtin_fmaxf(__uint_as_float(rr[0]),__uint_as_float(rr[1])); } \
      resc=false; \
      if(__builtin_expect(__any(rm>(float)THRL),0)){ const float dl=__builtin_fmaxf(rm,0.f); mhat+=dl; \
        _Pragma("unroll") for(int r=0;r<16;++r){C0[r]-=dl;C1[r]-=dl;} \
        const float f=__builtin_amdgcn_exp2f(-dl); l_reg*=f; if(hi==0)wsf[r32]=f; resc=true; } } \
    SBAR(); \
    GAPB(o[0]=__builtin_amdgcn_mfma_f32_32x32x16_bf16(PAF(0),VFR(0),o[0],0,0,0), C0,0); \
    GAPB(o[1]=__builtin_amdgcn_mfma_f32_32x32x16_bf16(PAF(0),VFR(4),o[1],0,0,0), C0,4); \
    KRD(GL,0); GAPB(o[0]=__builtin_amdgcn_mfma_f32_32x32x16_bf16(PAF(1),VFR(1),o[0],0,0,0), C0,8); \
    KRD(GL,1); GAPB(o[1]=__builtin_amdgcn_mfma_f32_32x32x16_bf16(PAF(1),VFR(5),o[1],0,0,0), C0,12); \
    KRD(GL,2); GAPB(o[0]=__builtin_amdgcn_mfma_f32_32x32x16_bf16(PAF(2),VFR(2),o[0],0,0,0), C1,0); \
    KRD(GL,3); GAPB(o[1]=__builtin_amdgcn_mfma_f32_32x32x16_bf16(PAF(2),VFR(6),o[1],0,0,0), C1,4); \
    GAPB(o[0]=__builtin_amdgcn_mfma_f32_32x32x16_bf16(PAF(3),VFR(3),o[0],0,0,0), C1,8); \
    GAPB(o[1]=__builtin_amdgcn_mfma_f32_32x32x16_bf16(PAF(3),VFR(7),o[1],0,0,0), C1,12); \
    }while(0)
  int t=1;
  #undef CMASK
  #define CMASK(P0,P1,t) do{}while(0)
  for(;t+5<NT;t+=2){
    STEP(pB0,pB1,pA0,pA1,t,true,true,true);     WAIT_BAR(2); RESC(); ROT();
    STEP(pA0,pA1,pB0,pB1,t+1,true,true,true);   WAIT_BAR(2); RESC(); ROT();
  }
  #undef CMASK
  #define CMASK(P0,P1,t) do{int jb_=(t)-(NT-4); if(jb_>=0)cmask(P0,P1,jb_,qrel,hi);}while(0)
  #define ENDW(tt) do{ if((tt)+3<NT){WAIT_BAR(2);} else if((tt)+2<NT){WAIT_BAR(1);} else {WAIT_BAR(0);} }while(0)
  for(;t+1<NT;t+=2){
    STEP(pB0,pB1,pA0,pA1,t,(t+3<NT),(t+1<NT),(t+1<NT));       ENDW(t);   RESC(); ROT();
    STEP(pA0,pA1,pB0,pB1,t+1,(t+4<NT),(t+2<NT),(t+2<NT));     ENDW(t+1); RESC(); ROT();
  }
  STEP(pB0,pB1,pA0,pA1,NT-1,false,false,false); RESC();
  { float sacc=pB0[0]+pB0[1]; _Pragma("unroll") for(int r=2;r<16;++r)sacc+=pB0[r]; _Pragma("unroll") for(int r=0;r<16;++r)sacc+=pB1[r]; l_reg+=sacc;
    pw0=(u32x4){PKW(pB0,0),PKW(pB0,2),PKW(pB0,4),PKW(pB0,6)};pw1=(u32x4){PKW(pB0,8),PKW(pB0,10),PKW(pB0,12),PKW(pB0,14)};pw2=(u32x4){PKW(pB1,0),PKW(pB1,2),PKW(pB1,4),PKW(pB1,6)};pw3=(u32x4){PKW(pB1,8),PKW(pB1,10),PKW(pB1,12),PKW(pB1,14)};
    SBAR(); pv(o,vb0+sl_cur,PAF(0),PAF(1),PAF(2),PAF(3)); }
  #undef PKW
  #undef PAF
  #undef VFR
  #undef PIN
  #undef MX3
  #undef GAPA
  #undef GAPB
  #undef EX
  #undef VRD
  #undef KRD
  #undef STEP
  #undef ENDW
  {auto rr=__builtin_amdgcn_permlane32_swap(__float_as_uint(l_reg),__float_as_uint(l_reg),false,false);l_reg=__uint_as_float(rr[0])+__uint_as_float(rr[1]);}
  if(hi==0)wsf[32+r32]=l_reg;asm volatile("s_waitcnt lgkmcnt(0)":::"memory");
  float rli[16];
  #pragma unroll
  for(int r=0;r<16;++r)rli[r]=__builtin_amdgcn_rcpf(wsf[32+crow(r,hi)]);
  bf16*Ow=O+(rowbase+q0+wid*QBLK)*DM+h*D;
  { bf16*stg=(bf16*)(shm+LDS_OST)+wid*2048;
    #pragma unroll
    for(int r=0;r<16;++r){const int orow=crow(r,hi);
      #pragma unroll
      for(int d0=0;d0<2;++d0)stg[orow*64+d0*32+r32]=__float2bfloat16(o[d0][r]*rli[r]);}
    asm volatile("s_waitcnt lgkmcnt(0)":::"memory");
    #pragma unroll
    for(int i=0;i<4;++i){const int row=i*8+(lane>>3),ch=lane&7; const u32x4 v=*(const u32x4*)(stg+row*64+ch*8); ATTN_STORE16(Ow+(long)row*DM+ch*8,v);} }
  asm volatile("s_waitcnt lgkmcnt(0)\n\ts_barrier":::"memory");
  #undef DMA_K
  #undef DMA_V
  #undef INITC
  #undef CMASK
  #undef START
  #undef RESC
  #undef ROT
}
constexpr int ATTN_LDS_BYTES=LDS_BYTES;
struct AttnTensors { const bf16* Q; const bf16* K; const bf16* V; bf16* O; const float* F; const float* NRM; };
struct AttnUnit { int bh; int qb; };
struct StaticOrder {
  int vcu;
  __device__ __forceinline__ explicit StaticOrder(int grid,int block):vcu((block%8)*(grid/8)+block/8){}
  __device__ __forceinline__ bool next(int i,AttnUnit&u)const{ if(i>=4)return false; const int s=vcu&7; u.bh=vcu>>3; u.qb=(i==0)?s:(i==1)?15-s:(i==2)?16+s:31-s; return true; }
  __device__ __forceinline__ void a_ready(const AttnUnit&)const{}
  __device__ __forceinline__ void done(const AttnUnit&)const{}
};
template<int THRL=8> __device__ __forceinline__ void attn_phase(char*lds,const AttnTensors&T,unsigned*qctr,volatile __attribute__((address_space(3))) unsigned*qword,int wid_in){
  const int lane0=(int)__builtin_amdgcn_mbcnt_hi(~0u,__builtin_amdgcn_mbcnt_lo(~0u,0u));
  for(;;){
    if(wid_in==0&&lane0==0){ const unsigned n=__hip_atomic_fetch_add(qctr,1u,__ATOMIC_RELAXED,__HIP_MEMORY_SCOPE_AGENT); *qword=n; }
    asm volatile("s_waitcnt vmcnt(0) lgkmcnt(0)\n\ts_barrier":::"memory");
    const int n=__builtin_amdgcn_readfirstlane((int)*qword);
    if(n>=BATCH*NHEAD*NQB)break;
    const int bh=n%(BATCH*NHEAD),qb=NQB-1-n/(BATCH*NHEAD);
    attn_unit<THRL>(bh/NHEAD,bh%NHEAD,qb,T.Q,T.K,T.V,T.O,T.F,T.NRM,lds,wid_in);
  }
}
#undef SBAR
#undef WAIT_BAR
}
#define GAS __attribute__((address_space(1)))
#define LAS __attribute__((address_space(3)))
typedef unsigned short bf16;
typedef unsigned v4u __attribute__((ext_vector_type(4)));
typedef float f32x4 __attribute__((ext_vector_type(4)));
typedef short bf16x8 __attribute__((ext_vector_type(8)));
typedef GAS unsigned gu32;
typedef GAS unsigned long long gu64;
#define RLX_AGENT __ATOMIC_RELAXED, __HIP_MEMORY_SCOPE_AGENT
#define LDS_WAIT() asm volatile("s_waitcnt lgkmcnt(0)" ::: "memory")
#define VM_WAIT() asm volatile("s_waitcnt vmcnt(0)" ::: "memory")
__device__ __forceinline__ unsigned long long rt() { return __builtin_amdgcn_s_memrealtime(); }
__device__ __forceinline__ unsigned f2bf(float f) { unsigned u = __builtin_bit_cast(unsigned, f); return (u + 0x7fffu + ((u >> 16) & 1u)) >> 16; }
__device__ __forceinline__ unsigned pk2(float lo, float hi) { return f2bf(lo) | (f2bf(hi) << 16); }

#define XB_TMO      128
#define XB_XCNT(j)  (256  + 64 * (j))
#define XB_XSUB(j)  (1280 + 64 * (j))
#define XB_XGEN(j)  (2304 + 64 * (j))
#define XB_TOP      3328
#define XB_TOPGEN   3392
#define XCD_BAR_WORDS 3456
#define XB_SPIN_CAP (1u << 18)

__device__ __forceinline__ unsigned xb_ld(unsigned* p)              { return __hip_atomic_load(p, __ATOMIC_RELAXED, __HIP_MEMORY_SCOPE_AGENT); }
__device__ __forceinline__ unsigned xb_add(unsigned* p, unsigned v) { return __hip_atomic_fetch_add(p, v, __ATOMIC_RELAXED, __HIP_MEMORY_SCOPE_AGENT); }
__device__ __forceinline__ unsigned xb_xcc_id() { return (unsigned)__builtin_amdgcn_s_getreg((3 << 11) | 20) & 0xFu; }
#define XB_SPIN(cond, bar) do { unsigned _sp = 0; while (cond) { __builtin_amdgcn_s_sleep(1); \
    if ((++_sp & 255u) == 0u) { if (xb_ld(&(bar)[XB_TMO])) break; if (_sp > XB_SPIN_CAP) { atomicAdd(&(bar)[XB_TMO], 1u); break; } } } } while (0)

struct XcdBarrier {
    unsigned* bar; unsigned x; int wv;
    volatile LAS unsigned* st;
};

__device__ __forceinline__ bool xb_t0(int wv) { return wv == 0 && __builtin_amdgcn_mbcnt_hi(~0u, __builtin_amdgcn_mbcnt_lo(~0u, 0u)) == 0u; }
__device__ __forceinline__ XcdBarrier xcd_barrier_post(unsigned* bar, volatile LAS unsigned* st, int wv) {
    XcdBarrier b; b.bar = bar; b.x = xb_xcc_id(); b.st = st; b.wv = wv;
    if (xb_t0(wv)) (void)xb_add(&bar[XB_XCNT(b.x)], 1u);
    return b;
}
__device__ __forceinline__ void xcd_barrier_complete(unsigned* bar, unsigned x, unsigned& nloc, unsigned& nx) {
    const unsigned G = gridDim.x * gridDim.y * gridDim.z;
    unsigned sum, cnt, mine, sp = 0u;
    for (;;) {
        sum = 0u; cnt = 0u; mine = 0u;
#pragma unroll
        for (unsigned j = 0; j < 16; ++j) { const unsigned c = xb_ld(&bar[XB_XCNT(j)]); sum += c; cnt += (c > 0u) ? 1u : 0u; mine = (j == x) ? c : mine; }
        if (sum == G) break;
        __builtin_amdgcn_s_sleep(1);
        if ((++sp & 255u) == 0u) { if (xb_ld(&bar[XB_TMO])) break; if (sp > XB_SPIN_CAP) { atomicAdd(&bar[XB_TMO], 1u); break; } }
    }
    nloc = mine > 0u ? mine : 1u; nx = cnt > 0u ? cnt : 1u;
}

__device__ __forceinline__ void xcd_barrier(const XcdBarrier& b) {
    asm volatile("s_waitcnt vmcnt(0)" ::: "memory");
    __syncthreads();
    if (xb_t0(b.wv)) {
        unsigned* bar = b.bar;
        __builtin_amdgcn_s_waitcnt(0);
        unsigned nloc = b.st[0], nx = b.st[1];
        if (nloc == 0u) { xcd_barrier_complete(bar, b.x, nloc, nx); b.st[0] = nloc; b.st[1] = nx; }
        const unsigned old = xb_add(&bar[XB_XSUB(b.x)], 1u);
        const unsigned gen = old / nloc;
        if (old + 1u == (gen + 1u) * nloc) {
            __builtin_amdgcn_fence(__ATOMIC_RELEASE, "agent");
            asm volatile("s_waitcnt vmcnt(0)" ::: "memory");
            const unsigned og = xb_add(&bar[XB_TOP], 1u);
            const unsigned tg = og / nx;
            if (og + 1u == (tg + 1u) * nx) xb_add(&bar[XB_TOPGEN], 1u);
            else XB_SPIN(xb_ld(&bar[XB_TOPGEN]) == tg, bar);
            __builtin_amdgcn_fence(__ATOMIC_ACQUIRE, "agent");
            xb_add(&bar[XB_XGEN(b.x)], 1u);
            asm volatile("s_waitcnt vmcnt(0)" ::: "memory");
        } else {
            XB_SPIN(xb_ld(&bar[XB_XGEN(b.x)]) == gen, bar);
            __builtin_amdgcn_fence(__ATOMIC_ACQUIRE, "agent");
            asm volatile("s_waitcnt vmcnt(0)" ::: "memory");
        }
    }
    __syncthreads();
}

constexpr int NWAVES = 8;
constexpr int RING_OFF = 0, RING_BYTES = 131072;
constexpr int LDSCTL_OFF = RING_BYTES, MISC_OFF = LDSCTL_OFF + 320;
constexpr int LDS_BYTES = 147456;
constexpr int N_PHASES = 8;

struct Frame {
    LAS unsigned char* lds;
    volatile LAS unsigned* MISC;
    gu32* ctl;
    int tid, lane, wave, vcu, G;
};
__device__ __forceinline__ float wave_sum(float v) {
#pragma unroll
    for (int o = 1; o < 64; o <<= 1) v += __shfl_xor(v, o);
    return v;
}
struct Args { const float* in[20]; float* out; unsigned char* ws; int ph_lo, ph_hi, li, pad; };

__device__ __forceinline__ void p0_transpose_item(const float* W, int ld, int nblk, const float* glo, const float* ghi, int K, bf16* WT, LAS float* scr, int item, int lane) {
    const int kb = item / nblk, nb = item % nblk, k0 = 64 * kb, n0 = 32 * nb;
#pragma unroll 8
    for (int i = 0; i < 32; ++i) { const int kk = 2 * i + (lane >> 5), k = k0 + kk; float w = W[(size_t)k * ld + n0 + (lane & 31)];
        if (glo) w *= (k < K / 2) ? glo[k] : ghi[k - K / 2];
        scr[kk * 33 + (lane & 31)] = w; }
    LDS_WAIT(); asm volatile("" ::: "memory");
    const int c = lane & 7;
#pragma unroll
    for (int j = 0; j < 4; ++j) { const int n = (lane >> 3) + 8 * j; const LAS float* s = scr + (8 * c) * 33 + n;
        v4u o; o.x = pk2(s[0 * 33], s[1 * 33]); o.y = pk2(s[2 * 33], s[3 * 33]); o.z = pk2(s[4 * 33], s[5 * 33]); o.w = pk2(s[6 * 33], s[7 * 33]);
        *(GAS v4u*)(WT + (size_t)(n0 + n) * K + k0 + 8 * c) = o; }
    LDS_WAIT(); asm volatile("" ::: "memory");
}
__device__ __forceinline__ float log_sigmoid(float z) { return fminf(z, 0.f) - log1pf(expf(-fabsf(z))); }

__device__ __forceinline__ void p0_prologue(Frame& F, const Args& a) {
    LAS float* scr = (LAS float*)(F.lds + RING_OFF + F.wave * 16384);
    unsigned char* ws = a.ws;
    const float* x = a.in[0]; const float* g1 = a.in[1]; const float* w_in = a.in[2]; const float* bfv = a.in[10];
    const float* gn_l = a.in[11]; const float* gn_f = a.in[12]; const float* w_out = a.in[13]; const float* g2 = a.in[14];
    const float* w_q = a.in[15]; const float* sk = a.in[16]; const float* pu = a.in[17]; const float* pv = a.in[18];
    bf16* win_t = (bf16*)(ws + WS_WIN); bf16* wout_t = (bf16*)(ws + WS_WOUT); bf16* wq_t = (bf16*)(ws + WS_WQ); bf16* skb = (bf16*)(ws + WS_SKB); float* wfl = (float*)(ws + WS_WFL);
    float* logf = (float*)(ws + WS_LOGF); float* sumsq = (float*)(ws + WS_SUMSQ); bf16* h = (bf16*)(ws + WS_H);
    const int gw = F.vcu * NWAVES + F.wave, NGW = F.G * NWAVES, lane = F.lane;
    constexpr int I_IN = (DMODEL / 64) * (NG1 / 32), I_OUT = (DMODEL / 64) * (DMODEL / 32), I_Q = (DMODEL / 64) * (QPW / 32);
    constexpr int I_FL = 8 * DMODEL / 64, I_SK = PH * 2 * NKEY * PHALF / 512, I_SS = T / 64, I_WAX = 8 * 2 * 2 * 4;
    constexpr int E0 = I_IN, E1 = E0 + I_OUT, E2 = E1 + I_Q, E3 = E2 + I_FL, E4 = E3 + I_SK, E5 = E4 + I_SS, E6 = E5 + I_WAX;
    for (int it = gw; it < E6; it += NGW) {
        if (it < E0) { p0_transpose_item(w_in, INC, NG1 / 32, nullptr, nullptr, DMODEL, win_t, scr, it, lane); continue; }
        if (it < E1) { p0_transpose_item(w_out, DMODEL, DMODEL / 32, gn_l, gn_f, DMODEL, wout_t, scr, it - E0, lane); continue; }
        if (it < E2) { p0_transpose_item(w_q, QPW, QPW / 32, g2, g2 + DMODEL / 2, DMODEL, wq_t, scr, it - E1, lane); continue; }
        if (it < E3) { const int i = (it - E2) * 64 + lane, j = i / DMODEL, k = i % DMODEL; wfl[i] = w_in[(size_t)k * INC + NG1 + j]; continue; }
        if (it < E4) { const size_t i = (size_t)(it - E3) * 512 + lane * 8; const f32x4 s0 = *(const GAS f32x4*)(sk + i), s1 = *(const GAS f32x4*)(sk + i + 4);
            v4u o; o.x = pk2(s0[0], s0[1]); o.y = pk2(s0[2], s0[3]); o.z = pk2(s1[0], s1[1]); o.w = pk2(s1[2], s1[3]); *(GAS v4u*)(skb + i) = o; continue; }
        if (it < E5) { sumsq[(it - E4) * 64 + lane] = 0.f; continue; }
        { const int f = it - E5, ks = f & 3, n = (f >> 2) & 1, mat = (f >> 3) & 1, hh = f >> 4; const float* wsrc = mat ? a.in[7] : a.in[5];
          const size_t o = ((size_t)(hh * 64 + 16 * ks + 8 * (lane >> 5))) * 64 + 32 * n + (lane & 31);
          v4u pw; pw.x = pk2(wsrc[o], wsrc[o + 64]); pw.y = pk2(wsrc[o + 128], wsrc[o + 192]); pw.z = pk2(wsrc[o + 256], wsrc[o + 320]); pw.w = pk2(wsrc[o + 384], wsrc[o + 448]);
          *(GAS v4u*)((bf16*)(ws + WS_WAX) + (size_t)f * 512 + lane * 8) = pw; }
    }
    { f32x4 gg[4];
#pragma unroll
      for (int j = 0; j < 4; ++j) gg[j] = *(const GAS f32x4*)(g2 + 16 * lane + 4 * j);
      unsigned char* u8 = ws + WS_U8; unsigned char* v8 = ws + WS_V8; float* su = (float*)(ws + WS_SU);
      for (int e = gw; e < NEXP; e += NGW) {
        const GAS f32x4* ur = (const GAS f32x4*)(pu + (size_t)e * DMODEL + 16 * lane); const GAS f32x4* vr = (const GAS f32x4*)(pv + (size_t)e * DMODEL + 16 * lane);
        f32x4 uu[4], vv[4]; float mu = 0.f, mv = 0.f;
#pragma unroll
        for (int j = 0; j < 4; ++j) { uu[j] = ur[j] * gg[j]; vv[j] = vr[j];
#pragma unroll
            for (int c = 0; c < 4; ++c) { mu = fmaxf(mu, fabsf(uu[j][c])); mv = fmaxf(mv, fabsf(vv[j][c])); } }
#pragma unroll
        for (int o = 1; o < 64; o <<= 1) { mu = fmaxf(mu, __shfl_xor(mu, o)); mv = fmaxf(mv, __shfl_xor(mv, o)); }
        const float scu = mu > 0.f ? mu * (1.f / 440.f) : 1.f, scv = mv > 0.f ? mv * (1.f / 440.f) : 1.f, iu = 1.f / scu, iv = 1.f / scv;
        v4u qu, qv;
#pragma unroll
        for (int j = 0; j < 4; ++j) { int wu = 0, wv = 0;
            wu = __builtin_amdgcn_cvt_pk_fp8_f32(uu[j][0] * iu, uu[j][1] * iu, wu, false); wu = __builtin_amdgcn_cvt_pk_fp8_f32(uu[j][2] * iu, uu[j][3] * iu, wu, true);
            wv = __builtin_amdgcn_cvt_pk_fp8_f32(vv[j][0] * iv, vv[j][1] * iv, wv, false); wv = __builtin_amdgcn_cvt_pk_fp8_f32(vv[j][2] * iv, vv[j][3] * iv, wv, true);
            qu[j] = (unsigned)wu; qv[j] = (unsigned)wv; }
        *(GAS v4u*)(u8 + (size_t)e * DMODEL + 16 * lane) = qu; *(GAS v4u*)(v8 + (size_t)e * DMODEL + 16 * lane) = qv;
        if (lane == 0) { su[2 * e] = scu; su[2 * e + 1] = scv; }
      } }
    { f32x4 gg[4];
#pragma unroll
      for (int j = 0; j < 4; ++j) gg[j] = *(const GAS f32x4*)(g1 + 256 * j + 4 * lane);
      float fw[4][4][8];
#pragma unroll
      for (int j = 0; j < 4; ++j)
#pragma unroll
          for (int c = 0; c < 4; ++c) { const int k = 256 * j + 4 * lane + c; const GAS f32x4* wr = (const GAS f32x4*)(w_in + (size_t)k * INC + NG1); const f32x4 w0 = wr[0], w1 = wr[1];
#pragma unroll
              for (int e = 0; e < 4; ++e) { fw[j][c][e] = w0[e]; fw[j][c][4 + e] = w1[e]; } }
      for (int t = gw; t < T; t += NGW) {
        const GAS f32x4* xr = (const GAS f32x4*)(x + (size_t)t * DMODEL) + lane;
        f32x4 v[4]; float ss = 0.f;
#pragma unroll
        for (int j = 0; j < 4; ++j) { v[j] = xr[64 * j]; ss += (v[j][0] * v[j][0] + v[j][1] * v[j][1]) + (v[j][2] * v[j][2] + v[j][3] * v[j][3]); }
        const float rstd = rsqrtf(wave_sum(ss) * (1.f / DMODEL) + RMS_EPS);
        GAS unsigned long long* ho = (GAS unsigned long long*)(h + (size_t)t * DMODEL) + lane;
#pragma unroll
        for (int j = 0; j < 4; ++j) { v[j] = v[j] * rstd * gg[j]; ho[64 * j] = (unsigned long long)pk2(v[j][0], v[j][1]) | ((unsigned long long)pk2(v[j][2], v[j][3]) << 32); }
        float fl[8];
#pragma unroll
        for (int hh = 0; hh < 8; ++hh) fl[hh] = 0.f;
#pragma unroll
        for (int j = 0; j < 4; ++j)
#pragma unroll
            for (int c = 0; c < 4; ++c) {
#pragma unroll
                for (int hh = 0; hh < 8; ++hh) fl[hh] += v[j][c] * fw[j][c][hh]; }
        float res = 0.f;
#pragma unroll
        for (int hh = 0; hh < 8; ++hh) { const float s = wave_sum(fl[hh]); if (lane == hh) res = s; }
        if (lane < 8) logf[(size_t)t * 8 + lane] = log_sigmoid(res + bfv[lane]);
      } }
}

__device__ __forceinline__ void fcum_unit(Frame& F, int bh, const float* logf, float* fcum) {
    const int b = bh / NHEADS, hh = bh % NHEADS, s0 = F.tid * 16;
    float v[16]; float loc = 0.f;
#pragma unroll
    for (int i = 0; i < 16; ++i) { v[i] = logf[((size_t)b * SEQ + s0 + i) * 8 + hh]; loc += v[i]; }
    float inc = loc;
#pragma unroll
    for (int o = 1; o < 64; o <<= 1) { const float n = __shfl_up(inc, o); if (F.lane >= o) inc += n; }
    if (F.lane == 63) F.MISC[16 + F.wave] = __float_as_uint(inc);
    __syncthreads();
    float run = inc - loc;
    for (int w = 0; w < F.wave; ++w) run += __uint_as_float(F.MISC[16 + w]);
#pragma unroll
    for (int i = 0; i < 16; ++i) { run += v[i]; fcum[(size_t)bh * SEQ + s0 + i] = run; }
    __syncthreads();
}


namespace peer {
typedef unsigned u32;
typedef float f32x16 __attribute__((ext_vector_type(16)));
constexpr int TOK = 128;
constexpr int EX_STRIDE = 136, GT_STRIDE = 132;
constexpr int L_EX = 0, L_GT = L_EX + TOK * EX_STRIDE * 2, L_IDX = L_GT + TOK * GT_STRIDE * 4, IDX_STRIDE = 36, L_RST = L_IDX + 512 * IDX_STRIDE, L_END = L_RST + TOK * 4;
static_assert(L_END <= RING_BYTES && L_GT % 16 == 0 && L_IDX % 16 == 0, "PEER LDS map");
__device__ __forceinline__ u32 ordmap(float f) { const u32 u = __float_as_uint(f); return u ^ ((u32)((int)u >> 31) | 0x80000000u); }
__device__ __forceinline__ float unordmap(u32 k) { const u32 u = (k & 0x80000000u) ? (k ^ 0x80000000u) : ~k; return __uint_as_float(u); }
__device__ __forceinline__ u32 umin_(u32 a, u32 b) { return a < b ? a : b; }
__device__ __forceinline__ u32 umax_(u32 a, u32 b) { return a > b ? a : b; }
template <bool DESC> __device__ __forceinline__ void sort16(u32 (&k)[16]) {
#pragma unroll
    for (int size = 2; size <= 16; size <<= 1)
#pragma unroll
        for (int stride = size >> 1; stride > 0; stride >>= 1)
#pragma unroll
            for (int i = 0; i < 16; ++i) { const int j = i ^ stride;
                if (j > i) { const bool asc = (((i & size) == 0) != DESC); const u32 a = k[i], b = k[j], lo = umin_(a, b), hi = umax_(a, b); k[i] = asc ? lo : hi; k[j] = asc ? hi : lo; } }
}
template <bool DESC> __device__ __forceinline__ void merge16(u32 (&k)[16]) {
#pragma unroll
    for (int stride = 8; stride > 0; stride >>= 1)
#pragma unroll
        for (int i = 0; i < 16; ++i) { const int j = i ^ stride;
            if (j > i) { const u32 a = k[i], b = k[j], lo = umin_(a, b), hi = umax_(a, b); k[i] = DESC ? hi : lo; k[j] = DESC ? lo : hi; } }
}
__host__ __device__ constexpr int ccnt(int a) { return 16 / (a + 1); }
__host__ __device__ constexpr int cbase(int a) { int s = 0; for (int i = 0; i < a; ++i) s += ccnt(i); return s; }
static_assert(cbase(16) == 50, "hyperbola candidate count");
__device__ __forceinline__ int crow16(int r) { return (r & 3) + 8 * (r >> 2); }

__device__ __forceinline__ void route_tile(Frame& F, const bf16* qp, const bf16* skb, const float* sumsq, int t0) {
    int lane = F.lane; asm volatile("" : "+v"(lane));
    const int r32 = lane & 31, hi = lane >> 5, w = F.wave;
    LAS unsigned short* EXL = (LAS unsigned short*)(F.lds + RING_OFF + L_EX);
    LAS float* GTL = (LAS float*)(F.lds + RING_OFF + L_GT);
    LAS unsigned char* IDXB = F.lds + RING_OFF + L_IDX + (w * 64 + lane) * IDX_STRIDE;
    LAS float* RST = (LAS float*)(F.lds + RING_OFF + L_RST);
    for (int g = 0; g < 4; ++g) {
        const int tok = 32 * g + r32; const size_t trow = (size_t)(t0 + tok);
        const float rstd2 = rsqrtf(sumsq[trow] * (1.f / DMODEL) + RMS_EPS);
        if (w == 0 && hi == 0) RST[tok] = rstd2;
        u32 s0[16], s1[16];
#pragma unroll
        for (int p = 0; p < 2; ++p) {
            bf16x8 qf[8];
#pragma unroll
            for (int ks = 0; ks < 8; ++ks) qf[ks] = *(const GAS bf16x8*)(qp + trow * QPW + w * 256 + p * 128 + ks * 16 + hi * 8);
            u32 run[16];
#pragma unroll
            for (int nb = 0; nb < 4; ++nb) {
                f32x16 acc = {};
                const bf16* kr = skb + ((size_t)((w * 2 + p) * NKEY + 32 * nb + r32)) * PHALF + hi * 8;
#pragma unroll
                for (int ks = 0; ks < 8; ++ks) acc = __builtin_amdgcn_mfma_f32_32x32x16_bf16(*(const GAS bf16x8*)(kr + ks * 16), qf[ks], acc, 0, 0, 0);
                asm volatile("" ::: "memory");
                u32 blk[16];
#pragma unroll
                for (int r = 0; r < 16; ++r) blk[r] = (ordmap(acc[r]) & ~0x7Fu) | (u32)(127 - 32 * nb - crow16(r) - 4 * hi);
                if (nb == 0) { sort16<true>(blk);
#pragma unroll
                    for (int i = 0; i < 16; ++i) run[i] = blk[i]; }
                else { sort16<false>(blk);
#pragma unroll
                    for (int i = 0; i < 16; ++i) run[i] = umax_(run[i], blk[i]);
                    merge16<true>(run); }
            }
            u32 oth[16];
#pragma unroll
            for (int i = 0; i < 16; ++i) oth[i] = (u32)__shfl_xor((int)run[15 - i], 32);
#pragma unroll
            for (int i = 0; i < 16; ++i) run[i] = umax_(run[i], oth[i]);
            merge16<true>(run);
#pragma unroll
            for (int i = 0; i < 16; ++i) { if (p == 0) s0[i] = run[i]; else s1[i] = run[i]; }
        }
        { LAS u32* iw = (LAS u32*)IDXB;
#pragma unroll
          for (int j = 0; j < 4; ++j) {
              iw[j] = (127u - (s0[4 * j] & 127u)) | ((127u - (s0[4 * j + 1] & 127u)) << 8) | ((127u - (s0[4 * j + 2] & 127u)) << 16) | ((127u - (s0[4 * j + 3] & 127u)) << 24);
              iw[4 + j] = (127u - (s1[4 * j] & 127u)) | ((127u - (s1[4 * j + 1] & 127u)) << 8) | ((127u - (s1[4 * j + 2] & 127u)) << 16) | ((127u - (s1[4 * j + 3] & 127u)) << 24); } }
        float v1[16], v2[16];
#pragma unroll
        for (int i = 0; i < 16; ++i) { v1[i] = unordmap(s0[i] & ~0x7Fu); v2[i] = unordmap(s1[i] & ~0x7Fu); }
        u32 c0[16], c1[16], c2[16], c3[16];
#pragma unroll
        for (int a = 0; a < 16; ++a)
#pragma unroll
            for (int b = 0; b < ccnt(a); ++b) { const int pos = cbase(a) + b; const u32 key = (ordmap(v1[a] + v2[b]) & ~0xFFu) | (u32)(255 - (a * 16 + b));
                if (pos < 16) c0[pos] = key; else if (pos < 32) c1[pos - 16] = key; else if (pos < 48) c2[pos - 32] = key; else c3[pos - 48] = key; }
#pragma unroll
        for (int i = 2; i < 16; ++i) c3[i] = 0u;
        sort16<false>(c1);
#pragma unroll
        for (int i = 0; i < 16; ++i) c0[i] = umax_(c0[i], c1[i]);
        merge16<true>(c0);
        sort16<false>(c2);
#pragma unroll
        for (int i = 0; i < 16; ++i) c0[i] = umax_(c0[i], c2[i]);
        merge16<true>(c0);
        sort16<false>(c3);
#pragma unroll
        for (int i = 0; i < 16; ++i) c0[i] = umax_(c0[i], c3[i]);
        merge16<true>(c0);
        const float m = unordmap(c0[0] & ~0xFFu) * rstd2;
        float e[8]; float sum = 0.f; u32 ex[8];
#pragma unroll
        for (int k = 0; k < 8; ++k) { const u32 key = hi ? c0[k + 8] : c0[k]; const float ts = unordmap(key & ~0xFFu);
            e[k] = __builtin_amdgcn_exp2f((ts * rstd2 - m) * LOG2E); sum += e[k];
            const u32 flat = 255u - (key & 255u); ex[k] = (u32)IDXB[flat >> 4] * NKEY + (u32)IDXB[16 + (flat & 15u)]; }
        sum += __shfl_xor(sum, 32);
        const float inv = 1.f / sum;
        v4u exw; exw.x = ex[0] | (ex[1] << 16); exw.y = ex[2] | (ex[3] << 16); exw.z = ex[4] | (ex[5] << 16); exw.w = ex[6] | (ex[7] << 16);
        *(LAS v4u*)(EXL + tok * EX_STRIDE + w * 16 + hi * 8) = exw;
        *(LAS f32x4*)(GTL + tok * GT_STRIDE + w * 16 + hi * 8) = (f32x4){e[0] * inv, e[1] * inv, e[2] * inv, e[3] * inv};
        *(LAS f32x4*)(GTL + tok * GT_STRIDE + w * 16 + hi * 8 + 4) = (f32x4){e[4] * inv, e[5] * inv, e[6] * inv, e[7] * inv};
    }
}
__device__ __forceinline__ float gelu_fast(float x) {
    const float u2 = x * (1.5957691216057308f + 0.07135481627f * x * x);
    return x * __builtin_amdgcn_rcpf(1.f + __builtin_amdgcn_exp2f(-1.4426950408889634f * u2));
}
typedef float f32x2 __attribute__((ext_vector_type(2)));

__device__ __forceinline__ void sort128(u32 (&k)[8], int m) {
#pragma unroll
    for (int K = 2; K <= 128; K <<= 1) {
#pragma unroll
        for (int S = K >> 1; S > 0; S >>= 1) {
            if (S >= 8) {
                const int mm = S >> 3; const bool lower = (m & mm) == 0, up = (K == 128) ? true : ((m & (K >> 3)) == 0), keepmin = (lower == up);
#pragma unroll
                for (int r = 0; r < 8; ++r) { const u32 o = (u32)__shfl_xor((int)k[r], mm); const u32 mn = umin_(k[r], o), mx = umax_(k[r], o); k[r] = keepmin ? mn : mx; }
            } else {
#pragma unroll
                for (int r = 0; r < 8; ++r) { const int r2 = r ^ S;
                    if (r2 > r) { const u32 a = k[r], b = k[r2], mn = umin_(a, b), mx = umax_(a, b);
                        if (K < 8) { const bool up = (r & K) == 0; k[r] = up ? mn : mx; k[r2] = up ? mx : mn; }
                        else { const bool up = (K == 128) ? true : ((m & (K >> 3)) == 0); k[r] = up ? mn : mx; k[r2] = up ? mx : mn; } } }
            }
        }
    }
}
__device__ __forceinline__ void eval_lg(Frame& F, const unsigned char* u8, const unsigned char* v8, const float* suv, const float* fg, float* out, int t0) {
    int lane = F.lane; asm volatile("" : "+v"(lane));
    const int g = lane >> 4, m = lane & 15;
    const LAS unsigned short* EXL = (const LAS unsigned short*)(F.lds + RING_OFF + L_EX);
    const LAS float* GTL = (const LAS float*)(F.lds + RING_OFF + L_GT);
    const LAS float* RST = (const LAS float*)(F.lds + RING_OFF + L_RST);
    LAS u32* SK = (LAS u32*)(F.lds + RING_OFF + L_IDX) + F.wave * 512 + g * 128;
    for (int pass = 0; pass < 4; ++pass) {
        const int tok = 32 * pass + 4 * F.wave + g;
        { u32 k[8]; const v4u ev = *(const LAS v4u*)(EXL + tok * EX_STRIDE + 8 * m); const u32 s0 = (u32)(8 * m);
          k[0] = ((ev.x & 0xffffu) << 7) | s0; k[1] = ((ev.x >> 16) << 7) | (s0 + 1); k[2] = ((ev.y & 0xffffu) << 7) | (s0 + 2); k[3] = ((ev.y >> 16) << 7) | (s0 + 3);
          k[4] = ((ev.z & 0xffffu) << 7) | (s0 + 4); k[5] = ((ev.z >> 16) << 7) | (s0 + 5); k[6] = ((ev.w & 0xffffu) << 7) | (s0 + 6); k[7] = ((ev.w >> 16) << 7) | (s0 + 7);
          sort128(k, m);
          *(LAS v4u*)(SK + m * 8) = (v4u){k[0], k[1], k[2], k[3]}; *(LAS v4u*)(SK + m * 8 + 4) = (v4u){k[4], k[5], k[6], k[7]}; }
        asm volatile("" ::: "memory");
        f32x2 hv[32], y[32];
        const float rstd2 = RST[tok]; float* xrow = out + (size_t)(t0 + tok) * DMODEL + 64 * m;
#pragma unroll
        for (int q = 0; q < 16; ++q) { const f32x4 xa = *(const GAS f32x4*)(xrow + 4 * q); hv[2 * q] = (f32x2){xa[0] * rstd2, xa[1] * rstd2}; hv[2 * q + 1] = (f32x2){xa[2] * rstd2, xa[3] * rstd2};
            y[2 * q] = (f32x2){0.f, 0.f}; y[2 * q + 1] = (f32x2){0.f, 0.f}; }
        const LAS float* gtr = GTL + tok * GT_STRIDE;
        for (int i = 0; i < 128; i += 2) {
            const u32 key0 = SK[i], key1 = SK[i + 1];
            const unsigned char* up0 = u8 + (size_t)(key0 >> 7) * DMODEL + 64 * m; const unsigned char* up1 = u8 + (size_t)(key1 >> 7) * DMODEL + 64 * m;
            v4u ub0[4], ub1[4];
#pragma unroll
            for (int c = 0; c < 4; ++c) { ub0[c] = *(const GAS v4u*)(up0 + 16 * c); ub1[c] = *(const GAS v4u*)(up1 + 16 * c); }
            const f32x2 sc0 = *(const GAS f32x2*)(suv + 2 * (key0 >> 7)), sc1 = *(const GAS f32x2*)(suv + 2 * (key1 >> 7));
            const float gate0 = gtr[key0 & 127u], gate1 = gtr[key1 & 127u];
            f32x2 a0 = (f32x2){0.f, 0.f}, a1 = (f32x2){0.f, 0.f};
#pragma unroll
            for (int c = 0; c < 4; ++c)
#pragma unroll
                for (int d = 0; d < 4; ++d) { const int w0 = (int)ub0[c][d], w1 = (int)ub1[c][d];
                    a0 = __builtin_elementwise_fma(__builtin_amdgcn_cvt_pk_f32_fp8(w0, false), hv[8 * c + 2 * d], a0); a0 = __builtin_elementwise_fma(__builtin_amdgcn_cvt_pk_f32_fp8(w0, true), hv[8 * c + 2 * d + 1], a0);
                    a1 = __builtin_elementwise_fma(__builtin_amdgcn_cvt_pk_f32_fp8(w1, false), hv[8 * c + 2 * d], a1); a1 = __builtin_elementwise_fma(__builtin_amdgcn_cvt_pk_f32_fp8(w1, true), hv[8 * c + 2 * d + 1], a1); }
            asm volatile("" ::: "memory");
            const unsigned char* vp0 = v8 + (size_t)(key0 >> 7) * DMODEL + 64 * m; const unsigned char* vp1 = v8 + (size_t)(key1 >> 7) * DMODEL + 64 * m;
            v4u vb0[4], vb1[4];
#pragma unroll
            for (int c = 0; c < 4; ++c) { vb0[c] = *(const GAS v4u*)(vp0 + 16 * c); vb1[c] = *(const GAS v4u*)(vp1 + 16 * c); }
            float p0 = a0[0] + a0[1], p1 = a1[0] + a1[1];
            p0 += __shfl_xor(p0, 1); p1 += __shfl_xor(p1, 1); p0 += __shfl_xor(p0, 2); p1 += __shfl_xor(p1, 2); p0 += __shfl_xor(p0, 4); p1 += __shfl_xor(p1, 4); p0 += __shfl_xor(p0, 8); p1 += __shfl_xor(p1, 8);
            const float act0 = gelu_fast(p0 * sc0[0]) * (gate0 * sc0[1]), act1 = gelu_fast(p1 * sc1[0]) * (gate1 * sc1[1]);
            const f32x2 b0 = (f32x2){act0, act0}, b1 = (f32x2){act1, act1};
#pragma unroll
            for (int c = 0; c < 4; ++c)
#pragma unroll
                for (int d = 0; d < 4; ++d) { const int w0 = (int)vb0[c][d], w1 = (int)vb1[c][d];
                    y[8 * c + 2 * d] = __builtin_elementwise_fma(__builtin_amdgcn_cvt_pk_f32_fp8(w0, false), b0, y[8 * c + 2 * d]); y[8 * c + 2 * d + 1] = __builtin_elementwise_fma(__builtin_amdgcn_cvt_pk_f32_fp8(w0, true), b0, y[8 * c + 2 * d + 1]);
                    y[8 * c + 2 * d] = __builtin_elementwise_fma(__builtin_amdgcn_cvt_pk_f32_fp8(w1, false), b1, y[8 * c + 2 * d]); y[8 * c + 2 * d + 1] = __builtin_elementwise_fma(__builtin_amdgcn_cvt_pk_f32_fp8(w1, true), b1, y[8 * c + 2 * d + 1]); }
        }
        float ss = 0.f;
#pragma unroll
        for (int q = 0; q < 16; ++q) { const f32x4 xa = *(const GAS f32x4*)(xrow + 4 * q); y[2 * q][0] += xa[0]; y[2 * q][1] += xa[1]; y[2 * q + 1][0] += xa[2]; y[2 * q + 1][1] += xa[3];
            ss += (y[2 * q][0] * y[2 * q][0] + y[2 * q][1] * y[2 * q][1]) + (y[2 * q + 1][0] * y[2 * q + 1][0] + y[2 * q + 1][1] * y[2 * q + 1][1]); }
        ss += __shfl_xor(ss, 1); ss += __shfl_xor(ss, 2); ss += __shfl_xor(ss, 4); ss += __shfl_xor(ss, 8);
        const float rs = rsqrtf(ss * (1.f / DMODEL) + RMS_EPS);
#pragma unroll
        for (int q = 0; q < 16; ++q) { const f32x4 gq = *(const GAS f32x4*)(fg + 64 * m + 4 * q); f32x4 o; o[0] = y[2 * q][0] * rs * gq[0]; o[1] = y[2 * q][1] * rs * gq[1]; o[2] = y[2 * q + 1][0] * rs * gq[2]; o[3] = y[2 * q + 1][1] * rs * gq[3];
            *(GAS f32x4*)(xrow + 4 * q) = o; }
    }
}
__device__ __forceinline__ void peer_phase(Frame& F, const Args& a) {
    unsigned char* ws = a.ws;
    for (int tile = F.vcu; tile < T / TOK; tile += F.G) {
        route_tile(F, (const bf16*)(ws + WS_QP), (const bf16*)(ws + WS_SKB), (const float*)(ws + WS_SUMSQ), tile * TOK);
        __syncthreads();
        eval_lg(F, ws + WS_U8, ws + WS_V8, (const float*)(ws + WS_SU), a.in[19], a.out, tile * TOK);
        __syncthreads();
    }
}
}

namespace lru {
typedef float f32x16 __attribute__((ext_vector_type(16)));
constexpr int TOKT = 128, NTILE = SEQ / TOKT;
constexpr int WAVE_LDS = 14336, L_XS = 0, L_XC = 4608, L_GS = 9216, XC_STRIDE = 72  , L_SS = 8 * WAVE_LDS;
static_assert(L_SS + 32 * 8 * 4 <= RING_BYTES, "LRU LDS map");
__device__ __forceinline__ float bf2f(unsigned short h) { return __uint_as_float((unsigned)h << 16); }
__device__ __forceinline__ int crow16(int r) { return (r & 3) + 8 * (r >> 2); }
__device__ __forceinline__ float sigm(float x) { return __builtin_amdgcn_rcpf(1.f + __builtin_amdgcn_exp2f(-LOG2E * x)); }

template <bool FINAL> __device__ __forceinline__ void lru_tile(Frame& F, const Args& args, int tile) {
    int lane = F.lane; asm volatile("" : "+v"(lane));
    const int w = F.wave, j32 = lane & 31, hi = lane >> 5;
    unsigned char* ws = args.ws;
    const bf16* xr = (const bf16*)(ws + WS_XR); const bf16* gr = (const bf16*)(ws + WS_GR); float* carry = (float*)(ws + WS_CARRY);
    const float* cw = args.in[3]; const float* cb = args.in[4]; const float* ba = args.in[6]; const float* bx = args.in[8]; const float* lam = args.in[9];
    const int b = tile / NTILE, jt = tile % NTILE; const size_t trow0 = (size_t)b * SEQ + (size_t)jt * TOKT;
    LAS unsigned char* wl = F.lds + RING_OFF + w * WAVE_LDS;
    LAS unsigned short* XS = (LAS unsigned short*)(wl + L_XS); LAS unsigned short* XC = (LAS unsigned short*)(wl + L_XC); LAS unsigned short* GS = (LAS unsigned short*)(wl + L_GS);
    LAS float* SS = (LAS float*)(F.lds + RING_OFF + L_SS);
    float c_ba[2], c_bx[2], c_sp[2], c_cb[2], c_cw[2][4];
#pragma unroll
    for (int n = 0; n < 2; ++n) { const int c = 64 * w + 32 * n + j32; c_ba[n] = ba[c]; c_bx[n] = bx[c]; c_cb[n] = cb[c];
        const float l = lam[c]; c_sp[n] = 8.f * LOG2E * (fmaxf(-l, 0.f) + log1pf(expf(-fabsf(l))));
#pragma unroll
        for (int k = 0; k < 4; ++k) c_cw[n][k] = cw[k * LW + c]; }
    const bf16* wax = (const bf16*)(ws + WS_WAX);
    float hc[2] = {0.f, 0.f}, ap[2] = {1.f, 1.f};
    if (FINAL) {
        for (int jp = 0; jp < jt; ++jp) { const float* cp = carry + ((size_t)(b * NTILE + jp) * 2) * LW + 64 * w + j32;
#pragma unroll
            for (int n = 0; n < 2; ++n) hc[n] = cp[32 * n] * hc[n] + cp[LW + 32 * n]; }
    }
    for (int blk = 0; blk < 4; ++blk) {
        const size_t tb = trow0 + blk * 32;
        int ln = lane; asm volatile("" : "+v"(ln));
        const int k32 = ln & 31;
        for (int pc = ln; pc < 35 * 8; pc += 64) { const int row = pc >> 3, c8 = pc & 7; v4u v = (v4u){0u, 0u, 0u, 0u};
            if (!(jt == 0 && blk == 0 && row < 3)) v = *(const GAS v4u*)(xr + (tb + row - 3) * LW + w * 64 + c8 * 8);
            *(LAS v4u*)((LAS unsigned char*)XS + row * 128 + c8 * 16) = v; }
        if (FINAL) {
#pragma unroll
            for (int q = 0; q < 4; ++q) { const int pc = ln + 64 * q, row = pc >> 3, c8 = pc & 7;
                *(LAS v4u*)((LAS unsigned char*)GS + row * 128 + c8 * 16) = *(const GAS v4u*)(gr + (tb + row) * LW + w * 64 + c8 * 8); } }
        asm volatile("" ::: "memory");
        float xc[2][16];
#pragma unroll
        for (int n = 0; n < 2; ++n)
#pragma unroll
            for (int g = 0; g < 4; ++g) { float xv[7];
#pragma unroll
                for (int q = 0; q < 7; ++q) xv[q] = bf2f(XS[(8 * g + 4 * hi + q) * 64 + 32 * n + j32]);
#pragma unroll
                for (int e = 0; e < 4; ++e) xc[n][4 * g + e] = c_cb[n] + ((c_cw[n][0] * xv[e] + c_cw[n][1] * xv[e + 1]) + (c_cw[n][2] * xv[e + 2] + c_cw[n][3] * xv[e + 3])); }
#pragma unroll
        for (int n = 0; n < 2; ++n)
#pragma unroll
            for (int r = 0; r < 16; ++r) XC[(crow16(r) + 4 * hi) * XC_STRIDE + 32 * n + j32] = (unsigned short)f2bf(xc[n][r]);
        asm volatile("" ::: "memory");
        bf16x8 af[4];
#pragma unroll
        for (int ks = 0; ks < 4; ++ks) af[ks] = *(const LAS bf16x8*)(XC + j32 * XC_STRIDE + 16 * ks + 8 * hi);
        asm volatile("" ::: "memory");
        float yv[2][16];
#pragma unroll
        for (int n = 0; n < 2; ++n) {
            f32x16 R = {}, I = {};
            bf16x8 fa[4], fx[4];
#pragma unroll
            for (int ks = 0; ks < 4; ++ks) { fa[ks] = *(const GAS bf16x8*)(wax + (size_t)(((w * 2 + 0) * 2 + n) * 4 + ks) * 512 + lane * 8); fx[ks] = *(const GAS bf16x8*)(wax + (size_t)(((w * 2 + 1) * 2 + n) * 4 + ks) * 512 + lane * 8); }
#pragma unroll
            for (int ks = 0; ks < 4; ++ks) { R = __builtin_amdgcn_mfma_f32_32x32x16_bf16(af[ks], fa[ks], R, 0, 0, 0); I = __builtin_amdgcn_mfma_f32_32x32x16_bf16(af[ks], fx[ks], I, 0, 0, 0); }
            float av[16], uv[16];
#pragma unroll
            for (int r = 0; r < 16; ++r) { const float rg = sigm(R[r] + c_ba[n]), ig = sigm(I[r] + c_bx[n]); const float a_ = __builtin_amdgcn_exp2f(-rg * c_sp[n]);
                av[r] = a_; uv[r] = __builtin_amdgcn_sqrtf(fmaxf(1.f - a_ * a_, 0.f)) * (ig * xc[n][r]); }
            float Ar[4], Hr[4], hst[4];
#pragma unroll
            for (int g = 0; g < 4; ++g) { Ar[g] = (av[4 * g] * av[4 * g + 1]) * (av[4 * g + 2] * av[4 * g + 3]);
                Hr[g] = ((uv[4 * g] * av[4 * g + 1] + uv[4 * g + 1]) * av[4 * g + 2] + uv[4 * g + 2]) * av[4 * g + 3] + uv[4 * g + 3]; }
            float hin = hc[n];
#pragma unroll
            for (int g = 0; g < 4; ++g) { float o1 = Ar[g] * hin + Hr[g]; const float x = __shfl_xor(o1, 32); const float hg = hi ? x : hin; o1 = Ar[g] * hg + Hr[g]; hst[g] = hg;
                const float y = __shfl_xor(o1, 32); hin = hi ? o1 : y;
                if (!FINAL) ap[n] *= Ar[g] * __shfl_xor(Ar[g], 32); }
            hc[n] = hin;
            if (FINAL) {
#pragma unroll
                for (int g = 0; g < 4; ++g) { float h = hst[g];
#pragma unroll
                    for (int e = 0; e < 4; ++e) { const int r = 4 * g + e; h = av[r] * h + uv[r]; yv[n][r] = h * bf2f(GS[(crow16(r) + 4 * hi) * 64 + 32 * n + j32]); } } }
        }
        if (FINAL) {
#pragma unroll
            for (int r = 0; r < 16; ++r) { float s = yv[0][r] * yv[0][r] + yv[1][r] * yv[1][r];
                s += __shfl_xor(s, 1); s += __shfl_xor(s, 2); s += __shfl_xor(s, 4); s += __shfl_xor(s, 8); s += __shfl_xor(s, 16);
                if (j32 == 0) SS[(crow16(r) + 4 * hi) * 8 + w] = s; }
            __syncthreads();
            bf16* ymix = (bf16*)(ws + WS_H);
#pragma unroll
            for (int r = 0; r < 16; ++r) { const int tk = crow16(r) + 4 * hi; const f32x4 s0 = *(const LAS f32x4*)(SS + tk * 8), s1 = *(const LAS f32x4*)(SS + tk * 8 + 4);
                const float rstd = rsqrtf(((s0[0] + s0[1]) + (s0[2] + s0[3]) + (s1[0] + s1[1]) + (s1[2] + s1[3])) * (1.f / LW) + RMS_EPS);
                bf16* yp = ymix + (tb + tk) * DMODEL + 64 * w + k32;
                yp[0] = (bf16)f2bf(yv[0][r] * rstd); yp[32] = (bf16)f2bf(yv[1][r] * rstd); }
            __syncthreads();
        }
    }
    if (!FINAL) { if (hi == 0) { float* cp = carry + ((size_t)(b * NTILE + jt) * 2) * LW + 64 * w + j32;
#pragma unroll
        for (int n = 0; n < 2; ++n) { cp[32 * n] = ap[n]; cp[LW + 32 * n] = hc[n]; } } }
    else {
        const bf16* ob = (const bf16*)(ws + WS_O); bf16* ymix = (bf16*)(ws + WS_H);
        for (int i = 0; i < 16; ++i) { const size_t row = trow0 + 16 * w + i; const v4u v = *(const GAS v4u*)(ob + row * AW + 8 * lane);
            float f[8]; f[0] = __uint_as_float(v.x << 16); f[1] = __uint_as_float(v.x & 0xffff0000u); f[2] = __uint_as_float(v.y << 16); f[3] = __uint_as_float(v.y & 0xffff0000u);
            f[4] = __uint_as_float(v.z << 16); f[5] = __uint_as_float(v.z & 0xffff0000u); f[6] = __uint_as_float(v.w << 16); f[7] = __uint_as_float(v.w & 0xffff0000u);
            float ss = 0.f;
#pragma unroll
            for (int e = 0; e < 8; ++e) ss += f[e] * f[e];
            const float rstd = rsqrtf(wave_sum(ss) * (1.f / AW) + RMS_EPS);
            v4u o; o.x = pk2(f[0] * rstd, f[1] * rstd); o.y = pk2(f[2] * rstd, f[3] * rstd); o.z = pk2(f[4] * rstd, f[5] * rstd); o.w = pk2(f[6] * rstd, f[7] * rstd);
            *(GAS v4u*)(ymix + row * DMODEL + LW + 8 * lane) = o; }
    }
}
__device__ __forceinline__ void norm_pass(Frame& F, const Args& a) {
    unsigned char* ws = a.ws; float* nrm = (float*)(ws + WS_NRM);
    const int gw = F.vcu * NWAVES + F.wave, NGW = F.G * NWAVES, lane = F.lane;
    for (int it = gw; it < 2 * BATCH * (SEQ / 64); it += NGW) {
        const int which = it / (BATCH * (SEQ / 64)), r = it % (BATCH * (SEQ / 64)), b = r / (SEQ / 64), t = r % (SEQ / 64);
        const bf16* src = (const bf16*)(ws + (which ? WS_K : WS_Q)) + ((size_t)b * SEQ + 64 * t) * AW + 8 * lane;
        float mx = 0.f;
#pragma unroll 8
        for (int i = 0; i < 64; ++i) { const v4u v = *(const GAS v4u*)(src + (size_t)i * AW); float s = 0.f;
#pragma unroll
            for (int c = 0; c < 4; ++c) { const float lo = __uint_as_float(v[c] << 16), hi = __uint_as_float(v[c] & 0xffff0000u); s += lo * lo + hi * hi; }
            s += __shfl_xor(s, 1); s += __shfl_xor(s, 2); s += __shfl_xor(s, 4); mx = fmaxf(mx, s); }
        if ((lane & 7) == 0) nrm[which * 4096 + (b * NHEADS + (lane >> 3)) * 128 + t] = sqrtf(mx) * 1.0001f;
    }
}
template <bool FINAL> __device__ __forceinline__ void lru_phase(Frame& F, const Args& a) {
    for (int tile = F.vcu; tile < BATCH * NTILE; tile += F.G) { lru_tile<FINAL>(F, a, tile); __syncthreads(); }
}
}
__global__ void __launch_bounds__(NWAVES * 64, 2) mk_fwd(Args args) {
    extern __shared__ __attribute__((aligned(16))) unsigned char lds[];
    Frame F;
    F.lds = (LAS unsigned char*)lds;
    F.MISC = (volatile LAS unsigned*)(F.lds + MISC_OFF);
    F.wave = __builtin_amdgcn_readfirstlane((int)threadIdx.x >> 6); F.lane = (int)__builtin_amdgcn_mbcnt_hi(~0u, __builtin_amdgcn_mbcnt_lo(~0u, 0u)); F.tid = F.wave * 64 + F.lane;
    F.G = gridDim.x; { const int bx = blockIdx.x; F.vcu = (F.G % 8 == 0) ? (bx % 8) * (F.G / 8) + bx / 8 : bx; }
    unsigned char* ws = args.ws;
    F.ctl = (gu32*)(ws + WS_CTL);
    for (int u = F.tid; u < (LDS_BYTES - LDSCTL_OFF) / 4; u += NWAVES * 64) ((LAS unsigned*)(F.lds + LDSCTL_OFF))[u] = 0u;
    __syncthreads();
    XcdBarrier bar = xcd_barrier_post((unsigned*)(F.ctl + CW_BAR) + args.li * XCD_BAR_WORDS, F.MISC + 8, F.wave);
    const int lo = args.ph_lo, hi = args.ph_hi;
#ifndef MK_REP_MASK
#define MK_REP_MASK 0
#endif
#define REPS(k) (((MK_REP_MASK >> (k)) & 1) ? 2 : 1)
#define IN(k) (lo <= (k) && (k) < hi)
#define BOTH(k) (IN(k) && IN((k) + 1))
#define GRID_BAR() xcd_barrier(bar)

    if (IN(0)) { for (int rp = 0; rp < REPS(0); ++rp) { if (rp) GRID_BAR(); p0_prologue(F, args); } if (BOTH(0)) GRID_BAR(); }

    if (IN(1)) for (int rp = 0; rp < REPS(1); ++rp) {
        if (rp) GRID_BAR();
        if (F.vcu < BATCH * NHEADS) fcum_unit(F, F.vcu, (const float*)(ws + WS_LOGF), (float*)(ws + WS_FCUM));
        pg8::Gemm g{(const pg8::bf16_t*)(ws + WS_H), (const pg8::bf16_t*)(ws + WS_WIN), T, NG1, DMODEL}; pg8::StaticOrder S; S.init(T, NG1, F.G, (int)blockIdx.x);
        pg8::EpiG1 E{(pg8::bf16_t*)(ws + WS_XR), SPLIT_STRIDE, QSCALE};
        pg8::gemm_phase<pg8::EpiG1, pg8::StaticOrder, true, true>(F.lds + RING_OFF, g, S, E, F.wave);
        if (BOTH(1) && rp == REPS(1) - 1) GRID_BAR();
    }
    if (IN(2)) { lru::lru_phase<false>(F, args); lru::norm_pass(F, args); if (BOTH(2)) GRID_BAR(); }
    if (IN(3)) {
        static_assert(attn_body::ATTN_LDS_BYTES <= RING_BYTES, "attention LDS vs frame");
        const attn_body::AttnTensors AT{(const attn_body::bf16*)(ws + WS_Q), (const attn_body::bf16*)(ws + WS_K), (const attn_body::bf16*)(ws + WS_V), (attn_body::bf16*)(ws + WS_O), (const float*)(ws + WS_FCUM), (const float*)(ws + WS_NRM)};
        attn_body::attn_phase<8>((char*)lds + RING_OFF, AT, (unsigned*)(F.ctl + CW_ATTQ), F.MISC + 24, F.wave);
        if (BOTH(3)) GRID_BAR();
    }
    if (IN(4)) { lru::lru_phase<true>(F, args); if (BOTH(4)) GRID_BAR(); }
    if (IN(5)) {
        pg8::Gemm g{(const pg8::bf16_t*)(ws + WS_H), (const pg8::bf16_t*)(ws + WS_WOUT), T, DMODEL, DMODEL}; pg8::StaticOrder S; S.init(T, DMODEL, F.G, (int)blockIdx.x);
        pg8::EpiG2 E{args.in[0], args.out, (pg8::bf16_t*)(ws + WS_X1B), (float*)(ws + WS_SUMSQ), DMODEL};
        pg8::gemm_phase<pg8::EpiG2, pg8::StaticOrder, true, true>(F.lds + RING_OFF, g, S, E, F.wave);
        if (BOTH(5)) GRID_BAR();
    }
    if (IN(6)) for (int rp = 0; rp < REPS(6); ++rp) {
        if (rp) GRID_BAR();
        pg8::Gemm g{(const pg8::bf16_t*)(ws + WS_X1B), (const pg8::bf16_t*)(ws + WS_WQ), T, QPW, DMODEL}; pg8::StaticOrder S; S.init(T, QPW, F.G, (int)blockIdx.x);
        pg8::EpiG3 E{(pg8::bf16_t*)(ws + WS_QP), QPW};
        pg8::gemm_phase<pg8::EpiG3, pg8::StaticOrder, true, true>(F.lds + RING_OFF, g, S, E, F.wave);
        if (BOTH(6) && rp == REPS(6) - 1) GRID_BAR();
    }
    if (IN(7)) { peer::peer_phase(F, args); }
#undef IN
#undef BOTH
#undef GRID_BAR
}

#ifndef MK_FRAME_MASK
#define MK_FRAME_MASK 0xFF
#endif
extern "C" void kernel_launch(void* const* d_in, const int* in_sizes, int n_in, void* d_out, int out_size, void* d_ws, size_t ws_size, hipStream_t stream) {
    static int grid = 0;
    if (grid == 0) {
        if (n_in != 20 || in_sizes[0] != T * DMODEL || out_size != T * DMODEL || ws_size < WS_END) { fprintf(stderr, "kernel_launch: unexpected shapes (n_in %d, ws %zu)\n", n_in, ws_size); grid = -1; return; }
        int dev = 0, cus = 0;
        if (hipGetDevice(&dev) != hipSuccess || hipDeviceGetAttribute(&cus, hipDeviceAttributeMultiprocessorCount, dev) != hipSuccess) { grid = -1; return; }
        if (hipFuncSetAttribute((const void*)mk_fwd, hipFuncAttributeMaxDynamicSharedMemorySize, LDS_BYTES) != hipSuccess) { fprintf(stderr, "kernel_launch: hipFuncSetAttribute failed\n"); grid = -1; return; }
        (void)hipGetLastError();
        grid = cus;
    }
    if (grid < 0) return;
    using namespace naive;
    const float* x = (const float*)d_in[0]; const float* g1 = (const float*)d_in[1]; const float* w_in = (const float*)d_in[2];
    const float* cw = (const float*)d_in[3]; const float* cb = (const float*)d_in[4]; const float* wa = (const float*)d_in[5]; const float* ba = (const float*)d_in[6];
    const float* wx = (const float*)d_in[7]; const float* bx = (const float*)d_in[8]; const float* lam = (const float*)d_in[9]; const float* bfv = (const float*)d_in[10];
    const float* gn_l = (const float*)d_in[11]; const float* gn_f = (const float*)d_in[12]; const float* w_out = (const float*)d_in[13]; const float* g2 = (const float*)d_in[14];
    const float* w_q = (const float*)d_in[15]; const float* sk = (const float*)d_in[16]; const float* pu = (const float*)d_in[17]; const float* pv = (const float*)d_in[18]; const float* fg = (const float*)d_in[19];
    char* ws = (char*)d_ws; float* out = (float*)d_out;
    naive::bf16* win_t = (naive::bf16*)(ws + WS_WIN); naive::bf16* wout_t = (naive::bf16*)(ws + WS_WOUT); naive::bf16* wq_t = (naive::bf16*)(ws + WS_WQ); naive::bf16* skb = (naive::bf16*)(ws + WS_SKB); float* wfl = (float*)(ws + WS_WFL);
    float* logf = (float*)(ws + WS_LOGF); float* fcum = (float*)(ws + WS_FCUM); float* sumsq = (float*)(ws + WS_SUMSQ);
    naive::bf16* h = (naive::bf16*)(ws + WS_H); naive::bf16* xr = (naive::bf16*)(ws + WS_XR); naive::bf16* gr = (naive::bf16*)(ws + WS_GR); naive::bf16* q = (naive::bf16*)(ws + WS_Q); naive::bf16* k = (naive::bf16*)(ws + WS_K); naive::bf16* v = (naive::bf16*)(ws + WS_V);
    naive::bf16* x1b = (naive::bf16*)(ws + WS_X1B); naive::bf16* qp = (naive::bf16*)(ws + WS_QP); naive::bf16* ut = (naive::bf16*)(ws + WS_UT); naive::bf16* vt = (naive::bf16*)(ws + WS_VT); float* la = (float*)(ws + WS_LA); float* lu = (float*)(ws + WS_LU);
    naive::bf16* ymix = h;
    if (hipMemsetAsync((char*)d_ws + WS_CTL, 0, CTL_ZERO_BYTES, stream) != hipSuccess) return;
    Args a{};
    for (int i = 0; i < 20; ++i) a.in[i] = (const float*)d_in[i];
    a.out = out; a.ws = (unsigned char*)d_ws;
    int li = 0;
    for (int p = 0; p < N_PHASES;) {
        if ((MK_FRAME_MASK >> p) & 1) {
            int e = p; while (e < N_PHASES && ((MK_FRAME_MASK >> e) & 1)) ++e;
            a.ph_lo = p; a.ph_hi = e; a.li = li++;
            hipLaunchKernelGGL(mk_fwd, dim3(grid), dim3(NWAVES * 64), LDS_BYTES, stream, a);
            p = e; continue;
        }
        switch (p) {
        case 0: k_prep_w<<<2048, 256, 0, stream>>>(w_in, w_out, gn_l, gn_f, w_q, g2, sk, win_t, wfl, wout_t, wq_t, skb);
                k_prep_tab<<<4096, 256, 0, stream>>>(pu, pv, g2, ut, vt);
                k_prep_x<<<2048, 256, 0, stream>>>(x, g1, wfl, bfv, h, logf); break;
        case 1: k_fcum<<<BATCH * NHEADS, 64, 0, stream>>>(logf, fcum);
                { EpiArgs e{xr, gr, q, k, v, nullptr, nullptr}; k_gemm<1><<<dim3(NG1 / 64, T / 64), 256, 0, stream>>>(h, win_t, T, NG1, DMODEL, e); } break;
        case 2: break;
        case 3: k_attn<<<(BATCH * NHEADS * SEQ) / 4, 256, 0, stream>>>(q, k, v, fcum, (naive::bf16*)(ws + WS_O)); break;
        case 4: k_lru_gates<<<T * NHEADS, 64, 0, stream>>>(xr, cw, cb, wa, ba, wx, bx, lam, la, lu);
                k_lru_scan<<<(BATCH * LW + 63) / 64, 64, 0, stream>>>(la, lu, gr);
                k_ymix<<<2048, 256, 0, stream>>>(lu, (naive::bf16*)(ws + WS_O), ymix); break;
        case 5: { EpiArgs e{x1b, nullptr, nullptr, nullptr, nullptr, x, out}; k_gemm<2><<<dim3(DMODEL / 64, T / 64), 256, 0, stream>>>(ymix, wout_t, T, DMODEL, DMODEL, e); }
                k_sumsq<<<2048, 256, 0, stream>>>(out, sumsq); break;
        case 6: { EpiArgs e{qp, nullptr, nullptr, nullptr, nullptr, nullptr, nullptr}; k_gemm<3><<<dim3(QPW / 64, T / 64), 256, 0, stream>>>(x1b, wq_t, T, QPW, DMODEL, e); } break;
        case 7: k_peer<<<T, 64, 0, stream>>>(qp, skb, sumsq, ut, vt, fg, out); break;
        }
        ++p;
    }
}
```

```cpp
#include <hip/hip_runtime.h>
#include <hip/hip_bf16.h>
#include <cstdio>
#include <cstdint>
#include <cmath>

constexpr int BATCH = 4, SEQ = 8192, DMODEL = 1024, T = BATCH * SEQ;
constexpr int LW = 512, AW = 512, NHEADS = 8, HD = 64, INC = 2568, NG1 = 2560;
constexpr int PH = 8, NKEY = 128, PHALF = 128, TOPK = 16, NEXP = NKEY * NKEY, QPW = 2048;
constexpr float RMS_EPS = 1e-6f;
constexpr float LOG2E = 1.4426950408889634f;
constexpr float QSCALE = 0.125f * LOG2E;
constexpr size_t MiB = 1u << 20;
constexpr size_t WS_CTL = 0, CTL_ZERO_BYTES = 1 * MiB;
constexpr size_t WS_WIN = 2 * MiB, WS_WOUT = 8 * MiB, WS_WQ = 10 * MiB, WS_SKB = 14 * MiB, WS_WFL = 15 * MiB,
                 WS_LOGF = 16 * MiB, WS_FCUM = 17 * MiB, WS_CARRY = 18 * MiB, WS_SUMSQ = 19 * MiB, WS_WAX = 20 * MiB, WS_NRM = 22 * MiB  ,
                 WS_H = 32 * MiB, WS_XR = 96 * MiB, WS_GR = 128 * MiB, WS_Q = 160 * MiB, WS_K = 192 * MiB, WS_V = 224 * MiB,
                 WS_X1B = 256 * MiB, WS_O = 256 * MiB  , WS_QP = 96 * MiB, WS_UT = 320 * MiB, WS_VT = 352 * MiB, WS_U8 = 320 * MiB, WS_V8 = 336 * MiB, WS_SU = 21 * MiB, WS_SV = 21 * MiB + 65536, WS_LA = 384 * MiB, WS_LU = 448 * MiB, WS_END = 512 * MiB;
constexpr size_t SPLIT_STRIDE = (WS_GR - WS_XR) / 2;
constexpr int CW_TMO = 0, CW_ATTQ = 2048, CW_BAR = 4096;

namespace naive {
typedef unsigned short bf16;
__device__ __forceinline__ unsigned f2bf(float f) { unsigned u = __builtin_bit_cast(unsigned, f); return (u + 0x7fffu + ((u >> 16) & 1u)) >> 16; }
__device__ __forceinline__ float bf2f(unsigned short h) { return __builtin_bit_cast(float, (unsigned)h << 16); }
__device__ __forceinline__ float gelu_tanh(float x) { const float u = 0.7978845608028654f * (x + 0.044715f * x * x * x); return 0.5f * x * (1.f + tanhf(u)); }
__device__ __forceinline__ float sigmoidf_(float x) { return 1.f / (1.f + expf(-x)); }
__device__ __forceinline__ float wave_sum(float v) {
#pragma unroll
    for (int o = 1; o < 64; o <<= 1) v += __shfl_xor(v, o);
    return v;
}
__global__ void k_prep_w(const float* w_in, const float* w_out, const float* gn_l, const float* gn_f, const float* w_q, const float* g2, const float* sk,
                         bf16* win_t, float* wfl, bf16* wout_t, bf16* wq_t, bf16* skb) {
    const size_t gid = (size_t)blockIdx.x * blockDim.x + threadIdx.x, gsz = (size_t)gridDim.x * blockDim.x;
    for (size_t i = gid; i < (size_t)NG1 * DMODEL; i += gsz) { const int n = (int)(i / DMODEL), k = (int)(i % DMODEL); win_t[i] = (bf16)f2bf(w_in[(size_t)k * INC + n]); }
    for (size_t i = gid; i < (size_t)8 * DMODEL; i += gsz) { const int j = (int)(i / DMODEL), k = (int)(i % DMODEL); wfl[i] = w_in[(size_t)k * INC + NG1 + j]; }
    for (size_t i = gid; i < (size_t)DMODEL * DMODEL; i += gsz) { const int n = (int)(i / DMODEL), k = (int)(i % DMODEL); const float g = k < LW ? gn_l[k] : gn_f[k - LW]; wout_t[i] = (bf16)f2bf(g * w_out[(size_t)k * DMODEL + n]); }
    for (size_t i = gid; i < (size_t)QPW * DMODEL; i += gsz) { const int n = (int)(i / DMODEL), k = (int)(i % DMODEL); wq_t[i] = (bf16)f2bf(g2[k] * w_q[(size_t)k * QPW + n]); }
    for (size_t i = gid; i < (size_t)PH * 2 * NKEY * PHALF; i += gsz) skb[i] = (bf16)f2bf(sk[i]);
}
__global__ void k_prep_tab(const float* u, const float* v, const float* g2, bf16* ut, bf16* vt) {
    const size_t gid = (size_t)blockIdx.x * blockDim.x + threadIdx.x, gsz = (size_t)gridDim.x * blockDim.x;
    for (size_t i = gid; i < (size_t)NEXP * DMODEL; i += gsz) { const int d = (int)(i % DMODEL); ut[i] = (bf16)f2bf(g2[d] * u[i]); vt[i] = (bf16)f2bf(v[i]); }
}
__global__ void k_prep_x(const float* x, const float* g1, const float* wfl, const float* bfv, bf16* h, float* logf) {
    const int lane = threadIdx.x & 63, wv = (blockIdx.x * blockDim.x + threadIdx.x) >> 6, nw = (gridDim.x * blockDim.x) >> 6;
    for (int t = wv; t < T; t += nw) {
        float xv[16]; float ss = 0.f;
#pragma unroll
        for (int j = 0; j < 4; ++j) { const float4 v = *(const float4*)(x + (size_t)t * DMODEL + j * 256 + lane * 4); xv[4 * j] = v.x; xv[4 * j + 1] = v.y; xv[4 * j + 2] = v.z; xv[4 * j + 3] = v.w; ss += v.x * v.x + v.y * v.y + v.z * v.z + v.w * v.w; }
        const float rstd = rsqrtf(wave_sum(ss) * (1.f / DMODEL) + RMS_EPS);
#pragma unroll
        for (int j = 0; j < 4; ++j) { const float4 g = *(const float4*)(g1 + j * 256 + lane * 4); xv[4 * j] *= rstd * g.x; xv[4 * j + 1] *= rstd * g.y; xv[4 * j + 2] *= rstd * g.z; xv[4 * j + 3] *= rstd * g.w;
            uint2 o; o.x = f2bf(xv[4 * j]) | (f2bf(xv[4 * j + 1]) << 16); o.y = f2bf(xv[4 * j + 2]) | (f2bf(xv[4 * j + 3]) << 16); *(uint2*)(h + (size_t)t * DMODEL + j * 256 + lane * 4) = o; }
#pragma unroll
        for (int hh = 0; hh < 8; ++hh) { float a = 0.f;
#pragma unroll
            for (int j = 0; j < 4; ++j) { const float4 w = *(const float4*)(wfl + hh * DMODEL + j * 256 + lane * 4); a += xv[4 * j] * w.x + xv[4 * j + 1] * w.y + xv[4 * j + 2] * w.z + xv[4 * j + 3] * w.w; }
            a = wave_sum(a);
            if (lane == 0) { const float z = a + bfv[hh]; logf[(size_t)t * 8 + hh] = fminf(z, 0.f) - log1pf(expf(-fabsf(z))); } }
    }
}
__global__ void k_fcum(const float* logf, float* fcum) {
    const int lane = threadIdx.x & 63, bh = blockIdx.x, b = bh / NHEADS, hh = bh % NHEADS;
    float loc = 0.f;
    for (int i = 0; i < 128; ++i) loc += logf[((size_t)b * SEQ + lane * 128 + i) * 8 + hh];
    float inc = loc;
#pragma unroll
    for (int o = 1; o < 64; o <<= 1) { const float n = __shfl_up(inc, o); if (lane >= o) inc += n; }
    float run = inc - loc;
    for (int i = 0; i < 128; ++i) { run += logf[((size_t)b * SEQ + lane * 128 + i) * 8 + hh]; fcum[(size_t)bh * SEQ + lane * 128 + i] = run; }
}
struct EpiArgs { bf16* o0; bf16* o1; bf16* o2; bf16* o3; bf16* o4; const float* resid; float* outf; };
template <int EPI> __global__ void __launch_bounds__(256) k_gemm(const bf16* A, const bf16* Bt, int M, int N, int K, EpiArgs e) {
    __shared__ float As[32][65], Bs[32][65];
    const int tid = threadIdx.x, tx = tid & 15, ty = tid >> 4, m0 = blockIdx.y * 64, n0 = blockIdx.x * 64;
    float acc[4][4] = {};
    const int lr = tid >> 2, lc = (tid & 3) * 8;
    for (int k0 = 0; k0 < K; k0 += 32) {
        const uint4 av = *(const uint4*)(A + (size_t)(m0 + lr) * K + k0 + lc), bv = *(const uint4*)(Bt + (size_t)(n0 + lr) * K + k0 + lc);
        const unsigned aw[4] = {av.x, av.y, av.z, av.w}, bw[4] = {bv.x, bv.y, bv.z, bv.w};
#pragma unroll
        for (int i = 0; i < 4; ++i) { As[lc + 2 * i][lr] = bf2f(aw[i] & 0xffff); As[lc + 2 * i + 1][lr] = bf2f(aw[i] >> 16); Bs[lc + 2 * i][lr] = bf2f(bw[i] & 0xffff); Bs[lc + 2 * i + 1][lr] = bf2f(bw[i] >> 16); }
        __syncthreads();
#pragma unroll 8
        for (int k = 0; k < 32; ++k) { float a[4], b[4];
#pragma unroll
            for (int i = 0; i < 4; ++i) { a[i] = As[k][ty * 4 + i]; b[i] = Bs[k][tx * 4 + i]; }
#pragma unroll
            for (int i = 0; i < 4; ++i)
#pragma unroll
                for (int j = 0; j < 4; ++j) acc[i][j] += a[i] * b[j]; }
        __syncthreads();
    }
#pragma unroll
    for (int i = 0; i < 4; ++i)
#pragma unroll
        for (int j = 0; j < 4; ++j) { const int m = m0 + ty * 4 + i, n = n0 + tx * 4 + j; const float v = acc[i][j];
            if (EPI == 1) { const int s = n >> 9, c = n & 511; bf16* o = s == 0 ? e.o0 : s == 1 ? e.o1 : s == 2 ? e.o2 : s == 3 ? e.o3 : e.o4;
                const float w = s == 1 ? gelu_tanh(v) : s == 2 ? v * QSCALE : v; o[(size_t)m * 512 + c] = (bf16)f2bf(w); }
            else if (EPI == 2) { const float r = e.resid[(size_t)m * DMODEL + n] + v; e.outf[(size_t)m * DMODEL + n] = r; e.o0[(size_t)m * DMODEL + n] = (bf16)f2bf(r); }
            else { e.o0[(size_t)m * N + n] = (bf16)f2bf(v); } }
}
__global__ void k_sumsq(const float* x1, float* sumsq) {
    const int lane = threadIdx.x & 63, wv = (blockIdx.x * blockDim.x + threadIdx.x) >> 6, nw = (gridDim.x * blockDim.x) >> 6;
    for (int t = wv; t < T; t += nw) { float ss = 0.f;
#pragma unroll
        for (int j = 0; j < 4; ++j) { const float4 v = *(const float4*)(x1 + (size_t)t * DMODEL + j * 256 + lane * 4); ss += v.x * v.x + v.y * v.y + v.z * v.z + v.w * v.w; }
        ss = wave_sum(ss); if (lane == 0) sumsq[t] = ss; }
}
__global__ void k_lru_gates(const bf16* xr, const float* cw, const float* cb, const float* wa, const float* ba, const float* wx, const float* bx, const float* lam, float* la, float* lu) {
    __shared__ float xc[64];
    const int j = threadIdx.x, t = blockIdx.x / NHEADS, hh = blockIdx.x % NHEADS, ch = hh * 64 + j, s = t % SEQ;
    float c = cb[ch];
#pragma unroll
    for (int k = 0; k < 4; ++k) { const int ss = s - 3 + k; if (ss >= 0) c += cw[k * LW + ch] * bf2f(xr[(size_t)(t - 3 + k) * LW + ch]); }
    xc[j] = c; __syncthreads();
    float r = ba[ch], ii = bx[ch];
    for (int i = 0; i < 64; ++i) { const float xv = xc[i]; r += xv * wa[(size_t)(hh * 64 + i) * 64 + j]; ii += xv * wx[(size_t)(hh * 64 + i) * 64 + j]; }
    r = sigmoidf_(r); ii = sigmoidf_(ii);
    const float l = lam[ch], sp = fmaxf(-l, 0.f) + log1pf(expf(-fabsf(l)));
    const float log_a = -8.f * r * sp, a = expf(log_a), u = sqrtf(-expm1f(2.f * log_a)) * (ii * c);
    la[(size_t)t * LW + ch] = a; lu[(size_t)t * LW + ch] = u;
}
__global__ void k_lru_scan(const float* la, float* lu, const bf16* gr) {
    const int id = blockIdx.x * blockDim.x + threadIdx.x; if (id >= BATCH * LW) return;
    const int b = id / LW, ch = id % LW; float h = 0.f;
    for (int s = 0; s < SEQ; ++s) { const size_t o = ((size_t)b * SEQ + s) * LW + ch; h = la[o] * h + lu[o]; lu[o] = h * bf2f(gr[o]); }
}
__global__ void k_ymix(const float* ylru, const bf16* o, bf16* ymix) {
    const int lane = threadIdx.x & 63, wv = (blockIdx.x * blockDim.x + threadIdx.x) >> 6, nw = (gridDim.x * blockDim.x) >> 6;
    for (int t = wv; t < T; t += nw) {
        float a[8], f[8]; float sa = 0.f, sf = 0.f;
#pragma unroll
        for (int i = 0; i < 8; ++i) { a[i] = ylru[(size_t)t * LW + i * 64 + lane]; f[i] = bf2f(o[(size_t)t * AW + i * 64 + lane]); sa += a[i] * a[i]; sf += f[i] * f[i]; }
        const float ra = rsqrtf(wave_sum(sa) * (1.f / LW) + RMS_EPS), rf = rsqrtf(wave_sum(sf) * (1.f / AW) + RMS_EPS);
#pragma unroll
        for (int i = 0; i < 8; ++i) { ymix[(size_t)t * DMODEL + i * 64 + lane] = (bf16)f2bf(a[i] * ra); ymix[(size_t)t * DMODEL + LW + i * 64 + lane] = (bf16)f2bf(f[i] * rf); }
    }
}
__global__ void __launch_bounds__(256) k_attn(const bf16* Q, const bf16* K, const bf16* V, const float* fcum, bf16* O) {
    const int lane = threadIdx.x & 63, wv = (blockIdx.x * blockDim.x + threadIdx.x) >> 6;
    const int q = wv % SEQ, bh = wv / SEQ, b = bh / NHEADS, hh = bh % NHEADS;
    const size_t rowq = (size_t)b * SEQ + q;
    float qv[64];
#pragma unroll
    for (int i = 0; i < 8; ++i) { const uint4 w = *(const uint4*)(Q + rowq * AW + hh * 64 + i * 8); const unsigned ww[4] = {w.x, w.y, w.z, w.w};
#pragma unroll
        for (int c = 0; c < 4; ++c) { qv[i * 8 + 2 * c] = bf2f(ww[c] & 0xffff); qv[i * 8 + 2 * c + 1] = bf2f(ww[c] >> 16); } }
    const float fq = fcum[(size_t)bh * SEQ + q];
    float m = -INFINITY, l = 0.f; float o[64];
#pragma unroll
    for (int d = 0; d < 64; ++d) o[d] = 0.f;
    for (int j = lane; j <= q; j += 64) {
        const size_t rowk = (size_t)b * SEQ + j; float s = 0.f;
#pragma unroll
        for (int i = 0; i < 8; ++i) { const uint4 w = *(const uint4*)(K + rowk * AW + hh * 64 + i * 8); const unsigned ww[4] = {w.x, w.y, w.z, w.w};
#pragma unroll
            for (int c = 0; c < 4; ++c) { s += qv[i * 8 + 2 * c] * bf2f(ww[c] & 0xffff) + qv[i * 8 + 2 * c + 1] * bf2f(ww[c] >> 16); } }
        s += (fq - fcum[(size_t)bh * SEQ + j]) * LOG2E;
        const float mn = fmaxf(m, s), sc = exp2f(m - mn), p = exp2f(s - mn);
        l = l * sc + p; m = mn;
#pragma unroll
        for (int i = 0; i < 8; ++i) { const uint4 w = *(const uint4*)(V + rowk * AW + hh * 64 + i * 8); const unsigned ww[4] = {w.x, w.y, w.z, w.w};
#pragma unroll
            for (int c = 0; c < 4; ++c) { o[i * 8 + 2 * c] = o[i * 8 + 2 * c] * sc + p * bf2f(ww[c] & 0xffff); o[i * 8 + 2 * c + 1] = o[i * 8 + 2 * c + 1] * sc + p * bf2f(ww[c] >> 16); } }
    }
    float mall = m;
#pragma unroll
    for (int of = 1; of < 64; of <<= 1) mall = fmaxf(mall, __shfl_xor(mall, of));
    const float sc = (m == -INFINITY) ? 0.f : exp2f(m - mall);
    const float lt = wave_sum(l * sc); const float inv = 1.f / lt;
    float mine = 0.f;
#pragma unroll
    for (int d = 0; d < 64; ++d) { const float v = wave_sum(o[d] * sc); if (lane == d) mine = v; }
    O[rowq * AW + hh * 64 + lane] = (bf16)f2bf(mine * inv);
}
__device__ __forceinline__ void wave_argmax(float v, int idx, float& bv, int& bi) {
#pragma unroll
    for (int o = 1; o < 64; o <<= 1) { const float ov = __shfl_xor(v, o); const int oi = __shfl_xor(idx, o); if (ov > v || (ov == v && oi < idx)) { v = ov; idx = oi; } }
    bv = v; bi = idx;
}
__global__ void __launch_bounds__(64) k_peer(const bf16* qp, const bf16* skb, const float* sumsq, const bf16* ut, const bf16* vt, const float* fg, float* out) {
    __shared__ float qs[2048]; __shared__ float sc[256]; __shared__ float s1[16], s2[16]; __shared__ int i1[16], i2[16]; __shared__ int ex[128]; __shared__ float gt[128];
    const int lane = threadIdx.x, t = blockIdx.x;
    const float rstd2 = rsqrtf(sumsq[t] * (1.f / DMODEL) + RMS_EPS);
    for (int i = lane; i < 2048; i += 64) qs[i] = bf2f(qp[(size_t)t * 2048 + i]) * rstd2;
    __syncthreads();
    for (int hh = 0; hh < PH; ++hh) {
        for (int r = 0; r < 4; ++r) { const int idx = r * 64 + lane, p = idx >> 7, n = idx & 127; const bf16* kr = skb + ((size_t)(hh * 2 + p) * NKEY + n) * PHALF; const float* qq = qs + hh * 256 + p * 128;
            float a = 0.f; for (int c = 0; c < 128; ++c) a += qq[c] * bf2f(kr[c]); sc[idx] = a; }
        __syncthreads();
        for (int p = 0; p < 2; ++p) {
            float v0 = sc[p * 128 + lane], v1 = sc[p * 128 + 64 + lane];
            for (int k = 0; k < 16; ++k) { float v; int id; if (v0 >= v1) { v = v0; id = lane; } else { v = v1; id = lane + 64; }
                float bv; int bi; wave_argmax(v, id, bv, bi);
                if (lane == 0) { if (p == 0) { s1[k] = bv; i1[k] = bi; } else { s2[k] = bv; i2[k] = bi; } }
                if (bi == lane) v0 = -INFINITY; if (bi == lane + 64) v1 = -INFINITY; }
        }
        __syncthreads();
        float cv[4];
#pragma unroll
        for (int r = 0; r < 4; ++r) { const int idx = r * 64 + lane; cv[r] = s1[idx >> 4] + s2[idx & 15]; }
        float tops = 0.f; int topp = 0;
        for (int k = 0; k < 16; ++k) { float v = cv[0]; int id = lane;
#pragma unroll
            for (int r = 1; r < 4; ++r) if (cv[r] > v) { v = cv[r]; id = r * 64 + lane; }
            float bv; int bi; wave_argmax(v, id, bv, bi);
            if (lane == k) { tops = bv; topp = bi; }
#pragma unroll
            for (int r = 0; r < 4; ++r) if (bi == r * 64 + lane) cv[r] = -INFINITY; }
        float mx = lane < 16 ? tops : -INFINITY;
#pragma unroll
        for (int o = 1; o < 64; o <<= 1) mx = fmaxf(mx, __shfl_xor(mx, o));
        const float ev = lane < 16 ? expf(tops - mx) : 0.f; const float den = wave_sum(ev);
        if (lane < 16) { ex[hh * 16 + lane] = i1[topp >> 4] * NKEY + i2[topp & 15]; gt[hh * 16 + lane] = ev / den; }
        __syncthreads();
    }
    float hv[16], y[16];
    const float* x1 = out + (size_t)t * DMODEL;
#pragma unroll
    for (int j = 0; j < 4; ++j) { const float4 v = *(const float4*)(x1 + j * 256 + lane * 4); hv[4 * j] = v.x * rstd2; hv[4 * j + 1] = v.y * rstd2; hv[4 * j + 2] = v.z * rstd2; hv[4 * j + 3] = v.w * rstd2; }
#pragma unroll
    for (int i = 0; i < 16; ++i) y[i] = 0.f;
    for (int k = 0; k < 128; ++k) { const int e = ex[k]; const float g = gt[k]; float a = 0.f;
#pragma unroll
        for (int j = 0; j < 4; ++j) { const uint2 w = *(const uint2*)(ut + (size_t)e * DMODEL + j * 256 + lane * 4);
            a += hv[4 * j] * bf2f(w.x & 0xffff) + hv[4 * j + 1] * bf2f(w.x >> 16) + hv[4 * j + 2] * bf2f(w.y & 0xffff) + hv[4 * j + 3] * bf2f(w.y >> 16); }
        a = wave_sum(a); const float act = gelu_tanh(a) * g;
#pragma unroll
        for (int j = 0; j < 4; ++j) { const uint2 w = *(const uint2*)(vt + (size_t)e * DMODEL + j * 256 + lane * 4);
            y[4 * j] += act * bf2f(w.x & 0xffff); y[4 * j + 1] += act * bf2f(w.x >> 16); y[4 * j + 2] += act * bf2f(w.y & 0xffff); y[4 * j + 3] += act * bf2f(w.y >> 16); } }
    float ss = 0.f;
#pragma unroll
    for (int j = 0; j < 4; ++j) { const float4 v = *(const float4*)(x1 + j * 256 + lane * 4); y[4 * j] += v.x; y[4 * j + 1] += v.y; y[4 * j + 2] += v.z; y[4 * j + 3] += v.w; }
#pragma unroll
    for (int i = 0; i < 16; ++i) ss += y[i] * y[i];
    const float rs = rsqrtf(wave_sum(ss) * (1.f / DMODEL) + RMS_EPS);
#pragma unroll
    for (int j = 0; j < 4; ++j) { const float4 g = *(const float4*)(fg + j * 256 + lane * 4); float4 o; o.x = y[4 * j] * rs * g.x; o.y = y[4 * j + 1] * rs * g.y; o.z = y[4 * j + 2] * rs * g.z; o.w = y[4 * j + 3] * rs * g.w;
        *(float4*)(out + (size_t)t * DMODEL + j * 256 + lane * 4) = o; }
}
}

namespace pg8 {
#define PG8_LAS __attribute__((address_space(3)))
typedef unsigned short bf16_t;
typedef short bf16x8 __attribute__((ext_vector_type(8)));
typedef float f32x4 __attribute__((ext_vector_type(4)));
typedef unsigned u32x4 __attribute__((ext_vector_type(4)));
constexpr int BM = 256, BK = 64, HALF = 128, HTB = HALF * BK * 2  , STAGE_BYTES = 8 * HTB, NXCD = 8, WGM = 8;

__host__ __device__ __forceinline__ int lds_byte(int r, int c) { const int st = (r >> 4) * 2 + (c >> 5), rr = r & 15, cc = c & 31, ob = rr * 64 + cc * 2; return st * 1024 + (ob ^ (((ob >> 9) & 1) << 5)); }
__host__ __device__ __forceinline__ void stage_rc(int b, int& R, int& C) { const int st = b / 1024, sb = b % 1024, swz = sb ^ (((sb >> 9) & 1) << 5); R = (st >> 1) * 16 + swz / 64; C = (st & 1) * 32 + (swz % 64) / 2; }
__host__ __device__ __forceinline__ int perm32(int rho) { const int n = rho >> 4, i = rho & 15; return 8 * (i >> 2) + 4 * n + (i & 3); }

struct Unit { int pm, pn; };
struct Gemm { const bf16_t* A; const bf16_t* Bt; int M, N, K; };

struct StaticOrder {
    int nM, nN, nwg, G, c;
    __host__ __device__ void init(int M, int N, int G_, int c_) { nM = M / BM; nN = N / BM; nwg = nM * nN; G = G_; c = c_; }
    __host__ __device__ bool next(int i, Unit& u) const {
        const long L = (long)i * G + c; if (L >= nwg) return false;
        int wgid = (int)L; { const int q = nwg / NXCD, r = nwg % NXCD, xcd = wgid % NXCD, off = wgid / NXCD; wgid = (xcd < r ? xcd * (q + 1) : r * (q + 1) + (xcd - r) * q) + off; }
        const int nig = WGM * nN, gid = wgid / nig, fm = gid * WGM, gsz = (nM - fm) < WGM ? (nM - fm) : WGM;
        u.pm = fm + ((wgid % nig) % gsz); u.pn = (wgid % nig) / gsz; return true;
    }
    __device__ __forceinline__ void a_ready(const Unit&) const {}
    __device__ __forceinline__ void done(const Unit&) const {}
};

__device__ __forceinline__ unsigned cvt_pk_bf16(float lo, float hi) { unsigned r; asm volatile("v_cvt_pk_bf16_f32 %0, %1, %2" : "=v"(r) : "v"(lo), "v"(hi)); return r; }
typedef unsigned u32x2 __attribute__((ext_vector_type(2)));
__device__ __forceinline__ float gelu_fast(float x) {
    const float u2 = x * (1.5957691216057308f + 0.07135481627f * x * x);
    return x * __builtin_amdgcn_rcpf(1.f + __builtin_amdgcn_exp2f(-1.4426950408889634f * u2));
}
struct EpiG1 {
    static constexpr bool PERM = true, AFTER_DRAIN = false;
    bf16_t* base0; size_t split_stride; float qscale;
    __device__ __forceinline__ void operator()(const f32x4 (&acc)[2][2][4][2], const Unit& u, int wr, int wc, int fr, int fq) const {
        const int s = u.pn >> 1; bf16_t* base = base0 + (size_t)s * split_stride;
        const int row0 = u.pm * BM + wr * 64 + fr, col0 = (u.pn & 1) * 256 + wc * 32 + 8 * fq;
#pragma unroll
        for (int ai = 0; ai < 2; ++ai)
#pragma unroll
            for (int m = 0; m < 4; ++m) { bf16_t* rowp = base + (size_t)(row0 + ai * HALF + m * 16) * 512 + col0;
#pragma unroll
                for (int bj = 0; bj < 2; ++bj) { f32x4 v0 = acc[ai][bj][m][0], v1 = acc[ai][bj][m][1];
                    if (s == 1) {
#pragma unroll
                        for (int e = 0; e < 4; ++e) { v0[e] = gelu_fast(v0[e]); v1[e] = gelu_fast(v1[e]); } }
                    else if (s == 2) { v0 = v0 * qscale; v1 = v1 * qscale; }
                    u32x4 w; w.x = cvt_pk_bf16(v0[0], v0[1]); w.y = cvt_pk_bf16(v0[2], v0[3]); w.z = cvt_pk_bf16(v1[0], v1[1]); w.w = cvt_pk_bf16(v1[2], v1[3]);
                    *(u32x4*)(rowp + bj * HALF) = w; } }
    }
};
struct EpiG2 {
    static constexpr bool PERM = false, AFTER_DRAIN = false;
    const float* resid; float* out; bf16_t* xb; float* sumsq; int ldc;
    __device__ __forceinline__ void operator()(const f32x4 (&acc)[2][2][4][2], const Unit& u, int wr, int wc, int fr, int fq) const {
        const int row0 = u.pm * BM + wr * 64 + fr, col0 = u.pn * BM + wc * 32 + 4 * fq;
#pragma unroll
        for (int ai = 0; ai < 2; ++ai)
#pragma unroll
            for (int m = 0; m < 4; ++m) { const int r = row0 + ai * HALF + m * 16; const size_t off = (size_t)r * ldc + col0; float ss = 0.f;
#pragma unroll
                for (int bj = 0; bj < 2; ++bj)
#pragma unroll
                    for (int n = 0; n < 2; ++n) { const f32x4 x = *(const f32x4*)(resid + off + bj * HALF + n * 16) + acc[ai][bj][m][n];
                        *(f32x4*)(out + off + bj * HALF + n * 16) = x; ss += (x[0] * x[0] + x[1] * x[1]) + (x[2] * x[2] + x[3] * x[3]);
                        u32x2 w; w.x = cvt_pk_bf16(x[0], x[1]); w.y = cvt_pk_bf16(x[2], x[3]); *(u32x2*)(xb + off + bj * HALF + n * 16) = w; }
                ss += __shfl_xor(ss, 16); ss += __shfl_xor(ss, 32);
                if (fq == 0) atomicAdd(sumsq + r, ss);
                asm volatile("" ::: "memory"); }
    }
};
struct EpiG3 {
    static constexpr bool PERM = true, AFTER_DRAIN = false;
    bf16_t* O; int ldc;
    __device__ __forceinline__ void operator()(const f32x4 (&acc)[2][2][4][2], const Unit& u, int wr, int wc, int fr, int fq) const {
        const int row0 = u.pm * BM + wr * 64 + fr, col0 = u.pn * BM + wc * 32 + 8 * fq;
#pragma unroll
        for (int ai = 0; ai < 2; ++ai)
#pragma unroll
            for (int m = 0; m < 4; ++m) { bf16_t* rowp = O + (size_t)(row0 + ai * HALF + m * 16) * ldc + col0;
#pragma unroll
                for (int bj = 0; bj < 2; ++bj) { const f32x4 v0 = acc[ai][bj][m][0], v1 = acc[ai][bj][m][1];
                    u32x4 w; w.x = cvt_pk_bf16(v0[0], v0[1]); w.y = cvt_pk_bf16(v0[2], v0[3]); w.z = cvt_pk_bf16(v1[0], v1[1]); w.w = cvt_pk_bf16(v1[2], v1[3]);
                    *(u32x4*)(rowp + bj * HALF) = w; } }
    }
};

template <class Epi, class Sched, bool ALIGN_EPI = false, bool SP2 = false>
__device__ __forceinline__ void gemm_phase(PG8_LAS unsigned char* lds, const Gemm g, const Sched& S, const Epi& E, int wid_in) {
    const int wid = __builtin_amdgcn_readfirstlane(wid_in), lane = (int)__builtin_amdgcn_mbcnt_hi(~0u, __builtin_amdgcn_mbcnt_lo(~0u, 0u)), tid = wid * 64 + lane, wr = wid >> 2, wc = wid & 3, fr = lane & 15, fq = lane >> 4;
    const int K = g.K, nt = K / BK;
    unsigned voffA[2], voffB[2];
#pragma unroll
    for (int i = 0; i < 2; ++i) { int R, C; stage_rc(tid * 16 + i * 8192, R, C); const int Rb = Epi::PERM ? ((R & ~31) + perm32(R & 31)) : R;
        voffA[i] = (unsigned)(R * K + C) * 2u; voffB[i] = (unsigned)(Rb * K + C) * 2u; }
    const size_t kstep = (size_t)(BK * 2);
    const size_t hstep = (size_t)HALF * K * 2;
    const size_t tstep = 2 * hstep;
    const unsigned ldsw = (unsigned)wid * 1024u;
    const int aoff = lds_byte(wr * 64 + fr, fq * 8), boff = lds_byte(wc * 32 + fr, fq * 8);
#define PG8_SA(b, h) (((b) * 2 + (h)) * HTB)
#define PG8_SB(b, h) ((4 + (b) * 2 + (h)) * HTB)
#define PG8_STAGE(bufoff, gbase, voff) do { _Pragma("unroll") for (int _i = 0; _i < 2; ++_i) \
        __builtin_amdgcn_global_load_lds((const unsigned*)((const char*)(gbase) + (voff)[_i]), (PG8_LAS unsigned*)(lds + (bufoff) + ldsw + _i * 8192), 16, 0, 0); } while (0)
#define PG8_LDA(dst, b, h) do { _Pragma("unroll") for (int m = 0; m < 4; ++m) _Pragma("unroll") for (int k = 0; k < 2; ++k) dst[m][k] = *(const PG8_LAS bf16x8*)(lds + PG8_SA(b, h) + aoff + m * 2048 + k * 1024); } while (0)
#define PG8_LDB(dst, b, h) do { _Pragma("unroll") for (int n = 0; n < 2; ++n) _Pragma("unroll") for (int k = 0; k < 2; ++k) dst[n][k] = *(const PG8_LAS bf16x8*)(lds + PG8_SB(b, h) + boff + n * 2048 + k * 1024); } while (0)
#define PG8_MMA(ai, bj, At, Bt) do { __builtin_amdgcn_s_setprio(1); _Pragma("unroll") for (int m = 0; m < 4; ++m) _Pragma("unroll") for (int n = 0; n < 2; ++n) _Pragma("unroll") for (int k = 0; k < 2; ++k) \
        acc[ai][bj][m][n] = __builtin_amdgcn_mfma_f32_16x16x32_bf16(Bt[n][k], At[m][k], acc[ai][bj][m][n], 0, 0, 0); __builtin_amdgcn_s_setprio(0); } while (0)
#define PG8_WAIT_V(n) asm volatile("s_waitcnt vmcnt(" #n ")" ::: "memory")
#define PG8_WAIT_L(n) asm volatile("s_waitcnt lgkmcnt(" #n ")" ::: "memory")
#define PG8_BAR __builtin_amdgcn_s_barrier()
#define PG8_SCHED __builtin_amdgcn_sched_barrier(0)
    Unit cur, nxt; int ui = 0;
    if (!S.next(0, cur)) return;
    f32x4 acc[2][2][4][2];
#pragma unroll
    for (int a = 0; a < 2; ++a)
#pragma unroll
        for (int b = 0; b < 2; ++b)
#pragma unroll
            for (int m = 0; m < 4; ++m)
#pragma unroll
                for (int n = 0; n < 2; ++n) acc[a][b][m][n] = (f32x4){0.f, 0.f, 0.f, 0.f};
    bf16x8 At[4][2], B0[2][2], B1[2][2];
    const char* cA = (const char*)g.A + (size_t)cur.pm * tstep; const char* cB = (const char*)g.Bt + (size_t)cur.pn * tstep;
    S.a_ready(cur);
    if constexpr (SP2) {
        PG8_STAGE(PG8_SB(0, 0), cB, voffB); PG8_STAGE(PG8_SB(0, 1), cB + hstep, voffB); PG8_STAGE(PG8_SA(0, 0), cA, voffA); PG8_STAGE(PG8_SA(0, 1), cA + hstep, voffA);
        if (wr == 1) PG8_BAR;
        PG8_WAIT_V(2); PG8_BAR;
        PG8_STAGE(PG8_SB(1, 0), cB + kstep, voffB); PG8_STAGE(PG8_SA(1, 0), cA + kstep, voffA); PG8_STAGE(PG8_SB(1, 1), cB + hstep + kstep, voffB);
        PG8_WAIT_V(6); PG8_BAR;
    } else {
        PG8_STAGE(PG8_SB(0, 0), cB, voffB); PG8_STAGE(PG8_SA(0, 0), cA, voffA); PG8_STAGE(PG8_SB(0, 1), cB + hstep, voffB); PG8_STAGE(PG8_SA(0, 1), cA + hstep, voffA);
        if (wr == 1) PG8_BAR;
        PG8_WAIT_V(4); PG8_BAR;
        PG8_STAGE(PG8_SB(1, 0), cB + kstep, voffB); PG8_STAGE(PG8_SA(1, 0), cA + kstep, voffA); PG8_STAGE(PG8_SB(1, 1), cB + hstep + kstep, voffB);
        PG8_WAIT_V(6); PG8_BAR;
    }
    for (;;) {
        const bool has_next = S.next(ui + 1, nxt);
        const char* nA = has_next ? (const char*)g.A + (size_t)nxt.pm * tstep : cA; const char* nB = has_next ? (const char*)g.Bt + (size_t)nxt.pn * tstep : cB;
        for (int t = 0; t < nt; t += 2) {
            const bool last = (t == nt - 2);
            const char* a1 = cA + (size_t)(t + 1) * kstep;
            const char* a2 = last ? nA : cA + (size_t)(t + 2) * kstep; const char* b2 = last ? nB : cB + (size_t)(t + 2) * kstep;
            const char* a3 = a2 + kstep; const char* b3 = b2 + kstep;
            if (last && has_next) S.a_ready(nxt);
            if constexpr (SP2) {
            PG8_LDB(B0, 0, 0); PG8_LDB(B1, 0, 1); PG8_SCHED; PG8_LDA(At, 0, 0); PG8_STAGE(PG8_SA(1, 1), a1 + hstep, voffA);
            PG8_WAIT_V(8); PG8_WAIT_L(0); PG8_BAR; PG8_MMA(0, 0, At, B0); PG8_MMA(0, 1, At, B1); PG8_BAR; PG8_SCHED;
            PG8_LDA(At, 0, 1); PG8_STAGE(PG8_SB(0, 0), b2, voffB); PG8_STAGE(PG8_SB(0, 1), b2 + hstep, voffB); PG8_STAGE(PG8_SA(0, 0), a2, voffA);
            PG8_WAIT_V(8); PG8_WAIT_L(0); PG8_BAR; PG8_MMA(1, 0, At, B0); PG8_MMA(1, 1, At, B1); PG8_BAR; PG8_SCHED;
            PG8_LDB(B0, 1, 0); PG8_LDB(B1, 1, 1); PG8_SCHED; PG8_LDA(At, 1, 0); PG8_STAGE(PG8_SA(0, 1), a2 + hstep, voffA);
            PG8_WAIT_V(8); PG8_WAIT_L(0); PG8_BAR; PG8_MMA(0, 0, At, B0); PG8_MMA(0, 1, At, B1); PG8_BAR; PG8_SCHED;
            PG8_LDA(At, 1, 1); PG8_STAGE(PG8_SB(1, 0), b3, voffB); PG8_STAGE(PG8_SB(1, 1), b3 + hstep, voffB); PG8_STAGE(PG8_SA(1, 0), a3, voffA);
            PG8_WAIT_V(8); PG8_WAIT_L(0); PG8_BAR; PG8_MMA(1, 0, At, B0); PG8_MMA(1, 1, At, B1); PG8_BAR; PG8_SCHED;
            } else {
            PG8_LDB(B0, 0, 0); PG8_SCHED; PG8_LDA(At, 0, 0); PG8_STAGE(PG8_SA(1, 1), a1 + hstep, voffA);
            PG8_WAIT_L(8); PG8_BAR; PG8_WAIT_L(0); PG8_MMA(0, 0, At, B0); PG8_BAR; PG8_SCHED;
            PG8_LDB(B1, 0, 1); PG8_STAGE(PG8_SB(0, 0), b2, voffB);
            PG8_BAR; PG8_WAIT_L(0); PG8_MMA(0, 1, At, B1); PG8_BAR;
            PG8_LDA(At, 0, 1); PG8_STAGE(PG8_SA(0, 0), a2, voffA);
            PG8_BAR; PG8_WAIT_L(0); PG8_MMA(1, 0, At, B0); PG8_BAR; PG8_SCHED;
            PG8_STAGE(PG8_SB(0, 1), b2 + hstep, voffB);
            PG8_WAIT_V(6); PG8_BAR; PG8_MMA(1, 1, At, B1); PG8_BAR;
            PG8_LDB(B0, 1, 0); PG8_SCHED; PG8_LDA(At, 1, 0); PG8_STAGE(PG8_SA(0, 1), a2 + hstep, voffA);
            PG8_WAIT_L(8); PG8_BAR; PG8_WAIT_L(0); PG8_MMA(0, 0, At, B0); PG8_BAR; PG8_SCHED;
            PG8_LDB(B1, 1, 1); PG8_STAGE(PG8_SB(1, 0), b3, voffB);
            PG8_BAR; PG8_WAIT_L(0); PG8_MMA(0, 1, At, B1); PG8_BAR;
            PG8_LDA(At, 1, 1); PG8_STAGE(PG8_SA(1, 0), a3, voffA);
            PG8_BAR; PG8_WAIT_L(0); PG8_MMA(1, 0, At, B0); PG8_BAR; PG8_SCHED;
            PG8_STAGE(PG8_SB(1, 1), b3 + hstep, voffB);
            PG8_WAIT_V(6); PG8_BAR; PG8_MMA(1, 1, At, B1); PG8_BAR;
            }
        }
        if constexpr (ALIGN_EPI) { if (wr == 0) PG8_BAR; }
        if constexpr (!Epi::AFTER_DRAIN) { E(acc, cur, wr, wc, fr, fq); S.done(cur); }
        if (!has_next) break;
#pragma unroll
        for (int a = 0; a < 2; ++a)
#pragma unroll
            for (int b = 0; b < 2; ++b)
#pragma unroll
                for (int m = 0; m < 4; ++m)
#pragma unroll
                    for (int n = 0; n < 2; ++n) acc[a][b][m][n] = (f32x4){0.f, 0.f, 0.f, 0.f};
        cur = nxt; cA = nA; cB = nB; ++ui;
        if constexpr (ALIGN_EPI) { if (wr == 1) PG8_BAR; }
    }
    PG8_WAIT_V(0);
    if constexpr (!ALIGN_EPI) { if (wr == 0) PG8_BAR; }
    PG8_BAR;
    if constexpr (Epi::AFTER_DRAIN) { E.fused(acc, cur, wr, wc, fr, fq, lds, wid, lane); S.done(cur); }
#undef PG8_SA
#undef PG8_SB
#undef PG8_STAGE
#undef PG8_LDA
#undef PG8_LDB
#undef PG8_MMA
#undef PG8_WAIT_V
#undef PG8_WAIT_L
#undef PG8_BAR
#undef PG8_SCHED
}
}
#include <hip/hip_bf16.h>
#include <cmath>
namespace attn_body {
using bf16=__hip_bfloat16;
using bf16x8=__attribute__((ext_vector_type(8)))short;
using s16x4=__attribute__((ext_vector_type(4)))short;
using f32x16=__attribute__((ext_vector_type(16)))float;
using u32x4=__attribute__((ext_vector_type(4)))unsigned;
constexpr int BATCH=4,NHEAD=8,SEQ=8192,D=64,DM=NHEAD*D;
constexpr int NW=8,QBLK=32,QB=QBLK*NW,KVBLK=64,NQB=SEQ/QB;
constexpr int ATTN_PITCH=DM, ATTN_UNIT_ROWS=QB;
__device__ __forceinline__ int crow(int r,int hi){return (r&3)+8*(r>>2)+4*hi;}
#define SBAR() __builtin_amdgcn_sched_barrier(0)
__device__ __forceinline__ void cmask(f32x16&p0,f32x16&p1,int jb,int qrel,int hi){
  const float NEG=-INFINITY; int kb=64*jb+4*hi;
  #pragma unroll
  for(int r=0;r<16;++r){int kv=kb+(r&3)+8*(r>>2); if(kv>qrel)p0[r]=NEG; if(kv+32>qrel)p1[r]=NEG;}
}

constexpr int NSLOT=3, SLOTB=8192;
constexpr int LDS_K=0, LDS_V=NSLOT*SLOTB, LDS_WS=2*NSLOT*SLOTB, LDS_OST=LDS_WS+NW*64*4, LDS_FK=LDS_OST+NW*4096, LDS_BYTES=LDS_FK+SEQ*4;
constexpr float C2=0.125f*1.4426950408889634f;
__device__ __forceinline__ void glds16(const void*gsrc,unsigned lds_dst){unsigned keep;
  asm volatile("s_mov_b32 %0, m0\n\ts_mov_b32 m0, %2\n\ts_nop 0\n\tglobal_load_lds_dwordx4 %1, off\n\ts_mov_b32 m0, %0":"=&s"(keep):"v"(gsrc),"s"(lds_dst):"memory");}
__device__ __forceinline__ float max3f(float a,float b,float c){float r;asm("v_max3_f32 %0, %1, %2, %3":"=v"(r):"v"(a),"v"(b),"v"(c));return r;}
__device__ __forceinline__ float max2f(float a,float b){float r;asm("v_max_f32_e32 %0, %1, %2":"=v"(r):"v"(a),"v"(b));return r;}
__device__ __forceinline__ float fadd_s(float a,float b){float r;asm("v_add_f32_e32 %0, %1, %2":"=v"(r):"v"(a),"v"(b));return r;}
__device__ __forceinline__ float fsub_s(float a,float b){float r;asm("v_sub_f32_e32 %0, %1, %2":"=v"(r):"v"(a),"v"(b));return r;}
typedef float f32x2_t __attribute__((ext_vector_type(2))); typedef __bf16 bf16x2_t __attribute__((ext_vector_type(2)));
__device__ __forceinline__ unsigned cvtpk_s(float lo,float hi){f32x2_t v={lo,hi};bf16x2_t b=__builtin_convertvector(v,bf16x2_t);return __builtin_bit_cast(unsigned,b);}
#define WAIT_BAR(N) asm volatile("s_waitcnt vmcnt(" #N ") lgkmcnt(0)\n\ts_barrier":::"memory")

__device__ __forceinline__ void qkt(f32x16&p0,f32x16&p1,const char*Kslot,const bf16x8*qr,int r32,int hi){
  const char*kb=Kslot+hi*1024+r32*16;
  #pragma unroll
  for(int d0=0;d0<4;++d0){
    const bf16x8 b0=*reinterpret_cast<const bf16x8*>(kb+d0*2048);
    const bf16x8 b1=*reinterpret_cast<const bf16x8*>(kb+d0*2048+512);
    p0=__builtin_amdgcn_mfma_f32_32x32x16_bf16(b0,qr[d0],p0,0,0,0);p1=__builtin_amdgcn_mfma_f32_32x32x16_bf16(b1,qr[d0],p1,0,0,0);}
}
typedef __attribute__((address_space(3))) const char* lds_cptr;
typedef short v4i16_t __attribute__((ext_vector_type(4)));
__device__ __forceinline__ void kload8(bf16x8*kf,lds_cptr kp){
  kf[0]=*(const __attribute__((address_space(3))) bf16x8*)(kp);      kf[1]=*(const __attribute__((address_space(3))) bf16x8*)(kp+512);
  kf[2]=*(const __attribute__((address_space(3))) bf16x8*)(kp+2048); kf[3]=*(const __attribute__((address_space(3))) bf16x8*)(kp+2560);
  kf[4]=*(const __attribute__((address_space(3))) bf16x8*)(kp+4096); kf[5]=*(const __attribute__((address_space(3))) bf16x8*)(kp+4608);
  kf[6]=*(const __attribute__((address_space(3))) bf16x8*)(kp+6144); kf[7]=*(const __attribute__((address_space(3))) bf16x8*)(kp+6656);
}
__device__ __forceinline__ void kload2(bf16x8*kf,lds_cptr kp,int j){ kf[2*j]=*(const __attribute__((address_space(3))) bf16x8*)(kp+j*2048); kf[2*j+1]=*(const __attribute__((address_space(3))) bf16x8*)(kp+j*2048+512); }
__device__ __forceinline__ s16x4 vtr(lds_cptr p){ return __builtin_bit_cast(s16x4,__builtin_amdgcn_ds_read_tr16_b64_v4i16((__attribute__((address_space(3))) v4i16_t*)p)); }
__device__ __forceinline__ float rowmax(const f32x16&p0,const f32x16&p1){
  float a=max3f(p0[0],p0[1],p1[0]),b=max3f(p0[2],p0[3],p1[1]);a=max3f(a,p1[2],p1[3]);
  #pragma unroll
  for(int r=4;r<16;r+=4){a=max3f(a,p0[r],p0[r+1]);b=max3f(b,p0[r+2],p0[r+3]);a=max3f(a,p1[r],p1[r+1]);b=max3f(b,p1[r+2],p1[r+3]);}
  const float m=max2f(a,b);
  auto rr=__builtin_amdgcn_permlane32_swap(__float_as_uint(m),__float_as_uint(m),false,false);
  return max2f(__uint_as_float(rr[0]),__uint_as_float(rr[1]));
}
__device__ __forceinline__ void pv(f32x16*o,int vb,bf16x8 pa0,bf16x8 pa1,bf16x8 pa2,bf16x8 pa3){
  #pragma unroll
  for(int d0=0;d0<2;++d0){s16x4 lo[4],hi[4];
    #pragma unroll
    for(int ks=0;ks<4;++ks){
      asm volatile("ds_read_b64_tr_b16 %0,%1 offset:%c2":"=&v"(lo[ks]):"v"(vb),"i"(d0*4096+ks*1024):"memory");
      asm volatile("ds_read_b64_tr_b16 %0,%1 offset:%c2":"=&v"(hi[ks]):"v"(vb),"i"(d0*4096+ks*1024+512):"memory");}
    asm volatile("s_waitcnt lgkmcnt(0)":::"memory");SBAR();
    #define PK(k) (bf16x8){lo[k][0],lo[k][1],lo[k][2],lo[k][3],hi[k][0],hi[k][1],hi[k][2],hi[k][3]}
    o[d0]=__builtin_amdgcn_mfma_f32_32x32x16_bf16(pa0,PK(0),o[d0],0,0,0);
    o[d0]=__builtin_amdgcn_mfma_f32_32x32x16_bf16(pa1,PK(1),o[d0],0,0,0);
    o[d0]=__builtin_amdgcn_mfma_f32_32x32x16_bf16(pa2,PK(2),o[d0],0,0,0);
    o[d0]=__builtin_amdgcn_mfma_f32_32x32x16_bf16(pa3,PK(3),o[d0],0,0,0);
    #undef PK
  }
}

#ifndef ATTN_STORE16
#define ATTN_STORE16(p,v) (*(u32x4*)(p)=(v))
#endif
template<int THRL> __device__ __forceinline__ void attn_unit(int b,int h,int qb,const bf16*Q,const bf16*__restrict__ K,const bf16*__restrict__ V,bf16*O,const float*__restrict__ Fc,const float*__restrict__ NRM,char*shm,int wid_in){
  const int wid=__builtin_amdgcn_readfirstlane(wid_in); int lane_=(int)__builtin_amdgcn_mbcnt_hi(~0u,__builtin_amdgcn_mbcnt_lo(~0u,0u)); asm volatile("":"+v"(lane_));
  const int lane=lane_,tid=wid*64+lane,r32=lane&31,hi=lane>>5;
  const long rowbase=(long)b*SEQ; const int q0=qb*QB;
  const float*Fbh=Fc+(long)(b*NHEAD+h)*SEQ;
  const int NTF=(q0+QB)/KVBLK; int t_start;
  { const float*QNb=NRM+(b*NHEAD+h)*128,*KNb=NRM+4096+(b*NHEAD+h)*128;
    const float qn=fmaxf(fmaxf(QNb[4*qb],QNb[4*qb+1]),fmaxf(QNb[4*qb+2],QNb[4*qb+3])),knb=fmaxf(fmaxf(KNb[4*qb],KNb[4*qb+1]),fmaxf(KNb[4*qb+2],KNb[4*qb+3]));
    const float fq0=Fbh[q0]*1.4426950408889634f; bool k0=true,k1=true;
    if(lane<NTF-4)k0=!(qn*(KNb[lane]+knb)+(fq0-Fbh[64*lane+63]*1.4426950408889634f)<-40.f);
    if(lane+64<NTF-4)k1=!(qn*(KNb[lane+64]+knb)+(fq0-Fbh[64*(lane+64)+63]*1.4426950408889634f)<-40.f);
    const unsigned long long m0=__ballot(k0),m1=__ballot(k1);
    int tf=m0?(int)__builtin_ctzll(m0):64+(m1?(int)__builtin_ctzll(m1):64);
    tf=tf<NTF-4?tf:NTF-4; t_start=__builtin_amdgcn_readfirstlane(tf&~1); }
  { typedef float f32x4_t __attribute__((ext_vector_type(4))); __attribute__((address_space(3))) float*fk=(__attribute__((address_space(3))) float*)((__attribute__((address_space(3))) char*)shm+LDS_FK); const int n4=(q0+QB)/4;
    for(int i=16*t_start+tid;i<n4;i+=NW*64){ f32x4_t v=*(const f32x4_t*)(Fbh+4*i); v=v*(-1.4426950408889634f); *(__attribute__((address_space(3))) f32x4_t*)(fk+4*i)=v; } }
  float fq2=Fbh[q0+wid*QBLK+r32]*1.4426950408889634f; asm volatile("":"+v"(fq2));
  const bf16*Qw=Q+(rowbase+q0+wid*QBLK)*DM+h*D;
  const bf16*Kh=K+(rowbase+(long)t_start*KVBLK)*DM+h*D,*Vh=V+(rowbase+(long)t_start*KVBLK)*DM+h*D;
  const lds_cptr shm3=(lds_cptr)shm;
  const unsigned lds0=(unsigned)(uintptr_t)shm;
  float*wsf=(float*)(shm+LDS_WS)+wid*64;
  const bf16*ksrc=Kh+(long)lane*DM+wid*8;
  const bf16*vsrc=Vh+(long)(16*(wid&3)+(lane>>2))*DM+(wid>>2)*32+(lane&3)*8;
  const unsigned kdst=lds0+LDS_K+wid*1024, vdst=lds0+LDS_V+wid*1024;
  #define DMA_K(t,slot) glds16(ksrc+(long)(t)*KVBLK*DM,(unsigned)__builtin_amdgcn_readfirstlane(kdst+(slot)))
  #define DMA_V(t,slot) glds16(vsrc+(long)(t)*KVBLK*DM,(unsigned)__builtin_amdgcn_readfirstlane(vdst+(slot)))
  const int vb0=(int)(lds0+LDS_V)+((lane>>4)&1)*32+(lane&3)*8+(4*hi+((lane&15)>>2))*64;
  const char*Kbase=shm+LDS_K; bf16x8 kf[8];
  const lds_cptr kp0=shm3+LDS_K+hi*1024+r32*16; const lds_cptr vp0=shm3+LDS_V+((lane>>4)&1)*32+(lane&3)*8+(4*hi+((lane&15)>>2))*64;
  const int NT=NTF-t_start;
  DMA_K(0,0);DMA_V(0,0);DMA_K(1,SLOTB);
  bf16x8 qr[4];
  #pragma unroll
  for(int d0=0;d0<4;++d0)qr[d0]=*reinterpret_cast<const bf16x8*>(&Qw[(long)r32*DM+d0*16+hi*8]);
  float mhat=0.f,l_reg=0.f;f32x16 o[2];o[0]=f32x16{};o[1]=f32x16{};
  const __attribute__((address_space(3))) float*fkl=(const __attribute__((address_space(3))) float*)(shm3+LDS_FK)+64*t_start+4*hi;
  #define INITC(C0,C1,t) do{ const float nsc_=fq2-mhat; typedef float f32x4_t __attribute__((ext_vector_type(4))); const __attribute__((address_space(3))) float*kb_=fkl+64*(t); \
    _Pragma("unroll") for(int g_=0;g_<4;++g_){ const f32x4_t a_=*(const __attribute__((address_space(3))) f32x4_t*)(kb_+8*g_), b_=*(const __attribute__((address_space(3))) f32x4_t*)(kb_+32+8*g_); \
      _Pragma("unroll") for(int e_=0;e_<4;++e_){ C0[4*g_+e_]=nsc_+a_[e_]; C1[4*g_+e_]=nsc_+b_[e_]; } } }while(0)
  const int qrel=wid*QBLK+r32;
  #define CMASK(P0,P1,t) do{int jb_=(t)-(NT-4); if(jb_>=0)cmask(P0,P1,jb_,qrel,hi);}while(0)
  bool resc=false;
  #define START(P0,P1) do{ const float rm=rowmax(P0,P1); resc=false; \
    { const float dl=rm; mhat=fadd_s(mhat,dl); \
      _Pragma("unroll") for(int r=0;r<16;++r){P0[r]=fsub_s(P0[r],dl);P1[r]=fsub_s(P1[r],dl);} \
      } \
    _Pragma("unroll") for(int r=0;r<16;++r)P0[r]=__builtin_amdgcn_exp2f(P0[r]); }while(0)
  #define RESC() do{ if(resc){ asm volatile("s_waitcnt lgkmcnt(0)":::"memory"); \
      _Pragma("unroll") for(int d_=0;d_<2;++d_) _Pragma("unroll") for(int r=0;r<16;++r)o[d_][r]*=wsf[crow(r,hi)]; } }while(0)
  f32x16 pA0,pA1,pB0,pB1;
  int sl_prev=0,sl_cur=0,sl_next=SLOTB;
  #define ROT() do{sl_prev=sl_cur;sl_cur=sl_next;sl_next=(sl_next==(NSLOT-1)*SLOTB)?0:sl_next+SLOTB;}while(0)
  DMA_K(2,2*SLOTB);
  WAIT_BAR(3);
  INITC(pA0,pA1,0); qkt(pA0,pA1,Kbase,qr,r32,hi);asm volatile("s_nop 15\n\ts_nop 7":"+v"(pA0),"+v"(pA1));CMASK(pA0,pA1,0);
  START(pA0,pA1);
  _Pragma("unroll") for(int r=0;r<16;++r)pA1[r]=__builtin_amdgcn_exp2f(pA1[r]);
  WAIT_BAR(0);
  DMA_K(3,0);DMA_V(1,SLOTB);
  ROT();
  kload8(kf,kp0+sl_cur);
  WAIT_BAR(2);
  s16x4 vlo[8],vhi[8]; u32x4 pw0,pw1,pw2,pw3;
  #define PKW(P,B) cvtpk_s(P[B],P[B+1])
  #define PAF(k) __builtin_bit_cast(bf16x8,pw##k)
  #define VFR(i) (bf16x8){vlo[i][0],vlo[i][1],vlo[i][2],vlo[i][3],vhi[i][0],vhi[i][1],vhi[i][2],vhi[i][3]}
  #define PIN(x) asm volatile("":"+v"(x))
  #define MX3(a,b,c) __builtin_fmaxf(__builtin_fmaxf((a),(b)),(c))
  #define GAPA(MF,A0,A1,A2,A3,W0,W1,PW) do{ MF; sacc+=A0; sacc+=A1; sacc+=A2; sacc+=A3; PIN(sacc); W0; W1; PIN(PW); SBAR(); }while(0)
  #define EX(v) __builtin_amdgcn_exp2f(v)
  #define GAPB(MF,X,B) do{ MF; X[B]=EX(X[B]); X[B+1]=EX(X[B+1]); X[B+2]=EX(X[B+2]); X[B+3]=EX(X[B+3]); PIN(X); SBAR(); }while(0)
  #define VRD(i) do{ vlo[i]=vtr(vp_+(((i)>>2)*4096+((i)&3)*1024)); vhi[i]=vtr(vp_+(((i)>>2)*4096+((i)&3)*1024+512)); }while(0)
  #define KRD(G,j) do{ if(G){ kload2(kf,kp0+sl_next,j); SBAR(); } }while(0)
  #define STEP(C0,C1,P0,P1,t,GK,GV,GL) do{ SBAR(); INITC(C0,C1,t); PIN(C0); PIN(C1); SBAR(); \
    const lds_cptr vp_=vp0+sl_prev; \
    VRD(0); SBAR(); float sacc=(P0[0]+P0[1]); \
    GAPA(C0=__builtin_amdgcn_mfma_f32_32x32x16_bf16(kf[0],qr[0],C0,0,0,0), P0[2],P0[3],P0[4],P0[5],     pw0[0]=PKW(P0,0), pw0[1]=PKW(P0,2), pw0); \
    VRD(4); SBAR(); GAPA(C1=__builtin_amdgcn_mfma_f32_32x32x16_bf16(kf[1],qr[0],C1,0,0,0), P0[6],P0[7],P0[8],P0[9],     pw0[2]=PKW(P0,4), pw0[3]=PKW(P0,6), pw0); \
    VRD(1); SBAR(); GAPA(C0=__builtin_amdgcn_mfma_f32_32x32x16_bf16(kf[2],qr[1],C0,0,0,0),   P0[10],P0[11],P0[12],P0[13], pw1[0]=PKW(P0,8), pw1[1]=PKW(P0,10), pw1); \
    VRD(5); SBAR(); GAPA(C1=__builtin_amdgcn_mfma_f32_32x32x16_bf16(kf[3],qr[1],C1,0,0,0),   P0[14],P0[15],P1[0],P1[1],   pw1[2]=PKW(P0,12),pw1[3]=PKW(P0,14), pw1); \
    VRD(2); SBAR(); GAPA(C0=__builtin_amdgcn_mfma_f32_32x32x16_bf16(kf[4],qr[2],C0,0,0,0),   P1[2],P1[3],P1[4],P1[5],     pw2[0]=PKW(P1,0), pw2[1]=PKW(P1,2), pw2); \
    VRD(6); SBAR(); GAPA(C1=__builtin_amdgcn_mfma_f32_32x32x16_bf16(kf[5],qr[2],C1,0,0,0),   P1[6],P1[7],P1[8],P1[9],     pw2[2]=PKW(P1,4), pw2[3]=PKW(P1,6), pw2); \
    VRD(3); SBAR(); GAPA(C0=__builtin_amdgcn_mfma_f32_32x32x16_bf16(kf[6],qr[3],C0,0,0,0),   P1[10],P1[11],P1[12],P1[13], pw3[0]=PKW(P1,8), pw3[1]=PKW(P1,10), pw3); \
    VRD(7); SBAR(); GAPA(C1=__builtin_amdgcn_mfma_f32_32x32x16_bf16(kf[7],qr[3],C1,0,0,0),   P1[14],P1[15],0.f,0.f,       pw3[2]=PKW(P1,12),pw3[3]=PKW(P1,14), pw3); \
    l_reg+=sacc; \
    if(GK){DMA_K((t)+3,sl_cur);} if(GV){DMA_V((t)+1,sl_next);} \
    CMASK(C0,C1,t); \
    { float a=MX3(C0[0],C0[1],C1[0]),b=MX3(C0[2],C0[3],C1[1]); a=MX3(a,C1[2],C1[3]); \
      _Pragma("unroll") for(int r=4;r<16;r+=4){a=MX3(a,C0[r],C0[r+1]);b=MX3(b,C0[r+2],C0[r+3]);a=MX3(a,C1[r],C1[r+1]);b=MX3(b,C1[r+2],C1[r+3]);} \
      float rm=__builtin_fmaxf(a,b); { auto rr=__builtin_amdgcn_permlane32_swap(__float_as_uint(rm),__float_as_uint(rm),false,false); rm=__builtin_fmaxf(__uint_as_float(rr[0]),__uint_as_float(rr[1])); } \
      resc=false; \
      if(__builtin_expect(__any(rm>(float)THRL),0)){ const float dl=__builtin_fmaxf(rm,0.f); mhat+=dl; \
        _Pragma("unroll") for(int r=0;r<16;++r){C0[r]-=dl;C1[r]-=dl;} \
        const float f=__builtin_amdgcn_exp2f(-dl); l_reg*=f; if(hi==0)wsf[r32]=f; resc=true; } } \
    SBAR(); \
    GAPB(o[0]=__builtin_amdgcn_mfma_f32_32x32x16_bf16(PAF(0),VFR(0),o[0],0,0,0), C0,0); \
    GAPB(o[1]=__builtin_amdgcn_mfma_f32_32x32x16_bf16(PAF(0),VFR(4),o[1],0,0,0), C0,4); \
    KRD(GL,0); GAPB(o[0]=__builtin_amdgcn_mfma_f32_32x32x16_bf16(PAF(1),VFR(1),o[0],0,0,0), C0,8); \
    KRD(GL,1); GAPB(o[1]=__builtin_amdgcn_mfma_f32_32x32x16_bf16(PAF(1),VFR(5),o[1],0,0,0), C0,12); \
    KRD(GL,2); GAPB(o[0]=__builtin_amdgcn_mfma_f32_32x32x16_bf16(PAF(2),VFR(2),o[0],0,0,0), C1,0); \
    KRD(GL,3); GAPB(o[1]=__builtin_amdgcn_mfma_f32_32x32x16_bf16(PAF(2),VFR(6),o[1],0,0,0), C1,4); \
    GAPB(o[0]=__builtin_amdgcn_mfma_f32_32x32x16_bf16(PAF(3),VFR(3),o[0],0,0,0), C1,8); \
    GAPB(o[1]=__builtin_amdgcn_mfma_f32_32x32x16_bf16(PAF(3),VFR(7),o[1],0,0,0), C1,12); \
    }while(0)
  int t=1;
  #undef CMASK
  #define CMASK(P0,P1,t) do{}while(0)
  for(;t+5<NT;t+=2){
    STEP(pB0,pB1,pA0,pA1,t,true,true,true);     WAIT_BAR(2); RESC(); ROT();
    STEP(pA0,pA1,pB0,pB1,t+1,true,true,true);   WAIT_BAR(2); RESC(); ROT();
  }
  #undef CMASK
  #define CMASK(P0,P1,t) do{int jb_=(t)-(NT-4); if(jb_>=0)cmask(P0,P1,jb_,qrel,hi);}while(0)
  #define ENDW(tt) do{ if((tt)+3<NT){WAIT_BAR(2);} else if((tt)+2<NT){WAIT_BAR(1);} else {WAIT_BAR(0);} }while(0)
  for(;t+1<NT;t+=2){
    STEP(pB0,pB1,pA0,pA1,t,(t+3<NT),(t+1<NT),(t+1<NT));       ENDW(t);   RESC(); ROT();
    STEP(pA0,pA1,pB0,pB1,t+1,(t+4<NT),(t+2<NT),(t+2<NT));     ENDW(t+1); RESC(); ROT();
  }
  STEP(pB0,pB1,pA0,pA1,NT-1,false,false,false); RESC();
  { float sacc=pB0[0]+pB0[1]; _Pragma("unroll") for(int r=2;r<16;++r)sacc+=pB0[r]; _Pragma("unroll") for(int r=0;r<16;++r)sacc+=pB1[r]; l_reg+=sacc;
    pw0=(u32x4){PKW(pB0,0),PKW(pB0,2),PKW(pB0,4),PKW(pB0,6)};pw1=(u32x4){PKW(pB0,8),PKW(pB0,10),PKW(pB0,12),PKW(pB0,14)};pw2=(u32x4){PKW(pB1,0),PKW(pB1,2),PKW(pB1,4),PKW(pB1,6)};pw3=(u32x4){PKW(pB1,8),PKW(pB1,10),PKW(pB1,12),PKW(pB1,14)};
    SBAR(); pv(o,vb0+sl_cur,PAF(0),PAF(1),PAF(2),PAF(3)); }
  #undef PKW
  #undef PAF
  #undef VFR
  #undef PIN
  #undef MX3
  #undef GAPA
  #undef GAPB
  #undef EX
  #undef VRD
  #undef KRD
  #undef STEP
  #undef ENDW
  {auto rr=__builtin_amdgcn_permlane32_swap(__float_as_uint(l_reg),__float_as_uint(l_reg),false,false);l_reg=__uint_as_float(rr[0])+__uint_as_float(rr[1]);}
  if(hi==0)wsf[32+r32]=l_reg;asm volatile("s_waitcnt lgkmcnt(0)":::"memory");
  float rli[16];
  #pragma unroll
  for(int r=0;r<16;++r)rli[r]=__builtin_amdgcn_rcpf(wsf[32+crow(r,hi)]);
  bf16*Ow=O+(rowbase+q0+wid*QBLK)*DM+h*D;
  { bf16*stg=(bf16*)(shm+LDS_OST)+wid*2048;
    #pragma unroll
    for(int r=0;r<16;++r){const int orow=crow(r,hi);
      #pragma unroll
      for(int d0=0;d0<2;++d0)stg[orow*64+d0*32+r32]=__float2bfloat16(o[d0][r]*rli[r]);}
    asm volatile("s_waitcnt lgkmcnt(0)":::"memory");
    #pragma unroll
    for(int i=0;i<4;++i){const int row=i*8+(lane>>3),ch=lane&7; const u32x4 v=*(const u32x4*)(stg+row*64+ch*8); ATTN_STORE16(Ow+(long)row*DM+ch*8,v);} }
  asm volatile("s_waitcnt lgkmcnt(0)\n\ts_barrier":::"memory");
  #undef DMA_K
  #undef DMA_V
  #undef INITC
  #undef CMASK
  #undef START
  #undef RESC
  #undef ROT
}
constexpr int ATTN_LDS_BYTES=LDS_BYTES;
struct AttnTensors { const bf16* Q; const bf16* K; const bf16* V; bf16* O; const float* F; const float* NRM; };
struct AttnUnit { int bh; int qb; };
struct StaticOrder {
  int vcu;
  __device__ __forceinline__ explicit StaticOrder(int grid,int block):vcu((block%8)*(grid/8)+block/8){}
  __device__ __forceinline__ bool next(int i,AttnUnit&u)const{ if(i>=4)return false; const int s=vcu&7; u.bh=vcu>>3; u.qb=(i==0)?s:(i==1)?15-s:(i==2)?16+s:31-s; return true; }
  __device__ __forceinline__ void a_ready(const AttnUnit&)const{}
  __device__ __forceinline__ void done(const AttnUnit&)const{}
};
template<int THRL=8> __device__ __forceinline__ void attn_phase(char*lds,const AttnTensors&T,unsigned*qctr,volatile __attribute__((address_space(3))) unsigned*qword,int wid_in){
  const int lane0=(int)__builtin_amdgcn_mbcnt_hi(~0u,__builtin_amdgcn_mbcnt_lo(~0u,0u));
  for(;;){
    if(wid_in==0&&lane0==0){ const unsigned n=__hip_atomic_fetch_add(qctr,1u,__ATOMIC_RELAXED,__HIP_MEMORY_SCOPE_AGENT); *qword=n; }
    asm volatile("s_waitcnt vmcnt(0) lgkmcnt(0)\n\ts_barrier":::"memory");
    const int n=__builtin_amdgcn_readfirstlane((int)*qword);
    if(n>=BATCH*NHEAD*NQB)break;
    const int bh=n%(BATCH*NHEAD),qb=NQB-1-n/(BATCH*NHEAD);
    attn_unit<THRL>(bh/NHEAD,bh%NHEAD,qb,T.Q,T.K,T.V,T.O,T.F,T.NRM,lds,wid_in);
  }
}
#undef SBAR
#undef WAIT_BAR
}
#define GAS __attribute__((address_space(1)))
#define LAS __attribute__((address_space(3)))
typedef unsigned short bf16;
typedef unsigned v4u __attribute__((ext_vector_type(4)));
typedef float f32x4 __attribute__((ext_vector_type(4)));
typedef short bf16x8 __attribute__((ext_vector_type(8)));
typedef GAS unsigned gu32;
typedef GAS unsigned long long gu64;
#define RLX_AGENT __ATOMIC_RELAXED, __HIP_MEMORY_SCOPE_AGENT
#define LDS_WAIT() asm volatile("s_waitcnt lgkmcnt(0)" ::: "memory")
#define VM_WAIT() asm volatile("s_waitcnt vmcnt(0)" ::: "memory")
__device__ __forceinline__ unsigned long long rt() { return __builtin_amdgcn_s_memrealtime(); }
__device__ __forceinline__ unsigned f2bf(float f) { unsigned u = __builtin_bit_cast(unsigned, f); return (u + 0x7fffu + ((u >> 16) & 1u)) >> 16; }
__device__ __forceinline__ unsigned pk2(float lo, float hi) { return f2bf(lo) | (f2bf(hi) << 16); }

#define XB_TMO      128
#define XB_XCNT(j)  (256  + 64 * (j))
#define XB_XSUB(j)  (1280 + 64 * (j))
#define XB_XGEN(j)  (2304 + 64 * (j))
#define XB_TOP      3328
#define XB_TOPGEN   3392
#define XCD_BAR_WORDS 3456
#define XB_SPIN_CAP (1u << 18)

__device__ __forceinline__ unsigned xb_ld(unsigned* p)              { return __hip_atomic_load(p, __ATOMIC_RELAXED, __HIP_MEMORY_SCOPE_AGENT); }
__device__ __forceinline__ unsigned xb_add(unsigned* p, unsigned v) { return __hip_atomic_fetch_add(p, v, __ATOMIC_RELAXED, __HIP_MEMORY_SCOPE_AGENT); }
__device__ __forceinline__ unsigned xb_xcc_id() { return (unsigned)__builtin_amdgcn_s_getreg((3 << 11) | 20) & 0xFu; }
#define XB_SPIN(cond, bar) do { unsigned _sp = 0; while (cond) { __builtin_amdgcn_s_sleep(1); \
    if ((++_sp & 255u) == 0u) { if (xb_ld(&(bar)[XB_TMO])) break; if (_sp > XB_SPIN_CAP) { atomicAdd(&(bar)[XB_TMO], 1u); break; } } } } while (0)

struct XcdBarrier {
    unsigned* bar; unsigned x; int wv;
    volatile LAS unsigned* st;
};

__device__ __forceinline__ bool xb_t0(int wv) { return wv == 0 && __builtin_amdgcn_mbcnt_hi(~0u, __builtin_amdgcn_mbcnt_lo(~0u, 0u)) == 0u; }
__device__ __forceinline__ XcdBarrier xcd_barrier_post(unsigned* bar, volatile LAS unsigned* st, int wv) {
    XcdBarrier b; b.bar = bar; b.x = xb_xcc_id(); b.st = st; b.wv = wv;
    if (xb_t0(wv)) (void)xb_add(&bar[XB_XCNT(b.x)], 1u);
    return b;
}
__device__ __forceinline__ void xcd_barrier_complete(unsigned* bar, unsigned x, unsigned& nloc, unsigned& nx) {
    const unsigned G = gridDim.x * gridDim.y * gridDim.z;
    unsigned sum, cnt, mine, sp = 0u;
    for (;;) {
        sum = 0u; cnt = 0u; mine = 0u;
#pragma unroll
        for (unsigned j = 0; j < 16; ++j) { const unsigned c = xb_ld(&bar[XB_XCNT(j)]); sum += c; cnt += (c > 0u) ? 1u : 0u; mine = (j == x) ? c : mine; }
        if (sum == G) break;
        __builtin_amdgcn_s_sleep(1);
        if ((++sp & 255u) == 0u) { if (xb_ld(&bar[XB_TMO])) break; if (sp > XB_SPIN_CAP) { atomicAdd(&bar[XB_TMO], 1u); break; } }
    }
    nloc = mine > 0u ? mine : 1u; nx = cnt > 0u ? cnt : 1u;
}

__device__ __forceinline__ void xcd_barrier(const XcdBarrier& b) {
    asm volatile("s_waitcnt vmcnt(0)" ::: "memory");
    __syncthreads();
    if (xb_t0(b.wv)) {
        unsigned* bar = b.bar;
        __builtin_amdgcn_s_waitcnt(0);
        unsigned nloc = b.st[0], nx = b.st[1];
        if (nloc == 0u) { xcd_barrier_complete(bar, b.x, nloc, nx); b.st[0] = nloc; b.st[1] = nx; }
        const unsigned old = xb_add(&bar[XB_XSUB(b.x)], 1u);
        const unsigned gen = old / nloc;
        if (old + 1u == (gen + 1u) * nloc) {
            __builtin_amdgcn_fence(__ATOMIC_RELEASE, "agent");
            asm volatile("s_waitcnt vmcnt(0)" ::: "memory");
            const unsigned og = xb_add(&bar[XB_TOP], 1u);
            const unsigned tg = og / nx;
            if (og + 1u == (tg + 1u) * nx) xb_add(&bar[XB_TOPGEN], 1u);
            else XB_SPIN(xb_ld(&bar[XB_TOPGEN]) == tg, bar);
            __builtin_amdgcn_fence(__ATOMIC_ACQUIRE, "agent");
            xb_add(&bar[XB_XGEN(b.x)], 1u);
            asm volatile("s_waitcnt vmcnt(0)" ::: "memory");
        } else {
            XB_SPIN(xb_ld(&bar[XB_XGEN(b.x)]) == gen, bar);
            __builtin_amdgcn_fence(__ATOMIC_ACQUIRE, "agent");
            asm volatile("s_waitcnt vmcnt(0)" ::: "memory");
        }
    }
    __syncthreads();
}

constexpr int NWAVES = 8;
constexpr int RING_OFF = 0, RING_BYTES = 131072;
constexpr int LDSCTL_OFF = RING_BYTES, MISC_OFF = LDSCTL_OFF + 320;
constexpr int LDS_BYTES = 147456;
constexpr int N_PHASES = 8;

struct Frame {
    LAS unsigned char* lds;
    volatile LAS unsigned* MISC;
    gu32* ctl;
    int tid, lane, wave, vcu, G;
};
__device__ __forceinline__ float wave_sum(float v) {
#pragma unroll
    for (int o = 1; o < 64; o <<= 1) v += __shfl_xor(v, o);
    return v;
}
struct Args { const float* in[20]; float* out; unsigned char* ws; int ph_lo, ph_hi, li, pad; };

__device__ __forceinline__ void p0_transpose_item(const float* W, int ld, int nblk, const float* glo, const float* ghi, int K, bf16* WT, LAS float* scr, int item, int lane) {
    const int kb = item / nblk, nb = item % nblk, k0 = 64 * kb, n0 = 32 * nb;
#pragma unroll 8
    for (int i = 0; i < 32; ++i) { const int kk = 2 * i + (lane >> 5), k = k0 + kk; float w = W[(size_t)k * ld + n0 + (lane & 31)];
        if (glo) w *= (k < K / 2) ? glo[k] : ghi[k - K / 2];
        scr[kk * 33 + (lane & 31)] = w; }
    LDS_WAIT(); asm volatile("" ::: "memory");
    const int c = lane & 7;
#pragma unroll
    for (int j = 0; j < 4; ++j) { const int n = (lane >> 3) + 8 * j; const LAS float* s = scr + (8 * c) * 33 + n;
        v4u o; o.x = pk2(s[0 * 33], s[1 * 33]); o.y = pk2(s[2 * 33], s[3 * 33]); o.z = pk2(s[4 * 33], s[5 * 33]); o.w = pk2(s[6 * 33], s[7 * 33]);
        *(GAS v4u*)(WT + (size_t)(n0 + n) * K + k0 + 8 * c) = o; }
    LDS_WAIT(); asm volatile("" ::: "memory");
}
__device__ __forceinline__ float log_sigmoid(float z) { return fminf(z, 0.f) - log1pf(expf(-fabsf(z))); }

__device__ __forceinline__ void p0_prologue(Frame& F, const Args& a) {
    LAS float* scr = (LAS float*)(F.lds + RING_OFF + F.wave * 16384);
    unsigned char* ws = a.ws;
    const float* x = a.in[0]; const float* g1 = a.in[1]; const float* w_in = a.in[2]; const float* bfv = a.in[10];
    const float* gn_l = a.in[11]; const float* gn_f = a.in[12]; const float* w_out = a.in[13]; const float* g2 = a.in[14];
    const float* w_q = a.in[15]; const float* sk = a.in[16]; const float* pu = a.in[17]; const float* pv = a.in[18];
    bf16* win_t = (bf16*)(ws + WS_WIN); bf16* wout_t = (bf16*)(ws + WS_WOUT); bf16* wq_t = (bf16*)(ws + WS_WQ); bf16* skb = (bf16*)(ws + WS_SKB); float* wfl = (float*)(ws + WS_WFL);
    float* logf = (float*)(ws + WS_LOGF); float* sumsq = (float*)(ws + WS_SUMSQ); bf16* h = (bf16*)(ws + WS_H);
    const int gw = F.vcu * NWAVES + F.wave, NGW = F.G * NWAVES, lane = F.lane;
    constexpr int I_IN = (DMODEL / 64) * (NG1 / 32), I_OUT = (DMODEL / 64) * (DMODEL / 32), I_Q = (DMODEL / 64) * (QPW / 32);
    constexpr int I_FL = 8 * DMODEL / 64, I_SK = PH * 2 * NKEY * PHALF / 512, I_SS = T / 64, I_WAX = 8 * 2 * 2 * 4;
    constexpr int E0 = I_IN, E1 = E0 + I_OUT, E2 = E1 + I_Q, E3 = E2 + I_FL, E4 = E3 + I_SK, E5 = E4 + I_SS, E6 = E5 + I_WAX;
    for (int it = gw; it < E6; it += NGW) {
        if (it < E0) { p0_transpose_item(w_in, INC, NG1 / 32, nullptr, nullptr, DMODEL, win_t, scr, it, lane); continue; }
        if (it < E1) { p0_transpose_item(w_out, DMODEL, DMODEL / 32, gn_l, gn_f, DMODEL, wout_t, scr, it - E0, lane); continue; }
        if (it < E2) { p0_transpose_item(w_q, QPW, QPW / 32, g2, g2 + DMODEL / 2, DMODEL, wq_t, scr, it - E1, lane); continue; }
        if (it < E3) { const int i = (it - E2) * 64 + lane, j = i / DMODEL, k = i % DMODEL; wfl[i] = w_in[(size_t)k * INC + NG1 + j]; continue; }
        if (it < E4) { const size_t i = (size_t)(it - E3) * 512 + lane * 8; const f32x4 s0 = *(const GAS f32x4*)(sk + i), s1 = *(const GAS f32x4*)(sk + i + 4);
            v4u o; o.x = pk2(s0[0], s0[1]); o.y = pk2(s0[2], s0[3]); o.z = pk2(s1[0], s1[1]); o.w = pk2(s1[2], s1[3]); *(GAS v4u*)(skb + i) = o; continue; }
        if (it < E5) { sumsq[(it - E4) * 64 + lane] = 0.f; continue; }
        { const int f = it - E5, ks = f & 3, n = (f >> 2) & 1, mat = (f >> 3) & 1, hh = f >> 4; const float* wsrc = mat ? a.in[7] : a.in[5];
          const size_t o = ((size_t)(hh * 64 + 16 * ks + 8 * (lane >> 5))) * 64 + 32 * n + (lane & 31);
          v4u pw; pw.x = pk2(wsrc[o], wsrc[o + 64]); pw.y = pk2(wsrc[o + 128], wsrc[o + 192]); pw.z = pk2(wsrc[o + 256], wsrc[o + 320]); pw.w = pk2(wsrc[o + 384], wsrc[o + 448]);
          *(GAS v4u*)((bf16*)(ws + WS_WAX) + (size_t)f * 512 + lane * 8) = pw; }
    }
    { f32x4 gg[4];
#pragma unroll
      for (int j = 0; j < 4; ++j) gg[j] = *(const GAS f32x4*)(g2 + 16 * lane + 4 * j);
      unsigned char* u4 = ws + WS_U8; unsigned char* v4 = ws + WS_V8; float* su = (float*)(ws + WS_SU);
      for (int e = gw; e < NEXP; e += NGW) {
        const GAS f32x4* ur = (const GAS f32x4*)(pu + (size_t)e * DMODEL + 16 * lane); const GAS f32x4* vr = (const GAS f32x4*)(pv + (size_t)e * DMODEL + 16 * lane);
        f32x4 uu[4], vv[4]; float mu = 0.f, mv = 0.f;
#pragma unroll
        for (int j = 0; j < 4; ++j) { uu[j] = ur[j] * gg[j]; vv[j] = vr[j];
#pragma unroll
            for (int c = 0; c < 4; ++c) { mu = fmaxf(mu, fabsf(uu[j][c])); mv = fmaxf(mv, fabsf(vv[j][c])); } }
#pragma unroll
        for (int o = 1; o < 64; o <<= 1) { mu = fmaxf(mu, __shfl_xor(mu, o)); mv = fmaxf(mv, __shfl_xor(mv, o)); }
        const float scu = mu > 0.f ? mu * (1.f / 6.f) : 1.f, scv = mv > 0.f ? mv * (1.f / 6.f) : 1.f, iu = 1.f / scu, iv = 1.f / scv;
        unsigned qu0 = 0u, qu1 = 0u, qv0 = 0u, qv1 = 0u;
#define P0_Q4(Q, X, INV, B0, B1) do { Q = __builtin_amdgcn_cvt_scalef32_pk_fp4_f32(Q, X[0] * INV, X[1] * INV, 1.0f, B0); Q = __builtin_amdgcn_cvt_scalef32_pk_fp4_f32(Q, X[2] * INV, X[3] * INV, 1.0f, B1); } while (0)
        P0_Q4(qu0, uu[0], iu, 0, 1); P0_Q4(qu0, uu[1], iu, 2, 3); P0_Q4(qu1, uu[2], iu, 0, 1); P0_Q4(qu1, uu[3], iu, 2, 3);
        P0_Q4(qv0, vv[0], iv, 0, 1); P0_Q4(qv0, vv[1], iv, 2, 3); P0_Q4(qv1, vv[2], iv, 0, 1); P0_Q4(qv1, vv[3], iv, 2, 3);
#undef P0_Q4
        *(GAS unsigned long long*)(u4 + (size_t)e * 512 + 8 * lane) = (unsigned long long)qu0 | ((unsigned long long)qu1 << 32);
        *(GAS unsigned long long*)(v4 + (size_t)e * 512 + 8 * lane) = (unsigned long long)qv0 | ((unsigned long long)qv1 << 32);
        if (lane == 0) { su[2 * e] = scu; su[2 * e + 1] = scv; }
      } }
    { f32x4 gg[4];
#pragma unroll
      for (int j = 0; j < 4; ++j) gg[j] = *(const GAS f32x4*)(g1 + 256 * j + 4 * lane);
      float fw[4][4][8];
#pragma unroll
      for (int j = 0; j < 4; ++j)
#pragma unroll
          for (int c = 0; c < 4; ++c) { const int k = 256 * j + 4 * lane + c; const GAS f32x4* wr = (const GAS f32x4*)(w_in + (size_t)k * INC + NG1); const f32x4 w0 = wr[0], w1 = wr[1];
#pragma unroll
              for (int e = 0; e < 4; ++e) { fw[j][c][e] = w0[e]; fw[j][c][4 + e] = w1[e]; } }
      for (int t = gw; t < T; t += NGW) {
        const GAS f32x4* xr = (const GAS f32x4*)(x + (size_t)t * DMODEL) + lane;
        f32x4 v[4]; float ss = 0.f;
#pragma unroll
        for (int j = 0; j < 4; ++j) { v[j] = xr[64 * j]; ss += (v[j][0] * v[j][0] + v[j][1] * v[j][1]) + (v[j][2] * v[j][2] + v[j][3] * v[j][3]); }
        const float rstd = rsqrtf(wave_sum(ss) * (1.f / DMODEL) + RMS_EPS);
        GAS unsigned long long* ho = (GAS unsigned long long*)(h + (size_t)t * DMODEL) + lane;
#pragma unroll
        for (int j = 0; j < 4; ++j) { v[j] = v[j] * rstd * gg[j]; ho[64 * j] = (unsigned long long)pk2(v[j][0], v[j][1]) | ((unsigned long long)pk2(v[j][2], v[j][3]) << 32); }
        float fl[8];
#pragma unroll
        for (int hh = 0; hh < 8; ++hh) fl[hh] = 0.f;
#pragma unroll
        for (int j = 0; j < 4; ++j)
#pragma unroll
            for (int c = 0; c < 4; ++c) {
#pragma unroll
                for (int hh = 0; hh < 8; ++hh) fl[hh] += v[j][c] * fw[j][c][hh]; }
        float res = 0.f;
#pragma unroll
        for (int hh = 0; hh < 8; ++hh) { const float s = wave_sum(fl[hh]); if (lane == hh) res = s; }
        if (lane < 8) logf[(size_t)t * 8 + lane] = log_sigmoid(res + bfv[lane]);
      } }
}

__device__ __forceinline__ void fcum_unit(Frame& F, int bh, const float* logf, float* fcum) {
    const int b = bh / NHEADS, hh = bh % NHEADS, s0 = F.tid * 16;
    float v[16]; float loc = 0.f;
#pragma unroll
    for (int i = 0; i < 16; ++i) { v[i] = logf[((size_t)b * SEQ + s0 + i) * 8 + hh]; loc += v[i]; }
    float inc = loc;
#pragma unroll
    for (int o = 1; o < 64; o <<= 1) { const float n = __shfl_up(inc, o); if (F.lane >= o) inc += n; }
    if (F.lane == 63) F.MISC[16 + F.wave] = __float_as_uint(inc);
    __syncthreads();
    float run = inc - loc;
    for (int w = 0; w < F.wave; ++w) run += __uint_as_float(F.MISC[16 + w]);
#pragma unroll
    for (int i = 0; i < 16; ++i) { run += v[i]; fcum[(size_t)bh * SEQ + s0 + i] = run; }
    __syncthreads();
}


namespace peer {
typedef unsigned u32;
typedef float f32x16 __attribute__((ext_vector_type(16)));
constexpr int TOK = 128;
constexpr int EX_STRIDE = 136, GT_STRIDE = 132;
constexpr int L_EX = 0, L_GT = L_EX + TOK * EX_STRIDE * 2, L_IDX = L_GT + TOK * GT_STRIDE * 4, IDX_STRIDE = 36, L_RST = L_IDX + 512 * IDX_STRIDE, L_END = L_RST + TOK * 4;
static_assert(L_END <= RING_BYTES && L_GT % 16 == 0 && L_IDX % 16 == 0, "PEER LDS map");
__device__ __forceinline__ u32 ordmap(float f) { const u32 u = __float_as_uint(f); return u ^ ((u32)((int)u >> 31) | 0x80000000u); }
__device__ __forceinline__ float unordmap(u32 k) { const u32 u = (k & 0x80000000u) ? (k ^ 0x80000000u) : ~k; return __uint_as_float(u); }
__device__ __forceinline__ u32 umin_(u32 a, u32 b) { return a < b ? a : b; }
__device__ __forceinline__ u32 umax_(u32 a, u32 b) { return a > b ? a : b; }
template <bool DESC> __device__ __forceinline__ void sort16(u32 (&k)[16]) {
#pragma unroll
    for (int size = 2; size <= 16; size <<= 1)
#pragma unroll
        for (int stride = size >> 1; stride > 0; stride >>= 1)
#pragma unroll
            for (int i = 0; i < 16; ++i) { const int j = i ^ stride;
                if (j > i) { const bool asc = (((i & size) == 0) != DESC); const u32 a = k[i], b = k[j], lo = umin_(a, b), hi = umax_(a, b); k[i] = asc ? lo : hi; k[j] = asc ? hi : lo; } }
}
template <bool DESC> __device__ __forceinline__ void merge16(u32 (&k)[16]) {
#pragma unroll
    for (int stride = 8; stride > 0; stride >>= 1)
#pragma unroll
        for (int i = 0; i < 16; ++i) { const int j = i ^ stride;
            if (j > i) { const u32 a = k[i], b = k[j], lo = umin_(a, b), hi = umax_(a, b); k[i] = DESC ? hi : lo; k[j] = DESC ? lo : hi; } }
}
__host__ __device__ constexpr int ccnt(int a) { return 16 / (a + 1); }
__host__ __device__ constexpr int cbase(int a) { int s = 0; for (int i = 0; i < a; ++i) s += ccnt(i); return s; }
static_assert(cbase(16) == 50, "hyperbola candidate count");
__device__ __forceinline__ int crow16(int r) { return (r & 3) + 8 * (r >> 2); }

__device__ __forceinline__ void route_tile(Frame& F, const bf16* qp, const bf16* skb, const float* sumsq, int t0) {
    int lane = F.lane; asm volatile("" : "+v"(lane));
    const int r32 = lane & 31, hi = lane >> 5, w = F.wave;
    LAS unsigned short* EXL = (LAS unsigned short*)(F.lds + RING_OFF + L_EX);
    LAS float* GTL = (LAS float*)(F.lds + RING_OFF + L_GT);
    LAS unsigned char* IDXB = F.lds + RING_OFF + L_IDX + (w * 64 + lane) * IDX_STRIDE;
    LAS float* RST = (LAS float*)(F.lds + RING_OFF + L_RST);
    for (int g = 0; g < 4; ++g) {
        const int tok = 32 * g + r32; const size_t trow = (size_t)(t0 + tok);
        const float rstd2 = rsqrtf(sumsq[trow] * (1.f / DMODEL) + RMS_EPS);
        if (w == 0 && hi == 0) RST[tok] = rstd2;
        u32 s0[16], s1[16];
#pragma unroll
        for (int p = 0; p < 2; ++p) {
            bf16x8 qf[8];
#pragma unroll
            for (int ks = 0; ks < 8; ++ks) qf[ks] = *(const GAS bf16x8*)(qp + trow * QPW + w * 256 + p * 128 + ks * 16 + hi * 8);
            u32 run[16];
#pragma unroll
            for (int nb = 0; nb < 4; ++nb) {
                f32x16 acc = {};
                const bf16* kr = skb + ((size_t)((w * 2 + p) * NKEY + 32 * nb + r32)) * PHALF + hi * 8;
#pragma unroll
                for (int ks = 0; ks < 8; ++ks) acc = __builtin_amdgcn_mfma_f32_32x32x16_bf16(*(const GAS bf16x8*)(kr + ks * 16), qf[ks], acc, 0, 0, 0);
                asm volatile("" ::: "memory");
                u32 blk[16];
#pragma unroll
                for (int r = 0; r < 16; ++r) blk[r] = (ordmap(acc[r]) & ~0x7Fu) | (u32)(127 - 32 * nb - crow16(r) - 4 * hi);
                if (nb == 0) { sort16<true>(blk);
#pragma unroll
                    for (int i = 0; i < 16; ++i) run[i] = blk[i]; }
                else { sort16<false>(blk);
#pragma unroll
                    for (int i = 0; i < 16; ++i) run[i] = umax_(run[i], blk[i]);
                    merge16<true>(run); }
            }
            u32 oth[16];
#pragma unroll
            for (int i = 0; i < 16; ++i) oth[i] = (u32)__shfl_xor((int)run[15 - i], 32);
#pragma unroll
            for (int i = 0; i < 16; ++i) run[i] = umax_(run[i], oth[i]);
            merge16<true>(run);
#pragma unroll
            for (int i = 0; i < 16; ++i) { if (p == 0) s0[i] = run[i]; else s1[i] = run[i]; }
        }
        { LAS u32* iw = (LAS u32*)IDXB;
#pragma unroll
          for (int j = 0; j < 4; ++j) {
              iw[j] = (127u - (s0[4 * j] & 127u)) | ((127u - (s0[4 * j + 1] & 127u)) << 8) | ((127u - (s0[4 * j + 2] & 127u)) << 16) | ((127u - (s0[4 * j + 3] & 127u)) << 24);
              iw[4 + j] = (127u - (s1[4 * j] & 127u)) | ((127u - (s1[4 * j + 1] & 127u)) << 8) | ((127u - (s1[4 * j + 2] & 127u)) << 16) | ((127u - (s1[4 * j + 3] & 127u)) << 24); } }
        float v1[16], v2[16];
#pragma unroll
        for (int i = 0; i < 16; ++i) { v1[i] = unordmap(s0[i] & ~0x7Fu); v2[i] = unordmap(s1[i] & ~0x7Fu); }
        u32 c0[16], c1[16], c2[16], c3[16];
#pragma unroll
        for (int a = 0; a < 16; ++a)
#pragma unroll
            for (int b = 0; b < ccnt(a); ++b) { const int pos = cbase(a) + b; const u32 key = (ordmap(v1[a] + v2[b]) & ~0xFFu) | (u32)(255 - (a * 16 + b));
                if (pos < 16) c0[pos] = key; else if (pos < 32) c1[pos - 16] = key; else if (pos < 48) c2[pos - 32] = key; else c3[pos - 48] = key; }
#pragma unroll
        for (int i = 2; i < 16; ++i) c3[i] = 0u;
        sort16<false>(c1);
#pragma unroll
        for (int i = 0; i < 16; ++i) c0[i] = umax_(c0[i], c1[i]);
        merge16<true>(c0);
        sort16<false>(c2);
#pragma unroll
        for (int i = 0; i < 16; ++i) c0[i] = umax_(c0[i], c2[i]);
        merge16<true>(c0);
        sort16<false>(c3);
#pragma unroll
        for (int i = 0; i < 16; ++i) c0[i] = umax_(c0[i], c3[i]);
        merge16<true>(c0);
        const float m = unordmap(c0[0] & ~0xFFu) * rstd2;
        float e[8]; float sum = 0.f; u32 ex[8];
#pragma unroll
        for (int k = 0; k < 8; ++k) { const u32 key = hi ? c0[k + 8] : c0[k]; const float ts = unordmap(key & ~0xFFu);
            e[k] = __builtin_amdgcn_exp2f((ts * rstd2 - m) * LOG2E); sum += e[k];
            const u32 flat = 255u - (key & 255u); ex[k] = (u32)IDXB[flat >> 4] * NKEY + (u32)IDXB[16 + (flat & 15u)]; }
        sum += __shfl_xor(sum, 32);
        const float inv = 1.f / sum;
        v4u exw; exw.x = ex[0] | (ex[1] << 16); exw.y = ex[2] | (ex[3] << 16); exw.z = ex[4] | (ex[5] << 16); exw.w = ex[6] | (ex[7] << 16);
        *(LAS v4u*)(EXL + tok * EX_STRIDE + w * 16 + hi * 8) = exw;
        *(LAS f32x4*)(GTL + tok * GT_STRIDE + w * 16 + hi * 8) = (f32x4){e[0] * inv, e[1] * inv, e[2] * inv, e[3] * inv};
        *(LAS f32x4*)(GTL + tok * GT_STRIDE + w * 16 + hi * 8 + 4) = (f32x4){e[4] * inv, e[5] * inv, e[6] * inv, e[7] * inv};
    }
}
__device__ __forceinline__ float gelu_fast(float x) {
    const float u2 = x * (1.5957691216057308f + 0.07135481627f * x * x);
    return x * __builtin_amdgcn_rcpf(1.f + __builtin_amdgcn_exp2f(-1.4426950408889634f * u2));
}
typedef float f32x2 __attribute__((ext_vector_type(2)));

__device__ __forceinline__ void sort128(u32 (&k)[8], int m) {
#pragma unroll
    for (int K = 2; K <= 128; K <<= 1) {
#pragma unroll
        for (int S = K >> 1; S > 0; S >>= 1) {
            if (S >= 8) {
                const int mm = S >> 3; const bool lower = (m & mm) == 0, up = (K == 128) ? true : ((m & (K >> 3)) == 0), keepmin = (lower == up);
#pragma unroll
                for (int r = 0; r < 8; ++r) { const u32 o = (u32)__shfl_xor((int)k[r], mm); const u32 mn = umin_(k[r], o), mx = umax_(k[r], o); k[r] = keepmin ? mn : mx; }
            } else {
#pragma unroll
                for (int r = 0; r < 8; ++r) { const int r2 = r ^ S;
                    if (r2 > r) { const u32 a = k[r], b = k[r2], mn = umin_(a, b), mx = umax_(a, b);
                        if (K < 8) { const bool up = (r & K) == 0; k[r] = up ? mn : mx; k[r2] = up ? mx : mn; }
                        else { const bool up = (K == 128) ? true : ((m & (K >> 3)) == 0); k[r] = up ? mn : mx; k[r2] = up ? mx : mn; } } }
            }
        }
    }
}
__device__ __forceinline__ void eval_lg(Frame& F, const unsigned char* u8, const unsigned char* v8, const float* suv, const float* fg, float* out, int t0) {
    int lane = F.lane; asm volatile("" : "+v"(lane));
    const int g = lane >> 4, m = lane & 15;
    const LAS unsigned short* EXL = (const LAS unsigned short*)(F.lds + RING_OFF + L_EX);
    const LAS float* GTL = (const LAS float*)(F.lds + RING_OFF + L_GT);
    const LAS float* RST = (const LAS float*)(F.lds + RING_OFF + L_RST);
    LAS u32* SK = (LAS u32*)(F.lds + RING_OFF + L_IDX) + F.wave * 512 + g * 128;
    for (int pass = 0; pass < 4; ++pass) {
        const int tok = 32 * pass + 4 * F.wave + g;
        { u32 k[8]; const v4u ev = *(const LAS v4u*)(EXL + tok * EX_STRIDE + 8 * m); const u32 s0 = (u32)(8 * m);
          k[0] = ((ev.x & 0xffffu) << 7) | s0; k[1] = ((ev.x >> 16) << 7) | (s0 + 1); k[2] = ((ev.y & 0xffffu) << 7) | (s0 + 2); k[3] = ((ev.y >> 16) << 7) | (s0 + 3);
          k[4] = ((ev.z & 0xffffu) << 7) | (s0 + 4); k[5] = ((ev.z >> 16) << 7) | (s0 + 5); k[6] = ((ev.w & 0xffffu) << 7) | (s0 + 6); k[7] = ((ev.w >> 16) << 7) | (s0 + 7);
          sort128(k, m);
          *(LAS v4u*)(SK + m * 8) = (v4u){k[0], k[1], k[2], k[3]}; *(LAS v4u*)(SK + m * 8 + 4) = (v4u){k[4], k[5], k[6], k[7]}; }
        asm volatile("" ::: "memory");
        f32x2 hv[32], y[32];
        const float rstd2 = RST[tok]; float* xrow = out + (size_t)(t0 + tok) * DMODEL + 64 * m;
#pragma unroll
        for (int q = 0; q < 16; ++q) { const f32x4 xa = *(const GAS f32x4*)(xrow + 4 * q); hv[2 * q] = (f32x2){xa[0] * rstd2, xa[1] * rstd2}; hv[2 * q + 1] = (f32x2){xa[2] * rstd2, xa[3] * rstd2};
            y[2 * q] = (f32x2){0.f, 0.f}; y[2 * q + 1] = (f32x2){0.f, 0.f}; }
        const LAS float* gtr = GTL + tok * GT_STRIDE;
#define PEER_FP4_DOT(W, A) do { _Pragma("unroll") for (int c = 0; c < 2; ++c) _Pragma("unroll") for (int d = 0; d < 4; ++d) { const unsigned w_ = W[c][d]; const int hb = 16 * c + 4 * d; \
            A = __builtin_elementwise_fma(__builtin_amdgcn_cvt_scalef32_pk_f32_fp4(w_, 1.0f, 0), hv[hb], A); A = __builtin_elementwise_fma(__builtin_amdgcn_cvt_scalef32_pk_f32_fp4(w_, 1.0f, 1), hv[hb + 1], A); \
            A = __builtin_elementwise_fma(__builtin_amdgcn_cvt_scalef32_pk_f32_fp4(w_, 1.0f, 2), hv[hb + 2], A); A = __builtin_elementwise_fma(__builtin_amdgcn_cvt_scalef32_pk_f32_fp4(w_, 1.0f, 3), hv[hb + 3], A); } } while (0)
#define PEER_FP4_AXPY(W, B) do { _Pragma("unroll") for (int c = 0; c < 2; ++c) _Pragma("unroll") for (int d = 0; d < 4; ++d) { const unsigned w_ = W[c][d]; const int hb = 16 * c + 4 * d; \
            y[hb] = __builtin_elementwise_fma(__builtin_amdgcn_cvt_scalef32_pk_f32_fp4(w_, 1.0f, 0), B, y[hb]); y[hb + 1] = __builtin_elementwise_fma(__builtin_amdgcn_cvt_scalef32_pk_f32_fp4(w_, 1.0f, 1), B, y[hb + 1]); \
            y[hb + 2] = __builtin_elementwise_fma(__builtin_amdgcn_cvt_scalef32_pk_f32_fp4(w_, 1.0f, 2), B, y[hb + 2]); y[hb + 3] = __builtin_elementwise_fma(__builtin_amdgcn_cvt_scalef32_pk_f32_fp4(w_, 1.0f, 3), B, y[hb + 3]); } } while (0)
        for (int i = 0; i < 128; i += 4) {
            const v4u kq = *(const LAS v4u*)(SK + i);
            v4u ub[4][2]; f32x2 sc[4]; float gate[4];
#pragma unroll
            for (int s4 = 0; s4 < 4; ++s4) { const u32 key = kq[s4]; const u32 ro = (key >> 7) * 512u + 32u * (u32)m;
                ub[s4][0] = *(const GAS v4u*)(u8 + ro); ub[s4][1] = *(const GAS v4u*)(u8 + ro + 16);
                sc[s4] = *(const GAS f32x2*)(suv + 2 * (key >> 7)); gate[s4] = gtr[key & 127u]; }
            float pp[4];
#pragma unroll
            for (int s4 = 0; s4 < 4; ++s4) { f32x2 a = (f32x2){0.f, 0.f}; PEER_FP4_DOT(ub[s4], a); pp[s4] = a[0] + a[1]; }
            asm volatile("" ::: "memory");
            v4u vb[4][2];
#pragma unroll
            for (int s4 = 0; s4 < 4; ++s4) { const u32 ro = (kq[s4] >> 7) * 512u + 32u * (u32)m; vb[s4][0] = *(const GAS v4u*)(v8 + ro); vb[s4][1] = *(const GAS v4u*)(v8 + ro + 16); }
#pragma unroll
            for (int s4 = 0; s4 < 4; ++s4) { pp[s4] += __shfl_xor(pp[s4], 1); }
#pragma unroll
            for (int s4 = 0; s4 < 4; ++s4) { pp[s4] += __shfl_xor(pp[s4], 2); }
#pragma unroll
            for (int s4 = 0; s4 < 4; ++s4) { pp[s4] += __shfl_xor(pp[s4], 4); }
#pragma unroll
            for (int s4 = 0; s4 < 4; ++s4) { pp[s4] += __shfl_xor(pp[s4], 8); }
#pragma unroll
            for (int s4 = 0; s4 < 4; ++s4) { const float act = gelu_fast(pp[s4] * sc[s4][0]) * (gate[s4] * sc[s4][1]); const f32x2 b2 = (f32x2){act, act}; PEER_FP4_AXPY(vb[s4], b2); }
        }
#undef PEER_FP4_DOT
#undef PEER_FP4_AXPY
        float ss = 0.f;
#pragma unroll
        for (int q = 0; q < 16; ++q) { const f32x4 xa = *(const GAS f32x4*)(xrow + 4 * q); y[2 * q][0] += xa[0]; y[2 * q][1] += xa[1]; y[2 * q + 1][0] += xa[2]; y[2 * q + 1][1] += xa[3];
            ss += (y[2 * q][0] * y[2 * q][0] + y[2 * q][1] * y[2 * q][1]) + (y[2 * q + 1][0] * y[2 * q + 1][0] + y[2 * q + 1][1] * y[2 * q + 1][1]); }
        ss += __shfl_xor(ss, 1); ss += __shfl_xor(ss, 2); ss += __shfl_xor(ss, 4); ss += __shfl_xor(ss, 8);
        const float rs = rsqrtf(ss * (1.f / DMODEL) + RMS_EPS);
#pragma unroll
        for (int q = 0; q < 16; ++q) { const f32x4 gq = *(const GAS f32x4*)(fg + 64 * m + 4 * q); f32x4 o; o[0] = y[2 * q][0] * rs * gq[0]; o[1] = y[2 * q][1] * rs * gq[1]; o[2] = y[2 * q + 1][0] * rs * gq[2]; o[3] = y[2 * q + 1][1] * rs * gq[3];
            *(GAS f32x4*)(xrow + 4 * q) = o; }
    }
}
__device__ __forceinline__ void peer_phase(Frame& F, const Args& a) {
    unsigned char* ws = a.ws;
    for (int tile = F.vcu; tile < T / TOK; tile += F.G) {
        route_tile(F, (const bf16*)(ws + WS_QP), (const bf16*)(ws + WS_SKB), (const float*)(ws + WS_SUMSQ), tile * TOK);
        __syncthreads();
        eval_lg(F, ws + WS_U8, ws + WS_V8, (const float*)(ws + WS_SU), a.in[19], a.out, tile * TOK);
        __syncthreads();
    }
}
}

namespace lru {
typedef float f32x16 __attribute__((ext_vector_type(16)));
constexpr int TOKT = 128, NTILE = SEQ / TOKT;
constexpr int WAVE_LDS = 14336, L_XS = 0, L_XC = 4608, L_GS = 9216, XC_STRIDE = 72  , L_SS = 8 * WAVE_LDS;
static_assert(L_SS + 32 * 8 * 4 <= RING_BYTES, "LRU LDS map");
__device__ __forceinline__ float bf2f(unsigned short h) { return __uint_as_float((unsigned)h << 16); }
__device__ __forceinline__ int crow16(int r) { return (r & 3) + 8 * (r >> 2); }
__device__ __forceinline__ float sigm(float x) { return __builtin_amdgcn_rcpf(1.f + __builtin_amdgcn_exp2f(-LOG2E * x)); }

template <bool FINAL> __device__ __forceinline__ void lru_tile(Frame& F, const Args& args, int tile) {
    int lane = F.lane; asm volatile("" : "+v"(lane));
    const int w = F.wave, j32 = lane & 31, hi = lane >> 5;
    unsigned char* ws = args.ws;
    const bf16* xr = (const bf16*)(ws + WS_XR); const bf16* gr = (const bf16*)(ws + WS_GR); float* carry = (float*)(ws + WS_CARRY);
    const float* cw = args.in[3]; const float* cb = args.in[4]; const float* ba = args.in[6]; const float* bx = args.in[8]; const float* lam = args.in[9];
    const int b = tile / NTILE, jt = tile % NTILE; const size_t trow0 = (size_t)b * SEQ + (size_t)jt * TOKT;
    LAS unsigned char* wl = F.lds + RING_OFF + w * WAVE_LDS;
    LAS unsigned short* XS = (LAS unsigned short*)(wl + L_XS); LAS unsigned short* XC = (LAS unsigned short*)(wl + L_XC); LAS unsigned short* GS = (LAS unsigned short*)(wl + L_GS);
    LAS float* SS = (LAS float*)(F.lds + RING_OFF + L_SS);
    float c_ba[2], c_bx[2], c_sp[2], c_cb[2], c_cw[2][4];
#pragma unroll
    for (int n = 0; n < 2; ++n) { const int c = 64 * w + 32 * n + j32; c_ba[n] = ba[c]; c_bx[n] = bx[c]; c_cb[n] = cb[c];
        const float l = lam[c]; c_sp[n] = 8.f * LOG2E * (fmaxf(-l, 0.f) + log1pf(expf(-fabsf(l))));
#pragma unroll
        for (int k = 0; k < 4; ++k) c_cw[n][k] = cw[k * LW + c]; }
    const bf16* wax = (const bf16*)(ws + WS_WAX);
    float hc[2] = {0.f, 0.f}, ap[2] = {1.f, 1.f};
    if (FINAL) {
        for (int jp = 0; jp < jt; ++jp) { const float* cp = carry + ((size_t)(b * NTILE + jp) * 2) * LW + 64 * w + j32;
#pragma unroll
            for (int n = 0; n < 2; ++n) hc[n] = cp[32 * n] * hc[n] + cp[LW + 32 * n]; }
    }
    for (int blk = 0; blk < 4; ++blk) {
        const size_t tb = trow0 + blk * 32;
        int ln = lane; asm volatile("" : "+v"(ln));
        const int k32 = ln & 31;
        for (int pc = ln; pc < 35 * 8; pc += 64) { const int row = pc >> 3, c8 = pc & 7; v4u v = (v4u){0u, 0u, 0u, 0u};
            if (!(jt == 0 && blk == 0 && row < 3)) v = *(const GAS v4u*)(xr + (tb + row - 3) * LW + w * 64 + c8 * 8);
            *(LAS v4u*)((LAS unsigned char*)XS + row * 128 + c8 * 16) = v; }
        if (FINAL) {
#pragma unroll
            for (int q = 0; q < 4; ++q) { const int pc = ln + 64 * q, row = pc >> 3, c8 = pc & 7;
                *(LAS v4u*)((LAS unsigned char*)GS + row * 128 + c8 * 16) = *(const GAS v4u*)(gr + (tb + row) * LW + w * 64 + c8 * 8); } }
        asm volatile("" ::: "memory");
        float xc[2][16];
#pragma unroll
        for (int n = 0; n < 2; ++n)
#pragma unroll
            for (int g = 0; g < 4; ++g) { float xv[7];
#pragma unroll
                for (int q = 0; q < 7; ++q) xv[q] = bf2f(XS[(8 * g + 4 * hi + q) * 64 + 32 * n + j32]);
#pragma unroll
                for (int e = 0; e < 4; ++e) xc[n][4 * g + e] = c_cb[n] + ((c_cw[n][0] * xv[e] + c_cw[n][1] * xv[e + 1]) + (c_cw[n][2] * xv[e + 2] + c_cw[n][3] * xv[e + 3])); }
#pragma unroll
        for (int n = 0; n < 2; ++n)
#pragma unroll
            for (int r = 0; r < 16; ++r) XC[(crow16(r) + 4 * hi) * XC_STRIDE + 32 * n + j32] = (unsigned short)f2bf(xc[n][r]);
        asm volatile("" ::: "memory");
        bf16x8 af[4];
#pragma unroll
        for (int ks = 0; ks < 4; ++ks) af[ks] = *(const LAS bf16x8*)(XC + j32 * XC_STRIDE + 16 * ks + 8 * hi);
        asm volatile("" ::: "memory");
        float yv[2][16];
#pragma unroll
        for (int n = 0; n < 2; ++n) {
            f32x16 R = {}, I = {};
            bf16x8 fa[4], fx[4];
#pragma unroll
            for (int ks = 0; ks < 4; ++ks) { fa[ks] = *(const GAS bf16x8*)(wax + (size_t)(((w * 2 + 0) * 2 + n) * 4 + ks) * 512 + lane * 8); fx[ks] = *(const GAS bf16x8*)(wax + (size_t)(((w * 2 + 1) * 2 + n) * 4 + ks) * 512 + lane * 8); }
#pragma unroll
            for (int ks = 0; ks < 4; ++ks) { R = __builtin_amdgcn_mfma_f32_32x32x16_bf16(af[ks], fa[ks], R, 0, 0, 0); I = __builtin_amdgcn_mfma_f32_32x32x16_bf16(af[ks], fx[ks], I, 0, 0, 0); }
            float av[16], uv[16];
#pragma unroll
            for (int r = 0; r < 16; ++r) { const float rg = sigm(R[r] + c_ba[n]), ig = sigm(I[r] + c_bx[n]); const float a_ = __builtin_amdgcn_exp2f(-rg * c_sp[n]);
                av[r] = a_; uv[r] = __builtin_amdgcn_sqrtf(fmaxf(1.f - a_ * a_, 0.f)) * (ig * xc[n][r]); }
            float Ar[4], Hr[4], hst[4];
#pragma unroll
            for (int g = 0; g < 4; ++g) { Ar[g] = (av[4 * g] * av[4 * g + 1]) * (av[4 * g + 2] * av[4 * g + 3]);
                Hr[g] = ((uv[4 * g] * av[4 * g + 1] + uv[4 * g + 1]) * av[4 * g + 2] + uv[4 * g + 2]) * av[4 * g + 3] + uv[4 * g + 3]; }
            float hin = hc[n];
#pragma unroll
            for (int g = 0; g < 4; ++g) { float o1 = Ar[g] * hin + Hr[g]; const float x = __shfl_xor(o1, 32); const float hg = hi ? x : hin; o1 = Ar[g] * hg + Hr[g]; hst[g] = hg;
                const float y = __shfl_xor(o1, 32); hin = hi ? o1 : y;
                if (!FINAL) ap[n] *= Ar[g] * __shfl_xor(Ar[g], 32); }
            hc[n] = hin;
            if (FINAL) {
#pragma unroll
                for (int g = 0; g < 4; ++g) { float h = hst[g];
#pragma unroll
                    for (int e = 0; e < 4; ++e) { const int r = 4 * g + e; h = av[r] * h + uv[r]; yv[n][r] = h * bf2f(GS[(crow16(r) + 4 * hi) * 64 + 32 * n + j32]); } } }
        }
        if (FINAL) {
#pragma unroll
            for (int r = 0; r < 16; ++r) { float s = yv[0][r] * yv[0][r] + yv[1][r] * yv[1][r];
                s += __shfl_xor(s, 1); s += __shfl_xor(s, 2); s += __shfl_xor(s, 4); s += __shfl_xor(s, 8); s += __shfl_xor(s, 16);
                if (j32 == 0) SS[(crow16(r) + 4 * hi) * 8 + w] = s; }
            __syncthreads();
            bf16* ymix = (bf16*)(ws + WS_H);
#pragma unroll
            for (int r = 0; r < 16; ++r) { const int tk = crow16(r) + 4 * hi; const f32x4 s0 = *(const LAS f32x4*)(SS + tk * 8), s1 = *(const LAS f32x4*)(SS + tk * 8 + 4);
                const float rstd = rsqrtf(((s0[0] + s0[1]) + (s0[2] + s0[3]) + (s1[0] + s1[1]) + (s1[2] + s1[3])) * (1.f / LW) + RMS_EPS);
                bf16* yp = ymix + (tb + tk) * DMODEL + 64 * w + k32;
                yp[0] = (bf16)f2bf(yv[0][r] * rstd); yp[32] = (bf16)f2bf(yv[1][r] * rstd); }
            __syncthreads();
        }
    }
    if (!FINAL) { if (hi == 0) { float* cp = carry + ((size_t)(b * NTILE + jt) * 2) * LW + 64 * w + j32;
#pragma unroll
        for (int n = 0; n < 2; ++n) { cp[32 * n] = ap[n]; cp[LW + 32 * n] = hc[n]; } } }
    else {
        const bf16* ob = (const bf16*)(ws + WS_O); bf16* ymix = (bf16*)(ws + WS_H);
        for (int i = 0; i < 16; ++i) { const size_t row = trow0 + 16 * w + i; const v4u v = *(const GAS v4u*)(ob + row * AW + 8 * lane);
            float f[8]; f[0] = __uint_as_float(v.x << 16); f[1] = __uint_as_float(v.x & 0xffff0000u); f[2] = __uint_as_float(v.y << 16); f[3] = __uint_as_float(v.y & 0xffff0000u);
            f[4] = __uint_as_float(v.z << 16); f[5] = __uint_as_float(v.z & 0xffff0000u); f[6] = __uint_as_float(v.w << 16); f[7] = __uint_as_float(v.w & 0xffff0000u);
            float ss = 0.f;
#pragma unroll
            for (int e = 0; e < 8; ++e) ss += f[e] * f[e];
            const float rstd = rsqrtf(wave_sum(ss) * (1.f / AW) + RMS_EPS);
            v4u o; o.x = pk2(f[0] * rstd, f[1] * rstd); o.y = pk2(f[2] * rstd, f[3] * rstd); o.z = pk2(f[4] * rstd, f[5] * rstd); o.w = pk2(f[6] * rstd, f[7] * rstd);
            *(GAS v4u*)(ymix + row * DMODEL + LW + 8 * lane) = o; }
    }
}
__device__ __forceinline__ void norm_pass(Frame& F, const Args& a) {
    unsigned char* ws = a.ws; float* nrm = (float*)(ws + WS_NRM);
    const int gw = F.vcu * NWAVES + F.wave, NGW = F.G * NWAVES, lane = F.lane;
    for (int it = gw; it < 2 * BATCH * (SEQ / 64); it += NGW) {
        const int which = it / (BATCH * (SEQ / 64)), r = it % (BATCH * (SEQ / 64)), b = r / (SEQ / 64), t = r % (SEQ / 64);
        const bf16* src = (const bf16*)(ws + (which ? WS_K : WS_Q)) + ((size_t)b * SEQ + 64 * t) * AW + 8 * lane;
        float mx = 0.f;
#pragma unroll 8
        for (int i = 0; i < 64; ++i) { const v4u v = *(const GAS v4u*)(src + (size_t)i * AW); float s = 0.f;
#pragma unroll
            for (int c = 0; c < 4; ++c) { const float lo = __uint_as_float(v[c] << 16), hi = __uint_as_float(v[c] & 0xffff0000u); s += lo * lo + hi * hi; }
            s += __shfl_xor(s, 1); s += __shfl_xor(s, 2); s += __shfl_xor(s, 4); mx = fmaxf(mx, s); }
        if ((lane & 7) == 0) nrm[which * 4096 + (b * NHEADS + (lane >> 3)) * 128 + t] = sqrtf(mx) * 1.0001f;
    }
}
template <bool FINAL> __device__ __forceinline__ void lru_phase(Frame& F, const Args& a) {
    for (int tile = F.vcu; tile < BATCH * NTILE; tile += F.G) { lru_tile<FINAL>(F, a, tile); __syncthreads(); }
}
}
__global__ void __launch_bounds__(NWAVES * 64, 2) mk_fwd(Args args) {
    extern __shared__ __attribute__((aligned(16))) unsigned char lds[];
    Frame F;
    F.lds = (LAS unsigned char*)lds;
    F.MISC = (volatile LAS unsigned*)(F.lds + MISC_OFF);
    F.wave = __builtin_amdgcn_readfirstlane((int)threadIdx.x >> 6); F.lane = (int)__builtin_amdgcn_mbcnt_hi(~0u, __builtin_amdgcn_mbcnt_lo(~0u, 0u)); F.tid = F.wave * 64 + F.lane;
    F.G = gridDim.x; { const int bx = blockIdx.x; F.vcu = (F.G % 8 == 0) ? (bx % 8) * (F.G / 8) + bx / 8 : bx; }
    unsigned char* ws = args.ws;
    F.ctl = (gu32*)(ws + WS_CTL);
    for (int u = F.tid; u < (LDS_BYTES - LDSCTL_OFF) / 4; u += NWAVES * 64) ((LAS unsigned*)(F.lds + LDSCTL_OFF))[u] = 0u;
    __syncthreads();
    XcdBarrier bar = xcd_barrier_post((unsigned*)(F.ctl + CW_BAR) + args.li * XCD_BAR_WORDS, F.MISC + 8, F.wave);
    const int lo = args.ph_lo, hi = args.ph_hi;
#ifndef MK_REP_MASK
#define MK_REP_MASK 0
#endif
#define REPS(k) (((MK_REP_MASK >> (k)) & 1) ? 2 : 1)
#define IN(k) (lo <= (k) && (k) < hi)
#define BOTH(k) (IN(k) && IN((k) + 1))
#define GRID_BAR() xcd_barrier(bar)

    if (IN(0)) { for (int rp = 0; rp < REPS(0); ++rp) { if (rp) GRID_BAR(); p0_prologue(F, args); } if (BOTH(0)) GRID_BAR(); }

    if (IN(1)) for (int rp = 0; rp < REPS(1); ++rp) {
        if (rp) GRID_BAR();
        if (F.vcu < BATCH * NHEADS) fcum_unit(F, F.vcu, (const float*)(ws + WS_LOGF), (float*)(ws + WS_FCUM));
        pg8::Gemm g{(const pg8::bf16_t*)(ws + WS_H), (const pg8::bf16_t*)(ws + WS_WIN), T, NG1, DMODEL}; pg8::StaticOrder S; S.init(T, NG1, F.G, (int)blockIdx.x);
        pg8::EpiG1 E{(pg8::bf16_t*)(ws + WS_XR), SPLIT_STRIDE, QSCALE};
        pg8::gemm_phase<pg8::EpiG1, pg8::StaticOrder, true, true>(F.lds + RING_OFF, g, S, E, F.wave);
        if (BOTH(1) && rp == REPS(1) - 1) GRID_BAR();
    }
    if (IN(2)) { lru::lru_phase<false>(F, args); lru::norm_pass(F, args); if (BOTH(2)) GRID_BAR(); }
    if (IN(3)) {
        static_assert(attn_body::ATTN_LDS_BYTES <= RING_BYTES, "attention LDS vs frame");
        const attn_body::AttnTensors AT{(const attn_body::bf16*)(ws + WS_Q), (const attn_body::bf16*)(ws + WS_K), (const attn_body::bf16*)(ws + WS_V), (attn_body::bf16*)(ws + WS_O), (const float*)(ws + WS_FCUM), (const float*)(ws + WS_NRM)};
        attn_body::attn_phase<8>((char*)lds + RING_OFF, AT, (unsigned*)(F.ctl + CW_ATTQ), F.MISC + 24, F.wave);
        if (BOTH(3)) GRID_BAR();
    }
    if (IN(4)) { lru::lru_phase<true>(F, args); if (BOTH(4)) GRID_BAR(); }
    if (IN(5)) {
        pg8::Gemm g{(const pg8::bf16_t*)(ws + WS_H), (const pg8::bf16_t*)(ws + WS_WOUT), T, DMODEL, DMODEL}; pg8::StaticOrder S; S.init(T, DMODEL, F.G, (int)blockIdx.x);
        pg8::EpiG2 E{args.in[0], args.out, (pg8::bf16_t*)(ws + WS_X1B), (float*)(ws + WS_SUMSQ), DMODEL};
        pg8::gemm_phase<pg8::EpiG2, pg8::StaticOrder, true, true>(F.lds + RING_OFF, g, S, E, F.wave);
        if (BOTH(5)) GRID_BAR();
    }
    if (IN(6)) for (int rp = 0; rp < REPS(6); ++rp) {
        if (rp) GRID_BAR();
        pg8::Gemm g{(const pg8::bf16_t*)(ws + WS_X1B), (const pg8::bf16_t*)(ws + WS_WQ), T, QPW, DMODEL}; pg8::StaticOrder S; S.init(T, QPW, F.G, (int)blockIdx.x);
        pg8::EpiG3 E{(pg8::bf16_t*)(ws + WS_QP), QPW};
        pg8::gemm_phase<pg8::EpiG3, pg8::StaticOrder, true, true>(F.lds + RING_OFF, g, S, E, F.wave);
        if (BOTH(6) && rp == REPS(6) - 1) GRID_BAR();
    }
    if (IN(7)) { peer::peer_phase(F, args); }
#undef IN
#undef BOTH
#undef GRID_BAR
}

#ifndef MK_FRAME_MASK
#define MK_FRAME_MASK 0xFF
#endif
extern "C" void kernel_launch(void* const* d_in, const int* in_sizes, int n_in, void* d_out, int out_size, void* d_ws, size_t ws_size, hipStream_t stream) {
    static int grid = 0;
    if (grid == 0) {
        if (n_in != 20 || in_sizes[0] != T * DMODEL || out_size != T * DMODEL || ws_size < WS_END) { fprintf(stderr, "kernel_launch: unexpected shapes (n_in %d, ws %zu)\n", n_in, ws_size); grid = -1; return; }
        int dev = 0, cus = 0;
        if (hipGetDevice(&dev) != hipSuccess || hipDeviceGetAttribute(&cus, hipDeviceAttributeMultiprocessorCount, dev) != hipSuccess) { grid = -1; return; }
        if (hipFuncSetAttribute((const void*)mk_fwd, hipFuncAttributeMaxDynamicSharedMemorySize, LDS_BYTES) != hipSuccess) { fprintf(stderr, "kernel_launch: hipFuncSetAttribute failed\n"); grid = -1; return; }
        (void)hipGetLastError();
        grid = cus;
    }
    if (grid < 0) return;
    using namespace naive;
    const float* x = (const float*)d_in[0]; const float* g1 = (const float*)d_in[1]; const float* w_in = (const float*)d_in[2];
    const float* cw = (const float*)d_in[3]; const float* cb = (const float*)d_in[4]; const float* wa = (const float*)d_in[5]; const float* ba = (const float*)d_in[6];
    const float* wx = (const float*)d_in[7]; const float* bx = (const float*)d_in[8]; const float* lam = (const float*)d_in[9]; const float* bfv = (const float*)d_in[10];
    const float* gn_l = (const float*)d_in[11]; const float* gn_f = (const float*)d_in[12]; const float* w_out = (const float*)d_in[13]; const float* g2 = (const float*)d_in[14];
    const float* w_q = (const float*)d_in[15]; const float* sk = (const float*)d_in[16]; const float* pu = (const float*)d_in[17]; const float* pv = (const float*)d_in[18]; const float* fg = (const float*)d_in[19];
    char* ws = (char*)d_ws; float* out = (float*)d_out;
    naive::bf16* win_t = (naive::bf16*)(ws + WS_WIN); naive::bf16* wout_t = (naive::bf16*)(ws + WS_WOUT); naive::bf16* wq_t = (naive::bf16*)(ws + WS_WQ); naive::bf16* skb = (naive::bf16*)(ws + WS_SKB); float* wfl = (float*)(ws + WS_WFL);
    float* logf = (float*)(ws + WS_LOGF); float* fcum = (float*)(ws + WS_FCUM); float* sumsq = (float*)(ws + WS_SUMSQ);
    naive::bf16* h = (naive::bf16*)(ws + WS_H); naive::bf16* xr = (naive::bf16*)(ws + WS_XR); naive::bf16* gr = (naive::bf16*)(ws + WS_GR); naive::bf16* q = (naive::bf16*)(ws + WS_Q); naive::bf16* k = (naive::bf16*)(ws + WS_K); naive::bf16* v = (naive::bf16*)(ws + WS_V);
    naive::bf16* x1b = (naive::bf16*)(ws + WS_X1B); naive::bf16* qp = (naive::bf16*)(ws + WS_QP); naive::bf16* ut = (naive::bf16*)(ws + WS_UT); naive::bf16* vt = (naive::bf16*)(ws + WS_VT); float* la = (float*)(ws + WS_LA); float* lu = (float*)(ws + WS_LU);
    naive::bf16* ymix = h;
    if (hipMemsetAsync((char*)d_ws + WS_CTL, 0, CTL_ZERO_BYTES, stream) != hipSuccess) return;
    Args a{};
    for (int i = 0; i < 20; ++i) a.in[i] = (const float*)d_in[i];
    a.out = out; a.ws = (unsigned char*)d_ws;
    int li = 0;
    for (int p = 0; p < N_PHASES;) {
        if ((MK_FRAME_MASK >> p) & 1) {
            int e = p; while (e < N_PHASES && ((MK_FRAME_MASK >> e) & 1)) ++e;
            a.ph_lo = p; a.ph_hi = e; a.li = li++;
            hipLaunchKernelGGL(mk_fwd, dim3(grid), dim3(NWAVES * 64), LDS_BYTES, stream, a);
            p = e; continue;
        }
        switch (p) {
        case 0: k_prep_w<<<2048, 256, 0, stream>>>(w_in, w_out, gn_l, gn_f, w_q, g2, sk, win_t, wfl, wout_t, wq_t, skb);
                k_prep_tab<<<4096, 256, 0, stream>>>(pu, pv, g2, ut, vt);
                k_prep_x<<<2048, 256, 0, stream>>>(x, g1, wfl, bfv, h, logf); break;
        case 1: k_fcum<<<BATCH * NHEADS, 64, 0, stream>>>(logf, fcum);
                { EpiArgs e{xr, gr, q, k, v, nullptr, nullptr}; k_gemm<1><<<dim3(NG1 / 64, T / 64), 256, 0, stream>>>(h, win_t, T, NG1, DMODEL, e); } break;
        case 2: break;
        case 3: k_attn<<<(BATCH * NHEADS * SEQ) / 4, 256, 0, stream>>>(q, k, v, fcum, (naive::bf16*)(ws + WS_O)); break;
        case 4: k_lru_gates<<<T * NHEADS, 64, 0, stream>>>(xr, cw, cb, wa, ba, wx, bx, lam, la, lu);
                k_lru_scan<<<(BATCH * LW + 63) / 64, 64, 0, stream>>>(la, lu, gr);
                k_ymix<<<2048, 256, 0, stream>>>(lu, (naive::bf16*)(ws + WS_O), ymix); break;
        case 5: { EpiArgs e{x1b, nullptr, nullptr, nullptr, nullptr, x, out}; k_gemm<2><<<dim3(DMODEL / 64, T / 64), 256, 0, stream>>>(ymix, wout_t, T, DMODEL, DMODEL, e); }
                k_sumsq<<<2048, 256, 0, stream>>>(out, sumsq); break;
        case 6: { EpiArgs e{qp, nullptr, nullptr, nullptr, nullptr, nullptr, nullptr}; k_gemm<3><<<dim3(QPW / 64, T / 64), 256, 0, stream>>>(x1b, wq_t, T, QPW, DMODEL, e); } break;
        case 7: k_peer<<<T, 64, 0, stream>>>(qp, skb, sumsq, ut, vt, fg, out); break;
        }
        ++p;
    }
}
```

```cpp
#include <hip/hip_runtime.h>
#include <hip/hip_bf16.h>
#include <cstdio>
#include <cstdint>
#include <cmath>

constexpr int BATCH = 4, SEQ = 8192, DMODEL = 1024, T = BATCH * SEQ;
constexpr int LW = 512, AW = 512, NHEADS = 8, HD = 64, INC = 2568, NG1 = 2560;
constexpr int PH = 8, NKEY = 128, PHALF = 128, TOPK = 16, NEXP = NKEY * NKEY, QPW = 2048;
constexpr float RMS_EPS = 1e-6f;
constexpr float LOG2E = 1.4426950408889634f;
constexpr float QSCALE = 0.125f * LOG2E;
constexpr size_t MiB = 1u << 20;
constexpr size_t WS_CTL = 0, CTL_ZERO_BYTES = 1 * MiB;
constexpr size_t WS_WIN = 2 * MiB, WS_WOUT = 8 * MiB, WS_WQ = 10 * MiB, WS_SKB = 14 * MiB, WS_WFL = 15 * MiB,
                 WS_LOGF = 16 * MiB, WS_FCUM = 17 * MiB, WS_CARRY = 18 * MiB, WS_SUMSQ = 19 * MiB, WS_WAX = 20 * MiB, WS_CIN = 23 * MiB  , WS_NRM = 22 * MiB  ,
                 WS_H = 32 * MiB, WS_XR = 96 * MiB, WS_GR = 128 * MiB, WS_Q = 160 * MiB, WS_K = 192 * MiB, WS_V = 224 * MiB,
                 WS_X1B = 256 * MiB, WS_O = 256 * MiB  , WS_QP = 96 * MiB, WS_UT = 320 * MiB, WS_VT = 352 * MiB, WS_U8 = 320 * MiB, WS_V8 = 336 * MiB, WS_SU = 21 * MiB, WS_SV = 21 * MiB + 65536, WS_LA = 384 * MiB, WS_LU = 448 * MiB, WS_END = 512 * MiB;
constexpr size_t SPLIT_STRIDE = (WS_GR - WS_XR) / 2;
constexpr int CW_TMO = 0, CW_ATTQ = 2048, CW_BAR = 4096;

namespace naive {
typedef unsigned short bf16;
__device__ __forceinline__ unsigned f2bf(float f) { unsigned u = __builtin_bit_cast(unsigned, f); return (u + 0x7fffu + ((u >> 16) & 1u)) >> 16; }
__device__ __forceinline__ float bf2f(unsigned short h) { return __builtin_bit_cast(float, (unsigned)h << 16); }
__device__ __forceinline__ float gelu_tanh(float x) { const float u = 0.7978845608028654f * (x + 0.044715f * x * x * x); return 0.5f * x * (1.f + tanhf(u)); }
__device__ __forceinline__ float sigmoidf_(float x) { return 1.f / (1.f + expf(-x)); }
__device__ __forceinline__ float wave_sum(float v) {
#pragma unroll
    for (int o = 1; o < 64; o <<= 1) v += __shfl_xor(v, o);
    return v;
}
__global__ void k_prep_w(const float* w_in, const float* w_out, const float* gn_l, const float* gn_f, const float* w_q, const float* g2, const float* sk,
                         bf16* win_t, float* wfl, bf16* wout_t, bf16* wq_t, bf16* skb) {
    const size_t gid = (size_t)blockIdx.x * blockDim.x + threadIdx.x, gsz = (size_t)gridDim.x * blockDim.x;
    for (size_t i = gid; i < (size_t)NG1 * DMODEL; i += gsz) { const int n = (int)(i / DMODEL), k = (int)(i % DMODEL); win_t[i] = (bf16)f2bf(w_in[(size_t)k * INC + n]); }
    for (size_t i = gid; i < (size_t)8 * DMODEL; i += gsz) { const int j = (int)(i / DMODEL), k = (int)(i % DMODEL); wfl[i] = w_in[(size_t)k * INC + NG1 + j]; }
    for (size_t i = gid; i < (size_t)DMODEL * DMODEL; i += gsz) { const int n = (int)(i / DMODEL), k = (int)(i % DMODEL); const float g = k < LW ? gn_l[k] : gn_f[k - LW]; wout_t[i] = (bf16)f2bf(g * w_out[(size_t)k * DMODEL + n]); }
    for (size_t i = gid; i < (size_t)QPW * DMODEL; i += gsz) { const int n = (int)(i / DMODEL), k = (int)(i % DMODEL); wq_t[i] = (bf16)f2bf(g2[k] * w_q[(size_t)k * QPW + n]); }
    for (size_t i = gid; i < (size_t)PH * 2 * NKEY * PHALF; i += gsz) skb[i] = (bf16)f2bf(sk[i]);
}
__global__ void k_prep_tab(const float* u, const float* v, const float* g2, bf16* ut, bf16* vt) {
    const size_t gid = (size_t)blockIdx.x * blockDim.x + threadIdx.x, gsz = (size_t)gridDim.x * blockDim.x;
    for (size_t i = gid; i < (size_t)NEXP * DMODEL; i += gsz) { const int d = (int)(i % DMODEL); ut[i] = (bf16)f2bf(g2[d] * u[i]); vt[i] = (bf16)f2bf(v[i]); }
}
__global__ void k_prep_x(const float* x, const float* g1, const float* wfl, const float* bfv, bf16* h, float* logf) {
    const int lane = threadIdx.x & 63, wv = (blockIdx.x * blockDim.x + threadIdx.x) >> 6, nw = (gridDim.x * blockDim.x) >> 6;
    for (int t = wv; t < T; t += nw) {
        float xv[16]; float ss = 0.f;
#pragma unroll
        for (int j = 0; j < 4; ++j) { const float4 v = *(const float4*)(x + (size_t)t * DMODEL + j * 256 + lane * 4); xv[4 * j] = v.x; xv[4 * j + 1] = v.y; xv[4 * j + 2] = v.z; xv[4 * j + 3] = v.w; ss += v.x * v.x + v.y * v.y + v.z * v.z + v.w * v.w; }
        const float rstd = rsqrtf(wave_sum(ss) * (1.f / DMODEL) + RMS_EPS);
#pragma unroll
        for (int j = 0; j < 4; ++j) { const float4 g = *(const float4*)(g1 + j * 256 + lane * 4); xv[4 * j] *= rstd * g.x; xv[4 * j + 1] *= rstd * g.y; xv[4 * j + 2] *= rstd * g.z; xv[4 * j + 3] *= rstd * g.w;
            uint2 o; o.x = f2bf(xv[4 * j]) | (f2bf(xv[4 * j + 1]) << 16); o.y = f2bf(xv[4 * j + 2]) | (f2bf(xv[4 * j + 3]) << 16); *(uint2*)(h + (size_t)t * DMODEL + j * 256 + lane * 4) = o; }
#pragma unroll
        for (int hh = 0; hh < 8; ++hh) { float a = 0.f;
#pragma unroll
            for (int j = 0; j < 4; ++j) { const float4 w = *(const float4*)(wfl + hh * DMODEL + j * 256 + lane * 4); a += xv[4 * j] * w.x + xv[4 * j + 1] * w.y + xv[4 * j + 2] * w.z + xv[4 * j + 3] * w.w; }
            a = wave_sum(a);
            if (lane == 0) { const float z = a + bfv[hh]; logf[(size_t)t * 8 + hh] = fminf(z, 0.f) - log1pf(expf(-fabsf(z))); } }
    }
}
__global__ void k_fcum(const float* logf, float* fcum) {
    const int lane = threadIdx.x & 63, bh = blockIdx.x, b = bh / NHEADS, hh = bh % NHEADS;
    float loc = 0.f;
    for (int i = 0; i < 128; ++i) loc += logf[((size_t)b * SEQ + lane * 128 + i) * 8 + hh];
    float inc = loc;
#pragma unroll
    for (int o = 1; o < 64; o <<= 1) { const float n = __shfl_up(inc, o); if (lane >= o) inc += n; }
    float run = inc - loc;
    for (int i = 0; i < 128; ++i) { run += logf[((size_t)b * SEQ + lane * 128 + i) * 8 + hh]; fcum[(size_t)bh * SEQ + lane * 128 + i] = run; }
}
struct EpiArgs { bf16* o0; bf16* o1; bf16* o2; bf16* o3; bf16* o4; const float* resid; float* outf; };
template <int EPI> __global__ void __launch_bounds__(256) k_gemm(const bf16* A, const bf16* Bt, int M, int N, int K, EpiArgs e) {
    __shared__ float As[32][65], Bs[32][65];
    const int tid = threadIdx.x, tx = tid & 15, ty = tid >> 4, m0 = blockIdx.y * 64, n0 = blockIdx.x * 64;
    float acc[4][4] = {};
    const int lr = tid >> 2, lc = (tid & 3) * 8;
    for (int k0 = 0; k0 < K; k0 += 32) {
        const uint4 av = *(const uint4*)(A + (size_t)(m0 + lr) * K + k0 + lc), bv = *(const uint4*)(Bt + (size_t)(n0 + lr) * K + k0 + lc);
        const unsigned aw[4] = {av.x, av.y, av.z, av.w}, bw[4] = {bv.x, bv.y, bv.z, bv.w};
#pragma unroll
        for (int i = 0; i < 4; ++i) { As[lc + 2 * i][lr] = bf2f(aw[i] & 0xffff); As[lc + 2 * i + 1][lr] = bf2f(aw[i] >> 16); Bs[lc + 2 * i][lr] = bf2f(bw[i] & 0xffff); Bs[lc + 2 * i + 1][lr] = bf2f(bw[i] >> 16); }
        __syncthreads();
#pragma unroll 8
        for (int k = 0; k < 32; ++k) { float a[4], b[4];
#pragma unroll
            for (int i = 0; i < 4; ++i) { a[i] = As[k][ty * 4 + i]; b[i] = Bs[k][tx * 4 + i]; }
#pragma unroll
            for (int i = 0; i < 4; ++i)
#pragma unroll
                for (int j = 0; j < 4; ++j) acc[i][j] += a[i] * b[j]; }
        __syncthreads();
    }
#pragma unroll
    for (int i = 0; i < 4; ++i)
#pragma unroll
        for (int j = 0; j < 4; ++j) { const int m = m0 + ty * 4 + i, n = n0 + tx * 4 + j; const float v = acc[i][j];
            if (EPI == 1) { const int s = n >> 9, c = n & 511; bf16* o = s == 0 ? e.o0 : s == 1 ? e.o1 : s == 2 ? e.o2 : s == 3 ? e.o3 : e.o4;
                const float w = s == 1 ? gelu_tanh(v) : s == 2 ? v * QSCALE : v; o[(size_t)m * 512 + c] = (bf16)f2bf(w); }
            else if (EPI == 2) { const float r = e.resid[(size_t)m * DMODEL + n] + v; e.outf[(size_t)m * DMODEL + n] = r; e.o0[(size_t)m * DMODEL + n] = (bf16)f2bf(r); }
            else { e.o0[(size_t)m * N + n] = (bf16)f2bf(v); } }
}
__global__ void k_sumsq(const float* x1, float* sumsq) {
    const int lane = threadIdx.x & 63, wv = (blockIdx.x * blockDim.x + threadIdx.x) >> 6, nw = (gridDim.x * blockDim.x) >> 6;
    for (int t = wv; t < T; t += nw) { float ss = 0.f;
#pragma unroll
        for (int j = 0; j < 4; ++j) { const float4 v = *(const float4*)(x1 + (size_t)t * DMODEL + j * 256 + lane * 4); ss += v.x * v.x + v.y * v.y + v.z * v.z + v.w * v.w; }
        ss = wave_sum(ss); if (lane == 0) sumsq[t] = ss; }
}
__global__ void k_lru_gates(const bf16* xr, const float* cw, const float* cb, const float* wa, const float* ba, const float* wx, const float* bx, const float* lam, float* la, float* lu) {
    __shared__ float xc[64];
    const int j = threadIdx.x, t = blockIdx.x / NHEADS, hh = blockIdx.x % NHEADS, ch = hh * 64 + j, s = t % SEQ;
    float c = cb[ch];
#pragma unroll
    for (int k = 0; k < 4; ++k) { const int ss = s - 3 + k; if (ss >= 0) c += cw[k * LW + ch] * bf2f(xr[(size_t)(t - 3 + k) * LW + ch]); }
    xc[j] = c; __syncthreads();
    float r = ba[ch], ii = bx[ch];
    for (int i = 0; i < 64; ++i) { const float xv = xc[i]; r += xv * wa[(size_t)(hh * 64 + i) * 64 + j]; ii += xv * wx[(size_t)(hh * 64 + i) * 64 + j]; }
    r = sigmoidf_(r); ii = sigmoidf_(ii);
    const float l = lam[ch], sp = fmaxf(-l, 0.f) + log1pf(expf(-fabsf(l)));
    const float log_a = -8.f * r * sp, a = expf(log_a), u = sqrtf(-expm1f(2.f * log_a)) * (ii * c);
    la[(size_t)t * LW + ch] = a; lu[(size_t)t * LW + ch] = u;
}
__global__ void k_lru_scan(const float* la, float* lu, const bf16* gr) {
    const int id = blockIdx.x * blockDim.x + threadIdx.x; if (id >= BATCH * LW) return;
    const int b = id / LW, ch = id % LW; float h = 0.f;
    for (int s = 0; s < SEQ; ++s) { const size_t o = ((size_t)b * SEQ + s) * LW + ch; h = la[o] * h + lu[o]; lu[o] = h * bf2f(gr[o]); }
}
__global__ void k_ymix(const float* ylru, const bf16* o, bf16* ymix) {
    const int lane = threadIdx.x & 63, wv = (blockIdx.x * blockDim.x + threadIdx.x) >> 6, nw = (gridDim.x * blockDim.x) >> 6;
    for (int t = wv; t < T; t += nw) {
        float a[8], f[8]; float sa = 0.f, sf = 0.f;
#pragma unroll
        for (int i = 0; i < 8; ++i) { a[i] = ylru[(size_t)t * LW + i * 64 + lane]; f[i] = bf2f(o[(size_t)t * AW + i * 64 + lane]); sa += a[i] * a[i]; sf += f[i] * f[i]; }
        const float ra = rsqrtf(wave_sum(sa) * (1.f / LW) + RMS_EPS), rf = rsqrtf(wave_sum(sf) * (1.f / AW) + RMS_EPS);
#pragma unroll
        for (int i = 0; i < 8; ++i) { ymix[(size_t)t * DMODEL + i * 64 + lane] = (bf16)f2bf(a[i] * ra); ymix[(size_t)t * DMODEL + LW + i * 64 + lane] = (bf16)f2bf(f[i] * rf); }
    }
}
__global__ void __launch_bounds__(256) k_attn(const bf16* Q, const bf16* K, const bf16* V, const float* fcum, bf16* O) {
    const int lane = threadIdx.x & 63, wv = (blockIdx.x * blockDim.x + threadIdx.x) >> 6;
    const int q = wv % SEQ, bh = wv / SEQ, b = bh / NHEADS, hh = bh % NHEADS;
    const size_t rowq = (size_t)b * SEQ + q;
    float qv[64];
#pragma unroll
    for (int i = 0; i < 8; ++i) { const uint4 w = *(const uint4*)(Q + rowq * AW + hh * 64 + i * 8); const unsigned ww[4] = {w.x, w.y, w.z, w.w};
#pragma unroll
        for (int c = 0; c < 4; ++c) { qv[i * 8 + 2 * c] = bf2f(ww[c] & 0xffff); qv[i * 8 + 2 * c + 1] = bf2f(ww[c] >> 16); } }
    const float fq = fcum[(size_t)bh * SEQ + q];
    float m = -INFINITY, l = 0.f; float o[64];
#pragma unroll
    for (int d = 0; d < 64; ++d) o[d] = 0.f;
    for (int j = lane; j <= q; j += 64) {
        const size_t rowk = (size_t)b * SEQ + j; float s = 0.f;
#pragma unroll
        for (int i = 0; i < 8; ++i) { const uint4 w = *(const uint4*)(K + rowk * AW + hh * 64 + i * 8); const unsigned ww[4] = {w.x, w.y, w.z, w.w};
#pragma unroll
            for (int c = 0; c < 4; ++c) { s += qv[i * 8 + 2 * c] * bf2f(ww[c] & 0xffff) + qv[i * 8 + 2 * c + 1] * bf2f(ww[c] >> 16); } }
        s += (fq - fcum[(size_t)bh * SEQ + j]) * LOG2E;
        const float mn = fmaxf(m, s), sc = exp2f(m - mn), p = exp2f(s - mn);
        l = l * sc + p; m = mn;
#pragma unroll
        for (int i = 0; i < 8; ++i) { const uint4 w = *(const uint4*)(V + rowk * AW + hh * 64 + i * 8); const unsigned ww[4] = {w.x, w.y, w.z, w.w};
#pragma unroll
            for (int c = 0; c < 4; ++c) { o[i * 8 + 2 * c] = o[i * 8 + 2 * c] * sc + p * bf2f(ww[c] & 0xffff); o[i * 8 + 2 * c + 1] = o[i * 8 + 2 * c + 1] * sc + p * bf2f(ww[c] >> 16); } }
    }
    float mall = m;
#pragma unroll
    for (int of = 1; of < 64; of <<= 1) mall = fmaxf(mall, __shfl_xor(mall, of));
    const float sc = (m == -INFINITY) ? 0.f : exp2f(m - mall);
    const float lt = wave_sum(l * sc); const float inv = 1.f / lt;
    float mine = 0.f;
#pragma unroll
    for (int d = 0; d < 64; ++d) { const float v = wave_sum(o[d] * sc); if (lane == d) mine = v; }
    O[rowq * AW + hh * 64 + lane] = (bf16)f2bf(mine * inv);
}
__device__ __forceinline__ void wave_argmax(float v, int idx, float& bv, int& bi) {
#pragma unroll
    for (int o = 1; o < 64; o <<= 1) { const float ov = __shfl_xor(v, o); const int oi = __shfl_xor(idx, o); if (ov > v || (ov == v && oi < idx)) { v = ov; idx = oi; } }
    bv = v; bi = idx;
}
__global__ void __launch_bounds__(64) k_peer(const bf16* qp, const bf16* skb, const float* sumsq, const bf16* ut, const bf16* vt, const float* fg, float* out) {
    __shared__ float qs[2048]; __shared__ float sc[256]; __shared__ float s1[16], s2[16]; __shared__ int i1[16], i2[16]; __shared__ int ex[128]; __shared__ float gt[128];
    const int lane = threadIdx.x, t = blockIdx.x;
    const float rstd2 = rsqrtf(sumsq[t] * (1.f / DMODEL) + RMS_EPS);
    for (int i = lane; i < 2048; i += 64) qs[i] = bf2f(qp[(size_t)t * 2048 + i]) * rstd2;
    __syncthreads();
    for (int hh = 0; hh < PH; ++hh) {
        for (int r = 0; r < 4; ++r) { const int idx = r * 64 + lane, p = idx >> 7, n = idx & 127; const bf16* kr = skb + ((size_t)(hh * 2 + p) * NKEY + n) * PHALF; const float* qq = qs + hh * 256 + p * 128;
            float a = 0.f; for (int c = 0; c < 128; ++c) a += qq[c] * bf2f(kr[c]); sc[idx] = a; }
        __syncthreads();
        for (int p = 0; p < 2; ++p) {
            float v0 = sc[p * 128 + lane], v1 = sc[p * 128 + 64 + lane];
            for (int k = 0; k < 16; ++k) { float v; int id; if (v0 >= v1) { v = v0; id = lane; } else { v = v1; id = lane + 64; }
                float bv; int bi; wave_argmax(v, id, bv, bi);
                if (lane == 0) { if (p == 0) { s1[k] = bv; i1[k] = bi; } else { s2[k] = bv; i2[k] = bi; } }
                if (bi == lane) v0 = -INFINITY; if (bi == lane + 64) v1 = -INFINITY; }
        }
        __syncthreads();
        float cv[4];
#pragma unroll
        for (int r = 0; r < 4; ++r) { const int idx = r * 64 + lane; cv[r] = s1[idx >> 4] + s2[idx & 15]; }
        float tops = 0.f; int topp = 0;
        for (int k = 0; k < 16; ++k) { float v = cv[0]; int id = lane;
#pragma unroll
            for (int r = 1; r < 4; ++r) if (cv[r] > v) { v = cv[r]; id = r * 64 + lane; }
            float bv; int bi; wave_argmax(v, id, bv, bi);
            if (lane == k) { tops = bv; topp = bi; }
#pragma unroll
            for (int r = 0; r < 4; ++r) if (bi == r * 64 + lane) cv[r] = -INFINITY; }
        float mx = lane < 16 ? tops : -INFINITY;
#pragma unroll
        for (int o = 1; o < 64; o <<= 1) mx = fmaxf(mx, __shfl_xor(mx, o));
        const float ev = lane < 16 ? expf(tops - mx) : 0.f; const float den = wave_sum(ev);
        if (lane < 16) { ex[hh * 16 + lane] = i1[topp >> 4] * NKEY + i2[topp & 15]; gt[hh * 16 + lane] = ev / den; }
        __syncthreads();
    }
    float hv[16], y[16];
    const float* x1 = out + (size_t)t * DMODEL;
#pragma unroll
    for (int j = 0; j < 4; ++j) { const float4 v = *(const float4*)(x1 + j * 256 + lane * 4); hv[4 * j] = v.x * rstd2; hv[4 * j + 1] = v.y * rstd2; hv[4 * j + 2] = v.z * rstd2; hv[4 * j + 3] = v.w * rstd2; }
#pragma unroll
    for (int i = 0; i < 16; ++i) y[i] = 0.f;
    for (int k = 0; k < 128; ++k) { const int e = ex[k]; const float g = gt[k]; float a = 0.f;
#pragma unroll
        for (int j = 0; j < 4; ++j) { const uint2 w = *(const uint2*)(ut + (size_t)e * DMODEL + j * 256 + lane * 4);
            a += hv[4 * j] * bf2f(w.x & 0xffff) + hv[4 * j + 1] * bf2f(w.x >> 16) + hv[4 * j + 2] * bf2f(w.y & 0xffff) + hv[4 * j + 3] * bf2f(w.y >> 16); }
        a = wave_sum(a); const float act = gelu_tanh(a) * g;
#pragma unroll
        for (int j = 0; j < 4; ++j) { const uint2 w = *(const uint2*)(vt + (size_t)e * DMODEL + j * 256 + lane * 4);
            y[4 * j] += act * bf2f(w.x & 0xffff); y[4 * j + 1] += act * bf2f(w.x >> 16); y[4 * j + 2] += act * bf2f(w.y & 0xffff); y[4 * j + 3] += act * bf2f(w.y >> 16); } }
    float ss = 0.f;
#pragma unroll
    for (int j = 0; j < 4; ++j) { const float4 v = *(const float4*)(x1 + j * 256 + lane * 4); y[4 * j] += v.x; y[4 * j + 1] += v.y; y[4 * j + 2] += v.z; y[4 * j + 3] += v.w; }
#pragma unroll
    for (int i = 0; i < 16; ++i) ss += y[i] * y[i];
    const float rs = rsqrtf(wave_sum(ss) * (1.f / DMODEL) + RMS_EPS);
#pragma unroll
    for (int j = 0; j < 4; ++j) { const float4 g = *(const float4*)(fg + j * 256 + lane * 4); float4 o; o.x = y[4 * j] * rs * g.x; o.y = y[4 * j + 1] * rs * g.y; o.z = y[4 * j + 2] * rs * g.z; o.w = y[4 * j + 3] * rs * g.w;
        *(float4*)(out + (size_t)t * DMODEL + j * 256 + lane * 4) = o; }
}
}

namespace pg8 {
#define PG8_LAS __attribute__((address_space(3)))
typedef unsigned short bf16_t;
typedef short bf16x8 __attribute__((ext_vector_type(8)));
typedef float f32x4 __attribute__((ext_vector_type(4)));
typedef unsigned u32x4 __attribute__((ext_vector_type(4)));
constexpr int BM = 256, BK = 64, HALF = 128, HTB = HALF * BK * 2  , STAGE_BYTES = 8 * HTB, NXCD = 8, WGM = 8;

__host__ __device__ __forceinline__ int lds_byte(int r, int c) { const int st = (r >> 4) * 2 + (c >> 5), rr = r & 15, cc = c & 31, ob = rr * 64 + cc * 2; return st * 1024 + (ob ^ (((ob >> 9) & 1) << 5)); }
__host__ __device__ __forceinline__ void stage_rc(int b, int& R, int& C) { const int st = b / 1024, sb = b % 1024, swz = sb ^ (((sb >> 9) & 1) << 5); R = (st >> 1) * 16 + swz / 64; C = (st & 1) * 32 + (swz % 64) / 2; }
__host__ __device__ __forceinline__ int perm32(int rho) { const int n = rho >> 4, i = rho & 15; return 8 * (i >> 2) + 4 * n + (i & 3); }

struct Unit { int pm, pn; };
struct Gemm { const bf16_t* A; const bf16_t* Bt; int M, N, K; };

struct StaticOrder {
    int nM, nN, nwg, G, c;
    __host__ __device__ void init(int M, int N, int G_, int c_) { nM = M / BM; nN = N / BM; nwg = nM * nN; G = G_; c = c_; }
    __host__ __device__ bool next(int i, Unit& u) const {
        const long L = (long)i * G + c; if (L >= nwg) return false;
        int wgid = (int)L; { const int q = nwg / NXCD, r = nwg % NXCD, xcd = wgid % NXCD, off = wgid / NXCD; wgid = (xcd < r ? xcd * (q + 1) : r * (q + 1) + (xcd - r) * q) + off; }
        const int nig = WGM * nN, gid = wgid / nig, fm = gid * WGM, gsz = (nM - fm) < WGM ? (nM - fm) : WGM;
        u.pm = fm + ((wgid % nig) % gsz); u.pn = (wgid % nig) / gsz; return true;
    }
    __device__ __forceinline__ void a_ready(const Unit&) const {}
    __device__ __forceinline__ void done(const Unit&) const {}
};

__device__ __forceinline__ unsigned cvt_pk_bf16(float lo, float hi) { unsigned r; asm volatile("v_cvt_pk_bf16_f32 %0, %1, %2" : "=v"(r) : "v"(lo), "v"(hi)); return r; }
typedef unsigned u32x2 __attribute__((ext_vector_type(2)));
__device__ __forceinline__ float gelu_fast(float x) {
    const float u2 = x * (1.5957691216057308f + 0.07135481627f * x * x);
    return x * __builtin_amdgcn_rcpf(1.f + __builtin_amdgcn_exp2f(-1.4426950408889634f * u2));
}
struct EpiG1 {
    static constexpr bool PERM = true, AFTER_DRAIN = false;
    bf16_t* base0; size_t split_stride; float qscale;
    __device__ __forceinline__ void operator()(const f32x4 (&acc)[2][2][4][2], const Unit& u, int wr, int wc, int fr, int fq) const {
        const int s = u.pn >> 1; bf16_t* base = base0 + (size_t)s * split_stride;
        const int row0 = u.pm * BM + wr * 64 + fr, col0 = (u.pn & 1) * 256 + wc * 32 + 8 * fq;
#pragma unroll
        for (int ai = 0; ai < 2; ++ai)
#pragma unroll
            for (int m = 0; m < 4; ++m) { bf16_t* rowp = base + (size_t)(row0 + ai * HALF + m * 16) * 512 + col0;
#pragma unroll
                for (int bj = 0; bj < 2; ++bj) { f32x4 v0 = acc[ai][bj][m][0], v1 = acc[ai][bj][m][1];
                    if (s == 1) {
#pragma unroll
                        for (int e = 0; e < 4; ++e) { v0[e] = gelu_fast(v0[e]); v1[e] = gelu_fast(v1[e]); } }
                    else if (s == 2) { v0 = v0 * qscale; v1 = v1 * qscale; }
                    u32x4 w; w.x = cvt_pk_bf16(v0[0], v0[1]); w.y = cvt_pk_bf16(v0[2], v0[3]); w.z = cvt_pk_bf16(v1[0], v1[1]); w.w = cvt_pk_bf16(v1[2], v1[3]);
                    *(u32x4*)(rowp + bj * HALF) = w; } }
    }
};
struct EpiG2 {
    static constexpr bool PERM = false, AFTER_DRAIN = false;
    const float* resid; float* out; bf16_t* xb; float* sumsq; int ldc;
    __device__ __forceinline__ void operator()(const f32x4 (&acc)[2][2][4][2], const Unit& u, int wr, int wc, int fr, int fq) const {
        const int row0 = u.pm * BM + wr * 64 + fr, col0 = u.pn * BM + wc * 32 + 4 * fq;
#pragma unroll
        for (int ai = 0; ai < 2; ++ai)
#pragma unroll
            for (int m = 0; m < 4; ++m) { const int r = row0 + ai * HALF + m * 16; const size_t off = (size_t)r * ldc + col0; float ss = 0.f;
#pragma unroll
                for (int bj = 0; bj < 2; ++bj)
#pragma unroll
                    for (int n = 0; n < 2; ++n) { const f32x4 x = *(const f32x4*)(resid + off + bj * HALF + n * 16) + acc[ai][bj][m][n];
                        *(f32x4*)(out + off + bj * HALF + n * 16) = x; ss += (x[0] * x[0] + x[1] * x[1]) + (x[2] * x[2] + x[3] * x[3]);
                        u32x2 w; w.x = cvt_pk_bf16(x[0], x[1]); w.y = cvt_pk_bf16(x[2], x[3]); *(u32x2*)(xb + off + bj * HALF + n * 16) = w; }
                ss += __shfl_xor(ss, 16); ss += __shfl_xor(ss, 32);
                if (fq == 0) atomicAdd(sumsq + r, ss);
                asm volatile("" ::: "memory"); }
    }
};
struct EpiG3 {
    static constexpr bool PERM = true, AFTER_DRAIN = false;
    bf16_t* O; int ldc;
    __device__ __forceinline__ void operator()(const f32x4 (&acc)[2][2][4][2], const Unit& u, int wr, int wc, int fr, int fq) const {
        const int row0 = u.pm * BM + wr * 64 + fr, col0 = u.pn * BM + wc * 32 + 8 * fq;
#pragma unroll
        for (int ai = 0; ai < 2; ++ai)
#pragma unroll
            for (int m = 0; m < 4; ++m) { bf16_t* rowp = O + (size_t)(row0 + ai * HALF + m * 16) * ldc + col0;
#pragma unroll
                for (int bj = 0; bj < 2; ++bj) { const f32x4 v0 = acc[ai][bj][m][0], v1 = acc[ai][bj][m][1];
                    u32x4 w; w.x = cvt_pk_bf16(v0[0], v0[1]); w.y = cvt_pk_bf16(v0[2], v0[3]); w.z = cvt_pk_bf16(v1[0], v1[1]); w.w = cvt_pk_bf16(v1[2], v1[3]);
                    *(u32x4*)(rowp + bj * HALF) = w; } }
    }
};

template <class Epi, class Sched, bool ALIGN_EPI = false, bool SP2 = false>
__device__ __forceinline__ void gemm_phase(PG8_LAS unsigned char* lds, const Gemm g, const Sched& S, const Epi& E, int wid_in) {
    const int wid = __builtin_amdgcn_readfirstlane(wid_in), lane = (int)__builtin_amdgcn_mbcnt_hi(~0u, __builtin_amdgcn_mbcnt_lo(~0u, 0u)), tid = wid * 64 + lane, wr = wid >> 2, wc = wid & 3, fr = lane & 15, fq = lane >> 4;
    const int K = g.K, nt = K / BK;
    unsigned voffA[2], voffB[2];
#pragma unroll
    for (int i = 0; i < 2; ++i) { int R, C; stage_rc(tid * 16 + i * 8192, R, C); const int Rb = Epi::PERM ? ((R & ~31) + perm32(R & 31)) : R;
        voffA[i] = (unsigned)(R * K + C) * 2u; voffB[i] = (unsigned)(Rb * K + C) * 2u; }
    const size_t kstep = (size_t)(BK * 2);
    const size_t hstep = (size_t)HALF * K * 2;
    const size_t tstep = 2 * hstep;
    const unsigned ldsw = (unsigned)wid * 1024u;
    const int aoff = lds_byte(wr * 64 + fr, fq * 8), boff = lds_byte(wc * 32 + fr, fq * 8);
#define PG8_SA(b, h) (((b) * 2 + (h)) * HTB)
#define PG8_SB(b, h) ((4 + (b) * 2 + (h)) * HTB)
#define PG8_STAGE(bufoff, gbase, voff) do { _Pragma("unroll") for (int _i = 0; _i < 2; ++_i) \
        __builtin_amdgcn_global_load_lds((const unsigned*)((const char*)(gbase) + (voff)[_i]), (PG8_LAS unsigned*)(lds + (bufoff) + ldsw + _i * 8192), 16, 0, 0); } while (0)
#define PG8_LDA(dst, b, h) do { _Pragma("unroll") for (int m = 0; m < 4; ++m) _Pragma("unroll") for (int k = 0; k < 2; ++k) dst[m][k] = *(const PG8_LAS bf16x8*)(lds + PG8_SA(b, h) + aoff + m * 2048 + k * 1024); } while (0)
#define PG8_LDB(dst, b, h) do { _Pragma("unroll") for (int n = 0; n < 2; ++n) _Pragma("unroll") for (int k = 0; k < 2; ++k) dst[n][k] = *(const PG8_LAS bf16x8*)(lds + PG8_SB(b, h) + boff + n * 2048 + k * 1024); } while (0)
#define PG8_MMA(ai, bj, At, Bt) do { __builtin_amdgcn_s_setprio(1); _Pragma("unroll") for (int m = 0; m < 4; ++m) _Pragma("unroll") for (int n = 0; n < 2; ++n) _Pragma("unroll") for (int k = 0; k < 2; ++k) \
        acc[ai][bj][m][n] = __builtin_amdgcn_mfma_f32_16x16x32_bf16(Bt[n][k], At[m][k], acc[ai][bj][m][n], 0, 0, 0); __builtin_amdgcn_s_setprio(0); } while (0)
#define PG8_WAIT_V(n) asm volatile("s_waitcnt vmcnt(" #n ")" ::: "memory")
#define PG8_WAIT_L(n) asm volatile("s_waitcnt lgkmcnt(" #n ")" ::: "memory")
#define PG8_BAR __builtin_amdgcn_s_barrier()
#define PG8_SCHED __builtin_amdgcn_sched_barrier(0)
    Unit cur, nxt; int ui = 0;
    if (!S.next(0, cur)) return;
    f32x4 acc[2][2][4][2];
#pragma unroll
    for (int a = 0; a < 2; ++a)
#pragma unroll
        for (int b = 0; b < 2; ++b)
#pragma unroll
            for (int m = 0; m < 4; ++m)
#pragma unroll
                for (int n = 0; n < 2; ++n) acc[a][b][m][n] = (f32x4){0.f, 0.f, 0.f, 0.f};
    bf16x8 At[4][2], B0[2][2], B1[2][2];
    const char* cA = (const char*)g.A + (size_t)cur.pm * tstep; const char* cB = (const char*)g.Bt + (size_t)cur.pn * tstep;
    S.a_ready(cur);
    if constexpr (SP2) {
        PG8_STAGE(PG8_SB(0, 0), cB, voffB); PG8_STAGE(PG8_SB(0, 1), cB + hstep, voffB); PG8_STAGE(PG8_SA(0, 0), cA, voffA); PG8_STAGE(PG8_SA(0, 1), cA + hstep, voffA);
        if (wr == 1) PG8_BAR;
        PG8_WAIT_V(2); PG8_BAR;
        PG8_STAGE(PG8_SB(1, 0), cB + kstep, voffB); PG8_STAGE(PG8_SA(1, 0), cA + kstep, voffA); PG8_STAGE(PG8_SB(1, 1), cB + hstep + kstep, voffB);
        PG8_WAIT_V(6); PG8_BAR;
    } else {
        PG8_STAGE(PG8_SB(0, 0), cB, voffB); PG8_STAGE(PG8_SA(0, 0), cA, voffA); PG8_STAGE(PG8_SB(0, 1), cB + hstep, voffB); PG8_STAGE(PG8_SA(0, 1), cA + hstep, voffA);
        if (wr == 1) PG8_BAR;
        PG8_WAIT_V(4); PG8_BAR;
        PG8_STAGE(PG8_SB(1, 0), cB + kstep, voffB); PG8_STAGE(PG8_SA(1, 0), cA + kstep, voffA); PG8_STAGE(PG8_SB(1, 1), cB + hstep + kstep, voffB);
        PG8_WAIT_V(6); PG8_BAR;
    }
    for (;;) {
        const bool has_next = S.next(ui + 1, nxt);
        const char* nA = has_next ? (const char*)g.A + (size_t)nxt.pm * tstep : cA; const char* nB = has_next ? (const char*)g.Bt + (size_t)nxt.pn * tstep : cB;
        for (int t = 0; t < nt; t += 2) {
            const bool last = (t == nt - 2);
            const char* a1 = cA + (size_t)(t + 1) * kstep;
            const char* a2 = last ? nA : cA + (size_t)(t + 2) * kstep; const char* b2 = last ? nB : cB + (size_t)(t + 2) * kstep;
            const char* a3 = a2 + kstep; const char* b3 = b2 + kstep;
            if (last && has_next) S.a_ready(nxt);
            if constexpr (SP2) {
            PG8_LDB(B0, 0, 0); PG8_LDB(B1, 0, 1); PG8_SCHED; PG8_LDA(At, 0, 0); PG8_STAGE(PG8_SA(1, 1), a1 + hstep, voffA);
            PG8_WAIT_V(8); PG8_WAIT_L(0); PG8_BAR; PG8_MMA(0, 0, At, B0); PG8_MMA(0, 1, At, B1); PG8_BAR; PG8_SCHED;
            PG8_LDA(At, 0, 1); PG8_STAGE(PG8_SB(0, 0), b2, voffB); PG8_STAGE(PG8_SB(0, 1), b2 + hstep, voffB); PG8_STAGE(PG8_SA(0, 0), a2, voffA);
            PG8_WAIT_V(8); PG8_WAIT_L(0); PG8_BAR; PG8_MMA(1, 0, At, B0); PG8_MMA(1, 1, At, B1); PG8_BAR; PG8_SCHED;
            PG8_LDB(B0, 1, 0); PG8_LDB(B1, 1, 1); PG8_SCHED; PG8_LDA(At, 1, 0); PG8_STAGE(PG8_SA(0, 1), a2 + hstep, voffA);
            PG8_WAIT_V(8); PG8_WAIT_L(0); PG8_BAR; PG8_MMA(0, 0, At, B0); PG8_MMA(0, 1, At, B1); PG8_BAR; PG8_SCHED;
            PG8_LDA(At, 1, 1); PG8_STAGE(PG8_SB(1, 0), b3, voffB); PG8_STAGE(PG8_SB(1, 1), b3 + hstep, voffB); PG8_STAGE(PG8_SA(1, 0), a3, voffA);
            PG8_WAIT_V(8); PG8_WAIT_L(0); PG8_BAR; PG8_MMA(1, 0, At, B0); PG8_MMA(1, 1, At, B1); PG8_BAR; PG8_SCHED;
            } else {
            PG8_LDB(B0, 0, 0); PG8_SCHED; PG8_LDA(At, 0, 0); PG8_STAGE(PG8_SA(1, 1), a1 + hstep, voffA);
            PG8_WAIT_L(8); PG8_BAR; PG8_WAIT_L(0); PG8_MMA(0, 0, At, B0); PG8_BAR; PG8_SCHED;
            PG8_LDB(B1, 0, 1); PG8_STAGE(PG8_SB(0, 0), b2, voffB);
            PG8_BAR; PG8_WAIT_L(0); PG8_MMA(0, 1, At, B1); PG8_BAR;
            PG8_LDA(At, 0, 1); PG8_STAGE(PG8_SA(0, 0), a2, voffA);
            PG8_BAR; PG8_WAIT_L(0); PG8_MMA(1, 0, At, B0); PG8_BAR; PG8_SCHED;
            PG8_STAGE(PG8_SB(0, 1), b2 + hstep, voffB);
            PG8_WAIT_V(6); PG8_BAR; PG8_MMA(1, 1, At, B1); PG8_BAR;
            PG8_LDB(B0, 1, 0); PG8_SCHED; PG8_LDA(At, 1, 0); PG8_STAGE(PG8_SA(0, 1), a2 + hstep, voffA);
            PG8_WAIT_L(8); PG8_BAR; PG8_WAIT_L(0); PG8_MMA(0, 0, At, B0); PG8_BAR; PG8_SCHED;
            PG8_LDB(B1, 1, 1); PG8_STAGE(PG8_SB(1, 0), b3, voffB);
            PG8_BAR; PG8_WAIT_L(0); PG8_MMA(0, 1, At, B1); PG8_BAR;
            PG8_LDA(At, 1, 1); PG8_STAGE(PG8_SA(1, 0), a3, voffA);
            PG8_BAR; PG8_WAIT_L(0); PG8_MMA(1, 0, At, B0); PG8_BAR; PG8_SCHED;
            PG8_STAGE(PG8_SB(1, 1), b3 + hstep, voffB);
            PG8_WAIT_V(6); PG8_BAR; PG8_MMA(1, 1, At, B1); PG8_BAR;
            }
        }
        if constexpr (ALIGN_EPI) { if (wr == 0) PG8_BAR; }
        if constexpr (!Epi::AFTER_DRAIN) { E(acc, cur, wr, wc, fr, fq); S.done(cur); }
        if (!has_next) break;
#pragma unroll
        for (int a = 0; a < 2; ++a)
#pragma unroll
            for (int b = 0; b < 2; ++b)
#pragma unroll
                for (int m = 0; m < 4; ++m)
#pragma unroll
                    for (int n = 0; n < 2; ++n) acc[a][b][m][n] = (f32x4){0.f, 0.f, 0.f, 0.f};
        cur = nxt; cA = nA; cB = nB; ++ui;
        if constexpr (ALIGN_EPI) { if (wr == 1) PG8_BAR; }
    }
    PG8_WAIT_V(0);
    if constexpr (!ALIGN_EPI) { if (wr == 0) PG8_BAR; }
    PG8_BAR;
    if constexpr (Epi::AFTER_DRAIN) { E.fused(acc, cur, wr, wc, fr, fq, lds, wid, lane); S.done(cur); }
#undef PG8_SA
#undef PG8_SB
#undef PG8_STAGE
#undef PG8_LDA
#undef PG8_LDB
#undef PG8_MMA
#undef PG8_WAIT_V
#undef PG8_WAIT_L
#undef PG8_BAR
#undef PG8_SCHED
}
}
#include <hip/hip_bf16.h>
#include <cmath>
namespace attn_body {
using bf16=__hip_bfloat16;
using bf16x8=__attribute__((ext_vector_type(8)))short;
using s16x4=__attribute__((ext_vector_type(4)))short;
using f32x16=__attribute__((ext_vector_type(16)))float;
using u32x4=__attribute__((ext_vector_type(4)))unsigned;
constexpr int BATCH=4,NHEAD=8,SEQ=8192,D=64,DM=NHEAD*D;
constexpr int NW=8,QBLK=32,QB=QBLK*NW,KVBLK=64,NQB=SEQ/QB;
constexpr int ATTN_PITCH=DM, ATTN_UNIT_ROWS=QB;
__device__ __forceinline__ int crow(int r,int hi){return (r&3)+8*(r>>2)+4*hi;}
#define SBAR() __builtin_amdgcn_sched_barrier(0)
__device__ __forceinline__ void cmask(f32x16&p0,f32x16&p1,int jb,int qrel,int hi){
  const float NEG=-INFINITY; int kb=64*jb+4*hi;
  #pragma unroll
  for(int r=0;r<16;++r){int kv=kb+(r&3)+8*(r>>2); if(kv>qrel)p0[r]=NEG; if(kv+32>qrel)p1[r]=NEG;}
}

constexpr int NSLOT=3, SLOTB=8192;
constexpr int LDS_K=0, LDS_V=NSLOT*SLOTB, LDS_WS=2*NSLOT*SLOTB, LDS_OST=LDS_WS+NW*64*4, LDS_FK=LDS_OST+NW*4096, LDS_BYTES=LDS_FK+SEQ*4;
constexpr float C2=0.125f*1.4426950408889634f;
__device__ __forceinline__ void glds16(const void*gsrc,unsigned lds_dst){unsigned keep;
  asm volatile("s_mov_b32 %0, m0\n\ts_mov_b32 m0, %2\n\ts_nop 0\n\tglobal_load_lds_dwordx4 %1, off\n\ts_mov_b32 m0, %0":"=&s"(keep):"v"(gsrc),"s"(lds_dst):"memory");}
__device__ __forceinline__ float max3f(float a,float b,float c){float r;asm("v_max3_f32 %0, %1, %2, %3":"=v"(r):"v"(a),"v"(b),"v"(c));return r;}
__device__ __forceinline__ float max2f(float a,float b){float r;asm("v_max_f32_e32 %0, %1, %2":"=v"(r):"v"(a),"v"(b));return r;}
__device__ __forceinline__ float fadd_s(float a,float b){float r;asm("v_add_f32_e32 %0, %1, %2":"=v"(r):"v"(a),"v"(b));return r;}
__device__ __forceinline__ float fsub_s(float a,float b){float r;asm("v_sub_f32_e32 %0, %1, %2":"=v"(r):"v"(a),"v"(b));return r;}
typedef float f32x2_t __attribute__((ext_vector_type(2))); typedef __bf16 bf16x2_t __attribute__((ext_vector_type(2)));
__device__ __forceinline__ unsigned cvtpk_s(float lo,float hi){f32x2_t v={lo,hi};bf16x2_t b=__builtin_convertvector(v,bf16x2_t);return __builtin_bit_cast(unsigned,b);}
#define WAIT_BAR(N) asm volatile("s_waitcnt vmcnt(" #N ") lgkmcnt(0)\n\ts_barrier":::"memory")

__device__ __forceinline__ void qkt(f32x16&p0,f32x16&p1,const char*Kslot,const bf16x8*qr,int r32,int hi){
  const char*kb=Kslot+hi*1024+r32*16;
  #pragma unroll
  for(int d0=0;d0<4;++d0){
    const bf16x8 b0=*reinterpret_cast<const bf16x8*>(kb+d0*2048);
    const bf16x8 b1=*reinterpret_cast<const bf16x8*>(kb+d0*2048+512);
    p0=__builtin_amdgcn_mfma_f32_32x32x16_bf16(b0,qr[d0],p0,0,0,0);p1=__builtin_amdgcn_mfma_f32_32x32x16_bf16(b1,qr[d0],p1,0,0,0);}
}
typedef __attribute__((address_space(3))) const char* lds_cptr;
typedef short v4i16_t __attribute__((ext_vector_type(4)));
__device__ __forceinline__ void kload8(bf16x8*kf,lds_cptr kp){
  kf[0]=*(const __attribute__((address_space(3))) bf16x8*)(kp);      kf[1]=*(const __attribute__((address_space(3))) bf16x8*)(kp+512);
  kf[2]=*(const __attribute__((address_space(3))) bf16x8*)(kp+2048); kf[3]=*(const __attribute__((address_space(3))) bf16x8*)(kp+2560);
  kf[4]=*(const __attribute__((address_space(3))) bf16x8*)(kp+4096); kf[5]=*(const __attribute__((address_space(3))) bf16x8*)(kp+4608);
  kf[6]=*(const __attribute__((address_space(3))) bf16x8*)(kp+6144); kf[7]=*(const __attribute__((address_space(3))) bf16x8*)(kp+6656);
}
__device__ __forceinline__ void kload2(bf16x8*kf,lds_cptr kp,int j){ kf[2*j]=*(const __attribute__((address_space(3))) bf16x8*)(kp+j*2048); kf[2*j+1]=*(const __attribute__((address_space(3))) bf16x8*)(kp+j*2048+512); }
__device__ __forceinline__ s16x4 vtr(lds_cptr p){ return __builtin_bit_cast(s16x4,__builtin_amdgcn_ds_read_tr16_b64_v4i16((__attribute__((address_space(3))) v4i16_t*)p)); }
__device__ __forceinline__ float rowmax(const f32x16&p0,const f32x16&p1){
  float a=max3f(p0[0],p0[1],p1[0]),b=max3f(p0[2],p0[3],p1[1]);a=max3f(a,p1[2],p1[3]);
  #pragma unroll
  for(int r=4;r<16;r+=4){a=max3f(a,p0[r],p0[r+1]);b=max3f(b,p0[r+2],p0[r+3]);a=max3f(a,p1[r],p1[r+1]);b=max3f(b,p1[r+2],p1[r+3]);}
  const float m=max2f(a,b);
  auto rr=__builtin_amdgcn_permlane32_swap(__float_as_uint(m),__float_as_uint(m),false,false);
  return max2f(__uint_as_float(rr[0]),__uint_as_float(rr[1]));
}
__device__ __forceinline__ void pv(f32x16*o,int vb,bf16x8 pa0,bf16x8 pa1,bf16x8 pa2,bf16x8 pa3){
  #pragma unroll
  for(int d0=0;d0<2;++d0){s16x4 lo[4],hi[4];
    #pragma unroll
    for(int ks=0;ks<4;++ks){
      asm volatile("ds_read_b64_tr_b16 %0,%1 offset:%c2":"=&v"(lo[ks]):"v"(vb),"i"(d0*4096+ks*1024):"memory");
      asm volatile("ds_read_b64_tr_b16 %0,%1 offset:%c2":"=&v"(hi[ks]):"v"(vb),"i"(d0*4096+ks*1024+512):"memory");}
    asm volatile("s_waitcnt lgkmcnt(0)":::"memory");SBAR();
    #define PK(k) (bf16x8){lo[k][0],lo[k][1],lo[k][2],lo[k][3],hi[k][0],hi[k][1],hi[k][2],hi[k][3]}
    o[d0]=__builtin_amdgcn_mfma_f32_32x32x16_bf16(pa0,PK(0),o[d0],0,0,0);
    o[d0]=__builtin_amdgcn_mfma_f32_32x32x16_bf16(pa1,PK(1),o[d0],0,0,0);
    o[d0]=__builtin_amdgcn_mfma_f32_32x32x16_bf16(pa2,PK(2),o[d0],0,0,0);
    o[d0]=__builtin_amdgcn_mfma_f32_32x32x16_bf16(pa3,PK(3),o[d0],0,0,0);
    #undef PK
  }
}

#ifndef ATTN_STORE16
#define ATTN_STORE16(p,v) (*(u32x4*)(p)=(v))
#endif
template<int THRL> __device__ __forceinline__ void attn_unit(int b,int h,int qb,const bf16*Q,const bf16*__restrict__ K,const bf16*__restrict__ V,bf16*O,const float*__restrict__ Fc,const float*__restrict__ NRM,char*shm,int wid_in){
  const int wid=__builtin_amdgcn_readfirstlane(wid_in); int lane_=(int)__builtin_amdgcn_mbcnt_hi(~0u,__builtin_amdgcn_mbcnt_lo(~0u,0u)); asm volatile("":"+v"(lane_));
  const int lane=lane_,tid=wid*64+lane,r32=lane&31,hi=lane>>5;
  const long rowbase=(long)b*SEQ; const int q0=qb*QB;
  const float*Fbh=Fc+(long)(b*NHEAD+h)*SEQ;
  const int NTF=(q0+QB)/KVBLK; int t_start;
  { const float*QNb=NRM+(b*NHEAD+h)*128,*KNb=NRM+4096+(b*NHEAD+h)*128;
    const float qn=fmaxf(fmaxf(QNb[4*qb],QNb[4*qb+1]),fmaxf(QNb[4*qb+2],QNb[4*qb+3])),knb=fmaxf(fmaxf(KNb[4*qb],KNb[4*qb+1]),fmaxf(KNb[4*qb+2],KNb[4*qb+3]));
    const float fq0=Fbh[q0]*1.4426950408889634f; bool k0=true,k1=true;
    if(lane<NTF-4)k0=!(qn*(KNb[lane]+knb)+(fq0-Fbh[64*lane+63]*1.4426950408889634f)<-40.f);
    if(lane+64<NTF-4)k1=!(qn*(KNb[lane+64]+knb)+(fq0-Fbh[64*(lane+64)+63]*1.4426950408889634f)<-40.f);
    const unsigned long long m0=__ballot(k0),m1=__ballot(k1);
    int tf=m0?(int)__builtin_ctzll(m0):64+(m1?(int)__builtin_ctzll(m1):64);
    tf=tf<NTF-4?tf:NTF-4; t_start=__builtin_amdgcn_readfirstlane(tf&~1); }
  { typedef float f32x4_t __attribute__((ext_vector_type(4))); __attribute__((address_space(3))) float*fk=(__attribute__((address_space(3))) float*)((__attribute__((address_space(3))) char*)shm+LDS_FK); const int n4=(q0+QB)/4;
    for(int i=16*t_start+tid;i<n4;i+=NW*64){ f32x4_t v=*(const f32x4_t*)(Fbh+4*i); v=v*(-1.4426950408889634f); *(__attribute__((address_space(3))) f32x4_t*)(fk+4*i)=v; } }
  float fq2=Fbh[q0+wid*QBLK+r32]*1.4426950408889634f; asm volatile("":"+v"(fq2));
  const bf16*Qw=Q+(rowbase+q0+wid*QBLK)*DM+h*D;
  const bf16*Kh=K+(rowbase+(long)t_start*KVBLK)*DM+h*D,*Vh=V+(rowbase+(long)t_start*KVBLK)*DM+h*D;
  const lds_cptr shm3=(lds_cptr)shm;
  const unsigned lds0=(unsigned)(uintptr_t)shm;
  float*wsf=(float*)(shm+LDS_WS)+wid*64;
  const bf16*ksrc=Kh+(long)lane*DM+wid*8;
  const bf16*vsrc=Vh+(long)(16*(wid&3)+(lane>>2))*DM+(wid>>2)*32+(lane&3)*8;
  const unsigned kdst=lds0+LDS_K+wid*1024, vdst=lds0+LDS_V+wid*1024;
  #define DMA_K(t,slot) glds16(ksrc+(long)(t)*KVBLK*DM,(unsigned)__builtin_amdgcn_readfirstlane(kdst+(slot)))
  #define DMA_V(t,slot) glds16(vsrc+(long)(t)*KVBLK*DM,(unsigned)__builtin_amdgcn_readfirstlane(vdst+(slot)))
  const int vb0=(int)(lds0+LDS_V)+((lane>>4)&1)*32+(lane&3)*8+(4*hi+((lane&15)>>2))*64;
  const char*Kbase=shm+LDS_K; bf16x8 kf[8];
  const lds_cptr kp0=shm3+LDS_K+hi*1024+r32*16; const lds_cptr vp0=shm3+LDS_V+((lane>>4)&1)*32+(lane&3)*8+(4*hi+((lane&15)>>2))*64;
  const int NT=NTF-t_start;
  DMA_K(0,0);DMA_V(0,0);DMA_K(1,SLOTB);
  bf16x8 qr[4];
  #pragma unroll
  for(int d0=0;d0<4;++d0)qr[d0]=*reinterpret_cast<const bf16x8*>(&Qw[(long)r32*DM+d0*16+hi*8]);
  float mhat=0.f,l_reg=0.f;f32x16 o[2];o[0]=f32x16{};o[1]=f32x16{};
  const __attribute__((address_space(3))) float*fkl=(const __attribute__((address_space(3))) float*)(shm3+LDS_FK)+64*t_start+4*hi;
  #define INITC(C0,C1,t) do{ const float nsc_=fq2-mhat; typedef float f32x4_t __attribute__((ext_vector_type(4))); const __attribute__((address_space(3))) float*kb_=fkl+64*(t); \
    _Pragma("unroll") for(int g_=0;g_<4;++g_){ const f32x4_t a_=*(const __attribute__((address_space(3))) f32x4_t*)(kb_+8*g_), b_=*(const __attribute__((address_space(3))) f32x4_t*)(kb_+32+8*g_); \
      _Pragma("unroll") for(int e_=0;e_<4;++e_){ C0[4*g_+e_]=nsc_+a_[e_]; C1[4*g_+e_]=nsc_+b_[e_]; } } }while(0)
  const int qrel=wid*QBLK+r32;
  #define CMASK(P0,P1,t) do{int jb_=(t)-(NT-4); if(jb_>=0)cmask(P0,P1,jb_,qrel,hi);}while(0)
  bool resc=false;
  #define START(P0,P1) do{ const float rm=rowmax(P0,P1); resc=false; \
    { const float dl=rm; mhat=fadd_s(mhat,dl); \
      _Pragma("unroll") for(int r=0;r<16;++r){P0[r]=fsub_s(P0[r],dl);P1[r]=fsub_s(P1[r],dl);} \
      } \
    _Pragma("unroll") for(int r=0;r<16;++r)P0[r]=__builtin_amdgcn_exp2f(P0[r]); }while(0)
  #define RESC() do{ if(resc){ asm volatile("s_waitcnt lgkmcnt(0)":::"memory"); \
      _Pragma("unroll") for(int d_=0;d_<2;++d_) _Pragma("unroll") for(int r=0;r<16;++r)o[d_][r]*=wsf[crow(r,hi)]; } }while(0)
  f32x16 pA0,pA1,pB0,pB1;
  int sl_prev=0,sl_cur=0,sl_next=SLOTB;
  #define ROT() do{sl_prev=sl_cur;sl_cur=sl_next;sl_next=(sl_next==(NSLOT-1)*SLOTB)?0:sl_next+SLOTB;}while(0)
  DMA_K(2,2*SLOTB);
  WAIT_BAR(3);
  INITC(pA0,pA1,0); qkt(pA0,pA1,Kbase,qr,r32,hi);asm volatile("s_nop 15\n\ts_nop 7":"+v"(pA0),"+v"(pA1));CMASK(pA0,pA1,0);
  START(pA0,pA1);
  _Pragma("unroll") for(int r=0;r<16;++r)pA1[r]=__builtin_amdgcn_exp2f(pA1[r]);
  WAIT_BAR(0);
  DMA_K(3,0);DMA_V(1,SLOTB);
  ROT();
  kload8(kf,kp0+sl_cur);
  WAIT_BAR(2);
  s16x4 vlo[8],vhi[8]; u32x4 pw0,pw1,pw2,pw3;
  #define PKW(P,B) cvtpk_s(P[B],P[B+1])
  #define PAF(k) __builtin_bit_cast(bf16x8,pw##k)
  #define VFR(i) (bf16x8){vlo[i][0],vlo[i][1],vlo[i][2],vlo[i][3],vhi[i][0],vhi[i][1],vhi[i][2],vhi[i][3]}
  #define PIN(x) asm volatile("":"+v"(x))
  #define MX3(a,b,c) __builtin_fmaxf(__builtin_fmaxf((a),(b)),(c))
  #define GAPA(MF,A0,A1,A2,A3,W0,W1,PW) do{ MF; sacc+=A0; sacc+=A1; sacc+=A2; sacc+=A3; PIN(sacc); W0; W1; PIN(PW); SBAR(); }while(0)
  #define EX(v) __builtin_amdgcn_exp2f(v)
  #define GAPB(MF,X,B) do{ MF; X[B]=EX(X[B]); X[B+1]=EX(X[B+1]); X[B+2]=EX(X[B+2]); X[B+3]=EX(X[B+3]); PIN(X); SBAR(); }while(0)
  #define VRD(i) do{ vlo[i]=vtr(vp_+(((i)>>2)*4096+((i)&3)*1024)); vhi[i]=vtr(vp_+(((i)>>2)*4096+((i)&3)*1024+512)); }while(0)
  #define KRD(G,j) do{ if(G){ kload2(kf,kp0+sl_next,j); SBAR(); } }while(0)
  #define STEP(C0,C1,P0,P1,t,GK,GV,GL) do{ SBAR(); INITC(C0,C1,t); PIN(C0); PIN(C1); SBAR(); \
    const lds_cptr vp_=vp0+sl_prev; \
    VRD(0); SBAR(); float sacc=(P0[0]+P0[1]); \
    GAPA(C0=__builtin_amdgcn_mfma_f32_32x32x16_bf16(kf[0],qr[0],C0,0,0,0), P0[2],P0[3],P0[4],P0[5],     pw0[0]=PKW(P0,0), pw0[1]=PKW(P0,2), pw0); \
    VRD(4); SBAR(); GAPA(C1=__builtin_amdgcn_mfma_f32_32x32x16_bf16(kf[1],qr[0],C1,0,0,0), P0[6],P0[7],P0[8],P0[9],     pw0[2]=PKW(P0,4), pw0[3]=PKW(P0,6), pw0); \
    VRD(1); SBAR(); GAPA(C0=__builtin_amdgcn_mfma_f32_32x32x16_bf16(kf[2],qr[1],C0,0,0,0),   P0[10],P0[11],P0[12],P0[13], pw1[0]=PKW(P0,8), pw1[1]=PKW(P0,10), pw1); \
    VRD(5); SBAR(); GAPA(C1=__builtin_amdgcn_mfma_f32_32x32x16_bf16(kf[3],qr[1],C1,0,0,0),   P0[14],P0[15],P1[0],P1[1],   pw1[2]=PKW(P0,12),pw1[3]=PKW(P0,14), pw1); \
    VRD(2); SBAR(); GAPA(C0=__builtin_amdgcn_mfma_f32_32x32x16_bf16(kf[4],qr[2],C0,0,0,0),   P1[2],P1[3],P1[4],P1[5],     pw2[0]=PKW(P1,0), pw2[1]=PKW(P1,2), pw2); \
    VRD(6); SBAR(); GAPA(C1=__builtin_amdgcn_mfma_f32_32x32x16_bf16(kf[5],qr[2],C1,0,0,0),   P1[6],P1[7],P1[8],P1[9],     pw2[2]=PKW(P1,4), pw2[3]=PKW(P1,6), pw2); \
    VRD(3); SBAR(); GAPA(C0=__builtin_amdgcn_mfma_f32_32x32x16_bf16(kf[6],qr[3],C0,0,0,0),   P1[10],P1[11],P1[12],P1[13], pw3[0]=PKW(P1,8), pw3[1]=PKW(P1,10), pw3); \
    VRD(7); SBAR(); GAPA(C1=__builtin_amdgcn_mfma_f32_32x32x16_bf16(kf[7],qr[3],C1,0,0,0),   P1[14],P1[15],0.f,0.f,       pw3[2]=PKW(P1,12),pw3[3]=PKW(P1,14), pw3); \
    l_reg+=sacc; \
    if(GK){DMA_K((t)+3,sl_cur);} if(GV){DMA_V((t)+1,sl_next);} \
    CMASK(C0,C1,t); \
    { float a=MX3(C0[0],C0[1],C1[0]),b=MX3(C0[2],C0[3],C1[1]); a=MX3(a,C1[2],C1[3]); \
      _Pragma("unroll") for(int r=4;r<16;r+=4){a=MX3(a,C0[r],C0[r+1]);b=MX3(b,C0[r+2],C0[r+3]);a=MX3(a,C1[r],C1[r+1]);b=MX3(b,C1[r+2],C1[r+3]);} \
      float rm=__builtin_fmaxf(a,b); { auto rr=__builtin_amdgcn_permlane32_swap(__float_as_uint(rm),__float_as_uint(rm),false,false); rm=__builtin_fmaxf(__uint_as_float(rr[0]),__uint_as_float(rr[1])); } \
      resc=false; \
      if(__builtin_expect(__any(rm>(float)THRL),0)){ const float dl=__builtin_fmaxf(rm,0.f); mhat+=dl; \
        _Pragma("unroll") for(int r=0;r<16;++r){C0[r]-=dl;C1[r]-=dl;} \
        const float f=__builtin_amdgcn_exp2f(-dl); l_reg*=f; if(hi==0)wsf[r32]=f; resc=true; } } \
    SBAR(); \
    GAPB(o[0]=__builtin_amdgcn_mfma_f32_32x32x16_bf16(PAF(0),VFR(0),o[0],0,0,0), C0,0); \
    GAPB(o[1]=__builtin_amdgcn_mfma_f32_32x32x16_bf16(PAF(0),VFR(4),o[1],0,0,0), C0,4); \
    KRD(GL,0); GAPB(o[0]=__builtin_amdgcn_mfma_f32_32x32x16_bf16(PAF(1),VFR(1),o[0],0,0,0), C0,8); \
    KRD(GL,1); GAPB(o[1]=__builtin_amdgcn_mfma_f32_32x32x16_bf16(PAF(1),VFR(5),o[1],0,0,0), C0,12); \
    KRD(GL,2); GAPB(o[0]=__builtin_amdgcn_mfma_f32_32x32x16_bf16(PAF(2),VFR(2),o[0],0,0,0), C1,0); \
    KRD(GL,3); GAPB(o[1]=__builtin_amdgcn_mfma_f32_32x32x16_bf16(PAF(2),VFR(6),o[1],0,0,0), C1,4); \
    GAPB(o[0]=__builtin_amdgcn_mfma_f32_32x32x16_bf16(PAF(3),VFR(3),o[0],0,0,0), C1,8); \
    GAPB(o[1]=__builtin_amdgcn_mfma_f32_32x32x16_bf16(PAF(3),VFR(7),o[1],0,0,0), C1,12); \
    }while(0)
  int t=1;
  #undef CMASK
  #define CMASK(P0,P1,t) do{}while(0)
  for(;t+5<NT;t+=2){
    STEP(pB0,pB1,pA0,pA1,t,true,true,true);     WAIT_BAR(2); RESC(); ROT();
    STEP(pA0,pA1,pB0,pB1,t+1,true,true,true);   WAIT_BAR(2); RESC(); ROT();
  }
  #undef CMASK
  #define CMASK(P0,P1,t) do{int jb_=(t)-(NT-4); if(jb_>=0)cmask(P0,P1,jb_,qrel,hi);}while(0)
  #define ENDW(tt) do{ if((tt)+3<NT){WAIT_BAR(2);} else if((tt)+2<NT){WAIT_BAR(1);} else {WAIT_BAR(0);} }while(0)
  for(;t+1<NT;t+=2){
    STEP(pB0,pB1,pA0,pA1,t,(t+3<NT),(t+1<NT),(t+1<NT));       ENDW(t);   RESC(); ROT();
    STEP(pA0,pA1,pB0,pB1,t+1,(t+4<NT),(t+2<NT),(t+2<NT));     ENDW(t+1); RESC(); ROT();
  }
  STEP(pB0,pB1,pA0,pA1,NT-1,false,false,false); RESC();
  { float sacc=pB0[0]+pB0[1]; _Pragma("unroll") for(int r=2;r<16;++r)sacc+=pB0[r]; _Pragma("unroll") for(int r=0;r<16;++r)sacc+=pB1[r]; l_reg+=sacc;
    pw0=(u32x4){PKW(pB0,0),PKW(pB0,2),PKW(pB0,4),PKW(pB0,6)};pw1=(u32x4){PKW(pB0,8),PKW(pB0,10),PKW(pB0,12),PKW(pB0,14)};pw2=(u32x4){PKW(pB1,0),PKW(pB1,2),PKW(pB1,4),PKW(pB1,6)};pw3=(u32x4){PKW(pB1,8),PKW(pB1,10),PKW(pB1,12),PKW(pB1,14)};
    SBAR(); pv(o,vb0+sl_cur,PAF(0),PAF(1),PAF(2),PAF(3)); }
  #undef PKW
  #undef PAF
  #undef VFR
  #undef PIN
  #undef MX3
  #undef GAPA
  #undef GAPB
  #undef EX
  #undef VRD
  #undef KRD
  #undef STEP
  #undef ENDW
  {auto rr=__builtin_amdgcn_permlane32_swap(__float_as_uint(l_reg),__float_as_uint(l_reg),false,false);l_reg=__uint_as_float(rr[0])+__uint_as_float(rr[1]);}
  if(hi==0)wsf[32+r32]=l_reg;asm volatile("s_waitcnt lgkmcnt(0)":::"memory");
  float rli[16];
  #pragma unroll
  for(int r=0;r<16;++r)rli[r]=__builtin_amdgcn_rcpf(wsf[32+crow(r,hi)]);
  bf16*Ow=O+(rowbase+q0+wid*QBLK)*DM+h*D;
  { bf16*stg=(bf16*)(shm+LDS_OST)+wid*2048;
    #pragma unroll
    for(int r=0;r<16;++r){const int orow=crow(r,hi);
      #pragma unroll
      for(int d0=0;d0<2;++d0)stg[orow*64+d0*32+r32]=__float2bfloat16(o[d0][r]*rli[r]);}
    asm volatile("s_waitcnt lgkmcnt(0)":::"memory");
    #pragma unroll
    for(int i=0;i<4;++i){const int row=i*8+(lane>>3),ch=lane&7; const u32x4 v=*(const u32x4*)(stg+row*64+ch*8); ATTN_STORE16(Ow+(long)row*DM+ch*8,v);} }
  asm volatile("s_waitcnt lgkmcnt(0)\n\ts_barrier":::"memory");
  #undef DMA_K
  #undef DMA_V
  #undef INITC
  #undef CMASK
  #undef START
  #undef RESC
  #undef ROT
}
constexpr int ATTN_LDS_BYTES=LDS_BYTES;
struct AttnTensors { const bf16* Q; const bf16* K; const bf16* V; bf16* O; const float* F; const float* NRM; };
struct AttnUnit { int bh; int qb; };
struct StaticOrder {
  int vcu;
  __device__ __forceinline__ explicit StaticOrder(int grid,int block):vcu((block%8)*(grid/8)+block/8){}
  __device__ __forceinline__ bool next(int i,AttnUnit&u)const{ if(i>=4)return false; const int s=vcu&7; u.bh=vcu>>3; u.qb=(i==0)?s:(i==1)?15-s:(i==2)?16+s:31-s; return true; }
  __device__ __forceinline__ void a_ready(const AttnUnit&)const{}
  __device__ __forceinline__ void done(const AttnUnit&)const{}
};
template<int THRL=8> __device__ __forceinline__ void attn_phase(char*lds,const AttnTensors&T,unsigned*qctr,volatile __attribute__((address_space(3))) unsigned*qword,int wid_in){
  const int lane0=(int)__builtin_amdgcn_mbcnt_hi(~0u,__builtin_amdgcn_mbcnt_lo(~0u,0u));
  for(;;){
    if(wid_in==0&&lane0==0){ const unsigned n=__hip_atomic_fetch_add(qctr,1u,__ATOMIC_RELAXED,__HIP_MEMORY_SCOPE_AGENT); *qword=n; }
    asm volatile("s_waitcnt vmcnt(0) lgkmcnt(0)\n\ts_barrier":::"memory");
    const int n=__builtin_amdgcn_readfirstlane((int)*qword);
    if(n>=BATCH*NHEAD*NQB)break;
    const int bh=n%(BATCH*NHEAD),qb=NQB-1-n/(BATCH*NHEAD);
    attn_unit<THRL>(bh/NHEAD,bh%NHEAD,qb,T.Q,T.K,T.V,T.O,T.F,T.NRM,lds,wid_in);
  }
}
#undef SBAR
#undef WAIT_BAR
}
#define GAS __attribute__((address_space(1)))
#define LAS __attribute__((address_space(3)))
typedef unsigned short bf16;
typedef unsigned v4u __attribute__((ext_vector_type(4)));
typedef float f32x4 __attribute__((ext_vector_type(4)));
typedef short bf16x8 __attribute__((ext_vector_type(8)));
typedef GAS unsigned gu32;
typedef GAS unsigned long long gu64;
#define RLX_AGENT __ATOMIC_RELAXED, __HIP_MEMORY_SCOPE_AGENT
#define LDS_WAIT() asm volatile("s_waitcnt lgkmcnt(0)" ::: "memory")
#define VM_WAIT() asm volatile("s_waitcnt vmcnt(0)" ::: "memory")
__device__ __forceinline__ unsigned long long rt() { return __builtin_amdgcn_s_memrealtime(); }
__device__ __forceinline__ unsigned f2bf(float f) { unsigned u = __builtin_bit_cast(unsigned, f); return (u + 0x7fffu + ((u >> 16) & 1u)) >> 16; }
__device__ __forceinline__ unsigned pk2(float lo, float hi) { return f2bf(lo) | (f2bf(hi) << 16); }

#define XB_TMO      128
#define XB_XCNT(j)  (256  + 64 * (j))
#define XB_XSUB(j)  (1280 + 64 * (j))
#define XB_XGEN(j)  (2304 + 64 * (j))
#define XB_TOP      3328
#define XB_TOPGEN   3392
#define XCD_BAR_WORDS 3456
#define XB_SPIN_CAP (1u << 18)

__device__ __forceinline__ unsigned xb_ld(unsigned* p)              { return __hip_atomic_load(p, __ATOMIC_RELAXED, __HIP_MEMORY_SCOPE_AGENT); }
__device__ __forceinline__ unsigned xb_add(unsigned* p, unsigned v) { return __hip_atomic_fetch_add(p, v, __ATOMIC_RELAXED, __HIP_MEMORY_SCOPE_AGENT); }
__device__ __forceinline__ unsigned xb_xcc_id() { return (unsigned)__builtin_amdgcn_s_getreg((3 << 11) | 20) & 0xFu; }
#define XB_SPIN(cond, bar) do { unsigned _sp = 0; while (cond) { __builtin_amdgcn_s_sleep(1); \
    if ((++_sp & 255u) == 0u) { if (xb_ld(&(bar)[XB_TMO])) break; if (_sp > XB_SPIN_CAP) { atomicAdd(&(bar)[XB_TMO], 1u); break; } } } } while (0)

struct XcdBarrier {
    unsigned* bar; unsigned x; int wv;
    volatile LAS unsigned* st;
};

__device__ __forceinline__ bool xb_t0(int wv) { return wv == 0 && __builtin_amdgcn_mbcnt_hi(~0u, __builtin_amdgcn_mbcnt_lo(~0u, 0u)) == 0u; }
__device__ __forceinline__ XcdBarrier xcd_barrier_post(unsigned* bar, volatile LAS unsigned* st, int wv) {
    XcdBarrier b; b.bar = bar; b.x = xb_xcc_id(); b.st = st; b.wv = wv;
    if (xb_t0(wv)) (void)xb_add(&bar[XB_XCNT(b.x)], 1u);
    return b;
}
__device__ __forceinline__ void xcd_barrier_complete(unsigned* bar, unsigned x, unsigned& nloc, unsigned& nx) {
    const unsigned G = gridDim.x * gridDim.y * gridDim.z;
    unsigned sum, cnt, mine, sp = 0u;
    for (;;) {
        sum = 0u; cnt = 0u; mine = 0u;
#pragma unroll
        for (unsigned j = 0; j < 16; ++j) { const unsigned c = xb_ld(&bar[XB_XCNT(j)]); sum += c; cnt += (c > 0u) ? 1u : 0u; mine = (j == x) ? c : mine; }
        if (sum == G) break;
        __builtin_amdgcn_s_sleep(1);
        if ((++sp & 255u) == 0u) { if (xb_ld(&bar[XB_TMO])) break; if (sp > XB_SPIN_CAP) { atomicAdd(&bar[XB_TMO], 1u); break; } }
    }
    nloc = mine > 0u ? mine : 1u; nx = cnt > 0u ? cnt : 1u;
}

__device__ __forceinline__ void xcd_barrier(const XcdBarrier& b) {
    asm volatile("s_waitcnt vmcnt(0)" ::: "memory");
    __syncthreads();
    if (xb_t0(b.wv)) {
        unsigned* bar = b.bar;
        __builtin_amdgcn_s_waitcnt(0);
        unsigned nloc = b.st[0], nx = b.st[1];
        if (nloc == 0u) { xcd_barrier_complete(bar, b.x, nloc, nx); b.st[0] = nloc; b.st[1] = nx; }
        const unsigned old = xb_add(&bar[XB_XSUB(b.x)], 1u);
        const unsigned gen = old / nloc;
        if (old + 1u == (gen + 1u) * nloc) {
            __builtin_amdgcn_fence(__ATOMIC_RELEASE, "agent");
            asm volatile("s_waitcnt vmcnt(0)" ::: "memory");
            const unsigned og = xb_add(&bar[XB_TOP], 1u);
            const unsigned tg = og / nx;
            if (og + 1u == (tg + 1u) * nx) xb_add(&bar[XB_TOPGEN], 1u);
            else XB_SPIN(xb_ld(&bar[XB_TOPGEN]) == tg, bar);
            __builtin_amdgcn_fence(__ATOMIC_ACQUIRE, "agent");
            xb_add(&bar[XB_XGEN(b.x)], 1u);
            asm volatile("s_waitcnt vmcnt(0)" ::: "memory");
        } else {
            XB_SPIN(xb_ld(&bar[XB_XGEN(b.x)]) == gen, bar);
            __builtin_amdgcn_fence(__ATOMIC_ACQUIRE, "agent");
            asm volatile("s_waitcnt vmcnt(0)" ::: "memory");
        }
    }
    __syncthreads();
}

constexpr int NWAVES = 8;
constexpr int RING_OFF = 0, RING_BYTES = 131072;
constexpr int LDSCTL_OFF = RING_BYTES, MISC_OFF = LDSCTL_OFF + 320;
constexpr int LDS_BYTES = 147456;
constexpr int N_PHASES = 8;

struct Frame {
    LAS unsigned char* lds;
    volatile LAS unsigned* MISC;
    gu32* ctl;
    int tid, lane, wave, vcu, G;
};
__device__ __forceinline__ float wave_sum(float v) {
#pragma unroll
    for (int o = 1; o < 64; o <<= 1) v += __shfl_xor(v, o);
    return v;
}
struct Args { const float* in[20]; float* out; unsigned char* ws; int ph_lo, ph_hi, li, pad; };

__device__ __forceinline__ void p0_transpose_item(const float* W, int ld, int nblk, const float* glo, const float* ghi, int K, bf16* WT, LAS float* scr, int item, int lane) {
    const int kb = item / nblk, nb = item % nblk, k0 = 64 * kb, n0 = 32 * nb;
#pragma unroll 8
    for (int i = 0; i < 32; ++i) { const int kk = 2 * i + (lane >> 5), k = k0 + kk; float w = W[(size_t)k * ld + n0 + (lane & 31)];
        if (glo) w *= (k < K / 2) ? glo[k] : ghi[k - K / 2];
        scr[kk * 33 + (lane & 31)] = w; }
    LDS_WAIT(); asm volatile("" ::: "memory");
    const int c = lane & 7;
#pragma unroll
    for (int j = 0; j < 4; ++j) { const int n = (lane >> 3) + 8 * j; const LAS float* s = scr + (8 * c) * 33 + n;
        v4u o; o.x = pk2(s[0 * 33], s[1 * 33]); o.y = pk2(s[2 * 33], s[3 * 33]); o.z = pk2(s[4 * 33], s[5 * 33]); o.w = pk2(s[6 * 33], s[7 * 33]);
        *(GAS v4u*)(WT + (size_t)(n0 + n) * K + k0 + 8 * c) = o; }
    LDS_WAIT(); asm volatile("" ::: "memory");
}
__device__ __forceinline__ float log_sigmoid(float z) { return fminf(z, 0.f) - log1pf(expf(-fabsf(z))); }

__device__ __forceinline__ void p0_prologue(Frame& F, const Args& a) {
    LAS float* scr = (LAS float*)(F.lds + RING_OFF + F.wave * 16384);
    unsigned char* ws = a.ws;
    const float* x = a.in[0]; const float* g1 = a.in[1]; const float* w_in = a.in[2]; const float* bfv = a.in[10];
    const float* gn_l = a.in[11]; const float* gn_f = a.in[12]; const float* w_out = a.in[13]; const float* g2 = a.in[14];
    const float* w_q = a.in[15]; const float* sk = a.in[16]; const float* pu = a.in[17]; const float* pv = a.in[18];
    bf16* win_t = (bf16*)(ws + WS_WIN); bf16* wout_t = (bf16*)(ws + WS_WOUT); bf16* wq_t = (bf16*)(ws + WS_WQ); bf16* skb = (bf16*)(ws + WS_SKB); float* wfl = (float*)(ws + WS_WFL);
    float* logf = (float*)(ws + WS_LOGF); float* sumsq = (float*)(ws + WS_SUMSQ); bf16* h = (bf16*)(ws + WS_H);
    const int gw = F.vcu * NWAVES + F.wave, NGW = F.G * NWAVES, lane = F.lane;
    constexpr int I_IN = (DMODEL / 64) * (NG1 / 32), I_OUT = (DMODEL / 64) * (DMODEL / 32), I_Q = (DMODEL / 64) * (QPW / 32);
    constexpr int I_FL = 8 * DMODEL / 64, I_SK = PH * 2 * NKEY * PHALF / 512, I_SS = T / 64, I_WAX = 8 * 2 * 2 * 4;
    constexpr int E0 = I_IN, E1 = E0 + I_OUT, E2 = E1 + I_Q, E3 = E2 + I_FL, E4 = E3 + I_SK, E5 = E4 + I_SS, E6 = E5 + I_WAX;
    for (int it = gw; it < E6; it += NGW) {
        if (it < E0) { p0_transpose_item(w_in, INC, NG1 / 32, nullptr, nullptr, DMODEL, win_t, scr, it, lane); continue; }
        if (it < E1) { p0_transpose_item(w_out, DMODEL, DMODEL / 32, gn_l, gn_f, DMODEL, wout_t, scr, it - E0, lane); continue; }
        if (it < E2) { p0_transpose_item(w_q, QPW, QPW / 32, g2, g2 + DMODEL / 2, DMODEL, wq_t, scr, it - E1, lane); continue; }
        if (it < E3) { const int i = (it - E2) * 64 + lane, j = i / DMODEL, k = i % DMODEL; wfl[i] = w_in[(size_t)k * INC + NG1 + j]; continue; }
        if (it < E4) { const size_t i = (size_t)(it - E3) * 512 + lane * 8; const f32x4 s0 = *(const GAS f32x4*)(sk + i), s1 = *(const GAS f32x4*)(sk + i + 4);
            v4u o; o.x = pk2(s0[0], s0[1]); o.y = pk2(s0[2], s0[3]); o.z = pk2(s1[0], s1[1]); o.w = pk2(s1[2], s1[3]); *(GAS v4u*)(skb + i) = o; continue; }
        if (it < E5) { sumsq[(it - E4) * 64 + lane] = 0.f; continue; }
        { const int f = it - E5, ks = f & 3, n = (f >> 2) & 1, mat = (f >> 3) & 1, hh = f >> 4; const float* wsrc = mat ? a.in[7] : a.in[5];
          const size_t o = ((size_t)(hh * 64 + 16 * ks + 8 * (lane >> 5))) * 64 + 32 * n + (lane & 31);
          v4u pw; pw.x = pk2(wsrc[o], wsrc[o + 64]); pw.y = pk2(wsrc[o + 128], wsrc[o + 192]); pw.z = pk2(wsrc[o + 256], wsrc[o + 320]); pw.w = pk2(wsrc[o + 384], wsrc[o + 448]);
          *(GAS v4u*)((bf16*)(ws + WS_WAX) + (size_t)f * 512 + lane * 8) = pw; }
    }
    { f32x4 gg[4];
#pragma unroll
      for (int j = 0; j < 4; ++j) gg[j] = *(const GAS f32x4*)(g2 + 16 * lane + 4 * j);
      unsigned char* u4 = ws + WS_U8; unsigned char* v4 = ws + WS_V8; float* su = (float*)(ws + WS_SU);
      for (int e = gw; e < NEXP; e += NGW) {
        const GAS f32x4* ur = (const GAS f32x4*)(pu + (size_t)e * DMODEL + 16 * lane); const GAS f32x4* vr = (const GAS f32x4*)(pv + (size_t)e * DMODEL + 16 * lane);
        f32x4 uu[4], vv[4]; float mu = 0.f, mv = 0.f;
#pragma unroll
        for (int j = 0; j < 4; ++j) { uu[j] = ur[j] * gg[j]; vv[j] = vr[j];
#pragma unroll
            for (int c = 0; c < 4; ++c) { mu = fmaxf(mu, fabsf(uu[j][c])); mv = fmaxf(mv, fabsf(vv[j][c])); } }
#pragma unroll
        for (int o = 1; o < 64; o <<= 1) { mu = fmaxf(mu, __shfl_xor(mu, o)); mv = fmaxf(mv, __shfl_xor(mv, o)); }
        const float scu = mu > 0.f ? mu * (1.f / 6.f) : 1.f, scv = mv > 0.f ? mv * (1.f / 6.f) : 1.f, iu = 1.f / scu, iv = 1.f / scv;
        unsigned qu0 = 0u, qu1 = 0u, qv0 = 0u, qv1 = 0u;
#define P0_Q4(Q, X, INV, B0, B1) do { Q = __builtin_amdgcn_cvt_scalef32_pk_fp4_f32(Q, X[0] * INV, X[1] * INV, 1.0f, B0); Q = __builtin_amdgcn_cvt_scalef32_pk_fp4_f32(Q, X[2] * INV, X[3] * INV, 1.0f, B1); } while (0)
        P0_Q4(qu0, uu[0], iu, 0, 1); P0_Q4(qu0, uu[1], iu, 2, 3); P0_Q4(qu1, uu[2], iu, 0, 1); P0_Q4(qu1, uu[3], iu, 2, 3);
        P0_Q4(qv0, vv[0], iv, 0, 1); P0_Q4(qv0, vv[1], iv, 2, 3); P0_Q4(qv1, vv[2], iv, 0, 1); P0_Q4(qv1, vv[3], iv, 2, 3);
#undef P0_Q4
        *(GAS unsigned long long*)(u4 + (size_t)e * 512 + 8 * lane) = (unsigned long long)qu0 | ((unsigned long long)qu1 << 32);
        *(GAS unsigned long long*)(v4 + (size_t)e * 512 + 8 * lane) = (unsigned long long)qv0 | ((unsigned long long)qv1 << 32);
        if (lane == 0) { su[2 * e] = scu; su[2 * e + 1] = scv; }
      } }
    { f32x4 gg[4];
#pragma unroll
      for (int j = 0; j < 4; ++j) gg[j] = *(const GAS f32x4*)(g1 + 256 * j + 4 * lane);
      float fw[4][4][8];
#pragma unroll
      for (int j = 0; j < 4; ++j)
#pragma unroll
          for (int c = 0; c < 4; ++c) { const int k = 256 * j + 4 * lane + c; const GAS f32x4* wr = (const GAS f32x4*)(w_in + (size_t)k * INC + NG1); const f32x4 w0 = wr[0], w1 = wr[1];
#pragma unroll
              for (int e = 0; e < 4; ++e) { fw[j][c][e] = w0[e]; fw[j][c][4 + e] = w1[e]; } }
      for (int t = gw; t < T; t += NGW) {
        const GAS f32x4* xr = (const GAS f32x4*)(x + (size_t)t * DMODEL) + lane;
        f32x4 v[4]; float ss = 0.f;
#pragma unroll
        for (int j = 0; j < 4; ++j) { v[j] = xr[64 * j]; ss += (v[j][0] * v[j][0] + v[j][1] * v[j][1]) + (v[j][2] * v[j][2] + v[j][3] * v[j][3]); }
        const float rstd = rsqrtf(wave_sum(ss) * (1.f / DMODEL) + RMS_EPS);
        GAS unsigned long long* ho = (GAS unsigned long long*)(h + (size_t)t * DMODEL) + lane;
#pragma unroll
        for (int j = 0; j < 4; ++j) { v[j] = v[j] * rstd * gg[j]; ho[64 * j] = (unsigned long long)pk2(v[j][0], v[j][1]) | ((unsigned long long)pk2(v[j][2], v[j][3]) << 32); }
        float fl[8];
#pragma unroll
        for (int hh = 0; hh < 8; ++hh) fl[hh] = 0.f;
#pragma unroll
        for (int j = 0; j < 4; ++j)
#pragma unroll
            for (int c = 0; c < 4; ++c) {
#pragma unroll
                for (int hh = 0; hh < 8; ++hh) fl[hh] += v[j][c] * fw[j][c][hh]; }
        float res = 0.f;
#pragma unroll
        for (int hh = 0; hh < 8; ++hh) { const float s = wave_sum(fl[hh]); if (lane == hh) res = s; }
        if (lane < 8) logf[(size_t)t * 8 + lane] = log_sigmoid(res + bfv[lane]);
      } }
}

__device__ __forceinline__ void fcum_unit(Frame& F, int bh, const float* logf, float* fcum) {
    const int b = bh / NHEADS, hh = bh % NHEADS, s0 = F.tid * 16;
    float v[16]; float loc = 0.f;
#pragma unroll
    for (int i = 0; i < 16; ++i) { v[i] = logf[((size_t)b * SEQ + s0 + i) * 8 + hh]; loc += v[i]; }
    float inc = loc;
#pragma unroll
    for (int o = 1; o < 64; o <<= 1) { const float n = __shfl_up(inc, o); if (F.lane >= o) inc += n; }
    if (F.lane == 63) F.MISC[16 + F.wave] = __float_as_uint(inc);
    __syncthreads();
    float run = inc - loc;
    for (int w = 0; w < F.wave; ++w) run += __uint_as_float(F.MISC[16 + w]);
#pragma unroll
    for (int i = 0; i < 16; ++i) { run += v[i]; fcum[(size_t)bh * SEQ + s0 + i] = run; }
    __syncthreads();
}


#ifndef MK_REP_MASK
#define MK_REP_MASK 0
#endif
#define REPS(k) (((MK_REP_MASK >> (k)) & 1) ? 2 : 1)
namespace peer {
typedef unsigned u32;
typedef float f32x16 __attribute__((ext_vector_type(16)));
constexpr int TOK = 128;
constexpr int EX_STRIDE = 136, GT_STRIDE = 132;
constexpr int L_EX = 0, L_GT = L_EX + TOK * EX_STRIDE * 2, L_IDX = L_GT + TOK * GT_STRIDE * 4, IDX_STRIDE = 36, L_RST = L_IDX + 512 * IDX_STRIDE, L_END = L_RST + TOK * 4;
static_assert(L_END <= RING_BYTES && L_GT % 16 == 0 && L_IDX % 16 == 0, "PEER LDS map");
__device__ __forceinline__ u32 ordmap(float f) { const u32 u = __float_as_uint(f); return u ^ ((u32)((int)u >> 31) | 0x80000000u); }
__device__ __forceinline__ float unordmap(u32 k) { const u32 u = (k & 0x80000000u) ? (k ^ 0x80000000u) : ~k; return __uint_as_float(u); }
__device__ __forceinline__ u32 umin_(u32 a, u32 b) { return a < b ? a : b; }
__device__ __forceinline__ u32 umax_(u32 a, u32 b) { return a > b ? a : b; }
template <bool DESC> __device__ __forceinline__ void sort16(u32 (&k)[16]) {
#pragma unroll
    for (int size = 2; size <= 16; size <<= 1)
#pragma unroll
        for (int stride = size >> 1; stride > 0; stride >>= 1)
#pragma unroll
            for (int i = 0; i < 16; ++i) { const int j = i ^ stride;
                if (j > i) { const bool asc = (((i & size) == 0) != DESC); const u32 a = k[i], b = k[j], lo = umin_(a, b), hi = umax_(a, b); k[i] = asc ? lo : hi; k[j] = asc ? hi : lo; } }
}
template <bool DESC> __device__ __forceinline__ void merge16(u32 (&k)[16]) {
#pragma unroll
    for (int stride = 8; stride > 0; stride >>= 1)
#pragma unroll
        for (int i = 0; i < 16; ++i) { const int j = i ^ stride;
            if (j > i) { const u32 a = k[i], b = k[j], lo = umin_(a, b), hi = umax_(a, b); k[i] = DESC ? hi : lo; k[j] = DESC ? lo : hi; } }
}
__host__ __device__ constexpr int ccnt(int a) { return 16 / (a + 1); }
__host__ __device__ constexpr int cbase(int a) { int s = 0; for (int i = 0; i < a; ++i) s += ccnt(i); return s; }
static_assert(cbase(16) == 50, "hyperbola candidate count");
__device__ __forceinline__ int crow16(int r) { return (r & 3) + 8 * (r >> 2); }

__device__ __forceinline__ void route_tile(Frame& F, const bf16* qp, const bf16* skb, const float* sumsq, int t0) {
    int lane = F.lane; asm volatile("" : "+v"(lane));
    const int r32 = lane & 31, hi = lane >> 5, w = F.wave;
    LAS unsigned short* EXL = (LAS unsigned short*)(F.lds + RING_OFF + L_EX);
    LAS float* GTL = (LAS float*)(F.lds + RING_OFF + L_GT);
    LAS unsigned char* IDXB = F.lds + RING_OFF + L_IDX + (w * 64 + lane) * IDX_STRIDE;
    LAS float* RST = (LAS float*)(F.lds + RING_OFF + L_RST);
    for (int g = 0; g < 4; ++g) {
        const int tok = 32 * g + r32; const size_t trow = (size_t)(t0 + tok);
        const float rstd2 = rsqrtf(sumsq[trow] * (1.f / DMODEL) + RMS_EPS);
        if (w == 0 && hi == 0) RST[tok] = rstd2;
        u32 s0[16], s1[16];
#pragma unroll
        for (int p = 0; p < 2; ++p) {
            bf16x8 qf[8];
#pragma unroll
            for (int ks = 0; ks < 8; ++ks) qf[ks] = *(const GAS bf16x8*)(qp + trow * QPW + w * 256 + p * 128 + ks * 16 + hi * 8);
            u32 run[16];
#pragma unroll
            for (int nb = 0; nb < 4; ++nb) {
                f32x16 acc = {};
                const bf16* kr = skb + ((size_t)((w * 2 + p) * NKEY + 32 * nb + r32)) * PHALF + hi * 8;
#pragma unroll
                for (int ks = 0; ks < 8; ++ks) acc = __builtin_amdgcn_mfma_f32_32x32x16_bf16(*(const GAS bf16x8*)(kr + ks * 16), qf[ks], acc, 0, 0, 0);
                asm volatile("" ::: "memory");
                u32 blk[16];
#pragma unroll
                for (int r = 0; r < 16; ++r) blk[r] = (ordmap(acc[r]) & ~0x7Fu) | (u32)(127 - 32 * nb - crow16(r) - 4 * hi);
                if (nb == 0) { sort16<true>(blk);
#pragma unroll
                    for (int i = 0; i < 16; ++i) run[i] = blk[i]; }
                else { sort16<false>(blk);
#pragma unroll
                    for (int i = 0; i < 16; ++i) run[i] = umax_(run[i], blk[i]);
                    merge16<true>(run); }
            }
            u32 oth[16];
#pragma unroll
            for (int i = 0; i < 16; ++i) oth[i] = (u32)__shfl_xor((int)run[15 - i], 32);
#pragma unroll
            for (int i = 0; i < 16; ++i) run[i] = umax_(run[i], oth[i]);
            merge16<true>(run);
#pragma unroll
            for (int i = 0; i < 16; ++i) { if (p == 0) s0[i] = run[i]; else s1[i] = run[i]; }
        }
        { LAS u32* iw = (LAS u32*)IDXB;
#pragma unroll
          for (int j = 0; j < 4; ++j) {
              iw[j] = (127u - (s0[4 * j] & 127u)) | ((127u - (s0[4 * j + 1] & 127u)) << 8) | ((127u - (s0[4 * j + 2] & 127u)) << 16) | ((127u - (s0[4 * j + 3] & 127u)) << 24);
              iw[4 + j] = (127u - (s1[4 * j] & 127u)) | ((127u - (s1[4 * j + 1] & 127u)) << 8) | ((127u - (s1[4 * j + 2] & 127u)) << 16) | ((127u - (s1[4 * j + 3] & 127u)) << 24); } }
        float v1[16], v2[16];
#pragma unroll
        for (int i = 0; i < 16; ++i) { v1[i] = unordmap(s0[i] & ~0x7Fu); v2[i] = unordmap(s1[i] & ~0x7Fu); }
        u32 c0[16], c1[16], c2[16], c3[16];
#pragma unroll
        for (int a = 0; a < 16; ++a)
#pragma unroll
            for (int b = 0; b < ccnt(a); ++b) { const int pos = cbase(a) + b; const u32 key = (ordmap(v1[a] + v2[b]) & ~0xFFu) | (u32)(255 - (a * 16 + b));
                if (pos < 16) c0[pos] = key; else if (pos < 32) c1[pos - 16] = key; else if (pos < 48) c2[pos - 32] = key; else c3[pos - 48] = key; }
#pragma unroll
        for (int i = 2; i < 16; ++i) c3[i] = 0u;
        sort16<false>(c1);
#pragma unroll
        for (int i = 0; i < 16; ++i) c0[i] = umax_(c0[i], c1[i]);
        merge16<true>(c0);
        sort16<false>(c2);
#pragma unroll
        for (int i = 0; i < 16; ++i) c0[i] = umax_(c0[i], c2[i]);
        merge16<true>(c0);
        sort16<false>(c3);
#pragma unroll
        for (int i = 0; i < 16; ++i) c0[i] = umax_(c0[i], c3[i]);
        merge16<true>(c0);
        const float m = unordmap(c0[0] & ~0xFFu) * rstd2;
        float e[8]; float sum = 0.f; u32 ex[8];
#pragma unroll
        for (int k = 0; k < 8; ++k) { const u32 key = hi ? c0[k + 8] : c0[k]; const float ts = unordmap(key & ~0xFFu);
            e[k] = __builtin_amdgcn_exp2f((ts * rstd2 - m) * LOG2E); sum += e[k];
            const u32 flat = 255u - (key & 255u); ex[k] = (u32)IDXB[flat >> 4] * NKEY + (u32)IDXB[16 + (flat & 15u)]; }
        sum += __shfl_xor(sum, 32);
        const float inv = 1.f / sum;
        v4u exw; exw.x = ex[0] | (ex[1] << 16); exw.y = ex[2] | (ex[3] << 16); exw.z = ex[4] | (ex[5] << 16); exw.w = ex[6] | (ex[7] << 16);
        *(LAS v4u*)(EXL + tok * EX_STRIDE + w * 16 + hi * 8) = exw;
        *(LAS f32x4*)(GTL + tok * GT_STRIDE + w * 16 + hi * 8) = (f32x4){e[0] * inv, e[1] * inv, e[2] * inv, e[3] * inv};
        *(LAS f32x4*)(GTL + tok * GT_STRIDE + w * 16 + hi * 8 + 4) = (f32x4){e[4] * inv, e[5] * inv, e[6] * inv, e[7] * inv};
    }
}
__device__ __forceinline__ float gelu_fast(float x) {
    const float u2 = x * (1.5957691216057308f + 0.07135481627f * x * x);
    return x * __builtin_amdgcn_rcpf(1.f + __builtin_amdgcn_exp2f(-1.4426950408889634f * u2));
}
typedef float f32x2 __attribute__((ext_vector_type(2)));

__device__ __forceinline__ void sort128(u32 (&k)[8], int m) {
#pragma unroll
    for (int K = 2; K <= 128; K <<= 1) {
#pragma unroll
        for (int S = K >> 1; S > 0; S >>= 1) {
            if (S >= 8) {
                const int mm = S >> 3; const bool lower = (m & mm) == 0, up = (K == 128) ? true : ((m & (K >> 3)) == 0), keepmin = (lower == up);
#pragma unroll
                for (int r = 0; r < 8; ++r) { const u32 o = (u32)__shfl_xor((int)k[r], mm); const u32 mn = umin_(k[r], o), mx = umax_(k[r], o); k[r] = keepmin ? mn : mx; }
            } else {
#pragma unroll
                for (int r = 0; r < 8; ++r) { const int r2 = r ^ S;
                    if (r2 > r) { const u32 a = k[r], b = k[r2], mn = umin_(a, b), mx = umax_(a, b);
                        if (K < 8) { const bool up = (r & K) == 0; k[r] = up ? mn : mx; k[r2] = up ? mx : mn; }
                        else { const bool up = (K == 128) ? true : ((m & (K >> 3)) == 0); k[r] = up ? mn : mx; k[r2] = up ? mx : mn; } } }
            }
        }
    }
}
__device__ __forceinline__ void eval_lg(Frame& F, const unsigned char* u8, const unsigned char* v8, const float* suv, const float* fg, float* out, int t0) {
    int lane = F.lane; asm volatile("" : "+v"(lane));
    const int g = lane >> 4, m = lane & 15;
    const LAS unsigned short* EXL = (const LAS unsigned short*)(F.lds + RING_OFF + L_EX);
    const LAS float* GTL = (const LAS float*)(F.lds + RING_OFF + L_GT);
    const LAS float* RST = (const LAS float*)(F.lds + RING_OFF + L_RST);
    LAS u32* SK = (LAS u32*)(F.lds + RING_OFF + L_IDX) + F.wave * 512 + g * 128;
    for (int pass = 0; pass < 4; ++pass) {
        const int tok = 32 * pass + 4 * F.wave + g;
        { u32 k[8]; const v4u ev = *(const LAS v4u*)(EXL + tok * EX_STRIDE + 8 * m); const u32 s0 = (u32)(8 * m);
          k[0] = ((ev.x & 0xffffu) << 7) | s0; k[1] = ((ev.x >> 16) << 7) | (s0 + 1); k[2] = ((ev.y & 0xffffu) << 7) | (s0 + 2); k[3] = ((ev.y >> 16) << 7) | (s0 + 3);
          k[4] = ((ev.z & 0xffffu) << 7) | (s0 + 4); k[5] = ((ev.z >> 16) << 7) | (s0 + 5); k[6] = ((ev.w & 0xffffu) << 7) | (s0 + 6); k[7] = ((ev.w >> 16) << 7) | (s0 + 7);
          sort128(k, m);
          *(LAS v4u*)(SK + m * 8) = (v4u){k[0], k[1], k[2], k[3]}; *(LAS v4u*)(SK + m * 8 + 4) = (v4u){k[4], k[5], k[6], k[7]}; }
        asm volatile("" ::: "memory");
        f32x2 hv[32], y[32];
        const float rstd2 = RST[tok]; float* xrow = out + (size_t)(t0 + tok) * DMODEL + 64 * m;
#pragma unroll
        for (int q = 0; q < 16; ++q) { const f32x4 xa = *(const GAS f32x4*)(xrow + 4 * q); hv[2 * q] = (f32x2){xa[0] * rstd2, xa[1] * rstd2}; hv[2 * q + 1] = (f32x2){xa[2] * rstd2, xa[3] * rstd2};
            y[2 * q] = (f32x2){0.f, 0.f}; y[2 * q + 1] = (f32x2){0.f, 0.f}; }
        const LAS float* gtr = GTL + tok * GT_STRIDE;
#define PEER_FP4_DOT(W, A) do { _Pragma("unroll") for (int c = 0; c < 2; ++c) _Pragma("unroll") for (int d = 0; d < 4; ++d) { const unsigned w_ = W[c][d]; const int hb = 16 * c + 4 * d; \
            A = __builtin_elementwise_fma(__builtin_amdgcn_cvt_scalef32_pk_f32_fp4(w_, 1.0f, 0), hv[hb], A); A = __builtin_elementwise_fma(__builtin_amdgcn_cvt_scalef32_pk_f32_fp4(w_, 1.0f, 1), hv[hb + 1], A); \
            A = __builtin_elementwise_fma(__builtin_amdgcn_cvt_scalef32_pk_f32_fp4(w_, 1.0f, 2), hv[hb + 2], A); A = __builtin_elementwise_fma(__builtin_amdgcn_cvt_scalef32_pk_f32_fp4(w_, 1.0f, 3), hv[hb + 3], A); } } while (0)
#define PEER_FP4_AXPY(W, B) do { _Pragma("unroll") for (int c = 0; c < 2; ++c) _Pragma("unroll") for (int d = 0; d < 4; ++d) { const unsigned w_ = W[c][d]; const int hb = 16 * c + 4 * d; \
            y[hb] = __builtin_elementwise_fma(__builtin_amdgcn_cvt_scalef32_pk_f32_fp4(w_, 1.0f, 0), B, y[hb]); y[hb + 1] = __builtin_elementwise_fma(__builtin_amdgcn_cvt_scalef32_pk_f32_fp4(w_, 1.0f, 1), B, y[hb + 1]); \
            y[hb + 2] = __builtin_elementwise_fma(__builtin_amdgcn_cvt_scalef32_pk_f32_fp4(w_, 1.0f, 2), B, y[hb + 2]); y[hb + 3] = __builtin_elementwise_fma(__builtin_amdgcn_cvt_scalef32_pk_f32_fp4(w_, 1.0f, 3), B, y[hb + 3]); } } while (0)
        for (int i = 0; i < 128; i += 4) {
            const v4u kq = *(const LAS v4u*)(SK + i);
            v4u ub[4][2]; f32x2 sc[4]; float gate[4];
#pragma unroll
            for (int s4 = 0; s4 < 4; ++s4) { const u32 key = kq[s4]; const u32 ro = (key >> 7) * 512u + 32u * (u32)m;
                ub[s4][0] = *(const GAS v4u*)(u8 + ro); ub[s4][1] = *(const GAS v4u*)(u8 + ro + 16);
                sc[s4] = *(const GAS f32x2*)(suv + 2 * (key >> 7)); gate[s4] = gtr[key & 127u]; }
            float pp[4];
#pragma unroll
            for (int s4 = 0; s4 < 4; ++s4) { f32x2 a = (f32x2){0.f, 0.f}; PEER_FP4_DOT(ub[s4], a); pp[s4] = a[0] + a[1]; }
            asm volatile("" ::: "memory");
            v4u vb[4][2];
#pragma unroll
            for (int s4 = 0; s4 < 4; ++s4) { const u32 ro = (kq[s4] >> 7) * 512u + 32u * (u32)m; vb[s4][0] = *(const GAS v4u*)(v8 + ro); vb[s4][1] = *(const GAS v4u*)(v8 + ro + 16); }
#pragma unroll
            for (int s4 = 0; s4 < 4; ++s4) { pp[s4] += __shfl_xor(pp[s4], 1); }
#pragma unroll
            for (int s4 = 0; s4 < 4; ++s4) { pp[s4] += __shfl_xor(pp[s4], 2); }
#pragma unroll
            for (int s4 = 0; s4 < 4; ++s4) { pp[s4] += __shfl_xor(pp[s4], 4); }
#pragma unroll
            for (int s4 = 0; s4 < 4; ++s4) { pp[s4] += __shfl_xor(pp[s4], 8); }
#pragma unroll
            for (int s4 = 0; s4 < 4; ++s4) { const float act = gelu_fast(pp[s4] * sc[s4][0]) * (gate[s4] * sc[s4][1]); const f32x2 b2 = (f32x2){act, act}; PEER_FP4_AXPY(vb[s4], b2); }
        }
#undef PEER_FP4_DOT
#undef PEER_FP4_AXPY
        float ss = 0.f;
#pragma unroll
        for (int q = 0; q < 16; ++q) { const f32x4 xa = *(const GAS f32x4*)(xrow + 4 * q); y[2 * q][0] += xa[0]; y[2 * q][1] += xa[1]; y[2 * q + 1][0] += xa[2]; y[2 * q + 1][1] += xa[3];
            ss += (y[2 * q][0] * y[2 * q][0] + y[2 * q][1] * y[2 * q][1]) + (y[2 * q + 1][0] * y[2 * q + 1][0] + y[2 * q + 1][1] * y[2 * q + 1][1]); }
        ss += __shfl_xor(ss, 1); ss += __shfl_xor(ss, 2); ss += __shfl_xor(ss, 4); ss += __shfl_xor(ss, 8);
        const float rs = rsqrtf(ss * (1.f / DMODEL) + RMS_EPS);
#pragma unroll
        for (int q = 0; q < 16; ++q) { const f32x4 gq = *(const GAS f32x4*)(fg + 64 * m + 4 * q); f32x4 o; o[0] = y[2 * q][0] * rs * gq[0]; o[1] = y[2 * q][1] * rs * gq[1]; o[2] = y[2 * q + 1][0] * rs * gq[2]; o[3] = y[2 * q + 1][1] * rs * gq[3];
            *(GAS f32x4*)(xrow + 4 * q) = o; }
    }
}
__device__ __forceinline__ void peer_phase(Frame& F, const Args& a) {
    unsigned char* ws = a.ws;
    for (int tile = F.vcu; tile < T / TOK; tile += F.G) {
        for (int rp = 0; rp < REPS(7); ++rp) { if (rp) __syncthreads(); route_tile(F, (const bf16*)(ws + WS_QP), (const bf16*)(ws + WS_SKB), (const float*)(ws + WS_SUMSQ), tile * TOK); }
        __syncthreads();
        eval_lg(F, ws + WS_U8, ws + WS_V8, (const float*)(ws + WS_SU), a.in[19], a.out, tile * TOK);
        __syncthreads();
    }
}
}

namespace lru {
typedef float f32x16 __attribute__((ext_vector_type(16)));
constexpr int TOKT = 128, NTILE = SEQ / TOKT;
constexpr int WAVE_LDS = 14336, L_XS = 0, L_XC = 4608, L_GS = 9216, XC_STRIDE = 72  , L_SS = 8 * WAVE_LDS;
static_assert(L_SS + 32 * 8 * 4 <= RING_BYTES, "LRU LDS map");
__device__ __forceinline__ float bf2f(unsigned short h) { return __uint_as_float((unsigned)h << 16); }
__device__ __forceinline__ int crow16(int r) { return (r & 3) + 8 * (r >> 2); }
__device__ __forceinline__ float sigm(float x) { return __builtin_amdgcn_rcpf(1.f + __builtin_amdgcn_exp2f(-LOG2E * x)); }

template <bool FINAL> __device__ __forceinline__ void lru_tile(Frame& F, const Args& args, int tile) {
    int lane = F.lane; asm volatile("" : "+v"(lane));
    const int w = F.wave, j32 = lane & 31, hi = lane >> 5;
    unsigned char* ws = args.ws;
    const bf16* xr = (const bf16*)(ws + WS_XR); const bf16* gr = (const bf16*)(ws + WS_GR); float* carry = (float*)(ws + WS_CARRY);
    const float* cw = args.in[3]; const float* cb = args.in[4]; const float* ba = args.in[6]; const float* bx = args.in[8]; const float* lam = args.in[9];
    const int b = tile / NTILE, jt = tile % NTILE; const size_t trow0 = (size_t)b * SEQ + (size_t)jt * TOKT;
    LAS unsigned char* wl = F.lds + RING_OFF + w * WAVE_LDS;
    LAS unsigned short* XS = (LAS unsigned short*)(wl + L_XS); LAS unsigned short* XC = (LAS unsigned short*)(wl + L_XC); LAS unsigned short* GS = (LAS unsigned short*)(wl + L_GS);
    LAS float* SS = (LAS float*)(F.lds + RING_OFF + L_SS);
    float c_ba[2], c_bx[2], c_sp[2], c_cb[2], c_cw[2][4];
#pragma unroll
    for (int n = 0; n < 2; ++n) { const int c = 64 * w + 32 * n + j32; c_ba[n] = ba[c]; c_bx[n] = bx[c]; c_cb[n] = cb[c];
        const float l = lam[c]; c_sp[n] = 8.f * LOG2E * (fmaxf(-l, 0.f) + log1pf(expf(-fabsf(l))));
#pragma unroll
        for (int k = 0; k < 4; ++k) c_cw[n][k] = cw[k * LW + c]; }
    const bf16* wax = (const bf16*)(ws + WS_WAX);
    float hc[2] = {0.f, 0.f}, ap[2] = {1.f, 1.f};
    if (FINAL) { const float* cin = (const float*)(ws + WS_CIN) + (size_t)(b * NTILE + jt) * LW + 64 * w + j32; hc[0] = cin[0]; hc[1] = cin[32]; }
    v4u pfx[5], pfg[4];
#define LRU_FETCH(B) do { const size_t tbn_ = trow0 + (B) * 32; _Pragma("unroll") for (int q_ = 0; q_ < 5; ++q_) { const int pc_ = lane + 64 * q_, row_ = pc_ >> 3, c8_ = pc_ & 7; \
        const bool z_ = (jt == 0 && (B) == 0 && row_ < 3) || pc_ >= 35 * 8; const v4u v_ = *(const GAS v4u*)(xr + (tbn_ + (z_ ? 3 : row_) - 3) * LW + w * 64 + c8_ * 8); pfx[q_] = z_ ? (v4u){0u, 0u, 0u, 0u} : v_; } \
        if (FINAL) { _Pragma("unroll") for (int q_ = 0; q_ < 4; ++q_) { const int pc_ = lane + 64 * q_; pfg[q_] = *(const GAS v4u*)(gr + (tbn_ + (pc_ >> 3)) * LW + w * 64 + (pc_ & 7) * 8); } } } while (0)
    LRU_FETCH(0);
    for (int blk = 0; blk < 4; ++blk) {
        const size_t tb = trow0 + blk * 32;
        int ln = lane; asm volatile("" : "+v"(ln));
        const int k32 = ln & 31;
#pragma unroll
        for (int q = 0; q < 5; ++q) { const int pc = ln + 64 * q; if (pc < 35 * 8) *(LAS v4u*)((LAS unsigned char*)XS + (pc >> 3) * 128 + (pc & 7) * 16) = pfx[q]; }
        if (FINAL) {
#pragma unroll
            for (int q = 0; q < 4; ++q) { const int pc = ln + 64 * q; *(LAS v4u*)((LAS unsigned char*)GS + (pc >> 3) * 128 + (pc & 7) * 16) = pfg[q]; } }
        if (blk < 3) { LRU_FETCH(blk + 1); }
        asm volatile("" ::: "memory");
        float xc[2][16];
#pragma unroll
        for (int n = 0; n < 2; ++n)
#pragma unroll
            for (int g = 0; g < 4; ++g) { float xv[7];
#pragma unroll
                for (int q = 0; q < 7; ++q) xv[q] = bf2f(XS[(8 * g + 4 * hi + q) * 64 + 32 * n + j32]);
#pragma unroll
                for (int e = 0; e < 4; ++e) xc[n][4 * g + e] = c_cb[n] + ((c_cw[n][0] * xv[e] + c_cw[n][1] * xv[e + 1]) + (c_cw[n][2] * xv[e + 2] + c_cw[n][3] * xv[e + 3])); }
#pragma unroll
        for (int n = 0; n < 2; ++n)
#pragma unroll
            for (int r = 0; r < 16; ++r) XC[(crow16(r) + 4 * hi) * XC_STRIDE + 32 * n + j32] = (unsigned short)f2bf(xc[n][r]);
        asm volatile("" ::: "memory");
        bf16x8 af[4];
#pragma unroll
        for (int ks = 0; ks < 4; ++ks) af[ks] = *(const LAS bf16x8*)(XC + j32 * XC_STRIDE + 16 * ks + 8 * hi);
        asm volatile("" ::: "memory");
        float yv[2][16];
#pragma unroll
        for (int n = 0; n < 2; ++n) {
            f32x16 R = {}, I = {};
            bf16x8 fa[4], fx[4];
#pragma unroll
            for (int ks = 0; ks < 4; ++ks) { fa[ks] = *(const GAS bf16x8*)(wax + (size_t)(((w * 2 + 0) * 2 + n) * 4 + ks) * 512 + lane * 8); fx[ks] = *(const GAS bf16x8*)(wax + (size_t)(((w * 2 + 1) * 2 + n) * 4 + ks) * 512 + lane * 8); }
#pragma unroll
            for (int ks = 0; ks < 4; ++ks) { R = __builtin_amdgcn_mfma_f32_32x32x16_bf16(af[ks], fa[ks], R, 0, 0, 0); I = __builtin_amdgcn_mfma_f32_32x32x16_bf16(af[ks], fx[ks], I, 0, 0, 0); }
            float av[16], uv[16];
#pragma unroll
            for (int r = 0; r < 16; ++r) { const float rg = sigm(R[r] + c_ba[n]), ig = sigm(I[r] + c_bx[n]); const float a_ = __builtin_amdgcn_exp2f(-rg * c_sp[n]);
                av[r] = a_; uv[r] = __builtin_amdgcn_sqrtf(fmaxf(1.f - a_ * a_, 0.f)) * (ig * xc[n][r]); }
            float Ar[4], Hr[4], hst[4];
#pragma unroll
            for (int g = 0; g < 4; ++g) { Ar[g] = (av[4 * g] * av[4 * g + 1]) * (av[4 * g + 2] * av[4 * g + 3]);
                Hr[g] = ((uv[4 * g] * av[4 * g + 1] + uv[4 * g + 1]) * av[4 * g + 2] + uv[4 * g + 2]) * av[4 * g + 3] + uv[4 * g + 3]; }
            float hin = hc[n];
#pragma unroll
            for (int g = 0; g < 4; ++g) { float o1 = Ar[g] * hin + Hr[g]; const float x = __shfl_xor(o1, 32); const float hg = hi ? x : hin; o1 = Ar[g] * hg + Hr[g]; hst[g] = hg;
                const float y = __shfl_xor(o1, 32); hin = hi ? o1 : y;
                if (!FINAL) ap[n] *= Ar[g] * __shfl_xor(Ar[g], 32); }
            hc[n] = hin;
            if (FINAL) {
#pragma unroll
                for (int g = 0; g < 4; ++g) { float h = hst[g];
#pragma unroll
                    for (int e = 0; e < 4; ++e) { const int r = 4 * g + e; h = av[r] * h + uv[r]; yv[n][r] = h * bf2f(GS[(crow16(r) + 4 * hi) * 64 + 32 * n + j32]); } } }
        }
        if (FINAL) {
#pragma unroll
            for (int r = 0; r < 16; ++r) { float s = yv[0][r] * yv[0][r] + yv[1][r] * yv[1][r];
                s += __shfl_xor(s, 1); s += __shfl_xor(s, 2); s += __shfl_xor(s, 4); s += __shfl_xor(s, 8); s += __shfl_xor(s, 16);
                if (j32 == 0) SS[(crow16(r) + 4 * hi) * 8 + w] = s; }
            __syncthreads();
            bf16* ymix = (bf16*)(ws + WS_H);
#pragma unroll
            for (int r = 0; r < 16; ++r) { const int tk = crow16(r) + 4 * hi; const f32x4 s0 = *(const LAS f32x4*)(SS + tk * 8), s1 = *(const LAS f32x4*)(SS + tk * 8 + 4);
                const float rstd = rsqrtf(((s0[0] + s0[1]) + (s0[2] + s0[3]) + (s1[0] + s1[1]) + (s1[2] + s1[3])) * (1.f / LW) + RMS_EPS);
                bf16* yp = ymix + (tb + tk) * DMODEL + 64 * w + k32;
                yp[0] = (bf16)f2bf(yv[0][r] * rstd); yp[32] = (bf16)f2bf(yv[1][r] * rstd); }
            __syncthreads();
        }
    }
#undef LRU_FETCH
    if (!FINAL) { if (hi == 0) { float* cp = carry + ((size_t)(b * NTILE + jt) * 2) * LW + 64 * w + j32;
#pragma unroll
        for (int n = 0; n < 2; ++n) { cp[32 * n] = ap[n]; cp[LW + 32 * n] = hc[n]; } } }
    else {
        const bf16* ob = (const bf16*)(ws + WS_O); bf16* ymix = (bf16*)(ws + WS_H);
        for (int i = 0; i < 16; ++i) { const size_t row = trow0 + 16 * w + i; const v4u v = *(const GAS v4u*)(ob + row * AW + 8 * lane);
            float f[8]; f[0] = __uint_as_float(v.x << 16); f[1] = __uint_as_float(v.x & 0xffff0000u); f[2] = __uint_as_float(v.y << 16); f[3] = __uint_as_float(v.y & 0xffff0000u);
            f[4] = __uint_as_float(v.z << 16); f[5] = __uint_as_float(v.z & 0xffff0000u); f[6] = __uint_as_float(v.w << 16); f[7] = __uint_as_float(v.w & 0xffff0000u);
            float ss = 0.f;
#pragma unroll
            for (int e = 0; e < 8; ++e) ss += f[e] * f[e];
            const float rstd = rsqrtf(wave_sum(ss) * (1.f / AW) + RMS_EPS);
            v4u o; o.x = pk2(f[0] * rstd, f[1] * rstd); o.y = pk2(f[2] * rstd, f[3] * rstd); o.z = pk2(f[4] * rstd, f[5] * rstd); o.w = pk2(f[6] * rstd, f[7] * rstd);
            *(GAS v4u*)(ymix + row * DMODEL + LW + 8 * lane) = o; }
    }
}
__device__ __forceinline__ void norm_pass(Frame& F, const Args& a) {
    unsigned char* ws = a.ws; float* nrm = (float*)(ws + WS_NRM);
    const int gw = F.vcu * NWAVES + F.wave, NGW = F.G * NWAVES, lane = F.lane;
    for (int it = gw; it < 2 * BATCH * (SEQ / 64); it += NGW) {
        const int which = it / (BATCH * (SEQ / 64)), r = it % (BATCH * (SEQ / 64)), b = r / (SEQ / 64), t = r % (SEQ / 64);
        const bf16* src = (const bf16*)(ws + (which ? WS_K : WS_Q)) + ((size_t)b * SEQ + 64 * t) * AW + 8 * lane;
        float mx = 0.f;
#pragma unroll 8
        for (int i = 0; i < 64; ++i) { const v4u v = *(const GAS v4u*)(src + (size_t)i * AW); float s = 0.f;
#pragma unroll
            for (int c = 0; c < 4; ++c) { const float lo = __uint_as_float(v[c] << 16), hi = __uint_as_float(v[c] & 0xffff0000u); s += lo * lo + hi * hi; }
            s += __shfl_xor(s, 1); s += __shfl_xor(s, 2); s += __shfl_xor(s, 4); mx = fmaxf(mx, s); }
        if ((lane & 7) == 0) nrm[which * 4096 + (b * NHEADS + (lane >> 3)) * 128 + t] = sqrtf(mx) * 1.0001f;
    }
}
__device__ __forceinline__ void carry_prefix(Frame& F, const Args& a, int b) {
    const float* carry = (const float*)(a.ws + WS_CARRY) + (size_t)b * NTILE * 2 * LW + F.tid; float* cin = (float*)(a.ws + WS_CIN) + (size_t)b * NTILE * LW + F.tid;
    float c = 0.f;
    for (int j0 = 0; j0 < NTILE; j0 += 8) { float A[8], H[8];
#pragma unroll
        for (int j = 0; j < 8; ++j) { A[j] = carry[(size_t)(j0 + j) * 2 * LW]; H[j] = carry[(size_t)(j0 + j) * 2 * LW + LW]; }
#pragma unroll
        for (int j = 0; j < 8; ++j) { cin[(size_t)(j0 + j) * LW] = c; c = A[j] * c + H[j]; } }
}
template <bool FINAL> __device__ __forceinline__ void lru_phase(Frame& F, const Args& a) {
    for (int tile = F.vcu; tile < BATCH * NTILE; tile += F.G) { lru_tile<FINAL>(F, a, tile); __syncthreads(); }
}
}
__global__ void __launch_bounds__(NWAVES * 64, 2) mk_fwd(Args args) {
    extern __shared__ __attribute__((aligned(16))) unsigned char lds[];
    Frame F;
    F.lds = (LAS unsigned char*)lds;
    F.MISC = (volatile LAS unsigned*)(F.lds + MISC_OFF);
    F.wave = __builtin_amdgcn_readfirstlane((int)threadIdx.x >> 6); F.lane = (int)__builtin_amdgcn_mbcnt_hi(~0u, __builtin_amdgcn_mbcnt_lo(~0u, 0u)); F.tid = F.wave * 64 + F.lane;
    F.G = gridDim.x; { const int bx = blockIdx.x; F.vcu = (F.G % 8 == 0) ? (bx % 8) * (F.G / 8) + bx / 8 : bx; }
    unsigned char* ws = args.ws;
    F.ctl = (gu32*)(ws + WS_CTL);
    for (int u = F.tid; u < (LDS_BYTES - LDSCTL_OFF) / 4; u += NWAVES * 64) ((LAS unsigned*)(F.lds + LDSCTL_OFF))[u] = 0u;
    __syncthreads();
    XcdBarrier bar = xcd_barrier_post((unsigned*)(F.ctl + CW_BAR) + args.li * XCD_BAR_WORDS, F.MISC + 8, F.wave);
    const int lo = args.ph_lo, hi = args.ph_hi;
#define IN(k) (lo <= (k) && (k) < hi)
#define BOTH(k) (IN(k) && IN((k) + 1))
#define GRID_BAR() xcd_barrier(bar)

    if (IN(0)) { for (int rp = 0; rp < REPS(0); ++rp) { if (rp) GRID_BAR(); p0_prologue(F, args); } if (BOTH(0)) GRID_BAR(); }

    if (IN(1)) for (int rp = 0; rp < REPS(1); ++rp) {
        if (rp) GRID_BAR();
        if (F.vcu < BATCH * NHEADS) fcum_unit(F, F.vcu, (const float*)(ws + WS_LOGF), (float*)(ws + WS_FCUM));
        pg8::Gemm g{(const pg8::bf16_t*)(ws + WS_H), (const pg8::bf16_t*)(ws + WS_WIN), T, NG1, DMODEL}; pg8::StaticOrder S; S.init(T, NG1, F.G, (int)blockIdx.x);
        pg8::EpiG1 E{(pg8::bf16_t*)(ws + WS_XR), SPLIT_STRIDE, QSCALE};
        pg8::gemm_phase<pg8::EpiG1, pg8::StaticOrder, true, true>(F.lds + RING_OFF, g, S, E, F.wave);
        if (BOTH(1) && rp == REPS(1) - 1) GRID_BAR();
    }
    if (IN(2)) { for (int rp = 0; rp < REPS(2); ++rp) { if (rp) GRID_BAR(); lru::lru_phase<false>(F, args); lru::norm_pass(F, args); } if (BOTH(2)) GRID_BAR(); }
    if (IN(3)) for (int rp = 0; rp < REPS(3); ++rp) {
        if (rp) { GRID_BAR(); if (F.wave == 0 && F.lane == 0 && blockIdx.x == 0) __hip_atomic_store((unsigned*)(F.ctl + CW_ATTQ), 0u, __ATOMIC_RELAXED, __HIP_MEMORY_SCOPE_AGENT); GRID_BAR(); }
        static_assert(attn_body::ATTN_LDS_BYTES <= RING_BYTES, "attention LDS vs frame");
        if (rp == 0 && F.vcu < BATCH) lru::carry_prefix(F, args, F.vcu);
        const attn_body::AttnTensors AT{(const attn_body::bf16*)(ws + WS_Q), (const attn_body::bf16*)(ws + WS_K), (const attn_body::bf16*)(ws + WS_V), (attn_body::bf16*)(ws + WS_O), (const float*)(ws + WS_FCUM), (const float*)(ws + WS_NRM)};
        attn_body::attn_phase<8>((char*)lds + RING_OFF, AT, (unsigned*)(F.ctl + CW_ATTQ), F.MISC + 24, F.wave);
        if (BOTH(3) && rp == REPS(3) - 1) GRID_BAR();
    }
    if (IN(4)) { for (int rp = 0; rp < REPS(4); ++rp) { if (rp) GRID_BAR(); lru::lru_phase<true>(F, args); } if (BOTH(4)) GRID_BAR(); }
    if (IN(5)) {
        pg8::Gemm g{(const pg8::bf16_t*)(ws + WS_H), (const pg8::bf16_t*)(ws + WS_WOUT), T, DMODEL, DMODEL}; pg8::StaticOrder S; S.init(T, DMODEL, F.G, (int)blockIdx.x);
        pg8::EpiG2 E{args.in[0], args.out, (pg8::bf16_t*)(ws + WS_X1B), (float*)(ws + WS_SUMSQ), DMODEL};
        pg8::gemm_phase<pg8::EpiG2, pg8::StaticOrder, true, true>(F.lds + RING_OFF, g, S, E, F.wave);
        if (BOTH(5)) GRID_BAR();
    }
    if (IN(6)) for (int rp = 0; rp < REPS(6); ++rp) {
        if (rp) GRID_BAR();
        pg8::Gemm g{(const pg8::bf16_t*)(ws + WS_X1B), (const pg8::bf16_t*)(ws + WS_WQ), T, QPW, DMODEL}; pg8::StaticOrder S; S.init(T, QPW, F.G, (int)blockIdx.x);
        pg8::EpiG3 E{(pg8::bf16_t*)(ws + WS_QP), QPW};
        pg8::gemm_phase<pg8::EpiG3, pg8::StaticOrder, true, true>(F.lds + RING_OFF, g, S, E, F.wave);
        if (BOTH(6) && rp == REPS(6) - 1) GRID_BAR();
    }
    if (IN(7)) { peer::peer_phase(F, args); }
#undef IN
#undef BOTH
#undef GRID_BAR
}

#ifndef MK_FRAME_MASK
#define MK_FRAME_MASK 0xFF
#endif
extern "C" void kernel_launch(void* const* d_in, const int* in_sizes, int n_in, void* d_out, int out_size, void* d_ws, size_t ws_size, hipStream_t stream) {
    static int grid = 0;
    if (grid == 0) {
        if (n_in != 20 || in_sizes[0] != T * DMODEL || out_size != T * DMODEL || ws_size < WS_END) { fprintf(stderr, "kernel_launch: unexpected shapes (n_in %d, ws %zu)\n", n_in, ws_size); grid = -1; return; }
        int dev = 0, cus = 0;
        if (hipGetDevice(&dev) != hipSuccess || hipDeviceGetAttribute(&cus, hipDeviceAttributeMultiprocessorCount, dev) != hipSuccess) { grid = -1; return; }
        if (hipFuncSetAttribute((const void*)mk_fwd, hipFuncAttributeMaxDynamicSharedMemorySize, LDS_BYTES) != hipSuccess) { fprintf(stderr, "kernel_launch: hipFuncSetAttribute failed\n"); grid = -1; return; }
        (void)hipGetLastError();
        grid = cus;
    }
    if (grid < 0) return;
    using namespace naive;
    const float* x = (const float*)d_in[0]; const float* g1 = (const float*)d_in[1]; const float* w_in = (const float*)d_in[2];
    const float* cw = (const float*)d_in[3]; const float* cb = (const float*)d_in[4]; const float* wa = (const float*)d_in[5]; const float* ba = (const float*)d_in[6];
    const float* wx = (const float*)d_in[7]; const float* bx = (const float*)d_in[8]; const float* lam = (const float*)d_in[9]; const float* bfv = (const float*)d_in[10];
    const float* gn_l = (const float*)d_in[11]; const float* gn_f = (const float*)d_in[12]; const float* w_out = (const float*)d_in[13]; const float* g2 = (const float*)d_in[14];
    const float* w_q = (const float*)d_in[15]; const float* sk = (const float*)d_in[16]; const float* pu = (const float*)d_in[17]; const float* pv = (const float*)d_in[18]; const float* fg = (const float*)d_in[19];
    char* ws = (char*)d_ws; float* out = (float*)d_out;
    naive::bf16* win_t = (naive::bf16*)(ws + WS_WIN); naive::bf16* wout_t = (naive::bf16*)(ws + WS_WOUT); naive::bf16* wq_t = (naive::bf16*)(ws + WS_WQ); naive::bf16* skb = (naive::bf16*)(ws + WS_SKB); float* wfl = (float*)(ws + WS_WFL);
    float* logf = (float*)(ws + WS_LOGF); float* fcum = (float*)(ws + WS_FCUM); float* sumsq = (float*)(ws + WS_SUMSQ);
    naive::bf16* h = (naive::bf16*)(ws + WS_H); naive::bf16* xr = (naive::bf16*)(ws + WS_XR); naive::bf16* gr = (naive::bf16*)(ws + WS_GR); naive::bf16* q = (naive::bf16*)(ws + WS_Q); naive::bf16* k = (naive::bf16*)(ws + WS_K); naive::bf16* v = (naive::bf16*)(ws + WS_V);
    naive::bf16* x1b = (naive::bf16*)(ws + WS_X1B); naive::bf16* qp = (naive::bf16*)(ws + WS_QP); naive::bf16* ut = (naive::bf16*)(ws + WS_UT); naive::bf16* vt = (naive::bf16*)(ws + WS_VT); float* la = (float*)(ws + WS_LA); float* lu = (float*)(ws + WS_LU);
    naive::bf16* ymix = h;
    if (hipMemsetAsync((char*)d_ws + WS_CTL, 0, CTL_ZERO_BYTES, stream) != hipSuccess) return;
    Args a{};
    for (int i = 0; i < 20; ++i) a.in[i] = (const float*)d_in[i];
    a.out = out; a.ws = (unsigned char*)d_ws;
    int li = 0;
    for (int p = 0; p < N_PHASES;) {
        if ((MK_FRAME_MASK >> p) & 1) {
            int e = p; while (e < N_PHASES && ((MK_FRAME_MASK >> e) & 1)) ++e;
            a.ph_lo = p; a.ph_hi = e; a.li = li++;
            hipLaunchKernelGGL(mk_fwd, dim3(grid), dim3(NWAVES * 64), LDS_BYTES, stream, a);
            p = e; continue;
        }
        switch (p) {
        case 0: k_prep_w<<<2048, 256, 0, stream>>>(w_in, w_out, gn_l, gn_f, w_q, g2, sk, win_t, wfl, wout_t, wq_t, skb);
                k_prep_tab<<<4096, 256, 0, stream>>>(pu, pv, g2, ut, vt);
                k_prep_x<<<2048, 256, 0, stream>>>(x, g1, wfl, bfv, h, logf); break;
        case 1: k_fcum<<<BATCH * NHEADS, 64, 0, stream>>>(logf, fcum);
                { EpiArgs e{xr, gr, q, k, v, nullptr, nullptr}; k_gemm<1><<<dim3(NG1 / 64, T / 64), 256, 0, stream>>>(h, win_t, T, NG1, DMODEL, e); } break;
        case 2: break;
        case 3: k_attn<<<(BATCH * NHEADS * SEQ) / 4, 256, 0, stream>>>(q, k, v, fcum, (naive::bf16*)(ws + WS_O)); break;
        case 4: k_lru_gates<<<T * NHEADS, 64, 0, stream>>>(xr, cw, cb, wa, ba, wx, bx, lam, la, lu);
                k_lru_scan<<<(BATCH * LW + 63) / 64, 64, 0, stream>>>(la, lu, gr);
                k_ymix<<<2048, 256, 0, stream>>>(lu, (naive::bf16*)(ws + WS_O), ymix); break;
        case 5: { EpiArgs e{x1b, nullptr, nullptr, nullptr, nullptr, x, out}; k_gemm<2><<<dim3(DMODEL / 64, T / 64), 256, 0, stream>>>(ymix, wout_t, T, DMODEL, DMODEL, e); }
                k_sumsq<<<2048, 256, 0, stream>>>(out, sumsq); break;
        case 6: { EpiArgs e{qp, nullptr, nullptr, nullptr, nullptr, nullptr, nullptr}; k_gemm<3><<<dim3(QPW / 64, T / 64), 256, 0, stream>>>(x1b, wq_t, T, QPW, DMODEL, e); } break;
        case 7: k_peer<<<T, 64, 0, stream>>>(qp, skb, sumsq, ut, vt, fg, out); break;
        }
        ++p;
    }
}
```

```cpp
#include <hip/hip_runtime.h>
#include <hip/hip_bf16.h>
#include <cstdio>
#include <cstdint>
#include <cmath>

constexpr int BATCH = 4, SEQ = 8192, DMODEL = 1024, T = BATCH * SEQ;
constexpr int LW = 512, AW = 512, NHEADS = 8, HD = 64, INC = 2568, NG1 = 2560;
constexpr int PH = 8, NKEY = 128, PHALF = 128, TOPK = 16, NEXP = NKEY * NKEY, QPW = 2048;
constexpr float RMS_EPS = 1e-6f;
constexpr float LOG2E = 1.4426950408889634f;
constexpr float QSCALE = 0.125f * LOG2E;
constexpr size_t MiB = 1u << 20;
constexpr size_t WS_CTL = 0, CTL_ZERO_BYTES = 1 * MiB;
constexpr size_t WS_WIN = 2 * MiB, WS_WOUT = 8 * MiB, WS_WQ = 10 * MiB, WS_SKB = 14 * MiB, WS_WFL = 15 * MiB,
                 WS_LOGF = 16 * MiB, WS_FCUM = 17 * MiB, WS_CARRY = 18 * MiB, WS_SUMSQ = 19 * MiB, WS_WAX = 20 * MiB, WS_CIN = 23 * MiB  , WS_NRM = 22 * MiB  ,
                 WS_H = 32 * MiB, WS_XR = 96 * MiB, WS_GR = 128 * MiB, WS_Q = 160 * MiB, WS_K = 192 * MiB, WS_V = 224 * MiB,
                 WS_X1B = 256 * MiB, WS_O = 256 * MiB  , WS_QP = 96 * MiB, WS_UT = 320 * MiB, WS_VT = 352 * MiB, WS_U8 = 320 * MiB, WS_V8 = 336 * MiB, WS_SU = 21 * MiB, WS_SV = 21 * MiB + 65536, WS_LA = 384 * MiB, WS_LU = 448 * MiB, WS_END = 512 * MiB;
constexpr size_t SPLIT_STRIDE = (WS_GR - WS_XR) / 2;
constexpr int CW_TMO = 0, CW_ATTQ = 2048, CW_BAR = 4096;

namespace naive {
typedef unsigned short bf16;
__device__ __forceinline__ unsigned f2bf(float f) { unsigned u = __builtin_bit_cast(unsigned, f); return (u + 0x7fffu + ((u >> 16) & 1u)) >> 16; }
__device__ __forceinline__ float bf2f(unsigned short h) { return __builtin_bit_cast(float, (unsigned)h << 16); }
__device__ __forceinline__ float gelu_tanh(float x) { const float u = 0.7978845608028654f * (x + 0.044715f * x * x * x); return 0.5f * x * (1.f + tanhf(u)); }
__device__ __forceinline__ float sigmoidf_(float x) { return 1.f / (1.f + expf(-x)); }
__device__ __forceinline__ float wave_sum(float v) {
#pragma unroll
    for (int o = 1; o < 64; o <<= 1) v += __shfl_xor(v, o);
    return v;
}
__global__ void k_prep_w(const float* w_in, const float* w_out, const float* gn_l, const float* gn_f, const float* w_q, const float* g2, const float* sk,
                         bf16* win_t, float* wfl, bf16* wout_t, bf16* wq_t, bf16* skb) {
    const size_t gid = (size_t)blockIdx.x * blockDim.x + threadIdx.x, gsz = (size_t)gridDim.x * blockDim.x;
    for (size_t i = gid; i < (size_t)NG1 * DMODEL; i += gsz) { const int n = (int)(i / DMODEL), k = (int)(i % DMODEL); win_t[i] = (bf16)f2bf(w_in[(size_t)k * INC + n]); }
    for (size_t i = gid; i < (size_t)8 * DMODEL; i += gsz) { const int j = (int)(i / DMODEL), k = (int)(i % DMODEL); wfl[i] = w_in[(size_t)k * INC + NG1 + j]; }
    for (size_t i = gid; i < (size_t)DMODEL * DMODEL; i += gsz) { const int n = (int)(i / DMODEL), k = (int)(i % DMODEL); const float g = k < LW ? gn_l[k] : gn_f[k - LW]; wout_t[i] = (bf16)f2bf(g * w_out[(size_t)k * DMODEL + n]); }
    for (size_t i = gid; i < (size_t)QPW * DMODEL; i += gsz) { const int n = (int)(i / DMODEL), k = (int)(i % DMODEL); wq_t[i] = (bf16)f2bf(g2[k] * w_q[(size_t)k * QPW + n]); }
    for (size_t i = gid; i < (size_t)PH * 2 * NKEY * PHALF; i += gsz) skb[i] = (bf16)f2bf(sk[i]);
}
__global__ void k_prep_tab(const float* u, const float* v, const float* g2, bf16* ut, bf16* vt) {
    const size_t gid = (size_t)blockIdx.x * blockDim.x + threadIdx.x, gsz = (size_t)gridDim.x * blockDim.x;
    for (size_t i = gid; i < (size_t)NEXP * DMODEL; i += gsz) { const int d = (int)(i % DMODEL); ut[i] = (bf16)f2bf(g2[d] * u[i]); vt[i] = (bf16)f2bf(v[i]); }
}
__global__ void k_prep_x(const float* x, const float* g1, const float* wfl, const float* bfv, bf16* h, float* logf) {
    const int lane = threadIdx.x & 63, wv = (blockIdx.x * blockDim.x + threadIdx.x) >> 6, nw = (gridDim.x * blockDim.x) >> 6;
    for (int t = wv; t < T; t += nw) {
        float xv[16]; float ss = 0.f;
#pragma unroll
        for (int j = 0; j < 4; ++j) { const float4 v = *(const float4*)(x + (size_t)t * DMODEL + j * 256 + lane * 4); xv[4 * j] = v.x; xv[4 * j + 1] = v.y; xv[4 * j + 2] = v.z; xv[4 * j + 3] = v.w; ss += v.x * v.x + v.y * v.y + v.z * v.z + v.w * v.w; }
        const float rstd = rsqrtf(wave_sum(ss) * (1.f / DMODEL) + RMS_EPS);
#pragma unroll
        for (int j = 0; j < 4; ++j) { const float4 g = *(const float4*)(g1 + j * 256 + lane * 4); xv[4 * j] *= rstd * g.x; xv[4 * j + 1] *= rstd * g.y; xv[4 * j + 2] *= rstd * g.z; xv[4 * j + 3] *= rstd * g.w;
            uint2 o; o.x = f2bf(xv[4 * j]) | (f2bf(xv[4 * j + 1]) << 16); o.y = f2bf(xv[4 * j + 2]) | (f2bf(xv[4 * j + 3]) << 16); *(uint2*)(h + (size_t)t * DMODEL + j * 256 + lane * 4) = o; }
#pragma unroll
        for (int hh = 0; hh < 8; ++hh) { float a = 0.f;
#pragma unroll
            for (int j = 0; j < 4; ++j) { const float4 w = *(const float4*)(wfl + hh * DMODEL + j * 256 + lane * 4); a += xv[4 * j] * w.x + xv[4 * j + 1] * w.y + xv[4 * j + 2] * w.z + xv[4 * j + 3] * w.w; }
            a = wave_sum(a);
            if (lane == 0) { const float z = a + bfv[hh]; logf[(size_t)t * 8 + hh] = fminf(z, 0.f) - log1pf(expf(-fabsf(z))); } }
    }
}
__global__ void k_fcum(const float* logf, float* fcum) {
    const int lane = threadIdx.x & 63, bh = blockIdx.x, b = bh / NHEADS, hh = bh % NHEADS;
    float loc = 0.f;
    for (int i = 0; i < 128; ++i) loc += logf[((size_t)b * SEQ + lane * 128 + i) * 8 + hh];
    float inc = loc;
#pragma unroll
    for (int o = 1; o < 64; o <<= 1) { const float n = __shfl_up(inc, o); if (lane >= o) inc += n; }
    float run = inc - loc;
    for (int i = 0; i < 128; ++i) { run += logf[((size_t)b * SEQ + lane * 128 + i) * 8 + hh]; fcum[(size_t)bh * SEQ + lane * 128 + i] = run; }
}
struct EpiArgs { bf16* o0; bf16* o1; bf16* o2; bf16* o3; bf16* o4; const float* resid; float* outf; };
template <int EPI> __global__ void __launch_bounds__(256) k_gemm(const bf16* A, const bf16* Bt, int M, int N, int K, EpiArgs e) {
    __shared__ float As[32][65], Bs[32][65];
    const int tid = threadIdx.x, tx = tid & 15, ty = tid >> 4, m0 = blockIdx.y * 64, n0 = blockIdx.x * 64;
    float acc[4][4] = {};
    const int lr = tid >> 2, lc = (tid & 3) * 8;
    for (int k0 = 0; k0 < K; k0 += 32) {
        const uint4 av = *(const uint4*)(A + (size_t)(m0 + lr) * K + k0 + lc), bv = *(const uint4*)(Bt + (size_t)(n0 + lr) * K + k0 + lc);
        const unsigned aw[4] = {av.x, av.y, av.z, av.w}, bw[4] = {bv.x, bv.y, bv.z, bv.w};
#pragma unroll
        for (int i = 0; i < 4; ++i) { As[lc + 2 * i][lr] = bf2f(aw[i] & 0xffff); As[lc + 2 * i + 1][lr] = bf2f(aw[i] >> 16); Bs[lc + 2 * i][lr] = bf2f(bw[i] & 0xffff); Bs[lc + 2 * i + 1][lr] = bf2f(bw[i] >> 16); }
        __syncthreads();
#pragma unroll 8
        for (int k = 0; k < 32; ++k) { float a[4], b[4];
#pragma unroll
            for (int i = 0; i < 4; ++i) { a[i] = As[k][ty * 4 + i]; b[i] = Bs[k][tx * 4 + i]; }
#pragma unroll
            for (int i = 0; i < 4; ++i)
#pragma unroll
                for (int j = 0; j < 4; ++j) acc[i][j] += a[i] * b[j]; }
        __syncthreads();
    }
#pragma unroll
    for (int i = 0; i < 4; ++i)
#pragma unroll
        for (int j = 0; j < 4; ++j) { const int m = m0 + ty * 4 + i, n = n0 + tx * 4 + j; const float v = acc[i][j];
            if (EPI == 1) { const int s = n >> 9, c = n & 511; bf16* o = s == 0 ? e.o0 : s == 1 ? e.o1 : s == 2 ? e.o2 : s == 3 ? e.o3 : e.o4;
                const float w = s == 1 ? gelu_tanh(v) : s == 2 ? v * QSCALE : v; o[(size_t)m * 512 + c] = (bf16)f2bf(w); }
            else if (EPI == 2) { const float r = e.resid[(size_t)m * DMODEL + n] + v; e.outf[(size_t)m * DMODEL + n] = r; e.o0[(size_t)m * DMODEL + n] = (bf16)f2bf(r); }
            else { e.o0[(size_t)m * N + n] = (bf16)f2bf(v); } }
}
__global__ void k_sumsq(const float* x1, float* sumsq) {
    const int lane = threadIdx.x & 63, wv = (blockIdx.x * blockDim.x + threadIdx.x) >> 6, nw = (gridDim.x * blockDim.x) >> 6;
    for (int t = wv; t < T; t += nw) { float ss = 0.f;
#pragma unroll
        for (int j = 0; j < 4; ++j) { const float4 v = *(const float4*)(x1 + (size_t)t * DMODEL + j * 256 + lane * 4); ss += v.x * v.x + v.y * v.y + v.z * v.z + v.w * v.w; }
        ss = wave_sum(ss); if (lane == 0) sumsq[t] = ss; }
}
__global__ void k_lru_gates(const bf16* xr, const float* cw, const float* cb, const float* wa, const float* ba, const float* wx, const float* bx, const float* lam, float* la, float* lu) {
    __shared__ float xc[64];
    const int j = threadIdx.x, t = blockIdx.x / NHEADS, hh = blockIdx.x % NHEADS, ch = hh * 64 + j, s = t % SEQ;
    float c = cb[ch];
#pragma unroll
    for (int k = 0; k < 4; ++k) { const int ss = s - 3 + k; if (ss >= 0) c += cw[k * LW + ch] * bf2f(xr[(size_t)(t - 3 + k) * LW + ch]); }
    xc[j] = c; __syncthreads();
    float r = ba[ch], ii = bx[ch];
    for (int i = 0; i < 64; ++i) { const float xv = xc[i]; r += xv * wa[(size_t)(hh * 64 + i) * 64 + j]; ii += xv * wx[(size_t)(hh * 64 + i) * 64 + j]; }
    r = sigmoidf_(r); ii = sigmoidf_(ii);
    const float l = lam[ch], sp = fmaxf(-l, 0.f) + log1pf(expf(-fabsf(l)));
    const float log_a = -8.f * r * sp, a = expf(log_a), u = sqrtf(-expm1f(2.f * log_a)) * (ii * c);
    la[(size_t)t * LW + ch] = a; lu[(size_t)t * LW + ch] = u;
}
__global__ void k_lru_scan(const float* la, float* lu, const bf16* gr) {
    const int id = blockIdx.x * blockDim.x + threadIdx.x; if (id >= BATCH * LW) return;
    const int b = id / LW, ch = id % LW; float h = 0.f;
    for (int s = 0; s < SEQ; ++s) { const size_t o = ((size_t)b * SEQ + s) * LW + ch; h = la[o] * h + lu[o]; lu[o] = h * bf2f(gr[o]); }
}
__global__ void k_ymix(const float* ylru, const bf16* o, bf16* ymix) {
    const int lane = threadIdx.x & 63, wv = (blockIdx.x * blockDim.x + threadIdx.x) >> 6, nw = (gridDim.x * blockDim.x) >> 6;
    for (int t = wv; t < T; t += nw) {
        float a[8], f[8]; float sa = 0.f, sf = 0.f;
#pragma unroll
        for (int i = 0; i < 8; ++i) { a[i] = ylru[(size_t)t * LW + i * 64 + lane]; f[i] = bf2f(o[(size_t)t * AW + i * 64 + lane]); sa += a[i] * a[i]; sf += f[i] * f[i]; }
        const float ra = rsqrtf(wave_sum(sa) * (1.f / LW) + RMS_EPS), rf = rsqrtf(wave_sum(sf) * (1.f / AW) + RMS_EPS);
#pragma unroll
        for (int i = 0; i < 8; ++i) { ymix[(size_t)t * DMODEL + i * 64 + lane] = (bf16)f2bf(a[i] * ra); ymix[(size_t)t * DMODEL + LW + i * 64 + lane] = (bf16)f2bf(f[i] * rf); }
    }
}
__global__ void __launch_bounds__(256) k_attn(const bf16* Q, const bf16* K, const bf16* V, const float* fcum, bf16* O) {
    const int lane = threadIdx.x & 63, wv = (blockIdx.x * blockDim.x + threadIdx.x) >> 6;
    const int q = wv % SEQ, bh = wv / SEQ, b = bh / NHEADS, hh = bh % NHEADS;
    const size_t rowq = (size_t)b * SEQ + q;
    float qv[64];
#pragma unroll
    for (int i = 0; i < 8; ++i) { const uint4 w = *(const uint4*)(Q + rowq * AW + hh * 64 + i * 8); const unsigned ww[4] = {w.x, w.y, w.z, w.w};
#pragma unroll
        for (int c = 0; c < 4; ++c) { qv[i * 8 + 2 * c] = bf2f(ww[c] & 0xffff); qv[i * 8 + 2 * c + 1] = bf2f(ww[c] >> 16); } }
    const float fq = fcum[(size_t)bh * SEQ + q];
    float m = -INFINITY, l = 0.f; float o[64];
#pragma unroll
    for (int d = 0; d < 64; ++d) o[d] = 0.f;
    for (int j = lane; j <= q; j += 64) {
        const size_t rowk = (size_t)b * SEQ + j; float s = 0.f;
#pragma unroll
        for (int i = 0; i < 8; ++i) { const uint4 w = *(const uint4*)(K + rowk * AW + hh * 64 + i * 8); const unsigned ww[4] = {w.x, w.y, w.z, w.w};
#pragma unroll
            for (int c = 0; c < 4; ++c) { s += qv[i * 8 + 2 * c] * bf2f(ww[c] & 0xffff) + qv[i * 8 + 2 * c + 1] * bf2f(ww[c] >> 16); } }
        s += (fq - fcum[(size_t)bh * SEQ + j]) * LOG2E;
        const float mn = fmaxf(m, s), sc = exp2f(m - mn), p = exp2f(s - mn);
        l = l * sc + p; m = mn;
#pragma unroll
        for (int i = 0; i < 8; ++i) { const uint4 w = *(const uint4*)(V + rowk * AW + hh * 64 + i * 8); const unsigned ww[4] = {w.x, w.y, w.z, w.w};
#pragma unroll
            for (int c = 0; c < 4; ++c) { o[i * 8 + 2 * c] = o[i * 8 + 2 * c] * sc + p * bf2f(ww[c] & 0xffff); o[i * 8 + 2 * c + 1] = o[i * 8 + 2 * c + 1] * sc + p * bf2f(ww[c] >> 16); } }
    }
    float mall = m;
#pragma unroll
    for (int of = 1; of < 64; of <<= 1) mall = fmaxf(mall, __shfl_xor(mall, of));
    const float sc = (m == -INFINITY) ? 0.f : exp2f(m - mall);
    const float lt = wave_sum(l * sc); const float inv = 1.f / lt;
    float mine = 0.f;
#pragma unroll
    for (int d = 0; d < 64; ++d) { const float v = wave_sum(o[d] * sc); if (lane == d) mine = v; }
    O[rowq * AW + hh * 64 + lane] = (bf16)f2bf(mine * inv);
}
__device__ __forceinline__ void wave_argmax(float v, int idx, float& bv, int& bi) {
#pragma unroll
    for (int o = 1; o < 64; o <<= 1) { const float ov = __shfl_xor(v, o); const int oi = __shfl_xor(idx, o); if (ov > v || (ov == v && oi < idx)) { v = ov; idx = oi; } }
    bv = v; bi = idx;
}
__global__ void __launch_bounds__(64) k_peer(const bf16* qp, const bf16* skb, const float* sumsq, const bf16* ut, const bf16* vt, const float* fg, float* out) {
    __shared__ float qs[2048]; __shared__ float sc[256]; __shared__ float s1[16], s2[16]; __shared__ int i1[16], i2[16]; __shared__ int ex[128]; __shared__ float gt[128];
    const int lane = threadIdx.x, t = blockIdx.x;
    const float rstd2 = rsqrtf(sumsq[t] * (1.f / DMODEL) + RMS_EPS);
    for (int i = lane; i < 2048; i += 64) qs[i] = bf2f(qp[(size_t)t * 2048 + i]) * rstd2;
    __syncthreads();
    for (int hh = 0; hh < PH; ++hh) {
        for (int r = 0; r < 4; ++r) { const int idx = r * 64 + lane, p = idx >> 7, n = idx & 127; const bf16* kr = skb + ((size_t)(hh * 2 + p) * NKEY + n) * PHALF; const float* qq = qs + hh * 256 + p * 128;
            float a = 0.f; for (int c = 0; c < 128; ++c) a += qq[c] * bf2f(kr[c]); sc[idx] = a; }
        __syncthreads();
        for (int p = 0; p < 2; ++p) {
            float v0 = sc[p * 128 + lane], v1 = sc[p * 128 + 64 + lane];
            for (int k = 0; k < 16; ++k) { float v; int id; if (v0 >= v1) { v = v0; id = lane; } else { v = v1; id = lane + 64; }
                float bv; int bi; wave_argmax(v, id, bv, bi);
                if (lane == 0) { if (p == 0) { s1[k] = bv; i1[k] = bi; } else { s2[k] = bv; i2[k] = bi; } }
                if (bi == lane) v0 = -INFINITY; if (bi == lane + 64) v1 = -INFINITY; }
        }
        __syncthreads();
        float cv[4];
#pragma unroll
        for (int r = 0; r < 4; ++r) { const int idx = r * 64 + lane; cv[r] = s1[idx >> 4] + s2[idx & 15]; }
        float tops = 0.f; int topp = 0;
        for (int k = 0; k < 16; ++k) { float v = cv[0]; int id = lane;
#pragma unroll
            for (int r = 1; r < 4; ++r) if (cv[r] > v) { v = cv[r]; id = r * 64 + lane; }
            float bv; int bi; wave_argmax(v, id, bv, bi);
            if (lane == k) { tops = bv; topp = bi; }
#pragma unroll
            for (int r = 0; r < 4; ++r) if (bi == r * 64 + lane) cv[r] = -INFINITY; }
        float mx = lane < 16 ? tops : -INFINITY;
#pragma unroll
        for (int o = 1; o < 64; o <<= 1) mx = fmaxf(mx, __shfl_xor(mx, o));
        const float ev = lane < 16 ? expf(tops - mx) : 0.f; const float den = wave_sum(ev);
        if (lane < 16) { ex[hh * 16 + lane] = i1[topp >> 4] * NKEY + i2[topp & 15]; gt[hh * 16 + lane] = ev / den; }
        __syncthreads();
    }
    float hv[16], y[16];
    const float* x1 = out + (size_t)t * DMODEL;
#pragma unroll
    for (int j = 0; j < 4; ++j) { const float4 v = *(const float4*)(x1 + j * 256 + lane * 4); hv[4 * j] = v.x * rstd2; hv[4 * j + 1] = v.y * rstd2; hv[4 * j + 2] = v.z * rstd2; hv[4 * j + 3] = v.w * rstd2; }
#pragma unroll
    for (int i = 0; i < 16; ++i) y[i] = 0.f;
    for (int k = 0; k < 128; ++k) { const int e = ex[k]; const float g = gt[k]; float a = 0.f;
#pragma unroll
        for (int j = 0; j < 4; ++j) { const uint2 w = *(const uint2*)(ut + (size_t)e * DMODEL + j * 256 + lane * 4);
            a += hv[4 * j] * bf2f(w.x & 0xffff) + hv[4 * j + 1] * bf2f(w.x >> 16) + hv[4 * j + 2] * bf2f(w.y & 0xffff) + hv[4 * j + 3] * bf2f(w.y >> 16); }
        a = wave_sum(a); const float act = gelu_tanh(a) * g;
#pragma unroll
        for (int j = 0; j < 4; ++j) { const uint2 w = *(const uint2*)(vt + (size_t)e * DMODEL + j * 256 + lane * 4);
            y[4 * j] += act * bf2f(w.x & 0xffff); y[4 * j + 1] += act * bf2f(w.x >> 16); y[4 * j + 2] += act * bf2f(w.y & 0xffff); y[4 * j + 3] += act * bf2f(w.y >> 16); } }
    float ss = 0.f;
#pragma unroll
    for (int j = 0; j < 4; ++j) { const float4 v = *(const float4*)(x1 + j * 256 + lane * 4); y[4 * j] += v.x; y[4 * j + 1] += v.y; y[4 * j + 2] += v.z; y[4 * j + 3] += v.w; }
#pragma unroll
    for (int i = 0; i < 16; ++i) ss += y[i] * y[i];
    const float rs = rsqrtf(wave_sum(ss) * (1.f / DMODEL) + RMS_EPS);
#pragma unroll
    for (int j = 0; j < 4; ++j) { const float4 g = *(const float4*)(fg + j * 256 + lane * 4); float4 o; o.x = y[4 * j] * rs * g.x; o.y = y[4 * j + 1] * rs * g.y; o.z = y[4 * j + 2] * rs * g.z; o.w = y[4 * j + 3] * rs * g.w;
        *(float4*)(out + (size_t)t * DMODEL + j * 256 + lane * 4) = o; }
}
}

namespace pg8 {
#define PG8_LAS __attribute__((address_space(3)))
typedef unsigned short bf16_t;
typedef short bf16x8 __attribute__((ext_vector_type(8)));
typedef float f32x4 __attribute__((ext_vector_type(4)));
typedef unsigned u32x4 __attribute__((ext_vector_type(4)));
constexpr int BM = 256, BK = 64, HALF = 128, HTB = HALF * BK * 2  , STAGE_BYTES = 8 * HTB, NXCD = 8, WGM = 8;

__host__ __device__ __forceinline__ int lds_byte(int r, int c) { const int st = (r >> 4) * 2 + (c >> 5), rr = r & 15, cc = c & 31, ob = rr * 64 + cc * 2; return st * 1024 + (ob ^ (((ob >> 9) & 1) << 5)); }
__host__ __device__ __forceinline__ void stage_rc(int b, int& R, int& C) { const int st = b / 1024, sb = b % 1024, swz = sb ^ (((sb >> 9) & 1) << 5); R = (st >> 1) * 16 + swz / 64; C = (st & 1) * 32 + (swz % 64) / 2; }
__host__ __device__ __forceinline__ int perm32(int rho) { const int n = rho >> 4, i = rho & 15; return 8 * (i >> 2) + 4 * n + (i & 3); }

struct Unit { int pm, pn; };
struct Gemm { const bf16_t* A; const bf16_t* Bt; int M, N, K; };

struct StaticOrder {
    int nM, nN, nwg, G, c;
    __host__ __device__ void init(int M, int N, int G_, int c_) { nM = M / BM; nN = N / BM; nwg = nM * nN; G = G_; c = c_; }
    __host__ __device__ bool next(int i, Unit& u) const {
        const long L = (long)i * G + c; if (L >= nwg) return false;
        int wgid = (int)L; { const int q = nwg / NXCD, r = nwg % NXCD, xcd = wgid % NXCD, off = wgid / NXCD; wgid = (xcd < r ? xcd * (q + 1) : r * (q + 1) + (xcd - r) * q) + off; }
        const int nig = WGM * nN, gid = wgid / nig, fm = gid * WGM, gsz = (nM - fm) < WGM ? (nM - fm) : WGM;
        u.pm = fm + ((wgid % nig) % gsz); u.pn = (wgid % nig) / gsz; return true;
    }
    __device__ __forceinline__ void a_ready(const Unit&) const {}
    __device__ __forceinline__ void done(const Unit&) const {}
};

__device__ __forceinline__ unsigned cvt_pk_bf16(float lo, float hi) { unsigned r; asm volatile("v_cvt_pk_bf16_f32 %0, %1, %2" : "=v"(r) : "v"(lo), "v"(hi)); return r; }
typedef unsigned u32x2 __attribute__((ext_vector_type(2)));
__device__ __forceinline__ float gelu_fast(float x) {
    const float u2 = x * (1.5957691216057308f + 0.07135481627f * x * x);
    return x * __builtin_amdgcn_rcpf(1.f + __builtin_amdgcn_exp2f(-1.4426950408889634f * u2));
}
struct EpiG1 {
    static constexpr bool PERM = true, AFTER_DRAIN = false;
    bf16_t* base0; size_t split_stride; float qscale;
    __device__ __forceinline__ void operator()(const f32x4 (&acc)[2][2][4][2], const Unit& u, int wr, int wc, int fr, int fq) const {
        const int s = u.pn >> 1; bf16_t* base = base0 + (size_t)s * split_stride;
        const int row0 = u.pm * BM + wr * 64 + fr, col0 = (u.pn & 1) * 256 + wc * 32 + 8 * fq;
#pragma unroll
        for (int ai = 0; ai < 2; ++ai)
#pragma unroll
            for (int m = 0; m < 4; ++m) { bf16_t* rowp = base + (size_t)(row0 + ai * HALF + m * 16) * 512 + col0;
#pragma unroll
                for (int bj = 0; bj < 2; ++bj) { f32x4 v0 = acc[ai][bj][m][0], v1 = acc[ai][bj][m][1];
                    if (s == 1) {
#pragma unroll
                        for (int e = 0; e < 4; ++e) { v0[e] = gelu_fast(v0[e]); v1[e] = gelu_fast(v1[e]); } }
                    else if (s == 2) { v0 = v0 * qscale; v1 = v1 * qscale; }
                    u32x4 w; w.x = cvt_pk_bf16(v0[0], v0[1]); w.y = cvt_pk_bf16(v0[2], v0[3]); w.z = cvt_pk_bf16(v1[0], v1[1]); w.w = cvt_pk_bf16(v1[2], v1[3]);
                    *(u32x4*)(rowp + bj * HALF) = w; } }
    }
};
struct EpiG2 {
    static constexpr bool PERM = false, AFTER_DRAIN = false;
    const float* resid; float* out; bf16_t* xb; float* sumsq; int ldc;
    __device__ __forceinline__ void operator()(const f32x4 (&acc)[2][2][4][2], const Unit& u, int wr, int wc, int fr, int fq) const {
        const int row0 = u.pm * BM + wr * 64 + fr, col0 = u.pn * BM + wc * 32 + 4 * fq;
#pragma unroll
        for (int ai = 0; ai < 2; ++ai) {
            f32x4 rs[4][2][2];
#pragma unroll
            for (int m = 0; m < 4; ++m) { const size_t off = (size_t)(row0 + ai * HALF + m * 16) * ldc + col0;
#pragma unroll
                for (int bj = 0; bj < 2; ++bj)
#pragma unroll
                    for (int n = 0; n < 2; ++n) rs[m][bj][n] = *(const f32x4*)(resid + off + bj * HALF + n * 16); }
#pragma unroll
            for (int m = 0; m < 4; ++m) { const int r = row0 + ai * HALF + m * 16; const size_t off = (size_t)r * ldc + col0; float ss = 0.f;
#pragma unroll
                for (int bj = 0; bj < 2; ++bj)
#pragma unroll
                    for (int n = 0; n < 2; ++n) { const f32x4 x = rs[m][bj][n] + acc[ai][bj][m][n];
                        *(f32x4*)(out + off + bj * HALF + n * 16) = x; ss += (x[0] * x[0] + x[1] * x[1]) + (x[2] * x[2] + x[3] * x[3]);
                        u32x2 w; w.x = cvt_pk_bf16(x[0], x[1]); w.y = cvt_pk_bf16(x[2], x[3]); *(u32x2*)(xb + off + bj * HALF + n * 16) = w; }
                ss += __shfl_xor(ss, 16); ss += __shfl_xor(ss, 32);
                if (fq == 0) atomicAdd(sumsq + r, ss); }
            asm volatile("" ::: "memory"); }
    }
};
struct EpiG3 {
    static constexpr bool PERM = true, AFTER_DRAIN = false;
    bf16_t* O; int ldc;
    __device__ __forceinline__ void operator()(const f32x4 (&acc)[2][2][4][2], const Unit& u, int wr, int wc, int fr, int fq) const {
        const int row0 = u.pm * BM + wr * 64 + fr, col0 = u.pn * BM + wc * 32 + 8 * fq;
#pragma unroll
        for (int ai = 0; ai < 2; ++ai)
#pragma unroll
            for (int m = 0; m < 4; ++m) { bf16_t* rowp = O + (size_t)(row0 + ai * HALF + m * 16) * ldc + col0;
#pragma unroll
                for (int bj = 0; bj < 2; ++bj) { const f32x4 v0 = acc[ai][bj][m][0], v1 = acc[ai][bj][m][1];
                    u32x4 w; w.x = cvt_pk_bf16(v0[0], v0[1]); w.y = cvt_pk_bf16(v0[2], v0[3]); w.z = cvt_pk_bf16(v1[0], v1[1]); w.w = cvt_pk_bf16(v1[2], v1[3]);
                    *(u32x4*)(rowp + bj * HALF) = w; } }
    }
};

template <class Epi, class Sched, bool ALIGN_EPI = false, bool SP2 = false>
__device__ __forceinline__ void gemm_phase(PG8_LAS unsigned char* lds, const Gemm g, const Sched& S, const Epi& E, int wid_in) {
    const int wid = __builtin_amdgcn_readfirstlane(wid_in), lane = (int)__builtin_amdgcn_mbcnt_hi(~0u, __builtin_amdgcn_mbcnt_lo(~0u, 0u)), tid = wid * 64 + lane, wr = wid >> 2, wc = wid & 3, fr = lane & 15, fq = lane >> 4;
    const int K = g.K, nt = K / BK;
    unsigned voffA[2], voffB[2];
#pragma unroll
    for (int i = 0; i < 2; ++i) { int R, C; stage_rc(tid * 16 + i * 8192, R, C); const int Rb = Epi::PERM ? ((R & ~31) + perm32(R & 31)) : R;
        voffA[i] = (unsigned)(R * K + C) * 2u; voffB[i] = (unsigned)(Rb * K + C) * 2u; }
    const size_t kstep = (size_t)(BK * 2);
    const size_t hstep = (size_t)HALF * K * 2;
    const size_t tstep = 2 * hstep;
    const unsigned ldsw = (unsigned)wid * 1024u;
    const int aoff = lds_byte(wr * 64 + fr, fq * 8), boff = lds_byte(wc * 32 + fr, fq * 8);
#define PG8_SA(b, h) (((b) * 2 + (h)) * HTB)
#define PG8_SB(b, h) ((4 + (b) * 2 + (h)) * HTB)
#define PG8_STAGE(bufoff, gbase, voff) do { _Pragma("unroll") for (int _i = 0; _i < 2; ++_i) \
        __builtin_amdgcn_global_load_lds((const unsigned*)((const char*)(gbase) + (voff)[_i]), (PG8_LAS unsigned*)(lds + (bufoff) + ldsw + _i * 8192), 16, 0, 0); } while (0)
#define PG8_LDA(dst, b, h) do { _Pragma("unroll") for (int m = 0; m < 4; ++m) _Pragma("unroll") for (int k = 0; k < 2; ++k) dst[m][k] = *(const PG8_LAS bf16x8*)(lds + PG8_SA(b, h) + aoff + m * 2048 + k * 1024); } while (0)
#define PG8_LDB(dst, b, h) do { _Pragma("unroll") for (int n = 0; n < 2; ++n) _Pragma("unroll") for (int k = 0; k < 2; ++k) dst[n][k] = *(const PG8_LAS bf16x8*)(lds + PG8_SB(b, h) + boff + n * 2048 + k * 1024); } while (0)
#define PG8_MMA(ai, bj, At, Bt) do { __builtin_amdgcn_s_setprio(1); _Pragma("unroll") for (int m = 0; m < 4; ++m) _Pragma("unroll") for (int n = 0; n < 2; ++n) _Pragma("unroll") for (int k = 0; k < 2; ++k) \
        acc[ai][bj][m][n] = __builtin_amdgcn_mfma_f32_16x16x32_bf16(Bt[n][k], At[m][k], acc[ai][bj][m][n], 0, 0, 0); __builtin_amdgcn_s_setprio(0); } while (0)
#define PG8_WAIT_V(n) asm volatile("s_waitcnt vmcnt(" #n ")" ::: "memory")
#define PG8_WAIT_L(n) asm volatile("s_waitcnt lgkmcnt(" #n ")" ::: "memory")
#define PG8_BAR __builtin_amdgcn_s_barrier()
#define PG8_SCHED __builtin_amdgcn_sched_barrier(0)
    Unit cur, nxt; int ui = 0;
    if (!S.next(0, cur)) return;
    f32x4 acc[2][2][4][2];
#pragma unroll
    for (int a = 0; a < 2; ++a)
#pragma unroll
        for (int b = 0; b < 2; ++b)
#pragma unroll
            for (int m = 0; m < 4; ++m)
#pragma unroll
                for (int n = 0; n < 2; ++n) acc[a][b][m][n] = (f32x4){0.f, 0.f, 0.f, 0.f};
    bf16x8 At[4][2], B0[2][2], B1[2][2];
    const char* cA = (const char*)g.A + (size_t)cur.pm * tstep; const char* cB = (const char*)g.Bt + (size_t)cur.pn * tstep;
    S.a_ready(cur);
    if constexpr (SP2) {
        PG8_STAGE(PG8_SB(0, 0), cB, voffB); PG8_STAGE(PG8_SB(0, 1), cB + hstep, voffB); PG8_STAGE(PG8_SA(0, 0), cA, voffA); PG8_STAGE(PG8_SA(0, 1), cA + hstep, voffA);
        if (wr == 1) PG8_BAR;
        PG8_WAIT_V(2); PG8_BAR;
        PG8_STAGE(PG8_SB(1, 0), cB + kstep, voffB); PG8_STAGE(PG8_SA(1, 0), cA + kstep, voffA); PG8_STAGE(PG8_SB(1, 1), cB + hstep + kstep, voffB);
        PG8_WAIT_V(6); PG8_BAR;
    } else {
        PG8_STAGE(PG8_SB(0, 0), cB, voffB); PG8_STAGE(PG8_SA(0, 0), cA, voffA); PG8_STAGE(PG8_SB(0, 1), cB + hstep, voffB); PG8_STAGE(PG8_SA(0, 1), cA + hstep, voffA);
        if (wr == 1) PG8_BAR;
        PG8_WAIT_V(4); PG8_BAR;
        PG8_STAGE(PG8_SB(1, 0), cB + kstep, voffB); PG8_STAGE(PG8_SA(1, 0), cA + kstep, voffA); PG8_STAGE(PG8_SB(1, 1), cB + hstep + kstep, voffB);
        PG8_WAIT_V(6); PG8_BAR;
    }
    for (;;) {
        const bool has_next = S.next(ui + 1, nxt);
        const char* nA = has_next ? (const char*)g.A + (size_t)nxt.pm * tstep : cA; const char* nB = has_next ? (const char*)g.Bt + (size_t)nxt.pn * tstep : cB;
        for (int t = 0; t < nt; t += 2) {
            const bool last = (t == nt - 2);
            const char* a1 = cA + (size_t)(t + 1) * kstep;
            const char* a2 = last ? nA : cA + (size_t)(t + 2) * kstep; const char* b2 = last ? nB : cB + (size_t)(t + 2) * kstep;
            const char* a3 = a2 + kstep; const char* b3 = b2 + kstep;
            if (last && has_next) S.a_ready(nxt);
            if constexpr (SP2) {
            PG8_LDB(B0, 0, 0); PG8_LDB(B1, 0, 1); PG8_SCHED; PG8_LDA(At, 0, 0); PG8_STAGE(PG8_SA(1, 1), a1 + hstep, voffA);
            PG8_WAIT_V(8); PG8_WAIT_L(0); PG8_BAR; PG8_MMA(0, 0, At, B0); PG8_MMA(0, 1, At, B1); PG8_BAR; PG8_SCHED;
            PG8_LDA(At, 0, 1); PG8_STAGE(PG8_SB(0, 0), b2, voffB); PG8_STAGE(PG8_SB(0, 1), b2 + hstep, voffB); PG8_STAGE(PG8_SA(0, 0), a2, voffA);
            PG8_WAIT_V(8); PG8_WAIT_L(0); PG8_BAR; PG8_MMA(1, 0, At, B0); PG8_MMA(1, 1, At, B1); PG8_BAR; PG8_SCHED;
            PG8_LDB(B0, 1, 0); PG8_LDB(B1, 1, 1); PG8_SCHED; PG8_LDA(At, 1, 0); PG8_STAGE(PG8_SA(0, 1), a2 + hstep, voffA);
            PG8_WAIT_V(8); PG8_WAIT_L(0); PG8_BAR; PG8_MMA(0, 0, At, B0); PG8_MMA(0, 1, At, B1); PG8_BAR; PG8_SCHED;
            PG8_LDA(At, 1, 1); PG8_STAGE(PG8_SB(1, 0), b3, voffB); PG8_STAGE(PG8_SB(1, 1), b3 + hstep, voffB); PG8_STAGE(PG8_SA(1, 0), a3, voffA);
            PG8_WAIT_V(8); PG8_WAIT_L(0); PG8_BAR; PG8_MMA(1, 0, At, B0); PG8_MMA(1, 1, At, B1); PG8_BAR; PG8_SCHED;
            } else {
            PG8_LDB(B0, 0, 0); PG8_SCHED; PG8_LDA(At, 0, 0); PG8_STAGE(PG8_SA(1, 1), a1 + hstep, voffA);
            PG8_WAIT_L(8); PG8_BAR; PG8_WAIT_L(0); PG8_MMA(0, 0, At, B0); PG8_BAR; PG8_SCHED;
            PG8_LDB(B1, 0, 1); PG8_STAGE(PG8_SB(0, 0), b2, voffB);
            PG8_BAR; PG8_WAIT_L(0); PG8_MMA(0, 1, At, B1); PG8_BAR;
            PG8_LDA(At, 0, 1); PG8_STAGE(PG8_SA(0, 0), a2, voffA);
            PG8_BAR; PG8_WAIT_L(0); PG8_MMA(1, 0, At, B0); PG8_BAR; PG8_SCHED;
            PG8_STAGE(PG8_SB(0, 1), b2 + hstep, voffB);
            PG8_WAIT_V(6); PG8_BAR; PG8_MMA(1, 1, At, B1); PG8_BAR;
            PG8_LDB(B0, 1, 0); PG8_SCHED; PG8_LDA(At, 1, 0); PG8_STAGE(PG8_SA(0, 1), a2 + hstep, voffA);
            PG8_WAIT_L(8); PG8_BAR; PG8_WAIT_L(0); PG8_MMA(0, 0, At, B0); PG8_BAR; PG8_SCHED;
            PG8_LDB(B1, 1, 1); PG8_STAGE(PG8_SB(1, 0), b3, voffB);
            PG8_BAR; PG8_WAIT_L(0); PG8_MMA(0, 1, At, B1); PG8_BAR;
            PG8_LDA(At, 1, 1); PG8_STAGE(PG8_SA(1, 0), a3, voffA);
            PG8_BAR; PG8_WAIT_L(0); PG8_MMA(1, 0, At, B0); PG8_BAR; PG8_SCHED;
            PG8_STAGE(PG8_SB(1, 1), b3 + hstep, voffB);
            PG8_WAIT_V(6); PG8_BAR; PG8_MMA(1, 1, At, B1); PG8_BAR;
            }
        }
        if constexpr (ALIGN_EPI) { if (wr == 0) PG8_BAR; }
        if constexpr (!Epi::AFTER_DRAIN) { E(acc, cur, wr, wc, fr, fq); S.done(cur); }
        if (!has_next) break;
#pragma unroll
        for (int a = 0; a < 2; ++a)
#pragma unroll
            for (int b = 0; b < 2; ++b)
#pragma unroll
                for (int m = 0; m < 4; ++m)
#pragma unroll
                    for (int n = 0; n < 2; ++n) acc[a][b][m][n] = (f32x4){0.f, 0.f, 0.f, 0.f};
        cur = nxt; cA = nA; cB = nB; ++ui;
        if constexpr (ALIGN_EPI) { if (wr == 1) PG8_BAR; }
    }
    PG8_WAIT_V(0);
    if constexpr (!ALIGN_EPI) { if (wr == 0) PG8_BAR; }
    PG8_BAR;
    if constexpr (Epi::AFTER_DRAIN) { E.fused(acc, cur, wr, wc, fr, fq, lds, wid, lane); S.done(cur); }
#undef PG8_SA
#undef PG8_SB
#undef PG8_STAGE
#undef PG8_LDA
#undef PG8_LDB
#undef PG8_MMA
#undef PG8_WAIT_V
#undef PG8_WAIT_L
#undef PG8_BAR
#undef PG8_SCHED
}
}
#include <hip/hip_bf16.h>
#include <cmath>
namespace attn_body {
using bf16=__hip_bfloat16;
using bf16x8=__attribute__((ext_vector_type(8)))short;
using s16x4=__attribute__((ext_vector_type(4)))short;
using f32x16=__attribute__((ext_vector_type(16)))float;
using u32x4=__attribute__((ext_vector_type(4)))unsigned;
constexpr int BATCH=4,NHEAD=8,SEQ=8192,D=64,DM=NHEAD*D;
constexpr int NW=8,QBLK=32,QB=QBLK*NW,KVBLK=64,NQB=SEQ/QB;
constexpr int ATTN_PITCH=DM, ATTN_UNIT_ROWS=QB;
__device__ __forceinline__ int crow(int r,int hi){return (r&3)+8*(r>>2)+4*hi;}
#define SBAR() __builtin_amdgcn_sched_barrier(0)
__device__ __forceinline__ void cmask(f32x16&p0,f32x16&p1,int jb,int qrel,int hi){
  const float NEG=-INFINITY; int kb=64*jb+4*hi;
  #pragma unroll
  for(int r=0;r<16;++r){int kv=kb+(r&3)+8*(r>>2); if(kv>qrel)p0[r]=NEG; if(kv+32>qrel)p1[r]=NEG;}
}

constexpr int NSLOT=3, SLOTB=8192;
constexpr int LDS_K=0, LDS_V=NSLOT*SLOTB, LDS_WS=2*NSLOT*SLOTB, LDS_OST=LDS_WS+NW*64*4, LDS_FK=LDS_OST+NW*4096, LDS_BYTES=LDS_FK+SEQ*4;
constexpr float C2=0.125f*1.4426950408889634f;
__device__ __forceinline__ void glds16(const void*gsrc,unsigned lds_dst){unsigned keep;
  asm volatile("s_mov_b32 %0, m0\n\ts_mov_b32 m0, %2\n\ts_nop 0\n\tglobal_load_lds_dwordx4 %1, off\n\ts_mov_b32 m0, %0":"=&s"(keep):"v"(gsrc),"s"(lds_dst):"memory");}
__device__ __forceinline__ float max3f(float a,float b,float c){float r;asm("v_max3_f32 %0, %1, %2, %3":"=v"(r):"v"(a),"v"(b),"v"(c));return r;}
__device__ __forceinline__ float max2f(float a,float b){float r;asm("v_max_f32_e32 %0, %1, %2":"=v"(r):"v"(a),"v"(b));return r;}
__device__ __forceinline__ float fadd_s(float a,float b){float r;asm("v_add_f32_e32 %0, %1, %2":"=v"(r):"v"(a),"v"(b));return r;}
__device__ __forceinline__ float fsub_s(float a,float b){float r;asm("v_sub_f32_e32 %0, %1, %2":"=v"(r):"v"(a),"v"(b));return r;}
typedef float f32x2_t __attribute__((ext_vector_type(2))); typedef __bf16 bf16x2_t __attribute__((ext_vector_type(2)));
__device__ __forceinline__ unsigned cvtpk_s(float lo,float hi){f32x2_t v={lo,hi};bf16x2_t b=__builtin_convertvector(v,bf16x2_t);return __builtin_bit_cast(unsigned,b);}
#define WAIT_BAR(N) asm volatile("s_waitcnt vmcnt(" #N ") lgkmcnt(0)\n\ts_barrier":::"memory")

__device__ __forceinline__ void qkt(f32x16&p0,f32x16&p1,const char*Kslot,const bf16x8*qr,int r32,int hi){
  const char*kb=Kslot+hi*1024+r32*16;
  #pragma unroll
  for(int d0=0;d0<4;++d0){
    const bf16x8 b0=*reinterpret_cast<const bf16x8*>(kb+d0*2048);
    const bf16x8 b1=*reinterpret_cast<const bf16x8*>(kb+d0*2048+512);
    p0=__builtin_amdgcn_mfma_f32_32x32x16_bf16(b0,qr[d0],p0,0,0,0);p1=__builtin_amdgcn_mfma_f32_32x32x16_bf16(b1,qr[d0],p1,0,0,0);}
}
typedef __attribute__((address_space(3))) const char* lds_cptr;
typedef short v4i16_t __attribute__((ext_vector_type(4)));
__device__ __forceinline__ void kload8(bf16x8*kf,lds_cptr kp){
  kf[0]=*(const __attribute__((address_space(3))) bf16x8*)(kp);      kf[1]=*(const __attribute__((address_space(3))) bf16x8*)(kp+512);
  kf[2]=*(const __attribute__((address_space(3))) bf16x8*)(kp+2048); kf[3]=*(const __attribute__((address_space(3))) bf16x8*)(kp+2560);
  kf[4]=*(const __attribute__((address_space(3))) bf16x8*)(kp+4096); kf[5]=*(const __attribute__((address_space(3))) bf16x8*)(kp+4608);
  kf[6]=*(const __attribute__((address_space(3))) bf16x8*)(kp+6144); kf[7]=*(const __attribute__((address_space(3))) bf16x8*)(kp+6656);
}
__device__ __forceinline__ void kload2(bf16x8*kf,lds_cptr kp,int j){ kf[2*j]=*(const __attribute__((address_space(3))) bf16x8*)(kp+j*2048); kf[2*j+1]=*(const __attribute__((address_space(3))) bf16x8*)(kp+j*2048+512); }
__device__ __forceinline__ s16x4 vtr(lds_cptr p){ return __builtin_bit_cast(s16x4,__builtin_amdgcn_ds_read_tr16_b64_v4i16((__attribute__((address_space(3))) v4i16_t*)p)); }
__device__ __forceinline__ float rowmax(const f32x16&p0,const f32x16&p1){
  float a=max3f(p0[0],p0[1],p1[0]),b=max3f(p0[2],p0[3],p1[1]);a=max3f(a,p1[2],p1[3]);
  #pragma unroll
  for(int r=4;r<16;r+=4){a=max3f(a,p0[r],p0[r+1]);b=max3f(b,p0[r+2],p0[r+3]);a=max3f(a,p1[r],p1[r+1]);b=max3f(b,p1[r+2],p1[r+3]);}
  const float m=max2f(a,b);
  auto rr=__builtin_amdgcn_permlane32_swap(__float_as_uint(m),__float_as_uint(m),false,false);
  return max2f(__uint_as_float(rr[0]),__uint_as_float(rr[1]));
}
__device__ __forceinline__ void pv(f32x16*o,int vb,bf16x8 pa0,bf16x8 pa1,bf16x8 pa2,bf16x8 pa3){
  #pragma unroll
  for(int d0=0;d0<2;++d0){s16x4 lo[4],hi[4];
    #pragma unroll
    for(int ks=0;ks<4;++ks){
      asm volatile("ds_read_b64_tr_b16 %0,%1 offset:%c2":"=&v"(lo[ks]):"v"(vb),"i"(d0*4096+ks*1024):"memory");
      asm volatile("ds_read_b64_tr_b16 %0,%1 offset:%c2":"=&v"(hi[ks]):"v"(vb),"i"(d0*4096+ks*1024+512):"memory");}
    asm volatile("s_waitcnt lgkmcnt(0)":::"memory");SBAR();
    #define PK(k) (bf16x8){lo[k][0],lo[k][1],lo[k][2],lo[k][3],hi[k][0],hi[k][1],hi[k][2],hi[k][3]}
    o[d0]=__builtin_amdgcn_mfma_f32_32x32x16_bf16(pa0,PK(0),o[d0],0,0,0);
    o[d0]=__builtin_amdgcn_mfma_f32_32x32x16_bf16(pa1,PK(1),o[d0],0,0,0);
    o[d0]=__builtin_amdgcn_mfma_f32_32x32x16_bf16(pa2,PK(2),o[d0],0,0,0);
    o[d0]=__builtin_amdgcn_mfma_f32_32x32x16_bf16(pa3,PK(3),o[d0],0,0,0);
    #undef PK
  }
}

#ifndef ATTN_STORE16
#define ATTN_STORE16(p,v) (*(u32x4*)(p)=(v))
#endif
template<int THRL> __device__ __forceinline__ void attn_unit(int b,int h,int qb,const bf16*Q,const bf16*__restrict__ K,const bf16*__restrict__ V,bf16*O,const float*__restrict__ Fc,const float*__restrict__ NRM,char*shm,int wid_in){
  const int wid=__builtin_amdgcn_readfirstlane(wid_in); int lane_=(int)__builtin_amdgcn_mbcnt_hi(~0u,__builtin_amdgcn_mbcnt_lo(~0u,0u)); asm volatile("":"+v"(lane_));
  const int lane=lane_,tid=wid*64+lane,r32=lane&31,hi=lane>>5;
  const long rowbase=(long)b*SEQ; const int q0=qb*QB;
  const float*Fbh=Fc+(long)(b*NHEAD+h)*SEQ;
  const int NTF=(q0+QB)/KVBLK; int t_start;
  { const float*QNb=NRM+(b*NHEAD+h)*128,*KNb=NRM+4096+(b*NHEAD+h)*128;
    const float qn=fmaxf(fmaxf(QNb[4*qb],QNb[4*qb+1]),fmaxf(QNb[4*qb+2],QNb[4*qb+3])),knb=fmaxf(fmaxf(KNb[4*qb],KNb[4*qb+1]),fmaxf(KNb[4*qb+2],KNb[4*qb+3]));
    const float fq0=Fbh[q0]*1.4426950408889634f; bool k0=true,k1=true;
    if(lane<NTF-4)k0=!(qn*(KNb[lane]+knb)+(fq0-Fbh[64*lane+63]*1.4426950408889634f)<-40.f);
    if(lane+64<NTF-4)k1=!(qn*(KNb[lane+64]+knb)+(fq0-Fbh[64*(lane+64)+63]*1.4426950408889634f)<-40.f);
    const unsigned long long m0=__ballot(k0),m1=__ballot(k1);
    int tf=m0?(int)__builtin_ctzll(m0):64+(m1?(int)__builtin_ctzll(m1):64);
    tf=tf<NTF-4?tf:NTF-4; t_start=__builtin_amdgcn_readfirstlane(tf&~1); }
  { typedef float f32x4_t __attribute__((ext_vector_type(4))); __attribute__((address_space(3))) float*fk=(__attribute__((address_space(3))) float*)((__attribute__((address_space(3))) char*)shm+LDS_FK); const int n4=(q0+QB)/4;
    for(int i=16*t_start+tid;i<n4;i+=NW*64){ f32x4_t v=*(const f32x4_t*)(Fbh+4*i); v=v*(-1.4426950408889634f); *(__attribute__((address_space(3))) f32x4_t*)(fk+4*i)=v; } }
  float fq2=Fbh[q0+wid*QBLK+r32]*1.4426950408889634f; asm volatile("":"+v"(fq2));
  const bf16*Qw=Q+(rowbase+q0+wid*QBLK)*DM+h*D;
  const bf16*Kh=K+(rowbase+(long)t_start*KVBLK)*DM+h*D,*Vh=V+(rowbase+(long)t_start*KVBLK)*DM+h*D;
  const lds_cptr shm3=(lds_cptr)shm;
  const unsigned lds0=(unsigned)(uintptr_t)shm;
  float*wsf=(float*)(shm+LDS_WS)+wid*64;
  const bf16*ksrc=Kh+(long)lane*DM+wid*8;
  const bf16*vsrc=Vh+(long)(16*(wid&3)+(lane>>2))*DM+(wid>>2)*32+(lane&3)*8;
  const unsigned kdst=lds0+LDS_K+wid*1024, vdst=lds0+LDS_V+wid*1024;
  #define DMA_K(t,slot) glds16(ksrc+(long)(t)*KVBLK*DM,(unsigned)__builtin_amdgcn_readfirstlane(kdst+(slot)))
  #define DMA_V(t,slot) glds16(vsrc+(long)(t)*KVBLK*DM,(unsigned)__builtin_amdgcn_readfirstlane(vdst+(slot)))
  const int vb0=(int)(lds0+LDS_V)+((lane>>4)&1)*32+(lane&3)*8+(4*hi+((lane&15)>>2))*64;
  const char*Kbase=shm+LDS_K; bf16x8 kf[8];
  const lds_cptr kp0=shm3+LDS_K+hi*1024+r32*16; const lds_cptr vp0=shm3+LDS_V+((lane>>4)&1)*32+(lane&3)*8+(4*hi+((lane&15)>>2))*64;
  const int NT=NTF-t_start;
  DMA_K(0,0);DMA_V(0,0);DMA_K(1,SLOTB);
  bf16x8 qr[4];
  #pragma unroll
  for(int d0=0;d0<4;++d0)qr[d0]=*reinterpret_cast<const bf16x8*>(&Qw[(long)r32*DM+d0*16+hi*8]);
  float mhat=0.f,l_reg=0.f;f32x16 o[2];o[0]=f32x16{};o[1]=f32x16{};
  const __attribute__((address_space(3))) float*fkl=(const __attribute__((address_space(3))) float*)(shm3+LDS_FK)+64*t_start+4*hi;
  #define INITC(C0,C1,t) do{ const float nsc_=fq2-mhat; typedef float f32x4_t __attribute__((ext_vector_type(4))); const __attribute__((address_space(3))) float*kb_=fkl+64*(t); \
    _Pragma("unroll") for(int g_=0;g_<4;++g_){ const f32x4_t a_=*(const __attribute__((address_space(3))) f32x4_t*)(kb_+8*g_), b_=*(const __attribute__((address_space(3))) f32x4_t*)(kb_+32+8*g_); \
      _Pragma("unroll") for(int e_=0;e_<4;++e_){ C0[4*g_+e_]=nsc_+a_[e_]; C1[4*g_+e_]=nsc_+b_[e_]; } } }while(0)
  const int qrel=wid*QBLK+r32;
  #define CMASK(P0,P1,t) do{int jb_=(t)-(NT-4); if(jb_>=0)cmask(P0,P1,jb_,qrel,hi);}while(0)
  bool resc=false;
  #define START(P0,P1) do{ const float rm=rowmax(P0,P1); resc=false; \
    { const float dl=rm; mhat=fadd_s(mhat,dl); \
      _Pragma("unroll") for(int r=0;r<16;++r){P0[r]=fsub_s(P0[r],dl);P1[r]=fsub_s(P1[r],dl);} \
      } \
    _Pragma("unroll") for(int r=0;r<16;++r)P0[r]=__builtin_amdgcn_exp2f(P0[r]); }while(0)
  #define RESC() do{ if(resc){ asm volatile("s_waitcnt lgkmcnt(0)":::"memory"); \
      _Pragma("unroll") for(int d_=0;d_<2;++d_) _Pragma("unroll") for(int r=0;r<16;++r)o[d_][r]*=wsf[crow(r,hi)]; } }while(0)
  f32x16 pA0,pA1,pB0,pB1;
  int sl_prev=0,sl_cur=0,sl_next=SLOTB;
  #define ROT() do{sl_prev=sl_cur;sl_cur=sl_next;sl_next=(sl_next==(NSLOT-1)*SLOTB)?0:sl_next+SLOTB;}while(0)
  DMA_K(2,2*SLOTB);
  WAIT_BAR(3);
  INITC(pA0,pA1,0); qkt(pA0,pA1,Kbase,qr,r32,hi);asm volatile("s_nop 15\n\ts_nop 7":"+v"(pA0),"+v"(pA1));CMASK(pA0,pA1,0);
  START(pA0,pA1);
  _Pragma("unroll") for(int r=0;r<16;++r)pA1[r]=__builtin_amdgcn_exp2f(pA1[r]);
  WAIT_BAR(0);
  DMA_K(3,0);DMA_V(1,SLOTB);
  ROT();
  kload8(kf,kp0+sl_cur);
  WAIT_BAR(2);
  s16x4 vlo[8],vhi[8]; u32x4 pw0,pw1,pw2,pw3;
  #define PKW(P,B) cvtpk_s(P[B],P[B+1])
  #define PAF(k) __builtin_bit_cast(bf16x8,pw##k)
  #define VFR(i) (bf16x8){vlo[i][0],vlo[i][1],vlo[i][2],vlo[i][3],vhi[i][0],vhi[i][1],vhi[i][2],vhi[i][3]}
  #define PIN(x) asm volatile("":"+v"(x))
  #define MX3(a,b,c) __builtin_fmaxf(__builtin_fmaxf((a),(b)),(c))
  #define GAPA(MF,A0,A1,A2,A3,W0,W1,PW) do{ MF; sacc+=A0; sacc+=A1; sacc+=A2; sacc+=A3; PIN(sacc); W0; W1; PIN(PW); SBAR(); }while(0)
  #define EX(v) __builtin_amdgcn_exp2f(v)
  #define GAPB(MF,X,B) do{ MF; X[B]=EX(X[B]); X[B+1]=EX(X[B+1]); X[B+2]=EX(X[B+2]); X[B+3]=EX(X[B+3]); PIN(X); SBAR(); }while(0)
  #define VRD(i) do{ vlo[i]=vtr(vp_+(((i)>>2)*4096+((i)&3)*1024)); vhi[i]=vtr(vp_+(((i)>>2)*4096+((i)&3)*1024+512)); }while(0)
  #define KRD(G,j) do{ if(G){ kload2(kf,kp0+sl_next,j); SBAR(); } }while(0)
  #define STEP(C0,C1,P0,P1,t,GK,GV,GL) do{ SBAR(); INITC(C0,C1,t); PIN(C0); PIN(C1); SBAR(); \
    const lds_cptr vp_=vp0+sl_prev; \
    VRD(0); SBAR(); float sacc=(P0[0]+P0[1]); \
    GAPA(C0=__builtin_amdgcn_mfma_f32_32x32x16_bf16(kf[0],qr[0],C0,0,0,0), P0[2],P0[3],P0[4],P0[5],     pw0[0]=PKW(P0,0), pw0[1]=PKW(P0,2), pw0); \
    VRD(4); SBAR(); GAPA(C1=__builtin_amdgcn_mfma_f32_32x32x16_bf16(kf[1],qr[0],C1,0,0,0), P0[6],P0[7],P0[8],P0[9],     pw0[2]=PKW(P0,4), pw0[3]=PKW(P0,6), pw0); \
    VRD(1); SBAR(); GAPA(C0=__builtin_amdgcn_mfma_f32_32x32x16_bf16(kf[2],qr[1],C0,0,0,0),   P0[10],P0[11],P0[12],P0[13], pw1[0]=PKW(P0,8), pw1[1]=PKW(P0,10), pw1); \
    VRD(5); SBAR(); GAPA(C1=__builtin_amdgcn_mfma_f32_32x32x16_bf16(kf[3],qr[1],C1,0,0,0),   P0[14],P0[15],P1[0],P1[1],   pw1[2]=PKW(P0,12),pw1[3]=PKW(P0,14), pw1); \
    VRD(2); SBAR(); GAPA(C0=__builtin_amdgcn_mfma_f32_32x32x16_bf16(kf[4],qr[2],C0,0,0,0),   P1[2],P1[3],P1[4],P1[5],     pw2[0]=PKW(P1,0), pw2[1]=PKW(P1,2), pw2); \
    VRD(6); SBAR(); GAPA(C1=__builtin_amdgcn_mfma_f32_32x32x16_bf16(kf[5],qr[2],C1,0,0,0),   P1[6],P1[7],P1[8],P1[9],     pw2[2]=PKW(P1,4), pw2[3]=PKW(P1,6), pw2); \
    VRD(3); SBAR(); GAPA(C0=__builtin_amdgcn_mfma_f32_32x32x16_bf16(kf[6],qr[3],C0,0,0,0),   P1[10],P1[11],P1[12],P1[13], pw3[0]=PKW(P1,8), pw3[1]=PKW(P1,10), pw3); \
    VRD(7); SBAR(); GAPA(C1=__builtin_amdgcn_mfma_f32_32x32x16_bf16(kf[7],qr[3],C1,0,0,0),   P1[14],P1[15],0.f,0.f,       pw3[2]=PKW(P1,12),pw3[3]=PKW(P1,14), pw3); \
    l_reg+=sacc; \
    if(GK){DMA_K((t)+3,sl_cur);} if(GV){DMA_V((t)+1,sl_next);} \
    CMASK(C0,C1,t); \
    { float a=MX3(C0[0],C0[1],C1[0]),b=MX3(C0[2],C0[3],C1[1]); a=MX3(a,C1[2],C1[3]); \
      _Pragma("unroll") for(int r=4;r<16;r+=4){a=MX3(a,C0[r],C0[r+1]);b=MX3(b,C0[r+2],C0[r+3]);a=MX3(a,C1[r],C1[r+1]);b=MX3(b,C1[r+2],C1[r+3]);} \
      float rm=__builtin_fmaxf(a,b); { auto rr=__builtin_amdgcn_permlane32_swap(__float_as_uint(rm),__float_as_uint(rm),false,false); rm=__builtin_fmaxf(__uint_as_float(rr[0]),__uint_as_float(rr[1])); } \
      resc=false; \
      if(__builtin_expect(__any(rm>(float)THRL),0)){ const float dl=__builtin_fmaxf(rm,0.f); mhat+=dl; \
        _Pragma("unroll") for(int r=0;r<16;++r){C0[r]-=dl;C1[r]-=dl;} \
        const float f=__builtin_amdgcn_exp2f(-dl); l_reg*=f; if(hi==0)wsf[r32]=f; resc=true; } } \
    SBAR(); \
    GAPB(o[0]=__builtin_amdgcn_mfma_f32_32x32x16_bf16(PAF(0),VFR(0),o[0],0,0,0), C0,0); \
    GAPB(o[1]=__builtin_amdgcn_mfma_f32_32x32x16_bf16(PAF(0),VFR(4),o[1],0,0,0), C0,4); \
    KRD(GL,0); GAPB(o[0]=__builtin_amdgcn_mfma_f32_32x32x16_bf16(PAF(1),VFR(1),o[0],0,0,0), C0,8); \
    KRD(GL,1); GAPB(o[1]=__builtin_amdgcn_mfma_f32_32x32x16_bf16(PAF(1),VFR(5),o[1],0,0,0), C0,12); \
    KRD(GL,2); GAPB(o[0]=__builtin_amdgcn_mfma_f32_32x32x16_bf16(PAF(2),VFR(2),o[0],0,0,0), C1,0); \
    KRD(GL,3); GAPB(o[1]=__builtin_amdgcn_mfma_f32_32x32x16_bf16(PAF(2),VFR(6),o[1],0,0,0), C1,4); \
    GAPB(o[0]=__builtin_amdgcn_mfma_f32_32x32x16_bf16(PAF(3),VFR(3),o[0],0,0,0), C1,8); \
    GAPB(o[1]=__builtin_amdgcn_mfma_f32_32x32x16_bf16(PAF(3),VFR(7),o[1],0,0,0), C1,12); \
    }while(0)
  int t=1;
  #undef CMASK
  #define CMASK(P0,P1,t) do{}while(0)
  for(;t+5<NT;t+=2){
    STEP(pB0,pB1,pA0,pA1,t,true,true,true);     WAIT_BAR(2); RESC(); ROT();
    STEP(pA0,pA1,pB0,pB1,t+1,true,true,true);   WAIT_BAR(2); RESC(); ROT();
  }
  #undef CMASK
  #define CMASK(P0,P1,t) do{int jb_=(t)-(NT-4); if(jb_>=0)cmask(P0,P1,jb_,qrel,hi);}while(0)
  #define ENDW(tt) do{ if((tt)+3<NT){WAIT_BAR(2);} else if((tt)+2<NT){WAIT_BAR(1);} else {WAIT_BAR(0);} }while(0)
  for(;t+1<NT;t+=2){
    STEP(pB0,pB1,pA0,pA1,t,(t+3<NT),(t+1<NT),(t+1<NT));       ENDW(t);   RESC(); ROT();
    STEP(pA0,pA1,pB0,pB1,t+1,(t+4<NT),(t+2<NT),(t+2<NT));     ENDW(t+1); RESC(); ROT();
  }
  STEP(pB0,pB1,pA0,pA1,NT-1,false,false,false); RESC();
  { float sacc=pB0[0]+pB0[1]; _Pragma("unroll") for(int r=2;r<16;++r)sacc+=pB0[r]; _Pragma("unroll") for(int r=0;r<16;++r)sacc+=pB1[r]; l_reg+=sacc;
    pw0=(u32x4){PKW(pB0,0),PKW(pB0,2),PKW(pB0,4),PKW(pB0,6)};pw1=(u32x4){PKW(pB0,8),PKW(pB0,10),PKW(pB0,12),PKW(pB0,14)};pw2=(u32x4){PKW(pB1,0),PKW(pB1,2),PKW(pB1,4),PKW(pB1,6)};pw3=(u32x4){PKW(pB1,8),PKW(pB1,10),PKW(pB1,12),PKW(pB1,14)};
    SBAR(); pv(o,vb0+sl_cur,PAF(0),PAF(1),PAF(2),PAF(3)); }
  #undef PKW
  #undef PAF
  #undef VFR
  #undef PIN
  #undef MX3
  #undef GAPA
  #undef GAPB
  #undef EX
  #undef VRD
  #undef KRD
  #undef STEP
  #undef ENDW
  {auto rr=__builtin_amdgcn_permlane32_swap(__float_as_uint(l_reg),__float_as_uint(l_reg),false,false);l_reg=__uint_as_float(rr[0])+__uint_as_float(rr[1]);}
  if(hi==0)wsf[32+r32]=l_reg;asm volatile("s_waitcnt lgkmcnt(0)":::"memory");
  float rli[16];
  #pragma unroll
  for(int r=0;r<16;++r)rli[r]=__builtin_amdgcn_rcpf(wsf[32+crow(r,hi)]);
  bf16*Ow=O+(rowbase+q0+wid*QBLK)*DM+h*D;
  { bf16*stg=(bf16*)(shm+LDS_OST)+wid*2048;
    #pragma unroll
    for(int r=0;r<16;++r){const int orow=crow(r,hi);
      #pragma unroll
      for(int d0=0;d0<2;++d0)stg[orow*64+d0*32+r32]=__float2bfloat16(o[d0][r]*rli[r]);}
    asm volatile("s_waitcnt lgkmcnt(0)":::"memory");
    #pragma unroll
    for(int i=0;i<4;++i){const int row=i*8+(lane>>3),ch=lane&7; const u32x4 v=*(const u32x4*)(stg+row*64+ch*8); ATTN_STORE16(Ow+(long)row*DM+ch*8,v);} }
  asm volatile("s_waitcnt lgkmcnt(0)\n\ts_barrier":::"memory");
  #undef DMA_K
  #undef DMA_V
  #undef INITC
  #undef CMASK
  #undef START
  #undef RESC
  #undef ROT
}
constexpr int ATTN_LDS_BYTES=LDS_BYTES;
struct AttnTensors { const bf16* Q; const bf16* K; const bf16* V; bf16* O; const float* F; const float* NRM; };
struct AttnUnit { int bh; int qb; };
struct StaticOrder {
  int vcu;
  __device__ __forceinline__ explicit StaticOrder(int grid,int block):vcu((block%8)*(grid/8)+block/8){}
  __device__ __forceinline__ bool next(int i,AttnUnit&u)const{ if(i>=4)return false; const int s=vcu&7; u.bh=vcu>>3; u.qb=(i==0)?s:(i==1)?15-s:(i==2)?16+s:31-s; return true; }
  __device__ __forceinline__ void a_ready(const AttnUnit&)const{}
  __device__ __forceinline__ void done(const AttnUnit&)const{}
};
template<int THRL=8> __device__ __forceinline__ void attn_phase(char*lds,const AttnTensors&T,unsigned*qctr,volatile __attribute__((address_space(3))) unsigned*qword,int wid_in){
  const int lane0=(int)__builtin_amdgcn_mbcnt_hi(~0u,__builtin_amdgcn_mbcnt_lo(~0u,0u));
  for(;;){
    if(wid_in==0&&lane0==0){ const unsigned n=__hip_atomic_fetch_add(qctr,1u,__ATOMIC_RELAXED,__HIP_MEMORY_SCOPE_AGENT); *qword=n; }
    asm volatile("s_waitcnt vmcnt(0) lgkmcnt(0)\n\ts_barrier":::"memory");
    const int n=__builtin_amdgcn_readfirstlane((int)*qword);
    if(n>=BATCH*NHEAD*NQB)break;
    const int bh=n%(BATCH*NHEAD),qb=NQB-1-n/(BATCH*NHEAD);
    attn_unit<THRL>(bh/NHEAD,bh%NHEAD,qb,T.Q,T.K,T.V,T.O,T.F,T.NRM,lds,wid_in);
  }
}
#undef SBAR
#undef WAIT_BAR
}
#define GAS __attribute__((address_space(1)))
#define LAS __attribute__((address_space(3)))
typedef unsigned short bf16;
typedef unsigned v4u __attribute__((ext_vector_type(4)));
typedef float f32x4 __attribute__((ext_vector_type(4)));
typedef short bf16x8 __attribute__((ext_vector_type(8)));
typedef GAS unsigned gu32;
typedef GAS unsigned long long gu64;
#define RLX_AGENT __ATOMIC_RELAXED, __HIP_MEMORY_SCOPE_AGENT
#define LDS_WAIT() asm volatile("s_waitcnt lgkmcnt(0)" ::: "memory")
#define VM_WAIT() asm volatile("s_waitcnt vmcnt(0)" ::: "memory")
__device__ __forceinline__ unsigned long long rt() { return __builtin_amdgcn_s_memrealtime(); }
__device__ __forceinline__ unsigned f2bf(float f) { unsigned u = __builtin_bit_cast(unsigned, f); return (u + 0x7fffu + ((u >> 16) & 1u)) >> 16; }
__device__ __forceinline__ unsigned pk2(float lo, float hi) { return f2bf(lo) | (f2bf(hi) << 16); }

#define XB_TMO      128
#define XB_XCNT(j)  (256  + 64 * (j))
#define XB_XSUB(j)  (1280 + 64 * (j))
#define XB_XGEN(j)  (2304 + 64 * (j))
#define XB_TOP      3328
#define XB_TOPGEN   3392
#define XCD_BAR_WORDS 3456
#define XB_SPIN_CAP (1u << 18)

__device__ __forceinline__ unsigned xb_ld(unsigned* p)              { return __hip_atomic_load(p, __ATOMIC_RELAXED, __HIP_MEMORY_SCOPE_AGENT); }
__device__ __forceinline__ unsigned xb_add(unsigned* p, unsigned v) { return __hip_atomic_fetch_add(p, v, __ATOMIC_RELAXED, __HIP_MEMORY_SCOPE_AGENT); }
__device__ __forceinline__ unsigned xb_xcc_id() { return (unsigned)__builtin_amdgcn_s_getreg((3 << 11) | 20) & 0xFu; }
#define XB_SPIN(cond, bar) do { unsigned _sp = 0; while (cond) { __builtin_amdgcn_s_sleep(1); \
    if ((++_sp & 255u) == 0u) { if (xb_ld(&(bar)[XB_TMO])) break; if (_sp > XB_SPIN_CAP) { atomicAdd(&(bar)[XB_TMO], 1u); break; } } } } while (0)

struct XcdBarrier {
    unsigned* bar; unsigned x; int wv;
    volatile LAS unsigned* st;
};

__device__ __forceinline__ bool xb_t0(int wv) { return wv == 0 && __builtin_amdgcn_mbcnt_hi(~0u, __builtin_amdgcn_mbcnt_lo(~0u, 0u)) == 0u; }
__device__ __forceinline__ XcdBarrier xcd_barrier_post(unsigned* bar, volatile LAS unsigned* st, int wv) {
    XcdBarrier b; b.bar = bar; b.x = xb_xcc_id(); b.st = st; b.wv = wv;
    if (xb_t0(wv)) (void)xb_add(&bar[XB_XCNT(b.x)], 1u);
    return b;
}
__device__ __forceinline__ void xcd_barrier_complete(unsigned* bar, unsigned x, unsigned& nloc, unsigned& nx) {
    const unsigned G = gridDim.x * gridDim.y * gridDim.z;
    unsigned sum, cnt, mine, sp = 0u;
    for (;;) {
        sum = 0u; cnt = 0u; mine = 0u;
#pragma unroll
        for (unsigned j = 0; j < 16; ++j) { const unsigned c = xb_ld(&bar[XB_XCNT(j)]); sum += c; cnt += (c > 0u) ? 1u : 0u; mine = (j == x) ? c : mine; }
        if (sum == G) break;
        __builtin_amdgcn_s_sleep(1);
        if ((++sp & 255u) == 0u) { if (xb_ld(&bar[XB_TMO])) break; if (sp > XB_SPIN_CAP) { atomicAdd(&bar[XB_TMO], 1u); break; } }
    }
    nloc = mine > 0u ? mine : 1u; nx = cnt > 0u ? cnt : 1u;
}

__device__ __forceinline__ void xcd_barrier(const XcdBarrier& b) {
    asm volatile("s_waitcnt vmcnt(0)" ::: "memory");
    __syncthreads();
    if (xb_t0(b.wv)) {
        unsigned* bar = b.bar;
        __builtin_amdgcn_s_waitcnt(0);
        unsigned nloc = b.st[0], nx = b.st[1];
        if (nloc == 0u) { xcd_barrier_complete(bar, b.x, nloc, nx); b.st[0] = nloc; b.st[1] = nx; }
        const unsigned old = xb_add(&bar[XB_XSUB(b.x)], 1u);
        const unsigned gen = old / nloc;
        if (old + 1u == (gen + 1u) * nloc) {
            __builtin_amdgcn_fence(__ATOMIC_RELEASE, "agent");
            asm volatile("s_waitcnt vmcnt(0)" ::: "memory");
            const unsigned og = xb_add(&bar[XB_TOP], 1u);
            const unsigned tg = og / nx;
            if (og + 1u == (tg + 1u) * nx) xb_add(&bar[XB_TOPGEN], 1u);
            else XB_SPIN(xb_ld(&bar[XB_TOPGEN]) == tg, bar);
            __builtin_amdgcn_fence(__ATOMIC_ACQUIRE, "agent");
            xb_add(&bar[XB_XGEN(b.x)], 1u);
            asm volatile("s_waitcnt vmcnt(0)" ::: "memory");
        } else {
            XB_SPIN(xb_ld(&bar[XB_XGEN(b.x)]) == gen, bar);
            __builtin_amdgcn_fence(__ATOMIC_ACQUIRE, "agent");
            asm volatile("s_waitcnt vmcnt(0)" ::: "memory");
        }
    }
    __syncthreads();
}

constexpr int NWAVES = 8;
constexpr int RING_OFF = 0, RING_BYTES = 131072;
constexpr int LDSCTL_OFF = RING_BYTES, MISC_OFF = LDSCTL_OFF + 320;
constexpr int LDS_BYTES = 147456;
constexpr int N_PHASES = 8;

struct Frame {
    LAS unsigned char* lds;
    volatile LAS unsigned* MISC;
    gu32* ctl;
    int tid, lane, wave, vcu, G;
};
__device__ __forceinline__ float wave_sum(float v) {
#pragma unroll
    for (int o = 1; o < 64; o <<= 1) v += __shfl_xor(v, o);
    return v;
}
struct Args { const float* in[20]; float* out; unsigned char* ws; int ph_lo, ph_hi, li, pad; };

__device__ __forceinline__ void p0_transpose_item(const float* W, int ld, int nblk, const float* glo, const float* ghi, int K, bf16* WT, LAS float* scr, int item, int lane) {
    const int kb = item / nblk, nb = item % nblk, k0 = 64 * kb, n0 = 32 * nb;
#pragma unroll 8
    for (int i = 0; i < 32; ++i) { const int kk = 2 * i + (lane >> 5), k = k0 + kk; float w = W[(size_t)k * ld + n0 + (lane & 31)];
        if (glo) w *= (k < K / 2) ? glo[k] : ghi[k - K / 2];
        scr[kk * 33 + (lane & 31)] = w; }
    LDS_WAIT(); asm volatile("" ::: "memory");
    const int c = lane & 7;
#pragma unroll
    for (int j = 0; j < 4; ++j) { const int n = (lane >> 3) + 8 * j; const LAS float* s = scr + (8 * c) * 33 + n;
        v4u o; o.x = pk2(s[0 * 33], s[1 * 33]); o.y = pk2(s[2 * 33], s[3 * 33]); o.z = pk2(s[4 * 33], s[5 * 33]); o.w = pk2(s[6 * 33], s[7 * 33]);
        *(GAS v4u*)(WT + (size_t)(n0 + n) * K + k0 + 8 * c) = o; }
    LDS_WAIT(); asm volatile("" ::: "memory");
}
__device__ __forceinline__ float log_sigmoid(float z) { return fminf(z, 0.f) - log1pf(expf(-fabsf(z))); }

__device__ __forceinline__ void p0_prologue(Frame& F, const Args& a) {
    LAS float* scr = (LAS float*)(F.lds + RING_OFF + F.wave * 16384);
    unsigned char* ws = a.ws;
    const float* x = a.in[0]; const float* g1 = a.in[1]; const float* w_in = a.in[2]; const float* bfv = a.in[10];
    const float* gn_l = a.in[11]; const float* gn_f = a.in[12]; const float* w_out = a.in[13]; const float* g2 = a.in[14];
    const float* w_q = a.in[15]; const float* sk = a.in[16]; const float* pu = a.in[17]; const float* pv = a.in[18];
    bf16* win_t = (bf16*)(ws + WS_WIN); bf16* wout_t = (bf16*)(ws + WS_WOUT); bf16* wq_t = (bf16*)(ws + WS_WQ); bf16* skb = (bf16*)(ws + WS_SKB); float* wfl = (float*)(ws + WS_WFL);
    float* logf = (float*)(ws + WS_LOGF); float* sumsq = (float*)(ws + WS_SUMSQ); bf16* h = (bf16*)(ws + WS_H);
    const int gw = F.vcu * NWAVES + F.wave, NGW = F.G * NWAVES, lane = F.lane;
    constexpr int I_IN = (DMODEL / 64) * (NG1 / 32), I_OUT = (DMODEL / 64) * (DMODEL / 32), I_Q = (DMODEL / 64) * (QPW / 32);
    constexpr int I_FL = 8 * DMODEL / 64, I_SK = PH * 2 * NKEY * PHALF / 512, I_SS = T / 64, I_WAX = 8 * 2 * 2 * 4;
    constexpr int E0 = I_IN, E1 = E0 + I_OUT, E2 = E1 + I_Q, E3 = E2 + I_FL, E4 = E3 + I_SK, E5 = E4 + I_SS, E6 = E5 + I_WAX;
    for (int it = gw; it < E6; it += NGW) {
        if (it < E0) { p0_transpose_item(w_in, INC, NG1 / 32, nullptr, nullptr, DMODEL, win_t, scr, it, lane); continue; }
        if (it < E1) { p0_transpose_item(w_out, DMODEL, DMODEL / 32, gn_l, gn_f, DMODEL, wout_t, scr, it - E0, lane); continue; }
        if (it < E2) { p0_transpose_item(w_q, QPW, QPW / 32, g2, g2 + DMODEL / 2, DMODEL, wq_t, scr, it - E1, lane); continue; }
        if (it < E3) { const int i = (it - E2) * 64 + lane, j = i / DMODEL, k = i % DMODEL; wfl[i] = w_in[(size_t)k * INC + NG1 + j]; continue; }
        if (it < E4) { const size_t i = (size_t)(it - E3) * 512 + lane * 8; const f32x4 s0 = *(const GAS f32x4*)(sk + i), s1 = *(const GAS f32x4*)(sk + i + 4);
            v4u o; o.x = pk2(s0[0], s0[1]); o.y = pk2(s0[2], s0[3]); o.z = pk2(s1[0], s1[1]); o.w = pk2(s1[2], s1[3]); *(GAS v4u*)(skb + i) = o; continue; }
        if (it < E5) { sumsq[(it - E4) * 64 + lane] = 0.f; continue; }
        { const int f = it - E5, ks = f & 3, n = (f >> 2) & 1, mat = (f >> 3) & 1, hh = f >> 4; const float* wsrc = mat ? a.in[7] : a.in[5];
          const size_t o = ((size_t)(hh * 64 + 16 * ks + 8 * (lane >> 5))) * 64 + 32 * n + (lane & 31);
          v4u pw; pw.x = pk2(wsrc[o], wsrc[o + 64]); pw.y = pk2(wsrc[o + 128], wsrc[o + 192]); pw.z = pk2(wsrc[o + 256], wsrc[o + 320]); pw.w = pk2(wsrc[o + 384], wsrc[o + 448]);
          *(GAS v4u*)((bf16*)(ws + WS_WAX) + (size_t)f * 512 + lane * 8) = pw; }
    }
    { f32x4 gg[4];
#pragma unroll
      for (int j = 0; j < 4; ++j) gg[j] = *(const GAS f32x4*)(g2 + 16 * lane + 4 * j);
      unsigned char* u4 = ws + WS_U8; unsigned char* v4 = ws + WS_V8; float* su = (float*)(ws + WS_SU);
      for (int e = gw; e < NEXP; e += NGW) {
        const GAS f32x4* ur = (const GAS f32x4*)(pu + (size_t)e * DMODEL + 16 * lane); const GAS f32x4* vr = (const GAS f32x4*)(pv + (size_t)e * DMODEL + 16 * lane);
        f32x4 uu[4], vv[4]; float mu = 0.f, mv = 0.f;
#pragma unroll
        for (int j = 0; j < 4; ++j) { uu[j] = ur[j] * gg[j]; vv[j] = vr[j];
#pragma unroll
            for (int c = 0; c < 4; ++c) { mu = fmaxf(mu, fabsf(uu[j][c])); mv = fmaxf(mv, fabsf(vv[j][c])); } }
#pragma unroll
        for (int o = 1; o < 64; o <<= 1) { mu = fmaxf(mu, __shfl_xor(mu, o)); mv = fmaxf(mv, __shfl_xor(mv, o)); }
        const float scu = mu > 0.f ? mu * (1.f / 6.f) : 1.f, scv = mv > 0.f ? mv * (1.f / 6.f) : 1.f, iu = 1.f / scu, iv = 1.f / scv;
        unsigned qu0 = 0u, qu1 = 0u, qv0 = 0u, qv1 = 0u;
#define P0_Q4(Q, X, INV, B0, B1) do { Q = __builtin_amdgcn_cvt_scalef32_pk_fp4_f32(Q, X[0] * INV, X[1] * INV, 1.0f, B0); Q = __builtin_amdgcn_cvt_scalef32_pk_fp4_f32(Q, X[2] * INV, X[3] * INV, 1.0f, B1); } while (0)
        P0_Q4(qu0, uu[0], iu, 0, 1); P0_Q4(qu0, uu[1], iu, 2, 3); P0_Q4(qu1, uu[2], iu, 0, 1); P0_Q4(qu1, uu[3], iu, 2, 3);
        P0_Q4(qv0, vv[0], iv, 0, 1); P0_Q4(qv0, vv[1], iv, 2, 3); P0_Q4(qv1, vv[2], iv, 0, 1); P0_Q4(qv1, vv[3], iv, 2, 3);
#undef P0_Q4
        *(GAS unsigned long long*)(u4 + (size_t)e * 512 + 8 * lane) = (unsigned long long)qu0 | ((unsigned long long)qu1 << 32);
        *(GAS unsigned long long*)(v4 + (size_t)e * 512 + 8 * lane) = (unsigned long long)qv0 | ((unsigned long long)qv1 << 32);
        if (lane == 0) { su[2 * e] = scu; su[2 * e + 1] = scv; }
      } }
    { f32x4 gg[4];
#pragma unroll
      for (int j = 0; j < 4; ++j) gg[j] = *(const GAS f32x4*)(g1 + 256 * j + 4 * lane);
      float fw[4][4][8];
#pragma unroll
      for (int j = 0; j < 4; ++j)
#pragma unroll
          for (int c = 0; c < 4; ++c) { const int k = 256 * j + 4 * lane + c; const GAS f32x4* wr = (const GAS f32x4*)(w_in + (size_t)k * INC + NG1); const f32x4 w0 = wr[0], w1 = wr[1];
#pragma unroll
              for (int e = 0; e < 4; ++e) { fw[j][c][e] = w0[e]; fw[j][c][4 + e] = w1[e]; } }
      for (int t0 = gw; t0 < T; t0 += 2 * NGW) {
        const int t1 = (t0 + NGW < T) ? t0 + NGW : t0;
        const GAS f32x4* xr0 = (const GAS f32x4*)(x + (size_t)t0 * DMODEL) + lane; const GAS f32x4* xr1 = (const GAS f32x4*)(x + (size_t)t1 * DMODEL) + lane;
        f32x4 va[4], vb[4]; float sa = 0.f, sb = 0.f;
#pragma unroll
        for (int j = 0; j < 4; ++j) { va[j] = xr0[64 * j]; vb[j] = xr1[64 * j]; }
#pragma unroll
        for (int j = 0; j < 4; ++j) { sa += (va[j][0] * va[j][0] + va[j][1] * va[j][1]) + (va[j][2] * va[j][2] + va[j][3] * va[j][3]); sb += (vb[j][0] * vb[j][0] + vb[j][1] * vb[j][1]) + (vb[j][2] * vb[j][2] + vb[j][3] * vb[j][3]); }
        const float ra = rsqrtf(wave_sum(sa) * (1.f / DMODEL) + RMS_EPS), rb = rsqrtf(wave_sum(sb) * (1.f / DMODEL) + RMS_EPS);
        GAS unsigned long long* ha = (GAS unsigned long long*)(h + (size_t)t0 * DMODEL) + lane; GAS unsigned long long* hb = (GAS unsigned long long*)(h + (size_t)t1 * DMODEL) + lane;
#pragma unroll
        for (int j = 0; j < 4; ++j) { va[j] = va[j] * ra * gg[j]; vb[j] = vb[j] * rb * gg[j];
            ha[64 * j] = (unsigned long long)pk2(va[j][0], va[j][1]) | ((unsigned long long)pk2(va[j][2], va[j][3]) << 32);
            hb[64 * j] = (unsigned long long)pk2(vb[j][0], vb[j][1]) | ((unsigned long long)pk2(vb[j][2], vb[j][3]) << 32); }
        float fa[8], fb[8];
#pragma unroll
        for (int hh = 0; hh < 8; ++hh) { fa[hh] = 0.f; fb[hh] = 0.f; }
#pragma unroll
        for (int j = 0; j < 4; ++j)
#pragma unroll
            for (int c = 0; c < 4; ++c) {
#pragma unroll
                for (int hh = 0; hh < 8; ++hh) { fa[hh] += va[j][c] * fw[j][c][hh]; fb[hh] += vb[j][c] * fw[j][c][hh]; } }
        float resa = 0.f, resb = 0.f;
#pragma unroll
        for (int hh = 0; hh < 8; ++hh) { const float s0 = wave_sum(fa[hh]), s1 = wave_sum(fb[hh]); if (lane == hh) { resa = s0; resb = s1; } }
        if (lane < 8) { logf[(size_t)t0 * 8 + lane] = log_sigmoid(resa + bfv[lane]); logf[(size_t)t1 * 8 + lane] = log_sigmoid(resb + bfv[lane]); }
      } }
}

__device__ __forceinline__ void fcum_unit(Frame& F, int bh, const float* logf, float* fcum) {
    const int b = bh / NHEADS, hh = bh % NHEADS, s0 = F.tid * 16;
    float v[16]; float loc = 0.f;
#pragma unroll
    for (int i = 0; i < 16; ++i) { v[i] = logf[((size_t)b * SEQ + s0 + i) * 8 + hh]; loc += v[i]; }
    float inc = loc;
#pragma unroll
    for (int o = 1; o < 64; o <<= 1) { const float n = __shfl_up(inc, o); if (F.lane >= o) inc += n; }
    if (F.lane == 63) F.MISC[16 + F.wave] = __float_as_uint(inc);
    __syncthreads();
    float run = inc - loc;
    for (int w = 0; w < F.wave; ++w) run += __uint_as_float(F.MISC[16 + w]);
#pragma unroll
    for (int i = 0; i < 16; ++i) { run += v[i]; fcum[(size_t)bh * SEQ + s0 + i] = run; }
    __syncthreads();
}


#ifndef MK_REP_MASK
#define MK_REP_MASK 0
#endif
#define REPS(k) (((MK_REP_MASK >> (k)) & 1) ? 2 : 1)
namespace peer {
typedef unsigned u32;
typedef float f32x16 __attribute__((ext_vector_type(16)));
constexpr int TOK = 128;
constexpr int EX_STRIDE = 136, GT_STRIDE = 132;
constexpr int L_EX = 0, L_GT = L_EX + TOK * EX_STRIDE * 2, L_IDX = L_GT + TOK * GT_STRIDE * 4, IDX_STRIDE = 36, L_RST = L_IDX + 512 * IDX_STRIDE, L_END = L_RST + TOK * 4;
static_assert(L_END <= RING_BYTES && L_GT % 16 == 0 && L_IDX % 16 == 0, "PEER LDS map");
__device__ __forceinline__ u32 ordmap(float f) { const u32 u = __float_as_uint(f); return u ^ ((u32)((int)u >> 31) | 0x80000000u); }
__device__ __forceinline__ float unordmap(u32 k) { const u32 u = (k & 0x80000000u) ? (k ^ 0x80000000u) : ~k; return __uint_as_float(u); }
__device__ __forceinline__ u32 umin_(u32 a, u32 b) { return a < b ? a : b; }
__device__ __forceinline__ u32 umax_(u32 a, u32 b) { return a > b ? a : b; }
template <bool DESC> __device__ __forceinline__ void sort16(u32 (&k)[16]) {
#pragma unroll
    for (int size = 2; size <= 16; size <<= 1)
#pragma unroll
        for (int stride = size >> 1; stride > 0; stride >>= 1)
#pragma unroll
            for (int i = 0; i < 16; ++i) { const int j = i ^ stride;
                if (j > i) { const bool asc = (((i & size) == 0) != DESC); const u32 a = k[i], b = k[j], lo = umin_(a, b), hi = umax_(a, b); k[i] = asc ? lo : hi; k[j] = asc ? hi : lo; } }
}
template <bool DESC> __device__ __forceinline__ void merge16(u32 (&k)[16]) {
#pragma unroll
    for (int stride = 8; stride > 0; stride >>= 1)
#pragma unroll
        for (int i = 0; i < 16; ++i) { const int j = i ^ stride;
            if (j > i) { const u32 a = k[i], b = k[j], lo = umin_(a, b), hi = umax_(a, b); k[i] = DESC ? hi : lo; k[j] = DESC ? lo : hi; } }
}
__host__ __device__ constexpr int ccnt(int a) { return 16 / (a + 1); }
__host__ __device__ constexpr int cbase(int a) { int s = 0; for (int i = 0; i < a; ++i) s += ccnt(i); return s; }
static_assert(cbase(16) == 50, "hyperbola candidate count");
__device__ __forceinline__ int crow16(int r) { return (r & 3) + 8 * (r >> 2); }

__device__ __forceinline__ void route_tile(Frame& F, const bf16* qp, const bf16* skb, const float* sumsq, int t0) {
    int lane = F.lane; asm volatile("" : "+v"(lane));
    const int r32 = lane & 31, hi = lane >> 5, w = F.wave;
    LAS unsigned short* EXL = (LAS unsigned short*)(F.lds + RING_OFF + L_EX);
    LAS float* GTL = (LAS float*)(F.lds + RING_OFF + L_GT);
    LAS unsigned char* IDXB = F.lds + RING_OFF + L_IDX + (w * 64 + lane) * IDX_STRIDE;
    LAS float* RST = (LAS float*)(F.lds + RING_OFF + L_RST);
    for (int g = 0; g < 4; ++g) {
        const int tok = 32 * g + r32; const size_t trow = (size_t)(t0 + tok);
        const float rstd2 = rsqrtf(sumsq[trow] * (1.f / DMODEL) + RMS_EPS);
        if (w == 0 && hi == 0) RST[tok] = rstd2;
        u32 s0[16], s1[16];
#pragma unroll
        for (int p = 0; p < 2; ++p) {
            bf16x8 qf[8];
#pragma unroll
            for (int ks = 0; ks < 8; ++ks) qf[ks] = *(const GAS bf16x8*)(qp + trow * QPW + w * 256 + p * 128 + ks * 16 + hi * 8);
            u32 run[16];
#pragma unroll
            for (int nb = 0; nb < 4; ++nb) {
                f32x16 acc = {};
                const bf16* kr = skb + ((size_t)((w * 2 + p) * NKEY + 32 * nb + r32)) * PHALF + hi * 8;
#pragma unroll
                for (int ks = 0; ks < 8; ++ks) acc = __builtin_amdgcn_mfma_f32_32x32x16_bf16(*(const GAS bf16x8*)(kr + ks * 16), qf[ks], acc, 0, 0, 0);
                asm volatile("" ::: "memory");
                u32 blk[16];
#pragma unroll
                for (int r = 0; r < 16; ++r) blk[r] = (ordmap(acc[r]) & ~0x7Fu) | (u32)(127 - 32 * nb - crow16(r) - 4 * hi);
                if (nb == 0) { sort16<true>(blk);
#pragma unroll
                    for (int i = 0; i < 16; ++i) run[i] = blk[i]; }
                else { sort16<false>(blk);
#pragma unroll
                    for (int i = 0; i < 16; ++i) run[i] = umax_(run[i], blk[i]);
                    merge16<true>(run); }
            }
            u32 oth[16];
#pragma unroll
            for (int i = 0; i < 16; ++i) oth[i] = (u32)__shfl_xor((int)run[15 - i], 32);
#pragma unroll
            for (int i = 0; i < 16; ++i) run[i] = umax_(run[i], oth[i]);
            merge16<true>(run);
#pragma unroll
            for (int i = 0; i < 16; ++i) { if (p == 0) s0[i] = run[i]; else s1[i] = run[i]; }
        }
        { LAS u32* iw = (LAS u32*)IDXB;
#pragma unroll
          for (int j = 0; j < 4; ++j) {
              iw[j] = (127u - (s0[4 * j] & 127u)) | ((127u - (s0[4 * j + 1] & 127u)) << 8) | ((127u - (s0[4 * j + 2] & 127u)) << 16) | ((127u - (s0[4 * j + 3] & 127u)) << 24);
              iw[4 + j] = (127u - (s1[4 * j] & 127u)) | ((127u - (s1[4 * j + 1] & 127u)) << 8) | ((127u - (s1[4 * j + 2] & 127u)) << 16) | ((127u - (s1[4 * j + 3] & 127u)) << 24); } }
        float v1[16], v2[16];
#pragma unroll
        for (int i = 0; i < 16; ++i) { v1[i] = unordmap(s0[i] & ~0x7Fu); v2[i] = unordmap(s1[i] & ~0x7Fu); }
        u32 c0[16], c1[16], c2[16], c3[16];
#pragma unroll
        for (int a = 0; a < 16; ++a)
#pragma unroll
            for (int b = 0; b < ccnt(a); ++b) { const int pos = cbase(a) + b; const u32 key = (ordmap(v1[a] + v2[b]) & ~0xFFu) | (u32)(255 - (a * 16 + b));
                if (pos < 16) c0[pos] = key; else if (pos < 32) c1[pos - 16] = key; else if (pos < 48) c2[pos - 32] = key; else c3[pos - 48] = key; }
#pragma unroll
        for (int i = 2; i < 16; ++i) c3[i] = 0u;
        sort16<false>(c1);
#pragma unroll
        for (int i = 0; i < 16; ++i) c0[i] = umax_(c0[i], c1[i]);
        merge16<true>(c0);
        sort16<false>(c2);
#pragma unroll
        for (int i = 0; i < 16; ++i) c0[i] = umax_(c0[i], c2[i]);
        merge16<true>(c0);
        sort16<false>(c3);
#pragma unroll
        for (int i = 0; i < 16; ++i) c0[i] = umax_(c0[i], c3[i]);
        merge16<true>(c0);
        const float m = unordmap(c0[0] & ~0xFFu) * rstd2;
        float e[8]; float sum = 0.f; u32 ex[8];
#pragma unroll
        for (int k = 0; k < 8; ++k) { const u32 key = hi ? c0[k + 8] : c0[k]; const float ts = unordmap(key & ~0xFFu);
            e[k] = __builtin_amdgcn_exp2f((ts * rstd2 - m) * LOG2E); sum += e[k];
            const u32 flat = 255u - (key & 255u); ex[k] = (u32)IDXB[flat >> 4] * NKEY + (u32)IDXB[16 + (flat & 15u)]; }
        sum += __shfl_xor(sum, 32);
        const float inv = 1.f / sum;
        v4u exw; exw.x = ex[0] | (ex[1] << 16); exw.y = ex[2] | (ex[3] << 16); exw.z = ex[4] | (ex[5] << 16); exw.w = ex[6] | (ex[7] << 16);
        *(LAS v4u*)(EXL + tok * EX_STRIDE + w * 16 + hi * 8) = exw;
        *(LAS f32x4*)(GTL + tok * GT_STRIDE + w * 16 + hi * 8) = (f32x4){e[0] * inv, e[1] * inv, e[2] * inv, e[3] * inv};
        *(LAS f32x4*)(GTL + tok * GT_STRIDE + w * 16 + hi * 8 + 4) = (f32x4){e[4] * inv, e[5] * inv, e[6] * inv, e[7] * inv};
    }
}
__device__ __forceinline__ float gelu_fast(float x) {
    const float u2 = x * (1.5957691216057308f + 0.07135481627f * x * x);
    return x * __builtin_amdgcn_rcpf(1.f + __builtin_amdgcn_exp2f(-1.4426950408889634f * u2));
}
typedef float f32x2 __attribute__((ext_vector_type(2)));

__device__ __forceinline__ void sort128(u32 (&k)[8], int m) {
#pragma unroll
    for (int K = 2; K <= 128; K <<= 1) {
#pragma unroll
        for (int S = K >> 1; S > 0; S >>= 1) {
            if (S >= 8) {
                const int mm = S >> 3; const bool lower = (m & mm) == 0, up = (K == 128) ? true : ((m & (K >> 3)) == 0), keepmin = (lower == up);
#pragma unroll
                for (int r = 0; r < 8; ++r) { const u32 o = (u32)__shfl_xor((int)k[r], mm); const u32 mn = umin_(k[r], o), mx = umax_(k[r], o); k[r] = keepmin ? mn : mx; }
            } else {
#pragma unroll
                for (int r = 0; r < 8; ++r) { const int r2 = r ^ S;
                    if (r2 > r) { const u32 a = k[r], b = k[r2], mn = umin_(a, b), mx = umax_(a, b);
                        if (K < 8) { const bool up = (r & K) == 0; k[r] = up ? mn : mx; k[r2] = up ? mx : mn; }
                        else { const bool up = (K == 128) ? true : ((m & (K >> 3)) == 0); k[r] = up ? mn : mx; k[r2] = up ? mx : mn; } } }
            }
        }
    }
}
__device__ __forceinline__ void eval_lg(Frame& F, const unsigned char* u8, const unsigned char* v8, const float* suv, const float* fg, float* out, int t0) {
    int lane = F.lane; asm volatile("" : "+v"(lane));
    const int g = lane >> 4, m = lane & 15;
    const LAS unsigned short* EXL = (const LAS unsigned short*)(F.lds + RING_OFF + L_EX);
    const LAS float* GTL = (const LAS float*)(F.lds + RING_OFF + L_GT);
    const LAS float* RST = (const LAS float*)(F.lds + RING_OFF + L_RST);
    LAS u32* SK = (LAS u32*)(F.lds + RING_OFF + L_IDX) + F.wave * 512 + g * 128;
    for (int pass = 0; pass < 4; ++pass) {
        const int tok = 32 * pass + 4 * F.wave + g;
        { u32 k[8]; const v4u ev = *(const LAS v4u*)(EXL + tok * EX_STRIDE + 8 * m); const u32 s0 = (u32)(8 * m);
          k[0] = ((ev.x & 0xffffu) << 7) | s0; k[1] = ((ev.x >> 16) << 7) | (s0 + 1); k[2] = ((ev.y & 0xffffu) << 7) | (s0 + 2); k[3] = ((ev.y >> 16) << 7) | (s0 + 3);
          k[4] = ((ev.z & 0xffffu) << 7) | (s0 + 4); k[5] = ((ev.z >> 16) << 7) | (s0 + 5); k[6] = ((ev.w & 0xffffu) << 7) | (s0 + 6); k[7] = ((ev.w >> 16) << 7) | (s0 + 7);
          sort128(k, m);
          *(LAS v4u*)(SK + m * 8) = (v4u){k[0], k[1], k[2], k[3]}; *(LAS v4u*)(SK + m * 8 + 4) = (v4u){k[4], k[5], k[6], k[7]}; }
        asm volatile("" ::: "memory");
        f32x2 hv[32], y[32];
        const float rstd2 = RST[tok]; float* xrow = out + (size_t)(t0 + tok) * DMODEL + 64 * m;
#pragma unroll
        for (int q = 0; q < 16; ++q) { const f32x4 xa = *(const GAS f32x4*)(xrow + 4 * q); hv[2 * q] = (f32x2){xa[0] * rstd2, xa[1] * rstd2}; hv[2 * q + 1] = (f32x2){xa[2] * rstd2, xa[3] * rstd2};
            y[2 * q] = (f32x2){0.f, 0.f}; y[2 * q + 1] = (f32x2){0.f, 0.f}; }
        const LAS float* gtr = GTL + tok * GT_STRIDE;
#define PEER_FP4_DOT(W, A) do { _Pragma("unroll") for (int c = 0; c < 2; ++c) _Pragma("unroll") for (int d = 0; d < 4; ++d) { const unsigned w_ = W[c][d]; const int hb = 16 * c + 4 * d; \
            A = __builtin_elementwise_fma(__builtin_amdgcn_cvt_scalef32_pk_f32_fp4(w_, 1.0f, 0), hv[hb], A); A = __builtin_elementwise_fma(__builtin_amdgcn_cvt_scalef32_pk_f32_fp4(w_, 1.0f, 1), hv[hb + 1], A); \
            A = __builtin_elementwise_fma(__builtin_amdgcn_cvt_scalef32_pk_f32_fp4(w_, 1.0f, 2), hv[hb + 2], A); A = __builtin_elementwise_fma(__builtin_amdgcn_cvt_scalef32_pk_f32_fp4(w_, 1.0f, 3), hv[hb + 3], A); } } while (0)
#define PEER_FP4_AXPY(W, B) do { _Pragma("unroll") for (int c = 0; c < 2; ++c) _Pragma("unroll") for (int d = 0; d < 4; ++d) { const unsigned w_ = W[c][d]; const int hb = 16 * c + 4 * d; \
            y[hb] = __builtin_elementwise_fma(__builtin_amdgcn_cvt_scalef32_pk_f32_fp4(w_, 1.0f, 0), B, y[hb]); y[hb + 1] = __builtin_elementwise_fma(__builtin_amdgcn_cvt_scalef32_pk_f32_fp4(w_, 1.0f, 1), B, y[hb + 1]); \
            y[hb + 2] = __builtin_elementwise_fma(__builtin_amdgcn_cvt_scalef32_pk_f32_fp4(w_, 1.0f, 2), B, y[hb + 2]); y[hb + 3] = __builtin_elementwise_fma(__builtin_amdgcn_cvt_scalef32_pk_f32_fp4(w_, 1.0f, 3), B, y[hb + 3]); } } while (0)
        for (int i = 0; i < 128; i += 4) {
            const v4u kq = *(const LAS v4u*)(SK + i);
            v4u ub[4][2]; f32x2 sc[4]; float gate[4];
#pragma unroll
            for (int s4 = 0; s4 < 4; ++s4) { const u32 key = kq[s4]; const u32 ro = (key >> 7) * 512u + 32u * (u32)m;
                ub[s4][0] = *(const GAS v4u*)(u8 + ro); ub[s4][1] = *(const GAS v4u*)(u8 + ro + 16);
                sc[s4] = *(const GAS f32x2*)(suv + 2 * (key >> 7)); gate[s4] = gtr[key & 127u]; }
            float pp[4];
#pragma unroll
            for (int s4 = 0; s4 < 4; ++s4) { f32x2 a = (f32x2){0.f, 0.f}; PEER_FP4_DOT(ub[s4], a); pp[s4] = a[0] + a[1]; }
            asm volatile("" ::: "memory");
            v4u vb[4][2];
#pragma unroll
            for (int s4 = 0; s4 < 4; ++s4) { const u32 ro = (kq[s4] >> 7) * 512u + 32u * (u32)m; vb[s4][0] = *(const GAS v4u*)(v8 + ro); vb[s4][1] = *(const GAS v4u*)(v8 + ro + 16); }
#pragma unroll
            for (int s4 = 0; s4 < 4; ++s4) { pp[s4] += __shfl_xor(pp[s4], 1); }
#pragma unroll
            for (int s4 = 0; s4 < 4; ++s4) { pp[s4] += __shfl_xor(pp[s4], 2); }
#pragma unroll
            for (int s4 = 0; s4 < 4; ++s4) { pp[s4] += __shfl_xor(pp[s4], 4); }
#pragma unroll
            for (int s4 = 0; s4 < 4; ++s4) { pp[s4] += __shfl_xor(pp[s4], 8); }
#pragma unroll
            for (int s4 = 0; s4 < 4; ++s4) { const float act = gelu_fast(pp[s4] * sc[s4][0]) * (gate[s4] * sc[s4][1]); const f32x2 b2 = (f32x2){act, act}; PEER_FP4_AXPY(vb[s4], b2); }
        }
#undef PEER_FP4_DOT
#undef PEER_FP4_AXPY
        float ss = 0.f;
#pragma unroll
        for (int q = 0; q < 16; ++q) { const f32x4 xa = *(const GAS f32x4*)(xrow + 4 * q); y[2 * q][0] += xa[0]; y[2 * q][1] += xa[1]; y[2 * q + 1][0] += xa[2]; y[2 * q + 1][1] += xa[3];
            ss += (y[2 * q][0] * y[2 * q][0] + y[2 * q][1] * y[2 * q][1]) + (y[2 * q + 1][0] * y[2 * q + 1][0] + y[2 * q + 1][1] * y[2 * q + 1][1]); }
        ss += __shfl_xor(ss, 1); ss += __shfl_xor(ss, 2); ss += __shfl_xor(ss, 4); ss += __shfl_xor(ss, 8);
        const float rs = rsqrtf(ss * (1.f / DMODEL) + RMS_EPS);
#pragma unroll
        for (int q = 0; q < 16; ++q) { const f32x4 gq = *(const GAS f32x4*)(fg + 64 * m + 4 * q); f32x4 o; o[0] = y[2 * q][0] * rs * gq[0]; o[1] = y[2 * q][1] * rs * gq[1]; o[2] = y[2 * q + 1][0] * rs * gq[2]; o[3] = y[2 * q + 1][1] * rs * gq[3];
            *(GAS f32x4*)(xrow + 4 * q) = o; }
    }
}
__device__ __forceinline__ void peer_phase(Frame& F, const Args& a) {
    unsigned char* ws = a.ws;
    for (int tile = F.vcu; tile < T / TOK; tile += F.G) {
        route_tile(F, (const bf16*)(ws + WS_QP), (const bf16*)(ws + WS_SKB), (const float*)(ws + WS_SUMSQ), tile * TOK);
        __syncthreads();
        eval_lg(F, ws + WS_U8, ws + WS_V8, (const float*)(ws + WS_SU), a.in[19], a.out, tile * TOK);
        __syncthreads();
    }
}
}

namespace lru {
typedef float f32x16 __attribute__((ext_vector_type(16)));
constexpr int TOKT = 128, NTILE = SEQ / TOKT;
constexpr int WAVE_LDS = 14336, L_XS = 0, L_XC = 4608, L_GS = 9216, XC_STRIDE = 72  , L_SS = 8 * WAVE_LDS;
static_assert(L_SS + 32 * 8 * 4 <= RING_BYTES, "LRU LDS map");
__device__ __forceinline__ float bf2f(unsigned short h) { return __uint_as_float((unsigned)h << 16); }
__device__ __forceinline__ int crow16(int r) { return (r & 3) + 8 * (r >> 2); }
__device__ __forceinline__ float sigm(float x) { return __builtin_amdgcn_rcpf(1.f + __builtin_amdgcn_exp2f(-LOG2E * x)); }

template <bool FINAL> __device__ __forceinline__ void lru_tile(Frame& F, const Args& args, int tile) {
    int lane = F.lane; asm volatile("" : "+v"(lane));
    const int w = F.wave, j32 = lane & 31, hi = lane >> 5;
    unsigned char* ws = args.ws;
    const bf16* xr = (const bf16*)(ws + WS_XR); const bf16* gr = (const bf16*)(ws + WS_GR); float* carry = (float*)(ws + WS_CARRY);
    const float* cw = args.in[3]; const float* cb = args.in[4]; const float* ba = args.in[6]; const float* bx = args.in[8]; const float* lam = args.in[9];
    const int b = tile / NTILE, jt = tile % NTILE; const size_t trow0 = (size_t)b * SEQ + (size_t)jt * TOKT;
    LAS unsigned char* wl = F.lds + RING_OFF + w * WAVE_LDS;
    LAS unsigned short* XS = (LAS unsigned short*)(wl + L_XS); LAS unsigned short* XC = (LAS unsigned short*)(wl + L_XC); LAS unsigned short* GS = (LAS unsigned short*)(wl + L_GS);
    LAS float* SS = (LAS float*)(F.lds + RING_OFF + L_SS);
    float c_ba[2], c_bx[2], c_sp[2], c_cb[2], c_cw[2][4];
#pragma unroll
    for (int n = 0; n < 2; ++n) { const int c = 64 * w + 32 * n + j32; c_ba[n] = ba[c]; c_bx[n] = bx[c]; c_cb[n] = cb[c];
        const float l = lam[c]; c_sp[n] = 8.f * LOG2E * (fmaxf(-l, 0.f) + log1pf(expf(-fabsf(l))));
#pragma unroll
        for (int k = 0; k < 4; ++k) c_cw[n][k] = cw[k * LW + c]; }
    const bf16* wax = (const bf16*)(ws + WS_WAX);
    float hc[2] = {0.f, 0.f}, ap[2] = {1.f, 1.f};
    if (FINAL) { const float* cin = (const float*)(ws + WS_CIN) + (size_t)(b * NTILE + jt) * LW + 64 * w + j32; hc[0] = cin[0]; hc[1] = cin[32]; }
    v4u pfx[5], pfg[4];
#define LRU_FETCH(B) do { const size_t tbn_ = trow0 + (B) * 32; _Pragma("unroll") for (int q_ = 0; q_ < 5; ++q_) { const int pc_ = lane + 64 * q_, row_ = pc_ >> 3, c8_ = pc_ & 7; \
        const bool z_ = (jt == 0 && (B) == 0 && row_ < 3) || pc_ >= 35 * 8; const v4u v_ = *(const GAS v4u*)(xr + (tbn_ + (z_ ? 3 : row_) - 3) * LW + w * 64 + c8_ * 8); pfx[q_] = z_ ? (v4u){0u, 0u, 0u, 0u} : v_; } \
        if (FINAL) { _Pragma("unroll") for (int q_ = 0; q_ < 4; ++q_) { const int pc_ = lane + 64 * q_; pfg[q_] = *(const GAS v4u*)(gr + (tbn_ + (pc_ >> 3)) * LW + w * 64 + (pc_ & 7) * 8); } } } while (0)
    LRU_FETCH(0);
    for (int blk = 0; blk < 4; ++blk) {
        const size_t tb = trow0 + blk * 32;
        int ln = lane; asm volatile("" : "+v"(ln));
        const int k32 = ln & 31;
#pragma unroll
        for (int q = 0; q < 5; ++q) { const int pc = ln + 64 * q; if (pc < 35 * 8) *(LAS v4u*)((LAS unsigned char*)XS + (pc >> 3) * 128 + (pc & 7) * 16) = pfx[q]; }
        if (FINAL) {
#pragma unroll
            for (int q = 0; q < 4; ++q) { const int pc = ln + 64 * q; *(LAS v4u*)((LAS unsigned char*)GS + (pc >> 3) * 128 + (pc & 7) * 16) = pfg[q]; } }
        if (blk < 3) { LRU_FETCH(blk + 1); }
        asm volatile("" ::: "memory");
        float xc[2][16];
#pragma unroll
        for (int n = 0; n < 2; ++n)
#pragma unroll
            for (int g = 0; g < 4; ++g) { float xv[7];
#pragma unroll
                for (int q = 0; q < 7; ++q) xv[q] = bf2f(XS[(8 * g + 4 * hi + q) * 64 + 32 * n + j32]);
#pragma unroll
                for (int e = 0; e < 4; ++e) xc[n][4 * g + e] = c_cb[n] + ((c_cw[n][0] * xv[e] + c_cw[n][1] * xv[e + 1]) + (c_cw[n][2] * xv[e + 2] + c_cw[n][3] * xv[e + 3])); }
#pragma unroll
        for (int n = 0; n < 2; ++n)
#pragma unroll
            for (int r = 0; r < 16; ++r) XC[(crow16(r) + 4 * hi) * XC_STRIDE + 32 * n + j32] = (unsigned short)f2bf(xc[n][r]);
        asm volatile("" ::: "memory");
        bf16x8 af[4];
#pragma unroll
        for (int ks = 0; ks < 4; ++ks) af[ks] = *(const LAS bf16x8*)(XC + j32 * XC_STRIDE + 16 * ks + 8 * hi);
        asm volatile("" ::: "memory");
        float yv[2][16];
#pragma unroll
        for (int n = 0; n < 2; ++n) {
            f32x16 R = {}, I = {};
            bf16x8 fa[4], fx[4];
#pragma unroll
            for (int ks = 0; ks < 4; ++ks) { fa[ks] = *(const GAS bf16x8*)(wax + (size_t)(((w * 2 + 0) * 2 + n) * 4 + ks) * 512 + lane * 8); fx[ks] = *(const GAS bf16x8*)(wax + (size_t)(((w * 2 + 1) * 2 + n) * 4 + ks) * 512 + lane * 8); }
#pragma unroll
            for (int ks = 0; ks < 4; ++ks) { R = __builtin_amdgcn_mfma_f32_32x32x16_bf16(af[ks], fa[ks], R, 0, 0, 0); I = __builtin_amdgcn_mfma_f32_32x32x16_bf16(af[ks], fx[ks], I, 0, 0, 0); }
            float av[16], uv[16];
#pragma unroll
            for (int r = 0; r < 16; ++r) { const float rg = sigm(R[r] + c_ba[n]), ig = sigm(I[r] + c_bx[n]); const float a_ = __builtin_amdgcn_exp2f(-rg * c_sp[n]);
                av[r] = a_; uv[r] = __builtin_amdgcn_sqrtf(fmaxf(1.f - a_ * a_, 0.f)) * (ig * xc[n][r]); }
            float Ar[4], Hr[4], hst[4];
#pragma unroll
            for (int g = 0; g < 4; ++g) { Ar[g] = (av[4 * g] * av[4 * g + 1]) * (av[4 * g + 2] * av[4 * g + 3]);
                Hr[g] = ((uv[4 * g] * av[4 * g + 1] + uv[4 * g + 1]) * av[4 * g + 2] + uv[4 * g + 2]) * av[4 * g + 3] + uv[4 * g + 3]; }
            float hin = hc[n];
#pragma unroll
            for (int g = 0; g < 4; ++g) { float o1 = Ar[g] * hin + Hr[g]; const float x = __shfl_xor(o1, 32); const float hg = hi ? x : hin; o1 = Ar[g] * hg + Hr[g]; hst[g] = hg;
                const float y = __shfl_xor(o1, 32); hin = hi ? o1 : y;
                if (!FINAL) ap[n] *= Ar[g] * __shfl_xor(Ar[g], 32); }
            hc[n] = hin;
            if (FINAL) {
#pragma unroll
                for (int g = 0; g < 4; ++g) { float h = hst[g];
#pragma unroll
                    for (int e = 0; e < 4; ++e) { const int r = 4 * g + e; h = av[r] * h + uv[r]; yv[n][r] = h * bf2f(GS[(crow16(r) + 4 * hi) * 64 + 32 * n + j32]); } } }
        }
        if (FINAL) {
#pragma unroll
            for (int r = 0; r < 16; ++r) { float s = yv[0][r] * yv[0][r] + yv[1][r] * yv[1][r];
                s += __shfl_xor(s, 1); s += __shfl_xor(s, 2); s += __shfl_xor(s, 4); s += __shfl_xor(s, 8); s += __shfl_xor(s, 16);
                if (j32 == 0) SS[(crow16(r) + 4 * hi) * 8 + w] = s; }
            __syncthreads();
            bf16* ymix = (bf16*)(ws + WS_H);
#pragma unroll
            for (int r = 0; r < 16; ++r) { const int tk = crow16(r) + 4 * hi; const f32x4 s0 = *(const LAS f32x4*)(SS + tk * 8), s1 = *(const LAS f32x4*)(SS + tk * 8 + 4);
                const float rstd = rsqrtf(((s0[0] + s0[1]) + (s0[2] + s0[3]) + (s1[0] + s1[1]) + (s1[2] + s1[3])) * (1.f / LW) + RMS_EPS);
                bf16* yp = ymix + (tb + tk) * DMODEL + 64 * w + k32;
                yp[0] = (bf16)f2bf(yv[0][r] * rstd); yp[32] = (bf16)f2bf(yv[1][r] * rstd); }
            __syncthreads();
        }
    }
#undef LRU_FETCH
    if (!FINAL) { if (hi == 0) { float* cp = carry + ((size_t)(b * NTILE + jt) * 2) * LW + 64 * w + j32;
#pragma unroll
        for (int n = 0; n < 2; ++n) { cp[32 * n] = ap[n]; cp[LW + 32 * n] = hc[n]; } } }
    else {
        const bf16* ob = (const bf16*)(ws + WS_O); bf16* ymix = (bf16*)(ws + WS_H);
        for (int i0 = 0; i0 < 16; i0 += 4) {
            v4u vv[4];
#pragma unroll
            for (int i = 0; i < 4; ++i) vv[i] = *(const GAS v4u*)(ob + (trow0 + 16 * w + i0 + i) * AW + 8 * lane);
            float ssq[4];
#pragma unroll
            for (int i = 0; i < 4; ++i) { float s = 0.f;
#pragma unroll
                for (int c = 0; c < 4; ++c) { const float lo = __uint_as_float(vv[i][c] << 16), hi2 = __uint_as_float(vv[i][c] & 0xffff0000u); s += lo * lo + hi2 * hi2; }
                ssq[i] = s; }
#pragma unroll
            for (int o = 1; o < 64; o <<= 1) {
#pragma unroll
                for (int i = 0; i < 4; ++i) ssq[i] += __shfl_xor(ssq[i], o); }
#pragma unroll
            for (int i = 0; i < 4; ++i) { const float rstd = rsqrtf(ssq[i] * (1.f / AW) + RMS_EPS); v4u o;
#pragma unroll
                for (int c = 0; c < 4; ++c) o[c] = pk2(__uint_as_float(vv[i][c] << 16) * rstd, __uint_as_float(vv[i][c] & 0xffff0000u) * rstd);
                *(GAS v4u*)(ymix + (trow0 + 16 * w + i0 + i) * DMODEL + LW + 8 * lane) = o; } }
    }
}
__device__ __forceinline__ void norm_pass(Frame& F, const Args& a) {
    unsigned char* ws = a.ws; float* nrm = (float*)(ws + WS_NRM);
    const int gw = F.vcu * NWAVES + F.wave, NGW = F.G * NWAVES, lane = F.lane;
    for (int it = gw; it < 2 * BATCH * (SEQ / 64); it += NGW) {
        const int which = it / (BATCH * (SEQ / 64)), r = it % (BATCH * (SEQ / 64)), b = r / (SEQ / 64), t = r % (SEQ / 64);
        const bf16* src = (const bf16*)(ws + (which ? WS_K : WS_Q)) + ((size_t)b * SEQ + 64 * t) * AW + 8 * lane;
        float mx = 0.f;
#pragma unroll 8
        for (int i = 0; i < 64; ++i) { const v4u v = *(const GAS v4u*)(src + (size_t)i * AW); float s = 0.f;
#pragma unroll
            for (int c = 0; c < 4; ++c) { const float lo = __uint_as_float(v[c] << 16), hi = __uint_as_float(v[c] & 0xffff0000u); s += lo * lo + hi * hi; }
            s += __shfl_xor(s, 1); s += __shfl_xor(s, 2); s += __shfl_xor(s, 4); mx = fmaxf(mx, s); }
        if ((lane & 7) == 0) nrm[which * 4096 + (b * NHEADS + (lane >> 3)) * 128 + t] = sqrtf(mx) * 1.0001f;
    }
}
__device__ __forceinline__ void carry_prefix(Frame& F, const Args& a, int b) {
    const float* carry = (const float*)(a.ws + WS_CARRY) + (size_t)b * NTILE * 2 * LW + F.tid; float* cin = (float*)(a.ws + WS_CIN) + (size_t)b * NTILE * LW + F.tid;
    float c = 0.f;
    for (int j0 = 0; j0 < NTILE; j0 += 8) { float A[8], H[8];
#pragma unroll
        for (int j = 0; j < 8; ++j) { A[j] = carry[(size_t)(j0 + j) * 2 * LW]; H[j] = carry[(size_t)(j0 + j) * 2 * LW + LW]; }
#pragma unroll
        for (int j = 0; j < 8; ++j) { cin[(size_t)(j0 + j) * LW] = c; c = A[j] * c + H[j]; } }
}
template <bool FINAL> __device__ __forceinline__ void lru_phase(Frame& F, const Args& a) {
    for (int tile = F.vcu; tile < BATCH * NTILE; tile += F.G) { lru_tile<FINAL>(F, a, tile); __syncthreads(); }
}
}
__global__ void __launch_bounds__(NWAVES * 64, 2) mk_fwd(Args args) {
    extern __shared__ __attribute__((aligned(16))) unsigned char lds[];
    Frame F;
    F.lds = (LAS unsigned char*)lds;
    F.MISC = (volatile LAS unsigned*)(F.lds + MISC_OFF);
    F.wave = __builtin_amdgcn_readfirstlane((int)threadIdx.x >> 6); F.lane = (int)__builtin_amdgcn_mbcnt_hi(~0u, __builtin_amdgcn_mbcnt_lo(~0u, 0u)); F.tid = F.wave * 64 + F.lane;
    F.G = gridDim.x; { const int bx = blockIdx.x; F.vcu = (F.G % 8 == 0) ? (bx % 8) * (F.G / 8) + bx / 8 : bx; }
    unsigned char* ws = args.ws;
    F.ctl = (gu32*)(ws + WS_CTL);
    for (int u = F.tid; u < (LDS_BYTES - LDSCTL_OFF) / 4; u += NWAVES * 64) ((LAS unsigned*)(F.lds + LDSCTL_OFF))[u] = 0u;
    __syncthreads();
    XcdBarrier bar = xcd_barrier_post((unsigned*)(F.ctl + CW_BAR) + args.li * XCD_BAR_WORDS, F.MISC + 8, F.wave);
    const int lo = args.ph_lo, hi = args.ph_hi;
#define IN(k) (lo <= (k) && (k) < hi)
#define BOTH(k) (IN(k) && IN((k) + 1))
#define GRID_BAR() xcd_barrier(bar)

    if (IN(0)) { for (int rp = 0; rp < REPS(0); ++rp) { if (rp) GRID_BAR(); p0_prologue(F, args); } if (BOTH(0)) GRID_BAR(); }

    if (IN(1)) for (int rp = 0; rp < REPS(1); ++rp) {
        if (rp) GRID_BAR();
        if (F.vcu < BATCH * NHEADS) fcum_unit(F, F.vcu, (const float*)(ws + WS_LOGF), (float*)(ws + WS_FCUM));
        pg8::Gemm g{(const pg8::bf16_t*)(ws + WS_H), (const pg8::bf16_t*)(ws + WS_WIN), T, NG1, DMODEL}; pg8::StaticOrder S; S.init(T, NG1, F.G, (int)blockIdx.x);
        pg8::EpiG1 E{(pg8::bf16_t*)(ws + WS_XR), SPLIT_STRIDE, QSCALE};
        pg8::gemm_phase<pg8::EpiG1, pg8::StaticOrder, true, true>(F.lds + RING_OFF, g, S, E, F.wave);
        if (BOTH(1) && rp == REPS(1) - 1) GRID_BAR();
    }
    if (IN(2)) { for (int rp = 0; rp < REPS(2); ++rp) { if (rp) GRID_BAR(); lru::lru_phase<false>(F, args); lru::norm_pass(F, args); } if (BOTH(2)) GRID_BAR(); }
    if (IN(3)) for (int rp = 0; rp < REPS(3); ++rp) {
        if (rp) { GRID_BAR(); if (F.wave == 0 && F.lane == 0 && blockIdx.x == 0) __hip_atomic_store((unsigned*)(F.ctl + CW_ATTQ), 0u, __ATOMIC_RELAXED, __HIP_MEMORY_SCOPE_AGENT); GRID_BAR(); }
        static_assert(attn_body::ATTN_LDS_BYTES <= RING_BYTES, "attention LDS vs frame");
        if (rp == 0 && F.vcu < BATCH) lru::carry_prefix(F, args, F.vcu);
        const attn_body::AttnTensors AT{(const attn_body::bf16*)(ws + WS_Q), (const attn_body::bf16*)(ws + WS_K), (const attn_body::bf16*)(ws + WS_V), (attn_body::bf16*)(ws + WS_O), (const float*)(ws + WS_FCUM), (const float*)(ws + WS_NRM)};
        attn_body::attn_phase<8>((char*)lds + RING_OFF, AT, (unsigned*)(F.ctl + CW_ATTQ), F.MISC + 24, F.wave);
        if (BOTH(3) && rp == REPS(3) - 1) GRID_BAR();
    }
    if (IN(4)) { for (int rp = 0; rp < REPS(4); ++rp) { if (rp) GRID_BAR(); lru::lru_phase<true>(F, args); } if (BOTH(4)) GRID_BAR(); }
    if (IN(5)) {
        pg8::Gemm g{(const pg8::bf16_t*)(ws + WS_H), (const pg8::bf16_t*)(ws + WS_WOUT), T, DMODEL, DMODEL}; pg8::StaticOrder S; S.init(T, DMODEL, F.G, (int)blockIdx.x);
        pg8::EpiG2 E{args.in[0], args.out, (pg8::bf16_t*)(ws + WS_X1B), (float*)(ws + WS_SUMSQ), DMODEL};
        pg8::gemm_phase<pg8::EpiG2, pg8::StaticOrder, true, true>(F.lds + RING_OFF, g, S, E, F.wave);
        if (BOTH(5)) GRID_BAR();
    }
    if (IN(6)) for (int rp = 0; rp < REPS(6); ++rp) {
        if (rp) GRID_BAR();
        pg8::Gemm g{(const pg8::bf16_t*)(ws + WS_X1B), (const pg8::bf16_t*)(ws + WS_WQ), T, QPW, DMODEL}; pg8::StaticOrder S; S.init(T, QPW, F.G, (int)blockIdx.x);
        pg8::EpiG3 E{(pg8::bf16_t*)(ws + WS_QP), QPW};
        pg8::gemm_phase<pg8::EpiG3, pg8::StaticOrder, true, true>(F.lds + RING_OFF, g, S, E, F.wave);
        if (BOTH(6) && rp == REPS(6) - 1) GRID_BAR();
    }
    if (IN(7)) { peer::peer_phase(F, args); }
#undef IN
#undef BOTH
#undef GRID_BAR
}

#ifndef MK_FRAME_MASK
#define MK_FRAME_MASK 0xFF
#endif
extern "C" void kernel_launch(void* const* d_in, const int* in_sizes, int n_in, void* d_out, int out_size, void* d_ws, size_t ws_size, hipStream_t stream) {
    static int grid = 0;
    if (grid == 0) {
        if (n_in != 20 || in_sizes[0] != T * DMODEL || out_size != T * DMODEL || ws_size < WS_END) { fprintf(stderr, "kernel_launch: unexpected shapes (n_in %d, ws %zu)\n", n_in, ws_size); grid = -1; return; }
        int dev = 0, cus = 0;
        if (hipGetDevice(&dev) != hipSuccess || hipDeviceGetAttribute(&cus, hipDeviceAttributeMultiprocessorCount, dev) != hipSuccess) { grid = -1; return; }
        if (hipFuncSetAttribute((const void*)mk_fwd, hipFuncAttributeMaxDynamicSharedMemorySize, LDS_BYTES) != hipSuccess) { fprintf(stderr, "kernel_launch: hipFuncSetAttribute failed\n"); grid = -1; return; }
        (void)hipGetLastError();
        grid = cus;
    }
    if (grid < 0) return;
    using namespace naive;
    const float* x = (const float*)d_in[0]; const float* g1 = (const float*)d_in[1]; const float* w_in = (const float*)d_in[2];
    const float* cw = (const float*)d_in[3]; const float* cb = (const float*)d_in[4]; const float* wa = (const float*)d_in[5]; const float* ba = (const float*)d_in[6];
    const float* wx = (const float*)d_in[7]; const float* bx = (const float*)d_in[8]; const float* lam = (const float*)d_in[9]; const float* bfv = (const float*)d_in[10];
    const float* gn_l = (const float*)d_in[11]; const float* gn_f = (const float*)d_in[12]; const float* w_out = (const float*)d_in[13]; const float* g2 = (const float*)d_in[14];
    const float* w_q = (const float*)d_in[15]; const float* sk = (const float*)d_in[16]; const float* pu = (const float*)d_in[17]; const float* pv = (const float*)d_in[18]; const float* fg = (const float*)d_in[19];
    char* ws = (char*)d_ws; float* out = (float*)d_out;
    naive::bf16* win_t = (naive::bf16*)(ws + WS_WIN); naive::bf16* wout_t = (naive::bf16*)(ws + WS_WOUT); naive::bf16* wq_t = (naive::bf16*)(ws + WS_WQ); naive::bf16* skb = (naive::bf16*)(ws + WS_SKB); float* wfl = (float*)(ws + WS_WFL);
    float* logf = (float*)(ws + WS_LOGF); float* fcum = (float*)(ws + WS_FCUM); float* sumsq = (float*)(ws + WS_SUMSQ);
    naive::bf16* h = (naive::bf16*)(ws + WS_H); naive::bf16* xr = (naive::bf16*)(ws + WS_XR); naive::bf16* gr = (naive::bf16*)(ws + WS_GR); naive::bf16* q = (naive::bf16*)(ws + WS_Q); naive::bf16* k = (naive::bf16*)(ws + WS_K); naive::bf16* v = (naive::bf16*)(ws + WS_V);
    naive::bf16* x1b = (naive::bf16*)(ws + WS_X1B); naive::bf16* qp = (naive::bf16*)(ws + WS_QP); naive::bf16* ut = (naive::bf16*)(ws + WS_UT); naive::bf16* vt = (naive::bf16*)(ws + WS_VT); float* la = (float*)(ws + WS_LA); float* lu = (float*)(ws + WS_LU);
    naive::bf16* ymix = h;
    if (hipMemsetAsync((char*)d_ws + WS_CTL, 0, CTL_ZERO_BYTES, stream) != hipSuccess) return;
    Args a{};
    for (int i = 0; i < 20; ++i) a.in[i] = (const float*)d_in[i];
    a.out = out; a.ws = (unsigned char*)d_ws;
    int li = 0;
    for (int p = 0; p < N_PHASES;) {
        if ((MK_FRAME_MASK >> p) & 1) {
            int e = p; while (e < N_PHASES && ((MK_FRAME_MASK >> e) & 1)) ++e;
            a.ph_lo = p; a.ph_hi = e; a.li = li++;
            hipLaunchKernelGGL(mk_fwd, dim3(grid), dim3(NWAVES * 64), LDS_BYTES, stream, a);
            p = e; continue;
        }
        switch (p) {
        case 0: k_prep_w<<<2048, 256, 0, stream>>>(w_in, w_out, gn_l, gn_f, w_q, g2, sk, win_t, wfl, wout_t, wq_t, skb);
                k_prep_tab<<<4096, 256, 0, stream>>>(pu, pv, g2, ut, vt);
                k_prep_x<<<2048, 256, 0, stream>>>(x, g1, wfl, bfv, h, logf); break;
        case 1: k_fcum<<<BATCH * NHEADS, 64, 0, stream>>>(logf, fcum);
                { EpiArgs e{xr, gr, q, k, v, nullptr, nullptr}; k_gemm<1><<<dim3(NG1 / 64, T / 64), 256, 0, stream>>>(h, win_t, T, NG1, DMODEL, e); } break;
        case 2: break;
        case 3: k_attn<<<(BATCH * NHEADS * SEQ) / 4, 256, 0, stream>>>(q, k, v, fcum, (naive::bf16*)(ws + WS_O)); break;
        case 4: k_lru_gates<<<T * NHEADS, 64, 0, stream>>>(xr, cw, cb, wa, ba, wx, bx, lam, la, lu);
                k_lru_scan<<<(BATCH * LW + 63) / 64, 64, 0, stream>>>(la, lu, gr);
                k_ymix<<<2048, 256, 0, stream>>>(lu, (naive::bf16*)(ws + WS_O), ymix); break;
        case 5: { EpiArgs e{x1b, nullptr, nullptr, nullptr, nullptr, x, out}; k_gemm<2><<<dim3(DMODEL / 64, T / 64), 256, 0, stream>>>(ymix, wout_t, T, DMODEL, DMODEL, e); }
                k_sumsq<<<2048, 256, 0, stream>>>(out, sumsq); break;
        case 6: { EpiArgs e{qp, nullptr, nullptr, nullptr, nullptr, nullptr, nullptr}; k_gemm<3><<<dim3(QPW / 64, T / 64), 256, 0, stream>>>(x1b, wq_t, T, QPW, DMODEL, e); } break;
        case 7: k_peer<<<T, 64, 0, stream>>>(qp, skb, sumsq, ut, vt, fg, out); break;
        }
        ++p;
    }
}
```

```cpp
#include <hip/hip_runtime.h>
#include <hip/hip_bf16.h>
#include <cstdio>
#include <cstdint>
#include <cmath>

constexpr int BATCH = 4, SEQ = 8192, DMODEL = 1024, T = BATCH * SEQ;
constexpr int LW = 512, AW = 512, NHEADS = 8, HD = 64, INC = 2568, NG1 = 2560;
constexpr int PH = 8, NKEY = 128, PHALF = 128, TOPK = 16, NEXP = NKEY * NKEY, QPW = 2048;
constexpr float RMS_EPS = 1e-6f;
constexpr float LOG2E = 1.4426950408889634f;
constexpr float QSCALE = 0.125f * LOG2E;
constexpr size_t MiB = 1u << 20;
constexpr size_t WS_CTL = 0, CTL_ZERO_BYTES = 1 * MiB;
constexpr size_t WS_WIN = 2 * MiB, WS_WOUT = 8 * MiB, WS_WQ = 10 * MiB, WS_SKB = 14 * MiB, WS_WFL = 15 * MiB,
                 WS_LOGF = 16 * MiB, WS_FCUM = 17 * MiB, WS_CARRY = 18 * MiB, WS_SUMSQ = 19 * MiB, WS_WAX = 20 * MiB, WS_CIN = 23 * MiB  , WS_NRM = 22 * MiB  ,
                 WS_H = 32 * MiB, WS_XR = 96 * MiB, WS_GR = 128 * MiB, WS_Q = 160 * MiB, WS_K = 192 * MiB, WS_V = 224 * MiB,
                 WS_X1B = 256 * MiB, WS_O = 256 * MiB  , WS_QP = 96 * MiB, WS_UT = 320 * MiB, WS_VT = 352 * MiB, WS_U8 = 320 * MiB, WS_V8 = 336 * MiB, WS_SU = 21 * MiB, WS_SV = 21 * MiB + 65536, WS_LA = 384 * MiB, WS_LU = 448 * MiB, WS_END = 512 * MiB;
constexpr size_t SPLIT_STRIDE = (WS_GR - WS_XR) / 2;
constexpr int CW_TMO = 0, CW_ATTQ = 2048, CW_BAR = 4096;

namespace naive {
typedef unsigned short bf16;
__device__ __forceinline__ unsigned f2bf(float f) { unsigned u = __builtin_bit_cast(unsigned, f); return (u + 0x7fffu + ((u >> 16) & 1u)) >> 16; }
__device__ __forceinline__ float bf2f(unsigned short h) { return __builtin_bit_cast(float, (unsigned)h << 16); }
__device__ __forceinline__ float gelu_tanh(float x) { const float u = 0.7978845608028654f * (x + 0.044715f * x * x * x); return 0.5f * x * (1.f + tanhf(u)); }
__device__ __forceinline__ float sigmoidf_(float x) { return 1.f / (1.f + expf(-x)); }
__device__ __forceinline__ float wave_sum(float v) {
#pragma unroll
    for (int o = 1; o < 64; o <<= 1) v += __shfl_xor(v, o);
    return v;
}
__global__ void k_prep_w(const float* w_in, const float* w_out, const float* gn_l, const float* gn_f, const float* w_q, const float* g2, const float* sk,
                         bf16* win_t, float* wfl, bf16* wout_t, bf16* wq_t, bf16* skb) {
    const size_t gid = (size_t)blockIdx.x * blockDim.x + threadIdx.x, gsz = (size_t)gridDim.x * blockDim.x;
    for (size_t i = gid; i < (size_t)NG1 * DMODEL; i += gsz) { const int n = (int)(i / DMODEL), k = (int)(i % DMODEL); win_t[i] = (bf16)f2bf(w_in[(size_t)k * INC + n]); }
    for (size_t i = gid; i < (size_t)8 * DMODEL; i += gsz) { const int j = (int)(i / DMODEL), k = (int)(i % DMODEL); wfl[i] = w_in[(size_t)k * INC + NG1 + j]; }
    for (size_t i = gid; i < (size_t)DMODEL * DMODEL; i += gsz) { const int n = (int)(i / DMODEL), k = (int)(i % DMODEL); const float g = k < LW ? gn_l[k] : gn_f[k - LW]; wout_t[i] = (bf16)f2bf(g * w_out[(size_t)k * DMODEL + n]); }
    for (size_t i = gid; i < (size_t)QPW * DMODEL; i += gsz) { const int n = (int)(i / DMODEL), k = (int)(i % DMODEL); wq_t[i] = (bf16)f2bf(g2[k] * w_q[(size_t)k * QPW + n]); }
    for (size_t i = gid; i < (size_t)PH * 2 * NKEY * PHALF; i += gsz) skb[i] = (bf16)f2bf(sk[i]);
}
__global__ void k_prep_tab(const float* u, const float* v, const float* g2, bf16* ut, bf16* vt) {
    const size_t gid = (size_t)blockIdx.x * blockDim.x + threadIdx.x, gsz = (size_t)gridDim.x * blockDim.x;
    for (size_t i = gid; i < (size_t)NEXP * DMODEL; i += gsz) { const int d = (int)(i % DMODEL); ut[i] = (bf16)f2bf(g2[d] * u[i]); vt[i] = (bf16)f2bf(v[i]); }
}
__global__ void k_prep_x(const float* x, const float* g1, const float* wfl, const float* bfv, bf16* h, float* logf) {
    const int lane = threadIdx.x & 63, wv = (blockIdx.x * blockDim.x + threadIdx.x) >> 6, nw = (gridDim.x * blockDim.x) >> 6;
    for (int t = wv; t < T; t += nw) {
        float xv[16]; float ss = 0.f;
#pragma unroll
        for (int j = 0; j < 4; ++j) { const float4 v = *(const float4*)(x + (size_t)t * DMODEL + j * 256 + lane * 4); xv[4 * j] = v.x; xv[4 * j + 1] = v.y; xv[4 * j + 2] = v.z; xv[4 * j + 3] = v.w; ss += v.x * v.x + v.y * v.y + v.z * v.z + v.w * v.w; }
        const float rstd = rsqrtf(wave_sum(ss) * (1.f / DMODEL) + RMS_EPS);
#pragma unroll
        for (int j = 0; j < 4; ++j) { const float4 g = *(const float4*)(g1 + j * 256 + lane * 4); xv[4 * j] *= rstd * g.x; xv[4 * j + 1] *= rstd * g.y; xv[4 * j + 2] *= rstd * g.z; xv[4 * j + 3] *= rstd * g.w;
            uint2 o; o.x = f2bf(xv[4 * j]) | (f2bf(xv[4 * j + 1]) << 16); o.y = f2bf(xv[4 * j + 2]) | (f2bf(xv[4 * j + 3]) << 16); *(uint2*)(h + (size_t)t * DMODEL + j * 256 + lane * 4) = o; }
#pragma unroll
        for (int hh = 0; hh < 8; ++hh) { float a = 0.f;
#pragma unroll
            for (int j = 0; j < 4; ++j) { const float4 w = *(const float4*)(wfl + hh * DMODEL + j * 256 + lane * 4); a += xv[4 * j] * w.x + xv[4 * j + 1] * w.y + xv[4 * j + 2] * w.z + xv[4 * j + 3] * w.w; }
            a = wave_sum(a);
            if (lane == 0) { const float z = a + bfv[hh]; logf[(size_t)t * 8 + hh] = fminf(z, 0.f) - log1pf(expf(-fabsf(z))); } }
    }
}
__global__ void k_fcum(const float* logf, float* fcum) {
    const int lane = threadIdx.x & 63, bh = blockIdx.x, b = bh / NHEADS, hh = bh % NHEADS;
    float loc = 0.f;
    for (int i = 0; i < 128; ++i) loc += logf[((size_t)b * SEQ + lane * 128 + i) * 8 + hh];
    float inc = loc;
#pragma unroll
    for (int o = 1; o < 64; o <<= 1) { const float n = __shfl_up(inc, o); if (lane >= o) inc += n; }
    float run = inc - loc;
    for (int i = 0; i < 128; ++i) { run += logf[((size_t)b * SEQ + lane * 128 + i) * 8 + hh]; fcum[(size_t)bh * SEQ + lane * 128 + i] = run; }
}
struct EpiArgs { bf16* o0; bf16* o1; bf16* o2; bf16* o3; bf16* o4; const float* resid; float* outf; };
template <int EPI> __global__ void __launch_bounds__(256) k_gemm(const bf16* A, const bf16* Bt, int M, int N, int K, EpiArgs e) {
    __shared__ float As[32][65], Bs[32][65];
    const int tid = threadIdx.x, tx = tid & 15, ty = tid >> 4, m0 = blockIdx.y * 64, n0 = blockIdx.x * 64;
    float acc[4][4] = {};
    const int lr = tid >> 2, lc = (tid & 3) * 8;
    for (int k0 = 0; k0 < K; k0 += 32) {
        const uint4 av = *(const uint4*)(A + (size_t)(m0 + lr) * K + k0 + lc), bv = *(const uint4*)(Bt + (size_t)(n0 + lr) * K + k0 + lc);
        const unsigned aw[4] = {av.x, av.y, av.z, av.w}, bw[4] = {bv.x, bv.y, bv.z, bv.w};
#pragma unroll
        for (int i = 0; i < 4; ++i) { As[lc + 2 * i][lr] = bf2f(aw[i] & 0xffff); As[lc + 2 * i + 1][lr] = bf2f(aw[i] >> 16); Bs[lc + 2 * i][lr] = bf2f(bw[i] & 0xffff); Bs[lc + 2 * i + 1][lr] = bf2f(bw[i] >> 16); }
        __syncthreads();
#pragma unroll 8
        for (int k = 0; k < 32; ++k) { float a[4], b[4];
#pragma unroll
            for (int i = 0; i < 4; ++i) { a[i] = As[k][ty * 4 + i]; b[i] = Bs[k][tx * 4 + i]; }
#pragma unroll
            for (int i = 0; i < 4; ++i)
#pragma unroll
                for (int j = 0; j < 4; ++j) acc[i][j] += a[i] * b[j]; }
        __syncthreads();
    }
#pragma unroll
    for (int i = 0; i < 4; ++i)
#pragma unroll
        for (int j = 0; j < 4; ++j) { const int m = m0 + ty * 4 + i, n = n0 + tx * 4 + j; const float v = acc[i][j];
            if (EPI == 1) { const int s = n >> 9, c = n & 511; bf16* o = s == 0 ? e.o0 : s == 1 ? e.o1 : s == 2 ? e.o2 : s == 3 ? e.o3 : e.o4;
                const float w = s == 1 ? gelu_tanh(v) : s == 2 ? v * QSCALE : v; o[(size_t)m * 512 + c] = (bf16)f2bf(w); }
            else if (EPI == 2) { const float r = e.resid[(size_t)m * DMODEL + n] + v; e.outf[(size_t)m * DMODEL + n] = r; e.o0[(size_t)m * DMODEL + n] = (bf16)f2bf(r); }
            else { e.o0[(size_t)m * N + n] = (bf16)f2bf(v); } }
}
__global__ void k_sumsq(const float* x1, float* sumsq) {
    const int lane = threadIdx.x & 63, wv = (blockIdx.x * blockDim.x + threadIdx.x) >> 6, nw = (gridDim.x * blockDim.x) >> 6;
    for (int t = wv; t < T; t += nw) { float ss = 0.f;
#pragma unroll
        for (int j = 0; j < 4; ++j) { const float4 v = *(const float4*)(x1 + (size_t)t * DMODEL + j * 256 + lane * 4); ss += v.x * v.x + v.y * v.y + v.z * v.z + v.w * v.w; }
        ss = wave_sum(ss); if (lane == 0) sumsq[t] = ss; }
}
__global__ void k_lru_gates(const bf16* xr, const float* cw, const float* cb, const float* wa, const float* ba, const float* wx, const float* bx, const float* lam, float* la, float* lu) {
    __shared__ float xc[64];
    const int j = threadIdx.x, t = blockIdx.x / NHEADS, hh = blockIdx.x % NHEADS, ch = hh * 64 + j, s = t % SEQ;
    float c = cb[ch];
#pragma unroll
    for (int k = 0; k < 4; ++k) { const int ss = s - 3 + k; if (ss >= 0) c += cw[k * LW + ch] * bf2f(xr[(size_t)(t - 3 + k) * LW + ch]); }
    xc[j] = c; __syncthreads();
    float r = ba[ch], ii = bx[ch];
    for (int i = 0; i < 64; ++i) { const float xv = xc[i]; r += xv * wa[(size_t)(hh * 64 + i) * 64 + j]; ii += xv * wx[(size_t)(hh * 64 + i) * 64 + j]; }
    r = sigmoidf_(r); ii = sigmoidf_(ii);
    const float l = lam[ch], sp = fmaxf(-l, 0.f) + log1pf(expf(-fabsf(l)));
    const float log_a = -8.f * r * sp, a = expf(log_a), u = sqrtf(-expm1f(2.f * log_a)) * (ii * c);
    la[(size_t)t * LW + ch] = a; lu[(size_t)t * LW + ch] = u;
}
__global__ void k_lru_scan(const float* la, float* lu, const bf16* gr) {
    const int id = blockIdx.x * blockDim.x + threadIdx.x; if (id >= BATCH * LW) return;
    const int b = id / LW, ch = id % LW; float h = 0.f;
    for (int s = 0; s < SEQ; ++s) { const size_t o = ((size_t)b * SEQ + s) * LW + ch; h = la[o] * h + lu[o]; lu[o] = h * bf2f(gr[o]); }
}
__global__ void k_ymix(const float* ylru, const bf16* o, bf16* ymix) {
    const int lane = threadIdx.x & 63, wv = (blockIdx.x * blockDim.x + threadIdx.x) >> 6, nw = (gridDim.x * blockDim.x) >> 6;
    for (int t = wv; t < T; t += nw) {
        float a[8], f[8]; float sa = 0.f, sf = 0.f;
#pragma unroll
        for (int i = 0; i < 8; ++i) { a[i] = ylru[(size_t)t * LW + i * 64 + lane]; f[i] = bf2f(o[(size_t)t * AW + i * 64 + lane]); sa += a[i] * a[i]; sf += f[i] * f[i]; }
        const float ra = rsqrtf(wave_sum(sa) * (1.f / LW) + RMS_EPS), rf = rsqrtf(wave_sum(sf) * (1.f / AW) + RMS_EPS);
#pragma unroll
        for (int i = 0; i < 8; ++i) { ymix[(size_t)t * DMODEL + i * 64 + lane] = (bf16)f2bf(a[i] * ra); ymix[(size_t)t * DMODEL + LW + i * 64 + lane] = (bf16)f2bf(f[i] * rf); }
    }
}
__global__ void __launch_bounds__(256) k_attn(const bf16* Q, const bf16* K, const bf16* V, const float* fcum, bf16* O) {
    const int lane = threadIdx.x & 63, wv = (blockIdx.x * blockDim.x + threadIdx.x) >> 6;
    const int q = wv % SEQ, bh = wv / SEQ, b = bh / NHEADS, hh = bh % NHEADS;
    const size_t rowq = (size_t)b * SEQ + q;
    float qv[64];
#pragma unroll
    for (int i = 0; i < 8; ++i) { const uint4 w = *(const uint4*)(Q + rowq * AW + hh * 64 + i * 8); const unsigned ww[4] = {w.x, w.y, w.z, w.w};
#pragma unroll
        for (int c = 0; c < 4; ++c) { qv[i * 8 + 2 * c] = bf2f(ww[c] & 0xffff); qv[i * 8 + 2 * c + 1] = bf2f(ww[c] >> 16); } }
    const float fq = fcum[(size_t)bh * SEQ + q];
    float m = -INFINITY, l = 0.f; float o[64];
#pragma unroll
    for (int d = 0; d < 64; ++d) o[d] = 0.f;
    for (int j = lane; j <= q; j += 64) {
        const size_t rowk = (size_t)b * SEQ + j; float s = 0.f;
#pragma unroll
        for (int i = 0; i < 8; ++i) { const uint4 w = *(const uint4*)(K + rowk * AW + hh * 64 + i * 8); const unsigned ww[4] = {w.x, w.y, w.z, w.w};
#pragma unroll
            for (int c = 0; c < 4; ++c) { s += qv[i * 8 + 2 * c] * bf2f(ww[c] & 0xffff) + qv[i * 8 + 2 * c + 1] * bf2f(ww[c] >> 16); } }
        s += (fq - fcum[(size_t)bh * SEQ + j]) * LOG2E;
        const float mn = fmaxf(m, s), sc = exp2f(m - mn), p = exp2f(s - mn);
        l = l * sc + p; m = mn;
#pragma unroll
        for (int i = 0; i < 8; ++i) { const uint4 w = *(const uint4*)(V + rowk * AW + hh * 64 + i * 8); const unsigned ww[4] = {w.x, w.y, w.z, w.w};
#pragma unroll
            for (int c = 0; c < 4; ++c) { o[i * 8 + 2 * c] = o[i * 8 + 2 * c] * sc + p * bf2f(ww[c] & 0xffff); o[i * 8 + 2 * c + 1] = o[i * 8 + 2 * c + 1] * sc + p * bf2f(ww[c] >> 16); } }
    }
    float mall = m;
#pragma unroll
    for (int of = 1; of < 64; of <<= 1) mall = fmaxf(mall, __shfl_xor(mall, of));
    const float sc = (m == -INFINITY) ? 0.f : exp2f(m - mall);
    const float lt = wave_sum(l * sc); const float inv = 1.f / lt;
    float mine = 0.f;
#pragma unroll
    for (int d = 0; d < 64; ++d) { const float v = wave_sum(o[d] * sc); if (lane == d) mine = v; }
    O[rowq * AW + hh * 64 + lane] = (bf16)f2bf(mine * inv);
}
__device__ __forceinline__ void wave_argmax(float v, int idx, float& bv, int& bi) {
#pragma unroll
    for (int o = 1; o < 64; o <<= 1) { const float ov = __shfl_xor(v, o); const int oi = __shfl_xor(idx, o); if (ov > v || (ov == v && oi < idx)) { v = ov; idx = oi; } }
    bv = v; bi = idx;
}
__global__ void __launch_bounds__(64) k_peer(const bf16* qp, const bf16* skb, const float* sumsq, const bf16* ut, const bf16* vt, const float* fg, float* out) {
    __shared__ float qs[2048]; __shared__ float sc[256]; __shared__ float s1[16], s2[16]; __shared__ int i1[16], i2[16]; __shared__ int ex[128]; __shared__ float gt[128];
    const int lane = threadIdx.x, t = blockIdx.x;
    const float rstd2 = rsqrtf(sumsq[t] * (1.f / DMODEL) + RMS_EPS);
    for (int i = lane; i < 2048; i += 64) qs[i] = bf2f(qp[(size_t)t * 2048 + i]) * rstd2;
    __syncthreads();
    for (int hh = 0; hh < PH; ++hh) {
        for (int r = 0; r < 4; ++r) { const int idx = r * 64 + lane, p = idx >> 7, n = idx & 127; const bf16* kr = skb + ((size_t)(hh * 2 + p) * NKEY + n) * PHALF; const float* qq = qs + hh * 256 + p * 128;
            float a = 0.f; for (int c = 0; c < 128; ++c) a += qq[c] * bf2f(kr[c]); sc[idx] = a; }
        __syncthreads();
        for (int p = 0; p < 2; ++p) {
            float v0 = sc[p * 128 + lane], v1 = sc[p * 128 + 64 + lane];
            for (int k = 0; k < 16; ++k) { float v; int id; if (v0 >= v1) { v = v0; id = lane; } else { v = v1; id = lane + 64; }
                float bv; int bi; wave_argmax(v, id, bv, bi);
                if (lane == 0) { if (p == 0) { s1[k] = bv; i1[k] = bi; } else { s2[k] = bv; i2[k] = bi; } }
                if (bi == lane) v0 = -INFINITY; if (bi == lane + 64) v1 = -INFINITY; }
        }
        __syncthreads();
        float cv[4];
#pragma unroll
        for (int r = 0; r < 4; ++r) { const int idx = r * 64 + lane; cv[r] = s1[idx >> 4] + s2[idx & 15]; }
        float tops = 0.f; int topp = 0;
        for (int k = 0; k < 16; ++k) { float v = cv[0]; int id = lane;
#pragma unroll
            for (int r = 1; r < 4; ++r) if (cv[r] > v) { v = cv[r]; id = r * 64 + lane; }
            float bv; int bi; wave_argmax(v, id, bv, bi);
            if (lane == k) { tops = bv; topp = bi; }
#pragma unroll
            for (int r = 0; r < 4; ++r) if (bi == r * 64 + lane) cv[r] = -INFINITY; }
        float mx = lane < 16 ? tops : -INFINITY;
#pragma unroll
        for (int o = 1; o < 64; o <<= 1) mx = fmaxf(mx, __shfl_xor(mx, o));
        const float ev = lane < 16 ? expf(tops - mx) : 0.f; const float den = wave_sum(ev);
        if (lane < 16) { ex[hh * 16 + lane] = i1[topp >> 4] * NKEY + i2[topp & 15]; gt[hh * 16 + lane] = ev / den; }
        __syncthreads();
    }
    float hv[16], y[16];
    const float* x1 = out + (size_t)t * DMODEL;
#pragma unroll
    for (int j = 0; j < 4; ++j) { const float4 v = *(const float4*)(x1 + j * 256 + lane * 4); hv[4 * j] = v.x * rstd2; hv[4 * j + 1] = v.y * rstd2; hv[4 * j + 2] = v.z * rstd2; hv[4 * j + 3] = v.w * rstd2; }
#pragma unroll
    for (int i = 0; i < 16; ++i) y[i] = 0.f;
    for (int k = 0; k < 128; ++k) { const int e = ex[k]; const float g = gt[k]; float a = 0.f;
#pragma unroll
        for (int j = 0; j < 4; ++j) { const uint2 w = *(const uint2*)(ut + (size_t)e * DMODEL + j * 256 + lane * 4);
            a += hv[4 * j] * bf2f(w.x & 0xffff) + hv[4 * j + 1] * bf2f(w.x >> 16) + hv[4 * j + 2] * bf2f(w.y & 0xffff) + hv[4 * j + 3] * bf2f(w.y >> 16); }
        a = wave_sum(a); const float act = gelu_tanh(a) * g;
#pragma unroll
        for (int j = 0; j < 4; ++j) { const uint2 w = *(const uint2*)(vt + (size_t)e * DMODEL + j * 256 + lane * 4);
            y[4 * j] += act * bf2f(w.x & 0xffff); y[4 * j + 1] += act * bf2f(w.x >> 16); y[4 * j + 2] += act * bf2f(w.y & 0xffff); y[4 * j + 3] += act * bf2f(w.y >> 16); } }
    float ss = 0.f;
#pragma unroll
    for (int j = 0; j < 4; ++j) { const float4 v = *(const float4*)(x1 + j * 256 + lane * 4); y[4 * j] += v.x; y[4 * j + 1] += v.y; y[4 * j + 2] += v.z; y[4 * j + 3] += v.w; }
#pragma unroll
    for (int i = 0; i < 16; ++i) ss += y[i] * y[i];
    const float rs = rsqrtf(wave_sum(ss) * (1.f / DMODEL) + RMS_EPS);
#pragma unroll
    for (int j = 0; j < 4; ++j) { const float4 g = *(const float4*)(fg + j * 256 + lane * 4); float4 o; o.x = y[4 * j] * rs * g.x; o.y = y[4 * j + 1] * rs * g.y; o.z = y[4 * j + 2] * rs * g.z; o.w = y[4 * j + 3] * rs * g.w;
        *(float4*)(out + (size_t)t * DMODEL + j * 256 + lane * 4) = o; }
}
}

namespace pg8 {
#define PG8_LAS __attribute__((address_space(3)))
typedef unsigned short bf16_t;
typedef short bf16x8 __attribute__((ext_vector_type(8)));
typedef float f32x4 __attribute__((ext_vector_type(4)));
typedef unsigned u32x4 __attribute__((ext_vector_type(4)));
constexpr int BM = 256, BK = 64, HALF = 128, HTB = HALF * BK * 2  , STAGE_BYTES = 8 * HTB, NXCD = 8, WGM = 8;

__host__ __device__ __forceinline__ int lds_byte(int r, int c) { const int st = (r >> 4) * 2 + (c >> 5), rr = r & 15, cc = c & 31, ob = rr * 64 + cc * 2; return st * 1024 + (ob ^ (((ob >> 9) & 1) << 5)); }
__host__ __device__ __forceinline__ void stage_rc(int b, int& R, int& C) { const int st = b / 1024, sb = b % 1024, swz = sb ^ (((sb >> 9) & 1) << 5); R = (st >> 1) * 16 + swz / 64; C = (st & 1) * 32 + (swz % 64) / 2; }
__host__ __device__ __forceinline__ int perm32(int rho) { const int n = rho >> 4, i = rho & 15; return 8 * (i >> 2) + 4 * n + (i & 3); }

struct Unit { int pm, pn; };
struct Gemm { const bf16_t* A; const bf16_t* Bt; int M, N, K; };

struct StaticOrder {
    int nM, nN, nwg, G, c;
    __host__ __device__ void init(int M, int N, int G_, int c_) { nM = M / BM; nN = N / BM; nwg = nM * nN; G = G_; c = c_; }
    __host__ __device__ bool next(int i, Unit& u) const {
        const long L = (long)i * G + c; if (L >= nwg) return false;
        int wgid = (int)L; { const int q = nwg / NXCD, r = nwg % NXCD, xcd = wgid % NXCD, off = wgid / NXCD; wgid = (xcd < r ? xcd * (q + 1) : r * (q + 1) + (xcd - r) * q) + off; }
        const int nig = WGM * nN, gid = wgid / nig, fm = gid * WGM, gsz = (nM - fm) < WGM ? (nM - fm) : WGM;
        u.pm = fm + ((wgid % nig) % gsz); u.pn = (wgid % nig) / gsz; return true;
    }
    __device__ __forceinline__ void a_ready(const Unit&) const {}
    __device__ __forceinline__ void done(const Unit&) const {}
};

__device__ __forceinline__ unsigned cvt_pk_bf16(float lo, float hi) { unsigned r; asm volatile("v_cvt_pk_bf16_f32 %0, %1, %2" : "=v"(r) : "v"(lo), "v"(hi)); return r; }
typedef unsigned u32x2 __attribute__((ext_vector_type(2)));
__device__ __forceinline__ float gelu_fast(float x) {
    const float u2 = x * (1.5957691216057308f + 0.07135481627f * x * x);
    return x * __builtin_amdgcn_rcpf(1.f + __builtin_amdgcn_exp2f(-1.4426950408889634f * u2));
}
struct EpiG1 {
    static constexpr bool PERM = true, AFTER_DRAIN = false;
    bf16_t* base0; size_t split_stride; float qscale;
    __device__ __forceinline__ void operator()(const f32x4 (&acc)[2][2][4][2], const Unit& u, int wr, int wc, int fr, int fq) const {
        const int s = u.pn >> 1; bf16_t* base = base0 + (size_t)s * split_stride;
        const int row0 = u.pm * BM + wr * 64 + fr, col0 = (u.pn & 1) * 256 + wc * 32 + 8 * fq;
#pragma unroll
        for (int ai = 0; ai < 2; ++ai)
#pragma unroll
            for (int m = 0; m < 4; ++m) { bf16_t* rowp = base + (size_t)(row0 + ai * HALF + m * 16) * 512 + col0;
#pragma unroll
                for (int bj = 0; bj < 2; ++bj) { f32x4 v0 = acc[ai][bj][m][0], v1 = acc[ai][bj][m][1];
                    if (s == 1) {
#pragma unroll
                        for (int e = 0; e < 4; ++e) { v0[e] = gelu_fast(v0[e]); v1[e] = gelu_fast(v1[e]); } }
                    else if (s == 2) { v0 = v0 * qscale; v1 = v1 * qscale; }
                    u32x4 w; w.x = cvt_pk_bf16(v0[0], v0[1]); w.y = cvt_pk_bf16(v0[2], v0[3]); w.z = cvt_pk_bf16(v1[0], v1[1]); w.w = cvt_pk_bf16(v1[2], v1[3]);
                    *(u32x4*)(rowp + bj * HALF) = w; } }
    }
};
struct EpiG2 {
    static constexpr bool PERM = false, AFTER_DRAIN = false;
    const float* resid; float* out; bf16_t* xb; float* sumsq; int ldc;
    __device__ __forceinline__ void operator()(const f32x4 (&acc)[2][2][4][2], const Unit& u, int wr, int wc, int fr, int fq) const {
        const int row0 = u.pm * BM + wr * 64 + fr, col0 = u.pn * BM + wc * 32 + 4 * fq;
#pragma unroll
        for (int ai = 0; ai < 2; ++ai) {
            f32x4 rs[4][2][2];
#pragma unroll
            for (int m = 0; m < 4; ++m) { const size_t off = (size_t)(row0 + ai * HALF + m * 16) * ldc + col0;
#pragma unroll
                for (int bj = 0; bj < 2; ++bj)
#pragma unroll
                    for (int n = 0; n < 2; ++n) rs[m][bj][n] = *(const f32x4*)(resid + off + bj * HALF + n * 16); }
#pragma unroll
            for (int m = 0; m < 4; ++m) { const int r = row0 + ai * HALF + m * 16; const size_t off = (size_t)r * ldc + col0; float ss = 0.f;
#pragma unroll
                for (int bj = 0; bj < 2; ++bj)
#pragma unroll
                    for (int n = 0; n < 2; ++n) { const f32x4 x = rs[m][bj][n] + acc[ai][bj][m][n];
                        *(f32x4*)(out + off + bj * HALF + n * 16) = x; ss += (x[0] * x[0] + x[1] * x[1]) + (x[2] * x[2] + x[3] * x[3]);
                        u32x2 w; w.x = cvt_pk_bf16(x[0], x[1]); w.y = cvt_pk_bf16(x[2], x[3]); *(u32x2*)(xb + off + bj * HALF + n * 16) = w; }
                ss += __shfl_xor(ss, 16); ss += __shfl_xor(ss, 32);
                if (fq == 0) atomicAdd(sumsq + r, ss); }
            asm volatile("" ::: "memory"); }
    }
};
struct EpiG3 {
    static constexpr bool PERM = true, AFTER_DRAIN = false;
    bf16_t* O; int ldc;
    __device__ __forceinline__ void operator()(const f32x4 (&acc)[2][2][4][2], const Unit& u, int wr, int wc, int fr, int fq) const {
        const int row0 = u.pm * BM + wr * 64 + fr, col0 = u.pn * BM + wc * 32 + 8 * fq;
#pragma unroll
        for (int ai = 0; ai < 2; ++ai)
#pragma unroll
            for (int m = 0; m < 4; ++m) { bf16_t* rowp = O + (size_t)(row0 + ai * HALF + m * 16) * ldc + col0;
#pragma unroll
                for (int bj = 0; bj < 2; ++bj) { const f32x4 v0 = acc[ai][bj][m][0], v1 = acc[ai][bj][m][1];
                    u32x4 w; w.x = cvt_pk_bf16(v0[0], v0[1]); w.y = cvt_pk_bf16(v0[2], v0[3]); w.z = cvt_pk_bf16(v1[0], v1[1]); w.w = cvt_pk_bf16(v1[2], v1[3]);
                    *(u32x4*)(rowp + bj * HALF) = w; } }
    }
};

template <class Epi, class Sched, bool ALIGN_EPI = false, bool SP2 = false>
__device__ __forceinline__ void gemm_phase(PG8_LAS unsigned char* lds, const Gemm g, const Sched& S, const Epi& E, int wid_in) {
    const int wid = __builtin_amdgcn_readfirstlane(wid_in), lane = (int)__builtin_amdgcn_mbcnt_hi(~0u, __builtin_amdgcn_mbcnt_lo(~0u, 0u)), tid = wid * 64 + lane, wr = wid >> 2, wc = wid & 3, fr = lane & 15, fq = lane >> 4;
    const int K = g.K, nt = K / BK;
    unsigned voffA[2], voffB[2];
#pragma unroll
    for (int i = 0; i < 2; ++i) { int R, C; stage_rc(tid * 16 + i * 8192, R, C); const int Rb = Epi::PERM ? ((R & ~31) + perm32(R & 31)) : R;
        voffA[i] = (unsigned)(R * K + C) * 2u; voffB[i] = (unsigned)(Rb * K + C) * 2u; }
    const size_t kstep = (size_t)(BK * 2);
    const size_t hstep = (size_t)HALF * K * 2;
    const size_t tstep = 2 * hstep;
    const unsigned ldsw = (unsigned)wid * 1024u;
    const int aoff = lds_byte(wr * 64 + fr, fq * 8), boff = lds_byte(wc * 32 + fr, fq * 8);
#define PG8_SA(b, h) (((b) * 2 + (h)) * HTB)
#define PG8_SB(b, h) ((4 + (b) * 2 + (h)) * HTB)
#define PG8_STAGE(bufoff, gbase, voff) do { _Pragma("unroll") for (int _i = 0; _i < 2; ++_i) \
        __builtin_amdgcn_global_load_lds((const unsigned*)((const char*)(gbase) + (voff)[_i]), (PG8_LAS unsigned*)(lds + (bufoff) + ldsw + _i * 8192), 16, 0, 0); } while (0)
#define PG8_LDA(dst, b, h) do { _Pragma("unroll") for (int m = 0; m < 4; ++m) _Pragma("unroll") for (int k = 0; k < 2; ++k) dst[m][k] = *(const PG8_LAS bf16x8*)(lds + PG8_SA(b, h) + aoff + m * 2048 + k * 1024); } while (0)
#define PG8_LDB(dst, b, h) do { _Pragma("unroll") for (int n = 0; n < 2; ++n) _Pragma("unroll") for (int k = 0; k < 2; ++k) dst[n][k] = *(const PG8_LAS bf16x8*)(lds + PG8_SB(b, h) + boff + n * 2048 + k * 1024); } while (0)
#define PG8_MMA(ai, bj, At, Bt) do { __builtin_amdgcn_s_setprio(1); _Pragma("unroll") for (int m = 0; m < 4; ++m) _Pragma("unroll") for (int n = 0; n < 2; ++n) _Pragma("unroll") for (int k = 0; k < 2; ++k) \
        acc[ai][bj][m][n] = __builtin_amdgcn_mfma_f32_16x16x32_bf16(Bt[n][k], At[m][k], acc[ai][bj][m][n], 0, 0, 0); __builtin_amdgcn_s_setprio(0); } while (0)
#define PG8_WAIT_V(n) asm volatile("s_waitcnt vmcnt(" #n ")" ::: "memory")
#define PG8_WAIT_L(n) asm volatile("s_waitcnt lgkmcnt(" #n ")" ::: "memory")
#define PG8_BAR __builtin_amdgcn_s_barrier()
#define PG8_SCHED __builtin_amdgcn_sched_barrier(0)
    Unit cur, nxt; int ui = 0;
    if (!S.next(0, cur)) return;
    f32x4 acc[2][2][4][2];
#pragma unroll
    for (int a = 0; a < 2; ++a)
#pragma unroll
        for (int b = 0; b < 2; ++b)
#pragma unroll
            for (int m = 0; m < 4; ++m)
#pragma unroll
                for (int n = 0; n < 2; ++n) acc[a][b][m][n] = (f32x4){0.f, 0.f, 0.f, 0.f};
    bf16x8 At[4][2], B0[2][2], B1[2][2];
    const char* cA = (const char*)g.A + (size_t)cur.pm * tstep; const char* cB = (const char*)g.Bt + (size_t)cur.pn * tstep;
    S.a_ready(cur);
    if constexpr (SP2) {
        PG8_STAGE(PG8_SB(0, 0), cB, voffB); PG8_STAGE(PG8_SB(0, 1), cB + hstep, voffB); PG8_STAGE(PG8_SA(0, 0), cA, voffA); PG8_STAGE(PG8_SA(0, 1), cA + hstep, voffA);
        if (wr == 1) PG8_BAR;
        PG8_WAIT_V(2); PG8_BAR;
        PG8_STAGE(PG8_SB(1, 0), cB + kstep, voffB); PG8_STAGE(PG8_SA(1, 0), cA + kstep, voffA); PG8_STAGE(PG8_SB(1, 1), cB + hstep + kstep, voffB);
        PG8_WAIT_V(6); PG8_BAR;
    } else {
        PG8_STAGE(PG8_SB(0, 0), cB, voffB); PG8_STAGE(PG8_SA(0, 0), cA, voffA); PG8_STAGE(PG8_SB(0, 1), cB + hstep, voffB); PG8_STAGE(PG8_SA(0, 1), cA + hstep, voffA);
        if (wr == 1) PG8_BAR;
        PG8_WAIT_V(4); PG8_BAR;
        PG8_STAGE(PG8_SB(1, 0), cB + kstep, voffB); PG8_STAGE(PG8_SA(1, 0), cA + kstep, voffA); PG8_STAGE(PG8_SB(1, 1), cB + hstep + kstep, voffB);
        PG8_WAIT_V(6); PG8_BAR;
    }
    for (;;) {
        const bool has_next = S.next(ui + 1, nxt);
        const char* nA = has_next ? (const char*)g.A + (size_t)nxt.pm * tstep : cA; const char* nB = has_next ? (const char*)g.Bt + (size_t)nxt.pn * tstep : cB;
        for (int t = 0; t < nt; t += 2) {
            const bool last = (t == nt - 2);
            const char* a1 = cA + (size_t)(t + 1) * kstep;
            const char* a2 = last ? nA : cA + (size_t)(t + 2) * kstep; const char* b2 = last ? nB : cB + (size_t)(t + 2) * kstep;
            const char* a3 = a2 + kstep; const char* b3 = b2 + kstep;
            if (last && has_next) S.a_ready(nxt);
            if constexpr (SP2) {
            PG8_LDB(B0, 0, 0); PG8_LDB(B1, 0, 1); PG8_SCHED; PG8_LDA(At, 0, 0); PG8_STAGE(PG8_SA(1, 1), a1 + hstep, voffA);
            PG8_WAIT_V(8); PG8_WAIT_L(0); PG8_BAR; PG8_MMA(0, 0, At, B0); PG8_MMA(0, 1, At, B1); PG8_BAR; PG8_SCHED;
            PG8_LDA(At, 0, 1); PG8_STAGE(PG8_SB(0, 0), b2, voffB); PG8_STAGE(PG8_SB(0, 1), b2 + hstep, voffB); PG8_STAGE(PG8_SA(0, 0), a2, voffA);
            PG8_WAIT_V(8); PG8_WAIT_L(0); PG8_BAR; PG8_MMA(1, 0, At, B0); PG8_MMA(1, 1, At, B1); PG8_BAR; PG8_SCHED;
            PG8_LDB(B0, 1, 0); PG8_LDB(B1, 1, 1); PG8_SCHED; PG8_LDA(At, 1, 0); PG8_STAGE(PG8_SA(0, 1), a2 + hstep, voffA);
            PG8_WAIT_V(8); PG8_WAIT_L(0); PG8_BAR; PG8_MMA(0, 0, At, B0); PG8_MMA(0, 1, At, B1); PG8_BAR; PG8_SCHED;
            PG8_LDA(At, 1, 1); PG8_STAGE(PG8_SB(1, 0), b3, voffB); PG8_STAGE(PG8_SB(1, 1), b3 + hstep, voffB); PG8_STAGE(PG8_SA(1, 0), a3, voffA);
            PG8_WAIT_V(8); PG8_WAIT_L(0); PG8_BAR; PG8_MMA(1, 0, At, B0); PG8_MMA(1, 1, At, B1); PG8_BAR; PG8_SCHED;
            } else {
            PG8_LDB(B0, 0, 0); PG8_SCHED; PG8_LDA(At, 0, 0); PG8_STAGE(PG8_SA(1, 1), a1 + hstep, voffA);
            PG8_WAIT_L(8); PG8_BAR; PG8_WAIT_L(0); PG8_MMA(0, 0, At, B0); PG8_BAR; PG8_SCHED;
            PG8_LDB(B1, 0, 1); PG8_STAGE(PG8_SB(0, 0), b2, voffB);
            PG8_BAR; PG8_WAIT_L(0); PG8_MMA(0, 1, At, B1); PG8_BAR;
            PG8_LDA(At, 0, 1); PG8_STAGE(PG8_SA(0, 0), a2, voffA);
            PG8_BAR; PG8_WAIT_L(0); PG8_MMA(1, 0, At, B0); PG8_BAR; PG8_SCHED;
            PG8_STAGE(PG8_SB(0, 1), b2 + hstep, voffB);
            PG8_WAIT_V(6); PG8_BAR; PG8_MMA(1, 1, At, B1); PG8_BAR;
            PG8_LDB(B0, 1, 0); PG8_SCHED; PG8_LDA(At, 1, 0); PG8_STAGE(PG8_SA(0, 1), a2 + hstep, voffA);
            PG8_WAIT_L(8); PG8_BAR; PG8_WAIT_L(0); PG8_MMA(0, 0, At, B0); PG8_BAR; PG8_SCHED;
            PG8_LDB(B1, 1, 1); PG8_STAGE(PG8_SB(1, 0), b3, voffB);
            PG8_BAR; PG8_WAIT_L(0); PG8_MMA(0, 1, At, B1); PG8_BAR;
            PG8_LDA(At, 1, 1); PG8_STAGE(PG8_SA(1, 0), a3, voffA);
            PG8_BAR; PG8_WAIT_L(0); PG8_MMA(1, 0, At, B0); PG8_BAR; PG8_SCHED;
            PG8_STAGE(PG8_SB(1, 1), b3 + hstep, voffB);
            PG8_WAIT_V(6); PG8_BAR; PG8_MMA(1, 1, At, B1); PG8_BAR;
            }
        }
        if constexpr (ALIGN_EPI) { if (wr == 0) PG8_BAR; }
        if constexpr (!Epi::AFTER_DRAIN) { E(acc, cur, wr, wc, fr, fq); S.done(cur); }
        if (!has_next) break;
#pragma unroll
        for (int a = 0; a < 2; ++a)
#pragma unroll
            for (int b = 0; b < 2; ++b)
#pragma unroll
                for (int m = 0; m < 4; ++m)
#pragma unroll
                    for (int n = 0; n < 2; ++n) acc[a][b][m][n] = (f32x4){0.f, 0.f, 0.f, 0.f};
        cur = nxt; cA = nA; cB = nB; ++ui;
        if constexpr (ALIGN_EPI) { if (wr == 1) PG8_BAR; }
    }
    PG8_WAIT_V(0);
    if constexpr (!ALIGN_EPI) { if (wr == 0) PG8_BAR; }
    PG8_BAR;
    if constexpr (Epi::AFTER_DRAIN) { E.fused(acc, cur, wr, wc, fr, fq, lds, wid, lane); S.done(cur); }
#undef PG8_SA
#undef PG8_SB
#undef PG8_STAGE
#undef PG8_LDA
#undef PG8_LDB
#undef PG8_MMA
#undef PG8_WAIT_V
#undef PG8_WAIT_L
#undef PG8_BAR
#undef PG8_SCHED
}
}
#include <hip/hip_bf16.h>
#include <cmath>
namespace attn_body {
using bf16=__hip_bfloat16;
using bf16x8=__attribute__((ext_vector_type(8)))short;
using s16x4=__attribute__((ext_vector_type(4)))short;
using f32x16=__attribute__((ext_vector_type(16)))float;
using u32x4=__attribute__((ext_vector_type(4)))unsigned;
constexpr int BATCH=4,NHEAD=8,SEQ=8192,D=64,DM=NHEAD*D;
constexpr int NW=8,QBLK=32,QB=QBLK*NW,KVBLK=64,NQB=SEQ/QB;
constexpr int ATTN_PITCH=DM, ATTN_UNIT_ROWS=QB;
__device__ __forceinline__ int crow(int r,int hi){return (r&3)+8*(r>>2)+4*hi;}
#define SBAR() __builtin_amdgcn_sched_barrier(0)
__device__ __forceinline__ void cmask(f32x16&p0,f32x16&p1,int jb,int qrel,int hi){
  const float NEG=-INFINITY; int kb=64*jb+4*hi;
  #pragma unroll
  for(int r=0;r<16;++r){int kv=kb+(r&3)+8*(r>>2); if(kv>qrel)p0[r]=NEG; if(kv+32>qrel)p1[r]=NEG;}
}

constexpr int NSLOT=3, SLOTB=8192;
constexpr int LDS_K=0, LDS_V=NSLOT*SLOTB, LDS_WS=2*NSLOT*SLOTB, LDS_OST=LDS_WS+NW*64*4, LDS_FK=LDS_OST+NW*4096, LDS_BYTES=LDS_FK+SEQ*4;
constexpr float C2=0.125f*1.4426950408889634f;
__device__ __forceinline__ void glds16(const void*gsrc,unsigned lds_dst){unsigned keep;
  asm volatile("s_mov_b32 %0, m0\n\ts_mov_b32 m0, %2\n\ts_nop 0\n\tglobal_load_lds_dwordx4 %1, off\n\ts_mov_b32 m0, %0":"=&s"(keep):"v"(gsrc),"s"(lds_dst):"memory");}
__device__ __forceinline__ float max3f(float a,float b,float c){float r;asm("v_max3_f32 %0, %1, %2, %3":"=v"(r):"v"(a),"v"(b),"v"(c));return r;}
__device__ __forceinline__ float max2f(float a,float b){float r;asm("v_max_f32_e32 %0, %1, %2":"=v"(r):"v"(a),"v"(b));return r;}
__device__ __forceinline__ float fadd_s(float a,float b){float r;asm("v_add_f32_e32 %0, %1, %2":"=v"(r):"v"(a),"v"(b));return r;}
__device__ __forceinline__ float fsub_s(float a,float b){float r;asm("v_sub_f32_e32 %0, %1, %2":"=v"(r):"v"(a),"v"(b));return r;}
typedef float f32x2_t __attribute__((ext_vector_type(2))); typedef __bf16 bf16x2_t __attribute__((ext_vector_type(2)));
__device__ __forceinline__ unsigned cvtpk_s(float lo,float hi){f32x2_t v={lo,hi};bf16x2_t b=__builtin_convertvector(v,bf16x2_t);return __builtin_bit_cast(unsigned,b);}
#define WAIT_BAR(N) asm volatile("s_waitcnt vmcnt(" #N ") lgkmcnt(0)\n\ts_barrier":::"memory")

__device__ __forceinline__ void qkt(f32x16&p0,f32x16&p1,const char*Kslot,const bf16x8*qr,int r32,int hi){
  const char*kb=Kslot+hi*1024+r32*16;
  #pragma unroll
  for(int d0=0;d0<4;++d0){
    const bf16x8 b0=*reinterpret_cast<const bf16x8*>(kb+d0*2048);
    const bf16x8 b1=*reinterpret_cast<const bf16x8*>(kb+d0*2048+512);
    p0=__builtin_amdgcn_mfma_f32_32x32x16_bf16(b0,qr[d0],p0,0,0,0);p1=__builtin_amdgcn_mfma_f32_32x32x16_bf16(b1,qr[d0],p1,0,0,0);}
}
typedef __attribute__((address_space(3))) const char* lds_cptr;
typedef short v4i16_t __attribute__((ext_vector_type(4)));
__device__ __forceinline__ void kload8(bf16x8*kf,lds_cptr kp){
  kf[0]=*(const __attribute__((address_space(3))) bf16x8*)(kp);      kf[1]=*(const __attribute__((address_space(3))) bf16x8*)(kp+512);
  kf[2]=*(const __attribute__((address_space(3))) bf16x8*)(kp+2048); kf[3]=*(const __attribute__((address_space(3))) bf16x8*)(kp+2560);
  kf[4]=*(const __attribute__((address_space(3))) bf16x8*)(kp+4096); kf[5]=*(const __attribute__((address_space(3))) bf16x8*)(kp+4608);
  kf[6]=*(const __attribute__((address_space(3))) bf16x8*)(kp+6144); kf[7]=*(const __attribute__((address_space(3))) bf16x8*)(kp+6656);
}
__device__ __forceinline__ void kload2(bf16x8*kf,lds_cptr kp,int j){ kf[2*j]=*(const __attribute__((address_space(3))) bf16x8*)(kp+j*2048); kf[2*j+1]=*(const __attribute__((address_space(3))) bf16x8*)(kp+j*2048+512); }
__device__ __forceinline__ s16x4 vtr(lds_cptr p){ return __builtin_bit_cast(s16x4,__builtin_amdgcn_ds_read_tr16_b64_v4i16((__attribute__((address_space(3))) v4i16_t*)p)); }
__device__ __forceinline__ float rowmax(const f32x16&p0,const f32x16&p1){
  float a=max3f(p0[0],p0[1],p1[0]),b=max3f(p0[2],p0[3],p1[1]);a=max3f(a,p1[2],p1[3]);
  #pragma unroll
  for(int r=4;r<16;r+=4){a=max3f(a,p0[r],p0[r+1]);b=max3f(b,p0[r+2],p0[r+3]);a=max3f(a,p1[r],p1[r+1]);b=max3f(b,p1[r+2],p1[r+3]);}
  const float m=max2f(a,b);
  auto rr=__builtin_amdgcn_permlane32_swap(__float_as_uint(m),__float_as_uint(m),false,false);
  return max2f(__uint_as_float(rr[0]),__uint_as_float(rr[1]));
}
__device__ __forceinline__ void pv(f32x16*o,int vb,bf16x8 pa0,bf16x8 pa1,bf16x8 pa2,bf16x8 pa3){
  #pragma unroll
  for(int d0=0;d0<2;++d0){s16x4 lo[4],hi[4];
    #pragma unroll
    for(int ks=0;ks<4;++ks){
      asm volatile("ds_read_b64_tr_b16 %0,%1 offset:%c2":"=&v"(lo[ks]):"v"(vb),"i"(d0*4096+ks*1024):"memory");
      asm volatile("ds_read_b64_tr_b16 %0,%1 offset:%c2":"=&v"(hi[ks]):"v"(vb),"i"(d0*4096+ks*1024+512):"memory");}
    asm volatile("s_waitcnt lgkmcnt(0)":::"memory");SBAR();
    #define PK(k) (bf16x8){lo[k][0],lo[k][1],lo[k][2],lo[k][3],hi[k][0],hi[k][1],hi[k][2],hi[k][3]}
    o[d0]=__builtin_amdgcn_mfma_f32_32x32x16_bf16(pa0,PK(0),o[d0],0,0,0);
    o[d0]=__builtin_amdgcn_mfma_f32_32x32x16_bf16(pa1,PK(1),o[d0],0,0,0);
    o[d0]=__builtin_amdgcn_mfma_f32_32x32x16_bf16(pa2,PK(2),o[d0],0,0,0);
    o[d0]=__builtin_amdgcn_mfma_f32_32x32x16_bf16(pa3,PK(3),o[d0],0,0,0);
    #undef PK
  }
}

#ifndef ATTN_STORE16
#define ATTN_STORE16(p,v) (*(u32x4*)(p)=(v))
#endif
template<int THRL> __device__ __forceinline__ void attn_unit(int b,int h,int qb,const bf16*Q,const bf16*__restrict__ K,const bf16*__restrict__ V,bf16*O,const float*__restrict__ Fc,const float*__restrict__ NRM,char*shm,int wid_in){
  const int wid=__builtin_amdgcn_readfirstlane(wid_in); int lane_=(int)__builtin_amdgcn_mbcnt_hi(~0u,__builtin_amdgcn_mbcnt_lo(~0u,0u)); asm volatile("":"+v"(lane_));
  const int lane=lane_,tid=wid*64+lane,r32=lane&31,hi=lane>>5;
  const long rowbase=(long)b*SEQ; const int q0=qb*QB;
  const float*Fbh=Fc+(long)(b*NHEAD+h)*SEQ;
  const int NTF=(q0+QB)/KVBLK; int t_start;
  { const float*QNb=NRM+(b*NHEAD+h)*128,*KNb=NRM+4096+(b*NHEAD+h)*128;
    const float qn=fmaxf(fmaxf(QNb[4*qb],QNb[4*qb+1]),fmaxf(QNb[4*qb+2],QNb[4*qb+3])),knb=fmaxf(fmaxf(KNb[4*qb],KNb[4*qb+1]),fmaxf(KNb[4*qb+2],KNb[4*qb+3]));
    const float fq0=Fbh[q0]*1.4426950408889634f; bool k0=true,k1=true;
    if(lane<NTF-4)k0=!(qn*(KNb[lane]+knb)+(fq0-Fbh[64*lane+63]*1.4426950408889634f)<-40.f);
    if(lane+64<NTF-4)k1=!(qn*(KNb[lane+64]+knb)+(fq0-Fbh[64*(lane+64)+63]*1.4426950408889634f)<-40.f);
    const unsigned long long m0=__ballot(k0),m1=__ballot(k1);
    int tf=m0?(int)__builtin_ctzll(m0):64+(m1?(int)__builtin_ctzll(m1):64);
    tf=tf<NTF-4?tf:NTF-4; t_start=__builtin_amdgcn_readfirstlane(tf&~1); }
  { typedef float f32x4_t __attribute__((ext_vector_type(4))); __attribute__((address_space(3))) float*fk=(__attribute__((address_space(3))) float*)((__attribute__((address_space(3))) char*)shm+LDS_FK); const int n4=(q0+QB)/4;
    for(int i=16*t_start+tid;i<n4;i+=NW*64){ f32x4_t v=*(const f32x4_t*)(Fbh+4*i); v=v*(-1.4426950408889634f); *(__attribute__((address_space(3))) f32x4_t*)(fk+4*i)=v; } }
  float fq2=Fbh[q0+wid*QBLK+r32]*1.4426950408889634f; asm volatile("":"+v"(fq2));
  const bf16*Qw=Q+(rowbase+q0+wid*QBLK)*DM+h*D;
  const bf16*Kh=K+(rowbase+(long)t_start*KVBLK)*DM+h*D,*Vh=V+(rowbase+(long)t_start*KVBLK)*DM+h*D;
  const lds_cptr shm3=(lds_cptr)shm;
  const unsigned lds0=(unsigned)(uintptr_t)shm;
  float*wsf=(float*)(shm+LDS_WS)+wid*64;
  const bf16*ksrc=Kh+(long)lane*DM+wid*8;
  const bf16*vsrc=Vh+(long)(16*(wid&3)+(lane>>2))*DM+(wid>>2)*32+(lane&3)*8;
  const unsigned kdst=lds0+LDS_K+wid*1024, vdst=lds0+LDS_V+wid*1024;
  #define DMA_K(t,slot) glds16(ksrc+(long)(t)*KVBLK*DM,(unsigned)__builtin_amdgcn_readfirstlane(kdst+(slot)))
  #define DMA_V(t,slot) glds16(vsrc+(long)(t)*KVBLK*DM,(unsigned)__builtin_amdgcn_readfirstlane(vdst+(slot)))
  const int vb0=(int)(lds0+LDS_V)+((lane>>4)&1)*32+(lane&3)*8+(4*hi+((lane&15)>>2))*64;
  const char*Kbase=shm+LDS_K; bf16x8 kf[8];
  const lds_cptr kp0=shm3+LDS_K+hi*1024+r32*16; const lds_cptr vp0=shm3+LDS_V+((lane>>4)&1)*32+(lane&3)*8+(4*hi+((lane&15)>>2))*64;
  const int NT=NTF-t_start;
  DMA_K(0,0);DMA_V(0,0);DMA_K(1,SLOTB);
  bf16x8 qr[4];
  #pragma unroll
  for(int d0=0;d0<4;++d0)qr[d0]=*reinterpret_cast<const bf16x8*>(&Qw[(long)r32*DM+d0*16+hi*8]);
  float mhat=0.f,l_reg=0.f;f32x16 o[2];o[0]=f32x16{};o[1]=f32x16{};
  const __attribute__((address_space(3))) float*fkl=(const __attribute__((address_space(3))) float*)(shm3+LDS_FK)+64*t_start+4*hi;
  #define INITC(C0,C1,t) do{ const float nsc_=fq2-mhat; typedef float f32x4_t __attribute__((ext_vector_type(4))); const __attribute__((address_space(3))) float*kb_=fkl+64*(t); \
    _Pragma("unroll") for(int g_=0;g_<4;++g_){ const f32x4_t a_=*(const __attribute__((address_space(3))) f32x4_t*)(kb_+8*g_), b_=*(const __attribute__((address_space(3))) f32x4_t*)(kb_+32+8*g_); \
      _Pragma("unroll") for(int e_=0;e_<4;++e_){ C0[4*g_+e_]=nsc_+a_[e_]; C1[4*g_+e_]=nsc_+b_[e_]; } } }while(0)
  const int qrel=wid*QBLK+r32;
  #define CMASK(P0,P1,t) do{int jb_=(t)-(NT-4); if(jb_>=0)cmask(P0,P1,jb_,qrel,hi);}while(0)
  bool resc=false;
  #define START(P0,P1) do{ const float rm=rowmax(P0,P1); resc=false; \
    { const float dl=rm; mhat=fadd_s(mhat,dl); \
      _Pragma("unroll") for(int r=0;r<16;++r){P0[r]=fsub_s(P0[r],dl);P1[r]=fsub_s(P1[r],dl);} \
      } \
    _Pragma("unroll") for(int r=0;r<16;++r)P0[r]=__builtin_amdgcn_exp2f(P0[r]); }while(0)
  #define RESC() do{ if(resc){ asm volatile("s_waitcnt lgkmcnt(0)":::"memory"); \
      _Pragma("unroll") for(int d_=0;d_<2;++d_) _Pragma("unroll") for(int r=0;r<16;++r)o[d_][r]*=wsf[crow(r,hi)]; } }while(0)
  f32x16 pA0,pA1,pB0,pB1;
  int sl_prev=0,sl_cur=0,sl_next=SLOTB;
  #define ROT() do{sl_prev=sl_cur;sl_cur=sl_next;sl_next=(sl_next==(NSLOT-1)*SLOTB)?0:sl_next+SLOTB;}while(0)
  DMA_K(2,2*SLOTB);
  WAIT_BAR(3);
  INITC(pA0,pA1,0); qkt(pA0,pA1,Kbase,qr,r32,hi);asm volatile("s_nop 15\n\ts_nop 7":"+v"(pA0),"+v"(pA1));CMASK(pA0,pA1,0);
  START(pA0,pA1);
  _Pragma("unroll") for(int r=0;r<16;++r)pA1[r]=__builtin_amdgcn_exp2f(pA1[r]);
  WAIT_BAR(0);
  DMA_K(3,0);DMA_V(1,SLOTB);
  ROT();
  kload8(kf,kp0+sl_cur);
  WAIT_BAR(2);
  s16x4 vlo[8],vhi[8]; u32x4 pw0,pw1,pw2,pw3;
  #define PKW(P,B) cvtpk_s(P[B],P[B+1])
  #define PAF(k) __builtin_bit_cast(bf16x8,pw##k)
  #define VFR(i) (bf16x8){vlo[i][0],vlo[i][1],vlo[i][2],vlo[i][3],vhi[i][0],vhi[i][1],vhi[i][2],vhi[i][3]}
  #define PIN(x) asm volatile("":"+v"(x))
  #define MX3(a,b,c) __builtin_fmaxf(__builtin_fmaxf((a),(b)),(c))
  #define GAPA(MF,A0,A1,A2,A3,W0,W1,PW) do{ MF; sacc+=A0; sacc+=A1; sacc+=A2; sacc+=A3; PIN(sacc); W0; W1; PIN(PW); SBAR(); }while(0)
  #define EX(v) __builtin_amdgcn_exp2f(v)
  #define GAPB(MF,X,B) do{ MF; X[B]=EX(X[B]); X[B+1]=EX(X[B+1]); X[B+2]=EX(X[B+2]); X[B+3]=EX(X[B+3]); PIN(X); SBAR(); }while(0)
  #define VRD(i) do{ vlo[i]=vtr(vp_+(((i)>>2)*4096+((i)&3)*1024)); vhi[i]=vtr(vp_+(((i)>>2)*4096+((i)&3)*1024+512)); }while(0)
  #define KRD(G,j) do{ if(G){ kload2(kf,kp0+sl_next,j); SBAR(); } }while(0)
  #define STEP(C0,C1,P0,P1,t,GK,GV,GL) do{ SBAR(); INITC(C0,C1,t); PIN(C0); PIN(C1); SBAR(); \
    const lds_cptr vp_=vp0+sl_prev; \
    VRD(0); SBAR(); float sacc=(P0[0]+P0[1]); \
    GAPA(C0=__builtin_amdgcn_mfma_f32_32x32x16_bf16(kf[0],qr[0],C0,0,0,0), P0[2],P0[3],P0[4],P0[5],     pw0[0]=PKW(P0,0), pw0[1]=PKW(P0,2), pw0); \
    VRD(4); SBAR(); GAPA(C1=__builtin_amdgcn_mfma_f32_32x32x16_bf16(kf[1],qr[0],C1,0,0,0), P0[6],P0[7],P0[8],P0[9],     pw0[2]=PKW(P0,4), pw0[3]=PKW(P0,6), pw0); \
    VRD(1); SBAR(); GAPA(C0=__builtin_amdgcn_mfma_f32_32x32x16_bf16(kf[2],qr[1],C0,0,0,0),   P0[10],P0[11],P0[12],P0[13], pw1[0]=PKW(P0,8), pw1[1]=PKW(P0,10), pw1); \
    VRD(5); SBAR(); GAPA(C1=__builtin_amdgcn_mfma_f32_32x32x16_bf16(kf[3],qr[1],C1,0,0,0),   P0[14],P0[15],P1[0],P1[1],   pw1[2]=PKW(P0,12),pw1[3]=PKW(P0,14), pw1); \
    VRD(2); SBAR(); GAPA(C0=__builtin_amdgcn_mfma_f32_32x32x16_bf16(kf[4],qr[2],C0,0,0,0),   P1[2],P1[3],P1[4],P1[5],     pw2[0]=PKW(P1,0), pw2[1]=PKW(P1,2), pw2); \
    VRD(6); SBAR(); GAPA(C1=__builtin_amdgcn_mfma_f32_32x32x16_bf16(kf[5],qr[2],C1,0,0,0),   P1[6],P1[7],P1[8],P1[9],     pw2[2]=PKW(P1,4), pw2[3]=PKW(P1,6), pw2); \
    VRD(3); SBAR(); GAPA(C0=__builtin_amdgcn_mfma_f32_32x32x16_bf16(kf[6],qr[3],C0,0,0,0),   P1[10],P1[11],P1[12],P1[13], pw3[0]=PKW(P1,8), pw3[1]=PKW(P1,10), pw3); \
    VRD(7); SBAR(); GAPA(C1=__builtin_amdgcn_mfma_f32_32x32x16_bf16(kf[7],qr[3],C1,0,0,0),   P1[14],P1[15],0.f,0.f,       pw3[2]=PKW(P1,12),pw3[3]=PKW(P1,14), pw3); \
    l_reg+=sacc; \
    if(GK){DMA_K((t)+3,sl_cur);} if(GV){DMA_V((t)+1,sl_next);} \
    CMASK(C0,C1,t); \
    { float a=MX3(C0[0],C0[1],C1[0]),b=MX3(C0[2],C0[3],C1[1]); a=MX3(a,C1[2],C1[3]); \
      _Pragma("unroll") for(int r=4;r<16;r+=4){a=MX3(a,C0[r],C0[r+1]);b=MX3(b,C0[r+2],C0[r+3]);a=MX3(a,C1[r],C1[r+1]);b=MX3(b,C1[r+2],C1[r+3]);} \
      float rm=__builtin_fmaxf(a,b); { auto rr=__builtin_amdgcn_permlane32_swap(__float_as_uint(rm),__float_as_uint(rm),false,false); rm=__builtin_fmaxf(__uint_as_float(rr[0]),__uint_as_float(rr[1])); } \
      resc=false; \
      if(__builtin_expect(__any(rm>(float)THRL),0)){ const float dl=__builtin_fmaxf(rm,0.f); mhat+=dl; \
        _Pragma("unroll") for(int r=0;r<16;++r){C0[r]-=dl;C1[r]-=dl;} \
        const float f=__builtin_amdgcn_exp2f(-dl); l_reg*=f; if(hi==0)wsf[r32]=f; resc=true; } } \
    SBAR(); \
    GAPB(o[0]=__builtin_amdgcn_mfma_f32_32x32x16_bf16(PAF(0),VFR(0),o[0],0,0,0), C0,0); \
    GAPB(o[1]=__builtin_amdgcn_mfma_f32_32x32x16_bf16(PAF(0),VFR(4),o[1],0,0,0), C0,4); \
    KRD(GL,0); GAPB(o[0]=__builtin_amdgcn_mfma_f32_32x32x16_bf16(PAF(1),VFR(1),o[0],0,0,0), C0,8); \
    KRD(GL,1); GAPB(o[1]=__builtin_amdgcn_mfma_f32_32x32x16_bf16(PAF(1),VFR(5),o[1],0,0,0), C0,12); \
    KRD(GL,2); GAPB(o[0]=__builtin_amdgcn_mfma_f32_32x32x16_bf16(PAF(2),VFR(2),o[0],0,0,0), C1,0); \
    KRD(GL,3); GAPB(o[1]=__builtin_amdgcn_mfma_f32_32x32x16_bf16(PAF(2),VFR(6),o[1],0,0,0), C1,4); \
    GAPB(o[0]=__builtin_amdgcn_mfma_f32_32x32x16_bf16(PAF(3),VFR(3),o[0],0,0,0), C1,8); \
    GAPB(o[1]=__builtin_amdgcn_mfma_f32_32x32x16_bf16(PAF(3),VFR(7),o[1],0,0,0), C1,12); \
    }while(0)
  int t=1;
  #undef CMASK
  #define CMASK(P0,P1,t) do{}while(0)
  for(;t+5<NT;t+=2){
    STEP(pB0,pB1,pA0,pA1,t,true,true,true);     WAIT_BAR(2); RESC(); ROT();
    STEP(pA0,pA1,pB0,pB1,t+1,true,true,true);   WAIT_BAR(2); RESC(); ROT();
  }
  #undef CMASK
  #define CMASK(P0,P1,t) do{int jb_=(t)-(NT-4); if(jb_>=0)cmask(P0,P1,jb_,qrel,hi);}while(0)
  #define ENDW(tt) do{ if((tt)+3<NT){WAIT_BAR(2);} else if((tt)+2<NT){WAIT_BAR(1);} else {WAIT_BAR(0);} }while(0)
  for(;t+1<NT;t+=2){
    STEP(pB0,pB1,pA0,pA1,t,(t+3<NT),(t+1<NT),(t+1<NT));       ENDW(t);   RESC(); ROT();
    STEP(pA0,pA1,pB0,pB1,t+1,(t+4<NT),(t+2<NT),(t+2<NT));     ENDW(t+1); RESC(); ROT();
  }
  STEP(pB0,pB1,pA0,pA1,NT-1,false,false,false); RESC();
  { float sacc=pB0[0]+pB0[1]; _Pragma("unroll") for(int r=2;r<16;++r)sacc+=pB0[r]; _Pragma("unroll") for(int r=0;r<16;++r)sacc+=pB1[r]; l_reg+=sacc;
    pw0=(u32x4){PKW(pB0,0),PKW(pB0,2),PKW(pB0,4),PKW(pB0,6)};pw1=(u32x4){PKW(pB0,8),PKW(pB0,10),PKW(pB0,12),PKW(pB0,14)};pw2=(u32x4){PKW(pB1,0),PKW(pB1,2),PKW(pB1,4),PKW(pB1,6)};pw3=(u32x4){PKW(pB1,8),PKW(pB1,10),PKW(pB1,12),PKW(pB1,14)};
    SBAR(); pv(o,vb0+sl_cur,PAF(0),PAF(1),PAF(2),PAF(3)); }
  #undef PKW
  #undef PAF
  #undef VFR
  #undef PIN
  #undef MX3
  #undef GAPA
  #undef GAPB
  #undef EX
  #undef VRD
  #undef KRD
  #undef STEP
  #undef ENDW
  {auto rr=__builtin_amdgcn_permlane32_swap(__float_as_uint(l_reg),__float_as_uint(l_reg),false,false);l_reg=__uint_as_float(rr[0])+__uint_as_float(rr[1]);}
  if(hi==0)wsf[32+r32]=l_reg;asm volatile("s_waitcnt lgkmcnt(0)":::"memory");
  float rli[16];
  #pragma unroll
  for(int r=0;r<16;++r)rli[r]=__builtin_amdgcn_rcpf(wsf[32+crow(r,hi)]);
  bf16*Ow=O+(rowbase+q0+wid*QBLK)*DM+h*D;
  { bf16*stg=(bf16*)(shm+LDS_OST)+wid*2048;
    #pragma unroll
    for(int r=0;r<16;++r){const int orow=crow(r,hi);
      #pragma unroll
      for(int d0=0;d0<2;++d0)stg[orow*64+d0*32+r32]=__float2bfloat16(o[d0][r]*rli[r]);}
    asm volatile("s_waitcnt lgkmcnt(0)":::"memory");
    #pragma unroll
    for(int i=0;i<4;++i){const int row=i*8+(lane>>3),ch=lane&7; const u32x4 v=*(const u32x4*)(stg+row*64+ch*8); ATTN_STORE16(Ow+(long)row*DM+ch*8,v);} }
  asm volatile("s_waitcnt lgkmcnt(0)\n\ts_barrier":::"memory");
  #undef DMA_K
  #undef DMA_V
  #undef INITC
  #undef CMASK
  #undef START
  #undef RESC
  #undef ROT
}
constexpr int ATTN_LDS_BYTES=LDS_BYTES;
struct AttnTensors { const bf16* Q; const bf16* K; const bf16* V; bf16* O; const float* F; const float* NRM; };
struct AttnUnit { int bh; int qb; };
struct StaticOrder {
  int vcu;
  __device__ __forceinline__ explicit StaticOrder(int grid,int block):vcu((block%8)*(grid/8)+block/8){}
  __device__ __forceinline__ bool next(int i,AttnUnit&u)const{ if(i>=4)return false; const int s=vcu&7; u.bh=vcu>>3; u.qb=(i==0)?s:(i==1)?15-s:(i==2)?16+s:31-s; return true; }
  __device__ __forceinline__ void a_ready(const AttnUnit&)const{}
  __device__ __forceinline__ void done(const AttnUnit&)const{}
};
template<int THRL=8> __device__ __forceinline__ void attn_phase(char*lds,const AttnTensors&T,unsigned*qctr,volatile __attribute__((address_space(3))) unsigned*qword,int wid_in){
  const int lane0=(int)__builtin_amdgcn_mbcnt_hi(~0u,__builtin_amdgcn_mbcnt_lo(~0u,0u));
  for(;;){
    if(wid_in==0&&lane0==0){ const unsigned n=__hip_atomic_fetch_add(qctr,1u,__ATOMIC_RELAXED,__HIP_MEMORY_SCOPE_AGENT); *qword=n; }
    asm volatile("s_waitcnt vmcnt(0) lgkmcnt(0)\n\ts_barrier":::"memory");
    const int n=__builtin_amdgcn_readfirstlane((int)*qword);
    if(n>=BATCH*NHEAD*NQB)break;
    const int bh=n%(BATCH*NHEAD),qb=NQB-1-n/(BATCH*NHEAD);
    attn_unit<THRL>(bh/NHEAD,bh%NHEAD,qb,T.Q,T.K,T.V,T.O,T.F,T.NRM,lds,wid_in);
  }
}
#undef SBAR
#undef WAIT_BAR
}
#define GAS __attribute__((address_space(1)))
#define LAS __attribute__((address_space(3)))
typedef unsigned short bf16;
typedef unsigned v4u __attribute__((ext_vector_type(4)));
typedef float f32x4 __attribute__((ext_vector_type(4)));
typedef short bf16x8 __attribute__((ext_vector_type(8)));
typedef GAS unsigned gu32;
typedef GAS unsigned long long gu64;
#define RLX_AGENT __ATOMIC_RELAXED, __HIP_MEMORY_SCOPE_AGENT
#define LDS_WAIT() asm volatile("s_waitcnt lgkmcnt(0)" ::: "memory")
#define VM_WAIT() asm volatile("s_waitcnt vmcnt(0)" ::: "memory")
__device__ __forceinline__ unsigned long long rt() { return __builtin_amdgcn_s_memrealtime(); }
__device__ __forceinline__ unsigned f2bf(float f) { unsigned u = __builtin_bit_cast(unsigned, f); return (u + 0x7fffu + ((u >> 16) & 1u)) >> 16; }
__device__ __forceinline__ unsigned pk2(float lo, float hi) { return f2bf(lo) | (f2bf(hi) << 16); }

#define XB_TMO      128
#define XB_XCNT(j)  (256  + 64 * (j))
#define XB_XSUB(j)  (1280 + 64 * (j))
#define XB_XGEN(j)  (2304 + 64 * (j))
#define XB_TOP      3328
#define XB_TOPGEN   3392
#define XCD_BAR_WORDS 3456
#define XB_SPIN_CAP (1u << 18)

__device__ __forceinline__ unsigned xb_ld(unsigned* p)              { return __hip_atomic_load(p, __ATOMIC_RELAXED, __HIP_MEMORY_SCOPE_AGENT); }
__device__ __forceinline__ unsigned xb_add(unsigned* p, unsigned v) { return __hip_atomic_fetch_add(p, v, __ATOMIC_RELAXED, __HIP_MEMORY_SCOPE_AGENT); }
__device__ __forceinline__ unsigned xb_xcc_id() { return (unsigned)__builtin_amdgcn_s_getreg((3 << 11) | 20) & 0xFu; }
#define XB_SPIN(cond, bar) do { unsigned _sp = 0; while (cond) { __builtin_amdgcn_s_sleep(1); \
    if ((++_sp & 255u) == 0u) { if (xb_ld(&(bar)[XB_TMO])) break; if (_sp > XB_SPIN_CAP) { atomicAdd(&(bar)[XB_TMO], 1u); break; } } } } while (0)

struct XcdBarrier {
    unsigned* bar; unsigned x; int wv;
    volatile LAS unsigned* st;
};

__device__ __forceinline__ bool xb_t0(int wv) { return wv == 0 && __builtin_amdgcn_mbcnt_hi(~0u, __builtin_amdgcn_mbcnt_lo(~0u, 0u)) == 0u; }
__device__ __forceinline__ XcdBarrier xcd_barrier_post(unsigned* bar, volatile LAS unsigned* st, int wv) {
    XcdBarrier b; b.bar = bar; b.x = xb_xcc_id(); b.st = st; b.wv = wv;
    if (xb_t0(wv)) (void)xb_add(&bar[XB_XCNT(b.x)], 1u);
    return b;
}
__device__ __forceinline__ void xcd_barrier_complete(unsigned* bar, unsigned x, unsigned& nloc, unsigned& nx) {
    const unsigned G = gridDim.x * gridDim.y * gridDim.z;
    unsigned sum, cnt, mine, sp = 0u;
    for (;;) {
        sum = 0u; cnt = 0u; mine = 0u;
#pragma unroll
        for (unsigned j = 0; j < 16; ++j) { const unsigned c = xb_ld(&bar[XB_XCNT(j)]); sum += c; cnt += (c > 0u) ? 1u : 0u; mine = (j == x) ? c : mine; }
        if (sum == G) break;
        __builtin_amdgcn_s_sleep(1);
        if ((++sp & 255u) == 0u) { if (xb_ld(&bar[XB_TMO])) break; if (sp > XB_SPIN_CAP) { atomicAdd(&bar[XB_TMO], 1u); break; } }
    }
    nloc = mine > 0u ? mine : 1u; nx = cnt > 0u ? cnt : 1u;
}

__device__ __forceinline__ void xcd_barrier(const XcdBarrier& b) {
    asm volatile("s_waitcnt vmcnt(0)" ::: "memory");
    __syncthreads();
    if (xb_t0(b.wv)) {
        unsigned* bar = b.bar;
        __builtin_amdgcn_s_waitcnt(0);
        unsigned nloc = b.st[0], nx = b.st[1];
        if (nloc == 0u) { xcd_barrier_complete(bar, b.x, nloc, nx); b.st[0] = nloc; b.st[1] = nx; }
        const unsigned old = xb_add(&bar[XB_XSUB(b.x)], 1u);
        const unsigned gen = old / nloc;
        if (old + 1u == (gen + 1u) * nloc) {
            __builtin_amdgcn_fence(__ATOMIC_RELEASE, "agent");
            asm volatile("s_waitcnt vmcnt(0)" ::: "memory");
            const unsigned og = xb_add(&bar[XB_TOP], 1u);
            const unsigned tg = og / nx;
            if (og + 1u == (tg + 1u) * nx) xb_add(&bar[XB_TOPGEN], 1u);
            else XB_SPIN(xb_ld(&bar[XB_TOPGEN]) == tg, bar);
            __builtin_amdgcn_fence(__ATOMIC_ACQUIRE, "agent");
            xb_add(&bar[XB_XGEN(b.x)], 1u);
            asm volatile("s_waitcnt vmcnt(0)" ::: "memory");
        } else {
            XB_SPIN(xb_ld(&bar[XB_XGEN(b.x)]) == gen, bar);
            __builtin_amdgcn_fence(__ATOMIC_ACQUIRE, "agent");
            asm volatile("s_waitcnt vmcnt(0)" ::: "memory");
        }
    }
    __syncthreads();
}

constexpr int NWAVES = 8;
constexpr int RING_OFF = 0, RING_BYTES = 131072;
constexpr int LDSCTL_OFF = RING_BYTES, MISC_OFF = LDSCTL_OFF + 320;
constexpr int LDS_BYTES = 147456;
constexpr int N_PHASES = 8;

struct Frame {
    LAS unsigned char* lds;
    volatile LAS unsigned* MISC;
    gu32* ctl;
    int tid, lane, wave, vcu, G;
};
__device__ __forceinline__ float wave_sum(float v) {
#pragma unroll
    for (int o = 1; o < 64; o <<= 1) v += __shfl_xor(v, o);
    return v;
}
struct Args { const float* in[20]; float* out; unsigned char* ws; int ph_lo, ph_hi, li, pad; };

__device__ __forceinline__ void p0_transpose_item(const float* W, int ld, int nblk, const float* glo, const float* ghi, int K, bf16* WT, LAS float* scr, int item, int lane) {
    const int kb = item / nblk, nb = item % nblk, k0 = 64 * kb, n0 = 32 * nb;
#pragma unroll 8
    for (int i = 0; i < 32; ++i) { const int kk = 2 * i + (lane >> 5), k = k0 + kk; float w = W[(size_t)k * ld + n0 + (lane & 31)];
        if (glo) w *= (k < K / 2) ? glo[k] : ghi[k - K / 2];
        scr[kk * 33 + (lane & 31)] = w; }
    LDS_WAIT(); asm volatile("" ::: "memory");
    const int c = lane & 7;
#pragma unroll
    for (int j = 0; j < 4; ++j) { const int n = (lane >> 3) + 8 * j; const LAS float* s = scr + (8 * c) * 33 + n;
        v4u o; o.x = pk2(s[0 * 33], s[1 * 33]); o.y = pk2(s[2 * 33], s[3 * 33]); o.z = pk2(s[4 * 33], s[5 * 33]); o.w = pk2(s[6 * 33], s[7 * 33]);
        *(GAS v4u*)(WT + (size_t)(n0 + n) * K + k0 + 8 * c) = o; }
    LDS_WAIT(); asm volatile("" ::: "memory");
}
__device__ __forceinline__ float log_sigmoid(float z) { return fminf(z, 0.f) - log1pf(expf(-fabsf(z))); }

__device__ __forceinline__ void p0_prologue(Frame& F, const Args& a) {
    LAS float* scr = (LAS float*)(F.lds + RING_OFF + F.wave * 16384);
    unsigned char* ws = a.ws;
    const float* x = a.in[0]; const float* g1 = a.in[1]; const float* w_in = a.in[2]; const float* bfv = a.in[10];
    const float* gn_l = a.in[11]; const float* gn_f = a.in[12]; const float* w_out = a.in[13]; const float* g2 = a.in[14];
    const float* w_q = a.in[15]; const float* sk = a.in[16]; const float* pu = a.in[17]; const float* pv = a.in[18];
    bf16* win_t = (bf16*)(ws + WS_WIN); bf16* wout_t = (bf16*)(ws + WS_WOUT); bf16* wq_t = (bf16*)(ws + WS_WQ); bf16* skb = (bf16*)(ws + WS_SKB); float* wfl = (float*)(ws + WS_WFL);
    float* logf = (float*)(ws + WS_LOGF); float* sumsq = (float*)(ws + WS_SUMSQ); bf16* h = (bf16*)(ws + WS_H);
    const int gw = F.vcu * NWAVES + F.wave, NGW = F.G * NWAVES, lane = F.lane;
    constexpr int I_IN = (DMODEL / 64) * (NG1 / 32), I_OUT = (DMODEL / 64) * (DMODEL / 32), I_Q = (DMODEL / 64) * (QPW / 32);
    constexpr int I_FL = 8 * DMODEL / 64, I_SK = PH * 2 * NKEY * PHALF / 512, I_SS = T / 64, I_WAX = 8 * 2 * 2 * 4;
    constexpr int E0 = I_IN, E1 = E0 + I_OUT, E2 = E1 + I_Q, E3 = E2 + I_FL, E4 = E3 + I_SK, E5 = E4 + I_SS, E6 = E5 + I_WAX;
    for (int it = gw; it < E6; it += NGW) {
        if (it < E0) { p0_transpose_item(w_in, INC, NG1 / 32, nullptr, nullptr, DMODEL, win_t, scr, it, lane); continue; }
        if (it < E1) { p0_transpose_item(w_out, DMODEL, DMODEL / 32, gn_l, gn_f, DMODEL, wout_t, scr, it - E0, lane); continue; }
        if (it < E2) { p0_transpose_item(w_q, QPW, QPW / 32, g2, g2 + DMODEL / 2, DMODEL, wq_t, scr, it - E1, lane); continue; }
        if (it < E3) { const int i = (it - E2) * 64 + lane, j = i / DMODEL, k = i % DMODEL; wfl[i] = w_in[(size_t)k * INC + NG1 + j]; continue; }
        if (it < E4) { const size_t i = (size_t)(it - E3) * 512 + lane * 8; const f32x4 s0 = *(const GAS f32x4*)(sk + i), s1 = *(const GAS f32x4*)(sk + i + 4);
            v4u o; o.x = pk2(s0[0], s0[1]); o.y = pk2(s0[2], s0[3]); o.z = pk2(s1[0], s1[1]); o.w = pk2(s1[2], s1[3]); *(GAS v4u*)(skb + i) = o; continue; }
        if (it < E5) { sumsq[(it - E4) * 64 + lane] = 0.f; continue; }
        { const int f = it - E5, ks = f & 3, n = (f >> 2) & 1, mat = (f >> 3) & 1, hh = f >> 4; const float* wsrc = mat ? a.in[7] : a.in[5];
          const size_t o = ((size_t)(hh * 64 + 16 * ks + 8 * (lane >> 5))) * 64 + 32 * n + (lane & 31);
          v4u pw; pw.x = pk2(wsrc[o], wsrc[o + 64]); pw.y = pk2(wsrc[o + 128], wsrc[o + 192]); pw.z = pk2(wsrc[o + 256], wsrc[o + 320]); pw.w = pk2(wsrc[o + 384], wsrc[o + 448]);
          *(GAS v4u*)((bf16*)(ws + WS_WAX) + (size_t)f * 512 + lane * 8) = pw; }
    }
    { f32x4 gg[4];
#pragma unroll
      for (int j = 0; j < 4; ++j) gg[j] = *(const GAS f32x4*)(g2 + 16 * lane + 4 * j);
      unsigned char* u4 = ws + WS_U8; unsigned char* v4 = ws + WS_V8; float* su = (float*)(ws + WS_SU);
      for (int e = gw; e < NEXP; e += NGW) {
        const GAS f32x4* ur = (const GAS f32x4*)(pu + (size_t)e * DMODEL + 16 * lane); const GAS f32x4* vr = (const GAS f32x4*)(pv + (size_t)e * DMODEL + 16 * lane);
        f32x4 uu[4], vv[4]; float mu = 0.f, mv = 0.f;
#pragma unroll
        for (int j = 0; j < 4; ++j) { uu[j] = ur[j] * gg[j]; vv[j] = vr[j];
#pragma unroll
            for (int c = 0; c < 4; ++c) { mu = fmaxf(mu, fabsf(uu[j][c])); mv = fmaxf(mv, fabsf(vv[j][c])); } }
#pragma unroll
        for (int o = 1; o < 64; o <<= 1) { mu = fmaxf(mu, __shfl_xor(mu, o)); mv = fmaxf(mv, __shfl_xor(mv, o)); }
        const float scu = mu > 0.f ? mu * (1.f / 6.f) : 1.f, scv = mv > 0.f ? mv * (1.f / 6.f) : 1.f, iu = 1.f / scu, iv = 1.f / scv;
        unsigned qu0 = 0u, qu1 = 0u, qv0 = 0u, qv1 = 0u;
#define P0_Q4(Q, X, INV, B0, B1) do { Q = __builtin_amdgcn_cvt_scalef32_pk_fp4_f32(Q, X[0] * INV, X[1] * INV, 1.0f, B0); Q = __builtin_amdgcn_cvt_scalef32_pk_fp4_f32(Q, X[2] * INV, X[3] * INV, 1.0f, B1); } while (0)
        P0_Q4(qu0, uu[0], iu, 0, 1); P0_Q4(qu0, uu[1], iu, 2, 3); P0_Q4(qu1, uu[2], iu, 0, 1); P0_Q4(qu1, uu[3], iu, 2, 3);
        P0_Q4(qv0, vv[0], iv, 0, 1); P0_Q4(qv0, vv[1], iv, 2, 3); P0_Q4(qv1, vv[2], iv, 0, 1); P0_Q4(qv1, vv[3], iv, 2, 3);
#undef P0_Q4
        *(GAS unsigned long long*)(u4 + (size_t)e * 512 + 8 * lane) = (unsigned long long)qu0 | ((unsigned long long)qu1 << 32);
        *(GAS unsigned long long*)(v4 + (size_t)e * 512 + 8 * lane) = (unsigned long long)qv0 | ((unsigned long long)qv1 << 32);
        if (lane == 0) { su[2 * e] = scu; su[2 * e + 1] = scv; }
      } }
    { f32x4 gg[4];
#pragma unroll
      for (int j = 0; j < 4; ++j) gg[j] = *(const GAS f32x4*)(g1 + 256 * j + 4 * lane);
      float fw[4][4][8];
#pragma unroll
      for (int j = 0; j < 4; ++j)
#pragma unroll
          for (int c = 0; c < 4; ++c) { const int k = 256 * j + 4 * lane + c; const GAS f32x4* wr = (const GAS f32x4*)(w_in + (size_t)k * INC + NG1); const f32x4 w0 = wr[0], w1 = wr[1];
#pragma unroll
              for (int e = 0; e < 4; ++e) { fw[j][c][e] = w0[e]; fw[j][c][4 + e] = w1[e]; } }
      for (int t0 = gw; t0 < T; t0 += 2 * NGW) {
        const int t1 = (t0 + NGW < T) ? t0 + NGW : t0;
        const GAS f32x4* xr0 = (const GAS f32x4*)(x + (size_t)t0 * DMODEL) + lane; const GAS f32x4* xr1 = (const GAS f32x4*)(x + (size_t)t1 * DMODEL) + lane;
        f32x4 va[4], vb[4]; float sa = 0.f, sb = 0.f;
#pragma unroll
        for (int j = 0; j < 4; ++j) { va[j] = xr0[64 * j]; vb[j] = xr1[64 * j]; }
#pragma unroll
        for (int j = 0; j < 4; ++j) { sa += (va[j][0] * va[j][0] + va[j][1] * va[j][1]) + (va[j][2] * va[j][2] + va[j][3] * va[j][3]); sb += (vb[j][0] * vb[j][0] + vb[j][1] * vb[j][1]) + (vb[j][2] * vb[j][2] + vb[j][3] * vb[j][3]); }
        const float ra = rsqrtf(wave_sum(sa) * (1.f / DMODEL) + RMS_EPS), rb = rsqrtf(wave_sum(sb) * (1.f / DMODEL) + RMS_EPS);
        GAS unsigned long long* ha = (GAS unsigned long long*)(h + (size_t)t0 * DMODEL) + lane; GAS unsigned long long* hb = (GAS unsigned long long*)(h + (size_t)t1 * DMODEL) + lane;
#pragma unroll
        for (int j = 0; j < 4; ++j) { va[j] = va[j] * ra * gg[j]; vb[j] = vb[j] * rb * gg[j];
            ha[64 * j] = (unsigned long long)pk2(va[j][0], va[j][1]) | ((unsigned long long)pk2(va[j][2], va[j][3]) << 32);
            hb[64 * j] = (unsigned long long)pk2(vb[j][0], vb[j][1]) | ((unsigned long long)pk2(vb[j][2], vb[j][3]) << 32); }
        float fa[8], fb[8];
#pragma unroll
        for (int hh = 0; hh < 8; ++hh) { fa[hh] = 0.f; fb[hh] = 0.f; }
#pragma unroll
        for (int j = 0; j < 4; ++j)
#pragma unroll
            for (int c = 0; c < 4; ++c) {
#pragma unroll
                for (int hh = 0; hh < 8; ++hh) { fa[hh] += va[j][c] * fw[j][c][hh]; fb[hh] += vb[j][c] * fw[j][c][hh]; } }
        float resa = 0.f, resb = 0.f;
#pragma unroll
        for (int hh = 0; hh < 8; ++hh) { const float s0 = wave_sum(fa[hh]), s1 = wave_sum(fb[hh]); if (lane == hh) { resa = s0; resb = s1; } }
        if (lane < 8) { logf[(size_t)t0 * 8 + lane] = log_sigmoid(resa + bfv[lane]); logf[(size_t)t1 * 8 + lane] = log_sigmoid(resb + bfv[lane]); }
      } }
}

__device__ __forceinline__ void fcum_unit(Frame& F, int bh, const float* logf, float* fcum) {
    const int b = bh / NHEADS, hh = bh % NHEADS, s0 = F.tid * 16;
    float v[16]; float loc = 0.f;
#pragma unroll
    for (int i = 0; i < 16; ++i) { v[i] = logf[((size_t)b * SEQ + s0 + i) * 8 + hh]; loc += v[i]; }
    float inc = loc;
#pragma unroll
    for (int o = 1; o < 64; o <<= 1) { const float n = __shfl_up(inc, o); if (F.lane >= o) inc += n; }
    if (F.lane == 63) F.MISC[16 + F.wave] = __float_as_uint(inc);
    __syncthreads();
    float run = inc - loc;
    for (int w = 0; w < F.wave; ++w) run += __uint_as_float(F.MISC[16 + w]);
#pragma unroll
    for (int i = 0; i < 16; ++i) { run += v[i]; fcum[(size_t)bh * SEQ + s0 + i] = run; }
    __syncthreads();
}


#ifndef MK_REP_MASK
#define MK_REP_MASK 0
#endif
#define REPS(k) (((MK_REP_MASK >> (k)) & 1) ? 2 : 1)
namespace peer {
typedef unsigned u32;
typedef float f32x16 __attribute__((ext_vector_type(16)));
constexpr int TOK = 128;
constexpr int EX_STRIDE = 136, GT_STRIDE = 132;
constexpr int L_EX = 0, L_GT = L_EX + TOK * EX_STRIDE * 2, L_IDX = L_GT + TOK * GT_STRIDE * 4, IDX_STRIDE = 36, L_RST = L_IDX + 512 * IDX_STRIDE, L_END = L_RST + TOK * 4;
static_assert(L_END <= RING_BYTES && L_GT % 16 == 0 && L_IDX % 16 == 0, "PEER LDS map");
__device__ __forceinline__ u32 ordmap(float f) { const u32 u = __float_as_uint(f); return u ^ ((u32)((int)u >> 31) | 0x80000000u); }
__device__ __forceinline__ float unordmap(u32 k) { const u32 u = (k & 0x80000000u) ? (k ^ 0x80000000u) : ~k; return __uint_as_float(u); }
__device__ __forceinline__ u32 umin_(u32 a, u32 b) { return a < b ? a : b; }
__device__ __forceinline__ u32 umax_(u32 a, u32 b) { return a > b ? a : b; }
template <bool DESC> __device__ __forceinline__ void sort16(u32 (&k)[16]) {
#pragma unroll
    for (int size = 2; size <= 16; size <<= 1)
#pragma unroll
        for (int stride = size >> 1; stride > 0; stride >>= 1)
#pragma unroll
            for (int i = 0; i < 16; ++i) { const int j = i ^ stride;
                if (j > i) { const bool asc = (((i & size) == 0) != DESC); const u32 a = k[i], b = k[j], lo = umin_(a, b), hi = umax_(a, b); k[i] = asc ? lo : hi; k[j] = asc ? hi : lo; } }
}
template <bool DESC> __device__ __forceinline__ void merge16(u32 (&k)[16]) {
#pragma unroll
    for (int stride = 8; stride > 0; stride >>= 1)
#pragma unroll
        for (int i = 0; i < 16; ++i) { const int j = i ^ stride;
            if (j > i) { const u32 a = k[i], b = k[j], lo = umin_(a, b), hi = umax_(a, b); k[i] = DESC ? hi : lo; k[j] = DESC ? lo : hi; } }
}
__host__ __device__ constexpr int ccnt(int a) { return 16 / (a + 1); }
__host__ __device__ constexpr int cbase(int a) { int s = 0; for (int i = 0; i < a; ++i) s += ccnt(i); return s; }
static_assert(cbase(16) == 50, "hyperbola candidate count");
__device__ __forceinline__ int crow16(int r) { return (r & 3) + 8 * (r >> 2); }

__device__ __forceinline__ void route_tile(Frame& F, const bf16* qp, const bf16* skb, const float* sumsq, int t0) {
    int lane = F.lane; asm volatile("" : "+v"(lane));
    const int r32 = lane & 31, hi = lane >> 5, w = F.wave;
    LAS unsigned short* EXL = (LAS unsigned short*)(F.lds + RING_OFF + L_EX);
    LAS float* GTL = (LAS float*)(F.lds + RING_OFF + L_GT);
    LAS unsigned char* IDXB = F.lds + RING_OFF + L_IDX + (w * 64 + lane) * IDX_STRIDE;
    LAS float* RST = (LAS float*)(F.lds + RING_OFF + L_RST);
    for (int g = 0; g < 4; ++g) {
        const int tok = 32 * g + r32; const size_t trow = (size_t)(t0 + tok);
        const float rstd2 = rsqrtf(sumsq[trow] * (1.f / DMODEL) + RMS_EPS);
        if (w == 0 && hi == 0) RST[tok] = rstd2;
        u32 s0[16], s1[16];
#pragma unroll
        for (int p = 0; p < 2; ++p) {
            bf16x8 qf[8];
#pragma unroll
            for (int ks = 0; ks < 8; ++ks) qf[ks] = *(const GAS bf16x8*)(qp + trow * QPW + w * 256 + p * 128 + ks * 16 + hi * 8);
            u32 run[16];
#pragma unroll
            for (int nb = 0; nb < 4; ++nb) {
                f32x16 acc = {};
                const bf16* kr = skb + ((size_t)((w * 2 + p) * NKEY + 32 * nb + r32)) * PHALF + hi * 8;
#pragma unroll
                for (int ks = 0; ks < 8; ++ks) acc = __builtin_amdgcn_mfma_f32_32x32x16_bf16(*(const GAS bf16x8*)(kr + ks * 16), qf[ks], acc, 0, 0, 0);
                asm volatile("" ::: "memory");
                u32 blk[16];
#pragma unroll
                for (int r = 0; r < 16; ++r) blk[r] = (ordmap(acc[r]) & ~0x7Fu) | (u32)(127 - 32 * nb - crow16(r) - 4 * hi);
                if (nb == 0) { sort16<true>(blk);
#pragma unroll
                    for (int i = 0; i < 16; ++i) run[i] = blk[i]; }
                else { sort16<false>(blk);
#pragma unroll
                    for (int i = 0; i < 16; ++i) run[i] = umax_(run[i], blk[i]);
                    merge16<true>(run); }
            }
            u32 oth[16];
#pragma unroll
            for (int i = 0; i < 16; ++i) oth[i] = (u32)__shfl_xor((int)run[15 - i], 32);
#pragma unroll
            for (int i = 0; i < 16; ++i) run[i] = umax_(run[i], oth[i]);
            merge16<true>(run);
#pragma unroll
            for (int i = 0; i < 16; ++i) { if (p == 0) s0[i] = run[i]; else s1[i] = run[i]; }
        }
        { LAS u32* iw = (LAS u32*)IDXB;
#pragma unroll
          for (int j = 0; j < 4; ++j) {
              iw[j] = (127u - (s0[4 * j] & 127u)) | ((127u - (s0[4 * j + 1] & 127u)) << 8) | ((127u - (s0[4 * j + 2] & 127u)) << 16) | ((127u - (s0[4 * j + 3] & 127u)) << 24);
              iw[4 + j] = (127u - (s1[4 * j] & 127u)) | ((127u - (s1[4 * j + 1] & 127u)) << 8) | ((127u - (s1[4 * j + 2] & 127u)) << 16) | ((127u - (s1[4 * j + 3] & 127u)) << 24); } }
        float v1[16], v2[16];
#pragma unroll
        for (int i = 0; i < 16; ++i) { v1[i] = unordmap(s0[i] & ~0x7Fu); v2[i] = unordmap(s1[i] & ~0x7Fu); }
        u32 c0[16], c1[16], c2[16], c3[16];
#pragma unroll
        for (int a = 0; a < 16; ++a)
#pragma unroll
            for (int b = 0; b < ccnt(a); ++b) { const int pos = cbase(a) + b; const u32 key = (ordmap(v1[a] + v2[b]) & ~0xFFu) | (u32)(255 - (a * 16 + b));
                if (pos < 16) c0[pos] = key; else if (pos < 32) c1[pos - 16] = key; else if (pos < 48) c2[pos - 32] = key; else c3[pos - 48] = key; }
#pragma unroll
        for (int i = 2; i < 16; ++i) c3[i] = 0u;
        sort16<false>(c1);
#pragma unroll
        for (int i = 0; i < 16; ++i) c0[i] = umax_(c0[i], c1[i]);
        merge16<true>(c0);
        sort16<false>(c2);
#pragma unroll
        for (int i = 0; i < 16; ++i) c0[i] = umax_(c0[i], c2[i]);
        merge16<true>(c0);
        sort16<false>(c3);
#pragma unroll
        for (int i = 0; i < 16; ++i) c0[i] = umax_(c0[i], c3[i]);
        merge16<true>(c0);
        const float m = unordmap(c0[0] & ~0xFFu) * rstd2;
        float e[8]; float sum = 0.f; u32 ex[8];
#pragma unroll
        for (int k = 0; k < 8; ++k) { const u32 key = hi ? c0[k + 8] : c0[k]; const float ts = unordmap(key & ~0xFFu);
            e[k] = __builtin_amdgcn_exp2f((ts * rstd2 - m) * LOG2E); sum += e[k];
            const u32 flat = 255u - (key & 255u); ex[k] = (u32)IDXB[flat >> 4] * NKEY + (u32)IDXB[16 + (flat & 15u)]; }
        sum += __shfl_xor(sum, 32);
        const float inv = 1.f / sum;
        v4u exw; exw.x = ex[0] | (ex[1] << 16); exw.y = ex[2] | (ex[3] << 16); exw.z = ex[4] | (ex[5] << 16); exw.w = ex[6] | (ex[7] << 16);
        *(LAS v4u*)(EXL + tok * EX_STRIDE + w * 16 + hi * 8) = exw;
        *(LAS f32x4*)(GTL + tok * GT_STRIDE + w * 16 + hi * 8) = (f32x4){e[0] * inv, e[1] * inv, e[2] * inv, e[3] * inv};
        *(LAS f32x4*)(GTL + tok * GT_STRIDE + w * 16 + hi * 8 + 4) = (f32x4){e[4] * inv, e[5] * inv, e[6] * inv, e[7] * inv};
    }
}
__device__ __forceinline__ float gelu_fast(float x) {
    const float u2 = x * (1.5957691216057308f + 0.07135481627f * x * x);
    return x * __builtin_amdgcn_rcpf(1.f + __builtin_amdgcn_exp2f(-1.4426950408889634f * u2));
}
typedef float f32x2 __attribute__((ext_vector_type(2)));

__device__ __forceinline__ void sort128(u32 (&k)[8], int m) {
#pragma unroll
    for (int K = 2; K <= 128; K <<= 1) {
#pragma unroll
        for (int S = K >> 1; S > 0; S >>= 1) {
            if (S >= 8) {
                const int mm = S >> 3; const bool lower = (m & mm) == 0, up = (K == 128) ? true : ((m & (K >> 3)) == 0), keepmin = (lower == up);
#pragma unroll
                for (int r = 0; r < 8; ++r) { const u32 o = (u32)__shfl_xor((int)k[r], mm); const u32 mn = umin_(k[r], o), mx = umax_(k[r], o); k[r] = keepmin ? mn : mx; }
            } else {
#pragma unroll
                for (int r = 0; r < 8; ++r) { const int r2 = r ^ S;
                    if (r2 > r) { const u32 a = k[r], b = k[r2], mn = umin_(a, b), mx = umax_(a, b);
                        if (K < 8) { const bool up = (r & K) == 0; k[r] = up ? mn : mx; k[r2] = up ? mx : mn; }
                        else { const bool up = (K == 128) ? true : ((m & (K >> 3)) == 0); k[r] = up ? mn : mx; k[r2] = up ? mx : mn; } } }
            }
        }
    }
}
typedef int v8i __attribute__((ext_vector_type(8)));
__device__ __forceinline__ void eval_mf(Frame& F, const unsigned char* u4, const unsigned char* v4, const float* suv, const float* fg, float* out, int t0) {
    int lane = F.lane; asm volatile("" : "+v"(lane));
    const int g = lane >> 4, m = lane & 15;
    const LAS unsigned short* EXL = (const LAS unsigned short*)(F.lds + RING_OFF + L_EX);
    const LAS float* GTL = (const LAS float*)(F.lds + RING_OFF + L_GT);
    const LAS float* RST = (const LAS float*)(F.lds + RING_OFF + L_RST);
    LAS u32* SKW = (LAS u32*)(F.lds + RING_OFF + L_IDX) + F.wave * 512;
    LAS u32* SK = SKW + g * 128;
    for (int pass = 0; pass < 4; ++pass) {
        const int tb4 = 32 * pass + 4 * F.wave, tok = tb4 + g;
        { u32 k[8]; const v4u ev = *(const LAS v4u*)(EXL + tok * EX_STRIDE + 8 * m); const u32 s0 = (u32)(8 * m);
          k[0] = ((ev.x & 0xffffu) << 7) | s0; k[1] = ((ev.x >> 16) << 7) | (s0 + 1); k[2] = ((ev.y & 0xffffu) << 7) | (s0 + 2); k[3] = ((ev.y >> 16) << 7) | (s0 + 3);
          k[4] = ((ev.z & 0xffffu) << 7) | (s0 + 4); k[5] = ((ev.z >> 16) << 7) | (s0 + 5); k[6] = ((ev.w & 0xffffu) << 7) | (s0 + 6); k[7] = ((ev.w >> 16) << 7) | (s0 + 7);
          sort128(k, m);
          *(LAS v4u*)(SK + m * 8) = (v4u){k[0], k[1], k[2], k[3]}; *(LAS v4u*)(SK + m * 8 + 4) = (v4u){k[4], k[5], k[6], k[7]}; }
        asm volatile("" ::: "memory");
        v8i hb[8];
#pragma unroll
        for (int st = 0; st < 8; ++st) hb[st] = (v8i){0, 0, 0, 0, 0, 0, 0, 0};
        if (m < 4) { const float rq = RST[tb4 + m]; const float* xr = out + (size_t)(t0 + tb4 + m) * DMODEL + 32 * g;
#pragma unroll
            for (int st = 0; st < 8; ++st)
#pragma unroll
                for (int q = 0; q < 8; ++q) { const f32x4 xa = *(const GAS f32x4*)(xr - 32 * g + 128 * st + 64 * (q >> 2) + 16 * g + 4 * (q & 3)); int w = 0;
                    w = __builtin_amdgcn_cvt_pk_fp8_f32(xa[0] * rq, xa[1] * rq, w, false); w = __builtin_amdgcn_cvt_pk_fp8_f32(xa[2] * rq, xa[3] * rq, w, true); hb[st][q] = w; } }
        f32x2 y[32];
#pragma unroll
        for (int q = 0; q < 32; ++q) y[q] = (f32x2){0.f, 0.f};
        float* xrow = out + (size_t)(t0 + tok) * DMODEL + 64 * m;
        const LAS float* gtr = GTL + tok * GT_STRIDE;
        for (int i = 0; i < 128; i += 4) {
            const u32 keyr = SKW[(m & 3) * 128 + i + (m >> 2)];
            const unsigned char* ap = u4 + (keyr >> 7) * 512u + 16u * (u32)g;
            v4u af[8];
#pragma unroll
            for (int st = 0; st < 8; ++st) af[st] = *(const GAS v4u*)(ap + 64 * st);
            const v4u kq = *(const LAS v4u*)(SK + i);
            f32x2 sc[4]; float gate[4];
#pragma unroll
            for (int s4 = 0; s4 < 4; ++s4) { sc[s4] = *(const GAS f32x2*)(suv + 2 * (kq[s4] >> 7)); gate[s4] = gtr[kq[s4] & 127u]; }
            f32x4 D = (f32x4){0.f, 0.f, 0.f, 0.f};
#pragma unroll
            for (int st = 0; st < 8; ++st) { const v8i a8 = (v8i){(int)af[st].x, (int)af[st].y, (int)af[st].z, (int)af[st].w, 0, 0, 0, 0};
                D = __builtin_amdgcn_mfma_scale_f32_16x16x128_f8f6f4(a8, hb[st], D, 4, 0, 0, 0x7f7f7f7f, 0, 0x7f7f7f7f); }
            asm volatile("" ::: "memory");
            v4u vb[4][2];
#pragma unroll
            for (int s4 = 0; s4 < 4; ++s4) { const u32 ro = (kq[s4] >> 7) * 512u + 32u * (u32)m; vb[s4][0] = *(const GAS v4u*)(v4 + ro); vb[s4][1] = *(const GAS v4u*)(v4 + ro + 16); }
            const int sel = lane & 3; const float mine = sel == 0 ? D[0] : sel == 1 ? D[1] : sel == 2 ? D[2] : D[3];
#pragma unroll
            for (int s4 = 0; s4 < 4; ++s4) { const float pre = __uint_as_float((unsigned)__builtin_amdgcn_ds_bpermute(4 * (g + 16 * s4), (int)__float_as_uint(mine)));
                const float act = gelu_fast(pre * sc[s4][0]) * (gate[s4] * sc[s4][1]); const f32x2 b2 = (f32x2){act, act};
#pragma unroll
                for (int c = 0; c < 2; ++c)
#pragma unroll
                    for (int d = 0; d < 4; ++d) { const unsigned w_ = vb[s4][c][d]; const int hq = 16 * c + 4 * d;
                        y[hq] = __builtin_elementwise_fma(__builtin_amdgcn_cvt_scalef32_pk_f32_fp4(w_, 1.0f, 0), b2, y[hq]); y[hq + 1] = __builtin_elementwise_fma(__builtin_amdgcn_cvt_scalef32_pk_f32_fp4(w_, 1.0f, 1), b2, y[hq + 1]);
                        y[hq + 2] = __builtin_elementwise_fma(__builtin_amdgcn_cvt_scalef32_pk_f32_fp4(w_, 1.0f, 2), b2, y[hq + 2]); y[hq + 3] = __builtin_elementwise_fma(__builtin_amdgcn_cvt_scalef32_pk_f32_fp4(w_, 1.0f, 3), b2, y[hq + 3]); } }
        }
        float ss = 0.f;
#pragma unroll
        for (int q = 0; q < 16; ++q) { const f32x4 xa = *(const GAS f32x4*)(xrow + 4 * q); y[2 * q][0] += xa[0]; y[2 * q][1] += xa[1]; y[2 * q + 1][0] += xa[2]; y[2 * q + 1][1] += xa[3];
            ss += (y[2 * q][0] * y[2 * q][0] + y[2 * q][1] * y[2 * q][1]) + (y[2 * q + 1][0] * y[2 * q + 1][0] + y[2 * q + 1][1] * y[2 * q + 1][1]); }
        ss += __shfl_xor(ss, 1); ss += __shfl_xor(ss, 2); ss += __shfl_xor(ss, 4); ss += __shfl_xor(ss, 8);
        const float rs = rsqrtf(ss * (1.f / DMODEL) + RMS_EPS);
        asm volatile("" ::: "memory");
#pragma unroll
        for (int q = 0; q < 16; ++q) { const f32x4 gq = *(const GAS f32x4*)(fg + 64 * m + 4 * q); f32x4 o; o[0] = y[2 * q][0] * rs * gq[0]; o[1] = y[2 * q][1] * rs * gq[1]; o[2] = y[2 * q + 1][0] * rs * gq[2]; o[3] = y[2 * q + 1][1] * rs * gq[3];
            *(GAS f32x4*)(xrow + 4 * q) = o; }
    }
}
__device__ __forceinline__ void peer_phase(Frame& F, const Args& a) {
    unsigned char* ws = a.ws;
    for (int tile = F.vcu; tile < T / TOK; tile += F.G) {
        route_tile(F, (const bf16*)(ws + WS_QP), (const bf16*)(ws + WS_SKB), (const float*)(ws + WS_SUMSQ), tile * TOK);
        __syncthreads();
        eval_mf(F, ws + WS_U8, ws + WS_V8, (const float*)(ws + WS_SU), a.in[19], a.out, tile * TOK);
        __syncthreads();
    }
}
}

namespace lru {
typedef float f32x16 __attribute__((ext_vector_type(16)));
constexpr int TOKT = 128, NTILE = SEQ / TOKT;
constexpr int WAVE_LDS = 14336, L_XS = 0, L_XC = 4608, L_GS = 9216, XC_STRIDE = 72  , L_SS = 8 * WAVE_LDS;
static_assert(L_SS + 32 * 8 * 4 <= RING_BYTES, "LRU LDS map");
__device__ __forceinline__ float bf2f(unsigned short h) { return __uint_as_float((unsigned)h << 16); }
__device__ __forceinline__ int crow16(int r) { return (r & 3) + 8 * (r >> 2); }
__device__ __forceinline__ float sigm(float x) { return __builtin_amdgcn_rcpf(1.f + __builtin_amdgcn_exp2f(-LOG2E * x)); }

template <bool FINAL> __device__ __forceinline__ void lru_tile(Frame& F, const Args& args, int tile) {
    int lane = F.lane; asm volatile("" : "+v"(lane));
    const int w = F.wave, j32 = lane & 31, hi = lane >> 5;
    unsigned char* ws = args.ws;
    const bf16* xr = (const bf16*)(ws + WS_XR); const bf16* gr = (const bf16*)(ws + WS_GR); float* carry = (float*)(ws + WS_CARRY);
    const float* cw = args.in[3]; const float* cb = args.in[4]; const float* ba = args.in[6]; const float* bx = args.in[8]; const float* lam = args.in[9];
    const int b = tile / NTILE, jt = tile % NTILE; const size_t trow0 = (size_t)b * SEQ + (size_t)jt * TOKT;
    LAS unsigned char* wl = F.lds + RING_OFF + w * WAVE_LDS;
    LAS unsigned short* XS = (LAS unsigned short*)(wl + L_XS); LAS unsigned short* XC = (LAS unsigned short*)(wl + L_XC); LAS unsigned short* GS = (LAS unsigned short*)(wl + L_GS);
    LAS float* SS = (LAS float*)(F.lds + RING_OFF + L_SS);
    float c_ba[2], c_bx[2], c_sp[2], c_cb[2], c_cw[2][4];
#pragma unroll
    for (int n = 0; n < 2; ++n) { const int c = 64 * w + 32 * n + j32; c_ba[n] = ba[c]; c_bx[n] = bx[c]; c_cb[n] = cb[c];
        const float l = lam[c]; c_sp[n] = 8.f * LOG2E * (fmaxf(-l, 0.f) + log1pf(expf(-fabsf(l))));
#pragma unroll
        for (int k = 0; k < 4; ++k) c_cw[n][k] = cw[k * LW + c]; }
    const bf16* wax = (const bf16*)(ws + WS_WAX);
    float hc[2] = {0.f, 0.f}, ap[2] = {1.f, 1.f};
    if (FINAL) { const float* cin = (const float*)(ws + WS_CIN) + (size_t)(b * NTILE + jt) * LW + 64 * w + j32; hc[0] = cin[0]; hc[1] = cin[32]; }
    v4u pfx[5], pfg[4];
#define LRU_FETCH(B) do { const size_t tbn_ = trow0 + (B) * 32; _Pragma("unroll") for (int q_ = 0; q_ < 5; ++q_) { const int pc_ = lane + 64 * q_, row_ = pc_ >> 3, c8_ = pc_ & 7; \
        const bool z_ = (jt == 0 && (B) == 0 && row_ < 3) || pc_ >= 35 * 8; const v4u v_ = *(const GAS v4u*)(xr + (tbn_ + (z_ ? 3 : row_) - 3) * LW + w * 64 + c8_ * 8); pfx[q_] = z_ ? (v4u){0u, 0u, 0u, 0u} : v_; } \
        if (FINAL) { _Pragma("unroll") for (int q_ = 0; q_ < 4; ++q_) { const int pc_ = lane + 64 * q_; pfg[q_] = *(const GAS v4u*)(gr + (tbn_ + (pc_ >> 3)) * LW + w * 64 + (pc_ & 7) * 8); } } } while (0)
    LRU_FETCH(0);
    for (int blk = 0; blk < 4; ++blk) {
        const size_t tb = trow0 + blk * 32;
        int ln = lane; asm volatile("" : "+v"(ln));
        const int k32 = ln & 31;
#pragma unroll
        for (int q = 0; q < 5; ++q) { const int pc = ln + 64 * q; if (pc < 35 * 8) *(LAS v4u*)((LAS unsigned char*)XS + (pc >> 3) * 128 + (pc & 7) * 16) = pfx[q]; }
        if (FINAL) {
#pragma unroll
            for (int q = 0; q < 4; ++q) { const int pc = ln + 64 * q; *(LAS v4u*)((LAS unsigned char*)GS + (pc >> 3) * 128 + (pc & 7) * 16) = pfg[q]; } }
        if (blk < 3) { LRU_FETCH(blk + 1); }
        asm volatile("" ::: "memory");
        float xc[2][16];
#pragma unroll
        for (int n = 0; n < 2; ++n)
#pragma unroll
            for (int g = 0; g < 4; ++g) { float xv[7];
#pragma unroll
                for (int q = 0; q < 7; ++q) xv[q] = bf2f(XS[(8 * g + 4 * hi + q) * 64 + 32 * n + j32]);
#pragma unroll
                for (int e = 0; e < 4; ++e) xc[n][4 * g + e] = c_cb[n] + ((c_cw[n][0] * xv[e] + c_cw[n][1] * xv[e + 1]) + (c_cw[n][2] * xv[e + 2] + c_cw[n][3] * xv[e + 3])); }
#pragma unroll
        for (int n = 0; n < 2; ++n)
#pragma unroll
            for (int r = 0; r < 16; ++r) XC[(crow16(r) + 4 * hi) * XC_STRIDE + 32 * n + j32] = (unsigned short)f2bf(xc[n][r]);
        asm volatile("" ::: "memory");
        bf16x8 af[4];
#pragma unroll
        for (int ks = 0; ks < 4; ++ks) af[ks] = *(const LAS bf16x8*)(XC + j32 * XC_STRIDE + 16 * ks + 8 * hi);
        asm volatile("" ::: "memory");
        float yv[2][16];
#pragma unroll
        for (int n = 0; n < 2; ++n) {
            f32x16 R = {}, I = {};
            bf16x8 fa[4], fx[4];
#pragma unroll
            for (int ks = 0; ks < 4; ++ks) { fa[ks] = *(const GAS bf16x8*)(wax + (size_t)(((w * 2 + 0) * 2 + n) * 4 + ks) * 512 + lane * 8); fx[ks] = *(const GAS bf16x8*)(wax + (size_t)(((w * 2 + 1) * 2 + n) * 4 + ks) * 512 + lane * 8); }
#pragma unroll
            for (int ks = 0; ks < 4; ++ks) { R = __builtin_amdgcn_mfma_f32_32x32x16_bf16(af[ks], fa[ks], R, 0, 0, 0); I = __builtin_amdgcn_mfma_f32_32x32x16_bf16(af[ks], fx[ks], I, 0, 0, 0); }
            float av[16], uv[16];
#pragma unroll
            for (int r = 0; r < 16; ++r) { const float rg = sigm(R[r] + c_ba[n]), ig = sigm(I[r] + c_bx[n]); const float a_ = __builtin_amdgcn_exp2f(-rg * c_sp[n]);
                av[r] = a_; uv[r] = __builtin_amdgcn_sqrtf(fmaxf(1.f - a_ * a_, 0.f)) * (ig * xc[n][r]); }
            float Ar[4], Hr[4], hst[4];
#pragma unroll
            for (int g = 0; g < 4; ++g) { Ar[g] = (av[4 * g] * av[4 * g + 1]) * (av[4 * g + 2] * av[4 * g + 3]);
                Hr[g] = ((uv[4 * g] * av[4 * g + 1] + uv[4 * g + 1]) * av[4 * g + 2] + uv[4 * g + 2]) * av[4 * g + 3] + uv[4 * g + 3]; }
            float hin = hc[n];
#pragma unroll
            for (int g = 0; g < 4; ++g) { float o1 = Ar[g] * hin + Hr[g]; const float x = __shfl_xor(o1, 32); const float hg = hi ? x : hin; o1 = Ar[g] * hg + Hr[g]; hst[g] = hg;
                const float y = __shfl_xor(o1, 32); hin = hi ? o1 : y;
                if (!FINAL) ap[n] *= Ar[g] * __shfl_xor(Ar[g], 32); }
            hc[n] = hin;
            if (FINAL) {
#pragma unroll
                for (int g = 0; g < 4; ++g) { float h = hst[g];
#pragma unroll
                    for (int e = 0; e < 4; ++e) { const int r = 4 * g + e; h = av[r] * h + uv[r]; yv[n][r] = h * bf2f(GS[(crow16(r) + 4 * hi) * 64 + 32 * n + j32]); } } }
        }
        if (FINAL) {
#pragma unroll
            for (int r = 0; r < 16; ++r) { float s = yv[0][r] * yv[0][r] + yv[1][r] * yv[1][r];
                s += __shfl_xor(s, 1); s += __shfl_xor(s, 2); s += __shfl_xor(s, 4); s += __shfl_xor(s, 8); s += __shfl_xor(s, 16);
                if (j32 == 0) SS[(crow16(r) + 4 * hi) * 8 + w] = s; }
            __syncthreads();
            bf16* ymix = (bf16*)(ws + WS_H);
#pragma unroll
            for (int r = 0; r < 16; ++r) { const int tk = crow16(r) + 4 * hi; const f32x4 s0 = *(const LAS f32x4*)(SS + tk * 8), s1 = *(const LAS f32x4*)(SS + tk * 8 + 4);
                const float rstd = rsqrtf(((s0[0] + s0[1]) + (s0[2] + s0[3]) + (s1[0] + s1[1]) + (s1[2] + s1[3])) * (1.f / LW) + RMS_EPS);
                bf16* yp = ymix + (tb + tk) * DMODEL + 64 * w + k32;
                yp[0] = (bf16)f2bf(yv[0][r] * rstd); yp[32] = (bf16)f2bf(yv[1][r] * rstd); }
            __syncthreads();
        }
    }
#undef LRU_FETCH
    if (!FINAL) { if (hi == 0) { float* cp = carry + ((size_t)(b * NTILE + jt) * 2) * LW + 64 * w + j32;
#pragma unroll
        for (int n = 0; n < 2; ++n) { cp[32 * n] = ap[n]; cp[LW + 32 * n] = hc[n]; } } }
    else {
        const bf16* ob = (const bf16*)(ws + WS_O); bf16* ymix = (bf16*)(ws + WS_H);
        for (int i0 = 0; i0 < 16; i0 += 4) {
            v4u vv[4];
#pragma unroll
            for (int i = 0; i < 4; ++i) vv[i] = *(const GAS v4u*)(ob + (trow0 + 16 * w + i0 + i) * AW + 8 * lane);
            float ssq[4];
#pragma unroll
            for (int i = 0; i < 4; ++i) { float s = 0.f;
#pragma unroll
                for (int c = 0; c < 4; ++c) { const float lo = __uint_as_float(vv[i][c] << 16), hi2 = __uint_as_float(vv[i][c] & 0xffff0000u); s += lo * lo + hi2 * hi2; }
                ssq[i] = s; }
#pragma unroll
            for (int o = 1; o < 64; o <<= 1) {
#pragma unroll
                for (int i = 0; i < 4; ++i) ssq[i] += __shfl_xor(ssq[i], o); }
#pragma unroll
            for (int i = 0; i < 4; ++i) { const float rstd = rsqrtf(ssq[i] * (1.f / AW) + RMS_EPS); v4u o;
#pragma unroll
                for (int c = 0; c < 4; ++c) o[c] = pk2(__uint_as_float(vv[i][c] << 16) * rstd, __uint_as_float(vv[i][c] & 0xffff0000u) * rstd);
                *(GAS v4u*)(ymix + (trow0 + 16 * w + i0 + i) * DMODEL + LW + 8 * lane) = o; } }
    }
}
__device__ __forceinline__ void norm_pass(Frame& F, const Args& a) {
    unsigned char* ws = a.ws; float* nrm = (float*)(ws + WS_NRM);
    const int gw = F.vcu * NWAVES + F.wave, NGW = F.G * NWAVES, lane = F.lane;
    for (int it = gw; it < 2 * BATCH * (SEQ / 64); it += NGW) {
        const int which = it / (BATCH * (SEQ / 64)), r = it % (BATCH * (SEQ / 64)), b = r / (SEQ / 64), t = r % (SEQ / 64);
        const bf16* src = (const bf16*)(ws + (which ? WS_K : WS_Q)) + ((size_t)b * SEQ + 64 * t) * AW + 8 * lane;
        float mx = 0.f;
#pragma unroll 8
        for (int i = 0; i < 64; ++i) { const v4u v = *(const GAS v4u*)(src + (size_t)i * AW); float s = 0.f;
#pragma unroll
            for (int c = 0; c < 4; ++c) { const float lo = __uint_as_float(v[c] << 16), hi = __uint_as_float(v[c] & 0xffff0000u); s += lo * lo + hi * hi; }
            s += __shfl_xor(s, 1); s += __shfl_xor(s, 2); s += __shfl_xor(s, 4); mx = fmaxf(mx, s); }
        if ((lane & 7) == 0) nrm[which * 4096 + (b * NHEADS + (lane >> 3)) * 128 + t] = sqrtf(mx) * 1.0001f;
    }
}
__device__ __forceinline__ void carry_prefix(Frame& F, const Args& a, int b) {
    const float* carry = (const float*)(a.ws + WS_CARRY) + (size_t)b * NTILE * 2 * LW + F.tid; float* cin = (float*)(a.ws + WS_CIN) + (size_t)b * NTILE * LW + F.tid;
    float c = 0.f;
    for (int j0 = 0; j0 < NTILE; j0 += 8) { float A[8], H[8];
#pragma unroll
        for (int j = 0; j < 8; ++j) { A[j] = carry[(size_t)(j0 + j) * 2 * LW]; H[j] = carry[(size_t)(j0 + j) * 2 * LW + LW]; }
#pragma unroll
        for (int j = 0; j < 8; ++j) { cin[(size_t)(j0 + j) * LW] = c; c = A[j] * c + H[j]; } }
}
template <bool FINAL> __device__ __forceinline__ void lru_phase(Frame& F, const Args& a) {
    for (int tile = F.vcu; tile < BATCH * NTILE; tile += F.G) { lru_tile<FINAL>(F, a, tile); __syncthreads(); }
}
}
__global__ void __launch_bounds__(NWAVES * 64, 2) mk_fwd(Args args) {
    extern __shared__ __attribute__((aligned(16))) unsigned char lds[];
    Frame F;
    F.lds = (LAS unsigned char*)lds;
    F.MISC = (volatile LAS unsigned*)(F.lds + MISC_OFF);
    F.wave = __builtin_amdgcn_readfirstlane((int)threadIdx.x >> 6); F.lane = (int)__builtin_amdgcn_mbcnt_hi(~0u, __builtin_amdgcn_mbcnt_lo(~0u, 0u)); F.tid = F.wave * 64 + F.lane;
    F.G = gridDim.x; { const int bx = blockIdx.x; F.vcu = (F.G % 8 == 0) ? (bx % 8) * (F.G / 8) + bx / 8 : bx; }
    unsigned char* ws = args.ws;
    F.ctl = (gu32*)(ws + WS_CTL);
    for (int u = F.tid; u < (LDS_BYTES - LDSCTL_OFF) / 4; u += NWAVES * 64) ((LAS unsigned*)(F.lds + LDSCTL_OFF))[u] = 0u;
    __syncthreads();
    XcdBarrier bar = xcd_barrier_post((unsigned*)(F.ctl + CW_BAR) + args.li * XCD_BAR_WORDS, F.MISC + 8, F.wave);
    const int lo = args.ph_lo, hi = args.ph_hi;
#define IN(k) (lo <= (k) && (k) < hi)
#define BOTH(k) (IN(k) && IN((k) + 1))
#define GRID_BAR() xcd_barrier(bar)

    if (IN(0)) { for (int rp = 0; rp < REPS(0); ++rp) { if (rp) GRID_BAR(); p0_prologue(F, args); } if (BOTH(0)) GRID_BAR(); }

    if (IN(1)) for (int rp = 0; rp < REPS(1); ++rp) {
        if (rp) GRID_BAR();
        if (F.vcu < BATCH * NHEADS) fcum_unit(F, F.vcu, (const float*)(ws + WS_LOGF), (float*)(ws + WS_FCUM));
        pg8::Gemm g{(const pg8::bf16_t*)(ws + WS_H), (const pg8::bf16_t*)(ws + WS_WIN), T, NG1, DMODEL}; pg8::StaticOrder S; S.init(T, NG1, F.G, (int)blockIdx.x);
        pg8::EpiG1 E{(pg8::bf16_t*)(ws + WS_XR), SPLIT_STRIDE, QSCALE};
        pg8::gemm_phase<pg8::EpiG1, pg8::StaticOrder, true, true>(F.lds + RING_OFF, g, S, E, F.wave);
        if (BOTH(1) && rp == REPS(1) - 1) GRID_BAR();
    }
    if (IN(2)) { for (int rp = 0; rp < REPS(2); ++rp) { if (rp) GRID_BAR(); lru::lru_phase<false>(F, args); lru::norm_pass(F, args); } if (BOTH(2)) GRID_BAR(); }
    if (IN(3)) for (int rp = 0; rp < REPS(3); ++rp) {
        if (rp) { GRID_BAR(); if (F.wave == 0 && F.lane == 0 && blockIdx.x == 0) __hip_atomic_store((unsigned*)(F.ctl + CW_ATTQ), 0u, __ATOMIC_RELAXED, __HIP_MEMORY_SCOPE_AGENT); GRID_BAR(); }
        static_assert(attn_body::ATTN_LDS_BYTES <= RING_BYTES, "attention LDS vs frame");
        if (rp == 0 && F.vcu < BATCH) lru::carry_prefix(F, args, F.vcu);
        const attn_body::AttnTensors AT{(const attn_body::bf16*)(ws + WS_Q), (const attn_body::bf16*)(ws + WS_K), (const attn_body::bf16*)(ws + WS_V), (attn_body::bf16*)(ws + WS_O), (const float*)(ws + WS_FCUM), (const float*)(ws + WS_NRM)};
        attn_body::attn_phase<8>((char*)lds + RING_OFF, AT, (unsigned*)(F.ctl + CW_ATTQ), F.MISC + 24, F.wave);
        if (BOTH(3) && rp == REPS(3) - 1) GRID_BAR();
    }
    if (IN(4)) { for (int rp = 0; rp < REPS(4); ++rp) { if (rp) GRID_BAR(); lru::lru_phase<true>(F, args); } if (BOTH(4)) GRID_BAR(); }
    if (IN(5)) {
        pg8::Gemm g{(const pg8::bf16_t*)(ws + WS_H), (const pg8::bf16_t*)(ws + WS_WOUT), T, DMODEL, DMODEL}; pg8::StaticOrder S; S.init(T, DMODEL, F.G, (int)blockIdx.x);
        pg8::EpiG2 E{args.in[0], args.out, (pg8::bf16_t*)(ws + WS_X1B), (float*)(ws + WS_SUMSQ), DMODEL};
        pg8::gemm_phase<pg8::EpiG2, pg8::StaticOrder, true, true>(F.lds + RING_OFF, g, S, E, F.wave);
        if (BOTH(5)) GRID_BAR();
    }
    if (IN(6)) for (int rp = 0; rp < REPS(6); ++rp) {
        if (rp) GRID_BAR();
        pg8::Gemm g{(const pg8::bf16_t*)(ws + WS_X1B), (const pg8::bf16_t*)(ws + WS_WQ), T, QPW, DMODEL}; pg8::StaticOrder S; S.init(T, QPW, F.G, (int)blockIdx.x);
        pg8::EpiG3 E{(pg8::bf16_t*)(ws + WS_QP), QPW};
        pg8::gemm_phase<pg8::EpiG3, pg8::StaticOrder, true, true>(F.lds + RING_OFF, g, S, E, F.wave);
        if (BOTH(6) && rp == REPS(6) - 1) GRID_BAR();
    }
    if (IN(7)) { peer::peer_phase(F, args); }
#undef IN
#undef BOTH
#undef GRID_BAR
}

#ifndef MK_FRAME_MASK
#define MK_FRAME_MASK 0xFF
#endif
extern "C" void kernel_launch(void* const* d_in, const int* in_sizes, int n_in, void* d_out, int out_size, void* d_ws, size_t ws_size, hipStream_t stream) {
    static int grid = 0;
    if (grid == 0) {
        if (n_in != 20 || in_sizes[0] != T * DMODEL || out_size != T * DMODEL || ws_size < WS_END) { fprintf(stderr, "kernel_launch: unexpected shapes (n_in %d, ws %zu)\n", n_in, ws_size); grid = -1; return; }
        int dev = 0, cus = 0;
        if (hipGetDevice(&dev) != hipSuccess || hipDeviceGetAttribute(&cus, hipDeviceAttributeMultiprocessorCount, dev) != hipSuccess) { grid = -1; return; }
        if (hipFuncSetAttribute((const void*)mk_fwd, hipFuncAttributeMaxDynamicSharedMemorySize, LDS_BYTES) != hipSuccess) { fprintf(stderr, "kernel_launch: hipFuncSetAttribute failed\n"); grid = -1; return; }
        (void)hipGetLastError();
        grid = cus;
    }
    if (grid < 0) return;
    using namespace naive;
    const float* x = (const float*)d_in[0]; const float* g1 = (const float*)d_in[1]; const float* w_in = (const float*)d_in[2];
    const float* cw = (const float*)d_in[3]; const float* cb = (const float*)d_in[4]; const float* wa = (const float*)d_in[5]; const float* ba = (const float*)d_in[6];
    const float* wx = (const float*)d_in[7]; const float* bx = (const float*)d_in[8]; const float* lam = (const float*)d_in[9]; const float* bfv = (const float*)d_in[10];
    const float* gn_l = (const float*)d_in[11]; const float* gn_f = (const float*)d_in[12]; const float* w_out = (const float*)d_in[13]; const float* g2 = (const float*)d_in[14];
    const float* w_q = (const float*)d_in[15]; const float* sk = (const float*)d_in[16]; const float* pu = (const float*)d_in[17]; const float* pv = (const float*)d_in[18]; const float* fg = (const float*)d_in[19];
    char* ws = (char*)d_ws; float* out = (float*)d_out;
    naive::bf16* win_t = (naive::bf16*)(ws + WS_WIN); naive::bf16* wout_t = (naive::bf16*)(ws + WS_WOUT); naive::bf16* wq_t = (naive::bf16*)(ws + WS_WQ); naive::bf16* skb = (naive::bf16*)(ws + WS_SKB); float* wfl = (float*)(ws + WS_WFL);
    float* logf = (float*)(ws + WS_LOGF); float* fcum = (float*)(ws + WS_FCUM); float* sumsq = (float*)(ws + WS_SUMSQ);
    naive::bf16* h = (naive::bf16*)(ws + WS_H); naive::bf16* xr = (naive::bf16*)(ws + WS_XR); naive::bf16* gr = (naive::bf16*)(ws + WS_GR); naive::bf16* q = (naive::bf16*)(ws + WS_Q); naive::bf16* k = (naive::bf16*)(ws + WS_K); naive::bf16* v = (naive::bf16*)(ws + WS_V);
    naive::bf16* x1b = (naive::bf16*)(ws + WS_X1B); naive::bf16* qp = (naive::bf16*)(ws + WS_QP); naive::bf16* ut = (naive::bf16*)(ws + WS_UT); naive::bf16* vt = (naive::bf16*)(ws + WS_VT); float* la = (float*)(ws + WS_LA); float* lu = (float*)(ws + WS_LU);
    naive::bf16* ymix = h;
    if (hipMemsetAsync((char*)d_ws + WS_CTL, 0, CTL_ZERO_BYTES, stream) != hipSuccess) return;
    Args a{};
    for (int i = 0; i < 20; ++i) a.in[i] = (const float*)d_in[i];
    a.out = out; a.ws = (unsigned char*)d_ws;
    int li = 0;
    for (int p = 0; p < N_PHASES;) {
        if ((MK_FRAME_MASK >> p) & 1) {
            int e = p; while (e < N_PHASES && ((MK_FRAME_MASK >> e) & 1)) ++e;
            a.ph_lo = p; a.ph_hi = e; a.li = li++;
            hipLaunchKernelGGL(mk_fwd, dim3(grid), dim3(NWAVES * 64), LDS_BYTES, stream, a);
            p = e; continue;
        }
        switch (p) {
        case 0: k_prep_w<<<2048, 256, 0, stream>>>(w_in, w_out, gn_l, gn_f, w_q, g2, sk, win_t, wfl, wout_t, wq_t, skb);
                k_prep_tab<<<4096, 256, 0, stream>>>(pu, pv, g2, ut, vt);
                k_prep_x<<<2048, 256, 0, stream>>>(x, g1, wfl, bfv, h, logf); break;
        case 1: k_fcum<<<BATCH * NHEADS, 64, 0, stream>>>(logf, fcum);
                { EpiArgs e{xr, gr, q, k, v, nullptr, nullptr}; k_gemm<1><<<dim3(NG1 / 64, T / 64), 256, 0, stream>>>(h, win_t, T, NG1, DMODEL, e); } break;
        case 2: break;
        case 3: k_attn<<<(BATCH * NHEADS * SEQ) / 4, 256, 0, stream>>>(q, k, v, fcum, (naive::bf16*)(ws + WS_O)); break;
        case 4: k_lru_gates<<<T * NHEADS, 64, 0, stream>>>(xr, cw, cb, wa, ba, wx, bx, lam, la, lu);
                k_lru_scan<<<(BATCH * LW + 63) / 64, 64, 0, stream>>>(la, lu, gr);
                k_ymix<<<2048, 256, 0, stream>>>(lu, (naive::bf16*)(ws + WS_O), ymix); break;
        case 5: { EpiArgs e{x1b, nullptr, nullptr, nullptr, nullptr, x, out}; k_gemm<2><<<dim3(DMODEL / 64, T / 64), 256, 0, stream>>>(ymix, wout_t, T, DMODEL, DMODEL, e); }
                k_sumsq<<<2048, 256, 0, stream>>>(out, sumsq); break;
        case 6: { EpiArgs e{qp, nullptr, nullptr, nullptr, nullptr, nullptr, nullptr}; k_gemm<3><<<dim3(QPW / 64, T / 64), 256, 0, stream>>>(x1b, wq_t, T, QPW, DMODEL, e); } break;
        case 7: k_peer<<<T, 64, 0, stream>>>(qp, skb, sumsq, ut, vt, fg, out); break;
        }
        ++p;
    }
}
```

```cpp
#include <hip/hip_runtime.h>
#include <hip/hip_bf16.h>
#include <cstdio>
#include <cstdint>
#include <cmath>

constexpr int BATCH = 4, SEQ = 8192, DMODEL = 1024, T = BATCH * SEQ;
constexpr int LW = 512, AW = 512, NHEADS = 8, HD = 64, INC = 2568, NG1 = 2560;
constexpr int PH = 8, NKEY = 128, PHALF = 128, TOPK = 16, NEXP = NKEY * NKEY, QPW = 2048;
constexpr float RMS_EPS = 1e-6f;
constexpr float LOG2E = 1.4426950408889634f;
constexpr float QSCALE = 0.125f * LOG2E;
constexpr size_t MiB = 1u << 20;
constexpr size_t WS_CTL = 0, CTL_ZERO_BYTES = 1 * MiB;
constexpr size_t WS_WIN = 2 * MiB, WS_WOUT = 8 * MiB, WS_WQ = 10 * MiB, WS_SKB = 14 * MiB, WS_WFL = 15 * MiB,
                 WS_LOGF = 16 * MiB, WS_FCUM = 17 * MiB, WS_CARRY = 18 * MiB, WS_SUMSQ = 19 * MiB, WS_WAX = 20 * MiB, WS_CIN = 23 * MiB  , WS_NRM = 22 * MiB  ,
                 WS_H = 32 * MiB, WS_XR = 96 * MiB, WS_GR = 128 * MiB, WS_Q = 160 * MiB, WS_K = 192 * MiB, WS_V = 224 * MiB,
                 WS_X1B = 256 * MiB, WS_O = 256 * MiB  , WS_QP = 96 * MiB, WS_UT = 320 * MiB, WS_VT = 352 * MiB, WS_U8 = 320 * MiB, WS_V8 = 336 * MiB, WS_SU = 21 * MiB, WS_SV = 21 * MiB + 65536, WS_LA = 384 * MiB, WS_LU = 448 * MiB, WS_END = 512 * MiB;
constexpr size_t SPLIT_STRIDE = (WS_GR - WS_XR) / 2;
constexpr int CW_TMO = 0, CW_ATTQ = 2048, CW_BAR = 4096;

namespace pg8 {
#define PG8_LAS __attribute__((address_space(3)))
typedef unsigned short bf16_t;
typedef short bf16x8 __attribute__((ext_vector_type(8)));
typedef float f32x4 __attribute__((ext_vector_type(4)));
typedef unsigned u32x4 __attribute__((ext_vector_type(4)));
constexpr int BM = 256, BK = 64, HALF = 128, HTB = HALF * BK * 2  , STAGE_BYTES = 8 * HTB, NXCD = 8, WGM = 8;

__host__ __device__ __forceinline__ int lds_byte(int r, int c) { const int st = (r >> 4) * 2 + (c >> 5), rr = r & 15, cc = c & 31, ob = rr * 64 + cc * 2; return st * 1024 + (ob ^ (((ob >> 9) & 1) << 5)); }
__host__ __device__ __forceinline__ void stage_rc(int b, int& R, int& C) { const int st = b / 1024, sb = b % 1024, swz = sb ^ (((sb >> 9) & 1) << 5); R = (st >> 1) * 16 + swz / 64; C = (st & 1) * 32 + (swz % 64) / 2; }
__host__ __device__ __forceinline__ int perm32(int rho) { const int n = rho >> 4, i = rho & 15; return 8 * (i >> 2) + 4 * n + (i & 3); }

struct Unit { int pm, pn; };
struct Gemm { const bf16_t* A; const bf16_t* Bt; int M, N, K; };

struct StaticOrder {
    int nM, nN, nwg, G, c;
    __host__ __device__ void init(int M, int N, int G_, int c_) { nM = M / BM; nN = N / BM; nwg = nM * nN; G = G_; c = c_; }
    __host__ __device__ bool next(int i, Unit& u) const {
        const long L = (long)i * G + c; if (L >= nwg) return false;
        int wgid = (int)L; { const int q = nwg / NXCD, r = nwg % NXCD, xcd = wgid % NXCD, off = wgid / NXCD; wgid = (xcd < r ? xcd * (q + 1) : r * (q + 1) + (xcd - r) * q) + off; }
        const int nig = WGM * nN, gid = wgid / nig, fm = gid * WGM, gsz = (nM - fm) < WGM ? (nM - fm) : WGM;
        u.pm = fm + ((wgid % nig) % gsz); u.pn = (wgid % nig) / gsz; return true;
    }
    __device__ __forceinline__ void a_ready(const Unit&) const {}
    __device__ __forceinline__ void done(const Unit&) const {}
};

__device__ __forceinline__ unsigned cvt_pk_bf16(float lo, float hi) { unsigned r; asm volatile("v_cvt_pk_bf16_f32 %0, %1, %2" : "=v"(r) : "v"(lo), "v"(hi)); return r; }
typedef unsigned u32x2 __attribute__((ext_vector_type(2)));
__device__ __forceinline__ float gelu_fast(float x) {
    const float u2 = x * (1.5957691216057308f + 0.07135481627f * x * x);
    return x * __builtin_amdgcn_rcpf(1.f + __builtin_amdgcn_exp2f(-1.4426950408889634f * u2));
}
struct EpiG1 {
    static constexpr bool PERM = true, AFTER_DRAIN = false;
    bf16_t* base0; size_t split_stride; float qscale;
    __device__ __forceinline__ void operator()(const f32x4 (&acc)[2][2][4][2], const Unit& u, int wr, int wc, int fr, int fq) const {
        const int s = u.pn >> 1; bf16_t* base = base0 + (size_t)s * split_stride;
        const int row0 = u.pm * BM + wr * 64 + fr, col0 = (u.pn & 1) * 256 + wc * 32 + 8 * fq;
#pragma unroll
        for (int ai = 0; ai < 2; ++ai)
#pragma unroll
            for (int m = 0; m < 4; ++m) { bf16_t* rowp = base + (size_t)(row0 + ai * HALF + m * 16) * 512 + col0;
#pragma unroll
                for (int bj = 0; bj < 2; ++bj) { f32x4 v0 = acc[ai][bj][m][0], v1 = acc[ai][bj][m][1];
                    if (s == 1) {
#pragma unroll
                        for (int e = 0; e < 4; ++e) { v0[e] = gelu_fast(v0[e]); v1[e] = gelu_fast(v1[e]); } }
                    else if (s == 2) { v0 = v0 * qscale; v1 = v1 * qscale; }
                    u32x4 w; w.x = cvt_pk_bf16(v0[0], v0[1]); w.y = cvt_pk_bf16(v0[2], v0[3]); w.z = cvt_pk_bf16(v1[0], v1[1]); w.w = cvt_pk_bf16(v1[2], v1[3]);
                    *(u32x4*)(rowp + bj * HALF) = w; } }
    }
};
struct EpiG2 {
    static constexpr bool PERM = false, AFTER_DRAIN = false;
    const float* resid; float* out; bf16_t* xb; float* sumsq; int ldc;
    __device__ __forceinline__ void operator()(const f32x4 (&acc)[2][2][4][2], const Unit& u, int wr, int wc, int fr, int fq) const {
        const int row0 = u.pm * BM + wr * 64 + fr, col0 = u.pn * BM + wc * 32 + 4 * fq;
#pragma unroll
        for (int ai = 0; ai < 2; ++ai) {
            f32x4 rs[4][2][2];
#pragma unroll
            for (int m = 0; m < 4; ++m) { const size_t off = (size_t)(row0 + ai * HALF + m * 16) * ldc + col0;
#pragma unroll
                for (int bj = 0; bj < 2; ++bj)
#pragma unroll
                    for (int n = 0; n < 2; ++n) rs[m][bj][n] = *(const f32x4*)(resid + off + bj * HALF + n * 16); }
#pragma unroll
            for (int m = 0; m < 4; ++m) { const int r = row0 + ai * HALF + m * 16; const size_t off = (size_t)r * ldc + col0; float ss = 0.f;
#pragma unroll
                for (int bj = 0; bj < 2; ++bj)
#pragma unroll
                    for (int n = 0; n < 2; ++n) { const f32x4 x = rs[m][bj][n] + acc[ai][bj][m][n];
                        *(f32x4*)(out + off + bj * HALF + n * 16) = x; ss += (x[0] * x[0] + x[1] * x[1]) + (x[2] * x[2] + x[3] * x[3]);
                        u32x2 w; w.x = cvt_pk_bf16(x[0], x[1]); w.y = cvt_pk_bf16(x[2], x[3]); *(u32x2*)(xb + off + bj * HALF + n * 16) = w; }
                ss += __shfl_xor(ss, 16); ss += __shfl_xor(ss, 32);
                if (fq == 0) atomicAdd(sumsq + r, ss); }
            asm volatile("" ::: "memory"); }
    }
};
struct EpiG3 {
    static constexpr bool PERM = true, AFTER_DRAIN = false;
    bf16_t* O; int ldc;
    __device__ __forceinline__ void operator()(const f32x4 (&acc)[2][2][4][2], const Unit& u, int wr, int wc, int fr, int fq) const {
        const int row0 = u.pm * BM + wr * 64 + fr, col0 = u.pn * BM + wc * 32 + 8 * fq;
#pragma unroll
        for (int ai = 0; ai < 2; ++ai)
#pragma unroll
            for (int m = 0; m < 4; ++m) { bf16_t* rowp = O + (size_t)(row0 + ai * HALF + m * 16) * ldc + col0;
#pragma unroll
                for (int bj = 0; bj < 2; ++bj) { const f32x4 v0 = acc[ai][bj][m][0], v1 = acc[ai][bj][m][1];
                    u32x4 w; w.x = cvt_pk_bf16(v0[0], v0[1]); w.y = cvt_pk_bf16(v0[2], v0[3]); w.z = cvt_pk_bf16(v1[0], v1[1]); w.w = cvt_pk_bf16(v1[2], v1[3]);
                    *(u32x4*)(rowp + bj * HALF) = w; } }
    }
};

template <class Epi, class Sched, bool ALIGN_EPI = false, bool SP2 = false>
__device__ __forceinline__ void gemm_phase(PG8_LAS unsigned char* lds, const Gemm g, const Sched& S, const Epi& E, int wid_in) {
    const int wid = __builtin_amdgcn_readfirstlane(wid_in), lane = (int)__builtin_amdgcn_mbcnt_hi(~0u, __builtin_amdgcn_mbcnt_lo(~0u, 0u)), tid = wid * 64 + lane, wr = wid >> 2, wc = wid & 3, fr = lane & 15, fq = lane >> 4;
    const int K = g.K, nt = K / BK;
    unsigned voffA[2], voffB[2];
#pragma unroll
    for (int i = 0; i < 2; ++i) { int R, C; stage_rc(tid * 16 + i * 8192, R, C); const int Rb = Epi::PERM ? ((R & ~31) + perm32(R & 31)) : R;
        voffA[i] = (unsigned)(R * K + C) * 2u; voffB[i] = (unsigned)(Rb * K + C) * 2u; }
    const size_t kstep = (size_t)(BK * 2);
    const size_t hstep = (size_t)HALF * K * 2;
    const size_t tstep = 2 * hstep;
    const unsigned ldsw = (unsigned)wid * 1024u;
    const int aoff = lds_byte(wr * 64 + fr, fq * 8), boff = lds_byte(wc * 32 + fr, fq * 8);
#define PG8_SA(b, h) (((b) * 2 + (h)) * HTB)
#define PG8_SB(b, h) ((4 + (b) * 2 + (h)) * HTB)
#define PG8_STAGE(bufoff, gbase, voff) do { _Pragma("unroll") for (int _i = 0; _i < 2; ++_i) \
        __builtin_amdgcn_global_load_lds((const unsigned*)((const char*)(gbase) + (voff)[_i]), (PG8_LAS unsigned*)(lds + (bufoff) + ldsw + _i * 8192), 16, 0, 0); } while (0)
#define PG8_LDA(dst, b, h) do { _Pragma("unroll") for (int m = 0; m < 4; ++m) _Pragma("unroll") for (int k = 0; k < 2; ++k) dst[m][k] = *(const PG8_LAS bf16x8*)(lds + PG8_SA(b, h) + aoff + m * 2048 + k * 1024); } while (0)
#define PG8_LDB(dst, b, h) do { _Pragma("unroll") for (int n = 0; n < 2; ++n) _Pragma("unroll") for (int k = 0; k < 2; ++k) dst[n][k] = *(const PG8_LAS bf16x8*)(lds + PG8_SB(b, h) + boff + n * 2048 + k * 1024); } while (0)
#define PG8_MMA(ai, bj, At, Bt) do { __builtin_amdgcn_s_setprio(1); _Pragma("unroll") for (int m = 0; m < 4; ++m) _Pragma("unroll") for (int n = 0; n < 2; ++n) _Pragma("unroll") for (int k = 0; k < 2; ++k) \
        acc[ai][bj][m][n] = __builtin_amdgcn_mfma_f32_16x16x32_bf16(Bt[n][k], At[m][k], acc[ai][bj][m][n], 0, 0, 0); __builtin_amdgcn_s_setprio(0); } while (0)
#define PG8_WAIT_V(n) asm volatile("s_waitcnt vmcnt(" #n ")" ::: "memory")
#define PG8_WAIT_L(n) asm volatile("s_waitcnt lgkmcnt(" #n ")" ::: "memory")
#define PG8_BAR __builtin_amdgcn_s_barrier()
#define PG8_SCHED __builtin_amdgcn_sched_barrier(0)
    Unit cur, nxt; int ui = 0;
    if (!S.next(0, cur)) return;
    f32x4 acc[2][2][4][2];
#pragma unroll
    for (int a = 0; a < 2; ++a)
#pragma unroll
        for (int b = 0; b < 2; ++b)
#pragma unroll
            for (int m = 0; m < 4; ++m)
#pragma unroll
                for (int n = 0; n < 2; ++n) acc[a][b][m][n] = (f32x4){0.f, 0.f, 0.f, 0.f};
    bf16x8 At[4][2], B0[2][2], B1[2][2];
    const char* cA = (const char*)g.A + (size_t)cur.pm * tstep; const char* cB = (const char*)g.Bt + (size_t)cur.pn * tstep;
    S.a_ready(cur);
    if constexpr (SP2) {
        PG8_STAGE(PG8_SB(0, 0), cB, voffB); PG8_STAGE(PG8_SB(0, 1), cB + hstep, voffB); PG8_STAGE(PG8_SA(0, 0), cA, voffA); PG8_STAGE(PG8_SA(0, 1), cA + hstep, voffA);
        if (wr == 1) PG8_BAR;
        PG8_WAIT_V(2); PG8_BAR;
        PG8_STAGE(PG8_SB(1, 0), cB + kstep, voffB); PG8_STAGE(PG8_SA(1, 0), cA + kstep, voffA); PG8_STAGE(PG8_SB(1, 1), cB + hstep + kstep, voffB);
        PG8_WAIT_V(6); PG8_BAR;
    } else {
        PG8_STAGE(PG8_SB(0, 0), cB, voffB); PG8_STAGE(PG8_SA(0, 0), cA, voffA); PG8_STAGE(PG8_SB(0, 1), cB + hstep, voffB); PG8_STAGE(PG8_SA(0, 1), cA + hstep, voffA);
        if (wr == 1) PG8_BAR;
        PG8_WAIT_V(4); PG8_BAR;
        PG8_STAGE(PG8_SB(1, 0), cB + kstep, voffB); PG8_STAGE(PG8_SA(1, 0), cA + kstep, voffA); PG8_STAGE(PG8_SB(1, 1), cB + hstep + kstep, voffB);
        PG8_WAIT_V(6); PG8_BAR;
    }
    for (;;) {
        const bool has_next = S.next(ui + 1, nxt);
        const char* nA = has_next ? (const char*)g.A + (size_t)nxt.pm * tstep : cA; const char* nB = has_next ? (const char*)g.Bt + (size_t)nxt.pn * tstep : cB;
        for (int t = 0; t < nt; t += 2) {
            const bool last = (t == nt - 2);
            const char* a1 = cA + (size_t)(t + 1) * kstep;
            const char* a2 = last ? nA : cA + (size_t)(t + 2) * kstep; const char* b2 = last ? nB : cB + (size_t)(t + 2) * kstep;
            const char* a3 = a2 + kstep; const char* b3 = b2 + kstep;
            if (last && has_next) S.a_ready(nxt);
            if constexpr (SP2) {
            PG8_LDB(B0, 0, 0); PG8_LDB(B1, 0, 1); PG8_SCHED; PG8_LDA(At, 0, 0); PG8_STAGE(PG8_SA(1, 1), a1 + hstep, voffA);
            PG8_WAIT_V(8); PG8_WAIT_L(0); PG8_BAR; PG8_MMA(0, 0, At, B0); PG8_MMA(0, 1, At, B1); PG8_BAR; PG8_SCHED;
            PG8_LDA(At, 0, 1); PG8_STAGE(PG8_SB(0, 0), b2, voffB); PG8_STAGE(PG8_SB(0, 1), b2 + hstep, voffB); PG8_STAGE(PG8_SA(0, 0), a2, voffA);
            PG8_WAIT_V(8); PG8_WAIT_L(0); PG8_BAR; PG8_MMA(1, 0, At, B0); PG8_MMA(1, 1, At, B1); PG8_BAR; PG8_SCHED;
            PG8_LDB(B0, 1, 0); PG8_LDB(B1, 1, 1); PG8_SCHED; PG8_LDA(At, 1, 0); PG8_STAGE(PG8_SA(0, 1), a2 + hstep, voffA);
            PG8_WAIT_V(8); PG8_WAIT_L(0); PG8_BAR; PG8_MMA(0, 0, At, B0); PG8_MMA(0, 1, At, B1); PG8_BAR; PG8_SCHED;
            PG8_LDA(At, 1, 1); PG8_STAGE(PG8_SB(1, 0), b3, voffB); PG8_STAGE(PG8_SB(1, 1), b3 + hstep, voffB); PG8_STAGE(PG8_SA(1, 0), a3, voffA);
            PG8_WAIT_V(8); PG8_WAIT_L(0); PG8_BAR; PG8_MMA(1, 0, At, B0); PG8_MMA(1, 1, At, B1); PG8_BAR; PG8_SCHED;
            } else {
            PG8_LDB(B0, 0, 0); PG8_SCHED; PG8_LDA(At, 0, 0); PG8_STAGE(PG8_SA(1, 1), a1 + hstep, voffA);
            PG8_WAIT_L(8); PG8_BAR; PG8_WAIT_L(0); PG8_MMA(0, 0, At, B0); PG8_BAR; PG8_SCHED;
            PG8_LDB(B1, 0, 1); PG8_STAGE(PG8_SB(0, 0), b2, voffB);
            PG8_BAR; PG8_WAIT_L(0); PG8_MMA(0, 1, At, B1); PG8_BAR;
            PG8_LDA(At, 0, 1); PG8_STAGE(PG8_SA(0, 0), a2, voffA);
            PG8_BAR; PG8_WAIT_L(0); PG8_MMA(1, 0, At, B0); PG8_BAR; PG8_SCHED;
            PG8_STAGE(PG8_SB(0, 1), b2 + hstep, voffB);
            PG8_WAIT_V(6); PG8_BAR; PG8_MMA(1, 1, At, B1); PG8_BAR;
            PG8_LDB(B0, 1, 0); PG8_SCHED; PG8_LDA(At, 1, 0); PG8_STAGE(PG8_SA(0, 1), a2 + hstep, voffA);
            PG8_WAIT_L(8); PG8_BAR; PG8_WAIT_L(0); PG8_MMA(0, 0, At, B0); PG8_BAR; PG8_SCHED;
            PG8_LDB(B1, 1, 1); PG8_STAGE(PG8_SB(1, 0), b3, voffB);
            PG8_BAR; PG8_WAIT_L(0); PG8_MMA(0, 1, At, B1); PG8_BAR;
            PG8_LDA(At, 1, 1); PG8_STAGE(PG8_SA(1, 0), a3, voffA);
            PG8_BAR; PG8_WAIT_L(0); PG8_MMA(1, 0, At, B0); PG8_BAR; PG8_SCHED;
            PG8_STAGE(PG8_SB(1, 1), b3 + hstep, voffB);
            PG8_WAIT_V(6); PG8_BAR; PG8_MMA(1, 1, At, B1); PG8_BAR;
            }
        }
        if constexpr (ALIGN_EPI) { if (wr == 0) PG8_BAR; }
        if constexpr (!Epi::AFTER_DRAIN) { E(acc, cur, wr, wc, fr, fq); S.done(cur); }
        if (!has_next) break;
#pragma unroll
        for (int a = 0; a < 2; ++a)
#pragma unroll
            for (int b = 0; b < 2; ++b)
#pragma unroll
                for (int m = 0; m < 4; ++m)
#pragma unroll
                    for (int n = 0; n < 2; ++n) acc[a][b][m][n] = (f32x4){0.f, 0.f, 0.f, 0.f};
        cur = nxt; cA = nA; cB = nB; ++ui;
        if constexpr (ALIGN_EPI) { if (wr == 1) PG8_BAR; }
    }
    PG8_WAIT_V(0);
    if constexpr (!ALIGN_EPI) { if (wr == 0) PG8_BAR; }
    PG8_BAR;
    if constexpr (Epi::AFTER_DRAIN) { E.fused(acc, cur, wr, wc, fr, fq, lds, wid, lane); S.done(cur); }
#undef PG8_SA
#undef PG8_SB
#undef PG8_STAGE
#undef PG8_LDA
#undef PG8_LDB
#undef PG8_MMA
#undef PG8_WAIT_V
#undef PG8_WAIT_L
#undef PG8_BAR
#undef PG8_SCHED
}
}
#include <hip/hip_bf16.h>
#include <cmath>
namespace attn_body {
using bf16=__hip_bfloat16;
using bf16x8=__attribute__((ext_vector_type(8)))short;
using s16x4=__attribute__((ext_vector_type(4)))short;
using f32x16=__attribute__((ext_vector_type(16)))float;
using u32x4=__attribute__((ext_vector_type(4)))unsigned;
constexpr int BATCH=4,NHEAD=8,SEQ=8192,D=64,DM=NHEAD*D;
constexpr int NW=8,QBLK=32,QB=QBLK*NW,KVBLK=64,NQB=SEQ/QB;
constexpr int ATTN_PITCH=DM, ATTN_UNIT_ROWS=QB;
__device__ __forceinline__ int crow(int r,int hi){return (r&3)+8*(r>>2)+4*hi;}
#define SBAR() __builtin_amdgcn_sched_barrier(0)
__device__ __forceinline__ void cmask(f32x16&p0,f32x16&p1,int jb,int qrel,int hi){
  const float NEG=-INFINITY; int kb=64*jb+4*hi;
  #pragma unroll
  for(int r=0;r<16;++r){int kv=kb+(r&3)+8*(r>>2); if(kv>qrel)p0[r]=NEG; if(kv+32>qrel)p1[r]=NEG;}
}

constexpr int NSLOT=3, SLOTB=8192;
constexpr int LDS_K=0, LDS_V=NSLOT*SLOTB, LDS_WS=2*NSLOT*SLOTB, LDS_OST=LDS_WS+NW*64*4, LDS_FK=LDS_OST+NW*4096, LDS_BYTES=LDS_FK+SEQ*4;
constexpr float C2=0.125f*1.4426950408889634f;
__device__ __forceinline__ void glds16(const void*gsrc,unsigned lds_dst){unsigned keep;
  asm volatile("s_mov_b32 %0, m0\n\ts_mov_b32 m0, %2\n\ts_nop 0\n\tglobal_load_lds_dwordx4 %1, off\n\ts_mov_b32 m0, %0":"=&s"(keep):"v"(gsrc),"s"(lds_dst):"memory");}
__device__ __forceinline__ float max3f(float a,float b,float c){float r;asm("v_max3_f32 %0, %1, %2, %3":"=v"(r):"v"(a),"v"(b),"v"(c));return r;}
__device__ __forceinline__ float max2f(float a,float b){float r;asm("v_max_f32_e32 %0, %1, %2":"=v"(r):"v"(a),"v"(b));return r;}
__device__ __forceinline__ float fadd_s(float a,float b){float r;asm("v_add_f32_e32 %0, %1, %2":"=v"(r):"v"(a),"v"(b));return r;}
__device__ __forceinline__ float fsub_s(float a,float b){float r;asm("v_sub_f32_e32 %0, %1, %2":"=v"(r):"v"(a),"v"(b));return r;}
typedef float f32x2_t __attribute__((ext_vector_type(2))); typedef __bf16 bf16x2_t __attribute__((ext_vector_type(2)));
__device__ __forceinline__ unsigned cvtpk_s(float lo,float hi){f32x2_t v={lo,hi};bf16x2_t b=__builtin_convertvector(v,bf16x2_t);return __builtin_bit_cast(unsigned,b);}
#define WAIT_BAR(N) asm volatile("s_waitcnt vmcnt(" #N ") lgkmcnt(0)\n\ts_barrier":::"memory")

__device__ __forceinline__ void qkt(f32x16&p0,f32x16&p1,const char*Kslot,const bf16x8*qr,int r32,int hi){
  const char*kb=Kslot+hi*1024+r32*16;
  #pragma unroll
  for(int d0=0;d0<4;++d0){
    const bf16x8 b0=*reinterpret_cast<const bf16x8*>(kb+d0*2048);
    const bf16x8 b1=*reinterpret_cast<const bf16x8*>(kb+d0*2048+512);
    p0=__builtin_amdgcn_mfma_f32_32x32x16_bf16(b0,qr[d0],p0,0,0,0);p1=__builtin_amdgcn_mfma_f32_32x32x16_bf16(b1,qr[d0],p1,0,0,0);}
}
typedef __attribute__((address_space(3))) const char* lds_cptr;
typedef short v4i16_t __attribute__((ext_vector_type(4)));
__device__ __forceinline__ void kload8(bf16x8*kf,lds_cptr kp){
  kf[0]=*(const __attribute__((address_space(3))) bf16x8*)(kp);      kf[1]=*(const __attribute__((address_space(3))) bf16x8*)(kp+512);
  kf[2]=*(const __attribute__((address_space(3))) bf16x8*)(kp+2048); kf[3]=*(const __attribute__((address_space(3))) bf16x8*)(kp+2560);
  kf[4]=*(const __attribute__((address_space(3))) bf16x8*)(kp+4096); kf[5]=*(const __attribute__((address_space(3))) bf16x8*)(kp+4608);
  kf[6]=*(const __attribute__((address_space(3))) bf16x8*)(kp+6144); kf[7]=*(const __attribute__((address_space(3))) bf16x8*)(kp+6656);
}
__device__ __forceinline__ void kload2(bf16x8*kf,lds_cptr kp,int j){ kf[2*j]=*(const __attribute__((address_space(3))) bf16x8*)(kp+j*2048); kf[2*j+1]=*(const __attribute__((address_space(3))) bf16x8*)(kp+j*2048+512); }
__device__ __forceinline__ s16x4 vtr(lds_cptr p){ return __builtin_bit_cast(s16x4,__builtin_amdgcn_ds_read_tr16_b64_v4i16((__attribute__((address_space(3))) v4i16_t*)p)); }
__device__ __forceinline__ float rowmax(const f32x16&p0,const f32x16&p1){
  float a=max3f(p0[0],p0[1],p1[0]),b=max3f(p0[2],p0[3],p1[1]);a=max3f(a,p1[2],p1[3]);
  #pragma unroll
  for(int r=4;r<16;r+=4){a=max3f(a,p0[r],p0[r+1]);b=max3f(b,p0[r+2],p0[r+3]);a=max3f(a,p1[r],p1[r+1]);b=max3f(b,p1[r+2],p1[r+3]);}
  const float m=max2f(a,b);
  auto rr=__builtin_amdgcn_permlane32_swap(__float_as_uint(m),__float_as_uint(m),false,false);
  return max2f(__uint_as_float(rr[0]),__uint_as_float(rr[1]));
}
__device__ __forceinline__ void pv(f32x16*o,int vb,bf16x8 pa0,bf16x8 pa1,bf16x8 pa2,bf16x8 pa3){
  #pragma unroll
  for(int d0=0;d0<2;++d0){s16x4 lo[4],hi[4];
    #pragma unroll
    for(int ks=0;ks<4;++ks){
      asm volatile("ds_read_b64_tr_b16 %0,%1 offset:%c2":"=&v"(lo[ks]):"v"(vb),"i"(d0*4096+ks*1024):"memory");
      asm volatile("ds_read_b64_tr_b16 %0,%1 offset:%c2":"=&v"(hi[ks]):"v"(vb),"i"(d0*4096+ks*1024+512):"memory");}
    asm volatile("s_waitcnt lgkmcnt(0)":::"memory");SBAR();
    #define PK(k) (bf16x8){lo[k][0],lo[k][1],lo[k][2],lo[k][3],hi[k][0],hi[k][1],hi[k][2],hi[k][3]}
    o[d0]=__builtin_amdgcn_mfma_f32_32x32x16_bf16(pa0,PK(0),o[d0],0,0,0);
    o[d0]=__builtin_amdgcn_mfma_f32_32x32x16_bf16(pa1,PK(1),o[d0],0,0,0);
    o[d0]=__builtin_amdgcn_mfma_f32_32x32x16_bf16(pa2,PK(2),o[d0],0,0,0);
    o[d0]=__builtin_amdgcn_mfma_f32_32x32x16_bf16(pa3,PK(3),o[d0],0,0,0);
    #undef PK
  }
}

#ifndef ATTN_STORE16
#define ATTN_STORE16(p,v) (*(u32x4*)(p)=(v))
#endif
template<int THRL> __device__ __forceinline__ void attn_unit(int b,int h,int qb,const bf16*Q,const bf16*__restrict__ K,const bf16*__restrict__ V,bf16*O,const float*__restrict__ Fc,const float*__restrict__ NRM,char*shm,int wid_in){
  const int wid=__builtin_amdgcn_readfirstlane(wid_in); int lane_=(int)__builtin_amdgcn_mbcnt_hi(~0u,__builtin_amdgcn_mbcnt_lo(~0u,0u)); asm volatile("":"+v"(lane_));
  const int lane=lane_,tid=wid*64+lane,r32=lane&31,hi=lane>>5;
  const long rowbase=(long)b*SEQ; const int q0=qb*QB;
  const float*Fbh=Fc+(long)(b*NHEAD+h)*SEQ;
  const int NTF=(q0+QB)/KVBLK; int t_start;
  { const float*QNb=NRM+(b*NHEAD+h)*128,*KNb=NRM+4096+(b*NHEAD+h)*128;
    const float qn=fmaxf(fmaxf(QNb[4*qb],QNb[4*qb+1]),fmaxf(QNb[4*qb+2],QNb[4*qb+3])),knb=fmaxf(fmaxf(KNb[4*qb],KNb[4*qb+1]),fmaxf(KNb[4*qb+2],KNb[4*qb+3]));
    const float fq0=Fbh[q0]*1.4426950408889634f; bool k0=true,k1=true;
    if(lane<NTF-4)k0=!(qn*(KNb[lane]+knb)+(fq0-Fbh[64*lane+63]*1.4426950408889634f)<-40.f);
    if(lane+64<NTF-4)k1=!(qn*(KNb[lane+64]+knb)+(fq0-Fbh[64*(lane+64)+63]*1.4426950408889634f)<-40.f);
    const unsigned long long m0=__ballot(k0),m1=__ballot(k1);
    int tf=m0?(int)__builtin_ctzll(m0):64+(m1?(int)__builtin_ctzll(m1):64);
    tf=tf<NTF-4?tf:NTF-4; t_start=__builtin_amdgcn_readfirstlane(tf&~1); }
  { typedef float f32x4_t __attribute__((ext_vector_type(4))); __attribute__((address_space(3))) float*fk=(__attribute__((address_space(3))) float*)((__attribute__((address_space(3))) char*)shm+LDS_FK); const int n4=(q0+QB)/4;
    for(int i=16*t_start+tid;i<n4;i+=NW*64){ f32x4_t v=*(const f32x4_t*)(Fbh+4*i); v=v*(-1.4426950408889634f); *(__attribute__((address_space(3))) f32x4_t*)(fk+4*i)=v; } }
  float fq2=Fbh[q0+wid*QBLK+r32]*1.4426950408889634f; asm volatile("":"+v"(fq2));
  const bf16*Qw=Q+(rowbase+q0+wid*QBLK)*DM+h*D;
  const bf16*Kh=K+(rowbase+(long)t_start*KVBLK)*DM+h*D,*Vh=V+(rowbase+(long)t_start*KVBLK)*DM+h*D;
  const lds_cptr shm3=(lds_cptr)shm;
  const unsigned lds0=(unsigned)(uintptr_t)shm;
  float*wsf=(float*)(shm+LDS_WS)+wid*64;
  const bf16*ksrc=Kh+(long)lane*DM+wid*8;
  const bf16*vsrc=Vh+(long)(16*(wid&3)+(lane>>2))*DM+(wid>>2)*32+(lane&3)*8;
  const unsigned kdst=lds0+LDS_K+wid*1024, vdst=lds0+LDS_V+wid*1024;
  #define DMA_K(t,slot) glds16(ksrc+(long)(t)*KVBLK*DM,(unsigned)__builtin_amdgcn_readfirstlane(kdst+(slot)))
  #define DMA_V(t,slot) glds16(vsrc+(long)(t)*KVBLK*DM,(unsigned)__builtin_amdgcn_readfirstlane(vdst+(slot)))
  const int vb0=(int)(lds0+LDS_V)+((lane>>4)&1)*32+(lane&3)*8+(4*hi+((lane&15)>>2))*64;
  const char*Kbase=shm+LDS_K; bf16x8 kf[8];
  const lds_cptr kp0=shm3+LDS_K+hi*1024+r32*16; const lds_cptr vp0=shm3+LDS_V+((lane>>4)&1)*32+(lane&3)*8+(4*hi+((lane&15)>>2))*64;
  const int NT=NTF-t_start;
  DMA_K(0,0);DMA_V(0,0);DMA_K(1,SLOTB);
  bf16x8 qr[4];
  #pragma unroll
  for(int d0=0;d0<4;++d0)qr[d0]=*reinterpret_cast<const bf16x8*>(&Qw[(long)r32*DM+d0*16+hi*8]);
  float mhat=0.f,l_reg=0.f;f32x16 o[2];o[0]=f32x16{};o[1]=f32x16{};
  const __attribute__((address_space(3))) float*fkl=(const __attribute__((address_space(3))) float*)(shm3+LDS_FK)+64*t_start+4*hi;
  #define INITC(C0,C1,t) do{ const float nsc_=fq2-mhat; typedef float f32x4_t __attribute__((ext_vector_type(4))); const __attribute__((address_space(3))) float*kb_=fkl+64*(t); \
    _Pragma("unroll") for(int g_=0;g_<4;++g_){ const f32x4_t a_=*(const __attribute__((address_space(3))) f32x4_t*)(kb_+8*g_), b_=*(const __attribute__((address_space(3))) f32x4_t*)(kb_+32+8*g_); \
      _Pragma("unroll") for(int e_=0;e_<4;++e_){ C0[4*g_+e_]=nsc_+a_[e_]; C1[4*g_+e_]=nsc_+b_[e_]; } } }while(0)
  const int qrel=wid*QBLK+r32;
  #define CMASK(P0,P1,t) do{int jb_=(t)-(NT-4); if(jb_>=0)cmask(P0,P1,jb_,qrel,hi);}while(0)
  bool resc=false;
  #define START(P0,P1) do{ const float rm=rowmax(P0,P1); resc=false; \
    { const float dl=rm; mhat=fadd_s(mhat,dl); \
      _Pragma("unroll") for(int r=0;r<16;++r){P0[r]=fsub_s(P0[r],dl);P1[r]=fsub_s(P1[r],dl);} \
      } \
    _Pragma("unroll") for(int r=0;r<16;++r)P0[r]=__builtin_amdgcn_exp2f(P0[r]); }while(0)
  #define RESC() do{ if(resc){ asm volatile("s_waitcnt lgkmcnt(0)":::"memory"); \
      _Pragma("unroll") for(int d_=0;d_<2;++d_) _Pragma("unroll") for(int r=0;r<16;++r)o[d_][r]*=wsf[crow(r,hi)]; } }while(0)
  f32x16 pA0,pA1,pB0,pB1;
  int sl_prev=0,sl_cur=0,sl_next=SLOTB;
  #define ROT() do{sl_prev=sl_cur;sl_cur=sl_next;sl_next=(sl_next==(NSLOT-1)*SLOTB)?0:sl_next+SLOTB;}while(0)
  DMA_K(2,2*SLOTB);
  WAIT_BAR(3);
  INITC(pA0,pA1,0); qkt(pA0,pA1,Kbase,qr,r32,hi);asm volatile("s_nop 15\n\ts_nop 7":"+v"(pA0),"+v"(pA1));CMASK(pA0,pA1,0);
  START(pA0,pA1);
  _Pragma("unroll") for(int r=0;r<16;++r)pA1[r]=__builtin_amdgcn_exp2f(pA1[r]);
  WAIT_BAR(0);
  DMA_K(3,0);DMA_V(1,SLOTB);
  ROT();
  kload8(kf,kp0+sl_cur);
  WAIT_BAR(2);
  s16x4 vlo[8],vhi[8]; u32x4 pw0,pw1,pw2,pw3;
  #define PKW(P,B) cvtpk_s(P[B],P[B+1])
  #define PAF(k) __builtin_bit_cast(bf16x8,pw##k)
  #define VFR(i) (bf16x8){vlo[i][0],vlo[i][1],vlo[i][2],vlo[i][3],vhi[i][0],vhi[i][1],vhi[i][2],vhi[i][3]}
  #define PIN(x) asm volatile("":"+v"(x))
  #define MX3(a,b,c) __builtin_fmaxf(__builtin_fmaxf((a),(b)),(c))
  #define GAPA(MF,A0,A1,A2,A3,W0,W1,PW) do{ MF; sacc+=A0; sacc+=A1; sacc+=A2; sacc+=A3; PIN(sacc); W0; W1; PIN(PW); SBAR(); }while(0)
  #define EX(v) __builtin_amdgcn_exp2f(v)
  #define GAPB(MF,X,B) do{ MF; X[B]=EX(X[B]); X[B+1]=EX(X[B+1]); X[B+2]=EX(X[B+2]); X[B+3]=EX(X[B+3]); PIN(X); SBAR(); }while(0)
  #define VRD(i) do{ vlo[i]=vtr(vp_+(((i)>>2)*4096+((i)&3)*1024)); vhi[i]=vtr(vp_+(((i)>>2)*4096+((i)&3)*1024+512)); }while(0)
  #define KRD(G,j) do{ if(G){ kload2(kf,kp0+sl_next,j); SBAR(); } }while(0)
  #define STEP(C0,C1,P0,P1,t,GK,GV,GL) do{ SBAR(); INITC(C0,C1,t); PIN(C0); PIN(C1); SBAR(); \
    const lds_cptr vp_=vp0+sl_prev; \
    VRD(0); SBAR(); float sacc=(P0[0]+P0[1]); \
    GAPA(C0=__builtin_amdgcn_mfma_f32_32x32x16_bf16(kf[0],qr[0],C0,0,0,0), P0[2],P0[3],P0[4],P0[5],     pw0[0]=PKW(P0,0), pw0[1]=PKW(P0,2), pw0); \
    VRD(4); SBAR(); GAPA(C1=__builtin_amdgcn_mfma_f32_32x32x16_bf16(kf[1],qr[0],C1,0,0,0), P0[6],P0[7],P0[8],P0[9],     pw0[2]=PKW(P0,4), pw0[3]=PKW(P0,6), pw0); \
    VRD(1); SBAR(); GAPA(C0=__builtin_amdgcn_mfma_f32_32x32x16_bf16(kf[2],qr[1],C0,0,0,0),   P0[10],P0[11],P0[12],P0[13], pw1[0]=PKW(P0,8), pw1[1]=PKW(P0,10), pw1); \
    VRD(5); SBAR(); GAPA(C1=__builtin_amdgcn_mfma_f32_32x32x16_bf16(kf[3],qr[1],C1,0,0,0),   P0[14],P0[15],P1[0],P1[1],   pw1[2]=PKW(P0,12),pw1[3]=PKW(P0,14), pw1); \
    VRD(2); SBAR(); GAPA(C0=__builtin_amdgcn_mfma_f32_32x32x16_bf16(kf[4],qr[2],C0,0,0,0),   P1[2],P1[3],P1[4],P1[5],     pw2[0]=PKW(P1,0), pw2[1]=PKW(P1,2), pw2); \
    VRD(6); SBAR(); GAPA(C1=__builtin_amdgcn_mfma_f32_32x32x16_bf16(kf[5],qr[2],C1,0,0,0),   P1[6],P1[7],P1[8],P1[9],     pw2[2]=PKW(P1,4), pw2[3]=PKW(P1,6), pw2); \
    VRD(3); SBAR(); GAPA(C0=__builtin_amdgcn_mfma_f32_32x32x16_bf16(kf[6],qr[3],C0,0,0,0),   P1[10],P1[11],P1[12],P1[13], pw3[0]=PKW(P1,8), pw3[1]=PKW(P1,10), pw3); \
    VRD(7); SBAR(); GAPA(C1=__builtin_amdgcn_mfma_f32_32x32x16_bf16(kf[7],qr[3],C1,0,0,0),   P1[14],P1[15],0.f,0.f,       pw3[2]=PKW(P1,12),pw3[3]=PKW(P1,14), pw3); \
    l_reg+=sacc; \
    if(GK){DMA_K((t)+3,sl_cur);} if(GV){DMA_V((t)+1,sl_next);} \
    CMASK(C0,C1,t); \
    { float a=MX3(C0[0],C0[1],C1[0]),b=MX3(C0[2],C0[3],C1[1]); a=MX3(a,C1[2],C1[3]); \
      _Pragma("unroll") for(int r=4;r<16;r+=4){a=MX3(a,C0[r],C0[r+1]);b=MX3(b,C0[r+2],C0[r+3]);a=MX3(a,C1[r],C1[r+1]);b=MX3(b,C1[r+2],C1[r+3]);} \
      float rm=__builtin_fmaxf(a,b); { auto rr=__builtin_amdgcn_permlane32_swap(__float_as_uint(rm),__float_as_uint(rm),false,false); rm=__builtin_fmaxf(__uint_as_float(rr[0]),__uint_as_float(rr[1])); } \
      resc=false; \
      if(__builtin_expect(__any(rm>(float)THRL),0)){ const float dl=__builtin_fmaxf(rm,0.f); mhat+=dl; \
        _Pragma("unroll") for(int r=0;r<16;++r){C0[r]-=dl;C1[r]-=dl;} \
        const float f=__builtin_amdgcn_exp2f(-dl); l_reg*=f; if(hi==0)wsf[r32]=f; resc=true; } } \
    SBAR(); \
    GAPB(o[0]=__builtin_amdgcn_mfma_f32_32x32x16_bf16(PAF(0),VFR(0),o[0],0,0,0), C0,0); \
    GAPB(o[1]=__builtin_amdgcn_mfma_f32_32x32x16_bf16(PAF(0),VFR(4),o[1],0,0,0), C0,4); \
    KRD(GL,0); GAPB(o[0]=__builtin_amdgcn_mfma_f32_32x32x16_bf16(PAF(1),VFR(1),o[0],0,0,0), C0,8); \
    KRD(GL,1); GAPB(o[1]=__builtin_amdgcn_mfma_f32_32x32x16_bf16(PAF(1),VFR(5),o[1],0,0,0), C0,12); \
    KRD(GL,2); GAPB(o[0]=__builtin_amdgcn_mfma_f32_32x32x16_bf16(PAF(2),VFR(2),o[0],0,0,0), C1,0); \
    KRD(GL,3); GAPB(o[1]=__builtin_amdgcn_mfma_f32_32x32x16_bf16(PAF(2),VFR(6),o[1],0,0,0), C1,4); \
    GAPB(o[0]=__builtin_amdgcn_mfma_f32_32x32x16_bf16(PAF(3),VFR(3),o[0],0,0,0), C1,8); \
    GAPB(o[1]=__builtin_amdgcn_mfma_f32_32x32x16_bf16(PAF(3),VFR(7),o[1],0,0,0), C1,12); \
    }while(0)
  int t=1;
  #undef CMASK
  #define CMASK(P0,P1,t) do{}while(0)
  for(;t+5<NT;t+=2){
    STEP(pB0,pB1,pA0,pA1,t,true,true,true);     WAIT_BAR(2); RESC(); ROT();
    STEP(pA0,pA1,pB0,pB1,t+1,true,true,true);   WAIT_BAR(2); RESC(); ROT();
  }
  #undef CMASK
  #define CMASK(P0,P1,t) do{int jb_=(t)-(NT-4); if(jb_>=0)cmask(P0,P1,jb_,qrel,hi);}while(0)
  #define ENDW(tt) do{ if((tt)+3<NT){WAIT_BAR(2);} else if((tt)+2<NT){WAIT_BAR(1);} else {WAIT_BAR(0);} }while(0)
  for(;t+1<NT;t+=2){
    STEP(pB0,pB1,pA0,pA1,t,(t+3<NT),(t+1<NT),(t+1<NT));       ENDW(t);   RESC(); ROT();
    STEP(pA0,pA1,pB0,pB1,t+1,(t+4<NT),(t+2<NT),(t+2<NT));     ENDW(t+1); RESC(); ROT();
  }
  STEP(pB0,pB1,pA0,pA1,NT-1,false,false,false); RESC();
  { float sacc=pB0[0]+pB0[1]; _Pragma("unroll") for(int r=2;r<16;++r)sacc+=pB0[r]; _Pragma("unroll") for(int r=0;r<16;++r)sacc+=pB1[r]; l_reg+=sacc;
    pw0=(u32x4){PKW(pB0,0),PKW(pB0,2),PKW(pB0,4),PKW(pB0,6)};pw1=(u32x4){PKW(pB0,8),PKW(pB0,10),PKW(pB0,12),PKW(pB0,14)};pw2=(u32x4){PKW(pB1,0),PKW(pB1,2),PKW(pB1,4),PKW(pB1,6)};pw3=(u32x4){PKW(pB1,8),PKW(pB1,10),PKW(pB1,12),PKW(pB1,14)};
    SBAR(); pv(o,vb0+sl_cur,PAF(0),PAF(1),PAF(2),PAF(3)); }
  #undef PKW
  #undef PAF
  #undef VFR
  #undef PIN
  #undef MX3
  #undef GAPA
  #undef GAPB
  #undef EX
  #undef VRD
  #undef KRD
  #undef STEP
  #undef ENDW
  {auto rr=__builtin_amdgcn_permlane32_swap(__float_as_uint(l_reg),__float_as_uint(l_reg),false,false);l_reg=__uint_as_float(rr[0])+__uint_as_float(rr[1]);}
  if(hi==0)wsf[32+r32]=l_reg;asm volatile("s_waitcnt lgkmcnt(0)":::"memory");
  float rli[16];
  #pragma unroll
  for(int r=0;r<16;++r)rli[r]=__builtin_amdgcn_rcpf(wsf[32+crow(r,hi)]);
  bf16*Ow=O+(rowbase+q0+wid*QBLK)*DM+h*D;
  { bf16*stg=(bf16*)(shm+LDS_OST)+wid*2048;
    #pragma unroll
    for(int r=0;r<16;++r){const int orow=crow(r,hi);
      #pragma unroll
      for(int d0=0;d0<2;++d0)stg[orow*64+d0*32+r32]=__float2bfloat16(o[d0][r]*rli[r]);}
    asm volatile("s_waitcnt lgkmcnt(0)":::"memory");
    #pragma unroll
    for(int i=0;i<4;++i){const int row=i*8+(lane>>3),ch=lane&7; const u32x4 v=*(const u32x4*)(stg+row*64+ch*8); ATTN_STORE16(Ow+(long)row*DM+ch*8,v);} }
  asm volatile("s_waitcnt lgkmcnt(0)\n\ts_barrier":::"memory");
  #undef DMA_K
  #undef DMA_V
  #undef INITC
  #undef CMASK
  #undef START
  #undef RESC
  #undef ROT
}
constexpr int ATTN_LDS_BYTES=LDS_BYTES;
struct AttnTensors { const bf16* Q; const bf16* K; const bf16* V; bf16* O; const float* F; const float* NRM; };
struct AttnUnit { int bh; int qb; };
struct StaticOrder {
  int vcu;
  __device__ __forceinline__ explicit StaticOrder(int grid,int block):vcu((block%8)*(grid/8)+block/8){}
  __device__ __forceinline__ bool next(int i,AttnUnit&u)const{ if(i>=4)return false; const int s=vcu&7; u.bh=vcu>>3; u.qb=(i==0)?s:(i==1)?15-s:(i==2)?16+s:31-s; return true; }
  __device__ __forceinline__ void a_ready(const AttnUnit&)const{}
  __device__ __forceinline__ void done(const AttnUnit&)const{}
};
template<int THRL=8> __device__ __forceinline__ void attn_phase(char*lds,const AttnTensors&T,unsigned*qctr,volatile __attribute__((address_space(3))) unsigned*qword,int wid_in){
  const int lane0=(int)__builtin_amdgcn_mbcnt_hi(~0u,__builtin_amdgcn_mbcnt_lo(~0u,0u));
  for(;;){
    if(wid_in==0&&lane0==0){ const unsigned n=__hip_atomic_fetch_add(qctr,1u,__ATOMIC_RELAXED,__HIP_MEMORY_SCOPE_AGENT); *qword=n; }
    asm volatile("s_waitcnt vmcnt(0) lgkmcnt(0)\n\ts_barrier":::"memory");
    const int n=__builtin_amdgcn_readfirstlane((int)*qword);
    if(n>=BATCH*NHEAD*NQB)break;
    const int bh=n%(BATCH*NHEAD),qb=NQB-1-n/(BATCH*NHEAD);
    attn_unit<THRL>(bh/NHEAD,bh%NHEAD,qb,T.Q,T.K,T.V,T.O,T.F,T.NRM,lds,wid_in);
  }
}
#undef SBAR
#undef WAIT_BAR
}
#define GAS __attribute__((address_space(1)))
#define LAS __attribute__((address_space(3)))
typedef unsigned short bf16;
typedef unsigned v4u __attribute__((ext_vector_type(4)));
typedef float f32x4 __attribute__((ext_vector_type(4)));
typedef short bf16x8 __attribute__((ext_vector_type(8)));
typedef GAS unsigned gu32;
typedef GAS unsigned long long gu64;
#define RLX_AGENT __ATOMIC_RELAXED, __HIP_MEMORY_SCOPE_AGENT
#define LDS_WAIT() asm volatile("s_waitcnt lgkmcnt(0)" ::: "memory")
#define VM_WAIT() asm volatile("s_waitcnt vmcnt(0)" ::: "memory")
__device__ __forceinline__ unsigned long long rt() { return __builtin_amdgcn_s_memrealtime(); }
__device__ __forceinline__ unsigned f2bf(float f) { unsigned u = __builtin_bit_cast(unsigned, f); return (u + 0x7fffu + ((u >> 16) & 1u)) >> 16; }
__device__ __forceinline__ unsigned pk2(float lo, float hi) { return f2bf(lo) | (f2bf(hi) << 16); }

#define XB_TMO      128
#define XB_XCNT(j)  (256  + 64 * (j))
#define XB_XSUB(j)  (1280 + 64 * (j))
#define XB_XGEN(j)  (2304 + 64 * (j))
#define XB_TOP      3328
#define XB_TOPGEN   3392
#define XCD_BAR_WORDS 3456
#define XB_SPIN_CAP (1u << 18)

__device__ __forceinline__ unsigned xb_ld(unsigned* p)              { return __hip_atomic_load(p, __ATOMIC_RELAXED, __HIP_MEMORY_SCOPE_AGENT); }
__device__ __forceinline__ unsigned xb_add(unsigned* p, unsigned v) { return __hip_atomic_fetch_add(p, v, __ATOMIC_RELAXED, __HIP_MEMORY_SCOPE_AGENT); }
__device__ __forceinline__ unsigned xb_xcc_id() { return (unsigned)__builtin_amdgcn_s_getreg((3 << 11) | 20) & 0xFu; }
#define XB_SPIN(cond, bar) do { unsigned _sp = 0; while (cond) { __builtin_amdgcn_s_sleep(1); \
    if ((++_sp & 255u) == 0u) { if (xb_ld(&(bar)[XB_TMO])) break; if (_sp > XB_SPIN_CAP) { atomicAdd(&(bar)[XB_TMO], 1u); break; } } } } while (0)

struct XcdBarrier {
    unsigned* bar; unsigned x; int wv;
    volatile LAS unsigned* st;
};

__device__ __forceinline__ bool xb_t0(int wv) { return wv == 0 && __builtin_amdgcn_mbcnt_hi(~0u, __builtin_amdgcn_mbcnt_lo(~0u, 0u)) == 0u; }
__device__ __forceinline__ XcdBarrier xcd_barrier_post(unsigned* bar, volatile LAS unsigned* st, int wv) {
    XcdBarrier b; b.bar = bar; b.x = xb_xcc_id(); b.st = st; b.wv = wv;
    if (xb_t0(wv)) (void)xb_add(&bar[XB_XCNT(b.x)], 1u);
    return b;
}
__device__ __forceinline__ void xcd_barrier_complete(unsigned* bar, unsigned x, unsigned& nloc, unsigned& nx) {
    const unsigned G = gridDim.x * gridDim.y * gridDim.z;
    unsigned sum, cnt, mine, sp = 0u;
    for (;;) {
        sum = 0u; cnt = 0u; mine = 0u;
#pragma unroll
        for (unsigned j = 0; j < 16; ++j) { const unsigned c = xb_ld(&bar[XB_XCNT(j)]); sum += c; cnt += (c > 0u) ? 1u : 0u; mine = (j == x) ? c : mine; }
        if (sum == G) break;
        __builtin_amdgcn_s_sleep(1);
        if ((++sp & 255u) == 0u) { if (xb_ld(&bar[XB_TMO])) break; if (sp > XB_SPIN_CAP) { atomicAdd(&bar[XB_TMO], 1u); break; } }
    }
    nloc = mine > 0u ? mine : 1u; nx = cnt > 0u ? cnt : 1u;
}

__device__ __forceinline__ void xcd_barrier(const XcdBarrier& b) {
    asm volatile("s_waitcnt vmcnt(0)" ::: "memory");
    __syncthreads();
    if (xb_t0(b.wv)) {
        unsigned* bar = b.bar;
        __builtin_amdgcn_s_waitcnt(0);
        unsigned nloc = b.st[0], nx = b.st[1];
        if (nloc == 0u) { xcd_barrier_complete(bar, b.x, nloc, nx); b.st[0] = nloc; b.st[1] = nx; }
        const unsigned old = xb_add(&bar[XB_XSUB(b.x)], 1u);
        const unsigned gen = old / nloc;
        if (old + 1u == (gen + 1u) * nloc) {
            __builtin_amdgcn_fence(__ATOMIC_RELEASE, "agent");
            asm volatile("s_waitcnt vmcnt(0)" ::: "memory");
            const unsigned og = xb_add(&bar[XB_TOP], 1u);
            const unsigned tg = og / nx;
            if (og + 1u == (tg + 1u) * nx) xb_add(&bar[XB_TOPGEN], 1u);
            else XB_SPIN(xb_ld(&bar[XB_TOPGEN]) == tg, bar);
            __builtin_amdgcn_fence(__ATOMIC_ACQUIRE, "agent");
            xb_add(&bar[XB_XGEN(b.x)], 1u);
            asm volatile("s_waitcnt vmcnt(0)" ::: "memory");
        } else {
            XB_SPIN(xb_ld(&bar[XB_XGEN(b.x)]) == gen, bar);
            __builtin_amdgcn_fence(__ATOMIC_ACQUIRE, "agent");
            asm volatile("s_waitcnt vmcnt(0)" ::: "memory");
        }
    }
    __syncthreads();
}

constexpr int NWAVES = 8;
constexpr int RING_OFF = 0, RING_BYTES = 131072;
constexpr int LDSCTL_OFF = RING_BYTES, MISC_OFF = LDSCTL_OFF + 320;
constexpr int LDS_BYTES = 147456;
constexpr int N_PHASES = 8;

struct Frame {
    LAS unsigned char* lds;
    volatile LAS unsigned* MISC;
    gu32* ctl;
    int tid, lane, wave, vcu, G;
};
__device__ __forceinline__ float wave_sum(float v) {
#pragma unroll
    for (int o = 1; o < 64; o <<= 1) v += __shfl_xor(v, o);
    return v;
}
struct Args { const float* in[20]; float* out; unsigned char* ws; int ph_lo, ph_hi, li, pad; };

__device__ __forceinline__ void p0_transpose_item(const float* W, int ld, int nblk, const float* glo, const float* ghi, int K, bf16* WT, LAS float* scr, int item, int lane) {
    const int kb = item / nblk, nb = item % nblk, k0 = 64 * kb, n0 = 32 * nb;
#pragma unroll 8
    for (int i = 0; i < 32; ++i) { const int kk = 2 * i + (lane >> 5), k = k0 + kk; float w = W[(size_t)k * ld + n0 + (lane & 31)];
        if (glo) w *= (k < K / 2) ? glo[k] : ghi[k - K / 2];
        scr[kk * 33 + (lane & 31)] = w; }
    LDS_WAIT(); asm volatile("" ::: "memory");
    const int c = lane & 7;
#pragma unroll
    for (int j = 0; j < 4; ++j) { const int n = (lane >> 3) + 8 * j; const LAS float* s = scr + (8 * c) * 33 + n;
        v4u o; o.x = pk2(s[0 * 33], s[1 * 33]); o.y = pk2(s[2 * 33], s[3 * 33]); o.z = pk2(s[4 * 33], s[5 * 33]); o.w = pk2(s[6 * 33], s[7 * 33]);
        *(GAS v4u*)(WT + (size_t)(n0 + n) * K + k0 + 8 * c) = o; }
    LDS_WAIT(); asm volatile("" ::: "memory");
}
__device__ __forceinline__ float log_sigmoid(float z) { return fminf(z, 0.f) - log1pf(expf(-fabsf(z))); }

__device__ __forceinline__ void p0_prologue(Frame& F, const Args& a) {
    LAS float* scr = (LAS float*)(F.lds + RING_OFF + F.wave * 16384);
    unsigned char* ws = a.ws;
    const float* x = a.in[0]; const float* g1 = a.in[1]; const float* w_in = a.in[2]; const float* bfv = a.in[10];
    const float* gn_l = a.in[11]; const float* gn_f = a.in[12]; const float* w_out = a.in[13]; const float* g2 = a.in[14];
    const float* w_q = a.in[15]; const float* sk = a.in[16]; const float* pu = a.in[17]; const float* pv = a.in[18];
    bf16* win_t = (bf16*)(ws + WS_WIN); bf16* wout_t = (bf16*)(ws + WS_WOUT); bf16* wq_t = (bf16*)(ws + WS_WQ); bf16* skb = (bf16*)(ws + WS_SKB);
    float* logf = (float*)(ws + WS_LOGF); float* sumsq = (float*)(ws + WS_SUMSQ); bf16* h = (bf16*)(ws + WS_H);
    const int gw = F.vcu * NWAVES + F.wave, NGW = F.G * NWAVES, lane = F.lane;
    constexpr int I_IN = (DMODEL / 64) * (NG1 / 32), I_OUT = (DMODEL / 64) * (DMODEL / 32), I_Q = (DMODEL / 64) * (QPW / 32);
    constexpr int I_FL = 8 * DMODEL / 64, I_SK = PH * 2 * NKEY * PHALF / 512, I_SS = T / 64, I_WAX = 8 * 2 * 2 * 4;
    constexpr int E0 = I_IN, E1 = E0 + I_OUT, E2 = E1 + I_Q, E3 = E2 + I_FL, E4 = E3 + I_SK, E5 = E4 + I_SS, E6 = E5 + I_WAX;
    for (int it = gw; it < E6; it += NGW) {
        if (it < E0) { p0_transpose_item(w_in, INC, NG1 / 32, nullptr, nullptr, DMODEL, win_t, scr, it, lane); continue; }
        if (it < E1) { p0_transpose_item(w_out, DMODEL, DMODEL / 32, gn_l, gn_f, DMODEL, wout_t, scr, it - E0, lane); continue; }
        if (it < E2) { p0_transpose_item(w_q, QPW, QPW / 32, g2, g2 + DMODEL / 2, DMODEL, wq_t, scr, it - E1, lane); continue; }
        if (it < E3) continue;
        if (it < E4) { const size_t i = (size_t)(it - E3) * 512 + lane * 8; const f32x4 s0 = *(const GAS f32x4*)(sk + i), s1 = *(const GAS f32x4*)(sk + i + 4);
            v4u o; o.x = pk2(s0[0], s0[1]); o.y = pk2(s0[2], s0[3]); o.z = pk2(s1[0], s1[1]); o.w = pk2(s1[2], s1[3]); *(GAS v4u*)(skb + i) = o; continue; }
        if (it < E5) { sumsq[(it - E4) * 64 + lane] = 0.f; continue; }
        { const int f = it - E5, ks = f & 3, n = (f >> 2) & 1, mat = (f >> 3) & 1, hh = f >> 4; const float* wsrc = mat ? a.in[7] : a.in[5];
          const size_t o = ((size_t)(hh * 64 + 16 * ks + 8 * (lane >> 5))) * 64 + 32 * n + (lane & 31);
          v4u pw; pw.x = pk2(wsrc[o], wsrc[o + 64]); pw.y = pk2(wsrc[o + 128], wsrc[o + 192]); pw.z = pk2(wsrc[o + 256], wsrc[o + 320]); pw.w = pk2(wsrc[o + 384], wsrc[o + 448]);
          *(GAS v4u*)((bf16*)(ws + WS_WAX) + (size_t)f * 512 + lane * 8) = pw; }
    }
    { f32x4 gg[4];
#pragma unroll
      for (int j = 0; j < 4; ++j) gg[j] = *(const GAS f32x4*)(g2 + 16 * lane + 4 * j);
      unsigned char* u4 = ws + WS_U8; unsigned char* v4 = ws + WS_V8; float* su = (float*)(ws + WS_SU);
      for (int e = gw; e < NEXP; e += NGW) {
        const GAS f32x4* ur = (const GAS f32x4*)(pu + (size_t)e * DMODEL + 16 * lane); const GAS f32x4* vr = (const GAS f32x4*)(pv + (size_t)e * DMODEL + 16 * lane);
        f32x4 uu[4], vv[4]; float mu = 0.f, mv = 0.f;
#pragma unroll
        for (int j = 0; j < 4; ++j) { uu[j] = ur[j] * gg[j]; vv[j] = vr[j];
#pragma unroll
            for (int c = 0; c < 4; ++c) { mu = fmaxf(mu, fabsf(uu[j][c])); mv = fmaxf(mv, fabsf(vv[j][c])); } }
#pragma unroll
        for (int o = 1; o < 64; o <<= 1) { mu = fmaxf(mu, __shfl_xor(mu, o)); mv = fmaxf(mv, __shfl_xor(mv, o)); }
        const float scu = mu > 0.f ? mu * (1.f / 6.f) : 1.f, scv = mv > 0.f ? mv * (1.f / 6.f) : 1.f, iu = 1.f / scu, iv = 1.f / scv;
        unsigned qu0 = 0u, qu1 = 0u, qv0 = 0u, qv1 = 0u;
#define P0_Q4(Q, X, INV, B0, B1) do { Q = __builtin_amdgcn_cvt_scalef32_pk_fp4_f32(Q, X[0] * INV, X[1] * INV, 1.0f, B0); Q = __builtin_amdgcn_cvt_scalef32_pk_fp4_f32(Q, X[2] * INV, X[3] * INV, 1.0f, B1); } while (0)
        P0_Q4(qu0, uu[0], iu, 0, 1); P0_Q4(qu0, uu[1], iu, 2, 3); P0_Q4(qu1, uu[2], iu, 0, 1); P0_Q4(qu1, uu[3], iu, 2, 3);
        P0_Q4(qv0, vv[0], iv, 0, 1); P0_Q4(qv0, vv[1], iv, 2, 3); P0_Q4(qv1, vv[2], iv, 0, 1); P0_Q4(qv1, vv[3], iv, 2, 3);
#undef P0_Q4
        *(GAS unsigned long long*)(u4 + (size_t)e * 512 + 8 * lane) = (unsigned long long)qu0 | ((unsigned long long)qu1 << 32);
        *(GAS unsigned long long*)(v4 + (size_t)e * 512 + 8 * lane) = (unsigned long long)qv0 | ((unsigned long long)qv1 << 32);
        if (lane == 0) { su[2 * e] = scu; su[2 * e + 1] = scv; }
      } }
    { f32x4 gg[4];
#pragma unroll
      for (int j = 0; j < 4; ++j) gg[j] = *(const GAS f32x4*)(g1 + 256 * j + 4 * lane);
      float fw[4][4][8];
#pragma unroll
      for (int j = 0; j < 4; ++j)
#pragma unroll
          for (int c = 0; c < 4; ++c) { const int k = 256 * j + 4 * lane + c; const GAS f32x4* wr = (const GAS f32x4*)(w_in + (size_t)k * INC + NG1); const f32x4 w0 = wr[0], w1 = wr[1];
#pragma unroll
              for (int e = 0; e < 4; ++e) { fw[j][c][e] = w0[e]; fw[j][c][4 + e] = w1[e]; } }
      for (int t0 = gw; t0 < T; t0 += 2 * NGW) {
        const int t1 = (t0 + NGW < T) ? t0 + NGW : t0;
        const GAS f32x4* xr0 = (const GAS f32x4*)(x + (size_t)t0 * DMODEL) + lane; const GAS f32x4* xr1 = (const GAS f32x4*)(x + (size_t)t1 * DMODEL) + lane;
        f32x4 va[4], vb[4]; float sa = 0.f, sb = 0.f;
#pragma unroll
        for (int j = 0; j < 4; ++j) { va[j] = xr0[64 * j]; vb[j] = xr1[64 * j]; }
#pragma unroll
        for (int j = 0; j < 4; ++j) { sa += (va[j][0] * va[j][0] + va[j][1] * va[j][1]) + (va[j][2] * va[j][2] + va[j][3] * va[j][3]); sb += (vb[j][0] * vb[j][0] + vb[j][1] * vb[j][1]) + (vb[j][2] * vb[j][2] + vb[j][3] * vb[j][3]); }
        const float ra = rsqrtf(wave_sum(sa) * (1.f / DMODEL) + RMS_EPS), rb = rsqrtf(wave_sum(sb) * (1.f / DMODEL) + RMS_EPS);
        GAS unsigned long long* ha = (GAS unsigned long long*)(h + (size_t)t0 * DMODEL) + lane; GAS unsigned long long* hb = (GAS unsigned long long*)(h + (size_t)t1 * DMODEL) + lane;
#pragma unroll
        for (int j = 0; j < 4; ++j) { va[j] = va[j] * ra * gg[j]; vb[j] = vb[j] * rb * gg[j];
            ha[64 * j] = (unsigned long long)pk2(va[j][0], va[j][1]) | ((unsigned long long)pk2(va[j][2], va[j][3]) << 32);
            hb[64 * j] = (unsigned long long)pk2(vb[j][0], vb[j][1]) | ((unsigned long long)pk2(vb[j][2], vb[j][3]) << 32); }
        float fa[8], fb[8];
#pragma unroll
        for (int hh = 0; hh < 8; ++hh) { fa[hh] = 0.f; fb[hh] = 0.f; }
#pragma unroll
        for (int j = 0; j < 4; ++j)
#pragma unroll
            for (int c = 0; c < 4; ++c) {
#pragma unroll
                for (int hh = 0; hh < 8; ++hh) { fa[hh] += va[j][c] * fw[j][c][hh]; fb[hh] += vb[j][c] * fw[j][c][hh]; } }
        float resa = 0.f, resb = 0.f;
#pragma unroll
        for (int hh = 0; hh < 8; ++hh) { const float s0 = wave_sum(fa[hh]), s1 = wave_sum(fb[hh]); if (lane == hh) { resa = s0; resb = s1; } }
        if (lane < 8) { logf[(size_t)t0 * 8 + lane] = log_sigmoid(resa + bfv[lane]); logf[(size_t)t1 * 8 + lane] = log_sigmoid(resb + bfv[lane]); }
      } }
}

__device__ __forceinline__ void fcum_unit(Frame& F, int bh, const float* logf, float* fcum) {
    const int b = bh / NHEADS, hh = bh % NHEADS, s0 = F.tid * 16;
    float v[16]; float loc = 0.f;
#pragma unroll
    for (int i = 0; i < 16; ++i) { v[i] = logf[((size_t)b * SEQ + s0 + i) * 8 + hh]; loc += v[i]; }
    float inc = loc;
#pragma unroll
    for (int o = 1; o < 64; o <<= 1) { const float n = __shfl_up(inc, o); if (F.lane >= o) inc += n; }
    if (F.lane == 63) F.MISC[16 + F.wave] = __float_as_uint(inc);
    __syncthreads();
    float run = inc - loc;
    for (int w = 0; w < F.wave; ++w) run += __uint_as_float(F.MISC[16 + w]);
#pragma unroll
    for (int i = 0; i < 16; ++i) { run += v[i]; fcum[(size_t)bh * SEQ + s0 + i] = run; }
    __syncthreads();
}


namespace peer {
typedef unsigned u32;
typedef float f32x16 __attribute__((ext_vector_type(16)));
constexpr int TOK = 128;
constexpr int EX_STRIDE = 136, GT_STRIDE = 132;
constexpr int L_EX = 0, L_GT = L_EX + TOK * EX_STRIDE * 2, L_IDX = L_GT + TOK * GT_STRIDE * 4, IDX_STRIDE = 36, L_RST = L_IDX + 512 * IDX_STRIDE, L_END = L_RST + TOK * 4;
static_assert(L_END <= RING_BYTES && L_GT % 16 == 0 && L_IDX % 16 == 0, "PEER LDS map");
__device__ __forceinline__ u32 ordmap(float f) { const u32 u = __float_as_uint(f); return u ^ ((u32)((int)u >> 31) | 0x80000000u); }
__device__ __forceinline__ float unordmap(u32 k) { const u32 u = (k & 0x80000000u) ? (k ^ 0x80000000u) : ~k; return __uint_as_float(u); }
__device__ __forceinline__ u32 umin_(u32 a, u32 b) { return a < b ? a : b; }
__device__ __forceinline__ u32 umax_(u32 a, u32 b) { return a > b ? a : b; }
template <bool DESC> __device__ __forceinline__ void sort16(u32 (&k)[16]) {
#pragma unroll
    for (int size = 2; size <= 16; size <<= 1)
#pragma unroll
        for (int stride = size >> 1; stride > 0; stride >>= 1)
#pragma unroll
            for (int i = 0; i < 16; ++i) { const int j = i ^ stride;
                if (j > i) { const bool asc = (((i & size) == 0) != DESC); const u32 a = k[i], b = k[j], lo = umin_(a, b), hi = umax_(a, b); k[i] = asc ? lo : hi; k[j] = asc ? hi : lo; } }
}
template <bool DESC> __device__ __forceinline__ void merge16(u32 (&k)[16]) {
#pragma unroll
    for (int stride = 8; stride > 0; stride >>= 1)
#pragma unroll
        for (int i = 0; i < 16; ++i) { const int j = i ^ stride;
            if (j > i) { const u32 a = k[i], b = k[j], lo = umin_(a, b), hi = umax_(a, b); k[i] = DESC ? hi : lo; k[j] = DESC ? lo : hi; } }
}
__host__ __device__ constexpr int ccnt(int a) { return 16 / (a + 1); }
__host__ __device__ constexpr int cbase(int a) { int s = 0; for (int i = 0; i < a; ++i) s += ccnt(i); return s; }
static_assert(cbase(16) == 50, "hyperbola candidate count");
__device__ __forceinline__ int crow16(int r) { return (r & 3) + 8 * (r >> 2); }

__device__ __forceinline__ void route_tile(Frame& F, const bf16* qp, const bf16* skb, const float* sumsq, int t0) {
    int lane = F.lane; asm volatile("" : "+v"(lane));
    const int r32 = lane & 31, hi = lane >> 5, w = F.wave;
    LAS unsigned short* EXL = (LAS unsigned short*)(F.lds + RING_OFF + L_EX);
    LAS float* GTL = (LAS float*)(F.lds + RING_OFF + L_GT);
    LAS unsigned char* IDXB = F.lds + RING_OFF + L_IDX + (w * 64 + lane) * IDX_STRIDE;
    LAS float* RST = (LAS float*)(F.lds + RING_OFF + L_RST);
    for (int g = 0; g < 4; ++g) {
        const int tok = 32 * g + r32; const size_t trow = (size_t)(t0 + tok);
        const float rstd2 = rsqrtf(sumsq[trow] * (1.f / DMODEL) + RMS_EPS);
        if (w == 0 && hi == 0) RST[tok] = rstd2;
        u32 s0[16], s1[16];
#pragma unroll
        for (int p = 0; p < 2; ++p) {
            bf16x8 qf[8];
#pragma unroll
            for (int ks = 0; ks < 8; ++ks) qf[ks] = *(const GAS bf16x8*)(qp + trow * QPW + w * 256 + p * 128 + ks * 16 + hi * 8);
            u32 run[16];
#pragma unroll
            for (int nb = 0; nb < 4; ++nb) {
                f32x16 acc = {};
                const bf16* kr = skb + ((size_t)((w * 2 + p) * NKEY + 32 * nb + r32)) * PHALF + hi * 8;
#pragma unroll
                for (int ks = 0; ks < 8; ++ks) acc = __builtin_amdgcn_mfma_f32_32x32x16_bf16(*(const GAS bf16x8*)(kr + ks * 16), qf[ks], acc, 0, 0, 0);
                asm volatile("" ::: "memory");
                u32 blk[16];
#pragma unroll
                for (int r = 0; r < 16; ++r) blk[r] = (ordmap(acc[r]) & ~0x7Fu) | (u32)(127 - 32 * nb - crow16(r) - 4 * hi);
                if (nb == 0) { sort16<true>(blk);
#pragma unroll
                    for (int i = 0; i < 16; ++i) run[i] = blk[i]; }
                else { sort16<false>(blk);
#pragma unroll
                    for (int i = 0; i < 16; ++i) run[i] = umax_(run[i], blk[i]);
                    merge16<true>(run); }
            }
            u32 oth[16];
#pragma unroll
            for (int i = 0; i < 16; ++i) oth[i] = (u32)__shfl_xor((int)run[15 - i], 32);
#pragma unroll
            for (int i = 0; i < 16; ++i) run[i] = umax_(run[i], oth[i]);
            merge16<true>(run);
#pragma unroll
            for (int i = 0; i < 16; ++i) { if (p == 0) s0[i] = run[i]; else s1[i] = run[i]; }
        }
        { LAS u32* iw = (LAS u32*)IDXB;
#pragma unroll
          for (int j = 0; j < 4; ++j) {
              iw[j] = (127u - (s0[4 * j] & 127u)) | ((127u - (s0[4 * j + 1] & 127u)) << 8) | ((127u - (s0[4 * j + 2] & 127u)) << 16) | ((127u - (s0[4 * j + 3] & 127u)) << 24);
              iw[4 + j] = (127u - (s1[4 * j] & 127u)) | ((127u - (s1[4 * j + 1] & 127u)) << 8) | ((127u - (s1[4 * j + 2] & 127u)) << 16) | ((127u - (s1[4 * j + 3] & 127u)) << 24); } }
        float v1[16], v2[16];
#pragma unroll
        for (int i = 0; i < 16; ++i) { v1[i] = unordmap(s0[i] & ~0x7Fu); v2[i] = unordmap(s1[i] & ~0x7Fu); }
        u32 c0[16], c1[16], c2[16], c3[16];
#pragma unroll
        for (int a = 0; a < 16; ++a)
#pragma unroll
            for (int b = 0; b < ccnt(a); ++b) { const int pos = cbase(a) + b; const u32 key = (ordmap(v1[a] + v2[b]) & ~0xFFu) | (u32)(255 - (a * 16 + b));
                if (pos < 16) c0[pos] = key; else if (pos < 32) c1[pos - 16] = key; else if (pos < 48) c2[pos - 32] = key; else c3[pos - 48] = key; }
#pragma unroll
        for (int i = 2; i < 16; ++i) c3[i] = 0u;
        sort16<false>(c1);
#pragma unroll
        for (int i = 0; i < 16; ++i) c0[i] = umax_(c0[i], c1[i]);
        merge16<true>(c0);
        sort16<false>(c2);
#pragma unroll
        for (int i = 0; i < 16; ++i) c0[i] = umax_(c0[i], c2[i]);
        merge16<true>(c0);
        sort16<false>(c3);
#pragma unroll
        for (int i = 0; i < 16; ++i) c0[i] = umax_(c0[i], c3[i]);
        merge16<true>(c0);
        const float m = unordmap(c0[0] & ~0xFFu) * rstd2;
        float e[8]; float sum = 0.f; u32 ex[8];
#pragma unroll
        for (int k = 0; k < 8; ++k) { const u32 key = hi ? c0[k + 8] : c0[k]; const float ts = unordmap(key & ~0xFFu);
            e[k] = __builtin_amdgcn_exp2f((ts * rstd2 - m) * LOG2E); sum += e[k];
            const u32 flat = 255u - (key & 255u); ex[k] = (u32)IDXB[flat >> 4] * NKEY + (u32)IDXB[16 + (flat & 15u)]; }
        sum += __shfl_xor(sum, 32);
        const float inv = 1.f / sum;
        v4u exw; exw.x = ex[0] | (ex[1] << 16); exw.y = ex[2] | (ex[3] << 16); exw.z = ex[4] | (ex[5] << 16); exw.w = ex[6] | (ex[7] << 16);
        *(LAS v4u*)(EXL + tok * EX_STRIDE + w * 16 + hi * 8) = exw;
        *(LAS f32x4*)(GTL + tok * GT_STRIDE + w * 16 + hi * 8) = (f32x4){e[0] * inv, e[1] * inv, e[2] * inv, e[3] * inv};
        *(LAS f32x4*)(GTL + tok * GT_STRIDE + w * 16 + hi * 8 + 4) = (f32x4){e[4] * inv, e[5] * inv, e[6] * inv, e[7] * inv};
    }
}
__device__ __forceinline__ float gelu_fast(float x) {
    const float u2 = x * (1.5957691216057308f + 0.07135481627f * x * x);
    return x * __builtin_amdgcn_rcpf(1.f + __builtin_amdgcn_exp2f(-1.4426950408889634f * u2));
}
typedef float f32x2 __attribute__((ext_vector_type(2)));

__device__ __forceinline__ void sort128(u32 (&k)[8], int m) {
#pragma unroll
    for (int K = 2; K <= 128; K <<= 1) {
#pragma unroll
        for (int S = K >> 1; S > 0; S >>= 1) {
            if (S >= 8) {
                const int mm = S >> 3; const bool lower = (m & mm) == 0, up = (K == 128) ? true : ((m & (K >> 3)) == 0), keepmin = (lower == up);
#pragma unroll
                for (int r = 0; r < 8; ++r) { const u32 o = (u32)__shfl_xor((int)k[r], mm); const u32 mn = umin_(k[r], o), mx = umax_(k[r], o); k[r] = keepmin ? mn : mx; }
            } else {
#pragma unroll
                for (int r = 0; r < 8; ++r) { const int r2 = r ^ S;
                    if (r2 > r) { const u32 a = k[r], b = k[r2], mn = umin_(a, b), mx = umax_(a, b);
                        if (K < 8) { const bool up = (r & K) == 0; k[r] = up ? mn : mx; k[r2] = up ? mx : mn; }
                        else { const bool up = (K == 128) ? true : ((m & (K >> 3)) == 0); k[r] = up ? mn : mx; k[r2] = up ? mx : mn; } } }
            }
        }
    }
}
typedef int v8i __attribute__((ext_vector_type(8)));
__device__ __forceinline__ void eval_mf(Frame& F, const unsigned char* u4, const unsigned char* v4, const float* suv, const float* fg, float* out, int t0) {
    int lane = F.lane; asm volatile("" : "+v"(lane));
    const int g = lane >> 4, m = lane & 15;
    const LAS unsigned short* EXL = (const LAS unsigned short*)(F.lds + RING_OFF + L_EX);
    const LAS float* GTL = (const LAS float*)(F.lds + RING_OFF + L_GT);
    const LAS float* RST = (const LAS float*)(F.lds + RING_OFF + L_RST);
    LAS u32* SKW = (LAS u32*)(F.lds + RING_OFF + L_IDX) + F.wave * 512;
    LAS u32* SK = SKW + g * 128;
    for (int pass = 0; pass < 4; ++pass) {
        const int tb4 = 32 * pass + 4 * F.wave, tok = tb4 + g;
        { u32 k[8]; const v4u ev = *(const LAS v4u*)(EXL + tok * EX_STRIDE + 8 * m); const u32 s0 = (u32)(8 * m);
          k[0] = ((ev.x & 0xffffu) << 7) | s0; k[1] = ((ev.x >> 16) << 7) | (s0 + 1); k[2] = ((ev.y & 0xffffu) << 7) | (s0 + 2); k[3] = ((ev.y >> 16) << 7) | (s0 + 3);
          k[4] = ((ev.z & 0xffffu) << 7) | (s0 + 4); k[5] = ((ev.z >> 16) << 7) | (s0 + 5); k[6] = ((ev.w & 0xffffu) << 7) | (s0 + 6); k[7] = ((ev.w >> 16) << 7) | (s0 + 7);
          sort128(k, m);
          *(LAS v4u*)(SK + m * 8) = (v4u){k[0], k[1], k[2], k[3]}; *(LAS v4u*)(SK + m * 8 + 4) = (v4u){k[4], k[5], k[6], k[7]}; }
        asm volatile("" ::: "memory");
        v8i hb[8];
#pragma unroll
        for (int st = 0; st < 8; ++st) hb[st] = (v8i){0, 0, 0, 0, 0, 0, 0, 0};
        if (m < 4) { const float rq = RST[tb4 + m]; const float* xr = out + (size_t)(t0 + tb4 + m) * DMODEL + 32 * g;
#pragma unroll
            for (int st = 0; st < 8; ++st)
#pragma unroll
                for (int q = 0; q < 8; ++q) { const f32x4 xa = *(const GAS f32x4*)(xr - 32 * g + 128 * st + 64 * (q >> 2) + 16 * g + 4 * (q & 3)); int w = 0;
                    w = __builtin_amdgcn_cvt_pk_fp8_f32(xa[0] * rq, xa[1] * rq, w, false); w = __builtin_amdgcn_cvt_pk_fp8_f32(xa[2] * rq, xa[3] * rq, w, true); hb[st][q] = w; } }
        f32x2 y[32];
#pragma unroll
        for (int q = 0; q < 32; ++q) y[q] = (f32x2){0.f, 0.f};
        float* xrow = out + (size_t)(t0 + tok) * DMODEL + 64 * m;
        const LAS float* gtr = GTL + tok * GT_STRIDE;
        for (int i = 0; i < 128; i += 4) {
            const u32 keyr = SKW[(m & 3) * 128 + i + (m >> 2)];
            const unsigned char* ap = u4 + (keyr >> 7) * 512u + 16u * (u32)g;
            v4u af[8];
#pragma unroll
            for (int st = 0; st < 8; ++st) af[st] = *(const GAS v4u*)(ap + 64 * st);
            const v4u kq = *(const LAS v4u*)(SK + i);
            f32x2 sc[4]; float gate[4];
#pragma unroll
            for (int s4 = 0; s4 < 4; ++s4) { sc[s4] = *(const GAS f32x2*)(suv + 2 * (kq[s4] >> 7)); gate[s4] = gtr[kq[s4] & 127u]; }
            f32x4 D = (f32x4){0.f, 0.f, 0.f, 0.f};
#pragma unroll
            for (int st = 0; st < 8; ++st) { const v8i a8 = (v8i){(int)af[st].x, (int)af[st].y, (int)af[st].z, (int)af[st].w, 0, 0, 0, 0};
                D = __builtin_amdgcn_mfma_scale_f32_16x16x128_f8f6f4(a8, hb[st], D, 4, 0, 0, 0x7f7f7f7f, 0, 0x7f7f7f7f); }
            asm volatile("" ::: "memory");
            v4u vb[4][2];
#pragma unroll
            for (int s4 = 0; s4 < 4; ++s4) { const u32 ro = (kq[s4] >> 7) * 512u + 32u * (u32)m; vb[s4][0] = *(const GAS v4u*)(v4 + ro); vb[s4][1] = *(const GAS v4u*)(v4 + ro + 16); }
            const int sel = lane & 3; const float mine = sel == 0 ? D[0] : sel == 1 ? D[1] : sel == 2 ? D[2] : D[3];
#pragma unroll
            for (int s4 = 0; s4 < 4; ++s4) { const float pre = __uint_as_float((unsigned)__builtin_amdgcn_ds_bpermute(4 * (g + 16 * s4), (int)__float_as_uint(mine)));
                const float act = gelu_fast(pre * sc[s4][0]) * (gate[s4] * sc[s4][1]); const f32x2 b2 = (f32x2){act, act};
#pragma unroll
                for (int c = 0; c < 2; ++c)
#pragma unroll
                    for (int d = 0; d < 4; ++d) { const unsigned w_ = vb[s4][c][d]; const int hq = 16 * c + 4 * d;
                        y[hq] = __builtin_elementwise_fma(__builtin_amdgcn_cvt_scalef32_pk_f32_fp4(w_, 1.0f, 0), b2, y[hq]); y[hq + 1] = __builtin_elementwise_fma(__builtin_amdgcn_cvt_scalef32_pk_f32_fp4(w_, 1.0f, 1), b2, y[hq + 1]);
                        y[hq + 2] = __builtin_elementwise_fma(__builtin_amdgcn_cvt_scalef32_pk_f32_fp4(w_, 1.0f, 2), b2, y[hq + 2]); y[hq + 3] = __builtin_elementwise_fma(__builtin_amdgcn_cvt_scalef32_pk_f32_fp4(w_, 1.0f, 3), b2, y[hq + 3]); } }
        }
        float ss = 0.f;
#pragma unroll
        for (int q = 0; q < 16; ++q) { const f32x4 xa = *(const GAS f32x4*)(xrow + 4 * q); y[2 * q][0] += xa[0]; y[2 * q][1] += xa[1]; y[2 * q + 1][0] += xa[2]; y[2 * q + 1][1] += xa[3];
            ss += (y[2 * q][0] * y[2 * q][0] + y[2 * q][1] * y[2 * q][1]) + (y[2 * q + 1][0] * y[2 * q + 1][0] + y[2 * q + 1][1] * y[2 * q + 1][1]); }
        ss += __shfl_xor(ss, 1); ss += __shfl_xor(ss, 2); ss += __shfl_xor(ss, 4); ss += __shfl_xor(ss, 8);
        const float rs = rsqrtf(ss * (1.f / DMODEL) + RMS_EPS);
        asm volatile("" ::: "memory");
#pragma unroll
        for (int q = 0; q < 16; ++q) { const f32x4 gq = *(const GAS f32x4*)(fg + 64 * m + 4 * q); f32x4 o; o[0] = y[2 * q][0] * rs * gq[0]; o[1] = y[2 * q][1] * rs * gq[1]; o[2] = y[2 * q + 1][0] * rs * gq[2]; o[3] = y[2 * q + 1][1] * rs * gq[3];
            *(GAS f32x4*)(xrow + 4 * q) = o; }
    }
}
__device__ __forceinline__ void peer_phase(Frame& F, const Args& a) {
    unsigned char* ws = a.ws;
    for (int tile = F.vcu; tile < T / TOK; tile += F.G) {
        route_tile(F, (const bf16*)(ws + WS_QP), (const bf16*)(ws + WS_SKB), (const float*)(ws + WS_SUMSQ), tile * TOK);
        __syncthreads();
        eval_mf(F, ws + WS_U8, ws + WS_V8, (const float*)(ws + WS_SU), a.in[19], a.out, tile * TOK);
        __syncthreads();
    }
}
}

namespace lru {
typedef float f32x16 __attribute__((ext_vector_type(16)));
constexpr int TOKT = 128, NTILE = SEQ / TOKT;
constexpr int WAVE_LDS = 14336, L_XS = 0, L_XC = 4608, L_GS = 9216, XC_STRIDE = 72  , L_SS = 8 * WAVE_LDS;
static_assert(L_SS + 32 * 8 * 4 <= RING_BYTES, "LRU LDS map");
__device__ __forceinline__ float bf2f(unsigned short h) { return __uint_as_float((unsigned)h << 16); }
__device__ __forceinline__ int crow16(int r) { return (r & 3) + 8 * (r >> 2); }
__device__ __forceinline__ float sigm(float x) { return __builtin_amdgcn_rcpf(1.f + __builtin_amdgcn_exp2f(-LOG2E * x)); }

template <bool FINAL> __device__ __forceinline__ void lru_tile(Frame& F, const Args& args, int tile) {
    int lane = F.lane; asm volatile("" : "+v"(lane));
    const int w = F.wave, j32 = lane & 31, hi = lane >> 5;
    unsigned char* ws = args.ws;
    const bf16* xr = (const bf16*)(ws + WS_XR); const bf16* gr = (const bf16*)(ws + WS_GR); float* carry = (float*)(ws + WS_CARRY);
    const float* cw = args.in[3]; const float* cb = args.in[4]; const float* ba = args.in[6]; const float* bx = args.in[8]; const float* lam = args.in[9];
    const int b = tile / NTILE, jt = tile % NTILE; const size_t trow0 = (size_t)b * SEQ + (size_t)jt * TOKT;
    LAS unsigned char* wl = F.lds + RING_OFF + w * WAVE_LDS;
    LAS unsigned short* XS = (LAS unsigned short*)(wl + L_XS); LAS unsigned short* XC = (LAS unsigned short*)(wl + L_XC); LAS unsigned short* GS = (LAS unsigned short*)(wl + L_GS);
    LAS float* SS = (LAS float*)(F.lds + RING_OFF + L_SS);
    float c_ba[2], c_bx[2], c_sp[2], c_cb[2], c_cw[2][4];
#pragma unroll
    for (int n = 0; n < 2; ++n) { const int c = 64 * w + 32 * n + j32; c_ba[n] = ba[c]; c_bx[n] = bx[c]; c_cb[n] = cb[c];
        const float l = lam[c]; c_sp[n] = 8.f * LOG2E * (fmaxf(-l, 0.f) + log1pf(expf(-fabsf(l))));
#pragma unroll
        for (int k = 0; k < 4; ++k) c_cw[n][k] = cw[k * LW + c]; }
    const bf16* wax = (const bf16*)(ws + WS_WAX);
    float hc[2] = {0.f, 0.f}, ap[2] = {1.f, 1.f};
    if (FINAL) { const float* cin = (const float*)(ws + WS_CIN) + (size_t)(b * NTILE + jt) * LW + 64 * w + j32; hc[0] = cin[0]; hc[1] = cin[32]; }
    v4u pfx[5], pfg[4];
#define LRU_FETCH(B) do { const size_t tbn_ = trow0 + (B) * 32; _Pragma("unroll") for (int q_ = 0; q_ < 5; ++q_) { const int pc_ = lane + 64 * q_, row_ = pc_ >> 3, c8_ = pc_ & 7; \
        const bool z_ = (jt == 0 && (B) == 0 && row_ < 3) || pc_ >= 35 * 8; const v4u v_ = *(const GAS v4u*)(xr + (tbn_ + (z_ ? 3 : row_) - 3) * LW + w * 64 + c8_ * 8); pfx[q_] = z_ ? (v4u){0u, 0u, 0u, 0u} : v_; } \
        if (FINAL) { _Pragma("unroll") for (int q_ = 0; q_ < 4; ++q_) { const int pc_ = lane + 64 * q_; pfg[q_] = *(const GAS v4u*)(gr + (tbn_ + (pc_ >> 3)) * LW + w * 64 + (pc_ & 7) * 8); } } } while (0)
    LRU_FETCH(0);
    for (int blk = 0; blk < 4; ++blk) {
        const size_t tb = trow0 + blk * 32;
        int ln = lane; asm volatile("" : "+v"(ln));
        const int k32 = ln & 31;
#pragma unroll
        for (int q = 0; q < 5; ++q) { const int pc = ln + 64 * q; if (pc < 35 * 8) *(LAS v4u*)((LAS unsigned char*)XS + (pc >> 3) * 128 + (pc & 7) * 16) = pfx[q]; }
        if (FINAL) {
#pragma unroll
            for (int q = 0; q < 4; ++q) { const int pc = ln + 64 * q; *(LAS v4u*)((LAS unsigned char*)GS + (pc >> 3) * 128 + (pc & 7) * 16) = pfg[q]; } }
        if (blk < 3) { LRU_FETCH(blk + 1); }
        asm volatile("" ::: "memory");
        float xc[2][16];
#pragma unroll
        for (int n = 0; n < 2; ++n)
#pragma unroll
            for (int g = 0; g < 4; ++g) { float xv[7];
#pragma unroll
                for (int q = 0; q < 7; ++q) xv[q] = bf2f(XS[(8 * g + 4 * hi + q) * 64 + 32 * n + j32]);
#pragma unroll
                for (int e = 0; e < 4; ++e) xc[n][4 * g + e] = c_cb[n] + ((c_cw[n][0] * xv[e] + c_cw[n][1] * xv[e + 1]) + (c_cw[n][2] * xv[e + 2] + c_cw[n][3] * xv[e + 3])); }
#pragma unroll
        for (int n = 0; n < 2; ++n)
#pragma unroll
            for (int r = 0; r < 16; ++r) XC[(crow16(r) + 4 * hi) * XC_STRIDE + 32 * n + j32] = (unsigned short)f2bf(xc[n][r]);
        asm volatile("" ::: "memory");
        bf16x8 af[4];
#pragma unroll
        for (int ks = 0; ks < 4; ++ks) af[ks] = *(const LAS bf16x8*)(XC + j32 * XC_STRIDE + 16 * ks + 8 * hi);
        asm volatile("" ::: "memory");
        float yv[2][16];
#pragma unroll
        for (int n = 0; n < 2; ++n) {
            f32x16 R = {}, I = {};
            bf16x8 fa[4], fx[4];
#pragma unroll
            for (int ks = 0; ks < 4; ++ks) { fa[ks] = *(const GAS bf16x8*)(wax + (size_t)(((w * 2 + 0) * 2 + n) * 4 + ks) * 512 + ln * 8); fx[ks] = *(const GAS bf16x8*)(wax + (size_t)(((w * 2 + 1) * 2 + n) * 4 + ks) * 512 + ln * 8); }
#pragma unroll
            for (int ks = 0; ks < 4; ++ks) { R = __builtin_amdgcn_mfma_f32_32x32x16_bf16(af[ks], fa[ks], R, 0, 0, 0); I = __builtin_amdgcn_mfma_f32_32x32x16_bf16(af[ks], fx[ks], I, 0, 0, 0); }
            float av[16], uv[16];
#pragma unroll
            for (int r = 0; r < 16; ++r) { const float rg = sigm(R[r] + c_ba[n]), ig = sigm(I[r] + c_bx[n]); const float a_ = __builtin_amdgcn_exp2f(-rg * c_sp[n]);
                av[r] = a_; uv[r] = __builtin_amdgcn_sqrtf(fmaxf(1.f - a_ * a_, 0.f)) * (ig * xc[n][r]); }
            float Ar[4], Hr[4], hst[4];
#pragma unroll
            for (int g = 0; g < 4; ++g) { Ar[g] = (av[4 * g] * av[4 * g + 1]) * (av[4 * g + 2] * av[4 * g + 3]);
                Hr[g] = ((uv[4 * g] * av[4 * g + 1] + uv[4 * g + 1]) * av[4 * g + 2] + uv[4 * g + 2]) * av[4 * g + 3] + uv[4 * g + 3]; }
            float hin = hc[n];
#pragma unroll
            for (int g = 0; g < 4; ++g) { float o1 = Ar[g] * hin + Hr[g]; const float x = __shfl_xor(o1, 32); const float hg = hi ? x : hin; o1 = Ar[g] * hg + Hr[g]; hst[g] = hg;
                const float y = __shfl_xor(o1, 32); hin = hi ? o1 : y;
                if (!FINAL) ap[n] *= Ar[g] * __shfl_xor(Ar[g], 32); }
            hc[n] = hin;
            if (FINAL) {
#pragma unroll
                for (int g = 0; g < 4; ++g) { float h = hst[g];
#pragma unroll
                    for (int e = 0; e < 4; ++e) { const int r = 4 * g + e; h = av[r] * h + uv[r]; yv[n][r] = h * bf2f(GS[(crow16(r) + 4 * hi) * 64 + 32 * n + j32]); } } }
        }
        if (FINAL) {
#pragma unroll
            for (int r = 0; r < 16; ++r) { float s = yv[0][r] * yv[0][r] + yv[1][r] * yv[1][r];
                s += __shfl_xor(s, 1); s += __shfl_xor(s, 2); s += __shfl_xor(s, 4); s += __shfl_xor(s, 8); s += __shfl_xor(s, 16);
                if (j32 == 0) SS[(crow16(r) + 4 * hi) * 8 + w] = s; }
            __syncthreads();
            bf16* ymix = (bf16*)(ws + WS_H);
#pragma unroll
            for (int r = 0; r < 16; ++r) { const int tk = crow16(r) + 4 * hi; const f32x4 s0 = *(const LAS f32x4*)(SS + tk * 8), s1 = *(const LAS f32x4*)(SS + tk * 8 + 4);
                const float rstd = rsqrtf(((s0[0] + s0[1]) + (s0[2] + s0[3]) + (s1[0] + s1[1]) + (s1[2] + s1[3])) * (1.f / LW) + RMS_EPS);
                bf16* yp = ymix + (tb + tk) * DMODEL + 64 * w + k32;
                yp[0] = (bf16)f2bf(yv[0][r] * rstd); yp[32] = (bf16)f2bf(yv[1][r] * rstd); }
            __syncthreads();
        }
    }
#undef LRU_FETCH
    if (!FINAL) { if (hi == 0) { float* cp = carry + ((size_t)(b * NTILE + jt) * 2) * LW + 64 * w + j32;
#pragma unroll
        for (int n = 0; n < 2; ++n) { cp[32 * n] = ap[n]; cp[LW + 32 * n] = hc[n]; } } }
    else {
        const bf16* ob = (const bf16*)(ws + WS_O); bf16* ymix = (bf16*)(ws + WS_H);
        for (int i0 = 0; i0 < 16; i0 += 4) {
            v4u vv[4];
#pragma unroll
            for (int i = 0; i < 4; ++i) vv[i] = *(const GAS v4u*)(ob + (trow0 + 16 * w + i0 + i) * AW + 8 * lane);
            float ssq[4];
#pragma unroll
            for (int i = 0; i < 4; ++i) { float s = 0.f;
#pragma unroll
                for (int c = 0; c < 4; ++c) { const float lo = __uint_as_float(vv[i][c] << 16), hi2 = __uint_as_float(vv[i][c] & 0xffff0000u); s += lo * lo + hi2 * hi2; }
                ssq[i] = s; }
#pragma unroll
            for (int o = 1; o < 64; o <<= 1) {
#pragma unroll
                for (int i = 0; i < 4; ++i) ssq[i] += __shfl_xor(ssq[i], o); }
#pragma unroll
            for (int i = 0; i < 4; ++i) { const float rstd = rsqrtf(ssq[i] * (1.f / AW) + RMS_EPS); v4u o;
#pragma unroll
                for (int c = 0; c < 4; ++c) o[c] = pk2(__uint_as_float(vv[i][c] << 16) * rstd, __uint_as_float(vv[i][c] & 0xffff0000u) * rstd);
                *(GAS v4u*)(ymix + (trow0 + 16 * w + i0 + i) * DMODEL + LW + 8 * lane) = o; } }
    }
}
__device__ __forceinline__ void norm_pass(Frame& F, const Args& a) {
    unsigned char* ws = a.ws; float* nrm = (float*)(ws + WS_NRM);
    const int gw = F.vcu * NWAVES + F.wave, NGW = F.G * NWAVES, lane = F.lane;
    for (int it = gw; it < 2 * BATCH * (SEQ / 64); it += NGW) {
        const int which = it / (BATCH * (SEQ / 64)), r = it % (BATCH * (SEQ / 64)), b = r / (SEQ / 64), t = r % (SEQ / 64);
        const bf16* src = (const bf16*)(ws + (which ? WS_K : WS_Q)) + ((size_t)b * SEQ + 64 * t) * AW + 8 * lane;
        float mx = 0.f;
#pragma unroll 8
        for (int i = 0; i < 64; ++i) { const v4u v = *(const GAS v4u*)(src + (size_t)i * AW); float s = 0.f;
#pragma unroll
            for (int c = 0; c < 4; ++c) { const float lo = __uint_as_float(v[c] << 16), hi = __uint_as_float(v[c] & 0xffff0000u); s += lo * lo + hi * hi; }
            s += __shfl_xor(s, 1); s += __shfl_xor(s, 2); s += __shfl_xor(s, 4); mx = fmaxf(mx, s); }
        if ((lane & 7) == 0) nrm[which * 4096 + (b * NHEADS + (lane >> 3)) * 128 + t] = sqrtf(mx) * 1.0001f;
    }
}
__device__ __forceinline__ void carry_prefix(Frame& F, const Args& a, int b) {
    const float* carry = (const float*)(a.ws + WS_CARRY) + (size_t)b * NTILE * 2 * LW + F.tid; float* cin = (float*)(a.ws + WS_CIN) + (size_t)b * NTILE * LW + F.tid;
    float c = 0.f;
    for (int j0 = 0; j0 < NTILE; j0 += 8) { float A[8], H[8];
#pragma unroll
        for (int j = 0; j < 8; ++j) { A[j] = carry[(size_t)(j0 + j) * 2 * LW]; H[j] = carry[(size_t)(j0 + j) * 2 * LW + LW]; }
#pragma unroll
        for (int j = 0; j < 8; ++j) { cin[(size_t)(j0 + j) * LW] = c; c = A[j] * c + H[j]; } }
}
template <bool FINAL> __device__ __forceinline__ void lru_phase(Frame& F, const Args& a) {
    for (int tile = F.vcu; tile < BATCH * NTILE; tile += F.G) { lru_tile<FINAL>(F, a, tile); __syncthreads(); }
}
}
__global__ void __launch_bounds__(NWAVES * 64, 2) mk_fwd(Args args) {
    extern __shared__ __attribute__((aligned(16))) unsigned char lds[];
    Frame F;
    F.lds = (LAS unsigned char*)lds;
    F.MISC = (volatile LAS unsigned*)(F.lds + MISC_OFF);
    F.wave = __builtin_amdgcn_readfirstlane((int)threadIdx.x >> 6); F.lane = (int)__builtin_amdgcn_mbcnt_hi(~0u, __builtin_amdgcn_mbcnt_lo(~0u, 0u)); F.tid = F.wave * 64 + F.lane;
    F.G = gridDim.x; { const int bx = blockIdx.x; F.vcu = (F.G % 8 == 0) ? (bx % 8) * (F.G / 8) + bx / 8 : bx; }
    unsigned char* ws = args.ws;
    F.ctl = (gu32*)(ws + WS_CTL);
    for (int u = F.tid; u < (LDS_BYTES - LDSCTL_OFF) / 4; u += NWAVES * 64) ((LAS unsigned*)(F.lds + LDSCTL_OFF))[u] = 0u;
    __syncthreads();
    XcdBarrier bar = xcd_barrier_post((unsigned*)(F.ctl + CW_BAR) + args.li * XCD_BAR_WORDS, F.MISC + 8, F.wave);
    const int lo = args.ph_lo, hi = args.ph_hi;
#define IN(k) (lo <= (k) && (k) < hi)
#define BOTH(k) (IN(k) && IN((k) + 1))
#define GRID_BAR() xcd_barrier(bar)

    if (IN(0)) { p0_prologue(F, args); if (BOTH(0)) GRID_BAR(); }

    if (IN(1)) {
        if (F.vcu < BATCH * NHEADS) fcum_unit(F, F.vcu, (const float*)(ws + WS_LOGF), (float*)(ws + WS_FCUM));
        pg8::Gemm g{(const pg8::bf16_t*)(ws + WS_H), (const pg8::bf16_t*)(ws + WS_WIN), T, NG1, DMODEL}; pg8::StaticOrder S; S.init(T, NG1, F.G, (int)blockIdx.x);
        pg8::EpiG1 E{(pg8::bf16_t*)(ws + WS_XR), SPLIT_STRIDE, QSCALE};
        pg8::gemm_phase<pg8::EpiG1, pg8::StaticOrder, true, true>(F.lds + RING_OFF, g, S, E, F.wave);
        if (BOTH(1)) GRID_BAR();
    }
    if (IN(2)) { lru::lru_phase<false>(F, args); lru::norm_pass(F, args); if (BOTH(2)) GRID_BAR(); }
    if (IN(3)) {
        static_assert(attn_body::ATTN_LDS_BYTES <= RING_BYTES, "attention LDS vs frame");
        if (F.vcu < BATCH) lru::carry_prefix(F, args, F.vcu);
        const attn_body::AttnTensors AT{(const attn_body::bf16*)(ws + WS_Q), (const attn_body::bf16*)(ws + WS_K), (const attn_body::bf16*)(ws + WS_V), (attn_body::bf16*)(ws + WS_O), (const float*)(ws + WS_FCUM), (const float*)(ws + WS_NRM)};
        attn_body::attn_phase<8>((char*)lds + RING_OFF, AT, (unsigned*)(F.ctl + CW_ATTQ), F.MISC + 24, F.wave);
        if (BOTH(3)) GRID_BAR();
    }
    if (IN(4)) { lru::lru_phase<true>(F, args); if (BOTH(4)) GRID_BAR(); }
    if (IN(5)) {
        pg8::Gemm g{(const pg8::bf16_t*)(ws + WS_H), (const pg8::bf16_t*)(ws + WS_WOUT), T, DMODEL, DMODEL}; pg8::StaticOrder S; S.init(T, DMODEL, F.G, (int)blockIdx.x);
        pg8::EpiG2 E{args.in[0], args.out, (pg8::bf16_t*)(ws + WS_X1B), (float*)(ws + WS_SUMSQ), DMODEL};
        pg8::gemm_phase<pg8::EpiG2, pg8::StaticOrder, true, true>(F.lds + RING_OFF, g, S, E, F.wave);
        if (BOTH(5)) GRID_BAR();
    }
    if (IN(6)) {
        pg8::Gemm g{(const pg8::bf16_t*)(ws + WS_X1B), (const pg8::bf16_t*)(ws + WS_WQ), T, QPW, DMODEL}; pg8::StaticOrder S; S.init(T, QPW, F.G, (int)blockIdx.x);
        pg8::EpiG3 E{(pg8::bf16_t*)(ws + WS_QP), QPW};
        pg8::gemm_phase<pg8::EpiG3, pg8::StaticOrder, true, true>(F.lds + RING_OFF, g, S, E, F.wave);
        if (BOTH(6)) GRID_BAR();
    }
    if (IN(7)) { peer::peer_phase(F, args); }
#undef IN
#undef BOTH
#undef GRID_BAR
}

extern "C" void kernel_launch(void* const* d_in, const int* in_sizes, int n_in, void* d_out, int out_size, void* d_ws, size_t ws_size, hipStream_t stream) {
    static int grid = 0;
    if (grid == 0) {
        if (n_in != 20 || in_sizes[0] != T * DMODEL || out_size != T * DMODEL || ws_size < WS_END) { fprintf(stderr, "kernel_launch: unexpected shapes (n_in %d, ws %zu)\n", n_in, ws_size); grid = -1; return; }
        int dev = 0, cus = 0;
        if (hipGetDevice(&dev) != hipSuccess || hipDeviceGetAttribute(&cus, hipDeviceAttributeMultiprocessorCount, dev) != hipSuccess) { grid = -1; return; }
        if (hipFuncSetAttribute((const void*)mk_fwd, hipFuncAttributeMaxDynamicSharedMemorySize, LDS_BYTES) != hipSuccess) { fprintf(stderr, "kernel_launch: hipFuncSetAttribute failed\n"); grid = -1; return; }
        (void)hipGetLastError();
        grid = cus;
    }
    if (grid < 0) return;
    if (hipMemsetAsync((char*)d_ws + WS_CTL, 0, CTL_ZERO_BYTES, stream) != hipSuccess) return;
    Args a{};
    for (int i = 0; i < 20; ++i) a.in[i] = (const float*)d_in[i];
    a.out = (float*)d_out; a.ws = (unsigned char*)d_ws; a.ph_lo = 0; a.ph_hi = N_PHASES; a.li = 0;
    hipLaunchKernelGGL(mk_fwd, dim3(grid), dim3(NWAVES * 64), LDS_BYTES, stream, a);
}
```

```cpp
#include <hip/hip_runtime.h>
#include <hip/hip_bf16.h>
#include <cstdio>
#include <cstdint>
#include <cmath>

constexpr int BATCH = 4, SEQ = 8192, DMODEL = 1024, T = BATCH * SEQ;
constexpr int LW = 512, AW = 512, NHEADS = 8, HD = 64, INC = 2568, NG1 = 2560;
constexpr int PH = 8, NKEY = 128, PHALF = 128, TOPK = 16, NEXP = NKEY * NKEY, QPW = 2048;
constexpr float RMS_EPS = 1e-6f;
constexpr float LOG2E = 1.4426950408889634f;
constexpr float QSCALE = 0.125f * LOG2E;
constexpr size_t MiB = 1u << 20;
constexpr size_t WS_CTL = 0, CTL_ZERO_BYTES = 1 * MiB;
constexpr size_t WS_WIN = 2 * MiB, WS_WOUT = 8 * MiB, WS_WQ = 10 * MiB, WS_SKB = 14 * MiB, WS_WFL = 15 * MiB,
                 WS_LOGF = 16 * MiB, WS_FCUM = 17 * MiB, WS_CARRY = 18 * MiB, WS_SUMSQ = 19 * MiB, WS_WAX = 20 * MiB, WS_CIN = 23 * MiB  , WS_NRM = 22 * MiB  ,
                 WS_H = 32 * MiB, WS_XR = 96 * MiB, WS_GR = 128 * MiB, WS_Q = 160 * MiB, WS_K = 192 * MiB, WS_V = 224 * MiB,
                 WS_X1B = 256 * MiB, WS_O = 256 * MiB  , WS_QP = 96 * MiB, WS_UT = 320 * MiB, WS_VT = 352 * MiB, WS_U8 = 320 * MiB, WS_V8 = 336 * MiB, WS_SU = 21 * MiB, WS_SV = 21 * MiB + 65536, WS_LA = 384 * MiB, WS_LU = 448 * MiB, WS_END = 512 * MiB;
constexpr size_t SPLIT_STRIDE = (WS_GR - WS_XR) / 2;
constexpr int CW_TMO = 0, CW_ATTQ = 2048, CW_BAR = 4096;

namespace pg8 {
#define PG8_LAS __attribute__((address_space(3)))
typedef unsigned short bf16_t;
typedef short bf16x8 __attribute__((ext_vector_type(8)));
typedef float f32x4 __attribute__((ext_vector_type(4)));
typedef unsigned u32x4 __attribute__((ext_vector_type(4)));
constexpr int BM = 256, BK = 64, HALF = 128, HTB = HALF * BK * 2  , STAGE_BYTES = 8 * HTB, NXCD = 8, WGM = 8;

__host__ __device__ __forceinline__ int lds_byte(int r, int c) { const int st = (r >> 4) * 2 + (c >> 5), rr = r & 15, cc = c & 31, ob = rr * 64 + cc * 2; return st * 1024 + (ob ^ (((ob >> 9) & 1) << 5)); }
__host__ __device__ __forceinline__ void stage_rc(int b, int& R, int& C) { const int st = b / 1024, sb = b % 1024, swz = sb ^ (((sb >> 9) & 1) << 5); R = (st >> 1) * 16 + swz / 64; C = (st & 1) * 32 + (swz % 64) / 2; }
__host__ __device__ __forceinline__ int perm32(int rho) { const int n = rho >> 4, i = rho & 15; return 8 * (i >> 2) + 4 * n + (i & 3); }

struct Unit { int pm, pn; };
struct Gemm { const bf16_t* A; const bf16_t* Bt; int M, N, K; };

struct StaticOrder {
    int nM, nN, nwg, G, c;
    __host__ __device__ void init(int M, int N, int G_, int c_) { nM = M / BM; nN = N / BM; nwg = nM * nN; G = G_; c = c_; }
    __host__ __device__ bool next(int i, Unit& u) const {
        const long L = (long)i * G + c; if (L >= nwg) return false;
        int wgid = (int)L; { const int q = nwg / NXCD, r = nwg % NXCD, xcd = wgid % NXCD, off = wgid / NXCD; wgid = (xcd < r ? xcd * (q + 1) : r * (q + 1) + (xcd - r) * q) + off; }
        const int nig = WGM * nN, gid = wgid / nig, fm = gid * WGM, gsz = (nM - fm) < WGM ? (nM - fm) : WGM;
        u.pm = fm + ((wgid % nig) % gsz); u.pn = (wgid % nig) / gsz; return true;
    }
    __device__ __forceinline__ void a_ready(const Unit&) const {}
    __device__ __forceinline__ void done(const Unit&) const {}
};

__device__ __forceinline__ unsigned cvt_pk_bf16(float lo, float hi) { unsigned r; asm volatile("v_cvt_pk_bf16_f32 %0, %1, %2" : "=v"(r) : "v"(lo), "v"(hi)); return r; }
typedef unsigned u32x2 __attribute__((ext_vector_type(2)));
__device__ __forceinline__ float gelu_fast(float x) {
    const float u2 = x * (1.5957691216057308f + 0.07135481627f * x * x);
    return x * __builtin_amdgcn_rcpf(1.f + __builtin_amdgcn_exp2f(-1.4426950408889634f * u2));
}
struct EpiG1 {
    static constexpr bool PERM = true, AFTER_DRAIN = false;
    bf16_t* base0; size_t split_stride; float qscale;
    __device__ __forceinline__ void operator()(const f32x4 (&acc)[2][2][4][2], const Unit& u, int wr, int wc, int fr, int fq) const {
        const int s = u.pn >> 1; bf16_t* base = base0 + (size_t)s * split_stride;
        const int row0 = u.pm * BM + wr * 64 + fr, col0 = (u.pn & 1) * 256 + wc * 32 + 8 * fq;
#pragma unroll
        for (int ai = 0; ai < 2; ++ai)
#pragma unroll
            for (int m = 0; m < 4; ++m) { bf16_t* rowp = base + (size_t)(row0 + ai * HALF + m * 16) * 512 + col0;
#pragma unroll
                for (int bj = 0; bj < 2; ++bj) { f32x4 v0 = acc[ai][bj][m][0], v1 = acc[ai][bj][m][1];
                    if (s == 1) {
#pragma unroll
                        for (int e = 0; e < 4; ++e) { v0[e] = gelu_fast(v0[e]); v1[e] = gelu_fast(v1[e]); } }
                    else if (s == 2) { v0 = v0 * qscale; v1 = v1 * qscale; }
                    u32x4 w; w.x = cvt_pk_bf16(v0[0], v0[1]); w.y = cvt_pk_bf16(v0[2], v0[3]); w.z = cvt_pk_bf16(v1[0], v1[1]); w.w = cvt_pk_bf16(v1[2], v1[3]);
                    *(u32x4*)(rowp + bj * HALF) = w; } }
    }
};
struct EpiG2 {
    static constexpr bool PERM = false, AFTER_DRAIN = false;
    const float* resid; float* out; bf16_t* xb; float* sumsq; int ldc;
    __device__ __forceinline__ void operator()(const f32x4 (&acc)[2][2][4][2], const Unit& u, int wr, int wc, int fr, int fq) const {
        const int row0 = u.pm * BM + wr * 64 + fr, col0 = u.pn * BM + wc * 32 + 4 * fq;
#pragma unroll
        for (int ai = 0; ai < 2; ++ai) {
            f32x4 rs[4][2][2];
#pragma unroll
            for (int m = 0; m < 4; ++m) { const size_t off = (size_t)(row0 + ai * HALF + m * 16) * ldc + col0;
#pragma unroll
                for (int bj = 0; bj < 2; ++bj)
#pragma unroll
                    for (int n = 0; n < 2; ++n) rs[m][bj][n] = *(const f32x4*)(resid + off + bj * HALF + n * 16); }
#pragma unroll
            for (int m = 0; m < 4; ++m) { const int r = row0 + ai * HALF + m * 16; const size_t off = (size_t)r * ldc + col0; float ss = 0.f;
#pragma unroll
                for (int bj = 0; bj < 2; ++bj)
#pragma unroll
                    for (int n = 0; n < 2; ++n) { const f32x4 x = rs[m][bj][n] + acc[ai][bj][m][n];
                        *(f32x4*)(out + off + bj * HALF + n * 16) = x; ss += (x[0] * x[0] + x[1] * x[1]) + (x[2] * x[2] + x[3] * x[3]);
                        u32x2 w; w.x = cvt_pk_bf16(x[0], x[1]); w.y = cvt_pk_bf16(x[2], x[3]); *(u32x2*)(xb + off + bj * HALF + n * 16) = w; }
                ss += __shfl_xor(ss, 16); ss += __shfl_xor(ss, 32);
                if (fq == 0) atomicAdd(sumsq + r, ss); }
            asm volatile("" ::: "memory"); }
    }
};
struct EpiG3 {
    static constexpr bool PERM = true, AFTER_DRAIN = false;
    bf16_t* O; int ldc;
    __device__ __forceinline__ void operator()(const f32x4 (&acc)[2][2][4][2], const Unit& u, int wr, int wc, int fr, int fq) const {
        const int row0 = u.pm * BM + wr * 64 + fr, col0 = u.pn * BM + wc * 32 + 8 * fq;
#pragma unroll
        for (int ai = 0; ai < 2; ++ai)
#pragma unroll
            for (int m = 0; m < 4; ++m) { bf16_t* rowp = O + (size_t)(row0 + ai * HALF + m * 16) * ldc + col0;
#pragma unroll
                for (int bj = 0; bj < 2; ++bj) { const f32x4 v0 = acc[ai][bj][m][0], v1 = acc[ai][bj][m][1];
                    u32x4 w; w.x = cvt_pk_bf16(v0[0], v0[1]); w.y = cvt_pk_bf16(v0[2], v0[3]); w.z = cvt_pk_bf16(v1[0], v1[1]); w.w = cvt_pk_bf16(v1[2], v1[3]);
                    *(u32x4*)(rowp + bj * HALF) = w; } }
    }
};

template <class Epi, class Sched, bool ALIGN_EPI = false, bool SP2 = false>
__device__ __forceinline__ void gemm_phase(PG8_LAS unsigned char* lds, const Gemm g, const Sched& S, const Epi& E, int wid_in) {
    const int wid = __builtin_amdgcn_readfirstlane(wid_in), lane = (int)__builtin_amdgcn_mbcnt_hi(~0u, __builtin_amdgcn_mbcnt_lo(~0u, 0u)), tid = wid * 64 + lane, wr = wid >> 2, wc = wid & 3, fr = lane & 15, fq = lane >> 4;
    const int K = g.K, nt = K / BK;
    unsigned voffA[2], voffB[2];
#pragma unroll
    for (int i = 0; i < 2; ++i) { int R, C; stage_rc(tid * 16 + i * 8192, R, C); const int Rb = Epi::PERM ? ((R & ~31) + perm32(R & 31)) : R;
        voffA[i] = (unsigned)(R * K + C) * 2u; voffB[i] = (unsigned)(Rb * K + C) * 2u; }
    const size_t kstep = (size_t)(BK * 2);
    const size_t hstep = (size_t)HALF * K * 2;
    const size_t tstep = 2 * hstep;
    const unsigned ldsw = (unsigned)wid * 1024u;
    const int aoff = lds_byte(wr * 64 + fr, fq * 8), boff = lds_byte(wc * 32 + fr, fq * 8);
#define PG8_SA(b, h) (((b) * 2 + (h)) * HTB)
#define PG8_SB(b, h) ((4 + (b) * 2 + (h)) * HTB)
#define PG8_STAGE(bufoff, gbase, voff) do { _Pragma("unroll") for (int _i = 0; _i < 2; ++_i) \
        __builtin_amdgcn_global_load_lds((const unsigned*)((const char*)(gbase) + (voff)[_i]), (PG8_LAS unsigned*)(lds + (bufoff) + ldsw + _i * 8192), 16, 0, 0); } while (0)
#define PG8_LDA(dst, b, h) do { _Pragma("unroll") for (int m = 0; m < 4; ++m) _Pragma("unroll") for (int k = 0; k < 2; ++k) dst[m][k] = *(const PG8_LAS bf16x8*)(lds + PG8_SA(b, h) + aoff + m * 2048 + k * 1024); } while (0)
#define PG8_LDB(dst, b, h) do { _Pragma("unroll") for (int n = 0; n < 2; ++n) _Pragma("unroll") for (int k = 0; k < 2; ++k) dst[n][k] = *(const PG8_LAS bf16x8*)(lds + PG8_SB(b, h) + boff + n * 2048 + k * 1024); } while (0)
#define PG8_MMA(ai, bj, At, Bt) do { __builtin_amdgcn_s_setprio(1); _Pragma("unroll") for (int m = 0; m < 4; ++m) _Pragma("unroll") for (int n = 0; n < 2; ++n) _Pragma("unroll") for (int k = 0; k < 2; ++k) \
        acc[ai][bj][m][n] = __builtin_amdgcn_mfma_f32_16x16x32_bf16(Bt[n][k], At[m][k], acc[ai][bj][m][n], 0, 0, 0); __builtin_amdgcn_s_setprio(0); } while (0)
#define PG8_WAIT_V(n) asm volatile("s_waitcnt vmcnt(" #n ")" ::: "memory")
#define PG8_WAIT_L(n) asm volatile("s_waitcnt lgkmcnt(" #n ")" ::: "memory")
#define PG8_BAR __builtin_amdgcn_s_barrier()
#define PG8_SCHED __builtin_amdgcn_sched_barrier(0)
    Unit cur, nxt; int ui = 0;
    if (!S.next(0, cur)) return;
    f32x4 acc[2][2][4][2];
#pragma unroll
    for (int a = 0; a < 2; ++a)
#pragma unroll
        for (int b = 0; b < 2; ++b)
#pragma unroll
            for (int m = 0; m < 4; ++m)
#pragma unroll
                for (int n = 0; n < 2; ++n) acc[a][b][m][n] = (f32x4){0.f, 0.f, 0.f, 0.f};
    bf16x8 At[4][2], B0[2][2], B1[2][2];
    const char* cA = (const char*)g.A + (size_t)cur.pm * tstep; const char* cB = (const char*)g.Bt + (size_t)cur.pn * tstep;
    S.a_ready(cur);
    if constexpr (SP2) {
        PG8_STAGE(PG8_SB(0, 0), cB, voffB); PG8_STAGE(PG8_SB(0, 1), cB + hstep, voffB); PG8_STAGE(PG8_SA(0, 0), cA, voffA); PG8_STAGE(PG8_SA(0, 1), cA + hstep, voffA);
        if (wr == 1) PG8_BAR;
        PG8_WAIT_V(2); PG8_BAR;
        PG8_STAGE(PG8_SB(1, 0), cB + kstep, voffB); PG8_STAGE(PG8_SA(1, 0), cA + kstep, voffA); PG8_STAGE(PG8_SB(1, 1), cB + hstep + kstep, voffB);
        PG8_WAIT_V(6); PG8_BAR;
    } else {
        PG8_STAGE(PG8_SB(0, 0), cB, voffB); PG8_STAGE(PG8_SA(0, 0), cA, voffA); PG8_STAGE(PG8_SB(0, 1), cB + hstep, voffB); PG8_STAGE(PG8_SA(0, 1), cA + hstep, voffA);
        if (wr == 1) PG8_BAR;
        PG8_WAIT_V(4); PG8_BAR;
        PG8_STAGE(PG8_SB(1, 0), cB + kstep, voffB); PG8_STAGE(PG8_SA(1, 0), cA + kstep, voffA); PG8_STAGE(PG8_SB(1, 1), cB + hstep + kstep, voffB);
        PG8_WAIT_V(6); PG8_BAR;
    }
    for (;;) {
        const bool has_next = S.next(ui + 1, nxt);
        const char* nA = has_next ? (const char*)g.A + (size_t)nxt.pm * tstep : cA; const char* nB = has_next ? (const char*)g.Bt + (size_t)nxt.pn * tstep : cB;
        for (int t = 0; t < nt; t += 2) {
            const bool last = (t == nt - 2);
            const char* a1 = cA + (size_t)(t + 1) * kstep;
            const char* a2 = last ? nA : cA + (size_t)(t + 2) * kstep; const char* b2 = last ? nB : cB + (size_t)(t + 2) * kstep;
            const char* a3 = a2 + kstep; const char* b3 = b2 + kstep;
            if (last && has_next) S.a_ready(nxt);
            if constexpr (SP2) {
            PG8_LDB(B0, 0, 0); PG8_LDB(B1, 0, 1); PG8_SCHED; PG8_LDA(At, 0, 0); PG8_STAGE(PG8_SA(1, 1), a1 + hstep, voffA);
            PG8_WAIT_V(8); PG8_WAIT_L(0); PG8_BAR; PG8_MMA(0, 0, At, B0); PG8_MMA(0, 1, At, B1); PG8_BAR; PG8_SCHED;
            PG8_LDA(At, 0, 1); PG8_STAGE(PG8_SB(0, 0), b2, voffB); PG8_STAGE(PG8_SB(0, 1), b2 + hstep, voffB); PG8_STAGE(PG8_SA(0, 0), a2, voffA);
            PG8_WAIT_V(8); PG8_WAIT_L(0); PG8_BAR; PG8_MMA(1, 0, At, B0); PG8_MMA(1, 1, At, B1); PG8_BAR; PG8_SCHED;
            PG8_LDB(B0, 1, 0); PG8_LDB(B1, 1, 1); PG8_SCHED; PG8_LDA(At, 1, 0); PG8_STAGE(PG8_SA(0, 1), a2 + hstep, voffA);
            PG8_WAIT_V(8); PG8_WAIT_L(0); PG8_BAR; PG8_MMA(0, 0, At, B0); PG8_MMA(0, 1, At, B1); PG8_BAR; PG8_SCHED;
            PG8_LDA(At, 1, 1); PG8_STAGE(PG8_SB(1, 0), b3, voffB); PG8_STAGE(PG8_SB(1, 1), b3 + hstep, voffB); PG8_STAGE(PG8_SA(1, 0), a3, voffA);
            PG8_WAIT_V(8); PG8_WAIT_L(0); PG8_BAR; PG8_MMA(1, 0, At, B0); PG8_MMA(1, 1, At, B1); PG8_BAR; PG8_SCHED;
            } else {
            PG8_LDB(B0, 0, 0); PG8_SCHED; PG8_LDA(At, 0, 0); PG8_STAGE(PG8_SA(1, 1), a1 + hstep, voffA);
            PG8_WAIT_L(8); PG8_BAR; PG8_WAIT_L(0); PG8_MMA(0, 0, At, B0); PG8_BAR; PG8_SCHED;
            PG8_LDB(B1, 0, 1); PG8_STAGE(PG8_SB(0, 0), b2, voffB);
            PG8_BAR; PG8_WAIT_L(0); PG8_MMA(0, 1, At, B1); PG8_BAR;
            PG8_LDA(At, 0, 1); PG8_STAGE(PG8_SA(0, 0), a2, voffA);
            PG8_BAR; PG8_WAIT_L(0); PG8_MMA(1, 0, At, B0); PG8_BAR; PG8_SCHED;
            PG8_STAGE(PG8_SB(0, 1), b2 + hstep, voffB);
            PG8_WAIT_V(6); PG8_BAR; PG8_MMA(1, 1, At, B1); PG8_BAR;
            PG8_LDB(B0, 1, 0); PG8_SCHED; PG8_LDA(At, 1, 0); PG8_STAGE(PG8_SA(0, 1), a2 + hstep, voffA);
            PG8_WAIT_L(8); PG8_BAR; PG8_WAIT_L(0); PG8_MMA(0, 0, At, B0); PG8_BAR; PG8_SCHED;
            PG8_LDB(B1, 1, 1); PG8_STAGE(PG8_SB(1, 0), b3, voffB);
            PG8_BAR; PG8_WAIT_L(0); PG8_MMA(0, 1, At, B1); PG8_BAR;
            PG8_LDA(At, 1, 1); PG8_STAGE(PG8_SA(1, 0), a3, voffA);
            PG8_BAR; PG8_WAIT_L(0); PG8_MMA(1, 0, At, B0); PG8_BAR; PG8_SCHED;
            PG8_STAGE(PG8_SB(1, 1), b3 + hstep, voffB);
            PG8_WAIT_V(6); PG8_BAR; PG8_MMA(1, 1, At, B1); PG8_BAR;
            }
        }
        if constexpr (ALIGN_EPI) { if (wr == 0) PG8_BAR; }
        if constexpr (!Epi::AFTER_DRAIN) { E(acc, cur, wr, wc, fr, fq); S.done(cur); }
        if (!has_next) break;
#pragma unroll
        for (int a = 0; a < 2; ++a)
#pragma unroll
            for (int b = 0; b < 2; ++b)
#pragma unroll
                for (int m = 0; m < 4; ++m)
#pragma unroll
                    for (int n = 0; n < 2; ++n) acc[a][b][m][n] = (f32x4){0.f, 0.f, 0.f, 0.f};
        cur = nxt; cA = nA; cB = nB; ++ui;
        if constexpr (ALIGN_EPI) { if (wr == 1) PG8_BAR; }
    }
    PG8_WAIT_V(0);
    if constexpr (!ALIGN_EPI) { if (wr == 0) PG8_BAR; }
    PG8_BAR;
    if constexpr (Epi::AFTER_DRAIN) { E.fused(acc, cur, wr, wc, fr, fq, lds, wid, lane); S.done(cur); }
#undef PG8_SA
#undef PG8_SB
#undef PG8_STAGE
#undef PG8_LDA
#undef PG8_LDB
#undef PG8_MMA
#undef PG8_WAIT_V
#undef PG8_WAIT_L
#undef PG8_BAR
#undef PG8_SCHED
}
}
#include <hip/hip_bf16.h>
#include <cmath>
namespace attn_body {
using bf16=__hip_bfloat16;
using bf16x8=__attribute__((ext_vector_type(8)))short;
using s16x4=__attribute__((ext_vector_type(4)))short;
using f32x16=__attribute__((ext_vector_type(16)))float;
using u32x4=__attribute__((ext_vector_type(4)))unsigned;
constexpr int BATCH=4,NHEAD=8,SEQ=8192,D=64,DM=NHEAD*D;
constexpr int NW=8,QBLK=32,QB=QBLK*NW,KVBLK=64,NQB=SEQ/QB;
constexpr int ATTN_PITCH=DM, ATTN_UNIT_ROWS=QB;
__device__ __forceinline__ int crow(int r,int hi){return (r&3)+8*(r>>2)+4*hi;}
#define SBAR() __builtin_amdgcn_sched_barrier(0)
__device__ __forceinline__ void cmask(f32x16&p0,f32x16&p1,int jb,int qrel,int hi){
  const float NEG=-INFINITY; int kb=64*jb+4*hi;
  #pragma unroll
  for(int r=0;r<16;++r){int kv=kb+(r&3)+8*(r>>2); if(kv>qrel)p0[r]=NEG; if(kv+32>qrel)p1[r]=NEG;}
}

constexpr int NSLOT=3, SLOTB=8192;
constexpr int LDS_K=0, LDS_V=NSLOT*SLOTB, LDS_WS=2*NSLOT*SLOTB, LDS_OST=LDS_WS+NW*64*4, LDS_FK=LDS_OST+NW*4096, LDS_BYTES=LDS_FK+SEQ*4;
constexpr float C2=0.125f*1.4426950408889634f;
__device__ __forceinline__ void glds16(const void*gsrc,unsigned lds_dst){unsigned keep;
  asm volatile("s_mov_b32 %0, m0\n\ts_mov_b32 m0, %2\n\ts_nop 0\n\tglobal_load_lds_dwordx4 %1, off\n\ts_mov_b32 m0, %0":"=&s"(keep):"v"(gsrc),"s"(lds_dst):"memory");}
__device__ __forceinline__ float max3f(float a,float b,float c){float r;asm("v_max3_f32 %0, %1, %2, %3":"=v"(r):"v"(a),"v"(b),"v"(c));return r;}
__device__ __forceinline__ float max2f(float a,float b){float r;asm("v_max_f32_e32 %0, %1, %2":"=v"(r):"v"(a),"v"(b));return r;}
__device__ __forceinline__ float fadd_s(float a,float b){float r;asm("v_add_f32_e32 %0, %1, %2":"=v"(r):"v"(a),"v"(b));return r;}
__device__ __forceinline__ float fsub_s(float a,float b){float r;asm("v_sub_f32_e32 %0, %1, %2":"=v"(r):"v"(a),"v"(b));return r;}
typedef float f32x2_t __attribute__((ext_vector_type(2))); typedef __bf16 bf16x2_t __attribute__((ext_vector_type(2)));
__device__ __forceinline__ unsigned cvtpk_s(float lo,float hi){f32x2_t v={lo,hi};bf16x2_t b=__builtin_convertvector(v,bf16x2_t);return __builtin_bit_cast(unsigned,b);}
#define WAIT_BAR(N) asm volatile("s_waitcnt vmcnt(" #N ") lgkmcnt(0)\n\ts_barrier":::"memory")

__device__ __forceinline__ void qkt(f32x16&p0,f32x16&p1,const char*Kslot,const bf16x8*qr,int r32,int hi){
  const char*kb=Kslot+hi*1024+r32*16;
  #pragma unroll
  for(int d0=0;d0<4;++d0){
    const bf16x8 b0=*reinterpret_cast<const bf16x8*>(kb+d0*2048);
    const bf16x8 b1=*reinterpret_cast<const bf16x8*>(kb+d0*2048+512);
    p0=__builtin_amdgcn_mfma_f32_32x32x16_bf16(b0,qr[d0],p0,0,0,0);p1=__builtin_amdgcn_mfma_f32_32x32x16_bf16(b1,qr[d0],p1,0,0,0);}
}
typedef __attribute__((address_space(3))) const char* lds_cptr;
typedef short v4i16_t __attribute__((ext_vector_type(4)));
__device__ __forceinline__ void kload8(bf16x8*kf,lds_cptr kp){
  kf[0]=*(const __attribute__((address_space(3))) bf16x8*)(kp);      kf[1]=*(const __attribute__((address_space(3))) bf16x8*)(kp+512);
  kf[2]=*(const __attribute__((address_space(3))) bf16x8*)(kp+2048); kf[3]=*(const __attribute__((address_space(3))) bf16x8*)(kp+2560);
  kf[4]=*(const __attribute__((address_space(3))) bf16x8*)(kp+4096); kf[5]=*(const __attribute__((address_space(3))) bf16x8*)(kp+4608);
  kf[6]=*(const __attribute__((address_space(3))) bf16x8*)(kp+6144); kf[7]=*(const __attribute__((address_space(3))) bf16x8*)(kp+6656);
}
__device__ __forceinline__ void kload2(bf16x8*kf,lds_cptr kp,int j){ kf[2*j]=*(const __attribute__((address_space(3))) bf16x8*)(kp+j*2048); kf[2*j+1]=*(const __attribute__((address_space(3))) bf16x8*)(kp+j*2048+512); }
__device__ __forceinline__ s16x4 vtr(lds_cptr p){ return __builtin_bit_cast(s16x4,__builtin_amdgcn_ds_read_tr16_b64_v4i16((__attribute__((address_space(3))) v4i16_t*)p)); }
__device__ __forceinline__ float rowmax(const f32x16&p0,const f32x16&p1){
  float a=max3f(p0[0],p0[1],p1[0]),b=max3f(p0[2],p0[3],p1[1]);a=max3f(a,p1[2],p1[3]);
  #pragma unroll
  for(int r=4;r<16;r+=4){a=max3f(a,p0[r],p0[r+1]);b=max3f(b,p0[r+2],p0[r+3]);a=max3f(a,p1[r],p1[r+1]);b=max3f(b,p1[r+2],p1[r+3]);}
  const float m=max2f(a,b);
  auto rr=__builtin_amdgcn_permlane32_swap(__float_as_uint(m),__float_as_uint(m),false,false);
  return max2f(__uint_as_float(rr[0]),__uint_as_float(rr[1]));
}
__device__ __forceinline__ void pv(f32x16*o,int vb,bf16x8 pa0,bf16x8 pa1,bf16x8 pa2,bf16x8 pa3){
  #pragma unroll
  for(int d0=0;d0<2;++d0){s16x4 lo[4],hi[4];
    #pragma unroll
    for(int ks=0;ks<4;++ks){
      asm volatile("ds_read_b64_tr_b16 %0,%1 offset:%c2":"=&v"(lo[ks]):"v"(vb),"i"(d0*4096+ks*1024):"memory");
      asm volatile("ds_read_b64_tr_b16 %0,%1 offset:%c2":"=&v"(hi[ks]):"v"(vb),"i"(d0*4096+ks*1024+512):"memory");}
    asm volatile("s_waitcnt lgkmcnt(0)":::"memory");SBAR();
    #define PK(k) (bf16x8){lo[k][0],lo[k][1],lo[k][2],lo[k][3],hi[k][0],hi[k][1],hi[k][2],hi[k][3]}
    o[d0]=__builtin_amdgcn_mfma_f32_32x32x16_bf16(pa0,PK(0),o[d0],0,0,0);
    o[d0]=__builtin_amdgcn_mfma_f32_32x32x16_bf16(pa1,PK(1),o[d0],0,0,0);
    o[d0]=__builtin_amdgcn_mfma_f32_32x32x16_bf16(pa2,PK(2),o[d0],0,0,0);
    o[d0]=__builtin_amdgcn_mfma_f32_32x32x16_bf16(pa3,PK(3),o[d0],0,0,0);
    #undef PK
  }
}

#ifndef ATTN_STORE16
#define ATTN_STORE16(p,v) (*(u32x4*)(p)=(v))
#endif
template<int THRL> __device__ __forceinline__ void attn_unit(int b,int h,int qb,const bf16*Q,const bf16*__restrict__ K,const bf16*__restrict__ V,bf16*O,const float*__restrict__ Fc,const float*__restrict__ NRM,char*shm,int wid_in){
  const int wid=__builtin_amdgcn_readfirstlane(wid_in); int lane_=(int)__builtin_amdgcn_mbcnt_hi(~0u,__builtin_amdgcn_mbcnt_lo(~0u,0u)); asm volatile("":"+v"(lane_));
  const int lane=lane_,tid=wid*64+lane,r32=lane&31,hi=lane>>5;
  const long rowbase=(long)b*SEQ; const int q0=qb*QB;
  const float*Fbh=Fc+(long)(b*NHEAD+h)*SEQ;
  const int NTF=(q0+QB)/KVBLK; int t_start;
  { const float*QNb=NRM+(b*NHEAD+h)*128,*KNb=NRM+4096+(b*NHEAD+h)*128;
    const float qn=fmaxf(fmaxf(QNb[4*qb],QNb[4*qb+1]),fmaxf(QNb[4*qb+2],QNb[4*qb+3])),knb=fmaxf(fmaxf(KNb[4*qb],KNb[4*qb+1]),fmaxf(KNb[4*qb+2],KNb[4*qb+3]));
    const float fq0=Fbh[q0]*1.4426950408889634f; bool k0=true,k1=true;
    if(lane<NTF-4)k0=!(qn*(KNb[lane]+knb)+(fq0-Fbh[64*lane+63]*1.4426950408889634f)<-40.f);
    if(lane+64<NTF-4)k1=!(qn*(KNb[lane+64]+knb)+(fq0-Fbh[64*(lane+64)+63]*1.4426950408889634f)<-40.f);
    const unsigned long long m0=__ballot(k0),m1=__ballot(k1);
    int tf=m0?(int)__builtin_ctzll(m0):64+(m1?(int)__builtin_ctzll(m1):64);
    tf=tf<NTF-4?tf:NTF-4; t_start=__builtin_amdgcn_readfirstlane(tf&~1); }
  { typedef float f32x4_t __attribute__((ext_vector_type(4))); __attribute__((address_space(3))) float*fk=(__attribute__((address_space(3))) float*)((__attribute__((address_space(3))) char*)shm+LDS_FK); const int n4=(q0+QB)/4;
    for(int i=16*t_start+tid;i<n4;i+=NW*64){ f32x4_t v=*(const f32x4_t*)(Fbh+4*i); v=v*(-1.4426950408889634f); *(__attribute__((address_space(3))) f32x4_t*)(fk+4*i)=v; } }
  float fq2=Fbh[q0+wid*QBLK+r32]*1.4426950408889634f; asm volatile("":"+v"(fq2));
  const bf16*Qw=Q+(rowbase+q0+wid*QBLK)*DM+h*D;
  const bf16*Kh=K+(rowbase+(long)t_start*KVBLK)*DM+h*D,*Vh=V+(rowbase+(long)t_start*KVBLK)*DM+h*D;
  const lds_cptr shm3=(lds_cptr)shm;
  const unsigned lds0=(unsigned)(uintptr_t)shm;
  float*wsf=(float*)(shm+LDS_WS)+wid*64;
  const bf16*ksrc=Kh+(long)lane*DM+wid*8;
  const bf16*vsrc=Vh+(long)(16*(wid&3)+(lane>>2))*DM+(wid>>2)*32+(lane&3)*8;
  const unsigned kdst=lds0+LDS_K+wid*1024, vdst=lds0+LDS_V+wid*1024;
  #define DMA_K(t,slot) glds16(ksrc+(long)(t)*KVBLK*DM,(unsigned)__builtin_amdgcn_readfirstlane(kdst+(slot)))
  #define DMA_V(t,slot) glds16(vsrc+(long)(t)*KVBLK*DM,(unsigned)__builtin_amdgcn_readfirstlane(vdst+(slot)))
  const int vb0=(int)(lds0+LDS_V)+((lane>>4)&1)*32+(lane&3)*8+(4*hi+((lane&15)>>2))*64;
  const char*Kbase=shm+LDS_K; bf16x8 kf[8];
  const lds_cptr kp0=shm3+LDS_K+hi*1024+r32*16; const lds_cptr vp0=shm3+LDS_V+((lane>>4)&1)*32+(lane&3)*8+(4*hi+((lane&15)>>2))*64;
  const int NT=NTF-t_start;
  DMA_K(0,0);DMA_V(0,0);DMA_K(1,SLOTB);
  bf16x8 qr[4];
  #pragma unroll
  for(int d0=0;d0<4;++d0)qr[d0]=*reinterpret_cast<const bf16x8*>(&Qw[(long)r32*DM+d0*16+hi*8]);
  float mhat=0.f,l_reg=0.f;f32x16 o[2];o[0]=f32x16{};o[1]=f32x16{};
  const __attribute__((address_space(3))) float*fkl=(const __attribute__((address_space(3))) float*)(shm3+LDS_FK)+64*t_start+4*hi;
  #define INITC(C0,C1,t) do{ const float nsc_=fq2-mhat; typedef float f32x4_t __attribute__((ext_vector_type(4))); const __attribute__((address_space(3))) float*kb_=fkl+64*(t); \
    _Pragma("unroll") for(int g_=0;g_<4;++g_){ const f32x4_t a_=*(const __attribute__((address_space(3))) f32x4_t*)(kb_+8*g_), b_=*(const __attribute__((address_space(3))) f32x4_t*)(kb_+32+8*g_); \
      _Pragma("unroll") for(int e_=0;e_<4;++e_){ C0[4*g_+e_]=nsc_+a_[e_]; C1[4*g_+e_]=nsc_+b_[e_]; } } }while(0)
  const int qrel=wid*QBLK+r32;
  #define CMASK(P0,P1,t) do{int jb_=(t)-(NT-4); if(jb_>=0)cmask(P0,P1,jb_,qrel,hi);}while(0)
  bool resc=false;
  #define START(P0,P1) do{ const float rm=rowmax(P0,P1); resc=false; \
    { const float dl=rm; mhat=fadd_s(mhat,dl); \
      _Pragma("unroll") for(int r=0;r<16;++r){P0[r]=fsub_s(P0[r],dl);P1[r]=fsub_s(P1[r],dl);} \
      } \
    _Pragma("unroll") for(int r=0;r<16;++r)P0[r]=__builtin_amdgcn_exp2f(P0[r]); }while(0)
  #define RESC() do{ if(resc){ asm volatile("s_waitcnt lgkmcnt(0)":::"memory"); \
      _Pragma("unroll") for(int d_=0;d_<2;++d_) _Pragma("unroll") for(int r=0;r<16;++r)o[d_][r]*=wsf[crow(r,hi)]; } }while(0)
  f32x16 pA0,pA1,pB0,pB1;
  int sl_prev=0,sl_cur=0,sl_next=SLOTB;
  #define ROT() do{sl_prev=sl_cur;sl_cur=sl_next;sl_next=(sl_next==(NSLOT-1)*SLOTB)?0:sl_next+SLOTB;}while(0)
  DMA_K(2,2*SLOTB);
  WAIT_BAR(3);
  INITC(pA0,pA1,0); qkt(pA0,pA1,Kbase,qr,r32,hi);asm volatile("s_nop 15\n\ts_nop 7":"+v"(pA0),"+v"(pA1));CMASK(pA0,pA1,0);
  START(pA0,pA1);
  _Pragma("unroll") for(int r=0;r<16;++r)pA1[r]=__builtin_amdgcn_exp2f(pA1[r]);
  WAIT_BAR(0);
  DMA_K(3,0);DMA_V(1,SLOTB);
  ROT();
  kload8(kf,kp0+sl_cur);
  WAIT_BAR(2);
  s16x4 vlo[8],vhi[8]; u32x4 pw0,pw1,pw2,pw3;
  #define PKW(P,B) cvtpk_s(P[B],P[B+1])
  #define PAF(k) __builtin_bit_cast(bf16x8,pw##k)
  #define VFR(i) (bf16x8){vlo[i][0],vlo[i][1],vlo[i][2],vlo[i][3],vhi[i][0],vhi[i][1],vhi[i][2],vhi[i][3]}
  #define PIN(x) asm volatile("":"+v"(x))
  #define MX3(a,b,c) __builtin_fmaxf(__builtin_fmaxf((a),(b)),(c))
  #define GAPA(MF,A0,A1,A2,A3,W0,W1,PW) do{ MF; sacc+=A0; sacc+=A1; sacc+=A2; sacc+=A3; PIN(sacc); W0; W1; PIN(PW); SBAR(); }while(0)
  #define EX(v) __builtin_amdgcn_exp2f(v)
  #define GAPB(MF,X,B) do{ MF; X[B]=EX(X[B]); X[B+1]=EX(X[B+1]); X[B+2]=EX(X[B+2]); X[B+3]=EX(X[B+3]); PIN(X); SBAR(); }while(0)
  #define VRD(i) do{ vlo[i]=vtr(vp_+(((i)>>2)*4096+((i)&3)*1024)); vhi[i]=vtr(vp_+(((i)>>2)*4096+((i)&3)*1024+512)); }while(0)
  #define KRD(G,j) do{ if(G){ kload2(kf,kp0+sl_next,j); SBAR(); } }while(0)
  #define STEP(C0,C1,P0,P1,t,GK,GV,GL) do{ SBAR(); INITC(C0,C1,t); PIN(C0); PIN(C1); SBAR(); \
    const lds_cptr vp_=vp0+sl_prev; \
    VRD(0); SBAR(); float sacc=(P0[0]+P0[1]); \
    GAPA(C0=__builtin_amdgcn_mfma_f32_32x32x16_bf16(kf[0],qr[0],C0,0,0,0), P0[2],P0[3],P0[4],P0[5],     pw0[0]=PKW(P0,0), pw0[1]=PKW(P0,2), pw0); \
    VRD(4); SBAR(); GAPA(C1=__builtin_amdgcn_mfma_f32_32x32x16_bf16(kf[1],qr[0],C1,0,0,0), P0[6],P0[7],P0[8],P0[9],     pw0[2]=PKW(P0,4), pw0[3]=PKW(P0,6), pw0); \
    VRD(1); SBAR(); GAPA(C0=__builtin_amdgcn_mfma_f32_32x32x16_bf16(kf[2],qr[1],C0,0,0,0),   P0[10],P0[11],P0[12],P0[13], pw1[0]=PKW(P0,8), pw1[1]=PKW(P0,10), pw1); \
    VRD(5); SBAR(); GAPA(C1=__builtin_amdgcn_mfma_f32_32x32x16_bf16(kf[3],qr[1],C1,0,0,0),   P0[14],P0[15],P1[0],P1[1],   pw1[2]=PKW(P0,12),pw1[3]=PKW(P0,14), pw1); \
    VRD(2); SBAR(); GAPA(C0=__builtin_amdgcn_mfma_f32_32x32x16_bf16(kf[4],qr[2],C0,0,0,0),   P1[2],P1[3],P1[4],P1[5],     pw2[0]=PKW(P1,0), pw2[1]=PKW(P1,2), pw2); \
    VRD(6); SBAR(); GAPA(C1=__builtin_amdgcn_mfma_f32_32x32x16_bf16(kf[5],qr[2],C1,0,0,0),   P1[6],P1[7],P1[8],P1[9],     pw2[2]=PKW(P1,4), pw2[3]=PKW(P1,6), pw2); \
    VRD(3); SBAR(); GAPA(C0=__builtin_amdgcn_mfma_f32_32x32x16_bf16(kf[6],qr[3],C0,0,0,0),   P1[10],P1[11],P1[12],P1[13], pw3[0]=PKW(P1,8), pw3[1]=PKW(P1,10), pw3); \
    VRD(7); SBAR(); GAPA(C1=__builtin_amdgcn_mfma_f32_32x32x16_bf16(kf[7],qr[3],C1,0,0,0),   P1[14],P1[15],0.f,0.f,       pw3[2]=PKW(P1,12),pw3[3]=PKW(P1,14), pw3); \
    l_reg+=sacc; \
    if(GK){DMA_K((t)+3,sl_cur);} if(GV){DMA_V((t)+1,sl_next);} \
    CMASK(C0,C1,t); \
    { float a=MX3(C0[0],C0[1],C1[0]),b=MX3(C0[2],C0[3],C1[1]); a=MX3(a,C1[2],C1[3]); \
      _Pragma("unroll") for(int r=4;r<16;r+=4){a=MX3(a,C0[r],C0[r+1]);b=MX3(b,C0[r+2],C0[r+3]);a=MX3(a,C1[r],C1[r+1]);b=MX3(b,C1[r+2],C1[r+3]);} \
      float rm=__builtin_fmaxf(a,b); { auto rr=__builtin_amdgcn_permlane32_swap(__float_as_uint(rm),__float_as_uint(rm),false,false); rm=__builtin_fmaxf(__uint_as_float(rr[0]),__uint_as_float(rr[1])); } \
      resc=false; \
      if(__builtin_expect(__any(rm>(float)THRL),0)){ const float dl=__builtin_fmaxf(rm,0.f); mhat+=dl; \
        _Pragma("unroll") for(int r=0;r<16;++r){C0[r]-=dl;C1[r]-=dl;} \
        const float f=__builtin_amdgcn_exp2f(-dl); l_reg*=f; if(hi==0)wsf[r32]=f; resc=true; } } \
    SBAR(); \
    GAPB(o[0]=__builtin_amdgcn_mfma_f32_32x32x16_bf16(PAF(0),VFR(0),o[0],0,0,0), C0,0); \
    GAPB(o[1]=__builtin_amdgcn_mfma_f32_32x32x16_bf16(PAF(0),VFR(4),o[1],0,0,0), C0,4); \
    KRD(GL,0); GAPB(o[0]=__builtin_amdgcn_mfma_f32_32x32x16_bf16(PAF(1),VFR(1),o[0],0,0,0), C0,8); \
    KRD(GL,1); GAPB(o[1]=__builtin_amdgcn_mfma_f32_32x32x16_bf16(PAF(1),VFR(5),o[1],0,0,0), C0,12); \
    KRD(GL,2); GAPB(o[0]=__builtin_amdgcn_mfma_f32_32x32x16_bf16(PAF(2),VFR(2),o[0],0,0,0), C1,0); \
    KRD(GL,3); GAPB(o[1]=__builtin_amdgcn_mfma_f32_32x32x16_bf16(PAF(2),VFR(6),o[1],0,0,0), C1,4); \
    GAPB(o[0]=__builtin_amdgcn_mfma_f32_32x32x16_bf16(PAF(3),VFR(3),o[0],0,0,0), C1,8); \
    GAPB(o[1]=__builtin_amdgcn_mfma_f32_32x32x16_bf16(PAF(3),VFR(7),o[1],0,0,0), C1,12); \
    }while(0)
  int t=1;
  #undef CMASK
  #define CMASK(P0,P1,t) do{}while(0)
  for(;t+5<NT;t+=2){
    STEP(pB0,pB1,pA0,pA1,t,true,true,true);     WAIT_BAR(2); RESC(); ROT();
    STEP(pA0,pA1,pB0,pB1,t+1,true,true,true);   WAIT_BAR(2); RESC(); ROT();
  }
  #undef CMASK
  #define CMASK(P0,P1,t) do{int jb_=(t)-(NT-4); if(jb_>=0)cmask(P0,P1,jb_,qrel,hi);}while(0)
  #define ENDW(tt) do{ if((tt)+3<NT){WAIT_BAR(2);} else if((tt)+2<NT){WAIT_BAR(1);} else {WAIT_BAR(0);} }while(0)
  for(;t+1<NT;t+=2){
    STEP(pB0,pB1,pA0,pA1,t,(t+3<NT),(t+1<NT),(t+1<NT));       ENDW(t);   RESC(); ROT();
    STEP(pA0,pA1,pB0,pB1,t+1,(t+4<NT),(t+2<NT),(t+2<NT));     ENDW(t+1); RESC(); ROT();
  }
  STEP(pB0,pB1,pA0,pA1,NT-1,false,false,false); RESC();
  { float sacc=pB0[0]+pB0[1]; _Pragma("unroll") for(int r=2;r<16;++r)sacc+=pB0[r]; _Pragma("unroll") for(int r=0;r<16;++r)sacc+=pB1[r]; l_reg+=sacc;
    pw0=(u32x4){PKW(pB0,0),PKW(pB0,2),PKW(pB0,4),PKW(pB0,6)};pw1=(u32x4){PKW(pB0,8),PKW(pB0,10),PKW(pB0,12),PKW(pB0,14)};pw2=(u32x4){PKW(pB1,0),PKW(pB1,2),PKW(pB1,4),PKW(pB1,6)};pw3=(u32x4){PKW(pB1,8),PKW(pB1,10),PKW(pB1,12),PKW(pB1,14)};
    SBAR(); pv(o,vb0+sl_cur,PAF(0),PAF(1),PAF(2),PAF(3)); }
  #undef PKW
  #undef PAF
  #undef VFR
  #undef PIN
  #undef MX3
  #undef GAPA
  #undef GAPB
  #undef EX
  #undef VRD
  #undef KRD
  #undef STEP
  #undef ENDW
  {auto rr=__builtin_amdgcn_permlane32_swap(__float_as_uint(l_reg),__float_as_uint(l_reg),false,false);l_reg=__uint_as_float(rr[0])+__uint_as_float(rr[1]);}
  if(hi==0)wsf[32+r32]=l_reg;asm volatile("s_waitcnt lgkmcnt(0)":::"memory");
  float rli[16];
  #pragma unroll
  for(int r=0;r<16;++r)rli[r]=__builtin_amdgcn_rcpf(wsf[32+crow(r,hi)]);
  bf16*Ow=O+(rowbase+q0+wid*QBLK)*DM+h*D;
  { bf16*stg=(bf16*)(shm+LDS_OST)+wid*2048;
    #pragma unroll
    for(int r=0;r<16;++r){const int orow=crow(r,hi);
      #pragma unroll
      for(int d0=0;d0<2;++d0)stg[orow*64+d0*32+r32]=__float2bfloat16(o[d0][r]*rli[r]);}
    asm volatile("s_waitcnt lgkmcnt(0)":::"memory");
    #pragma unroll
    for(int i=0;i<4;++i){const int row=i*8+(lane>>3),ch=lane&7; const u32x4 v=*(const u32x4*)(stg+row*64+ch*8); ATTN_STORE16(Ow+(long)row*DM+ch*8,v);} }
  asm volatile("s_waitcnt lgkmcnt(0)\n\ts_barrier":::"memory");
  #undef DMA_K
  #undef DMA_V
  #undef INITC
  #undef CMASK
  #undef START
  #undef RESC
  #undef ROT
}
constexpr int ATTN_LDS_BYTES=LDS_BYTES;
struct AttnTensors { const bf16* Q; const bf16* K; const bf16* V; bf16* O; const float* F; const float* NRM; };
struct AttnUnit { int bh; int qb; };
struct StaticOrder {
  int vcu;
  __device__ __forceinline__ explicit StaticOrder(int grid,int block):vcu((block%8)*(grid/8)+block/8){}
  __device__ __forceinline__ bool next(int i,AttnUnit&u)const{ if(i>=4)return false; const int s=vcu&7; u.bh=vcu>>3; u.qb=(i==0)?s:(i==1)?15-s:(i==2)?16+s:31-s; return true; }
  __device__ __forceinline__ void a_ready(const AttnUnit&)const{}
  __device__ __forceinline__ void done(const AttnUnit&)const{}
};
template<int THRL=8> __device__ __forceinline__ void attn_phase(char*lds,const AttnTensors&T,unsigned*qctr,volatile __attribute__((address_space(3))) unsigned*qword,int wid_in){
  const int lane0=(int)__builtin_amdgcn_mbcnt_hi(~0u,__builtin_amdgcn_mbcnt_lo(~0u,0u));
  for(;;){
    if(wid_in==0&&lane0==0){ const unsigned n=__hip_atomic_fetch_add(qctr,1u,__ATOMIC_RELAXED,__HIP_MEMORY_SCOPE_AGENT); *qword=n; }
    asm volatile("s_waitcnt vmcnt(0) lgkmcnt(0)\n\ts_barrier":::"memory");
    const int n=__builtin_amdgcn_readfirstlane((int)*qword);
    if(n>=BATCH*NHEAD*NQB)break;
    const int bh=n%(BATCH*NHEAD),qb=NQB-1-n/(BATCH*NHEAD);
    attn_unit<THRL>(bh/NHEAD,bh%NHEAD,qb,T.Q,T.K,T.V,T.O,T.F,T.NRM,lds,wid_in);
  }
}
#undef SBAR
#undef WAIT_BAR
}
#define GAS __attribute__((address_space(1)))
#define LAS __attribute__((address_space(3)))
typedef unsigned short bf16;
typedef unsigned v4u __attribute__((ext_vector_type(4)));
typedef float f32x4 __attribute__((ext_vector_type(4)));
typedef short bf16x8 __attribute__((ext_vector_type(8)));
typedef GAS unsigned gu32;
typedef GAS unsigned long long gu64;
#define RLX_AGENT __ATOMIC_RELAXED, __HIP_MEMORY_SCOPE_AGENT
#define LDS_WAIT() asm volatile("s_waitcnt lgkmcnt(0)" ::: "memory")
#define VM_WAIT() asm volatile("s_waitcnt vmcnt(0)" ::: "memory")
__device__ __forceinline__ unsigned long long rt() { return __builtin_amdgcn_s_memrealtime(); }
__device__ __forceinline__ unsigned f2bf(float f) { unsigned u = __builtin_bit_cast(unsigned, f); return (u + 0x7fffu + ((u >> 16) & 1u)) >> 16; }
__device__ __forceinline__ unsigned pk2(float lo, float hi) { return f2bf(lo) | (f2bf(hi) << 16); }

#define XB_TMO      128
#define XB_XCNT(j)  (256  + 64 * (j))
#define XB_XSUB(j)  (1280 + 64 * (j))
#define XB_XGEN(j)  (2304 + 64 * (j))
#define XB_TOP      3328
#define XB_TOPGEN   3392
#define XCD_BAR_WORDS 3456
#define XB_SPIN_CAP (1u << 18)

__device__ __forceinline__ unsigned xb_ld(unsigned* p)              { return __hip_atomic_load(p, __ATOMIC_RELAXED, __HIP_MEMORY_SCOPE_AGENT); }
__device__ __forceinline__ unsigned xb_add(unsigned* p, unsigned v) { return __hip_atomic_fetch_add(p, v, __ATOMIC_RELAXED, __HIP_MEMORY_SCOPE_AGENT); }
__device__ __forceinline__ unsigned xb_xcc_id() { return (unsigned)__builtin_amdgcn_s_getreg((3 << 11) | 20) & 0xFu; }
#define XB_SPIN(cond, bar) do { unsigned _sp = 0; while (cond) { __builtin_amdgcn_s_sleep(1); \
    if ((++_sp & 255u) == 0u) { if (xb_ld(&(bar)[XB_TMO])) break; if (_sp > XB_SPIN_CAP) { atomicAdd(&(bar)[XB_TMO], 1u); break; } } } } while (0)

struct XcdBarrier {
    unsigned* bar; unsigned x; int wv;
    volatile LAS unsigned* st;
};

__device__ __forceinline__ bool xb_t0(int wv) { return wv == 0 && __builtin_amdgcn_mbcnt_hi(~0u, __builtin_amdgcn_mbcnt_lo(~0u, 0u)) == 0u; }
__device__ __forceinline__ XcdBarrier xcd_barrier_post(unsigned* bar, volatile LAS unsigned* st, int wv) {
    XcdBarrier b; b.bar = bar; b.x = xb_xcc_id(); b.st = st; b.wv = wv;
    if (xb_t0(wv)) (void)xb_add(&bar[XB_XCNT(b.x)], 1u);
    return b;
}
__device__ __forceinline__ void xcd_barrier_complete(unsigned* bar, unsigned x, unsigned& nloc, unsigned& nx) {
    const unsigned G = gridDim.x * gridDim.y * gridDim.z;
    unsigned sum, cnt, mine, sp = 0u;
    for (;;) {
        sum = 0u; cnt = 0u; mine = 0u;
#pragma unroll
        for (unsigned j = 0; j < 16; ++j) { const unsigned c = xb_ld(&bar[XB_XCNT(j)]); sum += c; cnt += (c > 0u) ? 1u : 0u; mine = (j == x) ? c : mine; }
        if (sum == G) break;
        __builtin_amdgcn_s_sleep(1);
        if ((++sp & 255u) == 0u) { if (xb_ld(&bar[XB_TMO])) break; if (sp > XB_SPIN_CAP) { atomicAdd(&bar[XB_TMO], 1u); break; } }
    }
    nloc = mine > 0u ? mine : 1u; nx = cnt > 0u ? cnt : 1u;
}

__device__ __forceinline__ void xcd_barrier(const XcdBarrier& b) {
    asm volatile("s_waitcnt vmcnt(0)" ::: "memory");
    __syncthreads();
    if (xb_t0(b.wv)) {
        unsigned* bar = b.bar;
        __builtin_amdgcn_s_waitcnt(0);
        unsigned nloc = b.st[0], nx = b.st[1];
        if (nloc == 0u) { xcd_barrier_complete(bar, b.x, nloc, nx); b.st[0] = nloc; b.st[1] = nx; }
        const unsigned old = xb_add(&bar[XB_XSUB(b.x)], 1u);
        const unsigned gen = old / nloc;
        if (old + 1u == (gen + 1u) * nloc) {
            __builtin_amdgcn_fence(__ATOMIC_RELEASE, "agent");
            asm volatile("s_waitcnt vmcnt(0)" ::: "memory");
            const unsigned og = xb_add(&bar[XB_TOP], 1u);
            const unsigned tg = og / nx;
            if (og + 1u == (tg + 1u) * nx) xb_add(&bar[XB_TOPGEN], 1u);
            else XB_SPIN(xb_ld(&bar[XB_TOPGEN]) == tg, bar);
            __builtin_amdgcn_fence(__ATOMIC_ACQUIRE, "agent");
            xb_add(&bar[XB_XGEN(b.x)], 1u);
            asm volatile("s_waitcnt vmcnt(0)" ::: "memory");
        } else {
            XB_SPIN(xb_ld(&bar[XB_XGEN(b.x)]) == gen, bar);
            __builtin_amdgcn_fence(__ATOMIC_ACQUIRE, "agent");
            asm volatile("s_waitcnt vmcnt(0)" ::: "memory");
        }
    }
    __syncthreads();
}

constexpr int NWAVES = 8;
constexpr int RING_OFF = 0, RING_BYTES = 131072;
constexpr int LDSCTL_OFF = RING_BYTES, MISC_OFF = LDSCTL_OFF + 320;
constexpr int LDS_BYTES = 147456;
constexpr int N_PHASES = 8;

struct Frame {
    LAS unsigned char* lds;
    volatile LAS unsigned* MISC;
    gu32* ctl;
    int tid, lane, wave, vcu, G;
};
__device__ __forceinline__ float wave_sum(float v) {
#pragma unroll
    for (int o = 1; o < 64; o <<= 1) v += __shfl_xor(v, o);
    return v;
}
struct Args { const float* in[20]; float* out; unsigned char* ws; int ph_lo, ph_hi, li, pad; };

__device__ __forceinline__ void p0_transpose_item(const float* W, int ld, int nblk, const float* glo, const float* ghi, int K, bf16* WT, LAS float* scr, int item, int lane) {
    const int kb = item / nblk, nb = item % nblk, k0 = 64 * kb, n0 = 32 * nb;
#pragma unroll 8
    for (int i = 0; i < 32; ++i) { const int kk = 2 * i + (lane >> 5), k = k0 + kk; float w = W[(size_t)k * ld + n0 + (lane & 31)];
        if (glo) w *= (k < K / 2) ? glo[k] : ghi[k - K / 2];
        scr[kk * 33 + (lane & 31)] = w; }
    LDS_WAIT(); asm volatile("" ::: "memory");
    const int c = lane & 7;
#pragma unroll
    for (int j = 0; j < 4; ++j) { const int n = (lane >> 3) + 8 * j; const LAS float* s = scr + (8 * c) * 33 + n;
        v4u o; o.x = pk2(s[0 * 33], s[1 * 33]); o.y = pk2(s[2 * 33], s[3 * 33]); o.z = pk2(s[4 * 33], s[5 * 33]); o.w = pk2(s[6 * 33], s[7 * 33]);
        *(GAS v4u*)(WT + (size_t)(n0 + n) * K + k0 + 8 * c) = o; }
    LDS_WAIT(); asm volatile("" ::: "memory");
}
__device__ __forceinline__ float log_sigmoid(float z) { return fminf(z, 0.f) - log1pf(expf(-fabsf(z))); }

__device__ __forceinline__ void p0_prologue(Frame& F, const Args& a) {
    LAS float* scr = (LAS float*)(F.lds + RING_OFF + F.wave * 16384);
    unsigned char* ws = a.ws;
    const float* x = a.in[0]; const float* g1 = a.in[1]; const float* w_in = a.in[2]; const float* bfv = a.in[10];
    const float* gn_l = a.in[11]; const float* gn_f = a.in[12]; const float* w_out = a.in[13]; const float* g2 = a.in[14];
    const float* w_q = a.in[15]; const float* sk = a.in[16]; const float* pu = a.in[17]; const float* pv = a.in[18];
    bf16* win_t = (bf16*)(ws + WS_WIN); bf16* wout_t = (bf16*)(ws + WS_WOUT); bf16* wq_t = (bf16*)(ws + WS_WQ); bf16* skb = (bf16*)(ws + WS_SKB);
    float* logf = (float*)(ws + WS_LOGF); float* sumsq = (float*)(ws + WS_SUMSQ); bf16* h = (bf16*)(ws + WS_H);
    const int gw = F.vcu * NWAVES + F.wave, NGW = F.G * NWAVES, lane = F.lane;
    constexpr int I_IN = (DMODEL / 64) * (NG1 / 32), I_OUT = (DMODEL / 64) * (DMODEL / 32), I_Q = (DMODEL / 64) * (QPW / 32);
    constexpr int I_FL = 8 * DMODEL / 64, I_SK = PH * 2 * NKEY * PHALF / 512, I_SS = T / 64, I_WAX = 8 * 2 * 2 * 4;
    constexpr int E0 = I_IN, E1 = E0 + I_OUT, E2 = E1 + I_Q, E3 = E2 + I_FL, E4 = E3 + I_SK, E5 = E4 + I_SS, E6 = E5 + I_WAX;
    for (int it = gw; it < E6; it += NGW) {
        if (it < E0) { p0_transpose_item(w_in, INC, NG1 / 32, nullptr, nullptr, DMODEL, win_t, scr, it, lane); continue; }
        if (it < E1) { p0_transpose_item(w_out, DMODEL, DMODEL / 32, gn_l, gn_f, DMODEL, wout_t, scr, it - E0, lane); continue; }
        if (it < E2) { p0_transpose_item(w_q, QPW, QPW / 32, g2, g2 + DMODEL / 2, DMODEL, wq_t, scr, it - E1, lane); continue; }
        if (it < E3) continue;
        if (it < E4) { const size_t i = (size_t)(it - E3) * 512 + lane * 8; const f32x4 s0 = *(const GAS f32x4*)(sk + i), s1 = *(const GAS f32x4*)(sk + i + 4);
            v4u o; o.x = pk2(s0[0], s0[1]); o.y = pk2(s0[2], s0[3]); o.z = pk2(s1[0], s1[1]); o.w = pk2(s1[2], s1[3]); *(GAS v4u*)(skb + i) = o; continue; }
        if (it < E5) { sumsq[(it - E4) * 64 + lane] = 0.f; continue; }
        { const int f = it - E5, ks = f & 3, n = (f >> 2) & 1, mat = (f >> 3) & 1, hh = f >> 4; const float* wsrc = mat ? a.in[7] : a.in[5];
          const size_t o = ((size_t)(hh * 64 + 16 * ks + 8 * (lane >> 5))) * 64 + 32 * n + (lane & 31);
          v4u pw; pw.x = pk2(wsrc[o], wsrc[o + 64]); pw.y = pk2(wsrc[o + 128], wsrc[o + 192]); pw.z = pk2(wsrc[o + 256], wsrc[o + 320]); pw.w = pk2(wsrc[o + 384], wsrc[o + 448]);
          *(GAS v4u*)((bf16*)(ws + WS_WAX) + (size_t)f * 512 + lane * 8) = pw; }
    }
    { f32x4 gg[4];
#pragma unroll
      for (int j = 0; j < 4; ++j) gg[j] = *(const GAS f32x4*)(g2 + 16 * lane + 4 * j);
      unsigned char* u4 = ws + WS_U8; unsigned char* v4 = ws + WS_V8; float* su = (float*)(ws + WS_SU);
      for (int e = gw; e < NEXP; e += NGW) {
        const GAS f32x4* ur = (const GAS f32x4*)(pu + (size_t)e * DMODEL + 16 * lane); const GAS f32x4* vr = (const GAS f32x4*)(pv + (size_t)e * DMODEL + 16 * lane);
        f32x4 uu[4], vv[4]; float mu = 0.f, mv = 0.f;
#pragma unroll
        for (int j = 0; j < 4; ++j) { uu[j] = ur[j] * gg[j]; vv[j] = vr[j];
#pragma unroll
            for (int c = 0; c < 4; ++c) { mu = fmaxf(mu, fabsf(uu[j][c])); mv = fmaxf(mv, fabsf(vv[j][c])); } }
#pragma unroll
        for (int o = 1; o < 64; o <<= 1) { mu = fmaxf(mu, __shfl_xor(mu, o)); mv = fmaxf(mv, __shfl_xor(mv, o)); }
        const float scu = mu > 0.f ? mu * (1.f / 6.f) : 1.f, scv = mv > 0.f ? mv * (1.f / 6.f) : 1.f, iu = 1.f / scu, iv = 1.f / scv;
        unsigned qu0 = 0u, qu1 = 0u, qv0 = 0u, qv1 = 0u;
#define P0_Q4(Q, X, INV, B0, B1) do { Q = __builtin_amdgcn_cvt_scalef32_pk_fp4_f32(Q, X[0] * INV, X[1] * INV, 1.0f, B0); Q = __builtin_amdgcn_cvt_scalef32_pk_fp4_f32(Q, X[2] * INV, X[3] * INV, 1.0f, B1); } while (0)
        P0_Q4(qu0, uu[0], iu, 0, 1); P0_Q4(qu0, uu[1], iu, 2, 3); P0_Q4(qu1, uu[2], iu, 0, 1); P0_Q4(qu1, uu[3], iu, 2, 3);
        P0_Q4(qv0, vv[0], iv, 0, 1); P0_Q4(qv0, vv[1], iv, 2, 3); P0_Q4(qv1, vv[2], iv, 0, 1); P0_Q4(qv1, vv[3], iv, 2, 3);
#undef P0_Q4
        *(GAS unsigned long long*)(u4 + (size_t)e * 512 + 8 * lane) = (unsigned long long)qu0 | ((unsigned long long)qu1 << 32);
        *(GAS unsigned long long*)(v4 + (size_t)e * 512 + 8 * lane) = (unsigned long long)qv0 | ((unsigned long long)qv1 << 32);
        if (lane == 0) { su[2 * e] = scu; su[2 * e + 1] = scv; }
      } }
    { f32x4 gg[4];
#pragma unroll
      for (int j = 0; j < 4; ++j) gg[j] = *(const GAS f32x4*)(g1 + 256 * j + 4 * lane);
      float fw[4][4][8];
#pragma unroll
      for (int j = 0; j < 4; ++j)
#pragma unroll
          for (int c = 0; c < 4; ++c) { const int k = 256 * j + 4 * lane + c; const GAS f32x4* wr = (const GAS f32x4*)(w_in + (size_t)k * INC + NG1); const f32x4 w0 = wr[0], w1 = wr[1];
#pragma unroll
              for (int e = 0; e < 4; ++e) { fw[j][c][e] = w0[e]; fw[j][c][4 + e] = w1[e]; } }
      for (int t0 = gw; t0 < T; t0 += 2 * NGW) {
        const int t1 = (t0 + NGW < T) ? t0 + NGW : t0;
        const GAS f32x4* xr0 = (const GAS f32x4*)(x + (size_t)t0 * DMODEL) + lane; const GAS f32x4* xr1 = (const GAS f32x4*)(x + (size_t)t1 * DMODEL) + lane;
        f32x4 va[4], vb[4]; float sa = 0.f, sb = 0.f;
#pragma unroll
        for (int j = 0; j < 4; ++j) { va[j] = xr0[64 * j]; vb[j] = xr1[64 * j]; }
#pragma unroll
        for (int j = 0; j < 4; ++j) { sa += (va[j][0] * va[j][0] + va[j][1] * va[j][1]) + (va[j][2] * va[j][2] + va[j][3] * va[j][3]); sb += (vb[j][0] * vb[j][0] + vb[j][1] * vb[j][1]) + (vb[j][2] * vb[j][2] + vb[j][3] * vb[j][3]); }
        const float ra = rsqrtf(wave_sum(sa) * (1.f / DMODEL) + RMS_EPS), rb = rsqrtf(wave_sum(sb) * (1.f / DMODEL) + RMS_EPS);
        GAS unsigned long long* ha = (GAS unsigned long long*)(h + (size_t)t0 * DMODEL) + lane; GAS unsigned long long* hb = (GAS unsigned long long*)(h + (size_t)t1 * DMODEL) + lane;
#pragma unroll
        for (int j = 0; j < 4; ++j) { va[j] = va[j] * ra * gg[j]; vb[j] = vb[j] * rb * gg[j];
            ha[64 * j] = (unsigned long long)pk2(va[j][0], va[j][1]) | ((unsigned long long)pk2(va[j][2], va[j][3]) << 32);
            hb[64 * j] = (unsigned long long)pk2(vb[j][0], vb[j][1]) | ((unsigned long long)pk2(vb[j][2], vb[j][3]) << 32); }
        float fa[8], fb[8];
#pragma unroll
        for (int hh = 0; hh < 8; ++hh) { fa[hh] = 0.f; fb[hh] = 0.f; }
#pragma unroll
        for (int j = 0; j < 4; ++j)
#pragma unroll
            for (int c = 0; c < 4; ++c) {
#pragma unroll
                for (int hh = 0; hh < 8; ++hh) { fa[hh] += va[j][c] * fw[j][c][hh]; fb[hh] += vb[j][c] * fw[j][c][hh]; } }
        float resa = 0.f, resb = 0.f;
#pragma unroll
        for (int hh = 0; hh < 8; ++hh) { const float s0 = wave_sum(fa[hh]), s1 = wave_sum(fb[hh]); if (lane == hh) { resa = s0; resb = s1; } }
        if (lane < 8) { logf[(size_t)t0 * 8 + lane] = log_sigmoid(resa + bfv[lane]); logf[(size_t)t1 * 8 + lane] = log_sigmoid(resb + bfv[lane]); }
      } }
}

__device__ __forceinline__ void fcum_unit(Frame& F, int bh, const float* logf, float* fcum) {
    const int b = bh / NHEADS, hh = bh % NHEADS, s0 = F.tid * 16;
    float v[16]; float loc = 0.f;
#pragma unroll
    for (int i = 0; i < 16; ++i) { v[i] = logf[((size_t)b * SEQ + s0 + i) * 8 + hh]; loc += v[i]; }
    float inc = loc;
#pragma unroll
    for (int o = 1; o < 64; o <<= 1) { const float n = __shfl_up(inc, o); if (F.lane >= o) inc += n; }
    if (F.lane == 63) F.MISC[16 + F.wave] = __float_as_uint(inc);
    __syncthreads();
    float run = inc - loc;
    for (int w = 0; w < F.wave; ++w) run += __uint_as_float(F.MISC[16 + w]);
#pragma unroll
    for (int i = 0; i < 16; ++i) { run += v[i]; fcum[(size_t)bh * SEQ + s0 + i] = run; }
    __syncthreads();
}


namespace peer {
typedef unsigned u32;
typedef float f32x16 __attribute__((ext_vector_type(16)));
constexpr int TOK = 128;
constexpr int EX_STRIDE = 136, GT_STRIDE = 136;
constexpr int L_EX = 0, L_GT = L_EX + TOK * EX_STRIDE * 2, L_IDX = L_GT + TOK * GT_STRIDE * 2, IDX_STRIDE = 36, L_RST = L_IDX + 512 * IDX_STRIDE, L_BI = L_RST + TOK * 4, L_END = L_BI + 8 * 4096;
static_assert(L_END <= RING_BYTES && L_GT % 16 == 0 && L_IDX % 16 == 0, "PEER LDS map");
__device__ __forceinline__ u32 ordmap(float f) { const u32 u = __float_as_uint(f); return u ^ ((u32)((int)u >> 31) | 0x80000000u); }
__device__ __forceinline__ float unordmap(u32 k) { const u32 u = (k & 0x80000000u) ? (k ^ 0x80000000u) : ~k; return __uint_as_float(u); }
__device__ __forceinline__ u32 umin_(u32 a, u32 b) { return a < b ? a : b; }
__device__ __forceinline__ u32 umax_(u32 a, u32 b) { return a > b ? a : b; }
template <bool DESC> __device__ __forceinline__ void sort16(u32 (&k)[16]) {
#pragma unroll
    for (int size = 2; size <= 16; size <<= 1)
#pragma unroll
        for (int stride = size >> 1; stride > 0; stride >>= 1)
#pragma unroll
            for (int i = 0; i < 16; ++i) { const int j = i ^ stride;
                if (j > i) { const bool asc = (((i & size) == 0) != DESC); const u32 a = k[i], b = k[j], lo = umin_(a, b), hi = umax_(a, b); k[i] = asc ? lo : hi; k[j] = asc ? hi : lo; } }
}
template <bool DESC> __device__ __forceinline__ void merge16(u32 (&k)[16]) {
#pragma unroll
    for (int stride = 8; stride > 0; stride >>= 1)
#pragma unroll
        for (int i = 0; i < 16; ++i) { const int j = i ^ stride;
            if (j > i) { const u32 a = k[i], b = k[j], lo = umin_(a, b), hi = umax_(a, b); k[i] = DESC ? hi : lo; k[j] = DESC ? lo : hi; } }
}
__host__ __device__ constexpr int ccnt(int a) { return 16 / (a + 1); }
__host__ __device__ constexpr int cbase(int a) { int s = 0; for (int i = 0; i < a; ++i) s += ccnt(i); return s; }
static_assert(cbase(16) == 50, "hyperbola candidate count");
__device__ __forceinline__ int crow16(int r) { return (r & 3) + 8 * (r >> 2); }

__device__ __forceinline__ void route_tile(Frame& F, const bf16* qp, const bf16* skb, const float* sumsq, int t0) {
    int lane = F.lane; asm volatile("" : "+v"(lane));
    const int r32 = lane & 31, hi = lane >> 5, w = F.wave;
    LAS unsigned short* EXL = (LAS unsigned short*)(F.lds + RING_OFF + L_EX);
    LAS unsigned short* GTL = (LAS unsigned short*)(F.lds + RING_OFF + L_GT);
    LAS unsigned char* IDXB = F.lds + RING_OFF + L_IDX + (w * 64 + lane) * IDX_STRIDE;
    LAS float* RST = (LAS float*)(F.lds + RING_OFF + L_RST);
    for (int g = 0; g < 4; ++g) {
        const int tok = 32 * g + r32; const size_t trow = (size_t)(t0 + tok);
        const float rstd2 = rsqrtf(sumsq[trow] * (1.f / DMODEL) + RMS_EPS);
        if (w == 0 && hi == 0) RST[tok] = rstd2;
        u32 s0[16], s1[16];
#pragma unroll
        for (int p = 0; p < 2; ++p) {
            bf16x8 qf[8];
#pragma unroll
            for (int ks = 0; ks < 8; ++ks) qf[ks] = *(const GAS bf16x8*)(qp + trow * QPW + w * 256 + p * 128 + ks * 16 + hi * 8);
            u32 run[16];
#pragma unroll
            for (int nb = 0; nb < 4; ++nb) {
                f32x16 acc = {};
                const bf16* kr = skb + ((size_t)((w * 2 + p) * NKEY + 32 * nb + r32)) * PHALF + hi * 8;
#pragma unroll
                for (int ks = 0; ks < 8; ++ks) acc = __builtin_amdgcn_mfma_f32_32x32x16_bf16(*(const GAS bf16x8*)(kr + ks * 16), qf[ks], acc, 0, 0, 0);
                asm volatile("" ::: "memory");
                u32 blk[16];
#pragma unroll
                for (int r = 0; r < 16; ++r) blk[r] = (ordmap(acc[r]) & ~0x7Fu) | (u32)(127 - 32 * nb - crow16(r) - 4 * hi);
                if (nb == 0) { sort16<true>(blk);
#pragma unroll
                    for (int i = 0; i < 16; ++i) run[i] = blk[i]; }
                else { sort16<false>(blk);
#pragma unroll
                    for (int i = 0; i < 16; ++i) run[i] = umax_(run[i], blk[i]);
                    merge16<true>(run); }
            }
            u32 oth[16];
#pragma unroll
            for (int i = 0; i < 16; ++i) oth[i] = (u32)__shfl_xor((int)run[15 - i], 32);
#pragma unroll
            for (int i = 0; i < 16; ++i) run[i] = umax_(run[i], oth[i]);
            merge16<true>(run);
#pragma unroll
            for (int i = 0; i < 16; ++i) { if (p == 0) s0[i] = run[i]; else s1[i] = run[i]; }
        }
        { LAS u32* iw = (LAS u32*)IDXB;
#pragma unroll
          for (int j = 0; j < 4; ++j) {
              iw[j] = (127u - (s0[4 * j] & 127u)) | ((127u - (s0[4 * j + 1] & 127u)) << 8) | ((127u - (s0[4 * j + 2] & 127u)) << 16) | ((127u - (s0[4 * j + 3] & 127u)) << 24);
              iw[4 + j] = (127u - (s1[4 * j] & 127u)) | ((127u - (s1[4 * j + 1] & 127u)) << 8) | ((127u - (s1[4 * j + 2] & 127u)) << 16) | ((127u - (s1[4 * j + 3] & 127u)) << 24); } }
        float v1[16], v2[16];
#pragma unroll
        for (int i = 0; i < 16; ++i) { v1[i] = unordmap(s0[i] & ~0x7Fu); v2[i] = unordmap(s1[i] & ~0x7Fu); }
        u32 c0[16], c1[16], c2[16], c3[16];
#pragma unroll
        for (int a = 0; a < 16; ++a)
#pragma unroll
            for (int b = 0; b < ccnt(a); ++b) { const int pos = cbase(a) + b; const u32 key = (ordmap(v1[a] + v2[b]) & ~0xFFu) | (u32)(255 - (a * 16 + b));
                if (pos < 16) c0[pos] = key; else if (pos < 32) c1[pos - 16] = key; else if (pos < 48) c2[pos - 32] = key; else c3[pos - 48] = key; }
#pragma unroll
        for (int i = 2; i < 16; ++i) c3[i] = 0u;
        sort16<false>(c1);
#pragma unroll
        for (int i = 0; i < 16; ++i) c0[i] = umax_(c0[i], c1[i]);
        merge16<true>(c0);
        sort16<false>(c2);
#pragma unroll
        for (int i = 0; i < 16; ++i) c0[i] = umax_(c0[i], c2[i]);
        merge16<true>(c0);
        sort16<false>(c3);
#pragma unroll
        for (int i = 0; i < 16; ++i) c0[i] = umax_(c0[i], c3[i]);
        merge16<true>(c0);
        const float m = unordmap(c0[0] & ~0xFFu) * rstd2;
        float e[8]; float sum = 0.f; u32 ex[8];
#pragma unroll
        for (int k = 0; k < 8; ++k) { const u32 key = hi ? c0[k + 8] : c0[k]; const float ts = unordmap(key & ~0xFFu);
            e[k] = __builtin_amdgcn_exp2f((ts * rstd2 - m) * LOG2E); sum += e[k];
            const u32 flat = 255u - (key & 255u); ex[k] = (u32)IDXB[flat >> 4] * NKEY + (u32)IDXB[16 + (flat & 15u)]; }
        sum += __shfl_xor(sum, 32);
        const float inv = 1.f / sum;
        v4u exw; exw.x = ex[0] | (ex[1] << 16); exw.y = ex[2] | (ex[3] << 16); exw.z = ex[4] | (ex[5] << 16); exw.w = ex[6] | (ex[7] << 16);
        *(LAS v4u*)(EXL + tok * EX_STRIDE + w * 16 + hi * 8) = exw;
        *(LAS v4u*)(GTL + tok * GT_STRIDE + w * 16 + hi * 8) = (v4u){pk2(e[0] * inv, e[1] * inv), pk2(e[2] * inv, e[3] * inv), pk2(e[4] * inv, e[5] * inv), pk2(e[6] * inv, e[7] * inv)};
    }
}
__device__ __forceinline__ float gelu_fast(float x) {
    const float u2 = x * (1.5957691216057308f + 0.07135481627f * x * x);
    return x * __builtin_amdgcn_rcpf(1.f + __builtin_amdgcn_exp2f(-1.4426950408889634f * u2));
}
typedef float f32x2 __attribute__((ext_vector_type(2)));

__device__ __forceinline__ void sort128(u32 (&k)[8], int m) {
#pragma unroll
    for (int K = 2; K <= 128; K <<= 1) {
#pragma unroll
        for (int S = K >> 1; S > 0; S >>= 1) {
            if (S >= 8) {
                const int mm = S >> 3; const bool lower = (m & mm) == 0, up = (K == 128) ? true : ((m & (K >> 3)) == 0), keepmin = (lower == up);
#pragma unroll
                for (int r = 0; r < 8; ++r) { const u32 o = (u32)__shfl_xor((int)k[r], mm); const u32 mn = umin_(k[r], o), mx = umax_(k[r], o); k[r] = keepmin ? mn : mx; }
            } else {
#pragma unroll
                for (int r = 0; r < 8; ++r) { const int r2 = r ^ S;
                    if (r2 > r) { const u32 a = k[r], b = k[r2], mn = umin_(a, b), mx = umax_(a, b);
                        if (K < 8) { const bool up = (r & K) == 0; k[r] = up ? mn : mx; k[r2] = up ? mx : mn; }
                        else { const bool up = (K == 128) ? true : ((m & (K >> 3)) == 0); k[r] = up ? mn : mx; k[r2] = up ? mx : mn; } } }
            }
        }
    }
}
typedef int v8i __attribute__((ext_vector_type(8)));
__device__ __forceinline__ void eval_mf(Frame& F, const unsigned char* u4, const unsigned char* v4, const float* suv, const float* fg, float* out, int t0) {
    int lane = F.lane; asm volatile("" : "+v"(lane));
    const int g = lane >> 4, m = lane & 15;
    const LAS unsigned short* EXL = (const LAS unsigned short*)(F.lds + RING_OFF + L_EX);
    const LAS unsigned short* GTL = (const LAS unsigned short*)(F.lds + RING_OFF + L_GT);
    LAS unsigned char* BI = F.lds + RING_OFF + L_BI + F.wave * 4096;
    const LAS float* RST = (const LAS float*)(F.lds + RING_OFF + L_RST);
    LAS u32* SKW = (LAS u32*)(F.lds + RING_OFF + L_IDX) + F.wave * 512;
    LAS u32* SK = SKW + g * 128;
    for (int pass = 0; pass < 4; ++pass) {
        const int tb4 = 32 * pass + 4 * F.wave, tok = tb4 + g;
        { u32 k[8]; const v4u ev = *(const LAS v4u*)(EXL + tok * EX_STRIDE + 8 * m); const u32 s0 = (u32)(8 * m);
          k[0] = ((ev.x & 0xffffu) << 7) | s0; k[1] = ((ev.x >> 16) << 7) | (s0 + 1); k[2] = ((ev.y & 0xffffu) << 7) | (s0 + 2); k[3] = ((ev.y >> 16) << 7) | (s0 + 3);
          k[4] = ((ev.z & 0xffffu) << 7) | (s0 + 4); k[5] = ((ev.z >> 16) << 7) | (s0 + 5); k[6] = ((ev.w & 0xffffu) << 7) | (s0 + 6); k[7] = ((ev.w >> 16) << 7) | (s0 + 7);
          sort128(k, m);
          *(LAS v4u*)(SK + m * 8) = (v4u){k[0], k[1], k[2], k[3]}; *(LAS v4u*)(SK + m * 8 + 4) = (v4u){k[4], k[5], k[6], k[7]}; }
        asm volatile("" ::: "memory");
        {
#pragma unroll
            for (int tq = 0; tq < 4; ++tq) { const float rq = RST[tb4 + tq]; const float* xr = out + (size_t)(t0 + tb4 + tq) * DMODEL + 4 * lane;
#pragma unroll
                for (int c = 0; c < 4; ++c) { const f32x4 xa = *(const GAS f32x4*)(xr + 256 * c); int w = 0;
                    w = __builtin_amdgcn_cvt_pk_fp8_f32(xa[0] * rq, xa[1] * rq, w, false); w = __builtin_amdgcn_cvt_pk_fp8_f32(xa[2] * rq, xa[3] * rq, w, true);
                    const int d = 256 * c + 4 * lane, st = d >> 7, dd = d & 127, hh = dd >> 6, e = dd & 63;
                    *(LAS int*)(BI + ((st * 4 + tq) * 4 + (e >> 4)) * 32 + hh * 16 + (e & 15)) = w; } }
        }
        asm volatile("" ::: "memory");
        v8i hb[8];
#pragma unroll
        for (int st = 0; st < 8; ++st) { v4u b0 = *(const LAS v4u*)(BI + ((st * 4 + (m & 3)) * 4 + g) * 32), b1 = *(const LAS v4u*)(BI + ((st * 4 + (m & 3)) * 4 + g) * 32 + 16);
            if (m >= 4) { b0 = (v4u){0u, 0u, 0u, 0u}; b1 = b0; }
            hb[st] = (v8i){(int)b0.x, (int)b0.y, (int)b0.z, (int)b0.w, (int)b1.x, (int)b1.y, (int)b1.z, (int)b1.w}; }
        asm volatile("" ::: "memory");
        f32x2 y[32];
#pragma unroll
        for (int q = 0; q < 32; ++q) y[q] = (f32x2){0.f, 0.f};
        float* xrow = out + (size_t)(t0 + tok) * DMODEL + 64 * m;
        const LAS unsigned short* gtr = GTL + tok * GT_STRIDE;
        for (int i = 0; i < 128; i += 4) {
            const u32 keyr = SKW[(m & 3) * 128 + i + (m >> 2)];
            const unsigned char* ap = u4 + (keyr >> 7) * 512u + 16u * (u32)g;
            v4u af[8];
#pragma unroll
            for (int st = 0; st < 8; ++st) af[st] = *(const GAS v4u*)(ap + 64 * st);
            const v4u kq = *(const LAS v4u*)(SK + i);
            f32x2 sc[4]; float gate[4];
#pragma unroll
            for (int s4 = 0; s4 < 4; ++s4) { sc[s4] = *(const GAS f32x2*)(suv + 2 * (kq[s4] >> 7)); gate[s4] = __uint_as_float((u32)gtr[kq[s4] & 127u] << 16); }
            f32x4 D = (f32x4){0.f, 0.f, 0.f, 0.f};
#pragma unroll
            for (int st = 0; st < 8; ++st) { const v8i a8 = (v8i){(int)af[st].x, (int)af[st].y, (int)af[st].z, (int)af[st].w, 0, 0, 0, 0};
                D = __builtin_amdgcn_mfma_scale_f32_16x16x128_f8f6f4(a8, hb[st], D, 4, 0, 0, 0x7f7f7f7f, 0, 0x7f7f7f7f); }
            asm volatile("" ::: "memory");
            v4u vb[4][2];
#pragma unroll
            for (int s4 = 0; s4 < 4; ++s4) { const u32 ro = (kq[s4] >> 7) * 512u + 32u * (u32)m; vb[s4][0] = *(const GAS v4u*)(v4 + ro); vb[s4][1] = *(const GAS v4u*)(v4 + ro + 16); }
            const int sel = lane & 3; const float mine = sel == 0 ? D[0] : sel == 1 ? D[1] : sel == 2 ? D[2] : D[3];
#pragma unroll
            for (int s4 = 0; s4 < 4; ++s4) { const float pre = __uint_as_float((unsigned)__builtin_amdgcn_ds_bpermute(4 * (g + 16 * s4), (int)__float_as_uint(mine)));
                const float act = gelu_fast(pre * sc[s4][0]) * (gate[s4] * sc[s4][1]); const f32x2 b2 = (f32x2){act, act};
#pragma unroll
                for (int c = 0; c < 2; ++c)
#pragma unroll
                    for (int d = 0; d < 4; ++d) { const unsigned w_ = vb[s4][c][d]; const int hq = 16 * c + 4 * d;
                        y[hq] = __builtin_elementwise_fma(__builtin_amdgcn_cvt_scalef32_pk_f32_fp4(w_, 1.0f, 0), b2, y[hq]); y[hq + 1] = __builtin_elementwise_fma(__builtin_amdgcn_cvt_scalef32_pk_f32_fp4(w_, 1.0f, 1), b2, y[hq + 1]);
                        y[hq + 2] = __builtin_elementwise_fma(__builtin_amdgcn_cvt_scalef32_pk_f32_fp4(w_, 1.0f, 2), b2, y[hq + 2]); y[hq + 3] = __builtin_elementwise_fma(__builtin_amdgcn_cvt_scalef32_pk_f32_fp4(w_, 1.0f, 3), b2, y[hq + 3]); } }
        }
        float ss = 0.f;
#pragma unroll
        for (int q = 0; q < 16; ++q) { const f32x4 xa = *(const GAS f32x4*)(xrow + 4 * q); y[2 * q][0] += xa[0]; y[2 * q][1] += xa[1]; y[2 * q + 1][0] += xa[2]; y[2 * q + 1][1] += xa[3];
            ss += (y[2 * q][0] * y[2 * q][0] + y[2 * q][1] * y[2 * q][1]) + (y[2 * q + 1][0] * y[2 * q + 1][0] + y[2 * q + 1][1] * y[2 * q + 1][1]); }
        ss += __shfl_xor(ss, 1); ss += __shfl_xor(ss, 2); ss += __shfl_xor(ss, 4); ss += __shfl_xor(ss, 8);
        const float rs = rsqrtf(ss * (1.f / DMODEL) + RMS_EPS);
        asm volatile("" ::: "memory");
#pragma unroll
        for (int q = 0; q < 16; ++q) { const f32x4 gq = *(const GAS f32x4*)(fg + 64 * m + 4 * q); f32x4 o; o[0] = y[2 * q][0] * rs * gq[0]; o[1] = y[2 * q][1] * rs * gq[1]; o[2] = y[2 * q + 1][0] * rs * gq[2]; o[3] = y[2 * q + 1][1] * rs * gq[3];
            *(GAS f32x4*)(xrow + 4 * q) = o; }
    }
}
__device__ __forceinline__ void peer_phase(Frame& F, const Args& a) {
    unsigned char* ws = a.ws;
    for (int tile = F.vcu; tile < T / TOK; tile += F.G) {
        route_tile(F, (const bf16*)(ws + WS_QP), (const bf16*)(ws + WS_SKB), (const float*)(ws + WS_SUMSQ), tile * TOK);
        __syncthreads();
        eval_mf(F, ws + WS_U8, ws + WS_V8, (const float*)(ws + WS_SU), a.in[19], a.out, tile * TOK);
        __syncthreads();
    }
}
}

namespace lru {
typedef float f32x16 __attribute__((ext_vector_type(16)));
constexpr int TOKT = 128, NTILE = SEQ / TOKT;
constexpr int WAVE_LDS = 14336, L_XS = 0, L_XC = 4608, L_GS = 9216, XC_STRIDE = 72  , L_SS = 8 * WAVE_LDS;
static_assert(L_SS + 32 * 8 * 4 <= RING_BYTES, "LRU LDS map");
__device__ __forceinline__ float bf2f(unsigned short h) { return __uint_as_float((unsigned)h << 16); }
__device__ __forceinline__ int crow16(int r) { return (r & 3) + 8 * (r >> 2); }
__device__ __forceinline__ float sigm(float x) { return __builtin_amdgcn_rcpf(1.f + __builtin_amdgcn_exp2f(-LOG2E * x)); }

template <bool FINAL> __device__ __forceinline__ void lru_tile(Frame& F, const Args& args, int tile) {
    int lane = F.lane; asm volatile("" : "+v"(lane));
    const int w = F.wave, j32 = lane & 31, hi = lane >> 5;
    unsigned char* ws = args.ws;
    const bf16* xr = (const bf16*)(ws + WS_XR); const bf16* gr = (const bf16*)(ws + WS_GR); float* carry = (float*)(ws + WS_CARRY);
    const float* cw = args.in[3]; const float* cb = args.in[4]; const float* ba = args.in[6]; const float* bx = args.in[8]; const float* lam = args.in[9];
    const int b = tile / NTILE, jt = tile % NTILE; const size_t trow0 = (size_t)b * SEQ + (size_t)jt * TOKT;
    LAS unsigned char* wl = F.lds + RING_OFF + w * WAVE_LDS;
    LAS unsigned short* XS = (LAS unsigned short*)(wl + L_XS); LAS unsigned short* XC = (LAS unsigned short*)(wl + L_XC); LAS unsigned short* GS = (LAS unsigned short*)(wl + L_GS);
    LAS float* SS = (LAS float*)(F.lds + RING_OFF + L_SS);
    float c_ba[2], c_bx[2], c_sp[2], c_cb[2], c_cw[2][4];
#pragma unroll
    for (int n = 0; n < 2; ++n) { const int c = 64 * w + 32 * n + j32; c_ba[n] = ba[c]; c_bx[n] = bx[c]; c_cb[n] = cb[c];
        const float l = lam[c]; c_sp[n] = 8.f * LOG2E * (fmaxf(-l, 0.f) + log1pf(expf(-fabsf(l))));
#pragma unroll
        for (int k = 0; k < 4; ++k) c_cw[n][k] = cw[k * LW + c]; }
    const bf16* wax = (const bf16*)(ws + WS_WAX);
    float hc[2] = {0.f, 0.f}, ap[2] = {1.f, 1.f};
    if (FINAL) { const float* cin = (const float*)(ws + WS_CIN) + (size_t)(b * NTILE + jt) * LW + 64 * w + j32; hc[0] = cin[0]; hc[1] = cin[32]; }
    v4u pfx[5], pfg[4];
#define LRU_FETCH(B) do { const size_t tbn_ = trow0 + (B) * 32; _Pragma("unroll") for (int q_ = 0; q_ < 5; ++q_) { const int pc_ = lane + 64 * q_, row_ = pc_ >> 3, c8_ = pc_ & 7; \
        const bool z_ = (jt == 0 && (B) == 0 && row_ < 3) || pc_ >= 35 * 8; const v4u v_ = *(const GAS v4u*)(xr + (tbn_ + (z_ ? 3 : row_) - 3) * LW + w * 64 + c8_ * 8); pfx[q_] = z_ ? (v4u){0u, 0u, 0u, 0u} : v_; } \
        if (FINAL) { _Pragma("unroll") for (int q_ = 0; q_ < 4; ++q_) { const int pc_ = lane + 64 * q_; pfg[q_] = *(const GAS v4u*)(gr + (tbn_ + (pc_ >> 3)) * LW + w * 64 + (pc_ & 7) * 8); } } } while (0)
    LRU_FETCH(0);
    for (int blk = 0; blk < 4; ++blk) {
        const size_t tb = trow0 + blk * 32;
        int ln = lane; asm volatile("" : "+v"(ln));
        const int k32 = ln & 31;
#pragma unroll
        for (int q = 0; q < 5; ++q) { const int pc = ln + 64 * q; if (pc < 35 * 8) *(LAS v4u*)((LAS unsigned char*)XS + (pc >> 3) * 128 + (pc & 7) * 16) = pfx[q]; }
        if (FINAL) {
#pragma unroll
            for (int q = 0; q < 4; ++q) { const int pc = ln + 64 * q; *(LAS v4u*)((LAS unsigned char*)GS + (pc >> 3) * 128 + (pc & 7) * 16) = pfg[q]; } }
        if (blk < 3) { LRU_FETCH(blk + 1); }
        asm volatile("" ::: "memory");
        float xc[2][16];
#pragma unroll
        for (int n = 0; n < 2; ++n)
#pragma unroll
            for (int g = 0; g < 4; ++g) { float xv[7];
#pragma unroll
                for (int q = 0; q < 7; ++q) xv[q] = bf2f(XS[(8 * g + 4 * hi + q) * 64 + 32 * n + j32]);
#pragma unroll
                for (int e = 0; e < 4; ++e) xc[n][4 * g + e] = c_cb[n] + ((c_cw[n][0] * xv[e] + c_cw[n][1] * xv[e + 1]) + (c_cw[n][2] * xv[e + 2] + c_cw[n][3] * xv[e + 3])); }
#pragma unroll
        for (int n = 0; n < 2; ++n)
#pragma unroll
            for (int r = 0; r < 16; ++r) XC[(crow16(r) + 4 * hi) * XC_STRIDE + 32 * n + j32] = (unsigned short)f2bf(xc[n][r]);
        asm volatile("" ::: "memory");
        bf16x8 af[4];
#pragma unroll
        for (int ks = 0; ks < 4; ++ks) af[ks] = *(const LAS bf16x8*)(XC + j32 * XC_STRIDE + 16 * ks + 8 * hi);
        asm volatile("" ::: "memory");
        float yv[2][16];
#pragma unroll
        for (int n = 0; n < 2; ++n) {
            f32x16 R = {}, I = {};
            bf16x8 fa[4], fx[4];
#pragma unroll
            for (int ks = 0; ks < 4; ++ks) { fa[ks] = *(const GAS bf16x8*)(wax + (size_t)(((w * 2 + 0) * 2 + n) * 4 + ks) * 512 + ln * 8); fx[ks] = *(const GAS bf16x8*)(wax + (size_t)(((w * 2 + 1) * 2 + n) * 4 + ks) * 512 + ln * 8); }
#pragma unroll
            for (int ks = 0; ks < 4; ++ks) { R = __builtin_amdgcn_mfma_f32_32x32x16_bf16(af[ks], fa[ks], R, 0, 0, 0); I = __builtin_amdgcn_mfma_f32_32x32x16_bf16(af[ks], fx[ks], I, 0, 0, 0); }
            float av[16], uv[16];
#pragma unroll
            for (int r = 0; r < 16; ++r) { const float rg = sigm(R[r] + c_ba[n]), ig = sigm(I[r] + c_bx[n]); const float a_ = __builtin_amdgcn_exp2f(-rg * c_sp[n]);
                av[r] = a_; uv[r] = __builtin_amdgcn_sqrtf(fmaxf(1.f - a_ * a_, 0.f)) * (ig * xc[n][r]); }
            float Ar[4], Hr[4], hst[4];
#pragma unroll
            for (int g = 0; g < 4; ++g) { Ar[g] = (av[4 * g] * av[4 * g + 1]) * (av[4 * g + 2] * av[4 * g + 3]);
                Hr[g] = ((uv[4 * g] * av[4 * g + 1] + uv[4 * g + 1]) * av[4 * g + 2] + uv[4 * g + 2]) * av[4 * g + 3] + uv[4 * g + 3]; }
            float hin = hc[n];
#pragma unroll
            for (int g = 0; g < 4; ++g) { float o1 = Ar[g] * hin + Hr[g]; const float x = __shfl_xor(o1, 32); const float hg = hi ? x : hin; o1 = Ar[g] * hg + Hr[g]; hst[g] = hg;
                const float y = __shfl_xor(o1, 32); hin = hi ? o1 : y;
                if (!FINAL) ap[n] *= Ar[g] * __shfl_xor(Ar[g], 32); }
            hc[n] = hin;
            if (FINAL) {
#pragma unroll
                for (int g = 0; g < 4; ++g) { float h = hst[g];
#pragma unroll
                    for (int e = 0; e < 4; ++e) { const int r = 4 * g + e; h = av[r] * h + uv[r]; yv[n][r] = h * bf2f(GS[(crow16(r) + 4 * hi) * 64 + 32 * n + j32]); } } }
        }
        if (FINAL) {
#pragma unroll
            for (int r = 0; r < 16; ++r) { float s = yv[0][r] * yv[0][r] + yv[1][r] * yv[1][r];
                s += __shfl_xor(s, 1); s += __shfl_xor(s, 2); s += __shfl_xor(s, 4); s += __shfl_xor(s, 8); s += __shfl_xor(s, 16);
                if (j32 == 0) SS[(crow16(r) + 4 * hi) * 8 + w] = s; }
            __syncthreads();
            bf16* ymix = (bf16*)(ws + WS_H);
#pragma unroll
            for (int r = 0; r < 16; ++r) { const int tk = crow16(r) + 4 * hi; const f32x4 s0 = *(const LAS f32x4*)(SS + tk * 8), s1 = *(const LAS f32x4*)(SS + tk * 8 + 4);
                const float rstd = rsqrtf(((s0[0] + s0[1]) + (s0[2] + s0[3]) + (s1[0] + s1[1]) + (s1[2] + s1[3])) * (1.f / LW) + RMS_EPS);
                bf16* yp = ymix + (tb + tk) * DMODEL + 64 * w + k32;
                yp[0] = (bf16)f2bf(yv[0][r] * rstd); yp[32] = (bf16)f2bf(yv[1][r] * rstd); }
            __syncthreads();
        }
    }
#undef LRU_FETCH
    if (!FINAL) { if (hi == 0) { float* cp = carry + ((size_t)(b * NTILE + jt) * 2) * LW + 64 * w + j32;
#pragma unroll
        for (int n = 0; n < 2; ++n) { cp[32 * n] = ap[n]; cp[LW + 32 * n] = hc[n]; } } }
    else {
        const bf16* ob = (const bf16*)(ws + WS_O); bf16* ymix = (bf16*)(ws + WS_H);
        for (int i0 = 0; i0 < 16; i0 += 4) {
            v4u vv[4];
#pragma unroll
            for (int i = 0; i < 4; ++i) vv[i] = *(const GAS v4u*)(ob + (trow0 + 16 * w + i0 + i) * AW + 8 * lane);
            float ssq[4];
#pragma unroll
            for (int i = 0; i < 4; ++i) { float s = 0.f;
#pragma unroll
                for (int c = 0; c < 4; ++c) { const float lo = __uint_as_float(vv[i][c] << 16), hi2 = __uint_as_float(vv[i][c] & 0xffff0000u); s += lo * lo + hi2 * hi2; }
                ssq[i] = s; }
#pragma unroll
            for (int o = 1; o < 64; o <<= 1) {
#pragma unroll
                for (int i = 0; i < 4; ++i) ssq[i] += __shfl_xor(ssq[i], o); }
#pragma unroll
            for (int i = 0; i < 4; ++i) { const float rstd = rsqrtf(ssq[i] * (1.f / AW) + RMS_EPS); v4u o;
#pragma unroll
                for (int c = 0; c < 4; ++c) o[c] = pk2(__uint_as_float(vv[i][c] << 16) * rstd, __uint_as_float(vv[i][c] & 0xffff0000u) * rstd);
                *(GAS v4u*)(ymix + (trow0 + 16 * w + i0 + i) * DMODEL + LW + 8 * lane) = o; } }
    }
}
__device__ __forceinline__ void norm_pass(Frame& F, const Args& a) {
    unsigned char* ws = a.ws; float* nrm = (float*)(ws + WS_NRM);
    const int gw = F.vcu * NWAVES + F.wave, NGW = F.G * NWAVES, lane = F.lane;
    for (int it = gw; it < 2 * BATCH * (SEQ / 64); it += NGW) {
        const int which = it / (BATCH * (SEQ / 64)), r = it % (BATCH * (SEQ / 64)), b = r / (SEQ / 64), t = r % (SEQ / 64);
        const bf16* src = (const bf16*)(ws + (which ? WS_K : WS_Q)) + ((size_t)b * SEQ + 64 * t) * AW + 8 * lane;
        float mx = 0.f;
#pragma unroll 8
        for (int i = 0; i < 64; ++i) { const v4u v = *(const GAS v4u*)(src + (size_t)i * AW); float s = 0.f;
#pragma unroll
            for (int c = 0; c < 4; ++c) { const float lo = __uint_as_float(v[c] << 16), hi = __uint_as_float(v[c] & 0xffff0000u); s += lo * lo + hi * hi; }
            s += __shfl_xor(s, 1); s += __shfl_xor(s, 2); s += __shfl_xor(s, 4); mx = fmaxf(mx, s); }
        if ((lane & 7) == 0) nrm[which * 4096 + (b * NHEADS + (lane >> 3)) * 128 + t] = sqrtf(mx) * 1.0001f;
    }
}
__device__ __forceinline__ void carry_prefix(Frame& F, const Args& a, int b) {
    const float* carry = (const float*)(a.ws + WS_CARRY) + (size_t)b * NTILE * 2 * LW + F.tid; float* cin = (float*)(a.ws + WS_CIN) + (size_t)b * NTILE * LW + F.tid;
    float c = 0.f;
    for (int j0 = 0; j0 < NTILE; j0 += 8) { float A[8], H[8];
#pragma unroll
        for (int j = 0; j < 8; ++j) { A[j] = carry[(size_t)(j0 + j) * 2 * LW]; H[j] = carry[(size_t)(j0 + j) * 2 * LW + LW]; }
#pragma unroll
        for (int j = 0; j < 8; ++j) { cin[(size_t)(j0 + j) * LW] = c; c = A[j] * c + H[j]; } }
}
template <bool FINAL> __device__ __forceinline__ void lru_phase(Frame& F, const Args& a) {
    for (int tile = F.vcu; tile < BATCH * NTILE; tile += F.G) { lru_tile<FINAL>(F, a, tile); __syncthreads(); }
}
}
__global__ void __launch_bounds__(NWAVES * 64, 2) mk_fwd(Args args) {
    extern __shared__ __attribute__((aligned(16))) unsigned char lds[];
    Frame F;
    F.lds = (LAS unsigned char*)lds;
    F.MISC = (volatile LAS unsigned*)(F.lds + MISC_OFF);
    F.wave = __builtin_amdgcn_readfirstlane((int)threadIdx.x >> 6); F.lane = (int)__builtin_amdgcn_mbcnt_hi(~0u, __builtin_amdgcn_mbcnt_lo(~0u, 0u)); F.tid = F.wave * 64 + F.lane;
    F.G = gridDim.x; { const int bx = blockIdx.x; F.vcu = (F.G % 8 == 0) ? (bx % 8) * (F.G / 8) + bx / 8 : bx; }
    unsigned char* ws = args.ws;
    F.ctl = (gu32*)(ws + WS_CTL);
    for (int u = F.tid; u < (LDS_BYTES - LDSCTL_OFF) / 4; u += NWAVES * 64) ((LAS unsigned*)(F.lds + LDSCTL_OFF))[u] = 0u;
    __syncthreads();
    XcdBarrier bar = xcd_barrier_post((unsigned*)(F.ctl + CW_BAR) + args.li * XCD_BAR_WORDS, F.MISC + 8, F.wave);
    const int lo = args.ph_lo, hi = args.ph_hi;
#define IN(k) (lo <= (k) && (k) < hi)
#define BOTH(k) (IN(k) && IN((k) + 1))
#define GRID_BAR() xcd_barrier(bar)

    if (IN(0)) { p0_prologue(F, args); if (BOTH(0)) GRID_BAR(); }

    if (IN(1)) {
        if (F.vcu < BATCH * NHEADS) fcum_unit(F, F.vcu, (const float*)(ws + WS_LOGF), (float*)(ws + WS_FCUM));
        pg8::Gemm g{(const pg8::bf16_t*)(ws + WS_H), (const pg8::bf16_t*)(ws + WS_WIN), T, NG1, DMODEL}; pg8::StaticOrder S; S.init(T, NG1, F.G, (int)blockIdx.x);
        pg8::EpiG1 E{(pg8::bf16_t*)(ws + WS_XR), SPLIT_STRIDE, QSCALE};
        pg8::gemm_phase<pg8::EpiG1, pg8::StaticOrder, true, true>(F.lds + RING_OFF, g, S, E, F.wave);
        if (BOTH(1)) GRID_BAR();
    }
    if (IN(2)) { lru::lru_phase<false>(F, args); lru::norm_pass(F, args); if (BOTH(2)) GRID_BAR(); }
    if (IN(3)) {
        static_assert(attn_body::ATTN_LDS_BYTES <= RING_BYTES, "attention LDS vs frame");
        if (F.vcu < BATCH) lru::carry_prefix(F, args, F.vcu);
        const attn_body::AttnTensors AT{(const attn_body::bf16*)(ws + WS_Q), (const attn_body::bf16*)(ws + WS_K), (const attn_body::bf16*)(ws + WS_V), (attn_body::bf16*)(ws + WS_O), (const float*)(ws + WS_FCUM), (const float*)(ws + WS_NRM)};
        attn_body::attn_phase<8>((char*)lds + RING_OFF, AT, (unsigned*)(F.ctl + CW_ATTQ), F.MISC + 24, F.wave);
        if (BOTH(3)) GRID_BAR();
    }
    if (IN(4)) { lru::lru_phase<true>(F, args); if (BOTH(4)) GRID_BAR(); }
    if (IN(5)) {
        pg8::Gemm g{(const pg8::bf16_t*)(ws + WS_H), (const pg8::bf16_t*)(ws + WS_WOUT), T, DMODEL, DMODEL}; pg8::StaticOrder S; S.init(T, DMODEL, F.G, (int)blockIdx.x);
        pg8::EpiG2 E{args.in[0], args.out, (pg8::bf16_t*)(ws + WS_X1B), (float*)(ws + WS_SUMSQ), DMODEL};
        pg8::gemm_phase<pg8::EpiG2, pg8::StaticOrder, true, true>(F.lds + RING_OFF, g, S, E, F.wave);
        if (BOTH(5)) GRID_BAR();
    }
    if (IN(6)) {
        pg8::Gemm g{(const pg8::bf16_t*)(ws + WS_X1B), (const pg8::bf16_t*)(ws + WS_WQ), T, QPW, DMODEL}; pg8::StaticOrder S; S.init(T, QPW, F.G, (int)blockIdx.x);
        pg8::EpiG3 E{(pg8::bf16_t*)(ws + WS_QP), QPW};
        pg8::gemm_phase<pg8::EpiG3, pg8::StaticOrder, true, true>(F.lds + RING_OFF, g, S, E, F.wave);
        if (BOTH(6)) GRID_BAR();
    }
    if (IN(7)) { peer::peer_phase(F, args); }
#undef IN
#undef BOTH
#undef GRID_BAR
}

extern "C" void kernel_launch(void* const* d_in, const int* in_sizes, int n_in, void* d_out, int out_size, void* d_ws, size_t ws_size, hipStream_t stream) {
    static int grid = 0;
    if (grid == 0) {
        if (n_in != 20 || in_sizes[0] != T * DMODEL || out_size != T * DMODEL || ws_size < WS_END) { fprintf(stderr, "kernel_launch: unexpected shapes (n_in %d, ws %zu)\n", n_in, ws_size); grid = -1; return; }
        int dev = 0, cus = 0;
        if (hipGetDevice(&dev) != hipSuccess || hipDeviceGetAttribute(&cus, hipDeviceAttributeMultiprocessorCount, dev) != hipSuccess) { grid = -1; return; }
        if (hipFuncSetAttribute((const void*)mk_fwd, hipFuncAttributeMaxDynamicSharedMemorySize, LDS_BYTES) != hipSuccess) { fprintf(stderr, "kernel_launch: hipFuncSetAttribute failed\n"); grid = -1; return; }
        (void)hipGetLastError();
        grid = cus;
    }
    if (grid < 0) return;
    if (hipMemsetAsync((char*)d_ws + WS_CTL, 0, CTL_ZERO_BYTES, stream) != hipSuccess) return;
    Args a{};
    for (int i = 0; i < 20; ++i) a.in[i] = (const float*)d_in[i];
    a.out = (float*)d_out; a.ws = (unsigned char*)d_ws; a.ph_lo = 0; a.ph_hi = N_PHASES; a.li = 0;
    hipLaunchKernelGGL(mk_fwd, dim3(grid), dim3(NWAVES * 64), LDS_BYTES, stream, a);
}
```

```cpp
#include <hip/hip_runtime.h>
#include <hip/hip_bf16.h>
#include <cstdio>
#include <cstdint>
#include <cmath>

constexpr int BATCH = 4, SEQ = 8192, DMODEL = 1024, T = BATCH * SEQ;
constexpr int LW = 512, AW = 512, NHEADS = 8, HD = 64, INC = 2568, NG1 = 2560;
constexpr int PH = 8, NKEY = 128, PHALF = 128, TOPK = 16, NEXP = NKEY * NKEY, QPW = 2048;
constexpr float RMS_EPS = 1e-6f;
constexpr float LOG2E = 1.4426950408889634f;
constexpr float QSCALE = 0.125f * LOG2E;
constexpr size_t MiB = 1u << 20;
constexpr size_t WS_CTL = 0, CTL_ZERO_BYTES = 1 * MiB;
constexpr size_t WS_WIN = 2 * MiB, WS_WOUT = 8 * MiB, WS_WQ = 10 * MiB, WS_SKB = 14 * MiB, WS_WFL = 15 * MiB,
                 WS_LOGF = 16 * MiB, WS_FCUM = 17 * MiB, WS_CARRY = 18 * MiB, WS_SUMSQ = 19 * MiB, WS_WAX = 20 * MiB, WS_CIN = 23 * MiB  , WS_NRM = 22 * MiB  ,
                 WS_H = 32 * MiB, WS_XR = 96 * MiB, WS_GR = 128 * MiB, WS_Q = 160 * MiB, WS_K = 192 * MiB, WS_V = 224 * MiB,
                 WS_X1B = 256 * MiB, WS_O = 256 * MiB  , WS_QP = 96 * MiB, WS_UT = 320 * MiB, WS_VT = 352 * MiB, WS_U8 = 320 * MiB, WS_V8 = 336 * MiB, WS_SU = 21 * MiB, WS_SV = 21 * MiB + 65536, WS_LA = 384 * MiB, WS_LU = 448 * MiB, WS_END = 512 * MiB;
constexpr size_t SPLIT_STRIDE = (WS_GR - WS_XR) / 2;
constexpr int CW_TMO = 0, CW_ATTQ = 2048, CW_BAR = 4096;

namespace pg8 {
#define PG8_LAS __attribute__((address_space(3)))
typedef unsigned short bf16_t;
typedef short bf16x8 __attribute__((ext_vector_type(8)));
typedef float f32x4 __attribute__((ext_vector_type(4)));
typedef unsigned u32x4 __attribute__((ext_vector_type(4)));
constexpr int BM = 256, BK = 64, HALF = 128, HTB = HALF * BK * 2  , STAGE_BYTES = 8 * HTB, NXCD = 8, WGM = 8;

__host__ __device__ __forceinline__ int lds_byte(int r, int c) { const int st = (r >> 4) * 2 + (c >> 5), rr = r & 15, cc = c & 31, ob = rr * 64 + cc * 2; return st * 1024 + (ob ^ (((ob >> 9) & 1) << 5)); }
__host__ __device__ __forceinline__ void stage_rc(int b, int& R, int& C) { const int st = b / 1024, sb = b % 1024, swz = sb ^ (((sb >> 9) & 1) << 5); R = (st >> 1) * 16 + swz / 64; C = (st & 1) * 32 + (swz % 64) / 2; }
__host__ __device__ __forceinline__ int perm32(int rho) { const int n = rho >> 4, i = rho & 15; return 8 * (i >> 2) + 4 * n + (i & 3); }

struct Unit { int pm, pn; };
struct Gemm { const bf16_t* A; const bf16_t* Bt; int M, N, K; };

struct StaticOrder {
    int nM, nN, nwg, G, c;
    __host__ __device__ void init(int M, int N, int G_, int c_) { nM = M / BM; nN = N / BM; nwg = nM * nN; G = G_; c = c_; }
    __host__ __device__ bool next(int i, Unit& u) const {
        const long L = (long)i * G + c; if (L >= nwg) return false;
        int wgid = (int)L; { const int q = nwg / NXCD, r = nwg % NXCD, xcd = wgid % NXCD, off = wgid / NXCD; wgid = (xcd < r ? xcd * (q + 1) : r * (q + 1) + (xcd - r) * q) + off; }
        const int nig = WGM * nN, gid = wgid / nig, fm = gid * WGM, gsz = (nM - fm) < WGM ? (nM - fm) : WGM;
        u.pm = fm + ((wgid % nig) % gsz); u.pn = (wgid % nig) / gsz; return true;
    }
    __device__ __forceinline__ void a_ready(const Unit&) const {}
    __device__ __forceinline__ void done(const Unit&) const {}
};

__device__ __forceinline__ unsigned cvt_pk_bf16(float lo, float hi) { unsigned r; asm volatile("v_cvt_pk_bf16_f32 %0, %1, %2" : "=v"(r) : "v"(lo), "v"(hi)); return r; }
typedef unsigned u32x2 __attribute__((ext_vector_type(2)));
__device__ __forceinline__ float gelu_fast(float x) {
    const float u2 = x * (1.5957691216057308f + 0.07135481627f * x * x);
    return x * __builtin_amdgcn_rcpf(1.f + __builtin_amdgcn_exp2f(-1.4426950408889634f * u2));
}
struct EpiG1 {
    static constexpr bool PERM = true, AFTER_DRAIN = false;
    bf16_t* base0; size_t split_stride; float qscale;
    __device__ __forceinline__ void operator()(const f32x4 (&acc)[2][2][4][2], const Unit& u, int wr, int wc, int fr, int fq) const {
        const int s = u.pn >> 1; bf16_t* base = base0 + (size_t)s * split_stride;
        const int row0 = u.pm * BM + wr * 64 + fr, col0 = (u.pn & 1) * 256 + wc * 32 + 8 * fq;
#pragma unroll
        for (int ai = 0; ai < 2; ++ai)
#pragma unroll
            for (int m = 0; m < 4; ++m) { bf16_t* rowp = base + (size_t)(row0 + ai * HALF + m * 16) * 512 + col0;
#pragma unroll
                for (int bj = 0; bj < 2; ++bj) { f32x4 v0 = acc[ai][bj][m][0], v1 = acc[ai][bj][m][1];
                    if (s == 1) {
#pragma unroll
                        for (int e = 0; e < 4; ++e) { v0[e] = gelu_fast(v0[e]); v1[e] = gelu_fast(v1[e]); } }
                    else if (s == 2) { v0 = v0 * qscale; v1 = v1 * qscale; }
                    u32x4 w; w.x = cvt_pk_bf16(v0[0], v0[1]); w.y = cvt_pk_bf16(v0[2], v0[3]); w.z = cvt_pk_bf16(v1[0], v1[1]); w.w = cvt_pk_bf16(v1[2], v1[3]);
                    *(u32x4*)(rowp + bj * HALF) = w; } }
    }
};
struct EpiG2 {
    static constexpr bool PERM = false, AFTER_DRAIN = false;
    const float* resid; float* out; bf16_t* xb; float* sumsq; int ldc;
    __device__ __forceinline__ void operator()(const f32x4 (&acc)[2][2][4][2], const Unit& u, int wr, int wc, int fr, int fq) const {
        const int row0 = u.pm * BM + wr * 64 + fr, col0 = u.pn * BM + wc * 32 + 4 * fq;
#pragma unroll
        for (int ai = 0; ai < 2; ++ai) {
            f32x4 rs[4][2][2];
#pragma unroll
            for (int m = 0; m < 4; ++m) { const size_t off = (size_t)(row0 + ai * HALF + m * 16) * ldc + col0;
#pragma unroll
                for (int bj = 0; bj < 2; ++bj)
#pragma unroll
                    for (int n = 0; n < 2; ++n) rs[m][bj][n] = *(const f32x4*)(resid + off + bj * HALF + n * 16); }
#pragma unroll
            for (int m = 0; m < 4; ++m) { const int r = row0 + ai * HALF + m * 16; const size_t off = (size_t)r * ldc + col0; float ss = 0.f;
#pragma unroll
                for (int bj = 0; bj < 2; ++bj)
#pragma unroll
                    for (int n = 0; n < 2; ++n) { const f32x4 x = rs[m][bj][n] + acc[ai][bj][m][n];
                        *(f32x4*)(out + off + bj * HALF + n * 16) = x; ss += (x[0] * x[0] + x[1] * x[1]) + (x[2] * x[2] + x[3] * x[3]);
                        u32x2 w; w.x = cvt_pk_bf16(x[0], x[1]); w.y = cvt_pk_bf16(x[2], x[3]); *(u32x2*)(xb + off + bj * HALF + n * 16) = w; }
                ss += __shfl_xor(ss, 16); ss += __shfl_xor(ss, 32);
                if (fq == 0) atomicAdd(sumsq + r, ss); }
            asm volatile("" ::: "memory"); }
    }
};
struct EpiG3 {
    static constexpr bool PERM = true, AFTER_DRAIN = false;
    bf16_t* O; int ldc;
    __device__ __forceinline__ void operator()(const f32x4 (&acc)[2][2][4][2], const Unit& u, int wr, int wc, int fr, int fq) const {
        const int row0 = u.pm * BM + wr * 64 + fr, col0 = u.pn * BM + wc * 32 + 8 * fq;
#pragma unroll
        for (int ai = 0; ai < 2; ++ai)
#pragma unroll
            for (int m = 0; m < 4; ++m) { bf16_t* rowp = O + (size_t)(row0 + ai * HALF + m * 16) * ldc + col0;
#pragma unroll
                for (int bj = 0; bj < 2; ++bj) { const f32x4 v0 = acc[ai][bj][m][0], v1 = acc[ai][bj][m][1];
                    u32x4 w; w.x = cvt_pk_bf16(v0[0], v0[1]); w.y = cvt_pk_bf16(v0[2], v0[3]); w.z = cvt_pk_bf16(v1[0], v1[1]); w.w = cvt_pk_bf16(v1[2], v1[3]);
                    *(u32x4*)(rowp + bj * HALF) = w; } }
    }
};

template <class Epi, class Sched, bool ALIGN_EPI = false, bool SP2 = false>
__device__ __forceinline__ void gemm_phase(PG8_LAS unsigned char* lds, const Gemm g, const Sched& S, const Epi& E, int wid_in) {
    const int wid = __builtin_amdgcn_readfirstlane(wid_in), lane = (int)__builtin_amdgcn_mbcnt_hi(~0u, __builtin_amdgcn_mbcnt_lo(~0u, 0u)), tid = wid * 64 + lane, wr = wid >> 2, wc = wid & 3, fr = lane & 15, fq = lane >> 4;
    const int K = g.K, nt = K / BK;
    unsigned voffA[2], voffB[2];
#pragma unroll
    for (int i = 0; i < 2; ++i) { int R, C; stage_rc(tid * 16 + i * 8192, R, C); const int Rb = Epi::PERM ? ((R & ~31) + perm32(R & 31)) : R;
        voffA[i] = (unsigned)(R * K + C) * 2u; voffB[i] = (unsigned)(Rb * K + C) * 2u; }
    const size_t kstep = (size_t)(BK * 2);
    const size_t hstep = (size_t)HALF * K * 2;
    const size_t tstep = 2 * hstep;
    const unsigned ldsw = (unsigned)wid * 1024u;
    const int aoff = lds_byte(wr * 64 + fr, fq * 8), boff = lds_byte(wc * 32 + fr, fq * 8);
#define PG8_SA(b, h) (((b) * 2 + (h)) * HTB)
#define PG8_SB(b, h) ((4 + (b) * 2 + (h)) * HTB)
#define PG8_STAGE(bufoff, gbase, voff) do { _Pragma("unroll") for (int _i = 0; _i < 2; ++_i) \
        __builtin_amdgcn_global_load_lds((const unsigned*)((const char*)(gbase) + (voff)[_i]), (PG8_LAS unsigned*)(lds + (bufoff) + ldsw + _i * 8192), 16, 0, 0); } while (0)
#define PG8_LDA(dst, b, h) do { _Pragma("unroll") for (int m = 0; m < 4; ++m) _Pragma("unroll") for (int k = 0; k < 2; ++k) dst[m][k] = *(const PG8_LAS bf16x8*)(lds + PG8_SA(b, h) + aoff + m * 2048 + k * 1024); } while (0)
#define PG8_LDB(dst, b, h) do { _Pragma("unroll") for (int n = 0; n < 2; ++n) _Pragma("unroll") for (int k = 0; k < 2; ++k) dst[n][k] = *(const PG8_LAS bf16x8*)(lds + PG8_SB(b, h) + boff + n * 2048 + k * 1024); } while (0)
#define PG8_MMA(ai, bj, At, Bt) do { __builtin_amdgcn_s_setprio(1); _Pragma("unroll") for (int m = 0; m < 4; ++m) _Pragma("unroll") for (int n = 0; n < 2; ++n) _Pragma("unroll") for (int k = 0; k < 2; ++k) \
        acc[ai][bj][m][n] = __builtin_amdgcn_mfma_f32_16x16x32_bf16(Bt[n][k], At[m][k], acc[ai][bj][m][n], 0, 0, 0); __builtin_amdgcn_s_setprio(0); } while (0)
#define PG8_WAIT_V(n) asm volatile("s_waitcnt vmcnt(" #n ")" ::: "memory")
#define PG8_WAIT_L(n) asm volatile("s_waitcnt lgkmcnt(" #n ")" ::: "memory")
#define PG8_BAR __builtin_amdgcn_s_barrier()
#define PG8_SCHED __builtin_amdgcn_sched_barrier(0)
    Unit cur, nxt; int ui = 0;
    if (!S.next(0, cur)) return;
    f32x4 acc[2][2][4][2];
#pragma unroll
    for (int a = 0; a < 2; ++a)
#pragma unroll
        for (int b = 0; b < 2; ++b)
#pragma unroll
            for (int m = 0; m < 4; ++m)
#pragma unroll
                for (int n = 0; n < 2; ++n) acc[a][b][m][n] = (f32x4){0.f, 0.f, 0.f, 0.f};
    bf16x8 At[4][2], B0[2][2], B1[2][2];
    const char* cA = (const char*)g.A + (size_t)cur.pm * tstep; const char* cB = (const char*)g.Bt + (size_t)cur.pn * tstep;
    S.a_ready(cur);
    if constexpr (SP2) {
        PG8_STAGE(PG8_SB(0, 0), cB, voffB); PG8_STAGE(PG8_SB(0, 1), cB + hstep, voffB); PG8_STAGE(PG8_SA(0, 0), cA, voffA); PG8_STAGE(PG8_SA(0, 1), cA + hstep, voffA);
        if (wr == 1) PG8_BAR;
        PG8_WAIT_V(2); PG8_BAR;
        PG8_STAGE(PG8_SB(1, 0), cB + kstep, voffB); PG8_STAGE(PG8_SA(1, 0), cA + kstep, voffA); PG8_STAGE(PG8_SB(1, 1), cB + hstep + kstep, voffB);
        PG8_WAIT_V(6); PG8_BAR;
    } else {
        PG8_STAGE(PG8_SB(0, 0), cB, voffB); PG8_STAGE(PG8_SA(0, 0), cA, voffA); PG8_STAGE(PG8_SB(0, 1), cB + hstep, voffB); PG8_STAGE(PG8_SA(0, 1), cA + hstep, voffA);
        if (wr == 1) PG8_BAR;
        PG8_WAIT_V(4); PG8_BAR;
        PG8_STAGE(PG8_SB(1, 0), cB + kstep, voffB); PG8_STAGE(PG8_SA(1, 0), cA + kstep, voffA); PG8_STAGE(PG8_SB(1, 1), cB + hstep + kstep, voffB);
        PG8_WAIT_V(6); PG8_BAR;
    }
    for (;;) {
        const bool has_next = S.next(ui + 1, nxt);
        const char* nA = has_next ? (const char*)g.A + (size_t)nxt.pm * tstep : cA; const char* nB = has_next ? (const char*)g.Bt + (size_t)nxt.pn * tstep : cB;
        for (int t = 0; t < nt; t += 2) {
            const bool last = (t == nt - 2);
            const char* a1 = cA + (size_t)(t + 1) * kstep;
            const char* a2 = last ? nA : cA + (size_t)(t + 2) * kstep; const char* b2 = last ? nB : cB + (size_t)(t + 2) * kstep;
            const char* a3 = a2 + kstep; const char* b3 = b2 + kstep;
            if (last && has_next) S.a_ready(nxt);
            if constexpr (SP2) {
            PG8_LDB(B0, 0, 0); PG8_LDB(B1, 0, 1); PG8_SCHED; PG8_LDA(At, 0, 0); PG8_STAGE(PG8_SA(1, 1), a1 + hstep, voffA);
            PG8_WAIT_V(8); PG8_WAIT_L(0); PG8_BAR; PG8_MMA(0, 0, At, B0); PG8_MMA(0, 1, At, B1); PG8_BAR; PG8_SCHED;
            PG8_LDA(At, 0, 1); PG8_STAGE(PG8_SB(0, 0), b2, voffB); PG8_STAGE(PG8_SB(0, 1), b2 + hstep, voffB); PG8_STAGE(PG8_SA(0, 0), a2, voffA);
            PG8_WAIT_V(8); PG8_WAIT_L(0); PG8_BAR; PG8_MMA(1, 0, At, B0); PG8_MMA(1, 1, At, B1); PG8_BAR; PG8_SCHED;
            PG8_LDB(B0, 1, 0); PG8_LDB(B1, 1, 1); PG8_SCHED; PG8_LDA(At, 1, 0); PG8_STAGE(PG8_SA(0, 1), a2 + hstep, voffA);
            PG8_WAIT_V(8); PG8_WAIT_L(0); PG8_BAR; PG8_MMA(0, 0, At, B0); PG8_MMA(0, 1, At, B1); PG8_BAR; PG8_SCHED;
            PG8_LDA(At, 1, 1); PG8_STAGE(PG8_SB(1, 0), b3, voffB); PG8_STAGE(PG8_SB(1, 1), b3 + hstep, voffB); PG8_STAGE(PG8_SA(1, 0), a3, voffA);
            PG8_WAIT_V(8); PG8_WAIT_L(0); PG8_BAR; PG8_MMA(1, 0, At, B0); PG8_MMA(1, 1, At, B1); PG8_BAR; PG8_SCHED;
            } else {
            PG8_LDB(B0, 0, 0); PG8_SCHED; PG8_LDA(At, 0, 0); PG8_STAGE(PG8_SA(1, 1), a1 + hstep, voffA);
            PG8_WAIT_L(8); PG8_BAR; PG8_WAIT_L(0); PG8_MMA(0, 0, At, B0); PG8_BAR; PG8_SCHED;
            PG8_LDB(B1, 0, 1); PG8_STAGE(PG8_SB(0, 0), b2, voffB);
            PG8_BAR; PG8_WAIT_L(0); PG8_MMA(0, 1, At, B1); PG8_BAR;
            PG8_LDA(At, 0, 1); PG8_STAGE(PG8_SA(0, 0), a2, voffA);
            PG8_BAR; PG8_WAIT_L(0); PG8_MMA(1, 0, At, B0); PG8_BAR; PG8_SCHED;
            PG8_STAGE(PG8_SB(0, 1), b2 + hstep, voffB);
            PG8_WAIT_V(6); PG8_BAR; PG8_MMA(1, 1, At, B1); PG8_BAR;
            PG8_LDB(B0, 1, 0); PG8_SCHED; PG8_LDA(At, 1, 0); PG8_STAGE(PG8_SA(0, 1), a2 + hstep, voffA);
            PG8_WAIT_L(8); PG8_BAR; PG8_WAIT_L(0); PG8_MMA(0, 0, At, B0); PG8_BAR; PG8_SCHED;
            PG8_LDB(B1, 1, 1); PG8_STAGE(PG8_SB(1, 0), b3, voffB);
            PG8_BAR; PG8_WAIT_L(0); PG8_MMA(0, 1, At, B1); PG8_BAR;
            PG8_LDA(At, 1, 1); PG8_STAGE(PG8_SA(1, 0), a3, voffA);
            PG8_BAR; PG8_WAIT_L(0); PG8_MMA(1, 0, At, B0); PG8_BAR; PG8_SCHED;
            PG8_STAGE(PG8_SB(1, 1), b3 + hstep, voffB);
            PG8_WAIT_V(6); PG8_BAR; PG8_MMA(1, 1, At, B1); PG8_BAR;
            }
        }
        if constexpr (ALIGN_EPI) { if (wr == 0) PG8_BAR; }
        if constexpr (!Epi::AFTER_DRAIN) { E(acc, cur, wr, wc, fr, fq); S.done(cur); }
        if (!has_next) break;
#pragma unroll
        for (int a = 0; a < 2; ++a)
#pragma unroll
            for (int b = 0; b < 2; ++b)
#pragma unroll
                for (int m = 0; m < 4; ++m)
#pragma unroll
                    for (int n = 0; n < 2; ++n) acc[a][b][m][n] = (f32x4){0.f, 0.f, 0.f, 0.f};
        cur = nxt; cA = nA; cB = nB; ++ui;
        if constexpr (ALIGN_EPI) { if (wr == 1) PG8_BAR; }
    }
    PG8_WAIT_V(0);
    if constexpr (!ALIGN_EPI) { if (wr == 0) PG8_BAR; }
    PG8_BAR;
    if constexpr (Epi::AFTER_DRAIN) { E.fused(acc, cur, wr, wc, fr, fq, lds, wid, lane); S.done(cur); }
#undef PG8_SA
#undef PG8_SB
#undef PG8_STAGE
#undef PG8_LDA
#undef PG8_LDB
#undef PG8_MMA
#undef PG8_WAIT_V
#undef PG8_WAIT_L
#undef PG8_BAR
#undef PG8_SCHED
}
}
#include <hip/hip_bf16.h>
#include <cmath>
namespace attn_body {
using bf16=__hip_bfloat16;
using bf16x8=__attribute__((ext_vector_type(8)))short;
using s16x4=__attribute__((ext_vector_type(4)))short;
using f32x16=__attribute__((ext_vector_type(16)))float;
using u32x4=__attribute__((ext_vector_type(4)))unsigned;
constexpr int BATCH=4,NHEAD=8,SEQ=8192,D=64,DM=NHEAD*D;
constexpr int NW=8,QBLK=32,QB=QBLK*NW,KVBLK=64,NQB=SEQ/QB;
constexpr int ATTN_PITCH=DM, ATTN_UNIT_ROWS=QB;
__device__ __forceinline__ int crow(int r,int hi){return (r&3)+8*(r>>2)+4*hi;}
#define SBAR() __builtin_amdgcn_sched_barrier(0)
__device__ __forceinline__ void cmask(f32x16&p0,f32x16&p1,int jb,int qrel,int hi){
  const float NEG=-INFINITY; int kb=64*jb+4*hi;
  #pragma unroll
  for(int r=0;r<16;++r){int kv=kb+(r&3)+8*(r>>2); if(kv>qrel)p0[r]=NEG; if(kv+32>qrel)p1[r]=NEG;}
}

constexpr int NSLOT=3, SLOTB=8192;
constexpr int LDS_K=0, LDS_V=NSLOT*SLOTB, LDS_WS=2*NSLOT*SLOTB, LDS_OST=LDS_WS+NW*64*4, LDS_FK=LDS_OST+NW*4096, LDS_BYTES=LDS_FK+SEQ*4;
constexpr float C2=0.125f*1.4426950408889634f;
__device__ __forceinline__ void glds16(const void*gsrc,unsigned lds_dst){unsigned keep;
  asm volatile("s_mov_b32 %0, m0\n\ts_mov_b32 m0, %2\n\ts_nop 0\n\tglobal_load_lds_dwordx4 %1, off\n\ts_mov_b32 m0, %0":"=&s"(keep):"v"(gsrc),"s"(lds_dst):"memory");}
__device__ __forceinline__ float max3f(float a,float b,float c){float r;asm("v_max3_f32 %0, %1, %2, %3":"=v"(r):"v"(a),"v"(b),"v"(c));return r;}
__device__ __forceinline__ float max2f(float a,float b){float r;asm("v_max_f32_e32 %0, %1, %2":"=v"(r):"v"(a),"v"(b));return r;}
__device__ __forceinline__ float fadd_s(float a,float b){float r;asm("v_add_f32_e32 %0, %1, %2":"=v"(r):"v"(a),"v"(b));return r;}
__device__ __forceinline__ float fsub_s(float a,float b){float r;asm("v_sub_f32_e32 %0, %1, %2":"=v"(r):"v"(a),"v"(b));return r;}
typedef float f32x2_t __attribute__((ext_vector_type(2))); typedef __bf16 bf16x2_t __attribute__((ext_vector_type(2)));
__device__ __forceinline__ unsigned cvtpk_s(float lo,float hi){f32x2_t v={lo,hi};bf16x2_t b=__builtin_convertvector(v,bf16x2_t);return __builtin_bit_cast(unsigned,b);}
#define WAIT_BAR(N) asm volatile("s_waitcnt vmcnt(" #N ") lgkmcnt(0)\n\ts_barrier":::"memory")

__device__ __forceinline__ void qkt(f32x16&p0,f32x16&p1,const char*Kslot,const bf16x8*qr,int r32,int hi){
  const char*kb=Kslot+hi*1024+r32*16;
  #pragma unroll
  for(int d0=0;d0<4;++d0){
    const bf16x8 b0=*reinterpret_cast<const bf16x8*>(kb+d0*2048);
    const bf16x8 b1=*reinterpret_cast<const bf16x8*>(kb+d0*2048+512);
    p0=__builtin_amdgcn_mfma_f32_32x32x16_bf16(b0,qr[d0],p0,0,0,0);p1=__builtin_amdgcn_mfma_f32_32x32x16_bf16(b1,qr[d0],p1,0,0,0);}
}
typedef __attribute__((address_space(3))) const char* lds_cptr;
typedef short v4i16_t __attribute__((ext_vector_type(4)));
__device__ __forceinline__ void kload8(bf16x8*kf,lds_cptr kp){
  kf[0]=*(const __attribute__((address_space(3))) bf16x8*)(kp);      kf[1]=*(const __attribute__((address_space(3))) bf16x8*)(kp+512);
  kf[2]=*(const __attribute__((address_space(3))) bf16x8*)(kp+2048); kf[3]=*(const __attribute__((address_space(3))) bf16x8*)(kp+2560);
  kf[4]=*(const __attribute__((address_space(3))) bf16x8*)(kp+4096); kf[5]=*(const __attribute__((address_space(3))) bf16x8*)(kp+4608);
  kf[6]=*(const __attribute__((address_space(3))) bf16x8*)(kp+6144); kf[7]=*(const __attribute__((address_space(3))) bf16x8*)(kp+6656);
}
__device__ __forceinline__ void kload2(bf16x8*kf,lds_cptr kp,int j){ kf[2*j]=*(const __attribute__((address_space(3))) bf16x8*)(kp+j*2048); kf[2*j+1]=*(const __attribute__((address_space(3))) bf16x8*)(kp+j*2048+512); }
__device__ __forceinline__ s16x4 vtr(lds_cptr p){ return __builtin_bit_cast(s16x4,__builtin_amdgcn_ds_read_tr16_b64_v4i16((__attribute__((address_space(3))) v4i16_t*)p)); }
__device__ __forceinline__ float rowmax(const f32x16&p0,const f32x16&p1){
  float a=max3f(p0[0],p0[1],p1[0]),b=max3f(p0[2],p0[3],p1[1]);a=max3f(a,p1[2],p1[3]);
  #pragma unroll
  for(int r=4;r<16;r+=4){a=max3f(a,p0[r],p0[r+1]);b=max3f(b,p0[r+2],p0[r+3]);a=max3f(a,p1[r],p1[r+1]);b=max3f(b,p1[r+2],p1[r+3]);}
  const float m=max2f(a,b);
  auto rr=__builtin_amdgcn_permlane32_swap(__float_as_uint(m),__float_as_uint(m),false,false);
  return max2f(__uint_as_float(rr[0]),__uint_as_float(rr[1]));
}
__device__ __forceinline__ void pv(f32x16*o,int vb,bf16x8 pa0,bf16x8 pa1,bf16x8 pa2,bf16x8 pa3){
  #pragma unroll
  for(int d0=0;d0<2;++d0){s16x4 lo[4],hi[4];
    #pragma unroll
    for(int ks=0;ks<4;++ks){
      asm volatile("ds_read_b64_tr_b16 %0,%1 offset:%c2":"=&v"(lo[ks]):"v"(vb),"i"(d0*4096+ks*1024):"memory");
      asm volatile("ds_read_b64_tr_b16 %0,%1 offset:%c2":"=&v"(hi[ks]):"v"(vb),"i"(d0*4096+ks*1024+512):"memory");}
    asm volatile("s_waitcnt lgkmcnt(0)":::"memory");SBAR();
    #define PK(k) (bf16x8){lo[k][0],lo[k][1],lo[k][2],lo[k][3],hi[k][0],hi[k][1],hi[k][2],hi[k][3]}
    o[d0]=__builtin_amdgcn_mfma_f32_32x32x16_bf16(pa0,PK(0),o[d0],0,0,0);
    o[d0]=__builtin_amdgcn_mfma_f32_32x32x16_bf16(pa1,PK(1),o[d0],0,0,0);
    o[d0]=__builtin_amdgcn_mfma_f32_32x32x16_bf16(pa2,PK(2),o[d0],0,0,0);
    o[d0]=__builtin_amdgcn_mfma_f32_32x32x16_bf16(pa3,PK(3),o[d0],0,0,0);
    #undef PK
  }
}

#ifndef ATTN_STORE16
#define ATTN_STORE16(p,v) (*(u32x4*)(p)=(v))
#endif
template<int THRL> __device__ __forceinline__ void attn_unit(int b,int h,int qb,const bf16*Q,const bf16*__restrict__ K,const bf16*__restrict__ V,bf16*O,const float*__restrict__ Fc,const float*__restrict__ NRM,char*shm,int wid_in){
  const int wid=__builtin_amdgcn_readfirstlane(wid_in); int lane_=(int)__builtin_amdgcn_mbcnt_hi(~0u,__builtin_amdgcn_mbcnt_lo(~0u,0u)); asm volatile("":"+v"(lane_));
  const int lane=lane_,tid=wid*64+lane,r32=lane&31,hi=lane>>5;
  const long rowbase=(long)b*SEQ; const int q0=qb*QB;
  const float*Fbh=Fc+(long)(b*NHEAD+h)*SEQ;
  const int NTF=(q0+QB)/KVBLK; int t_start;
  { const float*QNb=NRM+(b*NHEAD+h)*128,*KNb=NRM+4096+(b*NHEAD+h)*128;
    const float qn=fmaxf(fmaxf(QNb[4*qb],QNb[4*qb+1]),fmaxf(QNb[4*qb+2],QNb[4*qb+3])),knb=fmaxf(fmaxf(KNb[4*qb],KNb[4*qb+1]),fmaxf(KNb[4*qb+2],KNb[4*qb+3]));
    const float fq0=Fbh[q0]*1.4426950408889634f; bool k0=true,k1=true;
    if(lane<NTF-4)k0=!(qn*(KNb[lane]+knb)+(fq0-Fbh[64*lane+63]*1.4426950408889634f)<-40.f);
    if(lane+64<NTF-4)k1=!(qn*(KNb[lane+64]+knb)+(fq0-Fbh[64*(lane+64)+63]*1.4426950408889634f)<-40.f);
    const unsigned long long m0=__ballot(k0),m1=__ballot(k1);
    int tf=m0?(int)__builtin_ctzll(m0):64+(m1?(int)__builtin_ctzll(m1):64);
    tf=tf<NTF-4?tf:NTF-4; t_start=__builtin_amdgcn_readfirstlane(tf&~1); }
  { typedef float f32x4_t __attribute__((ext_vector_type(4))); __attribute__((address_space(3))) float*fk=(__attribute__((address_space(3))) float*)((__attribute__((address_space(3))) char*)shm+LDS_FK); const int n4=(q0+QB)/4;
    for(int i=16*t_start+tid;i<n4;i+=NW*64){ f32x4_t v=*(const f32x4_t*)(Fbh+4*i); v=v*(-1.4426950408889634f); *(__attribute__((address_space(3))) f32x4_t*)(fk+4*i)=v; } }
  float fq2=Fbh[q0+wid*QBLK+r32]*1.4426950408889634f; asm volatile("":"+v"(fq2));
  const bf16*Qw=Q+(rowbase+q0+wid*QBLK)*DM+h*D;
  const bf16*Kh=K+(rowbase+(long)t_start*KVBLK)*DM+h*D,*Vh=V+(rowbase+(long)t_start*KVBLK)*DM+h*D;
  const lds_cptr shm3=(lds_cptr)shm;
  const unsigned lds0=(unsigned)(uintptr_t)shm;
  float*wsf=(float*)(shm+LDS_WS)+wid*64;
  const bf16*ksrc=Kh+(long)lane*DM+wid*8;
  const bf16*vsrc=Vh+(long)(16*(wid&3)+(lane>>2))*DM+(wid>>2)*32+(lane&3)*8;
  const unsigned kdst=lds0+LDS_K+wid*1024, vdst=lds0+LDS_V+wid*1024;
  #define DMA_K(t,slot) glds16(ksrc+(long)(t)*KVBLK*DM,(unsigned)__builtin_amdgcn_readfirstlane(kdst+(slot)))
  #define DMA_V(t,slot) glds16(vsrc+(long)(t)*KVBLK*DM,(unsigned)__builtin_amdgcn_readfirstlane(vdst+(slot)))
  const int vb0=(int)(lds0+LDS_V)+((lane>>4)&1)*32+(lane&3)*8+(4*hi+((lane&15)>>2))*64;
  const char*Kbase=shm+LDS_K; bf16x8 kf[8];
  const lds_cptr kp0=shm3+LDS_K+hi*1024+r32*16; const lds_cptr vp0=shm3+LDS_V+((lane>>4)&1)*32+(lane&3)*8+(4*hi+((lane&15)>>2))*64;
  const int NT=NTF-t_start;
  DMA_K(0,0);DMA_V(0,0);DMA_K(1,SLOTB);
  bf16x8 qr[4];
  #pragma unroll
  for(int d0=0;d0<4;++d0)qr[d0]=*reinterpret_cast<const bf16x8*>(&Qw[(long)r32*DM+d0*16+hi*8]);
  float mhat=0.f,l_reg=0.f;f32x16 o[2];o[0]=f32x16{};o[1]=f32x16{};
  const __attribute__((address_space(3))) float*fkl=(const __attribute__((address_space(3))) float*)(shm3+LDS_FK)+64*t_start+4*hi;
  #define INITC(C0,C1,t) do{ const float nsc_=fq2-mhat; typedef float f32x4_t __attribute__((ext_vector_type(4))); const __attribute__((address_space(3))) float*kb_=fkl+64*(t); \
    _Pragma("unroll") for(int g_=0;g_<4;++g_){ const f32x4_t a_=*(const __attribute__((address_space(3))) f32x4_t*)(kb_+8*g_), b_=*(const __attribute__((address_space(3))) f32x4_t*)(kb_+32+8*g_); \
      _Pragma("unroll") for(int e_=0;e_<4;++e_){ C0[4*g_+e_]=nsc_+a_[e_]; C1[4*g_+e_]=nsc_+b_[e_]; } } }while(0)
  const int qrel=wid*QBLK+r32;
  #define CMASK(P0,P1,t) do{int jb_=(t)-(NT-4); if(jb_>=0)cmask(P0,P1,jb_,qrel,hi);}while(0)
  bool resc=false;
  #define START(P0,P1) do{ const float rm=rowmax(P0,P1); resc=false; \
    { const float dl=rm; mhat=fadd_s(mhat,dl); \
      _Pragma("unroll") for(int r=0;r<16;++r){P0[r]=fsub_s(P0[r],dl);P1[r]=fsub_s(P1[r],dl);} \
      } \
    _Pragma("unroll") for(int r=0;r<16;++r)P0[r]=__builtin_amdgcn_exp2f(P0[r]); }while(0)
  #define RESC() do{ if(resc){ asm volatile("s_waitcnt lgkmcnt(0)":::"memory"); \
      _Pragma("unroll") for(int d_=0;d_<2;++d_) _Pragma("unroll") for(int r=0;r<16;++r)o[d_][r]*=wsf[crow(r,hi)]; } }while(0)
  f32x16 pA0,pA1,pB0,pB1;
  int sl_prev=0,sl_cur=0,sl_next=SLOTB;
  #define ROT() do{sl_prev=sl_cur;sl_cur=sl_next;sl_next=(sl_next==(NSLOT-1)*SLOTB)?0:sl_next+SLOTB;}while(0)
  DMA_K(2,2*SLOTB);
  WAIT_BAR(3);
  INITC(pA0,pA1,0); qkt(pA0,pA1,Kbase,qr,r32,hi);asm volatile("s_nop 15\n\ts_nop 7":"+v"(pA0),"+v"(pA1));CMASK(pA0,pA1,0);
  START(pA0,pA1);
  _Pragma("unroll") for(int r=0;r<16;++r)pA1[r]=__builtin_amdgcn_exp2f(pA1[r]);
  WAIT_BAR(0);
  DMA_K(3,0);DMA_V(1,SLOTB);
  ROT();
  kload8(kf,kp0+sl_cur);
  WAIT_BAR(2);
  s16x4 vlo[8],vhi[8]; u32x4 pw0,pw1,pw2,pw3;
  #define PKW(P,B) cvtpk_s(P[B],P[B+1])
  #define PAF(k) __builtin_bit_cast(bf16x8,pw##k)
  #define VFR(i) (bf16x8){vlo[i][0],vlo[i][1],vlo[i][2],vlo[i][3],vhi[i][0],vhi[i][1],vhi[i][2],vhi[i][3]}
  #define PIN(x) asm volatile("":"+v"(x))
  #define MX3(a,b,c) __builtin_fmaxf(__builtin_fmaxf((a),(b)),(c))
  #define GAPA(MF,A0,A1,A2,A3,W0,W1,PW) do{ MF; sacc+=A0; sacc+=A1; sacc+=A2; sacc+=A3; PIN(sacc); W0; W1; PIN(PW); SBAR(); }while(0)
  #define EX(v) __builtin_amdgcn_exp2f(v)
  #define GAPB(MF,X,B) do{ MF; X[B]=EX(X[B]); X[B+1]=EX(X[B+1]); X[B+2]=EX(X[B+2]); X[B+3]=EX(X[B+3]); PIN(X); SBAR(); }while(0)
  #define VRD(i) do{ vlo[i]=vtr(vp_+(((i)>>2)*4096+((i)&3)*1024)); vhi[i]=vtr(vp_+(((i)>>2)*4096+((i)&3)*1024+512)); }while(0)
  #define KRD(G,j) do{ if(G){ kload2(kf,kp0+sl_next,j); SBAR(); } }while(0)
  #define STEP(C0,C1,P0,P1,t,GK,GV,GL) do{ SBAR(); INITC(C0,C1,t); PIN(C0); PIN(C1); SBAR(); \
    const lds_cptr vp_=vp0+sl_prev; \
    VRD(0); SBAR(); float sacc=(P0[0]+P0[1]); \
    GAPA(C0=__builtin_amdgcn_mfma_f32_32x32x16_bf16(kf[0],qr[0],C0,0,0,0), P0[2],P0[3],P0[4],P0[5],     pw0[0]=PKW(P0,0), pw0[1]=PKW(P0,2), pw0); \
    VRD(4); SBAR(); GAPA(C1=__builtin_amdgcn_mfma_f32_32x32x16_bf16(kf[1],qr[0],C1,0,0,0), P0[6],P0[7],P0[8],P0[9],     pw0[2]=PKW(P0,4), pw0[3]=PKW(P0,6), pw0); \
    VRD(1); SBAR(); GAPA(C0=__builtin_amdgcn_mfma_f32_32x32x16_bf16(kf[2],qr[1],C0,0,0,0),   P0[10],P0[11],P0[12],P0[13], pw1[0]=PKW(P0,8), pw1[1]=PKW(P0,10), pw1); \
    VRD(5); SBAR(); GAPA(C1=__builtin_amdgcn_mfma_f32_32x32x16_bf16(kf[3],qr[1],C1,0,0,0),   P0[14],P0[15],P1[0],P1[1],   pw1[2]=PKW(P0,12),pw1[3]=PKW(P0,14), pw1); \
    VRD(2); SBAR(); GAPA(C0=__builtin_amdgcn_mfma_f32_32x32x16_bf16(kf[4],qr[2],C0,0,0,0),   P1[2],P1[3],P1[4],P1[5],     pw2[0]=PKW(P1,0), pw2[1]=PKW(P1,2), pw2); \
    VRD(6); SBAR(); GAPA(C1=__builtin_amdgcn_mfma_f32_32x32x16_bf16(kf[5],qr[2],C1,0,0,0),   P1[6],P1[7],P1[8],P1[9],     pw2[2]=PKW(P1,4), pw2[3]=PKW(P1,6), pw2); \
    VRD(3); SBAR(); GAPA(C0=__builtin_amdgcn_mfma_f32_32x32x16_bf16(kf[6],qr[3],C0,0,0,0),   P1[10],P1[11],P1[12],P1[13], pw3[0]=PKW(P1,8), pw3[1]=PKW(P1,10), pw3); \
    VRD(7); SBAR(); GAPA(C1=__builtin_amdgcn_mfma_f32_32x32x16_bf16(kf[7],qr[3],C1,0,0,0),   P1[14],P1[15],0.f,0.f,       pw3[2]=PKW(P1,12),pw3[3]=PKW(P1,14), pw3); \
    l_reg+=sacc; \
    if(GK){DMA_K((t)+3,sl_cur);} if(GV){DMA_V((t)+1,sl_next);} \
    CMASK(C0,C1,t); \
    { float a=MX3(C0[0],C0[1],C1[0]),b=MX3(C0[2],C0[3],C1[1]); a=MX3(a,C1[2],C1[3]); \
      _Pragma("unroll") for(int r=4;r<16;r+=4){a=MX3(a,C0[r],C0[r+1]);b=MX3(b,C0[r+2],C0[r+3]);a=MX3(a,C1[r],C1[r+1]);b=MX3(b,C1[r+2],C1[r+3]);} \
      float rm=__builtin_fmaxf(a,b); { auto rr=__builtin_amdgcn_permlane32_swap(__float_as_uint(rm),__float_as_uint(rm),false,false); rm=__builtin_fmaxf(__uint_as_float(rr[0]),__uint_as_float(rr[1])); } \
      resc=false; \
      if(__builtin_expect(__any(rm>(float)THRL),0)){ const float dl=__builtin_fmaxf(rm,0.f); mhat+=dl; \
        _Pragma("unroll") for(int r=0;r<16;++r){C0[r]-=dl;C1[r]-=dl;} \
        const float f=__builtin_amdgcn_exp2f(-dl); l_reg*=f; if(hi==0)wsf[r32]=f; resc=true; } } \
    SBAR(); \
    GAPB(o[0]=__builtin_amdgcn_mfma_f32_32x32x16_bf16(PAF(0),VFR(0),o[0],0,0,0), C0,0); \
    GAPB(o[1]=__builtin_amdgcn_mfma_f32_32x32x16_bf16(PAF(0),VFR(4),o[1],0,0,0), C0,4); \
    KRD(GL,0); GAPB(o[0]=__builtin_amdgcn_mfma_f32_32x32x16_bf16(PAF(1),VFR(1),o[0],0,0,0), C0,8); \
    KRD(GL,1); GAPB(o[1]=__builtin_amdgcn_mfma_f32_32x32x16_bf16(PAF(1),VFR(5),o[1],0,0,0), C0,12); \
    KRD(GL,2); GAPB(o[0]=__builtin_amdgcn_mfma_f32_32x32x16_bf16(PAF(2),VFR(2),o[0],0,0,0), C1,0); \
    KRD(GL,3); GAPB(o[1]=__builtin_amdgcn_mfma_f32_32x32x16_bf16(PAF(2),VFR(6),o[1],0,0,0), C1,4); \
    GAPB(o[0]=__builtin_amdgcn_mfma_f32_32x32x16_bf16(PAF(3),VFR(3),o[0],0,0,0), C1,8); \
    GAPB(o[1]=__builtin_amdgcn_mfma_f32_32x32x16_bf16(PAF(3),VFR(7),o[1],0,0,0), C1,12); \
    }while(0)
  int t=1;
  #undef CMASK
  #define CMASK(P0,P1,t) do{}while(0)
  for(;t+5<NT;t+=2){
    STEP(pB0,pB1,pA0,pA1,t,true,true,true);     WAIT_BAR(2); RESC(); ROT();
    STEP(pA0,pA1,pB0,pB1,t+1,true,true,true);   WAIT_BAR(2); RESC(); ROT();
  }
  #undef CMASK
  #define CMASK(P0,P1,t) do{int jb_=(t)-(NT-4); if(jb_>=0)cmask(P0,P1,jb_,qrel,hi);}while(0)
  #define ENDW(tt) do{ if((tt)+3<NT){WAIT_BAR(2);} else if((tt)+2<NT){WAIT_BAR(1);} else {WAIT_BAR(0);} }while(0)
  for(;t+1<NT;t+=2){
    STEP(pB0,pB1,pA0,pA1,t,(t+3<NT),(t+1<NT),(t+1<NT));       ENDW(t);   RESC(); ROT();
    STEP(pA0,pA1,pB0,pB1,t+1,(t+4<NT),(t+2<NT),(t+2<NT));     ENDW(t+1); RESC(); ROT();
  }
  STEP(pB0,pB1,pA0,pA1,NT-1,false,false,false); RESC();
  { float sacc=pB0[0]+pB0[1]; _Pragma("unroll") for(int r=2;r<16;++r)sacc+=pB0[r]; _Pragma("unroll") for(int r=0;r<16;++r)sacc+=pB1[r]; l_reg+=sacc;
    pw0=(u32x4){PKW(pB0,0),PKW(pB0,2),PKW(pB0,4),PKW(pB0,6)};pw1=(u32x4){PKW(pB0,8),PKW(pB0,10),PKW(pB0,12),PKW(pB0,14)};pw2=(u32x4){PKW(pB1,0),PKW(pB1,2),PKW(pB1,4),PKW(pB1,6)};pw3=(u32x4){PKW(pB1,8),PKW(pB1,10),PKW(pB1,12),PKW(pB1,14)};
    SBAR(); pv(o,vb0+sl_cur,PAF(0),PAF(1),PAF(2),PAF(3)); }
  #undef PKW
  #undef PAF
  #undef VFR
  #undef PIN
  #undef MX3
  #undef GAPA
  #undef GAPB
  #undef EX
  #undef VRD
  #undef KRD
  #undef STEP
  #undef ENDW
  {auto rr=__builtin_amdgcn_permlane32_swap(__float_as_uint(l_reg),__float_as_uint(l_reg),false,false);l_reg=__uint_as_float(rr[0])+__uint_as_float(rr[1]);}
  if(hi==0)wsf[32+r32]=l_reg;asm volatile("s_waitcnt lgkmcnt(0)":::"memory");
  float rli[16];
  #pragma unroll
  for(int r=0;r<16;++r)rli[r]=__builtin_amdgcn_rcpf(wsf[32+crow(r,hi)]);
  bf16*Ow=O+(rowbase+q0+wid*QBLK)*DM+h*D;
  { bf16*stg=(bf16*)(shm+LDS_OST)+wid*2048;
    #pragma unroll
    for(int r=0;r<16;++r){const int orow=crow(r,hi);
      #pragma unroll
      for(int d0=0;d0<2;++d0)stg[orow*64+d0*32+r32]=__float2bfloat16(o[d0][r]*rli[r]);}
    asm volatile("s_waitcnt lgkmcnt(0)":::"memory");
    #pragma unroll
    for(int i=0;i<4;++i){const int row=i*8+(lane>>3),ch=lane&7; const u32x4 v=*(const u32x4*)(stg+row*64+ch*8); ATTN_STORE16(Ow+(long)row*DM+ch*8,v);} }
  asm volatile("s_waitcnt lgkmcnt(0)\n\ts_barrier":::"memory");
  #undef DMA_K
  #undef DMA_V
  #undef INITC
  #undef CMASK
  #undef START
  #undef RESC
  #undef ROT
}
constexpr int ATTN_LDS_BYTES=LDS_BYTES;
struct AttnTensors { const bf16* Q; const bf16* K; const bf16* V; bf16* O; const float* F; const float* NRM; };
struct AttnUnit { int bh; int qb; };
struct StaticOrder {
  int vcu;
  __device__ __forceinline__ explicit StaticOrder(int grid,int block):vcu((block%8)*(grid/8)+block/8){}
  __device__ __forceinline__ bool next(int i,AttnUnit&u)const{ if(i>=4)return false; const int s=vcu&7; u.bh=vcu>>3; u.qb=(i==0)?s:(i==1)?15-s:(i==2)?16+s:31-s; return true; }
  __device__ __forceinline__ void a_ready(const AttnUnit&)const{}
  __device__ __forceinline__ void done(const AttnUnit&)const{}
};
template<int THRL=8> __device__ __forceinline__ void attn_phase(char*lds,const AttnTensors&T,unsigned*qctr,volatile __attribute__((address_space(3))) unsigned*qword,int wid_in){
  const int lane0=(int)__builtin_amdgcn_mbcnt_hi(~0u,__builtin_amdgcn_mbcnt_lo(~0u,0u));
  for(;;){
    if(wid_in==0&&lane0==0){ const unsigned n=__hip_atomic_fetch_add(qctr,1u,__ATOMIC_RELAXED,__HIP_MEMORY_SCOPE_AGENT); *qword=n; }
    asm volatile("s_waitcnt vmcnt(0) lgkmcnt(0)\n\ts_barrier":::"memory");
    const int n=__builtin_amdgcn_readfirstlane((int)*qword);
    if(n>=BATCH*NHEAD*NQB)break;
    const int bh=n%(BATCH*NHEAD),qb=NQB-1-n/(BATCH*NHEAD);
    attn_unit<THRL>(bh/NHEAD,bh%NHEAD,qb,T.Q,T.K,T.V,T.O,T.F,T.NRM,lds,wid_in);
  }
}
#undef SBAR
#undef WAIT_BAR
}
#define GAS __attribute__((address_space(1)))
#define LAS __attribute__((address_space(3)))
typedef unsigned short bf16;
typedef unsigned v4u __attribute__((ext_vector_type(4)));
typedef float f32x4 __attribute__((ext_vector_type(4)));
typedef short bf16x8 __attribute__((ext_vector_type(8)));
typedef GAS unsigned gu32;
typedef GAS unsigned long long gu64;
#define RLX_AGENT __ATOMIC_RELAXED, __HIP_MEMORY_SCOPE_AGENT
#define LDS_WAIT() asm volatile("s_waitcnt lgkmcnt(0)" ::: "memory")
#define VM_WAIT() asm volatile("s_waitcnt vmcnt(0)" ::: "memory")
__device__ __forceinline__ unsigned long long rt() { return __builtin_amdgcn_s_memrealtime(); }
__device__ __forceinline__ unsigned f2bf(float f) { unsigned u = __builtin_bit_cast(unsigned, f); return (u + 0x7fffu + ((u >> 16) & 1u)) >> 16; }
__device__ __forceinline__ unsigned pk2(float lo, float hi) { return f2bf(lo) | (f2bf(hi) << 16); }

#define XB_TMO      128
#define XB_XCNT(j)  (256  + 64 * (j))
#define XB_XSUB(j)  (1280 + 64 * (j))
#define XB_XGEN(j)  (2304 + 64 * (j))
#define XB_TOP      3328
#define XB_TOPGEN   3392
#define XCD_BAR_WORDS 3456
#define XB_SPIN_CAP (1u << 18)

__device__ __forceinline__ unsigned xb_ld(unsigned* p)              { return __hip_atomic_load(p, __ATOMIC_RELAXED, __HIP_MEMORY_SCOPE_AGENT); }
__device__ __forceinline__ unsigned xb_add(unsigned* p, unsigned v) { return __hip_atomic_fetch_add(p, v, __ATOMIC_RELAXED, __HIP_MEMORY_SCOPE_AGENT); }
__device__ __forceinline__ unsigned xb_xcc_id() { return (unsigned)__builtin_amdgcn_s_getreg((3 << 11) | 20) & 0xFu; }
#define XB_SPIN(cond, bar) do { unsigned _sp = 0; while (cond) { __builtin_amdgcn_s_sleep(1); \
    if ((++_sp & 255u) == 0u) { if (xb_ld(&(bar)[XB_TMO])) break; if (_sp > XB_SPIN_CAP) { atomicAdd(&(bar)[XB_TMO], 1u); break; } } } } while (0)

struct XcdBarrier {
    unsigned* bar; unsigned x; int wv;
    volatile LAS unsigned* st;
};

__device__ __forceinline__ bool xb_t0(int wv) { return wv == 0 && __builtin_amdgcn_mbcnt_hi(~0u, __builtin_amdgcn_mbcnt_lo(~0u, 0u)) == 0u; }
__device__ __forceinline__ XcdBarrier xcd_barrier_post(unsigned* bar, volatile LAS unsigned* st, int wv) {
    XcdBarrier b; b.bar = bar; b.x = xb_xcc_id(); b.st = st; b.wv = wv;
    if (xb_t0(wv)) (void)xb_add(&bar[XB_XCNT(b.x)], 1u);
    return b;
}
__device__ __forceinline__ void xcd_barrier_complete(unsigned* bar, unsigned x, unsigned& nloc, unsigned& nx) {
    const unsigned G = gridDim.x * gridDim.y * gridDim.z;
    unsigned sum, cnt, mine, sp = 0u;
    for (;;) {
        sum = 0u; cnt = 0u; mine = 0u;
#pragma unroll
        for (unsigned j = 0; j < 16; ++j) { const unsigned c = xb_ld(&bar[XB_XCNT(j)]); sum += c; cnt += (c > 0u) ? 1u : 0u; mine = (j == x) ? c : mine; }
        if (sum == G) break;
        __builtin_amdgcn_s_sleep(1);
        if ((++sp & 255u) == 0u) { if (xb_ld(&bar[XB_TMO])) break; if (sp > XB_SPIN_CAP) { atomicAdd(&bar[XB_TMO], 1u); break; } }
    }
    nloc = mine > 0u ? mine : 1u; nx = cnt > 0u ? cnt : 1u;
}

__device__ __forceinline__ void xcd_barrier(const XcdBarrier& b) {
    asm volatile("s_waitcnt vmcnt(0)" ::: "memory");
    __syncthreads();
    if (xb_t0(b.wv)) {
        unsigned* bar = b.bar;
        __builtin_amdgcn_s_waitcnt(0);
        unsigned nloc = b.st[0], nx = b.st[1];
        if (nloc == 0u) { xcd_barrier_complete(bar, b.x, nloc, nx); b.st[0] = nloc; b.st[1] = nx; }
        const unsigned old = xb_add(&bar[XB_XSUB(b.x)], 1u);
        const unsigned gen = old / nloc;
        if (old + 1u == (gen + 1u) * nloc) {
            __builtin_amdgcn_fence(__ATOMIC_RELEASE, "agent");
            asm volatile("s_waitcnt vmcnt(0)" ::: "memory");
            const unsigned og = xb_add(&bar[XB_TOP], 1u);
            const unsigned tg = og / nx;
            if (og + 1u == (tg + 1u) * nx) xb_add(&bar[XB_TOPGEN], 1u);
            else XB_SPIN(xb_ld(&bar[XB_TOPGEN]) == tg, bar);
            __builtin_amdgcn_fence(__ATOMIC_ACQUIRE, "agent");
            xb_add(&bar[XB_XGEN(b.x)], 1u);
            asm volatile("s_waitcnt vmcnt(0)" ::: "memory");
        } else {
            XB_SPIN(xb_ld(&bar[XB_XGEN(b.x)]) == gen, bar);
            __builtin_amdgcn_fence(__ATOMIC_ACQUIRE, "agent");
            asm volatile("s_waitcnt vmcnt(0)" ::: "memory");
        }
    }
    __syncthreads();
}

constexpr int NWAVES = 8;
constexpr int RING_OFF = 0, RING_BYTES = 131072;
constexpr int LDSCTL_OFF = RING_BYTES, MISC_OFF = LDSCTL_OFF + 320;
constexpr int LDS_BYTES = 147456;
constexpr int N_PHASES = 8;

struct Frame {
    LAS unsigned char* lds;
    volatile LAS unsigned* MISC;
    gu32* ctl;
    int tid, lane, wave, vcu, G;
};
__device__ __forceinline__ float wave_sum(float v) {
#pragma unroll
    for (int o = 1; o < 64; o <<= 1) v += __shfl_xor(v, o);
    return v;
}
struct Args { const float* in[20]; float* out; unsigned char* ws; int ph_lo, ph_hi, li, pad; };

__device__ __forceinline__ void p0_transpose_item(const float* W, int ld, int nblk, const float* glo, const float* ghi, int K, bf16* WT, LAS float* scr, int item, int lane) {
    const int kb = item / nblk, nb = item % nblk, k0 = 64 * kb, n0 = 32 * nb;
#pragma unroll 8
    for (int i = 0; i < 32; ++i) { const int kk = 2 * i + (lane >> 5), k = k0 + kk; float w = W[(size_t)k * ld + n0 + (lane & 31)];
        if (glo) w *= (k < K / 2) ? glo[k] : ghi[k - K / 2];
        scr[kk * 33 + (lane & 31)] = w; }
    LDS_WAIT(); asm volatile("" ::: "memory");
    const int c = lane & 7;
#pragma unroll
    for (int j = 0; j < 4; ++j) { const int n = (lane >> 3) + 8 * j; const LAS float* s = scr + (8 * c) * 33 + n;
        v4u o; o.x = pk2(s[0 * 33], s[1 * 33]); o.y = pk2(s[2 * 33], s[3 * 33]); o.z = pk2(s[4 * 33], s[5 * 33]); o.w = pk2(s[6 * 33], s[7 * 33]);
        *(GAS v4u*)(WT + (size_t)(n0 + n) * K + k0 + 8 * c) = o; }
    LDS_WAIT(); asm volatile("" ::: "memory");
}
__device__ __forceinline__ float log_sigmoid(float z) { return fminf(z, 0.f) - log1pf(expf(-fabsf(z))); }

__device__ __forceinline__ void p0_prologue(Frame& F, const Args& a) {
    LAS float* scr = (LAS float*)(F.lds + RING_OFF + F.wave * 16384);
    unsigned char* ws = a.ws;
    const float* x = a.in[0]; const float* g1 = a.in[1]; const float* w_in = a.in[2]; const float* bfv = a.in[10];
    const float* gn_l = a.in[11]; const float* gn_f = a.in[12]; const float* w_out = a.in[13]; const float* g2 = a.in[14];
    const float* w_q = a.in[15]; const float* sk = a.in[16]; const float* pu = a.in[17]; const float* pv = a.in[18];
    bf16* win_t = (bf16*)(ws + WS_WIN); bf16* wout_t = (bf16*)(ws + WS_WOUT); bf16* wq_t = (bf16*)(ws + WS_WQ); bf16* skb = (bf16*)(ws + WS_SKB);
    float* logf = (float*)(ws + WS_LOGF); float* sumsq = (float*)(ws + WS_SUMSQ); bf16* h = (bf16*)(ws + WS_H);
    const int gw = F.vcu * NWAVES + F.wave, NGW = F.G * NWAVES, lane = F.lane;
    constexpr int I_IN = (DMODEL / 64) * (NG1 / 32), I_OUT = (DMODEL / 64) * (DMODEL / 32), I_Q = (DMODEL / 64) * (QPW / 32);
    constexpr int I_FL = 8 * DMODEL / 64, I_SK = PH * 2 * NKEY * PHALF / 512, I_SS = T / 64, I_WAX = 8 * 2 * 2 * 4;
    constexpr int E0 = I_IN, E1 = E0 + I_OUT, E2 = E1 + I_Q, E3 = E2 + I_FL, E4 = E3 + I_SK, E5 = E4 + I_SS, E6 = E5 + I_WAX;
    for (int it = gw; it < E6; it += NGW) {
        if (it < E0) { p0_transpose_item(w_in, INC, NG1 / 32, nullptr, nullptr, DMODEL, win_t, scr, it, lane); continue; }
        if (it < E1) { p0_transpose_item(w_out, DMODEL, DMODEL / 32, gn_l, gn_f, DMODEL, wout_t, scr, it - E0, lane); continue; }
        if (it < E2) { p0_transpose_item(w_q, QPW, QPW / 32, g2, g2 + DMODEL / 2, DMODEL, wq_t, scr, it - E1, lane); continue; }
        if (it < E3) continue;
        if (it < E4) { const size_t i = (size_t)(it - E3) * 512 + lane * 8; const f32x4 s0 = *(const GAS f32x4*)(sk + i), s1 = *(const GAS f32x4*)(sk + i + 4);
            v4u o; o.x = pk2(s0[0], s0[1]); o.y = pk2(s0[2], s0[3]); o.z = pk2(s1[0], s1[1]); o.w = pk2(s1[2], s1[3]); *(GAS v4u*)(skb + i) = o; continue; }
        if (it < E5) { sumsq[(it - E4) * 64 + lane] = 0.f; continue; }
        { const int f = it - E5, ks = f & 3, n = (f >> 2) & 1, mat = (f >> 3) & 1, hh = f >> 4; const float* wsrc = mat ? a.in[7] : a.in[5];
          const size_t o = ((size_t)(hh * 64 + 16 * ks + 8 * (lane >> 5))) * 64 + 32 * n + (lane & 31);
          v4u pw; pw.x = pk2(wsrc[o], wsrc[o + 64]); pw.y = pk2(wsrc[o + 128], wsrc[o + 192]); pw.z = pk2(wsrc[o + 256], wsrc[o + 320]); pw.w = pk2(wsrc[o + 384], wsrc[o + 448]);
          *(GAS v4u*)((bf16*)(ws + WS_WAX) + (size_t)f * 512 + lane * 8) = pw; }
    }
    { f32x4 gg[4];
#pragma unroll
      for (int j = 0; j < 4; ++j) gg[j] = *(const GAS f32x4*)(g2 + 16 * lane + 4 * j);
      unsigned char* u4 = ws + WS_U8; unsigned char* v4 = ws + WS_V8; float* su = (float*)(ws + WS_SU);
      for (int e = gw; e < NEXP; e += NGW) {
        const GAS f32x4* ur = (const GAS f32x4*)(pu + (size_t)e * DMODEL + 16 * lane); const GAS f32x4* vr = (const GAS f32x4*)(pv + (size_t)e * DMODEL + 16 * lane);
        f32x4 uu[4], vv[4]; float mu = 0.f, mv = 0.f;
#pragma unroll
        for (int j = 0; j < 4; ++j) { uu[j] = ur[j] * gg[j]; vv[j] = vr[j];
#pragma unroll
            for (int c = 0; c < 4; ++c) { mu = fmaxf(mu, fabsf(uu[j][c])); mv = fmaxf(mv, fabsf(vv[j][c])); } }
#pragma unroll
        for (int o = 1; o < 64; o <<= 1) { mu = fmaxf(mu, __shfl_xor(mu, o)); mv = fmaxf(mv, __shfl_xor(mv, o)); }
        const float scu = mu > 0.f ? mu * (1.f / 6.f) : 1.f, scv = mv > 0.f ? mv * (1.f / 6.f) : 1.f, iu = 1.f / scu, iv = 1.f / scv;
        unsigned qu0 = 0u, qu1 = 0u, qv0 = 0u, qv1 = 0u;
#define P0_Q4(Q, X, INV, B0, B1) do { Q = __builtin_amdgcn_cvt_scalef32_pk_fp4_f32(Q, X[0] * INV, X[1] * INV, 1.0f, B0); Q = __builtin_amdgcn_cvt_scalef32_pk_fp4_f32(Q, X[2] * INV, X[3] * INV, 1.0f, B1); } while (0)
        P0_Q4(qu0, uu[0], iu, 0, 1); P0_Q4(qu0, uu[1], iu, 2, 3); P0_Q4(qu1, uu[2], iu, 0, 1); P0_Q4(qu1, uu[3], iu, 2, 3);
        P0_Q4(qv0, vv[0], iv, 0, 1); P0_Q4(qv0, vv[1], iv, 2, 3); P0_Q4(qv1, vv[2], iv, 0, 1); P0_Q4(qv1, vv[3], iv, 2, 3);
#undef P0_Q4
        *(GAS unsigned long long*)(u4 + (size_t)e * 512 + 8 * lane) = (unsigned long long)qu0 | ((unsigned long long)qu1 << 32);
        { unsigned char* vrow = v4 + (size_t)e * 512 + 2 * (lane >> 2);
          *(GAS unsigned short*)(vrow + 32 * (4 * (lane & 3) + 0)) = (unsigned short)(qv0 & 0xffffu); *(GAS unsigned short*)(vrow + 32 * (4 * (lane & 3) + 1)) = (unsigned short)(qv0 >> 16);
          *(GAS unsigned short*)(vrow + 32 * (4 * (lane & 3) + 2)) = (unsigned short)(qv1 & 0xffffu); *(GAS unsigned short*)(vrow + 32 * (4 * (lane & 3) + 3)) = (unsigned short)(qv1 >> 16); }
        if (lane == 0) { su[2 * e] = scu; su[2 * e + 1] = scv; }
      } }
    { f32x4 gg[4];
#pragma unroll
      for (int j = 0; j < 4; ++j) gg[j] = *(const GAS f32x4*)(g1 + 256 * j + 4 * lane);
      float fw[4][4][8];
#pragma unroll
      for (int j = 0; j < 4; ++j)
#pragma unroll
          for (int c = 0; c < 4; ++c) { const int k = 256 * j + 4 * lane + c; const GAS f32x4* wr = (const GAS f32x4*)(w_in + (size_t)k * INC + NG1); const f32x4 w0 = wr[0], w1 = wr[1];
#pragma unroll
              for (int e = 0; e < 4; ++e) { fw[j][c][e] = w0[e]; fw[j][c][4 + e] = w1[e]; } }
      for (int t0 = gw; t0 < T; t0 += 2 * NGW) {
        const int t1 = (t0 + NGW < T) ? t0 + NGW : t0;
        const GAS f32x4* xr0 = (const GAS f32x4*)(x + (size_t)t0 * DMODEL) + lane; const GAS f32x4* xr1 = (const GAS f32x4*)(x + (size_t)t1 * DMODEL) + lane;
        f32x4 va[4], vb[4]; float sa = 0.f, sb = 0.f;
#pragma unroll
        for (int j = 0; j < 4; ++j) { va[j] = xr0[64 * j]; vb[j] = xr1[64 * j]; }
#pragma unroll
        for (int j = 0; j < 4; ++j) { sa += (va[j][0] * va[j][0] + va[j][1] * va[j][1]) + (va[j][2] * va[j][2] + va[j][3] * va[j][3]); sb += (vb[j][0] * vb[j][0] + vb[j][1] * vb[j][1]) + (vb[j][2] * vb[j][2] + vb[j][3] * vb[j][3]); }
        const float ra = rsqrtf(wave_sum(sa) * (1.f / DMODEL) + RMS_EPS), rb = rsqrtf(wave_sum(sb) * (1.f / DMODEL) + RMS_EPS);
        GAS unsigned long long* ha = (GAS unsigned long long*)(h + (size_t)t0 * DMODEL) + lane; GAS unsigned long long* hb = (GAS unsigned long long*)(h + (size_t)t1 * DMODEL) + lane;
#pragma unroll
        for (int j = 0; j < 4; ++j) { va[j] = va[j] * ra * gg[j]; vb[j] = vb[j] * rb * gg[j];
            ha[64 * j] = (unsigned long long)pk2(va[j][0], va[j][1]) | ((unsigned long long)pk2(va[j][2], va[j][3]) << 32);
            hb[64 * j] = (unsigned long long)pk2(vb[j][0], vb[j][1]) | ((unsigned long long)pk2(vb[j][2], vb[j][3]) << 32); }
        float fa[8], fb[8];
#pragma unroll
        for (int hh = 0; hh < 8; ++hh) { fa[hh] = 0.f; fb[hh] = 0.f; }
#pragma unroll
        for (int j = 0; j < 4; ++j)
#pragma unroll
            for (int c = 0; c < 4; ++c) {
#pragma unroll
                for (int hh = 0; hh < 8; ++hh) { fa[hh] += va[j][c] * fw[j][c][hh]; fb[hh] += vb[j][c] * fw[j][c][hh]; } }
        float resa = 0.f, resb = 0.f;
#pragma unroll
        for (int hh = 0; hh < 8; ++hh) { const float s0 = wave_sum(fa[hh]), s1 = wave_sum(fb[hh]); if (lane == hh) { resa = s0; resb = s1; } }
        if (lane < 8) { logf[(size_t)t0 * 8 + lane] = log_sigmoid(resa + bfv[lane]); logf[(size_t)t1 * 8 + lane] = log_sigmoid(resb + bfv[lane]); }
      } }
}

__device__ __forceinline__ void fcum_unit(Frame& F, int bh, const float* logf, float* fcum) {
    const int b = bh / NHEADS, hh = bh % NHEADS, s0 = F.tid * 16;
    float v[16]; float loc = 0.f;
#pragma unroll
    for (int i = 0; i < 16; ++i) { v[i] = logf[((size_t)b * SEQ + s0 + i) * 8 + hh]; loc += v[i]; }
    float inc = loc;
#pragma unroll
    for (int o = 1; o < 64; o <<= 1) { const float n = __shfl_up(inc, o); if (F.lane >= o) inc += n; }
    if (F.lane == 63) F.MISC[16 + F.wave] = __float_as_uint(inc);
    __syncthreads();
    float run = inc - loc;
    for (int w = 0; w < F.wave; ++w) run += __uint_as_float(F.MISC[16 + w]);
#pragma unroll
    for (int i = 0; i < 16; ++i) { run += v[i]; fcum[(size_t)bh * SEQ + s0 + i] = run; }
    __syncthreads();
}


namespace peer {
typedef unsigned u32;
typedef float f32x16 __attribute__((ext_vector_type(16)));
constexpr int TOK = 128;
constexpr int EX_STRIDE = 136, GT_STRIDE = 136;
constexpr int L_EX = 0, L_GT = L_EX + TOK * EX_STRIDE * 2, L_IDX = L_GT + TOK * GT_STRIDE * 2, IDX_STRIDE = 36, L_RST = L_IDX + 512 * IDX_STRIDE, L_BI = L_RST + TOK * 4, L_END = L_BI + 8 * 4096;
static_assert(L_END <= RING_BYTES && L_GT % 16 == 0 && L_IDX % 16 == 0, "PEER LDS map");
__device__ __forceinline__ u32 ordmap(float f) { const u32 u = __float_as_uint(f); return u ^ ((u32)((int)u >> 31) | 0x80000000u); }
__device__ __forceinline__ float unordmap(u32 k) { const u32 u = (k & 0x80000000u) ? (k ^ 0x80000000u) : ~k; return __uint_as_float(u); }
__device__ __forceinline__ u32 umin_(u32 a, u32 b) { return a < b ? a : b; }
__device__ __forceinline__ u32 umax_(u32 a, u32 b) { return a > b ? a : b; }
template <bool DESC> __device__ __forceinline__ void sort16(u32 (&k)[16]) {
#pragma unroll
    for (int size = 2; size <= 16; size <<= 1)
#pragma unroll
        for (int stride = size >> 1; stride > 0; stride >>= 1)
#pragma unroll
            for (int i = 0; i < 16; ++i) { const int j = i ^ stride;
                if (j > i) { const bool asc = (((i & size) == 0) != DESC); const u32 a = k[i], b = k[j], lo = umin_(a, b), hi = umax_(a, b); k[i] = asc ? lo : hi; k[j] = asc ? hi : lo; } }
}
template <bool DESC> __device__ __forceinline__ void merge16(u32 (&k)[16]) {
#pragma unroll
    for (int stride = 8; stride > 0; stride >>= 1)
#pragma unroll
        for (int i = 0; i < 16; ++i) { const int j = i ^ stride;
            if (j > i) { const u32 a = k[i], b = k[j], lo = umin_(a, b), hi = umax_(a, b); k[i] = DESC ? hi : lo; k[j] = DESC ? lo : hi; } }
}
__host__ __device__ constexpr int ccnt(int a) { return 16 / (a + 1); }
__host__ __device__ constexpr int cbase(int a) { int s = 0; for (int i = 0; i < a; ++i) s += ccnt(i); return s; }
static_assert(cbase(16) == 50, "hyperbola candidate count");
__device__ __forceinline__ int crow16(int r) { return (r & 3) + 8 * (r >> 2); }

__device__ __forceinline__ void route_tile(Frame& F, const bf16* qp, const bf16* skb, const float* sumsq, int t0) {
    int lane = F.lane; asm volatile("" : "+v"(lane));
    const int r32 = lane & 31, hi = lane >> 5, w = F.wave;
    LAS unsigned short* EXL = (LAS unsigned short*)(F.lds + RING_OFF + L_EX);
    LAS unsigned short* GTL = (LAS unsigned short*)(F.lds + RING_OFF + L_GT);
    LAS unsigned char* IDXB = F.lds + RING_OFF + L_IDX + (w * 64 + lane) * IDX_STRIDE;
    LAS float* RST = (LAS float*)(F.lds + RING_OFF + L_RST);
    for (int g = 0; g < 4; ++g) {
        const int tok = 32 * g + r32; const size_t trow = (size_t)(t0 + tok);
        const float rstd2 = rsqrtf(sumsq[trow] * (1.f / DMODEL) + RMS_EPS);
        if (w == 0 && hi == 0) RST[tok] = rstd2;
        u32 s0[16], s1[16];
#pragma unroll
        for (int p = 0; p < 2; ++p) {
            bf16x8 qf[8];
#pragma unroll
            for (int ks = 0; ks < 8; ++ks) qf[ks] = *(const GAS bf16x8*)(qp + trow * QPW + w * 256 + p * 128 + ks * 16 + hi * 8);
            u32 run[16];
#pragma unroll
            for (int nb = 0; nb < 4; ++nb) {
                f32x16 acc = {};
                const bf16* kr = skb + ((size_t)((w * 2 + p) * NKEY + 32 * nb + r32)) * PHALF + hi * 8;
#pragma unroll
                for (int ks = 0; ks < 8; ++ks) acc = __builtin_amdgcn_mfma_f32_32x32x16_bf16(*(const GAS bf16x8*)(kr + ks * 16), qf[ks], acc, 0, 0, 0);
                asm volatile("" ::: "memory");
                u32 blk[16];
#pragma unroll
                for (int r = 0; r < 16; ++r) blk[r] = (ordmap(acc[r]) & ~0x7Fu) | (u32)(127 - 32 * nb - crow16(r) - 4 * hi);
                if (nb == 0) { sort16<true>(blk);
#pragma unroll
                    for (int i = 0; i < 16; ++i) run[i] = blk[i]; }
                else { sort16<false>(blk);
#pragma unroll
                    for (int i = 0; i < 16; ++i) run[i] = umax_(run[i], blk[i]);
                    merge16<true>(run); }
            }
            u32 oth[16];
#pragma unroll
            for (int i = 0; i < 16; ++i) oth[i] = (u32)__shfl_xor((int)run[15 - i], 32);
#pragma unroll
            for (int i = 0; i < 16; ++i) run[i] = umax_(run[i], oth[i]);
            merge16<true>(run);
#pragma unroll
            for (int i = 0; i < 16; ++i) { if (p == 0) s0[i] = run[i]; else s1[i] = run[i]; }
        }
        { LAS u32* iw = (LAS u32*)IDXB;
#pragma unroll
          for (int j = 0; j < 4; ++j) {
              iw[j] = (127u - (s0[4 * j] & 127u)) | ((127u - (s0[4 * j + 1] & 127u)) << 8) | ((127u - (s0[4 * j + 2] & 127u)) << 16) | ((127u - (s0[4 * j + 3] & 127u)) << 24);
              iw[4 + j] = (127u - (s1[4 * j] & 127u)) | ((127u - (s1[4 * j + 1] & 127u)) << 8) | ((127u - (s1[4 * j + 2] & 127u)) << 16) | ((127u - (s1[4 * j + 3] & 127u)) << 24); } }
        float v1[16], v2[16];
#pragma unroll
        for (int i = 0; i < 16; ++i) { v1[i] = unordmap(s0[i] & ~0x7Fu); v2[i] = unordmap(s1[i] & ~0x7Fu); }
        u32 c0[16], c1[16], c2[16], c3[16];
#pragma unroll
        for (int a = 0; a < 16; ++a)
#pragma unroll
            for (int b = 0; b < ccnt(a); ++b) { const int pos = cbase(a) + b; const u32 key = (ordmap(v1[a] + v2[b]) & ~0xFFu) | (u32)(255 - (a * 16 + b));
                if (pos < 16) c0[pos] = key; else if (pos < 32) c1[pos - 16] = key; else if (pos < 48) c2[pos - 32] = key; else c3[pos - 48] = key; }
#pragma unroll
        for (int i = 2; i < 16; ++i) c3[i] = 0u;
        sort16<false>(c1);
#pragma unroll
        for (int i = 0; i < 16; ++i) c0[i] = umax_(c0[i], c1[i]);
        merge16<true>(c0);
        sort16<false>(c2);
#pragma unroll
        for (int i = 0; i < 16; ++i) c0[i] = umax_(c0[i], c2[i]);
        merge16<true>(c0);
        sort16<false>(c3);
#pragma unroll
        for (int i = 0; i < 16; ++i) c0[i] = umax_(c0[i], c3[i]);
        merge16<true>(c0);
        const float m = unordmap(c0[0] & ~0xFFu) * rstd2;
        float e[8]; float sum = 0.f; u32 ex[8];
#pragma unroll
        for (int k = 0; k < 8; ++k) { const u32 key = hi ? c0[k + 8] : c0[k]; const float ts = unordmap(key & ~0xFFu);
            e[k] = __builtin_amdgcn_exp2f((ts * rstd2 - m) * LOG2E); sum += e[k];
            const u32 flat = 255u - (key & 255u); ex[k] = (u32)IDXB[flat >> 4] * NKEY + (u32)IDXB[16 + (flat & 15u)]; }
        sum += __shfl_xor(sum, 32);
        const float inv = 1.f / sum;
        v4u exw; exw.x = ex[0] | (ex[1] << 16); exw.y = ex[2] | (ex[3] << 16); exw.z = ex[4] | (ex[5] << 16); exw.w = ex[6] | (ex[7] << 16);
        *(LAS v4u*)(EXL + tok * EX_STRIDE + w * 16 + hi * 8) = exw;
        *(LAS v4u*)(GTL + tok * GT_STRIDE + w * 16 + hi * 8) = (v4u){pk2(e[0] * inv, e[1] * inv), pk2(e[2] * inv, e[3] * inv), pk2(e[4] * inv, e[5] * inv), pk2(e[6] * inv, e[7] * inv)};
    }
}
__device__ __forceinline__ float gelu_fast(float x) {
    const float u2 = x * (1.5957691216057308f + 0.07135481627f * x * x);
    return x * __builtin_amdgcn_rcpf(1.f + __builtin_amdgcn_exp2f(-1.4426950408889634f * u2));
}
typedef float f32x2 __attribute__((ext_vector_type(2)));

__device__ __forceinline__ void sort128(u32 (&k)[8], int m) {
#pragma unroll
    for (int K = 2; K <= 128; K <<= 1) {
#pragma unroll
        for (int S = K >> 1; S > 0; S >>= 1) {
            if (S >= 8) {
                const int mm = S >> 3; const bool lower = (m & mm) == 0, up = (K == 128) ? true : ((m & (K >> 3)) == 0), keepmin = (lower == up);
#pragma unroll
                for (int r = 0; r < 8; ++r) { const u32 o = (u32)__shfl_xor((int)k[r], mm); const u32 mn = umin_(k[r], o), mx = umax_(k[r], o); k[r] = keepmin ? mn : mx; }
            } else {
#pragma unroll
                for (int r = 0; r < 8; ++r) { const int r2 = r ^ S;
                    if (r2 > r) { const u32 a = k[r], b = k[r2], mn = umin_(a, b), mx = umax_(a, b);
                        if (K < 8) { const bool up = (r & K) == 0; k[r] = up ? mn : mx; k[r2] = up ? mx : mn; }
                        else { const bool up = (K == 128) ? true : ((m & (K >> 3)) == 0); k[r] = up ? mn : mx; k[r2] = up ? mx : mn; } } }
            }
        }
    }
}
typedef int v8i __attribute__((ext_vector_type(8)));
__device__ __forceinline__ void eval_mf(Frame& F, const unsigned char* u4, const unsigned char* v4, const float* suv, const float* fg, float* out, int t0) {
    int lane = F.lane; asm volatile("" : "+v"(lane));
    const int g = lane >> 4, m = lane & 15;
    const LAS unsigned short* EXL = (const LAS unsigned short*)(F.lds + RING_OFF + L_EX);
    const LAS unsigned short* GTL = (const LAS unsigned short*)(F.lds + RING_OFF + L_GT);
    LAS unsigned char* BI = F.lds + RING_OFF + L_BI + F.wave * 4096;
    const LAS float* RST = (const LAS float*)(F.lds + RING_OFF + L_RST);
    LAS u32* SKW = (LAS u32*)(F.lds + RING_OFF + L_IDX) + F.wave * 512;
    LAS u32* SK = SKW + g * 128;
    for (int pass = 0; pass < 4; ++pass) {
        const int tb4 = 32 * pass + 4 * F.wave, tok = tb4 + g;
        { u32 k[8]; const v4u ev = *(const LAS v4u*)(EXL + tok * EX_STRIDE + 8 * m); const u32 s0 = (u32)(8 * m);
          k[0] = ((ev.x & 0xffffu) << 7) | s0; k[1] = ((ev.x >> 16) << 7) | (s0 + 1); k[2] = ((ev.y & 0xffffu) << 7) | (s0 + 2); k[3] = ((ev.y >> 16) << 7) | (s0 + 3);
          k[4] = ((ev.z & 0xffffu) << 7) | (s0 + 4); k[5] = ((ev.z >> 16) << 7) | (s0 + 5); k[6] = ((ev.w & 0xffffu) << 7) | (s0 + 6); k[7] = ((ev.w >> 16) << 7) | (s0 + 7);
          sort128(k, m);
          *(LAS v4u*)(SK + m * 8) = (v4u){k[0], k[1], k[2], k[3]}; *(LAS v4u*)(SK + m * 8 + 4) = (v4u){k[4], k[5], k[6], k[7]}; }
        asm volatile("" ::: "memory");
        {
#pragma unroll
            for (int tq = 0; tq < 4; ++tq) { const float rq = RST[tb4 + tq]; const float* xr = out + (size_t)(t0 + tb4 + tq) * DMODEL + 4 * lane;
#pragma unroll
                for (int c = 0; c < 4; ++c) { const f32x4 xa = *(const GAS f32x4*)(xr + 256 * c); int w = 0;
                    w = __builtin_amdgcn_cvt_pk_fp8_f32(xa[0] * rq, xa[1] * rq, w, false); w = __builtin_amdgcn_cvt_pk_fp8_f32(xa[2] * rq, xa[3] * rq, w, true);
                    const int d = 256 * c + 4 * lane, st = d >> 7, dd = d & 127, hh = dd >> 6, e = dd & 63;
                    *(LAS int*)(BI + ((st * 4 + tq) * 4 + (e >> 4)) * 32 + hh * 16 + (e & 15)) = w; } }
        }
        asm volatile("" ::: "memory");
        v8i hb[8];
#pragma unroll
        for (int st = 0; st < 8; ++st) { v4u b0 = *(const LAS v4u*)(BI + ((st * 4 + (m & 3)) * 4 + g) * 32), b1 = *(const LAS v4u*)(BI + ((st * 4 + (m & 3)) * 4 + g) * 32 + 16);
            if (m >= 4) { b0 = (v4u){0u, 0u, 0u, 0u}; b1 = b0; }
            hb[st] = (v8i){(int)b0.x, (int)b0.y, (int)b0.z, (int)b0.w, (int)b1.x, (int)b1.y, (int)b1.z, (int)b1.w}; }
        asm volatile("" ::: "memory");
        f32x2 y[32];
#pragma unroll
        for (int q = 0; q < 32; ++q) y[q] = (f32x2){0.f, 0.f};
        float* xrow = out + (size_t)(t0 + tok) * DMODEL + 4 * m;
        const LAS unsigned short* gtr = GTL + tok * GT_STRIDE;
        for (int i = 0; i < 128; i += 4) {
            const u32 keyr = SKW[(m & 3) * 128 + i + (m >> 2)];
            const unsigned char* ap = u4 + (keyr >> 7) * 512u + 16u * (u32)g;
            v4u af[8];
#pragma unroll
            for (int st = 0; st < 8; ++st) af[st] = *(const GAS v4u*)(ap + 64 * st);
            const v4u kq = *(const LAS v4u*)(SK + i);
            f32x2 sc[4]; float gate[4];
#pragma unroll
            for (int s4 = 0; s4 < 4; ++s4) { sc[s4] = *(const GAS f32x2*)(suv + 2 * (kq[s4] >> 7)); gate[s4] = __uint_as_float((u32)gtr[kq[s4] & 127u] << 16); }
            f32x4 D = (f32x4){0.f, 0.f, 0.f, 0.f};
#pragma unroll
            for (int st = 0; st < 8; ++st) { const v8i a8 = (v8i){(int)af[st].x, (int)af[st].y, (int)af[st].z, (int)af[st].w, 0, 0, 0, 0};
                D = __builtin_amdgcn_mfma_scale_f32_16x16x128_f8f6f4(a8, hb[st], D, 4, 0, 0, 0x7f7f7f7f, 0, 0x7f7f7f7f); }
            asm volatile("" ::: "memory");
            v4u vb[4][2];
#pragma unroll
            for (int s4 = 0; s4 < 4; ++s4) { const u32 ro = (kq[s4] >> 7) * 512u + 32u * (u32)m; vb[s4][0] = *(const GAS v4u*)(v4 + ro); vb[s4][1] = *(const GAS v4u*)(v4 + ro + 16); }
            const int sel = lane & 3; const float mine = sel == 0 ? D[0] : sel == 1 ? D[1] : sel == 2 ? D[2] : D[3];
#pragma unroll
            for (int s4 = 0; s4 < 4; ++s4) { const float pre = __uint_as_float((unsigned)__builtin_amdgcn_ds_bpermute(4 * (g + 16 * s4), (int)__float_as_uint(mine)));
                const float act = gelu_fast(pre * sc[s4][0]) * (gate[s4] * sc[s4][1]); const f32x2 b2 = (f32x2){act, act};
#pragma unroll
                for (int c = 0; c < 2; ++c)
#pragma unroll
                    for (int d = 0; d < 4; ++d) { const unsigned w_ = vb[s4][c][d]; const int hq = 16 * c + 4 * d;
                        y[hq] = __builtin_elementwise_fma(__builtin_amdgcn_cvt_scalef32_pk_f32_fp4(w_, 1.0f, 0), b2, y[hq]); y[hq + 1] = __builtin_elementwise_fma(__builtin_amdgcn_cvt_scalef32_pk_f32_fp4(w_, 1.0f, 1), b2, y[hq + 1]);
                        y[hq + 2] = __builtin_elementwise_fma(__builtin_amdgcn_cvt_scalef32_pk_f32_fp4(w_, 1.0f, 2), b2, y[hq + 2]); y[hq + 3] = __builtin_elementwise_fma(__builtin_amdgcn_cvt_scalef32_pk_f32_fp4(w_, 1.0f, 3), b2, y[hq + 3]); } }
        }
        float ss = 0.f;
#pragma unroll
        for (int q = 0; q < 16; ++q) { const f32x4 xa = *(const GAS f32x4*)(xrow + 64 * q); y[2 * q][0] += xa[0]; y[2 * q][1] += xa[1]; y[2 * q + 1][0] += xa[2]; y[2 * q + 1][1] += xa[3];
            ss += (y[2 * q][0] * y[2 * q][0] + y[2 * q][1] * y[2 * q][1]) + (y[2 * q + 1][0] * y[2 * q + 1][0] + y[2 * q + 1][1] * y[2 * q + 1][1]); }
        ss += __shfl_xor(ss, 1); ss += __shfl_xor(ss, 2); ss += __shfl_xor(ss, 4); ss += __shfl_xor(ss, 8);
        const float rs = rsqrtf(ss * (1.f / DMODEL) + RMS_EPS);
        asm volatile("" ::: "memory");
#pragma unroll
        for (int q = 0; q < 16; ++q) { const f32x4 gq = *(const GAS f32x4*)(fg + 64 * q + 4 * m); f32x4 o; o[0] = y[2 * q][0] * rs * gq[0]; o[1] = y[2 * q][1] * rs * gq[1]; o[2] = y[2 * q + 1][0] * rs * gq[2]; o[3] = y[2 * q + 1][1] * rs * gq[3];
            *(GAS f32x4*)(xrow + 64 * q) = o; }
    }
}
__device__ __forceinline__ void peer_phase(Frame& F, const Args& a) {
    unsigned char* ws = a.ws;
    for (int tile = F.vcu; tile < T / TOK; tile += F.G) {
        route_tile(F, (const bf16*)(ws + WS_QP), (const bf16*)(ws + WS_SKB), (const float*)(ws + WS_SUMSQ), tile * TOK);
        __syncthreads();
        eval_mf(F, ws + WS_U8, ws + WS_V8, (const float*)(ws + WS_SU), a.in[19], a.out, tile * TOK);
        __syncthreads();
    }
}
}

namespace lru {
typedef float f32x16 __attribute__((ext_vector_type(16)));
constexpr int TOKT = 128, NTILE = SEQ / TOKT;
constexpr int WAVE_LDS = 14336, L_XS = 0, L_XC = 4608, L_GS = 9216, XC_STRIDE = 72  , L_SS = 8 * WAVE_LDS;
static_assert(L_SS + 32 * 8 * 4 <= RING_BYTES, "LRU LDS map");
__device__ __forceinline__ float bf2f(unsigned short h) { return __uint_as_float((unsigned)h << 16); }
__device__ __forceinline__ int crow16(int r) { return (r & 3) + 8 * (r >> 2); }
__device__ __forceinline__ float sigm(float x) { return __builtin_amdgcn_rcpf(1.f + __builtin_amdgcn_exp2f(-LOG2E * x)); }

template <bool FINAL> __device__ __forceinline__ void lru_tile(Frame& F, const Args& args, int tile) {
    int lane = F.lane; asm volatile("" : "+v"(lane));
    const int w = F.wave, j32 = lane & 31, hi = lane >> 5;
    unsigned char* ws = args.ws;
    const bf16* xr = (const bf16*)(ws + WS_XR); const bf16* gr = (const bf16*)(ws + WS_GR); float* carry = (float*)(ws + WS_CARRY);
    const float* cw = args.in[3]; const float* cb = args.in[4]; const float* ba = args.in[6]; const float* bx = args.in[8]; const float* lam = args.in[9];
    const int b = tile / NTILE, jt = tile % NTILE; const size_t trow0 = (size_t)b * SEQ + (size_t)jt * TOKT;
    LAS unsigned char* wl = F.lds + RING_OFF + w * WAVE_LDS;
    LAS unsigned short* XS = (LAS unsigned short*)(wl + L_XS); LAS unsigned short* XC = (LAS unsigned short*)(wl + L_XC); LAS unsigned short* GS = (LAS unsigned short*)(wl + L_GS);
    LAS float* SS = (LAS float*)(F.lds + RING_OFF + L_SS);
    float c_ba[2], c_bx[2], c_sp[2], c_cb[2], c_cw[2][4];
#pragma unroll
    for (int n = 0; n < 2; ++n) { const int c = 64 * w + 32 * n + j32; c_ba[n] = ba[c]; c_bx[n] = bx[c]; c_cb[n] = cb[c];
        const float l = lam[c]; c_sp[n] = 8.f * LOG2E * (fmaxf(-l, 0.f) + log1pf(expf(-fabsf(l))));
#pragma unroll
        for (int k = 0; k < 4; ++k) c_cw[n][k] = cw[k * LW + c]; }
    const bf16* wax = (const bf16*)(ws + WS_WAX);
    float hc[2] = {0.f, 0.f}, ap[2] = {1.f, 1.f};
    if (FINAL) { const float* cin = (const float*)(ws + WS_CIN) + (size_t)(b * NTILE + jt) * LW + 64 * w + j32; hc[0] = cin[0]; hc[1] = cin[32]; }
    v4u pfx[5], pfg[4];
#define LRU_FETCH(B) do { const size_t tbn_ = trow0 + (B) * 32; _Pragma("unroll") for (int q_ = 0; q_ < 5; ++q_) { const int pc_ = lane + 64 * q_, row_ = pc_ >> 3, c8_ = pc_ & 7; \
        const bool z_ = (jt == 0 && (B) == 0 && row_ < 3) || pc_ >= 35 * 8; const v4u v_ = *(const GAS v4u*)(xr + (tbn_ + (z_ ? 3 : row_) - 3) * LW + w * 64 + c8_ * 8); pfx[q_] = z_ ? (v4u){0u, 0u, 0u, 0u} : v_; } \
        if (FINAL) { _Pragma("unroll") for (int q_ = 0; q_ < 4; ++q_) { const int pc_ = lane + 64 * q_; pfg[q_] = *(const GAS v4u*)(gr + (tbn_ + (pc_ >> 3)) * LW + w * 64 + (pc_ & 7) * 8); } } } while (0)
    LRU_FETCH(0);
    for (int blk = 0; blk < 4; ++blk) {
        const size_t tb = trow0 + blk * 32;
        int ln = lane; asm volatile("" : "+v"(ln));
        const int k32 = ln & 31;
#pragma unroll
        for (int q = 0; q < 5; ++q) { const int pc = ln + 64 * q; if (pc < 35 * 8) *(LAS v4u*)((LAS unsigned char*)XS + (pc >> 3) * 128 + (pc & 7) * 16) = pfx[q]; }
        if (FINAL) {
#pragma unroll
            for (int q = 0; q < 4; ++q) { const int pc = ln + 64 * q; *(LAS v4u*)((LAS unsigned char*)GS + (pc >> 3) * 128 + (pc & 7) * 16) = pfg[q]; } }
        if (blk < 3) { LRU_FETCH(blk + 1); }
        asm volatile("" ::: "memory");
        float xc[2][16];
#pragma unroll
        for (int n = 0; n < 2; ++n)
#pragma unroll
            for (int g = 0; g < 4; ++g) { float xv[7];
#pragma unroll
                for (int q = 0; q < 7; ++q) xv[q] = bf2f(XS[(8 * g + 4 * hi + q) * 64 + 32 * n + j32]);
#pragma unroll
                for (int e = 0; e < 4; ++e) xc[n][4 * g + e] = c_cb[n] + ((c_cw[n][0] * xv[e] + c_cw[n][1] * xv[e + 1]) + (c_cw[n][2] * xv[e + 2] + c_cw[n][3] * xv[e + 3])); }
#pragma unroll
        for (int n = 0; n < 2; ++n)
#pragma unroll
            for (int r = 0; r < 16; ++r) XC[(crow16(r) + 4 * hi) * XC_STRIDE + 32 * n + j32] = (unsigned short)f2bf(xc[n][r]);
        asm volatile("" ::: "memory");
        bf16x8 af[4];
#pragma unroll
        for (int ks = 0; ks < 4; ++ks) af[ks] = *(const LAS bf16x8*)(XC + j32 * XC_STRIDE + 16 * ks + 8 * hi);
        asm volatile("" ::: "memory");
        float yv[2][16];
#pragma unroll
        for (int n = 0; n < 2; ++n) {
            f32x16 R = {}, I = {};
            bf16x8 fa[4], fx[4];
#pragma unroll
            for (int ks = 0; ks < 4; ++ks) { fa[ks] = *(const GAS bf16x8*)(wax + (size_t)(((w * 2 + 0) * 2 + n) * 4 + ks) * 512 + ln * 8); fx[ks] = *(const GAS bf16x8*)(wax + (size_t)(((w * 2 + 1) * 2 + n) * 4 + ks) * 512 + ln * 8); }
#pragma unroll
            for (int ks = 0; ks < 4; ++ks) { R = __builtin_amdgcn_mfma_f32_32x32x16_bf16(af[ks], fa[ks], R, 0, 0, 0); I = __builtin_amdgcn_mfma_f32_32x32x16_bf16(af[ks], fx[ks], I, 0, 0, 0); }
            float av[16], uv[16];
#pragma unroll
            for (int r = 0; r < 16; ++r) { const float rg = sigm(R[r] + c_ba[n]), ig = sigm(I[r] + c_bx[n]); const float a_ = __builtin_amdgcn_exp2f(-rg * c_sp[n]);
                av[r] = a_; uv[r] = __builtin_amdgcn_sqrtf(fmaxf(1.f - a_ * a_, 0.f)) * (ig * xc[n][r]); }
            float Ar[4], Hr[4], hst[4];
#pragma unroll
            for (int g = 0; g < 4; ++g) { Ar[g] = (av[4 * g] * av[4 * g + 1]) * (av[4 * g + 2] * av[4 * g + 3]);
                Hr[g] = ((uv[4 * g] * av[4 * g + 1] + uv[4 * g + 1]) * av[4 * g + 2] + uv[4 * g + 2]) * av[4 * g + 3] + uv[4 * g + 3]; }
            float hin = hc[n];
#pragma unroll
            for (int g = 0; g < 4; ++g) { float o1 = Ar[g] * hin + Hr[g]; const float x = __shfl_xor(o1, 32); const float hg = hi ? x : hin; o1 = Ar[g] * hg + Hr[g]; hst[g] = hg;
                const float y = __shfl_xor(o1, 32); hin = hi ? o1 : y;
                if (!FINAL) ap[n] *= Ar[g] * __shfl_xor(Ar[g], 32); }
            hc[n] = hin;
            if (FINAL) {
#pragma unroll
                for (int g = 0; g < 4; ++g) { float h = hst[g];
#pragma unroll
                    for (int e = 0; e < 4; ++e) { const int r = 4 * g + e; h = av[r] * h + uv[r]; yv[n][r] = h * bf2f(GS[(crow16(r) + 4 * hi) * 64 + 32 * n + j32]); } } }
        }
        if (FINAL) {
#pragma unroll
            for (int r = 0; r < 16; ++r) { float s = yv[0][r] * yv[0][r] + yv[1][r] * yv[1][r];
                s += __shfl_xor(s, 1); s += __shfl_xor(s, 2); s += __shfl_xor(s, 4); s += __shfl_xor(s, 8); s += __shfl_xor(s, 16);
                if (j32 == 0) SS[(crow16(r) + 4 * hi) * 8 + w] = s; }
            __syncthreads();
            bf16* ymix = (bf16*)(ws + WS_H);
#pragma unroll
            for (int r = 0; r < 16; ++r) { const int tk = crow16(r) + 4 * hi; const f32x4 s0 = *(const LAS f32x4*)(SS + tk * 8), s1 = *(const LAS f32x4*)(SS + tk * 8 + 4);
                const float rstd = rsqrtf(((s0[0] + s0[1]) + (s0[2] + s0[3]) + (s1[0] + s1[1]) + (s1[2] + s1[3])) * (1.f / LW) + RMS_EPS);
                bf16* yp = ymix + (tb + tk) * DMODEL + 64 * w + k32;
                yp[0] = (bf16)f2bf(yv[0][r] * rstd); yp[32] = (bf16)f2bf(yv[1][r] * rstd); }
            __syncthreads();
        }
    }
#undef LRU_FETCH
    if (!FINAL) { if (hi == 0) { float* cp = carry + ((size_t)(b * NTILE + jt) * 2) * LW + 64 * w + j32;
#pragma unroll
        for (int n = 0; n < 2; ++n) { cp[32 * n] = ap[n]; cp[LW + 32 * n] = hc[n]; } } }
    else {
        const bf16* ob = (const bf16*)(ws + WS_O); bf16* ymix = (bf16*)(ws + WS_H);
        for (int i0 = 0; i0 < 16; i0 += 4) {
            v4u vv[4];
#pragma unroll
            for (int i = 0; i < 4; ++i) vv[i] = *(const GAS v4u*)(ob + (trow0 + 16 * w + i0 + i) * AW + 8 * lane);
            float ssq[4];
#pragma unroll
            for (int i = 0; i < 4; ++i) { float s = 0.f;
#pragma unroll
                for (int c = 0; c < 4; ++c) { const float lo = __uint_as_float(vv[i][c] << 16), hi2 = __uint_as_float(vv[i][c] & 0xffff0000u); s += lo * lo + hi2 * hi2; }
                ssq[i] = s; }
#pragma unroll
            for (int o = 1; o < 64; o <<= 1) {
#pragma unroll
                for (int i = 0; i < 4; ++i) ssq[i] += __shfl_xor(ssq[i], o); }
#pragma unroll
            for (int i = 0; i < 4; ++i) { const float rstd = rsqrtf(ssq[i] * (1.f / AW) + RMS_EPS); v4u o;
#pragma unroll
                for (int c = 0; c < 4; ++c) o[c] = pk2(__uint_as_float(vv[i][c] << 16) * rstd, __uint_as_float(vv[i][c] & 0xffff0000u) * rstd);
                *(GAS v4u*)(ymix + (trow0 + 16 * w + i0 + i) * DMODEL + LW + 8 * lane) = o; } }
    }
}
__device__ __forceinline__ void norm_pass(Frame& F, const Args& a) {
    unsigned char* ws = a.ws; float* nrm = (float*)(ws + WS_NRM);
    const int gw = F.vcu * NWAVES + F.wave, NGW = F.G * NWAVES, lane = F.lane;
    for (int it = gw; it < 2 * BATCH * (SEQ / 64); it += NGW) {
        const int which = it / (BATCH * (SEQ / 64)), r = it % (BATCH * (SEQ / 64)), b = r / (SEQ / 64), t = r % (SEQ / 64);
        const bf16* src = (const bf16*)(ws + (which ? WS_K : WS_Q)) + ((size_t)b * SEQ + 64 * t) * AW + 8 * lane;
        float mx = 0.f;
#pragma unroll 8
        for (int i = 0; i < 64; ++i) { const v4u v = *(const GAS v4u*)(src + (size_t)i * AW); float s = 0.f;
#pragma unroll
            for (int c = 0; c < 4; ++c) { const float lo = __uint_as_float(v[c] << 16), hi = __uint_as_float(v[c] & 0xffff0000u); s += lo * lo + hi * hi; }
            s += __shfl_xor(s, 1); s += __shfl_xor(s, 2); s += __shfl_xor(s, 4); mx = fmaxf(mx, s); }
        if ((lane & 7) == 0) nrm[which * 4096 + (b * NHEADS + (lane >> 3)) * 128 + t] = sqrtf(mx) * 1.0001f;
    }
}
__device__ __forceinline__ void carry_prefix(Frame& F, const Args& a, int b) {
    const float* carry = (const float*)(a.ws + WS_CARRY) + (size_t)b * NTILE * 2 * LW + F.tid; float* cin = (float*)(a.ws + WS_CIN) + (size_t)b * NTILE * LW + F.tid;
    float c = 0.f;
    for (int j0 = 0; j0 < NTILE; j0 += 8) { float A[8], H[8];
#pragma unroll
        for (int j = 0; j < 8; ++j) { A[j] = carry[(size_t)(j0 + j) * 2 * LW]; H[j] = carry[(size_t)(j0 + j) * 2 * LW + LW]; }
#pragma unroll
        for (int j = 0; j < 8; ++j) { cin[(size_t)(j0 + j) * LW] = c; c = A[j] * c + H[j]; } }
}
template <bool FINAL> __device__ __forceinline__ void lru_phase(Frame& F, const Args& a) {
    for (int tile = F.vcu; tile < BATCH * NTILE; tile += F.G) { lru_tile<FINAL>(F, a, tile); __syncthreads(); }
}
}
__global__ void __launch_bounds__(NWAVES * 64, 2) mk_fwd(Args args) {
    extern __shared__ __attribute__((aligned(16))) unsigned char lds[];
    Frame F;
    F.lds = (LAS unsigned char*)lds;
    F.MISC = (volatile LAS unsigned*)(F.lds + MISC_OFF);
    F.wave = __builtin_amdgcn_readfirstlane((int)threadIdx.x >> 6); F.lane = (int)__builtin_amdgcn_mbcnt_hi(~0u, __builtin_amdgcn_mbcnt_lo(~0u, 0u)); F.tid = F.wave * 64 + F.lane;
    F.G = gridDim.x; { const int bx = blockIdx.x; F.vcu = (F.G % 8 == 0) ? (bx % 8) * (F.G / 8) + bx / 8 : bx; }
    unsigned char* ws = args.ws;
    F.ctl = (gu32*)(ws + WS_CTL);
    for (int u = F.tid; u < (LDS_BYTES - LDSCTL_OFF) / 4; u += NWAVES * 64) ((LAS unsigned*)(F.lds + LDSCTL_OFF))[u] = 0u;
    __syncthreads();
    XcdBarrier bar = xcd_barrier_post((unsigned*)(F.ctl + CW_BAR) + args.li * XCD_BAR_WORDS, F.MISC + 8, F.wave);
    const int lo = args.ph_lo, hi = args.ph_hi;
#define IN(k) (lo <= (k) && (k) < hi)
#define BOTH(k) (IN(k) && IN((k) + 1))
#define GRID_BAR() xcd_barrier(bar)

    if (IN(0)) { p0_prologue(F, args); if (BOTH(0)) GRID_BAR(); }

    if (IN(1)) {
        if (F.vcu < BATCH * NHEADS) fcum_unit(F, F.vcu, (const float*)(ws + WS_LOGF), (float*)(ws + WS_FCUM));
        pg8::Gemm g{(const pg8::bf16_t*)(ws + WS_H), (const pg8::bf16_t*)(ws + WS_WIN), T, NG1, DMODEL}; pg8::StaticOrder S; S.init(T, NG1, F.G, (int)blockIdx.x);
        pg8::EpiG1 E{(pg8::bf16_t*)(ws + WS_XR), SPLIT_STRIDE, QSCALE};
        pg8::gemm_phase<pg8::EpiG1, pg8::StaticOrder, true, true>(F.lds + RING_OFF, g, S, E, F.wave);
        if (BOTH(1)) GRID_BAR();
    }
    if (IN(2)) { lru::lru_phase<false>(F, args); lru::norm_pass(F, args); if (BOTH(2)) GRID_BAR(); }
    if (IN(3)) {
        static_assert(attn_body::ATTN_LDS_BYTES <= RING_BYTES, "attention LDS vs frame");
        if (F.vcu < BATCH) lru::carry_prefix(F, args, F.vcu);
        const attn_body::AttnTensors AT{(const attn_body::bf16*)(ws + WS_Q), (const attn_body::bf16*)(ws + WS_K), (const attn_body::bf16*)(ws + WS_V), (attn_body::bf16*)(ws + WS_O), (const float*)(ws + WS_FCUM), (const float*)(ws + WS_NRM)};
        attn_body::attn_phase<8>((char*)lds + RING_OFF, AT, (unsigned*)(F.ctl + CW_ATTQ), F.MISC + 24, F.wave);
        if (BOTH(3)) GRID_BAR();
    }
    if (IN(4)) { lru::lru_phase<true>(F, args); if (BOTH(4)) GRID_BAR(); }
    if (IN(5)) {
        pg8::Gemm g{(const pg8::bf16_t*)(ws + WS_H), (const pg8::bf16_t*)(ws + WS_WOUT), T, DMODEL, DMODEL}; pg8::StaticOrder S; S.init(T, DMODEL, F.G, (int)blockIdx.x);
        pg8::EpiG2 E{args.in[0], args.out, (pg8::bf16_t*)(ws + WS_X1B), (float*)(ws + WS_SUMSQ), DMODEL};
        pg8::gemm_phase<pg8::EpiG2, pg8::StaticOrder, true, true>(F.lds + RING_OFF, g, S, E, F.wave);
        if (BOTH(5)) GRID_BAR();
    }
    if (IN(6)) {
        pg8::Gemm g{(const pg8::bf16_t*)(ws + WS_X1B), (const pg8::bf16_t*)(ws + WS_WQ), T, QPW, DMODEL}; pg8::StaticOrder S; S.init(T, QPW, F.G, (int)blockIdx.x);
        pg8::EpiG3 E{(pg8::bf16_t*)(ws + WS_QP), QPW};
        pg8::gemm_phase<pg8::EpiG3, pg8::StaticOrder, true, true>(F.lds + RING_OFF, g, S, E, F.wave);
        if (BOTH(6)) GRID_BAR();
    }
    if (IN(7)) { peer::peer_phase(F, args); }
#undef IN
#undef BOTH
#undef GRID_BAR
}

extern "C" void kernel_launch(void* const* d_in, const int* in_sizes, int n_in, void* d_out, int out_size, void* d_ws, size_t ws_size, hipStream_t stream) {
    static int grid = 0;
    if (grid == 0) {
        if (n_in != 20 || in_sizes[0] != T * DMODEL || out_size != T * DMODEL || ws_size < WS_END) { fprintf(stderr, "kernel_launch: unexpected shapes (n_in %d, ws %zu)\n", n_in, ws_size); grid = -1; return; }
        int dev = 0, cus = 0;
        if (hipGetDevice(&dev) != hipSuccess || hipDeviceGetAttribute(&cus, hipDeviceAttributeMultiprocessorCount, dev) != hipSuccess) { grid = -1; return; }
        if (hipFuncSetAttribute((const void*)mk_fwd, hipFuncAttributeMaxDynamicSharedMemorySize, LDS_BYTES) != hipSuccess) { fprintf(stderr, "kernel_launch: hipFuncSetAttribute failed\n"); grid = -1; return; }
        (void)hipGetLastError();
        grid = cus;
    }
    if (grid < 0) return;
    if (hipMemsetAsync((char*)d_ws + WS_CTL, 0, CTL_ZERO_BYTES, stream) != hipSuccess) return;
    Args a{};
    for (int i = 0; i < 20; ++i) a.in[i] = (const float*)d_in[i];
    a.out = (float*)d_out; a.ws = (unsigned char*)d_ws; a.ph_lo = 0; a.ph_hi = N_PHASES; a.li = 0;
    hipLaunchKernelGGL(mk_fwd, dim3(grid), dim3(NWAVES * 64), LDS_BYTES, stream, a);
}
```

```cpp
#include <hip/hip_runtime.h>
#include <hip/hip_bf16.h>
#include <cstdio>
#include <cstdint>
#include <cmath>

constexpr int BATCH = 4, SEQ = 8192, DMODEL = 1024, T = BATCH * SEQ;
constexpr int LW = 512, AW = 512, NHEADS = 8, HD = 64, INC = 2568, NG1 = 2560;
constexpr int PH = 8, NKEY = 128, PHALF = 128, TOPK = 16, NEXP = NKEY * NKEY, QPW = 2048;
constexpr float RMS_EPS = 1e-6f;
constexpr float LOG2E = 1.4426950408889634f;
constexpr float QSCALE = 0.125f * LOG2E;
constexpr size_t MiB = 1u << 20;
constexpr size_t WS_CTL = 0, CTL_ZERO_BYTES = 1 * MiB;
constexpr size_t WS_WIN = 2 * MiB, WS_WOUT = 8 * MiB, WS_WQ = 10 * MiB, WS_SKB = 14 * MiB, WS_WFL = 15 * MiB,
                 WS_LOGF = 16 * MiB, WS_FCUM = 17 * MiB, WS_CARRY = 18 * MiB, WS_SUMSQ = 19 * MiB, WS_WAX = 20 * MiB, WS_CIN = 23 * MiB  , WS_NRM = 22 * MiB  ,
                 WS_H = 32 * MiB, WS_XR = 96 * MiB, WS_GR = 128 * MiB, WS_Q = 160 * MiB, WS_K = 192 * MiB, WS_V = 224 * MiB,
                 WS_X1B = 256 * MiB, WS_O = 256 * MiB  , WS_QP = 96 * MiB, WS_UT = 320 * MiB, WS_VT = 352 * MiB, WS_U8 = 320 * MiB, WS_V8 = 336 * MiB, WS_SU = 21 * MiB, WS_SV = 21 * MiB + 65536, WS_LA = 384 * MiB, WS_LU = 448 * MiB, WS_END = 512 * MiB;
constexpr size_t SPLIT_STRIDE = (WS_GR - WS_XR) / 2;
constexpr int CW_TMO = 0, CW_ATTQ = 2048, CW_BAR = 4096;

namespace pg8 {
#define PG8_LAS __attribute__((address_space(3)))
typedef unsigned short bf16_t;
typedef short bf16x8 __attribute__((ext_vector_type(8)));
typedef float f32x4 __attribute__((ext_vector_type(4)));
typedef unsigned u32x4 __attribute__((ext_vector_type(4)));
constexpr int BM = 256, BK = 64, HALF = 128, HTB = HALF * BK * 2  , STAGE_BYTES = 8 * HTB, NXCD = 8, WGM = 8;

__host__ __device__ __forceinline__ int lds_byte(int r, int c) { const int st = (r >> 4) * 2 + (c >> 5), rr = r & 15, cc = c & 31, ob = rr * 64 + cc * 2; return st * 1024 + (ob ^ (((ob >> 9) & 1) << 5)); }
__host__ __device__ __forceinline__ void stage_rc(int b, int& R, int& C) { const int st = b / 1024, sb = b % 1024, swz = sb ^ (((sb >> 9) & 1) << 5); R = (st >> 1) * 16 + swz / 64; C = (st & 1) * 32 + (swz % 64) / 2; }
__host__ __device__ __forceinline__ int perm32(int rho) { const int n = rho >> 4, i = rho & 15; return 8 * (i >> 2) + 4 * n + (i & 3); }

struct Unit { int pm, pn; };
struct Gemm { const bf16_t* A; const bf16_t* Bt; int M, N, K; };

struct StaticOrder {
    int nM, nN, nwg, G, c;
    __host__ __device__ void init(int M, int N, int G_, int c_) { nM = M / BM; nN = N / BM; nwg = nM * nN; G = G_; c = c_; }
    __host__ __device__ bool next(int i, Unit& u) const {
        const long L = (long)i * G + c; if (L >= nwg) return false;
        int wgid = (int)L; { const int q = nwg / NXCD, r = nwg % NXCD, xcd = wgid % NXCD, off = wgid / NXCD; wgid = (xcd < r ? xcd * (q + 1) : r * (q + 1) + (xcd - r) * q) + off; }
        const int nig = WGM * nN, gid = wgid / nig, fm = gid * WGM, gsz = (nM - fm) < WGM ? (nM - fm) : WGM;
        u.pm = fm + ((wgid % nig) % gsz); u.pn = (wgid % nig) / gsz; return true;
    }
    __device__ __forceinline__ void a_ready(const Unit&) const {}
    __device__ __forceinline__ void done(const Unit&) const {}
};

__device__ __forceinline__ unsigned cvt_pk_bf16(float lo, float hi) { unsigned r; asm volatile("v_cvt_pk_bf16_f32 %0, %1, %2" : "=v"(r) : "v"(lo), "v"(hi)); return r; }
typedef unsigned u32x2 __attribute__((ext_vector_type(2)));
__device__ __forceinline__ float gelu_fast(float x) {
    const float u2 = x * (1.5957691216057308f + 0.07135481627f * x * x);
    return x * __builtin_amdgcn_rcpf(1.f + __builtin_amdgcn_exp2f(-1.4426950408889634f * u2));
}
struct EpiG1 {
    static constexpr bool PERM = true, AFTER_DRAIN = false;
    bf16_t* base0; size_t split_stride; float qscale;
    __device__ __forceinline__ void operator()(const f32x4 (&acc)[2][2][4][2], const Unit& u, int wr, int wc, int fr, int fq) const {
        const int s = u.pn >> 1; bf16_t* base = base0 + (size_t)s * split_stride;
        const int row0 = u.pm * BM + wr * 64 + fr, col0 = (u.pn & 1) * 256 + wc * 32 + 8 * fq;
#pragma unroll
        for (int ai = 0; ai < 2; ++ai)
#pragma unroll
            for (int m = 0; m < 4; ++m) { bf16_t* rowp = base + (size_t)(row0 + ai * HALF + m * 16) * 512 + col0;
#pragma unroll
                for (int bj = 0; bj < 2; ++bj) { f32x4 v0 = acc[ai][bj][m][0], v1 = acc[ai][bj][m][1];
                    if (s == 1) {
#pragma unroll
                        for (int e = 0; e < 4; ++e) { v0[e] = gelu_fast(v0[e]); v1[e] = gelu_fast(v1[e]); } }
                    else if (s == 2) { v0 = v0 * qscale; v1 = v1 * qscale; }
                    u32x4 w; w.x = cvt_pk_bf16(v0[0], v0[1]); w.y = cvt_pk_bf16(v0[2], v0[3]); w.z = cvt_pk_bf16(v1[0], v1[1]); w.w = cvt_pk_bf16(v1[2], v1[3]);
                    *(u32x4*)(rowp + bj * HALF) = w; } }
    }
};
struct EpiG2 {
    static constexpr bool PERM = false, AFTER_DRAIN = false;
    const float* resid; float* out; bf16_t* xb; float* sumsq; int ldc;
    __device__ __forceinline__ void operator()(const f32x4 (&acc)[2][2][4][2], const Unit& u, int wr, int wc, int fr, int fq) const {
        const int row0 = u.pm * BM + wr * 64 + fr, col0 = u.pn * BM + wc * 32 + 4 * fq;
#pragma unroll
        for (int ai = 0; ai < 2; ++ai) {
            f32x4 rs[4][2][2];
#pragma unroll
            for (int m = 0; m < 4; ++m) { const size_t off = (size_t)(row0 + ai * HALF + m * 16) * ldc + col0;
#pragma unroll
                for (int bj = 0; bj < 2; ++bj)
#pragma unroll
                    for (int n = 0; n < 2; ++n) rs[m][bj][n] = *(const f32x4*)(resid + off + bj * HALF + n * 16); }
#pragma unroll
            for (int m = 0; m < 4; ++m) { const int r = row0 + ai * HALF + m * 16; const size_t off = (size_t)r * ldc + col0; float ss = 0.f;
#pragma unroll
                for (int bj = 0; bj < 2; ++bj)
#pragma unroll
                    for (int n = 0; n < 2; ++n) { const f32x4 x = rs[m][bj][n] + acc[ai][bj][m][n];
                        *(f32x4*)(out + off + bj * HALF + n * 16) = x; ss += (x[0] * x[0] + x[1] * x[1]) + (x[2] * x[2] + x[3] * x[3]);
                        u32x2 w; w.x = cvt_pk_bf16(x[0], x[1]); w.y = cvt_pk_bf16(x[2], x[3]); *(u32x2*)(xb + off + bj * HALF + n * 16) = w; }
                ss += __shfl_xor(ss, 16); ss += __shfl_xor(ss, 32);
                if (fq == 0) atomicAdd(sumsq + r, ss); }
            asm volatile("" ::: "memory"); }
    }
};
struct EpiG3 {
    static constexpr bool PERM = true, AFTER_DRAIN = false;
    bf16_t* O; int ldc;
    __device__ __forceinline__ void operator()(const f32x4 (&acc)[2][2][4][2], const Unit& u, int wr, int wc, int fr, int fq) const {
        const int row0 = u.pm * BM + wr * 64 + fr, col0 = u.pn * BM + wc * 32 + 8 * fq;
#pragma unroll
        for (int ai = 0; ai < 2; ++ai)
#pragma unroll
            for (int m = 0; m < 4; ++m) { bf16_t* rowp = O + (size_t)(row0 + ai * HALF + m * 16) * ldc + col0;
#pragma unroll
                for (int bj = 0; bj < 2; ++bj) { const f32x4 v0 = acc[ai][bj][m][0], v1 = acc[ai][bj][m][1];
                    u32x4 w; w.x = cvt_pk_bf16(v0[0], v0[1]); w.y = cvt_pk_bf16(v0[2], v0[3]); w.z = cvt_pk_bf16(v1[0], v1[1]); w.w = cvt_pk_bf16(v1[2], v1[3]);
                    *(u32x4*)(rowp + bj * HALF) = w; } }
    }
};

template <class Epi, class Sched, bool ALIGN_EPI = false, bool SP2 = false>
__device__ __forceinline__ void gemm_phase(PG8_LAS unsigned char* lds, const Gemm g, const Sched& S, const Epi& E, int wid_in) {
    const int wid = __builtin_amdgcn_readfirstlane(wid_in), lane = (int)__builtin_amdgcn_mbcnt_hi(~0u, __builtin_amdgcn_mbcnt_lo(~0u, 0u)), tid = wid * 64 + lane, wr = wid >> 2, wc = wid & 3, fr = lane & 15, fq = lane >> 4;
    const int K = g.K, nt = K / BK;
    unsigned voffA[2], voffB[2];
#pragma unroll
    for (int i = 0; i < 2; ++i) { int R, C; stage_rc(tid * 16 + i * 8192, R, C); const int Rb = Epi::PERM ? ((R & ~31) + perm32(R & 31)) : R;
        voffA[i] = (unsigned)(R * K + C) * 2u; voffB[i] = (unsigned)(Rb * K + C) * 2u; }
    const size_t kstep = (size_t)(BK * 2);
    const size_t hstep = (size_t)HALF * K * 2;
    const size_t tstep = 2 * hstep;
    const unsigned ldsw = (unsigned)wid * 1024u;
    const int aoff = lds_byte(wr * 64 + fr, fq * 8), boff = lds_byte(wc * 32 + fr, fq * 8);
#define PG8_SA(b, h) (((b) * 2 + (h)) * HTB)
#define PG8_SB(b, h) ((4 + (b) * 2 + (h)) * HTB)
#define PG8_STAGE(bufoff, gbase, voff) do { _Pragma("unroll") for (int _i = 0; _i < 2; ++_i) \
        __builtin_amdgcn_global_load_lds((const unsigned*)((const char*)(gbase) + (voff)[_i]), (PG8_LAS unsigned*)(lds + (bufoff) + ldsw + _i * 8192), 16, 0, 0); } while (0)
#define PG8_LDA(dst, b, h) do { _Pragma("unroll") for (int m = 0; m < 4; ++m) _Pragma("unroll") for (int k = 0; k < 2; ++k) dst[m][k] = *(const PG8_LAS bf16x8*)(lds + PG8_SA(b, h) + aoff + m * 2048 + k * 1024); } while (0)
#define PG8_LDB(dst, b, h) do { _Pragma("unroll") for (int n = 0; n < 2; ++n) _Pragma("unroll") for (int k = 0; k < 2; ++k) dst[n][k] = *(const PG8_LAS bf16x8*)(lds + PG8_SB(b, h) + boff + n * 2048 + k * 1024); } while (0)
#define PG8_MMA(ai, bj, At, Bt) do { __builtin_amdgcn_s_setprio(1); _Pragma("unroll") for (int m = 0; m < 4; ++m) _Pragma("unroll") for (int n = 0; n < 2; ++n) _Pragma("unroll") for (int k = 0; k < 2; ++k) \
        acc[ai][bj][m][n] = __builtin_amdgcn_mfma_f32_16x16x32_bf16(Bt[n][k], At[m][k], acc[ai][bj][m][n], 0, 0, 0); __builtin_amdgcn_s_setprio(0); } while (0)
#define PG8_WAIT_V(n) asm volatile("s_waitcnt vmcnt(" #n ")" ::: "memory")
#define PG8_WAIT_L(n) asm volatile("s_waitcnt lgkmcnt(" #n ")" ::: "memory")
#define PG8_BAR __builtin_amdgcn_s_barrier()
#define PG8_SCHED __builtin_amdgcn_sched_barrier(0)
    Unit cur, nxt; int ui = 0;
    if (!S.next(0, cur)) return;
    f32x4 acc[2][2][4][2];
#pragma unroll
    for (int a = 0; a < 2; ++a)
#pragma unroll
        for (int b = 0; b < 2; ++b)
#pragma unroll
            for (int m = 0; m < 4; ++m)
#pragma unroll
                for (int n = 0; n < 2; ++n) acc[a][b][m][n] = (f32x4){0.f, 0.f, 0.f, 0.f};
    bf16x8 At[4][2], B0[2][2], B1[2][2];
    const char* cA = (const char*)g.A + (size_t)cur.pm * tstep; const char* cB = (const char*)g.Bt + (size_t)cur.pn * tstep;
    S.a_ready(cur);
    if constexpr (SP2) {
        PG8_STAGE(PG8_SB(0, 0), cB, voffB); PG8_STAGE(PG8_SB(0, 1), cB + hstep, voffB); PG8_STAGE(PG8_SA(0, 0), cA, voffA); PG8_STAGE(PG8_SA(0, 1), cA + hstep, voffA);
        if (wr == 1) PG8_BAR;
        PG8_WAIT_V(2); PG8_BAR;
        PG8_STAGE(PG8_SB(1, 0), cB + kstep, voffB); PG8_STAGE(PG8_SA(1, 0), cA + kstep, voffA); PG8_STAGE(PG8_SB(1, 1), cB + hstep + kstep, voffB);
        PG8_WAIT_V(6); PG8_BAR;
    } else {
        PG8_STAGE(PG8_SB(0, 0), cB, voffB); PG8_STAGE(PG8_SA(0, 0), cA, voffA); PG8_STAGE(PG8_SB(0, 1), cB + hstep, voffB); PG8_STAGE(PG8_SA(0, 1), cA + hstep, voffA);
        if (wr == 1) PG8_BAR;
        PG8_WAIT_V(4); PG8_BAR;
        PG8_STAGE(PG8_SB(1, 0), cB + kstep, voffB); PG8_STAGE(PG8_SA(1, 0), cA + kstep, voffA); PG8_STAGE(PG8_SB(1, 1), cB + hstep + kstep, voffB);
        PG8_WAIT_V(6); PG8_BAR;
    }
    for (;;) {
        const bool has_next = S.next(ui + 1, nxt);
        const char* nA = has_next ? (const char*)g.A + (size_t)nxt.pm * tstep : cA; const char* nB = has_next ? (const char*)g.Bt + (size_t)nxt.pn * tstep : cB;
        for (int t = 0; t < nt; t += 2) {
            const bool last = (t == nt - 2);
            const char* a1 = cA + (size_t)(t + 1) * kstep;
            const char* a2 = last ? nA : cA + (size_t)(t + 2) * kstep; const char* b2 = last ? nB : cB + (size_t)(t + 2) * kstep;
            const char* a3 = a2 + kstep; const char* b3 = b2 + kstep;
            if (last && has_next) S.a_ready(nxt);
            if constexpr (SP2) {
            PG8_LDB(B0, 0, 0); PG8_LDB(B1, 0, 1); PG8_SCHED; PG8_LDA(At, 0, 0); PG8_STAGE(PG8_SA(1, 1), a1 + hstep, voffA);
            PG8_WAIT_V(8); PG8_WAIT_L(0); PG8_BAR; PG8_MMA(0, 0, At, B0); PG8_MMA(0, 1, At, B1); PG8_BAR; PG8_SCHED;
            PG8_LDA(At, 0, 1); PG8_STAGE(PG8_SB(0, 0), b2, voffB); PG8_STAGE(PG8_SB(0, 1), b2 + hstep, voffB); PG8_STAGE(PG8_SA(0, 0), a2, voffA);
            PG8_WAIT_V(8); PG8_WAIT_L(0); PG8_BAR; PG8_MMA(1, 0, At, B0); PG8_MMA(1, 1, At, B1); PG8_BAR; PG8_SCHED;
            PG8_LDB(B0, 1, 0); PG8_LDB(B1, 1, 1); PG8_SCHED; PG8_LDA(At, 1, 0); PG8_STAGE(PG8_SA(0, 1), a2 + hstep, voffA);
            PG8_WAIT_V(8); PG8_WAIT_L(0); PG8_BAR; PG8_MMA(0, 0, At, B0); PG8_MMA(0, 1, At, B1); PG8_BAR; PG8_SCHED;
            PG8_LDA(At, 1, 1); PG8_STAGE(PG8_SB(1, 0), b3, voffB); PG8_STAGE(PG8_SB(1, 1), b3 + hstep, voffB); PG8_STAGE(PG8_SA(1, 0), a3, voffA);
            PG8_WAIT_V(8); PG8_WAIT_L(0); PG8_BAR; PG8_MMA(1, 0, At, B0); PG8_MMA(1, 1, At, B1); PG8_BAR; PG8_SCHED;
            } else {
            PG8_LDB(B0, 0, 0); PG8_SCHED; PG8_LDA(At, 0, 0); PG8_STAGE(PG8_SA(1, 1), a1 + hstep, voffA);
            PG8_WAIT_L(8); PG8_BAR; PG8_WAIT_L(0); PG8_MMA(0, 0, At, B0); PG8_BAR; PG8_SCHED;
            PG8_LDB(B1, 0, 1); PG8_STAGE(PG8_SB(0, 0), b2, voffB);
            PG8_BAR; PG8_WAIT_L(0); PG8_MMA(0, 1, At, B1); PG8_BAR;
            PG8_LDA(At, 0, 1); PG8_STAGE(PG8_SA(0, 0), a2, voffA);
            PG8_BAR; PG8_WAIT_L(0); PG8_MMA(1, 0, At, B0); PG8_BAR; PG8_SCHED;
            PG8_STAGE(PG8_SB(0, 1), b2 + hstep, voffB);
            PG8_WAIT_V(6); PG8_BAR; PG8_MMA(1, 1, At, B1); PG8_BAR;
            PG8_LDB(B0, 1, 0); PG8_SCHED; PG8_LDA(At, 1, 0); PG8_STAGE(PG8_SA(0, 1), a2 + hstep, voffA);
            PG8_WAIT_L(8); PG8_BAR; PG8_WAIT_L(0); PG8_MMA(0, 0, At, B0); PG8_BAR; PG8_SCHED;
            PG8_LDB(B1, 1, 1); PG8_STAGE(PG8_SB(1, 0), b3, voffB);
            PG8_BAR; PG8_WAIT_L(0); PG8_MMA(0, 1, At, B1); PG8_BAR;
            PG8_LDA(At, 1, 1); PG8_STAGE(PG8_SA(1, 0), a3, voffA);
            PG8_BAR; PG8_WAIT_L(0); PG8_MMA(1, 0, At, B0); PG8_BAR; PG8_SCHED;
            PG8_STAGE(PG8_SB(1, 1), b3 + hstep, voffB);
            PG8_WAIT_V(6); PG8_BAR; PG8_MMA(1, 1, At, B1); PG8_BAR;
            }
        }
        if constexpr (ALIGN_EPI) { if (wr == 0) PG8_BAR; }
        if constexpr (!Epi::AFTER_DRAIN) { E(acc, cur, wr, wc, fr, fq); S.done(cur); }
        if (!has_next) break;
#pragma unroll
        for (int a = 0; a < 2; ++a)
#pragma unroll
            for (int b = 0; b < 2; ++b)
#pragma unroll
                for (int m = 0; m < 4; ++m)
#pragma unroll
                    for (int n = 0; n < 2; ++n) acc[a][b][m][n] = (f32x4){0.f, 0.f, 0.f, 0.f};
        cur = nxt; cA = nA; cB = nB; ++ui;
        if constexpr (ALIGN_EPI) { if (wr == 1) PG8_BAR; }
    }
    PG8_WAIT_V(0);
    if constexpr (!ALIGN_EPI) { if (wr == 0) PG8_BAR; }
    PG8_BAR;
    if constexpr (Epi::AFTER_DRAIN) { E.fused(acc, cur, wr, wc, fr, fq, lds, wid, lane); S.done(cur); }
#undef PG8_SA
#undef PG8_SB
#undef PG8_STAGE
#undef PG8_LDA
#undef PG8_LDB
#undef PG8_MMA
#undef PG8_WAIT_V
#undef PG8_WAIT_L
#undef PG8_BAR
#undef PG8_SCHED
}
}
#include <hip/hip_bf16.h>
#include <cmath>
namespace attn_body {
using bf16=__hip_bfloat16;
using bf16x8=__attribute__((ext_vector_type(8)))short;
using s16x4=__attribute__((ext_vector_type(4)))short;
using f32x16=__attribute__((ext_vector_type(16)))float;
using u32x4=__attribute__((ext_vector_type(4)))unsigned;
constexpr int BATCH=4,NHEAD=8,SEQ=8192,D=64,DM=NHEAD*D;
constexpr int NW=8,QBLK=32,QB=QBLK*NW,KVBLK=64,NQB=SEQ/QB;
constexpr int ATTN_PITCH=DM, ATTN_UNIT_ROWS=QB;
__device__ __forceinline__ int crow(int r,int hi){return (r&3)+8*(r>>2)+4*hi;}
#define SBAR() __builtin_amdgcn_sched_barrier(0)
__device__ __forceinline__ void cmask(f32x16&p0,f32x16&p1,int jb,int qrel,int hi){
  const float NEG=-INFINITY; int kb=64*jb+4*hi;
  #pragma unroll
  for(int r=0;r<16;++r){int kv=kb+(r&3)+8*(r>>2); if(kv>qrel)p0[r]=NEG; if(kv+32>qrel)p1[r]=NEG;}
}

constexpr int NSLOT=3, SLOTB=8192;
constexpr int LDS_K=0, LDS_V=NSLOT*SLOTB, LDS_WS=2*NSLOT*SLOTB, LDS_OST=LDS_WS+NW*64*4, LDS_FK=LDS_OST+NW*4096, LDS_BYTES=LDS_FK+SEQ*4;
constexpr float C2=0.125f*1.4426950408889634f;
__device__ __forceinline__ void glds16(const void*gsrc,unsigned lds_dst){unsigned keep;
  asm volatile("s_mov_b32 %0, m0\n\ts_mov_b32 m0, %2\n\ts_nop 0\n\tglobal_load_lds_dwordx4 %1, off\n\ts_mov_b32 m0, %0":"=&s"(keep):"v"(gsrc),"s"(lds_dst):"memory");}
__device__ __forceinline__ float max3f(float a,float b,float c){float r;asm("v_max3_f32 %0, %1, %2, %3":"=v"(r):"v"(a),"v"(b),"v"(c));return r;}
__device__ __forceinline__ float max2f(float a,float b){float r;asm("v_max_f32_e32 %0, %1, %2":"=v"(r):"v"(a),"v"(b));return r;}
__device__ __forceinline__ float fadd_s(float a,float b){float r;asm("v_add_f32_e32 %0, %1, %2":"=v"(r):"v"(a),"v"(b));return r;}
__device__ __forceinline__ float fsub_s(float a,float b){float r;asm("v_sub_f32_e32 %0, %1, %2":"=v"(r):"v"(a),"v"(b));return r;}
typedef float f32x2_t __attribute__((ext_vector_type(2))); typedef __bf16 bf16x2_t __attribute__((ext_vector_type(2)));
__device__ __forceinline__ unsigned cvtpk_s(float lo,float hi){f32x2_t v={lo,hi};bf16x2_t b=__builtin_convertvector(v,bf16x2_t);return __builtin_bit_cast(unsigned,b);}
#define WAIT_BAR(N) asm volatile("s_waitcnt vmcnt(" #N ") lgkmcnt(0)\n\ts_barrier":::"memory")

__device__ __forceinline__ void qkt(f32x16&p0,f32x16&p1,const char*Kslot,const bf16x8*qr,int r32,int hi){
  const char*kb=Kslot+hi*1024+r32*16;
  #pragma unroll
  for(int d0=0;d0<4;++d0){
    const bf16x8 b0=*reinterpret_cast<const bf16x8*>(kb+d0*2048);
    const bf16x8 b1=*reinterpret_cast<const bf16x8*>(kb+d0*2048+512);
    p0=__builtin_amdgcn_mfma_f32_32x32x16_bf16(b0,qr[d0],p0,0,0,0);p1=__builtin_amdgcn_mfma_f32_32x32x16_bf16(b1,qr[d0],p1,0,0,0);}
}
typedef __attribute__((address_space(3))) const char* lds_cptr;
typedef short v4i16_t __attribute__((ext_vector_type(4)));
__device__ __forceinline__ void kload8(bf16x8*kf,lds_cptr kp){
  kf[0]=*(const __attribute__((address_space(3))) bf16x8*)(kp);      kf[1]=*(const __attribute__((address_space(3))) bf16x8*)(kp+512);
  kf[2]=*(const __attribute__((address_space(3))) bf16x8*)(kp+2048); kf[3]=*(const __attribute__((address_space(3))) bf16x8*)(kp+2560);
  kf[4]=*(const __attribute__((address_space(3))) bf16x8*)(kp+4096); kf[5]=*(const __attribute__((address_space(3))) bf16x8*)(kp+4608);
  kf[6]=*(const __attribute__((address_space(3))) bf16x8*)(kp+6144); kf[7]=*(const __attribute__((address_space(3))) bf16x8*)(kp+6656);
}
__device__ __forceinline__ void kload2(bf16x8*kf,lds_cptr kp,int j){ kf[2*j]=*(const __attribute__((address_space(3))) bf16x8*)(kp+j*2048); kf[2*j+1]=*(const __attribute__((address_space(3))) bf16x8*)(kp+j*2048+512); }
__device__ __forceinline__ s16x4 vtr(lds_cptr p){ return __builtin_bit_cast(s16x4,__builtin_amdgcn_ds_read_tr16_b64_v4i16((__attribute__((address_space(3))) v4i16_t*)p)); }
__device__ __forceinline__ float rowmax(const f32x16&p0,const f32x16&p1){
  float a=max3f(p0[0],p0[1],p1[0]),b=max3f(p0[2],p0[3],p1[1]);a=max3f(a,p1[2],p1[3]);
  #pragma unroll
  for(int r=4;r<16;r+=4){a=max3f(a,p0[r],p0[r+1]);b=max3f(b,p0[r+2],p0[r+3]);a=max3f(a,p1[r],p1[r+1]);b=max3f(b,p1[r+2],p1[r+3]);}
  const float m=max2f(a,b);
  auto rr=__builtin_amdgcn_permlane32_swap(__float_as_uint(m),__float_as_uint(m),false,false);
  return max2f(__uint_as_float(rr[0]),__uint_as_float(rr[1]));
}
__device__ __forceinline__ void pv(f32x16*o,int vb,bf16x8 pa0,bf16x8 pa1,bf16x8 pa2,bf16x8 pa3){
  #pragma unroll
  for(int d0=0;d0<2;++d0){s16x4 lo[4],hi[4];
    #pragma unroll
    for(int ks=0;ks<4;++ks){
      asm volatile("ds_read_b64_tr_b16 %0,%1 offset:%c2":"=&v"(lo[ks]):"v"(vb),"i"(d0*4096+ks*1024):"memory");
      asm volatile("ds_read_b64_tr_b16 %0,%1 offset:%c2":"=&v"(hi[ks]):"v"(vb),"i"(d0*4096+ks*1024+512):"memory");}
    asm volatile("s_waitcnt lgkmcnt(0)":::"memory");SBAR();
    #define PK(k) (bf16x8){lo[k][0],lo[k][1],lo[k][2],lo[k][3],hi[k][0],hi[k][1],hi[k][2],hi[k][3]}
    o[d0]=__builtin_amdgcn_mfma_f32_32x32x16_bf16(pa0,PK(0),o[d0],0,0,0);
    o[d0]=__builtin_amdgcn_mfma_f32_32x32x16_bf16(pa1,PK(1),o[d0],0,0,0);
    o[d0]=__builtin_amdgcn_mfma_f32_32x32x16_bf16(pa2,PK(2),o[d0],0,0,0);
    o[d0]=__builtin_amdgcn_mfma_f32_32x32x16_bf16(pa3,PK(3),o[d0],0,0,0);
    #undef PK
  }
}

#ifndef ATTN_STORE16
#define ATTN_STORE16(p,v) (*(u32x4*)(p)=(v))
#endif
template<int THRL> __device__ __forceinline__ void attn_unit(int b,int h,int qb,const bf16*Q,const bf16*__restrict__ K,const bf16*__restrict__ V,bf16*O,const float*__restrict__ Fc,const float*__restrict__ NRM,char*shm,int wid_in){
  const int wid=__builtin_amdgcn_readfirstlane(wid_in); int lane_=(int)__builtin_amdgcn_mbcnt_hi(~0u,__builtin_amdgcn_mbcnt_lo(~0u,0u)); asm volatile("":"+v"(lane_));
  const int lane=lane_,tid=wid*64+lane,r32=lane&31,hi=lane>>5;
  const long rowbase=(long)b*SEQ; const int q0=qb*QB;
  const float*Fbh=Fc+(long)(b*NHEAD+h)*SEQ;
  const int NTF=(q0+QB)/KVBLK; int t_start;
  { const float*QNb=NRM+(b*NHEAD+h)*128,*KNb=NRM+4096+(b*NHEAD+h)*128;
    const float qn=fmaxf(fmaxf(QNb[4*qb],QNb[4*qb+1]),fmaxf(QNb[4*qb+2],QNb[4*qb+3])),knb=fmaxf(fmaxf(KNb[4*qb],KNb[4*qb+1]),fmaxf(KNb[4*qb+2],KNb[4*qb+3]));
    const float fq0=Fbh[q0]*1.4426950408889634f; bool k0=true,k1=true;
    if(lane<NTF-4)k0=!(qn*(KNb[lane]+knb)+(fq0-Fbh[64*lane+63]*1.4426950408889634f)<-40.f);
    if(lane+64<NTF-4)k1=!(qn*(KNb[lane+64]+knb)+(fq0-Fbh[64*(lane+64)+63]*1.4426950408889634f)<-40.f);
    const unsigned long long m0=__ballot(k0),m1=__ballot(k1);
    int tf=m0?(int)__builtin_ctzll(m0):64+(m1?(int)__builtin_ctzll(m1):64);
    tf=tf<NTF-4?tf:NTF-4; t_start=__builtin_amdgcn_readfirstlane(tf&~1); }
  { typedef float f32x4_t __attribute__((ext_vector_type(4))); __attribute__((address_space(3))) float*fk=(__attribute__((address_space(3))) float*)((__attribute__((address_space(3))) char*)shm+LDS_FK); const int n4=(q0+QB)/4;
    for(int i=16*t_start+tid;i<n4;i+=NW*64){ f32x4_t v=*(const f32x4_t*)(Fbh+4*i); v=v*(-1.4426950408889634f); *(__attribute__((address_space(3))) f32x4_t*)(fk+4*i)=v; } }
  float fq2=Fbh[q0+wid*QBLK+r32]*1.4426950408889634f; asm volatile("":"+v"(fq2));
  const bf16*Qw=Q+(rowbase+q0+wid*QBLK)*DM+h*D;
  const bf16*Kh=K+(rowbase+(long)t_start*KVBLK)*DM+h*D,*Vh=V+(rowbase+(long)t_start*KVBLK)*DM+h*D;
  const lds_cptr shm3=(lds_cptr)shm;
  const unsigned lds0=(unsigned)(uintptr_t)shm;
  float*wsf=(float*)(shm+LDS_WS)+wid*64;
  const bf16*ksrc=Kh+(long)lane*DM+wid*8;
  const bf16*vsrc=Vh+(long)(16*(wid&3)+(lane>>2))*DM+(wid>>2)*32+(lane&3)*8;
  const unsigned kdst=lds0+LDS_K+wid*1024, vdst=lds0+LDS_V+wid*1024;
  #define DMA_K(t,slot) glds16(ksrc+(long)(t)*KVBLK*DM,(unsigned)__builtin_amdgcn_readfirstlane(kdst+(slot)))
  #define DMA_V(t,slot) glds16(vsrc+(long)(t)*KVBLK*DM,(unsigned)__builtin_amdgcn_readfirstlane(vdst+(slot)))
  const int vb0=(int)(lds0+LDS_V)+((lane>>4)&1)*32+(lane&3)*8+(4*hi+((lane&15)>>2))*64;
  const char*Kbase=shm+LDS_K; bf16x8 kf[8];
  const lds_cptr kp0=shm3+LDS_K+hi*1024+r32*16; const lds_cptr vp0=shm3+LDS_V+((lane>>4)&1)*32+(lane&3)*8+(4*hi+((lane&15)>>2))*64;
  const int NT=NTF-t_start;
  DMA_K(0,0);DMA_V(0,0);DMA_K(1,SLOTB);
  bf16x8 qr[4];
  #pragma unroll
  for(int d0=0;d0<4;++d0)qr[d0]=*reinterpret_cast<const bf16x8*>(&Qw[(long)r32*DM+d0*16+hi*8]);
  float mhat=0.f,l_reg=0.f;f32x16 o[2];o[0]=f32x16{};o[1]=f32x16{};
  const __attribute__((address_space(3))) float*fkl=(const __attribute__((address_space(3))) float*)(shm3+LDS_FK)+64*t_start+4*hi;
  #define INITC(C0,C1,t) do{ const float nsc_=fq2-mhat; typedef float f32x4_t __attribute__((ext_vector_type(4))); const __attribute__((address_space(3))) float*kb_=fkl+64*(t); \
    _Pragma("unroll") for(int g_=0;g_<4;++g_){ const f32x4_t a_=*(const __attribute__((address_space(3))) f32x4_t*)(kb_+8*g_), b_=*(const __attribute__((address_space(3))) f32x4_t*)(kb_+32+8*g_); \
      _Pragma("unroll") for(int e_=0;e_<4;++e_){ C0[4*g_+e_]=nsc_+a_[e_]; C1[4*g_+e_]=nsc_+b_[e_]; } } }while(0)
  const int qrel=wid*QBLK+r32;
  #define CMASK(P0,P1,t) do{int jb_=(t)-(NT-4); if(jb_>=0)cmask(P0,P1,jb_,qrel,hi);}while(0)
  bool resc=false;
  #define START(P0,P1) do{ const float rm=rowmax(P0,P1); resc=false; \
    { const float dl=rm; mhat=fadd_s(mhat,dl); \
      _Pragma("unroll") for(int r=0;r<16;++r){P0[r]=fsub_s(P0[r],dl);P1[r]=fsub_s(P1[r],dl);} \
      } \
    _Pragma("unroll") for(int r=0;r<16;++r)P0[r]=__builtin_amdgcn_exp2f(P0[r]); }while(0)
  #define RESC() do{ if(resc){ asm volatile("s_waitcnt lgkmcnt(0)":::"memory"); \
      _Pragma("unroll") for(int d_=0;d_<2;++d_) _Pragma("unroll") for(int r=0;r<16;++r)o[d_][r]*=wsf[crow(r,hi)]; } }while(0)
  f32x16 pA0,pA1,pB0,pB1;
  int sl_prev=0,sl_cur=0,sl_next=SLOTB;
  #define ROT() do{sl_prev=sl_cur;sl_cur=sl_next;sl_next=(sl_next==(NSLOT-1)*SLOTB)?0:sl_next+SLOTB;}while(0)
  DMA_K(2,2*SLOTB);
  WAIT_BAR(3);
  INITC(pA0,pA1,0); qkt(pA0,pA1,Kbase,qr,r32,hi);asm volatile("s_nop 15\n\ts_nop 7":"+v"(pA0),"+v"(pA1));CMASK(pA0,pA1,0);
  START(pA0,pA1);
  _Pragma("unroll") for(int r=0;r<16;++r)pA1[r]=__builtin_amdgcn_exp2f(pA1[r]);
  WAIT_BAR(0);
  DMA_K(3,0);DMA_V(1,SLOTB);
  ROT();
  kload8(kf,kp0+sl_cur);
  WAIT_BAR(2);
  s16x4 vlo[8],vhi[8]; u32x4 pw0,pw1,pw2,pw3;
  #define PKW(P,B) cvtpk_s(P[B],P[B+1])
  #define PAF(k) __builtin_bit_cast(bf16x8,pw##k)
  #define VFR(i) (bf16x8){vlo[i][0],vlo[i][1],vlo[i][2],vlo[i][3],vhi[i][0],vhi[i][1],vhi[i][2],vhi[i][3]}
  #define PIN(x) asm volatile("":"+v"(x))
  #define MX3(a,b,c) __builtin_fmaxf(__builtin_fmaxf((a),(b)),(c))
  #define GAPA(MF,A0,A1,A2,A3,W0,W1,PW) do{ MF; sacc+=A0; sacc+=A1; sacc+=A2; sacc+=A3; PIN(sacc); W0; W1; PIN(PW); SBAR(); }while(0)
  #define EX(v) __builtin_amdgcn_exp2f(v)
  #define GAPB(MF,X,B) do{ MF; X[B]=EX(X[B]); X[B+1]=EX(X[B+1]); X[B+2]=EX(X[B+2]); X[B+3]=EX(X[B+3]); PIN(X); SBAR(); }while(0)
  #define VRD(i) do{ vlo[i]=vtr(vp_+(((i)>>2)*4096+((i)&3)*1024)); vhi[i]=vtr(vp_+(((i)>>2)*4096+((i)&3)*1024+512)); }while(0)
  #define KRD(G,j) do{ if(G){ kload2(kf,kp0+sl_next,j); SBAR(); } }while(0)
  #define STEP(C0,C1,P0,P1,t,GK,GV,GL) do{ SBAR(); INITC(C0,C1,t); PIN(C0); PIN(C1); SBAR(); \
    const lds_cptr vp_=vp0+sl_prev; \
    VRD(0); SBAR(); float sacc=(P0[0]+P0[1]); \
    GAPA(C0=__builtin_amdgcn_mfma_f32_32x32x16_bf16(kf[0],qr[0],C0,0,0,0), P0[2],P0[3],P0[4],P0[5],     pw0[0]=PKW(P0,0), pw0[1]=PKW(P0,2), pw0); \
    VRD(4); SBAR(); GAPA(C1=__builtin_amdgcn_mfma_f32_32x32x16_bf16(kf[1],qr[0],C1,0,0,0), P0[6],P0[7],P0[8],P0[9],     pw0[2]=PKW(P0,4), pw0[3]=PKW(P0,6), pw0); \
    VRD(1); SBAR(); GAPA(C0=__builtin_amdgcn_mfma_f32_32x32x16_bf16(kf[2],qr[1],C0,0,0,0),   P0[10],P0[11],P0[12],P0[13], pw1[0]=PKW(P0,8), pw1[1]=PKW(P0,10), pw1); \
    VRD(5); SBAR(); GAPA(C1=__builtin_amdgcn_mfma_f32_32x32x16_bf16(kf[3],qr[1],C1,0,0,0),   P0[14],P0[15],P1[0],P1[1],   pw1[2]=PKW(P0,12),pw1[3]=PKW(P0,14), pw1); \
    VRD(2); SBAR(); GAPA(C0=__builtin_amdgcn_mfma_f32_32x32x16_bf16(kf[4],qr[2],C0,0,0,0),   P1[2],P1[3],P1[4],P1[5],     pw2[0]=PKW(P1,0), pw2[1]=PKW(P1,2), pw2); \
    VRD(6); SBAR(); GAPA(C1=__builtin_amdgcn_mfma_f32_32x32x16_bf16(kf[5],qr[2],C1,0,0,0),   P1[6],P1[7],P1[8],P1[9],     pw2[2]=PKW(P1,4), pw2[3]=PKW(P1,6), pw2); \
    VRD(3); SBAR(); GAPA(C0=__builtin_amdgcn_mfma_f32_32x32x16_bf16(kf[6],qr[3],C0,0,0,0),   P1[10],P1[11],P1[12],P1[13], pw3[0]=PKW(P1,8), pw3[1]=PKW(P1,10), pw3); \
    VRD(7); SBAR(); GAPA(C1=__builtin_amdgcn_mfma_f32_32x32x16_bf16(kf[7],qr[3],C1,0,0,0),   P1[14],P1[15],0.f,0.f,       pw3[2]=PKW(P1,12),pw3[3]=PKW(P1,14), pw3); \
    l_reg+=sacc; \
    if(GK){DMA_K((t)+3,sl_cur);} if(GV){DMA_V((t)+1,sl_next);} \
    CMASK(C0,C1,t); \
    { float a=MX3(C0[0],C0[1],C1[0]),b=MX3(C0[2],C0[3],C1[1]); a=MX3(a,C1[2],C1[3]); \
      _Pragma("unroll") for(int r=4;r<16;r+=4){a=MX3(a,C0[r],C0[r+1]);b=MX3(b,C0[r+2],C0[r+3]);a=MX3(a,C1[r],C1[r+1]);b=MX3(b,C1[r+2],C1[r+3]);} \
      float rm=__builtin_fmaxf(a,b); { auto rr=__builtin_amdgcn_permlane32_swap(__float_as_uint(rm),__float_as_uint(rm),false,false); rm=__builtin_fmaxf(__uint_as_float(rr[0]),__uint_as_float(rr[1])); } \
      resc=false; \
      if(__builtin_expect(__any(rm>(float)THRL),0)){ const float dl=__builtin_fmaxf(rm,0.f); mhat+=dl; \
        _Pragma("unroll") for(int r=0;r<16;++r){C0[r]-=dl;C1[r]-=dl;} \
        const float f=__builtin_amdgcn_exp2f(-dl); l_reg*=f; if(hi==0)wsf[r32]=f; resc=true; } } \
    SBAR(); \
    GAPB(o[0]=__builtin_amdgcn_mfma_f32_32x32x16_bf16(PAF(0),VFR(0),o[0],0,0,0), C0,0); \
    GAPB(o[1]=__builtin_amdgcn_mfma_f32_32x32x16_bf16(PAF(0),VFR(4),o[1],0,0,0), C0,4); \
    KRD(GL,0); GAPB(o[0]=__builtin_amdgcn_mfma_f32_32x32x16_bf16(PAF(1),VFR(1),o[0],0,0,0), C0,8); \
    KRD(GL,1); GAPB(o[1]=__builtin_amdgcn_mfma_f32_32x32x16_bf16(PAF(1),VFR(5),o[1],0,0,0), C0,12); \
    KRD(GL,2); GAPB(o[0]=__builtin_amdgcn_mfma_f32_32x32x16_bf16(PAF(2),VFR(2),o[0],0,0,0), C1,0); \
    KRD(GL,3); GAPB(o[1]=__builtin_amdgcn_mfma_f32_32x32x16_bf16(PAF(2),VFR(6),o[1],0,0,0), C1,4); \
    GAPB(o[0]=__builtin_amdgcn_mfma_f32_32x32x16_bf16(PAF(3),VFR(3),o[0],0,0,0), C1,8); \
    GAPB(o[1]=__builtin_amdgcn_mfma_f32_32x32x16_bf16(PAF(3),VFR(7),o[1],0,0,0), C1,12); \
    }while(0)
  int t=1;
  #undef CMASK
  #define CMASK(P0,P1,t) do{}while(0)
  for(;t+5<NT;t+=2){
    STEP(pB0,pB1,pA0,pA1,t,true,true,true);     WAIT_BAR(2); RESC(); ROT();
    STEP(pA0,pA1,pB0,pB1,t+1,true,true,true);   WAIT_BAR(2); RESC(); ROT();
  }
  #undef CMASK
  #define CMASK(P0,P1,t) do{int jb_=(t)-(NT-4); if(jb_>=0)cmask(P0,P1,jb_,qrel,hi);}while(0)
  #define ENDW(tt) do{ if((tt)+3<NT){WAIT_BAR(2);} else if((tt)+2<NT){WAIT_BAR(1);} else {WAIT_BAR(0);} }while(0)
  for(;t+1<NT;t+=2){
    STEP(pB0,pB1,pA0,pA1,t,(t+3<NT),(t+1<NT),(t+1<NT));       ENDW(t);   RESC(); ROT();
    STEP(pA0,pA1,pB0,pB1,t+1,(t+4<NT),(t+2<NT),(t+2<NT));     ENDW(t+1); RESC(); ROT();
  }
  STEP(pB0,pB1,pA0,pA1,NT-1,false,false,false); RESC();
  { float sacc=pB0[0]+pB0[1]; _Pragma("unroll") for(int r=2;r<16;++r)sacc+=pB0[r]; _Pragma("unroll") for(int r=0;r<16;++r)sacc+=pB1[r]; l_reg+=sacc;
    pw0=(u32x4){PKW(pB0,0),PKW(pB0,2),PKW(pB0,4),PKW(pB0,6)};pw1=(u32x4){PKW(pB0,8),PKW(pB0,10),PKW(pB0,12),PKW(pB0,14)};pw2=(u32x4){PKW(pB1,0),PKW(pB1,2),PKW(pB1,4),PKW(pB1,6)};pw3=(u32x4){PKW(pB1,8),PKW(pB1,10),PKW(pB1,12),PKW(pB1,14)};
    SBAR(); pv(o,vb0+sl_cur,PAF(0),PAF(1),PAF(2),PAF(3)); }
  #undef PKW
  #undef PAF
  #undef VFR
  #undef PIN
  #undef MX3
  #undef GAPA
  #undef GAPB
  #undef EX
  #undef VRD
  #undef KRD
  #undef STEP
  #undef ENDW
  {auto rr=__builtin_amdgcn_permlane32_swap(__float_as_uint(l_reg),__float_as_uint(l_reg),false,false);l_reg=__uint_as_float(rr[0])+__uint_as_float(rr[1]);}
  if(hi==0)wsf[32+r32]=l_reg;asm volatile("s_waitcnt lgkmcnt(0)":::"memory");
  float rli[16];
  #pragma unroll
  for(int r=0;r<16;++r)rli[r]=__builtin_amdgcn_rcpf(wsf[32+crow(r,hi)]);
  bf16*Ow=O+(rowbase+q0+wid*QBLK)*DM+h*D;
  { bf16*stg=(bf16*)(shm+LDS_OST)+wid*2048;
    #pragma unroll
    for(int r=0;r<16;++r){const int orow=crow(r,hi);
      #pragma unroll
      for(int d0=0;d0<2;++d0)stg[orow*64+d0*32+r32]=__float2bfloat16(o[d0][r]*rli[r]);}
    asm volatile("s_waitcnt lgkmcnt(0)":::"memory");
    #pragma unroll
    for(int i=0;i<4;++i){const int row=i*8+(lane>>3),ch=lane&7; const u32x4 v=*(const u32x4*)(stg+row*64+ch*8); ATTN_STORE16(Ow+(long)row*DM+ch*8,v);} }
  asm volatile("s_waitcnt lgkmcnt(0)\n\ts_barrier":::"memory");
  #undef DMA_K
  #undef DMA_V
  #undef INITC
  #undef CMASK
  #undef START
  #undef RESC
  #undef ROT
}
constexpr int ATTN_LDS_BYTES=LDS_BYTES;
struct AttnTensors { const bf16* Q; const bf16* K; const bf16* V; bf16* O; const float* F; const float* NRM; };
struct AttnUnit { int bh; int qb; };
struct StaticOrder {
  int vcu;
  __device__ __forceinline__ explicit StaticOrder(int grid,int block):vcu((block%8)*(grid/8)+block/8){}
  __device__ __forceinline__ bool next(int i,AttnUnit&u)const{ if(i>=4)return false; const int s=vcu&7; u.bh=vcu>>3; u.qb=(i==0)?s:(i==1)?15-s:(i==2)?16+s:31-s; return true; }
  __device__ __forceinline__ void a_ready(const AttnUnit&)const{}
  __device__ __forceinline__ void done(const AttnUnit&)const{}
};
template<int THRL=8> __device__ __forceinline__ void attn_phase(char*lds,const AttnTensors&T,unsigned*qctr,volatile __attribute__((address_space(3))) unsigned*qword,int wid_in){
  const int lane0=(int)__builtin_amdgcn_mbcnt_hi(~0u,__builtin_amdgcn_mbcnt_lo(~0u,0u));
  for(;;){
    if(wid_in==0&&lane0==0){ const unsigned n=__hip_atomic_fetch_add(qctr,1u,__ATOMIC_RELAXED,__HIP_MEMORY_SCOPE_AGENT); *qword=n; }
    asm volatile("s_waitcnt vmcnt(0) lgkmcnt(0)\n\ts_barrier":::"memory");
    const int n=__builtin_amdgcn_readfirstlane((int)*qword);
    if(n>=BATCH*NHEAD*NQB)break;
    const int bh=n%(BATCH*NHEAD),qb=NQB-1-n/(BATCH*NHEAD);
    attn_unit<THRL>(bh/NHEAD,bh%NHEAD,qb,T.Q,T.K,T.V,T.O,T.F,T.NRM,lds,wid_in);
  }
}
#undef SBAR
#undef WAIT_BAR
}
#define GAS __attribute__((address_space(1)))
#define LAS __attribute__((address_space(3)))
typedef unsigned short bf16;
typedef unsigned v4u __attribute__((ext_vector_type(4)));
typedef float f32x4 __attribute__((ext_vector_type(4)));
typedef short bf16x8 __attribute__((ext_vector_type(8)));
typedef GAS unsigned gu32;
typedef GAS unsigned long long gu64;
#define RLX_AGENT __ATOMIC_RELAXED, __HIP_MEMORY_SCOPE_AGENT
#define LDS_WAIT() asm volatile("s_waitcnt lgkmcnt(0)" ::: "memory")
#define VM_WAIT() asm volatile("s_waitcnt vmcnt(0)" ::: "memory")
__device__ __forceinline__ unsigned long long rt() { return __builtin_amdgcn_s_memrealtime(); }
__device__ __forceinline__ unsigned f2bf(float f) { unsigned u = __builtin_bit_cast(unsigned, f); return (u + 0x7fffu + ((u >> 16) & 1u)) >> 16; }
__device__ __forceinline__ unsigned pk2(float lo, float hi) { return f2bf(lo) | (f2bf(hi) << 16); }

#define XB_TMO      128
#define XB_XCNT(j)  (256  + 64 * (j))
#define XB_XSUB(j)  (1280 + 64 * (j))
#define XB_XGEN(j)  (2304 + 64 * (j))
#define XB_TOP      3328
#define XB_TOPGEN   3392
#define XCD_BAR_WORDS 3456
#define XB_SPIN_CAP (1u << 18)

__device__ __forceinline__ unsigned xb_ld(unsigned* p)              { return __hip_atomic_load(p, __ATOMIC_RELAXED, __HIP_MEMORY_SCOPE_AGENT); }
__device__ __forceinline__ unsigned xb_add(unsigned* p, unsigned v) { return __hip_atomic_fetch_add(p, v, __ATOMIC_RELAXED, __HIP_MEMORY_SCOPE_AGENT); }
__device__ __forceinline__ unsigned xb_xcc_id() { return (unsigned)__builtin_amdgcn_s_getreg((3 << 11) | 20) & 0xFu; }
#define XB_SPIN(cond, bar) do { unsigned _sp = 0; while (cond) { __builtin_amdgcn_s_sleep(1); \
    if ((++_sp & 255u) == 0u) { if (xb_ld(&(bar)[XB_TMO])) break; if (_sp > XB_SPIN_CAP) { atomicAdd(&(bar)[XB_TMO], 1u); break; } } } } while (0)

struct XcdBarrier {
    unsigned* bar; unsigned x; int wv;
    volatile LAS unsigned* st;
};

__device__ __forceinline__ bool xb_t0(int wv) { return wv == 0 && __builtin_amdgcn_mbcnt_hi(~0u, __builtin_amdgcn_mbcnt_lo(~0u, 0u)) == 0u; }
__device__ __forceinline__ XcdBarrier xcd_barrier_post(unsigned* bar, volatile LAS unsigned* st, int wv) {
    XcdBarrier b; b.bar = bar; b.x = xb_xcc_id(); b.st = st; b.wv = wv;
    if (xb_t0(wv)) (void)xb_add(&bar[XB_XCNT(b.x)], 1u);
    return b;
}
__device__ __forceinline__ void xcd_barrier_complete(unsigned* bar, unsigned x, unsigned& nloc, unsigned& nx) {
    const unsigned G = gridDim.x * gridDim.y * gridDim.z;
    unsigned sum, cnt, mine, sp = 0u;
    for (;;) {
        sum = 0u; cnt = 0u; mine = 0u;
#pragma unroll
        for (unsigned j = 0; j < 16; ++j) { const unsigned c = xb_ld(&bar[XB_XCNT(j)]); sum += c; cnt += (c > 0u) ? 1u : 0u; mine = (j == x) ? c : mine; }
        if (sum == G) break;
        __builtin_amdgcn_s_sleep(1);
        if ((++sp & 255u) == 0u) { if (xb_ld(&bar[XB_TMO])) break; if (sp > XB_SPIN_CAP) { atomicAdd(&bar[XB_TMO], 1u); break; } }
    }
    nloc = mine > 0u ? mine : 1u; nx = cnt > 0u ? cnt : 1u;
}

__device__ __forceinline__ void xcd_barrier(const XcdBarrier& b) {
    asm volatile("s_waitcnt vmcnt(0)" ::: "memory");
    __syncthreads();
    if (xb_t0(b.wv)) {
        unsigned* bar = b.bar;
        __builtin_amdgcn_s_waitcnt(0);
        unsigned nloc = b.st[0], nx = b.st[1];
        if (nloc == 0u) { xcd_barrier_complete(bar, b.x, nloc, nx); b.st[0] = nloc; b.st[1] = nx; }
        const unsigned old = xb_add(&bar[XB_XSUB(b.x)], 1u);
        const unsigned gen = old / nloc;
        if (old + 1u == (gen + 1u) * nloc) {
            __builtin_amdgcn_fence(__ATOMIC_RELEASE, "agent");
            asm volatile("s_waitcnt vmcnt(0)" ::: "memory");
            const unsigned og = xb_add(&bar[XB_TOP], 1u);
            const unsigned tg = og / nx;
            if (og + 1u == (tg + 1u) * nx) xb_add(&bar[XB_TOPGEN], 1u);
            else XB_SPIN(xb_ld(&bar[XB_TOPGEN]) == tg, bar);
            __builtin_amdgcn_fence(__ATOMIC_ACQUIRE, "agent");
            xb_add(&bar[XB_XGEN(b.x)], 1u);
            asm volatile("s_waitcnt vmcnt(0)" ::: "memory");
        } else {
            XB_SPIN(xb_ld(&bar[XB_XGEN(b.x)]) == gen, bar);
            __builtin_amdgcn_fence(__ATOMIC_ACQUIRE, "agent");
            asm volatile("s_waitcnt vmcnt(0)" ::: "memory");
        }
    }
    __syncthreads();
}

constexpr int NWAVES = 8;
constexpr int RING_OFF = 0, RING_BYTES = 131072;
constexpr int LDSCTL_OFF = RING_BYTES, MISC_OFF = LDSCTL_OFF + 320;
constexpr int LDS_BYTES = 147456;
constexpr int N_PHASES = 8;

struct Frame {
    LAS unsigned char* lds;
    volatile LAS unsigned* MISC;
    gu32* ctl;
    int tid, lane, wave, vcu, G;
};
__device__ __forceinline__ float wave_sum(float v) {
#pragma unroll
    for (int o = 1; o < 64; o <<= 1) v += __shfl_xor(v, o);
    return v;
}
struct Args { const float* in[20]; float* out; unsigned char* ws; int ph_lo, ph_hi, li, pad; };

__device__ __forceinline__ void p0_transpose_item(const float* W, int ld, int nblk, const float* glo, const float* ghi, int K, bf16* WT, LAS float* scr, int item, int lane) {
    const int kb = item / nblk, nb = item % nblk, k0 = 64 * kb, n0 = 32 * nb;
#pragma unroll 8
    for (int i = 0; i < 32; ++i) { const int kk = 2 * i + (lane >> 5), k = k0 + kk; float w = W[(size_t)k * ld + n0 + (lane & 31)];
        if (glo) w *= (k < K / 2) ? glo[k] : ghi[k - K / 2];
        scr[kk * 33 + (lane & 31)] = w; }
    LDS_WAIT(); asm volatile("" ::: "memory");
    const int c = lane & 7;
#pragma unroll
    for (int j = 0; j < 4; ++j) { const int n = (lane >> 3) + 8 * j; const LAS float* s = scr + (8 * c) * 33 + n;
        v4u o; o.x = pk2(s[0 * 33], s[1 * 33]); o.y = pk2(s[2 * 33], s[3 * 33]); o.z = pk2(s[4 * 33], s[5 * 33]); o.w = pk2(s[6 * 33], s[7 * 33]);
        *(GAS v4u*)(WT + (size_t)(n0 + n) * K + k0 + 8 * c) = o; }
    LDS_WAIT(); asm volatile("" ::: "memory");
}
__device__ __forceinline__ float log_sigmoid(float z) { return fminf(z, 0.f) - log1pf(expf(-fabsf(z))); }

__device__ __forceinline__ void p0_prologue(Frame& F, const Args& a) {
    LAS float* scr = (LAS float*)(F.lds + RING_OFF + F.wave * 16384);
    unsigned char* ws = a.ws;
    const float* x = a.in[0]; const float* g1 = a.in[1]; const float* w_in = a.in[2]; const float* bfv = a.in[10];
    const float* gn_l = a.in[11]; const float* gn_f = a.in[12]; const float* w_out = a.in[13]; const float* g2 = a.in[14];
    const float* w_q = a.in[15]; const float* sk = a.in[16]; const float* pu = a.in[17]; const float* pv = a.in[18];
    bf16* win_t = (bf16*)(ws + WS_WIN); bf16* wout_t = (bf16*)(ws + WS_WOUT); bf16* wq_t = (bf16*)(ws + WS_WQ); bf16* skb = (bf16*)(ws + WS_SKB);
    float* logf = (float*)(ws + WS_LOGF); float* sumsq = (float*)(ws + WS_SUMSQ); bf16* h = (bf16*)(ws + WS_H);
    const int gw = F.vcu * NWAVES + F.wave, NGW = F.G * NWAVES, lane = F.lane;
    constexpr int I_IN = (DMODEL / 64) * (NG1 / 32), I_OUT = (DMODEL / 64) * (DMODEL / 32), I_Q = (DMODEL / 64) * (QPW / 32);
    constexpr int I_FL = 8 * DMODEL / 64, I_SK = PH * 2 * NKEY * PHALF / 512, I_SS = T / 64, I_WAX = 8 * 2 * 2 * 4;
    constexpr int E0 = I_IN, E1 = E0 + I_OUT, E2 = E1 + I_Q, E3 = E2 + I_FL, E4 = E3 + I_SK, E5 = E4 + I_SS, E6 = E5 + I_WAX;
    for (int it = gw; it < E6; it += NGW) {
        if (it < E0) { p0_transpose_item(w_in, INC, NG1 / 32, nullptr, nullptr, DMODEL, win_t, scr, it, lane); continue; }
        if (it < E1) { p0_transpose_item(w_out, DMODEL, DMODEL / 32, gn_l, gn_f, DMODEL, wout_t, scr, it - E0, lane); continue; }
        if (it < E2) { p0_transpose_item(w_q, QPW, QPW / 32, g2, g2 + DMODEL / 2, DMODEL, wq_t, scr, it - E1, lane); continue; }
        if (it < E3) continue;
        if (it < E4) { const size_t i = (size_t)(it - E3) * 512 + lane * 8; const f32x4 s0 = *(const GAS f32x4*)(sk + i), s1 = *(const GAS f32x4*)(sk + i + 4);
            v4u o; o.x = pk2(s0[0], s0[1]); o.y = pk2(s0[2], s0[3]); o.z = pk2(s1[0], s1[1]); o.w = pk2(s1[2], s1[3]); *(GAS v4u*)(skb + i) = o; continue; }
        if (it < E5) { sumsq[(it - E4) * 64 + lane] = 0.f; continue; }
        { const int f = it - E5, ks = f & 3, n = (f >> 2) & 1, mat = (f >> 3) & 1, hh = f >> 4; const float* wsrc = mat ? a.in[7] : a.in[5];
          const size_t o = ((size_t)(hh * 64 + 16 * ks + 8 * (lane >> 5))) * 64 + 32 * n + (lane & 31);
          v4u pw; pw.x = pk2(wsrc[o], wsrc[o + 64]); pw.y = pk2(wsrc[o + 128], wsrc[o + 192]); pw.z = pk2(wsrc[o + 256], wsrc[o + 320]); pw.w = pk2(wsrc[o + 384], wsrc[o + 448]);
          *(GAS v4u*)((bf16*)(ws + WS_WAX) + (size_t)f * 512 + lane * 8) = pw; }
    }
    { f32x4 gg[4];
#pragma unroll
      for (int j = 0; j < 4; ++j) gg[j] = *(const GAS f32x4*)(g2 + 16 * lane + 4 * j);
      unsigned char* u4 = ws + WS_U8; unsigned char* v4 = ws + WS_V8; float* su = (float*)(ws + WS_SU);
      for (int e = gw; e < NEXP; e += NGW) {
        const GAS f32x4* ur = (const GAS f32x4*)(pu + (size_t)e * DMODEL + 16 * lane); const GAS f32x4* vr = (const GAS f32x4*)(pv + (size_t)e * DMODEL + 16 * lane);
        f32x4 uu[4], vv[4]; float mu = 0.f, mv = 0.f;
#pragma unroll
        for (int j = 0; j < 4; ++j) { uu[j] = ur[j] * gg[j]; vv[j] = vr[j];
#pragma unroll
            for (int c = 0; c < 4; ++c) { mu = fmaxf(mu, fabsf(uu[j][c])); mv = fmaxf(mv, fabsf(vv[j][c])); } }
#pragma unroll
        for (int o = 1; o < 64; o <<= 1) { mu = fmaxf(mu, __shfl_xor(mu, o)); mv = fmaxf(mv, __shfl_xor(mv, o)); }
        const float scu = mu > 0.f ? mu * (1.f / 6.f) : 1.f, scv = mv > 0.f ? mv * (1.f / 6.f) : 1.f, iu = 1.f / scu, iv = 1.f / scv;
        unsigned qu0 = 0u, qu1 = 0u, qv0 = 0u, qv1 = 0u;
#define P0_Q4(Q, X, INV, B0, B1) do { Q = __builtin_amdgcn_cvt_scalef32_pk_fp4_f32(Q, X[0] * INV, X[1] * INV, 1.0f, B0); Q = __builtin_amdgcn_cvt_scalef32_pk_fp4_f32(Q, X[2] * INV, X[3] * INV, 1.0f, B1); } while (0)
        P0_Q4(qu0, uu[0], iu, 0, 1); P0_Q4(qu0, uu[1], iu, 2, 3); P0_Q4(qu1, uu[2], iu, 0, 1); P0_Q4(qu1, uu[3], iu, 2, 3);
        P0_Q4(qv0, vv[0], iv, 0, 1); P0_Q4(qv0, vv[1], iv, 2, 3); P0_Q4(qv1, vv[2], iv, 0, 1); P0_Q4(qv1, vv[3], iv, 2, 3);
#undef P0_Q4
        *(GAS unsigned long long*)(u4 + (size_t)e * 512 + 8 * lane) = (unsigned long long)qu0 | ((unsigned long long)qu1 << 32);
        { unsigned char* vrow = v4 + (size_t)e * 512 + 2 * (lane >> 2);
          *(GAS unsigned short*)(vrow + 32 * (4 * (lane & 3) + 0)) = (unsigned short)(qv0 & 0xffffu); *(GAS unsigned short*)(vrow + 32 * (4 * (lane & 3) + 1)) = (unsigned short)(qv0 >> 16);
          *(GAS unsigned short*)(vrow + 32 * (4 * (lane & 3) + 2)) = (unsigned short)(qv1 & 0xffffu); *(GAS unsigned short*)(vrow + 32 * (4 * (lane & 3) + 3)) = (unsigned short)(qv1 >> 16); }
        if (lane == 0) { su[2 * e] = scu; su[2 * e + 1] = scv; }
      } }
    { f32x4 gg[4];
#pragma unroll
      for (int j = 0; j < 4; ++j) gg[j] = *(const GAS f32x4*)(g1 + 256 * j + 4 * lane);
      float fw[4][4][8];
#pragma unroll
      for (int j = 0; j < 4; ++j)
#pragma unroll
          for (int c = 0; c < 4; ++c) { const int k = 256 * j + 4 * lane + c; const GAS f32x4* wr = (const GAS f32x4*)(w_in + (size_t)k * INC + NG1); const f32x4 w0 = wr[0], w1 = wr[1];
#pragma unroll
              for (int e = 0; e < 4; ++e) { fw[j][c][e] = w0[e]; fw[j][c][4 + e] = w1[e]; } }
      for (int t0 = gw; t0 < T; t0 += 2 * NGW) {
        const int t1 = (t0 + NGW < T) ? t0 + NGW : t0;
        const GAS f32x4* xr0 = (const GAS f32x4*)(x + (size_t)t0 * DMODEL) + lane; const GAS f32x4* xr1 = (const GAS f32x4*)(x + (size_t)t1 * DMODEL) + lane;
        f32x4 va[4], vb[4]; float sa = 0.f, sb = 0.f;
#pragma unroll
        for (int j = 0; j < 4; ++j) { va[j] = xr0[64 * j]; vb[j] = xr1[64 * j]; }
#pragma unroll
        for (int j = 0; j < 4; ++j) { sa += (va[j][0] * va[j][0] + va[j][1] * va[j][1]) + (va[j][2] * va[j][2] + va[j][3] * va[j][3]); sb += (vb[j][0] * vb[j][0] + vb[j][1] * vb[j][1]) + (vb[j][2] * vb[j][2] + vb[j][3] * vb[j][3]); }
        const float ra = rsqrtf(wave_sum(sa) * (1.f / DMODEL) + RMS_EPS), rb = rsqrtf(wave_sum(sb) * (1.f / DMODEL) + RMS_EPS);
        GAS unsigned long long* ha = (GAS unsigned long long*)(h + (size_t)t0 * DMODEL) + lane; GAS unsigned long long* hb = (GAS unsigned long long*)(h + (size_t)t1 * DMODEL) + lane;
#pragma unroll
        for (int j = 0; j < 4; ++j) { va[j] = va[j] * ra * gg[j]; vb[j] = vb[j] * rb * gg[j];
            ha[64 * j] = (unsigned long long)pk2(va[j][0], va[j][1]) | ((unsigned long long)pk2(va[j][2], va[j][3]) << 32);
            hb[64 * j] = (unsigned long long)pk2(vb[j][0], vb[j][1]) | ((unsigned long long)pk2(vb[j][2], vb[j][3]) << 32); }
        float fa[8], fb[8];
#pragma unroll
        for (int hh = 0; hh < 8; ++hh) { fa[hh] = 0.f; fb[hh] = 0.f; }
#pragma unroll
        for (int j = 0; j < 4; ++j)
#pragma unroll
            for (int c = 0; c < 4; ++c) {
#pragma unroll
                for (int hh = 0; hh < 8; ++hh) { fa[hh] += va[j][c] * fw[j][c][hh]; fb[hh] += vb[j][c] * fw[j][c][hh]; } }
        float resa = 0.f, resb = 0.f;
#pragma unroll
        for (int hh = 0; hh < 8; ++hh) { const float s0 = wave_sum(fa[hh]), s1 = wave_sum(fb[hh]); if (lane == hh) { resa = s0; resb = s1; } }
        if (lane < 8) { logf[(size_t)t0 * 8 + lane] = log_sigmoid(resa + bfv[lane]); logf[(size_t)t1 * 8 + lane] = log_sigmoid(resb + bfv[lane]); }
      } }
}

__device__ __forceinline__ void fcum_unit(Frame& F, int bh, const float* logf, float* fcum) {
    const int b = bh / NHEADS, hh = bh % NHEADS, s0 = F.tid * 16;
    float v[16]; float loc = 0.f;
#pragma unroll
    for (int i = 0; i < 16; ++i) { v[i] = logf[((size_t)b * SEQ + s0 + i) * 8 + hh]; loc += v[i]; }
    float inc = loc;
#pragma unroll
    for (int o = 1; o < 64; o <<= 1) { const float n = __shfl_up(inc, o); if (F.lane >= o) inc += n; }
    if (F.lane == 63) F.MISC[16 + F.wave] = __float_as_uint(inc);
    __syncthreads();
    float run = inc - loc;
    for (int w = 0; w < F.wave; ++w) run += __uint_as_float(F.MISC[16 + w]);
#pragma unroll
    for (int i = 0; i < 16; ++i) { run += v[i]; fcum[(size_t)bh * SEQ + s0 + i] = run; }
    __syncthreads();
}


namespace peer {
typedef unsigned u32;
typedef float f32x16 __attribute__((ext_vector_type(16)));
constexpr int TOK = 128;
constexpr int EX_STRIDE = 136, GT_STRIDE = 136;
constexpr int L_EX = 0, L_GT = L_EX + TOK * EX_STRIDE * 2, L_IDX = L_GT + TOK * GT_STRIDE * 2, IDX_STRIDE = 36, L_RST = L_IDX + 512 * IDX_STRIDE, L_BI = L_RST + TOK * 4, BI_WAVE = 4352, L_END = L_BI + 8 * BI_WAVE;
static_assert(L_END <= RING_BYTES && L_GT % 16 == 0 && L_IDX % 16 == 0, "PEER LDS map");
__device__ __forceinline__ u32 ordmap(float f) { const u32 u = __float_as_uint(f); return u ^ ((u32)((int)u >> 31) | 0x80000000u); }
__device__ __forceinline__ float unordmap(u32 k) { const u32 u = (k & 0x80000000u) ? (k ^ 0x80000000u) : ~k; return __uint_as_float(u); }
__device__ __forceinline__ u32 umin_(u32 a, u32 b) { return a < b ? a : b; }
__device__ __forceinline__ u32 umax_(u32 a, u32 b) { return a > b ? a : b; }
template <bool DESC> __device__ __forceinline__ void sort16(u32 (&k)[16]) {
#pragma unroll
    for (int size = 2; size <= 16; size <<= 1)
#pragma unroll
        for (int stride = size >> 1; stride > 0; stride >>= 1)
#pragma unroll
            for (int i = 0; i < 16; ++i) { const int j = i ^ stride;
                if (j > i) { const bool asc = (((i & size) == 0) != DESC); const u32 a = k[i], b = k[j], lo = umin_(a, b), hi = umax_(a, b); k[i] = asc ? lo : hi; k[j] = asc ? hi : lo; } }
}
template <bool DESC> __device__ __forceinline__ void merge16(u32 (&k)[16]) {
#pragma unroll
    for (int stride = 8; stride > 0; stride >>= 1)
#pragma unroll
        for (int i = 0; i < 16; ++i) { const int j = i ^ stride;
            if (j > i) { const u32 a = k[i], b = k[j], lo = umin_(a, b), hi = umax_(a, b); k[i] = DESC ? hi : lo; k[j] = DESC ? lo : hi; } }
}
__host__ __device__ constexpr int ccnt(int a) { return 16 / (a + 1); }
__host__ __device__ constexpr int cbase(int a) { int s = 0; for (int i = 0; i < a; ++i) s += ccnt(i); return s; }
static_assert(cbase(16) == 50, "hyperbola candidate count");
__device__ __forceinline__ int crow16(int r) { return (r & 3) + 8 * (r >> 2); }

__device__ __forceinline__ void route_tile(Frame& F, const bf16* qp, const bf16* skb, const float* sumsq, int t0) {
    int lane = F.lane; asm volatile("" : "+v"(lane));
    const int r32 = lane & 31, hi = lane >> 5, w = F.wave;
    LAS unsigned short* EXL = (LAS unsigned short*)(F.lds + RING_OFF + L_EX);
    LAS unsigned short* GTL = (LAS unsigned short*)(F.lds + RING_OFF + L_GT);
    LAS unsigned char* IDXB = F.lds + RING_OFF + L_IDX + (w * 64 + lane) * IDX_STRIDE;
    LAS float* RST = (LAS float*)(F.lds + RING_OFF + L_RST);
    for (int g = 0; g < 4; ++g) {
        const int tok = 32 * g + r32; const size_t trow = (size_t)(t0 + tok);
        const float rstd2 = rsqrtf(sumsq[trow] * (1.f / DMODEL) + RMS_EPS);
        if (w == 0 && hi == 0) RST[tok] = rstd2;
        u32 s0[16], s1[16];
#pragma unroll
        for (int p = 0; p < 2; ++p) {
            bf16x8 qf[8];
#pragma unroll
            for (int ks = 0; ks < 8; ++ks) qf[ks] = *(const GAS bf16x8*)(qp + trow * QPW + w * 256 + p * 128 + ks * 16 + hi * 8);
            u32 run[16];
#pragma unroll
            for (int nb = 0; nb < 4; ++nb) {
                f32x16 acc = {};
                const bf16* kr = skb + ((size_t)((w * 2 + p) * NKEY + 32 * nb + r32)) * PHALF + hi * 8;
#pragma unroll
                for (int ks = 0; ks < 8; ++ks) acc = __builtin_amdgcn_mfma_f32_32x32x16_bf16(*(const GAS bf16x8*)(kr + ks * 16), qf[ks], acc, 0, 0, 0);
                asm volatile("" ::: "memory");
                u32 blk[16];
#pragma unroll
                for (int r = 0; r < 16; ++r) blk[r] = (ordmap(acc[r]) & ~0x7Fu) | (u32)(127 - 32 * nb - crow16(r) - 4 * hi);
                if (nb == 0) { sort16<true>(blk);
#pragma unroll
                    for (int i = 0; i < 16; ++i) run[i] = blk[i]; }
                else { sort16<false>(blk);
#pragma unroll
                    for (int i = 0; i < 16; ++i) run[i] = umax_(run[i], blk[i]);
                    merge16<true>(run); }
            }
            u32 oth[16];
#pragma unroll
            for (int i = 0; i < 16; ++i) oth[i] = (u32)__shfl_xor((int)run[15 - i], 32);
#pragma unroll
            for (int i = 0; i < 16; ++i) run[i] = umax_(run[i], oth[i]);
            merge16<true>(run);
#pragma unroll
            for (int i = 0; i < 16; ++i) { if (p == 0) s0[i] = run[i]; else s1[i] = run[i]; }
        }
        { LAS u32* iw = (LAS u32*)IDXB;
#pragma unroll
          for (int j = 0; j < 4; ++j) {
              iw[j] = (127u - (s0[4 * j] & 127u)) | ((127u - (s0[4 * j + 1] & 127u)) << 8) | ((127u - (s0[4 * j + 2] & 127u)) << 16) | ((127u - (s0[4 * j + 3] & 127u)) << 24);
              iw[4 + j] = (127u - (s1[4 * j] & 127u)) | ((127u - (s1[4 * j + 1] & 127u)) << 8) | ((127u - (s1[4 * j + 2] & 127u)) << 16) | ((127u - (s1[4 * j + 3] & 127u)) << 24); } }
        float v1[16], v2[16];
#pragma unroll
        for (int i = 0; i < 16; ++i) { v1[i] = unordmap(s0[i] & ~0x7Fu); v2[i] = unordmap(s1[i] & ~0x7Fu); }
        u32 c0[16], c1[16], c2[16], c3[16];
#pragma unroll
        for (int a = 0; a < 16; ++a)
#pragma unroll
            for (int b = 0; b < ccnt(a); ++b) { const int pos = cbase(a) + b; const u32 key = (ordmap(v1[a] + v2[b]) & ~0xFFu) | (u32)(255 - (a * 16 + b));
                if (pos < 16) c0[pos] = key; else if (pos < 32) c1[pos - 16] = key; else if (pos < 48) c2[pos - 32] = key; else c3[pos - 48] = key; }
#pragma unroll
        for (int i = 2; i < 16; ++i) c3[i] = 0u;
        sort16<false>(c1);
#pragma unroll
        for (int i = 0; i < 16; ++i) c0[i] = umax_(c0[i], c1[i]);
        merge16<true>(c0);
        sort16<false>(c2);
#pragma unroll
        for (int i = 0; i < 16; ++i) c0[i] = umax_(c0[i], c2[i]);
        merge16<true>(c0);
        sort16<false>(c3);
#pragma unroll
        for (int i = 0; i < 16; ++i) c0[i] = umax_(c0[i], c3[i]);
        merge16<true>(c0);
        const float m = unordmap(c0[0] & ~0xFFu) * rstd2;
        float e[8]; float sum = 0.f; u32 ex[8];
#pragma unroll
        for (int k = 0; k < 8; ++k) { const u32 key = hi ? c0[k + 8] : c0[k]; const float ts = unordmap(key & ~0xFFu);
            e[k] = __builtin_amdgcn_exp2f((ts * rstd2 - m) * LOG2E); sum += e[k];
            const u32 flat = 255u - (key & 255u); ex[k] = (u32)IDXB[flat >> 4] * NKEY + (u32)IDXB[16 + (flat & 15u)]; }
        sum += __shfl_xor(sum, 32);
        const float inv = 1.f / sum;
        v4u exw; exw.x = ex[0] | (ex[1] << 16); exw.y = ex[2] | (ex[3] << 16); exw.z = ex[4] | (ex[5] << 16); exw.w = ex[6] | (ex[7] << 16);
        *(LAS v4u*)(EXL + tok * EX_STRIDE + w * 16 + hi * 8) = exw;
        *(LAS v4u*)(GTL + tok * GT_STRIDE + w * 16 + hi * 8) = (v4u){pk2(e[0] * inv, e[1] * inv), pk2(e[2] * inv, e[3] * inv), pk2(e[4] * inv, e[5] * inv), pk2(e[6] * inv, e[7] * inv)};
    }
}
__device__ __forceinline__ float gelu_fast(float x) {
    const float u2 = x * (1.5957691216057308f + 0.07135481627f * x * x);
    return x * __builtin_amdgcn_rcpf(1.f + __builtin_amdgcn_exp2f(-1.4426950408889634f * u2));
}
typedef float f32x2 __attribute__((ext_vector_type(2)));

__device__ __forceinline__ void sort128(u32 (&k)[8], int m) {
#pragma unroll
    for (int K = 2; K <= 128; K <<= 1) {
#pragma unroll
        for (int S = K >> 1; S > 0; S >>= 1) {
            if (S >= 8) {
                const int mm = S >> 3; const bool lower = (m & mm) == 0, up = (K == 128) ? true : ((m & (K >> 3)) == 0), keepmin = (lower == up);
#pragma unroll
                for (int r = 0; r < 8; ++r) { const u32 o = (u32)__shfl_xor((int)k[r], mm); const u32 mn = umin_(k[r], o), mx = umax_(k[r], o); k[r] = keepmin ? mn : mx; }
            } else {
#pragma unroll
                for (int r = 0; r < 8; ++r) { const int r2 = r ^ S;
                    if (r2 > r) { const u32 a = k[r], b = k[r2], mn = umin_(a, b), mx = umax_(a, b);
                        if (K < 8) { const bool up = (r & K) == 0; k[r] = up ? mn : mx; k[r2] = up ? mx : mn; }
                        else { const bool up = (K == 128) ? true : ((m & (K >> 3)) == 0); k[r] = up ? mn : mx; k[r2] = up ? mx : mn; } } }
            }
        }
    }
}
typedef int v8i __attribute__((ext_vector_type(8)));
__device__ __forceinline__ void eval_mf(Frame& F, const unsigned char* u4, const unsigned char* v4, const float* suv, const float* fg, float* out, int t0) {
    int lane = F.lane; asm volatile("" : "+v"(lane));
    const int g = lane >> 4, m = lane & 15;
    const LAS unsigned short* EXL = (const LAS unsigned short*)(F.lds + RING_OFF + L_EX);
    const LAS unsigned short* GTL = (const LAS unsigned short*)(F.lds + RING_OFF + L_GT);
    LAS unsigned char* BI = F.lds + RING_OFF + L_BI + F.wave * BI_WAVE;
    const LAS float* RST = (const LAS float*)(F.lds + RING_OFF + L_RST);
    LAS u32* SKW = (LAS u32*)(F.lds + RING_OFF + L_IDX) + F.wave * 512;
    LAS u32* SK = SKW + g * 128;
    for (int pass = 0; pass < 4; ++pass) {
        const int tb4 = 32 * pass + 4 * F.wave, tok = tb4 + g;
        { u32 k[8]; const v4u ev = *(const LAS v4u*)(EXL + tok * EX_STRIDE + 8 * m); const u32 s0 = (u32)(8 * m);
          k[0] = ((ev.x & 0xffffu) << 7) | s0; k[1] = ((ev.x >> 16) << 7) | (s0 + 1); k[2] = ((ev.y & 0xffffu) << 7) | (s0 + 2); k[3] = ((ev.y >> 16) << 7) | (s0 + 3);
          k[4] = ((ev.z & 0xffffu) << 7) | (s0 + 4); k[5] = ((ev.z >> 16) << 7) | (s0 + 5); k[6] = ((ev.w & 0xffffu) << 7) | (s0 + 6); k[7] = ((ev.w >> 16) << 7) | (s0 + 7);
          sort128(k, m);
          *(LAS v4u*)(SK + m * 8) = (v4u){k[0], k[1], k[2], k[3]}; *(LAS v4u*)(SK + m * 8 + 4) = (v4u){k[4], k[5], k[6], k[7]}; }
        asm volatile("" ::: "memory");
        {
#pragma unroll
            for (int tq = 0; tq < 4; ++tq) { const float rq = RST[tb4 + tq]; const float* xr = out + (size_t)(t0 + tb4 + tq) * DMODEL + 4 * lane;
#pragma unroll
                for (int c = 0; c < 4; ++c) { const f32x4 xa = *(const GAS f32x4*)(xr + 256 * c); int w = 0;
                    w = __builtin_amdgcn_cvt_pk_fp8_f32(xa[0] * rq, xa[1] * rq, w, false); w = __builtin_amdgcn_cvt_pk_fp8_f32(xa[2] * rq, xa[3] * rq, w, true);
                    const int d = 256 * c + 4 * lane, st = d >> 7, dd = d & 127, hh = dd >> 6, e = dd & 63;
                    *(LAS int*)(BI + ((st * 4 + tq) * 4 + (e >> 4)) * 32 + hh * 16 + (e & 15)) = w; } }
        }
        asm volatile("" ::: "memory");
        v8i hb[8];
#pragma unroll
        for (int st = 0; st < 8; ++st) { v4u b0 = *(const LAS v4u*)(BI + ((st * 4 + (m & 3)) * 4 + g) * 32), b1 = *(const LAS v4u*)(BI + ((st * 4 + (m & 3)) * 4 + g) * 32 + 16);
            if (m >= 4) { b0 = (v4u){0u, 0u, 0u, 0u}; b1 = b0; }
            hb[st] = (v8i){(int)b0.x, (int)b0.y, (int)b0.z, (int)b0.w, (int)b1.x, (int)b1.y, (int)b1.z, (int)b1.w}; }
        asm volatile("" ::: "memory");
        f32x2 y[32];
#pragma unroll
        for (int q = 0; q < 32; ++q) y[q] = (f32x2){0.f, 0.f};
        float* xrow = out + (size_t)(t0 + tok) * DMODEL + 4 * m;
        const LAS unsigned short* gtr = GTL + tok * GT_STRIDE;
        for (int i = 0; i < 128; i += 4) {
            const v4u kq = *(const LAS v4u*)(SK + i);
            v4u ua[4][2];
#pragma unroll
            for (int s4 = 0; s4 < 4; ++s4) { const u32 ro = (kq[s4] >> 7) * 512u + 16u * (u32)m; ua[s4][0] = *(const GAS v4u*)(u4 + ro); ua[s4][1] = *(const GAS v4u*)(u4 + ro + 256); }
            v4u af[8];
#pragma unroll
            for (int hf = 0; hf < 2; ++hf) {
#pragma unroll
                for (int s4 = 0; s4 < 4; ++s4) *(LAS v4u*)(BI + (4 * s4 + g) * 272 + 16 * m) = ua[s4][hf];
                asm volatile("" ::: "memory");
#pragma unroll
                for (int st = 0; st < 4; ++st) af[4 * hf + st] = *(const LAS v4u*)(BI + m * 272 + 64 * st + 16 * g);
                asm volatile("" ::: "memory");
            }
            f32x2 sc[4]; float gate[4];
#pragma unroll
            for (int s4 = 0; s4 < 4; ++s4) { sc[s4] = *(const GAS f32x2*)(suv + 2 * (kq[s4] >> 7)); gate[s4] = __uint_as_float((u32)gtr[kq[s4] & 127u] << 16); }
            f32x4 D = (f32x4){0.f, 0.f, 0.f, 0.f};
#pragma unroll
            for (int st = 0; st < 8; ++st) { const v8i a8 = (v8i){(int)af[st].x, (int)af[st].y, (int)af[st].z, (int)af[st].w, 0, 0, 0, 0};
                D = __builtin_amdgcn_mfma_scale_f32_16x16x128_f8f6f4(a8, hb[st], D, 4, 0, 0, 0x7f7f7f7f, 0, 0x7f7f7f7f); }
            asm volatile("" ::: "memory");
            v4u vb[4][2];
#pragma unroll
            for (int s4 = 0; s4 < 4; ++s4) { const u32 ro = (kq[s4] >> 7) * 512u + 32u * (u32)m; vb[s4][0] = *(const GAS v4u*)(v4 + ro); vb[s4][1] = *(const GAS v4u*)(v4 + ro + 16); }
            const int sel = lane & 3; const float mine = sel == 0 ? D[0] : sel == 1 ? D[1] : sel == 2 ? D[2] : D[3];
#pragma unroll
            for (int s4 = 0; s4 < 4; ++s4) { const float pre = __uint_as_float((unsigned)__builtin_amdgcn_ds_bpermute(4 * (g + 16 * s4), (int)__float_as_uint(mine)));
                const float act = gelu_fast(pre * sc[s4][0]) * (gate[s4] * sc[s4][1]); const f32x2 b2 = (f32x2){act, act};
#pragma unroll
                for (int c = 0; c < 2; ++c)
#pragma unroll
                    for (int d = 0; d < 4; ++d) { const unsigned w_ = vb[s4][c][d]; const int hq = 16 * c + 4 * d;
                        y[hq] = __builtin_elementwise_fma(__builtin_amdgcn_cvt_scalef32_pk_f32_fp4(w_, 1.0f, 0), b2, y[hq]); y[hq + 1] = __builtin_elementwise_fma(__builtin_amdgcn_cvt_scalef32_pk_f32_fp4(w_, 1.0f, 1), b2, y[hq + 1]);
                        y[hq + 2] = __builtin_elementwise_fma(__builtin_amdgcn_cvt_scalef32_pk_f32_fp4(w_, 1.0f, 2), b2, y[hq + 2]); y[hq + 3] = __builtin_elementwise_fma(__builtin_amdgcn_cvt_scalef32_pk_f32_fp4(w_, 1.0f, 3), b2, y[hq + 3]); } }
        }
        float ss = 0.f;
#pragma unroll
        for (int q = 0; q < 16; ++q) { const f32x4 xa = *(const GAS f32x4*)(xrow + 64 * q); y[2 * q][0] += xa[0]; y[2 * q][1] += xa[1]; y[2 * q + 1][0] += xa[2]; y[2 * q + 1][1] += xa[3];
            ss += (y[2 * q][0] * y[2 * q][0] + y[2 * q][1] * y[2 * q][1]) + (y[2 * q + 1][0] * y[2 * q + 1][0] + y[2 * q + 1][1] * y[2 * q + 1][1]); }
        ss += __shfl_xor(ss, 1); ss += __shfl_xor(ss, 2); ss += __shfl_xor(ss, 4); ss += __shfl_xor(ss, 8);
        const float rs = rsqrtf(ss * (1.f / DMODEL) + RMS_EPS);
        asm volatile("" ::: "memory");
#pragma unroll
        for (int q = 0; q < 16; ++q) { const f32x4 gq = *(const GAS f32x4*)(fg + 64 * q + 4 * m); f32x4 o; o[0] = y[2 * q][0] * rs * gq[0]; o[1] = y[2 * q][1] * rs * gq[1]; o[2] = y[2 * q + 1][0] * rs * gq[2]; o[3] = y[2 * q + 1][1] * rs * gq[3];
            *(GAS f32x4*)(xrow + 64 * q) = o; }
    }
}
__device__ __forceinline__ void peer_phase(Frame& F, const Args& a) {
    unsigned char* ws = a.ws;
    for (int tile = F.vcu; tile < T / TOK; tile += F.G) {
        route_tile(F, (const bf16*)(ws + WS_QP), (const bf16*)(ws + WS_SKB), (const float*)(ws + WS_SUMSQ), tile * TOK);
        __syncthreads();
        eval_mf(F, ws + WS_U8, ws + WS_V8, (const float*)(ws + WS_SU), a.in[19], a.out, tile * TOK);
        __syncthreads();
    }
}
}

namespace lru {
typedef float f32x16 __attribute__((ext_vector_type(16)));
constexpr int TOKT = 128, NTILE = SEQ / TOKT;
constexpr int WAVE_LDS = 14336, L_XS = 0, L_XC = 4608, L_GS = 9216, XC_STRIDE = 72  , L_SS = 8 * WAVE_LDS;
static_assert(L_SS + 32 * 8 * 4 <= RING_BYTES, "LRU LDS map");
__device__ __forceinline__ float bf2f(unsigned short h) { return __uint_as_float((unsigned)h << 16); }
__device__ __forceinline__ int crow16(int r) { return (r & 3) + 8 * (r >> 2); }
__device__ __forceinline__ float sigm(float x) { return __builtin_amdgcn_rcpf(1.f + __builtin_amdgcn_exp2f(-LOG2E * x)); }

template <bool FINAL> __device__ __forceinline__ void lru_tile(Frame& F, const Args& args, int tile) {
    int lane = F.lane; asm volatile("" : "+v"(lane));
    const int w = F.wave, j32 = lane & 31, hi = lane >> 5;
    unsigned char* ws = args.ws;
    const bf16* xr = (const bf16*)(ws + WS_XR); const bf16* gr = (const bf16*)(ws + WS_GR); float* carry = (float*)(ws + WS_CARRY);
    const float* cw = args.in[3]; const float* cb = args.in[4]; const float* ba = args.in[6]; const float* bx = args.in[8]; const float* lam = args.in[9];
    const int b = tile / NTILE, jt = tile % NTILE; const size_t trow0 = (size_t)b * SEQ + (size_t)jt * TOKT;
    LAS unsigned char* wl = F.lds + RING_OFF + w * WAVE_LDS;
    LAS unsigned short* XS = (LAS unsigned short*)(wl + L_XS); LAS unsigned short* XC = (LAS unsigned short*)(wl + L_XC); LAS unsigned short* GS = (LAS unsigned short*)(wl + L_GS);
    LAS float* SS = (LAS float*)(F.lds + RING_OFF + L_SS);
    float c_ba[2], c_bx[2], c_sp[2], c_cb[2], c_cw[2][4];
#pragma unroll
    for (int n = 0; n < 2; ++n) { const int c = 64 * w + 32 * n + j32; c_ba[n] = ba[c]; c_bx[n] = bx[c]; c_cb[n] = cb[c];
        const float l = lam[c]; c_sp[n] = 8.f * LOG2E * (fmaxf(-l, 0.f) + log1pf(expf(-fabsf(l))));
#pragma unroll
        for (int k = 0; k < 4; ++k) c_cw[n][k] = cw[k * LW + c]; }
    const bf16* wax = (const bf16*)(ws + WS_WAX);
    float hc[2] = {0.f, 0.f}, ap[2] = {1.f, 1.f};
    if (FINAL) { const float* cin = (const float*)(ws + WS_CIN) + (size_t)(b * NTILE + jt) * LW + 64 * w + j32; hc[0] = cin[0]; hc[1] = cin[32]; }
    v4u pfx[5], pfg[4];
#define LRU_FETCH(B) do { const size_t tbn_ = trow0 + (B) * 32; _Pragma("unroll") for (int q_ = 0; q_ < 5; ++q_) { const int pc_ = lane + 64 * q_, row_ = pc_ >> 3, c8_ = pc_ & 7; \
        const bool z_ = (jt == 0 && (B) == 0 && row_ < 3) || pc_ >= 35 * 8; const v4u v_ = *(const GAS v4u*)(xr + (tbn_ + (z_ ? 3 : row_) - 3) * LW + w * 64 + c8_ * 8); pfx[q_] = z_ ? (v4u){0u, 0u, 0u, 0u} : v_; } \
        if (FINAL) { _Pragma("unroll") for (int q_ = 0; q_ < 4; ++q_) { const int pc_ = lane + 64 * q_; pfg[q_] = *(const GAS v4u*)(gr + (tbn_ + (pc_ >> 3)) * LW + w * 64 + (pc_ & 7) * 8); } } } while (0)
    LRU_FETCH(0);
    for (int blk = 0; blk < 4; ++blk) {
        const size_t tb = trow0 + blk * 32;
        int ln = lane; asm volatile("" : "+v"(ln));
        const int k32 = ln & 31;
#pragma unroll
        for (int q = 0; q < 5; ++q) { const int pc = ln + 64 * q; if (pc < 35 * 8) *(LAS v4u*)((LAS unsigned char*)XS + (pc >> 3) * 128 + (pc & 7) * 16) = pfx[q]; }
        if (FINAL) {
#pragma unroll
            for (int q = 0; q < 4; ++q) { const int pc = ln + 64 * q; *(LAS v4u*)((LAS unsigned char*)GS + (pc >> 3) * 128 + (pc & 7) * 16) = pfg[q]; } }
        if (blk < 3) { LRU_FETCH(blk + 1); }
        asm volatile("" ::: "memory");
        float xc[2][16];
#pragma unroll
        for (int n = 0; n < 2; ++n)
#pragma unroll
            for (int g = 0; g < 4; ++g) { float xv[7];
#pragma unroll
                for (int q = 0; q < 7; ++q) xv[q] = bf2f(XS[(8 * g + 4 * hi + q) * 64 + 32 * n + j32]);
#pragma unroll
                for (int e = 0; e < 4; ++e) xc[n][4 * g + e] = c_cb[n] + ((c_cw[n][0] * xv[e] + c_cw[n][1] * xv[e + 1]) + (c_cw[n][2] * xv[e + 2] + c_cw[n][3] * xv[e + 3])); }
#pragma unroll
        for (int n = 0; n < 2; ++n)
#pragma unroll
            for (int r = 0; r < 16; ++r) XC[(crow16(r) + 4 * hi) * XC_STRIDE + 32 * n + j32] = (unsigned short)f2bf(xc[n][r]);
        asm volatile("" ::: "memory");
        bf16x8 af[4];
#pragma unroll
        for (int ks = 0; ks < 4; ++ks) af[ks] = *(const LAS bf16x8*)(XC + j32 * XC_STRIDE + 16 * ks + 8 * hi);
        asm volatile("" ::: "memory");
        float yv[2][16];
#pragma unroll
        for (int n = 0; n < 2; ++n) {
            f32x16 R = {}, I = {};
            bf16x8 fa[4], fx[4];
#pragma unroll
            for (int ks = 0; ks < 4; ++ks) { fa[ks] = *(const GAS bf16x8*)(wax + (size_t)(((w * 2 + 0) * 2 + n) * 4 + ks) * 512 + ln * 8); fx[ks] = *(const GAS bf16x8*)(wax + (size_t)(((w * 2 + 1) * 2 + n) * 4 + ks) * 512 + ln * 8); }
#pragma unroll
            for (int ks = 0; ks < 4; ++ks) { R = __builtin_amdgcn_mfma_f32_32x32x16_bf16(af[ks], fa[ks], R, 0, 0, 0); I = __builtin_amdgcn_mfma_f32_32x32x16_bf16(af[ks], fx[ks], I, 0, 0, 0); }
            float av[16], uv[16];
#pragma unroll
            for (int r = 0; r < 16; ++r) { const float rg = sigm(R[r] + c_ba[n]), ig = sigm(I[r] + c_bx[n]); const float a_ = __builtin_amdgcn_exp2f(-rg * c_sp[n]);
                av[r] = a_; uv[r] = __builtin_amdgcn_sqrtf(fmaxf(1.f - a_ * a_, 0.f)) * (ig * xc[n][r]); }
            float Ar[4], Hr[4], hst[4];
#pragma unroll
            for (int g = 0; g < 4; ++g) { Ar[g] = (av[4 * g] * av[4 * g + 1]) * (av[4 * g + 2] * av[4 * g + 3]);
                Hr[g] = ((uv[4 * g] * av[4 * g + 1] + uv[4 * g + 1]) * av[4 * g + 2] + uv[4 * g + 2]) * av[4 * g + 3] + uv[4 * g + 3]; }
            float hin = hc[n];
#pragma unroll
            for (int g = 0; g < 4; ++g) { float o1 = Ar[g] * hin + Hr[g]; const float x = __shfl_xor(o1, 32); const float hg = hi ? x : hin; o1 = Ar[g] * hg + Hr[g]; hst[g] = hg;
                const float y = __shfl_xor(o1, 32); hin = hi ? o1 : y;
                if (!FINAL) ap[n] *= Ar[g] * __shfl_xor(Ar[g], 32); }
            hc[n] = hin;
            if (FINAL) {
#pragma unroll
                for (int g = 0; g < 4; ++g) { float h = hst[g];
#pragma unroll
                    for (int e = 0; e < 4; ++e) { const int r = 4 * g + e; h = av[r] * h + uv[r]; yv[n][r] = h * bf2f(GS[(crow16(r) + 4 * hi) * 64 + 32 * n + j32]); } } }
        }
        if (FINAL) {
#pragma unroll
            for (int r = 0; r < 16; ++r) { float s = yv[0][r] * yv[0][r] + yv[1][r] * yv[1][r];
                s += __shfl_xor(s, 1); s += __shfl_xor(s, 2); s += __shfl_xor(s, 4); s += __shfl_xor(s, 8); s += __shfl_xor(s, 16);
                if (j32 == 0) SS[(crow16(r) + 4 * hi) * 8 + w] = s; }
            __syncthreads();
            bf16* ymix = (bf16*)(ws + WS_H);
#pragma unroll
            for (int r = 0; r < 16; ++r) { const int tk = crow16(r) + 4 * hi; const f32x4 s0 = *(const LAS f32x4*)(SS + tk * 8), s1 = *(const LAS f32x4*)(SS + tk * 8 + 4);
                const float rstd = rsqrtf(((s0[0] + s0[1]) + (s0[2] + s0[3]) + (s1[0] + s1[1]) + (s1[2] + s1[3])) * (1.f / LW) + RMS_EPS);
                bf16* yp = ymix + (tb + tk) * DMODEL + 64 * w + k32;
                yp[0] = (bf16)f2bf(yv[0][r] * rstd); yp[32] = (bf16)f2bf(yv[1][r] * rstd); }
            __syncthreads();
        }
    }
#undef LRU_FETCH
    if (!FINAL) { if (hi == 0) { float* cp = carry + ((size_t)(b * NTILE + jt) * 2) * LW + 64 * w + j32;
#pragma unroll
        for (int n = 0; n < 2; ++n) { cp[32 * n] = ap[n]; cp[LW + 32 * n] = hc[n]; } } }
    else {
        const bf16* ob = (const bf16*)(ws + WS_O); bf16* ymix = (bf16*)(ws + WS_H);
        for (int i0 = 0; i0 < 16; i0 += 4) {
            v4u vv[4];
#pragma unroll
            for (int i = 0; i < 4; ++i) vv[i] = *(const GAS v4u*)(ob + (trow0 + 16 * w + i0 + i) * AW + 8 * lane);
            float ssq[4];
#pragma unroll
            for (int i = 0; i < 4; ++i) { float s = 0.f;
#pragma unroll
                for (int c = 0; c < 4; ++c) { const float lo = __uint_as_float(vv[i][c] << 16), hi2 = __uint_as_float(vv[i][c] & 0xffff0000u); s += lo * lo + hi2 * hi2; }
                ssq[i] = s; }
#pragma unroll
            for (int o = 1; o < 64; o <<= 1) {
#pragma unroll
                for (int i = 0; i < 4; ++i) ssq[i] += __shfl_xor(ssq[i], o); }
#pragma unroll
            for (int i = 0; i < 4; ++i) { const float rstd = rsqrtf(ssq[i] * (1.f / AW) + RMS_EPS); v4u o;
#pragma unroll
                for (int c = 0; c < 4; ++c) o[c] = pk2(__uint_as_float(vv[i][c] << 16) * rstd, __uint_as_float(vv[i][c] & 0xffff0000u) * rstd);
                *(GAS v4u*)(ymix + (trow0 + 16 * w + i0 + i) * DMODEL + LW + 8 * lane) = o; } }
    }
}
__device__ __forceinline__ void norm_pass(Frame& F, const Args& a) {
    unsigned char* ws = a.ws; float* nrm = (float*)(ws + WS_NRM);
    const int gw = F.vcu * NWAVES + F.wave, NGW = F.G * NWAVES, lane = F.lane;
    for (int it = gw; it < 2 * BATCH * (SEQ / 64); it += NGW) {
        const int which = it / (BATCH * (SEQ / 64)), r = it % (BATCH * (SEQ / 64)), b = r / (SEQ / 64), t = r % (SEQ / 64);
        const bf16* src = (const bf16*)(ws + (which ? WS_K : WS_Q)) + ((size_t)b * SEQ + 64 * t) * AW + 8 * lane;
        float mx = 0.f;
#pragma unroll 8
        for (int i = 0; i < 64; ++i) { const v4u v = *(const GAS v4u*)(src + (size_t)i * AW); float s = 0.f;
#pragma unroll
            for (int c = 0; c < 4; ++c) { const float lo = __uint_as_float(v[c] << 16), hi = __uint_as_float(v[c] & 0xffff0000u); s += lo * lo + hi * hi; }
            s += __shfl_xor(s, 1); s += __shfl_xor(s, 2); s += __shfl_xor(s, 4); mx = fmaxf(mx, s); }
        if ((lane & 7) == 0) nrm[which * 4096 + (b * NHEADS + (lane >> 3)) * 128 + t] = sqrtf(mx) * 1.0001f;
    }
}
__device__ __forceinline__ void carry_prefix(Frame& F, const Args& a, int b) {
    const float* carry = (const float*)(a.ws + WS_CARRY) + (size_t)b * NTILE * 2 * LW + F.tid; float* cin = (float*)(a.ws + WS_CIN) + (size_t)b * NTILE * LW + F.tid;
    float c = 0.f;
    for (int j0 = 0; j0 < NTILE; j0 += 8) { float A[8], H[8];
#pragma unroll
        for (int j = 0; j < 8; ++j) { A[j] = carry[(size_t)(j0 + j) * 2 * LW]; H[j] = carry[(size_t)(j0 + j) * 2 * LW + LW]; }
#pragma unroll
        for (int j = 0; j < 8; ++j) { cin[(size_t)(j0 + j) * LW] = c; c = A[j] * c + H[j]; } }
}
template <bool FINAL> __device__ __forceinline__ void lru_phase(Frame& F, const Args& a) {
    for (int tile = F.vcu; tile < BATCH * NTILE; tile += F.G) { lru_tile<FINAL>(F, a, tile); __syncthreads(); }
}
}
__global__ void __launch_bounds__(NWAVES * 64, 2) mk_fwd(Args args) {
    extern __shared__ __attribute__((aligned(16))) unsigned char lds[];
    Frame F;
    F.lds = (LAS unsigned char*)lds;
    F.MISC = (volatile LAS unsigned*)(F.lds + MISC_OFF);
    F.wave = __builtin_amdgcn_readfirstlane((int)threadIdx.x >> 6); F.lane = (int)__builtin_amdgcn_mbcnt_hi(~0u, __builtin_amdgcn_mbcnt_lo(~0u, 0u)); F.tid = F.wave * 64 + F.lane;
    F.G = gridDim.x; { const int bx = blockIdx.x; F.vcu = (F.G % 8 == 0) ? (bx % 8) * (F.G / 8) + bx / 8 : bx; }
    unsigned char* ws = args.ws;
    F.ctl = (gu32*)(ws + WS_CTL);
    for (int u = F.tid; u < (LDS_BYTES - LDSCTL_OFF) / 4; u += NWAVES * 64) ((LAS unsigned*)(F.lds + LDSCTL_OFF))[u] = 0u;
    __syncthreads();
    XcdBarrier bar = xcd_barrier_post((unsigned*)(F.ctl + CW_BAR) + args.li * XCD_BAR_WORDS, F.MISC + 8, F.wave);
    const int lo = args.ph_lo, hi = args.ph_hi;
#define IN(k) (lo <= (k) && (k) < hi)
#define BOTH(k) (IN(k) && IN((k) + 1))
#define GRID_BAR() xcd_barrier(bar)

    if (IN(0)) { p0_prologue(F, args); if (BOTH(0)) GRID_BAR(); }

    if (IN(1)) {
        if (F.vcu < BATCH * NHEADS) fcum_unit(F, F.vcu, (const float*)(ws + WS_LOGF), (float*)(ws + WS_FCUM));
        pg8::Gemm g{(const pg8::bf16_t*)(ws + WS_H), (const pg8::bf16_t*)(ws + WS_WIN), T, NG1, DMODEL}; pg8::StaticOrder S; S.init(T, NG1, F.G, (int)blockIdx.x);
        pg8::EpiG1 E{(pg8::bf16_t*)(ws + WS_XR), SPLIT_STRIDE, QSCALE};
        pg8::gemm_phase<pg8::EpiG1, pg8::StaticOrder, true, true>(F.lds + RING_OFF, g, S, E, F.wave);
        if (BOTH(1)) GRID_BAR();
    }
    if (IN(2)) { lru::lru_phase<false>(F, args); lru::norm_pass(F, args); if (BOTH(2)) GRID_BAR(); }
    if (IN(3)) {
        static_assert(attn_body::ATTN_LDS_BYTES <= RING_BYTES, "attention LDS vs frame");
        if (F.vcu < BATCH) lru::carry_prefix(F, args, F.vcu);
        const attn_body::AttnTensors AT{(const attn_body::bf16*)(ws + WS_Q), (const attn_body::bf16*)(ws + WS_K), (const attn_body::bf16*)(ws + WS_V), (attn_body::bf16*)(ws + WS_O), (const float*)(ws + WS_FCUM), (const float*)(ws + WS_NRM)};
        attn_body::attn_phase<8>((char*)lds + RING_OFF, AT, (unsigned*)(F.ctl + CW_ATTQ), F.MISC + 24, F.wave);
        if (BOTH(3)) GRID_BAR();
    }
    if (IN(4)) { lru::lru_phase<true>(F, args); if (BOTH(4)) GRID_BAR(); }
    if (IN(5)) {
        pg8::Gemm g{(const pg8::bf16_t*)(ws + WS_H), (const pg8::bf16_t*)(ws + WS_WOUT), T, DMODEL, DMODEL}; pg8::StaticOrder S; S.init(T, DMODEL, F.G, (int)blockIdx.x);
        pg8::EpiG2 E{args.in[0], args.out, (pg8::bf16_t*)(ws + WS_X1B), (float*)(ws + WS_SUMSQ), DMODEL};
        pg8::gemm_phase<pg8::EpiG2, pg8::StaticOrder, true, true>(F.lds + RING_OFF, g, S, E, F.wave);
        if (BOTH(5)) GRID_BAR();
    }
    if (IN(6)) {
        pg8::Gemm g{(const pg8::bf16_t*)(ws + WS_X1B), (const pg8::bf16_t*)(ws + WS_WQ), T, QPW, DMODEL}; pg8::StaticOrder S; S.init(T, QPW, F.G, (int)blockIdx.x);
        pg8::EpiG3 E{(pg8::bf16_t*)(ws + WS_QP), QPW};
        pg8::gemm_phase<pg8::EpiG3, pg8::StaticOrder, true, true>(F.lds + RING_OFF, g, S, E, F.wave);
        if (BOTH(6)) GRID_BAR();
    }
    if (IN(7)) { peer::peer_phase(F, args); }
#undef IN
#undef BOTH
#undef GRID_BAR
}

extern "C" void kernel_launch(void* const* d_in, const int* in_sizes, int n_in, void* d_out, int out_size, void* d_ws, size_t ws_size, hipStream_t stream) {
    static int grid = 0;
    if (grid == 0) {
        if (n_in != 20 || in_sizes[0] != T * DMODEL || out_size != T * DMODEL || ws_size < WS_END) { fprintf(stderr, "kernel_launch: unexpected shapes (n_in %d, ws %zu)\n", n_in, ws_size); grid = -1; return; }
        int dev = 0, cus = 0;
        if (hipGetDevice(&dev) != hipSuccess || hipDeviceGetAttribute(&cus, hipDeviceAttributeMultiprocessorCount, dev) != hipSuccess) { grid = -1; return; }
        if (hipFuncSetAttribute((const void*)mk_fwd, hipFuncAttributeMaxDynamicSharedMemorySize, LDS_BYTES) != hipSuccess) { fprintf(stderr, "kernel_launch: hipFuncSetAttribute failed\n"); grid = -1; return; }
        (void)hipGetLastError();
        grid = cus;
    }
    if (grid < 0) return;
    if (hipMemsetAsync((char*)d_ws + WS_CTL, 0, CTL_ZERO_BYTES, stream) != hipSuccess) return;
    Args a{};
    for (int i = 0; i < 20; ++i) a.in[i] = (const float*)d_in[i];
    a.out = (float*)d_out; a.ws = (unsigned char*)d_ws; a.ph_lo = 0; a.ph_hi = N_PHASES; a.li = 0;
    hipLaunchKernelGGL(mk_fwd, dim3(grid), dim3(NWAVES * 64), LDS_BYTES, stream, a);
}
```

```cpp
#include <hip/hip_runtime.h>
#include <hip/hip_bf16.h>
#include <cstdio>
#include <cstdint>
#include <cmath>

constexpr int BATCH = 4, SEQ = 8192, DMODEL = 1024, T = BATCH * SEQ;
constexpr int LW = 512, AW = 512, NHEADS = 8, HD = 64, INC = 2568, NG1 = 2560;
constexpr int PH = 8, NKEY = 128, PHALF = 128, TOPK = 16, NEXP = NKEY * NKEY, QPW = 2048;
constexpr float RMS_EPS = 1e-6f;
constexpr float LOG2E = 1.4426950408889634f;
constexpr float QSCALE = 0.125f * LOG2E;
constexpr size_t MiB = 1u << 20;
constexpr size_t WS_CTL = 0, CTL_ZERO_BYTES = 1 * MiB;
constexpr size_t WS_WIN = 2 * MiB, WS_WOUT = 8 * MiB, WS_WQ = 10 * MiB, WS_SKB = 14 * MiB, WS_WFL = 15 * MiB,
                 WS_LOGF = 16 * MiB, WS_FCUM = 17 * MiB, WS_CARRY = 18 * MiB, WS_SUMSQ = 19 * MiB, WS_WAX = 20 * MiB, WS_CIN = 23 * MiB  , WS_NRM = 22 * MiB  ,
                 WS_H = 32 * MiB, WS_XR = 96 * MiB, WS_GR = 128 * MiB, WS_Q = 160 * MiB, WS_K = 192 * MiB, WS_V = 224 * MiB,
                 WS_X1B = 256 * MiB, WS_O = 256 * MiB  , WS_QP = 96 * MiB, WS_UT = 320 * MiB, WS_VT = 352 * MiB, WS_U8 = 320 * MiB, WS_V8 = 336 * MiB, WS_SU = 21 * MiB, WS_SV = 21 * MiB + 65536, WS_LA = 384 * MiB, WS_LU = 448 * MiB, WS_END = 512 * MiB;
constexpr size_t SPLIT_STRIDE = (WS_GR - WS_XR) / 2;
constexpr int CW_TMO = 0, CW_ATTQ = 2048, CW_BAR = 4096;

namespace pg8 {
#define PG8_LAS __attribute__((address_space(3)))
typedef unsigned short bf16_t;
typedef short bf16x8 __attribute__((ext_vector_type(8)));
typedef float f32x4 __attribute__((ext_vector_type(4)));
typedef unsigned u32x4 __attribute__((ext_vector_type(4)));
constexpr int BM = 256, BK = 64, HALF = 128, HTB = HALF * BK * 2  , STAGE_BYTES = 8 * HTB, NXCD = 8, WGM = 8;

__host__ __device__ __forceinline__ int lds_byte(int r, int c) { const int st = (r >> 4) * 2 + (c >> 5), rr = r & 15, cc = c & 31, ob = rr * 64 + cc * 2; return st * 1024 + (ob ^ (((ob >> 9) & 1) << 5)); }
__host__ __device__ __forceinline__ void stage_rc(int b, int& R, int& C) { const int st = b / 1024, sb = b % 1024, swz = sb ^ (((sb >> 9) & 1) << 5); R = (st >> 1) * 16 + swz / 64; C = (st & 1) * 32 + (swz % 64) / 2; }
__host__ __device__ __forceinline__ int perm32(int rho) { const int n = rho >> 4, i = rho & 15; return 8 * (i >> 2) + 4 * n + (i & 3); }

struct Unit { int pm, pn; };
struct Gemm { const bf16_t* A; const bf16_t* Bt; int M, N, K; };

struct StaticOrder {
    int nM, nN, nwg, G, c;
    __host__ __device__ void init(int M, int N, int G_, int c_) { nM = M / BM; nN = N / BM; nwg = nM * nN; G = G_; c = c_; }
    __host__ __device__ bool next(int i, Unit& u) const {
        const long L = (long)i * G + c; if (L >= nwg) return false;
        int wgid = (int)L; { const int q = nwg / NXCD, r = nwg % NXCD, xcd = wgid % NXCD, off = wgid / NXCD; wgid = (xcd < r ? xcd * (q + 1) : r * (q + 1) + (xcd - r) * q) + off; }
        const int nig = WGM * nN, gid = wgid / nig, fm = gid * WGM, gsz = (nM - fm) < WGM ? (nM - fm) : WGM;
        u.pm = fm + ((wgid % nig) % gsz); u.pn = (wgid % nig) / gsz; return true;
    }
    __device__ __forceinline__ void a_ready(const Unit&) const {}
    __device__ __forceinline__ void done(const Unit&) const {}
};

__device__ __forceinline__ unsigned cvt_pk_bf16(float lo, float hi) { unsigned r; asm volatile("v_cvt_pk_bf16_f32 %0, %1, %2" : "=v"(r) : "v"(lo), "v"(hi)); return r; }
typedef unsigned u32x2 __attribute__((ext_vector_type(2)));
__device__ __forceinline__ float gelu_fast(float x) {
    const float u2 = x * (1.5957691216057308f + 0.07135481627f * x * x);
    return x * __builtin_amdgcn_rcpf(1.f + __builtin_amdgcn_exp2f(-1.4426950408889634f * u2));
}
struct EpiG1 {
    static constexpr bool PERM = true, AFTER_DRAIN = false;
    bf16_t* base0; size_t split_stride; float qscale;
    __device__ __forceinline__ void operator()(const f32x4 (&acc)[2][2][4][2], const Unit& u, int wr, int wc, int fr, int fq) const {
        const int s = u.pn >> 1; bf16_t* base = base0 + (size_t)s * split_stride;
        const int row0 = u.pm * BM + wr * 64 + fr, col0 = (u.pn & 1) * 256 + wc * 32 + 8 * fq;
#pragma unroll
        for (int ai = 0; ai < 2; ++ai)
#pragma unroll
            for (int m = 0; m < 4; ++m) { bf16_t* rowp = base + (size_t)(row0 + ai * HALF + m * 16) * 512 + col0;
#pragma unroll
                for (int bj = 0; bj < 2; ++bj) { f32x4 v0 = acc[ai][bj][m][0], v1 = acc[ai][bj][m][1];
                    if (s == 1) {
#pragma unroll
                        for (int e = 0; e < 4; ++e) { v0[e] = gelu_fast(v0[e]); v1[e] = gelu_fast(v1[e]); } }
                    else if (s == 2) { v0 = v0 * qscale; v1 = v1 * qscale; }
                    u32x4 w; w.x = cvt_pk_bf16(v0[0], v0[1]); w.y = cvt_pk_bf16(v0[2], v0[3]); w.z = cvt_pk_bf16(v1[0], v1[1]); w.w = cvt_pk_bf16(v1[2], v1[3]);
                    *(u32x4*)(rowp + bj * HALF) = w; } }
    }
};
struct EpiG2 {
    static constexpr bool PERM = false, AFTER_DRAIN = false;
    const float* resid; float* out; bf16_t* xb; float* sumsq; int ldc;
    __device__ __forceinline__ void operator()(const f32x4 (&acc)[2][2][4][2], const Unit& u, int wr, int wc, int fr, int fq) const {
        const int row0 = u.pm * BM + wr * 64 + fr, col0 = u.pn * BM + wc * 32 + 4 * fq;
#pragma unroll
        for (int ai = 0; ai < 2; ++ai) {
            f32x4 rs[4][2][2];
#pragma unroll
            for (int m = 0; m < 4; ++m) { const size_t off = (size_t)(row0 + ai * HALF + m * 16) * ldc + col0;
#pragma unroll
                for (int bj = 0; bj < 2; ++bj)
#pragma unroll
                    for (int n = 0; n < 2; ++n) rs[m][bj][n] = *(const f32x4*)(resid + off + bj * HALF + n * 16); }
#pragma unroll
            for (int m = 0; m < 4; ++m) { const int r = row0 + ai * HALF + m * 16; const size_t off = (size_t)r * ldc + col0; float ss = 0.f;
#pragma unroll
                for (int bj = 0; bj < 2; ++bj)
#pragma unroll
                    for (int n = 0; n < 2; ++n) { const f32x4 x = rs[m][bj][n] + acc[ai][bj][m][n];
                        *(f32x4*)(out + off + bj * HALF + n * 16) = x; ss += (x[0] * x[0] + x[1] * x[1]) + (x[2] * x[2] + x[3] * x[3]);
                        u32x2 w; w.x = cvt_pk_bf16(x[0], x[1]); w.y = cvt_pk_bf16(x[2], x[3]); *(u32x2*)(xb + off + bj * HALF + n * 16) = w; }
                ss += __shfl_xor(ss, 16); ss += __shfl_xor(ss, 32);
                if (fq == 0) atomicAdd(sumsq + r, ss); }
            asm volatile("" ::: "memory"); }
    }
};
struct EpiG3 {
    static constexpr bool PERM = true, AFTER_DRAIN = false;
    bf16_t* O; int ldc;
    __device__ __forceinline__ void operator()(const f32x4 (&acc)[2][2][4][2], const Unit& u, int wr, int wc, int fr, int fq) const {
        const int row0 = u.pm * BM + wr * 64 + fr;
#pragma unroll
        for (int ai = 0; ai < 2; ++ai)
#pragma unroll
            for (int m = 0; m < 4; ++m) { const int t = row0 + ai * HALF + m * 16;
#pragma unroll
                for (int bj = 0; bj < 2; ++bj) { const f32x4 v0 = acc[ai][bj][m][0], v1 = acc[ai][bj][m][1];
                    u32x4 w; w.x = cvt_pk_bf16(v0[0], v0[1]); w.y = cvt_pk_bf16(v0[2], v0[3]); w.z = cvt_pk_bf16(v1[0], v1[1]); w.w = cvt_pk_bf16(v1[2], v1[3]);
                    *(u32x4*)(O + ((size_t)(((((t >> 5) * 8 + u.pn) * 2 + bj) * 16 + 4 * wc + fq) * 32 + (t & 31))) * 8) = w; } }
    }
};

template <class Epi, class Sched, bool ALIGN_EPI = false, bool SP2 = false>
__device__ __forceinline__ void gemm_phase(PG8_LAS unsigned char* lds, const Gemm g, const Sched& S, const Epi& E, int wid_in) {
    const int wid = __builtin_amdgcn_readfirstlane(wid_in), lane = (int)__builtin_amdgcn_mbcnt_hi(~0u, __builtin_amdgcn_mbcnt_lo(~0u, 0u)), tid = wid * 64 + lane, wr = wid >> 2, wc = wid & 3, fr = lane & 15, fq = lane >> 4;
    const int K = g.K, nt = K / BK;
    unsigned voffA[2], voffB[2];
#pragma unroll
    for (int i = 0; i < 2; ++i) { int R, C; stage_rc(tid * 16 + i * 8192, R, C); const int Rb = Epi::PERM ? ((R & ~31) + perm32(R & 31)) : R;
        voffA[i] = (unsigned)(R * K + C) * 2u; voffB[i] = (unsigned)(Rb * K + C) * 2u; }
    const size_t kstep = (size_t)(BK * 2);
    const size_t hstep = (size_t)HALF * K * 2;
    const size_t tstep = 2 * hstep;
    const unsigned ldsw = (unsigned)wid * 1024u;
    const int aoff = lds_byte(wr * 64 + fr, fq * 8), boff = lds_byte(wc * 32 + fr, fq * 8);
#define PG8_SA(b, h) (((b) * 2 + (h)) * HTB)
#define PG8_SB(b, h) ((4 + (b) * 2 + (h)) * HTB)
#define PG8_STAGE(bufoff, gbase, voff) do { _Pragma("unroll") for (int _i = 0; _i < 2; ++_i) \
        __builtin_amdgcn_global_load_lds((const unsigned*)((const char*)(gbase) + (voff)[_i]), (PG8_LAS unsigned*)(lds + (bufoff) + ldsw + _i * 8192), 16, 0, 0); } while (0)
#define PG8_LDA(dst, b, h) do { _Pragma("unroll") for (int m = 0; m < 4; ++m) _Pragma("unroll") for (int k = 0; k < 2; ++k) dst[m][k] = *(const PG8_LAS bf16x8*)(lds + PG8_SA(b, h) + aoff + m * 2048 + k * 1024); } while (0)
#define PG8_LDB(dst, b, h) do { _Pragma("unroll") for (int n = 0; n < 2; ++n) _Pragma("unroll") for (int k = 0; k < 2; ++k) dst[n][k] = *(const PG8_LAS bf16x8*)(lds + PG8_SB(b, h) + boff + n * 2048 + k * 1024); } while (0)
#define PG8_MMA(ai, bj, At, Bt) do { __builtin_amdgcn_s_setprio(1); _Pragma("unroll") for (int m = 0; m < 4; ++m) _Pragma("unroll") for (int n = 0; n < 2; ++n) _Pragma("unroll") for (int k = 0; k < 2; ++k) \
        acc[ai][bj][m][n] = __builtin_amdgcn_mfma_f32_16x16x32_bf16(Bt[n][k], At[m][k], acc[ai][bj][m][n], 0, 0, 0); __builtin_amdgcn_s_setprio(0); } while (0)
#define PG8_WAIT_V(n) asm volatile("s_waitcnt vmcnt(" #n ")" ::: "memory")
#define PG8_WAIT_L(n) asm volatile("s_waitcnt lgkmcnt(" #n ")" ::: "memory")
#define PG8_BAR __builtin_amdgcn_s_barrier()
#define PG8_SCHED __builtin_amdgcn_sched_barrier(0)
    Unit cur, nxt; int ui = 0;
    if (!S.next(0, cur)) return;
    f32x4 acc[2][2][4][2];
#pragma unroll
    for (int a = 0; a < 2; ++a)
#pragma unroll
        for (int b = 0; b < 2; ++b)
#pragma unroll
            for (int m = 0; m < 4; ++m)
#pragma unroll
                for (int n = 0; n < 2; ++n) acc[a][b][m][n] = (f32x4){0.f, 0.f, 0.f, 0.f};
    bf16x8 At[4][2], B0[2][2], B1[2][2];
    const char* cA = (const char*)g.A + (size_t)cur.pm * tstep; const char* cB = (const char*)g.Bt + (size_t)cur.pn * tstep;
    S.a_ready(cur);
    if constexpr (SP2) {
        PG8_STAGE(PG8_SB(0, 0), cB, voffB); PG8_STAGE(PG8_SB(0, 1), cB + hstep, voffB); PG8_STAGE(PG8_SA(0, 0), cA, voffA); PG8_STAGE(PG8_SA(0, 1), cA + hstep, voffA);
        if (wr == 1) PG8_BAR;
        PG8_WAIT_V(2); PG8_BAR;
        PG8_STAGE(PG8_SB(1, 0), cB + kstep, voffB); PG8_STAGE(PG8_SA(1, 0), cA + kstep, voffA); PG8_STAGE(PG8_SB(1, 1), cB + hstep + kstep, voffB);
        PG8_WAIT_V(6); PG8_BAR;
    } else {
        PG8_STAGE(PG8_SB(0, 0), cB, voffB); PG8_STAGE(PG8_SA(0, 0), cA, voffA); PG8_STAGE(PG8_SB(0, 1), cB + hstep, voffB); PG8_STAGE(PG8_SA(0, 1), cA + hstep, voffA);
        if (wr == 1) PG8_BAR;
        PG8_WAIT_V(4); PG8_BAR;
        PG8_STAGE(PG8_SB(1, 0), cB + kstep, voffB); PG8_STAGE(PG8_SA(1, 0), cA + kstep, voffA); PG8_STAGE(PG8_SB(1, 1), cB + hstep + kstep, voffB);
        PG8_WAIT_V(6); PG8_BAR;
    }
    for (;;) {
        const bool has_next = S.next(ui + 1, nxt);
        const char* nA = has_next ? (const char*)g.A + (size_t)nxt.pm * tstep : cA; const char* nB = has_next ? (const char*)g.Bt + (size_t)nxt.pn * tstep : cB;
        for (int t = 0; t < nt; t += 2) {
            const bool last = (t == nt - 2);
            const char* a1 = cA + (size_t)(t + 1) * kstep;
            const char* a2 = last ? nA : cA + (size_t)(t + 2) * kstep; const char* b2 = last ? nB : cB + (size_t)(t + 2) * kstep;
            const char* a3 = a2 + kstep; const char* b3 = b2 + kstep;
            if (last && has_next) S.a_ready(nxt);
            if constexpr (SP2) {
            PG8_LDB(B0, 0, 0); PG8_LDB(B1, 0, 1); PG8_SCHED; PG8_LDA(At, 0, 0); PG8_STAGE(PG8_SA(1, 1), a1 + hstep, voffA);
            PG8_WAIT_V(8); PG8_WAIT_L(0); PG8_BAR; PG8_MMA(0, 0, At, B0); PG8_MMA(0, 1, At, B1); PG8_BAR; PG8_SCHED;
            PG8_LDA(At, 0, 1); PG8_STAGE(PG8_SB(0, 0), b2, voffB); PG8_STAGE(PG8_SB(0, 1), b2 + hstep, voffB); PG8_STAGE(PG8_SA(0, 0), a2, voffA);
            PG8_WAIT_V(8); PG8_WAIT_L(0); PG8_BAR; PG8_MMA(1, 0, At, B0); PG8_MMA(1, 1, At, B1); PG8_BAR; PG8_SCHED;
            PG8_LDB(B0, 1, 0); PG8_LDB(B1, 1, 1); PG8_SCHED; PG8_LDA(At, 1, 0); PG8_STAGE(PG8_SA(0, 1), a2 + hstep, voffA);
            PG8_WAIT_V(8); PG8_WAIT_L(0); PG8_BAR; PG8_MMA(0, 0, At, B0); PG8_MMA(0, 1, At, B1); PG8_BAR; PG8_SCHED;
            PG8_LDA(At, 1, 1); PG8_STAGE(PG8_SB(1, 0), b3, voffB); PG8_STAGE(PG8_SB(1, 1), b3 + hstep, voffB); PG8_STAGE(PG8_SA(1, 0), a3, voffA);
            PG8_WAIT_V(8); PG8_WAIT_L(0); PG8_BAR; PG8_MMA(1, 0, At, B0); PG8_MMA(1, 1, At, B1); PG8_BAR; PG8_SCHED;
            } else {
            PG8_LDB(B0, 0, 0); PG8_SCHED; PG8_LDA(At, 0, 0); PG8_STAGE(PG8_SA(1, 1), a1 + hstep, voffA);
            PG8_WAIT_L(8); PG8_BAR; PG8_WAIT_L(0); PG8_MMA(0, 0, At, B0); PG8_BAR; PG8_SCHED;
            PG8_LDB(B1, 0, 1); PG8_STAGE(PG8_SB(0, 0), b2, voffB);
            PG8_BAR; PG8_WAIT_L(0); PG8_MMA(0, 1, At, B1); PG8_BAR;
            PG8_LDA(At, 0, 1); PG8_STAGE(PG8_SA(0, 0), a2, voffA);
            PG8_BAR; PG8_WAIT_L(0); PG8_MMA(1, 0, At, B0); PG8_BAR; PG8_SCHED;
            PG8_STAGE(PG8_SB(0, 1), b2 + hstep, voffB);
            PG8_WAIT_V(6); PG8_BAR; PG8_MMA(1, 1, At, B1); PG8_BAR;
            PG8_LDB(B0, 1, 0); PG8_SCHED; PG8_LDA(At, 1, 0); PG8_STAGE(PG8_SA(0, 1), a2 + hstep, voffA);
            PG8_WAIT_L(8); PG8_BAR; PG8_WAIT_L(0); PG8_MMA(0, 0, At, B0); PG8_BAR; PG8_SCHED;
            PG8_LDB(B1, 1, 1); PG8_STAGE(PG8_SB(1, 0), b3, voffB);
            PG8_BAR; PG8_WAIT_L(0); PG8_MMA(0, 1, At, B1); PG8_BAR;
            PG8_LDA(At, 1, 1); PG8_STAGE(PG8_SA(1, 0), a3, voffA);
            PG8_BAR; PG8_WAIT_L(0); PG8_MMA(1, 0, At, B0); PG8_BAR; PG8_SCHED;
            PG8_STAGE(PG8_SB(1, 1), b3 + hstep, voffB);
            PG8_WAIT_V(6); PG8_BAR; PG8_MMA(1, 1, At, B1); PG8_BAR;
            }
        }
        if constexpr (ALIGN_EPI) { if (wr == 0) PG8_BAR; }
        if constexpr (!Epi::AFTER_DRAIN) { E(acc, cur, wr, wc, fr, fq); S.done(cur); }
        if (!has_next) break;
#pragma unroll
        for (int a = 0; a < 2; ++a)
#pragma unroll
            for (int b = 0; b < 2; ++b)
#pragma unroll
                for (int m = 0; m < 4; ++m)
#pragma unroll
                    for (int n = 0; n < 2; ++n) acc[a][b][m][n] = (f32x4){0.f, 0.f, 0.f, 0.f};
        cur = nxt; cA = nA; cB = nB; ++ui;
        if constexpr (ALIGN_EPI) { if (wr == 1) PG8_BAR; }
    }
    PG8_WAIT_V(0);
    if constexpr (!ALIGN_EPI) { if (wr == 0) PG8_BAR; }
    PG8_BAR;
    if constexpr (Epi::AFTER_DRAIN) { E.fused(acc, cur, wr, wc, fr, fq, lds, wid, lane); S.done(cur); }
#undef PG8_SA
#undef PG8_SB
#undef PG8_STAGE
#undef PG8_LDA
#undef PG8_LDB
#undef PG8_MMA
#undef PG8_WAIT_V
#undef PG8_WAIT_L
#undef PG8_BAR
#undef PG8_SCHED
}
}
#include <hip/hip_bf16.h>
#include <cmath>
namespace attn_body {
using bf16=__hip_bfloat16;
using bf16x8=__attribute__((ext_vector_type(8)))short;
using s16x4=__attribute__((ext_vector_type(4)))short;
using f32x16=__attribute__((ext_vector_type(16)))float;
using u32x4=__attribute__((ext_vector_type(4)))unsigned;
constexpr int BATCH=4,NHEAD=8,SEQ=8192,D=64,DM=NHEAD*D;
constexpr int NW=8,QBLK=32,QB=QBLK*NW,KVBLK=64,NQB=SEQ/QB;
constexpr int ATTN_PITCH=DM, ATTN_UNIT_ROWS=QB;
__device__ __forceinline__ int crow(int r,int hi){return (r&3)+8*(r>>2)+4*hi;}
#define SBAR() __builtin_amdgcn_sched_barrier(0)
__device__ __forceinline__ void cmask(f32x16&p0,f32x16&p1,int jb,int qrel,int hi){
  const float NEG=-INFINITY; int kb=64*jb+4*hi;
  #pragma unroll
  for(int r=0;r<16;++r){int kv=kb+(r&3)+8*(r>>2); if(kv>qrel)p0[r]=NEG; if(kv+32>qrel)p1[r]=NEG;}
}

constexpr int NSLOT=3, SLOTB=8192;
constexpr int LDS_K=0, LDS_V=NSLOT*SLOTB, LDS_WS=2*NSLOT*SLOTB, LDS_OST=LDS_WS+NW*64*4, LDS_FK=LDS_OST+NW*4096, LDS_BYTES=LDS_FK+SEQ*4;
constexpr float C2=0.125f*1.4426950408889634f;
__device__ __forceinline__ void glds16(const void*gsrc,unsigned lds_dst){unsigned keep;
  asm volatile("s_mov_b32 %0, m0\n\ts_mov_b32 m0, %2\n\ts_nop 0\n\tglobal_load_lds_dwordx4 %1, off\n\ts_mov_b32 m0, %0":"=&s"(keep):"v"(gsrc),"s"(lds_dst):"memory");}
__device__ __forceinline__ float max3f(float a,float b,float c){float r;asm("v_max3_f32 %0, %1, %2, %3":"=v"(r):"v"(a),"v"(b),"v"(c));return r;}
__device__ __forceinline__ float max2f(float a,float b){float r;asm("v_max_f32_e32 %0, %1, %2":"=v"(r):"v"(a),"v"(b));return r;}
__device__ __forceinline__ float fadd_s(float a,float b){float r;asm("v_add_f32_e32 %0, %1, %2":"=v"(r):"v"(a),"v"(b));return r;}
__device__ __forceinline__ float fsub_s(float a,float b){float r;asm("v_sub_f32_e32 %0, %1, %2":"=v"(r):"v"(a),"v"(b));return r;}
typedef float f32x2_t __attribute__((ext_vector_type(2))); typedef __bf16 bf16x2_t __attribute__((ext_vector_type(2)));
__device__ __forceinline__ unsigned cvtpk_s(float lo,float hi){f32x2_t v={lo,hi};bf16x2_t b=__builtin_convertvector(v,bf16x2_t);return __builtin_bit_cast(unsigned,b);}
#define WAIT_BAR(N) asm volatile("s_waitcnt vmcnt(" #N ") lgkmcnt(0)\n\ts_barrier":::"memory")

__device__ __forceinline__ void qkt(f32x16&p0,f32x16&p1,const char*Kslot,const bf16x8*qr,int r32,int hi){
  const char*kb=Kslot+hi*1024+r32*16;
  #pragma unroll
  for(int d0=0;d0<4;++d0){
    const bf16x8 b0=*reinterpret_cast<const bf16x8*>(kb+d0*2048);
    const bf16x8 b1=*reinterpret_cast<const bf16x8*>(kb+d0*2048+512);
    p0=__builtin_amdgcn_mfma_f32_32x32x16_bf16(b0,qr[d0],p0,0,0,0);p1=__builtin_amdgcn_mfma_f32_32x32x16_bf16(b1,qr[d0],p1,0,0,0);}
}
typedef __attribute__((address_space(3))) const char* lds_cptr;
typedef short v4i16_t __attribute__((ext_vector_type(4)));
__device__ __forceinline__ void kload8(bf16x8*kf,lds_cptr kp){
  kf[0]=*(const __attribute__((address_space(3))) bf16x8*)(kp);      kf[1]=*(const __attribute__((address_space(3))) bf16x8*)(kp+512);
  kf[2]=*(const __attribute__((address_space(3))) bf16x8*)(kp+2048); kf[3]=*(const __attribute__((address_space(3))) bf16x8*)(kp+2560);
  kf[4]=*(const __attribute__((address_space(3))) bf16x8*)(kp+4096); kf[5]=*(const __attribute__((address_space(3))) bf16x8*)(kp+4608);
  kf[6]=*(const __attribute__((address_space(3))) bf16x8*)(kp+6144); kf[7]=*(const __attribute__((address_space(3))) bf16x8*)(kp+6656);
}
__device__ __forceinline__ void kload2(bf16x8*kf,lds_cptr kp,int j){ kf[2*j]=*(const __attribute__((address_space(3))) bf16x8*)(kp+j*2048); kf[2*j+1]=*(const __attribute__((address_space(3))) bf16x8*)(kp+j*2048+512); }
__device__ __forceinline__ s16x4 vtr(lds_cptr p){ return __builtin_bit_cast(s16x4,__builtin_amdgcn_ds_read_tr16_b64_v4i16((__attribute__((address_space(3))) v4i16_t*)p)); }
__device__ __forceinline__ float rowmax(const f32x16&p0,const f32x16&p1){
  float a=max3f(p0[0],p0[1],p1[0]),b=max3f(p0[2],p0[3],p1[1]);a=max3f(a,p1[2],p1[3]);
  #pragma unroll
  for(int r=4;r<16;r+=4){a=max3f(a,p0[r],p0[r+1]);b=max3f(b,p0[r+2],p0[r+3]);a=max3f(a,p1[r],p1[r+1]);b=max3f(b,p1[r+2],p1[r+3]);}
  const float m=max2f(a,b);
  auto rr=__builtin_amdgcn_permlane32_swap(__float_as_uint(m),__float_as_uint(m),false,false);
  return max2f(__uint_as_float(rr[0]),__uint_as_float(rr[1]));
}
__device__ __forceinline__ void pv(f32x16*o,int vb,bf16x8 pa0,bf16x8 pa1,bf16x8 pa2,bf16x8 pa3){
  #pragma unroll
  for(int d0=0;d0<2;++d0){s16x4 lo[4],hi[4];
    #pragma unroll
    for(int ks=0;ks<4;++ks){
      asm volatile("ds_read_b64_tr_b16 %0,%1 offset:%c2":"=&v"(lo[ks]):"v"(vb),"i"(d0*4096+ks*1024):"memory");
      asm volatile("ds_read_b64_tr_b16 %0,%1 offset:%c2":"=&v"(hi[ks]):"v"(vb),"i"(d0*4096+ks*1024+512):"memory");}
    asm volatile("s_waitcnt lgkmcnt(0)":::"memory");SBAR();
    #define PK(k) (bf16x8){lo[k][0],lo[k][1],lo[k][2],lo[k][3],hi[k][0],hi[k][1],hi[k][2],hi[k][3]}
    o[d0]=__builtin_amdgcn_mfma_f32_32x32x16_bf16(pa0,PK(0),o[d0],0,0,0);
    o[d0]=__builtin_amdgcn_mfma_f32_32x32x16_bf16(pa1,PK(1),o[d0],0,0,0);
    o[d0]=__builtin_amdgcn_mfma_f32_32x32x16_bf16(pa2,PK(2),o[d0],0,0,0);
    o[d0]=__builtin_amdgcn_mfma_f32_32x32x16_bf16(pa3,PK(3),o[d0],0,0,0);
    #undef PK
  }
}

#ifndef ATTN_STORE16
#define ATTN_STORE16(p,v) (*(u32x4*)(p)=(v))
#endif
template<int THRL> __device__ __forceinline__ void attn_unit(int b,int h,int qb,const bf16*Q,const bf16*__restrict__ K,const bf16*__restrict__ V,bf16*O,const float*__restrict__ Fc,const float*__restrict__ NRM,char*shm,int wid_in){
  const int wid=__builtin_amdgcn_readfirstlane(wid_in); int lane_=(int)__builtin_amdgcn_mbcnt_hi(~0u,__builtin_amdgcn_mbcnt_lo(~0u,0u)); asm volatile("":"+v"(lane_));
  const int lane=lane_,tid=wid*64+lane,r32=lane&31,hi=lane>>5;
  const long rowbase=(long)b*SEQ; const int q0=qb*QB;
  const float*Fbh=Fc+(long)(b*NHEAD+h)*SEQ;
  const int NTF=(q0+QB)/KVBLK; int t_start;
  { const float*QNb=NRM+(b*NHEAD+h)*128,*KNb=NRM+4096+(b*NHEAD+h)*128;
    const float qn=fmaxf(fmaxf(QNb[4*qb],QNb[4*qb+1]),fmaxf(QNb[4*qb+2],QNb[4*qb+3])),knb=fmaxf(fmaxf(KNb[4*qb],KNb[4*qb+1]),fmaxf(KNb[4*qb+2],KNb[4*qb+3]));
    const float fq0=Fbh[q0]*1.4426950408889634f; bool k0=true,k1=true;
    if(lane<NTF-4)k0=!(qn*(KNb[lane]+knb)+(fq0-Fbh[64*lane+63]*1.4426950408889634f)<-40.f);
    if(lane+64<NTF-4)k1=!(qn*(KNb[lane+64]+knb)+(fq0-Fbh[64*(lane+64)+63]*1.4426950408889634f)<-40.f);
    const unsigned long long m0=__ballot(k0),m1=__ballot(k1);
    int tf=m0?(int)__builtin_ctzll(m0):64+(m1?(int)__builtin_ctzll(m1):64);
    tf=tf<NTF-4?tf:NTF-4; t_start=__builtin_amdgcn_readfirstlane(tf&~1); }
  { typedef float f32x4_t __attribute__((ext_vector_type(4))); __attribute__((address_space(3))) float*fk=(__attribute__((address_space(3))) float*)((__attribute__((address_space(3))) char*)shm+LDS_FK); const int n4=(q0+QB)/4;
    for(int i=16*t_start+tid;i<n4;i+=NW*64){ f32x4_t v=*(const f32x4_t*)(Fbh+4*i); v=v*(-1.4426950408889634f); *(__attribute__((address_space(3))) f32x4_t*)(fk+4*i)=v; } }
  float fq2=Fbh[q0+wid*QBLK+r32]*1.4426950408889634f; asm volatile("":"+v"(fq2));
  const bf16*Qw=Q+(rowbase+q0+wid*QBLK)*DM+h*D;
  const bf16*Kh=K+(rowbase+(long)t_start*KVBLK)*DM+h*D,*Vh=V+(rowbase+(long)t_start*KVBLK)*DM+h*D;
  const lds_cptr shm3=(lds_cptr)shm;
  const unsigned lds0=(unsigned)(uintptr_t)shm;
  float*wsf=(float*)(shm+LDS_WS)+wid*64;
  const bf16*ksrc=Kh+(long)lane*DM+wid*8;
  const bf16*vsrc=Vh+(long)(16*(wid&3)+(lane>>2))*DM+(wid>>2)*32+(lane&3)*8;
  const unsigned kdst=lds0+LDS_K+wid*1024, vdst=lds0+LDS_V+wid*1024;
  #define DMA_K(t,slot) glds16(ksrc+(long)(t)*KVBLK*DM,(unsigned)__builtin_amdgcn_readfirstlane(kdst+(slot)))
  #define DMA_V(t,slot) glds16(vsrc+(long)(t)*KVBLK*DM,(unsigned)__builtin_amdgcn_readfirstlane(vdst+(slot)))
  const int vb0=(int)(lds0+LDS_V)+((lane>>4)&1)*32+(lane&3)*8+(4*hi+((lane&15)>>2))*64;
  const char*Kbase=shm+LDS_K; bf16x8 kf[8];
  const lds_cptr kp0=shm3+LDS_K+hi*1024+r32*16; const lds_cptr vp0=shm3+LDS_V+((lane>>4)&1)*32+(lane&3)*8+(4*hi+((lane&15)>>2))*64;
  const int NT=NTF-t_start;
  DMA_K(0,0);DMA_V(0,0);DMA_K(1,SLOTB);
  bf16x8 qr[4];
  #pragma unroll
  for(int d0=0;d0<4;++d0)qr[d0]=*reinterpret_cast<const bf16x8*>(&Qw[(long)r32*DM+d0*16+hi*8]);
  float mhat=0.f,l_reg=0.f;f32x16 o[2];o[0]=f32x16{};o[1]=f32x16{};
  const __attribute__((address_space(3))) float*fkl=(const __attribute__((address_space(3))) float*)(shm3+LDS_FK)+64*t_start+4*hi;
  #define INITC(C0,C1,t) do{ const float nsc_=fq2-mhat; typedef float f32x4_t __attribute__((ext_vector_type(4))); const __attribute__((address_space(3))) float*kb_=fkl+64*(t); \
    _Pragma("unroll") for(int g_=0;g_<4;++g_){ const f32x4_t a_=*(const __attribute__((address_space(3))) f32x4_t*)(kb_+8*g_), b_=*(const __attribute__((address_space(3))) f32x4_t*)(kb_+32+8*g_); \
      _Pragma("unroll") for(int e_=0;e_<4;++e_){ C0[4*g_+e_]=nsc_+a_[e_]; C1[4*g_+e_]=nsc_+b_[e_]; } } }while(0)
  const int qrel=wid*QBLK+r32;
  #define CMASK(P0,P1,t) do{int jb_=(t)-(NT-4); if(jb_>=0)cmask(P0,P1,jb_,qrel,hi);}while(0)
  bool resc=false;
  #define START(P0,P1) do{ const float rm=rowmax(P0,P1); resc=false; \
    { const float dl=rm; mhat=fadd_s(mhat,dl); \
      _Pragma("unroll") for(int r=0;r<16;++r){P0[r]=fsub_s(P0[r],dl);P1[r]=fsub_s(P1[r],dl);} \
      } \
    _Pragma("unroll") for(int r=0;r<16;++r)P0[r]=__builtin_amdgcn_exp2f(P0[r]); }while(0)
  #define RESC() do{ if(resc){ asm volatile("s_waitcnt lgkmcnt(0)":::"memory"); \
      _Pragma("unroll") for(int d_=0;d_<2;++d_) _Pragma("unroll") for(int r=0;r<16;++r)o[d_][r]*=wsf[crow(r,hi)]; } }while(0)
  f32x16 pA0,pA1,pB0,pB1;
  int sl_prev=0,sl_cur=0,sl_next=SLOTB;
  #define ROT() do{sl_prev=sl_cur;sl_cur=sl_next;sl_next=(sl_next==(NSLOT-1)*SLOTB)?0:sl_next+SLOTB;}while(0)
  DMA_K(2,2*SLOTB);
  WAIT_BAR(3);
  INITC(pA0,pA1,0); qkt(pA0,pA1,Kbase,qr,r32,hi);asm volatile("s_nop 15\n\ts_nop 7":"+v"(pA0),"+v"(pA1));CMASK(pA0,pA1,0);
  START(pA0,pA1);
  _Pragma("unroll") for(int r=0;r<16;++r)pA1[r]=__builtin_amdgcn_exp2f(pA1[r]);
  WAIT_BAR(0);
  DMA_K(3,0);DMA_V(1,SLOTB);
  ROT();
  kload8(kf,kp0+sl_cur);
  WAIT_BAR(2);
  s16x4 vlo[8],vhi[8]; u32x4 pw0,pw1,pw2,pw3;
  #define PKW(P,B) cvtpk_s(P[B],P[B+1])
  #define PAF(k) __builtin_bit_cast(bf16x8,pw##k)
  #define VFR(i) (bf16x8){vlo[i][0],vlo[i][1],vlo[i][2],vlo[i][3],vhi[i][0],vhi[i][1],vhi[i][2],vhi[i][3]}
  #define PIN(x) asm volatile("":"+v"(x))
  #define MX3(a,b,c) __builtin_fmaxf(__builtin_fmaxf((a),(b)),(c))
  #define GAPA(MF,A0,A1,A2,A3,W0,W1,PW) do{ MF; sacc+=A0; sacc+=A1; sacc+=A2; sacc+=A3; PIN(sacc); W0; W1; PIN(PW); SBAR(); }while(0)
  #define EX(v) __builtin_amdgcn_exp2f(v)
  #define GAPB(MF,X,B) do{ MF; X[B]=EX(X[B]); X[B+1]=EX(X[B+1]); X[B+2]=EX(X[B+2]); X[B+3]=EX(X[B+3]); PIN(X); SBAR(); }while(0)
  #define VRD(i) do{ vlo[i]=vtr(vp_+(((i)>>2)*4096+((i)&3)*1024)); vhi[i]=vtr(vp_+(((i)>>2)*4096+((i)&3)*1024+512)); }while(0)
  #define KRD(G,j) do{ if(G){ kload2(kf,kp0+sl_next,j); SBAR(); } }while(0)
  #define STEP(C0,C1,P0,P1,t,GK,GV,GL) do{ SBAR(); INITC(C0,C1,t); PIN(C0); PIN(C1); SBAR(); \
    const lds_cptr vp_=vp0+sl_prev; \
    VRD(0); SBAR(); float sacc=(P0[0]+P0[1]); \
    GAPA(C0=__builtin_amdgcn_mfma_f32_32x32x16_bf16(kf[0],qr[0],C0,0,0,0), P0[2],P0[3],P0[4],P0[5],     pw0[0]=PKW(P0,0), pw0[1]=PKW(P0,2), pw0); \
    VRD(4); SBAR(); GAPA(C1=__builtin_amdgcn_mfma_f32_32x32x16_bf16(kf[1],qr[0],C1,0,0,0), P0[6],P0[7],P0[8],P0[9],     pw0[2]=PKW(P0,4), pw0[3]=PKW(P0,6), pw0); \
    VRD(1); SBAR(); GAPA(C0=__builtin_amdgcn_mfma_f32_32x32x16_bf16(kf[2],qr[1],C0,0,0,0),   P0[10],P0[11],P0[12],P0[13], pw1[0]=PKW(P0,8), pw1[1]=PKW(P0,10), pw1); \
    VRD(5); SBAR(); GAPA(C1=__builtin_amdgcn_mfma_f32_32x32x16_bf16(kf[3],qr[1],C1,0,0,0),   P0[14],P0[15],P1[0],P1[1],   pw1[2]=PKW(P0,12),pw1[3]=PKW(P0,14), pw1); \
    VRD(2); SBAR(); GAPA(C0=__builtin_amdgcn_mfma_f32_32x32x16_bf16(kf[4],qr[2],C0,0,0,0),   P1[2],P1[3],P1[4],P1[5],     pw2[0]=PKW(P1,0), pw2[1]=PKW(P1,2), pw2); \
    VRD(6); SBAR(); GAPA(C1=__builtin_amdgcn_mfma_f32_32x32x16_bf16(kf[5],qr[2],C1,0,0,0),   P1[6],P1[7],P1[8],P1[9],     pw2[2]=PKW(P1,4), pw2[3]=PKW(P1,6), pw2); \
    VRD(3); SBAR(); GAPA(C0=__builtin_amdgcn_mfma_f32_32x32x16_bf16(kf[6],qr[3],C0,0,0,0),   P1[10],P1[11],P1[12],P1[13], pw3[0]=PKW(P1,8), pw3[1]=PKW(P1,10), pw3); \
    VRD(7); SBAR(); GAPA(C1=__builtin_amdgcn_mfma_f32_32x32x16_bf16(kf[7],qr[3],C1,0,0,0),   P1[14],P1[15],0.f,0.f,       pw3[2]=PKW(P1,12),pw3[3]=PKW(P1,14), pw3); \
    l_reg+=sacc; \
    if(GK){DMA_K((t)+3,sl_cur);} if(GV){DMA_V((t)+1,sl_next);} \
    CMASK(C0,C1,t); \
    { float a=MX3(C0[0],C0[1],C1[0]),b=MX3(C0[2],C0[3],C1[1]); a=MX3(a,C1[2],C1[3]); \
      _Pragma("unroll") for(int r=4;r<16;r+=4){a=MX3(a,C0[r],C0[r+1]);b=MX3(b,C0[r+2],C0[r+3]);a=MX3(a,C1[r],C1[r+1]);b=MX3(b,C1[r+2],C1[r+3]);} \
      float rm=__builtin_fmaxf(a,b); { auto rr=__builtin_amdgcn_permlane32_swap(__float_as_uint(rm),__float_as_uint(rm),false,false); rm=__builtin_fmaxf(__uint_as_float(rr[0]),__uint_as_float(rr[1])); } \
      resc=false; \
      if(__builtin_expect(__any(rm>(float)THRL),0)){ const float dl=__builtin_fmaxf(rm,0.f); mhat+=dl; \
        _Pragma("unroll") for(int r=0;r<16;++r){C0[r]-=dl;C1[r]-=dl;} \
        const float f=__builtin_amdgcn_exp2f(-dl); l_reg*=f; if(hi==0)wsf[r32]=f; resc=true; } } \
    SBAR(); \
    GAPB(o[0]=__builtin_amdgcn_mfma_f32_32x32x16_bf16(PAF(0),VFR(0),o[0],0,0,0), C0,0); \
    GAPB(o[1]=__builtin_amdgcn_mfma_f32_32x32x16_bf16(PAF(0),VFR(4),o[1],0,0,0), C0,4); \
    KRD(GL,0); GAPB(o[0]=__builtin_amdgcn_mfma_f32_32x32x16_bf16(PAF(1),VFR(1),o[0],0,0,0), C0,8); \
    KRD(GL,1); GAPB(o[1]=__builtin_amdgcn_mfma_f32_32x32x16_bf16(PAF(1),VFR(5),o[1],0,0,0), C0,12); \
    KRD(GL,2); GAPB(o[0]=__builtin_amdgcn_mfma_f32_32x32x16_bf16(PAF(2),VFR(2),o[0],0,0,0), C1,0); \
    KRD(GL,3); GAPB(o[1]=__builtin_amdgcn_mfma_f32_32x32x16_bf16(PAF(2),VFR(6),o[1],0,0,0), C1,4); \
    GAPB(o[0]=__builtin_amdgcn_mfma_f32_32x32x16_bf16(PAF(3),VFR(3),o[0],0,0,0), C1,8); \
    GAPB(o[1]=__builtin_amdgcn_mfma_f32_32x32x16_bf16(PAF(3),VFR(7),o[1],0,0,0), C1,12); \
    }while(0)
  int t=1;
  #undef CMASK
  #define CMASK(P0,P1,t) do{}while(0)
  for(;t+5<NT;t+=2){
    STEP(pB0,pB1,pA0,pA1,t,true,true,true);     WAIT_BAR(2); RESC(); ROT();
    STEP(pA0,pA1,pB0,pB1,t+1,true,true,true);   WAIT_BAR(2); RESC(); ROT();
  }
  #undef CMASK
  #define CMASK(P0,P1,t) do{int jb_=(t)-(NT-4); if(jb_>=0)cmask(P0,P1,jb_,qrel,hi);}while(0)
  #define ENDW(tt) do{ if((tt)+3<NT){WAIT_BAR(2);} else if((tt)+2<NT){WAIT_BAR(1);} else {WAIT_BAR(0);} }while(0)
  for(;t+1<NT;t+=2){
    STEP(pB0,pB1,pA0,pA1,t,(t+3<NT),(t+1<NT),(t+1<NT));       ENDW(t);   RESC(); ROT();
    STEP(pA0,pA1,pB0,pB1,t+1,(t+4<NT),(t+2<NT),(t+2<NT));     ENDW(t+1); RESC(); ROT();
  }
  STEP(pB0,pB1,pA0,pA1,NT-1,false,false,false); RESC();
  { float sacc=pB0[0]+pB0[1]; _Pragma("unroll") for(int r=2;r<16;++r)sacc+=pB0[r]; _Pragma("unroll") for(int r=0;r<16;++r)sacc+=pB1[r]; l_reg+=sacc;
    pw0=(u32x4){PKW(pB0,0),PKW(pB0,2),PKW(pB0,4),PKW(pB0,6)};pw1=(u32x4){PKW(pB0,8),PKW(pB0,10),PKW(pB0,12),PKW(pB0,14)};pw2=(u32x4){PKW(pB1,0),PKW(pB1,2),PKW(pB1,4),PKW(pB1,6)};pw3=(u32x4){PKW(pB1,8),PKW(pB1,10),PKW(pB1,12),PKW(pB1,14)};
    SBAR(); pv(o,vb0+sl_cur,PAF(0),PAF(1),PAF(2),PAF(3)); }
  #undef PKW
  #undef PAF
  #undef VFR
  #undef PIN
  #undef MX3
  #undef GAPA
  #undef GAPB
  #undef EX
  #undef VRD
  #undef KRD
  #undef STEP
  #undef ENDW
  {auto rr=__builtin_amdgcn_permlane32_swap(__float_as_uint(l_reg),__float_as_uint(l_reg),false,false);l_reg=__uint_as_float(rr[0])+__uint_as_float(rr[1]);}
  if(hi==0)wsf[32+r32]=l_reg;asm volatile("s_waitcnt lgkmcnt(0)":::"memory");
  float rli[16];
  #pragma unroll
  for(int r=0;r<16;++r)rli[r]=__builtin_amdgcn_rcpf(wsf[32+crow(r,hi)]);
  bf16*Ow=O+(rowbase+q0+wid*QBLK)*DM+h*D;
  { bf16*stg=(bf16*)(shm+LDS_OST)+wid*2048;
    #pragma unroll
    for(int r=0;r<16;++r){const int orow=crow(r,hi);
      #pragma unroll
      for(int d0=0;d0<2;++d0)stg[orow*64+d0*32+r32]=__float2bfloat16(o[d0][r]*rli[r]);}
    asm volatile("s_waitcnt lgkmcnt(0)":::"memory");
    #pragma unroll
    for(int i=0;i<4;++i){const int row=i*8+(lane>>3),ch=lane&7; const u32x4 v=*(const u32x4*)(stg+row*64+ch*8); ATTN_STORE16(Ow+(long)row*DM+ch*8,v);} }
  asm volatile("s_waitcnt lgkmcnt(0)\n\ts_barrier":::"memory");
  #undef DMA_K
  #undef DMA_V
  #undef INITC
  #undef CMASK
  #undef START
  #undef RESC
  #undef ROT
}
constexpr int ATTN_LDS_BYTES=LDS_BYTES;
struct AttnTensors { const bf16* Q; const bf16* K; const bf16* V; bf16* O; const float* F; const float* NRM; };
struct AttnUnit { int bh; int qb; };
struct StaticOrder {
  int vcu;
  __device__ __forceinline__ explicit StaticOrder(int grid,int block):vcu((block%8)*(grid/8)+block/8){}
  __device__ __forceinline__ bool next(int i,AttnUnit&u)const{ if(i>=4)return false; const int s=vcu&7; u.bh=vcu>>3; u.qb=(i==0)?s:(i==1)?15-s:(i==2)?16+s:31-s; return true; }
  __device__ __forceinline__ void a_ready(const AttnUnit&)const{}
  __device__ __forceinline__ void done(const AttnUnit&)const{}
};
template<int THRL=8> __device__ __forceinline__ void attn_phase(char*lds,const AttnTensors&T,unsigned*qctr,volatile __attribute__((address_space(3))) unsigned*qword,int wid_in){
  const int lane0=(int)__builtin_amdgcn_mbcnt_hi(~0u,__builtin_amdgcn_mbcnt_lo(~0u,0u));
  for(;;){
    if(wid_in==0&&lane0==0){ const unsigned n=__hip_atomic_fetch_add(qctr,1u,__ATOMIC_RELAXED,__HIP_MEMORY_SCOPE_AGENT); *qword=n; }
    asm volatile("s_waitcnt vmcnt(0) lgkmcnt(0)\n\ts_barrier":::"memory");
    const int n=__builtin_amdgcn_readfirstlane((int)*qword);
    if(n>=BATCH*NHEAD*NQB)break;
    const int bh=n%(BATCH*NHEAD),qb=NQB-1-n/(BATCH*NHEAD);
    attn_unit<THRL>(bh/NHEAD,bh%NHEAD,qb,T.Q,T.K,T.V,T.O,T.F,T.NRM,lds,wid_in);
  }
}
#undef SBAR
#undef WAIT_BAR
}
#define GAS __attribute__((address_space(1)))
#define LAS __attribute__((address_space(3)))
typedef unsigned short bf16;
typedef unsigned v4u __attribute__((ext_vector_type(4)));
typedef float f32x4 __attribute__((ext_vector_type(4)));
typedef short bf16x8 __attribute__((ext_vector_type(8)));
typedef GAS unsigned gu32;
typedef GAS unsigned long long gu64;
#define RLX_AGENT __ATOMIC_RELAXED, __HIP_MEMORY_SCOPE_AGENT
#define LDS_WAIT() asm volatile("s_waitcnt lgkmcnt(0)" ::: "memory")
#define VM_WAIT() asm volatile("s_waitcnt vmcnt(0)" ::: "memory")
__device__ __forceinline__ unsigned long long rt() { return __builtin_amdgcn_s_memrealtime(); }
__device__ __forceinline__ unsigned f2bf(float f) { unsigned u = __builtin_bit_cast(unsigned, f); return (u + 0x7fffu + ((u >> 16) & 1u)) >> 16; }
__device__ __forceinline__ unsigned pk2(float lo, float hi) { return f2bf(lo) | (f2bf(hi) << 16); }

#define XB_TMO      128
#define XB_XCNT(j)  (256  + 64 * (j))
#define XB_XSUB(j)  (1280 + 64 * (j))
#define XB_XGEN(j)  (2304 + 64 * (j))
#define XB_TOP      3328
#define XB_TOPGEN   3392
#define XCD_BAR_WORDS 3456
#define XB_SPIN_CAP (1u << 18)

__device__ __forceinline__ unsigned xb_ld(unsigned* p)              { return __hip_atomic_load(p, __ATOMIC_RELAXED, __HIP_MEMORY_SCOPE_AGENT); }
__device__ __forceinline__ unsigned xb_add(unsigned* p, unsigned v) { return __hip_atomic_fetch_add(p, v, __ATOMIC_RELAXED, __HIP_MEMORY_SCOPE_AGENT); }
__device__ __forceinline__ unsigned xb_xcc_id() { return (unsigned)__builtin_amdgcn_s_getreg((3 << 11) | 20) & 0xFu; }
#define XB_SPIN(cond, bar) do { unsigned _sp = 0; while (cond) { __builtin_amdgcn_s_sleep(1); \
    if ((++_sp & 255u) == 0u) { if (xb_ld(&(bar)[XB_TMO])) break; if (_sp > XB_SPIN_CAP) { atomicAdd(&(bar)[XB_TMO], 1u); break; } } } } while (0)

struct XcdBarrier {
    unsigned* bar; unsigned x; int wv;
    volatile LAS unsigned* st;
};

__device__ __forceinline__ bool xb_t0(int wv) { return wv == 0 && __builtin_amdgcn_mbcnt_hi(~0u, __builtin_amdgcn_mbcnt_lo(~0u, 0u)) == 0u; }
__device__ __forceinline__ XcdBarrier xcd_barrier_post(unsigned* bar, volatile LAS unsigned* st, int wv) {
    XcdBarrier b; b.bar = bar; b.x = xb_xcc_id(); b.st = st; b.wv = wv;
    if (xb_t0(wv)) (void)xb_add(&bar[XB_XCNT(b.x)], 1u);
    return b;
}
__device__ __forceinline__ void xcd_barrier_complete(unsigned* bar, unsigned x, unsigned& nloc, unsigned& nx) {
    const unsigned G = gridDim.x * gridDim.y * gridDim.z;
    unsigned sum, cnt, mine, sp = 0u;
    for (;;) {
        sum = 0u; cnt = 0u; mine = 0u;
#pragma unroll
        for (unsigned j = 0; j < 16; ++j) { const unsigned c = xb_ld(&bar[XB_XCNT(j)]); sum += c; cnt += (c > 0u) ? 1u : 0u; mine = (j == x) ? c : mine; }
        if (sum == G) break;
        __builtin_amdgcn_s_sleep(1);
        if ((++sp & 255u) == 0u) { if (xb_ld(&bar[XB_TMO])) break; if (sp > XB_SPIN_CAP) { atomicAdd(&bar[XB_TMO], 1u); break; } }
    }
    nloc = mine > 0u ? mine : 1u; nx = cnt > 0u ? cnt : 1u;
}

__device__ __forceinline__ void xcd_barrier(const XcdBarrier& b) {
    asm volatile("s_waitcnt vmcnt(0)" ::: "memory");
    __syncthreads();
    if (xb_t0(b.wv)) {
        unsigned* bar = b.bar;
        __builtin_amdgcn_s_waitcnt(0);
        unsigned nloc = b.st[0], nx = b.st[1];
        if (nloc == 0u) { xcd_barrier_complete(bar, b.x, nloc, nx); b.st[0] = nloc; b.st[1] = nx; }
        const unsigned old = xb_add(&bar[XB_XSUB(b.x)], 1u);
        const unsigned gen = old / nloc;
        if (old + 1u == (gen + 1u) * nloc) {
            __builtin_amdgcn_fence(__ATOMIC_RELEASE, "agent");
            asm volatile("s_waitcnt vmcnt(0)" ::: "memory");
            const unsigned og = xb_add(&bar[XB_TOP], 1u);
            const unsigned tg = og / nx;
            if (og + 1u == (tg + 1u) * nx) xb_add(&bar[XB_TOPGEN], 1u);
            else XB_SPIN(xb_ld(&bar[XB_TOPGEN]) == tg, bar);
            __builtin_amdgcn_fence(__ATOMIC_ACQUIRE, "agent");
            xb_add(&bar[XB_XGEN(b.x)], 1u);
            asm volatile("s_waitcnt vmcnt(0)" ::: "memory");
        } else {
            XB_SPIN(xb_ld(&bar[XB_XGEN(b.x)]) == gen, bar);
            __builtin_amdgcn_fence(__ATOMIC_ACQUIRE, "agent");
            asm volatile("s_waitcnt vmcnt(0)" ::: "memory");
        }
    }
    __syncthreads();
}

constexpr int NWAVES = 8;
constexpr int RING_OFF = 0, RING_BYTES = 131072;
constexpr int LDSCTL_OFF = RING_BYTES, MISC_OFF = LDSCTL_OFF + 320;
constexpr int LDS_BYTES = 147456;
constexpr int N_PHASES = 8;

struct Frame {
    LAS unsigned char* lds;
    volatile LAS unsigned* MISC;
    gu32* ctl;
    int tid, lane, wave, vcu, G;
};
__device__ __forceinline__ float wave_sum(float v) {
#pragma unroll
    for (int o = 1; o < 64; o <<= 1) v += __shfl_xor(v, o);
    return v;
}
struct Args { const float* in[20]; float* out; unsigned char* ws; int ph_lo, ph_hi, li, pad; };

__device__ __forceinline__ void p0_transpose_item(const float* W, int ld, int nblk, const float* glo, const float* ghi, int K, bf16* WT, LAS float* scr, int item, int lane) {
    const int kb = item / nblk, nb = item % nblk, k0 = 64 * kb, n0 = 32 * nb;
#pragma unroll 8
    for (int i = 0; i < 32; ++i) { const int kk = 2 * i + (lane >> 5), k = k0 + kk; float w = W[(size_t)k * ld + n0 + (lane & 31)];
        if (glo) w *= (k < K / 2) ? glo[k] : ghi[k - K / 2];
        scr[kk * 33 + (lane & 31)] = w; }
    LDS_WAIT(); asm volatile("" ::: "memory");
    const int c = lane & 7;
#pragma unroll
    for (int j = 0; j < 4; ++j) { const int n = (lane >> 3) + 8 * j; const LAS float* s = scr + (8 * c) * 33 + n;
        v4u o; o.x = pk2(s[0 * 33], s[1 * 33]); o.y = pk2(s[2 * 33], s[3 * 33]); o.z = pk2(s[4 * 33], s[5 * 33]); o.w = pk2(s[6 * 33], s[7 * 33]);
        *(GAS v4u*)(WT + (size_t)(n0 + n) * K + k0 + 8 * c) = o; }
    LDS_WAIT(); asm volatile("" ::: "memory");
}
__device__ __forceinline__ float log_sigmoid(float z) { return fminf(z, 0.f) - log1pf(expf(-fabsf(z))); }

__device__ __forceinline__ void p0_prologue(Frame& F, const Args& a) {
    LAS float* scr = (LAS float*)(F.lds + RING_OFF + F.wave * 16384);
    unsigned char* ws = a.ws;
    const float* x = a.in[0]; const float* g1 = a.in[1]; const float* w_in = a.in[2]; const float* bfv = a.in[10];
    const float* gn_l = a.in[11]; const float* gn_f = a.in[12]; const float* w_out = a.in[13]; const float* g2 = a.in[14];
    const float* w_q = a.in[15]; const float* sk = a.in[16]; const float* pu = a.in[17]; const float* pv = a.in[18];
    bf16* win_t = (bf16*)(ws + WS_WIN); bf16* wout_t = (bf16*)(ws + WS_WOUT); bf16* wq_t = (bf16*)(ws + WS_WQ); bf16* skb = (bf16*)(ws + WS_SKB);
    float* logf = (float*)(ws + WS_LOGF); float* sumsq = (float*)(ws + WS_SUMSQ); bf16* h = (bf16*)(ws + WS_H);
    const int gw = F.vcu * NWAVES + F.wave, NGW = F.G * NWAVES, lane = F.lane;
    constexpr int I_IN = (DMODEL / 64) * (NG1 / 32), I_OUT = (DMODEL / 64) * (DMODEL / 32), I_Q = (DMODEL / 64) * (QPW / 32);
    constexpr int I_FL = 8 * DMODEL / 64, I_SK = PH * 2 * NKEY * PHALF / 512, I_SS = T / 64, I_WAX = 8 * 2 * 2 * 4;
    constexpr int E0 = I_IN, E1 = E0 + I_OUT, E2 = E1 + I_Q, E3 = E2 + I_FL, E4 = E3 + I_SK, E5 = E4 + I_SS, E6 = E5 + I_WAX;
    for (int it = gw; it < E6; it += NGW) {
        if (it < E0) { p0_transpose_item(w_in, INC, NG1 / 32, nullptr, nullptr, DMODEL, win_t, scr, it, lane); continue; }
        if (it < E1) { p0_transpose_item(w_out, DMODEL, DMODEL / 32, gn_l, gn_f, DMODEL, wout_t, scr, it - E0, lane); continue; }
        if (it < E2) { p0_transpose_item(w_q, QPW, QPW / 32, g2, g2 + DMODEL / 2, DMODEL, wq_t, scr, it - E1, lane); continue; }
        if (it < E3) continue;
        if (it < E4) { const size_t i = (size_t)(it - E3) * 512 + lane * 8; const f32x4 s0 = *(const GAS f32x4*)(sk + i), s1 = *(const GAS f32x4*)(sk + i + 4);
            v4u o; o.x = pk2(s0[0], s0[1]); o.y = pk2(s0[2], s0[3]); o.z = pk2(s1[0], s1[1]); o.w = pk2(s1[2], s1[3]);
            { const size_t hp = i >> 14; const int key = (int)(i >> 7) & 127, c8 = (int)(i >> 3) & 15; *(GAS v4u*)(skb + hp * 16384 + ((size_t)((((key >> 5) * 2 + (c8 & 1)) * 8 + (c8 >> 1)) * 32 + (key & 31))) * 8) = o; } continue; }
        if (it < E5) { sumsq[(it - E4) * 64 + lane] = 0.f; continue; }
        { const int f = it - E5, ks = f & 3, n = (f >> 2) & 1, mat = (f >> 3) & 1, hh = f >> 4; const float* wsrc = mat ? a.in[7] : a.in[5];
          const size_t o = ((size_t)(hh * 64 + 16 * ks + 8 * (lane >> 5))) * 64 + 32 * n + (lane & 31);
          v4u pw; pw.x = pk2(wsrc[o], wsrc[o + 64]); pw.y = pk2(wsrc[o + 128], wsrc[o + 192]); pw.z = pk2(wsrc[o + 256], wsrc[o + 320]); pw.w = pk2(wsrc[o + 384], wsrc[o + 448]);
          *(GAS v4u*)((bf16*)(ws + WS_WAX) + (size_t)f * 512 + lane * 8) = pw; }
    }
    { f32x4 gg[4];
#pragma unroll
      for (int j = 0; j < 4; ++j) gg[j] = *(const GAS f32x4*)(g2 + 16 * lane + 4 * j);
      unsigned char* u4 = ws + WS_U8; unsigned char* v4 = ws + WS_V8; float* su = (float*)(ws + WS_SU);
      for (int e = gw; e < NEXP; e += NGW) {
        const GAS f32x4* ur = (const GAS f32x4*)(pu + (size_t)e * DMODEL + 16 * lane); const GAS f32x4* vr = (const GAS f32x4*)(pv + (size_t)e * DMODEL + 16 * lane);
        f32x4 uu[4], vv[4]; float mu = 0.f, mv = 0.f;
#pragma unroll
        for (int j = 0; j < 4; ++j) { uu[j] = ur[j] * gg[j]; vv[j] = vr[j];
#pragma unroll
            for (int c = 0; c < 4; ++c) { mu = fmaxf(mu, fabsf(uu[j][c])); mv = fmaxf(mv, fabsf(vv[j][c])); } }
#pragma unroll
        for (int o = 1; o < 64; o <<= 1) { mu = fmaxf(mu, __shfl_xor(mu, o)); mv = fmaxf(mv, __shfl_xor(mv, o)); }
        const float scu = mu > 0.f ? mu * (1.f / 6.f) : 1.f, scv = mv > 0.f ? mv * (1.f / 6.f) : 1.f, iu = 1.f / scu, iv = 1.f / scv;
        unsigned qu0 = 0u, qu1 = 0u, qv0 = 0u, qv1 = 0u;
#define P0_Q4(Q, X, INV, B0, B1) do { Q = __builtin_amdgcn_cvt_scalef32_pk_fp4_f32(Q, X[0] * INV, X[1] * INV, 1.0f, B0); Q = __builtin_amdgcn_cvt_scalef32_pk_fp4_f32(Q, X[2] * INV, X[3] * INV, 1.0f, B1); } while (0)
        P0_Q4(qu0, uu[0], iu, 0, 1); P0_Q4(qu0, uu[1], iu, 2, 3); P0_Q4(qu1, uu[2], iu, 0, 1); P0_Q4(qu1, uu[3], iu, 2, 3);
        P0_Q4(qv0, vv[0], iv, 0, 1); P0_Q4(qv0, vv[1], iv, 2, 3); P0_Q4(qv1, vv[2], iv, 0, 1); P0_Q4(qv1, vv[3], iv, 2, 3);
#undef P0_Q4
        *(GAS unsigned long long*)(u4 + (size_t)e * 512 + 8 * lane) = (unsigned long long)qu0 | ((unsigned long long)qu1 << 32);
        { unsigned char* vrow = v4 + (size_t)e * 512 + 2 * (lane >> 2);
          *(GAS unsigned short*)(vrow + 32 * (4 * (lane & 3) + 0)) = (unsigned short)(qv0 & 0xffffu); *(GAS unsigned short*)(vrow + 32 * (4 * (lane & 3) + 1)) = (unsigned short)(qv0 >> 16);
          *(GAS unsigned short*)(vrow + 32 * (4 * (lane & 3) + 2)) = (unsigned short)(qv1 & 0xffffu); *(GAS unsigned short*)(vrow + 32 * (4 * (lane & 3) + 3)) = (unsigned short)(qv1 >> 16); }
        if (lane == 0) { su[2 * e] = scu; su[2 * e + 1] = scv; }
      } }
    { f32x4 gg[4];
#pragma unroll
      for (int j = 0; j < 4; ++j) gg[j] = *(const GAS f32x4*)(g1 + 256 * j + 4 * lane);
      float fw[4][4][8];
#pragma unroll
      for (int j = 0; j < 4; ++j)
#pragma unroll
          for (int c = 0; c < 4; ++c) { const int k = 256 * j + 4 * lane + c; const GAS f32x4* wr = (const GAS f32x4*)(w_in + (size_t)k * INC + NG1); const f32x4 w0 = wr[0], w1 = wr[1];
#pragma unroll
              for (int e = 0; e < 4; ++e) { fw[j][c][e] = w0[e]; fw[j][c][4 + e] = w1[e]; } }
      for (int t0 = gw; t0 < T; t0 += 2 * NGW) {
        const int t1 = (t0 + NGW < T) ? t0 + NGW : t0;
        const GAS f32x4* xr0 = (const GAS f32x4*)(x + (size_t)t0 * DMODEL) + lane; const GAS f32x4* xr1 = (const GAS f32x4*)(x + (size_t)t1 * DMODEL) + lane;
        f32x4 va[4], vb[4]; float sa = 0.f, sb = 0.f;
#pragma unroll
        for (int j = 0; j < 4; ++j) { va[j] = xr0[64 * j]; vb[j] = xr1[64 * j]; }
#pragma unroll
        for (int j = 0; j < 4; ++j) { sa += (va[j][0] * va[j][0] + va[j][1] * va[j][1]) + (va[j][2] * va[j][2] + va[j][3] * va[j][3]); sb += (vb[j][0] * vb[j][0] + vb[j][1] * vb[j][1]) + (vb[j][2] * vb[j][2] + vb[j][3] * vb[j][3]); }
        const float ra = rsqrtf(wave_sum(sa) * (1.f / DMODEL) + RMS_EPS), rb = rsqrtf(wave_sum(sb) * (1.f / DMODEL) + RMS_EPS);
        GAS unsigned long long* ha = (GAS unsigned long long*)(h + (size_t)t0 * DMODEL) + lane; GAS unsigned long long* hb = (GAS unsigned long long*)(h + (size_t)t1 * DMODEL) + lane;
#pragma unroll
        for (int j = 0; j < 4; ++j) { va[j] = va[j] * ra * gg[j]; vb[j] = vb[j] * rb * gg[j];
            ha[64 * j] = (unsigned long long)pk2(va[j][0], va[j][1]) | ((unsigned long long)pk2(va[j][2], va[j][3]) << 32);
            hb[64 * j] = (unsigned long long)pk2(vb[j][0], vb[j][1]) | ((unsigned long long)pk2(vb[j][2], vb[j][3]) << 32); }
        float fa[8], fb[8];
#pragma unroll
        for (int hh = 0; hh < 8; ++hh) { fa[hh] = 0.f; fb[hh] = 0.f; }
#pragma unroll
        for (int j = 0; j < 4; ++j)
#pragma unroll
            for (int c = 0; c < 4; ++c) {
#pragma unroll
                for (int hh = 0; hh < 8; ++hh) { fa[hh] += va[j][c] * fw[j][c][hh]; fb[hh] += vb[j][c] * fw[j][c][hh]; } }
        float resa = 0.f, resb = 0.f;
#pragma unroll
        for (int hh = 0; hh < 8; ++hh) { const float s0 = wave_sum(fa[hh]), s1 = wave_sum(fb[hh]); if (lane == hh) { resa = s0; resb = s1; } }
        if (lane < 8) { logf[(size_t)t0 * 8 + lane] = log_sigmoid(resa + bfv[lane]); logf[(size_t)t1 * 8 + lane] = log_sigmoid(resb + bfv[lane]); }
      } }
}

__device__ __forceinline__ void fcum_unit(Frame& F, int bh, const float* logf, float* fcum) {
    const int b = bh / NHEADS, hh = bh % NHEADS, s0 = F.tid * 16;
    float v[16]; float loc = 0.f;
#pragma unroll
    for (int i = 0; i < 16; ++i) { v[i] = logf[((size_t)b * SEQ + s0 + i) * 8 + hh]; loc += v[i]; }
    float inc = loc;
#pragma unroll
    for (int o = 1; o < 64; o <<= 1) { const float n = __shfl_up(inc, o); if (F.lane >= o) inc += n; }
    if (F.lane == 63) F.MISC[16 + F.wave] = __float_as_uint(inc);
    __syncthreads();
    float run = inc - loc;
    for (int w = 0; w < F.wave; ++w) run += __uint_as_float(F.MISC[16 + w]);
#pragma unroll
    for (int i = 0; i < 16; ++i) { run += v[i]; fcum[(size_t)bh * SEQ + s0 + i] = run; }
    __syncthreads();
}


namespace peer {
typedef unsigned u32;
typedef float f32x16 __attribute__((ext_vector_type(16)));
constexpr int TOK = 128;
constexpr int EX_STRIDE = 136, GT_STRIDE = 136;
constexpr int L_EX = 0, L_GT = L_EX + TOK * EX_STRIDE * 2, L_IDX = L_GT + TOK * GT_STRIDE * 2, IDX_STRIDE = 36, L_RST = L_IDX + 512 * IDX_STRIDE, L_BI = L_RST + TOK * 4, BI_WAVE = 4352, L_END = L_BI + 8 * BI_WAVE;
static_assert(L_END <= RING_BYTES && L_GT % 16 == 0 && L_IDX % 16 == 0, "PEER LDS map");
__device__ __forceinline__ u32 ordmap(float f) { const u32 u = __float_as_uint(f); return u ^ ((u32)((int)u >> 31) | 0x80000000u); }
__device__ __forceinline__ float unordmap(u32 k) { const u32 u = (k & 0x80000000u) ? (k ^ 0x80000000u) : ~k; return __uint_as_float(u); }
__device__ __forceinline__ u32 umin_(u32 a, u32 b) { return a < b ? a : b; }
__device__ __forceinline__ u32 umax_(u32 a, u32 b) { return a > b ? a : b; }
template <bool DESC> __device__ __forceinline__ void sort16(u32 (&k)[16]) {
#pragma unroll
    for (int size = 2; size <= 16; size <<= 1)
#pragma unroll
        for (int stride = size >> 1; stride > 0; stride >>= 1)
#pragma unroll
            for (int i = 0; i < 16; ++i) { const int j = i ^ stride;
                if (j > i) { const bool asc = (((i & size) == 0) != DESC); const u32 a = k[i], b = k[j], lo = umin_(a, b), hi = umax_(a, b); k[i] = asc ? lo : hi; k[j] = asc ? hi : lo; } }
}
template <bool DESC> __device__ __forceinline__ void merge16(u32 (&k)[16]) {
#pragma unroll
    for (int stride = 8; stride > 0; stride >>= 1)
#pragma unroll
        for (int i = 0; i < 16; ++i) { const int j = i ^ stride;
            if (j > i) { const u32 a = k[i], b = k[j], lo = umin_(a, b), hi = umax_(a, b); k[i] = DESC ? hi : lo; k[j] = DESC ? lo : hi; } }
}
__host__ __device__ constexpr int ccnt(int a) { return 16 / (a + 1); }
__host__ __device__ constexpr int cbase(int a) { int s = 0; for (int i = 0; i < a; ++i) s += ccnt(i); return s; }
static_assert(cbase(16) == 50, "hyperbola candidate count");
__device__ __forceinline__ int crow16(int r) { return (r & 3) + 8 * (r >> 2); }

__device__ __forceinline__ void route_tile(Frame& F, const bf16* qp, const bf16* skb, const float* sumsq, int t0) {
    int lane = F.lane; asm volatile("" : "+v"(lane));
    const int r32 = lane & 31, hi = lane >> 5, w = F.wave;
    LAS unsigned short* EXL = (LAS unsigned short*)(F.lds + RING_OFF + L_EX);
    LAS unsigned short* GTL = (LAS unsigned short*)(F.lds + RING_OFF + L_GT);
    LAS unsigned char* IDXB = F.lds + RING_OFF + L_IDX + (w * 64 + lane) * IDX_STRIDE;
    LAS float* RST = (LAS float*)(F.lds + RING_OFF + L_RST);
    for (int g = 0; g < 4; ++g) {
        const int tok = 32 * g + r32; const size_t trow = (size_t)(t0 + tok);
        const float rstd2 = rsqrtf(sumsq[trow] * (1.f / DMODEL) + RMS_EPS);
        if (w == 0 && hi == 0) RST[tok] = rstd2;
        u32 s0[16], s1[16];
#pragma unroll
        for (int p = 0; p < 2; ++p) {
            bf16x8 qf[8];
#pragma unroll
            for (int ks = 0; ks < 8; ++ks) qf[ks] = *(const GAS bf16x8*)(qp + ((size_t)((((trow >> 5) * 8 + w) * 2 + p) * 16 + 2 * ks + hi) * 32 + r32) * 8);
            u32 run[16];
#pragma unroll
            for (int nb = 0; nb < 4; ++nb) {
                f32x16 acc = {};
                const bf16* kr = skb + (size_t)(w * 2 + p) * 16384 + ((size_t)((nb * 2 + hi) * 8 * 32 + r32)) * 8;
#pragma unroll
                for (int ks = 0; ks < 8; ++ks) acc = __builtin_amdgcn_mfma_f32_32x32x16_bf16(*(const GAS bf16x8*)(kr + ks * 256), qf[ks], acc, 0, 0, 0);
                asm volatile("" ::: "memory");
                u32 blk[16];
#pragma unroll
                for (int r = 0; r < 16; ++r) blk[r] = (ordmap(acc[r]) & ~0x7Fu) | (u32)(127 - 32 * nb - crow16(r) - 4 * hi);
                if (nb == 0) { sort16<true>(blk);
#pragma unroll
                    for (int i = 0; i < 16; ++i) run[i] = blk[i]; }
                else { sort16<false>(blk);
#pragma unroll
                    for (int i = 0; i < 16; ++i) run[i] = umax_(run[i], blk[i]);
                    merge16<true>(run); }
            }
            u32 oth[16];
#pragma unroll
            for (int i = 0; i < 16; ++i) oth[i] = (u32)__shfl_xor((int)run[15 - i], 32);
#pragma unroll
            for (int i = 0; i < 16; ++i) run[i] = umax_(run[i], oth[i]);
            merge16<true>(run);
#pragma unroll
            for (int i = 0; i < 16; ++i) { if (p == 0) s0[i] = run[i]; else s1[i] = run[i]; }
        }
        { LAS u32* iw = (LAS u32*)IDXB;
#pragma unroll
          for (int j = 0; j < 4; ++j) {
              iw[j] = (127u - (s0[4 * j] & 127u)) | ((127u - (s0[4 * j + 1] & 127u)) << 8) | ((127u - (s0[4 * j + 2] & 127u)) << 16) | ((127u - (s0[4 * j + 3] & 127u)) << 24);
              iw[4 + j] = (127u - (s1[4 * j] & 127u)) | ((127u - (s1[4 * j + 1] & 127u)) << 8) | ((127u - (s1[4 * j + 2] & 127u)) << 16) | ((127u - (s1[4 * j + 3] & 127u)) << 24); } }
        float v1[16], v2[16];
#pragma unroll
        for (int i = 0; i < 16; ++i) { v1[i] = unordmap(s0[i] & ~0x7Fu); v2[i] = unordmap(s1[i] & ~0x7Fu); }
        u32 c0[16], c1[16], c2[16], c3[16];
#pragma unroll
        for (int a = 0; a < 16; ++a)
#pragma unroll
            for (int b = 0; b < ccnt(a); ++b) { const int pos = cbase(a) + b; const u32 key = (ordmap(v1[a] + v2[b]) & ~0xFFu) | (u32)(255 - (a * 16 + b));
                if (pos < 16) c0[pos] = key; else if (pos < 32) c1[pos - 16] = key; else if (pos < 48) c2[pos - 32] = key; else c3[pos - 48] = key; }
#pragma unroll
        for (int i = 2; i < 16; ++i) c3[i] = 0u;
        sort16<false>(c1);
#pragma unroll
        for (int i = 0; i < 16; ++i) c0[i] = umax_(c0[i], c1[i]);
        merge16<true>(c0);
        sort16<false>(c2);
#pragma unroll
        for (int i = 0; i < 16; ++i) c0[i] = umax_(c0[i], c2[i]);
        merge16<true>(c0);
        sort16<false>(c3);
#pragma unroll
        for (int i = 0; i < 16; ++i) c0[i] = umax_(c0[i], c3[i]);
        merge16<true>(c0);
        const float m = unordmap(c0[0] & ~0xFFu) * rstd2;
        float e[8]; float sum = 0.f; u32 ex[8];
#pragma unroll
        for (int k = 0; k < 8; ++k) { const u32 key = hi ? c0[k + 8] : c0[k]; const float ts = unordmap(key & ~0xFFu);
            e[k] = __builtin_amdgcn_exp2f((ts * rstd2 - m) * LOG2E); sum += e[k];
            const u32 flat = 255u - (key & 255u); ex[k] = (u32)IDXB[flat >> 4] * NKEY + (u32)IDXB[16 + (flat & 15u)]; }
        sum += __shfl_xor(sum, 32);
        const float inv = 1.f / sum;
        v4u exw; exw.x = ex[0] | (ex[1] << 16); exw.y = ex[2] | (ex[3] << 16); exw.z = ex[4] | (ex[5] << 16); exw.w = ex[6] | (ex[7] << 16);
        *(LAS v4u*)(EXL + tok * EX_STRIDE + w * 16 + hi * 8) = exw;
        *(LAS v4u*)(GTL + tok * GT_STRIDE + w * 16 + hi * 8) = (v4u){pk2(e[0] * inv, e[1] * inv), pk2(e[2] * inv, e[3] * inv), pk2(e[4] * inv, e[5] * inv), pk2(e[6] * inv, e[7] * inv)};
    }
}
__device__ __forceinline__ float gelu_fast(float x) {
    const float u2 = x * (1.5957691216057308f + 0.07135481627f * x * x);
    return x * __builtin_amdgcn_rcpf(1.f + __builtin_amdgcn_exp2f(-1.4426950408889634f * u2));
}
typedef float f32x2 __attribute__((ext_vector_type(2)));

__device__ __forceinline__ void sort128(u32 (&k)[8], int m) {
#pragma unroll
    for (int K = 2; K <= 128; K <<= 1) {
#pragma unroll
        for (int S = K >> 1; S > 0; S >>= 1) {
            if (S >= 8) {
                const int mm = S >> 3; const bool lower = (m & mm) == 0, up = (K == 128) ? true : ((m & (K >> 3)) == 0), keepmin = (lower == up);
#pragma unroll
                for (int r = 0; r < 8; ++r) { const u32 o = (u32)__shfl_xor((int)k[r], mm); const u32 mn = umin_(k[r], o), mx = umax_(k[r], o); k[r] = keepmin ? mn : mx; }
            } else {
#pragma unroll
                for (int r = 0; r < 8; ++r) { const int r2 = r ^ S;
                    if (r2 > r) { const u32 a = k[r], b = k[r2], mn = umin_(a, b), mx = umax_(a, b);
                        if (K < 8) { const bool up = (r & K) == 0; k[r] = up ? mn : mx; k[r2] = up ? mx : mn; }
                        else { const bool up = (K == 128) ? true : ((m & (K >> 3)) == 0); k[r] = up ? mn : mx; k[r2] = up ? mx : mn; } } }
            }
        }
    }
}
typedef int v8i __attribute__((ext_vector_type(8)));
__device__ __forceinline__ void eval_mf(Frame& F, const unsigned char* u4, const unsigned char* v4, const float* suv, const float* fg, float* out, int t0) {
    int lane = F.lane; asm volatile("" : "+v"(lane));
    const int g = lane >> 4, m = lane & 15;
    const LAS unsigned short* EXL = (const LAS unsigned short*)(F.lds + RING_OFF + L_EX);
    const LAS unsigned short* GTL = (const LAS unsigned short*)(F.lds + RING_OFF + L_GT);
    LAS unsigned char* BI = F.lds + RING_OFF + L_BI + F.wave * BI_WAVE;
    const LAS float* RST = (const LAS float*)(F.lds + RING_OFF + L_RST);
    LAS u32* SKW = (LAS u32*)(F.lds + RING_OFF + L_IDX) + F.wave * 512;
    LAS u32* SK = SKW + g * 128;
    for (int pass = 0; pass < 4; ++pass) {
        const int tb4 = 32 * pass + 4 * F.wave, tok = tb4 + g;
        { u32 k[8]; const v4u ev = *(const LAS v4u*)(EXL + tok * EX_STRIDE + 8 * m); const u32 s0 = (u32)(8 * m);
          k[0] = ((ev.x & 0xffffu) << 7) | s0; k[1] = ((ev.x >> 16) << 7) | (s0 + 1); k[2] = ((ev.y & 0xffffu) << 7) | (s0 + 2); k[3] = ((ev.y >> 16) << 7) | (s0 + 3);
          k[4] = ((ev.z & 0xffffu) << 7) | (s0 + 4); k[5] = ((ev.z >> 16) << 7) | (s0 + 5); k[6] = ((ev.w & 0xffffu) << 7) | (s0 + 6); k[7] = ((ev.w >> 16) << 7) | (s0 + 7);
          sort128(k, m);
          *(LAS v4u*)(SK + m * 8) = (v4u){k[0], k[1], k[2], k[3]}; *(LAS v4u*)(SK + m * 8 + 4) = (v4u){k[4], k[5], k[6], k[7]}; }
        asm volatile("" ::: "memory");
        {
#pragma unroll
            for (int tq = 0; tq < 4; ++tq) { const float rq = RST[tb4 + tq]; const float* xr = out + (size_t)(t0 + tb4 + tq) * DMODEL + 4 * lane;
#pragma unroll
                for (int c = 0; c < 4; ++c) { const f32x4 xa = *(const GAS f32x4*)(xr + 256 * c); int w = 0;
                    w = __builtin_amdgcn_cvt_pk_fp8_f32(xa[0] * rq, xa[1] * rq, w, false); w = __builtin_amdgcn_cvt_pk_fp8_f32(xa[2] * rq, xa[3] * rq, w, true);
                    const int d = 256 * c + 4 * lane, st = d >> 7, dd = d & 127, hh = dd >> 6, e = dd & 63;
                    *(LAS int*)(BI + ((st * 4 + tq) * 4 + (e >> 4)) * 32 + hh * 16 + (e & 15)) = w; } }
        }
        asm volatile("" ::: "memory");
        v8i hb[8];
#pragma unroll
        for (int st = 0; st < 8; ++st) { v4u b0 = *(const LAS v4u*)(BI + ((st * 4 + (m & 3)) * 4 + g) * 32), b1 = *(const LAS v4u*)(BI + ((st * 4 + (m & 3)) * 4 + g) * 32 + 16);
            if (m >= 4) { b0 = (v4u){0u, 0u, 0u, 0u}; b1 = b0; }
            hb[st] = (v8i){(int)b0.x, (int)b0.y, (int)b0.z, (int)b0.w, (int)b1.x, (int)b1.y, (int)b1.z, (int)b1.w}; }
        asm volatile("" ::: "memory");
        f32x2 y[32];
#pragma unroll
        for (int q = 0; q < 32; ++q) y[q] = (f32x2){0.f, 0.f};
        float* xrow = out + (size_t)(t0 + tok) * DMODEL + 4 * m;
        const LAS unsigned short* gtr = GTL + tok * GT_STRIDE;
        for (int i = 0; i < 128; i += 4) {
            const v4u kq = *(const LAS v4u*)(SK + i);
            v4u ua[4][2];
#pragma unroll
            for (int s4 = 0; s4 < 4; ++s4) { const u32 ro = (kq[s4] >> 7) * 512u + 16u * (u32)m; ua[s4][0] = *(const GAS v4u*)(u4 + ro); ua[s4][1] = *(const GAS v4u*)(u4 + ro + 256); }
            v4u af[8];
#pragma unroll
            for (int hf = 0; hf < 2; ++hf) {
#pragma unroll
                for (int s4 = 0; s4 < 4; ++s4) *(LAS v4u*)(BI + (4 * s4 + g) * 272 + 16 * m) = ua[s4][hf];
                asm volatile("" ::: "memory");
#pragma unroll
                for (int st = 0; st < 4; ++st) af[4 * hf + st] = *(const LAS v4u*)(BI + m * 272 + 64 * st + 16 * g);
                asm volatile("" ::: "memory");
            }
            f32x2 sc[4]; float gate[4];
#pragma unroll
            for (int s4 = 0; s4 < 4; ++s4) { sc[s4] = *(const GAS f32x2*)(suv + 2 * (kq[s4] >> 7)); gate[s4] = __uint_as_float((u32)gtr[kq[s4] & 127u] << 16); }
            f32x4 D = (f32x4){0.f, 0.f, 0.f, 0.f};
#pragma unroll
            for (int st = 0; st < 8; ++st) { const v8i a8 = (v8i){(int)af[st].x, (int)af[st].y, (int)af[st].z, (int)af[st].w, 0, 0, 0, 0};
                D = __builtin_amdgcn_mfma_scale_f32_16x16x128_f8f6f4(a8, hb[st], D, 4, 0, 0, 0x7f7f7f7f, 0, 0x7f7f7f7f); }
            asm volatile("" ::: "memory");
            v4u vb[4][2];
#pragma unroll
            for (int s4 = 0; s4 < 4; ++s4) { const u32 ro = (kq[s4] >> 7) * 512u + 32u * (u32)m; vb[s4][0] = *(const GAS v4u*)(v4 + ro); vb[s4][1] = *(const GAS v4u*)(v4 + ro + 16); }
            const int sel = lane & 3; const float mine = sel == 0 ? D[0] : sel == 1 ? D[1] : sel == 2 ? D[2] : D[3];
#pragma unroll
            for (int s4 = 0; s4 < 4; ++s4) { const float pre = __uint_as_float((unsigned)__builtin_amdgcn_ds_bpermute(4 * (g + 16 * s4), (int)__float_as_uint(mine)));
                const float act = gelu_fast(pre * sc[s4][0]) * (gate[s4] * sc[s4][1]); const f32x2 b2 = (f32x2){act, act};
#pragma unroll
                for (int c = 0; c < 2; ++c)
#pragma unroll
                    for (int d = 0; d < 4; ++d) { const unsigned w_ = vb[s4][c][d]; const int hq = 16 * c + 4 * d;
                        y[hq] = __builtin_elementwise_fma(__builtin_amdgcn_cvt_scalef32_pk_f32_fp4(w_, 1.0f, 0), b2, y[hq]); y[hq + 1] = __builtin_elementwise_fma(__builtin_amdgcn_cvt_scalef32_pk_f32_fp4(w_, 1.0f, 1), b2, y[hq + 1]);
                        y[hq + 2] = __builtin_elementwise_fma(__builtin_amdgcn_cvt_scalef32_pk_f32_fp4(w_, 1.0f, 2), b2, y[hq + 2]); y[hq + 3] = __builtin_elementwise_fma(__builtin_amdgcn_cvt_scalef32_pk_f32_fp4(w_, 1.0f, 3), b2, y[hq + 3]); } }
        }
        float ss = 0.f;
#pragma unroll
        for (int q = 0; q < 16; ++q) { const f32x4 xa = *(const GAS f32x4*)(xrow + 64 * q); y[2 * q][0] += xa[0]; y[2 * q][1] += xa[1]; y[2 * q + 1][0] += xa[2]; y[2 * q + 1][1] += xa[3];
            ss += (y[2 * q][0] * y[2 * q][0] + y[2 * q][1] * y[2 * q][1]) + (y[2 * q + 1][0] * y[2 * q + 1][0] + y[2 * q + 1][1] * y[2 * q + 1][1]); }
        ss += __shfl_xor(ss, 1); ss += __shfl_xor(ss, 2); ss += __shfl_xor(ss, 4); ss += __shfl_xor(ss, 8);
        const float rs = rsqrtf(ss * (1.f / DMODEL) + RMS_EPS);
        asm volatile("" ::: "memory");
#pragma unroll
        for (int q = 0; q < 16; ++q) { const f32x4 gq = *(const GAS f32x4*)(fg + 64 * q + 4 * m); f32x4 o; o[0] = y[2 * q][0] * rs * gq[0]; o[1] = y[2 * q][1] * rs * gq[1]; o[2] = y[2 * q + 1][0] * rs * gq[2]; o[3] = y[2 * q + 1][1] * rs * gq[3];
            *(GAS f32x4*)(xrow + 64 * q) = o; }
    }
}
__device__ __forceinline__ void peer_phase(Frame& F, const Args& a) {
    unsigned char* ws = a.ws;
    for (int tile = F.vcu; tile < T / TOK; tile += F.G) {
        route_tile(F, (const bf16*)(ws + WS_QP), (const bf16*)(ws + WS_SKB), (const float*)(ws + WS_SUMSQ), tile * TOK);
        __syncthreads();
        eval_mf(F, ws + WS_U8, ws + WS_V8, (const float*)(ws + WS_SU), a.in[19], a.out, tile * TOK);
        __syncthreads();
    }
}
}

namespace lru {
typedef float f32x16 __attribute__((ext_vector_type(16)));
constexpr int TOKT = 128, NTILE = SEQ / TOKT;
constexpr int WAVE_LDS = 14336, L_XS = 0, L_XC = 4608, L_GS = 9216, XC_STRIDE = 72  , L_SS = 8 * WAVE_LDS;
static_assert(L_SS + 32 * 8 * 4 <= RING_BYTES, "LRU LDS map");
__device__ __forceinline__ float bf2f(unsigned short h) { return __uint_as_float((unsigned)h << 16); }
__device__ __forceinline__ int crow16(int r) { return (r & 3) + 8 * (r >> 2); }
__device__ __forceinline__ float sigm(float x) { return __builtin_amdgcn_rcpf(1.f + __builtin_amdgcn_exp2f(-LOG2E * x)); }

template <bool FINAL> __device__ __forceinline__ void lru_tile(Frame& F, const Args& args, int tile) {
    int lane = F.lane; asm volatile("" : "+v"(lane));
    const int w = F.wave, j32 = lane & 31, hi = lane >> 5;
    unsigned char* ws = args.ws;
    const bf16* xr = (const bf16*)(ws + WS_XR); const bf16* gr = (const bf16*)(ws + WS_GR); float* carry = (float*)(ws + WS_CARRY);
    const float* cw = args.in[3]; const float* cb = args.in[4]; const float* ba = args.in[6]; const float* bx = args.in[8]; const float* lam = args.in[9];
    const int b = tile / NTILE, jt = tile % NTILE; const size_t trow0 = (size_t)b * SEQ + (size_t)jt * TOKT;
    LAS unsigned char* wl = F.lds + RING_OFF + w * WAVE_LDS;
    LAS unsigned short* XS = (LAS unsigned short*)(wl + L_XS); LAS unsigned short* XC = (LAS unsigned short*)(wl + L_XC); LAS unsigned short* GS = (LAS unsigned short*)(wl + L_GS);
    LAS float* SS = (LAS float*)(F.lds + RING_OFF + L_SS);
    float c_ba[2], c_bx[2], c_sp[2], c_cb[2], c_cw[2][4];
#pragma unroll
    for (int n = 0; n < 2; ++n) { const int c = 64 * w + 32 * n + j32; c_ba[n] = ba[c]; c_bx[n] = bx[c]; c_cb[n] = cb[c];
        const float l = lam[c]; c_sp[n] = 8.f * LOG2E * (fmaxf(-l, 0.f) + log1pf(expf(-fabsf(l))));
#pragma unroll
        for (int k = 0; k < 4; ++k) c_cw[n][k] = cw[k * LW + c]; }
    const bf16* wax = (const bf16*)(ws + WS_WAX);
    float hc[2] = {0.f, 0.f}, ap[2] = {1.f, 1.f};
    if (FINAL) { const float* cin = (const float*)(ws + WS_CIN) + (size_t)(b * NTILE + jt) * LW + 64 * w + j32; hc[0] = cin[0]; hc[1] = cin[32]; }
    v4u pfx[5], pfg[4];
#define LRU_FETCH(B) do { const size_t tbn_ = trow0 + (B) * 32; _Pragma("unroll") for (int q_ = 0; q_ < 5; ++q_) { const int pc_ = lane + 64 * q_, row_ = pc_ >> 3, c8_ = pc_ & 7; \
        const bool z_ = (jt == 0 && (B) == 0 && row_ < 3) || pc_ >= 35 * 8; const v4u v_ = *(const GAS v4u*)(xr + (tbn_ + (z_ ? 3 : row_) - 3) * LW + w * 64 + c8_ * 8); pfx[q_] = z_ ? (v4u){0u, 0u, 0u, 0u} : v_; } \
        if (FINAL) { _Pragma("unroll") for (int q_ = 0; q_ < 4; ++q_) { const int pc_ = lane + 64 * q_; pfg[q_] = *(const GAS v4u*)(gr + (tbn_ + (pc_ >> 3)) * LW + w * 64 + (pc_ & 7) * 8); } } } while (0)
    LRU_FETCH(0);
    for (int blk = 0; blk < 4; ++blk) {
        const size_t tb = trow0 + blk * 32;
        int ln = lane; asm volatile("" : "+v"(ln));
        const int k32 = ln & 31;
#pragma unroll
        for (int q = 0; q < 5; ++q) { const int pc = ln + 64 * q; if (pc < 35 * 8) *(LAS v4u*)((LAS unsigned char*)XS + (pc >> 3) * 128 + (pc & 7) * 16) = pfx[q]; }
        if (FINAL) {
#pragma unroll
            for (int q = 0; q < 4; ++q) { const int pc = ln + 64 * q; *(LAS v4u*)((LAS unsigned char*)GS + (pc >> 3) * 128 + (pc & 7) * 16) = pfg[q]; } }
        if (blk < 3) { LRU_FETCH(blk + 1); }
        asm volatile("" ::: "memory");
        float xc[2][16];
#pragma unroll
        for (int n = 0; n < 2; ++n)
#pragma unroll
            for (int g = 0; g < 4; ++g) { float xv[7];
#pragma unroll
                for (int q = 0; q < 7; ++q) xv[q] = bf2f(XS[(8 * g + 4 * hi + q) * 64 + 32 * n + j32]);
#pragma unroll
                for (int e = 0; e < 4; ++e) xc[n][4 * g + e] = c_cb[n] + ((c_cw[n][0] * xv[e] + c_cw[n][1] * xv[e + 1]) + (c_cw[n][2] * xv[e + 2] + c_cw[n][3] * xv[e + 3])); }
#pragma unroll
        for (int n = 0; n < 2; ++n)
#pragma unroll
            for (int r = 0; r < 16; ++r) XC[(crow16(r) + 4 * hi) * XC_STRIDE + 32 * n + j32] = (unsigned short)f2bf(xc[n][r]);
        asm volatile("" ::: "memory");
        bf16x8 af[4];
#pragma unroll
        for (int ks = 0; ks < 4; ++ks) af[ks] = *(const LAS bf16x8*)(XC + j32 * XC_STRIDE + 16 * ks + 8 * hi);
        asm volatile("" ::: "memory");
        float yv[2][16];
#pragma unroll
        for (int n = 0; n < 2; ++n) {
            f32x16 R = {}, I = {};
            bf16x8 fa[4], fx[4];
#pragma unroll
            for (int ks = 0; ks < 4; ++ks) { fa[ks] = *(const GAS bf16x8*)(wax + (size_t)(((w * 2 + 0) * 2 + n) * 4 + ks) * 512 + ln * 8); fx[ks] = *(const GAS bf16x8*)(wax + (size_t)(((w * 2 + 1) * 2 + n) * 4 + ks) * 512 + ln * 8); }
#pragma unroll
            for (int ks = 0; ks < 4; ++ks) { R = __builtin_amdgcn_mfma_f32_32x32x16_bf16(af[ks], fa[ks], R, 0, 0, 0); I = __builtin_amdgcn_mfma_f32_32x32x16_bf16(af[ks], fx[ks], I, 0, 0, 0); }
            float av[16], uv[16];
#pragma unroll
            for (int r = 0; r < 16; ++r) { const float rg = sigm(R[r] + c_ba[n]), ig = sigm(I[r] + c_bx[n]); const float a_ = __builtin_amdgcn_exp2f(-rg * c_sp[n]);
                av[r] = a_; uv[r] = __builtin_amdgcn_sqrtf(fmaxf(1.f - a_ * a_, 0.f)) * (ig * xc[n][r]); }
            float Ar[4], Hr[4], hst[4];
#pragma unroll
            for (int g = 0; g < 4; ++g) { Ar[g] = (av[4 * g] * av[4 * g + 1]) * (av[4 * g + 2] * av[4 * g + 3]);
                Hr[g] = ((uv[4 * g] * av[4 * g + 1] + uv[4 * g + 1]) * av[4 * g + 2] + uv[4 * g + 2]) * av[4 * g + 3] + uv[4 * g + 3]; }
            float hin = hc[n];
#pragma unroll
            for (int g = 0; g < 4; ++g) { float o1 = Ar[g] * hin + Hr[g]; const float x = __shfl_xor(o1, 32); const float hg = hi ? x : hin; o1 = Ar[g] * hg + Hr[g]; hst[g] = hg;
                const float y = __shfl_xor(o1, 32); hin = hi ? o1 : y;
                if (!FINAL) ap[n] *= Ar[g] * __shfl_xor(Ar[g], 32); }
            hc[n] = hin;
            if (FINAL) {
#pragma unroll
                for (int g = 0; g < 4; ++g) { float h = hst[g];
#pragma unroll
                    for (int e = 0; e < 4; ++e) { const int r = 4 * g + e; h = av[r] * h + uv[r]; yv[n][r] = h * bf2f(GS[(crow16(r) + 4 * hi) * 64 + 32 * n + j32]); } } }
        }
        if (FINAL) {
#pragma unroll
            for (int r = 0; r < 16; ++r) { float s = yv[0][r] * yv[0][r] + yv[1][r] * yv[1][r];
                s += __shfl_xor(s, 1); s += __shfl_xor(s, 2); s += __shfl_xor(s, 4); s += __shfl_xor(s, 8); s += __shfl_xor(s, 16);
                if (j32 == 0) SS[(crow16(r) + 4 * hi) * 8 + w] = s; }
            __syncthreads();
            bf16* ymix = (bf16*)(ws + WS_H);
#pragma unroll
            for (int r = 0; r < 16; ++r) { const int tk = crow16(r) + 4 * hi; const f32x4 s0 = *(const LAS f32x4*)(SS + tk * 8), s1 = *(const LAS f32x4*)(SS + tk * 8 + 4);
                const float rstd = rsqrtf(((s0[0] + s0[1]) + (s0[2] + s0[3]) + (s1[0] + s1[1]) + (s1[2] + s1[3])) * (1.f / LW) + RMS_EPS);
                bf16* yp = ymix + (tb + tk) * DMODEL + 64 * w + k32;
                yp[0] = (bf16)f2bf(yv[0][r] * rstd); yp[32] = (bf16)f2bf(yv[1][r] * rstd); }
            __syncthreads();
        }
    }
#undef LRU_FETCH
    if (!FINAL) { if (hi == 0) { float* cp = carry + ((size_t)(b * NTILE + jt) * 2) * LW + 64 * w + j32;
#pragma unroll
        for (int n = 0; n < 2; ++n) { cp[32 * n] = ap[n]; cp[LW + 32 * n] = hc[n]; } } }
    else {
        const bf16* ob = (const bf16*)(ws + WS_O); bf16* ymix = (bf16*)(ws + WS_H);
        for (int i0 = 0; i0 < 16; i0 += 4) {
            v4u vv[4];
#pragma unroll
            for (int i = 0; i < 4; ++i) vv[i] = *(const GAS v4u*)(ob + (trow0 + 16 * w + i0 + i) * AW + 8 * lane);
            float ssq[4];
#pragma unroll
            for (int i = 0; i < 4; ++i) { float s = 0.f;
#pragma unroll
                for (int c = 0; c < 4; ++c) { const float lo = __uint_as_float(vv[i][c] << 16), hi2 = __uint_as_float(vv[i][c] & 0xffff0000u); s += lo * lo + hi2 * hi2; }
                ssq[i] = s; }
#pragma unroll
            for (int o = 1; o < 64; o <<= 1) {
#pragma unroll
                for (int i = 0; i < 4; ++i) ssq[i] += __shfl_xor(ssq[i], o); }
#pragma unroll
            for (int i = 0; i < 4; ++i) { const float rstd = rsqrtf(ssq[i] * (1.f / AW) + RMS_EPS); v4u o;
#pragma unroll
                for (int c = 0; c < 4; ++c) o[c] = pk2(__uint_as_float(vv[i][c] << 16) * rstd, __uint_as_float(vv[i][c] & 0xffff0000u) * rstd);
                *(GAS v4u*)(ymix + (trow0 + 16 * w + i0 + i) * DMODEL + LW + 8 * lane) = o; } }
    }
}
__device__ __forceinline__ void norm_pass(Frame& F, const Args& a) {
    unsigned char* ws = a.ws; float* nrm = (float*)(ws + WS_NRM);
    const int gw = F.vcu * NWAVES + F.wave, NGW = F.G * NWAVES, lane = F.lane;
    for (int it = gw; it < 2 * BATCH * (SEQ / 64); it += NGW) {
        const int which = it / (BATCH * (SEQ / 64)), r = it % (BATCH * (SEQ / 64)), b = r / (SEQ / 64), t = r % (SEQ / 64);
        const bf16* src = (const bf16*)(ws + (which ? WS_K : WS_Q)) + ((size_t)b * SEQ + 64 * t) * AW + 8 * lane;
        float mx = 0.f;
#pragma unroll 8
        for (int i = 0; i < 64; ++i) { const v4u v = *(const GAS v4u*)(src + (size_t)i * AW); float s = 0.f;
#pragma unroll
            for (int c = 0; c < 4; ++c) { const float lo = __uint_as_float(v[c] << 16), hi = __uint_as_float(v[c] & 0xffff0000u); s += lo * lo + hi * hi; }
            s += __shfl_xor(s, 1); s += __shfl_xor(s, 2); s += __shfl_xor(s, 4); mx = fmaxf(mx, s); }
        if ((lane & 7) == 0) nrm[which * 4096 + (b * NHEADS + (lane >> 3)) * 128 + t] = sqrtf(mx) * 1.0001f;
    }
}
__device__ __forceinline__ void carry_prefix(Frame& F, const Args& a, int b) {
    const float* carry = (const float*)(a.ws + WS_CARRY) + (size_t)b * NTILE * 2 * LW + F.tid; float* cin = (float*)(a.ws + WS_CIN) + (size_t)b * NTILE * LW + F.tid;
    float c = 0.f;
    for (int j0 = 0; j0 < NTILE; j0 += 8) { float A[8], H[8];
#pragma unroll
        for (int j = 0; j < 8; ++j) { A[j] = carry[(size_t)(j0 + j) * 2 * LW]; H[j] = carry[(size_t)(j0 + j) * 2 * LW + LW]; }
#pragma unroll
        for (int j = 0; j < 8; ++j) { cin[(size_t)(j0 + j) * LW] = c; c = A[j] * c + H[j]; } }
}
template <bool FINAL> __device__ __forceinline__ void lru_phase(Frame& F, const Args& a) {
    for (int tile = F.vcu; tile < BATCH * NTILE; tile += F.G) { lru_tile<FINAL>(F, a, tile); __syncthreads(); }
}
}
__global__ void __launch_bounds__(NWAVES * 64, 2) mk_fwd(Args args) {
    extern __shared__ __attribute__((aligned(16))) unsigned char lds[];
    Frame F;
    F.lds = (LAS unsigned char*)lds;
    F.MISC = (volatile LAS unsigned*)(F.lds + MISC_OFF);
    F.wave = __builtin_amdgcn_readfirstlane((int)threadIdx.x >> 6); F.lane = (int)__builtin_amdgcn_mbcnt_hi(~0u, __builtin_amdgcn_mbcnt_lo(~0u, 0u)); F.tid = F.wave * 64 + F.lane;
    F.G = gridDim.x; { const int bx = blockIdx.x; F.vcu = (F.G % 8 == 0) ? (bx % 8) * (F.G / 8) + bx / 8 : bx; }
    unsigned char* ws = args.ws;
    F.ctl = (gu32*)(ws + WS_CTL);
    for (int u = F.tid; u < (LDS_BYTES - LDSCTL_OFF) / 4; u += NWAVES * 64) ((LAS unsigned*)(F.lds + LDSCTL_OFF))[u] = 0u;
    __syncthreads();
    XcdBarrier bar = xcd_barrier_post((unsigned*)(F.ctl + CW_BAR) + args.li * XCD_BAR_WORDS, F.MISC + 8, F.wave);
    const int lo = args.ph_lo, hi = args.ph_hi;
#define IN(k) (lo <= (k) && (k) < hi)
#define BOTH(k) (IN(k) && IN((k) + 1))
#define GRID_BAR() xcd_barrier(bar)

    if (IN(0)) { p0_prologue(F, args); if (BOTH(0)) GRID_BAR(); }

    if (IN(1)) {
        if (F.vcu < BATCH * NHEADS) fcum_unit(F, F.vcu, (const float*)(ws + WS_LOGF), (float*)(ws + WS_FCUM));
        pg8::Gemm g{(const pg8::bf16_t*)(ws + WS_H), (const pg8::bf16_t*)(ws + WS_WIN), T, NG1, DMODEL}; pg8::StaticOrder S; S.init(T, NG1, F.G, (int)blockIdx.x);
        pg8::EpiG1 E{(pg8::bf16_t*)(ws + WS_XR), SPLIT_STRIDE, QSCALE};
        pg8::gemm_phase<pg8::EpiG1, pg8::StaticOrder, true, true>(F.lds + RING_OFF, g, S, E, F.wave);
        if (BOTH(1)) GRID_BAR();
    }
    if (IN(2)) { lru::lru_phase<false>(F, args); lru::norm_pass(F, args); if (BOTH(2)) GRID_BAR(); }
    if (IN(3)) {
        static_assert(attn_body::ATTN_LDS_BYTES <= RING_BYTES, "attention LDS vs frame");
        if (F.vcu < BATCH) lru::carry_prefix(F, args, F.vcu);
        const attn_body::AttnTensors AT{(const attn_body::bf16*)(ws + WS_Q), (const attn_body::bf16*)(ws + WS_K), (const attn_body::bf16*)(ws + WS_V), (attn_body::bf16*)(ws + WS_O), (const float*)(ws + WS_FCUM), (const float*)(ws + WS_NRM)};
        attn_body::attn_phase<8>((char*)lds + RING_OFF, AT, (unsigned*)(F.ctl + CW_ATTQ), F.MISC + 24, F.wave);
        if (BOTH(3)) GRID_BAR();
    }
    if (IN(4)) { lru::lru_phase<true>(F, args); if (BOTH(4)) GRID_BAR(); }
    if (IN(5)) {
        pg8::Gemm g{(const pg8::bf16_t*)(ws + WS_H), (const pg8::bf16_t*)(ws + WS_WOUT), T, DMODEL, DMODEL}; pg8::StaticOrder S; S.init(T, DMODEL, F.G, (int)blockIdx.x);
        pg8::EpiG2 E{args.in[0], args.out, (pg8::bf16_t*)(ws + WS_X1B), (float*)(ws + WS_SUMSQ), DMODEL};
        pg8::gemm_phase<pg8::EpiG2, pg8::StaticOrder, true, true>(F.lds + RING_OFF, g, S, E, F.wave);
        if (BOTH(5)) GRID_BAR();
    }
    if (IN(6)) {
        pg8::Gemm g{(const pg8::bf16_t*)(ws + WS_X1B), (const pg8::bf16_t*)(ws + WS_WQ), T, QPW, DMODEL}; pg8::StaticOrder S; S.init(T, QPW, F.G, (int)blockIdx.x);
        pg8::EpiG3 E{(pg8::bf16_t*)(ws + WS_QP), QPW};
        pg8::gemm_phase<pg8::EpiG3, pg8::StaticOrder, true, true>(F.lds + RING_OFF, g, S, E, F.wave);
        if (BOTH(6)) GRID_BAR();
    }
    if (IN(7)) { peer::peer_phase(F, args); }
#undef IN
#undef BOTH
#undef GRID_BAR
}

extern "C" void kernel_launch(void* const* d_in, const int* in_sizes, int n_in, void* d_out, int out_size, void* d_ws, size_t ws_size, hipStream_t stream) {
    static int grid = 0;
    if (grid == 0) {
        if (n_in != 20 || in_sizes[0] != T * DMODEL || out_size != T * DMODEL || ws_size < WS_END) { fprintf(stderr, "kernel_launch: unexpected shapes (n_in %d, ws %zu)\n", n_in, ws_size); grid = -1; return; }
        int dev = 0, cus = 0;
        if (hipGetDevice(&dev) != hipSuccess || hipDeviceGetAttribute(&cus, hipDeviceAttributeMultiprocessorCount, dev) != hipSuccess) { grid = -1; return; }
        if (hipFuncSetAttribute((const void*)mk_fwd, hipFuncAttributeMaxDynamicSharedMemorySize, LDS_BYTES) != hipSuccess) { fprintf(stderr, "kernel_launch: hipFuncSetAttribute failed\n"); grid = -1; return; }
        (void)hipGetLastError();
        grid = cus;
    }
    if (grid < 0) return;
    if (hipMemsetAsync((char*)d_ws + WS_CTL, 0, CTL_ZERO_BYTES, stream) != hipSuccess) return;
    Args a{};
    for (int i = 0; i < 20; ++i) a.in[i] = (const float*)d_in[i];
    a.out = (float*)d_out; a.ws = (unsigned char*)d_ws; a.ph_lo = 0; a.ph_hi = N_PHASES; a.li = 0;
    hipLaunchKernelGGL(mk_fwd, dim3(grid), dim3(NWAVES * 64), LDS_BYTES, stream, a);
}
```

```cpp
#include <hip/hip_runtime.h>
#include <hip/hip_bf16.h>
#include <cstdio>
#include <cstdint>
#include <cmath>

constexpr int BATCH = 4, SEQ = 8192, DMODEL = 1024, T = BATCH * SEQ;
constexpr int LW = 512, AW = 512, NHEADS = 8, HD = 64, INC = 2568, NG1 = 2560;
constexpr int PH = 8, NKEY = 128, PHALF = 128, TOPK = 16, NEXP = NKEY * NKEY, QPW = 2048;
constexpr float RMS_EPS = 1e-6f;
constexpr float LOG2E = 1.4426950408889634f;
constexpr float QSCALE = 0.125f * LOG2E;
constexpr size_t MiB = 1u << 20;
constexpr size_t WS_CTL = 0, CTL_ZERO_BYTES = 1 * MiB;
constexpr size_t WS_WIN = 2 * MiB, WS_WOUT = 8 * MiB, WS_WQ = 10 * MiB, WS_SKB = 14 * MiB, WS_WFL = 15 * MiB,
                 WS_LOGF = 16 * MiB, WS_FCUM = 17 * MiB, WS_CARRY = 18 * MiB, WS_SUMSQ = 19 * MiB, WS_WAX = 20 * MiB, WS_CIN = 23 * MiB  , WS_NRM = 22 * MiB  ,
                 WS_H = 32 * MiB, WS_XR = 96 * MiB, WS_GR = 128 * MiB, WS_Q = 160 * MiB, WS_K = 192 * MiB, WS_V = 224 * MiB,
                 WS_X1B = 256 * MiB, WS_O = 256 * MiB  , WS_QP = 96 * MiB, WS_UT = 320 * MiB, WS_VT = 352 * MiB, WS_U8 = 320 * MiB, WS_V8 = 336 * MiB, WS_SU = 21 * MiB, WS_SV = 21 * MiB + 65536, WS_LA = 384 * MiB, WS_LU = 448 * MiB, WS_END = 512 * MiB;
constexpr size_t SPLIT_STRIDE = (WS_GR - WS_XR) / 2;
constexpr int CW_TMO = 0, CW_ATTQ = 2048, CW_BAR = 4096;

namespace pg8 {
#define PG8_LAS __attribute__((address_space(3)))
typedef unsigned short bf16_t;
typedef short bf16x8 __attribute__((ext_vector_type(8)));
typedef float f32x4 __attribute__((ext_vector_type(4)));
typedef unsigned u32x4 __attribute__((ext_vector_type(4)));
constexpr int BM = 256, BK = 64, HALF = 128, HTB = HALF * BK * 2  , STAGE_BYTES = 8 * HTB, NXCD = 8, WGM = 8;

__host__ __device__ __forceinline__ int lds_byte(int r, int c) { const int st = (r >> 4) * 2 + (c >> 5), rr = r & 15, cc = c & 31, ob = rr * 64 + cc * 2; return st * 1024 + (ob ^ (((ob >> 9) & 1) << 5)); }
__host__ __device__ __forceinline__ void stage_rc(int b, int& R, int& C) { const int st = b / 1024, sb = b % 1024, swz = sb ^ (((sb >> 9) & 1) << 5); R = (st >> 1) * 16 + swz / 64; C = (st & 1) * 32 + (swz % 64) / 2; }
__host__ __device__ __forceinline__ int perm32(int rho) { const int n = rho >> 4, i = rho & 15; return 8 * (i >> 2) + 4 * n + (i & 3); }

struct Unit { int pm, pn; };
struct Gemm { const bf16_t* A; const bf16_t* Bt; int M, N, K; };

struct StaticOrder {
    int nM, nN, nwg, G, c;
    __host__ __device__ void init(int M, int N, int G_, int c_) { nM = M / BM; nN = N / BM; nwg = nM * nN; G = G_; c = c_; }
    __host__ __device__ bool next(int i, Unit& u) const {
        const long L = (long)i * G + c; if (L >= nwg) return false;
        int wgid = (int)L; { const int q = nwg / NXCD, r = nwg % NXCD, xcd = wgid % NXCD, off = wgid / NXCD; wgid = (xcd < r ? xcd * (q + 1) : r * (q + 1) + (xcd - r) * q) + off; }
        const int nig = WGM * nN, gid = wgid / nig, fm = gid * WGM, gsz = (nM - fm) < WGM ? (nM - fm) : WGM;
        u.pm = fm + ((wgid % nig) % gsz); u.pn = (wgid % nig) / gsz; return true;
    }
    __device__ __forceinline__ void a_ready(const Unit&) const {}
    __device__ __forceinline__ void done(const Unit&) const {}
};

__device__ __forceinline__ unsigned cvt_pk_bf16(float lo, float hi) { unsigned r; asm volatile("v_cvt_pk_bf16_f32 %0, %1, %2" : "=v"(r) : "v"(lo), "v"(hi)); return r; }
typedef unsigned u32x2 __attribute__((ext_vector_type(2)));
__device__ __forceinline__ float gelu_fast(float x) {
    const float u2 = x * (1.5957691216057308f + 0.07135481627f * x * x);
    return x * __builtin_amdgcn_rcpf(1.f + __builtin_amdgcn_exp2f(-1.4426950408889634f * u2));
}
struct EpiG1 {
    static constexpr bool PERM = true, AFTER_DRAIN = false;
    bf16_t* base0; size_t split_stride; float qscale;
    __device__ __forceinline__ void operator()(const f32x4 (&acc)[2][2][4][2], const Unit& u, int wr, int wc, int fr, int fq) const {
        const int s = u.pn >> 1; bf16_t* base = base0 + (size_t)s * split_stride;
        const int row0 = u.pm * BM + wr * 64 + fr, col0 = (u.pn & 1) * 256 + wc * 32 + 8 * fq;
#pragma unroll
        for (int ai = 0; ai < 2; ++ai)
#pragma unroll
            for (int m = 0; m < 4; ++m) { bf16_t* rowp = base + (size_t)(row0 + ai * HALF + m * 16) * 512 + col0;
#pragma unroll
                for (int bj = 0; bj < 2; ++bj) { f32x4 v0 = acc[ai][bj][m][0], v1 = acc[ai][bj][m][1];
                    if (s == 1) {
#pragma unroll
                        for (int e = 0; e < 4; ++e) { v0[e] = gelu_fast(v0[e]); v1[e] = gelu_fast(v1[e]); } }
                    else if (s == 2) { v0 = v0 * qscale; v1 = v1 * qscale; }
                    u32x4 w; w.x = cvt_pk_bf16(v0[0], v0[1]); w.y = cvt_pk_bf16(v0[2], v0[3]); w.z = cvt_pk_bf16(v1[0], v1[1]); w.w = cvt_pk_bf16(v1[2], v1[3]);
                    *(u32x4*)(rowp + bj * HALF) = w; } }
    }
};
struct EpiG2 {
    static constexpr bool PERM = false, AFTER_DRAIN = false;
    const float* resid; float* out; bf16_t* xb; float* sumsq; int ldc;
    __device__ __forceinline__ void operator()(const f32x4 (&acc)[2][2][4][2], const Unit& u, int wr, int wc, int fr, int fq) const {
        const int row0 = u.pm * BM + wr * 64 + fr, col0 = u.pn * BM + wc * 32 + 4 * fq;
#pragma unroll
        for (int ai = 0; ai < 2; ++ai) {
            f32x4 rs[4][2][2];
#pragma unroll
            for (int m = 0; m < 4; ++m) { const size_t off = (size_t)(row0 + ai * HALF + m * 16) * ldc + col0;
#pragma unroll
                for (int bj = 0; bj < 2; ++bj)
#pragma unroll
                    for (int n = 0; n < 2; ++n) rs[m][bj][n] = *(const f32x4*)(resid + off + bj * HALF + n * 16); }
#pragma unroll
            for (int m = 0; m < 4; ++m) { const int r = row0 + ai * HALF + m * 16; const size_t off = (size_t)r * ldc + col0; float ss = 0.f;
#pragma unroll
                for (int bj = 0; bj < 2; ++bj)
#pragma unroll
                    for (int n = 0; n < 2; ++n) { const f32x4 x = rs[m][bj][n] + acc[ai][bj][m][n];
                        *(f32x4*)(out + off + bj * HALF + n * 16) = x; ss += (x[0] * x[0] + x[1] * x[1]) + (x[2] * x[2] + x[3] * x[3]);
                        u32x2 w; w.x = cvt_pk_bf16(x[0], x[1]); w.y = cvt_pk_bf16(x[2], x[3]); *(u32x2*)(xb + off + bj * HALF + n * 16) = w; }
                ss += __shfl_xor(ss, 16); ss += __shfl_xor(ss, 32);
                if (fq == 0) atomicAdd(sumsq + r, ss); }
            asm volatile("" ::: "memory"); }
    }
};
struct EpiG3 {
    static constexpr bool PERM = true, AFTER_DRAIN = false;
    bf16_t* O; int ldc;
    __device__ __forceinline__ void operator()(const f32x4 (&acc)[2][2][4][2], const Unit& u, int wr, int wc, int fr, int fq) const {
        const int row0 = u.pm * BM + wr * 64 + fr;
#pragma unroll
        for (int ai = 0; ai < 2; ++ai)
#pragma unroll
            for (int m = 0; m < 4; ++m) { const int t = row0 + ai * HALF + m * 16;
#pragma unroll
                for (int bj = 0; bj < 2; ++bj) { const f32x4 v0 = acc[ai][bj][m][0], v1 = acc[ai][bj][m][1];
                    u32x4 w; w.x = cvt_pk_bf16(v0[0], v0[1]); w.y = cvt_pk_bf16(v0[2], v0[3]); w.z = cvt_pk_bf16(v1[0], v1[1]); w.w = cvt_pk_bf16(v1[2], v1[3]);
                    *(u32x4*)(O + ((size_t)(((((t >> 5) * 8 + u.pn) * 2 + bj) * 16 + 4 * wc + fq) * 32 + (t & 31))) * 8) = w; } }
    }
};

template <class Epi, class Sched, bool ALIGN_EPI = false, bool SP2 = false>
__device__ __forceinline__ void gemm_phase(PG8_LAS unsigned char* lds, const Gemm g, const Sched& S, const Epi& E, int wid_in) {
    const int wid = __builtin_amdgcn_readfirstlane(wid_in), lane = (int)__builtin_amdgcn_mbcnt_hi(~0u, __builtin_amdgcn_mbcnt_lo(~0u, 0u)), tid = wid * 64 + lane, wr = wid >> 2, wc = wid & 3, fr = lane & 15, fq = lane >> 4;
    const int K = g.K, nt = K / BK;
    unsigned voffA[2], voffB[2];
#pragma unroll
    for (int i = 0; i < 2; ++i) { int R, C; stage_rc(tid * 16 + i * 8192, R, C); const int Rb = Epi::PERM ? ((R & ~31) + perm32(R & 31)) : R;
        voffA[i] = (unsigned)(R * K + C) * 2u; voffB[i] = (unsigned)(Rb * K + C) * 2u; }
    const size_t kstep = (size_t)(BK * 2);
    const size_t hstep = (size_t)HALF * K * 2;
    const size_t tstep = 2 * hstep;
    const unsigned ldsw = (unsigned)wid * 1024u;
    const int aoff = lds_byte(wr * 64 + fr, fq * 8), boff = lds_byte(wc * 32 + fr, fq * 8);
#define PG8_SA(b, h) (((b) * 2 + (h)) * HTB)
#define PG8_SB(b, h) ((4 + (b) * 2 + (h)) * HTB)
#define PG8_STAGE(bufoff, gbase, voff) do { _Pragma("unroll") for (int _i = 0; _i < 2; ++_i) \
        __builtin_amdgcn_global_load_lds((const unsigned*)((const char*)(gbase) + (voff)[_i]), (PG8_LAS unsigned*)(lds + (bufoff) + ldsw + _i * 8192), 16, 0, 0); } while (0)
#define PG8_LDA(dst, b, h) do { _Pragma("unroll") for (int m = 0; m < 4; ++m) _Pragma("unroll") for (int k = 0; k < 2; ++k) dst[m][k] = *(const PG8_LAS bf16x8*)(lds + PG8_SA(b, h) + aoff + m * 2048 + k * 1024); } while (0)
#define PG8_LDB(dst, b, h) do { _Pragma("unroll") for (int n = 0; n < 2; ++n) _Pragma("unroll") for (int k = 0; k < 2; ++k) dst[n][k] = *(const PG8_LAS bf16x8*)(lds + PG8_SB(b, h) + boff + n * 2048 + k * 1024); } while (0)
#define PG8_MMA(ai, bj, At, Bt) do { __builtin_amdgcn_s_setprio(1); _Pragma("unroll") for (int m = 0; m < 4; ++m) _Pragma("unroll") for (int n = 0; n < 2; ++n) _Pragma("unroll") for (int k = 0; k < 2; ++k) \
        acc[ai][bj][m][n] = __builtin_amdgcn_mfma_f32_16x16x32_bf16(Bt[n][k], At[m][k], acc[ai][bj][m][n], 0, 0, 0); __builtin_amdgcn_s_setprio(0); } while (0)
#define PG8_WAIT_V(n) asm volatile("s_waitcnt vmcnt(" #n ")" ::: "memory")
#define PG8_WAIT_L(n) asm volatile("s_waitcnt lgkmcnt(" #n ")" ::: "memory")
#define PG8_BAR __builtin_amdgcn_s_barrier()
#define PG8_SCHED __builtin_amdgcn_sched_barrier(0)
    Unit cur, nxt; int ui = 0;
    if (!S.next(0, cur)) return;
    f32x4 acc[2][2][4][2];
#pragma unroll
    for (int a = 0; a < 2; ++a)
#pragma unroll
        for (int b = 0; b < 2; ++b)
#pragma unroll
            for (int m = 0; m < 4; ++m)
#pragma unroll
                for (int n = 0; n < 2; ++n) acc[a][b][m][n] = (f32x4){0.f, 0.f, 0.f, 0.f};
    bf16x8 At[4][2], B0[2][2], B1[2][2];
    const char* cA = (const char*)g.A + (size_t)cur.pm * tstep; const char* cB = (const char*)g.Bt + (size_t)cur.pn * tstep;
    S.a_ready(cur);
    if constexpr (SP2) {
        PG8_STAGE(PG8_SB(0, 0), cB, voffB); PG8_STAGE(PG8_SB(0, 1), cB + hstep, voffB); PG8_STAGE(PG8_SA(0, 0), cA, voffA); PG8_STAGE(PG8_SA(0, 1), cA + hstep, voffA);
        if (wr == 1) PG8_BAR;
        PG8_WAIT_V(2); PG8_BAR;
        PG8_STAGE(PG8_SB(1, 0), cB + kstep, voffB); PG8_STAGE(PG8_SA(1, 0), cA + kstep, voffA); PG8_STAGE(PG8_SB(1, 1), cB + hstep + kstep, voffB);
        PG8_WAIT_V(6); PG8_BAR;
    } else {
        PG8_STAGE(PG8_SB(0, 0), cB, voffB); PG8_STAGE(PG8_SA(0, 0), cA, voffA); PG8_STAGE(PG8_SB(0, 1), cB + hstep, voffB); PG8_STAGE(PG8_SA(0, 1), cA + hstep, voffA);
        if (wr == 1) PG8_BAR;
        PG8_WAIT_V(4); PG8_BAR;
        PG8_STAGE(PG8_SB(1, 0), cB + kstep, voffB); PG8_STAGE(PG8_SA(1, 0), cA + kstep, voffA); PG8_STAGE(PG8_SB(1, 1), cB + hstep + kstep, voffB);
        PG8_WAIT_V(6); PG8_BAR;
    }
    for (;;) {
        const bool has_next = S.next(ui + 1, nxt);
        const char* nA = has_next ? (const char*)g.A + (size_t)nxt.pm * tstep : cA; const char* nB = has_next ? (const char*)g.Bt + (size_t)nxt.pn * tstep : cB;
        for (int t = 0; t < nt; t += 2) {
            const bool last = (t == nt - 2);
            const char* a1 = cA + (size_t)(t + 1) * kstep;
            const char* a2 = last ? nA : cA + (size_t)(t + 2) * kstep; const char* b2 = last ? nB : cB + (size_t)(t + 2) * kstep;
            const char* a3 = a2 + kstep; const char* b3 = b2 + kstep;
            if (last && has_next) S.a_ready(nxt);
            if constexpr (SP2) {
            PG8_LDB(B0, 0, 0); PG8_LDB(B1, 0, 1); PG8_SCHED; PG8_LDA(At, 0, 0); PG8_STAGE(PG8_SA(1, 1), a1 + hstep, voffA);
            PG8_WAIT_V(8); PG8_WAIT_L(0); PG8_BAR; PG8_MMA(0, 0, At, B0); PG8_MMA(0, 1, At, B1); PG8_BAR; PG8_SCHED;
            PG8_LDA(At, 0, 1); PG8_STAGE(PG8_SB(0, 0), b2, voffB); PG8_STAGE(PG8_SB(0, 1), b2 + hstep, voffB); PG8_STAGE(PG8_SA(0, 0), a2, voffA);
            PG8_WAIT_V(8); PG8_WAIT_L(0); PG8_BAR; PG8_MMA(1, 0, At, B0); PG8_MMA(1, 1, At, B1); PG8_BAR; PG8_SCHED;
            PG8_LDB(B0, 1, 0); PG8_LDB(B1, 1, 1); PG8_SCHED; PG8_LDA(At, 1, 0); PG8_STAGE(PG8_SA(0, 1), a2 + hstep, voffA);
            PG8_WAIT_V(8); PG8_WAIT_L(0); PG8_BAR; PG8_MMA(0, 0, At, B0); PG8_MMA(0, 1, At, B1); PG8_BAR; PG8_SCHED;
            PG8_LDA(At, 1, 1); PG8_STAGE(PG8_SB(1, 0), b3, voffB); PG8_STAGE(PG8_SB(1, 1), b3 + hstep, voffB); PG8_STAGE(PG8_SA(1, 0), a3, voffA);
            PG8_WAIT_V(8); PG8_WAIT_L(0); PG8_BAR; PG8_MMA(1, 0, At, B0); PG8_MMA(1, 1, At, B1); PG8_BAR; PG8_SCHED;
            } else {
            PG8_LDB(B0, 0, 0); PG8_SCHED; PG8_LDA(At, 0, 0); PG8_STAGE(PG8_SA(1, 1), a1 + hstep, voffA);
            PG8_WAIT_L(8); PG8_BAR; PG8_WAIT_L(0); PG8_MMA(0, 0, At, B0); PG8_BAR; PG8_SCHED;
            PG8_LDB(B1, 0, 1); PG8_STAGE(PG8_SB(0, 0), b2, voffB);
            PG8_BAR; PG8_WAIT_L(0); PG8_MMA(0, 1, At, B1); PG8_BAR;
            PG8_LDA(At, 0, 1); PG8_STAGE(PG8_SA(0, 0), a2, voffA);
            PG8_BAR; PG8_WAIT_L(0); PG8_MMA(1, 0, At, B0); PG8_BAR; PG8_SCHED;
            PG8_STAGE(PG8_SB(0, 1), b2 + hstep, voffB);
            PG8_WAIT_V(6); PG8_BAR; PG8_MMA(1, 1, At, B1); PG8_BAR;
            PG8_LDB(B0, 1, 0); PG8_SCHED; PG8_LDA(At, 1, 0); PG8_STAGE(PG8_SA(0, 1), a2 + hstep, voffA);
            PG8_WAIT_L(8); PG8_BAR; PG8_WAIT_L(0); PG8_MMA(0, 0, At, B0); PG8_BAR; PG8_SCHED;
            PG8_LDB(B1, 1, 1); PG8_STAGE(PG8_SB(1, 0), b3, voffB);
            PG8_BAR; PG8_WAIT_L(0); PG8_MMA(0, 1, At, B1); PG8_BAR;
            PG8_LDA(At, 1, 1); PG8_STAGE(PG8_SA(1, 0), a3, voffA);
            PG8_BAR; PG8_WAIT_L(0); PG8_MMA(1, 0, At, B0); PG8_BAR; PG8_SCHED;
            PG8_STAGE(PG8_SB(1, 1), b3 + hstep, voffB);
            PG8_WAIT_V(6); PG8_BAR; PG8_MMA(1, 1, At, B1); PG8_BAR;
            }
        }
        if constexpr (ALIGN_EPI) { if (wr == 0) PG8_BAR; }
        if constexpr (!Epi::AFTER_DRAIN) { E(acc, cur, wr, wc, fr, fq); S.done(cur); }
        if (!has_next) break;
#pragma unroll
        for (int a = 0; a < 2; ++a)
#pragma unroll
            for (int b = 0; b < 2; ++b)
#pragma unroll
                for (int m = 0; m < 4; ++m)
#pragma unroll
                    for (int n = 0; n < 2; ++n) acc[a][b][m][n] = (f32x4){0.f, 0.f, 0.f, 0.f};
        cur = nxt; cA = nA; cB = nB; ++ui;
        if constexpr (ALIGN_EPI) { if (wr == 1) PG8_BAR; }
    }
    PG8_WAIT_V(0);
    if constexpr (!ALIGN_EPI) { if (wr == 0) PG8_BAR; }
    PG8_BAR;
    if constexpr (Epi::AFTER_DRAIN) { E.fused(acc, cur, wr, wc, fr, fq, lds, wid, lane); S.done(cur); }
#undef PG8_SA
#undef PG8_SB
#undef PG8_STAGE
#undef PG8_LDA
#undef PG8_LDB
#undef PG8_MMA
#undef PG8_WAIT_V
#undef PG8_WAIT_L
#undef PG8_BAR
#undef PG8_SCHED
}
}
#include <hip/hip_bf16.h>
#include <cmath>
namespace attn_body {
using bf16=__hip_bfloat16;
using bf16x8=__attribute__((ext_vector_type(8)))short;
using s16x4=__attribute__((ext_vector_type(4)))short;
using f32x16=__attribute__((ext_vector_type(16)))float;
using u32x4=__attribute__((ext_vector_type(4)))unsigned;
constexpr int BATCH=4,NHEAD=8,SEQ=8192,D=64,DM=NHEAD*D;
constexpr int NW=8,QBLK=32,QB=QBLK*NW,KVBLK=64,NQB=SEQ/QB;
constexpr int ATTN_PITCH=DM, ATTN_UNIT_ROWS=QB;
__device__ __forceinline__ int crow(int r,int hi){return (r&3)+8*(r>>2)+4*hi;}
#define SBAR() __builtin_amdgcn_sched_barrier(0)
__device__ __forceinline__ void cmask(f32x16&p0,f32x16&p1,int jb,int qrel,int hi){
  const float NEG=-INFINITY; int kb=64*jb+4*hi;
  #pragma unroll
  for(int r=0;r<16;++r){int kv=kb+(r&3)+8*(r>>2); if(kv>qrel)p0[r]=NEG; if(kv+32>qrel)p1[r]=NEG;}
}

constexpr int NSLOT=3, SLOTB=8192;
constexpr int LDS_K=0, LDS_V=NSLOT*SLOTB, LDS_WS=2*NSLOT*SLOTB, LDS_OST=LDS_WS+NW*64*4, LDS_FK=LDS_OST+NW*4096, LDS_BYTES=LDS_FK+SEQ*4;
constexpr float C2=0.125f*1.4426950408889634f;
__device__ __forceinline__ void glds16(const void*gsrc,unsigned lds_dst){unsigned keep;
  asm volatile("s_mov_b32 %0, m0\n\ts_mov_b32 m0, %2\n\ts_nop 0\n\tglobal_load_lds_dwordx4 %1, off\n\ts_mov_b32 m0, %0":"=&s"(keep):"v"(gsrc),"s"(lds_dst):"memory");}
__device__ __forceinline__ float max3f(float a,float b,float c){float r;asm("v_max3_f32 %0, %1, %2, %3":"=v"(r):"v"(a),"v"(b),"v"(c));return r;}
__device__ __forceinline__ float max2f(float a,float b){float r;asm("v_max_f32_e32 %0, %1, %2":"=v"(r):"v"(a),"v"(b));return r;}
__device__ __forceinline__ float fadd_s(float a,float b){float r;asm("v_add_f32_e32 %0, %1, %2":"=v"(r):"v"(a),"v"(b));return r;}
__device__ __forceinline__ float fsub_s(float a,float b){float r;asm("v_sub_f32_e32 %0, %1, %2":"=v"(r):"v"(a),"v"(b));return r;}
typedef float f32x2_t __attribute__((ext_vector_type(2))); typedef __bf16 bf16x2_t __attribute__((ext_vector_type(2)));
__device__ __forceinline__ unsigned cvtpk_s(float lo,float hi){f32x2_t v={lo,hi};bf16x2_t b=__builtin_convertvector(v,bf16x2_t);return __builtin_bit_cast(unsigned,b);}
#define WAIT_BAR(N) asm volatile("s_waitcnt vmcnt(" #N ") lgkmcnt(0)\n\ts_barrier":::"memory")

__device__ __forceinline__ void qkt(f32x16&p0,f32x16&p1,const char*Kslot,const bf16x8*qr,int r32,int hi){
  const char*kb=Kslot+hi*1024+r32*16;
  #pragma unroll
  for(int d0=0;d0<4;++d0){
    const bf16x8 b0=*reinterpret_cast<const bf16x8*>(kb+d0*2048);
    const bf16x8 b1=*reinterpret_cast<const bf16x8*>(kb+d0*2048+512);
    p0=__builtin_amdgcn_mfma_f32_32x32x16_bf16(b0,qr[d0],p0,0,0,0);p1=__builtin_amdgcn_mfma_f32_32x32x16_bf16(b1,qr[d0],p1,0,0,0);}
}
typedef __attribute__((address_space(3))) const char* lds_cptr;
typedef short v4i16_t __attribute__((ext_vector_type(4)));
__device__ __forceinline__ void kload8(bf16x8*kf,lds_cptr kp){
  kf[0]=*(const __attribute__((address_space(3))) bf16x8*)(kp);      kf[1]=*(const __attribute__((address_space(3))) bf16x8*)(kp+512);
  kf[2]=*(const __attribute__((address_space(3))) bf16x8*)(kp+2048); kf[3]=*(const __attribute__((address_space(3))) bf16x8*)(kp+2560);
  kf[4]=*(const __attribute__((address_space(3))) bf16x8*)(kp+4096); kf[5]=*(const __attribute__((address_space(3))) bf16x8*)(kp+4608);
  kf[6]=*(const __attribute__((address_space(3))) bf16x8*)(kp+6144); kf[7]=*(const __attribute__((address_space(3))) bf16x8*)(kp+6656);
}
__device__ __forceinline__ void kload2(bf16x8*kf,lds_cptr kp,int j){ kf[2*j]=*(const __attribute__((address_space(3))) bf16x8*)(kp+j*2048); kf[2*j+1]=*(const __attribute__((address_space(3))) bf16x8*)(kp+j*2048+512); }
__device__ __forceinline__ s16x4 vtr(lds_cptr p){ return __builtin_bit_cast(s16x4,__builtin_amdgcn_ds_read_tr16_b64_v4i16((__attribute__((address_space(3))) v4i16_t*)p)); }
__device__ __forceinline__ float rowmax(const f32x16&p0,const f32x16&p1){
  float a=max3f(p0[0],p0[1],p1[0]),b=max3f(p0[2],p0[3],p1[1]);a=max3f(a,p1[2],p1[3]);
  #pragma unroll
  for(int r=4;r<16;r+=4){a=max3f(a,p0[r],p0[r+1]);b=max3f(b,p0[r+2],p0[r+3]);a=max3f(a,p1[r],p1[r+1]);b=max3f(b,p1[r+2],p1[r+3]);}
  const float m=max2f(a,b);
  auto rr=__builtin_amdgcn_permlane32_swap(__float_as_uint(m),__float_as_uint(m),false,false);
  return max2f(__uint_as_float(rr[0]),__uint_as_float(rr[1]));
}
__device__ __forceinline__ void pv(f32x16*o,int vb,bf16x8 pa0,bf16x8 pa1,bf16x8 pa2,bf16x8 pa3){
  #pragma unroll
  for(int d0=0;d0<2;++d0){s16x4 lo[4],hi[4];
    #pragma unroll
    for(int ks=0;ks<4;++ks){
      asm volatile("ds_read_b64_tr_b16 %0,%1 offset:%c2":"=&v"(lo[ks]):"v"(vb),"i"(d0*4096+ks*1024):"memory");
      asm volatile("ds_read_b64_tr_b16 %0,%1 offset:%c2":"=&v"(hi[ks]):"v"(vb),"i"(d0*4096+ks*1024+512):"memory");}
    asm volatile("s_waitcnt lgkmcnt(0)":::"memory");SBAR();
    #define PK(k) (bf16x8){lo[k][0],lo[k][1],lo[k][2],lo[k][3],hi[k][0],hi[k][1],hi[k][2],hi[k][3]}
    o[d0]=__builtin_amdgcn_mfma_f32_32x32x16_bf16(pa0,PK(0),o[d0],0,0,0);
    o[d0]=__builtin_amdgcn_mfma_f32_32x32x16_bf16(pa1,PK(1),o[d0],0,0,0);
    o[d0]=__builtin_amdgcn_mfma_f32_32x32x16_bf16(pa2,PK(2),o[d0],0,0,0);
    o[d0]=__builtin_amdgcn_mfma_f32_32x32x16_bf16(pa3,PK(3),o[d0],0,0,0);
    #undef PK
  }
}

#ifndef ATTN_STORE16
#define ATTN_STORE16(p,v) (*(u32x4*)(p)=(v))
#endif
template<int THRL> __device__ __forceinline__ void attn_unit(int b,int h,int qb,const bf16*Q,const bf16*__restrict__ K,const bf16*__restrict__ V,bf16*O,const float*__restrict__ Fc,const float*__restrict__ NRM,char*shm,int wid_in){
  const int wid=__builtin_amdgcn_readfirstlane(wid_in); int lane_=(int)__builtin_amdgcn_mbcnt_hi(~0u,__builtin_amdgcn_mbcnt_lo(~0u,0u)); asm volatile("":"+v"(lane_));
  const int lane=lane_,tid=wid*64+lane,r32=lane&31,hi=lane>>5;
  const long rowbase=(long)b*SEQ; const int q0=qb*QB;
  const float*Fbh=Fc+(long)(b*NHEAD+h)*SEQ;
  const int NTF=(q0+QB)/KVBLK; int t_start;
  { const float*QNb=NRM+(b*NHEAD+h)*128,*KNb=NRM+4096+(b*NHEAD+h)*128;
    const float qn=fmaxf(fmaxf(QNb[4*qb],QNb[4*qb+1]),fmaxf(QNb[4*qb+2],QNb[4*qb+3])),knb=fmaxf(fmaxf(KNb[4*qb],KNb[4*qb+1]),fmaxf(KNb[4*qb+2],KNb[4*qb+3]));
    const float fq0=Fbh[q0]*1.4426950408889634f; bool k0=true,k1=true;
    if(lane<NTF-4)k0=!(qn*(KNb[lane]+knb)+(fq0-Fbh[64*lane+63]*1.4426950408889634f)<-40.f);
    if(lane+64<NTF-4)k1=!(qn*(KNb[lane+64]+knb)+(fq0-Fbh[64*(lane+64)+63]*1.4426950408889634f)<-40.f);
    const unsigned long long m0=__ballot(k0),m1=__ballot(k1);
    int tf=m0?(int)__builtin_ctzll(m0):64+(m1?(int)__builtin_ctzll(m1):64);
    tf=tf<NTF-4?tf:NTF-4; t_start=__builtin_amdgcn_readfirstlane(tf&~1); }
  { typedef float f32x4_t __attribute__((ext_vector_type(4))); __attribute__((address_space(3))) float*fk=(__attribute__((address_space(3))) float*)((__attribute__((address_space(3))) char*)shm+LDS_FK); const int n4=(q0+QB)/4;
    for(int i=16*t_start+tid;i<n4;i+=NW*64){ f32x4_t v=*(const f32x4_t*)(Fbh+4*i); v=v*(-1.4426950408889634f); *(__attribute__((address_space(3))) f32x4_t*)(fk+4*i)=v; } }
  float fq2=Fbh[q0+wid*QBLK+r32]*1.4426950408889634f; asm volatile("":"+v"(fq2));
  const bf16*Qw=Q+(rowbase+q0+wid*QBLK)*DM+h*D;
  const bf16*Kh=K+(rowbase+(long)t_start*KVBLK)*DM+h*D,*Vh=V+(rowbase+(long)t_start*KVBLK)*DM+h*D;
  const lds_cptr shm3=(lds_cptr)shm;
  const unsigned lds0=(unsigned)(uintptr_t)shm;
  float*wsf=(float*)(shm+LDS_WS)+wid*64;
  const bf16*ksrc=Kh+(long)lane*DM+wid*8;
  const bf16*vsrc=Vh+(long)(16*(wid&3)+(lane>>2))*DM+(wid>>2)*32+(lane&3)*8;
  const unsigned kdst=lds0+LDS_K+wid*1024, vdst=lds0+LDS_V+wid*1024;
  #define DMA_K(t,slot) glds16(ksrc+(long)(t)*KVBLK*DM,(unsigned)__builtin_amdgcn_readfirstlane(kdst+(slot)))
  #define DMA_V(t,slot) glds16(vsrc+(long)(t)*KVBLK*DM,(unsigned)__builtin_amdgcn_readfirstlane(vdst+(slot)))
  const int vb0=(int)(lds0+LDS_V)+((lane>>4)&1)*32+(lane&3)*8+(4*hi+((lane&15)>>2))*64;
  const char*Kbase=shm+LDS_K; bf16x8 kf[8];
  const lds_cptr kp0=shm3+LDS_K+hi*1024+r32*16; const lds_cptr vp0=shm3+LDS_V+((lane>>4)&1)*32+(lane&3)*8+(4*hi+((lane&15)>>2))*64;
  const int NT=NTF-t_start;
  DMA_K(0,0);DMA_V(0,0);DMA_K(1,SLOTB);
  bf16x8 qr[4];
  #pragma unroll
  for(int d0=0;d0<4;++d0)qr[d0]=*reinterpret_cast<const bf16x8*>(&Qw[(long)r32*DM+d0*16+hi*8]);
  float mhat=0.f,l_reg=0.f;f32x16 o[2];o[0]=f32x16{};o[1]=f32x16{};
  const __attribute__((address_space(3))) float*fkl=(const __attribute__((address_space(3))) float*)(shm3+LDS_FK)+64*t_start+4*hi;
  #define INITC(C0,C1,t) do{ const float nsc_=fq2-mhat; typedef float f32x4_t __attribute__((ext_vector_type(4))); const __attribute__((address_space(3))) float*kb_=fkl+64*(t); \
    _Pragma("unroll") for(int g_=0;g_<4;++g_){ const f32x4_t a_=*(const __attribute__((address_space(3))) f32x4_t*)(kb_+8*g_), b_=*(const __attribute__((address_space(3))) f32x4_t*)(kb_+32+8*g_); \
      _Pragma("unroll") for(int e_=0;e_<4;++e_){ C0[4*g_+e_]=nsc_+a_[e_]; C1[4*g_+e_]=nsc_+b_[e_]; } } }while(0)
  const int qrel=wid*QBLK+r32;
  #define CMASK(P0,P1,t) do{int jb_=(t)-(NT-4); if(jb_>=0)cmask(P0,P1,jb_,qrel,hi);}while(0)
  bool resc=false;
  #define START(P0,P1) do{ const float rm=rowmax(P0,P1); resc=false; \
    { const float dl=rm; mhat=fadd_s(mhat,dl); \
      _Pragma("unroll") for(int r=0;r<16;++r){P0[r]=fsub_s(P0[r],dl);P1[r]=fsub_s(P1[r],dl);} \
      } \
    _Pragma("unroll") for(int r=0;r<16;++r)P0[r]=__builtin_amdgcn_exp2f(P0[r]); }while(0)
  #define RESC() do{ if(resc){ asm volatile("s_waitcnt lgkmcnt(0)":::"memory"); \
      _Pragma("unroll") for(int d_=0;d_<2;++d_) _Pragma("unroll") for(int r=0;r<16;++r)o[d_][r]*=wsf[crow(r,hi)]; } }while(0)
  f32x16 pA0,pA1,pB0,pB1;
  int sl_prev=0,sl_cur=0,sl_next=SLOTB;
  #define ROT() do{sl_prev=sl_cur;sl_cur=sl_next;sl_next=(sl_next==(NSLOT-1)*SLOTB)?0:sl_next+SLOTB;}while(0)
  DMA_K(2,2*SLOTB);
  WAIT_BAR(3);
  INITC(pA0,pA1,0); qkt(pA0,pA1,Kbase,qr,r32,hi);asm volatile("s_nop 15\n\ts_nop 7":"+v"(pA0),"+v"(pA1));CMASK(pA0,pA1,0);
  START(pA0,pA1);
  _Pragma("unroll") for(int r=0;r<16;++r)pA1[r]=__builtin_amdgcn_exp2f(pA1[r]);
  WAIT_BAR(0);
  DMA_K(3,0);DMA_V(1,SLOTB);
  ROT();
  kload8(kf,kp0+sl_cur);
  WAIT_BAR(2);
  s16x4 vlo[8],vhi[8]; u32x4 pw0,pw1,pw2,pw3;
  #define PKW(P,B) cvtpk_s(P[B],P[B+1])
  #define PAF(k) __builtin_bit_cast(bf16x8,pw##k)
  #define VFR(i) (bf16x8){vlo[i][0],vlo[i][1],vlo[i][2],vlo[i][3],vhi[i][0],vhi[i][1],vhi[i][2],vhi[i][3]}
  #define PIN(x) asm volatile("":"+v"(x))
  #define MX3(a,b,c) __builtin_fmaxf(__builtin_fmaxf((a),(b)),(c))
  #define GAPA(MF,A0,A1,A2,A3,W0,W1,PW) do{ MF; sacc+=A0; sacc+=A1; sacc+=A2; sacc+=A3; PIN(sacc); W0; W1; PIN(PW); SBAR(); }while(0)
  #define EX(v) __builtin_amdgcn_exp2f(v)
  #define GAPB(MF,X,B) do{ MF; X[B]=EX(X[B]); X[B+1]=EX(X[B+1]); X[B+2]=EX(X[B+2]); X[B+3]=EX(X[B+3]); PIN(X); SBAR(); }while(0)
  #define VRD(i) do{ vlo[i]=vtr(vp_+(((i)>>2)*4096+((i)&3)*1024)); vhi[i]=vtr(vp_+(((i)>>2)*4096+((i)&3)*1024+512)); }while(0)
  #define KRD(G,j) do{ if(G){ kload2(kf,kp0+sl_next,j); SBAR(); } }while(0)
  #define STEP(C0,C1,P0,P1,t,GK,GV,GL) do{ SBAR(); INITC(C0,C1,t); PIN(C0); PIN(C1); SBAR(); \
    const lds_cptr vp_=vp0+sl_prev; \
    VRD(0); SBAR(); float sacc=(P0[0]+P0[1]); \
    GAPA(C0=__builtin_amdgcn_mfma_f32_32x32x16_bf16(kf[0],qr[0],C0,0,0,0), P0[2],P0[3],P0[4],P0[5],     pw0[0]=PKW(P0,0), pw0[1]=PKW(P0,2), pw0); \
    VRD(4); SBAR(); GAPA(C1=__builtin_amdgcn_mfma_f32_32x32x16_bf16(kf[1],qr[0],C1,0,0,0), P0[6],P0[7],P0[8],P0[9],     pw0[2]=PKW(P0,4), pw0[3]=PKW(P0,6), pw0); \
    VRD(1); SBAR(); GAPA(C0=__builtin_amdgcn_mfma_f32_32x32x16_bf16(kf[2],qr[1],C0,0,0,0),   P0[10],P0[11],P0[12],P0[13], pw1[0]=PKW(P0,8), pw1[1]=PKW(P0,10), pw1); \
    VRD(5); SBAR(); GAPA(C1=__builtin_amdgcn_mfma_f32_32x32x16_bf16(kf[3],qr[1],C1,0,0,0),   P0[14],P0[15],P1[0],P1[1],   pw1[2]=PKW(P0,12),pw1[3]=PKW(P0,14), pw1); \
    VRD(2); SBAR(); GAPA(C0=__builtin_amdgcn_mfma_f32_32x32x16_bf16(kf[4],qr[2],C0,0,0,0),   P1[2],P1[3],P1[4],P1[5],     pw2[0]=PKW(P1,0), pw2[1]=PKW(P1,2), pw2); \
    VRD(6); SBAR(); GAPA(C1=__builtin_amdgcn_mfma_f32_32x32x16_bf16(kf[5],qr[2],C1,0,0,0),   P1[6],P1[7],P1[8],P1[9],     pw2[2]=PKW(P1,4), pw2[3]=PKW(P1,6), pw2); \
    VRD(3); SBAR(); GAPA(C0=__builtin_amdgcn_mfma_f32_32x32x16_bf16(kf[6],qr[3],C0,0,0,0),   P1[10],P1[11],P1[12],P1[13], pw3[0]=PKW(P1,8), pw3[1]=PKW(P1,10), pw3); \
    VRD(7); SBAR(); GAPA(C1=__builtin_amdgcn_mfma_f32_32x32x16_bf16(kf[7],qr[3],C1,0,0,0),   P1[14],P1[15],0.f,0.f,       pw3[2]=PKW(P1,12),pw3[3]=PKW(P1,14), pw3); \
    l_reg+=sacc; \
    if(GK){DMA_K((t)+3,sl_cur);} if(GV){DMA_V((t)+1,sl_next);} \
    CMASK(C0,C1,t); \
    { float a=MX3(C0[0],C0[1],C1[0]),b=MX3(C0[2],C0[3],C1[1]); a=MX3(a,C1[2],C1[3]); \
      _Pragma("unroll") for(int r=4;r<16;r+=4){a=MX3(a,C0[r],C0[r+1]);b=MX3(b,C0[r+2],C0[r+3]);a=MX3(a,C1[r],C1[r+1]);b=MX3(b,C1[r+2],C1[r+3]);} \
      float rm=__builtin_fmaxf(a,b); { auto rr=__builtin_amdgcn_permlane32_swap(__float_as_uint(rm),__float_as_uint(rm),false,false); rm=__builtin_fmaxf(__uint_as_float(rr[0]),__uint_as_float(rr[1])); } \
      resc=false; \
      if(__builtin_expect(__any(rm>(float)THRL),0)){ const float dl=__builtin_fmaxf(rm,0.f); mhat+=dl; \
        _Pragma("unroll") for(int r=0;r<16;++r){C0[r]-=dl;C1[r]-=dl;} \
        const float f=__builtin_amdgcn_exp2f(-dl); l_reg*=f; if(hi==0)wsf[r32]=f; resc=true; } } \
    SBAR(); \
    GAPB(o[0]=__builtin_amdgcn_mfma_f32_32x32x16_bf16(PAF(0),VFR(0),o[0],0,0,0), C0,0); \
    GAPB(o[1]=__builtin_amdgcn_mfma_f32_32x32x16_bf16(PAF(0),VFR(4),o[1],0,0,0), C0,4); \
    KRD(GL,0); GAPB(o[0]=__builtin_amdgcn_mfma_f32_32x32x16_bf16(PAF(1),VFR(1),o[0],0,0,0), C0,8); \
    KRD(GL,1); GAPB(o[1]=__builtin_amdgcn_mfma_f32_32x32x16_bf16(PAF(1),VFR(5),o[1],0,0,0), C0,12); \
    KRD(GL,2); GAPB(o[0]=__builtin_amdgcn_mfma_f32_32x32x16_bf16(PAF(2),VFR(2),o[0],0,0,0), C1,0); \
    KRD(GL,3); GAPB(o[1]=__builtin_amdgcn_mfma_f32_32x32x16_bf16(PAF(2),VFR(6),o[1],0,0,0), C1,4); \
    GAPB(o[0]=__builtin_amdgcn_mfma_f32_32x32x16_bf16(PAF(3),VFR(3),o[0],0,0,0), C1,8); \
    GAPB(o[1]=__builtin_amdgcn_mfma_f32_32x32x16_bf16(PAF(3),VFR(7),o[1],0,0,0), C1,12); \
    }while(0)
  int t=1;
  #undef CMASK
  #define CMASK(P0,P1,t) do{}while(0)
  for(;t+5<NT;t+=2){
    STEP(pB0,pB1,pA0,pA1,t,true,true,true);     WAIT_BAR(2); RESC(); ROT();
    STEP(pA0,pA1,pB0,pB1,t+1,true,true,true);   WAIT_BAR(2); RESC(); ROT();
  }
  #undef CMASK
  #define CMASK(P0,P1,t) do{int jb_=(t)-(NT-4); if(jb_>=0)cmask(P0,P1,jb_,qrel,hi);}while(0)
  #define ENDW(tt) do{ if((tt)+3<NT){WAIT_BAR(2);} else if((tt)+2<NT){WAIT_BAR(1);} else {WAIT_BAR(0);} }while(0)
  for(;t+1<NT;t+=2){
    STEP(pB0,pB1,pA0,pA1,t,(t+3<NT),(t+1<NT),(t+1<NT));       ENDW(t);   RESC(); ROT();
    STEP(pA0,pA1,pB0,pB1,t+1,(t+4<NT),(t+2<NT),(t+2<NT));     ENDW(t+1); RESC(); ROT();
  }
  STEP(pB0,pB1,pA0,pA1,NT-1,false,false,false); RESC();
  { float sacc=pB0[0]+pB0[1]; _Pragma("unroll") for(int r=2;r<16;++r)sacc+=pB0[r]; _Pragma("unroll") for(int r=0;r<16;++r)sacc+=pB1[r]; l_reg+=sacc;
    pw0=(u32x4){PKW(pB0,0),PKW(pB0,2),PKW(pB0,4),PKW(pB0,6)};pw1=(u32x4){PKW(pB0,8),PKW(pB0,10),PKW(pB0,12),PKW(pB0,14)};pw2=(u32x4){PKW(pB1,0),PKW(pB1,2),PKW(pB1,4),PKW(pB1,6)};pw3=(u32x4){PKW(pB1,8),PKW(pB1,10),PKW(pB1,12),PKW(pB1,14)};
    SBAR(); pv(o,vb0+sl_cur,PAF(0),PAF(1),PAF(2),PAF(3)); }
  #undef PKW
  #undef PAF
  #undef VFR
  #undef PIN
  #undef MX3
  #undef GAPA
  #undef GAPB
  #undef EX
  #undef VRD
  #undef KRD
  #undef STEP
  #undef ENDW
  {auto rr=__builtin_amdgcn_permlane32_swap(__float_as_uint(l_reg),__float_as_uint(l_reg),false,false);l_reg=__uint_as_float(rr[0])+__uint_as_float(rr[1]);}
  if(hi==0)wsf[32+r32]=l_reg;asm volatile("s_waitcnt lgkmcnt(0)":::"memory");
  float rli[16];
  #pragma unroll
  for(int r=0;r<16;++r)rli[r]=__builtin_amdgcn_rcpf(wsf[32+crow(r,hi)]);
  bf16*Ow=O+(rowbase+q0+wid*QBLK)*DM+h*D;
  { bf16*stg=(bf16*)(shm+LDS_OST)+wid*2048;
    #pragma unroll
    for(int r=0;r<16;++r){const int orow=crow(r,hi);
      #pragma unroll
      for(int d0=0;d0<2;++d0)stg[orow*64+d0*32+r32]=__float2bfloat16(o[d0][r]*rli[r]);}
    asm volatile("s_waitcnt lgkmcnt(0)":::"memory");
    #pragma unroll
    for(int i=0;i<4;++i){const int row=i*8+(lane>>3),ch=lane&7; const u32x4 v=*(const u32x4*)(stg+row*64+ch*8); ATTN_STORE16(Ow+(long)row*DM+ch*8,v);} }
  asm volatile("s_waitcnt lgkmcnt(0)\n\ts_barrier":::"memory");
  #undef DMA_K
  #undef DMA_V
  #undef INITC
  #undef CMASK
  #undef START
  #undef RESC
  #undef ROT
}
constexpr int ATTN_LDS_BYTES=LDS_BYTES;
struct AttnTensors { const bf16* Q; const bf16* K; const bf16* V; bf16* O; const float* F; const float* NRM; };
struct AttnUnit { int bh; int qb; };
struct StaticOrder {
  int vcu;
  __device__ __forceinline__ explicit StaticOrder(int grid,int block):vcu((block%8)*(grid/8)+block/8){}
  __device__ __forceinline__ bool next(int i,AttnUnit&u)const{ if(i>=4)return false; const int s=vcu&7; u.bh=vcu>>3; u.qb=(i==0)?s:(i==1)?15-s:(i==2)?16+s:31-s; return true; }
  __device__ __forceinline__ void a_ready(const AttnUnit&)const{}
  __device__ __forceinline__ void done(const AttnUnit&)const{}
};
template<int THRL=8> __device__ __forceinline__ void attn_phase(char*lds,const AttnTensors&T,unsigned*qctr,volatile __attribute__((address_space(3))) unsigned*qword,int wid_in){
  const int lane0=(int)__builtin_amdgcn_mbcnt_hi(~0u,__builtin_amdgcn_mbcnt_lo(~0u,0u));
  for(;;){
    if(wid_in==0&&lane0==0){ const unsigned n=__hip_atomic_fetch_add(qctr,1u,__ATOMIC_RELAXED,__HIP_MEMORY_SCOPE_AGENT); *qword=n; }
    asm volatile("s_waitcnt vmcnt(0) lgkmcnt(0)\n\ts_barrier":::"memory");
    const int n=__builtin_amdgcn_readfirstlane((int)*qword);
    if(n>=BATCH*NHEAD*NQB)break;
    const int bh=n%(BATCH*NHEAD),qb=NQB-1-n/(BATCH*NHEAD);
    attn_unit<THRL>(bh/NHEAD,bh%NHEAD,qb,T.Q,T.K,T.V,T.O,T.F,T.NRM,lds,wid_in);
  }
}
#undef SBAR
#undef WAIT_BAR
}
#define GAS __attribute__((address_space(1)))
#define LAS __attribute__((address_space(3)))
typedef unsigned short bf16;
typedef unsigned v4u __attribute__((ext_vector_type(4)));
typedef float f32x4 __attribute__((ext_vector_type(4)));
typedef short bf16x8 __attribute__((ext_vector_type(8)));
typedef GAS unsigned gu32;
typedef GAS unsigned long long gu64;
#define RLX_AGENT __ATOMIC_RELAXED, __HIP_MEMORY_SCOPE_AGENT
#define LDS_WAIT() asm volatile("s_waitcnt lgkmcnt(0)" ::: "memory")
#define VM_WAIT() asm volatile("s_waitcnt vmcnt(0)" ::: "memory")
__device__ __forceinline__ unsigned long long rt() { return __builtin_amdgcn_s_memrealtime(); }
__device__ __forceinline__ unsigned f2bf(float f) { unsigned u = __builtin_bit_cast(unsigned, f); return (u + 0x7fffu + ((u >> 16) & 1u)) >> 16; }
__device__ __forceinline__ unsigned pk2(float lo, float hi) { return f2bf(lo) | (f2bf(hi) << 16); }

#define XB_TMO      128
#define XB_XCNT(j)  (256  + 64 * (j))
#define XB_XSUB(j)  (1280 + 64 * (j))
#define XB_XGEN(j)  (2304 + 64 * (j))
#define XB_TOP      3328
#define XB_TOPGEN   3392
#define XCD_BAR_WORDS 3456
#define XB_SPIN_CAP (1u << 18)

__device__ __forceinline__ unsigned xb_ld(unsigned* p)              { return __hip_atomic_load(p, __ATOMIC_RELAXED, __HIP_MEMORY_SCOPE_AGENT); }
__device__ __forceinline__ unsigned xb_add(unsigned* p, unsigned v) { return __hip_atomic_fetch_add(p, v, __ATOMIC_RELAXED, __HIP_MEMORY_SCOPE_AGENT); }
__device__ __forceinline__ unsigned xb_xcc_id() { return (unsigned)__builtin_amdgcn_s_getreg((3 << 11) | 20) & 0xFu; }
#define XB_SPIN(cond, bar) do { unsigned _sp = 0; while (cond) { __builtin_amdgcn_s_sleep(1); \
    if ((++_sp & 255u) == 0u) { if (xb_ld(&(bar)[XB_TMO])) break; if (_sp > XB_SPIN_CAP) { atomicAdd(&(bar)[XB_TMO], 1u); break; } } } } while (0)

struct XcdBarrier {
    unsigned* bar; unsigned x; int wv;
    volatile LAS unsigned* st;
};

__device__ __forceinline__ bool xb_t0(int wv) { return wv == 0 && __builtin_amdgcn_mbcnt_hi(~0u, __builtin_amdgcn_mbcnt_lo(~0u, 0u)) == 0u; }
__device__ __forceinline__ XcdBarrier xcd_barrier_post(unsigned* bar, volatile LAS unsigned* st, int wv) {
    XcdBarrier b; b.bar = bar; b.x = xb_xcc_id(); b.st = st; b.wv = wv;
    if (xb_t0(wv)) (void)xb_add(&bar[XB_XCNT(b.x)], 1u);
    return b;
}
__device__ __forceinline__ void xcd_barrier_complete(unsigned* bar, unsigned x, unsigned& nloc, unsigned& nx) {
    const unsigned G = gridDim.x * gridDim.y * gridDim.z;
    unsigned sum, cnt, mine, sp = 0u;
    for (;;) {
        sum = 0u; cnt = 0u; mine = 0u;
#pragma unroll
        for (unsigned j = 0; j < 16; ++j) { const unsigned c = xb_ld(&bar[XB_XCNT(j)]); sum += c; cnt += (c > 0u) ? 1u : 0u; mine = (j == x) ? c : mine; }
        if (sum == G) break;
        __builtin_amdgcn_s_sleep(1);
        if ((++sp & 255u) == 0u) { if (xb_ld(&bar[XB_TMO])) break; if (sp > XB_SPIN_CAP) { atomicAdd(&bar[XB_TMO], 1u); break; } }
    }
    nloc = mine > 0u ? mine : 1u; nx = cnt > 0u ? cnt : 1u;
}

__device__ __forceinline__ void xcd_barrier(const XcdBarrier& b) {
    asm volatile("s_waitcnt vmcnt(0)" ::: "memory");
    __syncthreads();
    if (xb_t0(b.wv)) {
        unsigned* bar = b.bar;
        __builtin_amdgcn_s_waitcnt(0);
        unsigned nloc = b.st[0], nx = b.st[1];
        if (nloc == 0u) { xcd_barrier_complete(bar, b.x, nloc, nx); b.st[0] = nloc; b.st[1] = nx; }
        const unsigned old = xb_add(&bar[XB_XSUB(b.x)], 1u);
        const unsigned gen = old / nloc;
        if (old + 1u == (gen + 1u) * nloc) {
            __builtin_amdgcn_fence(__ATOMIC_RELEASE, "agent");
            asm volatile("s_waitcnt vmcnt(0)" ::: "memory");
            const unsigned og = xb_add(&bar[XB_TOP], 1u);
            const unsigned tg = og / nx;
            if (og + 1u == (tg + 1u) * nx) xb_add(&bar[XB_TOPGEN], 1u);
            else XB_SPIN(xb_ld(&bar[XB_TOPGEN]) == tg, bar);
            __builtin_amdgcn_fence(__ATOMIC_ACQUIRE, "agent");
            xb_add(&bar[XB_XGEN(b.x)], 1u);
            asm volatile("s_waitcnt vmcnt(0)" ::: "memory");
        } else {
            XB_SPIN(xb_ld(&bar[XB_XGEN(b.x)]) == gen, bar);
            __builtin_amdgcn_fence(__ATOMIC_ACQUIRE, "agent");
            asm volatile("s_waitcnt vmcnt(0)" ::: "memory");
        }
    }
    __syncthreads();
}

constexpr int NWAVES = 8;
constexpr int RING_OFF = 0, RING_BYTES = 131072;
constexpr int LDSCTL_OFF = RING_BYTES, MISC_OFF = LDSCTL_OFF + 320;
constexpr int LDS_BYTES = 147456;
constexpr int N_PHASES = 8;

struct Frame {
    LAS unsigned char* lds;
    volatile LAS unsigned* MISC;
    gu32* ctl;
    int tid, lane, wave, vcu, G;
};
__device__ __forceinline__ float wave_sum(float v) {
#pragma unroll
    for (int o = 1; o < 64; o <<= 1) v += __shfl_xor(v, o);
    return v;
}
struct Args { const float* in[20]; float* out; unsigned char* ws; int ph_lo, ph_hi, li, pad; };

__device__ __forceinline__ void p0_transpose_item(const float* W, int ld, int nblk, const float* glo, const float* ghi, int K, bf16* WT, LAS float* scr, int item, int lane) {
    const int kb = item / nblk, nb = item % nblk, k0 = 64 * kb, n0 = 32 * nb;
#pragma unroll 8
    for (int i = 0; i < 32; ++i) { const int kk = 2 * i + (lane >> 5), k = k0 + kk; float w = W[(size_t)k * ld + n0 + (lane & 31)];
        if (glo) w *= (k < K / 2) ? glo[k] : ghi[k - K / 2];
        scr[kk * 33 + (lane & 31)] = w; }
    LDS_WAIT(); asm volatile("" ::: "memory");
    const int c = lane & 7;
#pragma unroll
    for (int j = 0; j < 4; ++j) { const int n = (lane >> 3) + 8 * j; const LAS float* s = scr + (8 * c) * 33 + n;
        v4u o; o.x = pk2(s[0 * 33], s[1 * 33]); o.y = pk2(s[2 * 33], s[3 * 33]); o.z = pk2(s[4 * 33], s[5 * 33]); o.w = pk2(s[6 * 33], s[7 * 33]);
        *(GAS v4u*)(WT + (size_t)(n0 + n) * K + k0 + 8 * c) = o; }
    LDS_WAIT(); asm volatile("" ::: "memory");
}
__device__ __forceinline__ float log_sigmoid(float z) { return fminf(z, 0.f) - log1pf(expf(-fabsf(z))); }

__device__ __forceinline__ void p0_prologue(Frame& F, const Args& a) {
    LAS float* scr = (LAS float*)(F.lds + RING_OFF + F.wave * 16384);
    unsigned char* ws = a.ws;
    const float* x = a.in[0]; const float* g1 = a.in[1]; const float* w_in = a.in[2]; const float* bfv = a.in[10];
    const float* gn_l = a.in[11]; const float* gn_f = a.in[12]; const float* w_out = a.in[13]; const float* g2 = a.in[14];
    const float* w_q = a.in[15]; const float* sk = a.in[16]; const float* pu = a.in[17]; const float* pv = a.in[18];
    bf16* win_t = (bf16*)(ws + WS_WIN); bf16* wout_t = (bf16*)(ws + WS_WOUT); bf16* wq_t = (bf16*)(ws + WS_WQ); bf16* skb = (bf16*)(ws + WS_SKB);
    float* logf = (float*)(ws + WS_LOGF); float* sumsq = (float*)(ws + WS_SUMSQ); bf16* h = (bf16*)(ws + WS_H);
    const int gw = F.vcu * NWAVES + F.wave, NGW = F.G * NWAVES, lane = F.lane;
    constexpr int I_IN = (DMODEL / 64) * (NG1 / 32), I_OUT = (DMODEL / 64) * (DMODEL / 32), I_Q = (DMODEL / 64) * (QPW / 32);
    constexpr int I_FL = 8 * DMODEL / 64, I_SK = PH * 2 * NKEY * PHALF / 512, I_SS = T / 64, I_WAX = 8 * 2 * 2 * 4;
    constexpr int E0 = I_IN, E1 = E0 + I_OUT, E2 = E1 + I_Q, E3 = E2 + I_FL, E4 = E3 + I_SK, E5 = E4 + I_SS, E6 = E5 + I_WAX;
    for (int it = gw; it < E6; it += NGW) {
        if (it < E0) { p0_transpose_item(w_in, INC, NG1 / 32, nullptr, nullptr, DMODEL, win_t, scr, it, lane); continue; }
        if (it < E1) { p0_transpose_item(w_out, DMODEL, DMODEL / 32, gn_l, gn_f, DMODEL, wout_t, scr, it - E0, lane); continue; }
        if (it < E2) { p0_transpose_item(w_q, QPW, QPW / 32, g2, g2 + DMODEL / 2, DMODEL, wq_t, scr, it - E1, lane); continue; }
        if (it < E3) continue;
        if (it < E4) { const size_t i = (size_t)(it - E3) * 512 + lane * 8; const f32x4 s0 = *(const GAS f32x4*)(sk + i), s1 = *(const GAS f32x4*)(sk + i + 4);
            v4u o; o.x = pk2(s0[0], s0[1]); o.y = pk2(s0[2], s0[3]); o.z = pk2(s1[0], s1[1]); o.w = pk2(s1[2], s1[3]);
            { const size_t hp = i >> 14; const int key = (int)(i >> 7) & 127, c8 = (int)(i >> 3) & 15; *(GAS v4u*)(skb + hp * 16384 + ((size_t)((((key >> 5) * 2 + (c8 & 1)) * 8 + (c8 >> 1)) * 32 + (key & 31))) * 8) = o; } continue; }
        if (it < E5) { sumsq[(it - E4) * 64 + lane] = 0.f; continue; }
        { const int f = it - E5, ks = f & 3, n = (f >> 2) & 1, mat = (f >> 3) & 1, hh = f >> 4; const float* wsrc = mat ? a.in[7] : a.in[5];
          const size_t o = ((size_t)(hh * 64 + 16 * ks + 8 * (lane >> 5))) * 64 + 32 * n + (lane & 31);
          v4u pw; pw.x = pk2(wsrc[o], wsrc[o + 64]); pw.y = pk2(wsrc[o + 128], wsrc[o + 192]); pw.z = pk2(wsrc[o + 256], wsrc[o + 320]); pw.w = pk2(wsrc[o + 384], wsrc[o + 448]);
          *(GAS v4u*)((bf16*)(ws + WS_WAX) + (size_t)f * 512 + lane * 8) = pw; }
    }
    { f32x4 gg[4];
#pragma unroll
      for (int j = 0; j < 4; ++j) gg[j] = *(const GAS f32x4*)(g2 + 16 * lane + 4 * j);
      unsigned char* u4 = ws + WS_U8; unsigned char* v4 = ws + WS_V8; float* su = (float*)(ws + WS_SU);
      for (int e = gw; e < NEXP; e += NGW) {
        const GAS f32x4* ur = (const GAS f32x4*)(pu + (size_t)e * DMODEL + 16 * lane); const GAS f32x4* vr = (const GAS f32x4*)(pv + (size_t)e * DMODEL + 16 * lane);
        f32x4 uu[4], vv[4]; float mu = 0.f, mv = 0.f;
#pragma unroll
        for (int j = 0; j < 4; ++j) { uu[j] = ur[j] * gg[j]; vv[j] = vr[j];
#pragma unroll
            for (int c = 0; c < 4; ++c) { mu = fmaxf(mu, fabsf(uu[j][c])); mv = fmaxf(mv, fabsf(vv[j][c])); } }
#pragma unroll
        for (int o = 1; o < 64; o <<= 1) { mu = fmaxf(mu, __shfl_xor(mu, o)); mv = fmaxf(mv, __shfl_xor(mv, o)); }
        const float scu = mu > 0.f ? mu * (1.f / 6.f) : 1.f, scv = mv > 0.f ? mv * (1.f / 6.f) : 1.f, iu = 1.f / scu, iv = 1.f / scv;
        unsigned qu0 = 0u, qu1 = 0u, qv0 = 0u, qv1 = 0u;
#define P0_Q4(Q, X, INV, B0, B1) do { Q = __builtin_amdgcn_cvt_scalef32_pk_fp4_f32(Q, X[0] * INV, X[1] * INV, 1.0f, B0); Q = __builtin_amdgcn_cvt_scalef32_pk_fp4_f32(Q, X[2] * INV, X[3] * INV, 1.0f, B1); } while (0)
        P0_Q4(qu0, uu[0], iu, 0, 1); P0_Q4(qu0, uu[1], iu, 2, 3); P0_Q4(qu1, uu[2], iu, 0, 1); P0_Q4(qu1, uu[3], iu, 2, 3);
        P0_Q4(qv0, vv[0], iv, 0, 1); P0_Q4(qv0, vv[1], iv, 2, 3); P0_Q4(qv1, vv[2], iv, 0, 1); P0_Q4(qv1, vv[3], iv, 2, 3);
#undef P0_Q4
        *(GAS unsigned long long*)(u4 + (size_t)e * 512 + 8 * lane) = (unsigned long long)qu0 | ((unsigned long long)qu1 << 32);
        { unsigned char* vrow = v4 + (size_t)e * 512 + 2 * (lane >> 2);
          *(GAS unsigned short*)(vrow + 32 * (4 * (lane & 3) + 0)) = (unsigned short)(qv0 & 0xffffu); *(GAS unsigned short*)(vrow + 32 * (4 * (lane & 3) + 1)) = (unsigned short)(qv0 >> 16);
          *(GAS unsigned short*)(vrow + 32 * (4 * (lane & 3) + 2)) = (unsigned short)(qv1 & 0xffffu); *(GAS unsigned short*)(vrow + 32 * (4 * (lane & 3) + 3)) = (unsigned short)(qv1 >> 16); }
        if (lane == 0) { su[2 * e] = scu; su[2 * e + 1] = scv; }
      } }
    { f32x4 gg[4];
#pragma unroll
      for (int j = 0; j < 4; ++j) gg[j] = *(const GAS f32x4*)(g1 + 256 * j + 4 * lane);
      float fw[4][4][8];
#pragma unroll
      for (int j = 0; j < 4; ++j)
#pragma unroll
          for (int c = 0; c < 4; ++c) { const int k = 256 * j + 4 * lane + c; const GAS f32x4* wr = (const GAS f32x4*)(w_in + (size_t)k * INC + NG1); const f32x4 w0 = wr[0], w1 = wr[1];
#pragma unroll
              for (int e = 0; e < 4; ++e) { fw[j][c][e] = w0[e]; fw[j][c][4 + e] = w1[e]; } }
      for (int t0 = gw; t0 < T; t0 += 2 * NGW) {
        const int t1 = (t0 + NGW < T) ? t0 + NGW : t0;
        const GAS f32x4* xr0 = (const GAS f32x4*)(x + (size_t)t0 * DMODEL) + lane; const GAS f32x4* xr1 = (const GAS f32x4*)(x + (size_t)t1 * DMODEL) + lane;
        f32x4 va[4], vb[4]; float sa = 0.f, sb = 0.f;
#pragma unroll
        for (int j = 0; j < 4; ++j) { va[j] = xr0[64 * j]; vb[j] = xr1[64 * j]; }
#pragma unroll
        for (int j = 0; j < 4; ++j) { sa += (va[j][0] * va[j][0] + va[j][1] * va[j][1]) + (va[j][2] * va[j][2] + va[j][3] * va[j][3]); sb += (vb[j][0] * vb[j][0] + vb[j][1] * vb[j][1]) + (vb[j][2] * vb[j][2] + vb[j][3] * vb[j][3]); }
        const float ra = rsqrtf(wave_sum(sa) * (1.f / DMODEL) + RMS_EPS), rb = rsqrtf(wave_sum(sb) * (1.f / DMODEL) + RMS_EPS);
        GAS unsigned long long* ha = (GAS unsigned long long*)(h + (size_t)t0 * DMODEL) + lane; GAS unsigned long long* hb = (GAS unsigned long long*)(h + (size_t)t1 * DMODEL) + lane;
#pragma unroll
        for (int j = 0; j < 4; ++j) { va[j] = va[j] * ra * gg[j]; vb[j] = vb[j] * rb * gg[j];
            ha[64 * j] = (unsigned long long)pk2(va[j][0], va[j][1]) | ((unsigned long long)pk2(va[j][2], va[j][3]) << 32);
            hb[64 * j] = (unsigned long long)pk2(vb[j][0], vb[j][1]) | ((unsigned long long)pk2(vb[j][2], vb[j][3]) << 32); }
        float fa[8], fb[8];
#pragma unroll
        for (int hh = 0; hh < 8; ++hh) { fa[hh] = 0.f; fb[hh] = 0.f; }
#pragma unroll
        for (int j = 0; j < 4; ++j)
#pragma unroll
            for (int c = 0; c < 4; ++c) {
#pragma unroll
                for (int hh = 0; hh < 8; ++hh) { fa[hh] += va[j][c] * fw[j][c][hh]; fb[hh] += vb[j][c] * fw[j][c][hh]; } }
        float resa = 0.f, resb = 0.f;
#pragma unroll
        for (int hh = 0; hh < 8; ++hh) { const float s0 = wave_sum(fa[hh]), s1 = wave_sum(fb[hh]); if (lane == hh) { resa = s0; resb = s1; } }
        if (lane < 8) { logf[(size_t)t0 * 8 + lane] = log_sigmoid(resa + bfv[lane]); logf[(size_t)t1 * 8 + lane] = log_sigmoid(resb + bfv[lane]); }
      } }
}

__device__ __forceinline__ void fcum_unit(Frame& F, int bh, const float* logf, float* fcum) {
    const int b = bh / NHEADS, hh = bh % NHEADS, s0 = F.tid * 16;
    float v[16]; float loc = 0.f;
#pragma unroll
    for (int i = 0; i < 16; ++i) { v[i] = logf[((size_t)b * SEQ + s0 + i) * 8 + hh]; loc += v[i]; }
    float inc = loc;
#pragma unroll
    for (int o = 1; o < 64; o <<= 1) { const float n = __shfl_up(inc, o); if (F.lane >= o) inc += n; }
    if (F.lane == 63) F.MISC[16 + F.wave] = __float_as_uint(inc);
    __syncthreads();
    float run = inc - loc;
    for (int w = 0; w < F.wave; ++w) run += __uint_as_float(F.MISC[16 + w]);
#pragma unroll
    for (int i = 0; i < 16; ++i) { run += v[i]; fcum[(size_t)bh * SEQ + s0 + i] = run; }
    __syncthreads();
}


namespace peer {
typedef unsigned u32;
typedef float f32x16 __attribute__((ext_vector_type(16)));
constexpr int TOK = 128;
constexpr int EX_STRIDE = 136, GT_STRIDE = 136;
constexpr int L_EX = 0, L_GT = L_EX + TOK * EX_STRIDE * 2, L_IDX = L_GT + TOK * GT_STRIDE * 2, IDX_STRIDE = 36, L_RST = L_IDX + 512 * IDX_STRIDE, L_BI = L_RST + TOK * 4, BI_WAVE = 4352, L_END = L_BI + 8 * BI_WAVE;
static_assert(L_END <= RING_BYTES && L_GT % 16 == 0 && L_IDX % 16 == 0, "PEER LDS map");
__device__ __forceinline__ u32 ordmap(float f) { const u32 u = __float_as_uint(f); return u ^ ((u32)((int)u >> 31) | 0x80000000u); }
__device__ __forceinline__ float unordmap(u32 k) { const u32 u = (k & 0x80000000u) ? (k ^ 0x80000000u) : ~k; return __uint_as_float(u); }
__device__ __forceinline__ u32 umin_(u32 a, u32 b) { return a < b ? a : b; }
__device__ __forceinline__ u32 umax_(u32 a, u32 b) { return a > b ? a : b; }
template <bool DESC> __device__ __forceinline__ void sort16(u32 (&k)[16]) {
#pragma unroll
    for (int size = 2; size <= 16; size <<= 1)
#pragma unroll
        for (int stride = size >> 1; stride > 0; stride >>= 1)
#pragma unroll
            for (int i = 0; i < 16; ++i) { const int j = i ^ stride;
                if (j > i) { const bool asc = (((i & size) == 0) != DESC); const u32 a = k[i], b = k[j], lo = umin_(a, b), hi = umax_(a, b); k[i] = asc ? lo : hi; k[j] = asc ? hi : lo; } }
}
template <bool DESC> __device__ __forceinline__ void merge16(u32 (&k)[16]) {
#pragma unroll
    for (int stride = 8; stride > 0; stride >>= 1)
#pragma unroll
        for (int i = 0; i < 16; ++i) { const int j = i ^ stride;
            if (j > i) { const u32 a = k[i], b = k[j], lo = umin_(a, b), hi = umax_(a, b); k[i] = DESC ? hi : lo; k[j] = DESC ? lo : hi; } }
}
__host__ __device__ constexpr int ccnt(int a) { return 16 / (a + 1); }
__host__ __device__ constexpr int cbase(int a) { int s = 0; for (int i = 0; i < a; ++i) s += ccnt(i); return s; }
static_assert(cbase(16) == 50, "hyperbola candidate count");
__device__ __forceinline__ int crow16(int r) { return (r & 3) + 8 * (r >> 2); }

__device__ __forceinline__ void route_tile(Frame& F, const bf16* qp, const bf16* skb, const float* sumsq, int t0) {
    int lane = F.lane; asm volatile("" : "+v"(lane));
    const int r32 = lane & 31, hi = lane >> 5, w = F.wave;
    LAS unsigned short* EXL = (LAS unsigned short*)(F.lds + RING_OFF + L_EX);
    LAS unsigned short* GTL = (LAS unsigned short*)(F.lds + RING_OFF + L_GT);
    LAS unsigned char* IDXB = F.lds + RING_OFF + L_IDX + (w * 64 + lane) * IDX_STRIDE;
    LAS float* RST = (LAS float*)(F.lds + RING_OFF + L_RST);
    for (int g = 0; g < 4; ++g) {
        const int tok = 32 * g + r32; const size_t trow = (size_t)(t0 + tok);
        const float rstd2 = rsqrtf(sumsq[trow] * (1.f / DMODEL) + RMS_EPS);
        if (w == 0 && hi == 0) RST[tok] = rstd2;
        u32 s0[16], s1[16];
#pragma unroll
        for (int p = 0; p < 2; ++p) {
            bf16x8 qf[8];
#pragma unroll
            for (int ks = 0; ks < 8; ++ks) qf[ks] = *(const GAS bf16x8*)(qp + ((size_t)((((trow >> 5) * 8 + w) * 2 + p) * 16 + 2 * ks + hi) * 32 + r32) * 8);
            u32 run[16];
#pragma unroll
            for (int nb = 0; nb < 4; ++nb) {
                f32x16 acc = {};
                const bf16* kr = skb + (size_t)(w * 2 + p) * 16384 + ((size_t)((nb * 2 + hi) * 8 * 32 + r32)) * 8;
#pragma unroll
                for (int ks = 0; ks < 8; ++ks) acc = __builtin_amdgcn_mfma_f32_32x32x16_bf16(*(const GAS bf16x8*)(kr + ks * 256), qf[ks], acc, 0, 0, 0);
                asm volatile("" ::: "memory");
                u32 blk[16];
#pragma unroll
                for (int r = 0; r < 16; ++r) blk[r] = (ordmap(acc[r]) & ~0x7Fu) | (u32)(127 - 32 * nb - crow16(r) - 4 * hi);
                if (nb == 0) { sort16<true>(blk);
#pragma unroll
                    for (int i = 0; i < 16; ++i) run[i] = blk[i]; }
                else { sort16<false>(blk);
#pragma unroll
                    for (int i = 0; i < 16; ++i) run[i] = umax_(run[i], blk[i]);
                    merge16<true>(run); }
            }
            u32 oth[16];
#pragma unroll
            for (int i = 0; i < 16; ++i) oth[i] = (u32)__shfl_xor((int)run[15 - i], 32);
#pragma unroll
            for (int i = 0; i < 16; ++i) run[i] = umax_(run[i], oth[i]);
            merge16<true>(run);
#pragma unroll
            for (int i = 0; i < 16; ++i) { if (p == 0) s0[i] = run[i]; else s1[i] = run[i]; }
        }
        { LAS u32* iw = (LAS u32*)IDXB;
#pragma unroll
          for (int j = 0; j < 4; ++j) {
              iw[j] = (127u - (s0[4 * j] & 127u)) | ((127u - (s0[4 * j + 1] & 127u)) << 8) | ((127u - (s0[4 * j + 2] & 127u)) << 16) | ((127u - (s0[4 * j + 3] & 127u)) << 24);
              iw[4 + j] = (127u - (s1[4 * j] & 127u)) | ((127u - (s1[4 * j + 1] & 127u)) << 8) | ((127u - (s1[4 * j + 2] & 127u)) << 16) | ((127u - (s1[4 * j + 3] & 127u)) << 24); } }
        float v1[16], v2[16];
#pragma unroll
        for (int i = 0; i < 16; ++i) { v1[i] = unordmap(s0[i] & ~0x7Fu); v2[i] = unordmap(s1[i] & ~0x7Fu); }
        u32 c0[16], c1[16], c2[16], c3[16];
#pragma unroll
        for (int a = 0; a < 16; ++a)
#pragma unroll
            for (int b = 0; b < ccnt(a); ++b) { const int pos = cbase(a) + b; const u32 key = (ordmap(v1[a] + v2[b]) & ~0xFFu) | (u32)(255 - (a * 16 + b));
                if (pos < 16) c0[pos] = key; else if (pos < 32) c1[pos - 16] = key; else if (pos < 48) c2[pos - 32] = key; else c3[pos - 48] = key; }
#pragma unroll
        for (int i = 2; i < 16; ++i) c3[i] = 0u;
        sort16<false>(c1);
#pragma unroll
        for (int i = 0; i < 16; ++i) c0[i] = umax_(c0[i], c1[i]);
        merge16<true>(c0);
        sort16<false>(c2);
#pragma unroll
        for (int i = 0; i < 16; ++i) c0[i] = umax_(c0[i], c2[i]);
        merge16<true>(c0);
        sort16<false>(c3);
#pragma unroll
        for (int i = 0; i < 16; ++i) c0[i] = umax_(c0[i], c3[i]);
        merge16<true>(c0);
        const float m = unordmap(c0[0] & ~0xFFu) * rstd2;
        float e[8]; float sum = 0.f; u32 ex[8];
#pragma unroll
        for (int k = 0; k < 8; ++k) { const u32 key = hi ? c0[k + 8] : c0[k]; const float ts = unordmap(key & ~0xFFu);
            e[k] = __builtin_amdgcn_exp2f((ts * rstd2 - m) * LOG2E); sum += e[k];
            const u32 flat = 255u - (key & 255u); ex[k] = (u32)IDXB[flat >> 4] * NKEY + (u32)IDXB[16 + (flat & 15u)]; }
        sum += __shfl_xor(sum, 32);
        const float inv = 1.f / sum;
        v4u exw; exw.x = ex[0] | (ex[1] << 16); exw.y = ex[2] | (ex[3] << 16); exw.z = ex[4] | (ex[5] << 16); exw.w = ex[6] | (ex[7] << 16);
        *(LAS v4u*)(EXL + tok * EX_STRIDE + w * 16 + hi * 8) = exw;
        *(LAS v4u*)(GTL + tok * GT_STRIDE + w * 16 + hi * 8) = (v4u){pk2(e[0] * inv, e[1] * inv), pk2(e[2] * inv, e[3] * inv), pk2(e[4] * inv, e[5] * inv), pk2(e[6] * inv, e[7] * inv)};
    }
}
__device__ __forceinline__ float gelu_fast(float x) {
    const float u2 = x * (1.5957691216057308f + 0.07135481627f * x * x);
    return x * __builtin_amdgcn_rcpf(1.f + __builtin_amdgcn_exp2f(-1.4426950408889634f * u2));
}
typedef float f32x2 __attribute__((ext_vector_type(2)));

__device__ __forceinline__ void sort128(u32 (&k)[8], int m) {
#pragma unroll
    for (int K = 2; K <= 128; K <<= 1) {
#pragma unroll
        for (int S = K >> 1; S > 0; S >>= 1) {
            if (S >= 8) {
                const int mm = S >> 3; const bool lower = (m & mm) == 0, up = (K == 128) ? true : ((m & (K >> 3)) == 0), keepmin = (lower == up);
#pragma unroll
                for (int r = 0; r < 8; ++r) { const u32 o = (u32)__shfl_xor((int)k[r], mm); const u32 mn = umin_(k[r], o), mx = umax_(k[r], o); k[r] = keepmin ? mn : mx; }
            } else {
#pragma unroll
                for (int r = 0; r < 8; ++r) { const int r2 = r ^ S;
                    if (r2 > r) { const u32 a = k[r], b = k[r2], mn = umin_(a, b), mx = umax_(a, b);
                        if (K < 8) { const bool up = (r & K) == 0; k[r] = up ? mn : mx; k[r2] = up ? mx : mn; }
                        else { const bool up = (K == 128) ? true : ((m & (K >> 3)) == 0); k[r] = up ? mn : mx; k[r2] = up ? mx : mn; } } }
            }
        }
    }
}
typedef int v8i __attribute__((ext_vector_type(8)));
typedef unsigned u2v __attribute__((ext_vector_type(2)));
__device__ __forceinline__ void eval_mf(Frame& F, const unsigned char* u4, const unsigned char* v4, const float* suv, const float* fg, float* out, int t0) {
    int lane = F.lane; asm volatile("" : "+v"(lane));
    const int g = lane >> 4, m = lane & 15;
    LAS unsigned short* EXL = (LAS unsigned short*)(F.lds + RING_OFF + L_EX);
    LAS unsigned short* GTL = (LAS unsigned short*)(F.lds + RING_OFF + L_GT);
    LAS unsigned char* BI = F.lds + RING_OFF + L_BI + F.wave * BI_WAVE;
    const LAS float* RST = (const LAS float*)(F.lds + RING_OFF + L_RST);
    LAS u32* SKW = (LAS u32*)(F.lds + RING_OFF + L_IDX) + F.wave * 512;
    LAS u32* SK = SKW + g * 128;
    for (int pass = 0; pass < 4; ++pass) {
        const int tb4 = 32 * pass + 4 * F.wave, tok = tb4 + g;
        LAS unsigned short* exr = EXL + tok * EX_STRIDE; LAS unsigned short* gtr = GTL + tok * GT_STRIDE;
        { u32 k[8]; const v4u ev = *(const LAS v4u*)(exr + 8 * m); const u32 s0 = (u32)(8 * m);
          k[0] = ((ev.x & 0xffffu) << 7) | s0; k[1] = ((ev.x >> 16) << 7) | (s0 + 1); k[2] = ((ev.y & 0xffffu) << 7) | (s0 + 2); k[3] = ((ev.y >> 16) << 7) | (s0 + 3);
          k[4] = ((ev.z & 0xffffu) << 7) | (s0 + 4); k[5] = ((ev.z >> 16) << 7) | (s0 + 5); k[6] = ((ev.w & 0xffffu) << 7) | (s0 + 6); k[7] = ((ev.w >> 16) << 7) | (s0 + 7);
          sort128(k, m);
          u32 wv[8];
#pragma unroll
          for (int r = 0; r < 8; ++r) wv[r] = ((k[r] >> 7) << 16) | (u32)gtr[k[r] & 127u];
          *(LAS v4u*)(SK + m * 8) = (v4u){wv[0], wv[1], wv[2], wv[3]}; *(LAS v4u*)(SK + m * 8 + 4) = (v4u){wv[4], wv[5], wv[6], wv[7]};
          *(LAS v4u*)(exr + 8 * m) = (v4u){(k[0] >> 7) | ((k[1] >> 7) << 16), (k[2] >> 7) | ((k[3] >> 7) << 16), (k[4] >> 7) | ((k[5] >> 7) << 16), (k[6] >> 7) | ((k[7] >> 7) << 16)}; }
        asm volatile("" ::: "memory");
        {
#pragma unroll
            for (int tq = 0; tq < 4; ++tq) { const float rq = RST[tb4 + tq]; const float* xr = out + (size_t)(t0 + tb4 + tq) * DMODEL + 4 * lane;
#pragma unroll
                for (int c = 0; c < 4; ++c) { const f32x4 xa = *(const GAS f32x4*)(xr + 256 * c); int w = 0;
                    w = __builtin_amdgcn_cvt_pk_fp8_f32(xa[0] * rq, xa[1] * rq, w, false); w = __builtin_amdgcn_cvt_pk_fp8_f32(xa[2] * rq, xa[3] * rq, w, true);
                    const int d = 256 * c + 4 * lane, st = d >> 7, dd = d & 127, hh = dd >> 6, e = dd & 63;
                    *(LAS int*)(BI + ((st * 4 + tq) * 4 + (e >> 4)) * 32 + hh * 16 + (e & 15)) = w; } }
        }
        asm volatile("" ::: "memory");
        v8i hb[8];
#pragma unroll
        for (int st = 0; st < 8; ++st) { v4u b0 = *(const LAS v4u*)(BI + ((st * 4 + (m & 3)) * 4 + g) * 32), b1 = *(const LAS v4u*)(BI + ((st * 4 + (m & 3)) * 4 + g) * 32 + 16);
            if (m >= 4) { b0 = (v4u){0u, 0u, 0u, 0u}; b1 = b0; }
            hb[st] = (v8i){(int)b0.x, (int)b0.y, (int)b0.z, (int)b0.w, (int)b1.x, (int)b1.y, (int)b1.z, (int)b1.w}; }
        asm volatile("" ::: "memory");
        v4u kq = *(const LAS v4u*)(SK);
        v4u ua[4][2]; f32x2 sc[4];
#pragma unroll
        for (int s4 = 0; s4 < 4; ++s4) { const u32 e = kq[s4] >> 16; const u32 ro = e * 512u + 16u * (u32)m; ua[s4][0] = *(const GAS v4u*)(u4 + ro); ua[s4][1] = *(const GAS v4u*)(u4 + ro + 256); sc[s4] = *(const GAS f32x2*)(suv + 2 * e); }
        for (int i = 0; i < 128; i += 4) {
            v4u af[8];
#pragma unroll
            for (int hf = 0; hf < 2; ++hf) {
#pragma unroll
                for (int s4 = 0; s4 < 4; ++s4) *(LAS v4u*)(BI + (4 * s4 + g) * 272 + 16 * m) = ua[s4][hf];
                asm volatile("" ::: "memory");
#pragma unroll
                for (int st = 0; st < 4; ++st) af[4 * hf + st] = *(const LAS v4u*)(BI + m * 272 + 64 * st + 16 * g);
                asm volatile("" ::: "memory");
            }
            const int inx = (i + 4 < 128) ? i + 4 : i;
            const v4u kqn = *(const LAS v4u*)(SK + inx);
            v4u un[4][2]; f32x2 scn[4];
#pragma unroll
            for (int s4 = 0; s4 < 4; ++s4) { const u32 e = kqn[s4] >> 16; const u32 ro = e * 512u + 16u * (u32)m; un[s4][0] = *(const GAS v4u*)(u4 + ro); un[s4][1] = *(const GAS v4u*)(u4 + ro + 256); scn[s4] = *(const GAS f32x2*)(suv + 2 * e); }
            f32x4 D = (f32x4){0.f, 0.f, 0.f, 0.f};
#pragma unroll
            for (int st = 0; st < 8; ++st) { const v8i a8 = (v8i){(int)af[st].x, (int)af[st].y, (int)af[st].z, (int)af[st].w, 0, 0, 0, 0};
                D = __builtin_amdgcn_mfma_scale_f32_16x16x128_f8f6f4(a8, hb[st], D, 4, 0, 0, 0x7f7f7f7f, 0, 0x7f7f7f7f); }
            const int sel = lane & 3; const float mine = sel == 0 ? D[0] : sel == 1 ? D[1] : sel == 2 ? D[2] : D[3];
            float act[4];
#pragma unroll
            for (int s4 = 0; s4 < 4; ++s4) { const float pre = __uint_as_float((unsigned)__builtin_amdgcn_ds_bpermute(4 * (g + 16 * s4), (int)__float_as_uint(mine)));
                act[s4] = gelu_fast(pre * sc[s4][0]) * (__uint_as_float(kq[s4] << 16) * sc[s4][1]); }
            if (m == 0) *(LAS u2v*)(gtr + i) = (u2v){pk2(act[0], act[1]), pk2(act[2], act[3])};
            kq = kqn;
#pragma unroll
            for (int s4 = 0; s4 < 4; ++s4) { ua[s4][0] = un[s4][0]; ua[s4][1] = un[s4][1]; sc[s4] = scn[s4]; }
        }
    }
    asm volatile("" ::: "memory");
    for (int pass = 0; pass < 4; ++pass) {
        const int tb4 = 32 * pass + 4 * F.wave, tok = tb4 + g;
        const LAS unsigned short* exr = EXL + tok * EX_STRIDE; const LAS unsigned short* acr = GTL + tok * GT_STRIDE;
        f32x2 y[32];
#pragma unroll
        for (int q = 0; q < 32; ++q) y[q] = (f32x2){0.f, 0.f};
        float* xrow = out + (size_t)(t0 + tok) * DMODEL + 4 * m;
        v4u vb[4][2];
        { const u2v e2 = *(const LAS u2v*)(exr);
#pragma unroll
          for (int s4 = 0; s4 < 4; ++s4) { const u32 e = (s4 & 1) ? (e2[s4 >> 1] >> 16) : (e2[s4 >> 1] & 0xffffu); const u32 ro = e * 512u + 32u * (u32)m; vb[s4][0] = *(const GAS v4u*)(v4 + ro); vb[s4][1] = *(const GAS v4u*)(v4 + ro + 16); } }
        for (int i = 0; i < 128; i += 4) {
            const int inx = (i + 4 < 128) ? i + 4 : i;
            const u2v e2 = *(const LAS u2v*)(exr + inx); const u2v a2 = *(const LAS u2v*)(acr + i);
            v4u vn[4][2];
#pragma unroll
            for (int s4 = 0; s4 < 4; ++s4) { const u32 e = (s4 & 1) ? (e2[s4 >> 1] >> 16) : (e2[s4 >> 1] & 0xffffu); const u32 ro = e * 512u + 32u * (u32)m; vn[s4][0] = *(const GAS v4u*)(v4 + ro); vn[s4][1] = *(const GAS v4u*)(v4 + ro + 16); }
#pragma unroll
            for (int s4 = 0; s4 < 4; ++s4) { const float act = (s4 & 1) ? __uint_as_float(a2[s4 >> 1] & 0xffff0000u) : __uint_as_float(a2[s4 >> 1] << 16); const f32x2 b2 = (f32x2){act, act};
#pragma unroll
                for (int c = 0; c < 2; ++c)
#pragma unroll
                    for (int d = 0; d < 4; ++d) { const unsigned w_ = vb[s4][c][d]; const int hq = 16 * c + 4 * d;
                        y[hq] = __builtin_elementwise_fma(__builtin_amdgcn_cvt_scalef32_pk_f32_fp4(w_, 1.0f, 0), b2, y[hq]); y[hq + 1] = __builtin_elementwise_fma(__builtin_amdgcn_cvt_scalef32_pk_f32_fp4(w_, 1.0f, 1), b2, y[hq + 1]);
                        y[hq + 2] = __builtin_elementwise_fma(__builtin_amdgcn_cvt_scalef32_pk_f32_fp4(w_, 1.0f, 2), b2, y[hq + 2]); y[hq + 3] = __builtin_elementwise_fma(__builtin_amdgcn_cvt_scalef32_pk_f32_fp4(w_, 1.0f, 3), b2, y[hq + 3]); } }
#pragma unroll
            for (int s4 = 0; s4 < 4; ++s4) { vb[s4][0] = vn[s4][0]; vb[s4][1] = vn[s4][1]; }
        }
        float ss = 0.f;
#pragma unroll
        for (int q = 0; q < 16; ++q) { const f32x4 xa = *(const GAS f32x4*)(xrow + 64 * q); y[2 * q][0] += xa[0]; y[2 * q][1] += xa[1]; y[2 * q + 1][0] += xa[2]; y[2 * q + 1][1] += xa[3];
            ss += (y[2 * q][0] * y[2 * q][0] + y[2 * q][1] * y[2 * q][1]) + (y[2 * q + 1][0] * y[2 * q + 1][0] + y[2 * q + 1][1] * y[2 * q + 1][1]); }
        ss += __shfl_xor(ss, 1); ss += __shfl_xor(ss, 2); ss += __shfl_xor(ss, 4); ss += __shfl_xor(ss, 8);
        const float rs = rsqrtf(ss * (1.f / DMODEL) + RMS_EPS);
        asm volatile("" ::: "memory");
#pragma unroll
        for (int q = 0; q < 16; ++q) { const f32x4 gq = *(const GAS f32x4*)(fg + 64 * q + 4 * m); f32x4 o; o[0] = y[2 * q][0] * rs * gq[0]; o[1] = y[2 * q][1] * rs * gq[1]; o[2] = y[2 * q + 1][0] * rs * gq[2]; o[3] = y[2 * q + 1][1] * rs * gq[3];
            *(GAS f32x4*)(xrow + 64 * q) = o; }
    }
}
__device__ __forceinline__ void peer_phase(Frame& F, const Args& a) {
    unsigned char* ws = a.ws;
    for (int tile = F.vcu; tile < T / TOK; tile += F.G) {
        route_tile(F, (const bf16*)(ws + WS_QP), (const bf16*)(ws + WS_SKB), (const float*)(ws + WS_SUMSQ), tile * TOK);
        __syncthreads();
        eval_mf(F, ws + WS_U8, ws + WS_V8, (const float*)(ws + WS_SU), a.in[19], a.out, tile * TOK);
        __syncthreads();
    }
}
}

namespace lru {
typedef float f32x16 __attribute__((ext_vector_type(16)));
constexpr int TOKT = 128, NTILE = SEQ / TOKT;
constexpr int WAVE_LDS = 14336, L_XS = 0, L_XC = 4608, L_GS = 9216, XC_STRIDE = 72  , L_SS = 8 * WAVE_LDS;
static_assert(L_SS + 32 * 8 * 4 <= RING_BYTES, "LRU LDS map");
__device__ __forceinline__ float bf2f(unsigned short h) { return __uint_as_float((unsigned)h << 16); }
__device__ __forceinline__ int crow16(int r) { return (r & 3) + 8 * (r >> 2); }
__device__ __forceinline__ float sigm(float x) { return __builtin_amdgcn_rcpf(1.f + __builtin_amdgcn_exp2f(-LOG2E * x)); }

template <bool FINAL> __device__ __forceinline__ void lru_tile(Frame& F, const Args& args, int tile) {
    int lane = F.lane; asm volatile("" : "+v"(lane));
    const int w = F.wave, j32 = lane & 31, hi = lane >> 5;
    unsigned char* ws = args.ws;
    const bf16* xr = (const bf16*)(ws + WS_XR); const bf16* gr = (const bf16*)(ws + WS_GR); float* carry = (float*)(ws + WS_CARRY);
    const float* cw = args.in[3]; const float* cb = args.in[4]; const float* ba = args.in[6]; const float* bx = args.in[8]; const float* lam = args.in[9];
    const int b = tile / NTILE, jt = tile % NTILE; const size_t trow0 = (size_t)b * SEQ + (size_t)jt * TOKT;
    LAS unsigned char* wl = F.lds + RING_OFF + w * WAVE_LDS;
    LAS unsigned short* XS = (LAS unsigned short*)(wl + L_XS); LAS unsigned short* XC = (LAS unsigned short*)(wl + L_XC); LAS unsigned short* GS = (LAS unsigned short*)(wl + L_GS);
    LAS float* SS = (LAS float*)(F.lds + RING_OFF + L_SS);
    float c_ba[2], c_bx[2], c_sp[2], c_cb[2], c_cw[2][4];
#pragma unroll
    for (int n = 0; n < 2; ++n) { const int c = 64 * w + 32 * n + j32; c_ba[n] = ba[c]; c_bx[n] = bx[c]; c_cb[n] = cb[c];
        const float l = lam[c]; c_sp[n] = 8.f * LOG2E * (fmaxf(-l, 0.f) + log1pf(expf(-fabsf(l))));
#pragma unroll
        for (int k = 0; k < 4; ++k) c_cw[n][k] = cw[k * LW + c]; }
    const bf16* wax = (const bf16*)(ws + WS_WAX);
    float hc[2] = {0.f, 0.f}, ap[2] = {1.f, 1.f};
    if (FINAL) { const float* cin = (const float*)(ws + WS_CIN) + (size_t)(b * NTILE + jt) * LW + 64 * w + j32; hc[0] = cin[0]; hc[1] = cin[32]; }
    v4u pfx[5], pfg[4];
#define LRU_FETCH(B) do { const size_t tbn_ = trow0 + (B) * 32; _Pragma("unroll") for (int q_ = 0; q_ < 5; ++q_) { const int pc_ = lane + 64 * q_, row_ = pc_ >> 3, c8_ = pc_ & 7; \
        const bool z_ = (jt == 0 && (B) == 0 && row_ < 3) || pc_ >= 35 * 8; const v4u v_ = *(const GAS v4u*)(xr + (tbn_ + (z_ ? 3 : row_) - 3) * LW + w * 64 + c8_ * 8); pfx[q_] = z_ ? (v4u){0u, 0u, 0u, 0u} : v_; } \
        if (FINAL) { _Pragma("unroll") for (int q_ = 0; q_ < 4; ++q_) { const int pc_ = lane + 64 * q_; pfg[q_] = *(const GAS v4u*)(gr + (tbn_ + (pc_ >> 3)) * LW + w * 64 + (pc_ & 7) * 8); } } } while (0)
    LRU_FETCH(0);
    for (int blk = 0; blk < 4; ++blk) {
        const size_t tb = trow0 + blk * 32;
        int ln = lane; asm volatile("" : "+v"(ln));
        const int k32 = ln & 31;
#pragma unroll
        for (int q = 0; q < 5; ++q) { const int pc = ln + 64 * q; if (pc < 35 * 8) *(LAS v4u*)((LAS unsigned char*)XS + (pc >> 3) * 128 + (pc & 7) * 16) = pfx[q]; }
        if (FINAL) {
#pragma unroll
            for (int q = 0; q < 4; ++q) { const int pc = ln + 64 * q; *(LAS v4u*)((LAS unsigned char*)GS + (pc >> 3) * 128 + (pc & 7) * 16) = pfg[q]; } }
        if (blk < 3) { LRU_FETCH(blk + 1); }
        asm volatile("" ::: "memory");
        float xc[2][16];
#pragma unroll
        for (int n = 0; n < 2; ++n)
#pragma unroll
            for (int g = 0; g < 4; ++g) { float xv[7];
#pragma unroll
                for (int q = 0; q < 7; ++q) xv[q] = bf2f(XS[(8 * g + 4 * hi + q) * 64 + 32 * n + j32]);
#pragma unroll
                for (int e = 0; e < 4; ++e) xc[n][4 * g + e] = c_cb[n] + ((c_cw[n][0] * xv[e] + c_cw[n][1] * xv[e + 1]) + (c_cw[n][2] * xv[e + 2] + c_cw[n][3] * xv[e + 3])); }
#pragma unroll
        for (int n = 0; n < 2; ++n)
#pragma unroll
            for (int r = 0; r < 16; ++r) XC[(crow16(r) + 4 * hi) * XC_STRIDE + 32 * n + j32] = (unsigned short)f2bf(xc[n][r]);
        asm volatile("" ::: "memory");
        bf16x8 af[4];
#pragma unroll
        for (int ks = 0; ks < 4; ++ks) af[ks] = *(const LAS bf16x8*)(XC + j32 * XC_STRIDE + 16 * ks + 8 * hi);
        asm volatile("" ::: "memory");
        float yv[2][16];
#pragma unroll
        for (int n = 0; n < 2; ++n) {
            f32x16 R = {}, I = {};
            bf16x8 fa[4], fx[4];
#pragma unroll
            for (int ks = 0; ks < 4; ++ks) { fa[ks] = *(const GAS bf16x8*)(wax + (size_t)(((w * 2 + 0) * 2 + n) * 4 + ks) * 512 + ln * 8); fx[ks] = *(const GAS bf16x8*)(wax + (size_t)(((w * 2 + 1) * 2 + n) * 4 + ks) * 512 + ln * 8); }
#pragma unroll
            for (int ks = 0; ks < 4; ++ks) { R = __builtin_amdgcn_mfma_f32_32x32x16_bf16(af[ks], fa[ks], R, 0, 0, 0); I = __builtin_amdgcn_mfma_f32_32x32x16_bf16(af[ks], fx[ks], I, 0, 0, 0); }
            float av[16], uv[16];
#pragma unroll
            for (int r = 0; r < 16; ++r) { const float rg = sigm(R[r] + c_ba[n]), ig = sigm(I[r] + c_bx[n]); const float a_ = __builtin_amdgcn_exp2f(-rg * c_sp[n]);
                av[r] = a_; uv[r] = __builtin_amdgcn_sqrtf(fmaxf(1.f - a_ * a_, 0.f)) * (ig * xc[n][r]); }
            float Ar[4], Hr[4], hst[4];
#pragma unroll
            for (int g = 0; g < 4; ++g) { Ar[g] = (av[4 * g] * av[4 * g + 1]) * (av[4 * g + 2] * av[4 * g + 3]);
                Hr[g] = ((uv[4 * g] * av[4 * g + 1] + uv[4 * g + 1]) * av[4 * g + 2] + uv[4 * g + 2]) * av[4 * g + 3] + uv[4 * g + 3]; }
            float hin = hc[n];
#pragma unroll
            for (int g = 0; g < 4; ++g) { float o1 = Ar[g] * hin + Hr[g]; const float x = __shfl_xor(o1, 32); const float hg = hi ? x : hin; o1 = Ar[g] * hg + Hr[g]; hst[g] = hg;
                const float y = __shfl_xor(o1, 32); hin = hi ? o1 : y;
                if (!FINAL) ap[n] *= Ar[g] * __shfl_xor(Ar[g], 32); }
            hc[n] = hin;
            if (FINAL) {
#pragma unroll
                for (int g = 0; g < 4; ++g) { float h = hst[g];
#pragma unroll
                    for (int e = 0; e < 4; ++e) { const int r = 4 * g + e; h = av[r] * h + uv[r]; yv[n][r] = h * bf2f(GS[(crow16(r) + 4 * hi) * 64 + 32 * n + j32]); } } }
        }
        if (FINAL) {
#pragma unroll
            for (int r = 0; r < 16; ++r) { float s = yv[0][r] * yv[0][r] + yv[1][r] * yv[1][r];
                s += __shfl_xor(s, 1); s += __shfl_xor(s, 2); s += __shfl_xor(s, 4); s += __shfl_xor(s, 8); s += __shfl_xor(s, 16);
                if (j32 == 0) SS[(crow16(r) + 4 * hi) * 8 + w] = s; }
            __syncthreads();
            bf16* ymix = (bf16*)(ws + WS_H);
#pragma unroll
            for (int r = 0; r < 16; ++r) { const int tk = crow16(r) + 4 * hi; const f32x4 s0 = *(const LAS f32x4*)(SS + tk * 8), s1 = *(const LAS f32x4*)(SS + tk * 8 + 4);
                const float rstd = rsqrtf(((s0[0] + s0[1]) + (s0[2] + s0[3]) + (s1[0] + s1[1]) + (s1[2] + s1[3])) * (1.f / LW) + RMS_EPS);
                bf16* yp = ymix + (tb + tk) * DMODEL + 64 * w + k32;
                yp[0] = (bf16)f2bf(yv[0][r] * rstd); yp[32] = (bf16)f2bf(yv[1][r] * rstd); }
            __syncthreads();
        }
    }
#undef LRU_FETCH
    if (!FINAL) { if (hi == 0) { float* cp = carry + ((size_t)(b * NTILE + jt) * 2) * LW + 64 * w + j32;
#pragma unroll
        for (int n = 0; n < 2; ++n) { cp[32 * n] = ap[n]; cp[LW + 32 * n] = hc[n]; } } }
    else {
        const bf16* ob = (const bf16*)(ws + WS_O); bf16* ymix = (bf16*)(ws + WS_H);
        for (int i0 = 0; i0 < 16; i0 += 4) {
            v4u vv[4];
#pragma unroll
            for (int i = 0; i < 4; ++i) vv[i] = *(const GAS v4u*)(ob + (trow0 + 16 * w + i0 + i) * AW + 8 * lane);
            float ssq[4];
#pragma unroll
            for (int i = 0; i < 4; ++i) { float s = 0.f;
#pragma unroll
                for (int c = 0; c < 4; ++c) { const float lo = __uint_as_float(vv[i][c] << 16), hi2 = __uint_as_float(vv[i][c] & 0xffff0000u); s += lo * lo + hi2 * hi2; }
                ssq[i] = s; }
#pragma unroll
            for (int o = 1; o < 64; o <<= 1) {
#pragma unroll
                for (int i = 0; i < 4; ++i) ssq[i] += __shfl_xor(ssq[i], o); }
#pragma unroll
            for (int i = 0; i < 4; ++i) { const float rstd = rsqrtf(ssq[i] * (1.f / AW) + RMS_EPS); v4u o;
#pragma unroll
                for (int c = 0; c < 4; ++c) o[c] = pk2(__uint_as_float(vv[i][c] << 16) * rstd, __uint_as_float(vv[i][c] & 0xffff0000u) * rstd);
                *(GAS v4u*)(ymix + (trow0 + 16 * w + i0 + i) * DMODEL + LW + 8 * lane) = o; } }
    }
}
__device__ __forceinline__ void norm_pass(Frame& F, const Args& a) {
    unsigned char* ws = a.ws; float* nrm = (float*)(ws + WS_NRM);
    const int gw = F.vcu * NWAVES + F.wave, NGW = F.G * NWAVES, lane = F.lane;
    for (int it = gw; it < 2 * BATCH * (SEQ / 64); it += NGW) {
        const int which = it / (BATCH * (SEQ / 64)), r = it % (BATCH * (SEQ / 64)), b = r / (SEQ / 64), t = r % (SEQ / 64);
        const bf16* src = (const bf16*)(ws + (which ? WS_K : WS_Q)) + ((size_t)b * SEQ + 64 * t) * AW + 8 * lane;
        float mx = 0.f;
#pragma unroll 8
        for (int i = 0; i < 64; ++i) { const v4u v = *(const GAS v4u*)(src + (size_t)i * AW); float s = 0.f;
#pragma unroll
            for (int c = 0; c < 4; ++c) { const float lo = __uint_as_float(v[c] << 16), hi = __uint_as_float(v[c] & 0xffff0000u); s += lo * lo + hi * hi; }
            s += __shfl_xor(s, 1); s += __shfl_xor(s, 2); s += __shfl_xor(s, 4); mx = fmaxf(mx, s); }
        if ((lane & 7) == 0) nrm[which * 4096 + (b * NHEADS + (lane >> 3)) * 128 + t] = sqrtf(mx) * 1.0001f;
    }
}
__device__ __forceinline__ void carry_prefix(Frame& F, const Args& a, int b) {
    const float* carry = (const float*)(a.ws + WS_CARRY) + (size_t)b * NTILE * 2 * LW + F.tid; float* cin = (float*)(a.ws + WS_CIN) + (size_t)b * NTILE * LW + F.tid;
    float c = 0.f;
    for (int j0 = 0; j0 < NTILE; j0 += 8) { float A[8], H[8];
#pragma unroll
        for (int j = 0; j < 8; ++j) { A[j] = carry[(size_t)(j0 + j) * 2 * LW]; H[j] = carry[(size_t)(j0 + j) * 2 * LW + LW]; }
#pragma unroll
        for (int j = 0; j < 8; ++j) { cin[(size_t)(j0 + j) * LW] = c; c = A[j] * c + H[j]; } }
}
template <bool FINAL> __device__ __forceinline__ void lru_phase(Frame& F, const Args& a) {
    for (int tile = F.vcu; tile < BATCH * NTILE; tile += F.G) { lru_tile<FINAL>(F, a, tile); __syncthreads(); }
}
}
__global__ void __launch_bounds__(NWAVES * 64, 2) mk_fwd(Args args) {
    extern __shared__ __attribute__((aligned(16))) unsigned char lds[];
    Frame F;
    F.lds = (LAS unsigned char*)lds;
    F.MISC = (volatile LAS unsigned*)(F.lds + MISC_OFF);
    F.wave = __builtin_amdgcn_readfirstlane((int)threadIdx.x >> 6); F.lane = (int)__builtin_amdgcn_mbcnt_hi(~0u, __builtin_amdgcn_mbcnt_lo(~0u, 0u)); F.tid = F.wave * 64 + F.lane;
    F.G = gridDim.x; { const int bx = blockIdx.x; F.vcu = (F.G % 8 == 0) ? (bx % 8) * (F.G / 8) + bx / 8 : bx; }
    unsigned char* ws = args.ws;
    F.ctl = (gu32*)(ws + WS_CTL);
    for (int u = F.tid; u < (LDS_BYTES - LDSCTL_OFF) / 4; u += NWAVES * 64) ((LAS unsigned*)(F.lds + LDSCTL_OFF))[u] = 0u;
    __syncthreads();
    XcdBarrier bar = xcd_barrier_post((unsigned*)(F.ctl + CW_BAR) + args.li * XCD_BAR_WORDS, F.MISC + 8, F.wave);
    const int lo = args.ph_lo, hi = args.ph_hi;
#define IN(k) (lo <= (k) && (k) < hi)
#define BOTH(k) (IN(k) && IN((k) + 1))
#define GRID_BAR() xcd_barrier(bar)

    if (IN(0)) { p0_prologue(F, args); if (BOTH(0)) GRID_BAR(); }

    if (IN(1)) {
        if (F.vcu < BATCH * NHEADS) fcum_unit(F, F.vcu, (const float*)(ws + WS_LOGF), (float*)(ws + WS_FCUM));
        pg8::Gemm g{(const pg8::bf16_t*)(ws + WS_H), (const pg8::bf16_t*)(ws + WS_WIN), T, NG1, DMODEL}; pg8::StaticOrder S; S.init(T, NG1, F.G, (int)blockIdx.x);
        pg8::EpiG1 E{(pg8::bf16_t*)(ws + WS_XR), SPLIT_STRIDE, QSCALE};
        pg8::gemm_phase<pg8::EpiG1, pg8::StaticOrder, true, true>(F.lds + RING_OFF, g, S, E, F.wave);
        if (BOTH(1)) GRID_BAR();
    }
    if (IN(2)) { lru::lru_phase<false>(F, args); lru::norm_pass(F, args); if (BOTH(2)) GRID_BAR(); }
    if (IN(3)) {
        static_assert(attn_body::ATTN_LDS_BYTES <= RING_BYTES, "attention LDS vs frame");
        if (F.vcu < BATCH) lru::carry_prefix(F, args, F.vcu);
        const attn_body::AttnTensors AT{(const attn_body::bf16*)(ws + WS_Q), (const attn_body::bf16*)(ws + WS_K), (const attn_body::bf16*)(ws + WS_V), (attn_body::bf16*)(ws + WS_O), (const float*)(ws + WS_FCUM), (const float*)(ws + WS_NRM)};
        attn_body::attn_phase<8>((char*)lds + RING_OFF, AT, (unsigned*)(F.ctl + CW_ATTQ), F.MISC + 24, F.wave);
        if (BOTH(3)) GRID_BAR();
    }
    if (IN(4)) { lru::lru_phase<true>(F, args); if (BOTH(4)) GRID_BAR(); }
    if (IN(5)) {
        pg8::Gemm g{(const pg8::bf16_t*)(ws + WS_H), (const pg8::bf16_t*)(ws + WS_WOUT), T, DMODEL, DMODEL}; pg8::StaticOrder S; S.init(T, DMODEL, F.G, (int)blockIdx.x);
        pg8::EpiG2 E{args.in[0], args.out, (pg8::bf16_t*)(ws + WS_X1B), (float*)(ws + WS_SUMSQ), DMODEL};
        pg8::gemm_phase<pg8::EpiG2, pg8::StaticOrder, true, true>(F.lds + RING_OFF, g, S, E, F.wave);
        if (BOTH(5)) GRID_BAR();
    }
    if (IN(6)) {
        pg8::Gemm g{(const pg8::bf16_t*)(ws + WS_X1B), (const pg8::bf16_t*)(ws + WS_WQ), T, QPW, DMODEL}; pg8::StaticOrder S; S.init(T, QPW, F.G, (int)blockIdx.x);
        pg8::EpiG3 E{(pg8::bf16_t*)(ws + WS_QP), QPW};
        pg8::gemm_phase<pg8::EpiG3, pg8::StaticOrder, true, true>(F.lds + RING_OFF, g, S, E, F.wave);
        if (BOTH(6)) GRID_BAR();
    }
    if (IN(7)) { peer::peer_phase(F, args); }
#undef IN
#undef BOTH
#undef GRID_BAR
}

extern "C" void kernel_launch(void* const* d_in, const int* in_sizes, int n_in, void* d_out, int out_size, void* d_ws, size_t ws_size, hipStream_t stream) {
    static int grid = 0;
    if (grid == 0) {
        if (n_in != 20 || in_sizes[0] != T * DMODEL || out_size != T * DMODEL || ws_size < WS_END) { fprintf(stderr, "kernel_launch: unexpected shapes (n_in %d, ws %zu)\n", n_in, ws_size); grid = -1; return; }
        int dev = 0, cus = 0;
        if (hipGetDevice(&dev) != hipSuccess || hipDeviceGetAttribute(&cus, hipDeviceAttributeMultiprocessorCount, dev) != hipSuccess) { grid = -1; return; }
        if (hipFuncSetAttribute((const void*)mk_fwd, hipFuncAttributeMaxDynamicSharedMemorySize, LDS_BYTES) != hipSuccess) { fprintf(stderr, "kernel_launch: hipFuncSetAttribute failed\n"); grid = -1; return; }
        (void)hipGetLastError();
        grid = cus;
    }
    if (grid < 0) return;
    if (hipMemsetAsync((char*)d_ws + WS_CTL, 0, CTL_ZERO_BYTES, stream) != hipSuccess) return;
    Args a{};
    for (int i = 0; i < 20; ++i) a.in[i] = (const float*)d_in[i];
    a.out = (float*)d_out; a.ws = (unsigned char*)d_ws; a.ph_lo = 0; a.ph_hi = N_PHASES; a.li = 0;
    hipLaunchKernelGGL(mk_fwd, dim3(grid), dim3(NWAVES * 64), LDS_BYTES, stream, a);
}
```

```cpp
#include <hip/hip_runtime.h>
#include <hip/hip_bf16.h>
#include <cstdio>
#include <cstdint>
#include <cmath>

constexpr int BATCH = 4, SEQ = 8192, DMODEL = 1024, T = BATCH * SEQ;
constexpr int LW = 512, AW = 512, NHEADS = 8, HD = 64, INC = 2568, NG1 = 2560;
constexpr int PH = 8, NKEY = 128, PHALF = 128, TOPK = 16, NEXP = NKEY * NKEY, QPW = 2048;
constexpr float RMS_EPS = 1e-6f;
constexpr float LOG2E = 1.4426950408889634f;
constexpr float QSCALE = 0.125f * LOG2E;
constexpr size_t MiB = 1u << 20;
constexpr size_t WS_CTL = 0, CTL_ZERO_BYTES = 1 * MiB;
constexpr size_t WS_WIN = 2 * MiB, WS_WOUT = 8 * MiB, WS_WQ = 10 * MiB, WS_SKB = 14 * MiB, WS_WFL = 15 * MiB,
                 WS_LOGF = 16 * MiB, WS_FCUM = 17 * MiB, WS_CARRY = 18 * MiB, WS_SUMSQ = 19 * MiB, WS_WAX = 20 * MiB, WS_CIN = 23 * MiB  , WS_NRM = 22 * MiB  ,
                 WS_H = 32 * MiB, WS_XR = 96 * MiB, WS_GR = 128 * MiB, WS_Q = 160 * MiB, WS_K = 192 * MiB, WS_V = 224 * MiB,
                 WS_X1B = 256 * MiB, WS_O = 256 * MiB  , WS_QP = 96 * MiB, WS_UT = 320 * MiB, WS_VT = 352 * MiB, WS_U8 = 320 * MiB, WS_V8 = 336 * MiB, WS_SU = 21 * MiB, WS_SV = 21 * MiB + 65536, WS_LA = 384 * MiB, WS_LU = 448 * MiB, WS_END = 512 * MiB;
constexpr size_t SPLIT_STRIDE = (WS_GR - WS_XR) / 2;
constexpr int CW_TMO = 0, CW_ATTQ = 2048, CW_BAR = 4096;

namespace pg8 {
#define PG8_LAS __attribute__((address_space(3)))
typedef unsigned short bf16_t;
typedef short bf16x8 __attribute__((ext_vector_type(8)));
typedef float f32x4 __attribute__((ext_vector_type(4)));
typedef unsigned u32x4 __attribute__((ext_vector_type(4)));
constexpr int BM = 256, BK = 64, HALF = 128, HTB = HALF * BK * 2  , STAGE_BYTES = 8 * HTB, NXCD = 8, WGM = 8;

__host__ __device__ __forceinline__ int lds_byte(int r, int c) { const int st = (r >> 4) * 2 + (c >> 5), rr = r & 15, cc = c & 31, ob = rr * 64 + cc * 2; return st * 1024 + (ob ^ (((ob >> 9) & 1) << 5)); }
__host__ __device__ __forceinline__ void stage_rc(int b, int& R, int& C) { const int st = b / 1024, sb = b % 1024, swz = sb ^ (((sb >> 9) & 1) << 5); R = (st >> 1) * 16 + swz / 64; C = (st & 1) * 32 + (swz % 64) / 2; }
__host__ __device__ __forceinline__ int perm32(int rho) { const int n = rho >> 4, i = rho & 15; return 8 * (i >> 2) + 4 * n + (i & 3); }

struct Unit { int pm, pn; };
struct Gemm { const bf16_t* A; const bf16_t* Bt; int M, N, K; };

struct StaticOrder {
    int nM, nN, nwg, G, c;
    __host__ __device__ void init(int M, int N, int G_, int c_) { nM = M / BM; nN = N / BM; nwg = nM * nN; G = G_; c = c_; }
    __host__ __device__ bool next(int i, Unit& u) const {
        const long L = (long)i * G + c; if (L >= nwg) return false;
        int wgid = (int)L; { const int q = nwg / NXCD, r = nwg % NXCD, xcd = wgid % NXCD, off = wgid / NXCD; wgid = (xcd < r ? xcd * (q + 1) : r * (q + 1) + (xcd - r) * q) + off; }
        const int nig = WGM * nN, gid = wgid / nig, fm = gid * WGM, gsz = (nM - fm) < WGM ? (nM - fm) : WGM;
        u.pm = fm + ((wgid % nig) % gsz); u.pn = (wgid % nig) / gsz; return true;
    }
    __device__ __forceinline__ void a_ready(const Unit&) const {}
    __device__ __forceinline__ void done(const Unit&) const {}
};

__device__ __forceinline__ unsigned cvt_pk_bf16(float lo, float hi) { unsigned r; asm volatile("v_cvt_pk_bf16_f32 %0, %1, %2" : "=v"(r) : "v"(lo), "v"(hi)); return r; }
typedef unsigned u32x2 __attribute__((ext_vector_type(2)));
__device__ __forceinline__ float gelu_fast(float x) {
    const float u2 = x * (1.5957691216057308f + 0.07135481627f * x * x);
    return x * __builtin_amdgcn_rcpf(1.f + __builtin_amdgcn_exp2f(-1.4426950408889634f * u2));
}
struct EpiG1 {
    static constexpr bool PERM = true, AFTER_DRAIN = false;
    bf16_t* base0; size_t split_stride; float qscale;
    __device__ __forceinline__ void operator()(const f32x4 (&acc)[2][2][4][2], const Unit& u, int wr, int wc, int fr, int fq) const {
        const int s = u.pn >> 1; bf16_t* base = base0 + (size_t)s * split_stride;
        const int row0 = u.pm * BM + wr * 64 + fr, col0 = (u.pn & 1) * 256 + wc * 32 + 8 * fq;
#pragma unroll
        for (int ai = 0; ai < 2; ++ai)
#pragma unroll
            for (int m = 0; m < 4; ++m) { bf16_t* rowp = base + (size_t)(row0 + ai * HALF + m * 16) * 512 + col0;
#pragma unroll
                for (int bj = 0; bj < 2; ++bj) { f32x4 v0 = acc[ai][bj][m][0], v1 = acc[ai][bj][m][1];
                    if (s == 1) {
#pragma unroll
                        for (int e = 0; e < 4; ++e) { v0[e] = gelu_fast(v0[e]); v1[e] = gelu_fast(v1[e]); } }
                    else if (s == 2) { v0 = v0 * qscale; v1 = v1 * qscale; }
                    u32x4 w; w.x = cvt_pk_bf16(v0[0], v0[1]); w.y = cvt_pk_bf16(v0[2], v0[3]); w.z = cvt_pk_bf16(v1[0], v1[1]); w.w = cvt_pk_bf16(v1[2], v1[3]);
                    *(u32x4*)(rowp + bj * HALF) = w; } }
    }
};
struct EpiG2 {
    static constexpr bool PERM = false, AFTER_DRAIN = false;
    const float* resid; float* out; bf16_t* xb; float* sumsq; int ldc;
    __device__ __forceinline__ void operator()(const f32x4 (&acc)[2][2][4][2], const Unit& u, int wr, int wc, int fr, int fq) const {
        const int row0 = u.pm * BM + wr * 64 + fr, col0 = u.pn * BM + wc * 32 + 4 * fq;
#pragma unroll
        for (int ai = 0; ai < 2; ++ai) {
            f32x4 rs[4][2][2];
#pragma unroll
            for (int m = 0; m < 4; ++m) { const size_t off = (size_t)(row0 + ai * HALF + m * 16) * ldc + col0;
#pragma unroll
                for (int bj = 0; bj < 2; ++bj)
#pragma unroll
                    for (int n = 0; n < 2; ++n) rs[m][bj][n] = *(const f32x4*)(resid + off + bj * HALF + n * 16); }
#pragma unroll
            for (int m = 0; m < 4; ++m) { const int r = row0 + ai * HALF + m * 16; const size_t off = (size_t)r * ldc + col0; float ss = 0.f;
#pragma unroll
                for (int bj = 0; bj < 2; ++bj)
#pragma unroll
                    for (int n = 0; n < 2; ++n) { const f32x4 x = rs[m][bj][n] + acc[ai][bj][m][n];
                        *(f32x4*)(out + off + bj * HALF + n * 16) = x; ss += (x[0] * x[0] + x[1] * x[1]) + (x[2] * x[2] + x[3] * x[3]);
                        u32x2 w; w.x = cvt_pk_bf16(x[0], x[1]); w.y = cvt_pk_bf16(x[2], x[3]); *(u32x2*)(xb + off + bj * HALF + n * 16) = w; }
                ss += __shfl_xor(ss, 16); ss += __shfl_xor(ss, 32);
                if (fq == 0) atomicAdd(sumsq + r, ss); }
            asm volatile("" ::: "memory"); }
    }
};
struct EpiG3 {
    static constexpr bool PERM = true, AFTER_DRAIN = false;
    bf16_t* O; int ldc;
    __device__ __forceinline__ void operator()(const f32x4 (&acc)[2][2][4][2], const Unit& u, int wr, int wc, int fr, int fq) const {
        const int row0 = u.pm * BM + wr * 64 + fr;
#pragma unroll
        for (int ai = 0; ai < 2; ++ai)
#pragma unroll
            for (int m = 0; m < 4; ++m) { const int t = row0 + ai * HALF + m * 16;
#pragma unroll
                for (int bj = 0; bj < 2; ++bj) { const f32x4 v0 = acc[ai][bj][m][0], v1 = acc[ai][bj][m][1];
                    u32x4 w; w.x = cvt_pk_bf16(v0[0], v0[1]); w.y = cvt_pk_bf16(v0[2], v0[3]); w.z = cvt_pk_bf16(v1[0], v1[1]); w.w = cvt_pk_bf16(v1[2], v1[3]);
                    *(u32x4*)(O + ((size_t)(((((t >> 5) * 8 + u.pn) * 2 + bj) * 16 + 4 * wc + fq) * 32 + (t & 31))) * 8) = w; } }
    }
};

template <class Epi, class Sched, bool ALIGN_EPI = false, bool SP2 = false>
__device__ __forceinline__ void gemm_phase(PG8_LAS unsigned char* lds, const Gemm g, const Sched& S, const Epi& E, int wid_in) {
    const int wid = __builtin_amdgcn_readfirstlane(wid_in), lane = (int)__builtin_amdgcn_mbcnt_hi(~0u, __builtin_amdgcn_mbcnt_lo(~0u, 0u)), tid = wid * 64 + lane, wr = wid >> 2, wc = wid & 3, fr = lane & 15, fq = lane >> 4;
    const int K = g.K, nt = K / BK;
    unsigned voffA[2], voffB[2];
#pragma unroll
    for (int i = 0; i < 2; ++i) { int R, C; stage_rc(tid * 16 + i * 8192, R, C); const int Rb = Epi::PERM ? ((R & ~31) + perm32(R & 31)) : R;
        voffA[i] = (unsigned)(R * K + C) * 2u; voffB[i] = (unsigned)(Rb * K + C) * 2u; }
    const size_t kstep = (size_t)(BK * 2);
    const size_t hstep = (size_t)HALF * K * 2;
    const size_t tstep = 2 * hstep;
    const unsigned ldsw = (unsigned)wid * 1024u;
    const int aoff = lds_byte(wr * 64 + fr, fq * 8), boff = lds_byte(wc * 32 + fr, fq * 8);
#define PG8_SA(b, h) (((b) * 2 + (h)) * HTB)
#define PG8_SB(b, h) ((4 + (b) * 2 + (h)) * HTB)
#define PG8_STAGE(bufoff, gbase, voff) do { _Pragma("unroll") for (int _i = 0; _i < 2; ++_i) \
        __builtin_amdgcn_global_load_lds((const unsigned*)((const char*)(gbase) + (voff)[_i]), (PG8_LAS unsigned*)(lds + (bufoff) + ldsw + _i * 8192), 16, 0, 0); } while (0)
#define PG8_LDA(dst, b, h) do { _Pragma("unroll") for (int m = 0; m < 4; ++m) _Pragma("unroll") for (int k = 0; k < 2; ++k) dst[m][k] = *(const PG8_LAS bf16x8*)(lds + PG8_SA(b, h) + aoff + m * 2048 + k * 1024); } while (0)
#define PG8_LDB(dst, b, h) do { _Pragma("unroll") for (int n = 0; n < 2; ++n) _Pragma("unroll") for (int k = 0; k < 2; ++k) dst[n][k] = *(const PG8_LAS bf16x8*)(lds + PG8_SB(b, h) + boff + n * 2048 + k * 1024); } while (0)
#define PG8_MMA(ai, bj, At, Bt) do { __builtin_amdgcn_s_setprio(1); _Pragma("unroll") for (int m = 0; m < 4; ++m) _Pragma("unroll") for (int n = 0; n < 2; ++n) _Pragma("unroll") for (int k = 0; k < 2; ++k) \
        acc[ai][bj][m][n] = __builtin_amdgcn_mfma_f32_16x16x32_bf16(Bt[n][k], At[m][k], acc[ai][bj][m][n], 0, 0, 0); __builtin_amdgcn_s_setprio(0); } while (0)
#define PG8_WAIT_V(n) asm volatile("s_waitcnt vmcnt(" #n ")" ::: "memory")
#define PG8_WAIT_L(n) asm volatile("s_waitcnt lgkmcnt(" #n ")" ::: "memory")
#define PG8_BAR __builtin_amdgcn_s_barrier()
#define PG8_SCHED __builtin_amdgcn_sched_barrier(0)
    Unit cur, nxt; int ui = 0;
    if (!S.next(0, cur)) return;
    f32x4 acc[2][2][4][2];
#pragma unroll
    for (int a = 0; a < 2; ++a)
#pragma unroll
        for (int b = 0; b < 2; ++b)
#pragma unroll
            for (int m = 0; m < 4; ++m)
#pragma unroll
                for (int n = 0; n < 2; ++n) acc[a][b][m][n] = (f32x4){0.f, 0.f, 0.f, 0.f};
    bf16x8 At[4][2], B0[2][2], B1[2][2];
    const char* cA = (const char*)g.A + (size_t)cur.pm * tstep; const char* cB = (const char*)g.Bt + (size_t)cur.pn * tstep;
    S.a_ready(cur);
    if constexpr (SP2) {
        PG8_STAGE(PG8_SB(0, 0), cB, voffB); PG8_STAGE(PG8_SB(0, 1), cB + hstep, voffB); PG8_STAGE(PG8_SA(0, 0), cA, voffA); PG8_STAGE(PG8_SA(0, 1), cA + hstep, voffA);
        if (wr == 1) PG8_BAR;
        PG8_WAIT_V(2); PG8_BAR;
        PG8_STAGE(PG8_SB(1, 0), cB + kstep, voffB); PG8_STAGE(PG8_SA(1, 0), cA + kstep, voffA); PG8_STAGE(PG8_SB(1, 1), cB + hstep + kstep, voffB);
        PG8_WAIT_V(6); PG8_BAR;
    } else {
        PG8_STAGE(PG8_SB(0, 0), cB, voffB); PG8_STAGE(PG8_SA(0, 0), cA, voffA); PG8_STAGE(PG8_SB(0, 1), cB + hstep, voffB); PG8_STAGE(PG8_SA(0, 1), cA + hstep, voffA);
        if (wr == 1) PG8_BAR;
        PG8_WAIT_V(4); PG8_BAR;
        PG8_STAGE(PG8_SB(1, 0), cB + kstep, voffB); PG8_STAGE(PG8_SA(1, 0), cA + kstep, voffA); PG8_STAGE(PG8_SB(1, 1), cB + hstep + kstep, voffB);
        PG8_WAIT_V(6); PG8_BAR;
    }
    for (;;) {
        const bool has_next = S.next(ui + 1, nxt);
        const char* nA = has_next ? (const char*)g.A + (size_t)nxt.pm * tstep : cA; const char* nB = has_next ? (const char*)g.Bt + (size_t)nxt.pn * tstep : cB;
        for (int t = 0; t < nt; t += 2) {
            const bool last = (t == nt - 2);
            const char* a1 = cA + (size_t)(t + 1) * kstep;
            const char* a2 = last ? nA : cA + (size_t)(t + 2) * kstep; const char* b2 = last ? nB : cB + (size_t)(t + 2) * kstep;
            const char* a3 = a2 + kstep; const char* b3 = b2 + kstep;
            if (last && has_next) S.a_ready(nxt);
            if constexpr (SP2) {
            PG8_LDB(B0, 0, 0); PG8_LDB(B1, 0, 1); PG8_SCHED; PG8_LDA(At, 0, 0); PG8_STAGE(PG8_SA(1, 1), a1 + hstep, voffA);
            PG8_WAIT_V(8); PG8_WAIT_L(0); PG8_BAR; PG8_MMA(0, 0, At, B0); PG8_MMA(0, 1, At, B1); PG8_BAR; PG8_SCHED;
            PG8_LDA(At, 0, 1); PG8_STAGE(PG8_SB(0, 0), b2, voffB); PG8_STAGE(PG8_SB(0, 1), b2 + hstep, voffB); PG8_STAGE(PG8_SA(0, 0), a2, voffA);
            PG8_WAIT_V(8); PG8_WAIT_L(0); PG8_BAR; PG8_MMA(1, 0, At, B0); PG8_MMA(1, 1, At, B1); PG8_BAR; PG8_SCHED;
            PG8_LDB(B0, 1, 0); PG8_LDB(B1, 1, 1); PG8_SCHED; PG8_LDA(At, 1, 0); PG8_STAGE(PG8_SA(0, 1), a2 + hstep, voffA);
            PG8_WAIT_V(8); PG8_WAIT_L(0); PG8_BAR; PG8_MMA(0, 0, At, B0); PG8_MMA(0, 1, At, B1); PG8_BAR; PG8_SCHED;
            PG8_LDA(At, 1, 1); PG8_STAGE(PG8_SB(1, 0), b3, voffB); PG8_STAGE(PG8_SB(1, 1), b3 + hstep, voffB); PG8_STAGE(PG8_SA(1, 0), a3, voffA);
            PG8_WAIT_V(8); PG8_WAIT_L(0); PG8_BAR; PG8_MMA(1, 0, At, B0); PG8_MMA(1, 1, At, B1); PG8_BAR; PG8_SCHED;
            } else {
            PG8_LDB(B0, 0, 0); PG8_SCHED; PG8_LDA(At, 0, 0); PG8_STAGE(PG8_SA(1, 1), a1 + hstep, voffA);
            PG8_WAIT_L(8); PG8_BAR; PG8_WAIT_L(0); PG8_MMA(0, 0, At, B0); PG8_BAR; PG8_SCHED;
            PG8_LDB(B1, 0, 1); PG8_STAGE(PG8_SB(0, 0), b2, voffB);
            PG8_BAR; PG8_WAIT_L(0); PG8_MMA(0, 1, At, B1); PG8_BAR;
            PG8_LDA(At, 0, 1); PG8_STAGE(PG8_SA(0, 0), a2, voffA);
            PG8_BAR; PG8_WAIT_L(0); PG8_MMA(1, 0, At, B0); PG8_BAR; PG8_SCHED;
            PG8_STAGE(PG8_SB(0, 1), b2 + hstep, voffB);
            PG8_WAIT_V(6); PG8_BAR; PG8_MMA(1, 1, At, B1); PG8_BAR;
            PG8_LDB(B0, 1, 0); PG8_SCHED; PG8_LDA(At, 1, 0); PG8_STAGE(PG8_SA(0, 1), a2 + hstep, voffA);
            PG8_WAIT_L(8); PG8_BAR; PG8_WAIT_L(0); PG8_MMA(0, 0, At, B0); PG8_BAR; PG8_SCHED;
            PG8_LDB(B1, 1, 1); PG8_STAGE(PG8_SB(1, 0), b3, voffB);
            PG8_BAR; PG8_WAIT_L(0); PG8_MMA(0, 1, At, B1); PG8_BAR;
            PG8_LDA(At, 1, 1); PG8_STAGE(PG8_SA(1, 0), a3, voffA);
            PG8_BAR; PG8_WAIT_L(0); PG8_MMA(1, 0, At, B0); PG8_BAR; PG8_SCHED;
            PG8_STAGE(PG8_SB(1, 1), b3 + hstep, voffB);
            PG8_WAIT_V(6); PG8_BAR; PG8_MMA(1, 1, At, B1); PG8_BAR;
            }
        }
        if constexpr (ALIGN_EPI) { if (wr == 0) PG8_BAR; }
        if constexpr (!Epi::AFTER_DRAIN) { E(acc, cur, wr, wc, fr, fq); S.done(cur); }
        if (!has_next) break;
#pragma unroll
        for (int a = 0; a < 2; ++a)
#pragma unroll
            for (int b = 0; b < 2; ++b)
#pragma unroll
                for (int m = 0; m < 4; ++m)
#pragma unroll
                    for (int n = 0; n < 2; ++n) acc[a][b][m][n] = (f32x4){0.f, 0.f, 0.f, 0.f};
        cur = nxt; cA = nA; cB = nB; ++ui;
        if constexpr (ALIGN_EPI) { if (wr == 1) PG8_BAR; }
    }
    PG8_WAIT_V(0);
    if constexpr (!ALIGN_EPI) { if (wr == 0) PG8_BAR; }
    PG8_BAR;
    if constexpr (Epi::AFTER_DRAIN) { E.fused(acc, cur, wr, wc, fr, fq, lds, wid, lane); S.done(cur); }
#undef PG8_SA
#undef PG8_SB
#undef PG8_STAGE
#undef PG8_LDA
#undef PG8_LDB
#undef PG8_MMA
#undef PG8_WAIT_V
#undef PG8_WAIT_L
#undef PG8_BAR
#undef PG8_SCHED
}
}
#include <hip/hip_bf16.h>
#include <cmath>
namespace attn_body {
using bf16=__hip_bfloat16;
using bf16x8=__attribute__((ext_vector_type(8)))short;
using s16x4=__attribute__((ext_vector_type(4)))short;
using f32x16=__attribute__((ext_vector_type(16)))float;
using u32x4=__attribute__((ext_vector_type(4)))unsigned;
constexpr int BATCH=4,NHEAD=8,SEQ=8192,D=64,DM=NHEAD*D;
constexpr int NW=8,QBLK=32,QB=QBLK*NW,KVBLK=64,NQB=SEQ/QB;
constexpr int ATTN_PITCH=DM, ATTN_UNIT_ROWS=QB;
__device__ __forceinline__ int crow(int r,int hi){return (r&3)+8*(r>>2)+4*hi;}
#define SBAR() __builtin_amdgcn_sched_barrier(0)
__device__ __forceinline__ void cmask(f32x16&p0,f32x16&p1,int jb,int qrel,int hi){
  const float NEG=-INFINITY; int kb=64*jb+4*hi;
  #pragma unroll
  for(int r=0;r<16;++r){int kv=kb+(r&3)+8*(r>>2); if(kv>qrel)p0[r]=NEG; if(kv+32>qrel)p1[r]=NEG;}
}

constexpr int NSLOT=3, SLOTB=8192;
constexpr int LDS_K=0, LDS_V=NSLOT*SLOTB, LDS_WS=2*NSLOT*SLOTB, LDS_OST=LDS_WS+NW*64*4, LDS_FK=LDS_OST+NW*4096, LDS_BYTES=LDS_FK+SEQ*4;
constexpr float C2=0.125f*1.4426950408889634f;
__device__ __forceinline__ void glds16(const void*gsrc,unsigned lds_dst){unsigned keep;
  asm volatile("s_mov_b32 %0, m0\n\ts_mov_b32 m0, %2\n\ts_nop 0\n\tglobal_load_lds_dwordx4 %1, off\n\ts_mov_b32 m0, %0":"=&s"(keep):"v"(gsrc),"s"(lds_dst):"memory");}
__device__ __forceinline__ float max3f(float a,float b,float c){float r;asm("v_max3_f32 %0, %1, %2, %3":"=v"(r):"v"(a),"v"(b),"v"(c));return r;}
__device__ __forceinline__ float max2f(float a,float b){float r;asm("v_max_f32_e32 %0, %1, %2":"=v"(r):"v"(a),"v"(b));return r;}
__device__ __forceinline__ float fadd_s(float a,float b){float r;asm("v_add_f32_e32 %0, %1, %2":"=v"(r):"v"(a),"v"(b));return r;}
__device__ __forceinline__ float fsub_s(float a,float b){float r;asm("v_sub_f32_e32 %0, %1, %2":"=v"(r):"v"(a),"v"(b));return r;}
typedef float f32x2_t __attribute__((ext_vector_type(2))); typedef __bf16 bf16x2_t __attribute__((ext_vector_type(2)));
__device__ __forceinline__ unsigned cvtpk_s(float lo,float hi){f32x2_t v={lo,hi};bf16x2_t b=__builtin_convertvector(v,bf16x2_t);return __builtin_bit_cast(unsigned,b);}
#define WAIT_BAR(N) asm volatile("s_waitcnt vmcnt(" #N ") lgkmcnt(0)\n\ts_barrier":::"memory")

__device__ __forceinline__ void qkt(f32x16&p0,f32x16&p1,const char*Kslot,const bf16x8*qr,int r32,int hi){
  const char*kb=Kslot+hi*1024+r32*16;
  #pragma unroll
  for(int d0=0;d0<4;++d0){
    const bf16x8 b0=*reinterpret_cast<const bf16x8*>(kb+d0*2048);
    const bf16x8 b1=*reinterpret_cast<const bf16x8*>(kb+d0*2048+512);
    p0=__builtin_amdgcn_mfma_f32_32x32x16_bf16(b0,qr[d0],p0,0,0,0);p1=__builtin_amdgcn_mfma_f32_32x32x16_bf16(b1,qr[d0],p1,0,0,0);}
}
typedef __attribute__((address_space(3))) const char* lds_cptr;
typedef short v4i16_t __attribute__((ext_vector_type(4)));
__device__ __forceinline__ void kload8(bf16x8*kf,lds_cptr kp){
  kf[0]=*(const __attribute__((address_space(3))) bf16x8*)(kp);      kf[1]=*(const __attribute__((address_space(3))) bf16x8*)(kp+512);
  kf[2]=*(const __attribute__((address_space(3))) bf16x8*)(kp+2048); kf[3]=*(const __attribute__((address_space(3))) bf16x8*)(kp+2560);
  kf[4]=*(const __attribute__((address_space(3))) bf16x8*)(kp+4096); kf[5]=*(const __attribute__((address_space(3))) bf16x8*)(kp+4608);
  kf[6]=*(const __attribute__((address_space(3))) bf16x8*)(kp+6144); kf[7]=*(const __attribute__((address_space(3))) bf16x8*)(kp+6656);
}
__device__ __forceinline__ void kload2(bf16x8*kf,lds_cptr kp,int j){ kf[2*j]=*(const __attribute__((address_space(3))) bf16x8*)(kp+j*2048); kf[2*j+1]=*(const __attribute__((address_space(3))) bf16x8*)(kp+j*2048+512); }
__device__ __forceinline__ s16x4 vtr(lds_cptr p){ return __builtin_bit_cast(s16x4,__builtin_amdgcn_ds_read_tr16_b64_v4i16((__attribute__((address_space(3))) v4i16_t*)p)); }
__device__ __forceinline__ float rowmax(const f32x16&p0,const f32x16&p1){
  float a=max3f(p0[0],p0[1],p1[0]),b=max3f(p0[2],p0[3],p1[1]);a=max3f(a,p1[2],p1[3]);
  #pragma unroll
  for(int r=4;r<16;r+=4){a=max3f(a,p0[r],p0[r+1]);b=max3f(b,p0[r+2],p0[r+3]);a=max3f(a,p1[r],p1[r+1]);b=max3f(b,p1[r+2],p1[r+3]);}
  const float m=max2f(a,b);
  auto rr=__builtin_amdgcn_permlane32_swap(__float_as_uint(m),__float_as_uint(m),false,false);
  return max2f(__uint_as_float(rr[0]),__uint_as_float(rr[1]));
}
__device__ __forceinline__ void pv(f32x16*o,int vb,bf16x8 pa0,bf16x8 pa1,bf16x8 pa2,bf16x8 pa3){
  #pragma unroll
  for(int d0=0;d0<2;++d0){s16x4 lo[4],hi[4];
    #pragma unroll
    for(int ks=0;ks<4;++ks){
      asm volatile("ds_read_b64_tr_b16 %0,%1 offset:%c2":"=&v"(lo[ks]):"v"(vb),"i"(d0*4096+ks*1024):"memory");
      asm volatile("ds_read_b64_tr_b16 %0,%1 offset:%c2":"=&v"(hi[ks]):"v"(vb),"i"(d0*4096+ks*1024+512):"memory");}
    asm volatile("s_waitcnt lgkmcnt(0)":::"memory");SBAR();
    #define PK(k) (bf16x8){lo[k][0],lo[k][1],lo[k][2],lo[k][3],hi[k][0],hi[k][1],hi[k][2],hi[k][3]}
    o[d0]=__builtin_amdgcn_mfma_f32_32x32x16_bf16(pa0,PK(0),o[d0],0,0,0);
    o[d0]=__builtin_amdgcn_mfma_f32_32x32x16_bf16(pa1,PK(1),o[d0],0,0,0);
    o[d0]=__builtin_amdgcn_mfma_f32_32x32x16_bf16(pa2,PK(2),o[d0],0,0,0);
    o[d0]=__builtin_amdgcn_mfma_f32_32x32x16_bf16(pa3,PK(3),o[d0],0,0,0);
    #undef PK
  }
}

#ifndef ATTN_STORE16
#define ATTN_STORE16(p,v) (*(u32x4*)(p)=(v))
#endif
template<int THRL> __device__ __forceinline__ void attn_unit(int b,int h,int qb,const bf16*Q,const bf16*__restrict__ K,const bf16*__restrict__ V,bf16*O,const float*__restrict__ Fc,const float*__restrict__ NRM,char*shm,int wid_in){
  const int wid=__builtin_amdgcn_readfirstlane(wid_in); int lane_=(int)__builtin_amdgcn_mbcnt_hi(~0u,__builtin_amdgcn_mbcnt_lo(~0u,0u)); asm volatile("":"+v"(lane_));
  const int lane=lane_,tid=wid*64+lane,r32=lane&31,hi=lane>>5;
  const long rowbase=(long)b*SEQ; const int q0=qb*QB;
  const float*Fbh=Fc+(long)(b*NHEAD+h)*SEQ;
  const int NTF=(q0+QB)/KVBLK; int t_start;
  { const float*QNb=NRM+(b*NHEAD+h)*128,*KNb=NRM+4096+(b*NHEAD+h)*128;
    const float qn=fmaxf(fmaxf(QNb[4*qb],QNb[4*qb+1]),fmaxf(QNb[4*qb+2],QNb[4*qb+3])),knb=fmaxf(fmaxf(KNb[4*qb],KNb[4*qb+1]),fmaxf(KNb[4*qb+2],KNb[4*qb+3]));
    const float fq0=Fbh[q0]*1.4426950408889634f; bool k0=true,k1=true;
    if(lane<NTF-4)k0=!(qn*(KNb[lane]+knb)+(fq0-Fbh[64*lane+63]*1.4426950408889634f)<-40.f);
    if(lane+64<NTF-4)k1=!(qn*(KNb[lane+64]+knb)+(fq0-Fbh[64*(lane+64)+63]*1.4426950408889634f)<-40.f);
    const unsigned long long m0=__ballot(k0),m1=__ballot(k1);
    int tf=m0?(int)__builtin_ctzll(m0):64+(m1?(int)__builtin_ctzll(m1):64);
    tf=tf<NTF-4?tf:NTF-4; t_start=__builtin_amdgcn_readfirstlane(tf&~1); }
  { typedef float f32x4_t __attribute__((ext_vector_type(4))); __attribute__((address_space(3))) float*fk=(__attribute__((address_space(3))) float*)((__attribute__((address_space(3))) char*)shm+LDS_FK); const int n4=(q0+QB)/4;
    for(int i=16*t_start+tid;i<n4;i+=NW*64){ f32x4_t v=*(const f32x4_t*)(Fbh+4*i); v=v*(-1.4426950408889634f); *(__attribute__((address_space(3))) f32x4_t*)(fk+4*i)=v; } }
  float fq2=Fbh[q0+wid*QBLK+r32]*1.4426950408889634f; asm volatile("":"+v"(fq2));
  const bf16*Qw=Q+(rowbase+q0+wid*QBLK)*DM+h*D;
  const bf16*Kh=K+(rowbase+(long)t_start*KVBLK)*DM+h*D,*Vh=V+(rowbase+(long)t_start*KVBLK)*DM+h*D;
  const lds_cptr shm3=(lds_cptr)shm;
  const unsigned lds0=(unsigned)(uintptr_t)shm;
  float*wsf=(float*)(shm+LDS_WS)+wid*64;
  const bf16*ksrc=Kh+(long)lane*DM+wid*8;
  const bf16*vsrc=Vh+(long)(16*(wid&3)+(lane>>2))*DM+(wid>>2)*32+(lane&3)*8;
  const unsigned kdst=lds0+LDS_K+wid*1024, vdst=lds0+LDS_V+wid*1024;
  #define DMA_K(t,slot) glds16(ksrc+(long)(t)*KVBLK*DM,(unsigned)__builtin_amdgcn_readfirstlane(kdst+(slot)))
  #define DMA_V(t,slot) glds16(vsrc+(long)(t)*KVBLK*DM,(unsigned)__builtin_amdgcn_readfirstlane(vdst+(slot)))
  const int vb0=(int)(lds0+LDS_V)+((lane>>4)&1)*32+(lane&3)*8+(4*hi+((lane&15)>>2))*64;
  const char*Kbase=shm+LDS_K; bf16x8 kf[8];
  const lds_cptr kp0=shm3+LDS_K+hi*1024+r32*16; const lds_cptr vp0=shm3+LDS_V+((lane>>4)&1)*32+(lane&3)*8+(4*hi+((lane&15)>>2))*64;
  const int NT=NTF-t_start;
  DMA_K(0,0);DMA_V(0,0);DMA_K(1,SLOTB);
  bf16x8 qr[4];
  #pragma unroll
  for(int d0=0;d0<4;++d0)qr[d0]=*reinterpret_cast<const bf16x8*>(&Qw[(long)r32*DM+d0*16+hi*8]);
  float mhat=0.f,l_reg=0.f;f32x16 o[2];o[0]=f32x16{};o[1]=f32x16{};
  const __attribute__((address_space(3))) float*fkl=(const __attribute__((address_space(3))) float*)(shm3+LDS_FK)+64*t_start+4*hi;
  #define INITC(C0,C1,t) do{ const float nsc_=fq2-mhat; typedef float f32x4_t __attribute__((ext_vector_type(4))); const __attribute__((address_space(3))) float*kb_=fkl+64*(t); \
    _Pragma("unroll") for(int g_=0;g_<4;++g_){ const f32x4_t a_=*(const __attribute__((address_space(3))) f32x4_t*)(kb_+8*g_), b_=*(const __attribute__((address_space(3))) f32x4_t*)(kb_+32+8*g_); \
      _Pragma("unroll") for(int e_=0;e_<4;++e_){ C0[4*g_+e_]=nsc_+a_[e_]; C1[4*g_+e_]=nsc_+b_[e_]; } } }while(0)
  const int qrel=wid*QBLK+r32;
  #define CMASK(P0,P1,t) do{int jb_=(t)-(NT-4); if(jb_>=0)cmask(P0,P1,jb_,qrel,hi);}while(0)
  bool resc=false;
  #define START(P0,P1) do{ const float rm=rowmax(P0,P1); resc=false; \
    { const float dl=rm; mhat=fadd_s(mhat,dl); \
      _Pragma("unroll") for(int r=0;r<16;++r){P0[r]=fsub_s(P0[r],dl);P1[r]=fsub_s(P1[r],dl);} \
      } \
    _Pragma("unroll") for(int r=0;r<16;++r)P0[r]=__builtin_amdgcn_exp2f(P0[r]); }while(0)
  #define RESC() do{ if(resc){ asm volatile("s_waitcnt lgkmcnt(0)":::"memory"); \
      _Pragma("unroll") for(int d_=0;d_<2;++d_) _Pragma("unroll") for(int r=0;r<16;++r)o[d_][r]*=wsf[crow(r,hi)]; } }while(0)
  f32x16 pA0,pA1,pB0,pB1;
  int sl_prev=0,sl_cur=0,sl_next=SLOTB;
  #define ROT() do{sl_prev=sl_cur;sl_cur=sl_next;sl_next=(sl_next==(NSLOT-1)*SLOTB)?0:sl_next+SLOTB;}while(0)
  DMA_K(2,2*SLOTB);
  WAIT_BAR(3);
  INITC(pA0,pA1,0); qkt(pA0,pA1,Kbase,qr,r32,hi);asm volatile("s_nop 15\n\ts_nop 7":"+v"(pA0),"+v"(pA1));CMASK(pA0,pA1,0);
  START(pA0,pA1);
  _Pragma("unroll") for(int r=0;r<16;++r)pA1[r]=__builtin_amdgcn_exp2f(pA1[r]);
  WAIT_BAR(0);
  DMA_K(3,0);DMA_V(1,SLOTB);
  ROT();
  kload8(kf,kp0+sl_cur);
  WAIT_BAR(2);
  s16x4 vlo[8],vhi[8]; u32x4 pw0,pw1,pw2,pw3;
  #define PKW(P,B) cvtpk_s(P[B],P[B+1])
  #define PAF(k) __builtin_bit_cast(bf16x8,pw##k)
  #define VFR(i) (bf16x8){vlo[i][0],vlo[i][1],vlo[i][2],vlo[i][3],vhi[i][0],vhi[i][1],vhi[i][2],vhi[i][3]}
  #define PIN(x) asm volatile("":"+v"(x))
  #define MX3(a,b,c) __builtin_fmaxf(__builtin_fmaxf((a),(b)),(c))
  #define GAPA(MF,A0,A1,A2,A3,W0,W1,PW) do{ MF; sacc+=A0; sacc+=A1; sacc+=A2; sacc+=A3; PIN(sacc); W0; W1; PIN(PW); SBAR(); }while(0)
  #define EX(v) __builtin_amdgcn_exp2f(v)
  #define GAPB(MF,X,B) do{ MF; X[B]=EX(X[B]); X[B+1]=EX(X[B+1]); X[B+2]=EX(X[B+2]); X[B+3]=EX(X[B+3]); PIN(X); SBAR(); }while(0)
  #define VRD(i) do{ vlo[i]=vtr(vp_+(((i)>>2)*4096+((i)&3)*1024)); vhi[i]=vtr(vp_+(((i)>>2)*4096+((i)&3)*1024+512)); }while(0)
  #define KRD(G,j) do{ if(G){ kload2(kf,kp0+sl_next,j); SBAR(); } }while(0)
  #define STEP(C0,C1,P0,P1,t,GK,GV,GL) do{ SBAR(); INITC(C0,C1,t); PIN(C0); PIN(C1); SBAR(); \
    const lds_cptr vp_=vp0+sl_prev; \
    VRD(0); SBAR(); float sacc=(P0[0]+P0[1]); \
    GAPA(C0=__builtin_amdgcn_mfma_f32_32x32x16_bf16(kf[0],qr[0],C0,0,0,0), P0[2],P0[3],P0[4],P0[5],     pw0[0]=PKW(P0,0), pw0[1]=PKW(P0,2), pw0); \
    VRD(4); SBAR(); GAPA(C1=__builtin_amdgcn_mfma_f32_32x32x16_bf16(kf[1],qr[0],C1,0,0,0), P0[6],P0[7],P0[8],P0[9],     pw0[2]=PKW(P0,4), pw0[3]=PKW(P0,6), pw0); \
    VRD(1); SBAR(); GAPA(C0=__builtin_amdgcn_mfma_f32_32x32x16_bf16(kf[2],qr[1],C0,0,0,0),   P0[10],P0[11],P0[12],P0[13], pw1[0]=PKW(P0,8), pw1[1]=PKW(P0,10), pw1); \
    VRD(5); SBAR(); GAPA(C1=__builtin_amdgcn_mfma_f32_32x32x16_bf16(kf[3],qr[1],C1,0,0,0),   P0[14],P0[15],P1[0],P1[1],   pw1[2]=PKW(P0,12),pw1[3]=PKW(P0,14), pw1); \
    VRD(2); SBAR(); GAPA(C0=__builtin_amdgcn_mfma_f32_32x32x16_bf16(kf[4],qr[2],C0,0,0,0),   P1[2],P1[3],P1[4],P1[5],     pw2[0]=PKW(P1,0), pw2[1]=PKW(P1,2), pw2); \
    VRD(6); SBAR(); GAPA(C1=__builtin_amdgcn_mfma_f32_32x32x16_bf16(kf[5],qr[2],C1,0,0,0),   P1[6],P1[7],P1[8],P1[9],     pw2[2]=PKW(P1,4), pw2[3]=PKW(P1,6), pw2); \
    VRD(3); SBAR(); GAPA(C0=__builtin_amdgcn_mfma_f32_32x32x16_bf16(kf[6],qr[3],C0,0,0,0),   P1[10],P1[11],P1[12],P1[13], pw3[0]=PKW(P1,8), pw3[1]=PKW(P1,10), pw3); \
    VRD(7); SBAR(); GAPA(C1=__builtin_amdgcn_mfma_f32_32x32x16_bf16(kf[7],qr[3],C1,0,0,0),   P1[14],P1[15],0.f,0.f,       pw3[2]=PKW(P1,12),pw3[3]=PKW(P1,14), pw3); \
    l_reg+=sacc; \
    if(GK){DMA_K((t)+3,sl_cur);} if(GV){DMA_V((t)+1,sl_next);} \
    CMASK(C0,C1,t); \
    { float a=MX3(C0[0],C0[1],C1[0]),b=MX3(C0[2],C0[3],C1[1]); a=MX3(a,C1[2],C1[3]); \
      _Pragma("unroll") for(int r=4;r<16;r+=4){a=MX3(a,C0[r],C0[r+1]);b=MX3(b,C0[r+2],C0[r+3]);a=MX3(a,C1[r],C1[r+1]);b=MX3(b,C1[r+2],C1[r+3]);} \
      float rm=__builtin_fmaxf(a,b); { auto rr=__builtin_amdgcn_permlane32_swap(__float_as_uint(rm),__float_as_uint(rm),false,false); rm=__builtin_fmaxf(__uint_as_float(rr[0]),__uint_as_float(rr[1])); } \
      resc=false; \
      if(__builtin_expect(__any(rm>(float)THRL),0)){ const float dl=__builtin_fmaxf(rm,0.f); mhat+=dl; \
        _Pragma("unroll") for(int r=0;r<16;++r){C0[r]-=dl;C1[r]-=dl;} \
        const float f=__builtin_amdgcn_exp2f(-dl); l_reg*=f; if(hi==0)wsf[r32]=f; resc=true; } } \
    SBAR(); \
    GAPB(o[0]=__builtin_amdgcn_mfma_f32_32x32x16_bf16(PAF(0),VFR(0),o[0],0,0,0), C0,0); \
    GAPB(o[1]=__builtin_amdgcn_mfma_f32_32x32x16_bf16(PAF(0),VFR(4),o[1],0,0,0), C0,4); \
    KRD(GL,0); GAPB(o[0]=__builtin_amdgcn_mfma_f32_32x32x16_bf16(PAF(1),VFR(1),o[0],0,0,0), C0,8); \
    KRD(GL,1); GAPB(o[1]=__builtin_amdgcn_mfma_f32_32x32x16_bf16(PAF(1),VFR(5),o[1],0,0,0), C0,12); \
    KRD(GL,2); GAPB(o[0]=__builtin_amdgcn_mfma_f32_32x32x16_bf16(PAF(2),VFR(2),o[0],0,0,0), C1,0); \
    KRD(GL,3); GAPB(o[1]=__builtin_amdgcn_mfma_f32_32x32x16_bf16(PAF(2),VFR(6),o[1],0,0,0), C1,4); \
    GAPB(o[0]=__builtin_amdgcn_mfma_f32_32x32x16_bf16(PAF(3),VFR(3),o[0],0,0,0), C1,8); \
    GAPB(o[1]=__builtin_amdgcn_mfma_f32_32x32x16_bf16(PAF(3),VFR(7),o[1],0,0,0), C1,12); \
    }while(0)
  int t=1;
  #undef CMASK
  #define CMASK(P0,P1,t) do{}while(0)
  for(;t+5<NT;t+=2){
    STEP(pB0,pB1,pA0,pA1,t,true,true,true);     WAIT_BAR(2); RESC(); ROT();
    STEP(pA0,pA1,pB0,pB1,t+1,true,true,true);   WAIT_BAR(2); RESC(); ROT();
  }
  #undef CMASK
  #define CMASK(P0,P1,t) do{int jb_=(t)-(NT-4); if(jb_>=0)cmask(P0,P1,jb_,qrel,hi);}while(0)
  #define ENDW(tt) do{ if((tt)+3<NT){WAIT_BAR(2);} else if((tt)+2<NT){WAIT_BAR(1);} else {WAIT_BAR(0);} }while(0)
  for(;t+1<NT;t+=2){
    STEP(pB0,pB1,pA0,pA1,t,(t+3<NT),(t+1<NT),(t+1<NT));       ENDW(t);   RESC(); ROT();
    STEP(pA0,pA1,pB0,pB1,t+1,(t+4<NT),(t+2<NT),(t+2<NT));     ENDW(t+1); RESC(); ROT();
  }
  STEP(pB0,pB1,pA0,pA1,NT-1,false,false,false); RESC();
  { float sacc=pB0[0]+pB0[1]; _Pragma("unroll") for(int r=2;r<16;++r)sacc+=pB0[r]; _Pragma("unroll") for(int r=0;r<16;++r)sacc+=pB1[r]; l_reg+=sacc;
    pw0=(u32x4){PKW(pB0,0),PKW(pB0,2),PKW(pB0,4),PKW(pB0,6)};pw1=(u32x4){PKW(pB0,8),PKW(pB0,10),PKW(pB0,12),PKW(pB0,14)};pw2=(u32x4){PKW(pB1,0),PKW(pB1,2),PKW(pB1,4),PKW(pB1,6)};pw3=(u32x4){PKW(pB1,8),PKW(pB1,10),PKW(pB1,12),PKW(pB1,14)};
    SBAR(); pv(o,vb0+sl_cur,PAF(0),PAF(1),PAF(2),PAF(3)); }
  #undef PKW
  #undef PAF
  #undef VFR
  #undef PIN
  #undef MX3
  #undef GAPA
  #undef GAPB
  #undef EX
  #undef VRD
  #undef KRD
  #undef STEP
  #undef ENDW
  {auto rr=__builtin_amdgcn_permlane32_swap(__float_as_uint(l_reg),__float_as_uint(l_reg),false,false);l_reg=__uint_as_float(rr[0])+__uint_as_float(rr[1]);}
  if(hi==0)wsf[32+r32]=l_reg;asm volatile("s_waitcnt lgkmcnt(0)":::"memory");
  float rli[16];
  #pragma unroll
  for(int r=0;r<16;++r)rli[r]=__builtin_amdgcn_rcpf(wsf[32+crow(r,hi)]);
  bf16*Ow=O+(rowbase+q0+wid*QBLK)*DM+h*D;
  { bf16*stg=(bf16*)(shm+LDS_OST)+wid*2048;
    #pragma unroll
    for(int r=0;r<16;++r){const int orow=crow(r,hi);
      #pragma unroll
      for(int d0=0;d0<2;++d0)stg[orow*64+d0*32+r32]=__float2bfloat16(o[d0][r]*rli[r]);}
    asm volatile("s_waitcnt lgkmcnt(0)":::"memory");
    #pragma unroll
    for(int i=0;i<4;++i){const int row=i*8+(lane>>3),ch=lane&7; const u32x4 v=*(const u32x4*)(stg+row*64+ch*8); ATTN_STORE16(Ow+(long)row*DM+ch*8,v);} }
  asm volatile("s_waitcnt lgkmcnt(0)\n\ts_barrier":::"memory");
  #undef DMA_K
  #undef DMA_V
  #undef INITC
  #undef CMASK
  #undef START
  #undef RESC
  #undef ROT
}
constexpr int ATTN_LDS_BYTES=LDS_BYTES;
struct AttnTensors { const bf16* Q; const bf16* K; const bf16* V; bf16* O; const float* F; const float* NRM; };
struct AttnUnit { int bh; int qb; };
struct StaticOrder {
  int vcu;
  __device__ __forceinline__ explicit StaticOrder(int grid,int block):vcu((block%8)*(grid/8)+block/8){}
  __device__ __forceinline__ bool next(int i,AttnUnit&u)const{ if(i>=4)return false; const int s=vcu&7; u.bh=vcu>>3; u.qb=(i==0)?s:(i==1)?15-s:(i==2)?16+s:31-s; return true; }
  __device__ __forceinline__ void a_ready(const AttnUnit&)const{}
  __device__ __forceinline__ void done(const AttnUnit&)const{}
};
template<int THRL=8> __device__ __forceinline__ void attn_phase(char*lds,const AttnTensors&T,unsigned*qctr,volatile __attribute__((address_space(3))) unsigned*qword,int wid_in){
  const int lane0=(int)__builtin_amdgcn_mbcnt_hi(~0u,__builtin_amdgcn_mbcnt_lo(~0u,0u));
  for(;;){
    if(wid_in==0&&lane0==0){ const unsigned n=__hip_atomic_fetch_add(qctr,1u,__ATOMIC_RELAXED,__HIP_MEMORY_SCOPE_AGENT); *qword=n; }
    asm volatile("s_waitcnt vmcnt(0) lgkmcnt(0)\n\ts_barrier":::"memory");
    const int n=__builtin_amdgcn_readfirstlane((int)*qword);
    if(n>=BATCH*NHEAD*NQB)break;
    const int bh=n%(BATCH*NHEAD),qb=NQB-1-n/(BATCH*NHEAD);
    attn_unit<THRL>(bh/NHEAD,bh%NHEAD,qb,T.Q,T.K,T.V,T.O,T.F,T.NRM,lds,wid_in);
  }
}
#undef SBAR
#undef WAIT_BAR
}
#define GAS __attribute__((address_space(1)))
#define LAS __attribute__((address_space(3)))
typedef unsigned short bf16;
typedef unsigned v4u __attribute__((ext_vector_type(4)));
typedef float f32x4 __attribute__((ext_vector_type(4)));
typedef short bf16x8 __attribute__((ext_vector_type(8)));
typedef GAS unsigned gu32;
typedef GAS unsigned long long gu64;
#define RLX_AGENT __ATOMIC_RELAXED, __HIP_MEMORY_SCOPE_AGENT
#define LDS_WAIT() asm volatile("s_waitcnt lgkmcnt(0)" ::: "memory")
#define VM_WAIT() asm volatile("s_waitcnt vmcnt(0)" ::: "memory")
__device__ __forceinline__ unsigned long long rt() { return __builtin_amdgcn_s_memrealtime(); }
__device__ __forceinline__ unsigned f2bf(float f) { unsigned u = __builtin_bit_cast(unsigned, f); return (u + 0x7fffu + ((u >> 16) & 1u)) >> 16; }
__device__ __forceinline__ unsigned pk2(float lo, float hi) { return f2bf(lo) | (f2bf(hi) << 16); }

#define XB_TMO      128
#define XB_XCNT(j)  (256  + 64 * (j))
#define XB_XSUB(j)  (1280 + 64 * (j))
#define XB_XGEN(j)  (2304 + 64 * (j))
#define XB_TOP      3328
#define XB_TOPGEN   3392
#define XCD_BAR_WORDS 3456
#define XB_SPIN_CAP (1u << 18)

__device__ __forceinline__ unsigned xb_ld(unsigned* p)              { return __hip_atomic_load(p, __ATOMIC_RELAXED, __HIP_MEMORY_SCOPE_AGENT); }
__device__ __forceinline__ unsigned xb_add(unsigned* p, unsigned v) { return __hip_atomic_fetch_add(p, v, __ATOMIC_RELAXED, __HIP_MEMORY_SCOPE_AGENT); }
__device__ __forceinline__ unsigned xb_xcc_id() { return (unsigned)__builtin_amdgcn_s_getreg((3 << 11) | 20) & 0xFu; }
#define XB_SPIN(cond, bar) do { unsigned _sp = 0; while (cond) { __builtin_amdgcn_s_sleep(1); \
    if ((++_sp & 255u) == 0u) { if (xb_ld(&(bar)[XB_TMO])) break; if (_sp > XB_SPIN_CAP) { atomicAdd(&(bar)[XB_TMO], 1u); break; } } } } while (0)

struct XcdBarrier {
    unsigned* bar; unsigned x; int wv;
    volatile LAS unsigned* st;
};

__device__ __forceinline__ bool xb_t0(int wv) { return wv == 0 && __builtin_amdgcn_mbcnt_hi(~0u, __builtin_amdgcn_mbcnt_lo(~0u, 0u)) == 0u; }
__device__ __forceinline__ XcdBarrier xcd_barrier_post(unsigned* bar, volatile LAS unsigned* st, int wv) {
    XcdBarrier b; b.bar = bar; b.x = xb_xcc_id(); b.st = st; b.wv = wv;
    if (xb_t0(wv)) (void)xb_add(&bar[XB_XCNT(b.x)], 1u);
    return b;
}
__device__ __forceinline__ void xcd_barrier_complete(unsigned* bar, unsigned x, unsigned& nloc, unsigned& nx) {
    const unsigned G = gridDim.x * gridDim.y * gridDim.z;
    unsigned sum, cnt, mine, sp = 0u;
    for (;;) {
        sum = 0u; cnt = 0u; mine = 0u;
#pragma unroll
        for (unsigned j = 0; j < 16; ++j) { const unsigned c = xb_ld(&bar[XB_XCNT(j)]); sum += c; cnt += (c > 0u) ? 1u : 0u; mine = (j == x) ? c : mine; }
        if (sum == G) break;
        __builtin_amdgcn_s_sleep(1);
        if ((++sp & 255u) == 0u) { if (xb_ld(&bar[XB_TMO])) break; if (sp > XB_SPIN_CAP) { atomicAdd(&bar[XB_TMO], 1u); break; } }
    }
    nloc = mine > 0u ? mine : 1u; nx = cnt > 0u ? cnt : 1u;
}

__device__ __forceinline__ void xcd_barrier(const XcdBarrier& b) {
    asm volatile("s_waitcnt vmcnt(0)" ::: "memory");
    __syncthreads();
    if (xb_t0(b.wv)) {
        unsigned* bar = b.bar;
        __builtin_amdgcn_s_waitcnt(0);
        unsigned nloc = b.st[0], nx = b.st[1];
        if (nloc == 0u) { xcd_barrier_complete(bar, b.x, nloc, nx); b.st[0] = nloc; b.st[1] = nx; }
        const unsigned old = xb_add(&bar[XB_XSUB(b.x)], 1u);
        const unsigned gen = old / nloc;
        if (old + 1u == (gen + 1u) * nloc) {
            __builtin_amdgcn_fence(__ATOMIC_RELEASE, "agent");
            asm volatile("s_waitcnt vmcnt(0)" ::: "memory");
            const unsigned og = xb_add(&bar[XB_TOP], 1u);
            const unsigned tg = og / nx;
            if (og + 1u == (tg + 1u) * nx) xb_add(&bar[XB_TOPGEN], 1u);
            else XB_SPIN(xb_ld(&bar[XB_TOPGEN]) == tg, bar);
            __builtin_amdgcn_fence(__ATOMIC_ACQUIRE, "agent");
            xb_add(&bar[XB_XGEN(b.x)], 1u);
            asm volatile("s_waitcnt vmcnt(0)" ::: "memory");
        } else {
            XB_SPIN(xb_ld(&bar[XB_XGEN(b.x)]) == gen, bar);
            __builtin_amdgcn_fence(__ATOMIC_ACQUIRE, "agent");
            asm volatile("s_waitcnt vmcnt(0)" ::: "memory");
        }
    }
    __syncthreads();
}

constexpr int NWAVES = 8;
constexpr int RING_OFF = 0, RING_BYTES = 131072;
constexpr int LDSCTL_OFF = RING_BYTES, MISC_OFF = LDSCTL_OFF + 320;
constexpr int LDS_BYTES = 147456;
constexpr int N_PHASES = 8;

struct Frame {
    LAS unsigned char* lds;
    volatile LAS unsigned* MISC;
    gu32* ctl;
    int tid, lane, wave, vcu, G;
};
__device__ __forceinline__ float wave_sum(float v) {
#pragma unroll
    for (int o = 1; o < 64; o <<= 1) v += __shfl_xor(v, o);
    return v;
}
struct Args { const float* in[20]; float* out; unsigned char* ws; int ph_lo, ph_hi, li, pad; };

__device__ __forceinline__ void p0_transpose_item(const float* W, int ld, int nblk, const float* glo, const float* ghi, int K, bf16* WT, LAS float* scr, int item, int lane) {
    const int kb = item / nblk, nb = item % nblk, k0 = 64 * kb, n0 = 32 * nb;
#pragma unroll 8
    for (int i = 0; i < 32; ++i) { const int kk = 2 * i + (lane >> 5), k = k0 + kk; float w = W[(size_t)k * ld + n0 + (lane & 31)];
        if (glo) w *= (k < K / 2) ? glo[k] : ghi[k - K / 2];
        scr[kk * 33 + (lane & 31)] = w; }
    LDS_WAIT(); asm volatile("" ::: "memory");
    const int c = lane & 7;
#pragma unroll
    for (int j = 0; j < 4; ++j) { const int n = (lane >> 3) + 8 * j; const LAS float* s = scr + (8 * c) * 33 + n;
        v4u o; o.x = pk2(s[0 * 33], s[1 * 33]); o.y = pk2(s[2 * 33], s[3 * 33]); o.z = pk2(s[4 * 33], s[5 * 33]); o.w = pk2(s[6 * 33], s[7 * 33]);
        *(GAS v4u*)(WT + (size_t)(n0 + n) * K + k0 + 8 * c) = o; }
    LDS_WAIT(); asm volatile("" ::: "memory");
}
__device__ __forceinline__ float log_sigmoid(float z) { return fminf(z, 0.f) - log1pf(expf(-fabsf(z))); }

__device__ __forceinline__ void p0_prologue(Frame& F, const Args& a) {
    LAS float* scr = (LAS float*)(F.lds + RING_OFF + F.wave * 16384);
    unsigned char* ws = a.ws;
    const float* x = a.in[0]; const float* g1 = a.in[1]; const float* w_in = a.in[2]; const float* bfv = a.in[10];
    const float* gn_l = a.in[11]; const float* gn_f = a.in[12]; const float* w_out = a.in[13]; const float* g2 = a.in[14];
    const float* w_q = a.in[15]; const float* sk = a.in[16]; const float* pu = a.in[17]; const float* pv = a.in[18];
    bf16* win_t = (bf16*)(ws + WS_WIN); bf16* wout_t = (bf16*)(ws + WS_WOUT); bf16* wq_t = (bf16*)(ws + WS_WQ); bf16* skb = (bf16*)(ws + WS_SKB);
    float* logf = (float*)(ws + WS_LOGF); float* sumsq = (float*)(ws + WS_SUMSQ); bf16* h = (bf16*)(ws + WS_H);
    const int gw = F.vcu * NWAVES + F.wave, NGW = F.G * NWAVES, lane = F.lane;
    constexpr int I_IN = (DMODEL / 64) * (NG1 / 32), I_OUT = (DMODEL / 64) * (DMODEL / 32), I_Q = (DMODEL / 64) * (QPW / 32);
    constexpr int I_FL = 8 * DMODEL / 64, I_SK = PH * 2 * NKEY * PHALF / 512, I_SS = T / 64, I_WAX = 8 * 2 * 2 * 4;
    constexpr int E0 = I_IN, E1 = E0 + I_OUT, E2 = E1 + I_Q, E3 = E2 + I_FL, E4 = E3 + I_SK, E5 = E4 + I_SS, E6 = E5 + I_WAX;
    for (int it = gw; it < E6; it += NGW) {
        if (it < E0) { p0_transpose_item(w_in, INC, NG1 / 32, nullptr, nullptr, DMODEL, win_t, scr, it, lane); continue; }
        if (it < E1) { p0_transpose_item(w_out, DMODEL, DMODEL / 32, gn_l, gn_f, DMODEL, wout_t, scr, it - E0, lane); continue; }
        if (it < E2) { p0_transpose_item(w_q, QPW, QPW / 32, g2, g2 + DMODEL / 2, DMODEL, wq_t, scr, it - E1, lane); continue; }
        if (it < E3) continue;
        if (it < E4) { const size_t i = (size_t)(it - E3) * 512 + lane * 8; const f32x4 s0 = *(const GAS f32x4*)(sk + i), s1 = *(const GAS f32x4*)(sk + i + 4);
            v4u o; o.x = pk2(s0[0], s0[1]); o.y = pk2(s0[2], s0[3]); o.z = pk2(s1[0], s1[1]); o.w = pk2(s1[2], s1[3]);
            { const size_t hp = i >> 14; const int key = (int)(i >> 7) & 127, c8 = (int)(i >> 3) & 15; *(GAS v4u*)(skb + hp * 16384 + ((size_t)((((key >> 5) * 2 + (c8 & 1)) * 8 + (c8 >> 1)) * 32 + (key & 31))) * 8) = o; } continue; }
        if (it < E5) { sumsq[(it - E4) * 64 + lane] = 0.f; continue; }
        { const int f = it - E5, ks = f & 3, n = (f >> 2) & 1, mat = (f >> 3) & 1, hh = f >> 4; const float* wsrc = mat ? a.in[7] : a.in[5];
          const size_t o = ((size_t)(hh * 64 + 16 * ks + 8 * (lane >> 5))) * 64 + 32 * n + (lane & 31);
          v4u pw; pw.x = pk2(wsrc[o], wsrc[o + 64]); pw.y = pk2(wsrc[o + 128], wsrc[o + 192]); pw.z = pk2(wsrc[o + 256], wsrc[o + 320]); pw.w = pk2(wsrc[o + 384], wsrc[o + 448]);
          *(GAS v4u*)((bf16*)(ws + WS_WAX) + (size_t)f * 512 + lane * 8) = pw; }
    }
    { f32x4 gg[4];
#pragma unroll
      for (int j = 0; j < 4; ++j) gg[j] = *(const GAS f32x4*)(g2 + 16 * lane + 4 * j);
      unsigned char* u4 = ws + WS_U8; unsigned char* v4 = ws + WS_V8; float* su = (float*)(ws + WS_SU);
      for (int e = gw; e < NEXP; e += NGW) {
        const GAS f32x4* ur = (const GAS f32x4*)(pu + (size_t)e * DMODEL + 16 * lane); const GAS f32x4* vr = (const GAS f32x4*)(pv + (size_t)e * DMODEL + 16 * lane);
        f32x4 uu[4], vv[4]; float mu = 0.f, mv = 0.f;
#pragma unroll
        for (int j = 0; j < 4; ++j) { uu[j] = ur[j] * gg[j]; vv[j] = vr[j];
#pragma unroll
            for (int c = 0; c < 4; ++c) { mu = fmaxf(mu, fabsf(uu[j][c])); mv = fmaxf(mv, fabsf(vv[j][c])); } }
#pragma unroll
        for (int o = 1; o < 64; o <<= 1) { mu = fmaxf(mu, __shfl_xor(mu, o)); mv = fmaxf(mv, __shfl_xor(mv, o)); }
        const float scu = mu > 0.f ? mu * (1.f / 6.f) : 1.f, scv = mv > 0.f ? mv * (1.f / 6.f) : 1.f, iu = 1.f / scu, iv = 1.f / scv;
        unsigned qu0 = 0u, qu1 = 0u, qv0 = 0u, qv1 = 0u;
#define P0_Q4(Q, X, INV, B0, B1) do { Q = __builtin_amdgcn_cvt_scalef32_pk_fp4_f32(Q, X[0] * INV, X[1] * INV, 1.0f, B0); Q = __builtin_amdgcn_cvt_scalef32_pk_fp4_f32(Q, X[2] * INV, X[3] * INV, 1.0f, B1); } while (0)
        P0_Q4(qu0, uu[0], iu, 0, 1); P0_Q4(qu0, uu[1], iu, 2, 3); P0_Q4(qu1, uu[2], iu, 0, 1); P0_Q4(qu1, uu[3], iu, 2, 3);
        P0_Q4(qv0, vv[0], iv, 0, 1); P0_Q4(qv0, vv[1], iv, 2, 3); P0_Q4(qv1, vv[2], iv, 0, 1); P0_Q4(qv1, vv[3], iv, 2, 3);
#undef P0_Q4
        *(GAS unsigned long long*)(u4 + (size_t)e * 512 + 8 * lane) = (unsigned long long)qu0 | ((unsigned long long)qu1 << 32);
        { unsigned char* vrow = v4 + (size_t)e * 512 + 2 * (lane >> 2);
          *(GAS unsigned short*)(vrow + 32 * (4 * (lane & 3) + 0)) = (unsigned short)(qv0 & 0xffffu); *(GAS unsigned short*)(vrow + 32 * (4 * (lane & 3) + 1)) = (unsigned short)(qv0 >> 16);
          *(GAS unsigned short*)(vrow + 32 * (4 * (lane & 3) + 2)) = (unsigned short)(qv1 & 0xffffu); *(GAS unsigned short*)(vrow + 32 * (4 * (lane & 3) + 3)) = (unsigned short)(qv1 >> 16); }
        if (lane == 0) { su[2 * e] = scu; su[2 * e + 1] = scv; }
      } }
    { f32x4 gg[4];
#pragma unroll
      for (int j = 0; j < 4; ++j) gg[j] = *(const GAS f32x4*)(g1 + 256 * j + 4 * lane);
      float fw[4][4][8];
#pragma unroll
      for (int j = 0; j < 4; ++j)
#pragma unroll
          for (int c = 0; c < 4; ++c) { const int k = 256 * j + 4 * lane + c; const GAS f32x4* wr = (const GAS f32x4*)(w_in + (size_t)k * INC + NG1); const f32x4 w0 = wr[0], w1 = wr[1];
#pragma unroll
              for (int e = 0; e < 4; ++e) { fw[j][c][e] = w0[e]; fw[j][c][4 + e] = w1[e]; } }
      for (int t0 = gw; t0 < T; t0 += 2 * NGW) {
        const int t1 = (t0 + NGW < T) ? t0 + NGW : t0;
        const GAS f32x4* xr0 = (const GAS f32x4*)(x + (size_t)t0 * DMODEL) + lane; const GAS f32x4* xr1 = (const GAS f32x4*)(x + (size_t)t1 * DMODEL) + lane;
        f32x4 va[4], vb[4]; float sa = 0.f, sb = 0.f;
#pragma unroll
        for (int j = 0; j < 4; ++j) { va[j] = xr0[64 * j]; vb[j] = xr1[64 * j]; }
#pragma unroll
        for (int j = 0; j < 4; ++j) { sa += (va[j][0] * va[j][0] + va[j][1] * va[j][1]) + (va[j][2] * va[j][2] + va[j][3] * va[j][3]); sb += (vb[j][0] * vb[j][0] + vb[j][1] * vb[j][1]) + (vb[j][2] * vb[j][2] + vb[j][3] * vb[j][3]); }
        const float ra = rsqrtf(wave_sum(sa) * (1.f / DMODEL) + RMS_EPS), rb = rsqrtf(wave_sum(sb) * (1.f / DMODEL) + RMS_EPS);
        GAS unsigned long long* ha = (GAS unsigned long long*)(h + (size_t)t0 * DMODEL) + lane; GAS unsigned long long* hb = (GAS unsigned long long*)(h + (size_t)t1 * DMODEL) + lane;
#pragma unroll
        for (int j = 0; j < 4; ++j) { va[j] = va[j] * ra * gg[j]; vb[j] = vb[j] * rb * gg[j];
            ha[64 * j] = (unsigned long long)pk2(va[j][0], va[j][1]) | ((unsigned long long)pk2(va[j][2], va[j][3]) << 32);
            hb[64 * j] = (unsigned long long)pk2(vb[j][0], vb[j][1]) | ((unsigned long long)pk2(vb[j][2], vb[j][3]) << 32); }
        float fa[8], fb[8];
#pragma unroll
        for (int hh = 0; hh < 8; ++hh) { fa[hh] = 0.f; fb[hh] = 0.f; }
#pragma unroll
        for (int j = 0; j < 4; ++j)
#pragma unroll
            for (int c = 0; c < 4; ++c) {
#pragma unroll
                for (int hh = 0; hh < 8; ++hh) { fa[hh] += va[j][c] * fw[j][c][hh]; fb[hh] += vb[j][c] * fw[j][c][hh]; } }
        float resa = 0.f, resb = 0.f;
#pragma unroll
        for (int hh = 0; hh < 8; ++hh) { const float s0 = wave_sum(fa[hh]), s1 = wave_sum(fb[hh]); if (lane == hh) { resa = s0; resb = s1; } }
        if (lane < 8) { logf[(size_t)t0 * 8 + lane] = log_sigmoid(resa + bfv[lane]); logf[(size_t)t1 * 8 + lane] = log_sigmoid(resb + bfv[lane]); }
      } }
}

__device__ __forceinline__ void fcum_unit(Frame& F, int bh, const float* logf, float* fcum) {
    const int b = bh / NHEADS, hh = bh % NHEADS, s0 = F.tid * 16;
    float v[16]; float loc = 0.f;
#pragma unroll
    for (int i = 0; i < 16; ++i) { v[i] = logf[((size_t)b * SEQ + s0 + i) * 8 + hh]; loc += v[i]; }
    float inc = loc;
#pragma unroll
    for (int o = 1; o < 64; o <<= 1) { const float n = __shfl_up(inc, o); if (F.lane >= o) inc += n; }
    if (F.lane == 63) F.MISC[16 + F.wave] = __float_as_uint(inc);
    __syncthreads();
    float run = inc - loc;
    for (int w = 0; w < F.wave; ++w) run += __uint_as_float(F.MISC[16 + w]);
#pragma unroll
    for (int i = 0; i < 16; ++i) { run += v[i]; fcum[(size_t)bh * SEQ + s0 + i] = run; }
    __syncthreads();
}


namespace peer {
typedef unsigned u32;
typedef float f32x16 __attribute__((ext_vector_type(16)));
constexpr int TOK = 128;
constexpr int EX_STRIDE = 136, GT_STRIDE = 136;
constexpr int L_EX = 0, L_GT = L_EX + TOK * EX_STRIDE * 2, L_IDX = L_GT + TOK * GT_STRIDE * 2, IDX_STRIDE = 36, L_RST = L_IDX + 512 * IDX_STRIDE, L_BI = L_RST + TOK * 4, BI_WAVE = 4352, L_END = L_BI + 8 * BI_WAVE;
static_assert(L_END <= RING_BYTES && L_GT % 16 == 0 && L_IDX % 16 == 0, "PEER LDS map");
__device__ __forceinline__ u32 ordmap(float f) { const u32 u = __float_as_uint(f); return u ^ ((u32)((int)u >> 31) | 0x80000000u); }
__device__ __forceinline__ float unordmap(u32 k) { const u32 u = (k & 0x80000000u) ? (k ^ 0x80000000u) : ~k; return __uint_as_float(u); }
__device__ __forceinline__ u32 umin_(u32 a, u32 b) { return a < b ? a : b; }
__device__ __forceinline__ u32 umax_(u32 a, u32 b) { return a > b ? a : b; }
template <bool DESC> __device__ __forceinline__ void sort16(u32 (&k)[16]) {
#pragma unroll
    for (int size = 2; size <= 16; size <<= 1)
#pragma unroll
        for (int stride = size >> 1; stride > 0; stride >>= 1)
#pragma unroll
            for (int i = 0; i < 16; ++i) { const int j = i ^ stride;
                if (j > i) { const bool asc = (((i & size) == 0) != DESC); const u32 a = k[i], b = k[j], lo = umin_(a, b), hi = umax_(a, b); k[i] = asc ? lo : hi; k[j] = asc ? hi : lo; } }
}
template <bool DESC> __device__ __forceinline__ void merge16(u32 (&k)[16]) {
#pragma unroll
    for (int stride = 8; stride > 0; stride >>= 1)
#pragma unroll
        for (int i = 0; i < 16; ++i) { const int j = i ^ stride;
            if (j > i) { const u32 a = k[i], b = k[j], lo = umin_(a, b), hi = umax_(a, b); k[i] = DESC ? hi : lo; k[j] = DESC ? lo : hi; } }
}
__host__ __device__ constexpr int ccnt(int a) { return 16 / (a + 1); }
__host__ __device__ constexpr int cbase(int a) { int s = 0; for (int i = 0; i < a; ++i) s += ccnt(i); return s; }
static_assert(cbase(16) == 50, "hyperbola candidate count");
__device__ __forceinline__ int crow16(int r) { return (r & 3) + 8 * (r >> 2); }

__device__ __forceinline__ void route_tile(Frame& F, const bf16* qp, const bf16* skb, const float* sumsq, int t0) {
    int lane = F.lane; asm volatile("" : "+v"(lane));
    const int r32 = lane & 31, hi = lane >> 5, w = F.wave;
    LAS unsigned short* EXL = (LAS unsigned short*)(F.lds + RING_OFF + L_EX);
    LAS unsigned short* GTL = (LAS unsigned short*)(F.lds + RING_OFF + L_GT);
    LAS unsigned char* IDXB = F.lds + RING_OFF + L_IDX + (w * 64 + lane) * IDX_STRIDE;
    LAS float* RST = (LAS float*)(F.lds + RING_OFF + L_RST);
    for (int g = 0; g < 4; ++g) {
        const int tok = 32 * g + r32; const size_t trow = (size_t)(t0 + tok);
        const float rstd2 = rsqrtf(sumsq[trow] * (1.f / DMODEL) + RMS_EPS);
        if (w == 0 && hi == 0) RST[tok] = rstd2;
        u32 s0[16], s1[16];
#pragma unroll
        for (int p = 0; p < 2; ++p) {
            bf16x8 qf[8];
#pragma unroll
            for (int ks = 0; ks < 8; ++ks) qf[ks] = *(const GAS bf16x8*)(qp + ((size_t)((((trow >> 5) * 8 + w) * 2 + p) * 16 + 2 * ks + hi) * 32 + r32) * 8);
            u32 run[16];
#pragma unroll
            for (int nb = 0; nb < 4; ++nb) {
                f32x16 acc = {};
                const bf16* kr = skb + (size_t)(w * 2 + p) * 16384 + ((size_t)((nb * 2 + hi) * 8 * 32 + r32)) * 8;
#pragma unroll
                for (int ks = 0; ks < 8; ++ks) acc = __builtin_amdgcn_mfma_f32_32x32x16_bf16(*(const GAS bf16x8*)(kr + ks * 256), qf[ks], acc, 0, 0, 0);
                asm volatile("" ::: "memory");
                u32 blk[16];
#pragma unroll
                for (int r = 0; r < 16; ++r) blk[r] = (ordmap(acc[r]) & ~0x7Fu) | (u32)(127 - 32 * nb - crow16(r) - 4 * hi);
                if (nb == 0) { sort16<true>(blk);
#pragma unroll
                    for (int i = 0; i < 16; ++i) run[i] = blk[i]; }
                else { sort16<false>(blk);
#pragma unroll
                    for (int i = 0; i < 16; ++i) run[i] = umax_(run[i], blk[i]);
                    merge16<true>(run); }
            }
            u32 oth[16];
#pragma unroll
            for (int i = 0; i < 16; ++i) oth[i] = (u32)__shfl_xor((int)run[15 - i], 32);
#pragma unroll
            for (int i = 0; i < 16; ++i) run[i] = umax_(run[i], oth[i]);
            merge16<true>(run);
#pragma unroll
            for (int i = 0; i < 16; ++i) { if (p == 0) s0[i] = run[i]; else s1[i] = run[i]; }
        }
        { LAS u32* iw = (LAS u32*)IDXB;
#pragma unroll
          for (int j = 0; j < 4; ++j) {
              iw[j] = (127u - (s0[4 * j] & 127u)) | ((127u - (s0[4 * j + 1] & 127u)) << 8) | ((127u - (s0[4 * j + 2] & 127u)) << 16) | ((127u - (s0[4 * j + 3] & 127u)) << 24);
              iw[4 + j] = (127u - (s1[4 * j] & 127u)) | ((127u - (s1[4 * j + 1] & 127u)) << 8) | ((127u - (s1[4 * j + 2] & 127u)) << 16) | ((127u - (s1[4 * j + 3] & 127u)) << 24); } }
        float v1[16], v2[16];
#pragma unroll
        for (int i = 0; i < 16; ++i) { v1[i] = unordmap(s0[i] & ~0x7Fu); v2[i] = unordmap(s1[i] & ~0x7Fu); }
        u32 c0[16], c1[16], c2[16], c3[16];
#pragma unroll
        for (int a = 0; a < 16; ++a)
#pragma unroll
            for (int b = 0; b < ccnt(a); ++b) { const int pos = cbase(a) + b; const u32 key = (ordmap(v1[a] + v2[b]) & ~0xFFu) | (u32)(255 - (a * 16 + b));
                if (pos < 16) c0[pos] = key; else if (pos < 32) c1[pos - 16] = key; else if (pos < 48) c2[pos - 32] = key; else c3[pos - 48] = key; }
#pragma unroll
        for (int i = 2; i < 16; ++i) c3[i] = 0u;
        sort16<false>(c1);
#pragma unroll
        for (int i = 0; i < 16; ++i) c0[i] = umax_(c0[i], c1[i]);
        merge16<true>(c0);
        sort16<false>(c2);
#pragma unroll
        for (int i = 0; i < 16; ++i) c0[i] = umax_(c0[i], c2[i]);
        merge16<true>(c0);
        sort16<false>(c3);
#pragma unroll
        for (int i = 0; i < 16; ++i) c0[i] = umax_(c0[i], c3[i]);
        merge16<true>(c0);
        const float m = unordmap(c0[0] & ~0xFFu) * rstd2;
        float e[8]; float sum = 0.f; u32 ex[8];
#pragma unroll
        for (int k = 0; k < 8; ++k) { const u32 key = hi ? c0[k + 8] : c0[k]; const float ts = unordmap(key & ~0xFFu);
            e[k] = __builtin_amdgcn_exp2f((ts * rstd2 - m) * LOG2E); sum += e[k];
            const u32 flat = 255u - (key & 255u); ex[k] = (u32)IDXB[flat >> 4] * NKEY + (u32)IDXB[16 + (flat & 15u)]; }
        sum += __shfl_xor(sum, 32);
        const float inv = 1.f / sum;
        v4u exw; exw.x = ex[0] | (ex[1] << 16); exw.y = ex[2] | (ex[3] << 16); exw.z = ex[4] | (ex[5] << 16); exw.w = ex[6] | (ex[7] << 16);
        *(LAS v4u*)(EXL + tok * EX_STRIDE + w * 16 + hi * 8) = exw;
        *(LAS v4u*)(GTL + tok * GT_STRIDE + w * 16 + hi * 8) = (v4u){pk2(e[0] * inv, e[1] * inv), pk2(e[2] * inv, e[3] * inv), pk2(e[4] * inv, e[5] * inv), pk2(e[6] * inv, e[7] * inv)};
    }
}
__device__ __forceinline__ float gelu_fast(float x) {
    const float u2 = x * (1.5957691216057308f + 0.07135481627f * x * x);
    return x * __builtin_amdgcn_rcpf(1.f + __builtin_amdgcn_exp2f(-1.4426950408889634f * u2));
}
typedef float f32x2 __attribute__((ext_vector_type(2)));

__device__ __forceinline__ void sort128(u32 (&k)[8], int m) {
#pragma unroll
    for (int K = 2; K <= 128; K <<= 1) {
#pragma unroll
        for (int S = K >> 1; S > 0; S >>= 1) {
            if (S >= 8) {
                const int mm = S >> 3; const bool lower = (m & mm) == 0, up = (K == 128) ? true : ((m & (K >> 3)) == 0), keepmin = (lower == up);
#pragma unroll
                for (int r = 0; r < 8; ++r) { const u32 o = (u32)__shfl_xor((int)k[r], mm); const u32 mn = umin_(k[r], o), mx = umax_(k[r], o); k[r] = keepmin ? mn : mx; }
            } else {
#pragma unroll
                for (int r = 0; r < 8; ++r) { const int r2 = r ^ S;
                    if (r2 > r) { const u32 a = k[r], b = k[r2], mn = umin_(a, b), mx = umax_(a, b);
                        if (K < 8) { const bool up = (r & K) == 0; k[r] = up ? mn : mx; k[r2] = up ? mx : mn; }
                        else { const bool up = (K == 128) ? true : ((m & (K >> 3)) == 0); k[r] = up ? mn : mx; k[r2] = up ? mx : mn; } } }
            }
        }
    }
}
typedef int v8i __attribute__((ext_vector_type(8)));
typedef unsigned u2v __attribute__((ext_vector_type(2)));
__device__ __forceinline__ void eval_mf(Frame& F, const unsigned char* u4, const unsigned char* v4, const float* suv, const float* fg, float* out, int t0) {
    int lane = F.lane; asm volatile("" : "+v"(lane));
    const int g = lane >> 4, m = lane & 15;
    LAS unsigned short* EXL = (LAS unsigned short*)(F.lds + RING_OFF + L_EX);
    LAS unsigned short* GTL = (LAS unsigned short*)(F.lds + RING_OFF + L_GT);
    LAS unsigned char* BI = F.lds + RING_OFF + L_BI + F.wave * BI_WAVE;
    const LAS float* RST = (const LAS float*)(F.lds + RING_OFF + L_RST);
    LAS u32* SKW = (LAS u32*)(F.lds + RING_OFF + L_IDX) + F.wave * 512;
    LAS u32* SK = SKW + g * 128;
    for (int pass = 0; pass < 4; ++pass) {
        const int tb4 = 32 * pass + 4 * F.wave, tok = tb4 + g;
        LAS unsigned short* exr = EXL + tok * EX_STRIDE; LAS unsigned short* gtr = GTL + tok * GT_STRIDE;
        { u32 k[8]; const v4u ev = *(const LAS v4u*)(exr + 8 * m); const u32 s0 = (u32)(8 * m);
          k[0] = ((ev.x & 0xffffu) << 7) | s0; k[1] = ((ev.x >> 16) << 7) | (s0 + 1); k[2] = ((ev.y & 0xffffu) << 7) | (s0 + 2); k[3] = ((ev.y >> 16) << 7) | (s0 + 3);
          k[4] = ((ev.z & 0xffffu) << 7) | (s0 + 4); k[5] = ((ev.z >> 16) << 7) | (s0 + 5); k[6] = ((ev.w & 0xffffu) << 7) | (s0 + 6); k[7] = ((ev.w >> 16) << 7) | (s0 + 7);
          sort128(k, m);
          u32 wv[8];
#pragma unroll
          for (int r = 0; r < 8; ++r) wv[r] = ((k[r] >> 7) << 16) | (u32)gtr[k[r] & 127u];
          *(LAS v4u*)(SK + m * 8) = (v4u){wv[0], wv[1], wv[2], wv[3]}; *(LAS v4u*)(SK + m * 8 + 4) = (v4u){wv[4], wv[5], wv[6], wv[7]};
          *(LAS v4u*)(exr + 8 * m) = (v4u){(k[0] >> 7) | ((k[1] >> 7) << 16), (k[2] >> 7) | ((k[3] >> 7) << 16), (k[4] >> 7) | ((k[5] >> 7) << 16), (k[6] >> 7) | ((k[7] >> 7) << 16)}; }
        asm volatile("" ::: "memory");
        {
#pragma unroll
            for (int tq = 0; tq < 4; ++tq) { const float rq = RST[tb4 + tq]; const float* xr = out + (size_t)(t0 + tb4 + tq) * DMODEL + 4 * lane;
#pragma unroll
                for (int c = 0; c < 4; ++c) { const f32x4 xa = *(const GAS f32x4*)(xr + 256 * c); int w = 0;
                    w = __builtin_amdgcn_cvt_pk_fp8_f32(xa[0] * rq, xa[1] * rq, w, false); w = __builtin_amdgcn_cvt_pk_fp8_f32(xa[2] * rq, xa[3] * rq, w, true);
                    const int d = 256 * c + 4 * lane, st = d >> 7, dd = d & 127, hh = dd >> 6, e = dd & 63;
                    *(LAS int*)(BI + ((st * 4 + tq) * 4 + (e >> 4)) * 32 + hh * 16 + (e & 15)) = w; } }
        }
        asm volatile("" ::: "memory");
        v8i hb[8];
#pragma unroll
        for (int st = 0; st < 8; ++st) { v4u b0 = *(const LAS v4u*)(BI + ((st * 4 + (m & 3)) * 4 + g) * 32), b1 = *(const LAS v4u*)(BI + ((st * 4 + (m & 3)) * 4 + g) * 32 + 16);
            if (m >= 4) { b0 = (v4u){0u, 0u, 0u, 0u}; b1 = b0; }
            hb[st] = (v8i){(int)b0.x, (int)b0.y, (int)b0.z, (int)b0.w, (int)b1.x, (int)b1.y, (int)b1.z, (int)b1.w}; }
        asm volatile("" ::: "memory");
#define PEER_BAR() do { asm volatile("" ::: "memory"); __builtin_amdgcn_sched_barrier(0); } while (0)
#define PEER_LOADU(UA, KQ, SC, I) do { KQ = *(const LAS v4u*)(SK + (I)); _Pragma("unroll") for (int s4 = 0; s4 < 4; ++s4) { const u32 e_ = KQ[s4] >> 16; const u32 ro_ = e_ * 512u + 16u * (u32)m; \
            UA[s4][0] = *(const GAS v4u*)(u4 + ro_); UA[s4][1] = *(const GAS v4u*)(u4 + ro_ + 256); SC[s4] = *(const GAS f32x2*)(suv + 2 * e_); } } while (0)
#define PEER_TRANSP(UA) do { _Pragma("unroll") for (int hf = 0; hf < 2; ++hf) { \
                _Pragma("unroll") for (int s4 = 0; s4 < 4; ++s4) *(LAS v4u*)(BI + (4 * s4 + g) * 272 + 16 * m) = UA[s4][hf]; \
                asm volatile("" ::: "memory"); \
                _Pragma("unroll") for (int st = 0; st < 4; ++st) af[4 * hf + st] = *(const LAS v4u*)(BI + m * 272 + 64 * st + 16 * g); \
                asm volatile("" ::: "memory"); } } while (0)
#define PEER_DOTS(KQ, SC, I) do { f32x4 D = (f32x4){0.f, 0.f, 0.f, 0.f}; \
            _Pragma("unroll") for (int st = 0; st < 8; ++st) { const v8i a8 = (v8i){(int)af[st].x, (int)af[st].y, (int)af[st].z, (int)af[st].w, 0, 0, 0, 0}; \
                D = __builtin_amdgcn_mfma_scale_f32_16x16x128_f8f6f4(a8, hb[st], D, 4, 0, 0, 0x7f7f7f7f, 0, 0x7f7f7f7f); } \
            const int sel = lane & 3; const float mine = sel == 0 ? D[0] : sel == 1 ? D[1] : sel == 2 ? D[2] : D[3]; float act[4]; \
            _Pragma("unroll") for (int s4 = 0; s4 < 4; ++s4) { const float pre = __uint_as_float((unsigned)__builtin_amdgcn_ds_bpermute(4 * (g + 16 * s4), (int)__float_as_uint(mine))); \
                act[s4] = gelu_fast(pre * SC[s4][0]) * (__uint_as_float(KQ[s4] << 16) * SC[s4][1]); } \
            if (m == 0) *(LAS u2v*)(gtr + (I)) = (u2v){pk2(act[0], act[1]), pk2(act[2], act[3])}; } while (0)
        v4u kqA, kqB, uaA[4][2], uaB[4][2], af[8]; f32x2 scA[4], scB[4];
        PEER_LOADU(uaA, kqA, scA, 0);
        for (int i = 0; i < 128; i += 8) {
            PEER_TRANSP(uaA);
            PEER_LOADU(uaB, kqB, scB, i + 4);
            PEER_BAR();
            PEER_DOTS(kqA, scA, i);
            PEER_BAR();
            PEER_TRANSP(uaB);
            PEER_LOADU(uaA, kqA, scA, (i + 8 < 128) ? i + 8 : i + 4);
            PEER_BAR();
            PEER_DOTS(kqB, scB, i + 4);
            PEER_BAR();
        }
    }
    asm volatile("" ::: "memory");
    for (int pass = 0; pass < 4; ++pass) {
        const int tb4 = 32 * pass + 4 * F.wave, tok = tb4 + g;
        const LAS unsigned short* exr = EXL + tok * EX_STRIDE; const LAS unsigned short* acr = GTL + tok * GT_STRIDE;
        f32x2 y[32];
#pragma unroll
        for (int q = 0; q < 32; ++q) y[q] = (f32x2){0.f, 0.f};
        float* xrow = out + (size_t)(t0 + tok) * DMODEL + 4 * m;
#define PEER_LOADV(VB, I) do { const u2v e2_ = *(const LAS u2v*)(exr + (I)); _Pragma("unroll") for (int s4 = 0; s4 < 4; ++s4) { const u32 e_ = (s4 & 1) ? (e2_[s4 >> 1] >> 16) : (e2_[s4 >> 1] & 0xffffu); \
            const u32 ro_ = e_ * 512u + 32u * (u32)m; VB[s4][0] = *(const GAS v4u*)(v4 + ro_); VB[s4][1] = *(const GAS v4u*)(v4 + ro_ + 16); } } while (0)
#define PEER_FMAV(VB, I) do { const u2v a2_ = *(const LAS u2v*)(acr + (I)); _Pragma("unroll") for (int s4 = 0; s4 < 4; ++s4) { \
            const float act_ = (s4 & 1) ? __uint_as_float(a2_[s4 >> 1] & 0xffff0000u) : __uint_as_float(a2_[s4 >> 1] << 16); const f32x2 b2_ = (f32x2){act_, act_}; \
            _Pragma("unroll") for (int c = 0; c < 2; ++c) _Pragma("unroll") for (int d = 0; d < 4; ++d) { const unsigned w_ = VB[s4][c][d]; const int hq = 16 * c + 4 * d; \
                y[hq] = __builtin_elementwise_fma(__builtin_amdgcn_cvt_scalef32_pk_f32_fp4(w_, 1.0f, 0), b2_, y[hq]); y[hq + 1] = __builtin_elementwise_fma(__builtin_amdgcn_cvt_scalef32_pk_f32_fp4(w_, 1.0f, 1), b2_, y[hq + 1]); \
                y[hq + 2] = __builtin_elementwise_fma(__builtin_amdgcn_cvt_scalef32_pk_f32_fp4(w_, 1.0f, 2), b2_, y[hq + 2]); y[hq + 3] = __builtin_elementwise_fma(__builtin_amdgcn_cvt_scalef32_pk_f32_fp4(w_, 1.0f, 3), b2_, y[hq + 3]); } } } while (0)
        v4u vbA[4][2], vbB[4][2];
        PEER_LOADV(vbA, 0);
        for (int i = 0; i < 128; i += 8) {
            PEER_LOADV(vbB, i + 4);
            PEER_BAR();
            PEER_FMAV(vbA, i);
            PEER_BAR();
            PEER_LOADV(vbA, (i + 8 < 128) ? i + 8 : i + 4);
            PEER_BAR();
            PEER_FMAV(vbB, i + 4);
            PEER_BAR();
        }
        float ss = 0.f;
#pragma unroll
        for (int q = 0; q < 16; ++q) { const f32x4 xa = *(const GAS f32x4*)(xrow + 64 * q); y[2 * q][0] += xa[0]; y[2 * q][1] += xa[1]; y[2 * q + 1][0] += xa[2]; y[2 * q + 1][1] += xa[3];
            ss += (y[2 * q][0] * y[2 * q][0] + y[2 * q][1] * y[2 * q][1]) + (y[2 * q + 1][0] * y[2 * q + 1][0] + y[2 * q + 1][1] * y[2 * q + 1][1]); }
        ss += __shfl_xor(ss, 1); ss += __shfl_xor(ss, 2); ss += __shfl_xor(ss, 4); ss += __shfl_xor(ss, 8);
        const float rs = rsqrtf(ss * (1.f / DMODEL) + RMS_EPS);
        asm volatile("" ::: "memory");
#pragma unroll
        for (int q = 0; q < 16; ++q) { const f32x4 gq = *(const GAS f32x4*)(fg + 64 * q + 4 * m); f32x4 o; o[0] = y[2 * q][0] * rs * gq[0]; o[1] = y[2 * q][1] * rs * gq[1]; o[2] = y[2 * q + 1][0] * rs * gq[2]; o[3] = y[2 * q + 1][1] * rs * gq[3];
            *(GAS f32x4*)(xrow + 64 * q) = o; }
    }
}
__device__ __forceinline__ void peer_phase(Frame& F, const Args& a) {
    unsigned char* ws = a.ws;
    for (int tile = F.vcu; tile < T / TOK; tile += F.G) {
        route_tile(F, (const bf16*)(ws + WS_QP), (const bf16*)(ws + WS_SKB), (const float*)(ws + WS_SUMSQ), tile * TOK);
        __syncthreads();
        eval_mf(F, ws + WS_U8, ws + WS_V8, (const float*)(ws + WS_SU), a.in[19], a.out, tile * TOK);
        __syncthreads();
    }
}
}

namespace lru {
typedef float f32x16 __attribute__((ext_vector_type(16)));
constexpr int TOKT = 128, NTILE = SEQ / TOKT;
constexpr int WAVE_LDS = 14336, L_XS = 0, L_XC = 4608, L_GS = 9216, XC_STRIDE = 72  , L_SS = 8 * WAVE_LDS;
static_assert(L_SS + 32 * 8 * 4 <= RING_BYTES, "LRU LDS map");
__device__ __forceinline__ float bf2f(unsigned short h) { return __uint_as_float((unsigned)h << 16); }
__device__ __forceinline__ int crow16(int r) { return (r & 3) + 8 * (r >> 2); }
__device__ __forceinline__ float sigm(float x) { return __builtin_amdgcn_rcpf(1.f + __builtin_amdgcn_exp2f(-LOG2E * x)); }

template <bool FINAL> __device__ __forceinline__ void lru_tile(Frame& F, const Args& args, int tile) {
    int lane = F.lane; asm volatile("" : "+v"(lane));
    const int w = F.wave, j32 = lane & 31, hi = lane >> 5;
    unsigned char* ws = args.ws;
    const bf16* xr = (const bf16*)(ws + WS_XR); const bf16* gr = (const bf16*)(ws + WS_GR); float* carry = (float*)(ws + WS_CARRY);
    const float* cw = args.in[3]; const float* cb = args.in[4]; const float* ba = args.in[6]; const float* bx = args.in[8]; const float* lam = args.in[9];
    const int b = tile / NTILE, jt = tile % NTILE; const size_t trow0 = (size_t)b * SEQ + (size_t)jt * TOKT;
    LAS unsigned char* wl = F.lds + RING_OFF + w * WAVE_LDS;
    LAS unsigned short* XS = (LAS unsigned short*)(wl + L_XS); LAS unsigned short* XC = (LAS unsigned short*)(wl + L_XC); LAS unsigned short* GS = (LAS unsigned short*)(wl + L_GS);
    LAS float* SS = (LAS float*)(F.lds + RING_OFF + L_SS);
    float c_ba[2], c_bx[2], c_sp[2], c_cb[2], c_cw[2][4];
#pragma unroll
    for (int n = 0; n < 2; ++n) { const int c = 64 * w + 32 * n + j32; c_ba[n] = ba[c]; c_bx[n] = bx[c]; c_cb[n] = cb[c];
        const float l = lam[c]; c_sp[n] = 8.f * LOG2E * (fmaxf(-l, 0.f) + log1pf(expf(-fabsf(l))));
#pragma unroll
        for (int k = 0; k < 4; ++k) c_cw[n][k] = cw[k * LW + c]; }
    const bf16* wax = (const bf16*)(ws + WS_WAX);
    float hc[2] = {0.f, 0.f}, ap[2] = {1.f, 1.f};
    if (FINAL) { const float* cin = (const float*)(ws + WS_CIN) + (size_t)(b * NTILE + jt) * LW + 64 * w + j32; hc[0] = cin[0]; hc[1] = cin[32]; }
    v4u pfx[5], pfg[4];
#define LRU_FETCH(B) do { const size_t tbn_ = trow0 + (B) * 32; _Pragma("unroll") for (int q_ = 0; q_ < 5; ++q_) { const int pc_ = lane + 64 * q_, row_ = pc_ >> 3, c8_ = pc_ & 7; \
        const bool z_ = (jt == 0 && (B) == 0 && row_ < 3) || pc_ >= 35 * 8; const v4u v_ = *(const GAS v4u*)(xr + (tbn_ + (z_ ? 3 : row_) - 3) * LW + w * 64 + c8_ * 8); pfx[q_] = z_ ? (v4u){0u, 0u, 0u, 0u} : v_; } \
        if (FINAL) { _Pragma("unroll") for (int q_ = 0; q_ < 4; ++q_) { const int pc_ = lane + 64 * q_; pfg[q_] = *(const GAS v4u*)(gr + (tbn_ + (pc_ >> 3)) * LW + w * 64 + (pc_ & 7) * 8); } } } while (0)
    LRU_FETCH(0);
    for (int blk = 0; blk < 4; ++blk) {
        const size_t tb = trow0 + blk * 32;
        int ln = lane; asm volatile("" : "+v"(ln));
        const int k32 = ln & 31;
#pragma unroll
        for (int q = 0; q < 5; ++q) { const int pc = ln + 64 * q; if (pc < 35 * 8) *(LAS v4u*)((LAS unsigned char*)XS + (pc >> 3) * 128 + (pc & 7) * 16) = pfx[q]; }
        if (FINAL) {
#pragma unroll
            for (int q = 0; q < 4; ++q) { const int pc = ln + 64 * q; *(LAS v4u*)((LAS unsigned char*)GS + (pc >> 3) * 128 + (pc & 7) * 16) = pfg[q]; } }
        if (blk < 3) { LRU_FETCH(blk + 1); }
        asm volatile("" ::: "memory");
        float xc[2][16];
#pragma unroll
        for (int n = 0; n < 2; ++n)
#pragma unroll
            for (int g = 0; g < 4; ++g) { float xv[7];
#pragma unroll
                for (int q = 0; q < 7; ++q) xv[q] = bf2f(XS[(8 * g + 4 * hi + q) * 64 + 32 * n + j32]);
#pragma unroll
                for (int e = 0; e < 4; ++e) xc[n][4 * g + e] = c_cb[n] + ((c_cw[n][0] * xv[e] + c_cw[n][1] * xv[e + 1]) + (c_cw[n][2] * xv[e + 2] + c_cw[n][3] * xv[e + 3])); }
#pragma unroll
        for (int n = 0; n < 2; ++n)
#pragma unroll
            for (int r = 0; r < 16; ++r) XC[(crow16(r) + 4 * hi) * XC_STRIDE + 32 * n + j32] = (unsigned short)f2bf(xc[n][r]);
        asm volatile("" ::: "memory");
        bf16x8 af[4];
#pragma unroll
        for (int ks = 0; ks < 4; ++ks) af[ks] = *(const LAS bf16x8*)(XC + j32 * XC_STRIDE + 16 * ks + 8 * hi);
        asm volatile("" ::: "memory");
        float yv[2][16];
#pragma unroll
        for (int n = 0; n < 2; ++n) {
            f32x16 R = {}, I = {};
            bf16x8 fa[4], fx[4];
#pragma unroll
            for (int ks = 0; ks < 4; ++ks) { fa[ks] = *(const GAS bf16x8*)(wax + (size_t)(((w * 2 + 0) * 2 + n) * 4 + ks) * 512 + ln * 8); fx[ks] = *(const GAS bf16x8*)(wax + (size_t)(((w * 2 + 1) * 2 + n) * 4 + ks) * 512 + ln * 8); }
#pragma unroll
            for (int ks = 0; ks < 4; ++ks) { R = __builtin_amdgcn_mfma_f32_32x32x16_bf16(af[ks], fa[ks], R, 0, 0, 0); I = __builtin_amdgcn_mfma_f32_32x32x16_bf16(af[ks], fx[ks], I, 0, 0, 0); }
            float av[16], uv[16];
#pragma unroll
            for (int r = 0; r < 16; ++r) { const float rg = sigm(R[r] + c_ba[n]), ig = sigm(I[r] + c_bx[n]); const float a_ = __builtin_amdgcn_exp2f(-rg * c_sp[n]);
                av[r] = a_; uv[r] = __builtin_amdgcn_sqrtf(fmaxf(1.f - a_ * a_, 0.f)) * (ig * xc[n][r]); }
            float Ar[4], Hr[4], hst[4];
#pragma unroll
            for (int g = 0; g < 4; ++g) { Ar[g] = (av[4 * g] * av[4 * g + 1]) * (av[4 * g + 2] * av[4 * g + 3]);
                Hr[g] = ((uv[4 * g] * av[4 * g + 1] + uv[4 * g + 1]) * av[4 * g + 2] + uv[4 * g + 2]) * av[4 * g + 3] + uv[4 * g + 3]; }
            float hin = hc[n];
#pragma unroll
            for (int g = 0; g < 4; ++g) { float o1 = Ar[g] * hin + Hr[g]; const float x = __shfl_xor(o1, 32); const float hg = hi ? x : hin; o1 = Ar[g] * hg + Hr[g]; hst[g] = hg;
                const float y = __shfl_xor(o1, 32); hin = hi ? o1 : y;
                if (!FINAL) ap[n] *= Ar[g] * __shfl_xor(Ar[g], 32); }
            hc[n] = hin;
            if (FINAL) {
#pragma unroll
                for (int g = 0; g < 4; ++g) { float h = hst[g];
#pragma unroll
                    for (int e = 0; e < 4; ++e) { const int r = 4 * g + e; h = av[r] * h + uv[r]; yv[n][r] = h * bf2f(GS[(crow16(r) + 4 * hi) * 64 + 32 * n + j32]); } } }
        }
        if (FINAL) {
#pragma unroll
            for (int r = 0; r < 16; ++r) { float s = yv[0][r] * yv[0][r] + yv[1][r] * yv[1][r];
                s += __shfl_xor(s, 1); s += __shfl_xor(s, 2); s += __shfl_xor(s, 4); s += __shfl_xor(s, 8); s += __shfl_xor(s, 16);
                if (j32 == 0) SS[(crow16(r) + 4 * hi) * 8 + w] = s; }
            __syncthreads();
            bf16* ymix = (bf16*)(ws + WS_H);
#pragma unroll
            for (int r = 0; r < 16; ++r) { const int tk = crow16(r) + 4 * hi; const f32x4 s0 = *(const LAS f32x4*)(SS + tk * 8), s1 = *(const LAS f32x4*)(SS + tk * 8 + 4);
                const float rstd = rsqrtf(((s0[0] + s0[1]) + (s0[2] + s0[3]) + (s1[0] + s1[1]) + (s1[2] + s1[3])) * (1.f / LW) + RMS_EPS);
                bf16* yp = ymix + (tb + tk) * DMODEL + 64 * w + k32;
                yp[0] = (bf16)f2bf(yv[0][r] * rstd); yp[32] = (bf16)f2bf(yv[1][r] * rstd); }
            __syncthreads();
        }
    }
#undef LRU_FETCH
    if (!FINAL) { if (hi == 0) { float* cp = carry + ((size_t)(b * NTILE + jt) * 2) * LW + 64 * w + j32;
#pragma unroll
        for (int n = 0; n < 2; ++n) { cp[32 * n] = ap[n]; cp[LW + 32 * n] = hc[n]; } } }
    else {
        const bf16* ob = (const bf16*)(ws + WS_O); bf16* ymix = (bf16*)(ws + WS_H);
        for (int i0 = 0; i0 < 16; i0 += 4) {
            v4u vv[4];
#pragma unroll
            for (int i = 0; i < 4; ++i) vv[i] = *(const GAS v4u*)(ob + (trow0 + 16 * w + i0 + i) * AW + 8 * lane);
            float ssq[4];
#pragma unroll
            for (int i = 0; i < 4; ++i) { float s = 0.f;
#pragma unroll
                for (int c = 0; c < 4; ++c) { const float lo = __uint_as_float(vv[i][c] << 16), hi2 = __uint_as_float(vv[i][c] & 0xffff0000u); s += lo * lo + hi2 * hi2; }
                ssq[i] = s; }
#pragma unroll
            for (int o = 1; o < 64; o <<= 1) {
#pragma unroll
                for (int i = 0; i < 4; ++i) ssq[i] += __shfl_xor(ssq[i], o); }
#pragma unroll
            for (int i = 0; i < 4; ++i) { const float rstd = rsqrtf(ssq[i] * (1.f / AW) + RMS_EPS); v4u o;
#pragma unroll
                for (int c = 0; c < 4; ++c) o[c] = pk2(__uint_as_float(vv[i][c] << 16) * rstd, __uint_as_float(vv[i][c] & 0xffff0000u) * rstd);
                *(GAS v4u*)(ymix + (trow0 + 16 * w + i0 + i) * DMODEL + LW + 8 * lane) = o; } }
    }
}
__device__ __forceinline__ void norm_pass(Frame& F, const Args& a) {
    unsigned char* ws = a.ws; float* nrm = (float*)(ws + WS_NRM);
    const int gw = F.vcu * NWAVES + F.wave, NGW = F.G * NWAVES, lane = F.lane;
    for (int it = gw; it < 2 * BATCH * (SEQ / 64); it += NGW) {
        const int which = it / (BATCH * (SEQ / 64)), r = it % (BATCH * (SEQ / 64)), b = r / (SEQ / 64), t = r % (SEQ / 64);
        const bf16* src = (const bf16*)(ws + (which ? WS_K : WS_Q)) + ((size_t)b * SEQ + 64 * t) * AW + 8 * lane;
        float mx = 0.f;
#pragma unroll 8
        for (int i = 0; i < 64; ++i) { const v4u v = *(const GAS v4u*)(src + (size_t)i * AW); float s = 0.f;
#pragma unroll
            for (int c = 0; c < 4; ++c) { const float lo = __uint_as_float(v[c] << 16), hi = __uint_as_float(v[c] & 0xffff0000u); s += lo * lo + hi * hi; }
            s += __shfl_xor(s, 1); s += __shfl_xor(s, 2); s += __shfl_xor(s, 4); mx = fmaxf(mx, s); }
        if ((lane & 7) == 0) nrm[which * 4096 + (b * NHEADS + (lane >> 3)) * 128 + t] = sqrtf(mx) * 1.0001f;
    }
}
__device__ __forceinline__ void carry_prefix(Frame& F, const Args& a, int b) {
    const float* carry = (const float*)(a.ws + WS_CARRY) + (size_t)b * NTILE * 2 * LW + F.tid; float* cin = (float*)(a.ws + WS_CIN) + (size_t)b * NTILE * LW + F.tid;
    float c = 0.f;
    for (int j0 = 0; j0 < NTILE; j0 += 8) { float A[8], H[8];
#pragma unroll
        for (int j = 0; j < 8; ++j) { A[j] = carry[(size_t)(j0 + j) * 2 * LW]; H[j] = carry[(size_t)(j0 + j) * 2 * LW + LW]; }
#pragma unroll
        for (int j = 0; j < 8; ++j) { cin[(size_t)(j0 + j) * LW] = c; c = A[j] * c + H[j]; } }
}
template <bool FINAL> __device__ __forceinline__ void lru_phase(Frame& F, const Args& a) {
    for (int tile = F.vcu; tile < BATCH * NTILE; tile += F.G) { lru_tile<FINAL>(F, a, tile); __syncthreads(); }
}
}
__global__ void __launch_bounds__(NWAVES * 64, 2) mk_fwd(Args args) {
    extern __shared__ __attribute__((aligned(16))) unsigned char lds[];
    Frame F;
    F.lds = (LAS unsigned char*)lds;
    F.MISC = (volatile LAS unsigned*)(F.lds + MISC_OFF);
    F.wave = __builtin_amdgcn_readfirstlane((int)threadIdx.x >> 6); F.lane = (int)__builtin_amdgcn_mbcnt_hi(~0u, __builtin_amdgcn_mbcnt_lo(~0u, 0u)); F.tid = F.wave * 64 + F.lane;
    F.G = gridDim.x; { const int bx = blockIdx.x; F.vcu = (F.G % 8 == 0) ? (bx % 8) * (F.G / 8) + bx / 8 : bx; }
    unsigned char* ws = args.ws;
    F.ctl = (gu32*)(ws + WS_CTL);
    for (int u = F.tid; u < (LDS_BYTES - LDSCTL_OFF) / 4; u += NWAVES * 64) ((LAS unsigned*)(F.lds + LDSCTL_OFF))[u] = 0u;
    __syncthreads();
    XcdBarrier bar = xcd_barrier_post((unsigned*)(F.ctl + CW_BAR) + args.li * XCD_BAR_WORDS, F.MISC + 8, F.wave);
    const int lo = args.ph_lo, hi = args.ph_hi;
#define IN(k) (lo <= (k) && (k) < hi)
#define BOTH(k) (IN(k) && IN((k) + 1))
#define GRID_BAR() xcd_barrier(bar)

    if (IN(0)) { p0_prologue(F, args); if (BOTH(0)) GRID_BAR(); }

    if (IN(1)) {
        if (F.vcu < BATCH * NHEADS) fcum_unit(F, F.vcu, (const float*)(ws + WS_LOGF), (float*)(ws + WS_FCUM));
        pg8::Gemm g{(const pg8::bf16_t*)(ws + WS_H), (const pg8::bf16_t*)(ws + WS_WIN), T, NG1, DMODEL}; pg8::StaticOrder S; S.init(T, NG1, F.G, (int)blockIdx.x);
        pg8::EpiG1 E{(pg8::bf16_t*)(ws + WS_XR), SPLIT_STRIDE, QSCALE};
        pg8::gemm_phase<pg8::EpiG1, pg8::StaticOrder, true, true>(F.lds + RING_OFF, g, S, E, F.wave);
        if (BOTH(1)) GRID_BAR();
    }
    if (IN(2)) { lru::lru_phase<false>(F, args); lru::norm_pass(F, args); if (BOTH(2)) GRID_BAR(); }
    if (IN(3)) {
        static_assert(attn_body::ATTN_LDS_BYTES <= RING_BYTES, "attention LDS vs frame");
        if (F.vcu < BATCH) lru::carry_prefix(F, args, F.vcu);
        const attn_body::AttnTensors AT{(const attn_body::bf16*)(ws + WS_Q), (const attn_body::bf16*)(ws + WS_K), (const attn_body::bf16*)(ws + WS_V), (attn_body::bf16*)(ws + WS_O), (const float*)(ws + WS_FCUM), (const float*)(ws + WS_NRM)};
        attn_body::attn_phase<8>((char*)lds + RING_OFF, AT, (unsigned*)(F.ctl + CW_ATTQ), F.MISC + 24, F.wave);
        if (BOTH(3)) GRID_BAR();
    }
    if (IN(4)) { lru::lru_phase<true>(F, args); if (BOTH(4)) GRID_BAR(); }
    if (IN(5)) {
        pg8::Gemm g{(const pg8::bf16_t*)(ws + WS_H), (const pg8::bf16_t*)(ws + WS_WOUT), T, DMODEL, DMODEL}; pg8::StaticOrder S; S.init(T, DMODEL, F.G, (int)blockIdx.x);
        pg8::EpiG2 E{args.in[0], args.out, (pg8::bf16_t*)(ws + WS_X1B), (float*)(ws + WS_SUMSQ), DMODEL};
        pg8::gemm_phase<pg8::EpiG2, pg8::StaticOrder, true, true>(F.lds + RING_OFF, g, S, E, F.wave);
        if (BOTH(5)) GRID_BAR();
    }
    if (IN(6)) {
        pg8::Gemm g{(const pg8::bf16_t*)(ws + WS_X1B), (const pg8::bf16_t*)(ws + WS_WQ), T, QPW, DMODEL}; pg8::StaticOrder S; S.init(T, QPW, F.G, (int)blockIdx.x);
        pg8::EpiG3 E{(pg8::bf16_t*)(ws + WS_QP), QPW};
        pg8::gemm_phase<pg8::EpiG3, pg8::StaticOrder, true, true>(F.lds + RING_OFF, g, S, E, F.wave);
        if (BOTH(6)) GRID_BAR();
    }
    if (IN(7)) { peer::peer_phase(F, args); }
#undef IN
#undef BOTH
#undef GRID_BAR
}

extern "C" void kernel_launch(void* const* d_in, const int* in_sizes, int n_in, void* d_out, int out_size, void* d_ws, size_t ws_size, hipStream_t stream) {
    static int grid = 0;
    if (grid == 0) {
        if (n_in != 20 || in_sizes[0] != T * DMODEL || out_size != T * DMODEL || ws_size < WS_END) { fprintf(stderr, "kernel_launch: unexpected shapes (n_in %d, ws %zu)\n", n_in, ws_size); grid = -1; return; }
        int dev = 0, cus = 0;
        if (hipGetDevice(&dev) != hipSuccess || hipDeviceGetAttribute(&cus, hipDeviceAttributeMultiprocessorCount, dev) != hipSuccess) { grid = -1; return; }
        if (hipFuncSetAttribute((const void*)mk_fwd, hipFuncAttributeMaxDynamicSharedMemorySize, LDS_BYTES) != hipSuccess) { fprintf(stderr, "kernel_launch: hipFuncSetAttribute failed\n"); grid = -1; return; }
        (void)hipGetLastError();
        grid = cus;
    }
    if (grid < 0) return;
    if (hipMemsetAsync((char*)d_ws + WS_CTL, 0, CTL_ZERO_BYTES, stream) != hipSuccess) return;
    Args a{};
    for (int i = 0; i < 20; ++i) a.in[i] = (const float*)d_in[i];
    a.out = (float*)d_out; a.ws = (unsigned char*)d_ws; a.ph_lo = 0; a.ph_hi = N_PHASES; a.li = 0;
    hipLaunchKernelGGL(mk_fwd, dim3(grid), dim3(NWAVES * 64), LDS_BYTES, stream, a);
}
```

```cpp
#include <hip/hip_runtime.h>
#include <hip/hip_bf16.h>
#include <cstdio>
#include <cstdint>
#include <cmath>

constexpr int BATCH = 4, SEQ = 8192, DMODEL = 1024, T = BATCH * SEQ;
constexpr int LW = 512, AW = 512, NHEADS = 8, HD = 64, INC = 2568, NG1 = 2560;
constexpr int PH = 8, NKEY = 128, PHALF = 128, TOPK = 16, NEXP = NKEY * NKEY, QPW = 2048;
constexpr float RMS_EPS = 1e-6f;
constexpr float LOG2E = 1.4426950408889634f;
constexpr float QSCALE = 0.125f * LOG2E;
constexpr size_t MiB = 1u << 20;
constexpr size_t WS_CTL = 0, CTL_ZERO_BYTES = 1 * MiB;
constexpr size_t WS_WIN = 2 * MiB, WS_WOUT = 8 * MiB, WS_WQ = 10 * MiB, WS_SKB = 14 * MiB, WS_WFL = 15 * MiB,
                 WS_LOGF = 16 * MiB, WS_FCUM = 17 * MiB, WS_CARRY = 18 * MiB, WS_SUMSQ = 19 * MiB, WS_WAX = 20 * MiB, WS_CIN = 23 * MiB  , WS_NRM = 22 * MiB  ,
                 WS_H = 32 * MiB, WS_XR = 96 * MiB, WS_GR = 128 * MiB, WS_Q = 160 * MiB, WS_K = 192 * MiB, WS_V = 224 * MiB,
                 WS_X1B = 256 * MiB, WS_O = 256 * MiB  , WS_QP = 96 * MiB, WS_UT = 320 * MiB, WS_VT = 352 * MiB, WS_U8 = 320 * MiB, WS_V8 = 336 * MiB, WS_SU = 21 * MiB, WS_SV = 21 * MiB + 65536, WS_LA = 384 * MiB, WS_LU = 448 * MiB, WS_END = 512 * MiB;
constexpr size_t SPLIT_STRIDE = (WS_GR - WS_XR) / 2;
constexpr int CW_TMO = 0, CW_ATTQ = 2048, CW_BAR = 4096;

namespace pg8 {
#define PG8_LAS __attribute__((address_space(3)))
typedef unsigned short bf16_t;
typedef short bf16x8 __attribute__((ext_vector_type(8)));
typedef float f32x4 __attribute__((ext_vector_type(4)));
typedef unsigned u32x4 __attribute__((ext_vector_type(4)));
constexpr int BM = 256, BK = 64, HALF = 128, HTB = HALF * BK * 2  , STAGE_BYTES = 8 * HTB, NXCD = 8, WGM = 8;

__host__ __device__ __forceinline__ int lds_byte(int r, int c) { const int st = (r >> 4) * 2 + (c >> 5), rr = r & 15, cc = c & 31, ob = rr * 64 + cc * 2; return st * 1024 + (ob ^ (((ob >> 9) & 1) << 5)); }
__host__ __device__ __forceinline__ void stage_rc(int b, int& R, int& C) { const int st = b / 1024, sb = b % 1024, swz = sb ^ (((sb >> 9) & 1) << 5); R = (st >> 1) * 16 + swz / 64; C = (st & 1) * 32 + (swz % 64) / 2; }
__host__ __device__ __forceinline__ int perm32(int rho) { const int n = rho >> 4, i = rho & 15; return 8 * (i >> 2) + 4 * n + (i & 3); }

struct Unit { int pm, pn; };
struct Gemm { const bf16_t* A; const bf16_t* Bt; int M, N, K; };

struct StaticOrder {
    int nM, nN, nwg, G, c;
    __host__ __device__ void init(int M, int N, int G_, int c_) { nM = M / BM; nN = N / BM; nwg = nM * nN; G = G_; c = c_; }
    __host__ __device__ bool next(int i, Unit& u) const {
        const long L = (long)i * G + c; if (L >= nwg) return false;
        int wgid = (int)L; { const int q = nwg / NXCD, r = nwg % NXCD, xcd = wgid % NXCD, off = wgid / NXCD; wgid = (xcd < r ? xcd * (q + 1) : r * (q + 1) + (xcd - r) * q) + off; }
        const int nig = WGM * nN, gid = wgid / nig, fm = gid * WGM, gsz = (nM - fm) < WGM ? (nM - fm) : WGM;
        u.pm = fm + ((wgid % nig) % gsz); u.pn = (wgid % nig) / gsz; return true;
    }
    __device__ __forceinline__ void a_ready(const Unit&) const {}
    __device__ __forceinline__ void done(const Unit&) const {}
};

__device__ __forceinline__ unsigned cvt_pk_bf16(float lo, float hi) { unsigned r; asm volatile("v_cvt_pk_bf16_f32 %0, %1, %2" : "=v"(r) : "v"(lo), "v"(hi)); return r; }
typedef unsigned u32x2 __attribute__((ext_vector_type(2)));
__device__ __forceinline__ float gelu_fast(float x) {
    const float u2 = x * (1.5957691216057308f + 0.07135481627f * x * x);
    return x * __builtin_amdgcn_rcpf(1.f + __builtin_amdgcn_exp2f(-1.4426950408889634f * u2));
}
struct EpiG1 {
    static constexpr bool PERM = true, AFTER_DRAIN = false;
    bf16_t* base0; size_t split_stride; float qscale;
    __device__ __forceinline__ void operator()(const f32x4 (&acc)[2][2][4][2], const Unit& u, int wr, int wc, int fr, int fq) const {
        const int s = u.pn >> 1; bf16_t* base = base0 + (size_t)s * split_stride;
        const int row0 = u.pm * BM + wr * 64 + fr, col0 = (u.pn & 1) * 256 + wc * 32 + 8 * fq;
#pragma unroll
        for (int ai = 0; ai < 2; ++ai)
#pragma unroll
            for (int m = 0; m < 4; ++m) { bf16_t* rowp = base + (size_t)(row0 + ai * HALF + m * 16) * 512 + col0;
#pragma unroll
                for (int bj = 0; bj < 2; ++bj) { f32x4 v0 = acc[ai][bj][m][0], v1 = acc[ai][bj][m][1];
                    if (s == 1) {
#pragma unroll
                        for (int e = 0; e < 4; ++e) { v0[e] = gelu_fast(v0[e]); v1[e] = gelu_fast(v1[e]); } }
                    else if (s == 2) { v0 = v0 * qscale; v1 = v1 * qscale; }
                    u32x4 w; w.x = cvt_pk_bf16(v0[0], v0[1]); w.y = cvt_pk_bf16(v0[2], v0[3]); w.z = cvt_pk_bf16(v1[0], v1[1]); w.w = cvt_pk_bf16(v1[2], v1[3]);
                    *(u32x4*)(rowp + bj * HALF) = w; } }
    }
};
struct EpiG2 {
    static constexpr bool PERM = false, AFTER_DRAIN = false;
    const float* resid; float* out; bf16_t* xb; float* sumsq; int ldc;
    __device__ __forceinline__ void operator()(const f32x4 (&acc)[2][2][4][2], const Unit& u, int wr, int wc, int fr, int fq) const {
        const int row0 = u.pm * BM + wr * 64 + fr, col0 = u.pn * BM + wc * 32 + 4 * fq;
#pragma unroll
        for (int ai = 0; ai < 2; ++ai) {
            f32x4 rs[4][2][2];
#pragma unroll
            for (int m = 0; m < 4; ++m) { const size_t off = (size_t)(row0 + ai * HALF + m * 16) * ldc + col0;
#pragma unroll
                for (int bj = 0; bj < 2; ++bj)
#pragma unroll
                    for (int n = 0; n < 2; ++n) rs[m][bj][n] = *(const f32x4*)(resid + off + bj * HALF + n * 16); }
#pragma unroll
            for (int m = 0; m < 4; ++m) { const int r = row0 + ai * HALF + m * 16; const size_t off = (size_t)r * ldc + col0; float ss = 0.f;
#pragma unroll
                for (int bj = 0; bj < 2; ++bj)
#pragma unroll
                    for (int n = 0; n < 2; ++n) { const f32x4 x = rs[m][bj][n] + acc[ai][bj][m][n];
                        *(f32x4*)(out + off + bj * HALF + n * 16) = x; ss += (x[0] * x[0] + x[1] * x[1]) + (x[2] * x[2] + x[3] * x[3]);
                        u32x2 w; w.x = cvt_pk_bf16(x[0], x[1]); w.y = cvt_pk_bf16(x[2], x[3]); *(u32x2*)(xb + off + bj * HALF + n * 16) = w; }
                ss += __shfl_xor(ss, 16); ss += __shfl_xor(ss, 32);
                if (fq == 0) atomicAdd(sumsq + r, ss); }
            asm volatile("" ::: "memory"); }
    }
};
struct EpiG3 {
    static constexpr bool PERM = true, AFTER_DRAIN = false;
    bf16_t* O; int ldc;
    __device__ __forceinline__ void operator()(const f32x4 (&acc)[2][2][4][2], const Unit& u, int wr, int wc, int fr, int fq) const {
        const int row0 = u.pm * BM + wr * 64 + fr;
#pragma unroll
        for (int ai = 0; ai < 2; ++ai)
#pragma unroll
            for (int m = 0; m < 4; ++m) { const int t = row0 + ai * HALF + m * 16;
#pragma unroll
                for (int bj = 0; bj < 2; ++bj) { const f32x4 v0 = acc[ai][bj][m][0], v1 = acc[ai][bj][m][1];
                    u32x4 w; w.x = cvt_pk_bf16(v0[0], v0[1]); w.y = cvt_pk_bf16(v0[2], v0[3]); w.z = cvt_pk_bf16(v1[0], v1[1]); w.w = cvt_pk_bf16(v1[2], v1[3]);
                    *(u32x4*)(O + ((size_t)(((((t >> 5) * 8 + u.pn) * 2 + bj) * 16 + 4 * wc + fq) * 32 + (t & 31))) * 8) = w; } }
    }
};

template <class Epi, class Sched, bool ALIGN_EPI = false, bool SP2 = false>
__device__ __forceinline__ void gemm_phase(PG8_LAS unsigned char* lds, const Gemm g, const Sched& S, const Epi& E, int wid_in) {
    const int wid = __builtin_amdgcn_readfirstlane(wid_in), lane = (int)__builtin_amdgcn_mbcnt_hi(~0u, __builtin_amdgcn_mbcnt_lo(~0u, 0u)), tid = wid * 64 + lane, wr = wid >> 2, wc = wid & 3, fr = lane & 15, fq = lane >> 4;
    const int K = g.K, nt = K / BK;
    unsigned voffA[2], voffB[2];
#pragma unroll
    for (int i = 0; i < 2; ++i) { int R, C; stage_rc(tid * 16 + i * 8192, R, C); const int Rb = Epi::PERM ? ((R & ~31) + perm32(R & 31)) : R;
        voffA[i] = (unsigned)(R * K + C) * 2u; voffB[i] = (unsigned)(Rb * K + C) * 2u; }
    const size_t kstep = (size_t)(BK * 2);
    const size_t hstep = (size_t)HALF * K * 2;
    const size_t tstep = 2 * hstep;
    const unsigned ldsw = (unsigned)wid * 1024u;
    const int aoff = lds_byte(wr * 64 + fr, fq * 8), boff = lds_byte(wc * 32 + fr, fq * 8);
#define PG8_SA(b, h) (((b) * 2 + (h)) * HTB)
#define PG8_SB(b, h) ((4 + (b) * 2 + (h)) * HTB)
#define PG8_STAGE(bufoff, gbase, voff) do { _Pragma("unroll") for (int _i = 0; _i < 2; ++_i) \
        __builtin_amdgcn_global_load_lds((const unsigned*)((const char*)(gbase) + (voff)[_i]), (PG8_LAS unsigned*)(lds + (bufoff) + ldsw + _i * 8192), 16, 0, 0); } while (0)
#define PG8_LDA(dst, b, h) do { _Pragma("unroll") for (int m = 0; m < 4; ++m) _Pragma("unroll") for (int k = 0; k < 2; ++k) dst[m][k] = *(const PG8_LAS bf16x8*)(lds + PG8_SA(b, h) + aoff + m * 2048 + k * 1024); } while (0)
#define PG8_LDB(dst, b, h) do { _Pragma("unroll") for (int n = 0; n < 2; ++n) _Pragma("unroll") for (int k = 0; k < 2; ++k) dst[n][k] = *(const PG8_LAS bf16x8*)(lds + PG8_SB(b, h) + boff + n * 2048 + k * 1024); } while (0)
#define PG8_MMA(ai, bj, At, Bt) do { __builtin_amdgcn_s_setprio(1); _Pragma("unroll") for (int m = 0; m < 4; ++m) _Pragma("unroll") for (int n = 0; n < 2; ++n) _Pragma("unroll") for (int k = 0; k < 2; ++k) \
        acc[ai][bj][m][n] = __builtin_amdgcn_mfma_f32_16x16x32_bf16(Bt[n][k], At[m][k], acc[ai][bj][m][n], 0, 0, 0); __builtin_amdgcn_s_setprio(0); } while (0)
#define PG8_WAIT_V(n) asm volatile("s_waitcnt vmcnt(" #n ")" ::: "memory")
#define PG8_WAIT_L(n) asm volatile("s_waitcnt lgkmcnt(" #n ")" ::: "memory")
#define PG8_BAR __builtin_amdgcn_s_barrier()
#define PG8_SCHED __builtin_amdgcn_sched_barrier(0)
    Unit cur, nxt; int ui = 0;
    if (!S.next(0, cur)) return;
    f32x4 acc[2][2][4][2];
#pragma unroll
    for (int a = 0; a < 2; ++a)
#pragma unroll
        for (int b = 0; b < 2; ++b)
#pragma unroll
            for (int m = 0; m < 4; ++m)
#pragma unroll
                for (int n = 0; n < 2; ++n) acc[a][b][m][n] = (f32x4){0.f, 0.f, 0.f, 0.f};
    bf16x8 At[4][2], B0[2][2], B1[2][2];
    const char* cA = (const char*)g.A + (size_t)cur.pm * tstep; const char* cB = (const char*)g.Bt + (size_t)cur.pn * tstep;
    S.a_ready(cur);
    if constexpr (SP2) {
        PG8_STAGE(PG8_SB(0, 0), cB, voffB); PG8_STAGE(PG8_SB(0, 1), cB + hstep, voffB); PG8_STAGE(PG8_SA(0, 0), cA, voffA); PG8_STAGE(PG8_SA(0, 1), cA + hstep, voffA);
        if (wr == 1) PG8_BAR;
        PG8_WAIT_V(2); PG8_BAR;
        PG8_STAGE(PG8_SB(1, 0), cB + kstep, voffB); PG8_STAGE(PG8_SA(1, 0), cA + kstep, voffA); PG8_STAGE(PG8_SB(1, 1), cB + hstep + kstep, voffB);
        PG8_WAIT_V(6); PG8_BAR;
    } else {
        PG8_STAGE(PG8_SB(0, 0), cB, voffB); PG8_STAGE(PG8_SA(0, 0), cA, voffA); PG8_STAGE(PG8_SB(0, 1), cB + hstep, voffB); PG8_STAGE(PG8_SA(0, 1), cA + hstep, voffA);
        if (wr == 1) PG8_BAR;
        PG8_WAIT_V(4); PG8_BAR;
        PG8_STAGE(PG8_SB(1, 0), cB + kstep, voffB); PG8_STAGE(PG8_SA(1, 0), cA + kstep, voffA); PG8_STAGE(PG8_SB(1, 1), cB + hstep + kstep, voffB);
        PG8_WAIT_V(6); PG8_BAR;
    }
    for (;;) {
        const bool has_next = S.next(ui + 1, nxt);
        const char* nA = has_next ? (const char*)g.A + (size_t)nxt.pm * tstep : cA; const char* nB = has_next ? (const char*)g.Bt + (size_t)nxt.pn * tstep : cB;
        for (int t = 0; t < nt; t += 2) {
            const bool last = (t == nt - 2);
            const char* a1 = cA + (size_t)(t + 1) * kstep;
            const char* a2 = last ? nA : cA + (size_t)(t + 2) * kstep; const char* b2 = last ? nB : cB + (size_t)(t + 2) * kstep;
            const char* a3 = a2 + kstep; const char* b3 = b2 + kstep;
            if (last && has_next) S.a_ready(nxt);
            if constexpr (SP2) {
            PG8_LDB(B0, 0, 0); PG8_LDB(B1, 0, 1); PG8_SCHED; PG8_LDA(At, 0, 0); PG8_STAGE(PG8_SA(1, 1), a1 + hstep, voffA);
            PG8_WAIT_V(8); PG8_WAIT_L(0); PG8_BAR; PG8_MMA(0, 0, At, B0); PG8_MMA(0, 1, At, B1); PG8_BAR; PG8_SCHED;
            PG8_LDA(At, 0, 1); PG8_STAGE(PG8_SB(0, 0), b2, voffB); PG8_STAGE(PG8_SB(0, 1), b2 + hstep, voffB); PG8_STAGE(PG8_SA(0, 0), a2, voffA);
            PG8_WAIT_V(8); PG8_WAIT_L(0); PG8_BAR; PG8_MMA(1, 0, At, B0); PG8_MMA(1, 1, At, B1); PG8_BAR; PG8_SCHED;
            PG8_LDB(B0, 1, 0); PG8_LDB(B1, 1, 1); PG8_SCHED; PG8_LDA(At, 1, 0); PG8_STAGE(PG8_SA(0, 1), a2 + hstep, voffA);
            PG8_WAIT_V(8); PG8_WAIT_L(0); PG8_BAR; PG8_MMA(0, 0, At, B0); PG8_MMA(0, 1, At, B1); PG8_BAR; PG8_SCHED;
            PG8_LDA(At, 1, 1); PG8_STAGE(PG8_SB(1, 0), b3, voffB); PG8_STAGE(PG8_SB(1, 1), b3 + hstep, voffB); PG8_STAGE(PG8_SA(1, 0), a3, voffA);
            PG8_WAIT_V(8); PG8_WAIT_L(0); PG8_BAR; PG8_MMA(1, 0, At, B0); PG8_MMA(1, 1, At, B1); PG8_BAR; PG8_SCHED;
            } else {
            PG8_LDB(B0, 0, 0); PG8_SCHED; PG8_LDA(At, 0, 0); PG8_STAGE(PG8_SA(1, 1), a1 + hstep, voffA);
            PG8_WAIT_L(8); PG8_BAR; PG8_WAIT_L(0); PG8_MMA(0, 0, At, B0); PG8_BAR; PG8_SCHED;
            PG8_LDB(B1, 0, 1); PG8_STAGE(PG8_SB(0, 0), b2, voffB);
            PG8_BAR; PG8_WAIT_L(0); PG8_MMA(0, 1, At, B1); PG8_BAR;
            PG8_LDA(At, 0, 1); PG8_STAGE(PG8_SA(0, 0), a2, voffA);
            PG8_BAR; PG8_WAIT_L(0); PG8_MMA(1, 0, At, B0); PG8_BAR; PG8_SCHED;
            PG8_STAGE(PG8_SB(0, 1), b2 + hstep, voffB);
            PG8_WAIT_V(6); PG8_BAR; PG8_MMA(1, 1, At, B1); PG8_BAR;
            PG8_LDB(B0, 1, 0); PG8_SCHED; PG8_LDA(At, 1, 0); PG8_STAGE(PG8_SA(0, 1), a2 + hstep, voffA);
            PG8_WAIT_L(8); PG8_BAR; PG8_WAIT_L(0); PG8_MMA(0, 0, At, B0); PG8_BAR; PG8_SCHED;
            PG8_LDB(B1, 1, 1); PG8_STAGE(PG8_SB(1, 0), b3, voffB);
            PG8_BAR; PG8_WAIT_L(0); PG8_MMA(0, 1, At, B1); PG8_BAR;
            PG8_LDA(At, 1, 1); PG8_STAGE(PG8_SA(1, 0), a3, voffA);
            PG8_BAR; PG8_WAIT_L(0); PG8_MMA(1, 0, At, B0); PG8_BAR; PG8_SCHED;
            PG8_STAGE(PG8_SB(1, 1), b3 + hstep, voffB);
            PG8_WAIT_V(6); PG8_BAR; PG8_MMA(1, 1, At, B1); PG8_BAR;
            }
        }
        if constexpr (ALIGN_EPI) { if (wr == 0) PG8_BAR; }
        if constexpr (!Epi::AFTER_DRAIN) { E(acc, cur, wr, wc, fr, fq); S.done(cur); }
        if (!has_next) break;
#pragma unroll
        for (int a = 0; a < 2; ++a)
#pragma unroll
            for (int b = 0; b < 2; ++b)
#pragma unroll
                for (int m = 0; m < 4; ++m)
#pragma unroll
                    for (int n = 0; n < 2; ++n) acc[a][b][m][n] = (f32x4){0.f, 0.f, 0.f, 0.f};
        cur = nxt; cA = nA; cB = nB; ++ui;
        if constexpr (ALIGN_EPI) { if (wr == 1) PG8_BAR; }
    }
    PG8_WAIT_V(0);
    if constexpr (!ALIGN_EPI) { if (wr == 0) PG8_BAR; }
    PG8_BAR;
    if constexpr (Epi::AFTER_DRAIN) { E.fused(acc, cur, wr, wc, fr, fq, lds, wid, lane); S.done(cur); }
#undef PG8_SA
#undef PG8_SB
#undef PG8_STAGE
#undef PG8_LDA
#undef PG8_LDB
#undef PG8_MMA
#undef PG8_WAIT_V
#undef PG8_WAIT_L
#undef PG8_BAR
#undef PG8_SCHED
}
}
#include <hip/hip_bf16.h>
#include <cmath>
namespace attn_body {
using bf16=__hip_bfloat16;
using bf16x8=__attribute__((ext_vector_type(8)))short;
using s16x4=__attribute__((ext_vector_type(4)))short;
using f32x16=__attribute__((ext_vector_type(16)))float;
using u32x4=__attribute__((ext_vector_type(4)))unsigned;
constexpr int BATCH=4,NHEAD=8,SEQ=8192,D=64,DM=NHEAD*D;
constexpr int NW=8,QBLK=32,QB=QBLK*NW,KVBLK=64,NQB=SEQ/QB;
constexpr int ATTN_PITCH=DM, ATTN_UNIT_ROWS=QB;
__device__ __forceinline__ int crow(int r,int hi){return (r&3)+8*(r>>2)+4*hi;}
#define SBAR() __builtin_amdgcn_sched_barrier(0)
__device__ __forceinline__ void cmask(f32x16&p0,f32x16&p1,int jb,int qrel,int hi){
  const float NEG=-INFINITY; int kb=64*jb+4*hi;
  #pragma unroll
  for(int r=0;r<16;++r){int kv=kb+(r&3)+8*(r>>2); if(kv>qrel)p0[r]=NEG; if(kv+32>qrel)p1[r]=NEG;}
}

constexpr int NSLOT=3, SLOTB=8192;
constexpr int LDS_K=0, LDS_V=NSLOT*SLOTB, LDS_WS=2*NSLOT*SLOTB, LDS_OST=LDS_WS+NW*64*4, LDS_FK=LDS_OST+NW*4096, LDS_BYTES=LDS_FK+SEQ*4;
constexpr float C2=0.125f*1.4426950408889634f;
__device__ __forceinline__ void glds16(const void*gsrc,unsigned lds_dst){unsigned keep;
  asm volatile("s_mov_b32 %0, m0\n\ts_mov_b32 m0, %2\n\ts_nop 0\n\tglobal_load_lds_dwordx4 %1, off\n\ts_mov_b32 m0, %0":"=&s"(keep):"v"(gsrc),"s"(lds_dst):"memory");}
__device__ __forceinline__ float max3f(float a,float b,float c){float r;asm("v_max3_f32 %0, %1, %2, %3":"=v"(r):"v"(a),"v"(b),"v"(c));return r;}
__device__ __forceinline__ float max2f(float a,float b){float r;asm("v_max_f32_e32 %0, %1, %2":"=v"(r):"v"(a),"v"(b));return r;}
__device__ __forceinline__ float fadd_s(float a,float b){float r;asm("v_add_f32_e32 %0, %1, %2":"=v"(r):"v"(a),"v"(b));return r;}
__device__ __forceinline__ float fsub_s(float a,float b){float r;asm("v_sub_f32_e32 %0, %1, %2":"=v"(r):"v"(a),"v"(b));return r;}
typedef float f32x2_t __attribute__((ext_vector_type(2))); typedef __bf16 bf16x2_t __attribute__((ext_vector_type(2)));
__device__ __forceinline__ unsigned cvtpk_s(float lo,float hi){f32x2_t v={lo,hi};bf16x2_t b=__builtin_convertvector(v,bf16x2_t);return __builtin_bit_cast(unsigned,b);}
#define WAIT_BAR(N) asm volatile("s_waitcnt vmcnt(" #N ") lgkmcnt(0)\n\ts_barrier":::"memory")

__device__ __forceinline__ void qkt(f32x16&p0,f32x16&p1,const char*Kslot,const bf16x8*qr,int r32,int hi){
  const char*kb=Kslot+hi*1024+r32*16;
  #pragma unroll
  for(int d0=0;d0<4;++d0){
    const bf16x8 b0=*reinterpret_cast<const bf16x8*>(kb+d0*2048);
    const bf16x8 b1=*reinterpret_cast<const bf16x8*>(kb+d0*2048+512);
    p0=__builtin_amdgcn_mfma_f32_32x32x16_bf16(b0,qr[d0],p0,0,0,0);p1=__builtin_amdgcn_mfma_f32_32x32x16_bf16(b1,qr[d0],p1,0,0,0);}
}
typedef __attribute__((address_space(3))) const char* lds_cptr;
typedef short v4i16_t __attribute__((ext_vector_type(4)));
__device__ __forceinline__ void kload8(bf16x8*kf,lds_cptr kp){
  kf[0]=*(const __attribute__((address_space(3))) bf16x8*)(kp);      kf[1]=*(const __attribute__((address_space(3))) bf16x8*)(kp+512);
  kf[2]=*(const __attribute__((address_space(3))) bf16x8*)(kp+2048); kf[3]=*(const __attribute__((address_space(3))) bf16x8*)(kp+2560);
  kf[4]=*(const __attribute__((address_space(3))) bf16x8*)(kp+4096); kf[5]=*(const __attribute__((address_space(3))) bf16x8*)(kp+4608);
  kf[6]=*(const __attribute__((address_space(3))) bf16x8*)(kp+6144); kf[7]=*(const __attribute__((address_space(3))) bf16x8*)(kp+6656);
}
__device__ __forceinline__ void kload2(bf16x8*kf,lds_cptr kp,int j){ kf[2*j]=*(const __attribute__((address_space(3))) bf16x8*)(kp+j*2048); kf[2*j+1]=*(const __attribute__((address_space(3))) bf16x8*)(kp+j*2048+512); }
__device__ __forceinline__ s16x4 vtr(lds_cptr p){ return __builtin_bit_cast(s16x4,__builtin_amdgcn_ds_read_tr16_b64_v4i16((__attribute__((address_space(3))) v4i16_t*)p)); }
__device__ __forceinline__ float rowmax(const f32x16&p0,const f32x16&p1){
  float a=max3f(p0[0],p0[1],p1[0]),b=max3f(p0[2],p0[3],p1[1]);a=max3f(a,p1[2],p1[3]);
  #pragma unroll
  for(int r=4;r<16;r+=4){a=max3f(a,p0[r],p0[r+1]);b=max3f(b,p0[r+2],p0[r+3]);a=max3f(a,p1[r],p1[r+1]);b=max3f(b,p1[r+2],p1[r+3]);}
  const float m=max2f(a,b);
  auto rr=__builtin_amdgcn_permlane32_swap(__float_as_uint(m),__float_as_uint(m),false,false);
  return max2f(__uint_as_float(rr[0]),__uint_as_float(rr[1]));
}
__device__ __forceinline__ void pv(f32x16*o,int vb,bf16x8 pa0,bf16x8 pa1,bf16x8 pa2,bf16x8 pa3){
  #pragma unroll
  for(int d0=0;d0<2;++d0){s16x4 lo[4],hi[4];
    #pragma unroll
    for(int ks=0;ks<4;++ks){
      asm volatile("ds_read_b64_tr_b16 %0,%1 offset:%c2":"=&v"(lo[ks]):"v"(vb),"i"(d0*4096+ks*1024):"memory");
      asm volatile("ds_read_b64_tr_b16 %0,%1 offset:%c2":"=&v"(hi[ks]):"v"(vb),"i"(d0*4096+ks*1024+512):"memory");}
    asm volatile("s_waitcnt lgkmcnt(0)":::"memory");SBAR();
    #define PK(k) (bf16x8){lo[k][0],lo[k][1],lo[k][2],lo[k][3],hi[k][0],hi[k][1],hi[k][2],hi[k][3]}
    o[d0]=__builtin_amdgcn_mfma_f32_32x32x16_bf16(pa0,PK(0),o[d0],0,0,0);
    o[d0]=__builtin_amdgcn_mfma_f32_32x32x16_bf16(pa1,PK(1),o[d0],0,0,0);
    o[d0]=__builtin_amdgcn_mfma_f32_32x32x16_bf16(pa2,PK(2),o[d0],0,0,0);
    o[d0]=__builtin_amdgcn_mfma_f32_32x32x16_bf16(pa3,PK(3),o[d0],0,0,0);
    #undef PK
  }
}

#ifndef ATTN_STORE16
#define ATTN_STORE16(p,v) (*(u32x4*)(p)=(v))
#endif
template<int THRL> __device__ __forceinline__ void attn_unit(int b,int h,int qb,const bf16*Q,const bf16*__restrict__ K,const bf16*__restrict__ V,bf16*O,const float*__restrict__ Fc,const float*__restrict__ NRM,char*shm,int wid_in){
  const int wid=__builtin_amdgcn_readfirstlane(wid_in); int lane_=(int)__builtin_amdgcn_mbcnt_hi(~0u,__builtin_amdgcn_mbcnt_lo(~0u,0u)); asm volatile("":"+v"(lane_));
  const int lane=lane_,tid=wid*64+lane,r32=lane&31,hi=lane>>5;
  const long rowbase=(long)b*SEQ; const int q0=qb*QB;
  const float*Fbh=Fc+(long)(b*NHEAD+h)*SEQ;
  const int NTF=(q0+QB)/KVBLK; int t_start;
  { const float*QNb=NRM+(b*NHEAD+h)*128,*KNb=NRM+4096+(b*NHEAD+h)*128;
    const float qn=fmaxf(fmaxf(QNb[4*qb],QNb[4*qb+1]),fmaxf(QNb[4*qb+2],QNb[4*qb+3])),knb=fmaxf(fmaxf(KNb[4*qb],KNb[4*qb+1]),fmaxf(KNb[4*qb+2],KNb[4*qb+3]));
    const float fq0=Fbh[q0]*1.4426950408889634f; bool k0=true,k1=true;
    if(lane<NTF-4)k0=!(qn*(KNb[lane]+knb)+(fq0-Fbh[64*lane+63]*1.4426950408889634f)<-40.f);
    if(lane+64<NTF-4)k1=!(qn*(KNb[lane+64]+knb)+(fq0-Fbh[64*(lane+64)+63]*1.4426950408889634f)<-40.f);
    const unsigned long long m0=__ballot(k0),m1=__ballot(k1);
    int tf=m0?(int)__builtin_ctzll(m0):64+(m1?(int)__builtin_ctzll(m1):64);
    tf=tf<NTF-4?tf:NTF-4; t_start=__builtin_amdgcn_readfirstlane(tf&~1); }
  { typedef float f32x4_t __attribute__((ext_vector_type(4))); __attribute__((address_space(3))) float*fk=(__attribute__((address_space(3))) float*)((__attribute__((address_space(3))) char*)shm+LDS_FK); const int n4=(q0+QB)/4;
    for(int i=16*t_start+tid;i<n4;i+=NW*64){ f32x4_t v=*(const f32x4_t*)(Fbh+4*i); v=v*(-1.4426950408889634f); *(__attribute__((address_space(3))) f32x4_t*)(fk+4*i)=v; } }
  float fq2=Fbh[q0+wid*QBLK+r32]*1.4426950408889634f; asm volatile("":"+v"(fq2));
  const bf16*Qw=Q+(rowbase+q0+wid*QBLK)*DM+h*D;
  const bf16*Kh=K+(rowbase+(long)t_start*KVBLK)*DM+h*D,*Vh=V+(rowbase+(long)t_start*KVBLK)*DM+h*D;
  const lds_cptr shm3=(lds_cptr)shm;
  const unsigned lds0=(unsigned)(uintptr_t)shm;
  float*wsf=(float*)(shm+LDS_WS)+wid*64;
  const bf16*ksrc=Kh+(long)lane*DM+wid*8;
  const bf16*vsrc=Vh+(long)(16*(wid&3)+(lane>>2))*DM+(wid>>2)*32+(lane&3)*8;
  const unsigned kdst=lds0+LDS_K+wid*1024, vdst=lds0+LDS_V+wid*1024;
  #define DMA_K(t,slot) glds16(ksrc+(long)(t)*KVBLK*DM,(unsigned)__builtin_amdgcn_readfirstlane(kdst+(slot)))
  #define DMA_V(t,slot) glds16(vsrc+(long)(t)*KVBLK*DM,(unsigned)__builtin_amdgcn_readfirstlane(vdst+(slot)))
  const int vb0=(int)(lds0+LDS_V)+((lane>>4)&1)*32+(lane&3)*8+(4*hi+((lane&15)>>2))*64;
  const char*Kbase=shm+LDS_K; bf16x8 kf[8];
  const lds_cptr kp0=shm3+LDS_K+hi*1024+r32*16; const lds_cptr vp0=shm3+LDS_V+((lane>>4)&1)*32+(lane&3)*8+(4*hi+((lane&15)>>2))*64;
  const int NT=NTF-t_start;
  DMA_K(0,0);DMA_V(0,0);DMA_K(1,SLOTB);
  bf16x8 qr[4];
  #pragma unroll
  for(int d0=0;d0<4;++d0)qr[d0]=*reinterpret_cast<const bf16x8*>(&Qw[(long)r32*DM+d0*16+hi*8]);
  float mhat=0.f,l_reg=0.f;f32x16 o[2];o[0]=f32x16{};o[1]=f32x16{};
  const __attribute__((address_space(3))) float*fkl=(const __attribute__((address_space(3))) float*)(shm3+LDS_FK)+64*t_start+4*hi;
  #define INITC(C0,C1,t) do{ const float nsc_=fq2-mhat; typedef float f32x4_t __attribute__((ext_vector_type(4))); const __attribute__((address_space(3))) float*kb_=fkl+64*(t); \
    _Pragma("unroll") for(int g_=0;g_<4;++g_){ const f32x4_t a_=*(const __attribute__((address_space(3))) f32x4_t*)(kb_+8*g_), b_=*(const __attribute__((address_space(3))) f32x4_t*)(kb_+32+8*g_); \
      _Pragma("unroll") for(int e_=0;e_<4;++e_){ C0[4*g_+e_]=nsc_+a_[e_]; C1[4*g_+e_]=nsc_+b_[e_]; } } }while(0)
  const int qrel=wid*QBLK+r32;
  #define CMASK(P0,P1,t) do{int jb_=(t)-(NT-4); if(jb_>=0)cmask(P0,P1,jb_,qrel,hi);}while(0)
  bool resc=false;
  #define START(P0,P1) do{ const float rm=rowmax(P0,P1); resc=false; \
    { const float dl=rm; mhat=fadd_s(mhat,dl); \
      _Pragma("unroll") for(int r=0;r<16;++r){P0[r]=fsub_s(P0[r],dl);P1[r]=fsub_s(P1[r],dl);} \
      } \
    _Pragma("unroll") for(int r=0;r<16;++r)P0[r]=__builtin_amdgcn_exp2f(P0[r]); }while(0)
  #define RESC() do{ if(resc){ asm volatile("s_waitcnt lgkmcnt(0)":::"memory"); \
      _Pragma("unroll") for(int d_=0;d_<2;++d_) _Pragma("unroll") for(int r=0;r<16;++r)o[d_][r]*=wsf[crow(r,hi)]; } }while(0)
  f32x16 pA0,pA1,pB0,pB1;
  int sl_prev=0,sl_cur=0,sl_next=SLOTB;
  #define ROT() do{sl_prev=sl_cur;sl_cur=sl_next;sl_next=(sl_next==(NSLOT-1)*SLOTB)?0:sl_next+SLOTB;}while(0)
  DMA_K(2,2*SLOTB);
  WAIT_BAR(3);
  INITC(pA0,pA1,0); qkt(pA0,pA1,Kbase,qr,r32,hi);asm volatile("s_nop 15\n\ts_nop 7":"+v"(pA0),"+v"(pA1));CMASK(pA0,pA1,0);
  START(pA0,pA1);
  _Pragma("unroll") for(int r=0;r<16;++r)pA1[r]=__builtin_amdgcn_exp2f(pA1[r]);
  WAIT_BAR(0);
  DMA_K(3,0);DMA_V(1,SLOTB);
  ROT();
  kload8(kf,kp0+sl_cur);
  WAIT_BAR(2);
  s16x4 vlo[8],vhi[8]; u32x4 pw0,pw1,pw2,pw3;
  #define PKW(P,B) cvtpk_s(P[B],P[B+1])
  #define PAF(k) __builtin_bit_cast(bf16x8,pw##k)
  #define VFR(i) (bf16x8){vlo[i][0],vlo[i][1],vlo[i][2],vlo[i][3],vhi[i][0],vhi[i][1],vhi[i][2],vhi[i][3]}
  #define PIN(x) asm volatile("":"+v"(x))
  #define MX3(a,b,c) __builtin_fmaxf(__builtin_fmaxf((a),(b)),(c))
  #define GAPA(MF,A0,A1,A2,A3,W0,W1,PW) do{ MF; sacc+=A0; sacc+=A1; sacc+=A2; sacc+=A3; PIN(sacc); W0; W1; PIN(PW); SBAR(); }while(0)
  #define EX(v) __builtin_amdgcn_exp2f(v)
  #define GAPB(MF,X,B) do{ MF; X[B]=EX(X[B]); X[B+1]=EX(X[B+1]); X[B+2]=EX(X[B+2]); X[B+3]=EX(X[B+3]); PIN(X); SBAR(); }while(0)
  #define VRD(i) do{ vlo[i]=vtr(vp_+(((i)>>2)*4096+((i)&3)*1024)); vhi[i]=vtr(vp_+(((i)>>2)*4096+((i)&3)*1024+512)); }while(0)
  #define KRD(G,j) do{ if(G){ kload2(kf,kp0+sl_next,j); SBAR(); } }while(0)
  #define STEP(C0,C1,P0,P1,t,GK,GV,GL) do{ SBAR(); INITC(C0,C1,t); PIN(C0); PIN(C1); SBAR(); \
    const lds_cptr vp_=vp0+sl_prev; \
    VRD(0); SBAR(); float sacc=(P0[0]+P0[1]); \
    GAPA(C0=__builtin_amdgcn_mfma_f32_32x32x16_bf16(kf[0],qr[0],C0,0,0,0), P0[2],P0[3],P0[4],P0[5],     pw0[0]=PKW(P0,0), pw0[1]=PKW(P0,2), pw0); \
    VRD(4); SBAR(); GAPA(C1=__builtin_amdgcn_mfma_f32_32x32x16_bf16(kf[1],qr[0],C1,0,0,0), P0[6],P0[7],P0[8],P0[9],     pw0[2]=PKW(P0,4), pw0[3]=PKW(P0,6), pw0); \
    VRD(1); SBAR(); GAPA(C0=__builtin_amdgcn_mfma_f32_32x32x16_bf16(kf[2],qr[1],C0,0,0,0),   P0[10],P0[11],P0[12],P0[13], pw1[0]=PKW(P0,8), pw1[1]=PKW(P0,10), pw1); \
    VRD(5); SBAR(); GAPA(C1=__builtin_amdgcn_mfma_f32_32x32x16_bf16(kf[3],qr[1],C1,0,0,0),   P0[14],P0[15],P1[0],P1[1],   pw1[2]=PKW(P0,12),pw1[3]=PKW(P0,14), pw1); \
    VRD(2); SBAR(); GAPA(C0=__builtin_amdgcn_mfma_f32_32x32x16_bf16(kf[4],qr[2],C0,0,0,0),   P1[2],P1[3],P1[4],P1[5],     pw2[0]=PKW(P1,0), pw2[1]=PKW(P1,2), pw2); \
    VRD(6); SBAR(); GAPA(C1=__builtin_amdgcn_mfma_f32_32x32x16_bf16(kf[5],qr[2],C1,0,0,0),   P1[6],P1[7],P1[8],P1[9],     pw2[2]=PKW(P1,4), pw2[3]=PKW(P1,6), pw2); \
    VRD(3); SBAR(); GAPA(C0=__builtin_amdgcn_mfma_f32_32x32x16_bf16(kf[6],qr[3],C0,0,0,0),   P1[10],P1[11],P1[12],P1[13], pw3[0]=PKW(P1,8), pw3[1]=PKW(P1,10), pw3); \
    VRD(7); SBAR(); GAPA(C1=__builtin_amdgcn_mfma_f32_32x32x16_bf16(kf[7],qr[3],C1,0,0,0),   P1[14],P1[15],0.f,0.f,       pw3[2]=PKW(P1,12),pw3[3]=PKW(P1,14), pw3); \
    l_reg+=sacc; \
    if(GK){DMA_K((t)+3,sl_cur);} if(GV){DMA_V((t)+1,sl_next);} \
    CMASK(C0,C1,t); \
    { float a=MX3(C0[0],C0[1],C1[0]),b=MX3(C0[2],C0[3],C1[1]); a=MX3(a,C1[2],C1[3]); \
      _Pragma("unroll") for(int r=4;r<16;r+=4){a=MX3(a,C0[r],C0[r+1]);b=MX3(b,C0[r+2],C0[r+3]);a=MX3(a,C1[r],C1[r+1]);b=MX3(b,C1[r+2],C1[r+3]);} \
      float rm=__builtin_fmaxf(a,b); { auto rr=__builtin_amdgcn_permlane32_swap(__float_as_uint(rm),__float_as_uint(rm),false,false); rm=__builtin_fmaxf(__uint_as_float(rr[0]),__uint_as_float(rr[1])); } \
      resc=false; \
      if(__builtin_expect(__any(rm>(float)THRL),0)){ const float dl=__builtin_fmaxf(rm,0.f); mhat+=dl; \
        _Pragma("unroll") for(int r=0;r<16;++r){C0[r]-=dl;C1[r]-=dl;} \
        const float f=__builtin_amdgcn_exp2f(-dl); l_reg*=f; if(hi==0)wsf[r32]=f; resc=true; } } \
    SBAR(); \
    GAPB(o[0]=__builtin_amdgcn_mfma_f32_32x32x16_bf16(PAF(0),VFR(0),o[0],0,0,0), C0,0); \
    GAPB(o[1]=__builtin_amdgcn_mfma_f32_32x32x16_bf16(PAF(0),VFR(4),o[1],0,0,0), C0,4); \
    KRD(GL,0); GAPB(o[0]=__builtin_amdgcn_mfma_f32_32x32x16_bf16(PAF(1),VFR(1),o[0],0,0,0), C0,8); \
    KRD(GL,1); GAPB(o[1]=__builtin_amdgcn_mfma_f32_32x32x16_bf16(PAF(1),VFR(5),o[1],0,0,0), C0,12); \
    KRD(GL,2); GAPB(o[0]=__builtin_amdgcn_mfma_f32_32x32x16_bf16(PAF(2),VFR(2),o[0],0,0,0), C1,0); \
    KRD(GL,3); GAPB(o[1]=__builtin_amdgcn_mfma_f32_32x32x16_bf16(PAF(2),VFR(6),o[1],0,0,0), C1,4); \
    GAPB(o[0]=__builtin_amdgcn_mfma_f32_32x32x16_bf16(PAF(3),VFR(3),o[0],0,0,0), C1,8); \
    GAPB(o[1]=__builtin_amdgcn_mfma_f32_32x32x16_bf16(PAF(3),VFR(7),o[1],0,0,0), C1,12); \
    }while(0)
  int t=1;
  #undef CMASK
  #define CMASK(P0,P1,t) do{}while(0)
  for(;t+5<NT;t+=2){
    STEP(pB0,pB1,pA0,pA1,t,true,true,true);     WAIT_BAR(2); RESC(); ROT();
    STEP(pA0,pA1,pB0,pB1,t+1,true,true,true);   WAIT_BAR(2); RESC(); ROT();
  }
  #undef CMASK
  #define CMASK(P0,P1,t) do{int jb_=(t)-(NT-4); if(jb_>=0)cmask(P0,P1,jb_,qrel,hi);}while(0)
  #define ENDW(tt) do{ if((tt)+3<NT){WAIT_BAR(2);} else if((tt)+2<NT){WAIT_BAR(1);} else {WAIT_BAR(0);} }while(0)
  for(;t+1<NT;t+=2){
    STEP(pB0,pB1,pA0,pA1,t,(t+3<NT),(t+1<NT),(t+1<NT));       ENDW(t);   RESC(); ROT();
    STEP(pA0,pA1,pB0,pB1,t+1,(t+4<NT),(t+2<NT),(t+2<NT));     ENDW(t+1); RESC(); ROT();
  }
  STEP(pB0,pB1,pA0,pA1,NT-1,false,false,false); RESC();
  { float sacc=pB0[0]+pB0[1]; _Pragma("unroll") for(int r=2;r<16;++r)sacc+=pB0[r]; _Pragma("unroll") for(int r=0;r<16;++r)sacc+=pB1[r]; l_reg+=sacc;
    pw0=(u32x4){PKW(pB0,0),PKW(pB0,2),PKW(pB0,4),PKW(pB0,6)};pw1=(u32x4){PKW(pB0,8),PKW(pB0,10),PKW(pB0,12),PKW(pB0,14)};pw2=(u32x4){PKW(pB1,0),PKW(pB1,2),PKW(pB1,4),PKW(pB1,6)};pw3=(u32x4){PKW(pB1,8),PKW(pB1,10),PKW(pB1,12),PKW(pB1,14)};
    SBAR(); pv(o,vb0+sl_cur,PAF(0),PAF(1),PAF(2),PAF(3)); }
  #undef PKW
  #undef PAF
  #undef VFR
  #undef PIN
  #undef MX3
  #undef GAPA
  #undef GAPB
  #undef EX
  #undef VRD
  #undef KRD
  #undef STEP
  #undef ENDW
  {auto rr=__builtin_amdgcn_permlane32_swap(__float_as_uint(l_reg),__float_as_uint(l_reg),false,false);l_reg=__uint_as_float(rr[0])+__uint_as_float(rr[1]);}
  if(hi==0)wsf[32+r32]=l_reg;asm volatile("s_waitcnt lgkmcnt(0)":::"memory");
  float rli[16];
  #pragma unroll
  for(int r=0;r<16;++r)rli[r]=__builtin_amdgcn_rcpf(wsf[32+crow(r,hi)]);
  bf16*Ow=O+(rowbase+q0+wid*QBLK)*DM+h*D;
  { bf16*stg=(bf16*)(shm+LDS_OST)+wid*2048;
    #pragma unroll
    for(int r=0;r<16;++r){const int orow=crow(r,hi);
      #pragma unroll
      for(int d0=0;d0<2;++d0)stg[orow*64+d0*32+r32]=__float2bfloat16(o[d0][r]*rli[r]);}
    asm volatile("s_waitcnt lgkmcnt(0)":::"memory");
    #pragma unroll
    for(int i=0;i<4;++i){const int row=i*8+(lane>>3),ch=lane&7; const u32x4 v=*(const u32x4*)(stg+row*64+ch*8); ATTN_STORE16(Ow+(long)row*DM+ch*8,v);} }
  asm volatile("s_waitcnt lgkmcnt(0)\n\ts_barrier":::"memory");
  #undef DMA_K
  #undef DMA_V
  #undef INITC
  #undef CMASK
  #undef START
  #undef RESC
  #undef ROT
}
constexpr int ATTN_LDS_BYTES=LDS_BYTES;
struct AttnTensors { const bf16* Q; const bf16* K; const bf16* V; bf16* O; const float* F; const float* NRM; };
struct AttnUnit { int bh; int qb; };
struct StaticOrder {
  int vcu;
  __device__ __forceinline__ explicit StaticOrder(int grid,int block):vcu((block%8)*(grid/8)+block/8){}
  __device__ __forceinline__ bool next(int i,AttnUnit&u)const{ if(i>=4)return false; const int s=vcu&7; u.bh=vcu>>3; u.qb=(i==0)?s:(i==1)?15-s:(i==2)?16+s:31-s; return true; }
  __device__ __forceinline__ void a_ready(const AttnUnit&)const{}
  __device__ __forceinline__ void done(const AttnUnit&)const{}
};
template<int THRL=8> __device__ __forceinline__ void attn_phase(char*lds,const AttnTensors&T,unsigned*qctr,volatile __attribute__((address_space(3))) unsigned*qword,int wid_in){
  const int lane0=(int)__builtin_amdgcn_mbcnt_hi(~0u,__builtin_amdgcn_mbcnt_lo(~0u,0u));
  for(;;){
    if(wid_in==0&&lane0==0){ const unsigned n=__hip_atomic_fetch_add(qctr,1u,__ATOMIC_RELAXED,__HIP_MEMORY_SCOPE_AGENT); *qword=n; }
    asm volatile("s_waitcnt vmcnt(0) lgkmcnt(0)\n\ts_barrier":::"memory");
    const int n=__builtin_amdgcn_readfirstlane((int)*qword);
    if(n>=BATCH*NHEAD*NQB)break;
    const int bh=n%(BATCH*NHEAD),qb=NQB-1-n/(BATCH*NHEAD);
    attn_unit<THRL>(bh/NHEAD,bh%NHEAD,qb,T.Q,T.K,T.V,T.O,T.F,T.NRM,lds,wid_in);
  }
}
#undef SBAR
#undef WAIT_BAR
}
#define GAS __attribute__((address_space(1)))
#define LAS __attribute__((address_space(3)))
typedef unsigned short bf16;
typedef unsigned v4u __attribute__((ext_vector_type(4)));
typedef float f32x4 __attribute__((ext_vector_type(4)));
typedef short bf16x8 __attribute__((ext_vector_type(8)));
typedef GAS unsigned gu32;
typedef GAS unsigned long long gu64;
#define RLX_AGENT __ATOMIC_RELAXED, __HIP_MEMORY_SCOPE_AGENT
#define LDS_WAIT() asm volatile("s_waitcnt lgkmcnt(0)" ::: "memory")
#define VM_WAIT() asm volatile("s_waitcnt vmcnt(0)" ::: "memory")
__device__ __forceinline__ unsigned long long rt() { return __builtin_amdgcn_s_memrealtime(); }
__device__ __forceinline__ unsigned f2bf(float f) { unsigned u = __builtin_bit_cast(unsigned, f); return (u + 0x7fffu + ((u >> 16) & 1u)) >> 16; }
__device__ __forceinline__ unsigned pk2(float lo, float hi) { return f2bf(lo) | (f2bf(hi) << 16); }

#define XB_TMO      128
#define XB_XCNT(j)  (256  + 64 * (j))
#define XB_XSUB(j)  (1280 + 64 * (j))
#define XB_XGEN(j)  (2304 + 64 * (j))
#define XB_TOP      3328
#define XB_TOPGEN   3392
#define XCD_BAR_WORDS 3456
#define XB_SPIN_CAP (1u << 18)

__device__ __forceinline__ unsigned xb_ld(unsigned* p)              { return __hip_atomic_load(p, __ATOMIC_RELAXED, __HIP_MEMORY_SCOPE_AGENT); }
__device__ __forceinline__ unsigned xb_add(unsigned* p, unsigned v) { return __hip_atomic_fetch_add(p, v, __ATOMIC_RELAXED, __HIP_MEMORY_SCOPE_AGENT); }
__device__ __forceinline__ unsigned xb_xcc_id() { return (unsigned)__builtin_amdgcn_s_getreg((3 << 11) | 20) & 0xFu; }
#define XB_SPIN(cond, bar) do { unsigned _sp = 0; while (cond) { __builtin_amdgcn_s_sleep(1); \
    if ((++_sp & 255u) == 0u) { if (xb_ld(&(bar)[XB_TMO])) break; if (_sp > XB_SPIN_CAP) { atomicAdd(&(bar)[XB_TMO], 1u); break; } } } } while (0)

struct XcdBarrier {
    unsigned* bar; unsigned x; int wv;
    volatile LAS unsigned* st;
};

__device__ __forceinline__ bool xb_t0(int wv) { return wv == 0 && __builtin_amdgcn_mbcnt_hi(~0u, __builtin_amdgcn_mbcnt_lo(~0u, 0u)) == 0u; }
__device__ __forceinline__ XcdBarrier xcd_barrier_post(unsigned* bar, volatile LAS unsigned* st, int wv) {
    XcdBarrier b; b.bar = bar; b.x = xb_xcc_id(); b.st = st; b.wv = wv;
    if (xb_t0(wv)) (void)xb_add(&bar[XB_XCNT(b.x)], 1u);
    return b;
}
__device__ __forceinline__ void xcd_barrier_complete(unsigned* bar, unsigned x, unsigned& nloc, unsigned& nx) {
    const unsigned G = gridDim.x * gridDim.y * gridDim.z;
    unsigned sum, cnt, mine, sp = 0u;
    for (;;) {
        sum = 0u; cnt = 0u; mine = 0u;
#pragma unroll
        for (unsigned j = 0; j < 16; ++j) { const unsigned c = xb_ld(&bar[XB_XCNT(j)]); sum += c; cnt += (c > 0u) ? 1u : 0u; mine = (j == x) ? c : mine; }
        if (sum == G) break;
        __builtin_amdgcn_s_sleep(1);
        if ((++sp & 255u) == 0u) { if (xb_ld(&bar[XB_TMO])) break; if (sp > XB_SPIN_CAP) { atomicAdd(&bar[XB_TMO], 1u); break; } }
    }
    nloc = mine > 0u ? mine : 1u; nx = cnt > 0u ? cnt : 1u;
}

__device__ __forceinline__ void xcd_barrier(const XcdBarrier& b) {
    asm volatile("s_waitcnt vmcnt(0)" ::: "memory");
    __syncthreads();
    if (xb_t0(b.wv)) {
        unsigned* bar = b.bar;
        __builtin_amdgcn_s_waitcnt(0);
        unsigned nloc = b.st[0], nx = b.st[1];
        if (nloc == 0u) { xcd_barrier_complete(bar, b.x, nloc, nx); b.st[0] = nloc; b.st[1] = nx; }
        const unsigned old = xb_add(&bar[XB_XSUB(b.x)], 1u);
        const unsigned gen = old / nloc;
        if (old + 1u == (gen + 1u) * nloc) {
            __builtin_amdgcn_fence(__ATOMIC_RELEASE, "agent");
            asm volatile("s_waitcnt vmcnt(0)" ::: "memory");
            const unsigned og = xb_add(&bar[XB_TOP], 1u);
            const unsigned tg = og / nx;
            if (og + 1u == (tg + 1u) * nx) xb_add(&bar[XB_TOPGEN], 1u);
            else XB_SPIN(xb_ld(&bar[XB_TOPGEN]) == tg, bar);
            __builtin_amdgcn_fence(__ATOMIC_ACQUIRE, "agent");
            xb_add(&bar[XB_XGEN(b.x)], 1u);
            asm volatile("s_waitcnt vmcnt(0)" ::: "memory");
        } else {
            XB_SPIN(xb_ld(&bar[XB_XGEN(b.x)]) == gen, bar);
            __builtin_amdgcn_fence(__ATOMIC_ACQUIRE, "agent");
            asm volatile("s_waitcnt vmcnt(0)" ::: "memory");
        }
    }
    __syncthreads();
}

constexpr int NWAVES = 8;
constexpr int RING_OFF = 0, RING_BYTES = 131072;
constexpr int LDSCTL_OFF = RING_BYTES, MISC_OFF = LDSCTL_OFF + 320;
constexpr int LDS_BYTES = 147456;
constexpr int N_PHASES = 8;

struct Frame {
    LAS unsigned char* lds;
    volatile LAS unsigned* MISC;
    gu32* ctl;
    int tid, lane, wave, vcu, G;
};
__device__ __forceinline__ float wave_sum(float v) {
#pragma unroll
    for (int o = 1; o < 64; o <<= 1) v += __shfl_xor(v, o);
    return v;
}
struct Args { const float* in[20]; float* out; unsigned char* ws; int ph_lo, ph_hi, li, pad; };

__device__ __forceinline__ void p0_transpose_item(const float* W, int ld, int nblk, const float* glo, const float* ghi, int K, bf16* WT, LAS float* scr, int item, int lane) {
    const int kb = item / nblk, nb = item % nblk, k0 = 64 * kb, n0 = 32 * nb;
#pragma unroll 8
    for (int i = 0; i < 32; ++i) { const int kk = 2 * i + (lane >> 5), k = k0 + kk; float w = W[(size_t)k * ld + n0 + (lane & 31)];
        if (glo) w *= (k < K / 2) ? glo[k] : ghi[k - K / 2];
        scr[kk * 33 + (lane & 31)] = w; }
    LDS_WAIT(); asm volatile("" ::: "memory");
    const int c = lane & 7;
#pragma unroll
    for (int j = 0; j < 4; ++j) { const int n = (lane >> 3) + 8 * j; const LAS float* s = scr + (8 * c) * 33 + n;
        v4u o; o.x = pk2(s[0 * 33], s[1 * 33]); o.y = pk2(s[2 * 33], s[3 * 33]); o.z = pk2(s[4 * 33], s[5 * 33]); o.w = pk2(s[6 * 33], s[7 * 33]);
        *(GAS v4u*)(WT + (size_t)(n0 + n) * K + k0 + 8 * c) = o; }
    LDS_WAIT(); asm volatile("" ::: "memory");
}
__device__ __forceinline__ float log_sigmoid(float z) { return fminf(z, 0.f) - log1pf(expf(-fabsf(z))); }

__device__ __forceinline__ void p0_prologue(Frame& F, const Args& a) {
    LAS float* scr = (LAS float*)(F.lds + RING_OFF + F.wave * 16384);
    unsigned char* ws = a.ws;
    const float* x = a.in[0]; const float* g1 = a.in[1]; const float* w_in = a.in[2]; const float* bfv = a.in[10];
    const float* gn_l = a.in[11]; const float* gn_f = a.in[12]; const float* w_out = a.in[13]; const float* g2 = a.in[14];
    const float* w_q = a.in[15]; const float* sk = a.in[16]; const float* pu = a.in[17]; const float* pv = a.in[18];
    bf16* win_t = (bf16*)(ws + WS_WIN); bf16* wout_t = (bf16*)(ws + WS_WOUT); bf16* wq_t = (bf16*)(ws + WS_WQ); bf16* skb = (bf16*)(ws + WS_SKB);
    float* logf = (float*)(ws + WS_LOGF); float* sumsq = (float*)(ws + WS_SUMSQ); bf16* h = (bf16*)(ws + WS_H);
    const int gw = F.vcu * NWAVES + F.wave, NGW = F.G * NWAVES, lane = F.lane;
    constexpr int I_IN = (DMODEL / 64) * (NG1 / 32), I_OUT = (DMODEL / 64) * (DMODEL / 32), I_Q = (DMODEL / 64) * (QPW / 32);
    constexpr int I_FL = 8 * DMODEL / 64, I_SK = PH * 2 * NKEY * PHALF / 512, I_SS = T / 64, I_WAX = 8 * 2 * 2 * 4;
    constexpr int E0 = I_IN, E1 = E0 + I_OUT, E2 = E1 + I_Q, E3 = E2 + I_FL, E4 = E3 + I_SK, E5 = E4 + I_SS, E6 = E5 + I_WAX;
    for (int it = gw; it < E6; it += NGW) {
        if (it < E0) { p0_transpose_item(w_in, INC, NG1 / 32, nullptr, nullptr, DMODEL, win_t, scr, it, lane); continue; }
        if (it < E1) { p0_transpose_item(w_out, DMODEL, DMODEL / 32, gn_l, gn_f, DMODEL, wout_t, scr, it - E0, lane); continue; }
        if (it < E2) { p0_transpose_item(w_q, QPW, QPW / 32, g2, g2 + DMODEL / 2, DMODEL, wq_t, scr, it - E1, lane); continue; }
        if (it < E3) continue;
        if (it < E4) { const size_t i = (size_t)(it - E3) * 512 + lane * 8; const f32x4 s0 = *(const GAS f32x4*)(sk + i), s1 = *(const GAS f32x4*)(sk + i + 4);
            v4u o; o.x = pk2(s0[0], s0[1]); o.y = pk2(s0[2], s0[3]); o.z = pk2(s1[0], s1[1]); o.w = pk2(s1[2], s1[3]);
            { const size_t hp = i >> 14; const int key = (int)(i >> 7) & 127, c8 = (int)(i >> 3) & 15; *(GAS v4u*)(skb + hp * 16384 + ((size_t)((((key >> 5) * 2 + (c8 & 1)) * 8 + (c8 >> 1)) * 32 + (key & 31))) * 8) = o; } continue; }
        if (it < E5) { sumsq[(it - E4) * 64 + lane] = 0.f; continue; }
        { const int f = it - E5, ks = f & 3, n = (f >> 2) & 1, mat = (f >> 3) & 1, hh = f >> 4; const float* wsrc = mat ? a.in[7] : a.in[5];
          const size_t o = ((size_t)(hh * 64 + 16 * ks + 8 * (lane >> 5))) * 64 + 32 * n + (lane & 31);
          v4u pw; pw.x = pk2(wsrc[o], wsrc[o + 64]); pw.y = pk2(wsrc[o + 128], wsrc[o + 192]); pw.z = pk2(wsrc[o + 256], wsrc[o + 320]); pw.w = pk2(wsrc[o + 384], wsrc[o + 448]);
          *(GAS v4u*)((bf16*)(ws + WS_WAX) + (size_t)f * 512 + lane * 8) = pw; }
    }
    { f32x4 gg[4];
#pragma unroll
      for (int j = 0; j < 4; ++j) gg[j] = *(const GAS f32x4*)(g2 + 16 * lane + 4 * j);
      unsigned char* u4 = ws + WS_U8; unsigned char* v4 = ws + WS_V8; float* su = (float*)(ws + WS_SU);
      for (int e = gw; e < NEXP; e += NGW) {
        const GAS f32x4* ur = (const GAS f32x4*)(pu + (size_t)e * DMODEL + 16 * lane); const GAS f32x4* vr = (const GAS f32x4*)(pv + (size_t)e * DMODEL + 16 * lane);
        f32x4 uu[4], vv[4]; float mu = 0.f, mv = 0.f;
#pragma unroll
        for (int j = 0; j < 4; ++j) { uu[j] = ur[j] * gg[j]; vv[j] = vr[j];
#pragma unroll
            for (int c = 0; c < 4; ++c) { mu = fmaxf(mu, fabsf(uu[j][c])); mv = fmaxf(mv, fabsf(vv[j][c])); } }
#pragma unroll
        for (int o = 1; o < 64; o <<= 1) { mu = fmaxf(mu, __shfl_xor(mu, o)); mv = fmaxf(mv, __shfl_xor(mv, o)); }
        const float scu = mu > 0.f ? mu * (1.f / 6.f) : 1.f, scv = mv > 0.f ? mv * (1.f / 6.f) : 1.f, iu = 1.f / scu, iv = 1.f / scv;
        unsigned qu0 = 0u, qu1 = 0u, qv0 = 0u, qv1 = 0u;
#define P0_Q4(Q, X, INV, B0, B1) do { Q = __builtin_amdgcn_cvt_scalef32_pk_fp4_f32(Q, X[0] * INV, X[1] * INV, 1.0f, B0); Q = __builtin_amdgcn_cvt_scalef32_pk_fp4_f32(Q, X[2] * INV, X[3] * INV, 1.0f, B1); } while (0)
        P0_Q4(qu0, uu[0], iu, 0, 1); P0_Q4(qu0, uu[1], iu, 2, 3); P0_Q4(qu1, uu[2], iu, 0, 1); P0_Q4(qu1, uu[3], iu, 2, 3);
        P0_Q4(qv0, vv[0], iv, 0, 1); P0_Q4(qv0, vv[1], iv, 2, 3); P0_Q4(qv1, vv[2], iv, 0, 1); P0_Q4(qv1, vv[3], iv, 2, 3);
#undef P0_Q4
        *(GAS unsigned long long*)(u4 + (size_t)e * 512 + 8 * lane) = (unsigned long long)qu0 | ((unsigned long long)qu1 << 32);
        { unsigned char* vrow = v4 + (size_t)e * 512 + 2 * (lane >> 2);
          *(GAS unsigned short*)(vrow + 32 * (4 * (lane & 3) + 0)) = (unsigned short)(qv0 & 0xffffu); *(GAS unsigned short*)(vrow + 32 * (4 * (lane & 3) + 1)) = (unsigned short)(qv0 >> 16);
          *(GAS unsigned short*)(vrow + 32 * (4 * (lane & 3) + 2)) = (unsigned short)(qv1 & 0xffffu); *(GAS unsigned short*)(vrow + 32 * (4 * (lane & 3) + 3)) = (unsigned short)(qv1 >> 16); }
        if (lane == 0) { su[2 * e] = scu; su[2 * e + 1] = scv; }
      } }
    { f32x4 gg[4];
#pragma unroll
      for (int j = 0; j < 4; ++j) gg[j] = *(const GAS f32x4*)(g1 + 256 * j + 4 * lane);
      float fw[4][4][8];
#pragma unroll
      for (int j = 0; j < 4; ++j)
#pragma unroll
          for (int c = 0; c < 4; ++c) { const int k = 256 * j + 4 * lane + c; const GAS f32x4* wr = (const GAS f32x4*)(w_in + (size_t)k * INC + NG1); const f32x4 w0 = wr[0], w1 = wr[1];
#pragma unroll
              for (int e = 0; e < 4; ++e) { fw[j][c][e] = w0[e]; fw[j][c][4 + e] = w1[e]; } }
      for (int t0 = gw; t0 < T; t0 += 2 * NGW) {
        const int t1 = (t0 + NGW < T) ? t0 + NGW : t0;
        const GAS f32x4* xr0 = (const GAS f32x4*)(x + (size_t)t0 * DMODEL) + lane; const GAS f32x4* xr1 = (const GAS f32x4*)(x + (size_t)t1 * DMODEL) + lane;
        f32x4 va[4], vb[4]; float sa = 0.f, sb = 0.f;
#pragma unroll
        for (int j = 0; j < 4; ++j) { va[j] = xr0[64 * j]; vb[j] = xr1[64 * j]; }
#pragma unroll
        for (int j = 0; j < 4; ++j) { sa += (va[j][0] * va[j][0] + va[j][1] * va[j][1]) + (va[j][2] * va[j][2] + va[j][3] * va[j][3]); sb += (vb[j][0] * vb[j][0] + vb[j][1] * vb[j][1]) + (vb[j][2] * vb[j][2] + vb[j][3] * vb[j][3]); }
        const float ra = rsqrtf(wave_sum(sa) * (1.f / DMODEL) + RMS_EPS), rb = rsqrtf(wave_sum(sb) * (1.f / DMODEL) + RMS_EPS);
        GAS unsigned long long* ha = (GAS unsigned long long*)(h + (size_t)t0 * DMODEL) + lane; GAS unsigned long long* hb = (GAS unsigned long long*)(h + (size_t)t1 * DMODEL) + lane;
#pragma unroll
        for (int j = 0; j < 4; ++j) { va[j] = va[j] * ra * gg[j]; vb[j] = vb[j] * rb * gg[j];
            ha[64 * j] = (unsigned long long)pk2(va[j][0], va[j][1]) | ((unsigned long long)pk2(va[j][2], va[j][3]) << 32);
            hb[64 * j] = (unsigned long long)pk2(vb[j][0], vb[j][1]) | ((unsigned long long)pk2(vb[j][2], vb[j][3]) << 32); }
        float fa[8], fb[8];
#pragma unroll
        for (int hh = 0; hh < 8; ++hh) { fa[hh] = 0.f; fb[hh] = 0.f; }
#pragma unroll
        for (int j = 0; j < 4; ++j)
#pragma unroll
            for (int c = 0; c < 4; ++c) {
#pragma unroll
                for (int hh = 0; hh < 8; ++hh) { fa[hh] += va[j][c] * fw[j][c][hh]; fb[hh] += vb[j][c] * fw[j][c][hh]; } }
        float resa = 0.f, resb = 0.f;
#pragma unroll
        for (int hh = 0; hh < 8; ++hh) { const float s0 = wave_sum(fa[hh]), s1 = wave_sum(fb[hh]); if (lane == hh) { resa = s0; resb = s1; } }
        if (lane < 8) { logf[(size_t)t0 * 8 + lane] = log_sigmoid(resa + bfv[lane]); logf[(size_t)t1 * 8 + lane] = log_sigmoid(resb + bfv[lane]); }
      } }
}

__device__ __forceinline__ void fcum_unit(Frame& F, int bh, const float* logf, float* fcum) {
    const int b = bh / NHEADS, hh = bh % NHEADS, s0 = F.tid * 16;
    float v[16]; float loc = 0.f;
#pragma unroll
    for (int i = 0; i < 16; ++i) { v[i] = logf[((size_t)b * SEQ + s0 + i) * 8 + hh]; loc += v[i]; }
    float inc = loc;
#pragma unroll
    for (int o = 1; o < 64; o <<= 1) { const float n = __shfl_up(inc, o); if (F.lane >= o) inc += n; }
    if (F.lane == 63) F.MISC[16 + F.wave] = __float_as_uint(inc);
    __syncthreads();
    float run = inc - loc;
    for (int w = 0; w < F.wave; ++w) run += __uint_as_float(F.MISC[16 + w]);
#pragma unroll
    for (int i = 0; i < 16; ++i) { run += v[i]; fcum[(size_t)bh * SEQ + s0 + i] = run; }
    __syncthreads();
}


namespace peer {
typedef unsigned u32;
typedef float f32x16 __attribute__((ext_vector_type(16)));
constexpr int TOK = 128;
constexpr int EX_STRIDE = 136, GT_STRIDE = 136;
constexpr int L_EX = 0, L_GT = L_EX + TOK * EX_STRIDE * 2, L_IDX = L_GT + TOK * GT_STRIDE * 2, IDX_STRIDE = 36, L_RST = L_IDX + 512 * IDX_STRIDE, L_BI = L_RST + TOK * 4, BI_WAVE = 4352, L_END = L_BI + 8 * BI_WAVE;
static_assert(L_END <= RING_BYTES && L_GT % 16 == 0 && L_IDX % 16 == 0, "PEER LDS map");
__device__ __forceinline__ u32 ordmap(float f) { const u32 u = __float_as_uint(f); return u ^ ((u32)((int)u >> 31) | 0x80000000u); }
__device__ __forceinline__ float unordmap(u32 k) { const u32 u = (k & 0x80000000u) ? (k ^ 0x80000000u) : ~k; return __uint_as_float(u); }
__device__ __forceinline__ u32 umin_(u32 a, u32 b) { return a < b ? a : b; }
__device__ __forceinline__ u32 umax_(u32 a, u32 b) { return a > b ? a : b; }
template <bool DESC> __device__ __forceinline__ void sort16(u32 (&k)[16]) {
#pragma unroll
    for (int size = 2; size <= 16; size <<= 1)
#pragma unroll
        for (int stride = size >> 1; stride > 0; stride >>= 1)
#pragma unroll
            for (int i = 0; i < 16; ++i) { const int j = i ^ stride;
                if (j > i) { const bool asc = (((i & size) == 0) != DESC); const u32 a = k[i], b = k[j], lo = umin_(a, b), hi = umax_(a, b); k[i] = asc ? lo : hi; k[j] = asc ? hi : lo; } }
}
template <bool DESC> __device__ __forceinline__ void merge16(u32 (&k)[16]) {
#pragma unroll
    for (int stride = 8; stride > 0; stride >>= 1)
#pragma unroll
        for (int i = 0; i < 16; ++i) { const int j = i ^ stride;
            if (j > i) { const u32 a = k[i], b = k[j], lo = umin_(a, b), hi = umax_(a, b); k[i] = DESC ? hi : lo; k[j] = DESC ? lo : hi; } }
}
__host__ __device__ constexpr int ccnt(int a) { return 16 / (a + 1); }
__host__ __device__ constexpr int cbase(int a) { int s = 0; for (int i = 0; i < a; ++i) s += ccnt(i); return s; }
static_assert(cbase(16) == 50, "hyperbola candidate count");
__device__ __forceinline__ int crow16(int r) { return (r & 3) + 8 * (r >> 2); }

__device__ __forceinline__ void route_tile(Frame& F, const bf16* qp, const bf16* skb, const float* sumsq, int t0) {
    int lane = F.lane; asm volatile("" : "+v"(lane));
    const int r32 = lane & 31, hi = lane >> 5, w = F.wave;
    LAS unsigned short* EXL = (LAS unsigned short*)(F.lds + RING_OFF + L_EX);
    LAS unsigned short* GTL = (LAS unsigned short*)(F.lds + RING_OFF + L_GT);
    LAS unsigned char* IDXB = F.lds + RING_OFF + L_IDX + (w * 64 + lane) * IDX_STRIDE;
    LAS float* RST = (LAS float*)(F.lds + RING_OFF + L_RST);
    for (int g = 0; g < 4; ++g) {
        const int tok = 32 * g + r32; const size_t trow = (size_t)(t0 + tok);
        const float rstd2 = rsqrtf(sumsq[trow] * (1.f / DMODEL) + RMS_EPS);
        if (w == 0 && hi == 0) RST[tok] = rstd2;
        u32 s0[16], s1[16];
#pragma unroll
        for (int p = 0; p < 2; ++p) {
            bf16x8 qf[8];
#pragma unroll
            for (int ks = 0; ks < 8; ++ks) qf[ks] = *(const GAS bf16x8*)(qp + ((size_t)((((trow >> 5) * 8 + w) * 2 + p) * 16 + 2 * ks + hi) * 32 + r32) * 8);
            u32 run[16];
#pragma unroll
            for (int nb = 0; nb < 4; ++nb) {
                f32x16 acc = {};
                const bf16* kr = skb + (size_t)(w * 2 + p) * 16384 + ((size_t)((nb * 2 + hi) * 8 * 32 + r32)) * 8;
#pragma unroll
                for (int ks = 0; ks < 8; ++ks) acc = __builtin_amdgcn_mfma_f32_32x32x16_bf16(*(const GAS bf16x8*)(kr + ks * 256), qf[ks], acc, 0, 0, 0);
                asm volatile("" ::: "memory");
                u32 blk[16];
#pragma unroll
                for (int r = 0; r < 16; ++r) blk[r] = (ordmap(acc[r]) & ~0x7Fu) | (u32)(127 - 32 * nb - crow16(r) - 4 * hi);
                if (nb == 0) { sort16<true>(blk);
#pragma unroll
                    for (int i = 0; i < 16; ++i) run[i] = blk[i]; }
                else { sort16<false>(blk);
#pragma unroll
                    for (int i = 0; i < 16; ++i) run[i] = umax_(run[i], blk[i]);
                    merge16<true>(run); }
            }
            u32 oth[16];
#pragma unroll
            for (int i = 0; i < 16; ++i) oth[i] = (u32)__shfl_xor((int)run[15 - i], 32);
#pragma unroll
            for (int i = 0; i < 16; ++i) run[i] = umax_(run[i], oth[i]);
            merge16<true>(run);
#pragma unroll
            for (int i = 0; i < 16; ++i) { if (p == 0) s0[i] = run[i]; else s1[i] = run[i]; }
        }
        { LAS u32* iw = (LAS u32*)IDXB;
#pragma unroll
          for (int j = 0; j < 4; ++j) {
              iw[j] = (127u - (s0[4 * j] & 127u)) | ((127u - (s0[4 * j + 1] & 127u)) << 8) | ((127u - (s0[4 * j + 2] & 127u)) << 16) | ((127u - (s0[4 * j + 3] & 127u)) << 24);
              iw[4 + j] = (127u - (s1[4 * j] & 127u)) | ((127u - (s1[4 * j + 1] & 127u)) << 8) | ((127u - (s1[4 * j + 2] & 127u)) << 16) | ((127u - (s1[4 * j + 3] & 127u)) << 24); } }
        float v1[16], v2[16];
#pragma unroll
        for (int i = 0; i < 16; ++i) { v1[i] = unordmap(s0[i] & ~0x7Fu); v2[i] = unordmap(s1[i] & ~0x7Fu); }
        u32 c0[16], c1[16], c2[16], c3[16];
#pragma unroll
        for (int a = 0; a < 16; ++a)
#pragma unroll
            for (int b = 0; b < ccnt(a); ++b) { const int pos = cbase(a) + b; const u32 key = (ordmap(v1[a] + v2[b]) & ~0xFFu) | (u32)(255 - (a * 16 + b));
                if (pos < 16) c0[pos] = key; else if (pos < 32) c1[pos - 16] = key; else if (pos < 48) c2[pos - 32] = key; else c3[pos - 48] = key; }
#pragma unroll
        for (int i = 2; i < 16; ++i) c3[i] = 0u;
        sort16<false>(c1);
#pragma unroll
        for (int i = 0; i < 16; ++i) c0[i] = umax_(c0[i], c1[i]);
        merge16<true>(c0);
        sort16<false>(c2);
#pragma unroll
        for (int i = 0; i < 16; ++i) c0[i] = umax_(c0[i], c2[i]);
        merge16<true>(c0);
        sort16<false>(c3);
#pragma unroll
        for (int i = 0; i < 16; ++i) c0[i] = umax_(c0[i], c3[i]);
        merge16<true>(c0);
        const float m = unordmap(c0[0] & ~0xFFu) * rstd2;
        float e[8]; float sum = 0.f; u32 ex[8];
#pragma unroll
        for (int k = 0; k < 8; ++k) { const u32 key = hi ? c0[k + 8] : c0[k]; const float ts = unordmap(key & ~0xFFu);
            e[k] = __builtin_amdgcn_exp2f((ts * rstd2 - m) * LOG2E); sum += e[k];
            const u32 flat = 255u - (key & 255u); ex[k] = (u32)IDXB[flat >> 4] * NKEY + (u32)IDXB[16 + (flat & 15u)]; }
        sum += __shfl_xor(sum, 32);
        const float inv = 1.f / sum;
        v4u exw; exw.x = ex[0] | (ex[1] << 16); exw.y = ex[2] | (ex[3] << 16); exw.z = ex[4] | (ex[5] << 16); exw.w = ex[6] | (ex[7] << 16);
        *(LAS v4u*)(EXL + tok * EX_STRIDE + w * 16 + hi * 8) = exw;
        *(LAS v4u*)(GTL + tok * GT_STRIDE + w * 16 + hi * 8) = (v4u){pk2(e[0] * inv, e[1] * inv), pk2(e[2] * inv, e[3] * inv), pk2(e[4] * inv, e[5] * inv), pk2(e[6] * inv, e[7] * inv)};
    }
}
__device__ __forceinline__ float gelu_fast(float x) {
    const float u2 = x * (1.5957691216057308f + 0.07135481627f * x * x);
    return x * __builtin_amdgcn_rcpf(1.f + __builtin_amdgcn_exp2f(-1.4426950408889634f * u2));
}
typedef float f32x2 __attribute__((ext_vector_type(2)));

__device__ __forceinline__ void sort128(u32 (&k)[8], int m) {
#pragma unroll
    for (int K = 2; K <= 128; K <<= 1) {
#pragma unroll
        for (int S = K >> 1; S > 0; S >>= 1) {
            if (S >= 8) {
                const int mm = S >> 3; const bool lower = (m & mm) == 0, up = (K == 128) ? true : ((m & (K >> 3)) == 0), keepmin = (lower == up);
#pragma unroll
                for (int r = 0; r < 8; ++r) { const u32 o = (u32)__shfl_xor((int)k[r], mm); const u32 mn = umin_(k[r], o), mx = umax_(k[r], o); k[r] = keepmin ? mn : mx; }
            } else {
#pragma unroll
                for (int r = 0; r < 8; ++r) { const int r2 = r ^ S;
                    if (r2 > r) { const u32 a = k[r], b = k[r2], mn = umin_(a, b), mx = umax_(a, b);
                        if (K < 8) { const bool up = (r & K) == 0; k[r] = up ? mn : mx; k[r2] = up ? mx : mn; }
                        else { const bool up = (K == 128) ? true : ((m & (K >> 3)) == 0); k[r] = up ? mn : mx; k[r2] = up ? mx : mn; } } }
            }
        }
    }
}
typedef int v8i __attribute__((ext_vector_type(8)));
typedef unsigned u2v __attribute__((ext_vector_type(2)));
__device__ __forceinline__ void eval_mf(Frame& F, const unsigned char* u4, const unsigned char* v4, const float* suv, const float* fg, float* out, int t0) {
    int lane = F.lane; asm volatile("" : "+v"(lane));
    const int g = lane >> 4, m = lane & 15;
    LAS unsigned short* EXL = (LAS unsigned short*)(F.lds + RING_OFF + L_EX);
    LAS unsigned short* GTL = (LAS unsigned short*)(F.lds + RING_OFF + L_GT);
    LAS unsigned char* BI = F.lds + RING_OFF + L_BI + F.wave * BI_WAVE;
    const LAS float* RST = (const LAS float*)(F.lds + RING_OFF + L_RST);
    LAS u32* SKW = (LAS u32*)(F.lds + RING_OFF + L_IDX) + F.wave * 512;
    LAS u32* SK = SKW + g * 128;
    for (int pass = 0; pass < 4; ++pass) {
        const int tb4 = 32 * pass + 4 * F.wave, tok = tb4 + g;
        LAS unsigned short* exr = EXL + tok * EX_STRIDE; LAS unsigned short* gtr = GTL + tok * GT_STRIDE;
        { u32 k[8]; const v4u ev = *(const LAS v4u*)(exr + 8 * m); const u32 s0 = (u32)(8 * m);
          k[0] = ((ev.x & 0xffffu) << 7) | s0; k[1] = ((ev.x >> 16) << 7) | (s0 + 1); k[2] = ((ev.y & 0xffffu) << 7) | (s0 + 2); k[3] = ((ev.y >> 16) << 7) | (s0 + 3);
          k[4] = ((ev.z & 0xffffu) << 7) | (s0 + 4); k[5] = ((ev.z >> 16) << 7) | (s0 + 5); k[6] = ((ev.w & 0xffffu) << 7) | (s0 + 6); k[7] = ((ev.w >> 16) << 7) | (s0 + 7);
          sort128(k, m);
          u32 wv[8];
#pragma unroll
          for (int r = 0; r < 8; ++r) wv[r] = ((k[r] >> 7) << 16) | (u32)gtr[k[r] & 127u];
          *(LAS v4u*)(SK + m * 8) = (v4u){wv[0], wv[1], wv[2], wv[3]}; *(LAS v4u*)(SK + m * 8 + 4) = (v4u){wv[4], wv[5], wv[6], wv[7]};
          *(LAS v4u*)(exr + 8 * m) = (v4u){(k[0] >> 7) | ((k[1] >> 7) << 16), (k[2] >> 7) | ((k[3] >> 7) << 16), (k[4] >> 7) | ((k[5] >> 7) << 16), (k[6] >> 7) | ((k[7] >> 7) << 16)}; }
        asm volatile("" ::: "memory");
        {
#pragma unroll
            for (int tq = 0; tq < 4; ++tq) { const float rq = RST[tb4 + tq]; const float* xr = out + (size_t)(t0 + tb4 + tq) * DMODEL + 4 * lane;
#pragma unroll
                for (int c = 0; c < 4; ++c) { const f32x4 xa = *(const GAS f32x4*)(xr + 256 * c); int w = 0;
                    w = __builtin_amdgcn_cvt_pk_fp8_f32(xa[0] * rq, xa[1] * rq, w, false); w = __builtin_amdgcn_cvt_pk_fp8_f32(xa[2] * rq, xa[3] * rq, w, true);
                    const int d = 256 * c + 4 * lane, st = d >> 7, dd = d & 127, hh = dd >> 6, e = dd & 63;
                    *(LAS int*)(BI + ((st * 4 + tq) * 4 + (e >> 4)) * 32 + hh * 16 + (e & 15)) = w; } }
        }
        asm volatile("" ::: "memory");
        v8i hb[8];
#pragma unroll
        for (int st = 0; st < 8; ++st) { v4u b0 = *(const LAS v4u*)(BI + ((st * 4 + (m & 3)) * 4 + g) * 32), b1 = *(const LAS v4u*)(BI + ((st * 4 + (m & 3)) * 4 + g) * 32 + 16);
            if (m >= 4) { b0 = (v4u){0u, 0u, 0u, 0u}; b1 = b0; }
            hb[st] = (v8i){(int)b0.x, (int)b0.y, (int)b0.z, (int)b0.w, (int)b1.x, (int)b1.y, (int)b1.z, (int)b1.w}; }
        asm volatile("" ::: "memory");
#define PEER_BAR() do { asm volatile("" ::: "memory"); __builtin_amdgcn_sched_barrier(0); } while (0)
#define PEER_LOADU(UA, KQ, SC, I) do { KQ = *(const LAS v4u*)(SK + (I)); _Pragma("unroll") for (int s4 = 0; s4 < 4; ++s4) { const u32 e_ = KQ[s4] >> 16; const u32 ro_ = e_ * 512u + 16u * (u32)m; \
            UA[s4][0] = *(const GAS v4u*)(u4 + ro_); UA[s4][1] = *(const GAS v4u*)(u4 + ro_ + 256); SC[s4] = *(const GAS f32x2*)(suv + 2 * e_); } } while (0)
#define PEER_TRANSP(UA) do { _Pragma("unroll") for (int hf = 0; hf < 2; ++hf) { \
                _Pragma("unroll") for (int s4 = 0; s4 < 4; ++s4) *(LAS v4u*)(BI + (4 * s4 + g) * 272 + 16 * m) = UA[s4][hf]; \
                asm volatile("" ::: "memory"); \
                _Pragma("unroll") for (int st = 0; st < 4; ++st) af[4 * hf + st] = *(const LAS v4u*)(BI + m * 272 + 64 * st + 16 * g); \
                asm volatile("" ::: "memory"); } } while (0)
#define PEER_DOTS(KQ, SC, I) do { f32x4 D = (f32x4){0.f, 0.f, 0.f, 0.f}; \
            _Pragma("unroll") for (int st = 0; st < 8; ++st) { const v8i a8 = (v8i){(int)af[st].x, (int)af[st].y, (int)af[st].z, (int)af[st].w, 0, 0, 0, 0}; \
                D = __builtin_amdgcn_mfma_scale_f32_16x16x128_f8f6f4(a8, hb[st], D, 4, 0, 0, 0x7f7f7f7f, 0, 0x7f7f7f7f); } \
            const int sel = lane & 3; const float mine = sel == 0 ? D[0] : sel == 1 ? D[1] : sel == 2 ? D[2] : D[3]; float act[4]; \
            _Pragma("unroll") for (int s4 = 0; s4 < 4; ++s4) { const float pre = __uint_as_float((unsigned)__builtin_amdgcn_ds_bpermute(4 * (g + 16 * s4), (int)__float_as_uint(mine))); \
                act[s4] = gelu_fast(pre * SC[s4][0]) * (__uint_as_float(KQ[s4] << 16) * SC[s4][1]); } \
            if (m == 0) *(LAS u2v*)(gtr + (I)) = (u2v){pk2(act[0], act[1]), pk2(act[2], act[3])}; } while (0)
        v4u kqA, kqB, uaA[4][2], uaB[4][2], af[8]; f32x2 scA[4], scB[4];
        PEER_LOADU(uaA, kqA, scA, 0);
        for (int i = 0; i < 128; i += 8) {
            PEER_TRANSP(uaA);
            PEER_LOADU(uaB, kqB, scB, i + 4);
            PEER_BAR();
            PEER_DOTS(kqA, scA, i);
            PEER_BAR();
            PEER_TRANSP(uaB);
            PEER_LOADU(uaA, kqA, scA, (i + 8 < 128) ? i + 8 : i + 4);
            PEER_BAR();
            PEER_DOTS(kqB, scB, i + 4);
            PEER_BAR();
        }
    }
    asm volatile("" ::: "memory");
    for (int pass = 0; pass < 4; ++pass) {
        const int tb4 = 32 * pass + 4 * F.wave, tok = tb4 + g;
        const LAS unsigned short* exr = EXL + tok * EX_STRIDE; const LAS unsigned short* acr = GTL + tok * GT_STRIDE;
        f32x2 y[32];
#pragma unroll
        for (int q = 0; q < 32; ++q) y[q] = (f32x2){0.f, 0.f};
        float* xrow = out + (size_t)(t0 + tok) * DMODEL + 4 * m;
#define PEER_LOADV(VB, I) do { const u2v e2_ = *(const LAS u2v*)(exr + (I)); _Pragma("unroll") for (int s4 = 0; s4 < 4; ++s4) { const u32 e_ = (s4 & 1) ? (e2_[s4 >> 1] >> 16) : (e2_[s4 >> 1] & 0xffffu); \
            const u32 ro_ = e_ * 512u + 32u * (u32)m; VB[s4][0] = *(const GAS v4u*)(v4 + ro_); VB[s4][1] = *(const GAS v4u*)(v4 + ro_ + 16); } } while (0)
#define PEER_FMAV(VB, I) do { const u2v a2_ = *(const LAS u2v*)(acr + (I)); _Pragma("unroll") for (int s4 = 0; s4 < 4; ++s4) { \
            const float act_ = (s4 & 1) ? __uint_as_float(a2_[s4 >> 1] & 0xffff0000u) : __uint_as_float(a2_[s4 >> 1] << 16); const f32x2 b2_ = (f32x2){act_, act_}; \
            _Pragma("unroll") for (int c = 0; c < 2; ++c) _Pragma("unroll") for (int d = 0; d < 4; ++d) { const unsigned w_ = VB[s4][c][d]; const int hq = 16 * c + 4 * d; \
                y[hq] = __builtin_elementwise_fma(__builtin_amdgcn_cvt_scalef32_pk_f32_fp4(w_, 1.0f, 0), b2_, y[hq]); y[hq + 1] = __builtin_elementwise_fma(__builtin_amdgcn_cvt_scalef32_pk_f32_fp4(w_, 1.0f, 1), b2_, y[hq + 1]); \
                y[hq + 2] = __builtin_elementwise_fma(__builtin_amdgcn_cvt_scalef32_pk_f32_fp4(w_, 1.0f, 2), b2_, y[hq + 2]); y[hq + 3] = __builtin_elementwise_fma(__builtin_amdgcn_cvt_scalef32_pk_f32_fp4(w_, 1.0f, 3), b2_, y[hq + 3]); } } } while (0)
        v4u vbA[4][2], vbB[4][2], vbC[4][2];
        PEER_LOADV(vbA, 0); PEER_LOADV(vbB, 4);
        PEER_BAR();
        for (int i = 0; i < 120; i += 12) {
            PEER_LOADV(vbC, i + 8);  PEER_BAR(); PEER_FMAV(vbA, i);     PEER_BAR();
            PEER_LOADV(vbA, i + 12); PEER_BAR(); PEER_FMAV(vbB, i + 4); PEER_BAR();
            PEER_LOADV(vbB, i + 16); PEER_BAR(); PEER_FMAV(vbC, i + 8); PEER_BAR();
        }
        PEER_FMAV(vbA, 120); PEER_FMAV(vbB, 124);
        float ss = 0.f;
#pragma unroll
        for (int q = 0; q < 16; ++q) { const f32x4 xa = *(const GAS f32x4*)(xrow + 64 * q); y[2 * q][0] += xa[0]; y[2 * q][1] += xa[1]; y[2 * q + 1][0] += xa[2]; y[2 * q + 1][1] += xa[3];
            ss += (y[2 * q][0] * y[2 * q][0] + y[2 * q][1] * y[2 * q][1]) + (y[2 * q + 1][0] * y[2 * q + 1][0] + y[2 * q + 1][1] * y[2 * q + 1][1]); }
        ss += __shfl_xor(ss, 1); ss += __shfl_xor(ss, 2); ss += __shfl_xor(ss, 4); ss += __shfl_xor(ss, 8);
        const float rs = rsqrtf(ss * (1.f / DMODEL) + RMS_EPS);
        asm volatile("" ::: "memory");
#pragma unroll
        for (int q = 0; q < 16; ++q) { const f32x4 gq = *(const GAS f32x4*)(fg + 64 * q + 4 * m); f32x4 o; o[0] = y[2 * q][0] * rs * gq[0]; o[1] = y[2 * q][1] * rs * gq[1]; o[2] = y[2 * q + 1][0] * rs * gq[2]; o[3] = y[2 * q + 1][1] * rs * gq[3];
            *(GAS f32x4*)(xrow + 64 * q) = o; }
    }
}
__device__ __forceinline__ void peer_phase(Frame& F, const Args& a) {
    unsigned char* ws = a.ws;
    for (int tile = F.vcu; tile < T / TOK; tile += F.G) {
        route_tile(F, (const bf16*)(ws + WS_QP), (const bf16*)(ws + WS_SKB), (const float*)(ws + WS_SUMSQ), tile * TOK);
        __syncthreads();
        eval_mf(F, ws + WS_U8, ws + WS_V8, (const float*)(ws + WS_SU), a.in[19], a.out, tile * TOK);
        __syncthreads();
    }
}
}

namespace lru {
typedef float f32x16 __attribute__((ext_vector_type(16)));
constexpr int TOKT = 128, NTILE = SEQ / TOKT;
constexpr int WAVE_LDS = 14336, L_XS = 0, L_XC = 4608, L_GS = 9216, XC_STRIDE = 72  , L_SS = 8 * WAVE_LDS;
static_assert(L_SS + 32 * 8 * 4 <= RING_BYTES, "LRU LDS map");
__device__ __forceinline__ float bf2f(unsigned short h) { return __uint_as_float((unsigned)h << 16); }
__device__ __forceinline__ int crow16(int r) { return (r & 3) + 8 * (r >> 2); }
__device__ __forceinline__ float sigm(float x) { return __builtin_amdgcn_rcpf(1.f + __builtin_amdgcn_exp2f(-LOG2E * x)); }

template <bool FINAL> __device__ __forceinline__ void lru_tile(Frame& F, const Args& args, int tile) {
    int lane = F.lane; asm volatile("" : "+v"(lane));
    const int w = F.wave, j32 = lane & 31, hi = lane >> 5;
    unsigned char* ws = args.ws;
    const bf16* xr = (const bf16*)(ws + WS_XR); const bf16* gr = (const bf16*)(ws + WS_GR); float* carry = (float*)(ws + WS_CARRY);
    const float* cw = args.in[3]; const float* cb = args.in[4]; const float* ba = args.in[6]; const float* bx = args.in[8]; const float* lam = args.in[9];
    const int b = tile / NTILE, jt = tile % NTILE; const size_t trow0 = (size_t)b * SEQ + (size_t)jt * TOKT;
    LAS unsigned char* wl = F.lds + RING_OFF + w * WAVE_LDS;
    LAS unsigned short* XS = (LAS unsigned short*)(wl + L_XS); LAS unsigned short* XC = (LAS unsigned short*)(wl + L_XC); LAS unsigned short* GS = (LAS unsigned short*)(wl + L_GS);
    LAS float* SS = (LAS float*)(F.lds + RING_OFF + L_SS);
    float c_ba[2], c_bx[2], c_sp[2], c_cb[2], c_cw[2][4];
#pragma unroll
    for (int n = 0; n < 2; ++n) { const int c = 64 * w + 32 * n + j32; c_ba[n] = ba[c]; c_bx[n] = bx[c]; c_cb[n] = cb[c];
        const float l = lam[c]; c_sp[n] = 8.f * LOG2E * (fmaxf(-l, 0.f) + log1pf(expf(-fabsf(l))));
#pragma unroll
        for (int k = 0; k < 4; ++k) c_cw[n][k] = cw[k * LW + c]; }
    const bf16* wax = (const bf16*)(ws + WS_WAX);
    float hc[2] = {0.f, 0.f}, ap[2] = {1.f, 1.f};
    if (FINAL) { const float* cin = (const float*)(ws + WS_CIN) + (size_t)(b * NTILE + jt) * LW + 64 * w + j32; hc[0] = cin[0]; hc[1] = cin[32]; }
    v4u pfx[5], pfg[4], pce[2][2], pcu[2][2];
    unsigned char* cacheE = ws + WS_LA + ((size_t)(tile * 8 + w) * 4) * 4096; unsigned char* cacheU = ws + WS_LU + ((size_t)(tile * 8 + w) * 4) * 4096;
#define LRU_FETCH(B) do { const size_t tbn_ = trow0 + (B) * 32; \
        if (!FINAL) { _Pragma("unroll") for (int q_ = 0; q_ < 5; ++q_) { const int pc_ = lane + 64 * q_, row_ = pc_ >> 3, c8_ = pc_ & 7; \
            const bool z_ = (jt == 0 && (B) == 0 && row_ < 3) || pc_ >= 35 * 8; const v4u v_ = *(const GAS v4u*)(xr + (tbn_ + (z_ ? 3 : row_) - 3) * LW + w * 64 + c8_ * 8); pfx[q_] = z_ ? (v4u){0u, 0u, 0u, 0u} : v_; } } \
        if (FINAL) { _Pragma("unroll") for (int q_ = 0; q_ < 4; ++q_) { const int pc_ = lane + 64 * q_; pfg[q_] = *(const GAS v4u*)(gr + (tbn_ + (pc_ >> 3)) * LW + w * 64 + (pc_ & 7) * 8); } \
            _Pragma("unroll") for (int n_ = 0; n_ < 2; ++n_) _Pragma("unroll") for (int h_ = 0; h_ < 2; ++h_) { const size_t o_ = (size_t)(B) * 4096 + n_ * 2048 + h_ * 1024 + lane * 16; \
                pce[n_][h_] = *(const GAS v4u*)(cacheE + o_); pcu[n_][h_] = *(const GAS v4u*)(cacheU + o_); } } } while (0)
    LRU_FETCH(0);
    for (int blk = 0; blk < 4; ++blk) {
        const size_t tb = trow0 + blk * 32;
        int ln = lane; asm volatile("" : "+v"(ln));
        const int k32 = ln & 31;
        if (!FINAL) {
#pragma unroll
            for (int q = 0; q < 5; ++q) { const int pc = ln + 64 * q; if (pc < 35 * 8) *(LAS v4u*)((LAS unsigned char*)XS + (pc >> 3) * 128 + (pc & 7) * 16) = pfx[q]; } }
        v4u ce[2][2], cu[2][2];
        if (FINAL) {
#pragma unroll
            for (int n = 0; n < 2; ++n)
#pragma unroll
                for (int h = 0; h < 2; ++h) { ce[n][h] = pce[n][h]; cu[n][h] = pcu[n][h]; }
#pragma unroll
            for (int q = 0; q < 4; ++q) { const int pc = ln + 64 * q; *(LAS v4u*)((LAS unsigned char*)GS + (pc >> 3) * 128 + (pc & 7) * 16) = pfg[q]; } }
        if (blk < 3) { LRU_FETCH(blk + 1); }
        asm volatile("" ::: "memory");
        float xc[2][16];
        bf16x8 af[4];
        if (!FINAL) {
#pragma unroll
        for (int n = 0; n < 2; ++n)
#pragma unroll
            for (int g = 0; g < 4; ++g) { float xv[7];
#pragma unroll
                for (int q = 0; q < 7; ++q) xv[q] = bf2f(XS[(8 * g + 4 * hi + q) * 64 + 32 * n + j32]);
#pragma unroll
                for (int e = 0; e < 4; ++e) xc[n][4 * g + e] = c_cb[n] + ((c_cw[n][0] * xv[e] + c_cw[n][1] * xv[e + 1]) + (c_cw[n][2] * xv[e + 2] + c_cw[n][3] * xv[e + 3])); }
#pragma unroll
        for (int n = 0; n < 2; ++n)
#pragma unroll
            for (int r = 0; r < 16; ++r) XC[(crow16(r) + 4 * hi) * XC_STRIDE + 32 * n + j32] = (unsigned short)f2bf(xc[n][r]);
        asm volatile("" ::: "memory");
#pragma unroll
        for (int ks = 0; ks < 4; ++ks) af[ks] = *(const LAS bf16x8*)(XC + j32 * XC_STRIDE + 16 * ks + 8 * hi);
        asm volatile("" ::: "memory");
        }
        float yv[2][16];
#pragma unroll
        for (int n = 0; n < 2; ++n) {
            float av[16], uv[16];
            if (!FINAL) {
            f32x16 R = {}, I = {};
            bf16x8 fa[4], fx[4];
#pragma unroll
            for (int ks = 0; ks < 4; ++ks) { fa[ks] = *(const GAS bf16x8*)(wax + (size_t)(((w * 2 + 0) * 2 + n) * 4 + ks) * 512 + ln * 8); fx[ks] = *(const GAS bf16x8*)(wax + (size_t)(((w * 2 + 1) * 2 + n) * 4 + ks) * 512 + ln * 8); }
#pragma unroll
            for (int ks = 0; ks < 4; ++ks) { R = __builtin_amdgcn_mfma_f32_32x32x16_bf16(af[ks], fa[ks], R, 0, 0, 0); I = __builtin_amdgcn_mfma_f32_32x32x16_bf16(af[ks], fx[ks], I, 0, 0, 0); }
            unsigned we[8], wu[8];
#pragma unroll
            for (int k = 0; k < 8; ++k) { const float e0 = sigm(R[2 * k] + c_ba[n]) * c_sp[n], e1 = sigm(R[2 * k + 1] + c_ba[n]) * c_sp[n]; we[k] = pg8::cvt_pk_bf16(e0, e1);
                const float a0 = __builtin_amdgcn_exp2f(-__uint_as_float(we[k] << 16)), a1 = __builtin_amdgcn_exp2f(-__uint_as_float(we[k] & 0xffff0000u));
                const float u0 = __builtin_amdgcn_sqrtf(fmaxf(1.f - a0 * a0, 0.f)) * (sigm(I[2 * k] + c_bx[n]) * xc[n][2 * k]), u1 = __builtin_amdgcn_sqrtf(fmaxf(1.f - a1 * a1, 0.f)) * (sigm(I[2 * k + 1] + c_bx[n]) * xc[n][2 * k + 1]);
                wu[k] = pg8::cvt_pk_bf16(u0, u1);
                av[2 * k] = a0; av[2 * k + 1] = a1; uv[2 * k] = __uint_as_float(wu[k] << 16); uv[2 * k + 1] = __uint_as_float(wu[k] & 0xffff0000u); }
            { const size_t o = (size_t)blk * 4096 + n * 2048 + ln * 16;
              *(GAS v4u*)(cacheE + o) = (v4u){we[0], we[1], we[2], we[3]}; *(GAS v4u*)(cacheE + o + 1024) = (v4u){we[4], we[5], we[6], we[7]};
              *(GAS v4u*)(cacheU + o) = (v4u){wu[0], wu[1], wu[2], wu[3]}; *(GAS v4u*)(cacheU + o + 1024) = (v4u){wu[4], wu[5], wu[6], wu[7]}; }
            } else {
#pragma unroll
                for (int k = 0; k < 8; ++k) { const unsigned e2 = ce[n][k >> 2][k & 3], u2 = cu[n][k >> 2][k & 3];
                    av[2 * k] = __builtin_amdgcn_exp2f(-__uint_as_float(e2 << 16)); av[2 * k + 1] = __builtin_amdgcn_exp2f(-__uint_as_float(e2 & 0xffff0000u));
                    uv[2 * k] = __uint_as_float(u2 << 16); uv[2 * k + 1] = __uint_as_float(u2 & 0xffff0000u); }
            }
            float Ar[4], Hr[4], hst[4];
#pragma unroll
            for (int g = 0; g < 4; ++g) { Ar[g] = (av[4 * g] * av[4 * g + 1]) * (av[4 * g + 2] * av[4 * g + 3]);
                Hr[g] = ((uv[4 * g] * av[4 * g + 1] + uv[4 * g + 1]) * av[4 * g + 2] + uv[4 * g + 2]) * av[4 * g + 3] + uv[4 * g + 3]; }
            float hin = hc[n];
#pragma unroll
            for (int g = 0; g < 4; ++g) { float o1 = Ar[g] * hin + Hr[g]; const float x = __shfl_xor(o1, 32); const float hg = hi ? x : hin; o1 = Ar[g] * hg + Hr[g]; hst[g] = hg;
                const float y = __shfl_xor(o1, 32); hin = hi ? o1 : y;
                if (!FINAL) ap[n] *= Ar[g] * __shfl_xor(Ar[g], 32); }
            hc[n] = hin;
            if (FINAL) {
#pragma unroll
                for (int g = 0; g < 4; ++g) { float h = hst[g];
#pragma unroll
                    for (int e = 0; e < 4; ++e) { const int r = 4 * g + e; h = av[r] * h + uv[r]; yv[n][r] = h * bf2f(GS[(crow16(r) + 4 * hi) * 64 + 32 * n + j32]); } } }
        }
        if (FINAL) {
#pragma unroll
            for (int r = 0; r < 16; ++r) { float s = yv[0][r] * yv[0][r] + yv[1][r] * yv[1][r];
                s += __shfl_xor(s, 1); s += __shfl_xor(s, 2); s += __shfl_xor(s, 4); s += __shfl_xor(s, 8); s += __shfl_xor(s, 16);
                if (j32 == 0) SS[(crow16(r) + 4 * hi) * 8 + w] = s; }
            __syncthreads();
            bf16* ymix = (bf16*)(ws + WS_H);
#pragma unroll
            for (int r = 0; r < 16; ++r) { const int tk = crow16(r) + 4 * hi; const f32x4 s0 = *(const LAS f32x4*)(SS + tk * 8), s1 = *(const LAS f32x4*)(SS + tk * 8 + 4);
                const float rstd = rsqrtf(((s0[0] + s0[1]) + (s0[2] + s0[3]) + (s1[0] + s1[1]) + (s1[2] + s1[3])) * (1.f / LW) + RMS_EPS);
                bf16* yp = ymix + (tb + tk) * DMODEL + 64 * w + k32;
                yp[0] = (bf16)f2bf(yv[0][r] * rstd); yp[32] = (bf16)f2bf(yv[1][r] * rstd); }
            __syncthreads();
        }
    }
#undef LRU_FETCH
    if (!FINAL) { if (hi == 0) { float* cp = carry + ((size_t)(b * NTILE + jt) * 2) * LW + 64 * w + j32;
#pragma unroll
        for (int n = 0; n < 2; ++n) { cp[32 * n] = ap[n]; cp[LW + 32 * n] = hc[n]; } } }
    else {
        const bf16* ob = (const bf16*)(ws + WS_O); bf16* ymix = (bf16*)(ws + WS_H);
        for (int i0 = 0; i0 < 16; i0 += 4) {
            v4u vv[4];
#pragma unroll
            for (int i = 0; i < 4; ++i) vv[i] = *(const GAS v4u*)(ob + (trow0 + 16 * w + i0 + i) * AW + 8 * lane);
            float ssq[4];
#pragma unroll
            for (int i = 0; i < 4; ++i) { float s = 0.f;
#pragma unroll
                for (int c = 0; c < 4; ++c) { const float lo = __uint_as_float(vv[i][c] << 16), hi2 = __uint_as_float(vv[i][c] & 0xffff0000u); s += lo * lo + hi2 * hi2; }
                ssq[i] = s; }
#pragma unroll
            for (int o = 1; o < 64; o <<= 1) {
#pragma unroll
                for (int i = 0; i < 4; ++i) ssq[i] += __shfl_xor(ssq[i], o); }
#pragma unroll
            for (int i = 0; i < 4; ++i) { const float rstd = rsqrtf(ssq[i] * (1.f / AW) + RMS_EPS); v4u o;
#pragma unroll
                for (int c = 0; c < 4; ++c) o[c] = pk2(__uint_as_float(vv[i][c] << 16) * rstd, __uint_as_float(vv[i][c] & 0xffff0000u) * rstd);
                *(GAS v4u*)(ymix + (trow0 + 16 * w + i0 + i) * DMODEL + LW + 8 * lane) = o; } }
    }
}
__device__ __forceinline__ void norm_pass(Frame& F, const Args& a) {
    unsigned char* ws = a.ws; float* nrm = (float*)(ws + WS_NRM);
    const int gw = F.vcu * NWAVES + F.wave, NGW = F.G * NWAVES, lane = F.lane;
    for (int it = gw; it < 2 * BATCH * (SEQ / 64); it += NGW) {
        const int which = it / (BATCH * (SEQ / 64)), r = it % (BATCH * (SEQ / 64)), b = r / (SEQ / 64), t = r % (SEQ / 64);
        const bf16* src = (const bf16*)(ws + (which ? WS_K : WS_Q)) + ((size_t)b * SEQ + 64 * t) * AW + 8 * lane;
        float mx = 0.f;
#pragma unroll 8
        for (int i = 0; i < 64; ++i) { const v4u v = *(const GAS v4u*)(src + (size_t)i * AW); float s = 0.f;
#pragma unroll
            for (int c = 0; c < 4; ++c) { const float lo = __uint_as_float(v[c] << 16), hi = __uint_as_float(v[c] & 0xffff0000u); s += lo * lo + hi * hi; }
            s += __shfl_xor(s, 1); s += __shfl_xor(s, 2); s += __shfl_xor(s, 4); mx = fmaxf(mx, s); }
        if ((lane & 7) == 0) nrm[which * 4096 + (b * NHEADS + (lane >> 3)) * 128 + t] = sqrtf(mx) * 1.0001f;
    }
}
__device__ __forceinline__ void carry_prefix(Frame& F, const Args& a, int b) {
    const float* carry = (const float*)(a.ws + WS_CARRY) + (size_t)b * NTILE * 2 * LW + F.tid; float* cin = (float*)(a.ws + WS_CIN) + (size_t)b * NTILE * LW + F.tid;
    float c = 0.f;
    for (int j0 = 0; j0 < NTILE; j0 += 8) { float A[8], H[8];
#pragma unroll
        for (int j = 0; j < 8; ++j) { A[j] = carry[(size_t)(j0 + j) * 2 * LW]; H[j] = carry[(size_t)(j0 + j) * 2 * LW + LW]; }
#pragma unroll
        for (int j = 0; j < 8; ++j) { cin[(size_t)(j0 + j) * LW] = c; c = A[j] * c + H[j]; } }
}
template <bool FINAL> __device__ __forceinline__ void lru_phase(Frame& F, const Args& a) {
    for (int tile = F.vcu; tile < BATCH * NTILE; tile += F.G) { lru_tile<FINAL>(F, a, tile); __syncthreads(); }
}
}
__global__ void __launch_bounds__(NWAVES * 64, 2) mk_fwd(Args args) {
    extern __shared__ __attribute__((aligned(16))) unsigned char lds[];
    Frame F;
    F.lds = (LAS unsigned char*)lds;
    F.MISC = (volatile LAS unsigned*)(F.lds + MISC_OFF);
    F.wave = __builtin_amdgcn_readfirstlane((int)threadIdx.x >> 6); F.lane = (int)__builtin_amdgcn_mbcnt_hi(~0u, __builtin_amdgcn_mbcnt_lo(~0u, 0u)); F.tid = F.wave * 64 + F.lane;
    F.G = gridDim.x; { const int bx = blockIdx.x; F.vcu = (F.G % 8 == 0) ? (bx % 8) * (F.G / 8) + bx / 8 : bx; }
    unsigned char* ws = args.ws;
    F.ctl = (gu32*)(ws + WS_CTL);
    for (int u = F.tid; u < (LDS_BYTES - LDSCTL_OFF) / 4; u += NWAVES * 64) ((LAS unsigned*)(F.lds + LDSCTL_OFF))[u] = 0u;
    __syncthreads();
    XcdBarrier bar = xcd_barrier_post((unsigned*)(F.ctl + CW_BAR) + args.li * XCD_BAR_WORDS, F.MISC + 8, F.wave);
    const int lo = args.ph_lo, hi = args.ph_hi;
#define IN(k) (lo <= (k) && (k) < hi)
#define BOTH(k) (IN(k) && IN((k) + 1))
#define GRID_BAR() xcd_barrier(bar)

    if (IN(0)) { p0_prologue(F, args); if (BOTH(0)) GRID_BAR(); }

    if (IN(1)) {
        if (F.vcu < BATCH * NHEADS) fcum_unit(F, F.vcu, (const float*)(ws + WS_LOGF), (float*)(ws + WS_FCUM));
        pg8::Gemm g{(const pg8::bf16_t*)(ws + WS_H), (const pg8::bf16_t*)(ws + WS_WIN), T, NG1, DMODEL}; pg8::StaticOrder S; S.init(T, NG1, F.G, (int)blockIdx.x);
        pg8::EpiG1 E{(pg8::bf16_t*)(ws + WS_XR), SPLIT_STRIDE, QSCALE};
        pg8::gemm_phase<pg8::EpiG1, pg8::StaticOrder, true, true>(F.lds + RING_OFF, g, S, E, F.wave);
        if (BOTH(1)) GRID_BAR();
    }
    if (IN(2)) { lru::lru_phase<false>(F, args); lru::norm_pass(F, args); if (BOTH(2)) GRID_BAR(); }
    if (IN(3)) {
        static_assert(attn_body::ATTN_LDS_BYTES <= RING_BYTES, "attention LDS vs frame");
        if (F.vcu < BATCH) lru::carry_prefix(F, args, F.vcu);
        const attn_body::AttnTensors AT{(const attn_body::bf16*)(ws + WS_Q), (const attn_body::bf16*)(ws + WS_K), (const attn_body::bf16*)(ws + WS_V), (attn_body::bf16*)(ws + WS_O), (const float*)(ws + WS_FCUM), (const float*)(ws + WS_NRM)};
        attn_body::attn_phase<8>((char*)lds + RING_OFF, AT, (unsigned*)(F.ctl + CW_ATTQ), F.MISC + 24, F.wave);
        if (BOTH(3)) GRID_BAR();
    }
    if (IN(4)) { lru::lru_phase<true>(F, args); if (BOTH(4)) GRID_BAR(); }
    if (IN(5)) {
        pg8::Gemm g{(const pg8::bf16_t*)(ws + WS_H), (const pg8::bf16_t*)(ws + WS_WOUT), T, DMODEL, DMODEL}; pg8::StaticOrder S; S.init(T, DMODEL, F.G, (int)blockIdx.x);
        pg8::EpiG2 E{args.in[0], args.out, (pg8::bf16_t*)(ws + WS_X1B), (float*)(ws + WS_SUMSQ), DMODEL};
        pg8::gemm_phase<pg8::EpiG2, pg8::StaticOrder, true, true>(F.lds + RING_OFF, g, S, E, F.wave);
        if (BOTH(5)) GRID_BAR();
    }
    if (IN(6)) {
        pg8::Gemm g{(const pg8::bf16_t*)(ws + WS_X1B), (const pg8::bf16_t*)(ws + WS_WQ), T, QPW, DMODEL}; pg8::StaticOrder S; S.init(T, QPW, F.G, (int)blockIdx.x);
        pg8::EpiG3 E{(pg8::bf16_t*)(ws + WS_QP), QPW};
        pg8::gemm_phase<pg8::EpiG3, pg8::StaticOrder, true, true>(F.lds + RING_OFF, g, S, E, F.wave);
        if (BOTH(6)) GRID_BAR();
    }
    if (IN(7)) { peer::peer_phase(F, args); }
#undef IN
#undef BOTH
#undef GRID_BAR
}

extern "C" void kernel_launch(void* const* d_in, const int* in_sizes, int n_in, void* d_out, int out_size, void* d_ws, size_t ws_size, hipStream_t stream) {
    static int grid = 0;
    if (grid == 0) {
        if (n_in != 20 || in_sizes[0] != T * DMODEL || out_size != T * DMODEL || ws_size < WS_END) { fprintf(stderr, "kernel_launch: unexpected shapes (n_in %d, ws %zu)\n", n_in, ws_size); grid = -1; return; }
        int dev = 0, cus = 0;
        if (hipGetDevice(&dev) != hipSuccess || hipDeviceGetAttribute(&cus, hipDeviceAttributeMultiprocessorCount, dev) != hipSuccess) { grid = -1; return; }
        if (hipFuncSetAttribute((const void*)mk_fwd, hipFuncAttributeMaxDynamicSharedMemorySize, LDS_BYTES) != hipSuccess) { fprintf(stderr, "kernel_launch: hipFuncSetAttribute failed\n"); grid = -1; return; }
        (void)hipGetLastError();
        grid = cus;
    }
    if (grid < 0) return;
    if (hipMemsetAsync((char*)d_ws + WS_CTL, 0, CTL_ZERO_BYTES, stream) != hipSuccess) return;
    Args a{};
    for (int i = 0; i < 20; ++i) a.in[i] = (const float*)d_in[i];
    a.out = (float*)d_out; a.ws = (unsigned char*)d_ws; a.ph_lo = 0; a.ph_hi = N_PHASES; a.li = 0;
    hipLaunchKernelGGL(mk_fwd, dim3(grid), dim3(NWAVES * 64), LDS_BYTES, stream, a);
}
```

```cpp
#include <hip/hip_runtime.h>
#include <hip/hip_bf16.h>
#include <cstdio>
#include <cstdint>
#include <cmath>

constexpr int BATCH = 4, SEQ = 8192, DMODEL = 1024, T = BATCH * SEQ;
constexpr int LW = 512, AW = 512, NHEADS = 8, HD = 64, INC = 2568, NG1 = 2560;
constexpr int PH = 8, NKEY = 128, PHALF = 128, TOPK = 16, NEXP = NKEY * NKEY, QPW = 2048;
constexpr float RMS_EPS = 1e-6f;
constexpr float LOG2E = 1.4426950408889634f;
constexpr float QSCALE = 0.125f * LOG2E;
constexpr size_t MiB = 1u << 20;
constexpr size_t WS_CTL = 0, CTL_ZERO_BYTES = 1 * MiB;
constexpr size_t WS_WIN = 2 * MiB, WS_WOUT = 8 * MiB, WS_WQ = 10 * MiB, WS_SKB = 14 * MiB, WS_WFL = 15 * MiB,
                 WS_LOGF = 16 * MiB, WS_FCUM = 17 * MiB, WS_CARRY = 18 * MiB, WS_SUMSQ = 512 * 1024  , WS_WAX = 20 * MiB, WS_CIN = 23 * MiB  , WS_NRM = 22 * MiB  ,
                 WS_H = 32 * MiB, WS_XR = 96 * MiB, WS_GR = 128 * MiB, WS_Q = 160 * MiB, WS_K = 192 * MiB, WS_V = 224 * MiB,
                 WS_X1B = 256 * MiB, WS_O = 256 * MiB  , WS_QP = 96 * MiB, WS_UT = 320 * MiB, WS_VT = 352 * MiB, WS_U8 = 320 * MiB, WS_V8 = 336 * MiB, WS_SU = 21 * MiB, WS_SV = 21 * MiB + 65536, WS_LA = 384 * MiB, WS_LU = 448 * MiB, WS_END = 512 * MiB;
constexpr size_t SPLIT_STRIDE = (WS_GR - WS_XR) / 2;
constexpr int CW_TMO = 0, CW_ATTQ = 2048, CW_BAR = 4096;

namespace pg8 {
#define PG8_LAS __attribute__((address_space(3)))
typedef unsigned short bf16_t;
typedef short bf16x8 __attribute__((ext_vector_type(8)));
typedef float f32x4 __attribute__((ext_vector_type(4)));
typedef unsigned u32x4 __attribute__((ext_vector_type(4)));
constexpr int BM = 256, BK = 64, HALF = 128, HTB = HALF * BK * 2  , STAGE_BYTES = 8 * HTB, NXCD = 8, WGM = 8;

__host__ __device__ __forceinline__ int lds_byte(int r, int c) { const int st = (r >> 4) * 2 + (c >> 5), rr = r & 15, cc = c & 31, ob = rr * 64 + cc * 2; return st * 1024 + (ob ^ (((ob >> 9) & 1) << 5)); }
__host__ __device__ __forceinline__ void stage_rc(int b, int& R, int& C) { const int st = b / 1024, sb = b % 1024, swz = sb ^ (((sb >> 9) & 1) << 5); R = (st >> 1) * 16 + swz / 64; C = (st & 1) * 32 + (swz % 64) / 2; }
__host__ __device__ __forceinline__ int perm32(int rho) { const int n = rho >> 4, i = rho & 15; return 8 * (i >> 2) + 4 * n + (i & 3); }

struct Unit { int pm, pn; };
struct Gemm { const bf16_t* A; const bf16_t* Bt; int M, N, K; };

struct StaticOrder {
    int nM, nN, nwg, G, c;
    __host__ __device__ void init(int M, int N, int G_, int c_) { nM = M / BM; nN = N / BM; nwg = nM * nN; G = G_; c = c_; }
    __host__ __device__ bool next(int i, Unit& u) const {
        const long L = (long)i * G + c; if (L >= nwg) return false;
        int wgid = (int)L; { const int q = nwg / NXCD, r = nwg % NXCD, xcd = wgid % NXCD, off = wgid / NXCD; wgid = (xcd < r ? xcd * (q + 1) : r * (q + 1) + (xcd - r) * q) + off; }
        const int nig = WGM * nN, gid = wgid / nig, fm = gid * WGM, gsz = (nM - fm) < WGM ? (nM - fm) : WGM;
        u.pm = fm + ((wgid % nig) % gsz); u.pn = (wgid % nig) / gsz; return true;
    }
    __device__ __forceinline__ void a_ready(const Unit&) const {}
    __device__ __forceinline__ void done(const Unit&) const {}
};

__device__ __forceinline__ unsigned cvt_pk_bf16(float lo, float hi) { unsigned r; asm volatile("v_cvt_pk_bf16_f32 %0, %1, %2" : "=v"(r) : "v"(lo), "v"(hi)); return r; }
typedef unsigned u32x2 __attribute__((ext_vector_type(2)));
__device__ __forceinline__ float gelu_fast(float x) {
    const float u2 = x * (1.5957691216057308f + 0.07135481627f * x * x);
    return x * __builtin_amdgcn_rcpf(1.f + __builtin_amdgcn_exp2f(-1.4426950408889634f * u2));
}
struct EpiG1 {
    static constexpr bool PERM = true, AFTER_DRAIN = false;
    bf16_t* base0; size_t split_stride; float qscale;
    __device__ __forceinline__ void operator()(const f32x4 (&acc)[2][2][4][2], const Unit& u, int wr, int wc, int fr, int fq) const {
        const int s = u.pn >> 1; bf16_t* base = base0 + (size_t)s * split_stride;
        const int row0 = u.pm * BM + wr * 64 + fr, col0 = (u.pn & 1) * 256 + wc * 32 + 8 * fq;
#pragma unroll
        for (int ai = 0; ai < 2; ++ai)
#pragma unroll
            for (int m = 0; m < 4; ++m) { bf16_t* rowp = base + (size_t)(row0 + ai * HALF + m * 16) * 512 + col0;
#pragma unroll
                for (int bj = 0; bj < 2; ++bj) { f32x4 v0 = acc[ai][bj][m][0], v1 = acc[ai][bj][m][1];
                    if (s == 1) {
#pragma unroll
                        for (int e = 0; e < 4; ++e) { v0[e] = gelu_fast(v0[e]); v1[e] = gelu_fast(v1[e]); } }
                    else if (s == 2) { v0 = v0 * qscale; v1 = v1 * qscale; }
                    u32x4 w; w.x = cvt_pk_bf16(v0[0], v0[1]); w.y = cvt_pk_bf16(v0[2], v0[3]); w.z = cvt_pk_bf16(v1[0], v1[1]); w.w = cvt_pk_bf16(v1[2], v1[3]);
                    *(u32x4*)(rowp + bj * HALF) = w; } }
    }
};
struct EpiG2 {
    static constexpr bool PERM = false, AFTER_DRAIN = false;
    const float* resid; float* out; bf16_t* xb; float* sumsq; int ldc;
    __device__ __forceinline__ void operator()(const f32x4 (&acc)[2][2][4][2], const Unit& u, int wr, int wc, int fr, int fq) const {
        const int row0 = u.pm * BM + wr * 64 + fr, col0 = u.pn * BM + wc * 32 + 4 * fq;
#pragma unroll
        for (int ai = 0; ai < 2; ++ai) {
            f32x4 rs[4][2][2];
#pragma unroll
            for (int m = 0; m < 4; ++m) { const size_t off = (size_t)(row0 + ai * HALF + m * 16) * ldc + col0;
#pragma unroll
                for (int bj = 0; bj < 2; ++bj)
#pragma unroll
                    for (int n = 0; n < 2; ++n) rs[m][bj][n] = *(const f32x4*)(resid + off + bj * HALF + n * 16); }
#pragma unroll
            for (int m = 0; m < 4; ++m) { const int r = row0 + ai * HALF + m * 16; const size_t off = (size_t)r * ldc + col0; float ss = 0.f;
#pragma unroll
                for (int bj = 0; bj < 2; ++bj)
#pragma unroll
                    for (int n = 0; n < 2; ++n) { const f32x4 x = rs[m][bj][n] + acc[ai][bj][m][n];
                        *(f32x4*)(out + off + bj * HALF + n * 16) = x; ss += (x[0] * x[0] + x[1] * x[1]) + (x[2] * x[2] + x[3] * x[3]);
                        u32x2 w; w.x = cvt_pk_bf16(x[0], x[1]); w.y = cvt_pk_bf16(x[2], x[3]); *(u32x2*)(xb + off + bj * HALF + n * 16) = w; }
                ss += __shfl_xor(ss, 16); ss += __shfl_xor(ss, 32);
                if (fq == 0) atomicAdd(sumsq + r, ss); }
            asm volatile("" ::: "memory"); }
    }
};
struct EpiG3 {
    static constexpr bool PERM = true, AFTER_DRAIN = false;
    bf16_t* O; int ldc;
    __device__ __forceinline__ void operator()(const f32x4 (&acc)[2][2][4][2], const Unit& u, int wr, int wc, int fr, int fq) const {
        const int row0 = u.pm * BM + wr * 64 + fr;
#pragma unroll
        for (int ai = 0; ai < 2; ++ai)
#pragma unroll
            for (int m = 0; m < 4; ++m) { const int t = row0 + ai * HALF + m * 16;
#pragma unroll
                for (int bj = 0; bj < 2; ++bj) { const f32x4 v0 = acc[ai][bj][m][0], v1 = acc[ai][bj][m][1];
                    u32x4 w; w.x = cvt_pk_bf16(v0[0], v0[1]); w.y = cvt_pk_bf16(v0[2], v0[3]); w.z = cvt_pk_bf16(v1[0], v1[1]); w.w = cvt_pk_bf16(v1[2], v1[3]);
                    *(u32x4*)(O + ((size_t)(((((t >> 5) * 8 + u.pn) * 2 + bj) * 16 + 4 * wc + fq) * 32 + (t & 31))) * 8) = w; } }
    }
};

template <class Epi, class Sched, bool ALIGN_EPI = false, bool SP2 = false>
__device__ __forceinline__ void gemm_phase(PG8_LAS unsigned char* lds, const Gemm g, const Sched& S, const Epi& E, int wid_in) {
    const int wid = __builtin_amdgcn_readfirstlane(wid_in), lane = (int)__builtin_amdgcn_mbcnt_hi(~0u, __builtin_amdgcn_mbcnt_lo(~0u, 0u)), tid = wid * 64 + lane, wr = wid >> 2, wc = wid & 3, fr = lane & 15, fq = lane >> 4;
    const int K = g.K, nt = K / BK;
    unsigned voffA[2], voffB[2];
#pragma unroll
    for (int i = 0; i < 2; ++i) { int R, C; stage_rc(tid * 16 + i * 8192, R, C); const int Rb = Epi::PERM ? ((R & ~31) + perm32(R & 31)) : R;
        voffA[i] = (unsigned)(R * K + C) * 2u; voffB[i] = (unsigned)(Rb * K + C) * 2u; }
    const size_t kstep = (size_t)(BK * 2);
    const size_t hstep = (size_t)HALF * K * 2;
    const size_t tstep = 2 * hstep;
    const unsigned ldsw = (unsigned)wid * 1024u;
    const int aoff = lds_byte(wr * 64 + fr, fq * 8), boff = lds_byte(wc * 32 + fr, fq * 8);
#define PG8_SA(b, h) (((b) * 2 + (h)) * HTB)
#define PG8_SB(b, h) ((4 + (b) * 2 + (h)) * HTB)
#define PG8_STAGE(bufoff, gbase, voff) do { _Pragma("unroll") for (int _i = 0; _i < 2; ++_i) \
        __builtin_amdgcn_global_load_lds((const unsigned*)((const char*)(gbase) + (voff)[_i]), (PG8_LAS unsigned*)(lds + (bufoff) + ldsw + _i * 8192), 16, 0, 0); } while (0)
#define PG8_LDA(dst, b, h) do { _Pragma("unroll") for (int m = 0; m < 4; ++m) _Pragma("unroll") for (int k = 0; k < 2; ++k) dst[m][k] = *(const PG8_LAS bf16x8*)(lds + PG8_SA(b, h) + aoff + m * 2048 + k * 1024); } while (0)
#define PG8_LDB(dst, b, h) do { _Pragma("unroll") for (int n = 0; n < 2; ++n) _Pragma("unroll") for (int k = 0; k < 2; ++k) dst[n][k] = *(const PG8_LAS bf16x8*)(lds + PG8_SB(b, h) + boff + n * 2048 + k * 1024); } while (0)
#define PG8_MMA(ai, bj, At, Bt) do { __builtin_amdgcn_s_setprio(1); _Pragma("unroll") for (int m = 0; m < 4; ++m) _Pragma("unroll") for (int n = 0; n < 2; ++n) _Pragma("unroll") for (int k = 0; k < 2; ++k) \
        acc[ai][bj][m][n] = __builtin_amdgcn_mfma_f32_16x16x32_bf16(Bt[n][k], At[m][k], acc[ai][bj][m][n], 0, 0, 0); __builtin_amdgcn_s_setprio(0); } while (0)
#define PG8_WAIT_V(n) asm volatile("s_waitcnt vmcnt(" #n ")" ::: "memory")
#define PG8_WAIT_L(n) asm volatile("s_waitcnt lgkmcnt(" #n ")" ::: "memory")
#define PG8_BAR __builtin_amdgcn_s_barrier()
#define PG8_SCHED __builtin_amdgcn_sched_barrier(0)
    Unit cur, nxt; int ui = 0;
    if (!S.next(0, cur)) return;
    f32x4 acc[2][2][4][2];
#pragma unroll
    for (int a = 0; a < 2; ++a)
#pragma unroll
        for (int b = 0; b < 2; ++b)
#pragma unroll
            for (int m = 0; m < 4; ++m)
#pragma unroll
                for (int n = 0; n < 2; ++n) acc[a][b][m][n] = (f32x4){0.f, 0.f, 0.f, 0.f};
    bf16x8 At[4][2], B0[2][2], B1[2][2];
    const char* cA = (const char*)g.A + (size_t)cur.pm * tstep; const char* cB = (const char*)g.Bt + (size_t)cur.pn * tstep;
    S.a_ready(cur);
    if constexpr (SP2) {
        PG8_STAGE(PG8_SB(0, 0), cB, voffB); PG8_STAGE(PG8_SB(0, 1), cB + hstep, voffB); PG8_STAGE(PG8_SA(0, 0), cA, voffA); PG8_STAGE(PG8_SA(0, 1), cA + hstep, voffA);
        if (wr == 1) PG8_BAR;
        PG8_WAIT_V(2); PG8_BAR;
        PG8_STAGE(PG8_SB(1, 0), cB + kstep, voffB); PG8_STAGE(PG8_SA(1, 0), cA + kstep, voffA); PG8_STAGE(PG8_SB(1, 1), cB + hstep + kstep, voffB);
        PG8_WAIT_V(6); PG8_BAR;
    } else {
        PG8_STAGE(PG8_SB(0, 0), cB, voffB); PG8_STAGE(PG8_SA(0, 0), cA, voffA); PG8_STAGE(PG8_SB(0, 1), cB + hstep, voffB); PG8_STAGE(PG8_SA(0, 1), cA + hstep, voffA);
        if (wr == 1) PG8_BAR;
        PG8_WAIT_V(4); PG8_BAR;
        PG8_STAGE(PG8_SB(1, 0), cB + kstep, voffB); PG8_STAGE(PG8_SA(1, 0), cA + kstep, voffA); PG8_STAGE(PG8_SB(1, 1), cB + hstep + kstep, voffB);
        PG8_WAIT_V(6); PG8_BAR;
    }
    for (;;) {
        const bool has_next = S.next(ui + 1, nxt);
        const char* nA = has_next ? (const char*)g.A + (size_t)nxt.pm * tstep : cA; const char* nB = has_next ? (const char*)g.Bt + (size_t)nxt.pn * tstep : cB;
        for (int t = 0; t < nt; t += 2) {
            const bool last = (t == nt - 2);
            const char* a1 = cA + (size_t)(t + 1) * kstep;
            const char* a2 = last ? nA : cA + (size_t)(t + 2) * kstep; const char* b2 = last ? nB : cB + (size_t)(t + 2) * kstep;
            const char* a3 = a2 + kstep; const char* b3 = b2 + kstep;
            if (last && has_next) S.a_ready(nxt);
            if constexpr (SP2) {
            PG8_LDB(B0, 0, 0); PG8_LDB(B1, 0, 1); PG8_SCHED; PG8_LDA(At, 0, 0); PG8_STAGE(PG8_SA(1, 1), a1 + hstep, voffA);
            PG8_WAIT_V(8); PG8_WAIT_L(0); PG8_BAR; PG8_MMA(0, 0, At, B0); PG8_MMA(0, 1, At, B1); PG8_BAR; PG8_SCHED;
            PG8_LDA(At, 0, 1); PG8_STAGE(PG8_SB(0, 0), b2, voffB); PG8_STAGE(PG8_SB(0, 1), b2 + hstep, voffB); PG8_STAGE(PG8_SA(0, 0), a2, voffA);
            PG8_WAIT_V(8); PG8_WAIT_L(0); PG8_BAR; PG8_MMA(1, 0, At, B0); PG8_MMA(1, 1, At, B1); PG8_BAR; PG8_SCHED;
            PG8_LDB(B0, 1, 0); PG8_LDB(B1, 1, 1); PG8_SCHED; PG8_LDA(At, 1, 0); PG8_STAGE(PG8_SA(0, 1), a2 + hstep, voffA);
            PG8_WAIT_V(8); PG8_WAIT_L(0); PG8_BAR; PG8_MMA(0, 0, At, B0); PG8_MMA(0, 1, At, B1); PG8_BAR; PG8_SCHED;
            PG8_LDA(At, 1, 1); PG8_STAGE(PG8_SB(1, 0), b3, voffB); PG8_STAGE(PG8_SB(1, 1), b3 + hstep, voffB); PG8_STAGE(PG8_SA(1, 0), a3, voffA);
            PG8_WAIT_V(8); PG8_WAIT_L(0); PG8_BAR; PG8_MMA(1, 0, At, B0); PG8_MMA(1, 1, At, B1); PG8_BAR; PG8_SCHED;
            } else {
            PG8_LDB(B0, 0, 0); PG8_SCHED; PG8_LDA(At, 0, 0); PG8_STAGE(PG8_SA(1, 1), a1 + hstep, voffA);
            PG8_WAIT_L(8); PG8_BAR; PG8_WAIT_L(0); PG8_MMA(0, 0, At, B0); PG8_BAR; PG8_SCHED;
            PG8_LDB(B1, 0, 1); PG8_STAGE(PG8_SB(0, 0), b2, voffB);
            PG8_BAR; PG8_WAIT_L(0); PG8_MMA(0, 1, At, B1); PG8_BAR;
            PG8_LDA(At, 0, 1); PG8_STAGE(PG8_SA(0, 0), a2, voffA);
            PG8_BAR; PG8_WAIT_L(0); PG8_MMA(1, 0, At, B0); PG8_BAR; PG8_SCHED;
            PG8_STAGE(PG8_SB(0, 1), b2 + hstep, voffB);
            PG8_WAIT_V(6); PG8_BAR; PG8_MMA(1, 1, At, B1); PG8_BAR;
            PG8_LDB(B0, 1, 0); PG8_SCHED; PG8_LDA(At, 1, 0); PG8_STAGE(PG8_SA(0, 1), a2 + hstep, voffA);
            PG8_WAIT_L(8); PG8_BAR; PG8_WAIT_L(0); PG8_MMA(0, 0, At, B0); PG8_BAR; PG8_SCHED;
            PG8_LDB(B1, 1, 1); PG8_STAGE(PG8_SB(1, 0), b3, voffB);
            PG8_BAR; PG8_WAIT_L(0); PG8_MMA(0, 1, At, B1); PG8_BAR;
            PG8_LDA(At, 1, 1); PG8_STAGE(PG8_SA(1, 0), a3, voffA);
            PG8_BAR; PG8_WAIT_L(0); PG8_MMA(1, 0, At, B0); PG8_BAR; PG8_SCHED;
            PG8_STAGE(PG8_SB(1, 1), b3 + hstep, voffB);
            PG8_WAIT_V(6); PG8_BAR; PG8_MMA(1, 1, At, B1); PG8_BAR;
            }
        }
        if constexpr (ALIGN_EPI) { if (wr == 0) PG8_BAR; }
        if constexpr (!Epi::AFTER_DRAIN) { E(acc, cur, wr, wc, fr, fq); S.done(cur); }
        if (!has_next) break;
#pragma unroll
        for (int a = 0; a < 2; ++a)
#pragma unroll
            for (int b = 0; b < 2; ++b)
#pragma unroll
                for (int m = 0; m < 4; ++m)
#pragma unroll
                    for (int n = 0; n < 2; ++n) acc[a][b][m][n] = (f32x4){0.f, 0.f, 0.f, 0.f};
        cur = nxt; cA = nA; cB = nB; ++ui;
        if constexpr (ALIGN_EPI) { if (wr == 1) PG8_BAR; }
    }
    PG8_WAIT_V(0);
    if constexpr (!ALIGN_EPI) { if (wr == 0) PG8_BAR; }
    PG8_BAR;
    if constexpr (Epi::AFTER_DRAIN) { E.fused(acc, cur, wr, wc, fr, fq, lds, wid, lane); S.done(cur); }
#undef PG8_SA
#undef PG8_SB
#undef PG8_STAGE
#undef PG8_LDA
#undef PG8_LDB
#undef PG8_MMA
#undef PG8_WAIT_V
#undef PG8_WAIT_L
#undef PG8_BAR
#undef PG8_SCHED
}
}
#include <hip/hip_bf16.h>
#include <cmath>
namespace attn_body {
using bf16=__hip_bfloat16;
using bf16x8=__attribute__((ext_vector_type(8)))short;
using s16x4=__attribute__((ext_vector_type(4)))short;
using f32x16=__attribute__((ext_vector_type(16)))float;
using u32x4=__attribute__((ext_vector_type(4)))unsigned;
constexpr int BATCH=4,NHEAD=8,SEQ=8192,D=64,DM=NHEAD*D;
constexpr int NW=8,QBLK=32,QB=QBLK*NW,KVBLK=64,NQB=SEQ/QB;
constexpr int ATTN_PITCH=DM, ATTN_UNIT_ROWS=QB;
__device__ __forceinline__ int crow(int r,int hi){return (r&3)+8*(r>>2)+4*hi;}
#define SBAR() __builtin_amdgcn_sched_barrier(0)
__device__ __forceinline__ void cmask(f32x16&p0,f32x16&p1,int jb,int qrel,int hi){
  const float NEG=-INFINITY; int kb=64*jb+4*hi;
  #pragma unroll
  for(int r=0;r<16;++r){int kv=kb+(r&3)+8*(r>>2); if(kv>qrel)p0[r]=NEG; if(kv+32>qrel)p1[r]=NEG;}
}

constexpr int NSLOT=3, SLOTB=8192;
constexpr int LDS_K=0, LDS_V=NSLOT*SLOTB, LDS_WS=2*NSLOT*SLOTB, LDS_OST=LDS_WS+NW*64*4, LDS_FK=LDS_OST+NW*4096, LDS_BYTES=LDS_FK+SEQ*4;
constexpr float C2=0.125f*1.4426950408889634f;
__device__ __forceinline__ void glds16(const void*gsrc,unsigned lds_dst){unsigned keep;
  asm volatile("s_mov_b32 %0, m0\n\ts_mov_b32 m0, %2\n\ts_nop 0\n\tglobal_load_lds_dwordx4 %1, off\n\ts_mov_b32 m0, %0":"=&s"(keep):"v"(gsrc),"s"(lds_dst):"memory");}
__device__ __forceinline__ float max3f(float a,float b,float c){float r;asm("v_max3_f32 %0, %1, %2, %3":"=v"(r):"v"(a),"v"(b),"v"(c));return r;}
__device__ __forceinline__ float max2f(float a,float b){float r;asm("v_max_f32_e32 %0, %1, %2":"=v"(r):"v"(a),"v"(b));return r;}
__device__ __forceinline__ float fadd_s(float a,float b){float r;asm("v_add_f32_e32 %0, %1, %2":"=v"(r):"v"(a),"v"(b));return r;}
__device__ __forceinline__ float fsub_s(float a,float b){float r;asm("v_sub_f32_e32 %0, %1, %2":"=v"(r):"v"(a),"v"(b));return r;}
typedef float f32x2_t __attribute__((ext_vector_type(2))); typedef __bf16 bf16x2_t __attribute__((ext_vector_type(2)));
__device__ __forceinline__ unsigned cvtpk_s(float lo,float hi){f32x2_t v={lo,hi};bf16x2_t b=__builtin_convertvector(v,bf16x2_t);return __builtin_bit_cast(unsigned,b);}
#define WAIT_BAR(N) asm volatile("s_waitcnt vmcnt(" #N ") lgkmcnt(0)\n\ts_barrier":::"memory")

__device__ __forceinline__ void qkt(f32x16&p0,f32x16&p1,const char*Kslot,const bf16x8*qr,int r32,int hi){
  const char*kb=Kslot+hi*1024+r32*16;
  #pragma unroll
  for(int d0=0;d0<4;++d0){
    const bf16x8 b0=*reinterpret_cast<const bf16x8*>(kb+d0*2048);
    const bf16x8 b1=*reinterpret_cast<const bf16x8*>(kb+d0*2048+512);
    p0=__builtin_amdgcn_mfma_f32_32x32x16_bf16(b0,qr[d0],p0,0,0,0);p1=__builtin_amdgcn_mfma_f32_32x32x16_bf16(b1,qr[d0],p1,0,0,0);}
}
typedef __attribute__((address_space(3))) const char* lds_cptr;
typedef short v4i16_t __attribute__((ext_vector_type(4)));
__device__ __forceinline__ void kload8(bf16x8*kf,lds_cptr kp){
  kf[0]=*(const __attribute__((address_space(3))) bf16x8*)(kp);      kf[1]=*(const __attribute__((address_space(3))) bf16x8*)(kp+512);
  kf[2]=*(const __attribute__((address_space(3))) bf16x8*)(kp+2048); kf[3]=*(const __attribute__((address_space(3))) bf16x8*)(kp+2560);
  kf[4]=*(const __attribute__((address_space(3))) bf16x8*)(kp+4096); kf[5]=*(const __attribute__((address_space(3))) bf16x8*)(kp+4608);
  kf[6]=*(const __attribute__((address_space(3))) bf16x8*)(kp+6144); kf[7]=*(const __attribute__((address_space(3))) bf16x8*)(kp+6656);
}
__device__ __forceinline__ void kload2(bf16x8*kf,lds_cptr kp,int j){ kf[2*j]=*(const __attribute__((address_space(3))) bf16x8*)(kp+j*2048); kf[2*j+1]=*(const __attribute__((address_space(3))) bf16x8*)(kp+j*2048+512); }
__device__ __forceinline__ s16x4 vtr(lds_cptr p){ return __builtin_bit_cast(s16x4,__builtin_amdgcn_ds_read_tr16_b64_v4i16((__attribute__((address_space(3))) v4i16_t*)p)); }
__device__ __forceinline__ float rowmax(const f32x16&p0,const f32x16&p1){
  float a=max3f(p0[0],p0[1],p1[0]),b=max3f(p0[2],p0[3],p1[1]);a=max3f(a,p1[2],p1[3]);
  #pragma unroll
  for(int r=4;r<16;r+=4){a=max3f(a,p0[r],p0[r+1]);b=max3f(b,p0[r+2],p0[r+3]);a=max3f(a,p1[r],p1[r+1]);b=max3f(b,p1[r+2],p1[r+3]);}
  const float m=max2f(a,b);
  auto rr=__builtin_amdgcn_permlane32_swap(__float_as_uint(m),__float_as_uint(m),false,false);
  return max2f(__uint_as_float(rr[0]),__uint_as_float(rr[1]));
}
__device__ __forceinline__ void pv(f32x16*o,int vb,bf16x8 pa0,bf16x8 pa1,bf16x8 pa2,bf16x8 pa3){
  #pragma unroll
  for(int d0=0;d0<2;++d0){s16x4 lo[4],hi[4];
    #pragma unroll
    for(int ks=0;ks<4;++ks){
      asm volatile("ds_read_b64_tr_b16 %0,%1 offset:%c2":"=&v"(lo[ks]):"v"(vb),"i"(d0*4096+ks*1024):"memory");
      asm volatile("ds_read_b64_tr_b16 %0,%1 offset:%c2":"=&v"(hi[ks]):"v"(vb),"i"(d0*4096+ks*1024+512):"memory");}
    asm volatile("s_waitcnt lgkmcnt(0)":::"memory");SBAR();
    #define PK(k) (bf16x8){lo[k][0],lo[k][1],lo[k][2],lo[k][3],hi[k][0],hi[k][1],hi[k][2],hi[k][3]}
    o[d0]=__builtin_amdgcn_mfma_f32_32x32x16_bf16(pa0,PK(0),o[d0],0,0,0);
    o[d0]=__builtin_amdgcn_mfma_f32_32x32x16_bf16(pa1,PK(1),o[d0],0,0,0);
    o[d0]=__builtin_amdgcn_mfma_f32_32x32x16_bf16(pa2,PK(2),o[d0],0,0,0);
    o[d0]=__builtin_amdgcn_mfma_f32_32x32x16_bf16(pa3,PK(3),o[d0],0,0,0);
    #undef PK
  }
}

#ifndef ATTN_STORE16
#define ATTN_STORE16(p,v) (*(u32x4*)(p)=(v))
#endif
template<int THRL> __device__ __forceinline__ void attn_unit(int b,int h,int qb,const bf16*Q,const bf16*__restrict__ K,const bf16*__restrict__ V,bf16*O,const float*__restrict__ Fc,const float*__restrict__ NRM,char*shm,int wid_in){
  const int wid=__builtin_amdgcn_readfirstlane(wid_in); int lane_=(int)__builtin_amdgcn_mbcnt_hi(~0u,__builtin_amdgcn_mbcnt_lo(~0u,0u)); asm volatile("":"+v"(lane_));
  const int lane=lane_,tid=wid*64+lane,r32=lane&31,hi=lane>>5;
  const long rowbase=(long)b*SEQ; const int q0=qb*QB;
  const float*Fbh=Fc+(long)(b*NHEAD+h)*SEQ;
  const int NTF=(q0+QB)/KVBLK; int t_start;
  { const float*QNb=NRM+(b*NHEAD+h)*128,*KNb=NRM+4096+(b*NHEAD+h)*128;
    const float qn=fmaxf(fmaxf(QNb[4*qb],QNb[4*qb+1]),fmaxf(QNb[4*qb+2],QNb[4*qb+3])),knb=fmaxf(fmaxf(KNb[4*qb],KNb[4*qb+1]),fmaxf(KNb[4*qb+2],KNb[4*qb+3]));
    const float fq0=Fbh[q0]*1.4426950408889634f; bool k0=true,k1=true;
    if(lane<NTF-4)k0=!(qn*(KNb[lane]+knb)+(fq0-Fbh[64*lane+63]*1.4426950408889634f)<-40.f);
    if(lane+64<NTF-4)k1=!(qn*(KNb[lane+64]+knb)+(fq0-Fbh[64*(lane+64)+63]*1.4426950408889634f)<-40.f);
    const unsigned long long m0=__ballot(k0),m1=__ballot(k1);
    int tf=m0?(int)__builtin_ctzll(m0):64+(m1?(int)__builtin_ctzll(m1):64);
    tf=tf<NTF-4?tf:NTF-4; t_start=__builtin_amdgcn_readfirstlane(tf&~1); }
  { typedef float f32x4_t __attribute__((ext_vector_type(4))); __attribute__((address_space(3))) float*fk=(__attribute__((address_space(3))) float*)((__attribute__((address_space(3))) char*)shm+LDS_FK); const int n4=(q0+QB)/4;
    for(int i=16*t_start+tid;i<n4;i+=NW*64){ f32x4_t v=*(const f32x4_t*)(Fbh+4*i); v=v*(-1.4426950408889634f); *(__attribute__((address_space(3))) f32x4_t*)(fk+4*i)=v; } }
  float fq2=Fbh[q0+wid*QBLK+r32]*1.4426950408889634f; asm volatile("":"+v"(fq2));
  const bf16*Qw=Q+(rowbase+q0+wid*QBLK)*DM+h*D;
  const bf16*Kh=K+(rowbase+(long)t_start*KVBLK)*DM+h*D,*Vh=V+(rowbase+(long)t_start*KVBLK)*DM+h*D;
  const lds_cptr shm3=(lds_cptr)shm;
  const unsigned lds0=(unsigned)(uintptr_t)shm;
  float*wsf=(float*)(shm+LDS_WS)+wid*64;
  const bf16*ksrc=Kh+(long)lane*DM+wid*8;
  const bf16*vsrc=Vh+(long)(16*(wid&3)+(lane>>2))*DM+(wid>>2)*32+(lane&3)*8;
  const unsigned kdst=lds0+LDS_K+wid*1024, vdst=lds0+LDS_V+wid*1024;
  #define DMA_K(t,slot) glds16(ksrc+(long)(t)*KVBLK*DM,(unsigned)__builtin_amdgcn_readfirstlane(kdst+(slot)))
  #define DMA_V(t,slot) glds16(vsrc+(long)(t)*KVBLK*DM,(unsigned)__builtin_amdgcn_readfirstlane(vdst+(slot)))
  const int vb0=(int)(lds0+LDS_V)+((lane>>4)&1)*32+(lane&3)*8+(4*hi+((lane&15)>>2))*64;
  const char*Kbase=shm+LDS_K; bf16x8 kf[8];
  const lds_cptr kp0=shm3+LDS_K+hi*1024+r32*16; const lds_cptr vp0=shm3+LDS_V+((lane>>4)&1)*32+(lane&3)*8+(4*hi+((lane&15)>>2))*64;
  const int NT=NTF-t_start;
  DMA_K(0,0);DMA_V(0,0);DMA_K(1,SLOTB);
  bf16x8 qr[4];
  #pragma unroll
  for(int d0=0;d0<4;++d0)qr[d0]=*reinterpret_cast<const bf16x8*>(&Qw[(long)r32*DM+d0*16+hi*8]);
  float mhat=0.f,l_reg=0.f;f32x16 o[2];o[0]=f32x16{};o[1]=f32x16{};
  const __attribute__((address_space(3))) float*fkl=(const __attribute__((address_space(3))) float*)(shm3+LDS_FK)+64*t_start+4*hi;
  #define INITC(C0,C1,t) do{ const float nsc_=fq2-mhat; typedef float f32x4_t __attribute__((ext_vector_type(4))); const __attribute__((address_space(3))) float*kb_=fkl+64*(t); \
    _Pragma("unroll") for(int g_=0;g_<4;++g_){ const f32x4_t a_=*(const __attribute__((address_space(3))) f32x4_t*)(kb_+8*g_), b_=*(const __attribute__((address_space(3))) f32x4_t*)(kb_+32+8*g_); \
      _Pragma("unroll") for(int e_=0;e_<4;++e_){ C0[4*g_+e_]=nsc_+a_[e_]; C1[4*g_+e_]=nsc_+b_[e_]; } } }while(0)
  const int qrel=wid*QBLK+r32;
  #define CMASK(P0,P1,t) do{int jb_=(t)-(NT-4); if(jb_>=0)cmask(P0,P1,jb_,qrel,hi);}while(0)
  bool resc=false;
  #define START(P0,P1) do{ const float rm=rowmax(P0,P1); resc=false; \
    { const float dl=rm; mhat=fadd_s(mhat,dl); \
      _Pragma("unroll") for(int r=0;r<16;++r){P0[r]=fsub_s(P0[r],dl);P1[r]=fsub_s(P1[r],dl);} \
      } \
    _Pragma("unroll") for(int r=0;r<16;++r)P0[r]=__builtin_amdgcn_exp2f(P0[r]); }while(0)
  #define RESC() do{ if(resc){ asm volatile("s_waitcnt lgkmcnt(0)":::"memory"); \
      _Pragma("unroll") for(int d_=0;d_<2;++d_) _Pragma("unroll") for(int r=0;r<16;++r)o[d_][r]*=wsf[crow(r,hi)]; } }while(0)
  f32x16 pA0,pA1,pB0,pB1;
  int sl_prev=0,sl_cur=0,sl_next=SLOTB;
  #define ROT() do{sl_prev=sl_cur;sl_cur=sl_next;sl_next=(sl_next==(NSLOT-1)*SLOTB)?0:sl_next+SLOTB;}while(0)
  DMA_K(2,2*SLOTB);
  WAIT_BAR(3);
  INITC(pA0,pA1,0); qkt(pA0,pA1,Kbase,qr,r32,hi);asm volatile("s_nop 15\n\ts_nop 7":"+v"(pA0),"+v"(pA1));CMASK(pA0,pA1,0);
  START(pA0,pA1);
  _Pragma("unroll") for(int r=0;r<16;++r)pA1[r]=__builtin_amdgcn_exp2f(pA1[r]);
  WAIT_BAR(0);
  DMA_K(3,0);DMA_V(1,SLOTB);
  ROT();
  kload8(kf,kp0+sl_cur);
  WAIT_BAR(2);
  s16x4 vlo[8],vhi[8]; u32x4 pw0,pw1,pw2,pw3;
  #define PKW(P,B) cvtpk_s(P[B],P[B+1])
  #define PAF(k) __builtin_bit_cast(bf16x8,pw##k)
  #define VFR(i) (bf16x8){vlo[i][0],vlo[i][1],vlo[i][2],vlo[i][3],vhi[i][0],vhi[i][1],vhi[i][2],vhi[i][3]}
  #define PIN(x) asm volatile("":"+v"(x))
  #define MX3(a,b,c) __builtin_fmaxf(__builtin_fmaxf((a),(b)),(c))
  #define GAPA(MF,A0,A1,A2,A3,W0,W1,PW) do{ MF; sacc+=A0; sacc+=A1; sacc+=A2; sacc+=A3; PIN(sacc); W0; W1; PIN(PW); SBAR(); }while(0)
  #define EX(v) __builtin_amdgcn_exp2f(v)
  #define GAPB(MF,X,B) do{ MF; X[B]=EX(X[B]); X[B+1]=EX(X[B+1]); X[B+2]=EX(X[B+2]); X[B+3]=EX(X[B+3]); PIN(X); SBAR(); }while(0)
  #define VRD(i) do{ vlo[i]=vtr(vp_+(((i)>>2)*4096+((i)&3)*1024)); vhi[i]=vtr(vp_+(((i)>>2)*4096+((i)&3)*1024+512)); }while(0)
  #define KRD(G,j) do{ if(G){ kload2(kf,kp0+sl_next,j); SBAR(); } }while(0)
  #define STEP(C0,C1,P0,P1,t,GK,GV,GL) do{ SBAR(); INITC(C0,C1,t); PIN(C0); PIN(C1); SBAR(); \
    const lds_cptr vp_=vp0+sl_prev; \
    VRD(0); SBAR(); float sacc=(P0[0]+P0[1]); \
    GAPA(C0=__builtin_amdgcn_mfma_f32_32x32x16_bf16(kf[0],qr[0],C0,0,0,0), P0[2],P0[3],P0[4],P0[5],     pw0[0]=PKW(P0,0), pw0[1]=PKW(P0,2), pw0); \
    VRD(4); SBAR(); GAPA(C1=__builtin_amdgcn_mfma_f32_32x32x16_bf16(kf[1],qr[0],C1,0,0,0), P0[6],P0[7],P0[8],P0[9],     pw0[2]=PKW(P0,4), pw0[3]=PKW(P0,6), pw0); \
    VRD(1); SBAR(); GAPA(C0=__builtin_amdgcn_mfma_f32_32x32x16_bf16(kf[2],qr[1],C0,0,0,0),   P0[10],P0[11],P0[12],P0[13], pw1[0]=PKW(P0,8), pw1[1]=PKW(P0,10), pw1); \
    VRD(5); SBAR(); GAPA(C1=__builtin_amdgcn_mfma_f32_32x32x16_bf16(kf[3],qr[1],C1,0,0,0),   P0[14],P0[15],P1[0],P1[1],   pw1[2]=PKW(P0,12),pw1[3]=PKW(P0,14), pw1); \
    VRD(2); SBAR(); GAPA(C0=__builtin_amdgcn_mfma_f32_32x32x16_bf16(kf[4],qr[2],C0,0,0,0),   P1[2],P1[3],P1[4],P1[5],     pw2[0]=PKW(P1,0), pw2[1]=PKW(P1,2), pw2); \
    VRD(6); SBAR(); GAPA(C1=__builtin_amdgcn_mfma_f32_32x32x16_bf16(kf[5],qr[2],C1,0,0,0),   P1[6],P1[7],P1[8],P1[9],     pw2[2]=PKW(P1,4), pw2[3]=PKW(P1,6), pw2); \
    VRD(3); SBAR(); GAPA(C0=__builtin_amdgcn_mfma_f32_32x32x16_bf16(kf[6],qr[3],C0,0,0,0),   P1[10],P1[11],P1[12],P1[13], pw3[0]=PKW(P1,8), pw3[1]=PKW(P1,10), pw3); \
    VRD(7); SBAR(); GAPA(C1=__builtin_amdgcn_mfma_f32_32x32x16_bf16(kf[7],qr[3],C1,0,0,0),   P1[14],P1[15],0.f,0.f,       pw3[2]=PKW(P1,12),pw3[3]=PKW(P1,14), pw3); \
    l_reg+=sacc; \
    if(GK){DMA_K((t)+3,sl_cur);} if(GV){DMA_V((t)+1,sl_next);} \
    CMASK(C0,C1,t); \
    { float a=MX3(C0[0],C0[1],C1[0]),b=MX3(C0[2],C0[3],C1[1]); a=MX3(a,C1[2],C1[3]); \
      _Pragma("unroll") for(int r=4;r<16;r+=4){a=MX3(a,C0[r],C0[r+1]);b=MX3(b,C0[r+2],C0[r+3]);a=MX3(a,C1[r],C1[r+1]);b=MX3(b,C1[r+2],C1[r+3]);} \
      float rm=__builtin_fmaxf(a,b); { auto rr=__builtin_amdgcn_permlane32_swap(__float_as_uint(rm),__float_as_uint(rm),false,false); rm=__builtin_fmaxf(__uint_as_float(rr[0]),__uint_as_float(rr[1])); } \
      resc=false; \
      if(__builtin_expect(__any(rm>(float)THRL),0)){ const float dl=__builtin_fmaxf(rm,0.f); mhat+=dl; \
        _Pragma("unroll") for(int r=0;r<16;++r){C0[r]-=dl;C1[r]-=dl;} \
        const float f=__builtin_amdgcn_exp2f(-dl); l_reg*=f; if(hi==0)wsf[r32]=f; resc=true; } } \
    SBAR(); \
    GAPB(o[0]=__builtin_amdgcn_mfma_f32_32x32x16_bf16(PAF(0),VFR(0),o[0],0,0,0), C0,0); \
    GAPB(o[1]=__builtin_amdgcn_mfma_f32_32x32x16_bf16(PAF(0),VFR(4),o[1],0,0,0), C0,4); \
    KRD(GL,0); GAPB(o[0]=__builtin_amdgcn_mfma_f32_32x32x16_bf16(PAF(1),VFR(1),o[0],0,0,0), C0,8); \
    KRD(GL,1); GAPB(o[1]=__builtin_amdgcn_mfma_f32_32x32x16_bf16(PAF(1),VFR(5),o[1],0,0,0), C0,12); \
    KRD(GL,2); GAPB(o[0]=__builtin_amdgcn_mfma_f32_32x32x16_bf16(PAF(2),VFR(2),o[0],0,0,0), C1,0); \
    KRD(GL,3); GAPB(o[1]=__builtin_amdgcn_mfma_f32_32x32x16_bf16(PAF(2),VFR(6),o[1],0,0,0), C1,4); \
    GAPB(o[0]=__builtin_amdgcn_mfma_f32_32x32x16_bf16(PAF(3),VFR(3),o[0],0,0,0), C1,8); \
    GAPB(o[1]=__builtin_amdgcn_mfma_f32_32x32x16_bf16(PAF(3),VFR(7),o[1],0,0,0), C1,12); \
    }while(0)
  int t=1;
  #undef CMASK
  #define CMASK(P0,P1,t) do{}while(0)
  for(;t+5<NT;t+=2){
    STEP(pB0,pB1,pA0,pA1,t,true,true,true);     WAIT_BAR(2); RESC(); ROT();
    STEP(pA0,pA1,pB0,pB1,t+1,true,true,true);   WAIT_BAR(2); RESC(); ROT();
  }
  #undef CMASK
  #define CMASK(P0,P1,t) do{int jb_=(t)-(NT-4); if(jb_>=0)cmask(P0,P1,jb_,qrel,hi);}while(0)
  #define ENDW(tt) do{ if((tt)+3<NT){WAIT_BAR(2);} else if((tt)+2<NT){WAIT_BAR(1);} else {WAIT_BAR(0);} }while(0)
  for(;t+1<NT;t+=2){
    STEP(pB0,pB1,pA0,pA1,t,(t+3<NT),(t+1<NT),(t+1<NT));       ENDW(t);   RESC(); ROT();
    STEP(pA0,pA1,pB0,pB1,t+1,(t+4<NT),(t+2<NT),(t+2<NT));     ENDW(t+1); RESC(); ROT();
  }
  STEP(pB0,pB1,pA0,pA1,NT-1,false,false,false); RESC();
  { float sacc=pB0[0]+pB0[1]; _Pragma("unroll") for(int r=2;r<16;++r)sacc+=pB0[r]; _Pragma("unroll") for(int r=0;r<16;++r)sacc+=pB1[r]; l_reg+=sacc;
    pw0=(u32x4){PKW(pB0,0),PKW(pB0,2),PKW(pB0,4),PKW(pB0,6)};pw1=(u32x4){PKW(pB0,8),PKW(pB0,10),PKW(pB0,12),PKW(pB0,14)};pw2=(u32x4){PKW(pB1,0),PKW(pB1,2),PKW(pB1,4),PKW(pB1,6)};pw3=(u32x4){PKW(pB1,8),PKW(pB1,10),PKW(pB1,12),PKW(pB1,14)};
    SBAR(); pv(o,vb0+sl_cur,PAF(0),PAF(1),PAF(2),PAF(3)); }
  #undef PKW
  #undef PAF
  #undef VFR
  #undef PIN
  #undef MX3
  #undef GAPA
  #undef GAPB
  #undef EX
  #undef VRD
  #undef KRD
  #undef STEP
  #undef ENDW
  {auto rr=__builtin_amdgcn_permlane32_swap(__float_as_uint(l_reg),__float_as_uint(l_reg),false,false);l_reg=__uint_as_float(rr[0])+__uint_as_float(rr[1]);}
  if(hi==0)wsf[32+r32]=l_reg;asm volatile("s_waitcnt lgkmcnt(0)":::"memory");
  float rli[16];
  #pragma unroll
  for(int r=0;r<16;++r)rli[r]=__builtin_amdgcn_rcpf(wsf[32+crow(r,hi)]);
  bf16*Ow=O+(rowbase+q0+wid*QBLK)*DM+h*D;
  { bf16*stg=(bf16*)(shm+LDS_OST)+wid*2048;
    #pragma unroll
    for(int r=0;r<16;++r){const int orow=crow(r,hi);
      #pragma unroll
      for(int d0=0;d0<2;++d0)stg[orow*64+d0*32+r32]=__float2bfloat16(o[d0][r]*rli[r]);}
    asm volatile("s_waitcnt lgkmcnt(0)":::"memory");
    #pragma unroll
    for(int i=0;i<4;++i){const int row=i*8+(lane>>3),ch=lane&7; const u32x4 v=*(const u32x4*)(stg+row*64+ch*8); ATTN_STORE16(Ow+(long)row*DM+ch*8,v);} }
  asm volatile("s_waitcnt lgkmcnt(0)\n\ts_barrier":::"memory");
  #undef DMA_K
  #undef DMA_V
  #undef INITC
  #undef CMASK
  #undef START
  #undef RESC
  #undef ROT
}
constexpr int ATTN_LDS_BYTES=LDS_BYTES;
struct AttnTensors { const bf16* Q; const bf16* K; const bf16* V; bf16* O; const float* F; const float* NRM; };
struct AttnUnit { int bh; int qb; };
struct StaticOrder {
  int vcu;
  __device__ __forceinline__ explicit StaticOrder(int grid,int block):vcu((block%8)*(grid/8)+block/8){}
  __device__ __forceinline__ bool next(int i,AttnUnit&u)const{ if(i>=4)return false; const int s=vcu&7; u.bh=vcu>>3; u.qb=(i==0)?s:(i==1)?15-s:(i==2)?16+s:31-s; return true; }
  __device__ __forceinline__ void a_ready(const AttnUnit&)const{}
  __device__ __forceinline__ void done(const AttnUnit&)const{}
};
template<int THRL=8> __device__ __forceinline__ void attn_phase(char*lds,const AttnTensors&T,unsigned*qctr,volatile __attribute__((address_space(3))) unsigned*qword,int wid_in){
  const int lane0=(int)__builtin_amdgcn_mbcnt_hi(~0u,__builtin_amdgcn_mbcnt_lo(~0u,0u));
  for(;;){
    if(wid_in==0&&lane0==0){ const unsigned n=__hip_atomic_fetch_add(qctr,1u,__ATOMIC_RELAXED,__HIP_MEMORY_SCOPE_AGENT); *qword=n; }
    asm volatile("s_waitcnt vmcnt(0) lgkmcnt(0)\n\ts_barrier":::"memory");
    const int n=__builtin_amdgcn_readfirstlane((int)*qword);
    if(n>=BATCH*NHEAD*NQB)break;
    const int bh=n%(BATCH*NHEAD),qb=NQB-1-n/(BATCH*NHEAD);
    attn_unit<THRL>(bh/NHEAD,bh%NHEAD,qb,T.Q,T.K,T.V,T.O,T.F,T.NRM,lds,wid_in);
  }
}
#undef SBAR
#undef WAIT_BAR
}
#define GAS __attribute__((address_space(1)))
#define LAS __attribute__((address_space(3)))
typedef unsigned short bf16;
typedef unsigned v4u __attribute__((ext_vector_type(4)));
typedef float f32x4 __attribute__((ext_vector_type(4)));
typedef short bf16x8 __attribute__((ext_vector_type(8)));
typedef GAS unsigned gu32;
typedef GAS unsigned long long gu64;
#define RLX_AGENT __ATOMIC_RELAXED, __HIP_MEMORY_SCOPE_AGENT
#define LDS_WAIT() asm volatile("s_waitcnt lgkmcnt(0)" ::: "memory")
#define VM_WAIT() asm volatile("s_waitcnt vmcnt(0)" ::: "memory")
__device__ __forceinline__ unsigned long long rt() { return __builtin_amdgcn_s_memrealtime(); }
__device__ __forceinline__ unsigned f2bf(float f) { unsigned u = __builtin_bit_cast(unsigned, f); return (u + 0x7fffu + ((u >> 16) & 1u)) >> 16; }
__device__ __forceinline__ unsigned pk2(float lo, float hi) { return f2bf(lo) | (f2bf(hi) << 16); }

#define XB_TMO      128
#define XB_XCNT(j)  (256  + 64 * (j))
#define XB_XSUB(j)  (1280 + 64 * (j))
#define XB_XGEN(j)  (2304 + 64 * (j))
#define XB_TOP      3328
#define XB_TOPGEN   3392
#define XCD_BAR_WORDS 3456
#define XB_SPIN_CAP (1u << 18)

__device__ __forceinline__ unsigned xb_ld(unsigned* p)              { return __hip_atomic_load(p, __ATOMIC_RELAXED, __HIP_MEMORY_SCOPE_AGENT); }
__device__ __forceinline__ unsigned xb_add(unsigned* p, unsigned v) { return __hip_atomic_fetch_add(p, v, __ATOMIC_RELAXED, __HIP_MEMORY_SCOPE_AGENT); }
__device__ __forceinline__ unsigned xb_xcc_id() { return (unsigned)__builtin_amdgcn_s_getreg((3 << 11) | 20) & 0xFu; }
#define XB_SPIN(cond, bar) do { unsigned _sp = 0; while (cond) { __builtin_amdgcn_s_sleep(1); \
    if ((++_sp & 255u) == 0u) { if (xb_ld(&(bar)[XB_TMO])) break; if (_sp > XB_SPIN_CAP) { atomicAdd(&(bar)[XB_TMO], 1u); break; } } } } while (0)

struct XcdBarrier {
    unsigned* bar; unsigned x; int wv;
    volatile LAS unsigned* st;
};

__device__ __forceinline__ bool xb_t0(int wv) { return wv == 0 && __builtin_amdgcn_mbcnt_hi(~0u, __builtin_amdgcn_mbcnt_lo(~0u, 0u)) == 0u; }
__device__ __forceinline__ XcdBarrier xcd_barrier_post(unsigned* bar, volatile LAS unsigned* st, int wv) {
    XcdBarrier b; b.bar = bar; b.x = xb_xcc_id(); b.st = st; b.wv = wv;
    if (xb_t0(wv)) (void)xb_add(&bar[XB_XCNT(b.x)], 1u);
    return b;
}
__device__ __forceinline__ void xcd_barrier_complete(unsigned* bar, unsigned x, unsigned& nloc, unsigned& nx) {
    const unsigned G = gridDim.x * gridDim.y * gridDim.z;
    unsigned sum, cnt, mine, sp = 0u;
    for (;;) {
        sum = 0u; cnt = 0u; mine = 0u;
#pragma unroll
        for (unsigned j = 0; j < 16; ++j) { const unsigned c = xb_ld(&bar[XB_XCNT(j)]); sum += c; cnt += (c > 0u) ? 1u : 0u; mine = (j == x) ? c : mine; }
        if (sum == G) break;
        __builtin_amdgcn_s_sleep(1);
        if ((++sp & 255u) == 0u) { if (xb_ld(&bar[XB_TMO])) break; if (sp > XB_SPIN_CAP) { atomicAdd(&bar[XB_TMO], 1u); break; } }
    }
    nloc = mine > 0u ? mine : 1u; nx = cnt > 0u ? cnt : 1u;
}

__device__ __forceinline__ void xcd_barrier(const XcdBarrier& b) {
    asm volatile("s_waitcnt vmcnt(0)" ::: "memory");
    __syncthreads();
    if (xb_t0(b.wv)) {
        unsigned* bar = b.bar;
        __builtin_amdgcn_s_waitcnt(0);
        unsigned nloc = b.st[0], nx = b.st[1];
        if (nloc == 0u) { xcd_barrier_complete(bar, b.x, nloc, nx); b.st[0] = nloc; b.st[1] = nx; }
        const unsigned old = xb_add(&bar[XB_XSUB(b.x)], 1u);
        const unsigned gen = old / nloc;
        if (old + 1u == (gen + 1u) * nloc) {
            __builtin_amdgcn_fence(__ATOMIC_RELEASE, "agent");
            asm volatile("s_waitcnt vmcnt(0)" ::: "memory");
            const unsigned og = xb_add(&bar[XB_TOP], 1u);
            const unsigned tg = og / nx;
            if (og + 1u == (tg + 1u) * nx) xb_add(&bar[XB_TOPGEN], 1u);
            else XB_SPIN(xb_ld(&bar[XB_TOPGEN]) == tg, bar);
            __builtin_amdgcn_fence(__ATOMIC_ACQUIRE, "agent");
            xb_add(&bar[XB_XGEN(b.x)], 1u);
            asm volatile("s_waitcnt vmcnt(0)" ::: "memory");
        } else {
            XB_SPIN(xb_ld(&bar[XB_XGEN(b.x)]) == gen, bar);
            __builtin_amdgcn_fence(__ATOMIC_ACQUIRE, "agent");
            asm volatile("s_waitcnt vmcnt(0)" ::: "memory");
        }
    }
    __syncthreads();
}

constexpr int NWAVES = 8;
constexpr int RING_OFF = 0, RING_BYTES = 131072;
constexpr int LDSCTL_OFF = RING_BYTES, MISC_OFF = LDSCTL_OFF + 320;
constexpr int LDS_BYTES = 147456;
constexpr int N_PHASES = 8;

struct Frame {
    LAS unsigned char* lds;
    volatile LAS unsigned* MISC;
    gu32* ctl;
    int tid, lane, wave, vcu, G;
};
__device__ __forceinline__ float wave_sum(float v) {
#pragma unroll
    for (int o = 1; o < 64; o <<= 1) v += __shfl_xor(v, o);
    return v;
}
struct Args { const float* in[20]; float* out; unsigned char* ws; int ph_lo, ph_hi, li, pad; };

__device__ __forceinline__ void p0_transpose_item(const float* W, int ld, int nblk, const float* glo, const float* ghi, int K, bf16* WT, int item, int lane) {
    const int kb = item / nblk, nb = item % nblk, k0 = 64 * kb + 16 * (lane >> 4), n0 = 64 * nb + 4 * (lane & 15);
    f32x4 w[16];
#pragma unroll
    for (int j = 0; j < 16; ++j) w[j] = *(const GAS f32x4*)(W + (size_t)(k0 + j) * ld + n0);
    if (glo) { const float* gp = (k0 < K / 2) ? glo + k0 : ghi + (k0 - K / 2);
#pragma unroll
        for (int q = 0; q < 4; ++q) { const f32x4 g4 = *(const GAS f32x4*)(gp + 4 * q);
#pragma unroll
            for (int e = 0; e < 4; ++e) w[4 * q + e] = w[4 * q + e] * g4[e]; } }
#pragma unroll
    for (int c = 0; c < 4; ++c) { v4u o0, o1;
        o0.x = pk2(w[0][c], w[1][c]); o0.y = pk2(w[2][c], w[3][c]); o0.z = pk2(w[4][c], w[5][c]); o0.w = pk2(w[6][c], w[7][c]);
        o1.x = pk2(w[8][c], w[9][c]); o1.y = pk2(w[10][c], w[11][c]); o1.z = pk2(w[12][c], w[13][c]); o1.w = pk2(w[14][c], w[15][c]);
        bf16* dp = WT + (size_t)(n0 + c) * K + k0; *(GAS v4u*)dp = o0; *(GAS v4u*)(dp + 8) = o1; }
}
__device__ __forceinline__ float log_sigmoid(float z) { return fminf(z, 0.f) - log1pf(expf(-fabsf(z))); }

__device__ __forceinline__ void p0_prologue(Frame& F, const Args& a) {
    unsigned char* ws = a.ws;
    const float* x = a.in[0]; const float* g1 = a.in[1]; const float* w_in = a.in[2]; const float* bfv = a.in[10];
    const float* gn_l = a.in[11]; const float* gn_f = a.in[12]; const float* w_out = a.in[13]; const float* g2 = a.in[14];
    const float* w_q = a.in[15]; const float* sk = a.in[16]; const float* pu = a.in[17]; const float* pv = a.in[18];
    bf16* win_t = (bf16*)(ws + WS_WIN); bf16* wout_t = (bf16*)(ws + WS_WOUT); bf16* wq_t = (bf16*)(ws + WS_WQ); bf16* skb = (bf16*)(ws + WS_SKB);
    float* logf = (float*)(ws + WS_LOGF); bf16* h = (bf16*)(ws + WS_H);
    const int gw = F.vcu * NWAVES + F.wave, NGW = F.G * NWAVES, lane = F.lane;
    constexpr int I_IN = (DMODEL / 64) * (NG1 / 64), I_OUT = (DMODEL / 64) * (DMODEL / 64), I_Q = (DMODEL / 64) * (QPW / 64);
    constexpr int I_SK = PH * 2 * NKEY * PHALF / 512, I_WAX = 8 * 2 * 2 * 4;
    constexpr int E0 = I_IN, E1 = E0 + I_OUT, E2 = E1 + I_Q, E3 = E2, E4 = E3 + I_SK, E5 = E4, E6 = E5 + I_WAX;
    for (int it = gw; it < E6; it += NGW) {
        if (it < E0) { p0_transpose_item(w_in, INC, NG1 / 64, nullptr, nullptr, DMODEL, win_t, it, lane); continue; }
        if (it < E1) { p0_transpose_item(w_out, DMODEL, DMODEL / 64, gn_l, gn_f, DMODEL, wout_t, it - E0, lane); continue; }
        if (it < E2) { p0_transpose_item(w_q, QPW, QPW / 64, g2, g2 + DMODEL / 2, DMODEL, wq_t, it - E1, lane); continue; }
        if (it < E4) { const size_t i = (size_t)(it - E3) * 512 + lane * 8; const f32x4 s0 = *(const GAS f32x4*)(sk + i), s1 = *(const GAS f32x4*)(sk + i + 4);
            v4u o; o.x = pk2(s0[0], s0[1]); o.y = pk2(s0[2], s0[3]); o.z = pk2(s1[0], s1[1]); o.w = pk2(s1[2], s1[3]);
            { const size_t hp = i >> 14; const int key = (int)(i >> 7) & 127, c8 = (int)(i >> 3) & 15; *(GAS v4u*)(skb + hp * 16384 + ((size_t)((((key >> 5) * 2 + (c8 & 1)) * 8 + (c8 >> 1)) * 32 + (key & 31))) * 8) = o; } continue; }
        { const int f = it - E5, ks = f & 3, n = (f >> 2) & 1, mat = (f >> 3) & 1, hh = f >> 4; const float* wsrc = mat ? a.in[7] : a.in[5];
          const size_t o = ((size_t)(hh * 64 + 16 * ks + 8 * (lane >> 5))) * 64 + 32 * n + (lane & 31);
          v4u pw; pw.x = pk2(wsrc[o], wsrc[o + 64]); pw.y = pk2(wsrc[o + 128], wsrc[o + 192]); pw.z = pk2(wsrc[o + 256], wsrc[o + 320]); pw.w = pk2(wsrc[o + 384], wsrc[o + 448]);
          *(GAS v4u*)((bf16*)(ws + WS_WAX) + (size_t)f * 512 + lane * 8) = pw; }
    }
    { f32x4 gg[4];
#pragma unroll
      for (int j = 0; j < 4; ++j) gg[j] = *(const GAS f32x4*)(g2 + 16 * lane + 4 * j);
      unsigned char* u4 = ws + WS_U8; unsigned char* v4 = ws + WS_V8; float* su = (float*)(ws + WS_SU);
      for (int e = gw; e < NEXP; e += NGW) {
        const GAS f32x4* ur = (const GAS f32x4*)(pu + (size_t)e * DMODEL + 16 * lane); const GAS f32x4* vr = (const GAS f32x4*)(pv + (size_t)e * DMODEL + 16 * lane);
        f32x4 uu[4], vv[4]; float mu = 0.f, mv = 0.f;
#pragma unroll
        for (int j = 0; j < 4; ++j) { uu[j] = ur[j] * gg[j]; vv[j] = vr[j];
#pragma unroll
            for (int c = 0; c < 4; ++c) { mu = fmaxf(mu, fabsf(uu[j][c])); mv = fmaxf(mv, fabsf(vv[j][c])); } }
#pragma unroll
        for (int o = 1; o < 64; o <<= 1) { mu = fmaxf(mu, __shfl_xor(mu, o)); mv = fmaxf(mv, __shfl_xor(mv, o)); }
        const float scu = mu > 0.f ? mu * (1.f / 6.f) : 1.f, scv = mv > 0.f ? mv * (1.f / 6.f) : 1.f, iu = 1.f / scu, iv = 1.f / scv;
        unsigned qu0 = 0u, qu1 = 0u, qv0 = 0u, qv1 = 0u;
#define P0_Q4(Q, X, INV, B0, B1) do { Q = __builtin_amdgcn_cvt_scalef32_pk_fp4_f32(Q, X[0] * INV, X[1] * INV, 1.0f, B0); Q = __builtin_amdgcn_cvt_scalef32_pk_fp4_f32(Q, X[2] * INV, X[3] * INV, 1.0f, B1); } while (0)
        P0_Q4(qu0, uu[0], iu, 0, 1); P0_Q4(qu0, uu[1], iu, 2, 3); P0_Q4(qu1, uu[2], iu, 0, 1); P0_Q4(qu1, uu[3], iu, 2, 3);
        P0_Q4(qv0, vv[0], iv, 0, 1); P0_Q4(qv0, vv[1], iv, 2, 3); P0_Q4(qv1, vv[2], iv, 0, 1); P0_Q4(qv1, vv[3], iv, 2, 3);
#undef P0_Q4
        *(GAS unsigned long long*)(u4 + (size_t)e * 512 + 8 * lane) = (unsigned long long)qu0 | ((unsigned long long)qu1 << 32);
        { unsigned char* vrow = v4 + (size_t)e * 512 + 2 * (lane >> 2);
          *(GAS unsigned short*)(vrow + 32 * (4 * (lane & 3) + 0)) = (unsigned short)(qv0 & 0xffffu); *(GAS unsigned short*)(vrow + 32 * (4 * (lane & 3) + 1)) = (unsigned short)(qv0 >> 16);
          *(GAS unsigned short*)(vrow + 32 * (4 * (lane & 3) + 2)) = (unsigned short)(qv1 & 0xffffu); *(GAS unsigned short*)(vrow + 32 * (4 * (lane & 3) + 3)) = (unsigned short)(qv1 >> 16); }
        if (lane == 0) { su[2 * e] = scu; su[2 * e + 1] = scv; }
      } }
    { f32x4 gg[4];
#pragma unroll
      for (int j = 0; j < 4; ++j) gg[j] = *(const GAS f32x4*)(g1 + 256 * j + 4 * lane);
      float fw[4][4][8];
#pragma unroll
      for (int j = 0; j < 4; ++j)
#pragma unroll
          for (int c = 0; c < 4; ++c) { const int k = 256 * j + 4 * lane + c; const GAS f32x4* wr = (const GAS f32x4*)(w_in + (size_t)k * INC + NG1); const f32x4 w0 = wr[0], w1 = wr[1];
#pragma unroll
              for (int e = 0; e < 4; ++e) { fw[j][c][e] = w0[e]; fw[j][c][4 + e] = w1[e]; } }
      for (int t0 = gw; t0 < T; t0 += 2 * NGW) {
        const int t1 = (t0 + NGW < T) ? t0 + NGW : t0;
        const GAS f32x4* xr0 = (const GAS f32x4*)(x + (size_t)t0 * DMODEL) + lane; const GAS f32x4* xr1 = (const GAS f32x4*)(x + (size_t)t1 * DMODEL) + lane;
        f32x4 va[4], vb[4]; float sa = 0.f, sb = 0.f;
#pragma unroll
        for (int j = 0; j < 4; ++j) { va[j] = xr0[64 * j]; vb[j] = xr1[64 * j]; }
#pragma unroll
        for (int j = 0; j < 4; ++j) { sa += (va[j][0] * va[j][0] + va[j][1] * va[j][1]) + (va[j][2] * va[j][2] + va[j][3] * va[j][3]); sb += (vb[j][0] * vb[j][0] + vb[j][1] * vb[j][1]) + (vb[j][2] * vb[j][2] + vb[j][3] * vb[j][3]); }
        const float ra = rsqrtf(wave_sum(sa) * (1.f / DMODEL) + RMS_EPS), rb = rsqrtf(wave_sum(sb) * (1.f / DMODEL) + RMS_EPS);
        GAS unsigned long long* ha = (GAS unsigned long long*)(h + (size_t)t0 * DMODEL) + lane; GAS unsigned long long* hb = (GAS unsigned long long*)(h + (size_t)t1 * DMODEL) + lane;
#pragma unroll
        for (int j = 0; j < 4; ++j) { va[j] = va[j] * ra * gg[j]; vb[j] = vb[j] * rb * gg[j];
            ha[64 * j] = (unsigned long long)pk2(va[j][0], va[j][1]) | ((unsigned long long)pk2(va[j][2], va[j][3]) << 32);
            hb[64 * j] = (unsigned long long)pk2(vb[j][0], vb[j][1]) | ((unsigned long long)pk2(vb[j][2], vb[j][3]) << 32); }
        float fa[8], fb[8];
#pragma unroll
        for (int hh = 0; hh < 8; ++hh) { fa[hh] = 0.f; fb[hh] = 0.f; }
#pragma unroll
        for (int j = 0; j < 4; ++j)
#pragma unroll
            for (int c = 0; c < 4; ++c) {
#pragma unroll
                for (int hh = 0; hh < 8; ++hh) { fa[hh] += va[j][c] * fw[j][c][hh]; fb[hh] += vb[j][c] * fw[j][c][hh]; } }
        float resa = 0.f, resb = 0.f;
#pragma unroll
        for (int hh = 0; hh < 8; ++hh) { const float s0 = wave_sum(fa[hh]), s1 = wave_sum(fb[hh]); if (lane == hh) { resa = s0; resb = s1; } }
        if (lane < 8) { logf[(size_t)t0 * 8 + lane] = log_sigmoid(resa + bfv[lane]); logf[(size_t)t1 * 8 + lane] = log_sigmoid(resb + bfv[lane]); }
      } }
}

__device__ __forceinline__ void fcum_unit(Frame& F, int bh, const float* logf, float* fcum) {
    const int b = bh / NHEADS, hh = bh % NHEADS, s0 = F.tid * 16;
    float v[16]; float loc = 0.f;
#pragma unroll
    for (int i = 0; i < 16; ++i) { v[i] = logf[((size_t)b * SEQ + s0 + i) * 8 + hh]; loc += v[i]; }
    float inc = loc;
#pragma unroll
    for (int o = 1; o < 64; o <<= 1) { const float n = __shfl_up(inc, o); if (F.lane >= o) inc += n; }
    if (F.lane == 63) F.MISC[16 + F.wave] = __float_as_uint(inc);
    __syncthreads();
    float run = inc - loc;
    for (int w = 0; w < F.wave; ++w) run += __uint_as_float(F.MISC[16 + w]);
#pragma unroll
    for (int i = 0; i < 16; ++i) { run += v[i]; fcum[(size_t)bh * SEQ + s0 + i] = run; }
    __syncthreads();
}


namespace peer {
typedef unsigned u32;
typedef float f32x16 __attribute__((ext_vector_type(16)));
constexpr int TOK = 128;
constexpr int EX_STRIDE = 136, GT_STRIDE = 136;
constexpr int L_EX = 0, L_GT = L_EX + TOK * EX_STRIDE * 2, L_IDX = L_GT + TOK * GT_STRIDE * 2, IDX_STRIDE = 36, L_RST = L_IDX + 512 * IDX_STRIDE, L_BI = L_RST + TOK * 4, BI_WAVE = 4352, L_END = L_BI + 8 * BI_WAVE;
static_assert(L_END <= RING_BYTES && L_GT % 16 == 0 && L_IDX % 16 == 0, "PEER LDS map");
__device__ __forceinline__ u32 ordmap(float f) { const u32 u = __float_as_uint(f); return u ^ ((u32)((int)u >> 31) | 0x80000000u); }
__device__ __forceinline__ float unordmap(u32 k) { const u32 u = (k & 0x80000000u) ? (k ^ 0x80000000u) : ~k; return __uint_as_float(u); }
__device__ __forceinline__ u32 umin_(u32 a, u32 b) { return a < b ? a : b; }
__device__ __forceinline__ u32 umax_(u32 a, u32 b) { return a > b ? a : b; }
template <bool DESC> __device__ __forceinline__ void sort16(u32 (&k)[16]) {
#pragma unroll
    for (int size = 2; size <= 16; size <<= 1)
#pragma unroll
        for (int stride = size >> 1; stride > 0; stride >>= 1)
#pragma unroll
            for (int i = 0; i < 16; ++i) { const int j = i ^ stride;
                if (j > i) { const bool asc = (((i & size) == 0) != DESC); const u32 a = k[i], b = k[j], lo = umin_(a, b), hi = umax_(a, b); k[i] = asc ? lo : hi; k[j] = asc ? hi : lo; } }
}
template <bool DESC> __device__ __forceinline__ void merge16(u32 (&k)[16]) {
#pragma unroll
    for (int stride = 8; stride > 0; stride >>= 1)
#pragma unroll
        for (int i = 0; i < 16; ++i) { const int j = i ^ stride;
            if (j > i) { const u32 a = k[i], b = k[j], lo = umin_(a, b), hi = umax_(a, b); k[i] = DESC ? hi : lo; k[j] = DESC ? lo : hi; } }
}
__host__ __device__ constexpr int ccnt(int a) { return 16 / (a + 1); }
__host__ __device__ constexpr int cbase(int a) { int s = 0; for (int i = 0; i < a; ++i) s += ccnt(i); return s; }
static_assert(cbase(16) == 50, "hyperbola candidate count");
__device__ __forceinline__ int crow16(int r) { return (r & 3) + 8 * (r >> 2); }

__device__ __forceinline__ void route_tile(Frame& F, const bf16* qp, const bf16* skb, const float* sumsq, int t0) {
    int lane = F.lane; asm volatile("" : "+v"(lane));
    const int r32 = lane & 31, hi = lane >> 5, w = F.wave;
    LAS unsigned short* EXL = (LAS unsigned short*)(F.lds + RING_OFF + L_EX);
    LAS unsigned short* GTL = (LAS unsigned short*)(F.lds + RING_OFF + L_GT);
    LAS unsigned char* IDXB = F.lds + RING_OFF + L_IDX + (w * 64 + lane) * IDX_STRIDE;
    LAS float* RST = (LAS float*)(F.lds + RING_OFF + L_RST);
    for (int g = 0; g < 4; ++g) {
        const int tok = 32 * g + r32; const size_t trow = (size_t)(t0 + tok);
        const float rstd2 = rsqrtf(sumsq[trow] * (1.f / DMODEL) + RMS_EPS);
        if (w == 0 && hi == 0) RST[tok] = rstd2;
        u32 s0[16], s1[16];
#pragma unroll
        for (int p = 0; p < 2; ++p) {
            bf16x8 qf[8];
#pragma unroll
            for (int ks = 0; ks < 8; ++ks) qf[ks] = *(const GAS bf16x8*)(qp + ((size_t)((((trow >> 5) * 8 + w) * 2 + p) * 16 + 2 * ks + hi) * 32 + r32) * 8);
            u32 run[16];
#pragma unroll
            for (int nb = 0; nb < 4; ++nb) {
                f32x16 acc = {};
                const bf16* kr = skb + (size_t)(w * 2 + p) * 16384 + ((size_t)((nb * 2 + hi) * 8 * 32 + r32)) * 8;
#pragma unroll
                for (int ks = 0; ks < 8; ++ks) acc = __builtin_amdgcn_mfma_f32_32x32x16_bf16(*(const GAS bf16x8*)(kr + ks * 256), qf[ks], acc, 0, 0, 0);
                asm volatile("" ::: "memory");
                u32 blk[16];
#pragma unroll
                for (int r = 0; r < 16; ++r) blk[r] = (ordmap(acc[r]) & ~0x7Fu) | (u32)(127 - 32 * nb - crow16(r) - 4 * hi);
                if (nb == 0) { sort16<true>(blk);
#pragma unroll
                    for (int i = 0; i < 16; ++i) run[i] = blk[i]; }
                else { sort16<false>(blk);
#pragma unroll
                    for (int i = 0; i < 16; ++i) run[i] = umax_(run[i], blk[i]);
                    merge16<true>(run); }
            }
            u32 oth[16];
#pragma unroll
            for (int i = 0; i < 16; ++i) oth[i] = (u32)__shfl_xor((int)run[15 - i], 32);
#pragma unroll
            for (int i = 0; i < 16; ++i) run[i] = umax_(run[i], oth[i]);
            merge16<true>(run);
#pragma unroll
            for (int i = 0; i < 16; ++i) { if (p == 0) s0[i] = run[i]; else s1[i] = run[i]; }
        }
        { LAS u32* iw = (LAS u32*)IDXB;
#pragma unroll
          for (int j = 0; j < 4; ++j) {
              iw[j] = (127u - (s0[4 * j] & 127u)) | ((127u - (s0[4 * j + 1] & 127u)) << 8) | ((127u - (s0[4 * j + 2] & 127u)) << 16) | ((127u - (s0[4 * j + 3] & 127u)) << 24);
              iw[4 + j] = (127u - (s1[4 * j] & 127u)) | ((127u - (s1[4 * j + 1] & 127u)) << 8) | ((127u - (s1[4 * j + 2] & 127u)) << 16) | ((127u - (s1[4 * j + 3] & 127u)) << 24); } }
        float v1[16], v2[16];
#pragma unroll
        for (int i = 0; i < 16; ++i) { v1[i] = unordmap(s0[i] & ~0x7Fu); v2[i] = unordmap(s1[i] & ~0x7Fu); }
        u32 c0[16], c1[16], c2[16], c3[16];
#pragma unroll
        for (int a = 0; a < 16; ++a)
#pragma unroll
            for (int b = 0; b < ccnt(a); ++b) { const int pos = cbase(a) + b; const u32 key = (ordmap(v1[a] + v2[b]) & ~0xFFu) | (u32)(255 - (a * 16 + b));
                if (pos < 16) c0[pos] = key; else if (pos < 32) c1[pos - 16] = key; else if (pos < 48) c2[pos - 32] = key; else c3[pos - 48] = key; }
#pragma unroll
        for (int i = 2; i < 16; ++i) c3[i] = 0u;
        sort16<false>(c1);
#pragma unroll
        for (int i = 0; i < 16; ++i) c0[i] = umax_(c0[i], c1[i]);
        merge16<true>(c0);
        sort16<false>(c2);
#pragma unroll
        for (int i = 0; i < 16; ++i) c0[i] = umax_(c0[i], c2[i]);
        merge16<true>(c0);
        sort16<false>(c3);
#pragma unroll
        for (int i = 0; i < 16; ++i) c0[i] = umax_(c0[i], c3[i]);
        merge16<true>(c0);
        const float m = unordmap(c0[0] & ~0xFFu) * rstd2;
        float e[8]; float sum = 0.f; u32 ex[8];
#pragma unroll
        for (int k = 0; k < 8; ++k) { const u32 key = hi ? c0[k + 8] : c0[k]; const float ts = unordmap(key & ~0xFFu);
            e[k] = __builtin_amdgcn_exp2f((ts * rstd2 - m) * LOG2E); sum += e[k];
            const u32 flat = 255u - (key & 255u); ex[k] = (u32)IDXB[flat >> 4] * NKEY + (u32)IDXB[16 + (flat & 15u)]; }
        sum += __shfl_xor(sum, 32);
        const float inv = 1.f / sum;
        v4u exw; exw.x = ex[0] | (ex[1] << 16); exw.y = ex[2] | (ex[3] << 16); exw.z = ex[4] | (ex[5] << 16); exw.w = ex[6] | (ex[7] << 16);
        *(LAS v4u*)(EXL + tok * EX_STRIDE + w * 16 + hi * 8) = exw;
        *(LAS v4u*)(GTL + tok * GT_STRIDE + w * 16 + hi * 8) = (v4u){pk2(e[0] * inv, e[1] * inv), pk2(e[2] * inv, e[3] * inv), pk2(e[4] * inv, e[5] * inv), pk2(e[6] * inv, e[7] * inv)};
    }
}
__device__ __forceinline__ float gelu_fast(float x) {
    const float u2 = x * (1.5957691216057308f + 0.07135481627f * x * x);
    return x * __builtin_amdgcn_rcpf(1.f + __builtin_amdgcn_exp2f(-1.4426950408889634f * u2));
}
typedef float f32x2 __attribute__((ext_vector_type(2)));

__device__ __forceinline__ void sort128(u32 (&k)[8], int m) {
#pragma unroll
    for (int K = 2; K <= 128; K <<= 1) {
#pragma unroll
        for (int S = K >> 1; S > 0; S >>= 1) {
            if (S >= 8) {
                const int mm = S >> 3; const bool lower = (m & mm) == 0, up = (K == 128) ? true : ((m & (K >> 3)) == 0), keepmin = (lower == up);
#pragma unroll
                for (int r = 0; r < 8; ++r) { const u32 o = (u32)__shfl_xor((int)k[r], mm); const u32 mn = umin_(k[r], o), mx = umax_(k[r], o); k[r] = keepmin ? mn : mx; }
            } else {
#pragma unroll
                for (int r = 0; r < 8; ++r) { const int r2 = r ^ S;
                    if (r2 > r) { const u32 a = k[r], b = k[r2], mn = umin_(a, b), mx = umax_(a, b);
                        if (K < 8) { const bool up = (r & K) == 0; k[r] = up ? mn : mx; k[r2] = up ? mx : mn; }
                        else { const bool up = (K == 128) ? true : ((m & (K >> 3)) == 0); k[r] = up ? mn : mx; k[r2] = up ? mx : mn; } } }
            }
        }
    }
}
typedef int v8i __attribute__((ext_vector_type(8)));
typedef unsigned u2v __attribute__((ext_vector_type(2)));
__device__ __forceinline__ void eval_mf(Frame& F, const unsigned char* u4, const unsigned char* v4, const float* suv, const float* fg, float* out, int t0) {
    int lane = F.lane; asm volatile("" : "+v"(lane));
    const int g = lane >> 4, m = lane & 15;
    LAS unsigned short* EXL = (LAS unsigned short*)(F.lds + RING_OFF + L_EX);
    LAS unsigned short* GTL = (LAS unsigned short*)(F.lds + RING_OFF + L_GT);
    LAS unsigned char* BI = F.lds + RING_OFF + L_BI + F.wave * BI_WAVE;
    const LAS float* RST = (const LAS float*)(F.lds + RING_OFF + L_RST);
    LAS u32* SKW = (LAS u32*)(F.lds + RING_OFF + L_IDX) + F.wave * 512;
    LAS u32* SK = SKW + g * 128;
    for (int pass = 0; pass < 4; ++pass) {
        const int tb4 = 32 * pass + 4 * F.wave, tok = tb4 + g;
        LAS unsigned short* exr = EXL + tok * EX_STRIDE; LAS unsigned short* gtr = GTL + tok * GT_STRIDE;
        { u32 k[8]; const v4u ev = *(const LAS v4u*)(exr + 8 * m); const u32 s0 = (u32)(8 * m);
          k[0] = ((ev.x & 0xffffu) << 7) | s0; k[1] = ((ev.x >> 16) << 7) | (s0 + 1); k[2] = ((ev.y & 0xffffu) << 7) | (s0 + 2); k[3] = ((ev.y >> 16) << 7) | (s0 + 3);
          k[4] = ((ev.z & 0xffffu) << 7) | (s0 + 4); k[5] = ((ev.z >> 16) << 7) | (s0 + 5); k[6] = ((ev.w & 0xffffu) << 7) | (s0 + 6); k[7] = ((ev.w >> 16) << 7) | (s0 + 7);
          sort128(k, m);
          u32 wv[8];
#pragma unroll
          for (int r = 0; r < 8; ++r) wv[r] = ((k[r] >> 7) << 16) | (u32)gtr[k[r] & 127u];
          *(LAS v4u*)(SK + m * 8) = (v4u){wv[0], wv[1], wv[2], wv[3]}; *(LAS v4u*)(SK + m * 8 + 4) = (v4u){wv[4], wv[5], wv[6], wv[7]};
          *(LAS v4u*)(exr + 8 * m) = (v4u){(k[0] >> 7) | ((k[1] >> 7) << 16), (k[2] >> 7) | ((k[3] >> 7) << 16), (k[4] >> 7) | ((k[5] >> 7) << 16), (k[6] >> 7) | ((k[7] >> 7) << 16)}; }
        asm volatile("" ::: "memory");
        {
#pragma unroll
            for (int tq = 0; tq < 4; ++tq) { const float rq = RST[tb4 + tq]; const float* xr = out + (size_t)(t0 + tb4 + tq) * DMODEL + 4 * lane;
#pragma unroll
                for (int c = 0; c < 4; ++c) { const f32x4 xa = *(const GAS f32x4*)(xr + 256 * c); int w = 0;
                    w = __builtin_amdgcn_cvt_pk_fp8_f32(xa[0] * rq, xa[1] * rq, w, false); w = __builtin_amdgcn_cvt_pk_fp8_f32(xa[2] * rq, xa[3] * rq, w, true);
                    const int d = 256 * c + 4 * lane, st = d >> 7, dd = d & 127, hh = dd >> 6, e = dd & 63;
                    *(LAS int*)(BI + ((st * 4 + tq) * 4 + (e >> 4)) * 32 + hh * 16 + (e & 15)) = w; } }
        }
        asm volatile("" ::: "memory");
        v8i hb[8];
#pragma unroll
        for (int st = 0; st < 8; ++st) { v4u b0 = *(const LAS v4u*)(BI + ((st * 4 + (m & 3)) * 4 + g) * 32), b1 = *(const LAS v4u*)(BI + ((st * 4 + (m & 3)) * 4 + g) * 32 + 16);
            if (m >= 4) { b0 = (v4u){0u, 0u, 0u, 0u}; b1 = b0; }
            hb[st] = (v8i){(int)b0.x, (int)b0.y, (int)b0.z, (int)b0.w, (int)b1.x, (int)b1.y, (int)b1.z, (int)b1.w}; }
        asm volatile("" ::: "memory");
#define PEER_BAR() do { asm volatile("" ::: "memory"); __builtin_amdgcn_sched_barrier(0); } while (0)
#define PEER_LOADU(UA, KQ, SC, I) do { KQ = *(const LAS v4u*)(SK + (I)); _Pragma("unroll") for (int s4 = 0; s4 < 4; ++s4) { const u32 e_ = KQ[s4] >> 16; const u32 ro_ = e_ * 512u + 16u * (u32)m; \
            UA[s4][0] = *(const GAS v4u*)(u4 + ro_); UA[s4][1] = *(const GAS v4u*)(u4 + ro_ + 256); SC[s4] = *(const GAS f32x2*)(suv + 2 * e_); } } while (0)
#define PEER_TRANSP(UA) do { _Pragma("unroll") for (int hf = 0; hf < 2; ++hf) { \
                _Pragma("unroll") for (int s4 = 0; s4 < 4; ++s4) *(LAS v4u*)(BI + (4 * s4 + g) * 272 + 16 * m) = UA[s4][hf]; \
                asm volatile("" ::: "memory"); \
                _Pragma("unroll") for (int st = 0; st < 4; ++st) af[4 * hf + st] = *(const LAS v4u*)(BI + m * 272 + 64 * st + 16 * g); \
                asm volatile("" ::: "memory"); } } while (0)
#define PEER_DOTS(KQ, SC, I) do { f32x4 D = (f32x4){0.f, 0.f, 0.f, 0.f}; \
            _Pragma("unroll") for (int st = 0; st < 8; ++st) { const v8i a8 = (v8i){(int)af[st].x, (int)af[st].y, (int)af[st].z, (int)af[st].w, 0, 0, 0, 0}; \
                D = __builtin_amdgcn_mfma_scale_f32_16x16x128_f8f6f4(a8, hb[st], D, 4, 0, 0, 0x7f7f7f7f, 0, 0x7f7f7f7f); } \
            const int sel = lane & 3; const float mine = sel == 0 ? D[0] : sel == 1 ? D[1] : sel == 2 ? D[2] : D[3]; float act[4]; \
            _Pragma("unroll") for (int s4 = 0; s4 < 4; ++s4) { const float pre = __uint_as_float((unsigned)__builtin_amdgcn_ds_bpermute(4 * (g + 16 * s4), (int)__float_as_uint(mine))); \
                act[s4] = gelu_fast(pre * SC[s4][0]) * (__uint_as_float(KQ[s4] << 16) * SC[s4][1]); } \
            if (m == 0) *(LAS u2v*)(gtr + (I)) = (u2v){pk2(act[0], act[1]), pk2(act[2], act[3])}; } while (0)
        v4u kqA, kqB, uaA[4][2], uaB[4][2], af[8]; f32x2 scA[4], scB[4];
        PEER_LOADU(uaA, kqA, scA, 0);
        for (int i = 0; i < 128; i += 8) {
            PEER_TRANSP(uaA);
            PEER_LOADU(uaB, kqB, scB, i + 4);
            PEER_BAR();
            PEER_DOTS(kqA, scA, i);
            PEER_BAR();
            PEER_TRANSP(uaB);
            PEER_LOADU(uaA, kqA, scA, (i + 8 < 128) ? i + 8 : i + 4);
            PEER_BAR();
            PEER_DOTS(kqB, scB, i + 4);
            PEER_BAR();
        }
    }
    asm volatile("" ::: "memory");
    for (int pass = 0; pass < 4; ++pass) {
        const int tb4 = 32 * pass + 4 * F.wave, tok = tb4 + g;
        const LAS unsigned short* exr = EXL + tok * EX_STRIDE; const LAS unsigned short* acr = GTL + tok * GT_STRIDE;
        f32x2 y[32];
#pragma unroll
        for (int q = 0; q < 32; ++q) y[q] = (f32x2){0.f, 0.f};
        float* xrow = out + (size_t)(t0 + tok) * DMODEL + 4 * m;
#define PEER_LOADV(VB, I) do { const u2v e2_ = *(const LAS u2v*)(exr + (I)); _Pragma("unroll") for (int s4 = 0; s4 < 4; ++s4) { const u32 e_ = (s4 & 1) ? (e2_[s4 >> 1] >> 16) : (e2_[s4 >> 1] & 0xffffu); \
            const u32 ro_ = e_ * 512u + 32u * (u32)m; VB[s4][0] = *(const GAS v4u*)(v4 + ro_); VB[s4][1] = *(const GAS v4u*)(v4 + ro_ + 16); } } while (0)
#define PEER_FMAV(VB, I) do { const u2v a2_ = *(const LAS u2v*)(acr + (I)); _Pragma("unroll") for (int s4 = 0; s4 < 4; ++s4) { \
            const float act_ = (s4 & 1) ? __uint_as_float(a2_[s4 >> 1] & 0xffff0000u) : __uint_as_float(a2_[s4 >> 1] << 16); const f32x2 b2_ = (f32x2){act_, act_}; \
            _Pragma("unroll") for (int c = 0; c < 2; ++c) _Pragma("unroll") for (int d = 0; d < 4; ++d) { const unsigned w_ = VB[s4][c][d]; const int hq = 16 * c + 4 * d; \
                y[hq] = __builtin_elementwise_fma(__builtin_amdgcn_cvt_scalef32_pk_f32_fp4(w_, 1.0f, 0), b2_, y[hq]); y[hq + 1] = __builtin_elementwise_fma(__builtin_amdgcn_cvt_scalef32_pk_f32_fp4(w_, 1.0f, 1), b2_, y[hq + 1]); \
                y[hq + 2] = __builtin_elementwise_fma(__builtin_amdgcn_cvt_scalef32_pk_f32_fp4(w_, 1.0f, 2), b2_, y[hq + 2]); y[hq + 3] = __builtin_elementwise_fma(__builtin_amdgcn_cvt_scalef32_pk_f32_fp4(w_, 1.0f, 3), b2_, y[hq + 3]); } } } while (0)
        v4u vbA[4][2], vbB[4][2], vbC[4][2];
        PEER_LOADV(vbA, 0); PEER_LOADV(vbB, 4);
        PEER_BAR();
        for (int i = 0; i < 120; i += 12) {
            PEER_LOADV(vbC, i + 8);  PEER_BAR(); PEER_FMAV(vbA, i);     PEER_BAR();
            PEER_LOADV(vbA, i + 12); PEER_BAR(); PEER_FMAV(vbB, i + 4); PEER_BAR();
            PEER_LOADV(vbB, i + 16); PEER_BAR(); PEER_FMAV(vbC, i + 8); PEER_BAR();
        }
        PEER_FMAV(vbA, 120); PEER_FMAV(vbB, 124);
        float ss = 0.f;
#pragma unroll
        for (int q = 0; q < 16; ++q) { const f32x4 xa = *(const GAS f32x4*)(xrow + 64 * q); y[2 * q][0] += xa[0]; y[2 * q][1] += xa[1]; y[2 * q + 1][0] += xa[2]; y[2 * q + 1][1] += xa[3];
            ss += (y[2 * q][0] * y[2 * q][0] + y[2 * q][1] * y[2 * q][1]) + (y[2 * q + 1][0] * y[2 * q + 1][0] + y[2 * q + 1][1] * y[2 * q + 1][1]); }
        ss += __shfl_xor(ss, 1); ss += __shfl_xor(ss, 2); ss += __shfl_xor(ss, 4); ss += __shfl_xor(ss, 8);
        const float rs = rsqrtf(ss * (1.f / DMODEL) + RMS_EPS);
        asm volatile("" ::: "memory");
#pragma unroll
        for (int q = 0; q < 16; ++q) { const f32x4 gq = *(const GAS f32x4*)(fg + 64 * q + 4 * m); f32x4 o; o[0] = y[2 * q][0] * rs * gq[0]; o[1] = y[2 * q][1] * rs * gq[1]; o[2] = y[2 * q + 1][0] * rs * gq[2]; o[3] = y[2 * q + 1][1] * rs * gq[3];
            *(GAS f32x4*)(xrow + 64 * q) = o; }
    }
}
__device__ __forceinline__ void peer_phase(Frame& F, const Args& a) {
    unsigned char* ws = a.ws;
    for (int tile = F.vcu; tile < T / TOK; tile += F.G) {
        route_tile(F, (const bf16*)(ws + WS_QP), (const bf16*)(ws + WS_SKB), (const float*)(ws + WS_SUMSQ), tile * TOK);
        __syncthreads();
        eval_mf(F, ws + WS_U8, ws + WS_V8, (const float*)(ws + WS_SU), a.in[19], a.out, tile * TOK);
        __syncthreads();
    }
}
}

namespace lru {
typedef float f32x16 __attribute__((ext_vector_type(16)));
constexpr int TOKT = 128, NTILE = SEQ / TOKT;
constexpr int WAVE_LDS = 14336, L_XS = 0, L_XC = 4608, L_GS = 9216, XC_STRIDE = 72  , L_SS = 8 * WAVE_LDS;
static_assert(L_SS + 32 * 8 * 4 <= RING_BYTES, "LRU LDS map");
__device__ __forceinline__ float bf2f(unsigned short h) { return __uint_as_float((unsigned)h << 16); }
__device__ __forceinline__ int crow16(int r) { return (r & 3) + 8 * (r >> 2); }
__device__ __forceinline__ float sigm(float x) { return __builtin_amdgcn_rcpf(1.f + __builtin_amdgcn_exp2f(-LOG2E * x)); }

template <bool FINAL> __device__ __forceinline__ void lru_tile(Frame& F, const Args& args, int tile) {
    int lane = F.lane; asm volatile("" : "+v"(lane));
    const int w = F.wave, j32 = lane & 31, hi = lane >> 5;
    unsigned char* ws = args.ws;
    const bf16* xr = (const bf16*)(ws + WS_XR); const bf16* gr = (const bf16*)(ws + WS_GR); float* carry = (float*)(ws + WS_CARRY);
    const float* cw = args.in[3]; const float* cb = args.in[4]; const float* ba = args.in[6]; const float* bx = args.in[8]; const float* lam = args.in[9];
    const int b = tile / NTILE, jt = tile % NTILE; const size_t trow0 = (size_t)b * SEQ + (size_t)jt * TOKT;
    LAS unsigned char* wl = F.lds + RING_OFF + w * WAVE_LDS;
    LAS unsigned short* XS = (LAS unsigned short*)(wl + L_XS); LAS unsigned short* XC = (LAS unsigned short*)(wl + L_XC); LAS unsigned short* GS = (LAS unsigned short*)(wl + L_GS);
    LAS float* SS = (LAS float*)(F.lds + RING_OFF + L_SS);
    float c_ba[2], c_bx[2], c_sp[2], c_cb[2], c_cw[2][4];
#pragma unroll
    for (int n = 0; n < 2; ++n) { const int c = 64 * w + 32 * n + j32; c_ba[n] = ba[c]; c_bx[n] = bx[c]; c_cb[n] = cb[c];
        const float l = lam[c]; c_sp[n] = 8.f * LOG2E * (fmaxf(-l, 0.f) + log1pf(expf(-fabsf(l))));
#pragma unroll
        for (int k = 0; k < 4; ++k) c_cw[n][k] = cw[k * LW + c]; }
    const bf16* wax = (const bf16*)(ws + WS_WAX);
    float hc[2] = {0.f, 0.f}, ap[2] = {1.f, 1.f};
    if (FINAL) { const float* cin = (const float*)(ws + WS_CIN) + (size_t)(b * NTILE + jt) * LW + 64 * w + j32; hc[0] = cin[0]; hc[1] = cin[32]; }
    v4u pfx[5], pfg[4], pce[2][2], pcu[2][2];
    unsigned char* cacheE = ws + WS_LA + ((size_t)(tile * 8 + w) * 4) * 4096; unsigned char* cacheU = ws + WS_LU + ((size_t)(tile * 8 + w) * 4) * 4096;
#define LRU_FETCH(B) do { const size_t tbn_ = trow0 + (B) * 32; \
        if (!FINAL) { _Pragma("unroll") for (int q_ = 0; q_ < 5; ++q_) { const int pc_ = lane + 64 * q_, row_ = pc_ >> 3, c8_ = pc_ & 7; \
            const bool z_ = (jt == 0 && (B) == 0 && row_ < 3) || pc_ >= 35 * 8; const v4u v_ = *(const GAS v4u*)(xr + (tbn_ + (z_ ? 3 : row_) - 3) * LW + w * 64 + c8_ * 8); pfx[q_] = z_ ? (v4u){0u, 0u, 0u, 0u} : v_; } } \
        if (FINAL) { _Pragma("unroll") for (int q_ = 0; q_ < 4; ++q_) { const int pc_ = lane + 64 * q_; pfg[q_] = *(const GAS v4u*)(gr + (tbn_ + (pc_ >> 3)) * LW + w * 64 + (pc_ & 7) * 8); } \
            _Pragma("unroll") for (int n_ = 0; n_ < 2; ++n_) _Pragma("unroll") for (int h_ = 0; h_ < 2; ++h_) { const size_t o_ = (size_t)(B) * 4096 + n_ * 2048 + h_ * 1024 + lane * 16; \
                pce[n_][h_] = *(const GAS v4u*)(cacheE + o_); pcu[n_][h_] = *(const GAS v4u*)(cacheU + o_); } } } while (0)
    LRU_FETCH(0);
    for (int blk = 0; blk < 4; ++blk) {
        const size_t tb = trow0 + blk * 32;
        int ln = lane; asm volatile("" : "+v"(ln));
        const int k32 = ln & 31;
        if (!FINAL) {
#pragma unroll
            for (int q = 0; q < 5; ++q) { const int pc = ln + 64 * q; if (pc < 35 * 8) *(LAS v4u*)((LAS unsigned char*)XS + (pc >> 3) * 128 + (pc & 7) * 16) = pfx[q]; } }
        v4u ce[2][2], cu[2][2];
        if (FINAL) {
#pragma unroll
            for (int n = 0; n < 2; ++n)
#pragma unroll
                for (int h = 0; h < 2; ++h) { ce[n][h] = pce[n][h]; cu[n][h] = pcu[n][h]; }
#pragma unroll
            for (int q = 0; q < 4; ++q) { const int pc = ln + 64 * q; *(LAS v4u*)((LAS unsigned char*)GS + (pc >> 3) * 128 + (pc & 7) * 16) = pfg[q]; } }
        if (blk < 3) { LRU_FETCH(blk + 1); }
        asm volatile("" ::: "memory");
        float xc[2][16];
        bf16x8 af[4];
        if (!FINAL) {
#pragma unroll
        for (int n = 0; n < 2; ++n)
#pragma unroll
            for (int g = 0; g < 4; ++g) { float xv[7];
#pragma unroll
                for (int q = 0; q < 7; ++q) xv[q] = bf2f(XS[(8 * g + 4 * hi + q) * 64 + 32 * n + j32]);
#pragma unroll
                for (int e = 0; e < 4; ++e) xc[n][4 * g + e] = c_cb[n] + ((c_cw[n][0] * xv[e] + c_cw[n][1] * xv[e + 1]) + (c_cw[n][2] * xv[e + 2] + c_cw[n][3] * xv[e + 3])); }
#pragma unroll
        for (int n = 0; n < 2; ++n)
#pragma unroll
            for (int r = 0; r < 16; ++r) XC[(crow16(r) + 4 * hi) * XC_STRIDE + 32 * n + j32] = (unsigned short)f2bf(xc[n][r]);
        asm volatile("" ::: "memory");
#pragma unroll
        for (int ks = 0; ks < 4; ++ks) af[ks] = *(const LAS bf16x8*)(XC + j32 * XC_STRIDE + 16 * ks + 8 * hi);
        asm volatile("" ::: "memory");
        }
        float yv[2][16];
#pragma unroll
        for (int n = 0; n < 2; ++n) {
            float av[16], uv[16];
            if (!FINAL) {
            f32x16 R = {}, I = {};
            bf16x8 fa[4], fx[4];
#pragma unroll
            for (int ks = 0; ks < 4; ++ks) { fa[ks] = *(const GAS bf16x8*)(wax + (size_t)(((w * 2 + 0) * 2 + n) * 4 + ks) * 512 + ln * 8); fx[ks] = *(const GAS bf16x8*)(wax + (size_t)(((w * 2 + 1) * 2 + n) * 4 + ks) * 512 + ln * 8); }
#pragma unroll
            for (int ks = 0; ks < 4; ++ks) { R = __builtin_amdgcn_mfma_f32_32x32x16_bf16(af[ks], fa[ks], R, 0, 0, 0); I = __builtin_amdgcn_mfma_f32_32x32x16_bf16(af[ks], fx[ks], I, 0, 0, 0); }
            unsigned we[8], wu[8];
#pragma unroll
            for (int k = 0; k < 8; ++k) { const float e0 = sigm(R[2 * k] + c_ba[n]) * c_sp[n], e1 = sigm(R[2 * k + 1] + c_ba[n]) * c_sp[n]; we[k] = pg8::cvt_pk_bf16(e0, e1);
                const float a0 = __builtin_amdgcn_exp2f(-__uint_as_float(we[k] << 16)), a1 = __builtin_amdgcn_exp2f(-__uint_as_float(we[k] & 0xffff0000u));
                const float u0 = __builtin_amdgcn_sqrtf(fmaxf(1.f - a0 * a0, 0.f)) * (sigm(I[2 * k] + c_bx[n]) * xc[n][2 * k]), u1 = __builtin_amdgcn_sqrtf(fmaxf(1.f - a1 * a1, 0.f)) * (sigm(I[2 * k + 1] + c_bx[n]) * xc[n][2 * k + 1]);
                wu[k] = pg8::cvt_pk_bf16(u0, u1);
                av[2 * k] = a0; av[2 * k + 1] = a1; uv[2 * k] = __uint_as_float(wu[k] << 16); uv[2 * k + 1] = __uint_as_float(wu[k] & 0xffff0000u); }
            { const size_t o = (size_t)blk * 4096 + n * 2048 + ln * 16;
              *(GAS v4u*)(cacheE + o) = (v4u){we[0], we[1], we[2], we[3]}; *(GAS v4u*)(cacheE + o + 1024) = (v4u){we[4], we[5], we[6], we[7]};
              *(GAS v4u*)(cacheU + o) = (v4u){wu[0], wu[1], wu[2], wu[3]}; *(GAS v4u*)(cacheU + o + 1024) = (v4u){wu[4], wu[5], wu[6], wu[7]}; }
            } else {
#pragma unroll
                for (int k = 0; k < 8; ++k) { const unsigned e2 = ce[n][k >> 2][k & 3], u2 = cu[n][k >> 2][k & 3];
                    av[2 * k] = __builtin_amdgcn_exp2f(-__uint_as_float(e2 << 16)); av[2 * k + 1] = __builtin_amdgcn_exp2f(-__uint_as_float(e2 & 0xffff0000u));
                    uv[2 * k] = __uint_as_float(u2 << 16); uv[2 * k + 1] = __uint_as_float(u2 & 0xffff0000u); }
            }
            float Ar[4], Hr[4], hst[4];
#pragma unroll
            for (int g = 0; g < 4; ++g) { Ar[g] = (av[4 * g] * av[4 * g + 1]) * (av[4 * g + 2] * av[4 * g + 3]);
                Hr[g] = ((uv[4 * g] * av[4 * g + 1] + uv[4 * g + 1]) * av[4 * g + 2] + uv[4 * g + 2]) * av[4 * g + 3] + uv[4 * g + 3]; }
            float hin = hc[n];
#pragma unroll
            for (int g = 0; g < 4; ++g) { float o1 = Ar[g] * hin + Hr[g]; const float x = __shfl_xor(o1, 32); const float hg = hi ? x : hin; o1 = Ar[g] * hg + Hr[g]; hst[g] = hg;
                const float y = __shfl_xor(o1, 32); hin = hi ? o1 : y;
                if (!FINAL) ap[n] *= Ar[g] * __shfl_xor(Ar[g], 32); }
            hc[n] = hin;
            if (FINAL) {
#pragma unroll
                for (int g = 0; g < 4; ++g) { float h = hst[g];
#pragma unroll
                    for (int e = 0; e < 4; ++e) { const int r = 4 * g + e; h = av[r] * h + uv[r]; yv[n][r] = h * bf2f(GS[(crow16(r) + 4 * hi) * 64 + 32 * n + j32]); } } }
        }
        if (FINAL) {
#pragma unroll
            for (int r = 0; r < 16; ++r) { float s = yv[0][r] * yv[0][r] + yv[1][r] * yv[1][r];
                s += __shfl_xor(s, 1); s += __shfl_xor(s, 2); s += __shfl_xor(s, 4); s += __shfl_xor(s, 8); s += __shfl_xor(s, 16);
                if (j32 == 0) SS[(crow16(r) + 4 * hi) * 8 + w] = s; }
            __syncthreads();
            bf16* ymix = (bf16*)(ws + WS_H);
#pragma unroll
            for (int r = 0; r < 16; ++r) { const int tk = crow16(r) + 4 * hi; const f32x4 s0 = *(const LAS f32x4*)(SS + tk * 8), s1 = *(const LAS f32x4*)(SS + tk * 8 + 4);
                const float rstd = rsqrtf(((s0[0] + s0[1]) + (s0[2] + s0[3]) + (s1[0] + s1[1]) + (s1[2] + s1[3])) * (1.f / LW) + RMS_EPS);
                bf16* yp = ymix + (tb + tk) * DMODEL + 64 * w + k32;
                yp[0] = (bf16)f2bf(yv[0][r] * rstd); yp[32] = (bf16)f2bf(yv[1][r] * rstd); }
            __syncthreads();
        }
    }
#undef LRU_FETCH
    if (!FINAL) { if (hi == 0) { float* cp = carry + ((size_t)(b * NTILE + jt) * 2) * LW + 64 * w + j32;
#pragma unroll
        for (int n = 0; n < 2; ++n) { cp[32 * n] = ap[n]; cp[LW + 32 * n] = hc[n]; } } }
    else {
        const bf16* ob = (const bf16*)(ws + WS_O); bf16* ymix = (bf16*)(ws + WS_H);
        for (int i0 = 0; i0 < 16; i0 += 4) {
            v4u vv[4];
#pragma unroll
            for (int i = 0; i < 4; ++i) vv[i] = *(const GAS v4u*)(ob + (trow0 + 16 * w + i0 + i) * AW + 8 * lane);
            float ssq[4];
#pragma unroll
            for (int i = 0; i < 4; ++i) { float s = 0.f;
#pragma unroll
                for (int c = 0; c < 4; ++c) { const float lo = __uint_as_float(vv[i][c] << 16), hi2 = __uint_as_float(vv[i][c] & 0xffff0000u); s += lo * lo + hi2 * hi2; }
                ssq[i] = s; }
#pragma unroll
            for (int o = 1; o < 64; o <<= 1) {
#pragma unroll
                for (int i = 0; i < 4; ++i) ssq[i] += __shfl_xor(ssq[i], o); }
#pragma unroll
            for (int i = 0; i < 4; ++i) { const float rstd = rsqrtf(ssq[i] * (1.f / AW) + RMS_EPS); v4u o;
#pragma unroll
                for (int c = 0; c < 4; ++c) o[c] = pk2(__uint_as_float(vv[i][c] << 16) * rstd, __uint_as_float(vv[i][c] & 0xffff0000u) * rstd);
                *(GAS v4u*)(ymix + (trow0 + 16 * w + i0 + i) * DMODEL + LW + 8 * lane) = o; } }
    }
}
__device__ __forceinline__ void norm_pass(Frame& F, const Args& a) {
    unsigned char* ws = a.ws; float* nrm = (float*)(ws + WS_NRM);
    const int gw = F.vcu * NWAVES + F.wave, NGW = F.G * NWAVES, lane = F.lane;
    for (int it = gw; it < 2 * BATCH * (SEQ / 64); it += NGW) {
        const int which = it / (BATCH * (SEQ / 64)), r = it % (BATCH * (SEQ / 64)), b = r / (SEQ / 64), t = r % (SEQ / 64);
        const bf16* src = (const bf16*)(ws + (which ? WS_K : WS_Q)) + ((size_t)b * SEQ + 64 * t) * AW + 8 * lane;
        float mx = 0.f;
#pragma unroll 8
        for (int i = 0; i < 64; ++i) { const v4u v = *(const GAS v4u*)(src + (size_t)i * AW); float s = 0.f;
#pragma unroll
            for (int c = 0; c < 4; ++c) { const float lo = __uint_as_float(v[c] << 16), hi = __uint_as_float(v[c] & 0xffff0000u); s += lo * lo + hi * hi; }
            s += __shfl_xor(s, 1); s += __shfl_xor(s, 2); s += __shfl_xor(s, 4); mx = fmaxf(mx, s); }
        if ((lane & 7) == 0) nrm[which * 4096 + (b * NHEADS + (lane >> 3)) * 128 + t] = sqrtf(mx) * 1.0001f;
    }
}
__device__ __forceinline__ void carry_prefix(Frame& F, const Args& a, int b) {
    const float* carry = (const float*)(a.ws + WS_CARRY) + (size_t)b * NTILE * 2 * LW + F.tid; float* cin = (float*)(a.ws + WS_CIN) + (size_t)b * NTILE * LW + F.tid;
    float c = 0.f;
    for (int j0 = 0; j0 < NTILE; j0 += 8) { float A[8], H[8];
#pragma unroll
        for (int j = 0; j < 8; ++j) { A[j] = carry[(size_t)(j0 + j) * 2 * LW]; H[j] = carry[(size_t)(j0 + j) * 2 * LW + LW]; }
#pragma unroll
        for (int j = 0; j < 8; ++j) { cin[(size_t)(j0 + j) * LW] = c; c = A[j] * c + H[j]; } }
}
template <bool FINAL> __device__ __forceinline__ void lru_phase(Frame& F, const Args& a) {
    for (int tile = F.vcu; tile < BATCH * NTILE; tile += F.G) { lru_tile<FINAL>(F, a, tile); __syncthreads(); }
}
}
__global__ void __launch_bounds__(NWAVES * 64, 2) mk_fwd(Args args) {
    extern __shared__ __attribute__((aligned(16))) unsigned char lds[];
    Frame F;
    F.lds = (LAS unsigned char*)lds;
    F.MISC = (volatile LAS unsigned*)(F.lds + MISC_OFF);
    F.wave = __builtin_amdgcn_readfirstlane((int)threadIdx.x >> 6); F.lane = (int)__builtin_amdgcn_mbcnt_hi(~0u, __builtin_amdgcn_mbcnt_lo(~0u, 0u)); F.tid = F.wave * 64 + F.lane;
    F.G = gridDim.x; { const int bx = blockIdx.x; F.vcu = (F.G % 8 == 0) ? (bx % 8) * (F.G / 8) + bx / 8 : bx; }
    unsigned char* ws = args.ws;
    F.ctl = (gu32*)(ws + WS_CTL);
    for (int u = F.tid; u < (LDS_BYTES - LDSCTL_OFF) / 4; u += NWAVES * 64) ((LAS unsigned*)(F.lds + LDSCTL_OFF))[u] = 0u;
    __syncthreads();
    XcdBarrier bar = xcd_barrier_post((unsigned*)(F.ctl + CW_BAR) + args.li * XCD_BAR_WORDS, F.MISC + 8, F.wave);
    const int lo = args.ph_lo, hi = args.ph_hi;
#define IN(k) (lo <= (k) && (k) < hi)
#define BOTH(k) (IN(k) && IN((k) + 1))
#define GRID_BAR() xcd_barrier(bar)

    if (IN(0)) { p0_prologue(F, args); if (BOTH(0)) GRID_BAR(); }

    if (IN(1)) {
        if (F.vcu < BATCH * NHEADS) fcum_unit(F, F.vcu, (const float*)(ws + WS_LOGF), (float*)(ws + WS_FCUM));
        pg8::Gemm g{(const pg8::bf16_t*)(ws + WS_H), (const pg8::bf16_t*)(ws + WS_WIN), T, NG1, DMODEL}; pg8::StaticOrder S; S.init(T, NG1, F.G, (int)blockIdx.x);
        pg8::EpiG1 E{(pg8::bf16_t*)(ws + WS_XR), SPLIT_STRIDE, QSCALE};
        pg8::gemm_phase<pg8::EpiG1, pg8::StaticOrder, true, true>(F.lds + RING_OFF, g, S, E, F.wave);
        if (BOTH(1)) GRID_BAR();
    }
    if (IN(2)) { lru::lru_phase<false>(F, args); lru::norm_pass(F, args); if (BOTH(2)) GRID_BAR(); }
    if (IN(3)) {
        static_assert(attn_body::ATTN_LDS_BYTES <= RING_BYTES, "attention LDS vs frame");
        if (F.vcu < BATCH) lru::carry_prefix(F, args, F.vcu);
        const attn_body::AttnTensors AT{(const attn_body::bf16*)(ws + WS_Q), (const attn_body::bf16*)(ws + WS_K), (const attn_body::bf16*)(ws + WS_V), (attn_body::bf16*)(ws + WS_O), (const float*)(ws + WS_FCUM), (const float*)(ws + WS_NRM)};
        attn_body::attn_phase<8>((char*)lds + RING_OFF, AT, (unsigned*)(F.ctl + CW_ATTQ), F.MISC + 24, F.wave);
        if (BOTH(3)) GRID_BAR();
    }
    if (IN(4)) { lru::lru_phase<true>(F, args); if (BOTH(4)) GRID_BAR(); }
    if (IN(5)) {
        pg8::Gemm g{(const pg8::bf16_t*)(ws + WS_H), (const pg8::bf16_t*)(ws + WS_WOUT), T, DMODEL, DMODEL}; pg8::StaticOrder S; S.init(T, DMODEL, F.G, (int)blockIdx.x);
        pg8::EpiG2 E{args.in[0], args.out, (pg8::bf16_t*)(ws + WS_X1B), (float*)(ws + WS_SUMSQ), DMODEL};
        pg8::gemm_phase<pg8::EpiG2, pg8::StaticOrder, true, true>(F.lds + RING_OFF, g, S, E, F.wave);
        if (BOTH(5)) GRID_BAR();
    }
    if (IN(6)) {
        pg8::Gemm g{(const pg8::bf16_t*)(ws + WS_X1B), (const pg8::bf16_t*)(ws + WS_WQ), T, QPW, DMODEL}; pg8::StaticOrder S; S.init(T, QPW, F.G, (int)blockIdx.x);
        pg8::EpiG3 E{(pg8::bf16_t*)(ws + WS_QP), QPW};
        pg8::gemm_phase<pg8::EpiG3, pg8::StaticOrder, true, true>(F.lds + RING_OFF, g, S, E, F.wave);
        if (BOTH(6)) GRID_BAR();
    }
    if (IN(7)) { peer::peer_phase(F, args); }
#undef IN
#undef BOTH
#undef GRID_BAR
}

extern "C" void kernel_launch(void* const* d_in, const int* in_sizes, int n_in, void* d_out, int out_size, void* d_ws, size_t ws_size, hipStream_t stream) {
    static int grid = 0;
    if (grid == 0) {
        if (n_in != 20 || in_sizes[0] != T * DMODEL || out_size != T * DMODEL || ws_size < WS_END) { fprintf(stderr, "kernel_launch: unexpected shapes (n_in %d, ws %zu)\n", n_in, ws_size); grid = -1; return; }
        int dev = 0, cus = 0;
        if (hipGetDevice(&dev) != hipSuccess || hipDeviceGetAttribute(&cus, hipDeviceAttributeMultiprocessorCount, dev) != hipSuccess) { grid = -1; return; }
        if (hipFuncSetAttribute((const void*)mk_fwd, hipFuncAttributeMaxDynamicSharedMemorySize, LDS_BYTES) != hipSuccess) { fprintf(stderr, "kernel_launch: hipFuncSetAttribute failed\n"); grid = -1; return; }
        (void)hipGetLastError();
        grid = cus;
    }
    if (grid < 0) return;
    if (hipMemsetAsync((char*)d_ws + WS_CTL, 0, CTL_ZERO_BYTES, stream) != hipSuccess) return;
    Args a{};
    for (int i = 0; i < 20; ++i) a.in[i] = (const float*)d_in[i];
    a.out = (float*)d_out; a.ws = (unsigned char*)d_ws; a.ph_lo = 0; a.ph_hi = N_PHASES; a.li = 0;
    hipLaunchKernelGGL(mk_fwd, dim3(grid), dim3(NWAVES * 64), LDS_BYTES, stream, a);
}
```

```cpp
#include <hip/hip_runtime.h>
#include <hip/hip_bf16.h>
#include <cstdio>
#include <cstdint>
#include <cmath>

constexpr int BATCH = 4, SEQ = 8192, DMODEL = 1024, T = BATCH * SEQ;
constexpr int LW = 512, AW = 512, NHEADS = 8, HD = 64, INC = 2568, NG1 = 2560;
constexpr int PH = 8, NKEY = 128, PHALF = 128, TOPK = 16, NEXP = NKEY * NKEY, QPW = 2048;
constexpr float RMS_EPS = 1e-6f;
constexpr float LOG2E = 1.4426950408889634f;
constexpr float QSCALE = 0.125f * LOG2E;
constexpr size_t MiB = 1u << 20;
constexpr size_t WS_CTL = 0, CTL_ZERO_BYTES = 1 * MiB;
constexpr size_t WS_WIN = 2 * MiB, WS_WOUT = 8 * MiB, WS_WQ = 10 * MiB, WS_SKB = 14 * MiB, WS_WFL = 15 * MiB,
                 WS_LOGF = 16 * MiB, WS_FCUM = 17 * MiB, WS_CARRY = 18 * MiB, WS_SUMSQ = 512 * 1024  , WS_WAX = 20 * MiB, WS_CIN = 23 * MiB  , WS_NRM = 22 * MiB  ,
                 WS_H = 32 * MiB, WS_XR = 96 * MiB, WS_GR = 128 * MiB, WS_Q = 160 * MiB, WS_K = 192 * MiB, WS_V = 224 * MiB,
                 WS_X1B = 256 * MiB, WS_O = 256 * MiB  , WS_QP = 96 * MiB, WS_UT = 320 * MiB, WS_VT = 352 * MiB, WS_U8 = 320 * MiB, WS_V8 = 336 * MiB, WS_SU = 21 * MiB, WS_SV = 21 * MiB + 65536, WS_LA = 384 * MiB, WS_LU = 448 * MiB, WS_END = 512 * MiB;
constexpr size_t SPLIT_STRIDE = (WS_GR - WS_XR) / 2;
constexpr int CW_TMO = 0, CW_ATTQ = 2048, CW_BAR = 4096;

namespace pg8 {
#define PG8_LAS __attribute__((address_space(3)))
typedef unsigned short bf16_t;
typedef short bf16x8 __attribute__((ext_vector_type(8)));
typedef float f32x4 __attribute__((ext_vector_type(4)));
typedef unsigned u32x4 __attribute__((ext_vector_type(4)));
constexpr int BM = 256, BK = 64, HALF = 128, HTB = HALF * BK * 2  , STAGE_BYTES = 8 * HTB, NXCD = 8, WGM = 8;

__host__ __device__ __forceinline__ int lds_byte(int r, int c) { const int st = (r >> 4) * 2 + (c >> 5), rr = r & 15, cc = c & 31, ob = rr * 64 + cc * 2; return st * 1024 + (ob ^ (((ob >> 9) & 1) << 5)); }
__host__ __device__ __forceinline__ void stage_rc(int b, int& R, int& C) { const int st = b / 1024, sb = b % 1024, swz = sb ^ (((sb >> 9) & 1) << 5); R = (st >> 1) * 16 + swz / 64; C = (st & 1) * 32 + (swz % 64) / 2; }
__host__ __device__ __forceinline__ int perm32(int rho) { const int n = rho >> 4, i = rho & 15; return 8 * (i >> 2) + 4 * n + (i & 3); }

struct Unit { int pm, pn; };
struct Gemm { const bf16_t* A; const bf16_t* Bt; int M, N, K; };

struct StaticOrder {
    int nM, nN, nwg, G, c;
    __host__ __device__ void init(int M, int N, int G_, int c_) { nM = M / BM; nN = N / BM; nwg = nM * nN; G = G_; c = c_; }
    __host__ __device__ bool next(int i, Unit& u) const {
        const long L = (long)i * G + c; if (L >= nwg) return false;
        int wgid = (int)L; { const int q = nwg / NXCD, r = nwg % NXCD, xcd = wgid % NXCD, off = wgid / NXCD; wgid = (xcd < r ? xcd * (q + 1) : r * (q + 1) + (xcd - r) * q) + off; }
        const int nig = WGM * nN, gid = wgid / nig, fm = gid * WGM, gsz = (nM - fm) < WGM ? (nM - fm) : WGM;
        u.pm = fm + ((wgid % nig) % gsz); u.pn = (wgid % nig) / gsz; return true;
    }
    __device__ __forceinline__ void a_ready(const Unit&) const {}
    __device__ __forceinline__ void done(const Unit&) const {}
};

__device__ __forceinline__ unsigned cvt_pk_bf16(float lo, float hi) { unsigned r; asm volatile("v_cvt_pk_bf16_f32 %0, %1, %2" : "=v"(r) : "v"(lo), "v"(hi)); return r; }
typedef unsigned u32x2 __attribute__((ext_vector_type(2)));
__device__ __forceinline__ float gelu_fast(float x) {
    const float u2 = x * (1.5957691216057308f + 0.07135481627f * x * x);
    return x * __builtin_amdgcn_rcpf(1.f + __builtin_amdgcn_exp2f(-1.4426950408889634f * u2));
}
struct EpiG1 {
    static constexpr bool PERM = true, AFTER_DRAIN = false;
    bf16_t* base0; size_t split_stride; float qscale;
    __device__ __forceinline__ void operator()(const f32x4 (&acc)[2][2][4][2], const Unit& u, int wr, int wc, int fr, int fq) const {
        const int s = u.pn >> 1; bf16_t* base = base0 + (size_t)s * split_stride;
        const int row0 = u.pm * BM + wr * 64 + fr, col0 = (u.pn & 1) * 256 + wc * 32 + 8 * fq;
#pragma unroll
        for (int ai = 0; ai < 2; ++ai)
#pragma unroll
            for (int m = 0; m < 4; ++m) { bf16_t* rowp = base + (size_t)(row0 + ai * HALF + m * 16) * 512 + col0;
#pragma unroll
                for (int bj = 0; bj < 2; ++bj) { f32x4 v0 = acc[ai][bj][m][0], v1 = acc[ai][bj][m][1];
                    if (s == 1) {
#pragma unroll
                        for (int e = 0; e < 4; ++e) { v0[e] = gelu_fast(v0[e]); v1[e] = gelu_fast(v1[e]); } }
                    else if (s == 2) { v0 = v0 * qscale; v1 = v1 * qscale; }
                    u32x4 w; w.x = cvt_pk_bf16(v0[0], v0[1]); w.y = cvt_pk_bf16(v0[2], v0[3]); w.z = cvt_pk_bf16(v1[0], v1[1]); w.w = cvt_pk_bf16(v1[2], v1[3]);
                    *(u32x4*)(rowp + bj * HALF) = w; } }
    }
};
struct EpiG2 {
    static constexpr bool PERM = false, AFTER_DRAIN = false;
    const float* resid; float* out; bf16_t* xb; float* sumsq; int ldc;
    __device__ __forceinline__ void operator()(const f32x4 (&acc)[2][2][4][2], const Unit& u, int wr, int wc, int fr, int fq) const {
        const int row0 = u.pm * BM + wr * 64 + fr, col0 = u.pn * BM + wc * 32 + 4 * fq;
#pragma unroll
        for (int ai = 0; ai < 2; ++ai) {
            f32x4 rs[4][2][2];
#pragma unroll
            for (int m = 0; m < 4; ++m) { const size_t off = (size_t)(row0 + ai * HALF + m * 16) * ldc + col0;
#pragma unroll
                for (int bj = 0; bj < 2; ++bj)
#pragma unroll
                    for (int n = 0; n < 2; ++n) rs[m][bj][n] = *(const f32x4*)(resid + off + bj * HALF + n * 16); }
#pragma unroll
            for (int m = 0; m < 4; ++m) { const int r = row0 + ai * HALF + m * 16; const size_t off = (size_t)r * ldc + col0; float ss = 0.f;
#pragma unroll
                for (int bj = 0; bj < 2; ++bj)
#pragma unroll
                    for (int n = 0; n < 2; ++n) { const f32x4 x = rs[m][bj][n] + acc[ai][bj][m][n];
                        *(f32x4*)(out + off + bj * HALF + n * 16) = x; ss += (x[0] * x[0] + x[1] * x[1]) + (x[2] * x[2] + x[3] * x[3]);
                        u32x2 w; w.x = cvt_pk_bf16(x[0], x[1]); w.y = cvt_pk_bf16(x[2], x[3]); *(u32x2*)(xb + off + bj * HALF + n * 16) = w; }
                ss += __shfl_xor(ss, 16); ss += __shfl_xor(ss, 32);
                if (fq == 0) atomicAdd(sumsq + r, ss); }
            asm volatile("" ::: "memory"); }
    }
};
struct EpiG3 {
    static constexpr bool PERM = true, AFTER_DRAIN = false;
    bf16_t* O; int ldc;
    __device__ __forceinline__ void operator()(const f32x4 (&acc)[2][2][4][2], const Unit& u, int wr, int wc, int fr, int fq) const {
        const int row0 = u.pm * BM + wr * 64 + fr;
#pragma unroll
        for (int ai = 0; ai < 2; ++ai)
#pragma unroll
            for (int m = 0; m < 4; ++m) { const int t = row0 + ai * HALF + m * 16;
#pragma unroll
                for (int bj = 0; bj < 2; ++bj) { const f32x4 v0 = acc[ai][bj][m][0], v1 = acc[ai][bj][m][1];
                    u32x4 w; w.x = cvt_pk_bf16(v0[0], v0[1]); w.y = cvt_pk_bf16(v0[2], v0[3]); w.z = cvt_pk_bf16(v1[0], v1[1]); w.w = cvt_pk_bf16(v1[2], v1[3]);
                    *(u32x4*)(O + ((size_t)(((((t >> 5) * 8 + u.pn) * 2 + bj) * 16 + 4 * wc + fq) * 32 + (t & 31))) * 8) = w; } }
    }
};

template <class Epi, class Sched, bool ALIGN_EPI = false, bool SP2 = false>
__device__ __forceinline__ void gemm_phase(PG8_LAS unsigned char* lds, const Gemm g, const Sched& S, const Epi& E, int wid_in) {
    const int wid = __builtin_amdgcn_readfirstlane(wid_in), lane = (int)__builtin_amdgcn_mbcnt_hi(~0u, __builtin_amdgcn_mbcnt_lo(~0u, 0u)), tid = wid * 64 + lane, wr = wid >> 2, wc = wid & 3, fr = lane & 15, fq = lane >> 4;
    const int K = g.K, nt = K / BK;
    unsigned voffA[2], voffB[2];
#pragma unroll
    for (int i = 0; i < 2; ++i) { int R, C; stage_rc(tid * 16 + i * 8192, R, C); const int Rb = Epi::PERM ? ((R & ~31) + perm32(R & 31)) : R;
        voffA[i] = (unsigned)(R * K + C) * 2u; voffB[i] = (unsigned)(Rb * K + C) * 2u; }
    const size_t kstep = (size_t)(BK * 2);
    const size_t hstep = (size_t)HALF * K * 2;
    const size_t tstep = 2 * hstep;
    const unsigned ldsw = (unsigned)wid * 1024u;
    const int aoff = lds_byte(wr * 64 + fr, fq * 8), boff = lds_byte(wc * 32 + fr, fq * 8);
#define PG8_SA(b, h) (((b) * 2 + (h)) * HTB)
#define PG8_SB(b, h) ((4 + (b) * 2 + (h)) * HTB)
#define PG8_STAGE(bufoff, gbase, voff) do { _Pragma("unroll") for (int _i = 0; _i < 2; ++_i) \
        __builtin_amdgcn_global_load_lds((const unsigned*)((const char*)(gbase) + (voff)[_i]), (PG8_LAS unsigned*)(lds + (bufoff) + ldsw + _i * 8192), 16, 0, 0); } while (0)
#define PG8_LDA(dst, b, h) do { _Pragma("unroll") for (int m = 0; m < 4; ++m) _Pragma("unroll") for (int k = 0; k < 2; ++k) dst[m][k] = *(const PG8_LAS bf16x8*)(lds + PG8_SA(b, h) + aoff + m * 2048 + k * 1024); } while (0)
#define PG8_LDB(dst, b, h) do { _Pragma("unroll") for (int n = 0; n < 2; ++n) _Pragma("unroll") for (int k = 0; k < 2; ++k) dst[n][k] = *(const PG8_LAS bf16x8*)(lds + PG8_SB(b, h) + boff + n * 2048 + k * 1024); } while (0)
#define PG8_MMA(ai, bj, At, Bt) do { __builtin_amdgcn_s_setprio(1); _Pragma("unroll") for (int m = 0; m < 4; ++m) _Pragma("unroll") for (int n = 0; n < 2; ++n) _Pragma("unroll") for (int k = 0; k < 2; ++k) \
        acc[ai][bj][m][n] = __builtin_amdgcn_mfma_f32_16x16x32_bf16(Bt[n][k], At[m][k], acc[ai][bj][m][n], 0, 0, 0); __builtin_amdgcn_s_setprio(0); } while (0)
#define PG8_WAIT_V(n) asm volatile("s_waitcnt vmcnt(" #n ")" ::: "memory")
#define PG8_WAIT_L(n) asm volatile("s_waitcnt lgkmcnt(" #n ")" ::: "memory")
#define PG8_BAR __builtin_amdgcn_s_barrier()
#define PG8_SCHED __builtin_amdgcn_sched_barrier(0)
    Unit cur, nxt; int ui = 0;
    if (!S.next(0, cur)) return;
    f32x4 acc[2][2][4][2];
#pragma unroll
    for (int a = 0; a < 2; ++a)
#pragma unroll
        for (int b = 0; b < 2; ++b)
#pragma unroll
            for (int m = 0; m < 4; ++m)
#pragma unroll
                for (int n = 0; n < 2; ++n) acc[a][b][m][n] = (f32x4){0.f, 0.f, 0.f, 0.f};
    bf16x8 At[4][2], B0[2][2], B1[2][2];
    const char* cA = (const char*)g.A + (size_t)cur.pm * tstep; const char* cB = (const char*)g.Bt + (size_t)cur.pn * tstep;
    S.a_ready(cur);
    if constexpr (SP2) {
        PG8_STAGE(PG8_SB(0, 0), cB, voffB); PG8_STAGE(PG8_SB(0, 1), cB + hstep, voffB); PG8_STAGE(PG8_SA(0, 0), cA, voffA); PG8_STAGE(PG8_SA(0, 1), cA + hstep, voffA);
        if (wr == 1) PG8_BAR;
        PG8_WAIT_V(2); PG8_BAR;
        PG8_STAGE(PG8_SB(1, 0), cB + kstep, voffB); PG8_STAGE(PG8_SA(1, 0), cA + kstep, voffA); PG8_STAGE(PG8_SB(1, 1), cB + hstep + kstep, voffB);
        PG8_WAIT_V(6); PG8_BAR;
    } else {
        PG8_STAGE(PG8_SB(0, 0), cB, voffB); PG8_STAGE(PG8_SA(0, 0), cA, voffA); PG8_STAGE(PG8_SB(0, 1), cB + hstep, voffB); PG8_STAGE(PG8_SA(0, 1), cA + hstep, voffA);
        if (wr == 1) PG8_BAR;
        PG8_WAIT_V(4); PG8_BAR;
        PG8_STAGE(PG8_SB(1, 0), cB + kstep, voffB); PG8_STAGE(PG8_SA(1, 0), cA + kstep, voffA); PG8_STAGE(PG8_SB(1, 1), cB + hstep + kstep, voffB);
        PG8_WAIT_V(6); PG8_BAR;
    }
    for (;;) {
        const bool has_next = S.next(ui + 1, nxt);
        const char* nA = has_next ? (const char*)g.A + (size_t)nxt.pm * tstep : cA; const char* nB = has_next ? (const char*)g.Bt + (size_t)nxt.pn * tstep : cB;
        for (int t = 0; t < nt; t += 2) {
            const bool last = (t == nt - 2);
            const char* a1 = cA + (size_t)(t + 1) * kstep;
            const char* a2 = last ? nA : cA + (size_t)(t + 2) * kstep; const char* b2 = last ? nB : cB + (size_t)(t + 2) * kstep;
            const char* a3 = a2 + kstep; const char* b3 = b2 + kstep;
            if (last && has_next) S.a_ready(nxt);
            if constexpr (SP2) {
            PG8_LDB(B0, 0, 0); PG8_LDB(B1, 0, 1); PG8_SCHED; PG8_LDA(At, 0, 0); PG8_STAGE(PG8_SA(1, 1), a1 + hstep, voffA);
            PG8_WAIT_V(8); PG8_WAIT_L(0); PG8_BAR; PG8_MMA(0, 0, At, B0); PG8_MMA(0, 1, At, B1); PG8_BAR; PG8_SCHED;
            PG8_LDA(At, 0, 1); PG8_STAGE(PG8_SB(0, 0), b2, voffB); PG8_STAGE(PG8_SB(0, 1), b2 + hstep, voffB); PG8_STAGE(PG8_SA(0, 0), a2, voffA);
            PG8_WAIT_V(8); PG8_WAIT_L(0); PG8_BAR; PG8_MMA(1, 0, At, B0); PG8_MMA(1, 1, At, B1); PG8_BAR; PG8_SCHED;
            PG8_LDB(B0, 1, 0); PG8_LDB(B1, 1, 1); PG8_SCHED; PG8_LDA(At, 1, 0); PG8_STAGE(PG8_SA(0, 1), a2 + hstep, voffA);
            PG8_WAIT_V(8); PG8_WAIT_L(0); PG8_BAR; PG8_MMA(0, 0, At, B0); PG8_MMA(0, 1, At, B1); PG8_BAR; PG8_SCHED;
            PG8_LDA(At, 1, 1); PG8_STAGE(PG8_SB(1, 0), b3, voffB); PG8_STAGE(PG8_SB(1, 1), b3 + hstep, voffB); PG8_STAGE(PG8_SA(1, 0), a3, voffA);
            PG8_WAIT_V(8); PG8_WAIT_L(0); PG8_BAR; PG8_MMA(1, 0, At, B0); PG8_MMA(1, 1, At, B1); PG8_BAR; PG8_SCHED;
            } else {
            PG8_LDB(B0, 0, 0); PG8_SCHED; PG8_LDA(At, 0, 0); PG8_STAGE(PG8_SA(1, 1), a1 + hstep, voffA);
            PG8_WAIT_L(8); PG8_BAR; PG8_WAIT_L(0); PG8_MMA(0, 0, At, B0); PG8_BAR; PG8_SCHED;
            PG8_LDB(B1, 0, 1); PG8_STAGE(PG8_SB(0, 0), b2, voffB);
            PG8_BAR; PG8_WAIT_L(0); PG8_MMA(0, 1, At, B1); PG8_BAR;
            PG8_LDA(At, 0, 1); PG8_STAGE(PG8_SA(0, 0), a2, voffA);
            PG8_BAR; PG8_WAIT_L(0); PG8_MMA(1, 0, At, B0); PG8_BAR; PG8_SCHED;
            PG8_STAGE(PG8_SB(0, 1), b2 + hstep, voffB);
            PG8_WAIT_V(6); PG8_BAR; PG8_MMA(1, 1, At, B1); PG8_BAR;
            PG8_LDB(B0, 1, 0); PG8_SCHED; PG8_LDA(At, 1, 0); PG8_STAGE(PG8_SA(0, 1), a2 + hstep, voffA);
            PG8_WAIT_L(8); PG8_BAR; PG8_WAIT_L(0); PG8_MMA(0, 0, At, B0); PG8_BAR; PG8_SCHED;
            PG8_LDB(B1, 1, 1); PG8_STAGE(PG8_SB(1, 0), b3, voffB);
            PG8_BAR; PG8_WAIT_L(0); PG8_MMA(0, 1, At, B1); PG8_BAR;
            PG8_LDA(At, 1, 1); PG8_STAGE(PG8_SA(1, 0), a3, voffA);
            PG8_BAR; PG8_WAIT_L(0); PG8_MMA(1, 0, At, B0); PG8_BAR; PG8_SCHED;
            PG8_STAGE(PG8_SB(1, 1), b3 + hstep, voffB);
            PG8_WAIT_V(6); PG8_BAR; PG8_MMA(1, 1, At, B1); PG8_BAR;
            }
        }
        if constexpr (ALIGN_EPI) { if (wr == 0) PG8_BAR; }
        if constexpr (!Epi::AFTER_DRAIN) { E(acc, cur, wr, wc, fr, fq); S.done(cur); }
        if (!has_next) break;
#pragma unroll
        for (int a = 0; a < 2; ++a)
#pragma unroll
            for (int b = 0; b < 2; ++b)
#pragma unroll
                for (int m = 0; m < 4; ++m)
#pragma unroll
                    for (int n = 0; n < 2; ++n) acc[a][b][m][n] = (f32x4){0.f, 0.f, 0.f, 0.f};
        cur = nxt; cA = nA; cB = nB; ++ui;
        if constexpr (ALIGN_EPI) { if (wr == 1) PG8_BAR; }
    }
    PG8_WAIT_V(0);
    if constexpr (!ALIGN_EPI) { if (wr == 0) PG8_BAR; }
    PG8_BAR;
    if constexpr (Epi::AFTER_DRAIN) { E.fused(acc, cur, wr, wc, fr, fq, lds, wid, lane); S.done(cur); }
#undef PG8_SA
#undef PG8_SB
#undef PG8_STAGE
#undef PG8_LDA
#undef PG8_LDB
#undef PG8_MMA
#undef PG8_WAIT_V
#undef PG8_WAIT_L
#undef PG8_BAR
#undef PG8_SCHED
}
}
#include <hip/hip_bf16.h>
#include <cmath>
namespace attn_body {
using bf16=__hip_bfloat16;
using bf16x8=__attribute__((ext_vector_type(8)))short;
using s16x4=__attribute__((ext_vector_type(4)))short;
using f32x16=__attribute__((ext_vector_type(16)))float;
using u32x4=__attribute__((ext_vector_type(4)))unsigned;
constexpr int BATCH=4,NHEAD=8,SEQ=8192,D=64,DM=NHEAD*D;
constexpr int NW=8,QBLK=32,QB=QBLK*NW,KVBLK=64,NQB=SEQ/QB;
constexpr int ATTN_PITCH=DM, ATTN_UNIT_ROWS=QB;
__device__ __forceinline__ int crow(int r,int hi){return (r&3)+8*(r>>2)+4*hi;}
#define SBAR() __builtin_amdgcn_sched_barrier(0)
__device__ __forceinline__ void cmask(f32x16&p0,f32x16&p1,int jb,int qrel,int hi){
  const float NEG=-INFINITY; int kb=64*jb+4*hi;
  #pragma unroll
  for(int r=0;r<16;++r){int kv=kb+(r&3)+8*(r>>2); if(kv>qrel)p0[r]=NEG; if(kv+32>qrel)p1[r]=NEG;}
}

constexpr int NSLOT=3, SLOTB=8192;
constexpr int LDS_K=0, LDS_V=NSLOT*SLOTB, LDS_WS=2*NSLOT*SLOTB, LDS_OST=LDS_WS+NW*64*4, LDS_FK=LDS_OST+NW*4096, LDS_BYTES=LDS_FK+SEQ*4;
constexpr float C2=0.125f*1.4426950408889634f;
__device__ __forceinline__ void glds16(const void*gsrc,unsigned lds_dst){unsigned keep;
  asm volatile("s_mov_b32 %0, m0\n\ts_mov_b32 m0, %2\n\ts_nop 0\n\tglobal_load_lds_dwordx4 %1, off\n\ts_mov_b32 m0, %0":"=&s"(keep):"v"(gsrc),"s"(lds_dst):"memory");}
__device__ __forceinline__ float max3f(float a,float b,float c){float r;asm("v_max3_f32 %0, %1, %2, %3":"=v"(r):"v"(a),"v"(b),"v"(c));return r;}
__device__ __forceinline__ float max2f(float a,float b){float r;asm("v_max_f32_e32 %0, %1, %2":"=v"(r):"v"(a),"v"(b));return r;}
__device__ __forceinline__ float fadd_s(float a,float b){float r;asm("v_add_f32_e32 %0, %1, %2":"=v"(r):"v"(a),"v"(b));return r;}
__device__ __forceinline__ float fsub_s(float a,float b){float r;asm("v_sub_f32_e32 %0, %1, %2":"=v"(r):"v"(a),"v"(b));return r;}
typedef float f32x2_t __attribute__((ext_vector_type(2))); typedef __bf16 bf16x2_t __attribute__((ext_vector_type(2)));
__device__ __forceinline__ unsigned cvtpk_s(float lo,float hi){f32x2_t v={lo,hi};bf16x2_t b=__builtin_convertvector(v,bf16x2_t);return __builtin_bit_cast(unsigned,b);}
#define WAIT_BAR(N) asm volatile("s_waitcnt vmcnt(" #N ") lgkmcnt(0)\n\ts_barrier":::"memory")

__device__ __forceinline__ void qkt(f32x16&p0,f32x16&p1,const char*Kslot,const bf16x8*qr,int r32,int hi){
  const char*kb=Kslot+hi*1024+r32*16;
  #pragma unroll
  for(int d0=0;d0<4;++d0){
    const bf16x8 b0=*reinterpret_cast<const bf16x8*>(kb+d0*2048);
    const bf16x8 b1=*reinterpret_cast<const bf16x8*>(kb+d0*2048+512);
    p0=__builtin_amdgcn_mfma_f32_32x32x16_bf16(b0,qr[d0],p0,0,0,0);p1=__builtin_amdgcn_mfma_f32_32x32x16_bf16(b1,qr[d0],p1,0,0,0);}
}
typedef __attribute__((address_space(3))) const char* lds_cptr;
typedef short v4i16_t __attribute__((ext_vector_type(4)));
__device__ __forceinline__ void kload8(bf16x8*kf,lds_cptr kp){
  kf[0]=*(const __attribute__((address_space(3))) bf16x8*)(kp);      kf[1]=*(const __attribute__((address_space(3))) bf16x8*)(kp+512);
  kf[2]=*(const __attribute__((address_space(3))) bf16x8*)(kp+2048); kf[3]=*(const __attribute__((address_space(3))) bf16x8*)(kp+2560);
  kf[4]=*(const __attribute__((address_space(3))) bf16x8*)(kp+4096); kf[5]=*(const __attribute__((address_space(3))) bf16x8*)(kp+4608);
  kf[6]=*(const __attribute__((address_space(3))) bf16x8*)(kp+6144); kf[7]=*(const __attribute__((address_space(3))) bf16x8*)(kp+6656);
}
__device__ __forceinline__ void kload2(bf16x8*kf,lds_cptr kp,int j){ kf[2*j]=*(const __attribute__((address_space(3))) bf16x8*)(kp+j*2048); kf[2*j+1]=*(const __attribute__((address_space(3))) bf16x8*)(kp+j*2048+512); }
__device__ __forceinline__ s16x4 vtr(lds_cptr p){ return __builtin_bit_cast(s16x4,__builtin_amdgcn_ds_read_tr16_b64_v4i16((__attribute__((address_space(3))) v4i16_t*)p)); }
__device__ __forceinline__ float rowmax(const f32x16&p0,const f32x16&p1){
  float a=max3f(p0[0],p0[1],p1[0]),b=max3f(p0[2],p0[3],p1[1]);a=max3f(a,p1[2],p1[3]);
  #pragma unroll
  for(int r=4;r<16;r+=4){a=max3f(a,p0[r],p0[r+1]);b=max3f(b,p0[r+2],p0[r+3]);a=max3f(a,p1[r],p1[r+1]);b=max3f(b,p1[r+2],p1[r+3]);}
  const float m=max2f(a,b);
  auto rr=__builtin_amdgcn_permlane32_swap(__float_as_uint(m),__float_as_uint(m),false,false);
  return max2f(__uint_as_float(rr[0]),__uint_as_float(rr[1]));
}
__device__ __forceinline__ void pv(f32x16*o,int vb,bf16x8 pa0,bf16x8 pa1,bf16x8 pa2,bf16x8 pa3){
  #pragma unroll
  for(int d0=0;d0<2;++d0){s16x4 lo[4],hi[4];
    #pragma unroll
    for(int ks=0;ks<4;++ks){
      asm volatile("ds_read_b64_tr_b16 %0,%1 offset:%c2":"=&v"(lo[ks]):"v"(vb),"i"(d0*4096+ks*1024):"memory");
      asm volatile("ds_read_b64_tr_b16 %0,%1 offset:%c2":"=&v"(hi[ks]):"v"(vb),"i"(d0*4096+ks*1024+512):"memory");}
    asm volatile("s_waitcnt lgkmcnt(0)":::"memory");SBAR();
    #define PK(k) (bf16x8){lo[k][0],lo[k][1],lo[k][2],lo[k][3],hi[k][0],hi[k][1],hi[k][2],hi[k][3]}
    o[d0]=__builtin_amdgcn_mfma_f32_32x32x16_bf16(pa0,PK(0),o[d0],0,0,0);
    o[d0]=__builtin_amdgcn_mfma_f32_32x32x16_bf16(pa1,PK(1),o[d0],0,0,0);
    o[d0]=__builtin_amdgcn_mfma_f32_32x32x16_bf16(pa2,PK(2),o[d0],0,0,0);
    o[d0]=__builtin_amdgcn_mfma_f32_32x32x16_bf16(pa3,PK(3),o[d0],0,0,0);
    #undef PK
  }
}

#ifndef ATTN_STORE16
#define ATTN_STORE16(p,v) (*(u32x4*)(p)=(v))
#endif
template<int THRL> __device__ __forceinline__ void attn_unit(int b,int h,int qb,const bf16*Q,const bf16*__restrict__ K,const bf16*__restrict__ V,bf16*O,const float*__restrict__ Fc,const float*__restrict__ NRM,char*shm,int wid_in){
  const int wid=__builtin_amdgcn_readfirstlane(wid_in); int lane_=(int)__builtin_amdgcn_mbcnt_hi(~0u,__builtin_amdgcn_mbcnt_lo(~0u,0u)); asm volatile("":"+v"(lane_));
  const int lane=lane_,tid=wid*64+lane,r32=lane&31,hi=lane>>5;
  const long rowbase=(long)b*SEQ; const int q0=qb*QB;
  const float*Fbh=Fc+(long)(b*NHEAD+h)*SEQ;
  const int NTF=(q0+QB)/KVBLK; int t_start;
  { const float*QNb=NRM+(b*NHEAD+h)*128,*KNb=NRM+4096+(b*NHEAD+h)*128;
    const float qn=fmaxf(fmaxf(QNb[4*qb],QNb[4*qb+1]),fmaxf(QNb[4*qb+2],QNb[4*qb+3])),knb=fmaxf(fmaxf(KNb[4*qb],KNb[4*qb+1]),fmaxf(KNb[4*qb+2],KNb[4*qb+3]));
    const float fq0=Fbh[q0]*1.4426950408889634f; bool k0=true,k1=true;
    if(lane<NTF-4)k0=!(qn*(KNb[lane]+knb)+(fq0-Fbh[64*lane+63]*1.4426950408889634f)<-40.f);
    if(lane+64<NTF-4)k1=!(qn*(KNb[lane+64]+knb)+(fq0-Fbh[64*(lane+64)+63]*1.4426950408889634f)<-40.f);
    const unsigned long long m0=__ballot(k0),m1=__ballot(k1);
    int tf=m0?(int)__builtin_ctzll(m0):64+(m1?(int)__builtin_ctzll(m1):64);
    tf=tf<NTF-4?tf:NTF-4; t_start=__builtin_amdgcn_readfirstlane(tf&~1); }
  { typedef float f32x4_t __attribute__((ext_vector_type(4))); __attribute__((address_space(3))) float*fk=(__attribute__((address_space(3))) float*)((__attribute__((address_space(3))) char*)shm+LDS_FK); const int n4=(q0+QB)/4;
    for(int i=16*t_start+tid;i<n4;i+=NW*64){ f32x4_t v=*(const f32x4_t*)(Fbh+4*i); v=v*(-1.4426950408889634f); *(__attribute__((address_space(3))) f32x4_t*)(fk+4*i)=v; } }
  float fq2=Fbh[q0+wid*QBLK+r32]*1.4426950408889634f; asm volatile("":"+v"(fq2));
  const bf16*Qw=Q+(rowbase+q0+wid*QBLK)*DM+h*D;
  const bf16*Kh=K+(rowbase+(long)t_start*KVBLK)*DM+h*D,*Vh=V+(rowbase+(long)t_start*KVBLK)*DM+h*D;
  const lds_cptr shm3=(lds_cptr)shm;
  const unsigned lds0=(unsigned)(uintptr_t)shm;
  float*wsf=(float*)(shm+LDS_WS)+wid*64;
  const bf16*ksrc=Kh+(long)lane*DM+wid*8;
  const bf16*vsrc=Vh+(long)(16*(wid&3)+(lane>>2))*DM+(wid>>2)*32+(lane&3)*8;
  const unsigned kdst=lds0+LDS_K+wid*1024, vdst=lds0+LDS_V+wid*1024;
  #define DMA_K(t,slot) glds16(ksrc+(long)(t)*KVBLK*DM,(unsigned)__builtin_amdgcn_readfirstlane(kdst+(slot)))
  #define DMA_V(t,slot) glds16(vsrc+(long)(t)*KVBLK*DM,(unsigned)__builtin_amdgcn_readfirstlane(vdst+(slot)))
  const int vb0=(int)(lds0+LDS_V)+((lane>>4)&1)*32+(lane&3)*8+(4*hi+((lane&15)>>2))*64;
  const char*Kbase=shm+LDS_K; bf16x8 kf[8];
  const lds_cptr kp0=shm3+LDS_K+hi*1024+r32*16; const lds_cptr vp0=shm3+LDS_V+((lane>>4)&1)*32+(lane&3)*8+(4*hi+((lane&15)>>2))*64;
  const int NT=NTF-t_start;
  DMA_K(0,0);DMA_V(0,0);DMA_K(1,SLOTB);
  bf16x8 qr[4];
  #pragma unroll
  for(int d0=0;d0<4;++d0)qr[d0]=*reinterpret_cast<const bf16x8*>(&Qw[(long)r32*DM+d0*16+hi*8]);
  float mhat=0.f,l_reg=0.f;f32x16 o[2];o[0]=f32x16{};o[1]=f32x16{};
  const __attribute__((address_space(3))) float*fkl=(const __attribute__((address_space(3))) float*)(shm3+LDS_FK)+64*t_start+4*hi;
  #define INITC(C0,C1,t) do{ const float nsc_=fq2-mhat; typedef float f32x4_t __attribute__((ext_vector_type(4))); const __attribute__((address_space(3))) float*kb_=fkl+64*(t); \
    _Pragma("unroll") for(int g_=0;g_<4;++g_){ const f32x4_t a_=*(const __attribute__((address_space(3))) f32x4_t*)(kb_+8*g_), b_=*(const __attribute__((address_space(3))) f32x4_t*)(kb_+32+8*g_); \
      _Pragma("unroll") for(int e_=0;e_<4;++e_){ C0[4*g_+e_]=nsc_+a_[e_]; C1[4*g_+e_]=nsc_+b_[e_]; } } }while(0)
  const int qrel=wid*QBLK+r32;
  #define CMASK(P0,P1,t) do{int jb_=(t)-(NT-4); if(jb_>=0)cmask(P0,P1,jb_,qrel,hi);}while(0)
  bool resc=false;
  #define START(P0,P1) do{ const float rm=rowmax(P0,P1); resc=false; \
    { const float dl=rm; mhat=fadd_s(mhat,dl); \
      _Pragma("unroll") for(int r=0;r<16;++r){P0[r]=fsub_s(P0[r],dl);P1[r]=fsub_s(P1[r],dl);} \
      } \
    _Pragma("unroll") for(int r=0;r<16;++r)P0[r]=__builtin_amdgcn_exp2f(P0[r]); }while(0)
  #define RESC() do{ if(resc){ asm volatile("s_waitcnt lgkmcnt(0)":::"memory"); \
      _Pragma("unroll") for(int d_=0;d_<2;++d_) _Pragma("unroll") for(int r=0;r<16;++r)o[d_][r]*=wsf[crow(r,hi)]; } }while(0)
  f32x16 pA0,pA1,pB0,pB1;
  int sl_prev=0,sl_cur=0,sl_next=SLOTB;
  #define ROT() do{sl_prev=sl_cur;sl_cur=sl_next;sl_next=(sl_next==(NSLOT-1)*SLOTB)?0:sl_next+SLOTB;}while(0)
  DMA_K(2,2*SLOTB);
  WAIT_BAR(3);
  INITC(pA0,pA1,0); qkt(pA0,pA1,Kbase,qr,r32,hi);asm volatile("s_nop 15\n\ts_nop 7":"+v"(pA0),"+v"(pA1));CMASK(pA0,pA1,0);
  START(pA0,pA1);
  _Pragma("unroll") for(int r=0;r<16;++r)pA1[r]=__builtin_amdgcn_exp2f(pA1[r]);
  WAIT_BAR(0);
  DMA_K(3,0);DMA_V(1,SLOTB);
  ROT();
  kload8(kf,kp0+sl_cur);
  WAIT_BAR(2);
  s16x4 vlo[8],vhi[8]; u32x4 pw0,pw1,pw2,pw3;
  #define PKW(P,B) cvtpk_s(P[B],P[B+1])
  #define PAF(k) __builtin_bit_cast(bf16x8,pw##k)
  #define VFR(i) (bf16x8){vlo[i][0],vlo[i][1],vlo[i][2],vlo[i][3],vhi[i][0],vhi[i][1],vhi[i][2],vhi[i][3]}
  #define PIN(x) asm volatile("":"+v"(x))
  #define MX3(a,b,c) __builtin_fmaxf(__builtin_fmaxf((a),(b)),(c))
  #define GAPA(MF,A0,A1,A2,A3,W0,W1,PW) do{ MF; sacc+=A0; sacc+=A1; sacc+=A2; sacc+=A3; PIN(sacc); W0; W1; PIN(PW); SBAR(); }while(0)
  #define EX(v) __builtin_amdgcn_exp2f(v)
  #define GAPB(MF,X,B) do{ MF; X[B]=EX(X[B]); X[B+1]=EX(X[B+1]); X[B+2]=EX(X[B+2]); X[B+3]=EX(X[B+3]); PIN(X); SBAR(); }while(0)
  #define VRD(i) do{ vlo[i]=vtr(vp_+(((i)>>2)*4096+((i)&3)*1024)); vhi[i]=vtr(vp_+(((i)>>2)*4096+((i)&3)*1024+512)); }while(0)
  #define KRD(G,j) do{ if(G){ kload2(kf,kp0+sl_next,j); SBAR(); } }while(0)
  #define STEP(C0,C1,P0,P1,t,GK,GV,GL) do{ SBAR(); INITC(C0,C1,t); PIN(C0); PIN(C1); SBAR(); \
    const lds_cptr vp_=vp0+sl_prev; \
    VRD(0); SBAR(); float sacc=(P0[0]+P0[1]); \
    GAPA(C0=__builtin_amdgcn_mfma_f32_32x32x16_bf16(kf[0],qr[0],C0,0,0,0), P0[2],P0[3],P0[4],P0[5],     pw0[0]=PKW(P0,0), pw0[1]=PKW(P0,2), pw0); \
    VRD(4); SBAR(); GAPA(C1=__builtin_amdgcn_mfma_f32_32x32x16_bf16(kf[1],qr[0],C1,0,0,0), P0[6],P0[7],P0[8],P0[9],     pw0[2]=PKW(P0,4), pw0[3]=PKW(P0,6), pw0); \
    VRD(1); SBAR(); GAPA(C0=__builtin_amdgcn_mfma_f32_32x32x16_bf16(kf[2],qr[1],C0,0,0,0),   P0[10],P0[11],P0[12],P0[13], pw1[0]=PKW(P0,8), pw1[1]=PKW(P0,10), pw1); \
    VRD(5); SBAR(); GAPA(C1=__builtin_amdgcn_mfma_f32_32x32x16_bf16(kf[3],qr[1],C1,0,0,0),   P0[14],P0[15],P1[0],P1[1],   pw1[2]=PKW(P0,12),pw1[3]=PKW(P0,14), pw1); \
    VRD(2); SBAR(); GAPA(C0=__builtin_amdgcn_mfma_f32_32x32x16_bf16(kf[4],qr[2],C0,0,0,0),   P1[2],P1[3],P1[4],P1[5],     pw2[0]=PKW(P1,0), pw2[1]=PKW(P1,2), pw2); \
    VRD(6); SBAR(); GAPA(C1=__builtin_amdgcn_mfma_f32_32x32x16_bf16(kf[5],qr[2],C1,0,0,0),   P1[6],P1[7],P1[8],P1[9],     pw2[2]=PKW(P1,4), pw2[3]=PKW(P1,6), pw2); \
    VRD(3); SBAR(); GAPA(C0=__builtin_amdgcn_mfma_f32_32x32x16_bf16(kf[6],qr[3],C0,0,0,0),   P1[10],P1[11],P1[12],P1[13], pw3[0]=PKW(P1,8), pw3[1]=PKW(P1,10), pw3); \
    VRD(7); SBAR(); GAPA(C1=__builtin_amdgcn_mfma_f32_32x32x16_bf16(kf[7],qr[3],C1,0,0,0),   P1[14],P1[15],0.f,0.f,       pw3[2]=PKW(P1,12),pw3[3]=PKW(P1,14), pw3); \
    l_reg+=sacc; \
    if(GK){DMA_K((t)+3,sl_cur);} if(GV){DMA_V((t)+1,sl_next);} \
    CMASK(C0,C1,t); \
    { float a=MX3(C0[0],C0[1],C1[0]),b=MX3(C0[2],C0[3],C1[1]); a=MX3(a,C1[2],C1[3]); \
      _Pragma("unroll") for(int r=4;r<16;r+=4){a=MX3(a,C0[r],C0[r+1]);b=MX3(b,C0[r+2],C0[r+3]);a=MX3(a,C1[r],C1[r+1]);b=MX3(b,C1[r+2],C1[r+3]);} \
      float rm=__builtin_fmaxf(a,b); { auto rr=__builtin_amdgcn_permlane32_swap(__float_as_uint(rm),__float_as_uint(rm),false,false); rm=__builtin_fmaxf(__uint_as_float(rr[0]),__uint_as_float(rr[1])); } \
      resc=false; \
      if(__builtin_expect(__any(rm>(float)THRL),0)){ const float dl=__builtin_fmaxf(rm,0.f); mhat+=dl; \
        _Pragma("unroll") for(int r=0;r<16;++r){C0[r]-=dl;C1[r]-=dl;} \
        const float f=__builtin_amdgcn_exp2f(-dl); l_reg*=f; if(hi==0)wsf[r32]=f; resc=true; } } \
    SBAR(); \
    GAPB(o[0]=__builtin_amdgcn_mfma_f32_32x32x16_bf16(PAF(0),VFR(0),o[0],0,0,0), C0,0); \
    GAPB(o[1]=__builtin_amdgcn_mfma_f32_32x32x16_bf16(PAF(0),VFR(4),o[1],0,0,0), C0,4); \
    KRD(GL,0); GAPB(o[0]=__builtin_amdgcn_mfma_f32_32x32x16_bf16(PAF(1),VFR(1),o[0],0,0,0), C0,8); \
    KRD(GL,1); GAPB(o[1]=__builtin_amdgcn_mfma_f32_32x32x16_bf16(PAF(1),VFR(5),o[1],0,0,0), C0,12); \
    KRD(GL,2); GAPB(o[0]=__builtin_amdgcn_mfma_f32_32x32x16_bf16(PAF(2),VFR(2),o[0],0,0,0), C1,0); \
    KRD(GL,3); GAPB(o[1]=__builtin_amdgcn_mfma_f32_32x32x16_bf16(PAF(2),VFR(6),o[1],0,0,0), C1,4); \
    GAPB(o[0]=__builtin_amdgcn_mfma_f32_32x32x16_bf16(PAF(3),VFR(3),o[0],0,0,0), C1,8); \
    GAPB(o[1]=__builtin_amdgcn_mfma_f32_32x32x16_bf16(PAF(3),VFR(7),o[1],0,0,0), C1,12); \
    }while(0)
  int t=1;
  #undef CMASK
  #define CMASK(P0,P1,t) do{}while(0)
  for(;t+5<NT;t+=2){
    STEP(pB0,pB1,pA0,pA1,t,true,true,true);     WAIT_BAR(2); RESC(); ROT();
    STEP(pA0,pA1,pB0,pB1,t+1,true,true,true);   WAIT_BAR(2); RESC(); ROT();
  }
  #undef CMASK
  #define CMASK(P0,P1,t) do{int jb_=(t)-(NT-4); if(jb_>=0)cmask(P0,P1,jb_,qrel,hi);}while(0)
  #define ENDW(tt) do{ if((tt)+3<NT){WAIT_BAR(2);} else if((tt)+2<NT){WAIT_BAR(1);} else {WAIT_BAR(0);} }while(0)
  for(;t+1<NT;t+=2){
    STEP(pB0,pB1,pA0,pA1,t,(t+3<NT),(t+1<NT),(t+1<NT));       ENDW(t);   RESC(); ROT();
    STEP(pA0,pA1,pB0,pB1,t+1,(t+4<NT),(t+2<NT),(t+2<NT));     ENDW(t+1); RESC(); ROT();
  }
  STEP(pB0,pB1,pA0,pA1,NT-1,false,false,false); RESC();
  { float sacc=pB0[0]+pB0[1]; _Pragma("unroll") for(int r=2;r<16;++r)sacc+=pB0[r]; _Pragma("unroll") for(int r=0;r<16;++r)sacc+=pB1[r]; l_reg+=sacc;
    pw0=(u32x4){PKW(pB0,0),PKW(pB0,2),PKW(pB0,4),PKW(pB0,6)};pw1=(u32x4){PKW(pB0,8),PKW(pB0,10),PKW(pB0,12),PKW(pB0,14)};pw2=(u32x4){PKW(pB1,0),PKW(pB1,2),PKW(pB1,4),PKW(pB1,6)};pw3=(u32x4){PKW(pB1,8),PKW(pB1,10),PKW(pB1,12),PKW(pB1,14)};
    SBAR(); pv(o,vb0+sl_cur,PAF(0),PAF(1),PAF(2),PAF(3)); }
  #undef PKW
  #undef PAF
  #undef VFR
  #undef PIN
  #undef MX3
  #undef GAPA
  #undef GAPB
  #undef EX
  #undef VRD
  #undef KRD
  #undef STEP
  #undef ENDW
  {auto rr=__builtin_amdgcn_permlane32_swap(__float_as_uint(l_reg),__float_as_uint(l_reg),false,false);l_reg=__uint_as_float(rr[0])+__uint_as_float(rr[1]);}
  if(hi==0)wsf[32+r32]=l_reg;asm volatile("s_waitcnt lgkmcnt(0)":::"memory");
  float rli[16];
  #pragma unroll
  for(int r=0;r<16;++r)rli[r]=__builtin_amdgcn_rcpf(wsf[32+crow(r,hi)]);
  bf16*Ow=O+(rowbase+q0+wid*QBLK)*DM+h*D;
  { bf16*stg=(bf16*)(shm+LDS_OST)+wid*2048;
    #pragma unroll
    for(int r=0;r<16;++r){const int orow=crow(r,hi);
      #pragma unroll
      for(int d0=0;d0<2;++d0)stg[orow*64+d0*32+r32]=__float2bfloat16(o[d0][r]*rli[r]);}
    asm volatile("s_waitcnt lgkmcnt(0)":::"memory");
    #pragma unroll
    for(int i=0;i<4;++i){const int row=i*8+(lane>>3),ch=lane&7; const u32x4 v=*(const u32x4*)(stg+row*64+ch*8); ATTN_STORE16(Ow+(long)row*DM+ch*8,v);} }
  asm volatile("s_waitcnt lgkmcnt(0)\n\ts_barrier":::"memory");
  #undef DMA_K
  #undef DMA_V
  #undef INITC
  #undef CMASK
  #undef START
  #undef RESC
  #undef ROT
}
constexpr int ATTN_LDS_BYTES=LDS_BYTES;
struct AttnTensors { const bf16* Q; const bf16* K; const bf16* V; bf16* O; const float* F; const float* NRM; };
struct AttnUnit { int bh; int qb; };
struct StaticOrder {
  int vcu;
  __device__ __forceinline__ explicit StaticOrder(int grid,int block):vcu((block%8)*(grid/8)+block/8){}
  __device__ __forceinline__ bool next(int i,AttnUnit&u)const{ if(i>=4)return false; const int s=vcu&7; u.bh=vcu>>3; u.qb=(i==0)?s:(i==1)?15-s:(i==2)?16+s:31-s; return true; }
  __device__ __forceinline__ void a_ready(const AttnUnit&)const{}
  __device__ __forceinline__ void done(const AttnUnit&)const{}
};
template<int THRL=8> __device__ __forceinline__ void attn_phase(char*lds,const AttnTensors&T,unsigned*qctr,volatile __attribute__((address_space(3))) unsigned*qword,int wid_in){
  const int lane0=(int)__builtin_amdgcn_mbcnt_hi(~0u,__builtin_amdgcn_mbcnt_lo(~0u,0u));
  for(;;){
    if(wid_in==0&&lane0==0){ const unsigned n=__hip_atomic_fetch_add(qctr,1u,__ATOMIC_RELAXED,__HIP_MEMORY_SCOPE_AGENT); *qword=n; }
    asm volatile("s_waitcnt vmcnt(0) lgkmcnt(0)\n\ts_barrier":::"memory");
    const int n=__builtin_amdgcn_readfirstlane((int)*qword);
    if(n>=BATCH*NHEAD*NQB)break;
    const int bh=n%(BATCH*NHEAD),qb=NQB-1-n/(BATCH*NHEAD);
    attn_unit<THRL>(bh/NHEAD,bh%NHEAD,qb,T.Q,T.K,T.V,T.O,T.F,T.NRM,lds,wid_in);
  }
}
#undef SBAR
#undef WAIT_BAR
}
#define GAS __attribute__((address_space(1)))
#define LAS __attribute__((address_space(3)))
typedef unsigned short bf16;
typedef unsigned v4u __attribute__((ext_vector_type(4)));
typedef float f32x4 __attribute__((ext_vector_type(4)));
typedef short bf16x8 __attribute__((ext_vector_type(8)));
typedef GAS unsigned gu32;
typedef GAS unsigned long long gu64;
#define RLX_AGENT __ATOMIC_RELAXED, __HIP_MEMORY_SCOPE_AGENT
#define LDS_WAIT() asm volatile("s_waitcnt lgkmcnt(0)" ::: "memory")
#define VM_WAIT() asm volatile("s_waitcnt vmcnt(0)" ::: "memory")
__device__ __forceinline__ unsigned long long rt() { return __builtin_amdgcn_s_memrealtime(); }
__device__ __forceinline__ unsigned f2bf(float f) { unsigned u = __builtin_bit_cast(unsigned, f); return (u + 0x7fffu + ((u >> 16) & 1u)) >> 16; }
__device__ __forceinline__ unsigned pk2(float lo, float hi) { return f2bf(lo) | (f2bf(hi) << 16); }

#define XB_TMO      128
#define XB_XCNT(j)  (256  + 64 * (j))
#define XB_XSUB(j)  (1280 + 64 * (j))
#define XB_XGEN(j)  (2304 + 64 * (j))
#define XB_TOP      3328
#define XB_TOPGEN   3392
#define XCD_BAR_WORDS 3456
#define XB_SPIN_CAP (1u << 18)

__device__ __forceinline__ unsigned xb_ld(unsigned* p)              { return __hip_atomic_load(p, __ATOMIC_RELAXED, __HIP_MEMORY_SCOPE_AGENT); }
__device__ __forceinline__ unsigned xb_add(unsigned* p, unsigned v) { return __hip_atomic_fetch_add(p, v, __ATOMIC_RELAXED, __HIP_MEMORY_SCOPE_AGENT); }
__device__ __forceinline__ unsigned xb_xcc_id() { return (unsigned)__builtin_amdgcn_s_getreg((3 << 11) | 20) & 0xFu; }
#define XB_SPIN(cond, bar) do { unsigned _sp = 0; while (cond) { __builtin_amdgcn_s_sleep(1); \
    if ((++_sp & 255u) == 0u) { if (xb_ld(&(bar)[XB_TMO])) break; if (_sp > XB_SPIN_CAP) { atomicAdd(&(bar)[XB_TMO], 1u); break; } } } } while (0)

struct XcdBarrier {
    unsigned* bar; unsigned x; int wv;
    volatile LAS unsigned* st;
};

__device__ __forceinline__ bool xb_t0(int wv) { return wv == 0 && __builtin_amdgcn_mbcnt_hi(~0u, __builtin_amdgcn_mbcnt_lo(~0u, 0u)) == 0u; }
__device__ __forceinline__ XcdBarrier xcd_barrier_post(unsigned* bar, volatile LAS unsigned* st, int wv) {
    XcdBarrier b; b.bar = bar; b.x = xb_xcc_id(); b.st = st; b.wv = wv;
    if (xb_t0(wv)) (void)xb_add(&bar[XB_XCNT(b.x)], 1u);
    return b;
}
__device__ __forceinline__ void xcd_barrier_complete(unsigned* bar, unsigned x, unsigned& nloc, unsigned& nx) {
    const unsigned G = gridDim.x * gridDim.y * gridDim.z;
    unsigned sum, cnt, mine, sp = 0u;
    for (;;) {
        sum = 0u; cnt = 0u; mine = 0u;
#pragma unroll
        for (unsigned j = 0; j < 16; ++j) { const unsigned c = xb_ld(&bar[XB_XCNT(j)]); sum += c; cnt += (c > 0u) ? 1u : 0u; mine = (j == x) ? c : mine; }
        if (sum == G) break;
        __builtin_amdgcn_s_sleep(1);
        if ((++sp & 255u) == 0u) { if (xb_ld(&bar[XB_TMO])) break; if (sp > XB_SPIN_CAP) { atomicAdd(&bar[XB_TMO], 1u); break; } }
    }
    nloc = mine > 0u ? mine : 1u; nx = cnt > 0u ? cnt : 1u;
}

__device__ __forceinline__ void xcd_barrier(const XcdBarrier& b) {
    asm volatile("s_waitcnt vmcnt(0)" ::: "memory");
    __syncthreads();
    if (xb_t0(b.wv)) {
        unsigned* bar = b.bar;
        __builtin_amdgcn_s_waitcnt(0);
        unsigned nloc = b.st[0], nx = b.st[1];
        if (nloc == 0u) { xcd_barrier_complete(bar, b.x, nloc, nx); b.st[0] = nloc; b.st[1] = nx; }
        const unsigned old = xb_add(&bar[XB_XSUB(b.x)], 1u);
        const unsigned gen = old / nloc;
        if (old + 1u == (gen + 1u) * nloc) {
            __builtin_amdgcn_fence(__ATOMIC_RELEASE, "agent");
            asm volatile("s_waitcnt vmcnt(0)" ::: "memory");
            const unsigned og = xb_add(&bar[XB_TOP], 1u);
            const unsigned tg = og / nx;
            if (og + 1u == (tg + 1u) * nx) xb_add(&bar[XB_TOPGEN], 1u);
            else XB_SPIN(xb_ld(&bar[XB_TOPGEN]) == tg, bar);
            __builtin_amdgcn_fence(__ATOMIC_ACQUIRE, "agent");
            xb_add(&bar[XB_XGEN(b.x)], 1u);
            asm volatile("s_waitcnt vmcnt(0)" ::: "memory");
        } else {
            XB_SPIN(xb_ld(&bar[XB_XGEN(b.x)]) == gen, bar);
            __builtin_amdgcn_fence(__ATOMIC_ACQUIRE, "agent");
            asm volatile("s_waitcnt vmcnt(0)" ::: "memory");
        }
    }
    __syncthreads();
}

constexpr int NWAVES = 8;
constexpr int RING_OFF = 0, RING_BYTES = 131072;
constexpr int LDSCTL_OFF = RING_BYTES, MISC_OFF = LDSCTL_OFF + 320;
constexpr int LDS_BYTES = 147456;
constexpr int N_PHASES = 8;

struct Frame {
    LAS unsigned char* lds;
    volatile LAS unsigned* MISC;
    gu32* ctl;
    int tid, lane, wave, vcu, G;
};
__device__ __forceinline__ float wave_sum(float v) {
#pragma unroll
    for (int o = 1; o < 64; o <<= 1) v += __shfl_xor(v, o);
    return v;
}
struct Args { const float* in[20]; float* out; unsigned char* ws; int ph_lo, ph_hi, li, pad; };

__device__ __forceinline__ void p0_transpose_item(const float* W, int ld, int nblk, const float* glo, const float* ghi, int K, bf16* WT, int item, int lane) {
    const int kb = item / nblk, nb = item % nblk, k0 = 64 * kb + 16 * (lane >> 4), n0 = 64 * nb + 4 * (lane & 15);
    f32x4 w[16];
#pragma unroll
    for (int j = 0; j < 16; ++j) w[j] = *(const GAS f32x4*)(W + (size_t)(k0 + j) * ld + n0);
    if (glo) { const float* gp = (k0 < K / 2) ? glo + k0 : ghi + (k0 - K / 2);
#pragma unroll
        for (int q = 0; q < 4; ++q) { const f32x4 g4 = *(const GAS f32x4*)(gp + 4 * q);
#pragma unroll
            for (int e = 0; e < 4; ++e) w[4 * q + e] = w[4 * q + e] * g4[e]; } }
#pragma unroll
    for (int c = 0; c < 4; ++c) { v4u o0, o1;
        o0.x = pk2(w[0][c], w[1][c]); o0.y = pk2(w[2][c], w[3][c]); o0.z = pk2(w[4][c], w[5][c]); o0.w = pk2(w[6][c], w[7][c]);
        o1.x = pk2(w[8][c], w[9][c]); o1.y = pk2(w[10][c], w[11][c]); o1.z = pk2(w[12][c], w[13][c]); o1.w = pk2(w[14][c], w[15][c]);
        bf16* dp = WT + (size_t)(n0 + c) * K + k0; *(GAS v4u*)dp = o0; *(GAS v4u*)(dp + 8) = o1; }
}
__device__ __forceinline__ float log_sigmoid(float z) { return fminf(z, 0.f) - log1pf(expf(-fabsf(z))); }

__device__ __forceinline__ void p0_prologue(Frame& F, const Args& a) {
    unsigned char* ws = a.ws;
    const float* x = a.in[0]; const float* g1 = a.in[1]; const float* w_in = a.in[2]; const float* bfv = a.in[10];
    const float* gn_l = a.in[11]; const float* gn_f = a.in[12]; const float* w_out = a.in[13]; const float* g2 = a.in[14];
    const float* w_q = a.in[15]; const float* sk = a.in[16]; const float* pu = a.in[17]; const float* pv = a.in[18];
    bf16* win_t = (bf16*)(ws + WS_WIN); bf16* wout_t = (bf16*)(ws + WS_WOUT); bf16* wq_t = (bf16*)(ws + WS_WQ); bf16* skb = (bf16*)(ws + WS_SKB);
    float* logf = (float*)(ws + WS_LOGF); bf16* h = (bf16*)(ws + WS_H);
    const int gw = F.vcu * NWAVES + F.wave, NGW = F.G * NWAVES, lane = F.lane;
    constexpr int I_IN = (DMODEL / 64) * (NG1 / 64), I_OUT = (DMODEL / 64) * (DMODEL / 64), I_Q = (DMODEL / 64) * (QPW / 64);
    constexpr int I_SK = PH * 2 * NKEY * PHALF / 512, I_WAX = 8 * 2 * 2 * 4;
    constexpr int E0 = I_IN, E1 = E0 + I_OUT, E2 = E1 + I_Q, E3 = E2, E4 = E3 + I_SK, E5 = E4, E6 = E5 + I_WAX;
    for (int it = gw; it < E6; it += NGW) {
        if (it < E0) { p0_transpose_item(w_in, INC, NG1 / 64, nullptr, nullptr, DMODEL, win_t, it, lane); continue; }
        if (it < E1) { p0_transpose_item(w_out, DMODEL, DMODEL / 64, gn_l, gn_f, DMODEL, wout_t, it - E0, lane); continue; }
        if (it < E2) { p0_transpose_item(w_q, QPW, QPW / 64, g2, g2 + DMODEL / 2, DMODEL, wq_t, it - E1, lane); continue; }
        if (it < E4) { const size_t i = (size_t)(it - E3) * 512 + lane * 8; const f32x4 s0 = *(const GAS f32x4*)(sk + i), s1 = *(const GAS f32x4*)(sk + i + 4);
            v4u o; o.x = pk2(s0[0], s0[1]); o.y = pk2(s0[2], s0[3]); o.z = pk2(s1[0], s1[1]); o.w = pk2(s1[2], s1[3]);
            { const size_t hp = i >> 14; const int key = (int)(i >> 7) & 127, c8 = (int)(i >> 3) & 15; *(GAS v4u*)(skb + hp * 16384 + ((size_t)((((key >> 5) * 2 + (c8 & 1)) * 8 + (c8 >> 1)) * 32 + (key & 31))) * 8) = o; } continue; }
        { const int f = it - E5, ks = f & 3, n = (f >> 2) & 1, mat = (f >> 3) & 1, hh = f >> 4; const float* wsrc = mat ? a.in[7] : a.in[5];
          const size_t o = ((size_t)(hh * 64 + 16 * ks + 8 * (lane >> 5))) * 64 + 32 * n + (lane & 31);
          v4u pw; pw.x = pk2(wsrc[o], wsrc[o + 64]); pw.y = pk2(wsrc[o + 128], wsrc[o + 192]); pw.z = pk2(wsrc[o + 256], wsrc[o + 320]); pw.w = pk2(wsrc[o + 384], wsrc[o + 448]);
          *(GAS v4u*)((bf16*)(ws + WS_WAX) + (size_t)f * 512 + lane * 8) = pw; }
    }
    { f32x4 gg[4];
#pragma unroll
      for (int j = 0; j < 4; ++j) gg[j] = *(const GAS f32x4*)(g2 + 16 * lane + 4 * j);
      unsigned char* u4 = ws + WS_U8; unsigned char* v4 = ws + WS_V8; float* su = (float*)(ws + WS_SU);
      for (int e = gw; e < NEXP; e += NGW) {
        const GAS f32x4* ur = (const GAS f32x4*)(pu + (size_t)e * DMODEL + 16 * lane); const GAS f32x4* vr = (const GAS f32x4*)(pv + (size_t)e * DMODEL + 16 * lane);
        f32x4 uu[4], vv[4]; float mu = 0.f, mv = 0.f;
#pragma unroll
        for (int j = 0; j < 4; ++j) { uu[j] = ur[j] * gg[j]; vv[j] = vr[j];
#pragma unroll
            for (int c = 0; c < 4; ++c) { mu = fmaxf(mu, fabsf(uu[j][c])); mv = fmaxf(mv, fabsf(vv[j][c])); } }
#pragma unroll
        for (int o = 1; o < 64; o <<= 1) { mu = fmaxf(mu, __shfl_xor(mu, o)); mv = fmaxf(mv, __shfl_xor(mv, o)); }
        const float scu = mu > 0.f ? mu * (1.f / 6.f) : 1.f, scv = mv > 0.f ? mv * (1.f / 6.f) : 1.f, iu = 1.f / scu, iv = 1.f / scv;
        unsigned qu0 = 0u, qu1 = 0u, qv0 = 0u, qv1 = 0u;
#define P0_Q4(Q, X, INV, B0, B1) do { Q = __builtin_amdgcn_cvt_scalef32_pk_fp4_f32(Q, X[0] * INV, X[1] * INV, 1.0f, B0); Q = __builtin_amdgcn_cvt_scalef32_pk_fp4_f32(Q, X[2] * INV, X[3] * INV, 1.0f, B1); } while (0)
        P0_Q4(qu0, uu[0], iu, 0, 1); P0_Q4(qu0, uu[1], iu, 2, 3); P0_Q4(qu1, uu[2], iu, 0, 1); P0_Q4(qu1, uu[3], iu, 2, 3);
        P0_Q4(qv0, vv[0], iv, 0, 1); P0_Q4(qv0, vv[1], iv, 2, 3); P0_Q4(qv1, vv[2], iv, 0, 1); P0_Q4(qv1, vv[3], iv, 2, 3);
#undef P0_Q4
        *(GAS unsigned long long*)(u4 + (size_t)e * 512 + 8 * lane) = (unsigned long long)qu0 | ((unsigned long long)qu1 << 32);
        { unsigned char* vrow = v4 + (size_t)e * 512 + 2 * (lane >> 2);
          *(GAS unsigned short*)(vrow + 32 * (4 * (lane & 3) + 0)) = (unsigned short)(qv0 & 0xffffu); *(GAS unsigned short*)(vrow + 32 * (4 * (lane & 3) + 1)) = (unsigned short)(qv0 >> 16);
          *(GAS unsigned short*)(vrow + 32 * (4 * (lane & 3) + 2)) = (unsigned short)(qv1 & 0xffffu); *(GAS unsigned short*)(vrow + 32 * (4 * (lane & 3) + 3)) = (unsigned short)(qv1 >> 16); }
        if (lane == 0) { su[2 * e] = scu; su[2 * e + 1] = scv; }
      } }
    { f32x4 gg[4];
#pragma unroll
      for (int j = 0; j < 4; ++j) gg[j] = *(const GAS f32x4*)(g1 + 256 * j + 4 * lane);
      float fw[4][4][8];
#pragma unroll
      for (int j = 0; j < 4; ++j)
#pragma unroll
          for (int c = 0; c < 4; ++c) { const int k = 256 * j + 4 * lane + c; const GAS f32x4* wr = (const GAS f32x4*)(w_in + (size_t)k * INC + NG1); const f32x4 w0 = wr[0], w1 = wr[1];
#pragma unroll
              for (int e = 0; e < 4; ++e) { fw[j][c][e] = w0[e]; fw[j][c][4 + e] = w1[e]; } }
      for (int t0 = gw; t0 < T; t0 += 2 * NGW) {
        const int t1 = (t0 + NGW < T) ? t0 + NGW : t0;
        const GAS f32x4* xr0 = (const GAS f32x4*)(x + (size_t)t0 * DMODEL) + lane; const GAS f32x4* xr1 = (const GAS f32x4*)(x + (size_t)t1 * DMODEL) + lane;
        f32x4 va[4], vb[4]; float sa = 0.f, sb = 0.f;
#pragma unroll
        for (int j = 0; j < 4; ++j) { va[j] = xr0[64 * j]; vb[j] = xr1[64 * j]; }
#pragma unroll
        for (int j = 0; j < 4; ++j) { sa += (va[j][0] * va[j][0] + va[j][1] * va[j][1]) + (va[j][2] * va[j][2] + va[j][3] * va[j][3]); sb += (vb[j][0] * vb[j][0] + vb[j][1] * vb[j][1]) + (vb[j][2] * vb[j][2] + vb[j][3] * vb[j][3]); }
        const float ra = rsqrtf(wave_sum(sa) * (1.f / DMODEL) + RMS_EPS), rb = rsqrtf(wave_sum(sb) * (1.f / DMODEL) + RMS_EPS);
        GAS unsigned long long* ha = (GAS unsigned long long*)(h + (size_t)t0 * DMODEL) + lane; GAS unsigned long long* hb = (GAS unsigned long long*)(h + (size_t)t1 * DMODEL) + lane;
#pragma unroll
        for (int j = 0; j < 4; ++j) { va[j] = va[j] * ra * gg[j]; vb[j] = vb[j] * rb * gg[j];
            ha[64 * j] = (unsigned long long)pk2(va[j][0], va[j][1]) | ((unsigned long long)pk2(va[j][2], va[j][3]) << 32);
            hb[64 * j] = (unsigned long long)pk2(vb[j][0], vb[j][1]) | ((unsigned long long)pk2(vb[j][2], vb[j][3]) << 32); }
        float fa[8], fb[8];
#pragma unroll
        for (int hh = 0; hh < 8; ++hh) { fa[hh] = 0.f; fb[hh] = 0.f; }
#pragma unroll
        for (int j = 0; j < 4; ++j)
#pragma unroll
            for (int c = 0; c < 4; ++c) {
#pragma unroll
                for (int hh = 0; hh < 8; ++hh) { fa[hh] += va[j][c] * fw[j][c][hh]; fb[hh] += vb[j][c] * fw[j][c][hh]; } }
        const bool b0 = lane & 1, b1 = lane & 2, b2 = lane & 4;
        float ya[4], yb[4], za[2], zb[2];
#pragma unroll
        for (int j = 0; j < 4; ++j) { ya[j] = (b0 ? fa[j + 4] : fa[j]) + __shfl_xor(b0 ? fa[j] : fa[j + 4], 1); yb[j] = (b0 ? fb[j + 4] : fb[j]) + __shfl_xor(b0 ? fb[j] : fb[j + 4], 1); }
#pragma unroll
        for (int j = 0; j < 2; ++j) { za[j] = (b1 ? ya[j + 2] : ya[j]) + __shfl_xor(b1 ? ya[j] : ya[j + 2], 2); zb[j] = (b1 ? yb[j + 2] : yb[j]) + __shfl_xor(b1 ? yb[j] : yb[j + 2], 2); }
        float resa = (b2 ? za[1] : za[0]) + __shfl_xor(b2 ? za[0] : za[1], 4), resb = (b2 ? zb[1] : zb[0]) + __shfl_xor(b2 ? zb[0] : zb[1], 4);
#pragma unroll
        for (int o = 8; o < 64; o <<= 1) { resa += __shfl_xor(resa, o); resb += __shfl_xor(resb, o); }
        if (lane < 8) { const int hd = 4 * (lane & 1) + (lane & 2) + ((lane >> 2) & 1); logf[(size_t)t0 * 8 + hd] = log_sigmoid(resa + bfv[hd]); logf[(size_t)t1 * 8 + hd] = log_sigmoid(resb + bfv[hd]); }
      } }
}

__device__ __forceinline__ void fcum_unit(Frame& F, int bh, const float* logf, float* fcum) {
    const int b = bh / NHEADS, hh = bh % NHEADS, s0 = F.tid * 16;
    float v[16]; float loc = 0.f;
#pragma unroll
    for (int i = 0; i < 16; ++i) { v[i] = logf[((size_t)b * SEQ + s0 + i) * 8 + hh]; loc += v[i]; }
    float inc = loc;
#pragma unroll
    for (int o = 1; o < 64; o <<= 1) { const float n = __shfl_up(inc, o); if (F.lane >= o) inc += n; }
    if (F.lane == 63) F.MISC[16 + F.wave] = __float_as_uint(inc);
    __syncthreads();
    float run = inc - loc;
    for (int w = 0; w < F.wave; ++w) run += __uint_as_float(F.MISC[16 + w]);
#pragma unroll
    for (int i = 0; i < 16; ++i) { run += v[i]; fcum[(size_t)bh * SEQ + s0 + i] = run; }
    __syncthreads();
}


namespace peer {
typedef unsigned u32;
typedef float f32x16 __attribute__((ext_vector_type(16)));
constexpr int TOK = 128;
constexpr int EX_STRIDE = 136, GT_STRIDE = 136;
constexpr int L_EX = 0, L_GT = L_EX + TOK * EX_STRIDE * 2, L_IDX = L_GT + TOK * GT_STRIDE * 2, IDX_STRIDE = 36, L_RST = L_IDX + 512 * IDX_STRIDE, L_BI = L_RST + TOK * 4, BI_WAVE = 4352, L_END = L_BI + 8 * BI_WAVE;
static_assert(L_END <= RING_BYTES && L_GT % 16 == 0 && L_IDX % 16 == 0, "PEER LDS map");
__device__ __forceinline__ u32 ordmap(float f) { const u32 u = __float_as_uint(f); return u ^ ((u32)((int)u >> 31) | 0x80000000u); }
__device__ __forceinline__ float unordmap(u32 k) { const u32 u = (k & 0x80000000u) ? (k ^ 0x80000000u) : ~k; return __uint_as_float(u); }
__device__ __forceinline__ u32 umin_(u32 a, u32 b) { return a < b ? a : b; }
__device__ __forceinline__ u32 umax_(u32 a, u32 b) { return a > b ? a : b; }
template <bool DESC> __device__ __forceinline__ void sort16(u32 (&k)[16]) {
#pragma unroll
    for (int size = 2; size <= 16; size <<= 1)
#pragma unroll
        for (int stride = size >> 1; stride > 0; stride >>= 1)
#pragma unroll
            for (int i = 0; i < 16; ++i) { const int j = i ^ stride;
                if (j > i) { const bool asc = (((i & size) == 0) != DESC); const u32 a = k[i], b = k[j], lo = umin_(a, b), hi = umax_(a, b); k[i] = asc ? lo : hi; k[j] = asc ? hi : lo; } }
}
template <bool DESC> __device__ __forceinline__ void merge16(u32 (&k)[16]) {
#pragma unroll
    for (int stride = 8; stride > 0; stride >>= 1)
#pragma unroll
        for (int i = 0; i < 16; ++i) { const int j = i ^ stride;
            if (j > i) { const u32 a = k[i], b = k[j], lo = umin_(a, b), hi = umax_(a, b); k[i] = DESC ? hi : lo; k[j] = DESC ? lo : hi; } }
}
__host__ __device__ constexpr int ccnt(int a) { return 16 / (a + 1); }
__host__ __device__ constexpr int cbase(int a) { int s = 0; for (int i = 0; i < a; ++i) s += ccnt(i); return s; }
static_assert(cbase(16) == 50, "hyperbola candidate count");
__device__ __forceinline__ int crow16(int r) { return (r & 3) + 8 * (r >> 2); }

__device__ __forceinline__ void route_tile(Frame& F, const bf16* qp, const bf16* skb, const float* sumsq, int t0) {
    int lane = F.lane; asm volatile("" : "+v"(lane));
    const int r32 = lane & 31, hi = lane >> 5, w = F.wave;
    LAS unsigned short* EXL = (LAS unsigned short*)(F.lds + RING_OFF + L_EX);
    LAS unsigned short* GTL = (LAS unsigned short*)(F.lds + RING_OFF + L_GT);
    LAS unsigned char* IDXB = F.lds + RING_OFF + L_IDX + (w * 64 + lane) * IDX_STRIDE;
    LAS float* RST = (LAS float*)(F.lds + RING_OFF + L_RST);
    for (int g = 0; g < 4; ++g) {
        const int tok = 32 * g + r32; const size_t trow = (size_t)(t0 + tok);
        const float rstd2 = rsqrtf(sumsq[trow] * (1.f / DMODEL) + RMS_EPS);
        if (w == 0 && hi == 0) RST[tok] = rstd2;
        u32 s0[16], s1[16];
#pragma unroll
        for (int p = 0; p < 2; ++p) {
            bf16x8 qf[8];
#pragma unroll
            for (int ks = 0; ks < 8; ++ks) qf[ks] = *(const GAS bf16x8*)(qp + ((size_t)((((trow >> 5) * 8 + w) * 2 + p) * 16 + 2 * ks + hi) * 32 + r32) * 8);
            u32 run[16];
#pragma unroll
            for (int nb = 0; nb < 4; ++nb) {
                f32x16 acc = {};
                const bf16* kr = skb + (size_t)(w * 2 + p) * 16384 + ((size_t)((nb * 2 + hi) * 8 * 32 + r32)) * 8;
#pragma unroll
                for (int ks = 0; ks < 8; ++ks) acc = __builtin_amdgcn_mfma_f32_32x32x16_bf16(*(const GAS bf16x8*)(kr + ks * 256), qf[ks], acc, 0, 0, 0);
                asm volatile("" ::: "memory");
                u32 blk[16];
#pragma unroll
                for (int r = 0; r < 16; ++r) blk[r] = (ordmap(acc[r]) & ~0x7Fu) | (u32)(127 - 32 * nb - crow16(r) - 4 * hi);
                if (nb == 0) { sort16<true>(blk);
#pragma unroll
                    for (int i = 0; i < 16; ++i) run[i] = blk[i]; }
                else { sort16<false>(blk);
#pragma unroll
                    for (int i = 0; i < 16; ++i) run[i] = umax_(run[i], blk[i]);
                    merge16<true>(run); }
            }
            u32 oth[16];
#pragma unroll
            for (int i = 0; i < 16; ++i) oth[i] = (u32)__shfl_xor((int)run[15 - i], 32);
#pragma unroll
            for (int i = 0; i < 16; ++i) run[i] = umax_(run[i], oth[i]);
            merge16<true>(run);
#pragma unroll
            for (int i = 0; i < 16; ++i) { if (p == 0) s0[i] = run[i]; else s1[i] = run[i]; }
        }
        { LAS u32* iw = (LAS u32*)IDXB;
#pragma unroll
          for (int j = 0; j < 4; ++j) {
              iw[j] = (127u - (s0[4 * j] & 127u)) | ((127u - (s0[4 * j + 1] & 127u)) << 8) | ((127u - (s0[4 * j + 2] & 127u)) << 16) | ((127u - (s0[4 * j + 3] & 127u)) << 24);
              iw[4 + j] = (127u - (s1[4 * j] & 127u)) | ((127u - (s1[4 * j + 1] & 127u)) << 8) | ((127u - (s1[4 * j + 2] & 127u)) << 16) | ((127u - (s1[4 * j + 3] & 127u)) << 24); } }
        float v1[16], v2[16];
#pragma unroll
        for (int i = 0; i < 16; ++i) { v1[i] = unordmap(s0[i] & ~0x7Fu); v2[i] = unordmap(s1[i] & ~0x7Fu); }
        u32 c0[16], c1[16], c2[16], c3[16];
#pragma unroll
        for (int a = 0; a < 16; ++a)
#pragma unroll
            for (int b = 0; b < ccnt(a); ++b) { const int pos = cbase(a) + b; const u32 key = (ordmap(v1[a] + v2[b]) & ~0xFFu) | (u32)(255 - (a * 16 + b));
                if (pos < 16) c0[pos] = key; else if (pos < 32) c1[pos - 16] = key; else if (pos < 48) c2[pos - 32] = key; else c3[pos - 48] = key; }
#pragma unroll
        for (int i = 2; i < 16; ++i) c3[i] = 0u;
        sort16<false>(c1);
#pragma unroll
        for (int i = 0; i < 16; ++i) c0[i] = umax_(c0[i], c1[i]);
        merge16<true>(c0);
        sort16<false>(c2);
#pragma unroll
        for (int i = 0; i < 16; ++i) c0[i] = umax_(c0[i], c2[i]);
        merge16<true>(c0);
        sort16<false>(c3);
#pragma unroll
        for (int i = 0; i < 16; ++i) c0[i] = umax_(c0[i], c3[i]);
        merge16<true>(c0);
        const float m = unordmap(c0[0] & ~0xFFu) * rstd2;
        float e[8]; float sum = 0.f; u32 ex[8];
#pragma unroll
        for (int k = 0; k < 8; ++k) { const u32 key = hi ? c0[k + 8] : c0[k]; const float ts = unordmap(key & ~0xFFu);
            e[k] = __builtin_amdgcn_exp2f((ts * rstd2 - m) * LOG2E); sum += e[k];
            const u32 flat = 255u - (key & 255u); ex[k] = (u32)IDXB[flat >> 4] * NKEY + (u32)IDXB[16 + (flat & 15u)]; }
        sum += __shfl_xor(sum, 32);
        const float inv = 1.f / sum;
        v4u exw; exw.x = ex[0] | (ex[1] << 16); exw.y = ex[2] | (ex[3] << 16); exw.z = ex[4] | (ex[5] << 16); exw.w = ex[6] | (ex[7] << 16);
        *(LAS v4u*)(EXL + tok * EX_STRIDE + w * 16 + hi * 8) = exw;
        *(LAS v4u*)(GTL + tok * GT_STRIDE + w * 16 + hi * 8) = (v4u){pk2(e[0] * inv, e[1] * inv), pk2(e[2] * inv, e[3] * inv), pk2(e[4] * inv, e[5] * inv), pk2(e[6] * inv, e[7] * inv)};
    }
}
__device__ __forceinline__ float gelu_fast(float x) {
    const float u2 = x * (1.5957691216057308f + 0.07135481627f * x * x);
    return x * __builtin_amdgcn_rcpf(1.f + __builtin_amdgcn_exp2f(-1.4426950408889634f * u2));
}
typedef float f32x2 __attribute__((ext_vector_type(2)));

__device__ __forceinline__ void sort128(u32 (&k)[8], int m) {
#pragma unroll
    for (int K = 2; K <= 128; K <<= 1) {
#pragma unroll
        for (int S = K >> 1; S > 0; S >>= 1) {
            if (S >= 8) {
                const int mm = S >> 3; const bool lower = (m & mm) == 0, up = (K == 128) ? true : ((m & (K >> 3)) == 0), keepmin = (lower == up);
#pragma unroll
                for (int r = 0; r < 8; ++r) { const u32 o = (u32)__shfl_xor((int)k[r], mm); const u32 mn = umin_(k[r], o), mx = umax_(k[r], o); k[r] = keepmin ? mn : mx; }
            } else {
#pragma unroll
                for (int r = 0; r < 8; ++r) { const int r2 = r ^ S;
                    if (r2 > r) { const u32 a = k[r], b = k[r2], mn = umin_(a, b), mx = umax_(a, b);
                        if (K < 8) { const bool up = (r & K) == 0; k[r] = up ? mn : mx; k[r2] = up ? mx : mn; }
                        else { const bool up = (K == 128) ? true : ((m & (K >> 3)) == 0); k[r] = up ? mn : mx; k[r2] = up ? mx : mn; } } }
            }
        }
    }
}
typedef int v8i __attribute__((ext_vector_type(8)));
typedef unsigned u2v __attribute__((ext_vector_type(2)));
__device__ __forceinline__ void eval_mf(Frame& F, const unsigned char* u4, const unsigned char* v4, const float* suv, const float* fg, float* out, int t0) {
    int lane = F.lane; asm volatile("" : "+v"(lane));
    const int g = lane >> 4, m = lane & 15;
    LAS unsigned short* EXL = (LAS unsigned short*)(F.lds + RING_OFF + L_EX);
    LAS unsigned short* GTL = (LAS unsigned short*)(F.lds + RING_OFF + L_GT);
    LAS unsigned char* BI = F.lds + RING_OFF + L_BI + F.wave * BI_WAVE;
    const LAS float* RST = (const LAS float*)(F.lds + RING_OFF + L_RST);
    LAS u32* SKW = (LAS u32*)(F.lds + RING_OFF + L_IDX) + F.wave * 512;
    LAS u32* SK = SKW + g * 128;
    for (int pass = 0; pass < 4; ++pass) {
        const int tb4 = 32 * pass + 4 * F.wave, tok = tb4 + g;
        LAS unsigned short* exr = EXL + tok * EX_STRIDE; LAS unsigned short* gtr = GTL + tok * GT_STRIDE;
        { u32 k[8]; const v4u ev = *(const LAS v4u*)(exr + 8 * m); const u32 s0 = (u32)(8 * m);
          k[0] = ((ev.x & 0xffffu) << 7) | s0; k[1] = ((ev.x >> 16) << 7) | (s0 + 1); k[2] = ((ev.y & 0xffffu) << 7) | (s0 + 2); k[3] = ((ev.y >> 16) << 7) | (s0 + 3);
          k[4] = ((ev.z & 0xffffu) << 7) | (s0 + 4); k[5] = ((ev.z >> 16) << 7) | (s0 + 5); k[6] = ((ev.w & 0xffffu) << 7) | (s0 + 6); k[7] = ((ev.w >> 16) << 7) | (s0 + 7);
          sort128(k, m);
          u32 wv[8];
#pragma unroll
          for (int r = 0; r < 8; ++r) wv[r] = ((k[r] >> 7) << 16) | (u32)gtr[k[r] & 127u];
          *(LAS v4u*)(SK + m * 8) = (v4u){wv[0], wv[1], wv[2], wv[3]}; *(LAS v4u*)(SK + m * 8 + 4) = (v4u){wv[4], wv[5], wv[6], wv[7]};
          *(LAS v4u*)(exr + 8 * m) = (v4u){(k[0] >> 7) | ((k[1] >> 7) << 16), (k[2] >> 7) | ((k[3] >> 7) << 16), (k[4] >> 7) | ((k[5] >> 7) << 16), (k[6] >> 7) | ((k[7] >> 7) << 16)}; }
        asm volatile("" ::: "memory");
        {
#pragma unroll
            for (int tq = 0; tq < 4; ++tq) { const float rq = RST[tb4 + tq]; const float* xr = out + (size_t)(t0 + tb4 + tq) * DMODEL + 4 * lane;
#pragma unroll
                for (int c = 0; c < 4; ++c) { const f32x4 xa = *(const GAS f32x4*)(xr + 256 * c); int w = 0;
                    w = __builtin_amdgcn_cvt_pk_fp8_f32(xa[0] * rq, xa[1] * rq, w, false); w = __builtin_amdgcn_cvt_pk_fp8_f32(xa[2] * rq, xa[3] * rq, w, true);
                    const int d = 256 * c + 4 * lane, st = d >> 7, dd = d & 127, hh = dd >> 6, e = dd & 63;
                    *(LAS int*)(BI + ((st * 4 + tq) * 4 + (e >> 4)) * 32 + hh * 16 + (e & 15)) = w; } }
        }
        asm volatile("" ::: "memory");
        v8i hb[8];
#pragma unroll
        for (int st = 0; st < 8; ++st) { v4u b0 = *(const LAS v4u*)(BI + ((st * 4 + (m & 3)) * 4 + g) * 32), b1 = *(const LAS v4u*)(BI + ((st * 4 + (m & 3)) * 4 + g) * 32 + 16);
            if (m >= 4) { b0 = (v4u){0u, 0u, 0u, 0u}; b1 = b0; }
            hb[st] = (v8i){(int)b0.x, (int)b0.y, (int)b0.z, (int)b0.w, (int)b1.x, (int)b1.y, (int)b1.z, (int)b1.w}; }
        asm volatile("" ::: "memory");
#define PEER_BAR() do { asm volatile("" ::: "memory"); __builtin_amdgcn_sched_barrier(0); } while (0)
#define PEER_LOADU(UA, KQ, SC, I) do { KQ = *(const LAS v4u*)(SK + (I)); _Pragma("unroll") for (int s4 = 0; s4 < 4; ++s4) { const u32 e_ = KQ[s4] >> 16; const u32 ro_ = e_ * 512u + 16u * (u32)m; \
            UA[s4][0] = *(const GAS v4u*)(u4 + ro_); UA[s4][1] = *(const GAS v4u*)(u4 + ro_ + 256); SC[s4] = *(const GAS f32x2*)(suv + 2 * e_); } } while (0)
#define PEER_TRANSP(UA) do { _Pragma("unroll") for (int hf = 0; hf < 2; ++hf) { \
                _Pragma("unroll") for (int s4 = 0; s4 < 4; ++s4) *(LAS v4u*)(BI + (4 * s4 + g) * 272 + 16 * m) = UA[s4][hf]; \
                asm volatile("" ::: "memory"); \
                _Pragma("unroll") for (int st = 0; st < 4; ++st) af[4 * hf + st] = *(const LAS v4u*)(BI + m * 272 + 64 * st + 16 * g); \
                asm volatile("" ::: "memory"); } } while (0)
#define PEER_DOTS(KQ, SC, I) do { f32x4 D = (f32x4){0.f, 0.f, 0.f, 0.f}; \
            _Pragma("unroll") for (int st = 0; st < 8; ++st) { const v8i a8 = (v8i){(int)af[st].x, (int)af[st].y, (int)af[st].z, (int)af[st].w, 0, 0, 0, 0}; \
                D = __builtin_amdgcn_mfma_scale_f32_16x16x128_f8f6f4(a8, hb[st], D, 4, 0, 0, 0x7f7f7f7f, 0, 0x7f7f7f7f); } \
            const int sel = lane & 3; const float mine = sel == 0 ? D[0] : sel == 1 ? D[1] : sel == 2 ? D[2] : D[3]; float act[4]; \
            _Pragma("unroll") for (int s4 = 0; s4 < 4; ++s4) { const float pre = __uint_as_float((unsigned)__builtin_amdgcn_ds_bpermute(4 * (g + 16 * s4), (int)__float_as_uint(mine))); \
                act[s4] = gelu_fast(pre * SC[s4][0]) * (__uint_as_float(KQ[s4] << 16) * SC[s4][1]); } \
            if (m == 0) *(LAS u2v*)(gtr + (I)) = (u2v){pk2(act[0], act[1]), pk2(act[2], act[3])}; } while (0)
        v4u kqA, kqB, uaA[4][2], uaB[4][2], af[8]; f32x2 scA[4], scB[4];
        PEER_LOADU(uaA, kqA, scA, 0);
        for (int i = 0; i < 128; i += 8) {
            PEER_TRANSP(uaA);
            PEER_LOADU(uaB, kqB, scB, i + 4);
            PEER_BAR();
            PEER_DOTS(kqA, scA, i);
            PEER_BAR();
            PEER_TRANSP(uaB);
            PEER_LOADU(uaA, kqA, scA, (i + 8 < 128) ? i + 8 : i + 4);
            PEER_BAR();
            PEER_DOTS(kqB, scB, i + 4);
            PEER_BAR();
        }
    }
    asm volatile("" ::: "memory");
    for (int pass = 0; pass < 4; ++pass) {
        const int tb4 = 32 * pass + 4 * F.wave, tok = tb4 + g;
        const LAS unsigned short* exr = EXL + tok * EX_STRIDE; const LAS unsigned short* acr = GTL + tok * GT_STRIDE;
        f32x2 y[32];
#pragma unroll
        for (int q = 0; q < 32; ++q) y[q] = (f32x2){0.f, 0.f};
        float* xrow = out + (size_t)(t0 + tok) * DMODEL + 4 * m;
#define PEER_LOADV(VB, I) do { const u2v e2_ = *(const LAS u2v*)(exr + (I)); _Pragma("unroll") for (int s4 = 0; s4 < 4; ++s4) { const u32 e_ = (s4 & 1) ? (e2_[s4 >> 1] >> 16) : (e2_[s4 >> 1] & 0xffffu); \
            const u32 ro_ = e_ * 512u + 32u * (u32)m; VB[s4][0] = *(const GAS v4u*)(v4 + ro_); VB[s4][1] = *(const GAS v4u*)(v4 + ro_ + 16); } } while (0)
#define PEER_FMAV(VB, I) do { const u2v a2_ = *(const LAS u2v*)(acr + (I)); _Pragma("unroll") for (int s4 = 0; s4 < 4; ++s4) { \
            const float act_ = (s4 & 1) ? __uint_as_float(a2_[s4 >> 1] & 0xffff0000u) : __uint_as_float(a2_[s4 >> 1] << 16); const f32x2 b2_ = (f32x2){act_, act_}; \
            _Pragma("unroll") for (int c = 0; c < 2; ++c) _Pragma("unroll") for (int d = 0; d < 4; ++d) { const unsigned w_ = VB[s4][c][d]; const int hq = 16 * c + 4 * d; \
                y[hq] = __builtin_elementwise_fma(__builtin_amdgcn_cvt_scalef32_pk_f32_fp4(w_, 1.0f, 0), b2_, y[hq]); y[hq + 1] = __builtin_elementwise_fma(__builtin_amdgcn_cvt_scalef32_pk_f32_fp4(w_, 1.0f, 1), b2_, y[hq + 1]); \
                y[hq + 2] = __builtin_elementwise_fma(__builtin_amdgcn_cvt_scalef32_pk_f32_fp4(w_, 1.0f, 2), b2_, y[hq + 2]); y[hq + 3] = __builtin_elementwise_fma(__builtin_amdgcn_cvt_scalef32_pk_f32_fp4(w_, 1.0f, 3), b2_, y[hq + 3]); } } } while (0)
        v4u vbA[4][2], vbB[4][2], vbC[4][2];
        PEER_LOADV(vbA, 0); PEER_LOADV(vbB, 4);
        PEER_BAR();
        for (int i = 0; i < 120; i += 12) {
            PEER_LOADV(vbC, i + 8);  PEER_BAR(); PEER_FMAV(vbA, i);     PEER_BAR();
            PEER_LOADV(vbA, i + 12); PEER_BAR(); PEER_FMAV(vbB, i + 4); PEER_BAR();
            PEER_LOADV(vbB, i + 16); PEER_BAR(); PEER_FMAV(vbC, i + 8); PEER_BAR();
        }
        PEER_FMAV(vbA, 120); PEER_FMAV(vbB, 124);
        float ss = 0.f;
#pragma unroll
        for (int q = 0; q < 16; ++q) { const f32x4 xa = *(const GAS f32x4*)(xrow + 64 * q); y[2 * q][0] += xa[0]; y[2 * q][1] += xa[1]; y[2 * q + 1][0] += xa[2]; y[2 * q + 1][1] += xa[3];
            ss += (y[2 * q][0] * y[2 * q][0] + y[2 * q][1] * y[2 * q][1]) + (y[2 * q + 1][0] * y[2 * q + 1][0] + y[2 * q + 1][1] * y[2 * q + 1][1]); }
        ss += __shfl_xor(ss, 1); ss += __shfl_xor(ss, 2); ss += __shfl_xor(ss, 4); ss += __shfl_xor(ss, 8);
        const float rs = rsqrtf(ss * (1.f / DMODEL) + RMS_EPS);
        asm volatile("" ::: "memory");
#pragma unroll
        for (int q = 0; q < 16; ++q) { const f32x4 gq = *(const GAS f32x4*)(fg + 64 * q + 4 * m); f32x4 o; o[0] = y[2 * q][0] * rs * gq[0]; o[1] = y[2 * q][1] * rs * gq[1]; o[2] = y[2 * q + 1][0] * rs * gq[2]; o[3] = y[2 * q + 1][1] * rs * gq[3];
            *(GAS f32x4*)(xrow + 64 * q) = o; }
    }
}
__device__ __forceinline__ void peer_phase(Frame& F, const Args& a) {
    unsigned char* ws = a.ws;
    for (int tile = F.vcu; tile < T / TOK; tile += F.G) {
        route_tile(F, (const bf16*)(ws + WS_QP), (const bf16*)(ws + WS_SKB), (const float*)(ws + WS_SUMSQ), tile * TOK);
        __syncthreads();
        eval_mf(F, ws + WS_U8, ws + WS_V8, (const float*)(ws + WS_SU), a.in[19], a.out, tile * TOK);
        __syncthreads();
    }
}
}

namespace lru {
typedef float f32x16 __attribute__((ext_vector_type(16)));
constexpr int TOKT = 128, NTILE = SEQ / TOKT;
constexpr int WAVE_LDS = 14336, L_XS = 0, L_XC = 4608, L_GS = 9216, XC_STRIDE = 72  , L_SS = 8 * WAVE_LDS;
static_assert(L_SS + 32 * 8 * 4 <= RING_BYTES, "LRU LDS map");
__device__ __forceinline__ float bf2f(unsigned short h) { return __uint_as_float((unsigned)h << 16); }
__device__ __forceinline__ int crow16(int r) { return (r & 3) + 8 * (r >> 2); }
__device__ __forceinline__ float sigm(float x) { return __builtin_amdgcn_rcpf(1.f + __builtin_amdgcn_exp2f(-LOG2E * x)); }

template <bool FINAL> __device__ __forceinline__ void lru_tile(Frame& F, const Args& args, int tile) {
    int lane = F.lane; asm volatile("" : "+v"(lane));
    const int w = F.wave, j32 = lane & 31, hi = lane >> 5;
    unsigned char* ws = args.ws;
    const bf16* xr = (const bf16*)(ws + WS_XR); const bf16* gr = (const bf16*)(ws + WS_GR); float* carry = (float*)(ws + WS_CARRY);
    const float* cw = args.in[3]; const float* cb = args.in[4]; const float* ba = args.in[6]; const float* bx = args.in[8]; const float* lam = args.in[9];
    const int b = tile / NTILE, jt = tile % NTILE; const size_t trow0 = (size_t)b * SEQ + (size_t)jt * TOKT;
    LAS unsigned char* wl = F.lds + RING_OFF + w * WAVE_LDS;
    LAS unsigned short* XS = (LAS unsigned short*)(wl + L_XS); LAS unsigned short* XC = (LAS unsigned short*)(wl + L_XC); LAS unsigned short* GS = (LAS unsigned short*)(wl + L_GS);
    LAS float* SS = (LAS float*)(F.lds + RING_OFF + L_SS);
    float c_ba[2], c_bx[2], c_sp[2], c_cb[2], c_cw[2][4];
#pragma unroll
    for (int n = 0; n < 2; ++n) { const int c = 64 * w + 32 * n + j32; c_ba[n] = ba[c]; c_bx[n] = bx[c]; c_cb[n] = cb[c];
        const float l = lam[c]; c_sp[n] = 8.f * LOG2E * (fmaxf(-l, 0.f) + log1pf(expf(-fabsf(l))));
#pragma unroll
        for (int k = 0; k < 4; ++k) c_cw[n][k] = cw[k * LW + c]; }
    const bf16* wax = (const bf16*)(ws + WS_WAX);
    float hc[2] = {0.f, 0.f}, ap[2] = {1.f, 1.f};
    if (FINAL) { const float* cin = (const float*)(ws + WS_CIN) + (size_t)(b * NTILE + jt) * LW + 64 * w + j32; hc[0] = cin[0]; hc[1] = cin[32]; }
    v4u pfx[5], pfg[4], pce[2][2], pcu[2][2];
    unsigned char* cacheE = ws + WS_LA + ((size_t)(tile * 8 + w) * 4) * 4096; unsigned char* cacheU = ws + WS_LU + ((size_t)(tile * 8 + w) * 4) * 4096;
#define LRU_FETCH(B) do { const size_t tbn_ = trow0 + (B) * 32; \
        if (!FINAL) { _Pragma("unroll") for (int q_ = 0; q_ < 5; ++q_) { const int pc_ = lane + 64 * q_, row_ = pc_ >> 3, c8_ = pc_ & 7; \
            const bool z_ = (jt == 0 && (B) == 0 && row_ < 3) || pc_ >= 35 * 8; const v4u v_ = *(const GAS v4u*)(xr + (tbn_ + (z_ ? 3 : row_) - 3) * LW + w * 64 + c8_ * 8); pfx[q_] = z_ ? (v4u){0u, 0u, 0u, 0u} : v_; } } \
        if (FINAL) { _Pragma("unroll") for (int q_ = 0; q_ < 4; ++q_) { const int pc_ = lane + 64 * q_; pfg[q_] = *(const GAS v4u*)(gr + (tbn_ + (pc_ >> 3)) * LW + w * 64 + (pc_ & 7) * 8); } \
            _Pragma("unroll") for (int n_ = 0; n_ < 2; ++n_) _Pragma("unroll") for (int h_ = 0; h_ < 2; ++h_) { const size_t o_ = (size_t)(B) * 4096 + n_ * 2048 + h_ * 1024 + lane * 16; \
                pce[n_][h_] = *(const GAS v4u*)(cacheE + o_); pcu[n_][h_] = *(const GAS v4u*)(cacheU + o_); } } } while (0)
    LRU_FETCH(0);
    for (int blk = 0; blk < 4; ++blk) {
        const size_t tb = trow0 + blk * 32;
        int ln = lane; asm volatile("" : "+v"(ln));
        const int k32 = ln & 31;
        if (!FINAL) {
#pragma unroll
            for (int q = 0; q < 5; ++q) { const int pc = ln + 64 * q; if (pc < 35 * 8) *(LAS v4u*)((LAS unsigned char*)XS + (pc >> 3) * 128 + (pc & 7) * 16) = pfx[q]; } }
        v4u ce[2][2], cu[2][2];
        if (FINAL) {
#pragma unroll
            for (int n = 0; n < 2; ++n)
#pragma unroll
                for (int h = 0; h < 2; ++h) { ce[n][h] = pce[n][h]; cu[n][h] = pcu[n][h]; }
#pragma unroll
            for (int q = 0; q < 4; ++q) { const int pc = ln + 64 * q; *(LAS v4u*)((LAS unsigned char*)GS + (pc >> 3) * 128 + (pc & 7) * 16) = pfg[q]; } }
        if (blk < 3) { LRU_FETCH(blk + 1); }
        asm volatile("" ::: "memory");
        float xc[2][16];
        bf16x8 af[4];
        if (!FINAL) {
#pragma unroll
        for (int n = 0; n < 2; ++n)
#pragma unroll
            for (int g = 0; g < 4; ++g) { float xv[7];
#pragma unroll
                for (int q = 0; q < 7; ++q) xv[q] = bf2f(XS[(8 * g + 4 * hi + q) * 64 + 32 * n + j32]);
#pragma unroll
                for (int e = 0; e < 4; ++e) xc[n][4 * g + e] = c_cb[n] + ((c_cw[n][0] * xv[e] + c_cw[n][1] * xv[e + 1]) + (c_cw[n][2] * xv[e + 2] + c_cw[n][3] * xv[e + 3])); }
#pragma unroll
        for (int n = 0; n < 2; ++n)
#pragma unroll
            for (int r = 0; r < 16; ++r) XC[(crow16(r) + 4 * hi) * XC_STRIDE + 32 * n + j32] = (unsigned short)f2bf(xc[n][r]);
        asm volatile("" ::: "memory");
#pragma unroll
        for (int ks = 0; ks < 4; ++ks) af[ks] = *(const LAS bf16x8*)(XC + j32 * XC_STRIDE + 16 * ks + 8 * hi);
        asm volatile("" ::: "memory");
        }
        float yv[2][16];
#pragma unroll
        for (int n = 0; n < 2; ++n) {
            float av[16], uv[16];
            if (!FINAL) {
            f32x16 R = {}, I = {};
            bf16x8 fa[4], fx[4];
#pragma unroll
            for (int ks = 0; ks < 4; ++ks) { fa[ks] = *(const GAS bf16x8*)(wax + (size_t)(((w * 2 + 0) * 2 + n) * 4 + ks) * 512 + ln * 8); fx[ks] = *(const GAS bf16x8*)(wax + (size_t)(((w * 2 + 1) * 2 + n) * 4 + ks) * 512 + ln * 8); }
#pragma unroll
            for (int ks = 0; ks < 4; ++ks) { R = __builtin_amdgcn_mfma_f32_32x32x16_bf16(af[ks], fa[ks], R, 0, 0, 0); I = __builtin_amdgcn_mfma_f32_32x32x16_bf16(af[ks], fx[ks], I, 0, 0, 0); }
            unsigned we[8], wu[8];
#pragma unroll
            for (int k = 0; k < 8; ++k) { const float e0 = sigm(R[2 * k] + c_ba[n]) * c_sp[n], e1 = sigm(R[2 * k + 1] + c_ba[n]) * c_sp[n]; we[k] = pg8::cvt_pk_bf16(e0, e1);
                const float a0 = __builtin_amdgcn_exp2f(-__uint_as_float(we[k] << 16)), a1 = __builtin_amdgcn_exp2f(-__uint_as_float(we[k] & 0xffff0000u));
                const float u0 = __builtin_amdgcn_sqrtf(fmaxf(1.f - a0 * a0, 0.f)) * (sigm(I[2 * k] + c_bx[n]) * xc[n][2 * k]), u1 = __builtin_amdgcn_sqrtf(fmaxf(1.f - a1 * a1, 0.f)) * (sigm(I[2 * k + 1] + c_bx[n]) * xc[n][2 * k + 1]);
                wu[k] = pg8::cvt_pk_bf16(u0, u1);
                av[2 * k] = a0; av[2 * k + 1] = a1; uv[2 * k] = __uint_as_float(wu[k] << 16); uv[2 * k + 1] = __uint_as_float(wu[k] & 0xffff0000u); }
            { const size_t o = (size_t)blk * 4096 + n * 2048 + ln * 16;
              *(GAS v4u*)(cacheE + o) = (v4u){we[0], we[1], we[2], we[3]}; *(GAS v4u*)(cacheE + o + 1024) = (v4u){we[4], we[5], we[6], we[7]};
              *(GAS v4u*)(cacheU + o) = (v4u){wu[0], wu[1], wu[2], wu[3]}; *(GAS v4u*)(cacheU + o + 1024) = (v4u){wu[4], wu[5], wu[6], wu[7]}; }
            } else {
#pragma unroll
                for (int k = 0; k < 8; ++k) { const unsigned e2 = ce[n][k >> 2][k & 3], u2 = cu[n][k >> 2][k & 3];
                    av[2 * k] = __builtin_amdgcn_exp2f(-__uint_as_float(e2 << 16)); av[2 * k + 1] = __builtin_amdgcn_exp2f(-__uint_as_float(e2 & 0xffff0000u));
                    uv[2 * k] = __uint_as_float(u2 << 16); uv[2 * k + 1] = __uint_as_float(u2 & 0xffff0000u); }
            }
            float Ar[4], Hr[4], hst[4];
#pragma unroll
            for (int g = 0; g < 4; ++g) { Ar[g] = (av[4 * g] * av[4 * g + 1]) * (av[4 * g + 2] * av[4 * g + 3]);
                Hr[g] = ((uv[4 * g] * av[4 * g + 1] + uv[4 * g + 1]) * av[4 * g + 2] + uv[4 * g + 2]) * av[4 * g + 3] + uv[4 * g + 3]; }
            float hin = hc[n];
#pragma unroll
            for (int g = 0; g < 4; ++g) { float o1 = Ar[g] * hin + Hr[g]; const float x = __shfl_xor(o1, 32); const float hg = hi ? x : hin; o1 = Ar[g] * hg + Hr[g]; hst[g] = hg;
                const float y = __shfl_xor(o1, 32); hin = hi ? o1 : y;
                if (!FINAL) ap[n] *= Ar[g] * __shfl_xor(Ar[g], 32); }
            hc[n] = hin;
            if (FINAL) {
#pragma unroll
                for (int g = 0; g < 4; ++g) { float h = hst[g];
#pragma unroll
                    for (int e = 0; e < 4; ++e) { const int r = 4 * g + e; h = av[r] * h + uv[r]; yv[n][r] = h * bf2f(GS[(crow16(r) + 4 * hi) * 64 + 32 * n + j32]); } } }
        }
        if (FINAL) {
#pragma unroll
            for (int r = 0; r < 16; ++r) { float s = yv[0][r] * yv[0][r] + yv[1][r] * yv[1][r];
                s += __shfl_xor(s, 1); s += __shfl_xor(s, 2); s += __shfl_xor(s, 4); s += __shfl_xor(s, 8); s += __shfl_xor(s, 16);
                if (j32 == 0) SS[(crow16(r) + 4 * hi) * 8 + w] = s; }
            __syncthreads();
            bf16* ymix = (bf16*)(ws + WS_H);
#pragma unroll
            for (int r = 0; r < 16; ++r) { const int tk = crow16(r) + 4 * hi; const f32x4 s0 = *(const LAS f32x4*)(SS + tk * 8), s1 = *(const LAS f32x4*)(SS + tk * 8 + 4);
                const float rstd = rsqrtf(((s0[0] + s0[1]) + (s0[2] + s0[3]) + (s1[0] + s1[1]) + (s1[2] + s1[3])) * (1.f / LW) + RMS_EPS);
                bf16* yp = ymix + (tb + tk) * DMODEL + 64 * w + k32;
                yp[0] = (bf16)f2bf(yv[0][r] * rstd); yp[32] = (bf16)f2bf(yv[1][r] * rstd); }
            __syncthreads();
        }
    }
#undef LRU_FETCH
    if (!FINAL) { if (hi == 0) { float* cp = carry + ((size_t)(b * NTILE + jt) * 2) * LW + 64 * w + j32;
#pragma unroll
        for (int n = 0; n < 2; ++n) { cp[32 * n] = ap[n]; cp[LW + 32 * n] = hc[n]; } } }
    else {
        const bf16* ob = (const bf16*)(ws + WS_O); bf16* ymix = (bf16*)(ws + WS_H);
        for (int i0 = 0; i0 < 16; i0 += 4) {
            v4u vv[4];
#pragma unroll
            for (int i = 0; i < 4; ++i) vv[i] = *(const GAS v4u*)(ob + (trow0 + 16 * w + i0 + i) * AW + 8 * lane);
            float ssq[4];
#pragma unroll
            for (int i = 0; i < 4; ++i) { float s = 0.f;
#pragma unroll
                for (int c = 0; c < 4; ++c) { const float lo = __uint_as_float(vv[i][c] << 16), hi2 = __uint_as_float(vv[i][c] & 0xffff0000u); s += lo * lo + hi2 * hi2; }
                ssq[i] = s; }
#pragma unroll
            for (int o = 1; o < 64; o <<= 1) {
#pragma unroll
                for (int i = 0; i < 4; ++i) ssq[i] += __shfl_xor(ssq[i], o); }
#pragma unroll
            for (int i = 0; i < 4; ++i) { const float rstd = rsqrtf(ssq[i] * (1.f / AW) + RMS_EPS); v4u o;
#pragma unroll
                for (int c = 0; c < 4; ++c) o[c] = pk2(__uint_as_float(vv[i][c] << 16) * rstd, __uint_as_float(vv[i][c] & 0xffff0000u) * rstd);
                *(GAS v4u*)(ymix + (trow0 + 16 * w + i0 + i) * DMODEL + LW + 8 * lane) = o; } }
    }
}
__device__ __forceinline__ void norm_pass(Frame& F, const Args& a) {
    unsigned char* ws = a.ws; float* nrm = (float*)(ws + WS_NRM);
    const int gw = F.vcu * NWAVES + F.wave, NGW = F.G * NWAVES, lane = F.lane;
    for (int it = gw; it < 2 * BATCH * (SEQ / 64); it += NGW) {
        const int which = it / (BATCH * (SEQ / 64)), r = it % (BATCH * (SEQ / 64)), b = r / (SEQ / 64), t = r % (SEQ / 64);
        const bf16* src = (const bf16*)(ws + (which ? WS_K : WS_Q)) + ((size_t)b * SEQ + 64 * t) * AW + 8 * lane;
        float mx = 0.f;
#pragma unroll 8
        for (int i = 0; i < 64; ++i) { const v4u v = *(const GAS v4u*)(src + (size_t)i * AW); float s = 0.f;
#pragma unroll
            for (int c = 0; c < 4; ++c) { const float lo = __uint_as_float(v[c] << 16), hi = __uint_as_float(v[c] & 0xffff0000u); s += lo * lo + hi * hi; }
            s += __shfl_xor(s, 1); s += __shfl_xor(s, 2); s += __shfl_xor(s, 4); mx = fmaxf(mx, s); }
        if ((lane & 7) == 0) nrm[which * 4096 + (b * NHEADS + (lane >> 3)) * 128 + t] = sqrtf(mx) * 1.0001f;
    }
}
__device__ __forceinline__ void carry_prefix(Frame& F, const Args& a, int b) {
    const float* carry = (const float*)(a.ws + WS_CARRY) + (size_t)b * NTILE * 2 * LW + F.tid; float* cin = (float*)(a.ws + WS_CIN) + (size_t)b * NTILE * LW + F.tid;
    float c = 0.f;
    for (int j0 = 0; j0 < NTILE; j0 += 8) { float A[8], H[8];
#pragma unroll
        for (int j = 0; j < 8; ++j) { A[j] = carry[(size_t)(j0 + j) * 2 * LW]; H[j] = carry[(size_t)(j0 + j) * 2 * LW + LW]; }
#pragma unroll
        for (int j = 0; j < 8; ++j) { cin[(size_t)(j0 + j) * LW] = c; c = A[j] * c + H[j]; } }
}
template <bool FINAL> __device__ __forceinline__ void lru_phase(Frame& F, const Args& a) {
    for (int tile = F.vcu; tile < BATCH * NTILE; tile += F.G) { lru_tile<FINAL>(F, a, tile); __syncthreads(); }
}
}
__global__ void __launch_bounds__(NWAVES * 64, 2) mk_fwd(Args args) {
    extern __shared__ __attribute__((aligned(16))) unsigned char lds[];
    Frame F;
    F.lds = (LAS unsigned char*)lds;
    F.MISC = (volatile LAS unsigned*)(F.lds + MISC_OFF);
    F.wave = __builtin_amdgcn_readfirstlane((int)threadIdx.x >> 6); F.lane = (int)__builtin_amdgcn_mbcnt_hi(~0u, __builtin_amdgcn_mbcnt_lo(~0u, 0u)); F.tid = F.wave * 64 + F.lane;
    F.G = gridDim.x; { const int bx = blockIdx.x; F.vcu = (F.G % 8 == 0) ? (bx % 8) * (F.G / 8) + bx / 8 : bx; }
    unsigned char* ws = args.ws;
    F.ctl = (gu32*)(ws + WS_CTL);
    for (int u = F.tid; u < (LDS_BYTES - LDSCTL_OFF) / 4; u += NWAVES * 64) ((LAS unsigned*)(F.lds + LDSCTL_OFF))[u] = 0u;
    __syncthreads();
    XcdBarrier bar = xcd_barrier_post((unsigned*)(F.ctl + CW_BAR) + args.li * XCD_BAR_WORDS, F.MISC + 8, F.wave);
    const int lo = args.ph_lo, hi = args.ph_hi;
#define IN(k) (lo <= (k) && (k) < hi)
#define BOTH(k) (IN(k) && IN((k) + 1))
#define GRID_BAR() xcd_barrier(bar)

    if (IN(0)) { p0_prologue(F, args); if (BOTH(0)) GRID_BAR(); }

    if (IN(1)) {
        if (F.vcu < BATCH * NHEADS) fcum_unit(F, F.vcu, (const float*)(ws + WS_LOGF), (float*)(ws + WS_FCUM));
        pg8::Gemm g{(const pg8::bf16_t*)(ws + WS_H), (const pg8::bf16_t*)(ws + WS_WIN), T, NG1, DMODEL}; pg8::StaticOrder S; S.init(T, NG1, F.G, (int)blockIdx.x);
        pg8::EpiG1 E{(pg8::bf16_t*)(ws + WS_XR), SPLIT_STRIDE, QSCALE};
        pg8::gemm_phase<pg8::EpiG1, pg8::StaticOrder, true, true>(F.lds + RING_OFF, g, S, E, F.wave);
        if (BOTH(1)) GRID_BAR();
    }
    if (IN(2)) { lru::lru_phase<false>(F, args); lru::norm_pass(F, args); if (BOTH(2)) GRID_BAR(); }
    if (IN(3)) {
        static_assert(attn_body::ATTN_LDS_BYTES <= RING_BYTES, "attention LDS vs frame");
        if (F.vcu < BATCH) lru::carry_prefix(F, args, F.vcu);
        const attn_body::AttnTensors AT{(const attn_body::bf16*)(ws + WS_Q), (const attn_body::bf16*)(ws + WS_K), (const attn_body::bf16*)(ws + WS_V), (attn_body::bf16*)(ws + WS_O), (const float*)(ws + WS_FCUM), (const float*)(ws + WS_NRM)};
        attn_body::attn_phase<8>((char*)lds + RING_OFF, AT, (unsigned*)(F.ctl + CW_ATTQ), F.MISC + 24, F.wave);
        if (BOTH(3)) GRID_BAR();
    }
    if (IN(4)) { lru::lru_phase<true>(F, args); if (BOTH(4)) GRID_BAR(); }
    if (IN(5)) {
        pg8::Gemm g{(const pg8::bf16_t*)(ws + WS_H), (const pg8::bf16_t*)(ws + WS_WOUT), T, DMODEL, DMODEL}; pg8::StaticOrder S; S.init(T, DMODEL, F.G, (int)blockIdx.x);
        pg8::EpiG2 E{args.in[0], args.out, (pg8::bf16_t*)(ws + WS_X1B), (float*)(ws + WS_SUMSQ), DMODEL};
        pg8::gemm_phase<pg8::EpiG2, pg8::StaticOrder, true, true>(F.lds + RING_OFF, g, S, E, F.wave);
        if (BOTH(5)) GRID_BAR();
    }
    if (IN(6)) {
        pg8::Gemm g{(const pg8::bf16_t*)(ws + WS_X1B), (const pg8::bf16_t*)(ws + WS_WQ), T, QPW, DMODEL}; pg8::StaticOrder S; S.init(T, QPW, F.G, (int)blockIdx.x);
        pg8::EpiG3 E{(pg8::bf16_t*)(ws + WS_QP), QPW};
        pg8::gemm_phase<pg8::EpiG3, pg8::StaticOrder, true, true>(F.lds + RING_OFF, g, S, E, F.wave);
        if (BOTH(6)) GRID_BAR();
    }
    if (IN(7)) { peer::peer_phase(F, args); }
#undef IN
#undef BOTH
#undef GRID_BAR
}

extern "C" void kernel_launch(void* const* d_in, const int* in_sizes, int n_in, void* d_out, int out_size, void* d_ws, size_t ws_size, hipStream_t stream) {
    static int grid = 0;
    if (grid == 0) {
        if (n_in != 20 || in_sizes[0] != T * DMODEL || out_size != T * DMODEL || ws_size < WS_END) { fprintf(stderr, "kernel_launch: unexpected shapes (n_in %d, ws %zu)\n", n_in, ws_size); grid = -1; return; }
        int dev = 0, cus = 0;
        if (hipGetDevice(&dev) != hipSuccess || hipDeviceGetAttribute(&cus, hipDeviceAttributeMultiprocessorCount, dev) != hipSuccess) { grid = -1; return; }
        if (hipFuncSetAttribute((const void*)mk_fwd, hipFuncAttributeMaxDynamicSharedMemorySize, LDS_BYTES) != hipSuccess) { fprintf(stderr, "kernel_launch: hipFuncSetAttribute failed\n"); grid = -1; return; }
        (void)hipGetLastError();
        grid = cus;
    }
    if (grid < 0) return;
    if (hipMemsetAsync((char*)d_ws + WS_CTL, 0, CTL_ZERO_BYTES, stream) != hipSuccess) return;
    Args a{};
    for (int i = 0; i < 20; ++i) a.in[i] = (const float*)d_in[i];
    a.out = (float*)d_out; a.ws = (unsigned char*)d_ws; a.ph_lo = 0; a.ph_hi = N_PHASES; a.li = 0;
    hipLaunchKernelGGL(mk_fwd, dim3(grid), dim3(NWAVES * 64), LDS_BYTES, stream, a);
}
```

```cpp
#include <hip/hip_runtime.h>
#include <hip/hip_bf16.h>
#include <cstdio>
#include <cstdint>
#include <cmath>

constexpr int BATCH = 4, SEQ = 8192, DMODEL = 1024, T = BATCH * SEQ;
constexpr int LW = 512, AW = 512, NHEADS = 8, HD = 64, INC = 2568, NG1 = 2560;
constexpr int PH = 8, NKEY = 128, PHALF = 128, TOPK = 16, NEXP = NKEY * NKEY, QPW = 2048;
constexpr float RMS_EPS = 1e-6f;
constexpr float LOG2E = 1.4426950408889634f;
constexpr float QSCALE = 0.125f * LOG2E;
constexpr size_t MiB = 1u << 20;
constexpr size_t WS_CTL = 0, CTL_ZERO_BYTES = 1 * MiB;
constexpr size_t WS_WIN = 2 * MiB, WS_WOUT = 8 * MiB, WS_WQ = 10 * MiB, WS_SKB = 14 * MiB, WS_WFL = 15 * MiB,
                 WS_LOGF = 16 * MiB, WS_FCUM = 17 * MiB, WS_CARRY = 18 * MiB, WS_SUMSQ = 512 * 1024  , WS_WAX = 20 * MiB, WS_CIN = 23 * MiB  , WS_NRM = 22 * MiB  ,
                 WS_H = 32 * MiB, WS_XR = 96 * MiB, WS_GR = 128 * MiB, WS_Q = 160 * MiB, WS_K = 192 * MiB, WS_V = 224 * MiB,
                 WS_X1B = 256 * MiB, WS_O = 256 * MiB  , WS_QP = 96 * MiB, WS_UT = 320 * MiB, WS_VT = 352 * MiB, WS_U8 = 320 * MiB, WS_V8 = 336 * MiB, WS_SU = 21 * MiB, WS_SV = 21 * MiB + 65536, WS_LA = 384 * MiB, WS_LU = 448 * MiB, WS_END = 512 * MiB;
constexpr size_t SPLIT_STRIDE = (WS_GR - WS_XR) / 2;
constexpr int CW_TMO = 0, CW_ATTQ = 2048, CW_BAR = 4096;

namespace pg8 {
#define PG8_LAS __attribute__((address_space(3)))
typedef unsigned short bf16_t;
typedef short bf16x8 __attribute__((ext_vector_type(8)));
typedef float f32x4 __attribute__((ext_vector_type(4)));
typedef unsigned u32x4 __attribute__((ext_vector_type(4)));
constexpr int BM = 256, BK = 64, HALF = 128, HTB = HALF * BK * 2  , STAGE_BYTES = 8 * HTB, NXCD = 8, WGM = 8;

__host__ __device__ __forceinline__ int lds_byte(int r, int c) { const int st = (r >> 4) * 2 + (c >> 5), rr = r & 15, cc = c & 31, ob = rr * 64 + cc * 2; return st * 1024 + (ob ^ (((ob >> 9) & 1) << 5)); }
__host__ __device__ __forceinline__ void stage_rc(int b, int& R, int& C) { const int st = b / 1024, sb = b % 1024, swz = sb ^ (((sb >> 9) & 1) << 5); R = (st >> 1) * 16 + swz / 64; C = (st & 1) * 32 + (swz % 64) / 2; }
__host__ __device__ __forceinline__ int perm32(int rho) { const int n = rho >> 4, i = rho & 15; return 8 * (i >> 2) + 4 * n + (i & 3); }

struct Unit { int pm, pn; };
struct Gemm { const bf16_t* A; const bf16_t* Bt; int M, N, K; };

struct StaticOrder {
    int nM, nN, nwg, G, c;
    __host__ __device__ void init(int M, int N, int G_, int c_) { nM = M / BM; nN = N / BM; nwg = nM * nN; G = G_; c = c_; }
    __host__ __device__ bool next(int i, Unit& u) const {
        const long L = (long)i * G + c; if (L >= nwg) return false;
        int wgid = (int)L; { const int q = nwg / NXCD, r = nwg % NXCD, xcd = wgid % NXCD, off = wgid / NXCD; wgid = (xcd < r ? xcd * (q + 1) : r * (q + 1) + (xcd - r) * q) + off; }
        const int nig = WGM * nN, gid = wgid / nig, fm = gid * WGM, gsz = (nM - fm) < WGM ? (nM - fm) : WGM;
        u.pm = fm + ((wgid % nig) % gsz); u.pn = (wgid % nig) / gsz; return true;
    }
    __device__ __forceinline__ void a_ready(const Unit&) const {}
    __device__ __forceinline__ void done(const Unit&) const {}
};

__device__ __forceinline__ unsigned cvt_pk_bf16(float lo, float hi) { unsigned r; asm volatile("v_cvt_pk_bf16_f32 %0, %1, %2" : "=v"(r) : "v"(lo), "v"(hi)); return r; }
typedef unsigned u32x2 __attribute__((ext_vector_type(2)));
__device__ __forceinline__ float gelu_fast(float x) {
    const float u2 = x * (1.5957691216057308f + 0.07135481627f * x * x);
    return x * __builtin_amdgcn_rcpf(1.f + __builtin_amdgcn_exp2f(-1.4426950408889634f * u2));
}
struct EpiG1 {
    static constexpr bool PERM = true, AFTER_DRAIN = false;
    bf16_t* base0; size_t split_stride; float qscale;
    __device__ __forceinline__ void operator()(const f32x4 (&acc)[2][2][4][2], const Unit& u, int wr, int wc, int fr, int fq) const {
        const int s = u.pn >> 1; bf16_t* base = base0 + (size_t)s * split_stride;
        const int row0 = u.pm * BM + wr * 64 + fr, col0 = (u.pn & 1) * 256 + wc * 32 + 8 * fq;
#pragma unroll
        for (int ai = 0; ai < 2; ++ai)
#pragma unroll
            for (int m = 0; m < 4; ++m) { bf16_t* rowp = base + (size_t)(row0 + ai * HALF + m * 16) * 512 + col0;
#pragma unroll
                for (int bj = 0; bj < 2; ++bj) { f32x4 v0 = acc[ai][bj][m][0], v1 = acc[ai][bj][m][1];
                    if (s == 1) {
#pragma unroll
                        for (int e = 0; e < 4; ++e) { v0[e] = gelu_fast(v0[e]); v1[e] = gelu_fast(v1[e]); } }
                    else if (s == 2) { v0 = v0 * qscale; v1 = v1 * qscale; }
                    u32x4 w; w.x = cvt_pk_bf16(v0[0], v0[1]); w.y = cvt_pk_bf16(v0[2], v0[3]); w.z = cvt_pk_bf16(v1[0], v1[1]); w.w = cvt_pk_bf16(v1[2], v1[3]);
                    *(u32x4*)(rowp + bj * HALF) = w; } }
    }
};
struct EpiG2 {
    static constexpr bool PERM = true, AFTER_DRAIN = false;
    const float* resid; bf16_t* xb; float* sumsq; int ldc;
    __device__ __forceinline__ void operator()(const f32x4 (&acc)[2][2][4][2], const Unit& u, int wr, int wc, int fr, int fq) const {
        const int row0 = u.pm * BM + wr * 64 + fr, col0 = u.pn * BM + wc * 32 + 8 * fq;
#pragma unroll
        for (int ai = 0; ai < 2; ++ai) {
            f32x4 rs[4][2][2];
#pragma unroll
            for (int m = 0; m < 4; ++m) { const size_t off = (size_t)(row0 + ai * HALF + m * 16) * ldc + col0;
#pragma unroll
                for (int bj = 0; bj < 2; ++bj)
#pragma unroll
                    for (int n = 0; n < 2; ++n) rs[m][bj][n] = *(const f32x4*)(resid + off + bj * HALF + n * 4); }
#pragma unroll
            for (int m = 0; m < 4; ++m) { const int r = row0 + ai * HALF + m * 16; const size_t off = (size_t)r * ldc + col0; float ss = 0.f;
#pragma unroll
                for (int bj = 0; bj < 2; ++bj) { const f32x4 x0 = rs[m][bj][0] + acc[ai][bj][m][0], x1 = rs[m][bj][1] + acc[ai][bj][m][1];
                    ss += ((x0[0] * x0[0] + x0[1] * x0[1]) + (x0[2] * x0[2] + x0[3] * x0[3])) + ((x1[0] * x1[0] + x1[1] * x1[1]) + (x1[2] * x1[2] + x1[3] * x1[3]));
                    u32x4 w; w.x = cvt_pk_bf16(x0[0], x0[1]); w.y = cvt_pk_bf16(x0[2], x0[3]); w.z = cvt_pk_bf16(x1[0], x1[1]); w.w = cvt_pk_bf16(x1[2], x1[3]);
                    *(u32x4*)(xb + off + bj * HALF) = w; }
                ss += __shfl_xor(ss, 16); ss += __shfl_xor(ss, 32);
                if (fq == 0) atomicAdd(sumsq + r, ss); }
            asm volatile("" ::: "memory"); }
    }
};
struct EpiG3 {
    static constexpr bool PERM = true, AFTER_DRAIN = false;
    bf16_t* O; int ldc;
    __device__ __forceinline__ void operator()(const f32x4 (&acc)[2][2][4][2], const Unit& u, int wr, int wc, int fr, int fq) const {
        const int row0 = u.pm * BM + wr * 64 + fr;
#pragma unroll
        for (int ai = 0; ai < 2; ++ai)
#pragma unroll
            for (int m = 0; m < 4; ++m) { const int t = row0 + ai * HALF + m * 16;
#pragma unroll
                for (int bj = 0; bj < 2; ++bj) { const f32x4 v0 = acc[ai][bj][m][0], v1 = acc[ai][bj][m][1];
                    u32x4 w; w.x = cvt_pk_bf16(v0[0], v0[1]); w.y = cvt_pk_bf16(v0[2], v0[3]); w.z = cvt_pk_bf16(v1[0], v1[1]); w.w = cvt_pk_bf16(v1[2], v1[3]);
                    *(u32x4*)(O + ((size_t)(((((t >> 5) * 8 + u.pn) * 2 + bj) * 16 + 4 * wc + fq) * 32 + (t & 31))) * 8) = w; } }
    }
};

template <class Epi, class Sched, bool ALIGN_EPI = false, bool SP2 = false>
__device__ __forceinline__ void gemm_phase(PG8_LAS unsigned char* lds, const Gemm g, const Sched& S, const Epi& E, int wid_in) {
    const int wid = __builtin_amdgcn_readfirstlane(wid_in), lane = (int)__builtin_amdgcn_mbcnt_hi(~0u, __builtin_amdgcn_mbcnt_lo(~0u, 0u)), tid = wid * 64 + lane, wr = wid >> 2, wc = wid & 3, fr = lane & 15, fq = lane >> 4;
    const int K = g.K, nt = K / BK;
    unsigned voffA[2], voffB[2];
#pragma unroll
    for (int i = 0; i < 2; ++i) { int R, C; stage_rc(tid * 16 + i * 8192, R, C); const int Rb = Epi::PERM ? ((R & ~31) + perm32(R & 31)) : R;
        voffA[i] = (unsigned)(R * K + C) * 2u; voffB[i] = (unsigned)(Rb * K + C) * 2u; }
    const size_t kstep = (size_t)(BK * 2);
    const size_t hstep = (size_t)HALF * K * 2;
    const size_t tstep = 2 * hstep;
    const unsigned ldsw = (unsigned)wid * 1024u;
    const int aoff = lds_byte(wr * 64 + fr, fq * 8), boff = lds_byte(wc * 32 + fr, fq * 8);
#define PG8_SA(b, h) (((b) * 2 + (h)) * HTB)
#define PG8_SB(b, h) ((4 + (b) * 2 + (h)) * HTB)
#define PG8_STAGE(bufoff, gbase, voff) do { _Pragma("unroll") for (int _i = 0; _i < 2; ++_i) \
        __builtin_amdgcn_global_load_lds((const unsigned*)((const char*)(gbase) + (voff)[_i]), (PG8_LAS unsigned*)(lds + (bufoff) + ldsw + _i * 8192), 16, 0, 0); } while (0)
#define PG8_LDA(dst, b, h) do { _Pragma("unroll") for (int m = 0; m < 4; ++m) _Pragma("unroll") for (int k = 0; k < 2; ++k) dst[m][k] = *(const PG8_LAS bf16x8*)(lds + PG8_SA(b, h) + aoff + m * 2048 + k * 1024); } while (0)
#define PG8_LDB(dst, b, h) do { _Pragma("unroll") for (int n = 0; n < 2; ++n) _Pragma("unroll") for (int k = 0; k < 2; ++k) dst[n][k] = *(const PG8_LAS bf16x8*)(lds + PG8_SB(b, h) + boff + n * 2048 + k * 1024); } while (0)
#define PG8_MMA(ai, bj, At, Bt) do { __builtin_amdgcn_s_setprio(1); _Pragma("unroll") for (int m = 0; m < 4; ++m) _Pragma("unroll") for (int n = 0; n < 2; ++n) _Pragma("unroll") for (int k = 0; k < 2; ++k) \
        acc[ai][bj][m][n] = __builtin_amdgcn_mfma_f32_16x16x32_bf16(Bt[n][k], At[m][k], acc[ai][bj][m][n], 0, 0, 0); __builtin_amdgcn_s_setprio(0); } while (0)
#define PG8_WAIT_V(n) asm volatile("s_waitcnt vmcnt(" #n ")" ::: "memory")
#define PG8_WAIT_L(n) asm volatile("s_waitcnt lgkmcnt(" #n ")" ::: "memory")
#define PG8_BAR __builtin_amdgcn_s_barrier()
#define PG8_SCHED __builtin_amdgcn_sched_barrier(0)
    Unit cur, nxt; int ui = 0;
    if (!S.next(0, cur)) return;
    f32x4 acc[2][2][4][2];
#pragma unroll
    for (int a = 0; a < 2; ++a)
#pragma unroll
        for (int b = 0; b < 2; ++b)
#pragma unroll
            for (int m = 0; m < 4; ++m)
#pragma unroll
                for (int n = 0; n < 2; ++n) acc[a][b][m][n] = (f32x4){0.f, 0.f, 0.f, 0.f};
    bf16x8 At[4][2], B0[2][2], B1[2][2];
    const char* cA = (const char*)g.A + (size_t)cur.pm * tstep; const char* cB = (const char*)g.Bt + (size_t)cur.pn * tstep;
    S.a_ready(cur);
    if constexpr (SP2) {
        PG8_STAGE(PG8_SB(0, 0), cB, voffB); PG8_STAGE(PG8_SB(0, 1), cB + hstep, voffB); PG8_STAGE(PG8_SA(0, 0), cA, voffA); PG8_STAGE(PG8_SA(0, 1), cA + hstep, voffA);
        if (wr == 1) PG8_BAR;
        PG8_WAIT_V(2); PG8_BAR;
        PG8_STAGE(PG8_SB(1, 0), cB + kstep, voffB); PG8_STAGE(PG8_SA(1, 0), cA + kstep, voffA); PG8_STAGE(PG8_SB(1, 1), cB + hstep + kstep, voffB);
        PG8_WAIT_V(6); PG8_BAR;
    } else {
        PG8_STAGE(PG8_SB(0, 0), cB, voffB); PG8_STAGE(PG8_SA(0, 0), cA, voffA); PG8_STAGE(PG8_SB(0, 1), cB + hstep, voffB); PG8_STAGE(PG8_SA(0, 1), cA + hstep, voffA);
        if (wr == 1) PG8_BAR;
        PG8_WAIT_V(4); PG8_BAR;
        PG8_STAGE(PG8_SB(1, 0), cB + kstep, voffB); PG8_STAGE(PG8_SA(1, 0), cA + kstep, voffA); PG8_STAGE(PG8_SB(1, 1), cB + hstep + kstep, voffB);
        PG8_WAIT_V(6); PG8_BAR;
    }
    for (;;) {
        const bool has_next = S.next(ui + 1, nxt);
        const char* nA = has_next ? (const char*)g.A + (size_t)nxt.pm * tstep : cA; const char* nB = has_next ? (const char*)g.Bt + (size_t)nxt.pn * tstep : cB;
        for (int t = 0; t < nt; t += 2) {
            const bool last = (t == nt - 2);
            const char* a1 = cA + (size_t)(t + 1) * kstep;
            const char* a2 = last ? nA : cA + (size_t)(t + 2) * kstep; const char* b2 = last ? nB : cB + (size_t)(t + 2) * kstep;
            const char* a3 = a2 + kstep; const char* b3 = b2 + kstep;
            if (last && has_next) S.a_ready(nxt);
            if constexpr (SP2) {
            PG8_LDB(B0, 0, 0); PG8_LDB(B1, 0, 1); PG8_SCHED; PG8_LDA(At, 0, 0); PG8_STAGE(PG8_SA(1, 1), a1 + hstep, voffA);
            PG8_WAIT_V(8); PG8_WAIT_L(0); PG8_BAR; PG8_MMA(0, 0, At, B0); PG8_MMA(0, 1, At, B1); PG8_BAR; PG8_SCHED;
            PG8_LDA(At, 0, 1); PG8_STAGE(PG8_SB(0, 0), b2, voffB); PG8_STAGE(PG8_SB(0, 1), b2 + hstep, voffB); PG8_STAGE(PG8_SA(0, 0), a2, voffA);
            PG8_WAIT_V(8); PG8_WAIT_L(0); PG8_BAR; PG8_MMA(1, 0, At, B0); PG8_MMA(1, 1, At, B1); PG8_BAR; PG8_SCHED;
            PG8_LDB(B0, 1, 0); PG8_LDB(B1, 1, 1); PG8_SCHED; PG8_LDA(At, 1, 0); PG8_STAGE(PG8_SA(0, 1), a2 + hstep, voffA);
            PG8_WAIT_V(8); PG8_WAIT_L(0); PG8_BAR; PG8_MMA(0, 0, At, B0); PG8_MMA(0, 1, At, B1); PG8_BAR; PG8_SCHED;
            PG8_LDA(At, 1, 1); PG8_STAGE(PG8_SB(1, 0), b3, voffB); PG8_STAGE(PG8_SB(1, 1), b3 + hstep, voffB); PG8_STAGE(PG8_SA(1, 0), a3, voffA);
            PG8_WAIT_V(8); PG8_WAIT_L(0); PG8_BAR; PG8_MMA(1, 0, At, B0); PG8_MMA(1, 1, At, B1); PG8_BAR; PG8_SCHED;
            } else {
            PG8_LDB(B0, 0, 0); PG8_SCHED; PG8_LDA(At, 0, 0); PG8_STAGE(PG8_SA(1, 1), a1 + hstep, voffA);
            PG8_WAIT_L(8); PG8_BAR; PG8_WAIT_L(0); PG8_MMA(0, 0, At, B0); PG8_BAR; PG8_SCHED;
            PG8_LDB(B1, 0, 1); PG8_STAGE(PG8_SB(0, 0), b2, voffB);
            PG8_BAR; PG8_WAIT_L(0); PG8_MMA(0, 1, At, B1); PG8_BAR;
            PG8_LDA(At, 0, 1); PG8_STAGE(PG8_SA(0, 0), a2, voffA);
            PG8_BAR; PG8_WAIT_L(0); PG8_MMA(1, 0, At, B0); PG8_BAR; PG8_SCHED;
            PG8_STAGE(PG8_SB(0, 1), b2 + hstep, voffB);
            PG8_WAIT_V(6); PG8_BAR; PG8_MMA(1, 1, At, B1); PG8_BAR;
            PG8_LDB(B0, 1, 0); PG8_SCHED; PG8_LDA(At, 1, 0); PG8_STAGE(PG8_SA(0, 1), a2 + hstep, voffA);
            PG8_WAIT_L(8); PG8_BAR; PG8_WAIT_L(0); PG8_MMA(0, 0, At, B0); PG8_BAR; PG8_SCHED;
            PG8_LDB(B1, 1, 1); PG8_STAGE(PG8_SB(1, 0), b3, voffB);
            PG8_BAR; PG8_WAIT_L(0); PG8_MMA(0, 1, At, B1); PG8_BAR;
            PG8_LDA(At, 1, 1); PG8_STAGE(PG8_SA(1, 0), a3, voffA);
            PG8_BAR; PG8_WAIT_L(0); PG8_MMA(1, 0, At, B0); PG8_BAR; PG8_SCHED;
            PG8_STAGE(PG8_SB(1, 1), b3 + hstep, voffB);
            PG8_WAIT_V(6); PG8_BAR; PG8_MMA(1, 1, At, B1); PG8_BAR;
            }
        }
        if constexpr (ALIGN_EPI) { if (wr == 0) PG8_BAR; }
        if constexpr (!Epi::AFTER_DRAIN) { E(acc, cur, wr, wc, fr, fq); S.done(cur); }
        if (!has_next) break;
#pragma unroll
        for (int a = 0; a < 2; ++a)
#pragma unroll
            for (int b = 0; b < 2; ++b)
#pragma unroll
                for (int m = 0; m < 4; ++m)
#pragma unroll
                    for (int n = 0; n < 2; ++n) acc[a][b][m][n] = (f32x4){0.f, 0.f, 0.f, 0.f};
        cur = nxt; cA = nA; cB = nB; ++ui;
        if constexpr (ALIGN_EPI) { if (wr == 1) PG8_BAR; }
    }
    PG8_WAIT_V(0);
    if constexpr (!ALIGN_EPI) { if (wr == 0) PG8_BAR; }
    PG8_BAR;
    if constexpr (Epi::AFTER_DRAIN) { E.fused(acc, cur, wr, wc, fr, fq, lds, wid, lane); S.done(cur); }
#undef PG8_SA
#undef PG8_SB
#undef PG8_STAGE
#undef PG8_LDA
#undef PG8_LDB
#undef PG8_MMA
#undef PG8_WAIT_V
#undef PG8_WAIT_L
#undef PG8_BAR
#undef PG8_SCHED
}
}
#include <hip/hip_bf16.h>
#include <cmath>
namespace attn_body {
using bf16=__hip_bfloat16;
using bf16x8=__attribute__((ext_vector_type(8)))short;
using s16x4=__attribute__((ext_vector_type(4)))short;
using f32x16=__attribute__((ext_vector_type(16)))float;
using u32x4=__attribute__((ext_vector_type(4)))unsigned;
constexpr int BATCH=4,NHEAD=8,SEQ=8192,D=64,DM=NHEAD*D;
constexpr int NW=8,QBLK=32,QB=QBLK*NW,KVBLK=64,NQB=SEQ/QB;
constexpr int ATTN_PITCH=DM, ATTN_UNIT_ROWS=QB;
__device__ __forceinline__ int crow(int r,int hi){return (r&3)+8*(r>>2)+4*hi;}
#define SBAR() __builtin_amdgcn_sched_barrier(0)
__device__ __forceinline__ void cmask(f32x16&p0,f32x16&p1,int jb,int qrel,int hi){
  const float NEG=-INFINITY; int kb=64*jb+4*hi;
  #pragma unroll
  for(int r=0;r<16;++r){int kv=kb+(r&3)+8*(r>>2); if(kv>qrel)p0[r]=NEG; if(kv+32>qrel)p1[r]=NEG;}
}

constexpr int NSLOT=3, SLOTB=8192;
constexpr int LDS_K=0, LDS_V=NSLOT*SLOTB, LDS_WS=2*NSLOT*SLOTB, LDS_OST=LDS_WS+NW*64*4, LDS_FK=LDS_OST+NW*4096, LDS_BYTES=LDS_FK+SEQ*4;
constexpr float C2=0.125f*1.4426950408889634f;
__device__ __forceinline__ void glds16(const void*gsrc,unsigned lds_dst){unsigned keep;
  asm volatile("s_mov_b32 %0, m0\n\ts_mov_b32 m0, %2\n\ts_nop 0\n\tglobal_load_lds_dwordx4 %1, off\n\ts_mov_b32 m0, %0":"=&s"(keep):"v"(gsrc),"s"(lds_dst):"memory");}
__device__ __forceinline__ float max3f(float a,float b,float c){float r;asm("v_max3_f32 %0, %1, %2, %3":"=v"(r):"v"(a),"v"(b),"v"(c));return r;}
__device__ __forceinline__ float max2f(float a,float b){float r;asm("v_max_f32_e32 %0, %1, %2":"=v"(r):"v"(a),"v"(b));return r;}
__device__ __forceinline__ float fadd_s(float a,float b){float r;asm("v_add_f32_e32 %0, %1, %2":"=v"(r):"v"(a),"v"(b));return r;}
__device__ __forceinline__ float fsub_s(float a,float b){float r;asm("v_sub_f32_e32 %0, %1, %2":"=v"(r):"v"(a),"v"(b));return r;}
typedef float f32x2_t __attribute__((ext_vector_type(2))); typedef __bf16 bf16x2_t __attribute__((ext_vector_type(2)));
__device__ __forceinline__ unsigned cvtpk_s(float lo,float hi){f32x2_t v={lo,hi};bf16x2_t b=__builtin_convertvector(v,bf16x2_t);return __builtin_bit_cast(unsigned,b);}
#define WAIT_BAR(N) asm volatile("s_waitcnt vmcnt(" #N ") lgkmcnt(0)\n\ts_barrier":::"memory")

__device__ __forceinline__ void qkt(f32x16&p0,f32x16&p1,const char*Kslot,const bf16x8*qr,int r32,int hi){
  const char*kb=Kslot+hi*1024+r32*16;
  #pragma unroll
  for(int d0=0;d0<4;++d0){
    const bf16x8 b0=*reinterpret_cast<const bf16x8*>(kb+d0*2048);
    const bf16x8 b1=*reinterpret_cast<const bf16x8*>(kb+d0*2048+512);
    p0=__builtin_amdgcn_mfma_f32_32x32x16_bf16(b0,qr[d0],p0,0,0,0);p1=__builtin_amdgcn_mfma_f32_32x32x16_bf16(b1,qr[d0],p1,0,0,0);}
}
typedef __attribute__((address_space(3))) const char* lds_cptr;
typedef short v4i16_t __attribute__((ext_vector_type(4)));
__device__ __forceinline__ void kload8(bf16x8*kf,lds_cptr kp){
  kf[0]=*(const __attribute__((address_space(3))) bf16x8*)(kp);      kf[1]=*(const __attribute__((address_space(3))) bf16x8*)(kp+512);
  kf[2]=*(const __attribute__((address_space(3))) bf16x8*)(kp+2048); kf[3]=*(const __attribute__((address_space(3))) bf16x8*)(kp+2560);
  kf[4]=*(const __attribute__((address_space(3))) bf16x8*)(kp+4096); kf[5]=*(const __attribute__((address_space(3))) bf16x8*)(kp+4608);
  kf[6]=*(const __attribute__((address_space(3))) bf16x8*)(kp+6144); kf[7]=*(const __attribute__((address_space(3))) bf16x8*)(kp+6656);
}
__device__ __forceinline__ void kload2(bf16x8*kf,lds_cptr kp,int j){ kf[2*j]=*(const __attribute__((address_space(3))) bf16x8*)(kp+j*2048); kf[2*j+1]=*(const __attribute__((address_space(3))) bf16x8*)(kp+j*2048+512); }
__device__ __forceinline__ s16x4 vtr(lds_cptr p){ return __builtin_bit_cast(s16x4,__builtin_amdgcn_ds_read_tr16_b64_v4i16((__attribute__((address_space(3))) v4i16_t*)p)); }
__device__ __forceinline__ float rowmax(const f32x16&p0,const f32x16&p1){
  float a=max3f(p0[0],p0[1],p1[0]),b=max3f(p0[2],p0[3],p1[1]);a=max3f(a,p1[2],p1[3]);
  #pragma unroll
  for(int r=4;r<16;r+=4){a=max3f(a,p0[r],p0[r+1]);b=max3f(b,p0[r+2],p0[r+3]);a=max3f(a,p1[r],p1[r+1]);b=max3f(b,p1[r+2],p1[r+3]);}
  const float m=max2f(a,b);
  auto rr=__builtin_amdgcn_permlane32_swap(__float_as_uint(m),__float_as_uint(m),false,false);
  return max2f(__uint_as_float(rr[0]),__uint_as_float(rr[1]));
}
__device__ __forceinline__ void pv(f32x16*o,int vb,bf16x8 pa0,bf16x8 pa1,bf16x8 pa2,bf16x8 pa3){
  #pragma unroll
  for(int d0=0;d0<2;++d0){s16x4 lo[4],hi[4];
    #pragma unroll
    for(int ks=0;ks<4;++ks){
      asm volatile("ds_read_b64_tr_b16 %0,%1 offset:%c2":"=&v"(lo[ks]):"v"(vb),"i"(d0*4096+ks*1024):"memory");
      asm volatile("ds_read_b64_tr_b16 %0,%1 offset:%c2":"=&v"(hi[ks]):"v"(vb),"i"(d0*4096+ks*1024+512):"memory");}
    asm volatile("s_waitcnt lgkmcnt(0)":::"memory");SBAR();
    #define PK(k) (bf16x8){lo[k][0],lo[k][1],lo[k][2],lo[k][3],hi[k][0],hi[k][1],hi[k][2],hi[k][3]}
    o[d0]=__builtin_amdgcn_mfma_f32_32x32x16_bf16(pa0,PK(0),o[d0],0,0,0);
    o[d0]=__builtin_amdgcn_mfma_f32_32x32x16_bf16(pa1,PK(1),o[d0],0,0,0);
    o[d0]=__builtin_amdgcn_mfma_f32_32x32x16_bf16(pa2,PK(2),o[d0],0,0,0);
    o[d0]=__builtin_amdgcn_mfma_f32_32x32x16_bf16(pa3,PK(3),o[d0],0,0,0);
    #undef PK
  }
}

#ifndef ATTN_STORE16
#define ATTN_STORE16(p,v) (*(u32x4*)(p)=(v))
#endif
template<int THRL> __device__ __forceinline__ void attn_unit(int b,int h,int qb,const bf16*Q,const bf16*__restrict__ K,const bf16*__restrict__ V,bf16*O,const float*__restrict__ Fc,const float*__restrict__ NRM,char*shm,int wid_in){
  const int wid=__builtin_amdgcn_readfirstlane(wid_in); int lane_=(int)__builtin_amdgcn_mbcnt_hi(~0u,__builtin_amdgcn_mbcnt_lo(~0u,0u)); asm volatile("":"+v"(lane_));
  const int lane=lane_,tid=wid*64+lane,r32=lane&31,hi=lane>>5;
  const long rowbase=(long)b*SEQ; const int q0=qb*QB;
  const float*Fbh=Fc+(long)(b*NHEAD+h)*SEQ;
  const int NTF=(q0+QB)/KVBLK; int t_start;
  { const float*QNb=NRM+(b*NHEAD+h)*128,*KNb=NRM+4096+(b*NHEAD+h)*128;
    const float qn=fmaxf(fmaxf(QNb[4*qb],QNb[4*qb+1]),fmaxf(QNb[4*qb+2],QNb[4*qb+3])),knb=fmaxf(fmaxf(KNb[4*qb],KNb[4*qb+1]),fmaxf(KNb[4*qb+2],KNb[4*qb+3]));
    const float fq0=Fbh[q0]*1.4426950408889634f; bool k0=true,k1=true;
    if(lane<NTF-4)k0=!(qn*(KNb[lane]+knb)+(fq0-Fbh[64*lane+63]*1.4426950408889634f)<-40.f);
    if(lane+64<NTF-4)k1=!(qn*(KNb[lane+64]+knb)+(fq0-Fbh[64*(lane+64)+63]*1.4426950408889634f)<-40.f);
    const unsigned long long m0=__ballot(k0),m1=__ballot(k1);
    int tf=m0?(int)__builtin_ctzll(m0):64+(m1?(int)__builtin_ctzll(m1):64);
    tf=tf<NTF-4?tf:NTF-4; t_start=__builtin_amdgcn_readfirstlane(tf&~1); }
  { typedef float f32x4_t __attribute__((ext_vector_type(4))); __attribute__((address_space(3))) float*fk=(__attribute__((address_space(3))) float*)((__attribute__((address_space(3))) char*)shm+LDS_FK); const int n4=(q0+QB)/4;
    for(int i=16*t_start+tid;i<n4;i+=NW*64){ f32x4_t v=*(const f32x4_t*)(Fbh+4*i); v=v*(-1.4426950408889634f); *(__attribute__((address_space(3))) f32x4_t*)(fk+4*i)=v; } }
  float fq2=Fbh[q0+wid*QBLK+r32]*1.4426950408889634f; asm volatile("":"+v"(fq2));
  const bf16*Qw=Q+(rowbase+q0+wid*QBLK)*DM+h*D;
  const bf16*Kh=K+(rowbase+(long)t_start*KVBLK)*DM+h*D,*Vh=V+(rowbase+(long)t_start*KVBLK)*DM+h*D;
  const lds_cptr shm3=(lds_cptr)shm;
  const unsigned lds0=(unsigned)(uintptr_t)shm;
  float*wsf=(float*)(shm+LDS_WS)+wid*64;
  const bf16*ksrc=Kh+(long)lane*DM+wid*8;
  const bf16*vsrc=Vh+(long)(16*(wid&3)+(lane>>2))*DM+(wid>>2)*32+(lane&3)*8;
  const unsigned kdst=lds0+LDS_K+wid*1024, vdst=lds0+LDS_V+wid*1024;
  #define DMA_K(t,slot) glds16(ksrc+(long)(t)*KVBLK*DM,(unsigned)__builtin_amdgcn_readfirstlane(kdst+(slot)))
  #define DMA_V(t,slot) glds16(vsrc+(long)(t)*KVBLK*DM,(unsigned)__builtin_amdgcn_readfirstlane(vdst+(slot)))
  const int vb0=(int)(lds0+LDS_V)+((lane>>4)&1)*32+(lane&3)*8+(4*hi+((lane&15)>>2))*64;
  const char*Kbase=shm+LDS_K; bf16x8 kf[8];
  const lds_cptr kp0=shm3+LDS_K+hi*1024+r32*16; const lds_cptr vp0=shm3+LDS_V+((lane>>4)&1)*32+(lane&3)*8+(4*hi+((lane&15)>>2))*64;
  const int NT=NTF-t_start;
  DMA_K(0,0);DMA_V(0,0);DMA_K(1,SLOTB);
  bf16x8 qr[4];
  #pragma unroll
  for(int d0=0;d0<4;++d0)qr[d0]=*reinterpret_cast<const bf16x8*>(&Qw[(long)r32*DM+d0*16+hi*8]);
  float mhat=0.f,l_reg=0.f;f32x16 o[2];o[0]=f32x16{};o[1]=f32x16{};
  const __attribute__((address_space(3))) float*fkl=(const __attribute__((address_space(3))) float*)(shm3+LDS_FK)+64*t_start+4*hi;
  #define INITC(C0,C1,t) do{ const float nsc_=fq2-mhat; typedef float f32x4_t __attribute__((ext_vector_type(4))); const __attribute__((address_space(3))) float*kb_=fkl+64*(t); \
    _Pragma("unroll") for(int g_=0;g_<4;++g_){ const f32x4_t a_=*(const __attribute__((address_space(3))) f32x4_t*)(kb_+8*g_), b_=*(const __attribute__((address_space(3))) f32x4_t*)(kb_+32+8*g_); \
      _Pragma("unroll") for(int e_=0;e_<4;++e_){ C0[4*g_+e_]=nsc_+a_[e_]; C1[4*g_+e_]=nsc_+b_[e_]; } } }while(0)
  const int qrel=wid*QBLK+r32;
  #define CMASK(P0,P1,t) do{int jb_=(t)-(NT-4); if(jb_>=0)cmask(P0,P1,jb_,qrel,hi);}while(0)
  bool resc=false;
  #define START(P0,P1) do{ const float rm=rowmax(P0,P1); resc=false; \
    { const float dl=rm; mhat=fadd_s(mhat,dl); \
      _Pragma("unroll") for(int r=0;r<16;++r){P0[r]=fsub_s(P0[r],dl);P1[r]=fsub_s(P1[r],dl);} \
      } \
    _Pragma("unroll") for(int r=0;r<16;++r)P0[r]=__builtin_amdgcn_exp2f(P0[r]); }while(0)
  #define RESC() do{ if(resc){ asm volatile("s_waitcnt lgkmcnt(0)":::"memory"); \
      _Pragma("unroll") for(int d_=0;d_<2;++d_) _Pragma("unroll") for(int r=0;r<16;++r)o[d_][r]*=wsf[crow(r,hi)]; } }while(0)
  f32x16 pA0,pA1,pB0,pB1;
  int sl_prev=0,sl_cur=0,sl_next=SLOTB;
  #define ROT() do{sl_prev=sl_cur;sl_cur=sl_next;sl_next=(sl_next==(NSLOT-1)*SLOTB)?0:sl_next+SLOTB;}while(0)
  DMA_K(2,2*SLOTB);
  WAIT_BAR(3);
  INITC(pA0,pA1,0); qkt(pA0,pA1,Kbase,qr,r32,hi);asm volatile("s_nop 15\n\ts_nop 7":"+v"(pA0),"+v"(pA1));CMASK(pA0,pA1,0);
  START(pA0,pA1);
  _Pragma("unroll") for(int r=0;r<16;++r)pA1[r]=__builtin_amdgcn_exp2f(pA1[r]);
  WAIT_BAR(0);
  DMA_K(3,0);DMA_V(1,SLOTB);
  ROT();
  kload8(kf,kp0+sl_cur);
  WAIT_BAR(2);
  s16x4 vlo[8],vhi[8]; u32x4 pw0,pw1,pw2,pw3;
  #define PKW(P,B) cvtpk_s(P[B],P[B+1])
  #define PAF(k) __builtin_bit_cast(bf16x8,pw##k)
  #define VFR(i) (bf16x8){vlo[i][0],vlo[i][1],vlo[i][2],vlo[i][3],vhi[i][0],vhi[i][1],vhi[i][2],vhi[i][3]}
  #define PIN(x) asm volatile("":"+v"(x))
  #define MX3(a,b,c) __builtin_fmaxf(__builtin_fmaxf((a),(b)),(c))
  #define GAPA(MF,A0,A1,A2,A3,W0,W1,PW) do{ MF; sacc+=A0; sacc+=A1; sacc+=A2; sacc+=A3; PIN(sacc); W0; W1; PIN(PW); SBAR(); }while(0)
  #define EX(v) __builtin_amdgcn_exp2f(v)
  #define GAPB(MF,X,B) do{ MF; X[B]=EX(X[B]); X[B+1]=EX(X[B+1]); X[B+2]=EX(X[B+2]); X[B+3]=EX(X[B+3]); PIN(X); SBAR(); }while(0)
  #define VRD(i) do{ vlo[i]=vtr(vp_+(((i)>>2)*4096+((i)&3)*1024)); vhi[i]=vtr(vp_+(((i)>>2)*4096+((i)&3)*1024+512)); }while(0)
  #define KRD(G,j) do{ if(G){ kload2(kf,kp0+sl_next,j); SBAR(); } }while(0)
  #define STEP(C0,C1,P0,P1,t,GK,GV,GL) do{ SBAR(); INITC(C0,C1,t); PIN(C0); PIN(C1); SBAR(); \
    const lds_cptr vp_=vp0+sl_prev; \
    VRD(0); SBAR(); float sacc=(P0[0]+P0[1]); \
    GAPA(C0=__builtin_amdgcn_mfma_f32_32x32x16_bf16(kf[0],qr[0],C0,0,0,0), P0[2],P0[3],P0[4],P0[5],     pw0[0]=PKW(P0,0), pw0[1]=PKW(P0,2), pw0); \
    VRD(4); SBAR(); GAPA(C1=__builtin_amdgcn_mfma_f32_32x32x16_bf16(kf[1],qr[0],C1,0,0,0), P0[6],P0[7],P0[8],P0[9],     pw0[2]=PKW(P0,4), pw0[3]=PKW(P0,6), pw0); \
    VRD(1); SBAR(); GAPA(C0=__builtin_amdgcn_mfma_f32_32x32x16_bf16(kf[2],qr[1],C0,0,0,0),   P0[10],P0[11],P0[12],P0[13], pw1[0]=PKW(P0,8), pw1[1]=PKW(P0,10), pw1); \
    VRD(5); SBAR(); GAPA(C1=__builtin_amdgcn_mfma_f32_32x32x16_bf16(kf[3],qr[1],C1,0,0,0),   P0[14],P0[15],P1[0],P1[1],   pw1[2]=PKW(P0,12),pw1[3]=PKW(P0,14), pw1); \
    VRD(2); SBAR(); GAPA(C0=__builtin_amdgcn_mfma_f32_32x32x16_bf16(kf[4],qr[2],C0,0,0,0),   P1[2],P1[3],P1[4],P1[5],     pw2[0]=PKW(P1,0), pw2[1]=PKW(P1,2), pw2); \
    VRD(6); SBAR(); GAPA(C1=__builtin_amdgcn_mfma_f32_32x32x16_bf16(kf[5],qr[2],C1,0,0,0),   P1[6],P1[7],P1[8],P1[9],     pw2[2]=PKW(P1,4), pw2[3]=PKW(P1,6), pw2); \
    VRD(3); SBAR(); GAPA(C0=__builtin_amdgcn_mfma_f32_32x32x16_bf16(kf[6],qr[3],C0,0,0,0),   P1[10],P1[11],P1[12],P1[13], pw3[0]=PKW(P1,8), pw3[1]=PKW(P1,10), pw3); \
    VRD(7); SBAR(); GAPA(C1=__builtin_amdgcn_mfma_f32_32x32x16_bf16(kf[7],qr[3],C1,0,0,0),   P1[14],P1[15],0.f,0.f,       pw3[2]=PKW(P1,12),pw3[3]=PKW(P1,14), pw3); \
    l_reg+=sacc; \
    if(GK){DMA_K((t)+3,sl_cur);} if(GV){DMA_V((t)+1,sl_next);} \
    CMASK(C0,C1,t); \
    { float a=MX3(C0[0],C0[1],C1[0]),b=MX3(C0[2],C0[3],C1[1]); a=MX3(a,C1[2],C1[3]); \
      _Pragma("unroll") for(int r=4;r<16;r+=4){a=MX3(a,C0[r],C0[r+1]);b=MX3(b,C0[r+2],C0[r+3]);a=MX3(a,C1[r],C1[r+1]);b=MX3(b,C1[r+2],C1[r+3]);} \
      float rm=__builtin_fmaxf(a,b); { auto rr=__builtin_amdgcn_permlane32_swap(__float_as_uint(rm),__float_as_uint(rm),false,false); rm=__builtin_fmaxf(__uint_as_float(rr[0]),__uint_as_float(rr[1])); } \
      resc=false; \
      if(__builtin_expect(__any(rm>(float)THRL),0)){ const float dl=__builtin_fmaxf(rm,0.f); mhat+=dl; \
        _Pragma("unroll") for(int r=0;r<16;++r){C0[r]-=dl;C1[r]-=dl;} \
        const float f=__builtin_amdgcn_exp2f(-dl); l_reg*=f; if(hi==0)wsf[r32]=f; resc=true; } } \
    SBAR(); \
    GAPB(o[0]=__builtin_amdgcn_mfma_f32_32x32x16_bf16(PAF(0),VFR(0),o[0],0,0,0), C0,0); \
    GAPB(o[1]=__builtin_amdgcn_mfma_f32_32x32x16_bf16(PAF(0),VFR(4),o[1],0,0,0), C0,4); \
    KRD(GL,0); GAPB(o[0]=__builtin_amdgcn_mfma_f32_32x32x16_bf16(PAF(1),VFR(1),o[0],0,0,0), C0,8); \
    KRD(GL,1); GAPB(o[1]=__builtin_amdgcn_mfma_f32_32x32x16_bf16(PAF(1),VFR(5),o[1],0,0,0), C0,12); \
    KRD(GL,2); GAPB(o[0]=__builtin_amdgcn_mfma_f32_32x32x16_bf16(PAF(2),VFR(2),o[0],0,0,0), C1,0); \
    KRD(GL,3); GAPB(o[1]=__builtin_amdgcn_mfma_f32_32x32x16_bf16(PAF(2),VFR(6),o[1],0,0,0), C1,4); \
    GAPB(o[0]=__builtin_amdgcn_mfma_f32_32x32x16_bf16(PAF(3),VFR(3),o[0],0,0,0), C1,8); \
    GAPB(o[1]=__builtin_amdgcn_mfma_f32_32x32x16_bf16(PAF(3),VFR(7),o[1],0,0,0), C1,12); \
    }while(0)
  int t=1;
  #undef CMASK
  #define CMASK(P0,P1,t) do{}while(0)
  for(;t+5<NT;t+=2){
    STEP(pB0,pB1,pA0,pA1,t,true,true,true);     WAIT_BAR(2); RESC(); ROT();
    STEP(pA0,pA1,pB0,pB1,t+1,true,true,true);   WAIT_BAR(2); RESC(); ROT();
  }
  #undef CMASK
  #define CMASK(P0,P1,t) do{int jb_=(t)-(NT-4); if(jb_>=0)cmask(P0,P1,jb_,qrel,hi);}while(0)
  #define ENDW(tt) do{ if((tt)+3<NT){WAIT_BAR(2);} else if((tt)+2<NT){WAIT_BAR(1);} else {WAIT_BAR(0);} }while(0)
  for(;t+1<NT;t+=2){
    STEP(pB0,pB1,pA0,pA1,t,(t+3<NT),(t+1<NT),(t+1<NT));       ENDW(t);   RESC(); ROT();
    STEP(pA0,pA1,pB0,pB1,t+1,(t+4<NT),(t+2<NT),(t+2<NT));     ENDW(t+1); RESC(); ROT();
  }
  STEP(pB0,pB1,pA0,pA1,NT-1,false,false,false); RESC();
  { float sacc=pB0[0]+pB0[1]; _Pragma("unroll") for(int r=2;r<16;++r)sacc+=pB0[r]; _Pragma("unroll") for(int r=0;r<16;++r)sacc+=pB1[r]; l_reg+=sacc;
    pw0=(u32x4){PKW(pB0,0),PKW(pB0,2),PKW(pB0,4),PKW(pB0,6)};pw1=(u32x4){PKW(pB0,8),PKW(pB0,10),PKW(pB0,12),PKW(pB0,14)};pw2=(u32x4){PKW(pB1,0),PKW(pB1,2),PKW(pB1,4),PKW(pB1,6)};pw3=(u32x4){PKW(pB1,8),PKW(pB1,10),PKW(pB1,12),PKW(pB1,14)};
    SBAR(); pv(o,vb0+sl_cur,PAF(0),PAF(1),PAF(2),PAF(3)); }
  #undef PKW
  #undef PAF
  #undef VFR
  #undef PIN
  #undef MX3
  #undef GAPA
  #undef GAPB
  #undef EX
  #undef VRD
  #undef KRD
  #undef STEP
  #undef ENDW
  {auto rr=__builtin_amdgcn_permlane32_swap(__float_as_uint(l_reg),__float_as_uint(l_reg),false,false);l_reg=__uint_as_float(rr[0])+__uint_as_float(rr[1]);}
  if(hi==0)wsf[32+r32]=l_reg;asm volatile("s_waitcnt lgkmcnt(0)":::"memory");
  float rli[16];
  #pragma unroll
  for(int r=0;r<16;++r)rli[r]=__builtin_amdgcn_rcpf(wsf[32+crow(r,hi)]);
  bf16*Ow=O+(rowbase+q0+wid*QBLK)*DM+h*D;
  { bf16*stg=(bf16*)(shm+LDS_OST)+wid*2048;
    #pragma unroll
    for(int r=0;r<16;++r){const int orow=crow(r,hi);
      #pragma unroll
      for(int d0=0;d0<2;++d0)stg[orow*64+d0*32+r32]=__float2bfloat16(o[d0][r]*rli[r]);}
    asm volatile("s_waitcnt lgkmcnt(0)":::"memory");
    #pragma unroll
    for(int i=0;i<4;++i){const int row=i*8+(lane>>3),ch=lane&7; const u32x4 v=*(const u32x4*)(stg+row*64+ch*8); ATTN_STORE16(Ow+(long)row*DM+ch*8,v);} }
  asm volatile("s_waitcnt lgkmcnt(0)\n\ts_barrier":::"memory");
  #undef DMA_K
  #undef DMA_V
  #undef INITC
  #undef CMASK
  #undef START
  #undef RESC
  #undef ROT
}
constexpr int ATTN_LDS_BYTES=LDS_BYTES;
struct AttnTensors { const bf16* Q; const bf16* K; const bf16* V; bf16* O; const float* F; const float* NRM; };
struct AttnUnit { int bh; int qb; };
struct StaticOrder {
  int vcu;
  __device__ __forceinline__ explicit StaticOrder(int grid,int block):vcu((block%8)*(grid/8)+block/8){}
  __device__ __forceinline__ bool next(int i,AttnUnit&u)const{ if(i>=4)return false; const int s=vcu&7; u.bh=vcu>>3; u.qb=(i==0)?s:(i==1)?15-s:(i==2)?16+s:31-s; return true; }
  __device__ __forceinline__ void a_ready(const AttnUnit&)const{}
  __device__ __forceinline__ void done(const AttnUnit&)const{}
};
template<int THRL=8> __device__ __forceinline__ void attn_phase(char*lds,const AttnTensors&T,unsigned*qctr,volatile __attribute__((address_space(3))) unsigned*qword,int wid_in){
  const int lane0=(int)__builtin_amdgcn_mbcnt_hi(~0u,__builtin_amdgcn_mbcnt_lo(~0u,0u));
  for(;;){
    if(wid_in==0&&lane0==0){ const unsigned n=__hip_atomic_fetch_add(qctr,1u,__ATOMIC_RELAXED,__HIP_MEMORY_SCOPE_AGENT); *qword=n; }
    asm volatile("s_waitcnt vmcnt(0) lgkmcnt(0)\n\ts_barrier":::"memory");
    const int n=__builtin_amdgcn_readfirstlane((int)*qword);
    if(n>=BATCH*NHEAD*NQB)break;
    const int bh=n%(BATCH*NHEAD),qb=NQB-1-n/(BATCH*NHEAD);
    attn_unit<THRL>(bh/NHEAD,bh%NHEAD,qb,T.Q,T.K,T.V,T.O,T.F,T.NRM,lds,wid_in);
  }
}
#undef SBAR
#undef WAIT_BAR
}
#define GAS __attribute__((address_space(1)))
#define LAS __attribute__((address_space(3)))
typedef unsigned short bf16;
typedef unsigned v4u __attribute__((ext_vector_type(4)));
typedef float f32x4 __attribute__((ext_vector_type(4)));
typedef short bf16x8 __attribute__((ext_vector_type(8)));
typedef GAS unsigned gu32;
typedef GAS unsigned long long gu64;
#define RLX_AGENT __ATOMIC_RELAXED, __HIP_MEMORY_SCOPE_AGENT
#define LDS_WAIT() asm volatile("s_waitcnt lgkmcnt(0)" ::: "memory")
#define VM_WAIT() asm volatile("s_waitcnt vmcnt(0)" ::: "memory")
__device__ __forceinline__ unsigned long long rt() { return __builtin_amdgcn_s_memrealtime(); }
__device__ __forceinline__ unsigned f2bf(float f) { unsigned u = __builtin_bit_cast(unsigned, f); return (u + 0x7fffu + ((u >> 16) & 1u)) >> 16; }
__device__ __forceinline__ unsigned pk2(float lo, float hi) { return f2bf(lo) | (f2bf(hi) << 16); }

#define XB_TMO      128
#define XB_XCNT(j)  (256  + 64 * (j))
#define XB_XSUB(j)  (1280 + 64 * (j))
#define XB_XGEN(j)  (2304 + 64 * (j))
#define XB_TOP      3328
#define XB_TOPGEN   3392
#define XCD_BAR_WORDS 3456
#define XB_SPIN_CAP (1u << 18)

__device__ __forceinline__ unsigned xb_ld(unsigned* p)              { return __hip_atomic_load(p, __ATOMIC_RELAXED, __HIP_MEMORY_SCOPE_AGENT); }
__device__ __forceinline__ unsigned xb_add(unsigned* p, unsigned v) { return __hip_atomic_fetch_add(p, v, __ATOMIC_RELAXED, __HIP_MEMORY_SCOPE_AGENT); }
__device__ __forceinline__ unsigned xb_xcc_id() { return (unsigned)__builtin_amdgcn_s_getreg((3 << 11) | 20) & 0xFu; }
#define XB_SPIN(cond, bar) do { unsigned _sp = 0; while (cond) { __builtin_amdgcn_s_sleep(1); \
    if ((++_sp & 255u) == 0u) { if (xb_ld(&(bar)[XB_TMO])) break; if (_sp > XB_SPIN_CAP) { atomicAdd(&(bar)[XB_TMO], 1u); break; } } } } while (0)

struct XcdBarrier {
    unsigned* bar; unsigned x; int wv;
    volatile LAS unsigned* st;
};

__device__ __forceinline__ bool xb_t0(int wv) { return wv == 0 && __builtin_amdgcn_mbcnt_hi(~0u, __builtin_amdgcn_mbcnt_lo(~0u, 0u)) == 0u; }
__device__ __forceinline__ XcdBarrier xcd_barrier_post(unsigned* bar, volatile LAS unsigned* st, int wv) {
    XcdBarrier b; b.bar = bar; b.x = xb_xcc_id(); b.st = st; b.wv = wv;
    if (xb_t0(wv)) (void)xb_add(&bar[XB_XCNT(b.x)], 1u);
    return b;
}
__device__ __forceinline__ void xcd_barrier_complete(unsigned* bar, unsigned x, unsigned& nloc, unsigned& nx) {
    const unsigned G = gridDim.x * gridDim.y * gridDim.z;
    unsigned sum, cnt, mine, sp = 0u;
    for (;;) {
        sum = 0u; cnt = 0u; mine = 0u;
#pragma unroll
        for (unsigned j = 0; j < 16; ++j) { const unsigned c = xb_ld(&bar[XB_XCNT(j)]); sum += c; cnt += (c > 0u) ? 1u : 0u; mine = (j == x) ? c : mine; }
        if (sum == G) break;
        __builtin_amdgcn_s_sleep(1);
        if ((++sp & 255u) == 0u) { if (xb_ld(&bar[XB_TMO])) break; if (sp > XB_SPIN_CAP) { atomicAdd(&bar[XB_TMO], 1u); break; } }
    }
    nloc = mine > 0u ? mine : 1u; nx = cnt > 0u ? cnt : 1u;
}

__device__ __forceinline__ void xcd_barrier(const XcdBarrier& b) {
    asm volatile("s_waitcnt vmcnt(0)" ::: "memory");
    __syncthreads();
    if (xb_t0(b.wv)) {
        unsigned* bar = b.bar;
        __builtin_amdgcn_s_waitcnt(0);
        unsigned nloc = b.st[0], nx = b.st[1];
        if (nloc == 0u) { xcd_barrier_complete(bar, b.x, nloc, nx); b.st[0] = nloc; b.st[1] = nx; }
        const unsigned old = xb_add(&bar[XB_XSUB(b.x)], 1u);
        const unsigned gen = old / nloc;
        if (old + 1u == (gen + 1u) * nloc) {
            __builtin_amdgcn_fence(__ATOMIC_RELEASE, "agent");
            asm volatile("s_waitcnt vmcnt(0)" ::: "memory");
            const unsigned og = xb_add(&bar[XB_TOP], 1u);
            const unsigned tg = og / nx;
            if (og + 1u == (tg + 1u) * nx) xb_add(&bar[XB_TOPGEN], 1u);
            else XB_SPIN(xb_ld(&bar[XB_TOPGEN]) == tg, bar);
            __builtin_amdgcn_fence(__ATOMIC_ACQUIRE, "agent");
            xb_add(&bar[XB_XGEN(b.x)], 1u);
            asm volatile("s_waitcnt vmcnt(0)" ::: "memory");
        } else {
            XB_SPIN(xb_ld(&bar[XB_XGEN(b.x)]) == gen, bar);
            __builtin_amdgcn_fence(__ATOMIC_ACQUIRE, "agent");
            asm volatile("s_waitcnt vmcnt(0)" ::: "memory");
        }
    }
    __syncthreads();
}

constexpr int NWAVES = 8;
constexpr int RING_OFF = 0, RING_BYTES = 131072;
constexpr int LDSCTL_OFF = RING_BYTES, MISC_OFF = LDSCTL_OFF + 320;
constexpr int LDS_BYTES = 147456;
constexpr int N_PHASES = 8;

struct Frame {
    LAS unsigned char* lds;
    volatile LAS unsigned* MISC;
    gu32* ctl;
    int tid, lane, wave, vcu, G;
};
__device__ __forceinline__ float wave_sum(float v) {
#pragma unroll
    for (int o = 1; o < 64; o <<= 1) v += __shfl_xor(v, o);
    return v;
}
struct Args { const float* in[20]; float* out; unsigned char* ws; int ph_lo, ph_hi, li, pad; };

__device__ __forceinline__ void p0_transpose_item(const float* W, int ld, int nblk, const float* glo, const float* ghi, int K, bf16* WT, int item, int lane) {
    const int kb = item / nblk, nb = item % nblk, k0 = 64 * kb + 16 * (lane >> 4), n0 = 64 * nb + 4 * (lane & 15);
    f32x4 w[16];
#pragma unroll
    for (int j = 0; j < 16; ++j) w[j] = *(const GAS f32x4*)(W + (size_t)(k0 + j) * ld + n0);
    if (glo) { const float* gp = (k0 < K / 2) ? glo + k0 : ghi + (k0 - K / 2);
#pragma unroll
        for (int q = 0; q < 4; ++q) { const f32x4 g4 = *(const GAS f32x4*)(gp + 4 * q);
#pragma unroll
            for (int e = 0; e < 4; ++e) w[4 * q + e] = w[4 * q + e] * g4[e]; } }
#pragma unroll
    for (int c = 0; c < 4; ++c) { v4u o0, o1;
        o0.x = pk2(w[0][c], w[1][c]); o0.y = pk2(w[2][c], w[3][c]); o0.z = pk2(w[4][c], w[5][c]); o0.w = pk2(w[6][c], w[7][c]);
        o1.x = pk2(w[8][c], w[9][c]); o1.y = pk2(w[10][c], w[11][c]); o1.z = pk2(w[12][c], w[13][c]); o1.w = pk2(w[14][c], w[15][c]);
        bf16* dp = WT + (size_t)(n0 + c) * K + k0; *(GAS v4u*)dp = o0; *(GAS v4u*)(dp + 8) = o1; }
}
__device__ __forceinline__ float log_sigmoid(float z) { return fminf(z, 0.f) - log1pf(expf(-fabsf(z))); }

__device__ __forceinline__ void p0_prologue(Frame& F, const Args& a) {
    unsigned char* ws = a.ws;
    const float* x = a.in[0]; const float* g1 = a.in[1]; const float* w_in = a.in[2]; const float* bfv = a.in[10];
    const float* gn_l = a.in[11]; const float* gn_f = a.in[12]; const float* w_out = a.in[13]; const float* g2 = a.in[14];
    const float* w_q = a.in[15]; const float* sk = a.in[16]; const float* pu = a.in[17]; const float* pv = a.in[18];
    bf16* win_t = (bf16*)(ws + WS_WIN); bf16* wout_t = (bf16*)(ws + WS_WOUT); bf16* wq_t = (bf16*)(ws + WS_WQ); bf16* skb = (bf16*)(ws + WS_SKB);
    float* logf = (float*)(ws + WS_LOGF); bf16* h = (bf16*)(ws + WS_H);
    const int gw = F.vcu * NWAVES + F.wave, NGW = F.G * NWAVES, lane = F.lane;
    constexpr int I_IN = (DMODEL / 64) * (NG1 / 64), I_OUT = (DMODEL / 64) * (DMODEL / 64), I_Q = (DMODEL / 64) * (QPW / 64);
    constexpr int I_SK = PH * 2 * NKEY * PHALF / 512, I_WAX = 8 * 2 * 2 * 4;
    constexpr int E0 = I_IN, E1 = E0 + I_OUT, E2 = E1 + I_Q, E3 = E2, E4 = E3 + I_SK, E5 = E4, E6 = E5 + I_WAX;
    for (int it = gw; it < E6; it += NGW) {
        if (it < E0) { p0_transpose_item(w_in, INC, NG1 / 64, nullptr, nullptr, DMODEL, win_t, it, lane); continue; }
        if (it < E1) { p0_transpose_item(w_out, DMODEL, DMODEL / 64, gn_l, gn_f, DMODEL, wout_t, it - E0, lane); continue; }
        if (it < E2) { p0_transpose_item(w_q, QPW, QPW / 64, g2, g2 + DMODEL / 2, DMODEL, wq_t, it - E1, lane); continue; }
        if (it < E4) { const size_t i = (size_t)(it - E3) * 512 + lane * 8; const f32x4 s0 = *(const GAS f32x4*)(sk + i), s1 = *(const GAS f32x4*)(sk + i + 4);
            v4u o; o.x = pk2(s0[0], s0[1]); o.y = pk2(s0[2], s0[3]); o.z = pk2(s1[0], s1[1]); o.w = pk2(s1[2], s1[3]);
            { const size_t hp = i >> 14; const int key = (int)(i >> 7) & 127, c8 = (int)(i >> 3) & 15; *(GAS v4u*)(skb + hp * 16384 + ((size_t)((((key >> 5) * 2 + (c8 & 1)) * 8 + (c8 >> 1)) * 32 + (key & 31))) * 8) = o; } continue; }
        { const int f = it - E5, ks = f & 3, n = (f >> 2) & 1, mat = (f >> 3) & 1, hh = f >> 4; const float* wsrc = mat ? a.in[7] : a.in[5];
          const size_t o = ((size_t)(hh * 64 + 16 * ks + 8 * (lane >> 5))) * 64 + 32 * n + (lane & 31);
          v4u pw; pw.x = pk2(wsrc[o], wsrc[o + 64]); pw.y = pk2(wsrc[o + 128], wsrc[o + 192]); pw.z = pk2(wsrc[o + 256], wsrc[o + 320]); pw.w = pk2(wsrc[o + 384], wsrc[o + 448]);
          *(GAS v4u*)((bf16*)(ws + WS_WAX) + (size_t)f * 512 + lane * 8) = pw; }
    }
    { f32x4 gg[4];
#pragma unroll
      for (int j = 0; j < 4; ++j) gg[j] = *(const GAS f32x4*)(g2 + 16 * lane + 4 * j);
      unsigned char* u4 = ws + WS_U8; unsigned char* v4 = ws + WS_V8; float* su = (float*)(ws + WS_SU);
      for (int e = gw; e < NEXP; e += NGW) {
        const GAS f32x4* ur = (const GAS f32x4*)(pu + (size_t)e * DMODEL + 16 * lane); const GAS f32x4* vr = (const GAS f32x4*)(pv + (size_t)e * DMODEL + 16 * lane);
        f32x4 uu[4], vv[4]; float mu = 0.f, mv = 0.f;
#pragma unroll
        for (int j = 0; j < 4; ++j) { uu[j] = ur[j] * gg[j]; vv[j] = vr[j];
#pragma unroll
            for (int c = 0; c < 4; ++c) { mu = fmaxf(mu, fabsf(uu[j][c])); mv = fmaxf(mv, fabsf(vv[j][c])); } }
#pragma unroll
        for (int o = 1; o < 64; o <<= 1) { mu = fmaxf(mu, __shfl_xor(mu, o)); mv = fmaxf(mv, __shfl_xor(mv, o)); }
        const float scu = mu > 0.f ? mu * (1.f / 6.f) : 1.f, scv = mv > 0.f ? mv * (1.f / 6.f) : 1.f, iu = 1.f / scu, iv = 1.f / scv;
        unsigned qu0 = 0u, qu1 = 0u, qv0 = 0u, qv1 = 0u;
#define P0_Q4(Q, X, INV, B0, B1) do { Q = __builtin_amdgcn_cvt_scalef32_pk_fp4_f32(Q, X[0] * INV, X[1] * INV, 1.0f, B0); Q = __builtin_amdgcn_cvt_scalef32_pk_fp4_f32(Q, X[2] * INV, X[3] * INV, 1.0f, B1); } while (0)
        P0_Q4(qu0, uu[0], iu, 0, 1); P0_Q4(qu0, uu[1], iu, 2, 3); P0_Q4(qu1, uu[2], iu, 0, 1); P0_Q4(qu1, uu[3], iu, 2, 3);
        P0_Q4(qv0, vv[0], iv, 0, 1); P0_Q4(qv0, vv[1], iv, 2, 3); P0_Q4(qv1, vv[2], iv, 0, 1); P0_Q4(qv1, vv[3], iv, 2, 3);
#undef P0_Q4
        *(GAS unsigned long long*)(u4 + (size_t)e * 512 + 8 * lane) = (unsigned long long)qu0 | ((unsigned long long)qu1 << 32);
        { unsigned char* vrow = v4 + (size_t)e * 512 + 2 * (lane >> 2);
          *(GAS unsigned short*)(vrow + 32 * (4 * (lane & 3) + 0)) = (unsigned short)(qv0 & 0xffffu); *(GAS unsigned short*)(vrow + 32 * (4 * (lane & 3) + 1)) = (unsigned short)(qv0 >> 16);
          *(GAS unsigned short*)(vrow + 32 * (4 * (lane & 3) + 2)) = (unsigned short)(qv1 & 0xffffu); *(GAS unsigned short*)(vrow + 32 * (4 * (lane & 3) + 3)) = (unsigned short)(qv1 >> 16); }
        if (lane == 0) { su[2 * e] = scu; su[2 * e + 1] = scv; }
      } }
    { f32x4 gg[4];
#pragma unroll
      for (int j = 0; j < 4; ++j) gg[j] = *(const GAS f32x4*)(g1 + 256 * j + 4 * lane);
      float fw[4][4][8];
#pragma unroll
      for (int j = 0; j < 4; ++j)
#pragma unroll
          for (int c = 0; c < 4; ++c) { const int k = 256 * j + 4 * lane + c; const GAS f32x4* wr = (const GAS f32x4*)(w_in + (size_t)k * INC + NG1); const f32x4 w0 = wr[0], w1 = wr[1];
#pragma unroll
              for (int e = 0; e < 4; ++e) { fw[j][c][e] = w0[e]; fw[j][c][4 + e] = w1[e]; } }
      for (int t0 = gw; t0 < T; t0 += 2 * NGW) {
        const int t1 = (t0 + NGW < T) ? t0 + NGW : t0;
        const GAS f32x4* xr0 = (const GAS f32x4*)(x + (size_t)t0 * DMODEL) + lane; const GAS f32x4* xr1 = (const GAS f32x4*)(x + (size_t)t1 * DMODEL) + lane;
        f32x4 va[4], vb[4]; float sa = 0.f, sb = 0.f;
#pragma unroll
        for (int j = 0; j < 4; ++j) { va[j] = xr0[64 * j]; vb[j] = xr1[64 * j]; }
#pragma unroll
        for (int j = 0; j < 4; ++j) { sa += (va[j][0] * va[j][0] + va[j][1] * va[j][1]) + (va[j][2] * va[j][2] + va[j][3] * va[j][3]); sb += (vb[j][0] * vb[j][0] + vb[j][1] * vb[j][1]) + (vb[j][2] * vb[j][2] + vb[j][3] * vb[j][3]); }
        const float ra = rsqrtf(wave_sum(sa) * (1.f / DMODEL) + RMS_EPS), rb = rsqrtf(wave_sum(sb) * (1.f / DMODEL) + RMS_EPS);
        GAS unsigned long long* ha = (GAS unsigned long long*)(h + (size_t)t0 * DMODEL) + lane; GAS unsigned long long* hb = (GAS unsigned long long*)(h + (size_t)t1 * DMODEL) + lane;
#pragma unroll
        for (int j = 0; j < 4; ++j) { va[j] = va[j] * ra * gg[j]; vb[j] = vb[j] * rb * gg[j];
            ha[64 * j] = (unsigned long long)pk2(va[j][0], va[j][1]) | ((unsigned long long)pk2(va[j][2], va[j][3]) << 32);
            hb[64 * j] = (unsigned long long)pk2(vb[j][0], vb[j][1]) | ((unsigned long long)pk2(vb[j][2], vb[j][3]) << 32); }
        float fa[8], fb[8];
#pragma unroll
        for (int hh = 0; hh < 8; ++hh) { fa[hh] = 0.f; fb[hh] = 0.f; }
#pragma unroll
        for (int j = 0; j < 4; ++j)
#pragma unroll
            for (int c = 0; c < 4; ++c) {
#pragma unroll
                for (int hh = 0; hh < 8; ++hh) { fa[hh] += va[j][c] * fw[j][c][hh]; fb[hh] += vb[j][c] * fw[j][c][hh]; } }
        const bool b0 = lane & 1, b1 = lane & 2, b2 = lane & 4;
        float ya[4], yb[4], za[2], zb[2];
#pragma unroll
        for (int j = 0; j < 4; ++j) { ya[j] = (b0 ? fa[j + 4] : fa[j]) + __shfl_xor(b0 ? fa[j] : fa[j + 4], 1); yb[j] = (b0 ? fb[j + 4] : fb[j]) + __shfl_xor(b0 ? fb[j] : fb[j + 4], 1); }
#pragma unroll
        for (int j = 0; j < 2; ++j) { za[j] = (b1 ? ya[j + 2] : ya[j]) + __shfl_xor(b1 ? ya[j] : ya[j + 2], 2); zb[j] = (b1 ? yb[j + 2] : yb[j]) + __shfl_xor(b1 ? yb[j] : yb[j + 2], 2); }
        float resa = (b2 ? za[1] : za[0]) + __shfl_xor(b2 ? za[0] : za[1], 4), resb = (b2 ? zb[1] : zb[0]) + __shfl_xor(b2 ? zb[0] : zb[1], 4);
#pragma unroll
        for (int o = 8; o < 64; o <<= 1) { resa += __shfl_xor(resa, o); resb += __shfl_xor(resb, o); }
        if (lane < 8) { const int hd = 4 * (lane & 1) + (lane & 2) + ((lane >> 2) & 1); logf[(size_t)t0 * 8 + hd] = log_sigmoid(resa + bfv[hd]); logf[(size_t)t1 * 8 + hd] = log_sigmoid(resb + bfv[hd]); }
      } }
}

__device__ __forceinline__ void fcum_unit(Frame& F, int bh, const float* logf, float* fcum) {
    const int b = bh / NHEADS, hh = bh % NHEADS, s0 = F.tid * 16;
    float v[16]; float loc = 0.f;
#pragma unroll
    for (int i = 0; i < 16; ++i) { v[i] = logf[((size_t)b * SEQ + s0 + i) * 8 + hh]; loc += v[i]; }
    float inc = loc;
#pragma unroll
    for (int o = 1; o < 64; o <<= 1) { const float n = __shfl_up(inc, o); if (F.lane >= o) inc += n; }
    if (F.lane == 63) F.MISC[16 + F.wave] = __float_as_uint(inc);
    __syncthreads();
    float run = inc - loc;
    for (int w = 0; w < F.wave; ++w) run += __uint_as_float(F.MISC[16 + w]);
#pragma unroll
    for (int i = 0; i < 16; ++i) { run += v[i]; fcum[(size_t)bh * SEQ + s0 + i] = run; }
    __syncthreads();
}


namespace peer {
typedef unsigned u32;
typedef float f32x16 __attribute__((ext_vector_type(16)));
constexpr int TOK = 128;
constexpr int EX_STRIDE = 136, GT_STRIDE = 136;
constexpr int L_EX = 0, L_GT = L_EX + TOK * EX_STRIDE * 2, L_IDX = L_GT + TOK * GT_STRIDE * 2, IDX_STRIDE = 36, L_RST = L_IDX + 512 * IDX_STRIDE, L_BI = L_RST + TOK * 4, BI_WAVE = 4352, L_END = L_BI + 8 * BI_WAVE;
static_assert(L_END <= RING_BYTES && L_GT % 16 == 0 && L_IDX % 16 == 0, "PEER LDS map");
__device__ __forceinline__ u32 ordmap(float f) { const u32 u = __float_as_uint(f); return u ^ ((u32)((int)u >> 31) | 0x80000000u); }
__device__ __forceinline__ float unordmap(u32 k) { const u32 u = (k & 0x80000000u) ? (k ^ 0x80000000u) : ~k; return __uint_as_float(u); }
__device__ __forceinline__ u32 umin_(u32 a, u32 b) { return a < b ? a : b; }
__device__ __forceinline__ u32 umax_(u32 a, u32 b) { return a > b ? a : b; }
template <bool DESC> __device__ __forceinline__ void sort16(u32 (&k)[16]) {
#pragma unroll
    for (int size = 2; size <= 16; size <<= 1)
#pragma unroll
        for (int stride = size >> 1; stride > 0; stride >>= 1)
#pragma unroll
            for (int i = 0; i < 16; ++i) { const int j = i ^ stride;
                if (j > i) { const bool asc = (((i & size) == 0) != DESC); const u32 a = k[i], b = k[j], lo = umin_(a, b), hi = umax_(a, b); k[i] = asc ? lo : hi; k[j] = asc ? hi : lo; } }
}
template <bool DESC> __device__ __forceinline__ void merge16(u32 (&k)[16]) {
#pragma unroll
    for (int stride = 8; stride > 0; stride >>= 1)
#pragma unroll
        for (int i = 0; i < 16; ++i) { const int j = i ^ stride;
            if (j > i) { const u32 a = k[i], b = k[j], lo = umin_(a, b), hi = umax_(a, b); k[i] = DESC ? hi : lo; k[j] = DESC ? lo : hi; } }
}
__host__ __device__ constexpr int ccnt(int a) { return 16 / (a + 1); }
__host__ __device__ constexpr int cbase(int a) { int s = 0; for (int i = 0; i < a; ++i) s += ccnt(i); return s; }
static_assert(cbase(16) == 50, "hyperbola candidate count");
__device__ __forceinline__ int crow16(int r) { return (r & 3) + 8 * (r >> 2); }

__device__ __forceinline__ void route_tile(Frame& F, const bf16* qp, const bf16* skb, const float* sumsq, int t0) {
    int lane = F.lane; asm volatile("" : "+v"(lane));
    const int r32 = lane & 31, hi = lane >> 5, w = F.wave;
    LAS unsigned short* EXL = (LAS unsigned short*)(F.lds + RING_OFF + L_EX);
    LAS unsigned short* GTL = (LAS unsigned short*)(F.lds + RING_OFF + L_GT);
    LAS unsigned char* IDXB = F.lds + RING_OFF + L_IDX + (w * 64 + lane) * IDX_STRIDE;
    LAS float* RST = (LAS float*)(F.lds + RING_OFF + L_RST);
    for (int g = 0; g < 4; ++g) {
        const int tok = 32 * g + r32; const size_t trow = (size_t)(t0 + tok);
        const float rstd2 = rsqrtf(sumsq[trow] * (1.f / DMODEL) + RMS_EPS);
        if (w == 0 && hi == 0) RST[tok] = rstd2;
        u32 s0[16], s1[16];
#pragma unroll
        for (int p = 0; p < 2; ++p) {
            bf16x8 qf[8];
#pragma unroll
            for (int ks = 0; ks < 8; ++ks) qf[ks] = *(const GAS bf16x8*)(qp + ((size_t)((((trow >> 5) * 8 + w) * 2 + p) * 16 + 2 * ks + hi) * 32 + r32) * 8);
            u32 run[16];
#pragma unroll
            for (int nb = 0; nb < 4; ++nb) {
                f32x16 acc = {};
                const bf16* kr = skb + (size_t)(w * 2 + p) * 16384 + ((size_t)((nb * 2 + hi) * 8 * 32 + r32)) * 8;
#pragma unroll
                for (int ks = 0; ks < 8; ++ks) acc = __builtin_amdgcn_mfma_f32_32x32x16_bf16(*(const GAS bf16x8*)(kr + ks * 256), qf[ks], acc, 0, 0, 0);
                asm volatile("" ::: "memory");
                u32 blk[16];
#pragma unroll
                for (int r = 0; r < 16; ++r) blk[r] = (ordmap(acc[r]) & ~0x7Fu) | (u32)(127 - 32 * nb - crow16(r) - 4 * hi);
                if (nb == 0) { sort16<true>(blk);
#pragma unroll
                    for (int i = 0; i < 16; ++i) run[i] = blk[i]; }
                else { sort16<false>(blk);
#pragma unroll
                    for (int i = 0; i < 16; ++i) run[i] = umax_(run[i], blk[i]);
                    merge16<true>(run); }
            }
            u32 oth[16];
#pragma unroll
            for (int i = 0; i < 16; ++i) oth[i] = (u32)__shfl_xor((int)run[15 - i], 32);
#pragma unroll
            for (int i = 0; i < 16; ++i) run[i] = umax_(run[i], oth[i]);
            merge16<true>(run);
#pragma unroll
            for (int i = 0; i < 16; ++i) { if (p == 0) s0[i] = run[i]; else s1[i] = run[i]; }
        }
        { LAS u32* iw = (LAS u32*)IDXB;
#pragma unroll
          for (int j = 0; j < 4; ++j) {
              iw[j] = (127u - (s0[4 * j] & 127u)) | ((127u - (s0[4 * j + 1] & 127u)) << 8) | ((127u - (s0[4 * j + 2] & 127u)) << 16) | ((127u - (s0[4 * j + 3] & 127u)) << 24);
              iw[4 + j] = (127u - (s1[4 * j] & 127u)) | ((127u - (s1[4 * j + 1] & 127u)) << 8) | ((127u - (s1[4 * j + 2] & 127u)) << 16) | ((127u - (s1[4 * j + 3] & 127u)) << 24); } }
        float v1[16], v2[16];
#pragma unroll
        for (int i = 0; i < 16; ++i) { v1[i] = unordmap(s0[i] & ~0x7Fu); v2[i] = unordmap(s1[i] & ~0x7Fu); }
        u32 c0[16], c1[16], c2[16], c3[16];
#pragma unroll
        for (int a = 0; a < 16; ++a)
#pragma unroll
            for (int b = 0; b < ccnt(a); ++b) { const int pos = cbase(a) + b; const u32 key = (ordmap(v1[a] + v2[b]) & ~0xFFu) | (u32)(255 - (a * 16 + b));
                if (pos < 16) c0[pos] = key; else if (pos < 32) c1[pos - 16] = key; else if (pos < 48) c2[pos - 32] = key; else c3[pos - 48] = key; }
#pragma unroll
        for (int i = 2; i < 16; ++i) c3[i] = 0u;
        sort16<false>(c1);
#pragma unroll
        for (int i = 0; i < 16; ++i) c0[i] = umax_(c0[i], c1[i]);
        merge16<true>(c0);
        sort16<false>(c2);
#pragma unroll
        for (int i = 0; i < 16; ++i) c0[i] = umax_(c0[i], c2[i]);
        merge16<true>(c0);
        sort16<false>(c3);
#pragma unroll
        for (int i = 0; i < 16; ++i) c0[i] = umax_(c0[i], c3[i]);
        merge16<true>(c0);
        const float m = unordmap(c0[0] & ~0xFFu) * rstd2;
        float e[8]; float sum = 0.f; u32 ex[8];
#pragma unroll
        for (int k = 0; k < 8; ++k) { const u32 key = hi ? c0[k + 8] : c0[k]; const float ts = unordmap(key & ~0xFFu);
            e[k] = __builtin_amdgcn_exp2f((ts * rstd2 - m) * LOG2E); sum += e[k];
            const u32 flat = 255u - (key & 255u); ex[k] = (u32)IDXB[flat >> 4] * NKEY + (u32)IDXB[16 + (flat & 15u)]; }
        sum += __shfl_xor(sum, 32);
        const float inv = 1.f / sum;
        v4u exw; exw.x = ex[0] | (ex[1] << 16); exw.y = ex[2] | (ex[3] << 16); exw.z = ex[4] | (ex[5] << 16); exw.w = ex[6] | (ex[7] << 16);
        *(LAS v4u*)(EXL + tok * EX_STRIDE + w * 16 + hi * 8) = exw;
        *(LAS v4u*)(GTL + tok * GT_STRIDE + w * 16 + hi * 8) = (v4u){pk2(e[0] * inv, e[1] * inv), pk2(e[2] * inv, e[3] * inv), pk2(e[4] * inv, e[5] * inv), pk2(e[6] * inv, e[7] * inv)};
    }
}
__device__ __forceinline__ float gelu_fast(float x) {
    const float u2 = x * (1.5957691216057308f + 0.07135481627f * x * x);
    return x * __builtin_amdgcn_rcpf(1.f + __builtin_amdgcn_exp2f(-1.4426950408889634f * u2));
}
typedef float f32x2 __attribute__((ext_vector_type(2)));

__device__ __forceinline__ void sort128(u32 (&k)[8], int m) {
#pragma unroll
    for (int K = 2; K <= 128; K <<= 1) {
#pragma unroll
        for (int S = K >> 1; S > 0; S >>= 1) {
            if (S >= 8) {
                const int mm = S >> 3; const bool lower = (m & mm) == 0, up = (K == 128) ? true : ((m & (K >> 3)) == 0), keepmin = (lower == up);
#pragma unroll
                for (int r = 0; r < 8; ++r) { const u32 o = (u32)__shfl_xor((int)k[r], mm); const u32 mn = umin_(k[r], o), mx = umax_(k[r], o); k[r] = keepmin ? mn : mx; }
            } else {
#pragma unroll
                for (int r = 0; r < 8; ++r) { const int r2 = r ^ S;
                    if (r2 > r) { const u32 a = k[r], b = k[r2], mn = umin_(a, b), mx = umax_(a, b);
                        if (K < 8) { const bool up = (r & K) == 0; k[r] = up ? mn : mx; k[r2] = up ? mx : mn; }
                        else { const bool up = (K == 128) ? true : ((m & (K >> 3)) == 0); k[r] = up ? mn : mx; k[r2] = up ? mx : mn; } } }
            }
        }
    }
}
typedef int v8i __attribute__((ext_vector_type(8)));
typedef unsigned u2v __attribute__((ext_vector_type(2)));
__device__ __forceinline__ void eval_mf(Frame& F, const unsigned char* u4, const unsigned char* v4, const float* suv, const float* fg, const bf16* x1b, float* out, int t0) {
    int lane = F.lane; asm volatile("" : "+v"(lane));
    const int g = lane >> 4, m = lane & 15;
    LAS unsigned short* EXL = (LAS unsigned short*)(F.lds + RING_OFF + L_EX);
    LAS unsigned short* GTL = (LAS unsigned short*)(F.lds + RING_OFF + L_GT);
    LAS unsigned char* BI = F.lds + RING_OFF + L_BI + F.wave * BI_WAVE;
    const LAS float* RST = (const LAS float*)(F.lds + RING_OFF + L_RST);
    LAS u32* SKW = (LAS u32*)(F.lds + RING_OFF + L_IDX) + F.wave * 512;
    LAS u32* SK = SKW + g * 128;
    for (int pass = 0; pass < 4; ++pass) {
        const int tb4 = 32 * pass + 4 * F.wave, tok = tb4 + g;
        LAS unsigned short* exr = EXL + tok * EX_STRIDE; LAS unsigned short* gtr = GTL + tok * GT_STRIDE;
        { u32 k[8]; const v4u ev = *(const LAS v4u*)(exr + 8 * m); const u32 s0 = (u32)(8 * m);
          k[0] = ((ev.x & 0xffffu) << 7) | s0; k[1] = ((ev.x >> 16) << 7) | (s0 + 1); k[2] = ((ev.y & 0xffffu) << 7) | (s0 + 2); k[3] = ((ev.y >> 16) << 7) | (s0 + 3);
          k[4] = ((ev.z & 0xffffu) << 7) | (s0 + 4); k[5] = ((ev.z >> 16) << 7) | (s0 + 5); k[6] = ((ev.w & 0xffffu) << 7) | (s0 + 6); k[7] = ((ev.w >> 16) << 7) | (s0 + 7);
          sort128(k, m);
          u32 wv[8];
#pragma unroll
          for (int r = 0; r < 8; ++r) wv[r] = ((k[r] >> 7) << 16) | (u32)gtr[k[r] & 127u];
          *(LAS v4u*)(SK + m * 8) = (v4u){wv[0], wv[1], wv[2], wv[3]}; *(LAS v4u*)(SK + m * 8 + 4) = (v4u){wv[4], wv[5], wv[6], wv[7]};
          *(LAS v4u*)(exr + 8 * m) = (v4u){(k[0] >> 7) | ((k[1] >> 7) << 16), (k[2] >> 7) | ((k[3] >> 7) << 16), (k[4] >> 7) | ((k[5] >> 7) << 16), (k[6] >> 7) | ((k[7] >> 7) << 16)}; }
        asm volatile("" ::: "memory");
        {
#pragma unroll
            for (int tq = 0; tq < 4; ++tq) { const float rq = RST[tb4 + tq]; const bf16* xr = x1b + (size_t)(t0 + tb4 + tq) * DMODEL + 8 * lane;
#pragma unroll
                for (int c = 0; c < 2; ++c) { const v4u xa = *(const GAS v4u*)(xr + 512 * c); int w0 = 0, w1 = 0;
                    w0 = __builtin_amdgcn_cvt_pk_fp8_f32(__uint_as_float(xa.x << 16) * rq, __uint_as_float(xa.x & 0xffff0000u) * rq, w0, false); w0 = __builtin_amdgcn_cvt_pk_fp8_f32(__uint_as_float(xa.y << 16) * rq, __uint_as_float(xa.y & 0xffff0000u) * rq, w0, true);
                    w1 = __builtin_amdgcn_cvt_pk_fp8_f32(__uint_as_float(xa.z << 16) * rq, __uint_as_float(xa.z & 0xffff0000u) * rq, w1, false); w1 = __builtin_amdgcn_cvt_pk_fp8_f32(__uint_as_float(xa.w << 16) * rq, __uint_as_float(xa.w & 0xffff0000u) * rq, w1, true);
                    const int d = 512 * c + 8 * lane, st = d >> 7, dd = d & 127, hh = dd >> 6, e = dd & 63;
                    *(LAS u2v*)(BI + ((st * 4 + tq) * 4 + (e >> 4)) * 32 + hh * 16 + (e & 15)) = (u2v){(u32)w0, (u32)w1}; } }
        }
        asm volatile("" ::: "memory");
        v8i hb[8];
#pragma unroll
        for (int st = 0; st < 8; ++st) { v4u b0 = *(const LAS v4u*)(BI + ((st * 4 + (m & 3)) * 4 + g) * 32), b1 = *(const LAS v4u*)(BI + ((st * 4 + (m & 3)) * 4 + g) * 32 + 16);
            if (m >= 4) { b0 = (v4u){0u, 0u, 0u, 0u}; b1 = b0; }
            hb[st] = (v8i){(int)b0.x, (int)b0.y, (int)b0.z, (int)b0.w, (int)b1.x, (int)b1.y, (int)b1.z, (int)b1.w}; }
        asm volatile("" ::: "memory");
#define PEER_BAR() do { asm volatile("" ::: "memory"); __builtin_amdgcn_sched_barrier(0); } while (0)
#define PEER_LOADU(UA, KQ, SC, I) do { KQ = *(const LAS v4u*)(SK + (I)); _Pragma("unroll") for (int s4 = 0; s4 < 4; ++s4) { const u32 e_ = KQ[s4] >> 16; const u32 ro_ = e_ * 512u + 16u * (u32)m; \
            UA[s4][0] = *(const GAS v4u*)(u4 + ro_); UA[s4][1] = *(const GAS v4u*)(u4 + ro_ + 256); SC[s4] = *(const GAS f32x2*)(suv + 2 * e_); } } while (0)
#define PEER_TRANSP(UA) do { _Pragma("unroll") for (int hf = 0; hf < 2; ++hf) { \
                _Pragma("unroll") for (int s4 = 0; s4 < 4; ++s4) *(LAS v4u*)(BI + (4 * s4 + g) * 272 + 16 * m) = UA[s4][hf]; \
                asm volatile("" ::: "memory"); \
                _Pragma("unroll") for (int st = 0; st < 4; ++st) af[4 * hf + st] = *(const LAS v4u*)(BI + m * 272 + 64 * st + 16 * g); \
                asm volatile("" ::: "memory"); } } while (0)
#define PEER_DOTS(KQ, SC, I) do { f32x4 D = (f32x4){0.f, 0.f, 0.f, 0.f}; \
            _Pragma("unroll") for (int st = 0; st < 8; ++st) { const v8i a8 = (v8i){(int)af[st].x, (int)af[st].y, (int)af[st].z, (int)af[st].w, 0, 0, 0, 0}; \
                D = __builtin_amdgcn_mfma_scale_f32_16x16x128_f8f6f4(a8, hb[st], D, 4, 0, 0, 0x7f7f7f7f, 0, 0x7f7f7f7f); } \
            const int sel = lane & 3; const float mine = sel == 0 ? D[0] : sel == 1 ? D[1] : sel == 2 ? D[2] : D[3]; float act[4]; \
            _Pragma("unroll") for (int s4 = 0; s4 < 4; ++s4) { const float pre = __uint_as_float((unsigned)__builtin_amdgcn_ds_bpermute(4 * (g + 16 * s4), (int)__float_as_uint(mine))); \
                act[s4] = gelu_fast(pre * SC[s4][0]) * (__uint_as_float(KQ[s4] << 16) * SC[s4][1]); } \
            if (m == 0) *(LAS u2v*)(gtr + (I)) = (u2v){pk2(act[0], act[1]), pk2(act[2], act[3])}; } while (0)
        v4u kqA, kqB, uaA[4][2], uaB[4][2], af[8]; f32x2 scA[4], scB[4];
        PEER_LOADU(uaA, kqA, scA, 0);
        for (int i = 0; i < 128; i += 8) {
            PEER_TRANSP(uaA);
            PEER_LOADU(uaB, kqB, scB, i + 4);
            PEER_BAR();
            PEER_DOTS(kqA, scA, i);
            PEER_BAR();
            PEER_TRANSP(uaB);
            PEER_LOADU(uaA, kqA, scA, (i + 8 < 128) ? i + 8 : i + 4);
            PEER_BAR();
            PEER_DOTS(kqB, scB, i + 4);
            PEER_BAR();
        }
    }
    asm volatile("" ::: "memory");
    for (int pass = 0; pass < 4; ++pass) {
        const int tb4 = 32 * pass + 4 * F.wave, tok = tb4 + g;
        const LAS unsigned short* exr = EXL + tok * EX_STRIDE; const LAS unsigned short* acr = GTL + tok * GT_STRIDE;
        f32x2 y[32];
#pragma unroll
        for (int q = 0; q < 32; ++q) y[q] = (f32x2){0.f, 0.f};
        float* xrow = out + (size_t)(t0 + tok) * DMODEL + 4 * m; const bf16* xres = x1b + (size_t)(t0 + tok) * DMODEL + 4 * m;
#define PEER_LOADV(VB, I) do { const u2v e2_ = *(const LAS u2v*)(exr + (I)); _Pragma("unroll") for (int s4 = 0; s4 < 4; ++s4) { const u32 e_ = (s4 & 1) ? (e2_[s4 >> 1] >> 16) : (e2_[s4 >> 1] & 0xffffu); \
            const u32 ro_ = e_ * 512u + 32u * (u32)m; VB[s4][0] = *(const GAS v4u*)(v4 + ro_); VB[s4][1] = *(const GAS v4u*)(v4 + ro_ + 16); } } while (0)
#define PEER_FMAV(VB, I) do { const u2v a2_ = *(const LAS u2v*)(acr + (I)); _Pragma("unroll") for (int s4 = 0; s4 < 4; ++s4) { \
            const float act_ = (s4 & 1) ? __uint_as_float(a2_[s4 >> 1] & 0xffff0000u) : __uint_as_float(a2_[s4 >> 1] << 16); const f32x2 b2_ = (f32x2){act_, act_}; \
            _Pragma("unroll") for (int c = 0; c < 2; ++c) _Pragma("unroll") for (int d = 0; d < 4; ++d) { const unsigned w_ = VB[s4][c][d]; const int hq = 16 * c + 4 * d; \
                y[hq] = __builtin_elementwise_fma(__builtin_amdgcn_cvt_scalef32_pk_f32_fp4(w_, 1.0f, 0), b2_, y[hq]); y[hq + 1] = __builtin_elementwise_fma(__builtin_amdgcn_cvt_scalef32_pk_f32_fp4(w_, 1.0f, 1), b2_, y[hq + 1]); \
                y[hq + 2] = __builtin_elementwise_fma(__builtin_amdgcn_cvt_scalef32_pk_f32_fp4(w_, 1.0f, 2), b2_, y[hq + 2]); y[hq + 3] = __builtin_elementwise_fma(__builtin_amdgcn_cvt_scalef32_pk_f32_fp4(w_, 1.0f, 3), b2_, y[hq + 3]); } } } while (0)
        v4u vbA[4][2], vbB[4][2], vbC[4][2];
        PEER_LOADV(vbA, 0); PEER_LOADV(vbB, 4);
        PEER_BAR();
        for (int i = 0; i < 120; i += 12) {
            PEER_LOADV(vbC, i + 8);  PEER_BAR(); PEER_FMAV(vbA, i);     PEER_BAR();
            PEER_LOADV(vbA, i + 12); PEER_BAR(); PEER_FMAV(vbB, i + 4); PEER_BAR();
            PEER_LOADV(vbB, i + 16); PEER_BAR(); PEER_FMAV(vbC, i + 8); PEER_BAR();
        }
        PEER_FMAV(vbA, 120); PEER_FMAV(vbB, 124);
        float ss = 0.f;
#pragma unroll
        for (int q = 0; q < 16; ++q) { const u2v xa = *(const GAS u2v*)(xres + 64 * q); y[2 * q][0] += __uint_as_float(xa.x << 16); y[2 * q][1] += __uint_as_float(xa.x & 0xffff0000u); y[2 * q + 1][0] += __uint_as_float(xa.y << 16); y[2 * q + 1][1] += __uint_as_float(xa.y & 0xffff0000u);
            ss += (y[2 * q][0] * y[2 * q][0] + y[2 * q][1] * y[2 * q][1]) + (y[2 * q + 1][0] * y[2 * q + 1][0] + y[2 * q + 1][1] * y[2 * q + 1][1]); }
        ss += __shfl_xor(ss, 1); ss += __shfl_xor(ss, 2); ss += __shfl_xor(ss, 4); ss += __shfl_xor(ss, 8);
        const float rs = rsqrtf(ss * (1.f / DMODEL) + RMS_EPS);
        asm volatile("" ::: "memory");
#pragma unroll
        for (int q = 0; q < 16; ++q) { const f32x4 gq = *(const GAS f32x4*)(fg + 64 * q + 4 * m); f32x4 o; o[0] = y[2 * q][0] * rs * gq[0]; o[1] = y[2 * q][1] * rs * gq[1]; o[2] = y[2 * q + 1][0] * rs * gq[2]; o[3] = y[2 * q + 1][1] * rs * gq[3];
            *(GAS f32x4*)(xrow + 64 * q) = o; }
    }
}
__device__ __forceinline__ void peer_phase(Frame& F, const Args& a) {
    unsigned char* ws = a.ws;
    for (int tile = F.vcu; tile < T / TOK; tile += F.G) {
        route_tile(F, (const bf16*)(ws + WS_QP), (const bf16*)(ws + WS_SKB), (const float*)(ws + WS_SUMSQ), tile * TOK);
        __syncthreads();
        eval_mf(F, ws + WS_U8, ws + WS_V8, (const float*)(ws + WS_SU), a.in[19], (const bf16*)(ws + WS_X1B), a.out, tile * TOK);
        __syncthreads();
    }
}
}

namespace lru {
typedef float f32x16 __attribute__((ext_vector_type(16)));
constexpr int TOKT = 128, NTILE = SEQ / TOKT;
constexpr int WAVE_LDS = 14336, L_XS = 0, L_XC = 4608, L_GS = 9216, XC_STRIDE = 72  , L_SS = 8 * WAVE_LDS;
static_assert(L_SS + 32 * 8 * 4 <= RING_BYTES, "LRU LDS map");
__device__ __forceinline__ float bf2f(unsigned short h) { return __uint_as_float((unsigned)h << 16); }
__device__ __forceinline__ int crow16(int r) { return (r & 3) + 8 * (r >> 2); }
__device__ __forceinline__ float sigm(float x) { return __builtin_amdgcn_rcpf(1.f + __builtin_amdgcn_exp2f(-LOG2E * x)); }

template <bool FINAL> __device__ __forceinline__ void lru_tile(Frame& F, const Args& args, int tile) {
    int lane = F.lane; asm volatile("" : "+v"(lane));
    const int w = F.wave, j32 = lane & 31, hi = lane >> 5;
    unsigned char* ws = args.ws;
    const bf16* xr = (const bf16*)(ws + WS_XR); const bf16* gr = (const bf16*)(ws + WS_GR); float* carry = (float*)(ws + WS_CARRY);
    const float* cw = args.in[3]; const float* cb = args.in[4]; const float* ba = args.in[6]; const float* bx = args.in[8]; const float* lam = args.in[9];
    const int b = tile / NTILE, jt = tile % NTILE; const size_t trow0 = (size_t)b * SEQ + (size_t)jt * TOKT;
    LAS unsigned char* wl = F.lds + RING_OFF + w * WAVE_LDS;
    LAS unsigned short* XS = (LAS unsigned short*)(wl + L_XS); LAS unsigned short* XC = (LAS unsigned short*)(wl + L_XC); LAS unsigned short* GS = (LAS unsigned short*)(wl + L_GS);
    LAS float* SS = (LAS float*)(F.lds + RING_OFF + L_SS);
    float c_ba[2], c_bx[2], c_sp[2], c_cb[2], c_cw[2][4];
#pragma unroll
    for (int n = 0; n < 2; ++n) { const int c = 64 * w + 32 * n + j32; c_ba[n] = ba[c]; c_bx[n] = bx[c]; c_cb[n] = cb[c];
        const float l = lam[c]; c_sp[n] = 8.f * LOG2E * (fmaxf(-l, 0.f) + log1pf(expf(-fabsf(l))));
#pragma unroll
        for (int k = 0; k < 4; ++k) c_cw[n][k] = cw[k * LW + c]; }
    const bf16* wax = (const bf16*)(ws + WS_WAX);
    float hc[2] = {0.f, 0.f}, ap[2] = {1.f, 1.f};
    if (FINAL) { const float* cin = (const float*)(ws + WS_CIN) + (size_t)(b * NTILE + jt) * LW + 64 * w + j32; hc[0] = cin[0]; hc[1] = cin[32]; }
    v4u pfx[5], pfg[4], pce[2][2], pcu[2][2];
    unsigned char* cacheE = ws + WS_LA + ((size_t)(tile * 8 + w) * 4) * 4096; unsigned char* cacheU = ws + WS_LU + ((size_t)(tile * 8 + w) * 4) * 4096;
#define LRU_FETCH(B) do { const size_t tbn_ = trow0 + (B) * 32; \
        if (!FINAL) { _Pragma("unroll") for (int q_ = 0; q_ < 5; ++q_) { const int pc_ = lane + 64 * q_, row_ = pc_ >> 3, c8_ = pc_ & 7; \
            const bool z_ = (jt == 0 && (B) == 0 && row_ < 3) || pc_ >= 35 * 8; const v4u v_ = *(const GAS v4u*)(xr + (tbn_ + (z_ ? 3 : row_) - 3) * LW + w * 64 + c8_ * 8); pfx[q_] = z_ ? (v4u){0u, 0u, 0u, 0u} : v_; } } \
        if (FINAL) { _Pragma("unroll") for (int q_ = 0; q_ < 4; ++q_) { const int pc_ = lane + 64 * q_; pfg[q_] = *(const GAS v4u*)(gr + (tbn_ + (pc_ >> 3)) * LW + w * 64 + (pc_ & 7) * 8); } \
            _Pragma("unroll") for (int n_ = 0; n_ < 2; ++n_) _Pragma("unroll") for (int h_ = 0; h_ < 2; ++h_) { const size_t o_ = (size_t)(B) * 4096 + n_ * 2048 + h_ * 1024 + lane * 16; \
                pce[n_][h_] = *(const GAS v4u*)(cacheE + o_); pcu[n_][h_] = *(const GAS v4u*)(cacheU + o_); } } } while (0)
    LRU_FETCH(0);
    for (int blk = 0; blk < 4; ++blk) {
        const size_t tb = trow0 + blk * 32;
        int ln = lane; asm volatile("" : "+v"(ln));
        const int k32 = ln & 31;
        if (!FINAL) {
#pragma unroll
            for (int q = 0; q < 5; ++q) { const int pc = ln + 64 * q; if (pc < 35 * 8) *(LAS v4u*)((LAS unsigned char*)XS + (pc >> 3) * 128 + (pc & 7) * 16) = pfx[q]; } }
        v4u ce[2][2], cu[2][2];
        if (FINAL) {
#pragma unroll
            for (int n = 0; n < 2; ++n)
#pragma unroll
                for (int h = 0; h < 2; ++h) { ce[n][h] = pce[n][h]; cu[n][h] = pcu[n][h]; }
#pragma unroll
            for (int q = 0; q < 4; ++q) { const int pc = ln + 64 * q; *(LAS v4u*)((LAS unsigned char*)GS + (pc >> 3) * 128 + (pc & 7) * 16) = pfg[q]; } }
        if (blk < 3) { LRU_FETCH(blk + 1); }
        asm volatile("" ::: "memory");
        float xc[2][16];
        bf16x8 af[4];
        if (!FINAL) {
#pragma unroll
        for (int n = 0; n < 2; ++n)
#pragma unroll
            for (int g = 0; g < 4; ++g) { float xv[7];
#pragma unroll
                for (int q = 0; q < 7; ++q) xv[q] = bf2f(XS[(8 * g + 4 * hi + q) * 64 + 32 * n + j32]);
#pragma unroll
                for (int e = 0; e < 4; ++e) xc[n][4 * g + e] = c_cb[n] + ((c_cw[n][0] * xv[e] + c_cw[n][1] * xv[e + 1]) + (c_cw[n][2] * xv[e + 2] + c_cw[n][3] * xv[e + 3])); }
#pragma unroll
        for (int n = 0; n < 2; ++n)
#pragma unroll
            for (int r = 0; r < 16; ++r) XC[(crow16(r) + 4 * hi) * XC_STRIDE + 32 * n + j32] = (unsigned short)f2bf(xc[n][r]);
        asm volatile("" ::: "memory");
#pragma unroll
        for (int ks = 0; ks < 4; ++ks) af[ks] = *(const LAS bf16x8*)(XC + j32 * XC_STRIDE + 16 * ks + 8 * hi);
        asm volatile("" ::: "memory");
        }
        float yv[2][16];
#pragma unroll
        for (int n = 0; n < 2; ++n) {
            float av[16], uv[16];
            if (!FINAL) {
            f32x16 R = {}, I = {};
            bf16x8 fa[4], fx[4];
#pragma unroll
            for (int ks = 0; ks < 4; ++ks) { fa[ks] = *(const GAS bf16x8*)(wax + (size_t)(((w * 2 + 0) * 2 + n) * 4 + ks) * 512 + ln * 8); fx[ks] = *(const GAS bf16x8*)(wax + (size_t)(((w * 2 + 1) * 2 + n) * 4 + ks) * 512 + ln * 8); }
#pragma unroll
            for (int ks = 0; ks < 4; ++ks) { R = __builtin_amdgcn_mfma_f32_32x32x16_bf16(af[ks], fa[ks], R, 0, 0, 0); I = __builtin_amdgcn_mfma_f32_32x32x16_bf16(af[ks], fx[ks], I, 0, 0, 0); }
            unsigned we[8], wu[8];
#pragma unroll
            for (int k = 0; k < 8; ++k) { const float e0 = sigm(R[2 * k] + c_ba[n]) * c_sp[n], e1 = sigm(R[2 * k + 1] + c_ba[n]) * c_sp[n]; we[k] = pg8::cvt_pk_bf16(e0, e1);
                const float a0 = __builtin_amdgcn_exp2f(-__uint_as_float(we[k] << 16)), a1 = __builtin_amdgcn_exp2f(-__uint_as_float(we[k] & 0xffff0000u));
                const float u0 = __builtin_amdgcn_sqrtf(fmaxf(1.f - a0 * a0, 0.f)) * (sigm(I[2 * k] + c_bx[n]) * xc[n][2 * k]), u1 = __builtin_amdgcn_sqrtf(fmaxf(1.f - a1 * a1, 0.f)) * (sigm(I[2 * k + 1] + c_bx[n]) * xc[n][2 * k + 1]);
                wu[k] = pg8::cvt_pk_bf16(u0, u1);
                av[2 * k] = a0; av[2 * k + 1] = a1; uv[2 * k] = __uint_as_float(wu[k] << 16); uv[2 * k + 1] = __uint_as_float(wu[k] & 0xffff0000u); }
            { const size_t o = (size_t)blk * 4096 + n * 2048 + ln * 16;
              *(GAS v4u*)(cacheE + o) = (v4u){we[0], we[1], we[2], we[3]}; *(GAS v4u*)(cacheE + o + 1024) = (v4u){we[4], we[5], we[6], we[7]};
              *(GAS v4u*)(cacheU + o) = (v4u){wu[0], wu[1], wu[2], wu[3]}; *(GAS v4u*)(cacheU + o + 1024) = (v4u){wu[4], wu[5], wu[6], wu[7]}; }
            } else {
#pragma unroll
                for (int k = 0; k < 8; ++k) { const unsigned e2 = ce[n][k >> 2][k & 3], u2 = cu[n][k >> 2][k & 3];
                    av[2 * k] = __builtin_amdgcn_exp2f(-__uint_as_float(e2 << 16)); av[2 * k + 1] = __builtin_amdgcn_exp2f(-__uint_as_float(e2 & 0xffff0000u));
                    uv[2 * k] = __uint_as_float(u2 << 16); uv[2 * k + 1] = __uint_as_float(u2 & 0xffff0000u); }
            }
            float Ar[4], Hr[4], hst[4];
#pragma unroll
            for (int g = 0; g < 4; ++g) { Ar[g] = (av[4 * g] * av[4 * g + 1]) * (av[4 * g + 2] * av[4 * g + 3]);
                Hr[g] = ((uv[4 * g] * av[4 * g + 1] + uv[4 * g + 1]) * av[4 * g + 2] + uv[4 * g + 2]) * av[4 * g + 3] + uv[4 * g + 3]; }
            float hin = hc[n];
#pragma unroll
            for (int g = 0; g < 4; ++g) { float o1 = Ar[g] * hin + Hr[g]; const float x = __shfl_xor(o1, 32); const float hg = hi ? x : hin; o1 = Ar[g] * hg + Hr[g]; hst[g] = hg;
                const float y = __shfl_xor(o1, 32); hin = hi ? o1 : y;
                if (!FINAL) ap[n] *= Ar[g] * __shfl_xor(Ar[g], 32); }
            hc[n] = hin;
            if (FINAL) {
#pragma unroll
                for (int g = 0; g < 4; ++g) { float h = hst[g];
#pragma unroll
                    for (int e = 0; e < 4; ++e) { const int r = 4 * g + e; h = av[r] * h + uv[r]; yv[n][r] = h * bf2f(GS[(crow16(r) + 4 * hi) * 64 + 32 * n + j32]); } } }
        }
        if (FINAL) {
#pragma unroll
            for (int r = 0; r < 16; ++r) { float s = yv[0][r] * yv[0][r] + yv[1][r] * yv[1][r];
                s += __shfl_xor(s, 1); s += __shfl_xor(s, 2); s += __shfl_xor(s, 4); s += __shfl_xor(s, 8); s += __shfl_xor(s, 16);
                if (j32 == 0) SS[(crow16(r) + 4 * hi) * 8 + w] = s; }
            __syncthreads();
            bf16* ymix = (bf16*)(ws + WS_H);
#pragma unroll
            for (int r = 0; r < 16; ++r) { const int tk = crow16(r) + 4 * hi; const f32x4 s0 = *(const LAS f32x4*)(SS + tk * 8), s1 = *(const LAS f32x4*)(SS + tk * 8 + 4);
                const float rstd = rsqrtf(((s0[0] + s0[1]) + (s0[2] + s0[3]) + (s1[0] + s1[1]) + (s1[2] + s1[3])) * (1.f / LW) + RMS_EPS);
                bf16* yp = ymix + (tb + tk) * DMODEL + 64 * w + k32;
                yp[0] = (bf16)f2bf(yv[0][r] * rstd); yp[32] = (bf16)f2bf(yv[1][r] * rstd); }
            __syncthreads();
        }
    }
#undef LRU_FETCH
    if (!FINAL) { if (hi == 0) { float* cp = carry + ((size_t)(b * NTILE + jt) * 2) * LW + 64 * w + j32;
#pragma unroll
        for (int n = 0; n < 2; ++n) { cp[32 * n] = ap[n]; cp[LW + 32 * n] = hc[n]; } } }
    else {
        const bf16* ob = (const bf16*)(ws + WS_O); bf16* ymix = (bf16*)(ws + WS_H);
        for (int i0 = 0; i0 < 16; i0 += 4) {
            v4u vv[4];
#pragma unroll
            for (int i = 0; i < 4; ++i) vv[i] = *(const GAS v4u*)(ob + (trow0 + 16 * w + i0 + i) * AW + 8 * lane);
            float ssq[4];
#pragma unroll
            for (int i = 0; i < 4; ++i) { float s = 0.f;
#pragma unroll
                for (int c = 0; c < 4; ++c) { const float lo = __uint_as_float(vv[i][c] << 16), hi2 = __uint_as_float(vv[i][c] & 0xffff0000u); s += lo * lo + hi2 * hi2; }
                ssq[i] = s; }
#pragma unroll
            for (int o = 1; o < 64; o <<= 1) {
#pragma unroll
                for (int i = 0; i < 4; ++i) ssq[i] += __shfl_xor(ssq[i], o); }
#pragma unroll
            for (int i = 0; i < 4; ++i) { const float rstd = rsqrtf(ssq[i] * (1.f / AW) + RMS_EPS); v4u o;
#pragma unroll
                for (int c = 0; c < 4; ++c) o[c] = pk2(__uint_as_float(vv[i][c] << 16) * rstd, __uint_as_float(vv[i][c] & 0xffff0000u) * rstd);
                *(GAS v4u*)(ymix + (trow0 + 16 * w + i0 + i) * DMODEL + LW + 8 * lane) = o; } }
    }
}
__device__ __forceinline__ void norm_pass(Frame& F, const Args& a) {
    unsigned char* ws = a.ws; float* nrm = (float*)(ws + WS_NRM);
    const int gw = F.vcu * NWAVES + F.wave, NGW = F.G * NWAVES, lane = F.lane;
    for (int it = gw; it < 2 * BATCH * (SEQ / 64); it += NGW) {
        const int which = it / (BATCH * (SEQ / 64)), r = it % (BATCH * (SEQ / 64)), b = r / (SEQ / 64), t = r % (SEQ / 64);
        const bf16* src = (const bf16*)(ws + (which ? WS_K : WS_Q)) + ((size_t)b * SEQ + 64 * t) * AW + 8 * lane;
        float mx = 0.f;
#pragma unroll 8
        for (int i = 0; i < 64; ++i) { const v4u v = *(const GAS v4u*)(src + (size_t)i * AW); float s = 0.f;
#pragma unroll
            for (int c = 0; c < 4; ++c) { const float lo = __uint_as_float(v[c] << 16), hi = __uint_as_float(v[c] & 0xffff0000u); s += lo * lo + hi * hi; }
            s += __shfl_xor(s, 1); s += __shfl_xor(s, 2); s += __shfl_xor(s, 4); mx = fmaxf(mx, s); }
        if ((lane & 7) == 0) nrm[which * 4096 + (b * NHEADS + (lane >> 3)) * 128 + t] = sqrtf(mx) * 1.0001f;
    }
}
__device__ __forceinline__ void carry_prefix(Frame& F, const Args& a, int b) {
    const float* carry = (const float*)(a.ws + WS_CARRY) + (size_t)b * NTILE * 2 * LW + F.tid; float* cin = (float*)(a.ws + WS_CIN) + (size_t)b * NTILE * LW + F.tid;
    float c = 0.f;
    for (int j0 = 0; j0 < NTILE; j0 += 8) { float A[8], H[8];
#pragma unroll
        for (int j = 0; j < 8; ++j) { A[j] = carry[(size_t)(j0 + j) * 2 * LW]; H[j] = carry[(size_t)(j0 + j) * 2 * LW + LW]; }
#pragma unroll
        for (int j = 0; j < 8; ++j) { cin[(size_t)(j0 + j) * LW] = c; c = A[j] * c + H[j]; } }
}
template <bool FINAL> __device__ __forceinline__ void lru_phase(Frame& F, const Args& a) {
    for (int tile = F.vcu; tile < BATCH * NTILE; tile += F.G) { lru_tile<FINAL>(F, a, tile); __syncthreads(); }
}
}
__global__ void __launch_bounds__(NWAVES * 64, 2) mk_fwd(Args args) {
    extern __shared__ __attribute__((aligned(16))) unsigned char lds[];
    Frame F;
    F.lds = (LAS unsigned char*)lds;
    F.MISC = (volatile LAS unsigned*)(F.lds + MISC_OFF);
    F.wave = __builtin_amdgcn_readfirstlane((int)threadIdx.x >> 6); F.lane = (int)__builtin_amdgcn_mbcnt_hi(~0u, __builtin_amdgcn_mbcnt_lo(~0u, 0u)); F.tid = F.wave * 64 + F.lane;
    F.G = gridDim.x; { const int bx = blockIdx.x; F.vcu = (F.G % 8 == 0) ? (bx % 8) * (F.G / 8) + bx / 8 : bx; }
    unsigned char* ws = args.ws;
    F.ctl = (gu32*)(ws + WS_CTL);
    for (int u = F.tid; u < (LDS_BYTES - LDSCTL_OFF) / 4; u += NWAVES * 64) ((LAS unsigned*)(F.lds + LDSCTL_OFF))[u] = 0u;
    __syncthreads();
    XcdBarrier bar = xcd_barrier_post((unsigned*)(F.ctl + CW_BAR) + args.li * XCD_BAR_WORDS, F.MISC + 8, F.wave);
    const int lo = args.ph_lo, hi = args.ph_hi;
#define IN(k) (lo <= (k) && (k) < hi)
#define BOTH(k) (IN(k) && IN((k) + 1))
#define GRID_BAR() xcd_barrier(bar)

    if (IN(0)) { p0_prologue(F, args); if (BOTH(0)) GRID_BAR(); }

    if (IN(1)) {
        if (F.vcu < BATCH * NHEADS) fcum_unit(F, F.vcu, (const float*)(ws + WS_LOGF), (float*)(ws + WS_FCUM));
        pg8::Gemm g{(const pg8::bf16_t*)(ws + WS_H), (const pg8::bf16_t*)(ws + WS_WIN), T, NG1, DMODEL}; pg8::StaticOrder S; S.init(T, NG1, F.G, (int)blockIdx.x);
        pg8::EpiG1 E{(pg8::bf16_t*)(ws + WS_XR), SPLIT_STRIDE, QSCALE};
        pg8::gemm_phase<pg8::EpiG1, pg8::StaticOrder, true, true>(F.lds + RING_OFF, g, S, E, F.wave);
        if (BOTH(1)) GRID_BAR();
    }
    if (IN(2)) { lru::lru_phase<false>(F, args); lru::norm_pass(F, args); if (BOTH(2)) GRID_BAR(); }
    if (IN(3)) {
        static_assert(attn_body::ATTN_LDS_BYTES <= RING_BYTES, "attention LDS vs frame");
        if (F.vcu < BATCH) lru::carry_prefix(F, args, F.vcu);
        const attn_body::AttnTensors AT{(const attn_body::bf16*)(ws + WS_Q), (const attn_body::bf16*)(ws + WS_K), (const attn_body::bf16*)(ws + WS_V), (attn_body::bf16*)(ws + WS_O), (const float*)(ws + WS_FCUM), (const float*)(ws + WS_NRM)};
        attn_body::attn_phase<8>((char*)lds + RING_OFF, AT, (unsigned*)(F.ctl + CW_ATTQ), F.MISC + 24, F.wave);
        if (BOTH(3)) GRID_BAR();
    }
    if (IN(4)) { lru::lru_phase<true>(F, args); if (BOTH(4)) GRID_BAR(); }
    if (IN(5)) {
        pg8::Gemm g{(const pg8::bf16_t*)(ws + WS_H), (const pg8::bf16_t*)(ws + WS_WOUT), T, DMODEL, DMODEL}; pg8::StaticOrder S; S.init(T, DMODEL, F.G, (int)blockIdx.x);
        pg8::EpiG2 E{args.in[0], (pg8::bf16_t*)(ws + WS_X1B), (float*)(ws + WS_SUMSQ), DMODEL};
        pg8::gemm_phase<pg8::EpiG2, pg8::StaticOrder, true, true>(F.lds + RING_OFF, g, S, E, F.wave);
        if (BOTH(5)) GRID_BAR();
    }
    if (IN(6)) {
        pg8::Gemm g{(const pg8::bf16_t*)(ws + WS_X1B), (const pg8::bf16_t*)(ws + WS_WQ), T, QPW, DMODEL}; pg8::StaticOrder S; S.init(T, QPW, F.G, (int)blockIdx.x);
        pg8::EpiG3 E{(pg8::bf16_t*)(ws + WS_QP), QPW};
        pg8::gemm_phase<pg8::EpiG3, pg8::StaticOrder, true, true>(F.lds + RING_OFF, g, S, E, F.wave);
        if (BOTH(6)) GRID_BAR();
    }
    if (IN(7)) { peer::peer_phase(F, args); }
#undef IN
#undef BOTH
#undef GRID_BAR
}

extern "C" void kernel_launch(void* const* d_in, const int* in_sizes, int n_in, void* d_out, int out_size, void* d_ws, size_t ws_size, hipStream_t stream) {
    static int grid = 0;
    if (grid == 0) {
        if (n_in != 20 || in_sizes[0] != T * DMODEL || out_size != T * DMODEL || ws_size < WS_END) { fprintf(stderr, "kernel_launch: unexpected shapes (n_in %d, ws %zu)\n", n_in, ws_size); grid = -1; return; }
        int dev = 0, cus = 0;
        if (hipGetDevice(&dev) != hipSuccess || hipDeviceGetAttribute(&cus, hipDeviceAttributeMultiprocessorCount, dev) != hipSuccess) { grid = -1; return; }
        if (hipFuncSetAttribute((const void*)mk_fwd, hipFuncAttributeMaxDynamicSharedMemorySize, LDS_BYTES) != hipSuccess) { fprintf(stderr, "kernel_launch: hipFuncSetAttribute failed\n"); grid = -1; return; }
        (void)hipGetLastError();
        grid = cus;
    }
    if (grid < 0) return;
    if (hipMemsetAsync((char*)d_ws + WS_CTL, 0, CTL_ZERO_BYTES, stream) != hipSuccess) return;
    Args a{};
    for (int i = 0; i < 20; ++i) a.in[i] = (const float*)d_in[i];
    a.out = (float*)d_out; a.ws = (unsigned char*)d_ws; a.ph_lo = 0; a.ph_hi = N_PHASES; a.li = 0;
    hipLaunchKernelGGL(mk_fwd, dim3(grid), dim3(NWAVES * 64), LDS_BYTES, stream, a);
}
```

```cpp
#include <hip/hip_runtime.h>
#include <hip/hip_bf16.h>
#include <cstdio>
#include <cstdint>
#include <cmath>

constexpr int BATCH = 4, SEQ = 8192, DMODEL = 1024, T = BATCH * SEQ;
constexpr int LW = 512, AW = 512, NHEADS = 8, HD = 64, INC = 2568, NG1 = 2560;
constexpr int PH = 8, NKEY = 128, PHALF = 128, TOPK = 16, NEXP = NKEY * NKEY, QPW = 2048;
constexpr float RMS_EPS = 1e-6f;
constexpr float LOG2E = 1.4426950408889634f;
constexpr float QSCALE = 0.125f * LOG2E;
constexpr size_t MiB = 1u << 20;
constexpr size_t WS_CTL = 0, CTL_ZERO_BYTES = 1 * MiB;
constexpr size_t WS_WIN = 2 * MiB, WS_WOUT = 8 * MiB, WS_WQ = 10 * MiB, WS_SKB = 14 * MiB, WS_WFL = 15 * MiB,
                 WS_LOGF = 16 * MiB, WS_FCUM = 17 * MiB, WS_CARRY = 18 * MiB, WS_SUMSQ = 512 * 1024  , WS_WAX = 20 * MiB, WS_CIN = 23 * MiB  , WS_NRM = 22 * MiB  ,
                 WS_H = 32 * MiB, WS_XR = 96 * MiB, WS_GR = 128 * MiB, WS_Q = 160 * MiB, WS_K = 192 * MiB, WS_V = 224 * MiB,
                 WS_X1B = 256 * MiB, WS_O = 256 * MiB  , WS_QP = 96 * MiB, WS_UT = 320 * MiB, WS_VT = 352 * MiB, WS_U8 = 320 * MiB, WS_V8 = 336 * MiB, WS_SU = 21 * MiB, WS_SV = 21 * MiB + 65536, WS_LA = 384 * MiB, WS_LU = 448 * MiB, WS_END = 512 * MiB;
constexpr size_t SPLIT_STRIDE = (WS_GR - WS_XR) / 2;
constexpr int CW_TMO = 0, CW_ATTQ = 2048, CW_BAR = 4096;

namespace pg8 {
#define PG8_LAS __attribute__((address_space(3)))
typedef unsigned short bf16_t;
typedef short bf16x8 __attribute__((ext_vector_type(8)));
typedef float f32x4 __attribute__((ext_vector_type(4)));
typedef unsigned u32x4 __attribute__((ext_vector_type(4)));
constexpr int BM = 256, BK = 64, HALF = 128, HTB = HALF * BK * 2  , STAGE_BYTES = 8 * HTB, NXCD = 8, WGM = 8;

__host__ __device__ __forceinline__ int lds_byte(int r, int c) { const int st = (r >> 4) * 2 + (c >> 5), rr = r & 15, cc = c & 31, ob = rr * 64 + cc * 2; return st * 1024 + (ob ^ (((ob >> 9) & 1) << 5)); }
__host__ __device__ __forceinline__ void stage_rc(int b, int& R, int& C) { const int st = b / 1024, sb = b % 1024, swz = sb ^ (((sb >> 9) & 1) << 5); R = (st >> 1) * 16 + swz / 64; C = (st & 1) * 32 + (swz % 64) / 2; }
__host__ __device__ __forceinline__ int perm32(int rho) { const int n = rho >> 4, i = rho & 15; return 8 * (i >> 2) + 4 * n + (i & 3); }

struct Unit { int pm, pn; };
struct Gemm { const bf16_t* A; const bf16_t* Bt; int M, N, K; };

struct StaticOrder {
    int nM, nN, nwg, G, c;
    __host__ __device__ void init(int M, int N, int G_, int c_) { nM = M / BM; nN = N / BM; nwg = nM * nN; G = G_; c = c_; }
    __host__ __device__ bool next(int i, Unit& u) const {
        const long L = (long)i * G + c; if (L >= nwg) return false;
        int wgid = (int)L; { const int q = nwg / NXCD, r = nwg % NXCD, xcd = wgid % NXCD, off = wgid / NXCD; wgid = (xcd < r ? xcd * (q + 1) : r * (q + 1) + (xcd - r) * q) + off; }
        const int nig = WGM * nN, gid = wgid / nig, fm = gid * WGM, gsz = (nM - fm) < WGM ? (nM - fm) : WGM;
        u.pm = fm + ((wgid % nig) % gsz); u.pn = (wgid % nig) / gsz; return true;
    }
    __device__ __forceinline__ void a_ready(const Unit&) const {}
    __device__ __forceinline__ void done(const Unit&) const {}
};

__device__ __forceinline__ unsigned cvt_pk_bf16(float lo, float hi) { unsigned r; asm volatile("v_cvt_pk_bf16_f32 %0, %1, %2" : "=v"(r) : "v"(lo), "v"(hi)); return r; }
typedef unsigned u32x2 __attribute__((ext_vector_type(2)));
__device__ __forceinline__ float gelu_fast(float x) {
    const float u2 = x * (1.5957691216057308f + 0.07135481627f * x * x);
    return x * __builtin_amdgcn_rcpf(1.f + __builtin_amdgcn_exp2f(-1.4426950408889634f * u2));
}
struct EpiG1 {
    static constexpr bool PERM = true, AFTER_DRAIN = false;
    bf16_t* base0; size_t split_stride; float qscale;
    __device__ __forceinline__ void operator()(const f32x4 (&acc)[2][2][4][2], const Unit& u, int wr, int wc, int fr, int fq) const {
        const int s = u.pn >> 1; bf16_t* base = base0 + (size_t)s * split_stride;
        const int row0 = u.pm * BM + wr * 64 + fr, col0 = (u.pn & 1) * 256 + wc * 32 + 8 * fq;
#pragma unroll
        for (int ai = 0; ai < 2; ++ai)
#pragma unroll
            for (int m = 0; m < 4; ++m) { bf16_t* rowp = base + (size_t)(row0 + ai * HALF + m * 16) * 512 + col0;
#pragma unroll
                for (int bj = 0; bj < 2; ++bj) { f32x4 v0 = acc[ai][bj][m][0], v1 = acc[ai][bj][m][1];
                    if (s == 1) {
#pragma unroll
                        for (int e = 0; e < 4; ++e) { v0[e] = gelu_fast(v0[e]); v1[e] = gelu_fast(v1[e]); } }
                    else if (s == 2) { v0 = v0 * qscale; v1 = v1 * qscale; }
                    u32x4 w; w.x = cvt_pk_bf16(v0[0], v0[1]); w.y = cvt_pk_bf16(v0[2], v0[3]); w.z = cvt_pk_bf16(v1[0], v1[1]); w.w = cvt_pk_bf16(v1[2], v1[3]);
                    *(u32x4*)(rowp + bj * HALF) = w; } }
    }
};
struct EpiG2 {
    static constexpr bool PERM = true, AFTER_DRAIN = false;
    const float* resid; bf16_t* xb; float* sumsq; int ldc;
    __device__ __forceinline__ void operator()(const f32x4 (&acc)[2][2][4][2], const Unit& u, int wr, int wc, int fr, int fq) const {
        const int row0 = u.pm * BM + wr * 64 + fr, col0 = u.pn * BM + wc * 32 + 8 * fq;
#pragma unroll
        for (int ai = 0; ai < 2; ++ai) {
            f32x4 rs[4][2][2];
#pragma unroll
            for (int m = 0; m < 4; ++m) { const size_t off = (size_t)(row0 + ai * HALF + m * 16) * ldc + col0;
#pragma unroll
                for (int bj = 0; bj < 2; ++bj)
#pragma unroll
                    for (int n = 0; n < 2; ++n) rs[m][bj][n] = *(const f32x4*)(resid + off + bj * HALF + n * 4); }
#pragma unroll
            for (int m = 0; m < 4; ++m) { const int r = row0 + ai * HALF + m * 16; const size_t off = (size_t)r * ldc + col0; float ss = 0.f;
#pragma unroll
                for (int bj = 0; bj < 2; ++bj) { const f32x4 x0 = rs[m][bj][0] + acc[ai][bj][m][0], x1 = rs[m][bj][1] + acc[ai][bj][m][1];
                    ss += ((x0[0] * x0[0] + x0[1] * x0[1]) + (x0[2] * x0[2] + x0[3] * x0[3])) + ((x1[0] * x1[0] + x1[1] * x1[1]) + (x1[2] * x1[2] + x1[3] * x1[3]));
                    u32x4 w; w.x = cvt_pk_bf16(x0[0], x0[1]); w.y = cvt_pk_bf16(x0[2], x0[3]); w.z = cvt_pk_bf16(x1[0], x1[1]); w.w = cvt_pk_bf16(x1[2], x1[3]);
                    *(u32x4*)(xb + off + bj * HALF) = w; }
                ss += __shfl_xor(ss, 16); ss += __shfl_xor(ss, 32);
                if (fq == 0) atomicAdd(sumsq + r, ss); }
            asm volatile("" ::: "memory"); }
    }
};
struct EpiG3 {
    static constexpr bool PERM = true, AFTER_DRAIN = false;
    bf16_t* O; int ldc;
    __device__ __forceinline__ void operator()(const f32x4 (&acc)[2][2][4][2], const Unit& u, int wr, int wc, int fr, int fq) const {
        const int row0 = u.pm * BM + wr * 64 + fr;
#pragma unroll
        for (int ai = 0; ai < 2; ++ai)
#pragma unroll
            for (int m = 0; m < 4; ++m) { const int t = row0 + ai * HALF + m * 16;
#pragma unroll
                for (int bj = 0; bj < 2; ++bj) { const f32x4 v0 = acc[ai][bj][m][0], v1 = acc[ai][bj][m][1];
                    u32x4 w; w.x = cvt_pk_bf16(v0[0], v0[1]); w.y = cvt_pk_bf16(v0[2], v0[3]); w.z = cvt_pk_bf16(v1[0], v1[1]); w.w = cvt_pk_bf16(v1[2], v1[3]);
                    *(u32x4*)(O + ((size_t)(((((t >> 5) * 8 + u.pn) * 2 + bj) * 16 + 4 * wc + fq) * 32 + (t & 31))) * 8) = w; } }
    }
};

template <class Epi, class Sched, bool ALIGN_EPI = false, bool SP2 = false>
__device__ __forceinline__ void gemm_phase(PG8_LAS unsigned char* lds, const Gemm g, const Sched& S, const Epi& E, int wid_in) {
    const int wid = __builtin_amdgcn_readfirstlane(wid_in), lane = (int)__builtin_amdgcn_mbcnt_hi(~0u, __builtin_amdgcn_mbcnt_lo(~0u, 0u)), tid = wid * 64 + lane, wr = wid >> 2, wc = wid & 3, fr = lane & 15, fq = lane >> 4;
    const int K = g.K, nt = K / BK;
    unsigned voffA[2], voffB[2];
#pragma unroll
    for (int i = 0; i < 2; ++i) { int R, C; stage_rc(tid * 16 + i * 8192, R, C); const int Rb = Epi::PERM ? ((R & ~31) + perm32(R & 31)) : R;
        voffA[i] = (unsigned)(R * K + C) * 2u; voffB[i] = (unsigned)(Rb * K + C) * 2u; }
    const size_t kstep = (size_t)(BK * 2);
    const size_t hstep = (size_t)HALF * K * 2;
    const size_t tstep = 2 * hstep;
    const unsigned ldsw = (unsigned)wid * 1024u;
    const int aoff = lds_byte(wr * 64 + fr, fq * 8), boff = lds_byte(wc * 32 + fr, fq * 8);
#define PG8_SA(b, h) (((b) * 2 + (h)) * HTB)
#define PG8_SB(b, h) ((4 + (b) * 2 + (h)) * HTB)
#define PG8_STAGE(bufoff, gbase, voff) do { _Pragma("unroll") for (int _i = 0; _i < 2; ++_i) \
        __builtin_amdgcn_global_load_lds((const unsigned*)((const char*)(gbase) + (voff)[_i]), (PG8_LAS unsigned*)(lds + (bufoff) + ldsw + _i * 8192), 16, 0, 0); } while (0)
#define PG8_LDA(dst, b, h) do { _Pragma("unroll") for (int m = 0; m < 4; ++m) _Pragma("unroll") for (int k = 0; k < 2; ++k) dst[m][k] = *(const PG8_LAS bf16x8*)(lds + PG8_SA(b, h) + aoff + m * 2048 + k * 1024); } while (0)
#define PG8_LDB(dst, b, h) do { _Pragma("unroll") for (int n = 0; n < 2; ++n) _Pragma("unroll") for (int k = 0; k < 2; ++k) dst[n][k] = *(const PG8_LAS bf16x8*)(lds + PG8_SB(b, h) + boff + n * 2048 + k * 1024); } while (0)
#define PG8_MMA(ai, bj, At, Bt) do { __builtin_amdgcn_s_setprio(1); _Pragma("unroll") for (int m = 0; m < 4; ++m) _Pragma("unroll") for (int n = 0; n < 2; ++n) _Pragma("unroll") for (int k = 0; k < 2; ++k) \
        acc[ai][bj][m][n] = __builtin_amdgcn_mfma_f32_16x16x32_bf16(Bt[n][k], At[m][k], acc[ai][bj][m][n], 0, 0, 0); __builtin_amdgcn_s_setprio(0); } while (0)
#define PG8_WAIT_V(n) asm volatile("s_waitcnt vmcnt(" #n ")" ::: "memory")
#define PG8_WAIT_L(n) asm volatile("s_waitcnt lgkmcnt(" #n ")" ::: "memory")
#define PG8_BAR __builtin_amdgcn_s_barrier()
#define PG8_SCHED __builtin_amdgcn_sched_barrier(0)
    Unit cur, nxt; int ui = 0;
    if (!S.next(0, cur)) return;
    f32x4 acc[2][2][4][2];
#pragma unroll
    for (int a = 0; a < 2; ++a)
#pragma unroll
        for (int b = 0; b < 2; ++b)
#pragma unroll
            for (int m = 0; m < 4; ++m)
#pragma unroll
                for (int n = 0; n < 2; ++n) acc[a][b][m][n] = (f32x4){0.f, 0.f, 0.f, 0.f};
    bf16x8 At[4][2], B0[2][2], B1[2][2];
    const char* cA = (const char*)g.A + (size_t)cur.pm * tstep; const char* cB = (const char*)g.Bt + (size_t)cur.pn * tstep;
    S.a_ready(cur);
    if constexpr (SP2) {
        PG8_STAGE(PG8_SB(0, 0), cB, voffB); PG8_STAGE(PG8_SB(0, 1), cB + hstep, voffB); PG8_STAGE(PG8_SA(0, 0), cA, voffA); PG8_STAGE(PG8_SA(0, 1), cA + hstep, voffA);
        if (wr == 1) PG8_BAR;
        PG8_WAIT_V(2); PG8_BAR;
        PG8_STAGE(PG8_SB(1, 0), cB + kstep, voffB); PG8_STAGE(PG8_SA(1, 0), cA + kstep, voffA); PG8_STAGE(PG8_SB(1, 1), cB + hstep + kstep, voffB);
        PG8_WAIT_V(6); PG8_BAR;
    } else {
        PG8_STAGE(PG8_SB(0, 0), cB, voffB); PG8_STAGE(PG8_SA(0, 0), cA, voffA); PG8_STAGE(PG8_SB(0, 1), cB + hstep, voffB); PG8_STAGE(PG8_SA(0, 1), cA + hstep, voffA);
        if (wr == 1) PG8_BAR;
        PG8_WAIT_V(4); PG8_BAR;
        PG8_STAGE(PG8_SB(1, 0), cB + kstep, voffB); PG8_STAGE(PG8_SA(1, 0), cA + kstep, voffA); PG8_STAGE(PG8_SB(1, 1), cB + hstep + kstep, voffB);
        PG8_WAIT_V(6); PG8_BAR;
    }
    for (;;) {
        const bool has_next = S.next(ui + 1, nxt);
        const char* nA = has_next ? (const char*)g.A + (size_t)nxt.pm * tstep : cA; const char* nB = has_next ? (const char*)g.Bt + (size_t)nxt.pn * tstep : cB;
        for (int t = 0; t < nt; t += 2) {
            const bool last = (t == nt - 2);
            const char* a1 = cA + (size_t)(t + 1) * kstep;
            const char* a2 = last ? nA : cA + (size_t)(t + 2) * kstep; const char* b2 = last ? nB : cB + (size_t)(t + 2) * kstep;
            const char* a3 = a2 + kstep; const char* b3 = b2 + kstep;
            if (last && has_next) S.a_ready(nxt);
            if constexpr (SP2) {
            PG8_LDB(B0, 0, 0); PG8_LDB(B1, 0, 1); PG8_SCHED; PG8_LDA(At, 0, 0); PG8_STAGE(PG8_SA(1, 1), a1 + hstep, voffA);
            PG8_WAIT_V(8); PG8_WAIT_L(0); PG8_BAR; PG8_MMA(0, 0, At, B0); PG8_MMA(0, 1, At, B1); PG8_BAR; PG8_SCHED;
            PG8_LDA(At, 0, 1); PG8_STAGE(PG8_SB(0, 0), b2, voffB); PG8_STAGE(PG8_SB(0, 1), b2 + hstep, voffB); PG8_STAGE(PG8_SA(0, 0), a2, voffA);
            PG8_WAIT_V(8); PG8_WAIT_L(0); PG8_BAR; PG8_MMA(1, 0, At, B0); PG8_MMA(1, 1, At, B1); PG8_BAR; PG8_SCHED;
            PG8_LDB(B0, 1, 0); PG8_LDB(B1, 1, 1); PG8_SCHED; PG8_LDA(At, 1, 0); PG8_STAGE(PG8_SA(0, 1), a2 + hstep, voffA);
            PG8_WAIT_V(8); PG8_WAIT_L(0); PG8_BAR; PG8_MMA(0, 0, At, B0); PG8_MMA(0, 1, At, B1); PG8_BAR; PG8_SCHED;
            PG8_LDA(At, 1, 1); PG8_STAGE(PG8_SB(1, 0), b3, voffB); PG8_STAGE(PG8_SB(1, 1), b3 + hstep, voffB); PG8_STAGE(PG8_SA(1, 0), a3, voffA);
            PG8_WAIT_V(8); PG8_WAIT_L(0); PG8_BAR; PG8_MMA(1, 0, At, B0); PG8_MMA(1, 1, At, B1); PG8_BAR; PG8_SCHED;
            } else {
            PG8_LDB(B0, 0, 0); PG8_SCHED; PG8_LDA(At, 0, 0); PG8_STAGE(PG8_SA(1, 1), a1 + hstep, voffA);
            PG8_WAIT_L(8); PG8_BAR; PG8_WAIT_L(0); PG8_MMA(0, 0, At, B0); PG8_BAR; PG8_SCHED;
            PG8_LDB(B1, 0, 1); PG8_STAGE(PG8_SB(0, 0), b2, voffB);
            PG8_BAR; PG8_WAIT_L(0); PG8_MMA(0, 1, At, B1); PG8_BAR;
            PG8_LDA(At, 0, 1); PG8_STAGE(PG8_SA(0, 0), a2, voffA);
            PG8_BAR; PG8_WAIT_L(0); PG8_MMA(1, 0, At, B0); PG8_BAR; PG8_SCHED;
            PG8_STAGE(PG8_SB(0, 1), b2 + hstep, voffB);
            PG8_WAIT_V(6); PG8_BAR; PG8_MMA(1, 1, At, B1); PG8_BAR;
            PG8_LDB(B0, 1, 0); PG8_SCHED; PG8_LDA(At, 1, 0); PG8_STAGE(PG8_SA(0, 1), a2 + hstep, voffA);
            PG8_WAIT_L(8); PG8_BAR; PG8_WAIT_L(0); PG8_MMA(0, 0, At, B0); PG8_BAR; PG8_SCHED;
            PG8_LDB(B1, 1, 1); PG8_STAGE(PG8_SB(1, 0), b3, voffB);
            PG8_BAR; PG8_WAIT_L(0); PG8_MMA(0, 1, At, B1); PG8_BAR;
            PG8_LDA(At, 1, 1); PG8_STAGE(PG8_SA(1, 0), a3, voffA);
            PG8_BAR; PG8_WAIT_L(0); PG8_MMA(1, 0, At, B0); PG8_BAR; PG8_SCHED;
            PG8_STAGE(PG8_SB(1, 1), b3 + hstep, voffB);
            PG8_WAIT_V(6); PG8_BAR; PG8_MMA(1, 1, At, B1); PG8_BAR;
            }
        }
        if constexpr (ALIGN_EPI) { if (wr == 0) PG8_BAR; }
        if constexpr (!Epi::AFTER_DRAIN) { E(acc, cur, wr, wc, fr, fq); S.done(cur); }
        if (!has_next) break;
#pragma unroll
        for (int a = 0; a < 2; ++a)
#pragma unroll
            for (int b = 0; b < 2; ++b)
#pragma unroll
                for (int m = 0; m < 4; ++m)
#pragma unroll
                    for (int n = 0; n < 2; ++n) acc[a][b][m][n] = (f32x4){0.f, 0.f, 0.f, 0.f};
        cur = nxt; cA = nA; cB = nB; ++ui;
        if constexpr (ALIGN_EPI) { if (wr == 1) PG8_BAR; }
    }
    PG8_WAIT_V(0);
    if constexpr (!ALIGN_EPI) { if (wr == 0) PG8_BAR; }
    PG8_BAR;
    if constexpr (Epi::AFTER_DRAIN) { E.fused(acc, cur, wr, wc, fr, fq, lds, wid, lane); S.done(cur); }
#undef PG8_SA
#undef PG8_SB
#undef PG8_STAGE
#undef PG8_LDA
#undef PG8_LDB
#undef PG8_MMA
#undef PG8_WAIT_V
#undef PG8_WAIT_L
#undef PG8_BAR
#undef PG8_SCHED
}
}
#include <hip/hip_bf16.h>
#include <cmath>
namespace attn_body {
using bf16=__hip_bfloat16;
using bf16x8=__attribute__((ext_vector_type(8)))short;
using s16x4=__attribute__((ext_vector_type(4)))short;
using f32x16=__attribute__((ext_vector_type(16)))float;
using u32x4=__attribute__((ext_vector_type(4)))unsigned;
constexpr int BATCH=4,NHEAD=8,SEQ=8192,D=64,DM=NHEAD*D;
constexpr int NW=8,QBLK=32,QB=QBLK*NW,KVBLK=64,NQB=SEQ/QB;
constexpr int ATTN_PITCH=DM, ATTN_UNIT_ROWS=QB;
__device__ __forceinline__ int crow(int r,int hi){return (r&3)+8*(r>>2)+4*hi;}
#define SBAR() __builtin_amdgcn_sched_barrier(0)
__device__ __forceinline__ void cmask(f32x16&p0,f32x16&p1,int jb,int qrel,int hi){
  const float NEG=-INFINITY; int kb=64*jb+4*hi;
  #pragma unroll
  for(int r=0;r<16;++r){int kv=kb+(r&3)+8*(r>>2); if(kv>qrel)p0[r]=NEG; if(kv+32>qrel)p1[r]=NEG;}
}

constexpr int NSLOT=3, SLOTB=8192;
constexpr int LDS_K=0, LDS_V=NSLOT*SLOTB, LDS_WS=2*NSLOT*SLOTB, LDS_OST=LDS_WS+NW*64*4, LDS_FK=LDS_OST+NW*4096, LDS_BYTES=LDS_FK+SEQ*4;
constexpr float C2=0.125f*1.4426950408889634f;
__device__ __forceinline__ void glds16(const void*gsrc,unsigned lds_dst){unsigned keep;
  asm volatile("s_mov_b32 %0, m0\n\ts_mov_b32 m0, %2\n\ts_nop 0\n\tglobal_load_lds_dwordx4 %1, off\n\ts_mov_b32 m0, %0":"=&s"(keep):"v"(gsrc),"s"(lds_dst):"memory");}
__device__ __forceinline__ float max3f(float a,float b,float c){float r;asm("v_max3_f32 %0, %1, %2, %3":"=v"(r):"v"(a),"v"(b),"v"(c));return r;}
__device__ __forceinline__ float max2f(float a,float b){float r;asm("v_max_f32_e32 %0, %1, %2":"=v"(r):"v"(a),"v"(b));return r;}
__device__ __forceinline__ float fadd_s(float a,float b){float r;asm("v_add_f32_e32 %0, %1, %2":"=v"(r):"v"(a),"v"(b));return r;}
__device__ __forceinline__ float fsub_s(float a,float b){float r;asm("v_sub_f32_e32 %0, %1, %2":"=v"(r):"v"(a),"v"(b));return r;}
typedef float f32x2_t __attribute__((ext_vector_type(2))); typedef __bf16 bf16x2_t __attribute__((ext_vector_type(2)));
__device__ __forceinline__ unsigned cvtpk_s(float lo,float hi){f32x2_t v={lo,hi};bf16x2_t b=__builtin_convertvector(v,bf16x2_t);return __builtin_bit_cast(unsigned,b);}
#define WAIT_BAR(N) asm volatile("s_waitcnt vmcnt(" #N ") lgkmcnt(0)\n\ts_barrier":::"memory")

__device__ __forceinline__ void qkt(f32x16&p0,f32x16&p1,const char*Kslot,const bf16x8*qr,int r32,int hi){
  const char*kb=Kslot+hi*1024+r32*16;
  #pragma unroll
  for(int d0=0;d0<4;++d0){
    const bf16x8 b0=*reinterpret_cast<const bf16x8*>(kb+d0*2048);
    const bf16x8 b1=*reinterpret_cast<const bf16x8*>(kb+d0*2048+512);
    p0=__builtin_amdgcn_mfma_f32_32x32x16_bf16(b0,qr[d0],p0,0,0,0);p1=__builtin_amdgcn_mfma_f32_32x32x16_bf16(b1,qr[d0],p1,0,0,0);}
}
typedef __attribute__((address_space(3))) const char* lds_cptr;
typedef short v4i16_t __attribute__((ext_vector_type(4)));
__device__ __forceinline__ void kload8(bf16x8*kf,lds_cptr kp){
  kf[0]=*(const __attribute__((address_space(3))) bf16x8*)(kp);      kf[1]=*(const __attribute__((address_space(3))) bf16x8*)(kp+512);
  kf[2]=*(const __attribute__((address_space(3))) bf16x8*)(kp+2048); kf[3]=*(const __attribute__((address_space(3))) bf16x8*)(kp+2560);
  kf[4]=*(const __attribute__((address_space(3))) bf16x8*)(kp+4096); kf[5]=*(const __attribute__((address_space(3))) bf16x8*)(kp+4608);
  kf[6]=*(const __attribute__((address_space(3))) bf16x8*)(kp+6144); kf[7]=*(const __attribute__((address_space(3))) bf16x8*)(kp+6656);
}
__device__ __forceinline__ void kload2(bf16x8*kf,lds_cptr kp,int j){ kf[2*j]=*(const __attribute__((address_space(3))) bf16x8*)(kp+j*2048); kf[2*j+1]=*(const __attribute__((address_space(3))) bf16x8*)(kp+j*2048+512); }
__device__ __forceinline__ s16x4 vtr(lds_cptr p){ return __builtin_bit_cast(s16x4,__builtin_amdgcn_ds_read_tr16_b64_v4i16((__attribute__((address_space(3))) v4i16_t*)p)); }
__device__ __forceinline__ float rowmax(const f32x16&p0,const f32x16&p1){
  float a=max3f(p0[0],p0[1],p1[0]),b=max3f(p0[2],p0[3],p1[1]);a=max3f(a,p1[2],p1[3]);
  #pragma unroll
  for(int r=4;r<16;r+=4){a=max3f(a,p0[r],p0[r+1]);b=max3f(b,p0[r+2],p0[r+3]);a=max3f(a,p1[r],p1[r+1]);b=max3f(b,p1[r+2],p1[r+3]);}
  const float m=max2f(a,b);
  auto rr=__builtin_amdgcn_permlane32_swap(__float_as_uint(m),__float_as_uint(m),false,false);
  return max2f(__uint_as_float(rr[0]),__uint_as_float(rr[1]));
}
__device__ __forceinline__ void pv(f32x16*o,int vb,bf16x8 pa0,bf16x8 pa1,bf16x8 pa2,bf16x8 pa3){
  #pragma unroll
  for(int d0=0;d0<2;++d0){s16x4 lo[4],hi[4];
    #pragma unroll
    for(int ks=0;ks<4;++ks){
      asm volatile("ds_read_b64_tr_b16 %0,%1 offset:%c2":"=&v"(lo[ks]):"v"(vb),"i"(d0*4096+ks*1024):"memory");
      asm volatile("ds_read_b64_tr_b16 %0,%1 offset:%c2":"=&v"(hi[ks]):"v"(vb),"i"(d0*4096+ks*1024+512):"memory");}
    asm volatile("s_waitcnt lgkmcnt(0)":::"memory");SBAR();
    #define PK(k) (bf16x8){lo[k][0],lo[k][1],lo[k][2],lo[k][3],hi[k][0],hi[k][1],hi[k][2],hi[k][3]}
    o[d0]=__builtin_amdgcn_mfma_f32_32x32x16_bf16(pa0,PK(0),o[d0],0,0,0);
    o[d0]=__builtin_amdgcn_mfma_f32_32x32x16_bf16(pa1,PK(1),o[d0],0,0,0);
    o[d0]=__builtin_amdgcn_mfma_f32_32x32x16_bf16(pa2,PK(2),o[d0],0,0,0);
    o[d0]=__builtin_amdgcn_mfma_f32_32x32x16_bf16(pa3,PK(3),o[d0],0,0,0);
    #undef PK
  }
}

#ifndef ATTN_STORE16
#define ATTN_STORE16(p,v) (*(u32x4*)(p)=(v))
#endif
template<int THRL> __device__ __forceinline__ void attn_unit(int b,int h,int qb,const bf16*Q,const bf16*__restrict__ K,const bf16*__restrict__ V,bf16*O,const float*__restrict__ Fc,const float*__restrict__ NRM,char*shm,int wid_in){
  const int wid=__builtin_amdgcn_readfirstlane(wid_in); int lane_=(int)__builtin_amdgcn_mbcnt_hi(~0u,__builtin_amdgcn_mbcnt_lo(~0u,0u)); asm volatile("":"+v"(lane_));
  const int lane=lane_,tid=wid*64+lane,r32=lane&31,hi=lane>>5;
  const long rowbase=(long)b*SEQ; const int q0=qb*QB;
  const float*Fbh=Fc+(long)(b*NHEAD+h)*SEQ;
  const int NTF=(q0+QB)/KVBLK; int t_start;
  { const float*QNb=NRM+(b*NHEAD+h)*128,*KNb=NRM+4096+(b*NHEAD+h)*128;
    const float qn=fmaxf(fmaxf(QNb[4*qb],QNb[4*qb+1]),fmaxf(QNb[4*qb+2],QNb[4*qb+3])),knb=fmaxf(fmaxf(KNb[4*qb],KNb[4*qb+1]),fmaxf(KNb[4*qb+2],KNb[4*qb+3]));
    const float fq0=Fbh[q0]*1.4426950408889634f; bool k0=true,k1=true;
    if(lane<NTF-4)k0=!(qn*(KNb[lane]+knb)+(fq0-Fbh[64*lane+63]*1.4426950408889634f)<-40.f);
    if(lane+64<NTF-4)k1=!(qn*(KNb[lane+64]+knb)+(fq0-Fbh[64*(lane+64)+63]*1.4426950408889634f)<-40.f);
    const unsigned long long m0=__ballot(k0),m1=__ballot(k1);
    int tf=m0?(int)__builtin_ctzll(m0):64+(m1?(int)__builtin_ctzll(m1):64);
    tf=tf<NTF-4?tf:NTF-4; t_start=__builtin_amdgcn_readfirstlane(tf&~1); }
  { typedef float f32x4_t __attribute__((ext_vector_type(4))); __attribute__((address_space(3))) float*fk=(__attribute__((address_space(3))) float*)((__attribute__((address_space(3))) char*)shm+LDS_FK); const int n4=(q0+QB)/4;
    for(int i=16*t_start+tid;i<n4;i+=NW*64){ f32x4_t v=*(const f32x4_t*)(Fbh+4*i); v=v*(-1.4426950408889634f); *(__attribute__((address_space(3))) f32x4_t*)(fk+4*i)=v; } }
  float fq2=Fbh[q0+wid*QBLK+r32]*1.4426950408889634f; asm volatile("":"+v"(fq2));
  const bf16*Qw=Q+(rowbase+q0+wid*QBLK)*DM+h*D;
  const bf16*Kh=K+(rowbase+(long)t_start*KVBLK)*DM+h*D,*Vh=V+(rowbase+(long)t_start*KVBLK)*DM+h*D;
  const lds_cptr shm3=(lds_cptr)shm;
  const unsigned lds0=(unsigned)(uintptr_t)shm;
  float*wsf=(float*)(shm+LDS_WS)+wid*64;
  const bf16*ksrc=Kh+(long)lane*DM+wid*8;
  const bf16*vsrc=Vh+(long)(16*(wid&3)+(lane>>2))*DM+(wid>>2)*32+(lane&3)*8;
  const unsigned kdst=lds0+LDS_K+wid*1024, vdst=lds0+LDS_V+wid*1024;
  #define DMA_K(t,slot) glds16(ksrc+(long)(t)*KVBLK*DM,(unsigned)__builtin_amdgcn_readfirstlane(kdst+(slot)))
  #define DMA_V(t,slot) glds16(vsrc+(long)(t)*KVBLK*DM,(unsigned)__builtin_amdgcn_readfirstlane(vdst+(slot)))
  const int vb0=(int)(lds0+LDS_V)+((lane>>4)&1)*32+(lane&3)*8+(4*hi+((lane&15)>>2))*64;
  const char*Kbase=shm+LDS_K; bf16x8 kf[8];
  const lds_cptr kp0=shm3+LDS_K+hi*1024+r32*16; const lds_cptr vp0=shm3+LDS_V+((lane>>4)&1)*32+(lane&3)*8+(4*hi+((lane&15)>>2))*64;
  const int NT=NTF-t_start;
  DMA_K(0,0);DMA_V(0,0);DMA_K(1,SLOTB);
  bf16x8 qr[4];
  #pragma unroll
  for(int d0=0;d0<4;++d0)qr[d0]=*reinterpret_cast<const bf16x8*>(&Qw[(long)r32*DM+d0*16+hi*8]);
  float mhat=0.f,l_reg=0.f;f32x16 o[2];o[0]=f32x16{};o[1]=f32x16{};
  const __attribute__((address_space(3))) float*fkl=(const __attribute__((address_space(3))) float*)(shm3+LDS_FK)+64*t_start+4*hi;
  #define INITC(C0,C1,t) do{ const float nsc_=fq2-mhat; typedef float f32x4_t __attribute__((ext_vector_type(4))); const __attribute__((address_space(3))) float*kb_=fkl+64*(t); \
    _Pragma("unroll") for(int g_=0;g_<4;++g_){ const f32x4_t a_=*(const __attribute__((address_space(3))) f32x4_t*)(kb_+8*g_), b_=*(const __attribute__((address_space(3))) f32x4_t*)(kb_+32+8*g_); \
      _Pragma("unroll") for(int e_=0;e_<4;++e_){ C0[4*g_+e_]=nsc_+a_[e_]; C1[4*g_+e_]=nsc_+b_[e_]; } } }while(0)
  const int qrel=wid*QBLK+r32;
  #define CMASK(P0,P1,t) do{int jb_=(t)-(NT-4); if(jb_>=0)cmask(P0,P1,jb_,qrel,hi);}while(0)
  bool resc=false;
  #define START(P0,P1) do{ const float rm=rowmax(P0,P1); resc=false; \
    { const float dl=rm; mhat=fadd_s(mhat,dl); \
      _Pragma("unroll") for(int r=0;r<16;++r){P0[r]=fsub_s(P0[r],dl);P1[r]=fsub_s(P1[r],dl);} \
      } \
    _Pragma("unroll") for(int r=0;r<16;++r)P0[r]=__builtin_amdgcn_exp2f(P0[r]); }while(0)
  #define RESC() do{ if(resc){ asm volatile("s_waitcnt lgkmcnt(0)":::"memory"); \
      _Pragma("unroll") for(int d_=0;d_<2;++d_) _Pragma("unroll") for(int r=0;r<16;++r)o[d_][r]*=wsf[crow(r,hi)]; } }while(0)
  f32x16 pA0,pA1,pB0,pB1;
  int sl_prev=0,sl_cur=0,sl_next=SLOTB;
  #define ROT() do{sl_prev=sl_cur;sl_cur=sl_next;sl_next=(sl_next==(NSLOT-1)*SLOTB)?0:sl_next+SLOTB;}while(0)
  DMA_K(2,2*SLOTB);
  WAIT_BAR(3);
  INITC(pA0,pA1,0); qkt(pA0,pA1,Kbase,qr,r32,hi);asm volatile("s_nop 15\n\ts_nop 7":"+v"(pA0),"+v"(pA1));CMASK(pA0,pA1,0);
  START(pA0,pA1);
  _Pragma("unroll") for(int r=0;r<16;++r)pA1[r]=__builtin_amdgcn_exp2f(pA1[r]);
  WAIT_BAR(0);
  DMA_K(3,0);DMA_V(1,SLOTB);
  ROT();
  kload8(kf,kp0+sl_cur);
  WAIT_BAR(2);
  s16x4 vlo[8],vhi[8]; u32x4 pw0,pw1,pw2,pw3;
  #define PKW(P,B) cvtpk_s(P[B],P[B+1])
  #define PAF(k) __builtin_bit_cast(bf16x8,pw##k)
  #define VFR(i) (bf16x8){vlo[i][0],vlo[i][1],vlo[i][2],vlo[i][3],vhi[i][0],vhi[i][1],vhi[i][2],vhi[i][3]}
  #define PIN(x) asm volatile("":"+v"(x))
  #define MX3(a,b,c) __builtin_fmaxf(__builtin_fmaxf((a),(b)),(c))
  #define GAPA(MF,A0,A1,A2,A3,W0,W1,PW) do{ MF; sacc+=A0; sacc+=A1; sacc+=A2; sacc+=A3; PIN(sacc); W0; W1; PIN(PW); SBAR(); }while(0)
  #define EX(v) __builtin_amdgcn_exp2f(v)
  #define GAPB(MF,X,B) do{ MF; X[B]=EX(X[B]); X[B+1]=EX(X[B+1]); X[B+2]=EX(X[B+2]); X[B+3]=EX(X[B+3]); PIN(X); SBAR(); }while(0)
  #define VRD(i) do{ vlo[i]=vtr(vp_+(((i)>>2)*4096+((i)&3)*1024)); vhi[i]=vtr(vp_+(((i)>>2)*4096+((i)&3)*1024+512)); }while(0)
  #define KRD(G,j) do{ if(G){ kload2(kf,kp0+sl_next,j); SBAR(); } }while(0)
  #define STEP(C0,C1,P0,P1,t,GK,GV,GL) do{ SBAR(); INITC(C0,C1,t); PIN(C0); PIN(C1); SBAR(); \
    const lds_cptr vp_=vp0+sl_prev; \
    VRD(0); SBAR(); float sacc=(P0[0]+P0[1]); \
    GAPA(C0=__builtin_amdgcn_mfma_f32_32x32x16_bf16(kf[0],qr[0],C0,0,0,0), P0[2],P0[3],P0[4],P0[5],     pw0[0]=PKW(P0,0), pw0[1]=PKW(P0,2), pw0); \
    VRD(4); SBAR(); GAPA(C1=__builtin_amdgcn_mfma_f32_32x32x16_bf16(kf[1],qr[0],C1,0,0,0), P0[6],P0[7],P0[8],P0[9],     pw0[2]=PKW(P0,4), pw0[3]=PKW(P0,6), pw0); \
    VRD(1); SBAR(); GAPA(C0=__builtin_amdgcn_mfma_f32_32x32x16_bf16(kf[2],qr[1],C0,0,0,0),   P0[10],P0[11],P0[12],P0[13], pw1[0]=PKW(P0,8), pw1[1]=PKW(P0,10), pw1); \
    VRD(5); SBAR(); GAPA(C1=__builtin_amdgcn_mfma_f32_32x32x16_bf16(kf[3],qr[1],C1,0,0,0),   P0[14],P0[15],P1[0],P1[1],   pw1[2]=PKW(P0,12),pw1[3]=PKW(P0,14), pw1); \
    VRD(2); SBAR(); GAPA(C0=__builtin_amdgcn_mfma_f32_32x32x16_bf16(kf[4],qr[2],C0,0,0,0),   P1[2],P1[3],P1[4],P1[5],     pw2[0]=PKW(P1,0), pw2[1]=PKW(P1,2), pw2); \
    VRD(6); SBAR(); GAPA(C1=__builtin_amdgcn_mfma_f32_32x32x16_bf16(kf[5],qr[2],C1,0,0,0),   P1[6],P1[7],P1[8],P1[9],     pw2[2]=PKW(P1,4), pw2[3]=PKW(P1,6), pw2); \
    VRD(3); SBAR(); GAPA(C0=__builtin_amdgcn_mfma_f32_32x32x16_bf16(kf[6],qr[3],C0,0,0,0),   P1[10],P1[11],P1[12],P1[13], pw3[0]=PKW(P1,8), pw3[1]=PKW(P1,10), pw3); \
    VRD(7); SBAR(); GAPA(C1=__builtin_amdgcn_mfma_f32_32x32x16_bf16(kf[7],qr[3],C1,0,0,0),   P1[14],P1[15],0.f,0.f,       pw3[2]=PKW(P1,12),pw3[3]=PKW(P1,14), pw3); \
    l_reg+=sacc; \
    if(GK){DMA_K((t)+3,sl_cur);} if(GV){DMA_V((t)+1,sl_next);} \
    CMASK(C0,C1,t); \
    { float a=MX3(C0[0],C0[1],C1[0]),b=MX3(C0[2],C0[3],C1[1]); a=MX3(a,C1[2],C1[3]); \
      _Pragma("unroll") for(int r=4;r<16;r+=4){a=MX3(a,C0[r],C0[r+1]);b=MX3(b,C0[r+2],C0[r+3]);a=MX3(a,C1[r],C1[r+1]);b=MX3(b,C1[r+2],C1[r+3]);} \
      float rm=__builtin_fmaxf(a,b); { auto rr=__builtin_amdgcn_permlane32_swap(__float_as_uint(rm),__float_as_uint(rm),false,false); rm=__builtin_fmaxf(__uint_as_float(rr[0]),__uint_as_float(rr[1])); } \
      resc=false; \
      if(__builtin_expect(__any(rm>(float)THRL),0)){ const float dl=__builtin_fmaxf(rm,0.f); mhat+=dl; \
        _Pragma("unroll") for(int r=0;r<16;++r){C0[r]-=dl;C1[r]-=dl;} \
        const float f=__builtin_amdgcn_exp2f(-dl); l_reg*=f; if(hi==0)wsf[r32]=f; resc=true; } } \
    SBAR(); \
    GAPB(o[0]=__builtin_amdgcn_mfma_f32_32x32x16_bf16(PAF(0),VFR(0),o[0],0,0,0), C0,0); \
    GAPB(o[1]=__builtin_amdgcn_mfma_f32_32x32x16_bf16(PAF(0),VFR(4),o[1],0,0,0), C0,4); \
    KRD(GL,0); GAPB(o[0]=__builtin_amdgcn_mfma_f32_32x32x16_bf16(PAF(1),VFR(1),o[0],0,0,0), C0,8); \
    KRD(GL,1); GAPB(o[1]=__builtin_amdgcn_mfma_f32_32x32x16_bf16(PAF(1),VFR(5),o[1],0,0,0), C0,12); \
    KRD(GL,2); GAPB(o[0]=__builtin_amdgcn_mfma_f32_32x32x16_bf16(PAF(2),VFR(2),o[0],0,0,0), C1,0); \
    KRD(GL,3); GAPB(o[1]=__builtin_amdgcn_mfma_f32_32x32x16_bf16(PAF(2),VFR(6),o[1],0,0,0), C1,4); \
    GAPB(o[0]=__builtin_amdgcn_mfma_f32_32x32x16_bf16(PAF(3),VFR(3),o[0],0,0,0), C1,8); \
    GAPB(o[1]=__builtin_amdgcn_mfma_f32_32x32x16_bf16(PAF(3),VFR(7),o[1],0,0,0), C1,12); \
    }while(0)
  int t=1;
  #undef CMASK
  #define CMASK(P0,P1,t) do{}while(0)
  for(;t+5<NT;t+=2){
    STEP(pB0,pB1,pA0,pA1,t,true,true,true);     WAIT_BAR(2); RESC(); ROT();
    STEP(pA0,pA1,pB0,pB1,t+1,true,true,true);   WAIT_BAR(2); RESC(); ROT();
  }
  #undef CMASK
  #define CMASK(P0,P1,t) do{int jb_=(t)-(NT-4); if(jb_>=0)cmask(P0,P1,jb_,qrel,hi);}while(0)
  #define ENDW(tt) do{ if((tt)+3<NT){WAIT_BAR(2);} else if((tt)+2<NT){WAIT_BAR(1);} else {WAIT_BAR(0);} }while(0)
  for(;t+1<NT;t+=2){
    STEP(pB0,pB1,pA0,pA1,t,(t+3<NT),(t+1<NT),(t+1<NT));       ENDW(t);   RESC(); ROT();
    STEP(pA0,pA1,pB0,pB1,t+1,(t+4<NT),(t+2<NT),(t+2<NT));     ENDW(t+1); RESC(); ROT();
  }
  STEP(pB0,pB1,pA0,pA1,NT-1,false,false,false); RESC();
  { float sacc=pB0[0]+pB0[1]; _Pragma("unroll") for(int r=2;r<16;++r)sacc+=pB0[r]; _Pragma("unroll") for(int r=0;r<16;++r)sacc+=pB1[r]; l_reg+=sacc;
    pw0=(u32x4){PKW(pB0,0),PKW(pB0,2),PKW(pB0,4),PKW(pB0,6)};pw1=(u32x4){PKW(pB0,8),PKW(pB0,10),PKW(pB0,12),PKW(pB0,14)};pw2=(u32x4){PKW(pB1,0),PKW(pB1,2),PKW(pB1,4),PKW(pB1,6)};pw3=(u32x4){PKW(pB1,8),PKW(pB1,10),PKW(pB1,12),PKW(pB1,14)};
    SBAR(); pv(o,vb0+sl_cur,PAF(0),PAF(1),PAF(2),PAF(3)); }
  #undef PKW
  #undef PAF
  #undef VFR
  #undef PIN
  #undef MX3
  #undef GAPA
  #undef GAPB
  #undef EX
  #undef VRD
  #undef KRD
  #undef STEP
  #undef ENDW
  {auto rr=__builtin_amdgcn_permlane32_swap(__float_as_uint(l_reg),__float_as_uint(l_reg),false,false);l_reg=__uint_as_float(rr[0])+__uint_as_float(rr[1]);}
  if(hi==0)wsf[32+r32]=l_reg;asm volatile("s_waitcnt lgkmcnt(0)":::"memory");
  float rli[16];
  #pragma unroll
  for(int r=0;r<16;++r)rli[r]=__builtin_amdgcn_rcpf(wsf[32+crow(r,hi)]);
  bf16*Ow=O+(rowbase+q0+wid*QBLK)*DM+h*D;
  { bf16*stg=(bf16*)(shm+LDS_OST)+wid*2048;
    #pragma unroll
    for(int r=0;r<16;++r){const int orow=crow(r,hi);
      #pragma unroll
      for(int d0=0;d0<2;++d0)stg[orow*64+d0*32+r32]=__float2bfloat16(o[d0][r]*rli[r]);}
    asm volatile("s_waitcnt lgkmcnt(0)":::"memory");
    #pragma unroll
    for(int i=0;i<4;++i){const int row=i*8+(lane>>3),ch=lane&7; const u32x4 v=*(const u32x4*)(stg+row*64+ch*8); ATTN_STORE16(Ow+(long)row*DM+ch*8,v);} }
  asm volatile("s_waitcnt lgkmcnt(0)\n\ts_barrier":::"memory");
  #undef DMA_K
  #undef DMA_V
  #undef INITC
  #undef CMASK
  #undef START
  #undef RESC
  #undef ROT
}
constexpr int ATTN_LDS_BYTES=LDS_BYTES;
struct AttnTensors { const bf16* Q; const bf16* K; const bf16* V; bf16* O; const float* F; const float* NRM; };
struct AttnUnit { int bh; int qb; };
struct StaticOrder {
  int vcu;
  __device__ __forceinline__ explicit StaticOrder(int grid,int block):vcu((block%8)*(grid/8)+block/8){}
  __device__ __forceinline__ bool next(int i,AttnUnit&u)const{ if(i>=4)return false; const int s=vcu&7; u.bh=vcu>>3; u.qb=(i==0)?s:(i==1)?15-s:(i==2)?16+s:31-s; return true; }
  __device__ __forceinline__ void a_ready(const AttnUnit&)const{}
  __device__ __forceinline__ void done(const AttnUnit&)const{}
};
template<int THRL=8> __device__ __forceinline__ void attn_phase(char*lds,const AttnTensors&T,unsigned*qctr,volatile __attribute__((address_space(3))) unsigned*qword,int wid_in){
  const int lane0=(int)__builtin_amdgcn_mbcnt_hi(~0u,__builtin_amdgcn_mbcnt_lo(~0u,0u));
  for(;;){
    if(wid_in==0&&lane0==0){ const unsigned n=__hip_atomic_fetch_add(qctr,1u,__ATOMIC_RELAXED,__HIP_MEMORY_SCOPE_AGENT); *qword=n; }
    asm volatile("s_waitcnt vmcnt(0) lgkmcnt(0)\n\ts_barrier":::"memory");
    const int n=__builtin_amdgcn_readfirstlane((int)*qword);
    if(n>=BATCH*NHEAD*NQB)break;
    const int bh=n%(BATCH*NHEAD),qb=NQB-1-n/(BATCH*NHEAD);
    attn_unit<THRL>(bh/NHEAD,bh%NHEAD,qb,T.Q,T.K,T.V,T.O,T.F,T.NRM,lds,wid_in);
  }
}
#undef SBAR
#undef WAIT_BAR
}
#define GAS __attribute__((address_space(1)))
#define LAS __attribute__((address_space(3)))
typedef unsigned short bf16;
typedef unsigned v4u __attribute__((ext_vector_type(4)));
typedef float f32x4 __attribute__((ext_vector_type(4)));
typedef short bf16x8 __attribute__((ext_vector_type(8)));
typedef GAS unsigned gu32;
typedef GAS unsigned long long gu64;
#define RLX_AGENT __ATOMIC_RELAXED, __HIP_MEMORY_SCOPE_AGENT
#define LDS_WAIT() asm volatile("s_waitcnt lgkmcnt(0)" ::: "memory")
#define VM_WAIT() asm volatile("s_waitcnt vmcnt(0)" ::: "memory")
__device__ __forceinline__ unsigned long long rt() { return __builtin_amdgcn_s_memrealtime(); }
__device__ __forceinline__ unsigned f2bf(float f) { unsigned u = __builtin_bit_cast(unsigned, f); return (u + 0x7fffu + ((u >> 16) & 1u)) >> 16; }
__device__ __forceinline__ unsigned pk2(float lo, float hi) { return f2bf(lo) | (f2bf(hi) << 16); }

#define XB_TMO      128
#define XB_XCNT(j)  (256  + 64 * (j))
#define XB_XSUB(j)  (1280 + 64 * (j))
#define XB_XGEN(j)  (2304 + 64 * (j))
#define XB_TOP      3328
#define XB_TOPGEN   3392
#define XCD_BAR_WORDS 3456
#define XB_SPIN_CAP (1u << 18)

__device__ __forceinline__ unsigned xb_ld(unsigned* p)              { return __hip_atomic_load(p, __ATOMIC_RELAXED, __HIP_MEMORY_SCOPE_AGENT); }
__device__ __forceinline__ unsigned xb_add(unsigned* p, unsigned v) { return __hip_atomic_fetch_add(p, v, __ATOMIC_RELAXED, __HIP_MEMORY_SCOPE_AGENT); }
__device__ __forceinline__ unsigned xb_xcc_id() { return (unsigned)__builtin_amdgcn_s_getreg((3 << 11) | 20) & 0xFu; }
#define XB_SPIN(cond, bar) do { unsigned _sp = 0; while (cond) { __builtin_amdgcn_s_sleep(1); \
    if ((++_sp & 255u) == 0u) { if (xb_ld(&(bar)[XB_TMO])) break; if (_sp > XB_SPIN_CAP) { atomicAdd(&(bar)[XB_TMO], 1u); break; } } } } while (0)

struct XcdBarrier {
    unsigned* bar; unsigned x; int wv;
    volatile LAS unsigned* st;
};

__device__ __forceinline__ bool xb_t0(int wv) { return wv == 0 && __builtin_amdgcn_mbcnt_hi(~0u, __builtin_amdgcn_mbcnt_lo(~0u, 0u)) == 0u; }
__device__ __forceinline__ XcdBarrier xcd_barrier_post(unsigned* bar, volatile LAS unsigned* st, int wv) {
    XcdBarrier b; b.bar = bar; b.x = xb_xcc_id(); b.st = st; b.wv = wv;
    if (xb_t0(wv)) (void)xb_add(&bar[XB_XCNT(b.x)], 1u);
    return b;
}
__device__ __forceinline__ void xcd_barrier_complete(unsigned* bar, unsigned x, unsigned& nloc, unsigned& nx) {
    const unsigned G = gridDim.x * gridDim.y * gridDim.z;
    unsigned sum, cnt, mine, sp = 0u;
    for (;;) {
        sum = 0u; cnt = 0u; mine = 0u;
#pragma unroll
        for (unsigned j = 0; j < 16; ++j) { const unsigned c = xb_ld(&bar[XB_XCNT(j)]); sum += c; cnt += (c > 0u) ? 1u : 0u; mine = (j == x) ? c : mine; }
        if (sum == G) break;
        __builtin_amdgcn_s_sleep(1);
        if ((++sp & 255u) == 0u) { if (xb_ld(&bar[XB_TMO])) break; if (sp > XB_SPIN_CAP) { atomicAdd(&bar[XB_TMO], 1u); break; } }
    }
    nloc = mine > 0u ? mine : 1u; nx = cnt > 0u ? cnt : 1u;
}

__device__ __forceinline__ void xcd_barrier(const XcdBarrier& b) {
    asm volatile("s_waitcnt vmcnt(0)" ::: "memory");
    __syncthreads();
    if (xb_t0(b.wv)) {
        unsigned* bar = b.bar;
        __builtin_amdgcn_s_waitcnt(0);
        unsigned nloc = b.st[0], nx = b.st[1];
        if (nloc == 0u) { xcd_barrier_complete(bar, b.x, nloc, nx); b.st[0] = nloc; b.st[1] = nx; }
        const unsigned old = xb_add(&bar[XB_XSUB(b.x)], 1u);
        const unsigned gen = old / nloc;
        if (old + 1u == (gen + 1u) * nloc) {
            __builtin_amdgcn_fence(__ATOMIC_RELEASE, "agent");
            asm volatile("s_waitcnt vmcnt(0)" ::: "memory");
            const unsigned og = xb_add(&bar[XB_TOP], 1u);
            const unsigned tg = og / nx;
            if (og + 1u == (tg + 1u) * nx) xb_add(&bar[XB_TOPGEN], 1u);
            else XB_SPIN(xb_ld(&bar[XB_TOPGEN]) == tg, bar);
            __builtin_amdgcn_fence(__ATOMIC_ACQUIRE, "agent");
            xb_add(&bar[XB_XGEN(b.x)], 1u);
            asm volatile("s_waitcnt vmcnt(0)" ::: "memory");
        } else {
            XB_SPIN(xb_ld(&bar[XB_XGEN(b.x)]) == gen, bar);
            __builtin_amdgcn_fence(__ATOMIC_ACQUIRE, "agent");
            asm volatile("s_waitcnt vmcnt(0)" ::: "memory");
        }
    }
    __syncthreads();
}

constexpr int NWAVES = 8;
constexpr int RING_OFF = 0, RING_BYTES = 131072;
constexpr int LDSCTL_OFF = RING_BYTES, MISC_OFF = LDSCTL_OFF + 320;
constexpr int LDS_BYTES = 147456;
constexpr int N_PHASES = 8;

struct Frame {
    LAS unsigned char* lds;
    volatile LAS unsigned* MISC;
    gu32* ctl;
    int tid, lane, wave, vcu, G;
};
__device__ __forceinline__ float wave_sum(float v) {
#pragma unroll
    for (int o = 1; o < 64; o <<= 1) v += __shfl_xor(v, o);
    return v;
}
struct Args { const float* in[20]; float* out; unsigned char* ws; int ph_lo, ph_hi, li, pad; };

__device__ __forceinline__ void p0_transpose_item(const float* W, int ld, int nblk, const float* glo, const float* ghi, int K, bf16* WT, int item, int lane) {
    const int kb = item / nblk, nb = item % nblk, k0 = 64 * kb + 16 * (lane >> 4), n0 = 64 * nb + 4 * (lane & 15);
    f32x4 w[16];
#pragma unroll
    for (int j = 0; j < 16; ++j) w[j] = *(const GAS f32x4*)(W + (size_t)(k0 + j) * ld + n0);
    if (glo) { const float* gp = (k0 < K / 2) ? glo + k0 : ghi + (k0 - K / 2);
#pragma unroll
        for (int q = 0; q < 4; ++q) { const f32x4 g4 = *(const GAS f32x4*)(gp + 4 * q);
#pragma unroll
            for (int e = 0; e < 4; ++e) w[4 * q + e] = w[4 * q + e] * g4[e]; } }
#pragma unroll
    for (int c = 0; c < 4; ++c) { v4u o0, o1;
        o0.x = pk2(w[0][c], w[1][c]); o0.y = pk2(w[2][c], w[3][c]); o0.z = pk2(w[4][c], w[5][c]); o0.w = pk2(w[6][c], w[7][c]);
        o1.x = pk2(w[8][c], w[9][c]); o1.y = pk2(w[10][c], w[11][c]); o1.z = pk2(w[12][c], w[13][c]); o1.w = pk2(w[14][c], w[15][c]);
        bf16* dp = WT + (size_t)(n0 + c) * K + k0; *(GAS v4u*)dp = o0; *(GAS v4u*)(dp + 8) = o1; }
}
__device__ __forceinline__ float log_sigmoid(float z) { return fminf(z, 0.f) - log1pf(expf(-fabsf(z))); }

__device__ __forceinline__ void p0_prologue(Frame& F, const Args& a) {
    unsigned char* ws = a.ws;
    const float* x = a.in[0]; const float* g1 = a.in[1]; const float* w_in = a.in[2]; const float* bfv = a.in[10];
    const float* gn_l = a.in[11]; const float* gn_f = a.in[12]; const float* w_out = a.in[13]; const float* g2 = a.in[14];
    const float* w_q = a.in[15]; const float* sk = a.in[16]; const float* pu = a.in[17]; const float* pv = a.in[18];
    bf16* win_t = (bf16*)(ws + WS_WIN); bf16* wout_t = (bf16*)(ws + WS_WOUT); bf16* wq_t = (bf16*)(ws + WS_WQ); bf16* skb = (bf16*)(ws + WS_SKB);
    float* logf = (float*)(ws + WS_LOGF); bf16* h = (bf16*)(ws + WS_H);
    const int gw = F.vcu * NWAVES + F.wave, NGW = F.G * NWAVES, lane = F.lane;
    constexpr int I_IN = (DMODEL / 64) * (NG1 / 64), I_OUT = (DMODEL / 64) * (DMODEL / 64), I_Q = (DMODEL / 64) * (QPW / 64);
    constexpr int I_SK = PH * 2 * NKEY * PHALF / 512, I_WAX = 8 * 2 * 2 * 4;
    constexpr int E0 = I_IN, E1 = E0 + I_OUT, E2 = E1 + I_Q, E3 = E2, E4 = E3 + I_SK, E5 = E4, E6 = E5 + I_WAX;
    for (int it = gw; it < E6; it += NGW) {
        if (it < E0) { p0_transpose_item(w_in, INC, NG1 / 64, nullptr, nullptr, DMODEL, win_t, it, lane); continue; }
        if (it < E1) { p0_transpose_item(w_out, DMODEL, DMODEL / 64, gn_l, gn_f, DMODEL, wout_t, it - E0, lane); continue; }
        if (it < E2) { p0_transpose_item(w_q, QPW, QPW / 64, g2, g2 + DMODEL / 2, DMODEL, wq_t, it - E1, lane); continue; }
        if (it < E4) { const size_t i = (size_t)(it - E3) * 512 + lane * 8; const f32x4 s0 = *(const GAS f32x4*)(sk + i), s1 = *(const GAS f32x4*)(sk + i + 4);
            v4u o; o.x = pk2(s0[0], s0[1]); o.y = pk2(s0[2], s0[3]); o.z = pk2(s1[0], s1[1]); o.w = pk2(s1[2], s1[3]);
            { const size_t hp = i >> 14; const int key = (int)(i >> 7) & 127, c8 = (int)(i >> 3) & 15; *(GAS v4u*)(skb + hp * 16384 + ((size_t)((((key >> 5) * 2 + (c8 & 1)) * 8 + (c8 >> 1)) * 32 + (key & 31))) * 8) = o; } continue; }
        { const int f = it - E5, ks = f & 3, n = (f >> 2) & 1, mat = (f >> 3) & 1, hh = f >> 4; const float* wsrc = mat ? a.in[7] : a.in[5];
          const size_t o = ((size_t)(hh * 64 + 16 * ks + 8 * (lane >> 5))) * 64 + 32 * n + (lane & 31);
          v4u pw; pw.x = pk2(wsrc[o], wsrc[o + 64]); pw.y = pk2(wsrc[o + 128], wsrc[o + 192]); pw.z = pk2(wsrc[o + 256], wsrc[o + 320]); pw.w = pk2(wsrc[o + 384], wsrc[o + 448]);
          *(GAS v4u*)((bf16*)(ws + WS_WAX) + (size_t)f * 512 + lane * 8) = pw; }
    }
    { f32x4 gg[4];
#pragma unroll
      for (int j = 0; j < 4; ++j) gg[j] = *(const GAS f32x4*)(g2 + 16 * lane + 4 * j);
      unsigned char* u4 = ws + WS_U8; unsigned char* v4 = ws + WS_V8; float* su = (float*)(ws + WS_SU);
      for (int e = gw; e < NEXP; e += NGW) {
        const GAS f32x4* ur = (const GAS f32x4*)(pu + (size_t)e * DMODEL + 16 * lane); const GAS f32x4* vr = (const GAS f32x4*)(pv + (size_t)e * DMODEL + 16 * lane);
        f32x4 uu[4], vv[4]; float mu = 0.f, mv = 0.f;
#pragma unroll
        for (int j = 0; j < 4; ++j) { uu[j] = ur[j] * gg[j]; vv[j] = vr[j];
#pragma unroll
            for (int c = 0; c < 4; ++c) { mu = fmaxf(mu, fabsf(uu[j][c])); mv = fmaxf(mv, fabsf(vv[j][c])); } }
#pragma unroll
        for (int o = 1; o < 64; o <<= 1) { mu = fmaxf(mu, __shfl_xor(mu, o)); mv = fmaxf(mv, __shfl_xor(mv, o)); }
        const float scu = mu > 0.f ? mu * (1.f / 6.f) : 1.f, scv = mv > 0.f ? mv * (1.f / 6.f) : 1.f, iu = 1.f / scu, iv = 1.f / scv;
        unsigned qu0 = 0u, qu1 = 0u, qv0 = 0u, qv1 = 0u;
#define P0_Q4(Q, X, INV, B0, B1) do { Q = __builtin_amdgcn_cvt_scalef32_pk_fp4_f32(Q, X[0] * INV, X[1] * INV, 1.0f, B0); Q = __builtin_amdgcn_cvt_scalef32_pk_fp4_f32(Q, X[2] * INV, X[3] * INV, 1.0f, B1); } while (0)
        P0_Q4(qu0, uu[0], iu, 0, 1); P0_Q4(qu0, uu[1], iu, 2, 3); P0_Q4(qu1, uu[2], iu, 0, 1); P0_Q4(qu1, uu[3], iu, 2, 3);
        P0_Q4(qv0, vv[0], iv, 0, 1); P0_Q4(qv0, vv[1], iv, 2, 3); P0_Q4(qv1, vv[2], iv, 0, 1); P0_Q4(qv1, vv[3], iv, 2, 3);
#undef P0_Q4
        *(GAS unsigned long long*)(u4 + (size_t)e * 512 + 8 * lane) = (unsigned long long)qu0 | ((unsigned long long)qu1 << 32);
        { unsigned char* vrow = v4 + (size_t)e * 512 + 2 * (lane >> 2);
          *(GAS unsigned short*)(vrow + 32 * (4 * (lane & 3) + 0)) = (unsigned short)(qv0 & 0xffffu); *(GAS unsigned short*)(vrow + 32 * (4 * (lane & 3) + 1)) = (unsigned short)(qv0 >> 16);
          *(GAS unsigned short*)(vrow + 32 * (4 * (lane & 3) + 2)) = (unsigned short)(qv1 & 0xffffu); *(GAS unsigned short*)(vrow + 32 * (4 * (lane & 3) + 3)) = (unsigned short)(qv1 >> 16); }
        if (lane == 0) { su[2 * e] = scu; su[2 * e + 1] = scv; }
      } }
    { f32x4 gg[4];
#pragma unroll
      for (int j = 0; j < 4; ++j) gg[j] = *(const GAS f32x4*)(g1 + 256 * j + 4 * lane);
      float fw[4][4][8];
#pragma unroll
      for (int j = 0; j < 4; ++j)
#pragma unroll
          for (int c = 0; c < 4; ++c) { const int k = 256 * j + 4 * lane + c; const GAS f32x4* wr = (const GAS f32x4*)(w_in + (size_t)k * INC + NG1); const f32x4 w0 = wr[0], w1 = wr[1];
#pragma unroll
              for (int e = 0; e < 4; ++e) { fw[j][c][e] = w0[e]; fw[j][c][4 + e] = w1[e]; } }
      for (int t0 = gw; t0 < T; t0 += 2 * NGW) {
        const int t1 = (t0 + NGW < T) ? t0 + NGW : t0;
        const GAS f32x4* xr0 = (const GAS f32x4*)(x + (size_t)t0 * DMODEL) + lane; const GAS f32x4* xr1 = (const GAS f32x4*)(x + (size_t)t1 * DMODEL) + lane;
        f32x4 va[4], vb[4]; float sa = 0.f, sb = 0.f;
#pragma unroll
        for (int j = 0; j < 4; ++j) { va[j] = xr0[64 * j]; vb[j] = xr1[64 * j]; }
#pragma unroll
        for (int j = 0; j < 4; ++j) { sa += (va[j][0] * va[j][0] + va[j][1] * va[j][1]) + (va[j][2] * va[j][2] + va[j][3] * va[j][3]); sb += (vb[j][0] * vb[j][0] + vb[j][1] * vb[j][1]) + (vb[j][2] * vb[j][2] + vb[j][3] * vb[j][3]); }
        const float ra = rsqrtf(wave_sum(sa) * (1.f / DMODEL) + RMS_EPS), rb = rsqrtf(wave_sum(sb) * (1.f / DMODEL) + RMS_EPS);
        GAS unsigned long long* ha = (GAS unsigned long long*)(h + (size_t)t0 * DMODEL) + lane; GAS unsigned long long* hb = (GAS unsigned long long*)(h + (size_t)t1 * DMODEL) + lane;
#pragma unroll
        for (int j = 0; j < 4; ++j) { va[j] = va[j] * ra * gg[j]; vb[j] = vb[j] * rb * gg[j];
            ha[64 * j] = (unsigned long long)pk2(va[j][0], va[j][1]) | ((unsigned long long)pk2(va[j][2], va[j][3]) << 32);
            hb[64 * j] = (unsigned long long)pk2(vb[j][0], vb[j][1]) | ((unsigned long long)pk2(vb[j][2], vb[j][3]) << 32); }
        float fa[8], fb[8];
#pragma unroll
        for (int hh = 0; hh < 8; ++hh) { fa[hh] = 0.f; fb[hh] = 0.f; }
#pragma unroll
        for (int j = 0; j < 4; ++j)
#pragma unroll
            for (int c = 0; c < 4; ++c) {
#pragma unroll
                for (int hh = 0; hh < 8; ++hh) { fa[hh] += va[j][c] * fw[j][c][hh]; fb[hh] += vb[j][c] * fw[j][c][hh]; } }
        const bool b0 = lane & 1, b1 = lane & 2, b2 = lane & 4;
        float ya[4], yb[4], za[2], zb[2];
#pragma unroll
        for (int j = 0; j < 4; ++j) { ya[j] = (b0 ? fa[j + 4] : fa[j]) + __shfl_xor(b0 ? fa[j] : fa[j + 4], 1); yb[j] = (b0 ? fb[j + 4] : fb[j]) + __shfl_xor(b0 ? fb[j] : fb[j + 4], 1); }
#pragma unroll
        for (int j = 0; j < 2; ++j) { za[j] = (b1 ? ya[j + 2] : ya[j]) + __shfl_xor(b1 ? ya[j] : ya[j + 2], 2); zb[j] = (b1 ? yb[j + 2] : yb[j]) + __shfl_xor(b1 ? yb[j] : yb[j + 2], 2); }
        float resa = (b2 ? za[1] : za[0]) + __shfl_xor(b2 ? za[0] : za[1], 4), resb = (b2 ? zb[1] : zb[0]) + __shfl_xor(b2 ? zb[0] : zb[1], 4);
#pragma unroll
        for (int o = 8; o < 64; o <<= 1) { resa += __shfl_xor(resa, o); resb += __shfl_xor(resb, o); }
        if (lane < 8) { const int hd = 4 * (lane & 1) + (lane & 2) + ((lane >> 2) & 1); logf[(size_t)t0 * 8 + hd] = log_sigmoid(resa + bfv[hd]); logf[(size_t)t1 * 8 + hd] = log_sigmoid(resb + bfv[hd]); }
      } }
}

__device__ __forceinline__ void fcum_unit(Frame& F, int bh, const float* logf, float* fcum) {
    const int b = bh / NHEADS, hh = bh % NHEADS, s0 = F.tid * 16;
    float v[16]; float loc = 0.f;
#pragma unroll
    for (int i = 0; i < 16; ++i) { v[i] = logf[((size_t)b * SEQ + s0 + i) * 8 + hh]; loc += v[i]; }
    float inc = loc;
#pragma unroll
    for (int o = 1; o < 64; o <<= 1) { const float n = __shfl_up(inc, o); if (F.lane >= o) inc += n; }
    if (F.lane == 63) F.MISC[16 + F.wave] = __float_as_uint(inc);
    __syncthreads();
    float run = inc - loc;
    for (int w = 0; w < F.wave; ++w) run += __uint_as_float(F.MISC[16 + w]);
#pragma unroll
    for (int i = 0; i < 16; ++i) { run += v[i]; fcum[(size_t)bh * SEQ + s0 + i] = run; }
    __syncthreads();
}


namespace peer {
typedef unsigned u32;
typedef float f32x16 __attribute__((ext_vector_type(16)));
constexpr int TOK = 128;
constexpr int EX_STRIDE = 136, GT_STRIDE = 136;
constexpr int L_EX = 0, L_GT = L_EX + TOK * EX_STRIDE * 2, L_IDX = L_GT + TOK * GT_STRIDE * 2, IDX_STRIDE = 36, L_RST = L_IDX + 512 * IDX_STRIDE, L_BI = L_RST + TOK * 4, BI_WAVE = 4352, L_END = L_BI + 8 * BI_WAVE;
static_assert(L_END <= RING_BYTES && L_GT % 16 == 0 && L_IDX % 16 == 0, "PEER LDS map");
__device__ __forceinline__ u32 ordmap(float f) { const u32 u = __float_as_uint(f); return u ^ ((u32)((int)u >> 31) | 0x80000000u); }
__device__ __forceinline__ float unordmap(u32 k) { const u32 u = (k & 0x80000000u) ? (k ^ 0x80000000u) : ~k; return __uint_as_float(u); }
__device__ __forceinline__ u32 umin_(u32 a, u32 b) { return a < b ? a : b; }
__device__ __forceinline__ u32 umax_(u32 a, u32 b) { return a > b ? a : b; }
template <bool DESC> __device__ __forceinline__ void sort16(u32 (&k)[16]) {
#define PEER_CE(I, J) do { const u32 a_ = k[I], b_ = k[J], lo_ = umin_(a_, b_), hi_ = umax_(a_, b_); k[I] = DESC ? hi_ : lo_; k[J] = DESC ? lo_ : hi_; } while (0)
    PEER_CE(0, 13); PEER_CE(1, 12); PEER_CE(2, 15); PEER_CE(3, 14); PEER_CE(4, 8); PEER_CE(5, 6); PEER_CE(7, 11); PEER_CE(9, 10);
    PEER_CE(0, 5); PEER_CE(1, 7); PEER_CE(2, 9); PEER_CE(3, 4); PEER_CE(6, 13); PEER_CE(8, 14); PEER_CE(10, 15); PEER_CE(11, 12);
    PEER_CE(0, 1); PEER_CE(2, 3); PEER_CE(4, 5); PEER_CE(6, 8); PEER_CE(7, 9); PEER_CE(10, 11); PEER_CE(12, 13); PEER_CE(14, 15);
    PEER_CE(0, 2); PEER_CE(1, 3); PEER_CE(4, 10); PEER_CE(5, 11); PEER_CE(6, 7); PEER_CE(8, 9); PEER_CE(12, 14); PEER_CE(13, 15);
    PEER_CE(1, 2); PEER_CE(3, 12); PEER_CE(4, 6); PEER_CE(5, 7); PEER_CE(8, 10); PEER_CE(9, 11); PEER_CE(13, 14);
    PEER_CE(1, 4); PEER_CE(2, 6); PEER_CE(5, 8); PEER_CE(7, 10); PEER_CE(9, 13); PEER_CE(11, 14);
    PEER_CE(2, 4); PEER_CE(3, 6); PEER_CE(9, 12); PEER_CE(11, 13);
    PEER_CE(3, 5); PEER_CE(6, 8); PEER_CE(7, 9); PEER_CE(10, 12);
    PEER_CE(3, 4); PEER_CE(5, 6); PEER_CE(7, 8); PEER_CE(9, 10); PEER_CE(11, 12);
    PEER_CE(6, 7); PEER_CE(8, 9);
#undef PEER_CE
}
template <bool DESC> __device__ __forceinline__ void merge16(u32 (&k)[16]) {
#pragma unroll
    for (int stride = 8; stride > 0; stride >>= 1)
#pragma unroll
        for (int i = 0; i < 16; ++i) { const int j = i ^ stride;
            if (j > i) { const u32 a = k[i], b = k[j], lo = umin_(a, b), hi = umax_(a, b); k[i] = DESC ? hi : lo; k[j] = DESC ? lo : hi; } }
}
__host__ __device__ constexpr int ccnt(int a) { return 16 / (a + 1); }
__host__ __device__ constexpr int cbase(int a) { int s = 0; for (int i = 0; i < a; ++i) s += ccnt(i); return s; }
static_assert(cbase(16) == 50, "hyperbola candidate count");
__device__ __forceinline__ int crow16(int r) { return (r & 3) + 8 * (r >> 2); }

__device__ __forceinline__ void route_tile(Frame& F, const bf16* qp, const bf16* skb, const float* sumsq, int t0) {
    int lane = F.lane; asm volatile("" : "+v"(lane));
    const int r32 = lane & 31, hi = lane >> 5, w = F.wave;
    LAS unsigned short* EXL = (LAS unsigned short*)(F.lds + RING_OFF + L_EX);
    LAS unsigned short* GTL = (LAS unsigned short*)(F.lds + RING_OFF + L_GT);
    LAS unsigned char* IDXB = F.lds + RING_OFF + L_IDX + (w * 64 + lane) * IDX_STRIDE;
    LAS float* RST = (LAS float*)(F.lds + RING_OFF + L_RST);
    for (int g = 0; g < 4; ++g) {
        const int tok = 32 * g + r32; const size_t trow = (size_t)(t0 + tok);
        const float rstd2 = rsqrtf(sumsq[trow] * (1.f / DMODEL) + RMS_EPS);
        if (w == 0 && hi == 0) RST[tok] = rstd2;
        u32 s0[16], s1[16];
#pragma unroll
        for (int p = 0; p < 2; ++p) {
            bf16x8 qf[8];
#pragma unroll
            for (int ks = 0; ks < 8; ++ks) qf[ks] = *(const GAS bf16x8*)(qp + ((size_t)((((trow >> 5) * 8 + w) * 2 + p) * 16 + 2 * ks + hi) * 32 + r32) * 8);
            u32 run[16];
#pragma unroll
            for (int nb = 0; nb < 4; ++nb) {
                f32x16 acc = {};
                const bf16* kr = skb + (size_t)(w * 2 + p) * 16384 + ((size_t)((nb * 2 + hi) * 8 * 32 + r32)) * 8;
#pragma unroll
                for (int ks = 0; ks < 8; ++ks) acc = __builtin_amdgcn_mfma_f32_32x32x16_bf16(*(const GAS bf16x8*)(kr + ks * 256), qf[ks], acc, 0, 0, 0);
                asm volatile("" ::: "memory");
                u32 blk[16];
#pragma unroll
                for (int r = 0; r < 16; ++r) blk[r] = (ordmap(acc[r]) & ~0x7Fu) | (u32)(127 - 32 * nb - crow16(r) - 4 * hi);
                if (nb == 0) { sort16<true>(blk);
#pragma unroll
                    for (int i = 0; i < 16; ++i) run[i] = blk[i]; }
                else { sort16<false>(blk);
#pragma unroll
                    for (int i = 0; i < 16; ++i) run[i] = umax_(run[i], blk[i]);
                    merge16<true>(run); }
            }
            u32 oth[16];
#pragma unroll
            for (int i = 0; i < 16; ++i) oth[i] = (u32)__shfl_xor((int)run[15 - i], 32);
#pragma unroll
            for (int i = 0; i < 16; ++i) run[i] = umax_(run[i], oth[i]);
            merge16<true>(run);
#pragma unroll
            for (int i = 0; i < 16; ++i) { if (p == 0) s0[i] = run[i]; else s1[i] = run[i]; }
        }
        { LAS u32* iw = (LAS u32*)IDXB;
#pragma unroll
          for (int j = 0; j < 4; ++j) {
              iw[j] = (127u - (s0[4 * j] & 127u)) | ((127u - (s0[4 * j + 1] & 127u)) << 8) | ((127u - (s0[4 * j + 2] & 127u)) << 16) | ((127u - (s0[4 * j + 3] & 127u)) << 24);
              iw[4 + j] = (127u - (s1[4 * j] & 127u)) | ((127u - (s1[4 * j + 1] & 127u)) << 8) | ((127u - (s1[4 * j + 2] & 127u)) << 16) | ((127u - (s1[4 * j + 3] & 127u)) << 24); } }
        float v1[16], v2[16];
#pragma unroll
        for (int i = 0; i < 16; ++i) { v1[i] = unordmap(s0[i] & ~0x7Fu); v2[i] = unordmap(s1[i] & ~0x7Fu); }
        u32 c0[16], c1[16], c2[16], c3[16];
#pragma unroll
        for (int a = 0; a < 16; ++a)
#pragma unroll
            for (int b = 0; b < ccnt(a); ++b) { const int pos = cbase(a) + b; const u32 key = (ordmap(v1[a] + v2[b]) & ~0xFFu) | (u32)(255 - (a * 16 + b));
                if (pos < 16) c0[pos] = key; else if (pos < 32) c1[pos - 16] = key; else if (pos < 48) c2[pos - 32] = key; else c3[pos - 48] = key; }
#pragma unroll
        for (int i = 2; i < 16; ++i) c3[i] = 0u;
        sort16<false>(c1);
#pragma unroll
        for (int i = 0; i < 16; ++i) c0[i] = umax_(c0[i], c1[i]);
        merge16<true>(c0);
        sort16<false>(c2);
#pragma unroll
        for (int i = 0; i < 16; ++i) c0[i] = umax_(c0[i], c2[i]);
        merge16<true>(c0);
        sort16<false>(c3);
#pragma unroll
        for (int i = 0; i < 16; ++i) c0[i] = umax_(c0[i], c3[i]);
        merge16<true>(c0);
        const float m = unordmap(c0[0] & ~0xFFu) * rstd2;
        float e[8]; float sum = 0.f; u32 ex[8];
#pragma unroll
        for (int k = 0; k < 8; ++k) { const u32 key = hi ? c0[k + 8] : c0[k]; const float ts = unordmap(key & ~0xFFu);
            e[k] = __builtin_amdgcn_exp2f((ts * rstd2 - m) * LOG2E); sum += e[k];
            const u32 flat = 255u - (key & 255u); ex[k] = (u32)IDXB[flat >> 4] * NKEY + (u32)IDXB[16 + (flat & 15u)]; }
        sum += __shfl_xor(sum, 32);
        const float inv = 1.f / sum;
        v4u exw; exw.x = ex[0] | (ex[1] << 16); exw.y = ex[2] | (ex[3] << 16); exw.z = ex[4] | (ex[5] << 16); exw.w = ex[6] | (ex[7] << 16);
        *(LAS v4u*)(EXL + tok * EX_STRIDE + w * 16 + hi * 8) = exw;
        *(LAS v4u*)(GTL + tok * GT_STRIDE + w * 16 + hi * 8) = (v4u){pk2(e[0] * inv, e[1] * inv), pk2(e[2] * inv, e[3] * inv), pk2(e[4] * inv, e[5] * inv), pk2(e[6] * inv, e[7] * inv)};
    }
}
__device__ __forceinline__ float gelu_fast(float x) {
    const float u2 = x * (1.5957691216057308f + 0.07135481627f * x * x);
    return x * __builtin_amdgcn_rcpf(1.f + __builtin_amdgcn_exp2f(-1.4426950408889634f * u2));
}
typedef float f32x2 __attribute__((ext_vector_type(2)));

__device__ __forceinline__ void sort128(u32 (&k)[8], int m) {
#pragma unroll
    for (int K = 2; K <= 128; K <<= 1) {
#pragma unroll
        for (int S = K >> 1; S > 0; S >>= 1) {
            if (S >= 8) {
                const int mm = S >> 3; const bool lower = (m & mm) == 0, up = (K == 128) ? true : ((m & (K >> 3)) == 0), keepmin = (lower == up);
#pragma unroll
                for (int r = 0; r < 8; ++r) { const u32 o = (u32)__shfl_xor((int)k[r], mm); const u32 mn = umin_(k[r], o), mx = umax_(k[r], o); k[r] = keepmin ? mn : mx; }
            } else {
#pragma unroll
                for (int r = 0; r < 8; ++r) { const int r2 = r ^ S;
                    if (r2 > r) { const u32 a = k[r], b = k[r2], mn = umin_(a, b), mx = umax_(a, b);
                        if (K < 8) { const bool up = (r & K) == 0; k[r] = up ? mn : mx; k[r2] = up ? mx : mn; }
                        else { const bool up = (K == 128) ? true : ((m & (K >> 3)) == 0); k[r] = up ? mn : mx; k[r2] = up ? mx : mn; } } }
            }
        }
    }
}
typedef int v8i __attribute__((ext_vector_type(8)));
typedef unsigned u2v __attribute__((ext_vector_type(2)));
__device__ __forceinline__ void eval_mf(Frame& F, const unsigned char* u4, const unsigned char* v4, const float* suv, const float* fg, const bf16* x1b, float* out, int t0) {
    int lane = F.lane; asm volatile("" : "+v"(lane));
    const int g = lane >> 4, m = lane & 15;
    LAS unsigned short* EXL = (LAS unsigned short*)(F.lds + RING_OFF + L_EX);
    LAS unsigned short* GTL = (LAS unsigned short*)(F.lds + RING_OFF + L_GT);
    LAS unsigned char* BI = F.lds + RING_OFF + L_BI + F.wave * BI_WAVE;
    const LAS float* RST = (const LAS float*)(F.lds + RING_OFF + L_RST);
    LAS u32* SKW = (LAS u32*)(F.lds + RING_OFF + L_IDX) + F.wave * 512;
    LAS u32* SK = SKW + g * 128;
    for (int pass = 0; pass < 4; ++pass) {
        const int tb4 = 32 * pass + 4 * F.wave, tok = tb4 + g;
        LAS unsigned short* exr = EXL + tok * EX_STRIDE; LAS unsigned short* gtr = GTL + tok * GT_STRIDE;
        { u32 k[8]; const v4u ev = *(const LAS v4u*)(exr + 8 * m); const u32 s0 = (u32)(8 * m);
          k[0] = ((ev.x & 0xffffu) << 7) | s0; k[1] = ((ev.x >> 16) << 7) | (s0 + 1); k[2] = ((ev.y & 0xffffu) << 7) | (s0 + 2); k[3] = ((ev.y >> 16) << 7) | (s0 + 3);
          k[4] = ((ev.z & 0xffffu) << 7) | (s0 + 4); k[5] = ((ev.z >> 16) << 7) | (s0 + 5); k[6] = ((ev.w & 0xffffu) << 7) | (s0 + 6); k[7] = ((ev.w >> 16) << 7) | (s0 + 7);
          sort128(k, m);
          u32 wv[8];
#pragma unroll
          for (int r = 0; r < 8; ++r) wv[r] = ((k[r] >> 7) << 16) | (u32)gtr[k[r] & 127u];
          *(LAS v4u*)(SK + m * 8) = (v4u){wv[0], wv[1], wv[2], wv[3]}; *(LAS v4u*)(SK + m * 8 + 4) = (v4u){wv[4], wv[5], wv[6], wv[7]};
          *(LAS v4u*)(exr + 8 * m) = (v4u){(k[0] >> 7) | ((k[1] >> 7) << 16), (k[2] >> 7) | ((k[3] >> 7) << 16), (k[4] >> 7) | ((k[5] >> 7) << 16), (k[6] >> 7) | ((k[7] >> 7) << 16)}; }
        asm volatile("" ::: "memory");
        {
#pragma unroll
            for (int tq = 0; tq < 4; ++tq) { const float rq = RST[tb4 + tq]; const bf16* xr = x1b + (size_t)(t0 + tb4 + tq) * DMODEL + 8 * lane;
#pragma unroll
                for (int c = 0; c < 2; ++c) { const v4u xa = *(const GAS v4u*)(xr + 512 * c); int w0 = 0, w1 = 0;
                    w0 = __builtin_amdgcn_cvt_pk_fp8_f32(__uint_as_float(xa.x << 16) * rq, __uint_as_float(xa.x & 0xffff0000u) * rq, w0, false); w0 = __builtin_amdgcn_cvt_pk_fp8_f32(__uint_as_float(xa.y << 16) * rq, __uint_as_float(xa.y & 0xffff0000u) * rq, w0, true);
                    w1 = __builtin_amdgcn_cvt_pk_fp8_f32(__uint_as_float(xa.z << 16) * rq, __uint_as_float(xa.z & 0xffff0000u) * rq, w1, false); w1 = __builtin_amdgcn_cvt_pk_fp8_f32(__uint_as_float(xa.w << 16) * rq, __uint_as_float(xa.w & 0xffff0000u) * rq, w1, true);
                    const int d = 512 * c + 8 * lane, st = d >> 7, dd = d & 127, hh = dd >> 6, e = dd & 63;
                    *(LAS u2v*)(BI + ((st * 4 + tq) * 4 + (e >> 4)) * 32 + hh * 16 + (e & 15)) = (u2v){(u32)w0, (u32)w1}; } }
        }
        asm volatile("" ::: "memory");
        v8i hb[8];
#pragma unroll
        for (int st = 0; st < 8; ++st) { v4u b0 = *(const LAS v4u*)(BI + ((st * 4 + (m & 3)) * 4 + g) * 32), b1 = *(const LAS v4u*)(BI + ((st * 4 + (m & 3)) * 4 + g) * 32 + 16);
            if (m >= 4) { b0 = (v4u){0u, 0u, 0u, 0u}; b1 = b0; }
            hb[st] = (v8i){(int)b0.x, (int)b0.y, (int)b0.z, (int)b0.w, (int)b1.x, (int)b1.y, (int)b1.z, (int)b1.w}; }
        asm volatile("" ::: "memory");
#define PEER_BAR() do { asm volatile("" ::: "memory"); __builtin_amdgcn_sched_barrier(0); } while (0)
#define PEER_LOADU(UA, KQ, SC, I) do { KQ = *(const LAS v4u*)(SK + (I)); _Pragma("unroll") for (int s4 = 0; s4 < 4; ++s4) { const u32 e_ = KQ[s4] >> 16; const u32 ro_ = e_ * 512u + 16u * (u32)m; \
            UA[s4][0] = *(const GAS v4u*)(u4 + ro_); UA[s4][1] = *(const GAS v4u*)(u4 + ro_ + 256); SC[s4] = *(const GAS f32x2*)(suv + 2 * e_); } } while (0)
#define PEER_TRANSP(UA) do { _Pragma("unroll") for (int hf = 0; hf < 2; ++hf) { \
                _Pragma("unroll") for (int s4 = 0; s4 < 4; ++s4) *(LAS v4u*)(BI + (4 * s4 + g) * 272 + 16 * m) = UA[s4][hf]; \
                asm volatile("" ::: "memory"); \
                _Pragma("unroll") for (int st = 0; st < 4; ++st) af[4 * hf + st] = *(const LAS v4u*)(BI + m * 272 + 64 * st + 16 * g); \
                asm volatile("" ::: "memory"); } } while (0)
#define PEER_DOTS(KQ, SC, I) do { f32x4 D = (f32x4){0.f, 0.f, 0.f, 0.f}; \
            _Pragma("unroll") for (int st = 0; st < 8; ++st) { const v8i a8 = (v8i){(int)af[st].x, (int)af[st].y, (int)af[st].z, (int)af[st].w, 0, 0, 0, 0}; \
                D = __builtin_amdgcn_mfma_scale_f32_16x16x128_f8f6f4(a8, hb[st], D, 4, 0, 0, 0x7f7f7f7f, 0, 0x7f7f7f7f); } \
            const int sel = lane & 3; const float mine = sel == 0 ? D[0] : sel == 1 ? D[1] : sel == 2 ? D[2] : D[3]; float act[4]; \
            _Pragma("unroll") for (int s4 = 0; s4 < 4; ++s4) { const float pre = __uint_as_float((unsigned)__builtin_amdgcn_ds_bpermute(4 * (g + 16 * s4), (int)__float_as_uint(mine))); \
                act[s4] = gelu_fast(pre * SC[s4][0]) * (__uint_as_float(KQ[s4] << 16) * SC[s4][1]); } \
            if (m == 0) *(LAS u2v*)(gtr + (I)) = (u2v){pk2(act[0], act[1]), pk2(act[2], act[3])}; } while (0)
        v4u kqA, kqB, uaA[4][2], uaB[4][2], af[8]; f32x2 scA[4], scB[4];
        PEER_LOADU(uaA, kqA, scA, 0);
        for (int i = 0; i < 128; i += 8) {
            PEER_TRANSP(uaA);
            PEER_LOADU(uaB, kqB, scB, i + 4);
            PEER_BAR();
            PEER_DOTS(kqA, scA, i);
            PEER_BAR();
            PEER_TRANSP(uaB);
            PEER_LOADU(uaA, kqA, scA, (i + 8 < 128) ? i + 8 : i + 4);
            PEER_BAR();
            PEER_DOTS(kqB, scB, i + 4);
            PEER_BAR();
        }
    }
    asm volatile("" ::: "memory");
    for (int pass = 0; pass < 4; ++pass) {
        const int tb4 = 32 * pass + 4 * F.wave, tok = tb4 + g;
        const LAS unsigned short* exr = EXL + tok * EX_STRIDE; const LAS unsigned short* acr = GTL + tok * GT_STRIDE;
        f32x2 y[32];
#pragma unroll
        for (int q = 0; q < 32; ++q) y[q] = (f32x2){0.f, 0.f};
        float* xrow = out + (size_t)(t0 + tok) * DMODEL + 4 * m; const bf16* xres = x1b + (size_t)(t0 + tok) * DMODEL + 4 * m;
#define PEER_LOADV(VB, I) do { const u2v e2_ = *(const LAS u2v*)(exr + (I)); _Pragma("unroll") for (int s4 = 0; s4 < 4; ++s4) { const u32 e_ = (s4 & 1) ? (e2_[s4 >> 1] >> 16) : (e2_[s4 >> 1] & 0xffffu); \
            const u32 ro_ = e_ * 512u + 32u * (u32)m; VB[s4][0] = *(const GAS v4u*)(v4 + ro_); VB[s4][1] = *(const GAS v4u*)(v4 + ro_ + 16); } } while (0)
#define PEER_FMAV(VB, I) do { const u2v a2_ = *(const LAS u2v*)(acr + (I)); _Pragma("unroll") for (int s4 = 0; s4 < 4; ++s4) { \
            const float act_ = (s4 & 1) ? __uint_as_float(a2_[s4 >> 1] & 0xffff0000u) : __uint_as_float(a2_[s4 >> 1] << 16); const f32x2 b2_ = (f32x2){act_, act_}; \
            _Pragma("unroll") for (int c = 0; c < 2; ++c) _Pragma("unroll") for (int d = 0; d < 4; ++d) { const unsigned w_ = VB[s4][c][d]; const int hq = 16 * c + 4 * d; \
                y[hq] = __builtin_elementwise_fma(__builtin_amdgcn_cvt_scalef32_pk_f32_fp4(w_, 1.0f, 0), b2_, y[hq]); y[hq + 1] = __builtin_elementwise_fma(__builtin_amdgcn_cvt_scalef32_pk_f32_fp4(w_, 1.0f, 1), b2_, y[hq + 1]); \
                y[hq + 2] = __builtin_elementwise_fma(__builtin_amdgcn_cvt_scalef32_pk_f32_fp4(w_, 1.0f, 2), b2_, y[hq + 2]); y[hq + 3] = __builtin_elementwise_fma(__builtin_amdgcn_cvt_scalef32_pk_f32_fp4(w_, 1.0f, 3), b2_, y[hq + 3]); } } } while (0)
        v4u vbA[4][2], vbB[4][2], vbC[4][2];
        PEER_LOADV(vbA, 0); PEER_LOADV(vbB, 4);
        PEER_BAR();
        for (int i = 0; i < 120; i += 12) {
            PEER_LOADV(vbC, i + 8);  PEER_BAR(); PEER_FMAV(vbA, i);     PEER_BAR();
            PEER_LOADV(vbA, i + 12); PEER_BAR(); PEER_FMAV(vbB, i + 4); PEER_BAR();
            PEER_LOADV(vbB, i + 16); PEER_BAR(); PEER_FMAV(vbC, i + 8); PEER_BAR();
        }
        PEER_FMAV(vbA, 120); PEER_FMAV(vbB, 124);
        float ss = 0.f;
#pragma unroll
        for (int q = 0; q < 16; ++q) { const u2v xa = *(const GAS u2v*)(xres + 64 * q); y[2 * q][0] += __uint_as_float(xa.x << 16); y[2 * q][1] += __uint_as_float(xa.x & 0xffff0000u); y[2 * q + 1][0] += __uint_as_float(xa.y << 16); y[2 * q + 1][1] += __uint_as_float(xa.y & 0xffff0000u);
            ss += (y[2 * q][0] * y[2 * q][0] + y[2 * q][1] * y[2 * q][1]) + (y[2 * q + 1][0] * y[2 * q + 1][0] + y[2 * q + 1][1] * y[2 * q + 1][1]); }
        ss += __shfl_xor(ss, 1); ss += __shfl_xor(ss, 2); ss += __shfl_xor(ss, 4); ss += __shfl_xor(ss, 8);
        const float rs = rsqrtf(ss * (1.f / DMODEL) + RMS_EPS);
        asm volatile("" ::: "memory");
#pragma unroll
        for (int q = 0; q < 16; ++q) { const f32x4 gq = *(const GAS f32x4*)(fg + 64 * q + 4 * m); f32x4 o; o[0] = y[2 * q][0] * rs * gq[0]; o[1] = y[2 * q][1] * rs * gq[1]; o[2] = y[2 * q + 1][0] * rs * gq[2]; o[3] = y[2 * q + 1][1] * rs * gq[3];
            *(GAS f32x4*)(xrow + 64 * q) = o; }
    }
}
__device__ __forceinline__ void peer_phase(Frame& F, const Args& a) {
    unsigned char* ws = a.ws;
    for (int tile = F.vcu; tile < T / TOK; tile += F.G) {
        route_tile(F, (const bf16*)(ws + WS_QP), (const bf16*)(ws + WS_SKB), (const float*)(ws + WS_SUMSQ), tile * TOK);
        __syncthreads();
        eval_mf(F, ws + WS_U8, ws + WS_V8, (const float*)(ws + WS_SU), a.in[19], (const bf16*)(ws + WS_X1B), a.out, tile * TOK);
        __syncthreads();
    }
}
}

namespace lru {
typedef float f32x16 __attribute__((ext_vector_type(16)));
constexpr int TOKT = 128, NTILE = SEQ / TOKT;
constexpr int WAVE_LDS = 14336, L_XS = 0, L_XC = 4608, L_GS = 9216, XC_STRIDE = 72  , L_SS = 8 * WAVE_LDS;
static_assert(L_SS + 32 * 8 * 4 <= RING_BYTES, "LRU LDS map");
__device__ __forceinline__ float bf2f(unsigned short h) { return __uint_as_float((unsigned)h << 16); }
__device__ __forceinline__ int crow16(int r) { return (r & 3) + 8 * (r >> 2); }
__device__ __forceinline__ float sigm(float x) { return __builtin_amdgcn_rcpf(1.f + __builtin_amdgcn_exp2f(-LOG2E * x)); }

template <bool FINAL> __device__ __forceinline__ void lru_tile(Frame& F, const Args& args, int tile) {
    int lane = F.lane; asm volatile("" : "+v"(lane));
    const int w = F.wave, j32 = lane & 31, hi = lane >> 5;
    unsigned char* ws = args.ws;
    const bf16* xr = (const bf16*)(ws + WS_XR); const bf16* gr = (const bf16*)(ws + WS_GR); float* carry = (float*)(ws + WS_CARRY);
    const float* cw = args.in[3]; const float* cb = args.in[4]; const float* ba = args.in[6]; const float* bx = args.in[8]; const float* lam = args.in[9];
    const int b = tile / NTILE, jt = tile % NTILE; const size_t trow0 = (size_t)b * SEQ + (size_t)jt * TOKT;
    LAS unsigned char* wl = F.lds + RING_OFF + w * WAVE_LDS;
    LAS unsigned short* XS = (LAS unsigned short*)(wl + L_XS); LAS unsigned short* XC = (LAS unsigned short*)(wl + L_XC); LAS unsigned short* GS = (LAS unsigned short*)(wl + L_GS);
    LAS float* SS = (LAS float*)(F.lds + RING_OFF + L_SS);
    float c_ba[2], c_bx[2], c_sp[2], c_cb[2], c_cw[2][4];
#pragma unroll
    for (int n = 0; n < 2; ++n) { const int c = 64 * w + 32 * n + j32; c_ba[n] = ba[c]; c_bx[n] = bx[c]; c_cb[n] = cb[c];
        const float l = lam[c]; c_sp[n] = 8.f * LOG2E * (fmaxf(-l, 0.f) + log1pf(expf(-fabsf(l))));
#pragma unroll
        for (int k = 0; k < 4; ++k) c_cw[n][k] = cw[k * LW + c]; }
    const bf16* wax = (const bf16*)(ws + WS_WAX);
    float hc[2] = {0.f, 0.f}, ap[2] = {1.f, 1.f};
    if (FINAL) { const float* cin = (const float*)(ws + WS_CIN) + (size_t)(b * NTILE + jt) * LW + 64 * w + j32; hc[0] = cin[0]; hc[1] = cin[32]; }
    v4u pfx[5], pfg[4], pce[2][2], pcu[2][2];
    unsigned char* cacheE = ws + WS_LA + ((size_t)(tile * 8 + w) * 4) * 4096; unsigned char* cacheU = ws + WS_LU + ((size_t)(tile * 8 + w) * 4) * 4096;
#define LRU_FETCH(B) do { const size_t tbn_ = trow0 + (B) * 32; \
        if (!FINAL) { _Pragma("unroll") for (int q_ = 0; q_ < 5; ++q_) { const int pc_ = lane + 64 * q_, row_ = pc_ >> 3, c8_ = pc_ & 7; \
            const bool z_ = (jt == 0 && (B) == 0 && row_ < 3) || pc_ >= 35 * 8; const v4u v_ = *(const GAS v4u*)(xr + (tbn_ + (z_ ? 3 : row_) - 3) * LW + w * 64 + c8_ * 8); pfx[q_] = z_ ? (v4u){0u, 0u, 0u, 0u} : v_; } } \
        if (FINAL) { _Pragma("unroll") for (int q_ = 0; q_ < 4; ++q_) { const int pc_ = lane + 64 * q_; pfg[q_] = *(const GAS v4u*)(gr + (tbn_ + (pc_ >> 3)) * LW + w * 64 + (pc_ & 7) * 8); } \
            _Pragma("unroll") for (int n_ = 0; n_ < 2; ++n_) _Pragma("unroll") for (int h_ = 0; h_ < 2; ++h_) { const size_t o_ = (size_t)(B) * 4096 + n_ * 2048 + h_ * 1024 + lane * 16; \
                pce[n_][h_] = *(const GAS v4u*)(cacheE + o_); pcu[n_][h_] = *(const GAS v4u*)(cacheU + o_); } } } while (0)
    LRU_FETCH(0);
    for (int blk = 0; blk < 4; ++blk) {
        const size_t tb = trow0 + blk * 32;
        int ln = lane; asm volatile("" : "+v"(ln));
        const int k32 = ln & 31;
        if (!FINAL) {
#pragma unroll
            for (int q = 0; q < 5; ++q) { const int pc = ln + 64 * q; if (pc < 35 * 8) *(LAS v4u*)((LAS unsigned char*)XS + (pc >> 3) * 128 + (pc & 7) * 16) = pfx[q]; } }
        v4u ce[2][2], cu[2][2];
        if (FINAL) {
#pragma unroll
            for (int n = 0; n < 2; ++n)
#pragma unroll
                for (int h = 0; h < 2; ++h) { ce[n][h] = pce[n][h]; cu[n][h] = pcu[n][h]; }
#pragma unroll
            for (int q = 0; q < 4; ++q) { const int pc = ln + 64 * q; *(LAS v4u*)((LAS unsigned char*)GS + (pc >> 3) * 128 + (pc & 7) * 16) = pfg[q]; } }
        if (blk < 3) { LRU_FETCH(blk + 1); }
        asm volatile("" ::: "memory");
        float xc[2][16];
        bf16x8 af[4];
        if (!FINAL) {
#pragma unroll
        for (int n = 0; n < 2; ++n)
#pragma unroll
            for (int g = 0; g < 4; ++g) { float xv[7];
#pragma unroll
                for (int q = 0; q < 7; ++q) xv[q] = bf2f(XS[(8 * g + 4 * hi + q) * 64 + 32 * n + j32]);
#pragma unroll
                for (int e = 0; e < 4; ++e) xc[n][4 * g + e] = c_cb[n] + ((c_cw[n][0] * xv[e] + c_cw[n][1] * xv[e + 1]) + (c_cw[n][2] * xv[e + 2] + c_cw[n][3] * xv[e + 3])); }
#pragma unroll
        for (int n = 0; n < 2; ++n)
#pragma unroll
            for (int r = 0; r < 16; ++r) XC[(crow16(r) + 4 * hi) * XC_STRIDE + 32 * n + j32] = (unsigned short)f2bf(xc[n][r]);
        asm volatile("" ::: "memory");
#pragma unroll
        for (int ks = 0; ks < 4; ++ks) af[ks] = *(const LAS bf16x8*)(XC + j32 * XC_STRIDE + 16 * ks + 8 * hi);
        asm volatile("" ::: "memory");
        }
        float yv[2][16];
#pragma unroll
        for (int n = 0; n < 2; ++n) {
            float av[16], uv[16];
            if (!FINAL) {
            f32x16 R = {}, I = {};
            bf16x8 fa[4], fx[4];
#pragma unroll
            for (int ks = 0; ks < 4; ++ks) { fa[ks] = *(const GAS bf16x8*)(wax + (size_t)(((w * 2 + 0) * 2 + n) * 4 + ks) * 512 + ln * 8); fx[ks] = *(const GAS bf16x8*)(wax + (size_t)(((w * 2 + 1) * 2 + n) * 4 + ks) * 512 + ln * 8); }
#pragma unroll
            for (int ks = 0; ks < 4; ++ks) { R = __builtin_amdgcn_mfma_f32_32x32x16_bf16(af[ks], fa[ks], R, 0, 0, 0); I = __builtin_amdgcn_mfma_f32_32x32x16_bf16(af[ks], fx[ks], I, 0, 0, 0); }
            unsigned we[8], wu[8];
#pragma unroll
            for (int k = 0; k < 8; ++k) { const float e0 = sigm(R[2 * k] + c_ba[n]) * c_sp[n], e1 = sigm(R[2 * k + 1] + c_ba[n]) * c_sp[n]; we[k] = pg8::cvt_pk_bf16(e0, e1);
                const float a0 = __builtin_amdgcn_exp2f(-__uint_as_float(we[k] << 16)), a1 = __builtin_amdgcn_exp2f(-__uint_as_float(we[k] & 0xffff0000u));
                const float u0 = __builtin_amdgcn_sqrtf(fmaxf(1.f - a0 * a0, 0.f)) * (sigm(I[2 * k] + c_bx[n]) * xc[n][2 * k]), u1 = __builtin_amdgcn_sqrtf(fmaxf(1.f - a1 * a1, 0.f)) * (sigm(I[2 * k + 1] + c_bx[n]) * xc[n][2 * k + 1]);
                wu[k] = pg8::cvt_pk_bf16(u0, u1);
                av[2 * k] = a0; av[2 * k + 1] = a1; uv[2 * k] = __uint_as_float(wu[k] << 16); uv[2 * k + 1] = __uint_as_float(wu[k] & 0xffff0000u); }
            { const size_t o = (size_t)blk * 4096 + n * 2048 + ln * 16;
              *(GAS v4u*)(cacheE + o) = (v4u){we[0], we[1], we[2], we[3]}; *(GAS v4u*)(cacheE + o + 1024) = (v4u){we[4], we[5], we[6], we[7]};
              *(GAS v4u*)(cacheU + o) = (v4u){wu[0], wu[1], wu[2], wu[3]}; *(GAS v4u*)(cacheU + o + 1024) = (v4u){wu[4], wu[5], wu[6], wu[7]}; }
            } else {
#pragma unroll
                for (int k = 0; k < 8; ++k) { const unsigned e2 = ce[n][k >> 2][k & 3], u2 = cu[n][k >> 2][k & 3];
                    av[2 * k] = __builtin_amdgcn_exp2f(-__uint_as_float(e2 << 16)); av[2 * k + 1] = __builtin_amdgcn_exp2f(-__uint_as_float(e2 & 0xffff0000u));
                    uv[2 * k] = __uint_as_float(u2 << 16); uv[2 * k + 1] = __uint_as_float(u2 & 0xffff0000u); }
            }
            float Ar[4], Hr[4], hst[4];
#pragma unroll
            for (int g = 0; g < 4; ++g) { Ar[g] = (av[4 * g] * av[4 * g + 1]) * (av[4 * g + 2] * av[4 * g + 3]);
                Hr[g] = ((uv[4 * g] * av[4 * g + 1] + uv[4 * g + 1]) * av[4 * g + 2] + uv[4 * g + 2]) * av[4 * g + 3] + uv[4 * g + 3]; }
            float hin = hc[n];
#pragma unroll
            for (int g = 0; g < 4; ++g) { float o1 = Ar[g] * hin + Hr[g]; const float x = __shfl_xor(o1, 32); const float hg = hi ? x : hin; o1 = Ar[g] * hg + Hr[g]; hst[g] = hg;
                const float y = __shfl_xor(o1, 32); hin = hi ? o1 : y;
                if (!FINAL) ap[n] *= Ar[g] * __shfl_xor(Ar[g], 32); }
            hc[n] = hin;
            if (FINAL) {
#pragma unroll
                for (int g = 0; g < 4; ++g) { float h = hst[g];
#pragma unroll
                    for (int e = 0; e < 4; ++e) { const int r = 4 * g + e; h = av[r] * h + uv[r]; yv[n][r] = h * bf2f(GS[(crow16(r) + 4 * hi) * 64 + 32 * n + j32]); } } }
        }
        if (FINAL) {
#pragma unroll
            for (int r = 0; r < 16; ++r) { float s = yv[0][r] * yv[0][r] + yv[1][r] * yv[1][r];
                s += __shfl_xor(s, 1); s += __shfl_xor(s, 2); s += __shfl_xor(s, 4); s += __shfl_xor(s, 8); s += __shfl_xor(s, 16);
                if (j32 == 0) SS[(crow16(r) + 4 * hi) * 8 + w] = s; }
            __syncthreads();
            bf16* ymix = (bf16*)(ws + WS_H);
#pragma unroll
            for (int r = 0; r < 16; ++r) { const int tk = crow16(r) + 4 * hi; const f32x4 s0 = *(const LAS f32x4*)(SS + tk * 8), s1 = *(const LAS f32x4*)(SS + tk * 8 + 4);
                const float rstd = rsqrtf(((s0[0] + s0[1]) + (s0[2] + s0[3]) + (s1[0] + s1[1]) + (s1[2] + s1[3])) * (1.f / LW) + RMS_EPS);
                bf16* yp = ymix + (tb + tk) * DMODEL + 64 * w + k32;
                yp[0] = (bf16)f2bf(yv[0][r] * rstd); yp[32] = (bf16)f2bf(yv[1][r] * rstd); }
            __syncthreads();
        }
    }
#undef LRU_FETCH
    if (!FINAL) { if (hi == 0) { float* cp = carry + ((size_t)(b * NTILE + jt) * 2) * LW + 64 * w + j32;
#pragma unroll
        for (int n = 0; n < 2; ++n) { cp[32 * n] = ap[n]; cp[LW + 32 * n] = hc[n]; } } }
    else {
        const bf16* ob = (const bf16*)(ws + WS_O); bf16* ymix = (bf16*)(ws + WS_H);
        for (int i0 = 0; i0 < 16; i0 += 4) {
            v4u vv[4];
#pragma unroll
            for (int i = 0; i < 4; ++i) vv[i] = *(const GAS v4u*)(ob + (trow0 + 16 * w + i0 + i) * AW + 8 * lane);
            float ssq[4];
#pragma unroll
            for (int i = 0; i < 4; ++i) { float s = 0.f;
#pragma unroll
                for (int c = 0; c < 4; ++c) { const float lo = __uint_as_float(vv[i][c] << 16), hi2 = __uint_as_float(vv[i][c] & 0xffff0000u); s += lo * lo + hi2 * hi2; }
                ssq[i] = s; }
#pragma unroll
            for (int o = 1; o < 64; o <<= 1) {
#pragma unroll
                for (int i = 0; i < 4; ++i) ssq[i] += __shfl_xor(ssq[i], o); }
#pragma unroll
            for (int i = 0; i < 4; ++i) { const float rstd = rsqrtf(ssq[i] * (1.f / AW) + RMS_EPS); v4u o;
#pragma unroll
                for (int c = 0; c < 4; ++c) o[c] = pk2(__uint_as_float(vv[i][c] << 16) * rstd, __uint_as_float(vv[i][c] & 0xffff0000u) * rstd);
                *(GAS v4u*)(ymix + (trow0 + 16 * w + i0 + i) * DMODEL + LW + 8 * lane) = o; } }
    }
}
__device__ __forceinline__ void norm_pass(Frame& F, const Args& a) {
    unsigned char* ws = a.ws; float* nrm = (float*)(ws + WS_NRM);
    const int gw = F.vcu * NWAVES + F.wave, NGW = F.G * NWAVES, lane = F.lane;
    for (int it = gw; it < 2 * BATCH * (SEQ / 64); it += NGW) {
        const int which = it / (BATCH * (SEQ / 64)), r = it % (BATCH * (SEQ / 64)), b = r / (SEQ / 64), t = r % (SEQ / 64);
        const bf16* src = (const bf16*)(ws + (which ? WS_K : WS_Q)) + ((size_t)b * SEQ + 64 * t) * AW + 8 * lane;
        float mx = 0.f;
#pragma unroll 8
        for (int i = 0; i < 64; ++i) { const v4u v = *(const GAS v4u*)(src + (size_t)i * AW); float s = 0.f;
#pragma unroll
            for (int c = 0; c < 4; ++c) { const float lo = __uint_as_float(v[c] << 16), hi = __uint_as_float(v[c] & 0xffff0000u); s += lo * lo + hi * hi; }
            s += __shfl_xor(s, 1); s += __shfl_xor(s, 2); s += __shfl_xor(s, 4); mx = fmaxf(mx, s); }
        if ((lane & 7) == 0) nrm[which * 4096 + (b * NHEADS + (lane >> 3)) * 128 + t] = sqrtf(mx) * 1.0001f;
    }
}
__device__ __forceinline__ void carry_prefix(Frame& F, const Args& a, int b) {
    const float* carry = (const float*)(a.ws + WS_CARRY) + (size_t)b * NTILE * 2 * LW + F.tid; float* cin = (float*)(a.ws + WS_CIN) + (size_t)b * NTILE * LW + F.tid;
    float c = 0.f;
    for (int j0 = 0; j0 < NTILE; j0 += 8) { float A[8], H[8];
#pragma unroll
        for (int j = 0; j < 8; ++j) { A[j] = carry[(size_t)(j0 + j) * 2 * LW]; H[j] = carry[(size_t)(j0 + j) * 2 * LW + LW]; }
#pragma unroll
        for (int j = 0; j < 8; ++j) { cin[(size_t)(j0 + j) * LW] = c; c = A[j] * c + H[j]; } }
}
template <bool FINAL> __device__ __forceinline__ void lru_phase(Frame& F, const Args& a) {
    for (int tile = F.vcu; tile < BATCH * NTILE; tile += F.G) { lru_tile<FINAL>(F, a, tile); __syncthreads(); }
}
}
__global__ void __launch_bounds__(NWAVES * 64, 2) mk_fwd(Args args) {
    extern __shared__ __attribute__((aligned(16))) unsigned char lds[];
    Frame F;
    F.lds = (LAS unsigned char*)lds;
    F.MISC = (volatile LAS unsigned*)(F.lds + MISC_OFF);
    F.wave = __builtin_amdgcn_readfirstlane((int)threadIdx.x >> 6); F.lane = (int)__builtin_amdgcn_mbcnt_hi(~0u, __builtin_amdgcn_mbcnt_lo(~0u, 0u)); F.tid = F.wave * 64 + F.lane;
    F.G = gridDim.x; { const int bx = blockIdx.x; F.vcu = (F.G % 8 == 0) ? (bx % 8) * (F.G / 8) + bx / 8 : bx; }
    unsigned char* ws = args.ws;
    F.ctl = (gu32*)(ws + WS_CTL);
    for (int u = F.tid; u < (LDS_BYTES - LDSCTL_OFF) / 4; u += NWAVES * 64) ((LAS unsigned*)(F.lds + LDSCTL_OFF))[u] = 0u;
    __syncthreads();
    XcdBarrier bar = xcd_barrier_post((unsigned*)(F.ctl + CW_BAR) + args.li * XCD_BAR_WORDS, F.MISC + 8, F.wave);
    const int lo = args.ph_lo, hi = args.ph_hi;
#define IN(k) (lo <= (k) && (k) < hi)
#define BOTH(k) (IN(k) && IN((k) + 1))
#define GRID_BAR() xcd_barrier(bar)

    if (IN(0)) { p0_prologue(F, args); if (BOTH(0)) GRID_BAR(); }

    if (IN(1)) {
        if (F.vcu < BATCH * NHEADS) fcum_unit(F, F.vcu, (const float*)(ws + WS_LOGF), (float*)(ws + WS_FCUM));
        pg8::Gemm g{(const pg8::bf16_t*)(ws + WS_H), (const pg8::bf16_t*)(ws + WS_WIN), T, NG1, DMODEL}; pg8::StaticOrder S; S.init(T, NG1, F.G, (int)blockIdx.x);
        pg8::EpiG1 E{(pg8::bf16_t*)(ws + WS_XR), SPLIT_STRIDE, QSCALE};
        pg8::gemm_phase<pg8::EpiG1, pg8::StaticOrder, true, true>(F.lds + RING_OFF, g, S, E, F.wave);
        if (BOTH(1)) GRID_BAR();
    }
    if (IN(2)) { lru::lru_phase<false>(F, args); lru::norm_pass(F, args); if (BOTH(2)) GRID_BAR(); }
    if (IN(3)) {
        static_assert(attn_body::ATTN_LDS_BYTES <= RING_BYTES, "attention LDS vs frame");
        if (F.vcu < BATCH) lru::carry_prefix(F, args, F.vcu);
        const attn_body::AttnTensors AT{(const attn_body::bf16*)(ws + WS_Q), (const attn_body::bf16*)(ws + WS_K), (const attn_body::bf16*)(ws + WS_V), (attn_body::bf16*)(ws + WS_O), (const float*)(ws + WS_FCUM), (const float*)(ws + WS_NRM)};
        attn_body::attn_phase<8>((char*)lds + RING_OFF, AT, (unsigned*)(F.ctl + CW_ATTQ), F.MISC + 24, F.wave);
        if (BOTH(3)) GRID_BAR();
    }
    if (IN(4)) { lru::lru_phase<true>(F, args); if (BOTH(4)) GRID_BAR(); }
    if (IN(5)) {
        pg8::Gemm g{(const pg8::bf16_t*)(ws + WS_H), (const pg8::bf16_t*)(ws + WS_WOUT), T, DMODEL, DMODEL}; pg8::StaticOrder S; S.init(T, DMODEL, F.G, (int)blockIdx.x);
        pg8::EpiG2 E{args.in[0], (pg8::bf16_t*)(ws + WS_X1B), (float*)(ws + WS_SUMSQ), DMODEL};
        pg8::gemm_phase<pg8::EpiG2, pg8::StaticOrder, true, true>(F.lds + RING_OFF, g, S, E, F.wave);
        if (BOTH(5)) GRID_BAR();
    }
    if (IN(6)) {
        pg8::Gemm g{(const pg8::bf16_t*)(ws + WS_X1B), (const pg8::bf16_t*)(ws + WS_WQ), T, QPW, DMODEL}; pg8::StaticOrder S; S.init(T, QPW, F.G, (int)blockIdx.x);
        pg8::EpiG3 E{(pg8::bf16_t*)(ws + WS_QP), QPW};
        pg8::gemm_phase<pg8::EpiG3, pg8::StaticOrder, true, true>(F.lds + RING_OFF, g, S, E, F.wave);
        if (BOTH(6)) GRID_BAR();
    }
    if (IN(7)) { peer::peer_phase(F, args); }
#undef IN
#undef BOTH
#undef GRID_BAR
}

extern "C" void kernel_launch(void* const* d_in, const int* in_sizes, int n_in, void* d_out, int out_size, void* d_ws, size_t ws_size, hipStream_t stream) {
    static int grid = 0;
    if (grid == 0) {
        if (n_in != 20 || in_sizes[0] != T * DMODEL || out_size != T * DMODEL || ws_size < WS_END) { fprintf(stderr, "kernel_launch: unexpected shapes (n_in %d, ws %zu)\n", n_in, ws_size); grid = -1; return; }
        int dev = 0, cus = 0;
        if (hipGetDevice(&dev) != hipSuccess || hipDeviceGetAttribute(&cus, hipDeviceAttributeMultiprocessorCount, dev) != hipSuccess) { grid = -1; return; }
        if (hipFuncSetAttribute((const void*)mk_fwd, hipFuncAttributeMaxDynamicSharedMemorySize, LDS_BYTES) != hipSuccess) { fprintf(stderr, "kernel_launch: hipFuncSetAttribute failed\n"); grid = -1; return; }
        (void)hipGetLastError();
        grid = cus;
    }
    if (grid < 0) return;
    if (hipMemsetAsync((char*)d_ws + WS_CTL, 0, CTL_ZERO_BYTES, stream) != hipSuccess) return;
    Args a{};
    for (int i = 0; i < 20; ++i) a.in[i] = (const float*)d_in[i];
    a.out = (float*)d_out; a.ws = (unsigned char*)d_ws; a.ph_lo = 0; a.ph_hi = N_PHASES; a.li = 0;
    hipLaunchKernelGGL(mk_fwd, dim3(grid), dim3(NWAVES * 64), LDS_BYTES, stream, a);
}
```

```cpp
#include <hip/hip_runtime.h>
#include <hip/hip_bf16.h>
#include <cstdio>
#include <cstdint>
#include <cmath>

constexpr int BATCH = 4, SEQ = 8192, DMODEL = 1024, T = BATCH * SEQ;
constexpr int LW = 512, AW = 512, NHEADS = 8, HD = 64, INC = 2568, NG1 = 2560;
constexpr int PH = 8, NKEY = 128, PHALF = 128, TOPK = 16, NEXP = NKEY * NKEY, QPW = 2048;
constexpr float RMS_EPS = 1e-6f;
constexpr float LOG2E = 1.4426950408889634f;
constexpr float QSCALE = 0.125f * LOG2E;
constexpr size_t MiB = 1u << 20;
constexpr size_t WS_CTL = 0, CTL_ZERO_BYTES = 1 * MiB, WS_RN2 = 24 * MiB  ;
constexpr size_t WS_WIN = 2 * MiB, WS_WOUT = 8 * MiB, WS_WQ = 10 * MiB, WS_SKB = 14 * MiB, WS_WFL = 15 * MiB,
                 WS_LOGF = 16 * MiB, WS_FCUM = 17 * MiB, WS_CARRY = 18 * MiB, WS_SUMSQ = 512 * 1024  , WS_WAX = 20 * MiB, WS_CIN = 23 * MiB  , WS_NRM = 22 * MiB  ,
                 WS_H = 32 * MiB, WS_XR = 96 * MiB, WS_GR = 128 * MiB, WS_Q = 160 * MiB, WS_K = 192 * MiB, WS_V = 224 * MiB,
                 WS_X1B = 256 * MiB, WS_O = 256 * MiB  , WS_QP = 96 * MiB, WS_UT = 320 * MiB, WS_VT = 352 * MiB, WS_U8 = 320 * MiB, WS_V8 = 336 * MiB, WS_SU = 21 * MiB, WS_SV = 21 * MiB + 65536, WS_LA = 384 * MiB, WS_LU = 448 * MiB, WS_END = 512 * MiB;
constexpr size_t SPLIT_STRIDE = (WS_GR - WS_XR) / 2;
constexpr int CW_TMO = 0, CW_ATTQ = 2048, CW_BAR = 4096;

namespace pg8 {
constexpr int BATCH_T = 4 * 8192;
#define PG8_LAS __attribute__((address_space(3)))
typedef unsigned short bf16_t;
typedef short bf16x8 __attribute__((ext_vector_type(8)));
typedef float f32x4 __attribute__((ext_vector_type(4)));
typedef unsigned u32x4 __attribute__((ext_vector_type(4)));
constexpr int BM = 256, BK = 64, HALF = 128, HTB = HALF * BK * 2  , STAGE_BYTES = 8 * HTB, NXCD = 8, WGM = 8;

__host__ __device__ __forceinline__ int lds_byte(int r, int c) { const int st = (r >> 4) * 2 + (c >> 5), rr = r & 15, cc = c & 31, ob = rr * 64 + cc * 2; return st * 1024 + (ob ^ (((ob >> 9) & 1) << 5)); }
__host__ __device__ __forceinline__ void stage_rc(int b, int& R, int& C) { const int st = b / 1024, sb = b % 1024, swz = sb ^ (((sb >> 9) & 1) << 5); R = (st >> 1) * 16 + swz / 64; C = (st & 1) * 32 + (swz % 64) / 2; }
__host__ __device__ __forceinline__ int perm32(int rho) { const int n = rho >> 4, i = rho & 15; return 8 * (i >> 2) + 4 * n + (i & 3); }

struct Unit { int pm, pn; };
struct Gemm { const bf16_t* A; const bf16_t* Bt; int M, N, K; };

struct StaticOrder {
    int nM, nN, nwg, G, c;
    __host__ __device__ void init(int M, int N, int G_, int c_) { nM = M / BM; nN = N / BM; nwg = nM * nN; G = G_; c = c_; }
    __host__ __device__ bool next(int i, Unit& u) const {
        const long L = (long)i * G + c; if (L >= nwg) return false;
        int wgid = (int)L; { const int q = nwg / NXCD, r = nwg % NXCD, xcd = wgid % NXCD, off = wgid / NXCD; wgid = (xcd < r ? xcd * (q + 1) : r * (q + 1) + (xcd - r) * q) + off; }
        const int nig = WGM * nN, gid = wgid / nig, fm = gid * WGM, gsz = (nM - fm) < WGM ? (nM - fm) : WGM;
        u.pm = fm + ((wgid % nig) % gsz); u.pn = (wgid % nig) / gsz; return true;
    }
    __device__ __forceinline__ void a_ready(const Unit&) const {}
    __device__ __forceinline__ void done(const Unit&) const {}
};

__device__ __forceinline__ unsigned cvt_pk_bf16(float lo, float hi) { unsigned r; asm volatile("v_cvt_pk_bf16_f32 %0, %1, %2" : "=v"(r) : "v"(lo), "v"(hi)); return r; }
typedef unsigned u32x2 __attribute__((ext_vector_type(2)));
__device__ __forceinline__ float gelu_fast(float x) {
    const float u2 = x * (1.5957691216057308f + 0.07135481627f * x * x);
    return x * __builtin_amdgcn_rcpf(1.f + __builtin_amdgcn_exp2f(-1.4426950408889634f * u2));
}
struct EpiG1 {
    static constexpr bool PERM = true, AFTER_DRAIN = false;
    bf16_t* base0; size_t split_stride; float qscale; float* rn2;
    __device__ __forceinline__ void operator()(const f32x4 (&acc)[2][2][4][2], const Unit& u, int wr, int wc, int fr, int fq) const {
        const int s = u.pn >> 1; bf16_t* base = base0 + (size_t)s * split_stride;
        const int row0 = u.pm * BM + wr * 64 + fr, col0 = (u.pn & 1) * 256 + wc * 32 + 8 * fq;
#pragma unroll
        for (int ai = 0; ai < 2; ++ai)
#pragma unroll
            for (int m = 0; m < 4; ++m) { bf16_t* rowp = base + (size_t)(row0 + ai * HALF + m * 16) * 512 + col0;
#pragma unroll
                for (int bj = 0; bj < 2; ++bj) { f32x4 v0 = acc[ai][bj][m][0], v1 = acc[ai][bj][m][1];
                    if (s == 1) {
#pragma unroll
                        for (int e = 0; e < 4; ++e) { v0[e] = gelu_fast(v0[e]); v1[e] = gelu_fast(v1[e]); } }
                    else if (s == 2) { v0 = v0 * qscale; v1 = v1 * qscale; }
                    u32x4 w; w.x = cvt_pk_bf16(v0[0], v0[1]); w.y = cvt_pk_bf16(v0[2], v0[3]); w.z = cvt_pk_bf16(v1[0], v1[1]); w.w = cvt_pk_bf16(v1[2], v1[3]);
                    *(u32x4*)(rowp + bj * HALF) = w;
                    if (s == 2 || s == 3) {
                        float ss = 0.f;
#pragma unroll
                        for (int e = 0; e < 4; ++e) { const float lo = __uint_as_float(w[e] << 16), hi = __uint_as_float(w[e] & 0xffff0000u); ss += lo * lo + hi * hi; }
                        ss += __shfl_xor(ss, 16); ss += __shfl_xor(ss, 32);
                        if (fq == 0) { const int row = row0 + ai * HALF + m * 16; rn2[(((size_t)(s - 2) * (size_t)(BATCH_T / 16) + (size_t)(row >> 4)) * 16 + ((u.pn & 1) * 8 + bj * 4 + wc)) * 16 + (row & 15)] = ss; } } } }
    }
};
struct EpiG2 {
    static constexpr bool PERM = true, AFTER_DRAIN = false;
    const float* resid; bf16_t* xb; float* sumsq; int ldc;
    __device__ __forceinline__ void operator()(const f32x4 (&acc)[2][2][4][2], const Unit& u, int wr, int wc, int fr, int fq) const {
        const int row0 = u.pm * BM + wr * 64 + fr, col0 = u.pn * BM + wc * 32 + 8 * fq;
#pragma unroll
        for (int ai = 0; ai < 2; ++ai) {
            f32x4 rs[4][2][2];
#pragma unroll
            for (int m = 0; m < 4; ++m) { const size_t off = (size_t)(row0 + ai * HALF + m * 16) * ldc + col0;
#pragma unroll
                for (int bj = 0; bj < 2; ++bj)
#pragma unroll
                    for (int n = 0; n < 2; ++n) rs[m][bj][n] = *(const f32x4*)(resid + off + bj * HALF + n * 4); }
#pragma unroll
            for (int m = 0; m < 4; ++m) { const int r = row0 + ai * HALF + m * 16; const size_t off = (size_t)r * ldc + col0; float ss = 0.f;
#pragma unroll
                for (int bj = 0; bj < 2; ++bj) { const f32x4 x0 = rs[m][bj][0] + acc[ai][bj][m][0], x1 = rs[m][bj][1] + acc[ai][bj][m][1];
                    ss += ((x0[0] * x0[0] + x0[1] * x0[1]) + (x0[2] * x0[2] + x0[3] * x0[3])) + ((x1[0] * x1[0] + x1[1] * x1[1]) + (x1[2] * x1[2] + x1[3] * x1[3]));
                    u32x4 w; w.x = cvt_pk_bf16(x0[0], x0[1]); w.y = cvt_pk_bf16(x0[2], x0[3]); w.z = cvt_pk_bf16(x1[0], x1[1]); w.w = cvt_pk_bf16(x1[2], x1[3]);
                    *(u32x4*)(xb + off + bj * HALF) = w; }
                ss += __shfl_xor(ss, 16); ss += __shfl_xor(ss, 32);
                if (fq == 0) atomicAdd(sumsq + r, ss); }
            asm volatile("" ::: "memory"); }
    }
};
struct EpiG3 {
    static constexpr bool PERM = true, AFTER_DRAIN = false;
    bf16_t* O; int ldc;
    __device__ __forceinline__ void operator()(const f32x4 (&acc)[2][2][4][2], const Unit& u, int wr, int wc, int fr, int fq) const {
        const int row0 = u.pm * BM + wr * 64 + fr;
#pragma unroll
        for (int ai = 0; ai < 2; ++ai)
#pragma unroll
            for (int m = 0; m < 4; ++m) { const int t = row0 + ai * HALF + m * 16;
#pragma unroll
                for (int bj = 0; bj < 2; ++bj) { const f32x4 v0 = acc[ai][bj][m][0], v1 = acc[ai][bj][m][1];
                    u32x4 w; w.x = cvt_pk_bf16(v0[0], v0[1]); w.y = cvt_pk_bf16(v0[2], v0[3]); w.z = cvt_pk_bf16(v1[0], v1[1]); w.w = cvt_pk_bf16(v1[2], v1[3]);
                    *(u32x4*)(O + ((size_t)(((((t >> 5) * 8 + u.pn) * 2 + bj) * 16 + 4 * wc + fq) * 32 + (t & 31))) * 8) = w; } }
    }
};

template <class Epi, class Sched, bool ALIGN_EPI = false, bool SP2 = false>
__device__ __forceinline__ void gemm_phase(PG8_LAS unsigned char* lds, const Gemm g, const Sched& S, const Epi& E, int wid_in) {
    const int wid = __builtin_amdgcn_readfirstlane(wid_in), lane = (int)__builtin_amdgcn_mbcnt_hi(~0u, __builtin_amdgcn_mbcnt_lo(~0u, 0u)), tid = wid * 64 + lane, wr = wid >> 2, wc = wid & 3, fr = lane & 15, fq = lane >> 4;
    const int K = g.K, nt = K / BK;
    unsigned voffA[2], voffB[2];
#pragma unroll
    for (int i = 0; i < 2; ++i) { int R, C; stage_rc(tid * 16 + i * 8192, R, C); const int Rb = Epi::PERM ? ((R & ~31) + perm32(R & 31)) : R;
        voffA[i] = (unsigned)(R * K + C) * 2u; voffB[i] = (unsigned)(Rb * K + C) * 2u; }
    const size_t kstep = (size_t)(BK * 2);
    const size_t hstep = (size_t)HALF * K * 2;
    const size_t tstep = 2 * hstep;
    const unsigned ldsw = (unsigned)wid * 1024u;
    const int aoff = lds_byte(wr * 64 + fr, fq * 8), boff = lds_byte(wc * 32 + fr, fq * 8);
#define PG8_SA(b, h) (((b) * 2 + (h)) * HTB)
#define PG8_SB(b, h) ((4 + (b) * 2 + (h)) * HTB)
#define PG8_STAGE(bufoff, gbase, voff) do { _Pragma("unroll") for (int _i = 0; _i < 2; ++_i) \
        __builtin_amdgcn_global_load_lds((const unsigned*)((const char*)(gbase) + (voff)[_i]), (PG8_LAS unsigned*)(lds + (bufoff) + ldsw + _i * 8192), 16, 0, 0); } while (0)
#define PG8_LDA(dst, b, h) do { _Pragma("unroll") for (int m = 0; m < 4; ++m) _Pragma("unroll") for (int k = 0; k < 2; ++k) dst[m][k] = *(const PG8_LAS bf16x8*)(lds + PG8_SA(b, h) + aoff + m * 2048 + k * 1024); } while (0)
#define PG8_LDB(dst, b, h) do { _Pragma("unroll") for (int n = 0; n < 2; ++n) _Pragma("unroll") for (int k = 0; k < 2; ++k) dst[n][k] = *(const PG8_LAS bf16x8*)(lds + PG8_SB(b, h) + boff + n * 2048 + k * 1024); } while (0)
#define PG8_MMA(ai, bj, At, Bt) do { __builtin_amdgcn_s_setprio(1); _Pragma("unroll") for (int m = 0; m < 4; ++m) _Pragma("unroll") for (int n = 0; n < 2; ++n) _Pragma("unroll") for (int k = 0; k < 2; ++k) \
        acc[ai][bj][m][n] = __builtin_amdgcn_mfma_f32_16x16x32_bf16(Bt[n][k], At[m][k], acc[ai][bj][m][n], 0, 0, 0); __builtin_amdgcn_s_setprio(0); } while (0)
#define PG8_WAIT_V(n) asm volatile("s_waitcnt vmcnt(" #n ")" ::: "memory")
#define PG8_WAIT_L(n) asm volatile("s_waitcnt lgkmcnt(" #n ")" ::: "memory")
#define PG8_BAR __builtin_amdgcn_s_barrier()
#define PG8_SCHED __builtin_amdgcn_sched_barrier(0)
    Unit cur, nxt; int ui = 0;
    if (!S.next(0, cur)) return;
    f32x4 acc[2][2][4][2];
#pragma unroll
    for (int a = 0; a < 2; ++a)
#pragma unroll
        for (int b = 0; b < 2; ++b)
#pragma unroll
            for (int m = 0; m < 4; ++m)
#pragma unroll
                for (int n = 0; n < 2; ++n) acc[a][b][m][n] = (f32x4){0.f, 0.f, 0.f, 0.f};
    bf16x8 At[4][2], B0[2][2], B1[2][2];
    const char* cA = (const char*)g.A + (size_t)cur.pm * tstep; const char* cB = (const char*)g.Bt + (size_t)cur.pn * tstep;
    S.a_ready(cur);
    if constexpr (SP2) {
        PG8_STAGE(PG8_SB(0, 0), cB, voffB); PG8_STAGE(PG8_SB(0, 1), cB + hstep, voffB); PG8_STAGE(PG8_SA(0, 0), cA, voffA); PG8_STAGE(PG8_SA(0, 1), cA + hstep, voffA);
        if (wr == 1) PG8_BAR;
        PG8_WAIT_V(2); PG8_BAR;
        PG8_STAGE(PG8_SB(1, 0), cB + kstep, voffB); PG8_STAGE(PG8_SA(1, 0), cA + kstep, voffA); PG8_STAGE(PG8_SB(1, 1), cB + hstep + kstep, voffB);
        PG8_WAIT_V(6); PG8_BAR;
    } else {
        PG8_STAGE(PG8_SB(0, 0), cB, voffB); PG8_STAGE(PG8_SA(0, 0), cA, voffA); PG8_STAGE(PG8_SB(0, 1), cB + hstep, voffB); PG8_STAGE(PG8_SA(0, 1), cA + hstep, voffA);
        if (wr == 1) PG8_BAR;
        PG8_WAIT_V(4); PG8_BAR;
        PG8_STAGE(PG8_SB(1, 0), cB + kstep, voffB); PG8_STAGE(PG8_SA(1, 0), cA + kstep, voffA); PG8_STAGE(PG8_SB(1, 1), cB + hstep + kstep, voffB);
        PG8_WAIT_V(6); PG8_BAR;
    }
    for (;;) {
        const bool has_next = S.next(ui + 1, nxt);
        const char* nA = has_next ? (const char*)g.A + (size_t)nxt.pm * tstep : cA; const char* nB = has_next ? (const char*)g.Bt + (size_t)nxt.pn * tstep : cB;
        for (int t = 0; t < nt; t += 2) {
            const bool last = (t == nt - 2);
            const char* a1 = cA + (size_t)(t + 1) * kstep;
            const char* a2 = last ? nA : cA + (size_t)(t + 2) * kstep; const char* b2 = last ? nB : cB + (size_t)(t + 2) * kstep;
            const char* a3 = a2 + kstep; const char* b3 = b2 + kstep;
            if (last && has_next) S.a_ready(nxt);
            if constexpr (SP2) {
            PG8_LDB(B0, 0, 0); PG8_LDB(B1, 0, 1); PG8_SCHED; PG8_LDA(At, 0, 0); PG8_STAGE(PG8_SA(1, 1), a1 + hstep, voffA);
            PG8_WAIT_V(8); PG8_WAIT_L(0); PG8_BAR; PG8_MMA(0, 0, At, B0); PG8_MMA(0, 1, At, B1); PG8_BAR; PG8_SCHED;
            PG8_LDA(At, 0, 1); PG8_STAGE(PG8_SB(0, 0), b2, voffB); PG8_STAGE(PG8_SB(0, 1), b2 + hstep, voffB); PG8_STAGE(PG8_SA(0, 0), a2, voffA);
            PG8_WAIT_V(8); PG8_WAIT_L(0); PG8_BAR; PG8_MMA(1, 0, At, B0); PG8_MMA(1, 1, At, B1); PG8_BAR; PG8_SCHED;
            PG8_LDB(B0, 1, 0); PG8_LDB(B1, 1, 1); PG8_SCHED; PG8_LDA(At, 1, 0); PG8_STAGE(PG8_SA(0, 1), a2 + hstep, voffA);
            PG8_WAIT_V(8); PG8_WAIT_L(0); PG8_BAR; PG8_MMA(0, 0, At, B0); PG8_MMA(0, 1, At, B1); PG8_BAR; PG8_SCHED;
            PG8_LDA(At, 1, 1); PG8_STAGE(PG8_SB(1, 0), b3, voffB); PG8_STAGE(PG8_SB(1, 1), b3 + hstep, voffB); PG8_STAGE(PG8_SA(1, 0), a3, voffA);
            PG8_WAIT_V(8); PG8_WAIT_L(0); PG8_BAR; PG8_MMA(1, 0, At, B0); PG8_MMA(1, 1, At, B1); PG8_BAR; PG8_SCHED;
            } else {
            PG8_LDB(B0, 0, 0); PG8_SCHED; PG8_LDA(At, 0, 0); PG8_STAGE(PG8_SA(1, 1), a1 + hstep, voffA);
            PG8_WAIT_L(8); PG8_BAR; PG8_WAIT_L(0); PG8_MMA(0, 0, At, B0); PG8_BAR; PG8_SCHED;
            PG8_LDB(B1, 0, 1); PG8_STAGE(PG8_SB(0, 0), b2, voffB);
            PG8_BAR; PG8_WAIT_L(0); PG8_MMA(0, 1, At, B1); PG8_BAR;
            PG8_LDA(At, 0, 1); PG8_STAGE(PG8_SA(0, 0), a2, voffA);
            PG8_BAR; PG8_WAIT_L(0); PG8_MMA(1, 0, At, B0); PG8_BAR; PG8_SCHED;
            PG8_STAGE(PG8_SB(0, 1), b2 + hstep, voffB);
            PG8_WAIT_V(6); PG8_BAR; PG8_MMA(1, 1, At, B1); PG8_BAR;
            PG8_LDB(B0, 1, 0); PG8_SCHED; PG8_LDA(At, 1, 0); PG8_STAGE(PG8_SA(0, 1), a2 + hstep, voffA);
            PG8_WAIT_L(8); PG8_BAR; PG8_WAIT_L(0); PG8_MMA(0, 0, At, B0); PG8_BAR; PG8_SCHED;
            PG8_LDB(B1, 1, 1); PG8_STAGE(PG8_SB(1, 0), b3, voffB);
            PG8_BAR; PG8_WAIT_L(0); PG8_MMA(0, 1, At, B1); PG8_BAR;
            PG8_LDA(At, 1, 1); PG8_STAGE(PG8_SA(1, 0), a3, voffA);
            PG8_BAR; PG8_WAIT_L(0); PG8_MMA(1, 0, At, B0); PG8_BAR; PG8_SCHED;
            PG8_STAGE(PG8_SB(1, 1), b3 + hstep, voffB);
            PG8_WAIT_V(6); PG8_BAR; PG8_MMA(1, 1, At, B1); PG8_BAR;
            }
        }
        if constexpr (ALIGN_EPI) { if (wr == 0) PG8_BAR; }
        if constexpr (!Epi::AFTER_DRAIN) { E(acc, cur, wr, wc, fr, fq); S.done(cur); }
        if (!has_next) break;
#pragma unroll
        for (int a = 0; a < 2; ++a)
#pragma unroll
            for (int b = 0; b < 2; ++b)
#pragma unroll
                for (int m = 0; m < 4; ++m)
#pragma unroll
                    for (int n = 0; n < 2; ++n) acc[a][b][m][n] = (f32x4){0.f, 0.f, 0.f, 0.f};
        cur = nxt; cA = nA; cB = nB; ++ui;
        if constexpr (ALIGN_EPI) { if (wr == 1) PG8_BAR; }
    }
    PG8_WAIT_V(0);
    if constexpr (!ALIGN_EPI) { if (wr == 0) PG8_BAR; }
    PG8_BAR;
    if constexpr (Epi::AFTER_DRAIN) { E.fused(acc, cur, wr, wc, fr, fq, lds, wid, lane); S.done(cur); }
#undef PG8_SA
#undef PG8_SB
#undef PG8_STAGE
#undef PG8_LDA
#undef PG8_LDB
#undef PG8_MMA
#undef PG8_WAIT_V
#undef PG8_WAIT_L
#undef PG8_BAR
#undef PG8_SCHED
}
}
#include <hip/hip_bf16.h>
#include <cmath>
namespace attn_body {
using bf16=__hip_bfloat16;
using bf16x8=__attribute__((ext_vector_type(8)))short;
using s16x4=__attribute__((ext_vector_type(4)))short;
using f32x16=__attribute__((ext_vector_type(16)))float;
using u32x4=__attribute__((ext_vector_type(4)))unsigned;
constexpr int BATCH=4,NHEAD=8,SEQ=8192,D=64,DM=NHEAD*D;
constexpr int NW=8,QBLK=32,QB=QBLK*NW,KVBLK=64,NQB=SEQ/QB;
constexpr int ATTN_PITCH=DM, ATTN_UNIT_ROWS=QB;
__device__ __forceinline__ int crow(int r,int hi){return (r&3)+8*(r>>2)+4*hi;}
#define SBAR() __builtin_amdgcn_sched_barrier(0)
__device__ __forceinline__ void cmask(f32x16&p0,f32x16&p1,int jb,int qrel,int hi){
  const float NEG=-INFINITY; int kb=64*jb+4*hi;
  #pragma unroll
  for(int r=0;r<16;++r){int kv=kb+(r&3)+8*(r>>2); if(kv>qrel)p0[r]=NEG; if(kv+32>qrel)p1[r]=NEG;}
}

constexpr int NSLOT=3, SLOTB=8192;
constexpr int LDS_K=0, LDS_V=NSLOT*SLOTB, LDS_WS=2*NSLOT*SLOTB, LDS_OST=LDS_WS+NW*64*4, LDS_FK=LDS_OST+NW*4096, LDS_BYTES=LDS_FK+SEQ*4;
constexpr float C2=0.125f*1.4426950408889634f;
__device__ __forceinline__ void glds16(const void*gsrc,unsigned lds_dst){unsigned keep;
  asm volatile("s_mov_b32 %0, m0\n\ts_mov_b32 m0, %2\n\ts_nop 0\n\tglobal_load_lds_dwordx4 %1, off\n\ts_mov_b32 m0, %0":"=&s"(keep):"v"(gsrc),"s"(lds_dst):"memory");}
__device__ __forceinline__ float max3f(float a,float b,float c){float r;asm("v_max3_f32 %0, %1, %2, %3":"=v"(r):"v"(a),"v"(b),"v"(c));return r;}
__device__ __forceinline__ float max2f(float a,float b){float r;asm("v_max_f32_e32 %0, %1, %2":"=v"(r):"v"(a),"v"(b));return r;}
__device__ __forceinline__ float fadd_s(float a,float b){float r;asm("v_add_f32_e32 %0, %1, %2":"=v"(r):"v"(a),"v"(b));return r;}
__device__ __forceinline__ float fsub_s(float a,float b){float r;asm("v_sub_f32_e32 %0, %1, %2":"=v"(r):"v"(a),"v"(b));return r;}
typedef float f32x2_t __attribute__((ext_vector_type(2))); typedef __bf16 bf16x2_t __attribute__((ext_vector_type(2)));
__device__ __forceinline__ unsigned cvtpk_s(float lo,float hi){f32x2_t v={lo,hi};bf16x2_t b=__builtin_convertvector(v,bf16x2_t);return __builtin_bit_cast(unsigned,b);}
#define WAIT_BAR(N) asm volatile("s_waitcnt vmcnt(" #N ") lgkmcnt(0)\n\ts_barrier":::"memory")

__device__ __forceinline__ void qkt(f32x16&p0,f32x16&p1,const char*Kslot,const bf16x8*qr,int r32,int hi){
  const char*kb=Kslot+hi*1024+r32*16;
  #pragma unroll
  for(int d0=0;d0<4;++d0){
    const bf16x8 b0=*reinterpret_cast<const bf16x8*>(kb+d0*2048);
    const bf16x8 b1=*reinterpret_cast<const bf16x8*>(kb+d0*2048+512);
    p0=__builtin_amdgcn_mfma_f32_32x32x16_bf16(b0,qr[d0],p0,0,0,0);p1=__builtin_amdgcn_mfma_f32_32x32x16_bf16(b1,qr[d0],p1,0,0,0);}
}
typedef __attribute__((address_space(3))) const char* lds_cptr;
typedef short v4i16_t __attribute__((ext_vector_type(4)));
__device__ __forceinline__ void kload8(bf16x8*kf,lds_cptr kp){
  kf[0]=*(const __attribute__((address_space(3))) bf16x8*)(kp);      kf[1]=*(const __attribute__((address_space(3))) bf16x8*)(kp+512);
  kf[2]=*(const __attribute__((address_space(3))) bf16x8*)(kp+2048); kf[3]=*(const __attribute__((address_space(3))) bf16x8*)(kp+2560);
  kf[4]=*(const __attribute__((address_space(3))) bf16x8*)(kp+4096); kf[5]=*(const __attribute__((address_space(3))) bf16x8*)(kp+4608);
  kf[6]=*(const __attribute__((address_space(3))) bf16x8*)(kp+6144); kf[7]=*(const __attribute__((address_space(3))) bf16x8*)(kp+6656);
}
__device__ __forceinline__ void kload2(bf16x8*kf,lds_cptr kp,int j){ kf[2*j]=*(const __attribute__((address_space(3))) bf16x8*)(kp+j*2048); kf[2*j+1]=*(const __attribute__((address_space(3))) bf16x8*)(kp+j*2048+512); }
__device__ __forceinline__ s16x4 vtr(lds_cptr p){ return __builtin_bit_cast(s16x4,__builtin_amdgcn_ds_read_tr16_b64_v4i16((__attribute__((address_space(3))) v4i16_t*)p)); }
__device__ __forceinline__ float rowmax(const f32x16&p0,const f32x16&p1){
  float a=max3f(p0[0],p0[1],p1[0]),b=max3f(p0[2],p0[3],p1[1]);a=max3f(a,p1[2],p1[3]);
  #pragma unroll
  for(int r=4;r<16;r+=4){a=max3f(a,p0[r],p0[r+1]);b=max3f(b,p0[r+2],p0[r+3]);a=max3f(a,p1[r],p1[r+1]);b=max3f(b,p1[r+2],p1[r+3]);}
  const float m=max2f(a,b);
  auto rr=__builtin_amdgcn_permlane32_swap(__float_as_uint(m),__float_as_uint(m),false,false);
  return max2f(__uint_as_float(rr[0]),__uint_as_float(rr[1]));
}
__device__ __forceinline__ void pv(f32x16*o,int vb,bf16x8 pa0,bf16x8 pa1,bf16x8 pa2,bf16x8 pa3){
  #pragma unroll
  for(int d0=0;d0<2;++d0){s16x4 lo[4],hi[4];
    #pragma unroll
    for(int ks=0;ks<4;++ks){
      asm volatile("ds_read_b64_tr_b16 %0,%1 offset:%c2":"=&v"(lo[ks]):"v"(vb),"i"(d0*4096+ks*1024):"memory");
      asm volatile("ds_read_b64_tr_b16 %0,%1 offset:%c2":"=&v"(hi[ks]):"v"(vb),"i"(d0*4096+ks*1024+512):"memory");}
    asm volatile("s_waitcnt lgkmcnt(0)":::"memory");SBAR();
    #define PK(k) (bf16x8){lo[k][0],lo[k][1],lo[k][2],lo[k][3],hi[k][0],hi[k][1],hi[k][2],hi[k][3]}
    o[d0]=__builtin_amdgcn_mfma_f32_32x32x16_bf16(pa0,PK(0),o[d0],0,0,0);
    o[d0]=__builtin_amdgcn_mfma_f32_32x32x16_bf16(pa1,PK(1),o[d0],0,0,0);
    o[d0]=__builtin_amdgcn_mfma_f32_32x32x16_bf16(pa2,PK(2),o[d0],0,0,0);
    o[d0]=__builtin_amdgcn_mfma_f32_32x32x16_bf16(pa3,PK(3),o[d0],0,0,0);
    #undef PK
  }
}

#ifndef ATTN_STORE16
#define ATTN_STORE16(p,v) (*(u32x4*)(p)=(v))
#endif
template<int THRL> __device__ __forceinline__ void attn_unit(int b,int h,int qb,const bf16*Q,const bf16*__restrict__ K,const bf16*__restrict__ V,bf16*O,const float*__restrict__ Fc,const float*__restrict__ NRM,char*shm,int wid_in){
  const int wid=__builtin_amdgcn_readfirstlane(wid_in); int lane_=(int)__builtin_amdgcn_mbcnt_hi(~0u,__builtin_amdgcn_mbcnt_lo(~0u,0u)); asm volatile("":"+v"(lane_));
  const int lane=lane_,tid=wid*64+lane,r32=lane&31,hi=lane>>5;
  const long rowbase=(long)b*SEQ; const int q0=qb*QB;
  const float*Fbh=Fc+(long)(b*NHEAD+h)*SEQ;
  const int NTF=(q0+QB)/KVBLK; int t_start;
  { const float*QNb=NRM+(b*NHEAD+h)*128,*KNb=NRM+4096+(b*NHEAD+h)*128;
    const float qn=fmaxf(fmaxf(QNb[4*qb],QNb[4*qb+1]),fmaxf(QNb[4*qb+2],QNb[4*qb+3])),knb=fmaxf(fmaxf(KNb[4*qb],KNb[4*qb+1]),fmaxf(KNb[4*qb+2],KNb[4*qb+3]));
    const float fq0=Fbh[q0]*1.4426950408889634f; bool k0=true,k1=true;
    if(lane<NTF-4)k0=!(qn*(KNb[lane]+knb)+(fq0-Fbh[64*lane+63]*1.4426950408889634f)<-40.f);
    if(lane+64<NTF-4)k1=!(qn*(KNb[lane+64]+knb)+(fq0-Fbh[64*(lane+64)+63]*1.4426950408889634f)<-40.f);
    const unsigned long long m0=__ballot(k0),m1=__ballot(k1);
    int tf=m0?(int)__builtin_ctzll(m0):64+(m1?(int)__builtin_ctzll(m1):64);
    tf=tf<NTF-4?tf:NTF-4; t_start=__builtin_amdgcn_readfirstlane(tf&~1); }
  { typedef float f32x4_t __attribute__((ext_vector_type(4))); __attribute__((address_space(3))) float*fk=(__attribute__((address_space(3))) float*)((__attribute__((address_space(3))) char*)shm+LDS_FK); const int n4=(q0+QB)/4;
    for(int i=16*t_start+tid;i<n4;i+=NW*64){ f32x4_t v=*(const f32x4_t*)(Fbh+4*i); v=v*(-1.4426950408889634f); *(__attribute__((address_space(3))) f32x4_t*)(fk+4*i)=v; } }
  float fq2=Fbh[q0+wid*QBLK+r32]*1.4426950408889634f; asm volatile("":"+v"(fq2));
  const bf16*Qw=Q+(rowbase+q0+wid*QBLK)*DM+h*D;
  const bf16*Kh=K+(rowbase+(long)t_start*KVBLK)*DM+h*D,*Vh=V+(rowbase+(long)t_start*KVBLK)*DM+h*D;
  const lds_cptr shm3=(lds_cptr)shm;
  const unsigned lds0=(unsigned)(uintptr_t)shm;
  float*wsf=(float*)(shm+LDS_WS)+wid*64;
  const bf16*ksrc=Kh+(long)lane*DM+wid*8;
  const bf16*vsrc=Vh+(long)(16*(wid&3)+(lane>>2))*DM+(wid>>2)*32+(lane&3)*8;
  const unsigned kdst=lds0+LDS_K+wid*1024, vdst=lds0+LDS_V+wid*1024;
  #define DMA_K(t,slot) glds16(ksrc+(long)(t)*KVBLK*DM,(unsigned)__builtin_amdgcn_readfirstlane(kdst+(slot)))
  #define DMA_V(t,slot) glds16(vsrc+(long)(t)*KVBLK*DM,(unsigned)__builtin_amdgcn_readfirstlane(vdst+(slot)))
  const int vb0=(int)(lds0+LDS_V)+((lane>>4)&1)*32+(lane&3)*8+(4*hi+((lane&15)>>2))*64;
  const char*Kbase=shm+LDS_K; bf16x8 kf[8];
  const lds_cptr kp0=shm3+LDS_K+hi*1024+r32*16; const lds_cptr vp0=shm3+LDS_V+((lane>>4)&1)*32+(lane&3)*8+(4*hi+((lane&15)>>2))*64;
  const int NT=NTF-t_start;
  DMA_K(0,0);DMA_V(0,0);DMA_K(1,SLOTB);
  bf16x8 qr[4];
  #pragma unroll
  for(int d0=0;d0<4;++d0)qr[d0]=*reinterpret_cast<const bf16x8*>(&Qw[(long)r32*DM+d0*16+hi*8]);
  float mhat=0.f,l_reg=0.f;f32x16 o[2];o[0]=f32x16{};o[1]=f32x16{};
  const __attribute__((address_space(3))) float*fkl=(const __attribute__((address_space(3))) float*)(shm3+LDS_FK)+64*t_start+4*hi;
  #define INITC(C0,C1,t) do{ const float nsc_=fq2-mhat; typedef float f32x4_t __attribute__((ext_vector_type(4))); const __attribute__((address_space(3))) float*kb_=fkl+64*(t); \
    _Pragma("unroll") for(int g_=0;g_<4;++g_){ const f32x4_t a_=*(const __attribute__((address_space(3))) f32x4_t*)(kb_+8*g_), b_=*(const __attribute__((address_space(3))) f32x4_t*)(kb_+32+8*g_); \
      _Pragma("unroll") for(int e_=0;e_<4;++e_){ C0[4*g_+e_]=nsc_+a_[e_]; C1[4*g_+e_]=nsc_+b_[e_]; } } }while(0)
  const int qrel=wid*QBLK+r32;
  #define CMASK(P0,P1,t) do{int jb_=(t)-(NT-4); if(jb_>=0)cmask(P0,P1,jb_,qrel,hi);}while(0)
  bool resc=false;
  #define START(P0,P1) do{ const float rm=rowmax(P0,P1); resc=false; \
    { const float dl=rm; mhat=fadd_s(mhat,dl); \
      _Pragma("unroll") for(int r=0;r<16;++r){P0[r]=fsub_s(P0[r],dl);P1[r]=fsub_s(P1[r],dl);} \
      } \
    _Pragma("unroll") for(int r=0;r<16;++r)P0[r]=__builtin_amdgcn_exp2f(P0[r]); }while(0)
  #define RESC() do{ if(resc){ asm volatile("s_waitcnt lgkmcnt(0)":::"memory"); \
      _Pragma("unroll") for(int d_=0;d_<2;++d_) _Pragma("unroll") for(int r=0;r<16;++r)o[d_][r]*=wsf[crow(r,hi)]; } }while(0)
  f32x16 pA0,pA1,pB0,pB1;
  int sl_prev=0,sl_cur=0,sl_next=SLOTB;
  #define ROT() do{sl_prev=sl_cur;sl_cur=sl_next;sl_next=(sl_next==(NSLOT-1)*SLOTB)?0:sl_next+SLOTB;}while(0)
  DMA_K(2,2*SLOTB);
  WAIT_BAR(3);
  INITC(pA0,pA1,0); qkt(pA0,pA1,Kbase,qr,r32,hi);asm volatile("s_nop 15\n\ts_nop 7":"+v"(pA0),"+v"(pA1));CMASK(pA0,pA1,0);
  START(pA0,pA1);
  _Pragma("unroll") for(int r=0;r<16;++r)pA1[r]=__builtin_amdgcn_exp2f(pA1[r]);
  WAIT_BAR(0);
  DMA_K(3,0);DMA_V(1,SLOTB);
  ROT();
  kload8(kf,kp0+sl_cur);
  WAIT_BAR(2);
  s16x4 vlo[8],vhi[8]; u32x4 pw0,pw1,pw2,pw3;
  #define PKW(P,B) cvtpk_s(P[B],P[B+1])
  #define PAF(k) __builtin_bit_cast(bf16x8,pw##k)
  #define VFR(i) (bf16x8){vlo[i][0],vlo[i][1],vlo[i][2],vlo[i][3],vhi[i][0],vhi[i][1],vhi[i][2],vhi[i][3]}
  #define PIN(x) asm volatile("":"+v"(x))
  #define MX3(a,b,c) __builtin_fmaxf(__builtin_fmaxf((a),(b)),(c))
  #define GAPA(MF,A0,A1,A2,A3,W0,W1,PW) do{ MF; sacc+=A0; sacc+=A1; sacc+=A2; sacc+=A3; PIN(sacc); W0; W1; PIN(PW); SBAR(); }while(0)
  #define EX(v) __builtin_amdgcn_exp2f(v)
  #define GAPB(MF,X,B) do{ MF; X[B]=EX(X[B]); X[B+1]=EX(X[B+1]); X[B+2]=EX(X[B+2]); X[B+3]=EX(X[B+3]); PIN(X); SBAR(); }while(0)
  #define VRD(i) do{ vlo[i]=vtr(vp_+(((i)>>2)*4096+((i)&3)*1024)); vhi[i]=vtr(vp_+(((i)>>2)*4096+((i)&3)*1024+512)); }while(0)
  #define KRD(G,j) do{ if(G){ kload2(kf,kp0+sl_next,j); SBAR(); } }while(0)
  #define STEP(C0,C1,P0,P1,t,GK,GV,GL) do{ SBAR(); INITC(C0,C1,t); PIN(C0); PIN(C1); SBAR(); \
    const lds_cptr vp_=vp0+sl_prev; \
    VRD(0); SBAR(); float sacc=(P0[0]+P0[1]); \
    GAPA(C0=__builtin_amdgcn_mfma_f32_32x32x16_bf16(kf[0],qr[0],C0,0,0,0), P0[2],P0[3],P0[4],P0[5],     pw0[0]=PKW(P0,0), pw0[1]=PKW(P0,2), pw0); \
    VRD(4); SBAR(); GAPA(C1=__builtin_amdgcn_mfma_f32_32x32x16_bf16(kf[1],qr[0],C1,0,0,0), P0[6],P0[7],P0[8],P0[9],     pw0[2]=PKW(P0,4), pw0[3]=PKW(P0,6), pw0); \
    VRD(1); SBAR(); GAPA(C0=__builtin_amdgcn_mfma_f32_32x32x16_bf16(kf[2],qr[1],C0,0,0,0),   P0[10],P0[11],P0[12],P0[13], pw1[0]=PKW(P0,8), pw1[1]=PKW(P0,10), pw1); \
    VRD(5); SBAR(); GAPA(C1=__builtin_amdgcn_mfma_f32_32x32x16_bf16(kf[3],qr[1],C1,0,0,0),   P0[14],P0[15],P1[0],P1[1],   pw1[2]=PKW(P0,12),pw1[3]=PKW(P0,14), pw1); \
    VRD(2); SBAR(); GAPA(C0=__builtin_amdgcn_mfma_f32_32x32x16_bf16(kf[4],qr[2],C0,0,0,0),   P1[2],P1[3],P1[4],P1[5],     pw2[0]=PKW(P1,0), pw2[1]=PKW(P1,2), pw2); \
    VRD(6); SBAR(); GAPA(C1=__builtin_amdgcn_mfma_f32_32x32x16_bf16(kf[5],qr[2],C1,0,0,0),   P1[6],P1[7],P1[8],P1[9],     pw2[2]=PKW(P1,4), pw2[3]=PKW(P1,6), pw2); \
    VRD(3); SBAR(); GAPA(C0=__builtin_amdgcn_mfma_f32_32x32x16_bf16(kf[6],qr[3],C0,0,0,0),   P1[10],P1[11],P1[12],P1[13], pw3[0]=PKW(P1,8), pw3[1]=PKW(P1,10), pw3); \
    VRD(7); SBAR(); GAPA(C1=__builtin_amdgcn_mfma_f32_32x32x16_bf16(kf[7],qr[3],C1,0,0,0),   P1[14],P1[15],0.f,0.f,       pw3[2]=PKW(P1,12),pw3[3]=PKW(P1,14), pw3); \
    l_reg+=sacc; \
    if(GK){DMA_K((t)+3,sl_cur);} if(GV){DMA_V((t)+1,sl_next);} \
    CMASK(C0,C1,t); \
    { float a=MX3(C0[0],C0[1],C1[0]),b=MX3(C0[2],C0[3],C1[1]); a=MX3(a,C1[2],C1[3]); \
      _Pragma("unroll") for(int r=4;r<16;r+=4){a=MX3(a,C0[r],C0[r+1]);b=MX3(b,C0[r+2],C0[r+3]);a=MX3(a,C1[r],C1[r+1]);b=MX3(b,C1[r+2],C1[r+3]);} \
      float rm=__builtin_fmaxf(a,b); { auto rr=__builtin_amdgcn_permlane32_swap(__float_as_uint(rm),__float_as_uint(rm),false,false); rm=__builtin_fmaxf(__uint_as_float(rr[0]),__uint_as_float(rr[1])); } \
      resc=false; \
      if(__builtin_expect(__any(rm>(float)THRL),0)){ const float dl=__builtin_fmaxf(rm,0.f); mhat+=dl; \
        _Pragma("unroll") for(int r=0;r<16;++r){C0[r]-=dl;C1[r]-=dl;} \
        const float f=__builtin_amdgcn_exp2f(-dl); l_reg*=f; if(hi==0)wsf[r32]=f; resc=true; } } \
    SBAR(); \
    GAPB(o[0]=__builtin_amdgcn_mfma_f32_32x32x16_bf16(PAF(0),VFR(0),o[0],0,0,0), C0,0); \
    GAPB(o[1]=__builtin_amdgcn_mfma_f32_32x32x16_bf16(PAF(0),VFR(4),o[1],0,0,0), C0,4); \
    KRD(GL,0); GAPB(o[0]=__builtin_amdgcn_mfma_f32_32x32x16_bf16(PAF(1),VFR(1),o[0],0,0,0), C0,8); \
    KRD(GL,1); GAPB(o[1]=__builtin_amdgcn_mfma_f32_32x32x16_bf16(PAF(1),VFR(5),o[1],0,0,0), C0,12); \
    KRD(GL,2); GAPB(o[0]=__builtin_amdgcn_mfma_f32_32x32x16_bf16(PAF(2),VFR(2),o[0],0,0,0), C1,0); \
    KRD(GL,3); GAPB(o[1]=__builtin_amdgcn_mfma_f32_32x32x16_bf16(PAF(2),VFR(6),o[1],0,0,0), C1,4); \
    GAPB(o[0]=__builtin_amdgcn_mfma_f32_32x32x16_bf16(PAF(3),VFR(3),o[0],0,0,0), C1,8); \
    GAPB(o[1]=__builtin_amdgcn_mfma_f32_32x32x16_bf16(PAF(3),VFR(7),o[1],0,0,0), C1,12); \
    }while(0)
  int t=1;
  #undef CMASK
  #define CMASK(P0,P1,t) do{}while(0)
  for(;t+5<NT;t+=2){
    STEP(pB0,pB1,pA0,pA1,t,true,true,true);     WAIT_BAR(2); RESC(); ROT();
    STEP(pA0,pA1,pB0,pB1,t+1,true,true,true);   WAIT_BAR(2); RESC(); ROT();
  }
  #undef CMASK
  #define CMASK(P0,P1,t) do{int jb_=(t)-(NT-4); if(jb_>=0)cmask(P0,P1,jb_,qrel,hi);}while(0)
  #define ENDW(tt) do{ if((tt)+3<NT){WAIT_BAR(2);} else if((tt)+2<NT){WAIT_BAR(1);} else {WAIT_BAR(0);} }while(0)
  for(;t+1<NT;t+=2){
    STEP(pB0,pB1,pA0,pA1,t,(t+3<NT),(t+1<NT),(t+1<NT));       ENDW(t);   RESC(); ROT();
    STEP(pA0,pA1,pB0,pB1,t+1,(t+4<NT),(t+2<NT),(t+2<NT));     ENDW(t+1); RESC(); ROT();
  }
  STEP(pB0,pB1,pA0,pA1,NT-1,false,false,false); RESC();
  { float sacc=pB0[0]+pB0[1]; _Pragma("unroll") for(int r=2;r<16;++r)sacc+=pB0[r]; _Pragma("unroll") for(int r=0;r<16;++r)sacc+=pB1[r]; l_reg+=sacc;
    pw0=(u32x4){PKW(pB0,0),PKW(pB0,2),PKW(pB0,4),PKW(pB0,6)};pw1=(u32x4){PKW(pB0,8),PKW(pB0,10),PKW(pB0,12),PKW(pB0,14)};pw2=(u32x4){PKW(pB1,0),PKW(pB1,2),PKW(pB1,4),PKW(pB1,6)};pw3=(u32x4){PKW(pB1,8),PKW(pB1,10),PKW(pB1,12),PKW(pB1,14)};
    SBAR(); pv(o,vb0+sl_cur,PAF(0),PAF(1),PAF(2),PAF(3)); }
  #undef PKW
  #undef PAF
  #undef VFR
  #undef PIN
  #undef MX3
  #undef GAPA
  #undef GAPB
  #undef EX
  #undef VRD
  #undef KRD
  #undef STEP
  #undef ENDW
  {auto rr=__builtin_amdgcn_permlane32_swap(__float_as_uint(l_reg),__float_as_uint(l_reg),false,false);l_reg=__uint_as_float(rr[0])+__uint_as_float(rr[1]);}
  if(hi==0)wsf[32+r32]=l_reg;asm volatile("s_waitcnt lgkmcnt(0)":::"memory");
  float rli[16];
  #pragma unroll
  for(int r=0;r<16;++r)rli[r]=__builtin_amdgcn_rcpf(wsf[32+crow(r,hi)]);
  bf16*Ow=O+(rowbase+q0+wid*QBLK)*DM+h*D;
  { bf16*stg=(bf16*)(shm+LDS_OST)+wid*2048;
    #pragma unroll
    for(int r=0;r<16;++r){const int orow=crow(r,hi);
      #pragma unroll
      for(int d0=0;d0<2;++d0)stg[orow*64+d0*32+r32]=__float2bfloat16(o[d0][r]*rli[r]);}
    asm volatile("s_waitcnt lgkmcnt(0)":::"memory");
    #pragma unroll
    for(int i=0;i<4;++i){const int row=i*8+(lane>>3),ch=lane&7; const u32x4 v=*(const u32x4*)(stg+row*64+ch*8); ATTN_STORE16(Ow+(long)row*DM+ch*8,v);} }
  asm volatile("s_waitcnt lgkmcnt(0)\n\ts_barrier":::"memory");
  #undef DMA_K
  #undef DMA_V
  #undef INITC
  #undef CMASK
  #undef START
  #undef RESC
  #undef ROT
}
constexpr int ATTN_LDS_BYTES=LDS_BYTES;
struct AttnTensors { const bf16* Q; const bf16* K; const bf16* V; bf16* O; const float* F; const float* NRM; };
struct AttnUnit { int bh; int qb; };
struct StaticOrder {
  int vcu;
  __device__ __forceinline__ explicit StaticOrder(int grid,int block):vcu((block%8)*(grid/8)+block/8){}
  __device__ __forceinline__ bool next(int i,AttnUnit&u)const{ if(i>=4)return false; const int s=vcu&7; u.bh=vcu>>3; u.qb=(i==0)?s:(i==1)?15-s:(i==2)?16+s:31-s; return true; }
  __device__ __forceinline__ void a_ready(const AttnUnit&)const{}
  __device__ __forceinline__ void done(const AttnUnit&)const{}
};
template<int THRL=8> __device__ __forceinline__ void attn_phase(char*lds,const AttnTensors&T,unsigned*qctr,volatile __attribute__((address_space(3))) unsigned*qword,int wid_in){
  const int lane0=(int)__builtin_amdgcn_mbcnt_hi(~0u,__builtin_amdgcn_mbcnt_lo(~0u,0u));
  for(;;){
    if(wid_in==0&&lane0==0){ const unsigned n=__hip_atomic_fetch_add(qctr,1u,__ATOMIC_RELAXED,__HIP_MEMORY_SCOPE_AGENT); *qword=n; }
    asm volatile("s_waitcnt vmcnt(0) lgkmcnt(0)\n\ts_barrier":::"memory");
    const int n=__builtin_amdgcn_readfirstlane((int)*qword);
    if(n>=BATCH*NHEAD*NQB)break;
    const int bh=n%(BATCH*NHEAD),qb=NQB-1-n/(BATCH*NHEAD);
    attn_unit<THRL>(bh/NHEAD,bh%NHEAD,qb,T.Q,T.K,T.V,T.O,T.F,T.NRM,lds,wid_in);
  }
}
#undef SBAR
#undef WAIT_BAR
}
#define GAS __attribute__((address_space(1)))
#define LAS __attribute__((address_space(3)))
typedef unsigned short bf16;
typedef unsigned v4u __attribute__((ext_vector_type(4)));
typedef float f32x4 __attribute__((ext_vector_type(4)));
typedef short bf16x8 __attribute__((ext_vector_type(8)));
typedef GAS unsigned gu32;
typedef GAS unsigned long long gu64;
#define RLX_AGENT __ATOMIC_RELAXED, __HIP_MEMORY_SCOPE_AGENT
#define LDS_WAIT() asm volatile("s_waitcnt lgkmcnt(0)" ::: "memory")
#define VM_WAIT() asm volatile("s_waitcnt vmcnt(0)" ::: "memory")
__device__ __forceinline__ unsigned long long rt() { return __builtin_amdgcn_s_memrealtime(); }
__device__ __forceinline__ unsigned f2bf(float f) { unsigned u = __builtin_bit_cast(unsigned, f); return (u + 0x7fffu + ((u >> 16) & 1u)) >> 16; }
__device__ __forceinline__ unsigned pk2(float lo, float hi) { return f2bf(lo) | (f2bf(hi) << 16); }

#define XB_TMO      128
#define XB_XCNT(j)  (256  + 64 * (j))
#define XB_XSUB(j)  (1280 + 64 * (j))
#define XB_XGEN(j)  (2304 + 64 * (j))
#define XB_TOP      3328
#define XB_TOPGEN   3392
#define XCD_BAR_WORDS 3456
#define XB_SPIN_CAP (1u << 18)

__device__ __forceinline__ unsigned xb_ld(unsigned* p)              { return __hip_atomic_load(p, __ATOMIC_RELAXED, __HIP_MEMORY_SCOPE_AGENT); }
__device__ __forceinline__ unsigned xb_add(unsigned* p, unsigned v) { return __hip_atomic_fetch_add(p, v, __ATOMIC_RELAXED, __HIP_MEMORY_SCOPE_AGENT); }
__device__ __forceinline__ unsigned xb_xcc_id() { return (unsigned)__builtin_amdgcn_s_getreg((3 << 11) | 20) & 0xFu; }
#define XB_SPIN(cond, bar) do { unsigned _sp = 0; while (cond) { __builtin_amdgcn_s_sleep(1); \
    if ((++_sp & 255u) == 0u) { if (xb_ld(&(bar)[XB_TMO])) break; if (_sp > XB_SPIN_CAP) { atomicAdd(&(bar)[XB_TMO], 1u); break; } } } } while (0)

struct XcdBarrier {
    unsigned* bar; unsigned x; int wv;
    volatile LAS unsigned* st;
};

__device__ __forceinline__ bool xb_t0(int wv) { return wv == 0 && __builtin_amdgcn_mbcnt_hi(~0u, __builtin_amdgcn_mbcnt_lo(~0u, 0u)) == 0u; }
__device__ __forceinline__ XcdBarrier xcd_barrier_post(unsigned* bar, volatile LAS unsigned* st, int wv) {
    XcdBarrier b; b.bar = bar; b.x = xb_xcc_id(); b.st = st; b.wv = wv;
    if (xb_t0(wv)) (void)xb_add(&bar[XB_XCNT(b.x)], 1u);
    return b;
}
__device__ __forceinline__ void xcd_barrier_complete(unsigned* bar, unsigned x, unsigned& nloc, unsigned& nx) {
    const unsigned G = gridDim.x * gridDim.y * gridDim.z;
    unsigned sum, cnt, mine, sp = 0u;
    for (;;) {
        sum = 0u; cnt = 0u; mine = 0u;
#pragma unroll
        for (unsigned j = 0; j < 16; ++j) { const unsigned c = xb_ld(&bar[XB_XCNT(j)]); sum += c; cnt += (c > 0u) ? 1u : 0u; mine = (j == x) ? c : mine; }
        if (sum == G) break;
        __builtin_amdgcn_s_sleep(1);
        if ((++sp & 255u) == 0u) { if (xb_ld(&bar[XB_TMO])) break; if (sp > XB_SPIN_CAP) { atomicAdd(&bar[XB_TMO], 1u); break; } }
    }
    nloc = mine > 0u ? mine : 1u; nx = cnt > 0u ? cnt : 1u;
}

__device__ __forceinline__ void xcd_barrier(const XcdBarrier& b) {
    asm volatile("s_waitcnt vmcnt(0)" ::: "memory");
    __syncthreads();
    if (xb_t0(b.wv)) {
        unsigned* bar = b.bar;
        __builtin_amdgcn_s_waitcnt(0);
        unsigned nloc = b.st[0], nx = b.st[1];
        if (nloc == 0u) { xcd_barrier_complete(bar, b.x, nloc, nx); b.st[0] = nloc; b.st[1] = nx; }
        const unsigned old = xb_add(&bar[XB_XSUB(b.x)], 1u);
        const unsigned gen = old / nloc;
        if (old + 1u == (gen + 1u) * nloc) {
            __builtin_amdgcn_fence(__ATOMIC_RELEASE, "agent");
            asm volatile("s_waitcnt vmcnt(0)" ::: "memory");
            const unsigned og = xb_add(&bar[XB_TOP], 1u);
            const unsigned tg = og / nx;
            if (og + 1u == (tg + 1u) * nx) xb_add(&bar[XB_TOPGEN], 1u);
            else XB_SPIN(xb_ld(&bar[XB_TOPGEN]) == tg, bar);
            __builtin_amdgcn_fence(__ATOMIC_ACQUIRE, "agent");
            xb_add(&bar[XB_XGEN(b.x)], 1u);
            asm volatile("s_waitcnt vmcnt(0)" ::: "memory");
        } else {
            XB_SPIN(xb_ld(&bar[XB_XGEN(b.x)]) == gen, bar);
            __builtin_amdgcn_fence(__ATOMIC_ACQUIRE, "agent");
            asm volatile("s_waitcnt vmcnt(0)" ::: "memory");
        }
    }
    __syncthreads();
}

constexpr int NWAVES = 8;
constexpr int RING_OFF = 0, RING_BYTES = 131072;
constexpr int LDSCTL_OFF = RING_BYTES, MISC_OFF = LDSCTL_OFF + 320;
constexpr int LDS_BYTES = 147456;
constexpr int N_PHASES = 8;

struct Frame {
    LAS unsigned char* lds;
    volatile LAS unsigned* MISC;
    gu32* ctl;
    int tid, lane, wave, vcu, G;
};
__device__ __forceinline__ float wave_sum(float v) {
#pragma unroll
    for (int o = 1; o < 64; o <<= 1) v += __shfl_xor(v, o);
    return v;
}
struct Args { const float* in[20]; float* out; unsigned char* ws; int ph_lo, ph_hi, li, pad; };

__device__ __forceinline__ void p0_transpose_item(const float* W, int ld, int nblk, const float* glo, const float* ghi, int K, bf16* WT, int item, int lane) {
    const int kb = item / nblk, nb = item % nblk, k0 = 64 * kb + 16 * (lane >> 4), n0 = 64 * nb + 4 * (lane & 15);
    f32x4 w[16];
#pragma unroll
    for (int j = 0; j < 16; ++j) w[j] = *(const GAS f32x4*)(W + (size_t)(k0 + j) * ld + n0);
    if (glo) { const float* gp = (k0 < K / 2) ? glo + k0 : ghi + (k0 - K / 2);
#pragma unroll
        for (int q = 0; q < 4; ++q) { const f32x4 g4 = *(const GAS f32x4*)(gp + 4 * q);
#pragma unroll
            for (int e = 0; e < 4; ++e) w[4 * q + e] = w[4 * q + e] * g4[e]; } }
#pragma unroll
    for (int c = 0; c < 4; ++c) { v4u o0, o1;
        o0.x = pk2(w[0][c], w[1][c]); o0.y = pk2(w[2][c], w[3][c]); o0.z = pk2(w[4][c], w[5][c]); o0.w = pk2(w[6][c], w[7][c]);
        o1.x = pk2(w[8][c], w[9][c]); o1.y = pk2(w[10][c], w[11][c]); o1.z = pk2(w[12][c], w[13][c]); o1.w = pk2(w[14][c], w[15][c]);
        bf16* dp = WT + (size_t)(n0 + c) * K + k0; *(GAS v4u*)dp = o0; *(GAS v4u*)(dp + 8) = o1; }
}
__device__ __forceinline__ float log_sigmoid(float z) { return fminf(z, 0.f) - log1pf(expf(-fabsf(z))); }

__device__ __forceinline__ void p0_prologue(Frame& F, const Args& a) {
    unsigned char* ws = a.ws;
    const float* x = a.in[0]; const float* g1 = a.in[1]; const float* w_in = a.in[2]; const float* bfv = a.in[10];
    const float* gn_l = a.in[11]; const float* gn_f = a.in[12]; const float* w_out = a.in[13]; const float* g2 = a.in[14];
    const float* w_q = a.in[15]; const float* sk = a.in[16]; const float* pu = a.in[17]; const float* pv = a.in[18];
    bf16* win_t = (bf16*)(ws + WS_WIN); bf16* wout_t = (bf16*)(ws + WS_WOUT); bf16* wq_t = (bf16*)(ws + WS_WQ); bf16* skb = (bf16*)(ws + WS_SKB);
    float* logf = (float*)(ws + WS_LOGF); bf16* h = (bf16*)(ws + WS_H);
    const int gw = F.vcu * NWAVES + F.wave, NGW = F.G * NWAVES, lane = F.lane;
    constexpr int I_IN = (DMODEL / 64) * (NG1 / 64), I_OUT = (DMODEL / 64) * (DMODEL / 64), I_Q = (DMODEL / 64) * (QPW / 64);
    constexpr int I_SK = PH * 2 * NKEY * PHALF / 512, I_WAX = 8 * 2 * 2 * 4;
    constexpr int E0 = I_IN, E1 = E0 + I_OUT, E2 = E1 + I_Q, E3 = E2, E4 = E3 + I_SK, E5 = E4, E6 = E5 + I_WAX;
    for (int it = gw; it < E6; it += NGW) {
        if (it < E0) { p0_transpose_item(w_in, INC, NG1 / 64, nullptr, nullptr, DMODEL, win_t, it, lane); continue; }
        if (it < E1) { p0_transpose_item(w_out, DMODEL, DMODEL / 64, gn_l, gn_f, DMODEL, wout_t, it - E0, lane); continue; }
        if (it < E2) { p0_transpose_item(w_q, QPW, QPW / 64, g2, g2 + DMODEL / 2, DMODEL, wq_t, it - E1, lane); continue; }
        if (it < E4) { const size_t i = (size_t)(it - E3) * 512 + lane * 8; const f32x4 s0 = *(const GAS f32x4*)(sk + i), s1 = *(const GAS f32x4*)(sk + i + 4);
            v4u o; o.x = pk2(s0[0], s0[1]); o.y = pk2(s0[2], s0[3]); o.z = pk2(s1[0], s1[1]); o.w = pk2(s1[2], s1[3]);
            { const size_t hp = i >> 14; const int key = (int)(i >> 7) & 127, c8 = (int)(i >> 3) & 15; *(GAS v4u*)(skb + hp * 16384 + ((size_t)((((key >> 5) * 2 + (c8 & 1)) * 8 + (c8 >> 1)) * 32 + (key & 31))) * 8) = o; } continue; }
        { const int f = it - E5, ks = f & 3, n = (f >> 2) & 1, mat = (f >> 3) & 1, hh = f >> 4; const float* wsrc = mat ? a.in[7] : a.in[5];
          const size_t o = ((size_t)(hh * 64 + 16 * ks + 8 * (lane >> 5))) * 64 + 32 * n + (lane & 31);
          v4u pw; pw.x = pk2(wsrc[o], wsrc[o + 64]); pw.y = pk2(wsrc[o + 128], wsrc[o + 192]); pw.z = pk2(wsrc[o + 256], wsrc[o + 320]); pw.w = pk2(wsrc[o + 384], wsrc[o + 448]);
          *(GAS v4u*)((bf16*)(ws + WS_WAX) + (size_t)f * 512 + lane * 8) = pw; }
    }
    { f32x4 gg[4];
#pragma unroll
      for (int j = 0; j < 4; ++j) gg[j] = *(const GAS f32x4*)(g2 + 16 * lane + 4 * j);
      unsigned char* u4 = ws + WS_U8; unsigned char* v4 = ws + WS_V8; float* su = (float*)(ws + WS_SU);
      for (int e = gw; e < NEXP; e += NGW) {
        const GAS f32x4* ur = (const GAS f32x4*)(pu + (size_t)e * DMODEL + 16 * lane); const GAS f32x4* vr = (const GAS f32x4*)(pv + (size_t)e * DMODEL + 16 * lane);
        f32x4 uu[4], vv[4]; float mu = 0.f, mv = 0.f;
#pragma unroll
        for (int j = 0; j < 4; ++j) { uu[j] = ur[j] * gg[j]; vv[j] = vr[j];
#pragma unroll
            for (int c = 0; c < 4; ++c) { mu = fmaxf(mu, fabsf(uu[j][c])); mv = fmaxf(mv, fabsf(vv[j][c])); } }
#pragma unroll
        for (int o = 1; o < 64; o <<= 1) { mu = fmaxf(mu, __shfl_xor(mu, o)); mv = fmaxf(mv, __shfl_xor(mv, o)); }
        const float scu = mu > 0.f ? mu * (1.f / 6.f) : 1.f, scv = mv > 0.f ? mv * (1.f / 6.f) : 1.f, iu = 1.f / scu, iv = 1.f / scv;
        unsigned qu0 = 0u, qu1 = 0u, qv0 = 0u, qv1 = 0u;
#define P0_Q4(Q, X, INV, B0, B1) do { Q = __builtin_amdgcn_cvt_scalef32_pk_fp4_f32(Q, X[0] * INV, X[1] * INV, 1.0f, B0); Q = __builtin_amdgcn_cvt_scalef32_pk_fp4_f32(Q, X[2] * INV, X[3] * INV, 1.0f, B1); } while (0)
        P0_Q4(qu0, uu[0], iu, 0, 1); P0_Q4(qu0, uu[1], iu, 2, 3); P0_Q4(qu1, uu[2], iu, 0, 1); P0_Q4(qu1, uu[3], iu, 2, 3);
        P0_Q4(qv0, vv[0], iv, 0, 1); P0_Q4(qv0, vv[1], iv, 2, 3); P0_Q4(qv1, vv[2], iv, 0, 1); P0_Q4(qv1, vv[3], iv, 2, 3);
#undef P0_Q4
        *(GAS unsigned long long*)(u4 + (size_t)e * 512 + 8 * lane) = (unsigned long long)qu0 | ((unsigned long long)qu1 << 32);
        { unsigned char* vrow = v4 + (size_t)e * 512 + 2 * (lane >> 2);
          *(GAS unsigned short*)(vrow + 32 * (4 * (lane & 3) + 0)) = (unsigned short)(qv0 & 0xffffu); *(GAS unsigned short*)(vrow + 32 * (4 * (lane & 3) + 1)) = (unsigned short)(qv0 >> 16);
          *(GAS unsigned short*)(vrow + 32 * (4 * (lane & 3) + 2)) = (unsigned short)(qv1 & 0xffffu); *(GAS unsigned short*)(vrow + 32 * (4 * (lane & 3) + 3)) = (unsigned short)(qv1 >> 16); }
        if (lane == 0) { su[2 * e] = scu; su[2 * e + 1] = scv; }
      } }
    { f32x4 gg[4];
#pragma unroll
      for (int j = 0; j < 4; ++j) gg[j] = *(const GAS f32x4*)(g1 + 256 * j + 4 * lane);
      float fw[4][4][8];
#pragma unroll
      for (int j = 0; j < 4; ++j)
#pragma unroll
          for (int c = 0; c < 4; ++c) { const int k = 256 * j + 4 * lane + c; const GAS f32x4* wr = (const GAS f32x4*)(w_in + (size_t)k * INC + NG1); const f32x4 w0 = wr[0], w1 = wr[1];
#pragma unroll
              for (int e = 0; e < 4; ++e) { fw[j][c][e] = w0[e]; fw[j][c][4 + e] = w1[e]; } }
      for (int t0 = gw; t0 < T; t0 += 2 * NGW) {
        const int t1 = (t0 + NGW < T) ? t0 + NGW : t0;
        const GAS f32x4* xr0 = (const GAS f32x4*)(x + (size_t)t0 * DMODEL) + lane; const GAS f32x4* xr1 = (const GAS f32x4*)(x + (size_t)t1 * DMODEL) + lane;
        f32x4 va[4], vb[4]; float sa = 0.f, sb = 0.f;
#pragma unroll
        for (int j = 0; j < 4; ++j) { va[j] = xr0[64 * j]; vb[j] = xr1[64 * j]; }
#pragma unroll
        for (int j = 0; j < 4; ++j) { sa += (va[j][0] * va[j][0] + va[j][1] * va[j][1]) + (va[j][2] * va[j][2] + va[j][3] * va[j][3]); sb += (vb[j][0] * vb[j][0] + vb[j][1] * vb[j][1]) + (vb[j][2] * vb[j][2] + vb[j][3] * vb[j][3]); }
        const float ra = rsqrtf(wave_sum(sa) * (1.f / DMODEL) + RMS_EPS), rb = rsqrtf(wave_sum(sb) * (1.f / DMODEL) + RMS_EPS);
        GAS unsigned long long* ha = (GAS unsigned long long*)(h + (size_t)t0 * DMODEL) + lane; GAS unsigned long long* hb = (GAS unsigned long long*)(h + (size_t)t1 * DMODEL) + lane;
#pragma unroll
        for (int j = 0; j < 4; ++j) { va[j] = va[j] * ra * gg[j]; vb[j] = vb[j] * rb * gg[j];
            ha[64 * j] = (unsigned long long)pk2(va[j][0], va[j][1]) | ((unsigned long long)pk2(va[j][2], va[j][3]) << 32);
            hb[64 * j] = (unsigned long long)pk2(vb[j][0], vb[j][1]) | ((unsigned long long)pk2(vb[j][2], vb[j][3]) << 32); }
        float fa[8], fb[8];
#pragma unroll
        for (int hh = 0; hh < 8; ++hh) { fa[hh] = 0.f; fb[hh] = 0.f; }
#pragma unroll
        for (int j = 0; j < 4; ++j)
#pragma unroll
            for (int c = 0; c < 4; ++c) {
#pragma unroll
                for (int hh = 0; hh < 8; ++hh) { fa[hh] += va[j][c] * fw[j][c][hh]; fb[hh] += vb[j][c] * fw[j][c][hh]; } }
        const bool b0 = lane & 1, b1 = lane & 2, b2 = lane & 4;
        float ya[4], yb[4], za[2], zb[2];
#pragma unroll
        for (int j = 0; j < 4; ++j) { ya[j] = (b0 ? fa[j + 4] : fa[j]) + __shfl_xor(b0 ? fa[j] : fa[j + 4], 1); yb[j] = (b0 ? fb[j + 4] : fb[j]) + __shfl_xor(b0 ? fb[j] : fb[j + 4], 1); }
#pragma unroll
        for (int j = 0; j < 2; ++j) { za[j] = (b1 ? ya[j + 2] : ya[j]) + __shfl_xor(b1 ? ya[j] : ya[j + 2], 2); zb[j] = (b1 ? yb[j + 2] : yb[j]) + __shfl_xor(b1 ? yb[j] : yb[j + 2], 2); }
        float resa = (b2 ? za[1] : za[0]) + __shfl_xor(b2 ? za[0] : za[1], 4), resb = (b2 ? zb[1] : zb[0]) + __shfl_xor(b2 ? zb[0] : zb[1], 4);
#pragma unroll
        for (int o = 8; o < 64; o <<= 1) { resa += __shfl_xor(resa, o); resb += __shfl_xor(resb, o); }
        if (lane < 8) { const int hd = 4 * (lane & 1) + (lane & 2) + ((lane >> 2) & 1); logf[(size_t)t0 * 8 + hd] = log_sigmoid(resa + bfv[hd]); logf[(size_t)t1 * 8 + hd] = log_sigmoid(resb + bfv[hd]); }
      } }
}

__device__ __forceinline__ void fcum_unit(Frame& F, int bh, const float* logf, float* fcum) {
    const int b = bh / NHEADS, hh = bh % NHEADS, s0 = F.tid * 16;
    float v[16]; float loc = 0.f;
#pragma unroll
    for (int i = 0; i < 16; ++i) { v[i] = logf[((size_t)b * SEQ + s0 + i) * 8 + hh]; loc += v[i]; }
    float inc = loc;
#pragma unroll
    for (int o = 1; o < 64; o <<= 1) { const float n = __shfl_up(inc, o); if (F.lane >= o) inc += n; }
    if (F.lane == 63) F.MISC[16 + F.wave] = __float_as_uint(inc);
    __syncthreads();
    float run = inc - loc;
    for (int w = 0; w < F.wave; ++w) run += __uint_as_float(F.MISC[16 + w]);
#pragma unroll
    for (int i = 0; i < 16; ++i) { run += v[i]; fcum[(size_t)bh * SEQ + s0 + i] = run; }
    __syncthreads();
}


namespace peer {
typedef unsigned u32;
typedef float f32x16 __attribute__((ext_vector_type(16)));
constexpr int TOK = 128;
constexpr int EX_STRIDE = 136, GT_STRIDE = 136;
constexpr int L_EX = 0, L_GT = L_EX + TOK * EX_STRIDE * 2, L_IDX = L_GT + TOK * GT_STRIDE * 2, IDX_STRIDE = 36, L_RST = L_IDX + 512 * IDX_STRIDE, L_BI = L_RST + TOK * 4, BI_WAVE = 4352, L_END = L_BI + 8 * BI_WAVE;
static_assert(L_END <= RING_BYTES && L_GT % 16 == 0 && L_IDX % 16 == 0, "PEER LDS map");
__device__ __forceinline__ u32 ordmap(float f) { const u32 u = __float_as_uint(f); return u ^ ((u32)((int)u >> 31) | 0x80000000u); }
__device__ __forceinline__ float unordmap(u32 k) { const u32 u = (k & 0x80000000u) ? (k ^ 0x80000000u) : ~k; return __uint_as_float(u); }
__device__ __forceinline__ u32 umin_(u32 a, u32 b) { return a < b ? a : b; }
__device__ __forceinline__ u32 umax_(u32 a, u32 b) { return a > b ? a : b; }
template <bool DESC> __device__ __forceinline__ void sort16(u32 (&k)[16]) {
#define PEER_CE(I, J) do { const u32 a_ = k[I], b_ = k[J], lo_ = umin_(a_, b_), hi_ = umax_(a_, b_); k[I] = DESC ? hi_ : lo_; k[J] = DESC ? lo_ : hi_; } while (0)
    PEER_CE(0, 13); PEER_CE(1, 12); PEER_CE(2, 15); PEER_CE(3, 14); PEER_CE(4, 8); PEER_CE(5, 6); PEER_CE(7, 11); PEER_CE(9, 10);
    PEER_CE(0, 5); PEER_CE(1, 7); PEER_CE(2, 9); PEER_CE(3, 4); PEER_CE(6, 13); PEER_CE(8, 14); PEER_CE(10, 15); PEER_CE(11, 12);
    PEER_CE(0, 1); PEER_CE(2, 3); PEER_CE(4, 5); PEER_CE(6, 8); PEER_CE(7, 9); PEER_CE(10, 11); PEER_CE(12, 13); PEER_CE(14, 15);
    PEER_CE(0, 2); PEER_CE(1, 3); PEER_CE(4, 10); PEER_CE(5, 11); PEER_CE(6, 7); PEER_CE(8, 9); PEER_CE(12, 14); PEER_CE(13, 15);
    PEER_CE(1, 2); PEER_CE(3, 12); PEER_CE(4, 6); PEER_CE(5, 7); PEER_CE(8, 10); PEER_CE(9, 11); PEER_CE(13, 14);
    PEER_CE(1, 4); PEER_CE(2, 6); PEER_CE(5, 8); PEER_CE(7, 10); PEER_CE(9, 13); PEER_CE(11, 14);
    PEER_CE(2, 4); PEER_CE(3, 6); PEER_CE(9, 12); PEER_CE(11, 13);
    PEER_CE(3, 5); PEER_CE(6, 8); PEER_CE(7, 9); PEER_CE(10, 12);
    PEER_CE(3, 4); PEER_CE(5, 6); PEER_CE(7, 8); PEER_CE(9, 10); PEER_CE(11, 12);
    PEER_CE(6, 7); PEER_CE(8, 9);
#undef PEER_CE
}
template <bool DESC> __device__ __forceinline__ void merge16(u32 (&k)[16]) {
#pragma unroll
    for (int stride = 8; stride > 0; stride >>= 1)
#pragma unroll
        for (int i = 0; i < 16; ++i) { const int j = i ^ stride;
            if (j > i) { const u32 a = k[i], b = k[j], lo = umin_(a, b), hi = umax_(a, b); k[i] = DESC ? hi : lo; k[j] = DESC ? lo : hi; } }
}
__host__ __device__ constexpr int ccnt(int a) { return 16 / (a + 1); }
__host__ __device__ constexpr int cbase(int a) { int s = 0; for (int i = 0; i < a; ++i) s += ccnt(i); return s; }
static_assert(cbase(16) == 50, "hyperbola candidate count");
__device__ __forceinline__ int crow16(int r) { return (r & 3) + 8 * (r >> 2); }

__device__ __forceinline__ void route_tile(Frame& F, const bf16* qp, const bf16* skb, const float* sumsq, int t0) {
    int lane = F.lane; asm volatile("" : "+v"(lane));
    const int r32 = lane & 31, hi = lane >> 5, w = F.wave;
    LAS unsigned short* EXL = (LAS unsigned short*)(F.lds + RING_OFF + L_EX);
    LAS unsigned short* GTL = (LAS unsigned short*)(F.lds + RING_OFF + L_GT);
    LAS unsigned char* IDXB = F.lds + RING_OFF + L_IDX + (w * 64 + lane) * IDX_STRIDE;
    LAS float* RST = (LAS float*)(F.lds + RING_OFF + L_RST);
    for (int g = 0; g < 4; ++g) {
        const int tok = 32 * g + r32; const size_t trow = (size_t)(t0 + tok);
        const float rstd2 = rsqrtf(sumsq[trow] * (1.f / DMODEL) + RMS_EPS);
        if (w == 0 && hi == 0) RST[tok] = rstd2;
        u32 s0[16], s1[16];
#pragma unroll
        for (int p = 0; p < 2; ++p) {
            bf16x8 qf[8];
#pragma unroll
            for (int ks = 0; ks < 8; ++ks) qf[ks] = *(const GAS bf16x8*)(qp + ((size_t)((((trow >> 5) * 8 + w) * 2 + p) * 16 + 2 * ks + hi) * 32 + r32) * 8);
            u32 run[16];
#pragma unroll
            for (int nb = 0; nb < 4; ++nb) {
                f32x16 acc = {};
                const bf16* kr = skb + (size_t)(w * 2 + p) * 16384 + ((size_t)((nb * 2 + hi) * 8 * 32 + r32)) * 8;
#pragma unroll
                for (int ks = 0; ks < 8; ++ks) acc = __builtin_amdgcn_mfma_f32_32x32x16_bf16(*(const GAS bf16x8*)(kr + ks * 256), qf[ks], acc, 0, 0, 0);
                asm volatile("" ::: "memory");
                u32 blk[16];
#pragma unroll
                for (int r = 0; r < 16; ++r) blk[r] = (ordmap(acc[r]) & ~0x7Fu) | (u32)(127 - 32 * nb - crow16(r) - 4 * hi);
                if (nb == 0) { sort16<true>(blk);
#pragma unroll
                    for (int i = 0; i < 16; ++i) run[i] = blk[i]; }
                else { sort16<false>(blk);
#pragma unroll
                    for (int i = 0; i < 16; ++i) run[i] = umax_(run[i], blk[i]);
                    merge16<true>(run); }
            }
            u32 oth[16];
#pragma unroll
            for (int i = 0; i < 16; ++i) oth[i] = (u32)__shfl_xor((int)run[15 - i], 32);
#pragma unroll
            for (int i = 0; i < 16; ++i) run[i] = umax_(run[i], oth[i]);
            merge16<true>(run);
#pragma unroll
            for (int i = 0; i < 16; ++i) { if (p == 0) s0[i] = run[i]; else s1[i] = run[i]; }
        }
        { LAS u32* iw = (LAS u32*)IDXB;
#pragma unroll
          for (int j = 0; j < 4; ++j) {
              iw[j] = (127u - (s0[4 * j] & 127u)) | ((127u - (s0[4 * j + 1] & 127u)) << 8) | ((127u - (s0[4 * j + 2] & 127u)) << 16) | ((127u - (s0[4 * j + 3] & 127u)) << 24);
              iw[4 + j] = (127u - (s1[4 * j] & 127u)) | ((127u - (s1[4 * j + 1] & 127u)) << 8) | ((127u - (s1[4 * j + 2] & 127u)) << 16) | ((127u - (s1[4 * j + 3] & 127u)) << 24); } }
        float v1[16], v2[16];
#pragma unroll
        for (int i = 0; i < 16; ++i) { v1[i] = unordmap(s0[i] & ~0x7Fu); v2[i] = unordmap(s1[i] & ~0x7Fu); }
        u32 c0[16], c1[16], c2[16], c3[16];
#pragma unroll
        for (int a = 0; a < 16; ++a)
#pragma unroll
            for (int b = 0; b < ccnt(a); ++b) { const int pos = cbase(a) + b; const u32 key = (ordmap(v1[a] + v2[b]) & ~0xFFu) | (u32)(255 - (a * 16 + b));
                if (pos < 16) c0[pos] = key; else if (pos < 32) c1[pos - 16] = key; else if (pos < 48) c2[pos - 32] = key; else c3[pos - 48] = key; }
#pragma unroll
        for (int i = 2; i < 16; ++i) c3[i] = 0u;
        sort16<false>(c1);
#pragma unroll
        for (int i = 0; i < 16; ++i) c0[i] = umax_(c0[i], c1[i]);
        merge16<true>(c0);
        sort16<false>(c2);
#pragma unroll
        for (int i = 0; i < 16; ++i) c0[i] = umax_(c0[i], c2[i]);
        merge16<true>(c0);
        sort16<false>(c3);
#pragma unroll
        for (int i = 0; i < 16; ++i) c0[i] = umax_(c0[i], c3[i]);
        merge16<true>(c0);
        const float m = unordmap(c0[0] & ~0xFFu) * rstd2;
        float e[8]; float sum = 0.f; u32 ex[8];
#pragma unroll
        for (int k = 0; k < 8; ++k) { const u32 key = hi ? c0[k + 8] : c0[k]; const float ts = unordmap(key & ~0xFFu);
            e[k] = __builtin_amdgcn_exp2f((ts * rstd2 - m) * LOG2E); sum += e[k];
            const u32 flat = 255u - (key & 255u); ex[k] = (u32)IDXB[flat >> 4] * NKEY + (u32)IDXB[16 + (flat & 15u)]; }
        sum += __shfl_xor(sum, 32);
        const float inv = 1.f / sum;
        v4u exw; exw.x = ex[0] | (ex[1] << 16); exw.y = ex[2] | (ex[3] << 16); exw.z = ex[4] | (ex[5] << 16); exw.w = ex[6] | (ex[7] << 16);
        *(LAS v4u*)(EXL + tok * EX_STRIDE + w * 16 + hi * 8) = exw;
        *(LAS v4u*)(GTL + tok * GT_STRIDE + w * 16 + hi * 8) = (v4u){pk2(e[0] * inv, e[1] * inv), pk2(e[2] * inv, e[3] * inv), pk2(e[4] * inv, e[5] * inv), pk2(e[6] * inv, e[7] * inv)};
    }
}
__device__ __forceinline__ float gelu_fast(float x) {
    const float u2 = x * (1.5957691216057308f + 0.07135481627f * x * x);
    return x * __builtin_amdgcn_rcpf(1.f + __builtin_amdgcn_exp2f(-1.4426950408889634f * u2));
}
typedef float f32x2 __attribute__((ext_vector_type(2)));

__device__ __forceinline__ void sort128(u32 (&k)[8], int m) {
#pragma unroll
    for (int K = 2; K <= 128; K <<= 1) {
#pragma unroll
        for (int S = K >> 1; S > 0; S >>= 1) {
            if (S >= 8) {
                const int mm = S >> 3; const bool lower = (m & mm) == 0, up = (K == 128) ? true : ((m & (K >> 3)) == 0), keepmin = (lower == up);
#pragma unroll
                for (int r = 0; r < 8; ++r) { const u32 o = (u32)__shfl_xor((int)k[r], mm); const u32 mn = umin_(k[r], o), mx = umax_(k[r], o); k[r] = keepmin ? mn : mx; }
            } else {
#pragma unroll
                for (int r = 0; r < 8; ++r) { const int r2 = r ^ S;
                    if (r2 > r) { const u32 a = k[r], b = k[r2], mn = umin_(a, b), mx = umax_(a, b);
                        if (K < 8) { const bool up = (r & K) == 0; k[r] = up ? mn : mx; k[r2] = up ? mx : mn; }
                        else { const bool up = (K == 128) ? true : ((m & (K >> 3)) == 0); k[r] = up ? mn : mx; k[r2] = up ? mx : mn; } } }
            }
        }
    }
}
typedef int v8i __attribute__((ext_vector_type(8)));
typedef unsigned u2v __attribute__((ext_vector_type(2)));
__device__ __forceinline__ void eval_mf(Frame& F, const unsigned char* u4, const unsigned char* v4, const float* suv, const float* fg, const bf16* x1b, float* out, int t0) {
    int lane = F.lane; asm volatile("" : "+v"(lane));
    const int g = lane >> 4, m = lane & 15;
    LAS unsigned short* EXL = (LAS unsigned short*)(F.lds + RING_OFF + L_EX);
    LAS unsigned short* GTL = (LAS unsigned short*)(F.lds + RING_OFF + L_GT);
    LAS unsigned char* BI = F.lds + RING_OFF + L_BI + F.wave * BI_WAVE;
    const LAS float* RST = (const LAS float*)(F.lds + RING_OFF + L_RST);
    LAS u32* SKW = (LAS u32*)(F.lds + RING_OFF + L_IDX) + F.wave * 512;
    LAS u32* SK = SKW + g * 128;
    for (int pass = 0; pass < 4; ++pass) {
        const int tb4 = 32 * pass + 4 * F.wave, tok = tb4 + g;
        LAS unsigned short* exr = EXL + tok * EX_STRIDE; LAS unsigned short* gtr = GTL + tok * GT_STRIDE;
        { u32 k[8]; const v4u ev = *(const LAS v4u*)(exr + 8 * m); const u32 s0 = (u32)(8 * m);
          k[0] = ((ev.x & 0xffffu) << 7) | s0; k[1] = ((ev.x >> 16) << 7) | (s0 + 1); k[2] = ((ev.y & 0xffffu) << 7) | (s0 + 2); k[3] = ((ev.y >> 16) << 7) | (s0 + 3);
          k[4] = ((ev.z & 0xffffu) << 7) | (s0 + 4); k[5] = ((ev.z >> 16) << 7) | (s0 + 5); k[6] = ((ev.w & 0xffffu) << 7) | (s0 + 6); k[7] = ((ev.w >> 16) << 7) | (s0 + 7);
          sort128(k, m);
          u32 wv[8];
#pragma unroll
          for (int r = 0; r < 8; ++r) wv[r] = ((k[r] >> 7) << 16) | (u32)gtr[k[r] & 127u];
          *(LAS v4u*)(SK + m * 8) = (v4u){wv[0], wv[1], wv[2], wv[3]}; *(LAS v4u*)(SK + m * 8 + 4) = (v4u){wv[4], wv[5], wv[6], wv[7]};
          *(LAS v4u*)(exr + 8 * m) = (v4u){(k[0] >> 7) | ((k[1] >> 7) << 16), (k[2] >> 7) | ((k[3] >> 7) << 16), (k[4] >> 7) | ((k[5] >> 7) << 16), (k[6] >> 7) | ((k[7] >> 7) << 16)}; }
        asm volatile("" ::: "memory");
        {
#pragma unroll
            for (int tq = 0; tq < 4; ++tq) { const float rq = RST[tb4 + tq]; const bf16* xr = x1b + (size_t)(t0 + tb4 + tq) * DMODEL + 8 * lane;
#pragma unroll
                for (int c = 0; c < 2; ++c) { const v4u xa = *(const GAS v4u*)(xr + 512 * c); int w0 = 0, w1 = 0;
                    w0 = __builtin_amdgcn_cvt_pk_fp8_f32(__uint_as_float(xa.x << 16) * rq, __uint_as_float(xa.x & 0xffff0000u) * rq, w0, false); w0 = __builtin_amdgcn_cvt_pk_fp8_f32(__uint_as_float(xa.y << 16) * rq, __uint_as_float(xa.y & 0xffff0000u) * rq, w0, true);
                    w1 = __builtin_amdgcn_cvt_pk_fp8_f32(__uint_as_float(xa.z << 16) * rq, __uint_as_float(xa.z & 0xffff0000u) * rq, w1, false); w1 = __builtin_amdgcn_cvt_pk_fp8_f32(__uint_as_float(xa.w << 16) * rq, __uint_as_float(xa.w & 0xffff0000u) * rq, w1, true);
                    const int d = 512 * c + 8 * lane, st = d >> 7, dd = d & 127, hh = dd >> 6, e = dd & 63;
                    *(LAS u2v*)(BI + ((st * 4 + tq) * 4 + (e >> 4)) * 32 + hh * 16 + (e & 15)) = (u2v){(u32)w0, (u32)w1}; } }
        }
        asm volatile("" ::: "memory");
        v8i hb[8];
#pragma unroll
        for (int st = 0; st < 8; ++st) { v4u b0 = *(const LAS v4u*)(BI + ((st * 4 + (m & 3)) * 4 + g) * 32), b1 = *(const LAS v4u*)(BI + ((st * 4 + (m & 3)) * 4 + g) * 32 + 16);
            if (m >= 4) { b0 = (v4u){0u, 0u, 0u, 0u}; b1 = b0; }
            hb[st] = (v8i){(int)b0.x, (int)b0.y, (int)b0.z, (int)b0.w, (int)b1.x, (int)b1.y, (int)b1.z, (int)b1.w}; }
        asm volatile("" ::: "memory");
#define PEER_BAR() do { asm volatile("" ::: "memory"); __builtin_amdgcn_sched_barrier(0); } while (0)
#define PEER_LOADU(UA, KQ, SC, I) do { KQ = *(const LAS v4u*)(SK + (I)); _Pragma("unroll") for (int s4 = 0; s4 < 4; ++s4) { const u32 e_ = KQ[s4] >> 16; const u32 ro_ = e_ * 512u + 16u * (u32)m; \
            UA[s4][0] = *(const GAS v4u*)(u4 + ro_); UA[s4][1] = *(const GAS v4u*)(u4 + ro_ + 256); SC[s4] = *(const GAS f32x2*)(suv + 2 * e_); } } while (0)
#define PEER_TRANSP(UA) do { _Pragma("unroll") for (int hf = 0; hf < 2; ++hf) { \
                _Pragma("unroll") for (int s4 = 0; s4 < 4; ++s4) *(LAS v4u*)(BI + (4 * s4 + g) * 272 + 16 * m) = UA[s4][hf]; \
                asm volatile("" ::: "memory"); \
                _Pragma("unroll") for (int st = 0; st < 4; ++st) af[4 * hf + st] = *(const LAS v4u*)(BI + m * 272 + 64 * st + 16 * g); \
                asm volatile("" ::: "memory"); } } while (0)
#define PEER_DOTS(KQ, SC, I) do { f32x4 D = (f32x4){0.f, 0.f, 0.f, 0.f}; \
            _Pragma("unroll") for (int st = 0; st < 8; ++st) { const v8i a8 = (v8i){(int)af[st].x, (int)af[st].y, (int)af[st].z, (int)af[st].w, 0, 0, 0, 0}; \
                D = __builtin_amdgcn_mfma_scale_f32_16x16x128_f8f6f4(a8, hb[st], D, 4, 0, 0, 0x7f7f7f7f, 0, 0x7f7f7f7f); } \
            const int sel = lane & 3; const float mine = sel == 0 ? D[0] : sel == 1 ? D[1] : sel == 2 ? D[2] : D[3]; float act[4]; \
            _Pragma("unroll") for (int s4 = 0; s4 < 4; ++s4) { const float pre = __uint_as_float((unsigned)__builtin_amdgcn_ds_bpermute(4 * (g + 16 * s4), (int)__float_as_uint(mine))); \
                act[s4] = gelu_fast(pre * SC[s4][0]) * (__uint_as_float(KQ[s4] << 16) * SC[s4][1]); } \
            if (m == 0) *(LAS u2v*)(gtr + (I)) = (u2v){pk2(act[0], act[1]), pk2(act[2], act[3])}; } while (0)
        v4u kqA, kqB, uaA[4][2], uaB[4][2], af[8]; f32x2 scA[4], scB[4];
        PEER_LOADU(uaA, kqA, scA, 0);
        for (int i = 0; i < 128; i += 8) {
            PEER_TRANSP(uaA);
            PEER_LOADU(uaB, kqB, scB, i + 4);
            PEER_BAR();
            PEER_DOTS(kqA, scA, i);
            PEER_BAR();
            PEER_TRANSP(uaB);
            PEER_LOADU(uaA, kqA, scA, (i + 8 < 128) ? i + 8 : i + 4);
            PEER_BAR();
            PEER_DOTS(kqB, scB, i + 4);
            PEER_BAR();
        }
    }
    asm volatile("" ::: "memory");
    for (int pass = 0; pass < 4; ++pass) {
        const int tb4 = 32 * pass + 4 * F.wave, tok = tb4 + g;
        const LAS unsigned short* exr = EXL + tok * EX_STRIDE; const LAS unsigned short* acr = GTL + tok * GT_STRIDE;
        f32x2 y[32];
#pragma unroll
        for (int q = 0; q < 32; ++q) y[q] = (f32x2){0.f, 0.f};
        float* xrow = out + (size_t)(t0 + tok) * DMODEL + 4 * m; const bf16* xres = x1b + (size_t)(t0 + tok) * DMODEL + 4 * m;
#define PEER_LOADV(VB, I) do { const u2v e2_ = *(const LAS u2v*)(exr + (I)); _Pragma("unroll") for (int s4 = 0; s4 < 4; ++s4) { const u32 e_ = (s4 & 1) ? (e2_[s4 >> 1] >> 16) : (e2_[s4 >> 1] & 0xffffu); \
            const u32 ro_ = e_ * 512u + 32u * (u32)m; VB[s4][0] = *(const GAS v4u*)(v4 + ro_); VB[s4][1] = *(const GAS v4u*)(v4 + ro_ + 16); } } while (0)
#define PEER_FMAV(VB, I) do { const u2v a2_ = *(const LAS u2v*)(acr + (I)); _Pragma("unroll") for (int s4 = 0; s4 < 4; ++s4) { \
            const float act_ = (s4 & 1) ? __uint_as_float(a2_[s4 >> 1] & 0xffff0000u) : __uint_as_float(a2_[s4 >> 1] << 16); const f32x2 b2_ = (f32x2){act_, act_}; \
            _Pragma("unroll") for (int c = 0; c < 2; ++c) _Pragma("unroll") for (int d = 0; d < 4; ++d) { const unsigned w_ = VB[s4][c][d]; const int hq = 16 * c + 4 * d; \
                y[hq] = __builtin_elementwise_fma(__builtin_amdgcn_cvt_scalef32_pk_f32_fp4(w_, 1.0f, 0), b2_, y[hq]); y[hq + 1] = __builtin_elementwise_fma(__builtin_amdgcn_cvt_scalef32_pk_f32_fp4(w_, 1.0f, 1), b2_, y[hq + 1]); \
                y[hq + 2] = __builtin_elementwise_fma(__builtin_amdgcn_cvt_scalef32_pk_f32_fp4(w_, 1.0f, 2), b2_, y[hq + 2]); y[hq + 3] = __builtin_elementwise_fma(__builtin_amdgcn_cvt_scalef32_pk_f32_fp4(w_, 1.0f, 3), b2_, y[hq + 3]); } } } while (0)
        v4u vbA[4][2], vbB[4][2], vbC[4][2];
        PEER_LOADV(vbA, 0); PEER_LOADV(vbB, 4);
        PEER_BAR();
        for (int i = 0; i < 120; i += 12) {
            PEER_LOADV(vbC, i + 8);  PEER_BAR(); PEER_FMAV(vbA, i);     PEER_BAR();
            PEER_LOADV(vbA, i + 12); PEER_BAR(); PEER_FMAV(vbB, i + 4); PEER_BAR();
            PEER_LOADV(vbB, i + 16); PEER_BAR(); PEER_FMAV(vbC, i + 8); PEER_BAR();
        }
        PEER_FMAV(vbA, 120); PEER_FMAV(vbB, 124);
        float ss = 0.f;
#pragma unroll
        for (int q = 0; q < 16; ++q) { const u2v xa = *(const GAS u2v*)(xres + 64 * q); y[2 * q][0] += __uint_as_float(xa.x << 16); y[2 * q][1] += __uint_as_float(xa.x & 0xffff0000u); y[2 * q + 1][0] += __uint_as_float(xa.y << 16); y[2 * q + 1][1] += __uint_as_float(xa.y & 0xffff0000u);
            ss += (y[2 * q][0] * y[2 * q][0] + y[2 * q][1] * y[2 * q][1]) + (y[2 * q + 1][0] * y[2 * q + 1][0] + y[2 * q + 1][1] * y[2 * q + 1][1]); }
        ss += __shfl_xor(ss, 1); ss += __shfl_xor(ss, 2); ss += __shfl_xor(ss, 4); ss += __shfl_xor(ss, 8);
        const float rs = rsqrtf(ss * (1.f / DMODEL) + RMS_EPS);
        asm volatile("" ::: "memory");
#pragma unroll
        for (int q = 0; q < 16; ++q) { const f32x4 gq = *(const GAS f32x4*)(fg + 64 * q + 4 * m); f32x4 o; o[0] = y[2 * q][0] * rs * gq[0]; o[1] = y[2 * q][1] * rs * gq[1]; o[2] = y[2 * q + 1][0] * rs * gq[2]; o[3] = y[2 * q + 1][1] * rs * gq[3];
            *(GAS f32x4*)(xrow + 64 * q) = o; }
    }
}
__device__ __forceinline__ void peer_phase(Frame& F, const Args& a) {
    unsigned char* ws = a.ws;
    for (int tile = F.vcu; tile < T / TOK; tile += F.G) {
        route_tile(F, (const bf16*)(ws + WS_QP), (const bf16*)(ws + WS_SKB), (const float*)(ws + WS_SUMSQ), tile * TOK);
        __syncthreads();
        eval_mf(F, ws + WS_U8, ws + WS_V8, (const float*)(ws + WS_SU), a.in[19], (const bf16*)(ws + WS_X1B), a.out, tile * TOK);
        __syncthreads();
    }
}
}

namespace lru {
typedef float f32x16 __attribute__((ext_vector_type(16)));
constexpr int TOKT = 128, NTILE = SEQ / TOKT;
constexpr int WAVE_LDS = 14336, L_XS = 0, L_XC = 4608, L_GS = 9216, XC_STRIDE = 72  , L_SS = 8 * WAVE_LDS;
static_assert(L_SS + 32 * 8 * 4 <= RING_BYTES, "LRU LDS map");
__device__ __forceinline__ float bf2f(unsigned short h) { return __uint_as_float((unsigned)h << 16); }
__device__ __forceinline__ int crow16(int r) { return (r & 3) + 8 * (r >> 2); }
__device__ __forceinline__ float sigm(float x) { return __builtin_amdgcn_rcpf(1.f + __builtin_amdgcn_exp2f(-LOG2E * x)); }

template <bool FINAL> __device__ __forceinline__ void lru_tile(Frame& F, const Args& args, int tile) {
    int lane = F.lane; asm volatile("" : "+v"(lane));
    const int w = F.wave, j32 = lane & 31, hi = lane >> 5;
    unsigned char* ws = args.ws;
    const bf16* xr = (const bf16*)(ws + WS_XR); const bf16* gr = (const bf16*)(ws + WS_GR); float* carry = (float*)(ws + WS_CARRY);
    const float* cw = args.in[3]; const float* cb = args.in[4]; const float* ba = args.in[6]; const float* bx = args.in[8]; const float* lam = args.in[9];
    const int b = tile / NTILE, jt = tile % NTILE; const size_t trow0 = (size_t)b * SEQ + (size_t)jt * TOKT;
    LAS unsigned char* wl = F.lds + RING_OFF + w * WAVE_LDS;
    LAS unsigned short* XS = (LAS unsigned short*)(wl + L_XS); LAS unsigned short* XC = (LAS unsigned short*)(wl + L_XC); LAS unsigned short* GS = (LAS unsigned short*)(wl + L_GS);
    LAS float* SS = (LAS float*)(F.lds + RING_OFF + L_SS);
    float c_ba[2], c_bx[2], c_sp[2], c_cb[2], c_cw[2][4];
#pragma unroll
    for (int n = 0; n < 2; ++n) { const int c = 64 * w + 32 * n + j32; c_ba[n] = ba[c]; c_bx[n] = bx[c]; c_cb[n] = cb[c];
        const float l = lam[c]; c_sp[n] = 8.f * LOG2E * (fmaxf(-l, 0.f) + log1pf(expf(-fabsf(l))));
#pragma unroll
        for (int k = 0; k < 4; ++k) c_cw[n][k] = cw[k * LW + c]; }
    const bf16* wax = (const bf16*)(ws + WS_WAX);
    float hc[2] = {0.f, 0.f}, ap[2] = {1.f, 1.f};
    if (FINAL) { const float* cin = (const float*)(ws + WS_CIN) + (size_t)(b * NTILE + jt) * LW + 64 * w + j32; hc[0] = cin[0]; hc[1] = cin[32]; }
    v4u pfx[5], pfg[4], pce[2][2], pcu[2][2];
    unsigned char* cacheE = ws + WS_LA + ((size_t)(tile * 8 + w) * 4) * 4096; unsigned char* cacheU = ws + WS_LU + ((size_t)(tile * 8 + w) * 4) * 4096;
#define LRU_FETCH(B) do { const size_t tbn_ = trow0 + (B) * 32; \
        if (!FINAL) { _Pragma("unroll") for (int q_ = 0; q_ < 5; ++q_) { const int pc_ = lane + 64 * q_, row_ = pc_ >> 3, c8_ = pc_ & 7; \
            const bool z_ = (jt == 0 && (B) == 0 && row_ < 3) || pc_ >= 35 * 8; const v4u v_ = *(const GAS v4u*)(xr + (tbn_ + (z_ ? 3 : row_) - 3) * LW + w * 64 + c8_ * 8); pfx[q_] = z_ ? (v4u){0u, 0u, 0u, 0u} : v_; } } \
        if (FINAL) { _Pragma("unroll") for (int q_ = 0; q_ < 4; ++q_) { const int pc_ = lane + 64 * q_; pfg[q_] = *(const GAS v4u*)(gr + (tbn_ + (pc_ >> 3)) * LW + w * 64 + (pc_ & 7) * 8); } \
            _Pragma("unroll") for (int n_ = 0; n_ < 2; ++n_) _Pragma("unroll") for (int h_ = 0; h_ < 2; ++h_) { const size_t o_ = (size_t)(B) * 4096 + n_ * 2048 + h_ * 1024 + lane * 16; \
                pce[n_][h_] = *(const GAS v4u*)(cacheE + o_); pcu[n_][h_] = *(const GAS v4u*)(cacheU + o_); } } } while (0)
    LRU_FETCH(0);
    for (int blk = 0; blk < 4; ++blk) {
        const size_t tb = trow0 + blk * 32;
        int ln = lane; asm volatile("" : "+v"(ln));
        const int k32 = ln & 31;
        if (!FINAL) {
#pragma unroll
            for (int q = 0; q < 5; ++q) { const int pc = ln + 64 * q; if (pc < 35 * 8) *(LAS v4u*)((LAS unsigned char*)XS + (pc >> 3) * 128 + (pc & 7) * 16) = pfx[q]; } }
        v4u ce[2][2], cu[2][2];
        if (FINAL) {
#pragma unroll
            for (int n = 0; n < 2; ++n)
#pragma unroll
                for (int h = 0; h < 2; ++h) { ce[n][h] = pce[n][h]; cu[n][h] = pcu[n][h]; }
#pragma unroll
            for (int q = 0; q < 4; ++q) { const int pc = ln + 64 * q; *(LAS v4u*)((LAS unsigned char*)GS + (pc >> 3) * 128 + (pc & 7) * 16) = pfg[q]; } }
        if (blk < 3) { LRU_FETCH(blk + 1); }
        asm volatile("" ::: "memory");
        float xc[2][16];
        bf16x8 af[4];
        if (!FINAL) {
#pragma unroll
        for (int n = 0; n < 2; ++n)
#pragma unroll
            for (int g = 0; g < 4; ++g) { float xv[7];
#pragma unroll
                for (int q = 0; q < 7; ++q) xv[q] = bf2f(XS[(8 * g + 4 * hi + q) * 64 + 32 * n + j32]);
#pragma unroll
                for (int e = 0; e < 4; ++e) xc[n][4 * g + e] = c_cb[n] + ((c_cw[n][0] * xv[e] + c_cw[n][1] * xv[e + 1]) + (c_cw[n][2] * xv[e + 2] + c_cw[n][3] * xv[e + 3])); }
#pragma unroll
        for (int n = 0; n < 2; ++n)
#pragma unroll
            for (int r = 0; r < 16; ++r) XC[(crow16(r) + 4 * hi) * XC_STRIDE + 32 * n + j32] = (unsigned short)f2bf(xc[n][r]);
        asm volatile("" ::: "memory");
#pragma unroll
        for (int ks = 0; ks < 4; ++ks) af[ks] = *(const LAS bf16x8*)(XC + j32 * XC_STRIDE + 16 * ks + 8 * hi);
        asm volatile("" ::: "memory");
        }
        float yv[2][16];
#pragma unroll
        for (int n = 0; n < 2; ++n) {
            float av[16], uv[16];
            if (!FINAL) {
            f32x16 R = {}, I = {};
            bf16x8 fa[4], fx[4];
#pragma unroll
            for (int ks = 0; ks < 4; ++ks) { fa[ks] = *(const GAS bf16x8*)(wax + (size_t)(((w * 2 + 0) * 2 + n) * 4 + ks) * 512 + ln * 8); fx[ks] = *(const GAS bf16x8*)(wax + (size_t)(((w * 2 + 1) * 2 + n) * 4 + ks) * 512 + ln * 8); }
#pragma unroll
            for (int ks = 0; ks < 4; ++ks) { R = __builtin_amdgcn_mfma_f32_32x32x16_bf16(af[ks], fa[ks], R, 0, 0, 0); I = __builtin_amdgcn_mfma_f32_32x32x16_bf16(af[ks], fx[ks], I, 0, 0, 0); }
            unsigned we[8], wu[8];
#pragma unroll
            for (int k = 0; k < 8; ++k) { const float e0 = sigm(R[2 * k] + c_ba[n]) * c_sp[n], e1 = sigm(R[2 * k + 1] + c_ba[n]) * c_sp[n]; we[k] = pg8::cvt_pk_bf16(e0, e1);
                const float a0 = __builtin_amdgcn_exp2f(-__uint_as_float(we[k] << 16)), a1 = __builtin_amdgcn_exp2f(-__uint_as_float(we[k] & 0xffff0000u));
                const float u0 = __builtin_amdgcn_sqrtf(fmaxf(1.f - a0 * a0, 0.f)) * (sigm(I[2 * k] + c_bx[n]) * xc[n][2 * k]), u1 = __builtin_amdgcn_sqrtf(fmaxf(1.f - a1 * a1, 0.f)) * (sigm(I[2 * k + 1] + c_bx[n]) * xc[n][2 * k + 1]);
                wu[k] = pg8::cvt_pk_bf16(u0, u1);
                av[2 * k] = a0; av[2 * k + 1] = a1; uv[2 * k] = __uint_as_float(wu[k] << 16); uv[2 * k + 1] = __uint_as_float(wu[k] & 0xffff0000u); }
            { const size_t o = (size_t)blk * 4096 + n * 2048 + ln * 16;
              *(GAS v4u*)(cacheE + o) = (v4u){we[0], we[1], we[2], we[3]}; *(GAS v4u*)(cacheE + o + 1024) = (v4u){we[4], we[5], we[6], we[7]};
              *(GAS v4u*)(cacheU + o) = (v4u){wu[0], wu[1], wu[2], wu[3]}; *(GAS v4u*)(cacheU + o + 1024) = (v4u){wu[4], wu[5], wu[6], wu[7]}; }
            } else {
#pragma unroll
                for (int k = 0; k < 8; ++k) { const unsigned e2 = ce[n][k >> 2][k & 3], u2 = cu[n][k >> 2][k & 3];
                    av[2 * k] = __builtin_amdgcn_exp2f(-__uint_as_float(e2 << 16)); av[2 * k + 1] = __builtin_amdgcn_exp2f(-__uint_as_float(e2 & 0xffff0000u));
                    uv[2 * k] = __uint_as_float(u2 << 16); uv[2 * k + 1] = __uint_as_float(u2 & 0xffff0000u); }
            }
            float Ar[4], Hr[4], hst[4];
#pragma unroll
            for (int g = 0; g < 4; ++g) { Ar[g] = (av[4 * g] * av[4 * g + 1]) * (av[4 * g + 2] * av[4 * g + 3]);
                Hr[g] = ((uv[4 * g] * av[4 * g + 1] + uv[4 * g + 1]) * av[4 * g + 2] + uv[4 * g + 2]) * av[4 * g + 3] + uv[4 * g + 3]; }
            float hin = hc[n];
#pragma unroll
            for (int g = 0; g < 4; ++g) { float o1 = Ar[g] * hin + Hr[g]; const float x = __shfl_xor(o1, 32); const float hg = hi ? x : hin; o1 = Ar[g] * hg + Hr[g]; hst[g] = hg;
                const float y = __shfl_xor(o1, 32); hin = hi ? o1 : y;
                if (!FINAL) ap[n] *= Ar[g] * __shfl_xor(Ar[g], 32); }
            hc[n] = hin;
            if (FINAL) {
#pragma unroll
                for (int g = 0; g < 4; ++g) { float h = hst[g];
#pragma unroll
                    for (int e = 0; e < 4; ++e) { const int r = 4 * g + e; h = av[r] * h + uv[r]; yv[n][r] = h * bf2f(GS[(crow16(r) + 4 * hi) * 64 + 32 * n + j32]); } } }
        }
        if (FINAL) {
#pragma unroll
            for (int r = 0; r < 16; ++r) { float s = yv[0][r] * yv[0][r] + yv[1][r] * yv[1][r];
                s += __shfl_xor(s, 1); s += __shfl_xor(s, 2); s += __shfl_xor(s, 4); s += __shfl_xor(s, 8); s += __shfl_xor(s, 16);
                if (j32 == 0) SS[(crow16(r) + 4 * hi) * 8 + w] = s; }
            __syncthreads();
            bf16* ymix = (bf16*)(ws + WS_H);
#pragma unroll
            for (int r = 0; r < 16; ++r) { const int tk = crow16(r) + 4 * hi; const f32x4 s0 = *(const LAS f32x4*)(SS + tk * 8), s1 = *(const LAS f32x4*)(SS + tk * 8 + 4);
                const float rstd = rsqrtf(((s0[0] + s0[1]) + (s0[2] + s0[3]) + (s1[0] + s1[1]) + (s1[2] + s1[3])) * (1.f / LW) + RMS_EPS);
                bf16* yp = ymix + (tb + tk) * DMODEL + 64 * w + k32;
                yp[0] = (bf16)f2bf(yv[0][r] * rstd); yp[32] = (bf16)f2bf(yv[1][r] * rstd); }
            __syncthreads();
        }
    }
#undef LRU_FETCH
    if (!FINAL) { if (hi == 0) { float* cp = carry + ((size_t)(b * NTILE + jt) * 2) * LW + 64 * w + j32;
#pragma unroll
        for (int n = 0; n < 2; ++n) { cp[32 * n] = ap[n]; cp[LW + 32 * n] = hc[n]; } } }
    else {
        const bf16* ob = (const bf16*)(ws + WS_O); bf16* ymix = (bf16*)(ws + WS_H);
        for (int i0 = 0; i0 < 16; i0 += 4) {
            v4u vv[4];
#pragma unroll
            for (int i = 0; i < 4; ++i) vv[i] = *(const GAS v4u*)(ob + (trow0 + 16 * w + i0 + i) * AW + 8 * lane);
            float ssq[4];
#pragma unroll
            for (int i = 0; i < 4; ++i) { float s = 0.f;
#pragma unroll
                for (int c = 0; c < 4; ++c) { const float lo = __uint_as_float(vv[i][c] << 16), hi2 = __uint_as_float(vv[i][c] & 0xffff0000u); s += lo * lo + hi2 * hi2; }
                ssq[i] = s; }
#pragma unroll
            for (int o = 1; o < 64; o <<= 1) {
#pragma unroll
                for (int i = 0; i < 4; ++i) ssq[i] += __shfl_xor(ssq[i], o); }
#pragma unroll
            for (int i = 0; i < 4; ++i) { const float rstd = rsqrtf(ssq[i] * (1.f / AW) + RMS_EPS); v4u o;
#pragma unroll
                for (int c = 0; c < 4; ++c) o[c] = pk2(__uint_as_float(vv[i][c] << 16) * rstd, __uint_as_float(vv[i][c] & 0xffff0000u) * rstd);
                *(GAS v4u*)(ymix + (trow0 + 16 * w + i0 + i) * DMODEL + LW + 8 * lane) = o; } }
    }
}
__device__ __forceinline__ void norm_pass(Frame& F, const Args& a) {
    unsigned char* ws = a.ws; float* nrm = (float*)(ws + WS_NRM); const float* rn2 = (const float*)(ws + WS_RN2);
    const int gw = F.vcu * NWAVES + F.wave, NGW = F.G * NWAVES, lane = F.lane;
    for (int it = gw; it < 2 * BATCH * (SEQ / 64); it += NGW) {
        const int which = it / (BATCH * (SEQ / 64)), r = it % (BATCH * (SEQ / 64)), b = r / (SEQ / 64), t = r % (SEQ / 64);
        const float* src = rn2 + ((size_t)which * (T / 16) + (size_t)(b * SEQ + 64 * t) / 16) * 256 + lane;
        float v[16];
#pragma unroll
        for (int i = 0; i < 16; ++i) v[i] = src[64 * i];
        float mx[4] = {0.f, 0.f, 0.f, 0.f};
#pragma unroll
        for (int i = 0; i < 16; ++i) mx[i & 3] = fmaxf(mx[i & 3], v[i] + __shfl_xor(v[i], 16));
#pragma unroll
        for (int o = 1; o < 16; o <<= 1) {
#pragma unroll
            for (int j = 0; j < 4; ++j) mx[j] = fmaxf(mx[j], __shfl_xor(mx[j], o)); }
        if ((lane & 31) == 0) {
#pragma unroll
            for (int j = 0; j < 4; ++j) nrm[which * 4096 + (b * NHEADS + (lane >> 5) + 2 * j) * 128 + t] = sqrtf(mx[j]) * 1.0001f; }
    }
}
__device__ __forceinline__ void carry_prefix(Frame& F, const Args& a, int b) {
    const float* carry = (const float*)(a.ws + WS_CARRY) + (size_t)b * NTILE * 2 * LW + F.tid; float* cin = (float*)(a.ws + WS_CIN) + (size_t)b * NTILE * LW + F.tid;
    float c = 0.f;
    for (int j0 = 0; j0 < NTILE; j0 += 8) { float A[8], H[8];
#pragma unroll
        for (int j = 0; j < 8; ++j) { A[j] = carry[(size_t)(j0 + j) * 2 * LW]; H[j] = carry[(size_t)(j0 + j) * 2 * LW + LW]; }
#pragma unroll
        for (int j = 0; j < 8; ++j) { cin[(size_t)(j0 + j) * LW] = c; c = A[j] * c + H[j]; } }
}
template <bool FINAL> __device__ __forceinline__ void lru_phase(Frame& F, const Args& a) {
    for (int tile = F.vcu; tile < BATCH * NTILE; tile += F.G) { lru_tile<FINAL>(F, a, tile); __syncthreads(); }
}
}
__global__ void __launch_bounds__(NWAVES * 64, 2) mk_fwd(Args args) {
    extern __shared__ __attribute__((aligned(16))) unsigned char lds[];
    Frame F;
    F.lds = (LAS unsigned char*)lds;
    F.MISC = (volatile LAS unsigned*)(F.lds + MISC_OFF);
    F.wave = __builtin_amdgcn_readfirstlane((int)threadIdx.x >> 6); F.lane = (int)__builtin_amdgcn_mbcnt_hi(~0u, __builtin_amdgcn_mbcnt_lo(~0u, 0u)); F.tid = F.wave * 64 + F.lane;
    F.G = gridDim.x; { const int bx = blockIdx.x; F.vcu = (F.G % 8 == 0) ? (bx % 8) * (F.G / 8) + bx / 8 : bx; }
    unsigned char* ws = args.ws;
    F.ctl = (gu32*)(ws + WS_CTL);
    for (int u = F.tid; u < (LDS_BYTES - LDSCTL_OFF) / 4; u += NWAVES * 64) ((LAS unsigned*)(F.lds + LDSCTL_OFF))[u] = 0u;
    __syncthreads();
    XcdBarrier bar = xcd_barrier_post((unsigned*)(F.ctl + CW_BAR) + args.li * XCD_BAR_WORDS, F.MISC + 8, F.wave);
    const int lo = args.ph_lo, hi = args.ph_hi;
#define IN(k) (lo <= (k) && (k) < hi)
#define BOTH(k) (IN(k) && IN((k) + 1))
#define GRID_BAR() xcd_barrier(bar)

    if (IN(0)) { p0_prologue(F, args); if (BOTH(0)) GRID_BAR(); }

    if (IN(1)) {
        if (F.vcu < BATCH * NHEADS) fcum_unit(F, F.vcu, (const float*)(ws + WS_LOGF), (float*)(ws + WS_FCUM));
        pg8::Gemm g{(const pg8::bf16_t*)(ws + WS_H), (const pg8::bf16_t*)(ws + WS_WIN), T, NG1, DMODEL}; pg8::StaticOrder S; S.init(T, NG1, F.G, (int)blockIdx.x);
        pg8::EpiG1 E{(pg8::bf16_t*)(ws + WS_XR), SPLIT_STRIDE, QSCALE, (float*)(ws + WS_RN2)};
        pg8::gemm_phase<pg8::EpiG1, pg8::StaticOrder, true, true>(F.lds + RING_OFF, g, S, E, F.wave);
        if (BOTH(1)) GRID_BAR();
    }
    if (IN(2)) { lru::lru_phase<false>(F, args); lru::norm_pass(F, args); if (BOTH(2)) GRID_BAR(); }
    if (IN(3)) {
        static_assert(attn_body::ATTN_LDS_BYTES <= RING_BYTES, "attention LDS vs frame");
        if (F.vcu < BATCH) lru::carry_prefix(F, args, F.vcu);
        const attn_body::AttnTensors AT{(const attn_body::bf16*)(ws + WS_Q), (const attn_body::bf16*)(ws + WS_K), (const attn_body::bf16*)(ws + WS_V), (attn_body::bf16*)(ws + WS_O), (const float*)(ws + WS_FCUM), (const float*)(ws + WS_NRM)};
        attn_body::attn_phase<8>((char*)lds + RING_OFF, AT, (unsigned*)(F.ctl + CW_ATTQ), F.MISC + 24, F.wave);
        if (BOTH(3)) GRID_BAR();
    }
    if (IN(4)) { lru::lru_phase<true>(F, args); if (BOTH(4)) GRID_BAR(); }
    if (IN(5)) {
        pg8::Gemm g{(const pg8::bf16_t*)(ws + WS_H), (const pg8::bf16_t*)(ws + WS_WOUT), T, DMODEL, DMODEL}; pg8::StaticOrder S; S.init(T, DMODEL, F.G, (int)blockIdx.x);
        pg8::EpiG2 E{args.in[0], (pg8::bf16_t*)(ws + WS_X1B), (float*)(ws + WS_SUMSQ), DMODEL};
        pg8::gemm_phase<pg8::EpiG2, pg8::StaticOrder, true, true>(F.lds + RING_OFF, g, S, E, F.wave);
        if (BOTH(5)) GRID_BAR();
    }
    if (IN(6)) {
        pg8::Gemm g{(const pg8::bf16_t*)(ws + WS_X1B), (const pg8::bf16_t*)(ws + WS_WQ), T, QPW, DMODEL}; pg8::StaticOrder S; S.init(T, QPW, F.G, (int)blockIdx.x);
        pg8::EpiG3 E{(pg8::bf16_t*)(ws + WS_QP), QPW};
        pg8::gemm_phase<pg8::EpiG3, pg8::StaticOrder, true, true>(F.lds + RING_OFF, g, S, E, F.wave);
        if (BOTH(6)) GRID_BAR();
    }
    if (IN(7)) { peer::peer_phase(F, args); }
#undef IN
#undef BOTH
#undef GRID_BAR
}

extern "C" void kernel_launch(void* const* d_in, const int* in_sizes, int n_in, void* d_out, int out_size, void* d_ws, size_t ws_size, hipStream_t stream) {
    static int grid = 0;
    if (grid == 0) {
        if (n_in != 20 || in_sizes[0] != T * DMODEL || out_size != T * DMODEL || ws_size < WS_END) { fprintf(stderr, "kernel_launch: unexpected shapes (n_in %d, ws %zu)\n", n_in, ws_size); grid = -1; return; }
        int dev = 0, cus = 0;
        if (hipGetDevice(&dev) != hipSuccess || hipDeviceGetAttribute(&cus, hipDeviceAttributeMultiprocessorCount, dev) != hipSuccess) { grid = -1; return; }
        if (hipFuncSetAttribute((const void*)mk_fwd, hipFuncAttributeMaxDynamicSharedMemorySize, LDS_BYTES) != hipSuccess) { fprintf(stderr, "kernel_launch: hipFuncSetAttribute failed\n"); grid = -1; return; }
        (void)hipGetLastError();
        grid = cus;
    }
    if (grid < 0) return;
    if (hipMemsetAsync((char*)d_ws + WS_CTL, 0, CTL_ZERO_BYTES, stream) != hipSuccess) return;
    Args a{};
    for (int i = 0; i < 20; ++i) a.in[i] = (const float*)d_in[i];
    a.out = (float*)d_out; a.ws = (unsigned char*)d_ws; a.ph_lo = 0; a.ph_hi = N_PHASES; a.li = 0;
    hipLaunchKernelGGL(mk_fwd, dim3(grid), dim3(NWAVES * 64), LDS_BYTES, stream, a);
}
```

```cpp
#include <hip/hip_runtime.h>
#include <hip/hip_bf16.h>
#include <cstdio>
#include <cstdint>
#include <cmath>

constexpr int BATCH = 4, SEQ = 8192, DMODEL = 1024, T = BATCH * SEQ;
constexpr int LW = 512, AW = 512, NHEADS = 8, HD = 64, INC = 2568, NG1 = 2560;
constexpr int PH = 8, NKEY = 128, PHALF = 128, TOPK = 16, NEXP = NKEY * NKEY, QPW = 2048;
constexpr float RMS_EPS = 1e-6f;
constexpr float LOG2E = 1.4426950408889634f;
constexpr float QSCALE = 0.125f * LOG2E;
constexpr size_t MiB = 1u << 20;
constexpr size_t WS_CTL = 0, CTL_ZERO_BYTES = 1 * MiB, WS_RN2 = 24 * MiB  ;
constexpr size_t WS_WIN = 2 * MiB, WS_WOUT = 8 * MiB, WS_WQ = 10 * MiB, WS_SKB = 14 * MiB, WS_WFL = 15 * MiB,
                 WS_LOGF = 16 * MiB, WS_FCUM = 17 * MiB, WS_CARRY = 18 * MiB, WS_SUMSQ = 512 * 1024  , WS_WAX = 20 * MiB, WS_CIN = 23 * MiB  , WS_NRM = 22 * MiB  ,
                 WS_H = 32 * MiB, WS_XR = 96 * MiB, WS_GR = 128 * MiB, WS_Q = 160 * MiB, WS_K = 192 * MiB, WS_V = 224 * MiB,
                 WS_X1B = 256 * MiB, WS_O = 256 * MiB  , WS_QP = 96 * MiB, WS_UT = 320 * MiB, WS_VT = 352 * MiB, WS_U8 = 320 * MiB, WS_V8 = 336 * MiB, WS_SU = 21 * MiB, WS_SV = 21 * MiB + 65536, WS_LA = 384 * MiB, WS_LU = 448 * MiB, WS_END = 512 * MiB;
constexpr size_t SPLIT_STRIDE = (WS_GR - WS_XR) / 2;
constexpr int CW_TMO = 0, CW_ATTQ = 2048, CW_BAR = 4096;

namespace pg8 {
constexpr int BATCH_T = 4 * 8192;
#define PG8_LAS __attribute__((address_space(3)))
typedef unsigned short bf16_t;
typedef short bf16x8 __attribute__((ext_vector_type(8)));
typedef float f32x4 __attribute__((ext_vector_type(4)));
typedef unsigned u32x4 __attribute__((ext_vector_type(4)));
constexpr int BM = 256, BK = 64, HALF = 128, HTB = HALF * BK * 2  , STAGE_BYTES = 8 * HTB, NXCD = 8, WGM = 8;

__host__ __device__ __forceinline__ int lds_byte(int r, int c) { const int st = (r >> 4) * 2 + (c >> 5), rr = r & 15, cc = c & 31, ob = rr * 64 + cc * 2; return st * 1024 + (ob ^ (((ob >> 9) & 1) << 5)); }
__host__ __device__ __forceinline__ void stage_rc(int b, int& R, int& C) { const int st = b / 1024, sb = b % 1024, swz = sb ^ (((sb >> 9) & 1) << 5); R = (st >> 1) * 16 + swz / 64; C = (st & 1) * 32 + (swz % 64) / 2; }
__host__ __device__ __forceinline__ int perm32(int rho) { const int n = rho >> 4, i = rho & 15; return 8 * (i >> 2) + 4 * n + (i & 3); }

struct Unit { int pm, pn; };
struct Gemm { const bf16_t* A; const bf16_t* Bt; int M, N, K; };

struct StaticOrder {
    int nM, nN, nwg, G, c, wgm;
    __host__ __device__ void init(int M, int N, int G_, int c_, int wgm_ = WGM) { nM = M / BM; nN = N / BM; nwg = nM * nN; G = G_; c = c_; wgm = wgm_; }
    __host__ __device__ bool next(int i, Unit& u) const {
        const long L = (long)i * G + c; if (L >= nwg) return false;
        int wgid = (int)L; { const int q = nwg / NXCD, r = nwg % NXCD, xcd = wgid % NXCD, off = wgid / NXCD; wgid = (xcd < r ? xcd * (q + 1) : r * (q + 1) + (xcd - r) * q) + off; }
        const int nig = wgm * nN, gid = wgid / nig, fm = gid * wgm, gsz = (nM - fm) < wgm ? (nM - fm) : wgm;
        u.pm = fm + ((wgid % nig) % gsz); u.pn = (wgid % nig) / gsz; return true;
    }
    __device__ __forceinline__ void a_ready(const Unit&) const {}
    __device__ __forceinline__ void done(const Unit&) const {}
};

__device__ __forceinline__ unsigned cvt_pk_bf16(float lo, float hi) { unsigned r; asm volatile("v_cvt_pk_bf16_f32 %0, %1, %2" : "=v"(r) : "v"(lo), "v"(hi)); return r; }
typedef unsigned u32x2 __attribute__((ext_vector_type(2)));
__device__ __forceinline__ float gelu_fast(float x) {
    const float u2 = x * (1.5957691216057308f + 0.07135481627f * x * x);
    return x * __builtin_amdgcn_rcpf(1.f + __builtin_amdgcn_exp2f(-1.4426950408889634f * u2));
}
struct EpiG1 {
    static constexpr bool PERM = true, AFTER_DRAIN = false;
    bf16_t* base0; size_t split_stride; float qscale; float* rn2;
    __device__ __forceinline__ void operator()(const f32x4 (&acc)[2][2][4][2], const Unit& u, int wr, int wc, int fr, int fq) const {
        const int s = u.pn >> 1; bf16_t* base = base0 + (size_t)s * split_stride;
        const int row0 = u.pm * BM + wr * 64 + fr, col0 = (u.pn & 1) * 256 + wc * 32 + 8 * fq;
#pragma unroll
        for (int ai = 0; ai < 2; ++ai)
#pragma unroll
            for (int m = 0; m < 4; ++m) { bf16_t* rowp = base + (size_t)(row0 + ai * HALF + m * 16) * 512 + col0;
#pragma unroll
                for (int bj = 0; bj < 2; ++bj) { f32x4 v0 = acc[ai][bj][m][0], v1 = acc[ai][bj][m][1];
                    if (s == 1) {
#pragma unroll
                        for (int e = 0; e < 4; ++e) { v0[e] = gelu_fast(v0[e]); v1[e] = gelu_fast(v1[e]); } }
                    else if (s == 2) { v0 = v0 * qscale; v1 = v1 * qscale; }
                    u32x4 w; w.x = cvt_pk_bf16(v0[0], v0[1]); w.y = cvt_pk_bf16(v0[2], v0[3]); w.z = cvt_pk_bf16(v1[0], v1[1]); w.w = cvt_pk_bf16(v1[2], v1[3]);
                    *(u32x4*)(rowp + bj * HALF) = w;
                    if (s == 2 || s == 3) {
                        float ss = 0.f;
#pragma unroll
                        for (int e = 0; e < 4; ++e) { const float lo = __uint_as_float(w[e] << 16), hi = __uint_as_float(w[e] & 0xffff0000u); ss += lo * lo + hi * hi; }
                        ss += __shfl_xor(ss, 16); ss += __shfl_xor(ss, 32);
                        if (fq == 0) { const int row = row0 + ai * HALF + m * 16; rn2[(((size_t)(s - 2) * (size_t)(BATCH_T / 16) + (size_t)(row >> 4)) * 16 + ((u.pn & 1) * 8 + bj * 4 + wc)) * 16 + (row & 15)] = ss; } } } }
    }
};
struct EpiG2 {
    static constexpr bool PERM = true, AFTER_DRAIN = false;
    const float* resid; bf16_t* xb; float* sumsq; int ldc;
    __device__ __forceinline__ void operator()(const f32x4 (&acc)[2][2][4][2], const Unit& u, int wr, int wc, int fr, int fq) const {
        const int row0 = u.pm * BM + wr * 64 + fr, col0 = u.pn * BM + wc * 32 + 8 * fq;
#pragma unroll
        for (int ai = 0; ai < 2; ++ai) {
            f32x4 rs[4][2][2];
#pragma unroll
            for (int m = 0; m < 4; ++m) { const size_t off = (size_t)(row0 + ai * HALF + m * 16) * ldc + col0;
#pragma unroll
                for (int bj = 0; bj < 2; ++bj)
#pragma unroll
                    for (int n = 0; n < 2; ++n) rs[m][bj][n] = *(const f32x4*)(resid + off + bj * HALF + n * 4); }
#pragma unroll
            for (int m = 0; m < 4; ++m) { const int r = row0 + ai * HALF + m * 16; const size_t off = (size_t)r * ldc + col0; float ss = 0.f;
#pragma unroll
                for (int bj = 0; bj < 2; ++bj) { const f32x4 x0 = rs[m][bj][0] + acc[ai][bj][m][0], x1 = rs[m][bj][1] + acc[ai][bj][m][1];
                    ss += ((x0[0] * x0[0] + x0[1] * x0[1]) + (x0[2] * x0[2] + x0[3] * x0[3])) + ((x1[0] * x1[0] + x1[1] * x1[1]) + (x1[2] * x1[2] + x1[3] * x1[3]));
                    u32x4 w; w.x = cvt_pk_bf16(x0[0], x0[1]); w.y = cvt_pk_bf16(x0[2], x0[3]); w.z = cvt_pk_bf16(x1[0], x1[1]); w.w = cvt_pk_bf16(x1[2], x1[3]);
                    *(u32x4*)(xb + off + bj * HALF) = w; }
                ss += __shfl_xor(ss, 16); ss += __shfl_xor(ss, 32);
                if (fq == 0) atomicAdd(sumsq + r, ss); }
            asm volatile("" ::: "memory"); }
    }
};
struct EpiG3 {
    static constexpr bool PERM = true, AFTER_DRAIN = false;
    bf16_t* O; int ldc;
    __device__ __forceinline__ void operator()(const f32x4 (&acc)[2][2][4][2], const Unit& u, int wr, int wc, int fr, int fq) const {
        const int row0 = u.pm * BM + wr * 64 + fr;
#pragma unroll
        for (int ai = 0; ai < 2; ++ai)
#pragma unroll
            for (int m = 0; m < 4; ++m) { const int t = row0 + ai * HALF + m * 16;
#pragma unroll
                for (int bj = 0; bj < 2; ++bj) { const f32x4 v0 = acc[ai][bj][m][0], v1 = acc[ai][bj][m][1];
                    u32x4 w; w.x = cvt_pk_bf16(v0[0], v0[1]); w.y = cvt_pk_bf16(v0[2], v0[3]); w.z = cvt_pk_bf16(v1[0], v1[1]); w.w = cvt_pk_bf16(v1[2], v1[3]);
                    *(u32x4*)(O + ((size_t)(((((t >> 5) * 8 + u.pn) * 2 + bj) * 16 + 4 * wc + fq) * 32 + (t & 31))) * 8) = w; } }
    }
};

template <class Epi, class Sched, bool ALIGN_EPI = false, bool SP2 = false>
__device__ __forceinline__ void gemm_phase(PG8_LAS unsigned char* lds, const Gemm g, const Sched& S, const Epi& E, int wid_in) {
    const int wid = __builtin_amdgcn_readfirstlane(wid_in), lane = (int)__builtin_amdgcn_mbcnt_hi(~0u, __builtin_amdgcn_mbcnt_lo(~0u, 0u)), tid = wid * 64 + lane, wr = wid >> 2, wc = wid & 3, fr = lane & 15, fq = lane >> 4;
    const int K = g.K, nt = K / BK;
    unsigned voffA[2], voffB[2];
#pragma unroll
    for (int i = 0; i < 2; ++i) { int R, C; stage_rc(tid * 16 + i * 8192, R, C); const int Rb = Epi::PERM ? ((R & ~31) + perm32(R & 31)) : R;
        voffA[i] = (unsigned)(R * K + C) * 2u; voffB[i] = (unsigned)(Rb * K + C) * 2u; }
    const size_t kstep = (size_t)(BK * 2);
    const size_t hstep = (size_t)HALF * K * 2;
    const size_t tstep = 2 * hstep;
    const unsigned ldsw = (unsigned)wid * 1024u;
    const int aoff = lds_byte(wr * 64 + fr, fq * 8), boff = lds_byte(wc * 32 + fr, fq * 8);
#define PG8_SA(b, h) (((b) * 2 + (h)) * HTB)
#define PG8_SB(b, h) ((4 + (b) * 2 + (h)) * HTB)
#define PG8_STAGE(bufoff, gbase, voff) do { _Pragma("unroll") for (int _i = 0; _i < 2; ++_i) \
        __builtin_amdgcn_global_load_lds((const unsigned*)((const char*)(gbase) + (voff)[_i]), (PG8_LAS unsigned*)(lds + (bufoff) + ldsw + _i * 8192), 16, 0, 0); } while (0)
#define PG8_LDA(dst, b, h) do { _Pragma("unroll") for (int m = 0; m < 4; ++m) _Pragma("unroll") for (int k = 0; k < 2; ++k) dst[m][k] = *(const PG8_LAS bf16x8*)(lds + PG8_SA(b, h) + aoff + m * 2048 + k * 1024); } while (0)
#define PG8_LDB(dst, b, h) do { _Pragma("unroll") for (int n = 0; n < 2; ++n) _Pragma("unroll") for (int k = 0; k < 2; ++k) dst[n][k] = *(const PG8_LAS bf16x8*)(lds + PG8_SB(b, h) + boff + n * 2048 + k * 1024); } while (0)
#define PG8_MMA(ai, bj, At, Bt) do { __builtin_amdgcn_s_setprio(1); _Pragma("unroll") for (int m = 0; m < 4; ++m) _Pragma("unroll") for (int n = 0; n < 2; ++n) _Pragma("unroll") for (int k = 0; k < 2; ++k) \
        acc[ai][bj][m][n] = __builtin_amdgcn_mfma_f32_16x16x32_bf16(Bt[n][k], At[m][k], acc[ai][bj][m][n], 0, 0, 0); __builtin_amdgcn_s_setprio(0); } while (0)
#define PG8_WAIT_V(n) asm volatile("s_waitcnt vmcnt(" #n ")" ::: "memory")
#define PG8_WAIT_L(n) asm volatile("s_waitcnt lgkmcnt(" #n ")" ::: "memory")
#define PG8_BAR __builtin_amdgcn_s_barrier()
#define PG8_SCHED __builtin_amdgcn_sched_barrier(0)
    Unit cur, nxt; int ui = 0;
    if (!S.next(0, cur)) return;
    f32x4 acc[2][2][4][2];
#pragma unroll
    for (int a = 0; a < 2; ++a)
#pragma unroll
        for (int b = 0; b < 2; ++b)
#pragma unroll
            for (int m = 0; m < 4; ++m)
#pragma unroll
                for (int n = 0; n < 2; ++n) acc[a][b][m][n] = (f32x4){0.f, 0.f, 0.f, 0.f};
    bf16x8 At[4][2], B0[2][2], B1[2][2];
    const char* cA = (const char*)g.A + (size_t)cur.pm * tstep; const char* cB = (const char*)g.Bt + (size_t)cur.pn * tstep;
    S.a_ready(cur);
    if constexpr (SP2) {
        PG8_STAGE(PG8_SB(0, 0), cB, voffB); PG8_STAGE(PG8_SB(0, 1), cB + hstep, voffB); PG8_STAGE(PG8_SA(0, 0), cA, voffA); PG8_STAGE(PG8_SA(0, 1), cA + hstep, voffA);
        if (wr == 1) PG8_BAR;
        PG8_WAIT_V(2); PG8_BAR;
        PG8_STAGE(PG8_SB(1, 0), cB + kstep, voffB); PG8_STAGE(PG8_SA(1, 0), cA + kstep, voffA); PG8_STAGE(PG8_SB(1, 1), cB + hstep + kstep, voffB);
        PG8_WAIT_V(6); PG8_BAR;
    } else {
        PG8_STAGE(PG8_SB(0, 0), cB, voffB); PG8_STAGE(PG8_SA(0, 0), cA, voffA); PG8_STAGE(PG8_SB(0, 1), cB + hstep, voffB); PG8_STAGE(PG8_SA(0, 1), cA + hstep, voffA);
        if (wr == 1) PG8_BAR;
        PG8_WAIT_V(4); PG8_BAR;
        PG8_STAGE(PG8_SB(1, 0), cB + kstep, voffB); PG8_STAGE(PG8_SA(1, 0), cA + kstep, voffA); PG8_STAGE(PG8_SB(1, 1), cB + hstep + kstep, voffB);
        PG8_WAIT_V(6); PG8_BAR;
    }
    for (;;) {
        const bool has_next = S.next(ui + 1, nxt);
        const char* nA = has_next ? (const char*)g.A + (size_t)nxt.pm * tstep : cA; const char* nB = has_next ? (const char*)g.Bt + (size_t)nxt.pn * tstep : cB;
        for (int t = 0; t < nt; t += 2) {
            const bool last = (t == nt - 2);
            const char* a1 = cA + (size_t)(t + 1) * kstep;
            const char* a2 = last ? nA : cA + (size_t)(t + 2) * kstep; const char* b2 = last ? nB : cB + (size_t)(t + 2) * kstep;
            const char* a3 = a2 + kstep; const char* b3 = b2 + kstep;
            if (last && has_next) S.a_ready(nxt);
            if constexpr (SP2) {
            PG8_LDB(B0, 0, 0); PG8_LDB(B1, 0, 1); PG8_SCHED; PG8_LDA(At, 0, 0); PG8_STAGE(PG8_SA(1, 1), a1 + hstep, voffA);
            PG8_WAIT_V(8); PG8_WAIT_L(0); PG8_BAR; PG8_MMA(0, 0, At, B0); PG8_MMA(0, 1, At, B1); PG8_BAR; PG8_SCHED;
            PG8_LDA(At, 0, 1); PG8_STAGE(PG8_SB(0, 0), b2, voffB); PG8_STAGE(PG8_SB(0, 1), b2 + hstep, voffB); PG8_STAGE(PG8_SA(0, 0), a2, voffA);
            PG8_WAIT_V(8); PG8_WAIT_L(0); PG8_BAR; PG8_MMA(1, 0, At, B0); PG8_MMA(1, 1, At, B1); PG8_BAR; PG8_SCHED;
            PG8_LDB(B0, 1, 0); PG8_LDB(B1, 1, 1); PG8_SCHED; PG8_LDA(At, 1, 0); PG8_STAGE(PG8_SA(0, 1), a2 + hstep, voffA);
            PG8_WAIT_V(8); PG8_WAIT_L(0); PG8_BAR; PG8_MMA(0, 0, At, B0); PG8_MMA(0, 1, At, B1); PG8_BAR; PG8_SCHED;
            PG8_LDA(At, 1, 1); PG8_STAGE(PG8_SB(1, 0), b3, voffB); PG8_STAGE(PG8_SB(1, 1), b3 + hstep, voffB); PG8_STAGE(PG8_SA(1, 0), a3, voffA);
            PG8_WAIT_V(8); PG8_WAIT_L(0); PG8_BAR; PG8_MMA(1, 0, At, B0); PG8_MMA(1, 1, At, B1); PG8_BAR; PG8_SCHED;
            } else {
            PG8_LDB(B0, 0, 0); PG8_SCHED; PG8_LDA(At, 0, 0); PG8_STAGE(PG8_SA(1, 1), a1 + hstep, voffA);
            PG8_WAIT_L(8); PG8_BAR; PG8_WAIT_L(0); PG8_MMA(0, 0, At, B0); PG8_BAR; PG8_SCHED;
            PG8_LDB(B1, 0, 1); PG8_STAGE(PG8_SB(0, 0), b2, voffB);
            PG8_BAR; PG8_WAIT_L(0); PG8_MMA(0, 1, At, B1); PG8_BAR;
            PG8_LDA(At, 0, 1); PG8_STAGE(PG8_SA(0, 0), a2, voffA);
            PG8_BAR; PG8_WAIT_L(0); PG8_MMA(1, 0, At, B0); PG8_BAR; PG8_SCHED;
            PG8_STAGE(PG8_SB(0, 1), b2 + hstep, voffB);
            PG8_WAIT_V(6); PG8_BAR; PG8_MMA(1, 1, At, B1); PG8_BAR;
            PG8_LDB(B0, 1, 0); PG8_SCHED; PG8_LDA(At, 1, 0); PG8_STAGE(PG8_SA(0, 1), a2 + hstep, voffA);
            PG8_WAIT_L(8); PG8_BAR; PG8_WAIT_L(0); PG8_MMA(0, 0, At, B0); PG8_BAR; PG8_SCHED;
            PG8_LDB(B1, 1, 1); PG8_STAGE(PG8_SB(1, 0), b3, voffB);
            PG8_BAR; PG8_WAIT_L(0); PG8_MMA(0, 1, At, B1); PG8_BAR;
            PG8_LDA(At, 1, 1); PG8_STAGE(PG8_SA(1, 0), a3, voffA);
            PG8_BAR; PG8_WAIT_L(0); PG8_MMA(1, 0, At, B0); PG8_BAR; PG8_SCHED;
            PG8_STAGE(PG8_SB(1, 1), b3 + hstep, voffB);
            PG8_WAIT_V(6); PG8_BAR; PG8_MMA(1, 1, At, B1); PG8_BAR;
            }
        }
        if constexpr (ALIGN_EPI) { if (wr == 0) PG8_BAR; }
        if constexpr (!Epi::AFTER_DRAIN) { E(acc, cur, wr, wc, fr, fq); S.done(cur); }
        if (!has_next) break;
#pragma unroll
        for (int a = 0; a < 2; ++a)
#pragma unroll
            for (int b = 0; b < 2; ++b)
#pragma unroll
                for (int m = 0; m < 4; ++m)
#pragma unroll
                    for (int n = 0; n < 2; ++n) acc[a][b][m][n] = (f32x4){0.f, 0.f, 0.f, 0.f};
        cur = nxt; cA = nA; cB = nB; ++ui;
        if constexpr (ALIGN_EPI) { if (wr == 1) PG8_BAR; }
    }
    PG8_WAIT_V(0);
    if constexpr (!ALIGN_EPI) { if (wr == 0) PG8_BAR; }
    PG8_BAR;
    if constexpr (Epi::AFTER_DRAIN) { E.fused(acc, cur, wr, wc, fr, fq, lds, wid, lane); S.done(cur); }
#undef PG8_SA
#undef PG8_SB
#undef PG8_STAGE
#undef PG8_LDA
#undef PG8_LDB
#undef PG8_MMA
#undef PG8_WAIT_V
#undef PG8_WAIT_L
#undef PG8_BAR
#undef PG8_SCHED
}
}
#include <hip/hip_bf16.h>
#include <cmath>
namespace attn_body {
using bf16=__hip_bfloat16;
using bf16x8=__attribute__((ext_vector_type(8)))short;
using s16x4=__attribute__((ext_vector_type(4)))short;
using f32x16=__attribute__((ext_vector_type(16)))float;
using u32x4=__attribute__((ext_vector_type(4)))unsigned;
constexpr int BATCH=4,NHEAD=8,SEQ=8192,D=64,DM=NHEAD*D;
constexpr int NW=8,QBLK=32,QB=QBLK*NW,KVBLK=64,NQB=SEQ/QB;
constexpr int ATTN_PITCH=DM, ATTN_UNIT_ROWS=QB;
__device__ __forceinline__ int crow(int r,int hi){return (r&3)+8*(r>>2)+4*hi;}
#define SBAR() __builtin_amdgcn_sched_barrier(0)
__device__ __forceinline__ void cmask(f32x16&p0,f32x16&p1,int jb,int qrel,int hi){
  const float NEG=-INFINITY; int kb=64*jb+4*hi;
  #pragma unroll
  for(int r=0;r<16;++r){int kv=kb+(r&3)+8*(r>>2); if(kv>qrel)p0[r]=NEG; if(kv+32>qrel)p1[r]=NEG;}
}

constexpr int NSLOT=3, SLOTB=8192;
constexpr int LDS_K=0, LDS_V=NSLOT*SLOTB, LDS_WS=2*NSLOT*SLOTB, LDS_OST=LDS_WS+NW*64*4, LDS_FK=LDS_OST+NW*4096, LDS_BYTES=LDS_FK+SEQ*4;
constexpr float C2=0.125f*1.4426950408889634f;
__device__ __forceinline__ void glds16(const void*gsrc,unsigned lds_dst){unsigned keep;
  asm volatile("s_mov_b32 %0, m0\n\ts_mov_b32 m0, %2\n\ts_nop 0\n\tglobal_load_lds_dwordx4 %1, off\n\ts_mov_b32 m0, %0":"=&s"(keep):"v"(gsrc),"s"(lds_dst):"memory");}
__device__ __forceinline__ float max3f(float a,float b,float c){float r;asm("v_max3_f32 %0, %1, %2, %3":"=v"(r):"v"(a),"v"(b),"v"(c));return r;}
__device__ __forceinline__ float max2f(float a,float b){float r;asm("v_max_f32_e32 %0, %1, %2":"=v"(r):"v"(a),"v"(b));return r;}
__device__ __forceinline__ float fadd_s(float a,float b){float r;asm("v_add_f32_e32 %0, %1, %2":"=v"(r):"v"(a),"v"(b));return r;}
__device__ __forceinline__ float fsub_s(float a,float b){float r;asm("v_sub_f32_e32 %0, %1, %2":"=v"(r):"v"(a),"v"(b));return r;}
typedef float f32x2_t __attribute__((ext_vector_type(2))); typedef __bf16 bf16x2_t __attribute__((ext_vector_type(2)));
__device__ __forceinline__ unsigned cvtpk_s(float lo,float hi){f32x2_t v={lo,hi};bf16x2_t b=__builtin_convertvector(v,bf16x2_t);return __builtin_bit_cast(unsigned,b);}
#define WAIT_BAR(N) asm volatile("s_waitcnt vmcnt(" #N ") lgkmcnt(0)\n\ts_barrier":::"memory")

__device__ __forceinline__ void qkt(f32x16&p0,f32x16&p1,const char*Kslot,const bf16x8*qr,int r32,int hi){
  const char*kb=Kslot+hi*1024+r32*16;
  #pragma unroll
  for(int d0=0;d0<4;++d0){
    const bf16x8 b0=*reinterpret_cast<const bf16x8*>(kb+d0*2048);
    const bf16x8 b1=*reinterpret_cast<const bf16x8*>(kb+d0*2048+512);
    p0=__builtin_amdgcn_mfma_f32_32x32x16_bf16(b0,qr[d0],p0,0,0,0);p1=__builtin_amdgcn_mfma_f32_32x32x16_bf16(b1,qr[d0],p1,0,0,0);}
}
typedef __attribute__((address_space(3))) const char* lds_cptr;
typedef short v4i16_t __attribute__((ext_vector_type(4)));
__device__ __forceinline__ void kload8(bf16x8*kf,lds_cptr kp){
  kf[0]=*(const __attribute__((address_space(3))) bf16x8*)(kp);      kf[1]=*(const __attribute__((address_space(3))) bf16x8*)(kp+512);
  kf[2]=*(const __attribute__((address_space(3))) bf16x8*)(kp+2048); kf[3]=*(const __attribute__((address_space(3))) bf16x8*)(kp+2560);
  kf[4]=*(const __attribute__((address_space(3))) bf16x8*)(kp+4096); kf[5]=*(const __attribute__((address_space(3))) bf16x8*)(kp+4608);
  kf[6]=*(const __attribute__((address_space(3))) bf16x8*)(kp+6144); kf[7]=*(const __attribute__((address_space(3))) bf16x8*)(kp+6656);
}
__device__ __forceinline__ void kload2(bf16x8*kf,lds_cptr kp,int j){ kf[2*j]=*(const __attribute__((address_space(3))) bf16x8*)(kp+j*2048); kf[2*j+1]=*(const __attribute__((address_space(3))) bf16x8*)(kp+j*2048+512); }
__device__ __forceinline__ s16x4 vtr(lds_cptr p){ return __builtin_bit_cast(s16x4,__builtin_amdgcn_ds_read_tr16_b64_v4i16((__attribute__((address_space(3))) v4i16_t*)p)); }
__device__ __forceinline__ float rowmax(const f32x16&p0,const f32x16&p1){
  float a=max3f(p0[0],p0[1],p1[0]),b=max3f(p0[2],p0[3],p1[1]);a=max3f(a,p1[2],p1[3]);
  #pragma unroll
  for(int r=4;r<16;r+=4){a=max3f(a,p0[r],p0[r+1]);b=max3f(b,p0[r+2],p0[r+3]);a=max3f(a,p1[r],p1[r+1]);b=max3f(b,p1[r+2],p1[r+3]);}
  const float m=max2f(a,b);
  auto rr=__builtin_amdgcn_permlane32_swap(__float_as_uint(m),__float_as_uint(m),false,false);
  return max2f(__uint_as_float(rr[0]),__uint_as_float(rr[1]));
}
__device__ __forceinline__ void pv(f32x16*o,int vb,bf16x8 pa0,bf16x8 pa1,bf16x8 pa2,bf16x8 pa3){
  #pragma unroll
  for(int d0=0;d0<2;++d0){s16x4 lo[4],hi[4];
    #pragma unroll
    for(int ks=0;ks<4;++ks){
      asm volatile("ds_read_b64_tr_b16 %0,%1 offset:%c2":"=&v"(lo[ks]):"v"(vb),"i"(d0*4096+ks*1024):"memory");
      asm volatile("ds_read_b64_tr_b16 %0,%1 offset:%c2":"=&v"(hi[ks]):"v"(vb),"i"(d0*4096+ks*1024+512):"memory");}
    asm volatile("s_waitcnt lgkmcnt(0)":::"memory");SBAR();
    #define PK(k) (bf16x8){lo[k][0],lo[k][1],lo[k][2],lo[k][3],hi[k][0],hi[k][1],hi[k][2],hi[k][3]}
    o[d0]=__builtin_amdgcn_mfma_f32_32x32x16_bf16(pa0,PK(0),o[d0],0,0,0);
    o[d0]=__builtin_amdgcn_mfma_f32_32x32x16_bf16(pa1,PK(1),o[d0],0,0,0);
    o[d0]=__builtin_amdgcn_mfma_f32_32x32x16_bf16(pa2,PK(2),o[d0],0,0,0);
    o[d0]=__builtin_amdgcn_mfma_f32_32x32x16_bf16(pa3,PK(3),o[d0],0,0,0);
    #undef PK
  }
}

#ifndef ATTN_STORE16
#define ATTN_STORE16(p,v) (*(u32x4*)(p)=(v))
#endif
template<int THRL> __device__ __forceinline__ void attn_unit(int b,int h,int qb,const bf16*Q,const bf16*__restrict__ K,const bf16*__restrict__ V,bf16*O,const float*__restrict__ Fc,const float*__restrict__ NRM,char*shm,int wid_in){
  const int wid=__builtin_amdgcn_readfirstlane(wid_in); int lane_=(int)__builtin_amdgcn_mbcnt_hi(~0u,__builtin_amdgcn_mbcnt_lo(~0u,0u)); asm volatile("":"+v"(lane_));
  const int lane=lane_,tid=wid*64+lane,r32=lane&31,hi=lane>>5;
  const long rowbase=(long)b*SEQ; const int q0=qb*QB;
  const float*Fbh=Fc+(long)(b*NHEAD+h)*SEQ;
  const int NTF=(q0+QB)/KVBLK; int t_start;
  { const float*QNb=NRM+(b*NHEAD+h)*128,*KNb=NRM+4096+(b*NHEAD+h)*128;
    const float qn=fmaxf(fmaxf(QNb[4*qb],QNb[4*qb+1]),fmaxf(QNb[4*qb+2],QNb[4*qb+3])),knb=fmaxf(fmaxf(KNb[4*qb],KNb[4*qb+1]),fmaxf(KNb[4*qb+2],KNb[4*qb+3]));
    const float fq0=Fbh[q0]*1.4426950408889634f; bool k0=true,k1=true;
    if(lane<NTF-4)k0=!(qn*(KNb[lane]+knb)+(fq0-Fbh[64*lane+63]*1.4426950408889634f)<-40.f);
    if(lane+64<NTF-4)k1=!(qn*(KNb[lane+64]+knb)+(fq0-Fbh[64*(lane+64)+63]*1.4426950408889634f)<-40.f);
    const unsigned long long m0=__ballot(k0),m1=__ballot(k1);
    int tf=m0?(int)__builtin_ctzll(m0):64+(m1?(int)__builtin_ctzll(m1):64);
    tf=tf<NTF-4?tf:NTF-4; t_start=__builtin_amdgcn_readfirstlane(tf&~1); }
  { typedef float f32x4_t __attribute__((ext_vector_type(4))); __attribute__((address_space(3))) float*fk=(__attribute__((address_space(3))) float*)((__attribute__((address_space(3))) char*)shm+LDS_FK); const int n4=(q0+QB)/4;
    for(int i=16*t_start+tid;i<n4;i+=NW*64){ f32x4_t v=*(const f32x4_t*)(Fbh+4*i); v=v*(-1.4426950408889634f); *(__attribute__((address_space(3))) f32x4_t*)(fk+4*i)=v; } }
  float fq2=Fbh[q0+wid*QBLK+r32]*1.4426950408889634f; asm volatile("":"+v"(fq2));
  const bf16*Qw=Q+(rowbase+q0+wid*QBLK)*DM+h*D;
  const bf16*Kh=K+(rowbase+(long)t_start*KVBLK)*DM+h*D,*Vh=V+(rowbase+(long)t_start*KVBLK)*DM+h*D;
  const lds_cptr shm3=(lds_cptr)shm;
  const unsigned lds0=(unsigned)(uintptr_t)shm;
  float*wsf=(float*)(shm+LDS_WS)+wid*64;
  const bf16*ksrc=Kh+(long)lane*DM+wid*8;
  const bf16*vsrc=Vh+(long)(16*(wid&3)+(lane>>2))*DM+(wid>>2)*32+(lane&3)*8;
  const unsigned kdst=lds0+LDS_K+wid*1024, vdst=lds0+LDS_V+wid*1024;
  #define DMA_K(t,slot) glds16(ksrc+(long)(t)*KVBLK*DM,(unsigned)__builtin_amdgcn_readfirstlane(kdst+(slot)))
  #define DMA_V(t,slot) glds16(vsrc+(long)(t)*KVBLK*DM,(unsigned)__builtin_amdgcn_readfirstlane(vdst+(slot)))
  const int vb0=(int)(lds0+LDS_V)+((lane>>4)&1)*32+(lane&3)*8+(4*hi+((lane&15)>>2))*64;
  const char*Kbase=shm+LDS_K; bf16x8 kf[8];
  const lds_cptr kp0=shm3+LDS_K+hi*1024+r32*16; const lds_cptr vp0=shm3+LDS_V+((lane>>4)&1)*32+(lane&3)*8+(4*hi+((lane&15)>>2))*64;
  const int NT=NTF-t_start;
  DMA_K(0,0);DMA_V(0,0);DMA_K(1,SLOTB);
  bf16x8 qr[4];
  #pragma unroll
  for(int d0=0;d0<4;++d0)qr[d0]=*reinterpret_cast<const bf16x8*>(&Qw[(long)r32*DM+d0*16+hi*8]);
  float mhat=0.f,l_reg=0.f;f32x16 o[2];o[0]=f32x16{};o[1]=f32x16{};
  const __attribute__((address_space(3))) float*fkl=(const __attribute__((address_space(3))) float*)(shm3+LDS_FK)+64*t_start+4*hi;
  #define INITC(C0,C1,t) do{ const float nsc_=fq2-mhat; typedef float f32x4_t __attribute__((ext_vector_type(4))); const __attribute__((address_space(3))) float*kb_=fkl+64*(t); \
    _Pragma("unroll") for(int g_=0;g_<4;++g_){ const f32x4_t a_=*(const __attribute__((address_space(3))) f32x4_t*)(kb_+8*g_), b_=*(const __attribute__((address_space(3))) f32x4_t*)(kb_+32+8*g_); \
      _Pragma("unroll") for(int e_=0;e_<4;++e_){ C0[4*g_+e_]=nsc_+a_[e_]; C1[4*g_+e_]=nsc_+b_[e_]; } } }while(0)
  const int qrel=wid*QBLK+r32;
  #define CMASK(P0,P1,t) do{int jb_=(t)-(NT-4); if(jb_>=0)cmask(P0,P1,jb_,qrel,hi);}while(0)
  bool resc=false;
  #define START(P0,P1) do{ const float rm=rowmax(P0,P1); resc=false; \
    { const float dl=rm; mhat=fadd_s(mhat,dl); \
      _Pragma("unroll") for(int r=0;r<16;++r){P0[r]=fsub_s(P0[r],dl);P1[r]=fsub_s(P1[r],dl);} \
      } \
    _Pragma("unroll") for(int r=0;r<16;++r)P0[r]=__builtin_amdgcn_exp2f(P0[r]); }while(0)
  #define RESC() do{ if(resc){ asm volatile("s_waitcnt lgkmcnt(0)":::"memory"); \
      _Pragma("unroll") for(int d_=0;d_<2;++d_) _Pragma("unroll") for(int r=0;r<16;++r)o[d_][r]*=wsf[crow(r,hi)]; } }while(0)
  f32x16 pA0,pA1,pB0,pB1;
  int sl_prev=0,sl_cur=0,sl_next=SLOTB;
  #define ROT() do{sl_prev=sl_cur;sl_cur=sl_next;sl_next=(sl_next==(NSLOT-1)*SLOTB)?0:sl_next+SLOTB;}while(0)
  DMA_K(2,2*SLOTB);
  WAIT_BAR(3);
  INITC(pA0,pA1,0); qkt(pA0,pA1,Kbase,qr,r32,hi);asm volatile("s_nop 15\n\ts_nop 7":"+v"(pA0),"+v"(pA1));CMASK(pA0,pA1,0);
  START(pA0,pA1);
  _Pragma("unroll") for(int r=0;r<16;++r)pA1[r]=__builtin_amdgcn_exp2f(pA1[r]);
  WAIT_BAR(0);
  DMA_K(3,0);DMA_V(1,SLOTB);
  ROT();
  kload8(kf,kp0+sl_cur);
  WAIT_BAR(2);
  s16x4 vlo[8],vhi[8]; u32x4 pw0,pw1,pw2,pw3;
  #define PKW(P,B) cvtpk_s(P[B],P[B+1])
  #define PAF(k) __builtin_bit_cast(bf16x8,pw##k)
  #define VFR(i) (bf16x8){vlo[i][0],vlo[i][1],vlo[i][2],vlo[i][3],vhi[i][0],vhi[i][1],vhi[i][2],vhi[i][3]}
  #define PIN(x) asm volatile("":"+v"(x))
  #define MX3(a,b,c) __builtin_fmaxf(__builtin_fmaxf((a),(b)),(c))
  #define GAPA(MF,A0,A1,A2,A3,W0,W1,PW) do{ MF; sacc+=A0; sacc+=A1; sacc+=A2; sacc+=A3; PIN(sacc); W0; W1; PIN(PW); SBAR(); }while(0)
  #define EX(v) __builtin_amdgcn_exp2f(v)
  #define GAPB(MF,X,B) do{ MF; X[B]=EX(X[B]); X[B+1]=EX(X[B+1]); X[B+2]=EX(X[B+2]); X[B+3]=EX(X[B+3]); PIN(X); SBAR(); }while(0)
  #define VRD(i) do{ vlo[i]=vtr(vp_+(((i)>>2)*4096+((i)&3)*1024)); vhi[i]=vtr(vp_+(((i)>>2)*4096+((i)&3)*1024+512)); }while(0)
  #define KRD(G,j) do{ if(G){ kload2(kf,kp0+sl_next,j); SBAR(); } }while(0)
  #define STEP(C0,C1,P0,P1,t,GK,GV,GL) do{ SBAR(); INITC(C0,C1,t); PIN(C0); PIN(C1); SBAR(); \
    const lds_cptr vp_=vp0+sl_prev; \
    VRD(0); SBAR(); float sacc=(P0[0]+P0[1]); \
    GAPA(C0=__builtin_amdgcn_mfma_f32_32x32x16_bf16(kf[0],qr[0],C0,0,0,0), P0[2],P0[3],P0[4],P0[5],     pw0[0]=PKW(P0,0), pw0[1]=PKW(P0,2), pw0); \
    VRD(4); SBAR(); GAPA(C1=__builtin_amdgcn_mfma_f32_32x32x16_bf16(kf[1],qr[0],C1,0,0,0), P0[6],P0[7],P0[8],P0[9],     pw0[2]=PKW(P0,4), pw0[3]=PKW(P0,6), pw0); \
    VRD(1); SBAR(); GAPA(C0=__builtin_amdgcn_mfma_f32_32x32x16_bf16(kf[2],qr[1],C0,0,0,0),   P0[10],P0[11],P0[12],P0[13], pw1[0]=PKW(P0,8), pw1[1]=PKW(P0,10), pw1); \
    VRD(5); SBAR(); GAPA(C1=__builtin_amdgcn_mfma_f32_32x32x16_bf16(kf[3],qr[1],C1,0,0,0),   P0[14],P0[15],P1[0],P1[1],   pw1[2]=PKW(P0,12),pw1[3]=PKW(P0,14), pw1); \
    VRD(2); SBAR(); GAPA(C0=__builtin_amdgcn_mfma_f32_32x32x16_bf16(kf[4],qr[2],C0,0,0,0),   P1[2],P1[3],P1[4],P1[5],     pw2[0]=PKW(P1,0), pw2[1]=PKW(P1,2), pw2); \
    VRD(6); SBAR(); GAPA(C1=__builtin_amdgcn_mfma_f32_32x32x16_bf16(kf[5],qr[2],C1,0,0,0),   P1[6],P1[7],P1[8],P1[9],     pw2[2]=PKW(P1,4), pw2[3]=PKW(P1,6), pw2); \
    VRD(3); SBAR(); GAPA(C0=__builtin_amdgcn_mfma_f32_32x32x16_bf16(kf[6],qr[3],C0,0,0,0),   P1[10],P1[11],P1[12],P1[13], pw3[0]=PKW(P1,8), pw3[1]=PKW(P1,10), pw3); \
    VRD(7); SBAR(); GAPA(C1=__builtin_amdgcn_mfma_f32_32x32x16_bf16(kf[7],qr[3],C1,0,0,0),   P1[14],P1[15],0.f,0.f,       pw3[2]=PKW(P1,12),pw3[3]=PKW(P1,14), pw3); \
    l_reg+=sacc; \
    if(GK){DMA_K((t)+3,sl_cur);} if(GV){DMA_V((t)+1,sl_next);} \
    CMASK(C0,C1,t); \
    { float a=MX3(C0[0],C0[1],C1[0]),b=MX3(C0[2],C0[3],C1[1]); a=MX3(a,C1[2],C1[3]); \
      _Pragma("unroll") for(int r=4;r<16;r+=4){a=MX3(a,C0[r],C0[r+1]);b=MX3(b,C0[r+2],C0[r+3]);a=MX3(a,C1[r],C1[r+1]);b=MX3(b,C1[r+2],C1[r+3]);} \
      float rm=__builtin_fmaxf(a,b); { auto rr=__builtin_amdgcn_permlane32_swap(__float_as_uint(rm),__float_as_uint(rm),false,false); rm=__builtin_fmaxf(__uint_as_float(rr[0]),__uint_as_float(rr[1])); } \
      resc=false; \
      if(__builtin_expect(__any(rm>(float)THRL),0)){ const float dl=__builtin_fmaxf(rm,0.f); mhat+=dl; \
        _Pragma("unroll") for(int r=0;r<16;++r){C0[r]-=dl;C1[r]-=dl;} \
        const float f=__builtin_amdgcn_exp2f(-dl); l_reg*=f; if(hi==0)wsf[r32]=f; resc=true; } } \
    SBAR(); \
    GAPB(o[0]=__builtin_amdgcn_mfma_f32_32x32x16_bf16(PAF(0),VFR(0),o[0],0,0,0), C0,0); \
    GAPB(o[1]=__builtin_amdgcn_mfma_f32_32x32x16_bf16(PAF(0),VFR(4),o[1],0,0,0), C0,4); \
    KRD(GL,0); GAPB(o[0]=__builtin_amdgcn_mfma_f32_32x32x16_bf16(PAF(1),VFR(1),o[0],0,0,0), C0,8); \
    KRD(GL,1); GAPB(o[1]=__builtin_amdgcn_mfma_f32_32x32x16_bf16(PAF(1),VFR(5),o[1],0,0,0), C0,12); \
    KRD(GL,2); GAPB(o[0]=__builtin_amdgcn_mfma_f32_32x32x16_bf16(PAF(2),VFR(2),o[0],0,0,0), C1,0); \
    KRD(GL,3); GAPB(o[1]=__builtin_amdgcn_mfma_f32_32x32x16_bf16(PAF(2),VFR(6),o[1],0,0,0), C1,4); \
    GAPB(o[0]=__builtin_amdgcn_mfma_f32_32x32x16_bf16(PAF(3),VFR(3),o[0],0,0,0), C1,8); \
    GAPB(o[1]=__builtin_amdgcn_mfma_f32_32x32x16_bf16(PAF(3),VFR(7),o[1],0,0,0), C1,12); \
    }while(0)
  int t=1;
  #undef CMASK
  #define CMASK(P0,P1,t) do{}while(0)
  for(;t+5<NT;t+=2){
    STEP(pB0,pB1,pA0,pA1,t,true,true,true);     WAIT_BAR(2); RESC(); ROT();
    STEP(pA0,pA1,pB0,pB1,t+1,true,true,true);   WAIT_BAR(2); RESC(); ROT();
  }
  #undef CMASK
  #define CMASK(P0,P1,t) do{int jb_=(t)-(NT-4); if(jb_>=0)cmask(P0,P1,jb_,qrel,hi);}while(0)
  #define ENDW(tt) do{ if((tt)+3<NT){WAIT_BAR(2);} else if((tt)+2<NT){WAIT_BAR(1);} else {WAIT_BAR(0);} }while(0)
  for(;t+1<NT;t+=2){
    STEP(pB0,pB1,pA0,pA1,t,(t+3<NT),(t+1<NT),(t+1<NT));       ENDW(t);   RESC(); ROT();
    STEP(pA0,pA1,pB0,pB1,t+1,(t+4<NT),(t+2<NT),(t+2<NT));     ENDW(t+1); RESC(); ROT();
  }
  STEP(pB0,pB1,pA0,pA1,NT-1,false,false,false); RESC();
  { float sacc=pB0[0]+pB0[1]; _Pragma("unroll") for(int r=2;r<16;++r)sacc+=pB0[r]; _Pragma("unroll") for(int r=0;r<16;++r)sacc+=pB1[r]; l_reg+=sacc;
    pw0=(u32x4){PKW(pB0,0),PKW(pB0,2),PKW(pB0,4),PKW(pB0,6)};pw1=(u32x4){PKW(pB0,8),PKW(pB0,10),PKW(pB0,12),PKW(pB0,14)};pw2=(u32x4){PKW(pB1,0),PKW(pB1,2),PKW(pB1,4),PKW(pB1,6)};pw3=(u32x4){PKW(pB1,8),PKW(pB1,10),PKW(pB1,12),PKW(pB1,14)};
    SBAR(); pv(o,vb0+sl_cur,PAF(0),PAF(1),PAF(2),PAF(3)); }
  #undef PKW
  #undef PAF
  #undef VFR
  #undef PIN
  #undef MX3
  #undef GAPA
  #undef GAPB
  #undef EX
  #undef VRD
  #undef KRD
  #undef STEP
  #undef ENDW
  {auto rr=__builtin_amdgcn_permlane32_swap(__float_as_uint(l_reg),__float_as_uint(l_reg),false,false);l_reg=__uint_as_float(rr[0])+__uint_as_float(rr[1]);}
  if(hi==0)wsf[32+r32]=l_reg;asm volatile("s_waitcnt lgkmcnt(0)":::"memory");
  float rli[16];
  #pragma unroll
  for(int r=0;r<16;++r)rli[r]=__builtin_amdgcn_rcpf(wsf[32+crow(r,hi)]);
  bf16*Ow=O+(rowbase+q0+wid*QBLK)*DM+h*D;
  { bf16*stg=(bf16*)(shm+LDS_OST)+wid*2048;
    #pragma unroll
    for(int r=0;r<16;++r){const int orow=crow(r,hi);
      #pragma unroll
      for(int d0=0;d0<2;++d0)stg[orow*64+d0*32+r32]=__float2bfloat16(o[d0][r]*rli[r]);}
    asm volatile("s_waitcnt lgkmcnt(0)":::"memory");
    #pragma unroll
    for(int i=0;i<4;++i){const int row=i*8+(lane>>3),ch=lane&7; const u32x4 v=*(const u32x4*)(stg+row*64+ch*8); ATTN_STORE16(Ow+(long)row*DM+ch*8,v);} }
  asm volatile("s_waitcnt lgkmcnt(0)\n\ts_barrier":::"memory");
  #undef DMA_K
  #undef DMA_V
  #undef INITC
  #undef CMASK
  #undef START
  #undef RESC
  #undef ROT
}
constexpr int ATTN_LDS_BYTES=LDS_BYTES;
struct AttnTensors { const bf16* Q; const bf16* K; const bf16* V; bf16* O; const float* F; const float* NRM; };
struct AttnUnit { int bh; int qb; };
struct StaticOrder {
  int vcu;
  __device__ __forceinline__ explicit StaticOrder(int grid,int block):vcu((block%8)*(grid/8)+block/8){}
  __device__ __forceinline__ bool next(int i,AttnUnit&u)const{ if(i>=4)return false; const int s=vcu&7; u.bh=vcu>>3; u.qb=(i==0)?s:(i==1)?15-s:(i==2)?16+s:31-s; return true; }
  __device__ __forceinline__ void a_ready(const AttnUnit&)const{}
  __device__ __forceinline__ void done(const AttnUnit&)const{}
};
template<int THRL=8> __device__ __forceinline__ void attn_phase(char*lds,const AttnTensors&T,unsigned*qctr,volatile __attribute__((address_space(3))) unsigned*qword,int wid_in){
  const int lane0=(int)__builtin_amdgcn_mbcnt_hi(~0u,__builtin_amdgcn_mbcnt_lo(~0u,0u));
  for(;;){
    if(wid_in==0&&lane0==0){ const unsigned n=__hip_atomic_fetch_add(qctr,1u,__ATOMIC_RELAXED,__HIP_MEMORY_SCOPE_AGENT); *qword=n; }
    asm volatile("s_waitcnt vmcnt(0) lgkmcnt(0)\n\ts_barrier":::"memory");
    const int n=__builtin_amdgcn_readfirstlane((int)*qword);
    if(n>=BATCH*NHEAD*NQB)break;
    const int bh=n%(BATCH*NHEAD),qb=NQB-1-n/(BATCH*NHEAD);
    attn_unit<THRL>(bh/NHEAD,bh%NHEAD,qb,T.Q,T.K,T.V,T.O,T.F,T.NRM,lds,wid_in);
  }
}
#undef SBAR
#undef WAIT_BAR
}
#define GAS __attribute__((address_space(1)))
#define LAS __attribute__((address_space(3)))
typedef unsigned short bf16;
typedef unsigned v4u __attribute__((ext_vector_type(4)));
typedef float f32x4 __attribute__((ext_vector_type(4)));
typedef short bf16x8 __attribute__((ext_vector_type(8)));
typedef GAS unsigned gu32;
typedef GAS unsigned long long gu64;
#define RLX_AGENT __ATOMIC_RELAXED, __HIP_MEMORY_SCOPE_AGENT
#define LDS_WAIT() asm volatile("s_waitcnt lgkmcnt(0)" ::: "memory")
#define VM_WAIT() asm volatile("s_waitcnt vmcnt(0)" ::: "memory")
__device__ __forceinline__ unsigned long long rt() { return __builtin_amdgcn_s_memrealtime(); }
__device__ __forceinline__ unsigned f2bf(float f) { unsigned u = __builtin_bit_cast(unsigned, f); return (u + 0x7fffu + ((u >> 16) & 1u)) >> 16; }
__device__ __forceinline__ unsigned pk2(float lo, float hi) { return f2bf(lo) | (f2bf(hi) << 16); }

#define XB_TMO      128
#define XB_XCNT(j)  (256  + 64 * (j))
#define XB_XSUB(j)  (1280 + 64 * (j))
#define XB_XGEN(j)  (2304 + 64 * (j))
#define XB_TOP      3328
#define XB_TOPGEN   3392
#define XCD_BAR_WORDS 3456
#define XB_SPIN_CAP (1u << 18)

__device__ __forceinline__ unsigned xb_ld(unsigned* p)              { return __hip_atomic_load(p, __ATOMIC_RELAXED, __HIP_MEMORY_SCOPE_AGENT); }
__device__ __forceinline__ unsigned xb_add(unsigned* p, unsigned v) { return __hip_atomic_fetch_add(p, v, __ATOMIC_RELAXED, __HIP_MEMORY_SCOPE_AGENT); }
__device__ __forceinline__ unsigned xb_xcc_id() { return (unsigned)__builtin_amdgcn_s_getreg((3 << 11) | 20) & 0xFu; }
#define XB_SPIN(cond, bar) do { unsigned _sp = 0; while (cond) { __builtin_amdgcn_s_sleep(1); \
    if ((++_sp & 255u) == 0u) { if (xb_ld(&(bar)[XB_TMO])) break; if (_sp > XB_SPIN_CAP) { atomicAdd(&(bar)[XB_TMO], 1u); break; } } } } while (0)

struct XcdBarrier {
    unsigned* bar; unsigned x; int wv;
    volatile LAS unsigned* st;
};

__device__ __forceinline__ bool xb_t0(int wv) { return wv == 0 && __builtin_amdgcn_mbcnt_hi(~0u, __builtin_amdgcn_mbcnt_lo(~0u, 0u)) == 0u; }
__device__ __forceinline__ XcdBarrier xcd_barrier_post(unsigned* bar, volatile LAS unsigned* st, int wv) {
    XcdBarrier b; b.bar = bar; b.x = xb_xcc_id(); b.st = st; b.wv = wv;
    if (xb_t0(wv)) (void)xb_add(&bar[XB_XCNT(b.x)], 1u);
    return b;
}
__device__ __forceinline__ void xcd_barrier_complete(unsigned* bar, unsigned x, unsigned& nloc, unsigned& nx) {
    const unsigned G = gridDim.x * gridDim.y * gridDim.z;
    unsigned sum, cnt, mine, sp = 0u;
    for (;;) {
        sum = 0u; cnt = 0u; mine = 0u;
#pragma unroll
        for (unsigned j = 0; j < 16; ++j) { const unsigned c = xb_ld(&bar[XB_XCNT(j)]); sum += c; cnt += (c > 0u) ? 1u : 0u; mine = (j == x) ? c : mine; }
        if (sum == G) break;
        __builtin_amdgcn_s_sleep(1);
        if ((++sp & 255u) == 0u) { if (xb_ld(&bar[XB_TMO])) break; if (sp > XB_SPIN_CAP) { atomicAdd(&bar[XB_TMO], 1u); break; } }
    }
    nloc = mine > 0u ? mine : 1u; nx = cnt > 0u ? cnt : 1u;
}

__device__ __forceinline__ void xcd_barrier(const XcdBarrier& b) {
    asm volatile("s_waitcnt vmcnt(0)" ::: "memory");
    __syncthreads();
    if (xb_t0(b.wv)) {
        unsigned* bar = b.bar;
        __builtin_amdgcn_s_waitcnt(0);
        unsigned nloc = b.st[0], nx = b.st[1];
        if (nloc == 0u) { xcd_barrier_complete(bar, b.x, nloc, nx); b.st[0] = nloc; b.st[1] = nx; }
        const unsigned old = xb_add(&bar[XB_XSUB(b.x)], 1u);
        const unsigned gen = old / nloc;
        if (old + 1u == (gen + 1u) * nloc) {
            __builtin_amdgcn_fence(__ATOMIC_RELEASE, "agent");
            asm volatile("s_waitcnt vmcnt(0)" ::: "memory");
            const unsigned og = xb_add(&bar[XB_TOP], 1u);
            const unsigned tg = og / nx;
            if (og + 1u == (tg + 1u) * nx) xb_add(&bar[XB_TOPGEN], 1u);
            else XB_SPIN(xb_ld(&bar[XB_TOPGEN]) == tg, bar);
            __builtin_amdgcn_fence(__ATOMIC_ACQUIRE, "agent");
            xb_add(&bar[XB_XGEN(b.x)], 1u);
            asm volatile("s_waitcnt vmcnt(0)" ::: "memory");
        } else {
            XB_SPIN(xb_ld(&bar[XB_XGEN(b.x)]) == gen, bar);
            __builtin_amdgcn_fence(__ATOMIC_ACQUIRE, "agent");
            asm volatile("s_waitcnt vmcnt(0)" ::: "memory");
        }
    }
    __syncthreads();
}

constexpr int NWAVES = 8;
constexpr int RING_OFF = 0, RING_BYTES = 131072;
constexpr int LDSCTL_OFF = RING_BYTES, MISC_OFF = LDSCTL_OFF + 320;
constexpr int LDS_BYTES = 147456;
constexpr int N_PHASES = 8;

struct Frame {
    LAS unsigned char* lds;
    volatile LAS unsigned* MISC;
    gu32* ctl;
    int tid, lane, wave, vcu, G;
};
__device__ __forceinline__ float wave_sum(float v) {
#pragma unroll
    for (int o = 1; o < 64; o <<= 1) v += __shfl_xor(v, o);
    return v;
}
struct Args { const float* in[20]; float* out; unsigned char* ws; int ph_lo, ph_hi, li, pad; };

__device__ __forceinline__ void p0_transpose_item(const float* W, int ld, int nblk, const float* glo, const float* ghi, int K, bf16* WT, int item, int lane) {
    const int kb = item / nblk, nb = item % nblk, k0 = 64 * kb + 16 * (lane >> 4), n0 = 64 * nb + 4 * (lane & 15);
    f32x4 w[16];
#pragma unroll
    for (int j = 0; j < 16; ++j) w[j] = *(const GAS f32x4*)(W + (size_t)(k0 + j) * ld + n0);
    if (glo) { const float* gp = (k0 < K / 2) ? glo + k0 : ghi + (k0 - K / 2);
#pragma unroll
        for (int q = 0; q < 4; ++q) { const f32x4 g4 = *(const GAS f32x4*)(gp + 4 * q);
#pragma unroll
            for (int e = 0; e < 4; ++e) w[4 * q + e] = w[4 * q + e] * g4[e]; } }
#pragma unroll
    for (int c = 0; c < 4; ++c) { v4u o0, o1;
        o0.x = pk2(w[0][c], w[1][c]); o0.y = pk2(w[2][c], w[3][c]); o0.z = pk2(w[4][c], w[5][c]); o0.w = pk2(w[6][c], w[7][c]);
        o1.x = pk2(w[8][c], w[9][c]); o1.y = pk2(w[10][c], w[11][c]); o1.z = pk2(w[12][c], w[13][c]); o1.w = pk2(w[14][c], w[15][c]);
        bf16* dp = WT + (size_t)(n0 + c) * K + k0; *(GAS v4u*)dp = o0; *(GAS v4u*)(dp + 8) = o1; }
}
__device__ __forceinline__ float log_sigmoid(float z) { return fminf(z, 0.f) - log1pf(expf(-fabsf(z))); }

__device__ __forceinline__ void p0_prologue(Frame& F, const Args& a) {
    unsigned char* ws = a.ws;
    const float* x = a.in[0]; const float* g1 = a.in[1]; const float* w_in = a.in[2]; const float* bfv = a.in[10];
    const float* gn_l = a.in[11]; const float* gn_f = a.in[12]; const float* w_out = a.in[13]; const float* g2 = a.in[14];
    const float* w_q = a.in[15]; const float* sk = a.in[16]; const float* pu = a.in[17]; const float* pv = a.in[18];
    bf16* win_t = (bf16*)(ws + WS_WIN); bf16* wout_t = (bf16*)(ws + WS_WOUT); bf16* wq_t = (bf16*)(ws + WS_WQ); bf16* skb = (bf16*)(ws + WS_SKB);
    float* logf = (float*)(ws + WS_LOGF); bf16* h = (bf16*)(ws + WS_H);
    const int gw = F.vcu * NWAVES + F.wave, NGW = F.G * NWAVES, lane = F.lane;
    constexpr int I_IN = (DMODEL / 64) * (NG1 / 64), I_OUT = (DMODEL / 64) * (DMODEL / 64), I_Q = (DMODEL / 64) * (QPW / 64);
    constexpr int I_SK = PH * 2 * NKEY * PHALF / 512, I_WAX = 8 * 2 * 2 * 4;
    constexpr int E0 = I_IN, E1 = E0 + I_OUT, E2 = E1 + I_Q, E3 = E2, E4 = E3 + I_SK, E5 = E4, E6 = E5 + I_WAX;
    for (int it = gw; it < E6; it += NGW) {
        if (it < E0) { p0_transpose_item(w_in, INC, NG1 / 64, nullptr, nullptr, DMODEL, win_t, it, lane); continue; }
        if (it < E1) { p0_transpose_item(w_out, DMODEL, DMODEL / 64, gn_l, gn_f, DMODEL, wout_t, it - E0, lane); continue; }
        if (it < E2) { p0_transpose_item(w_q, QPW, QPW / 64, g2, g2 + DMODEL / 2, DMODEL, wq_t, it - E1, lane); continue; }
        if (it < E4) { const size_t i = (size_t)(it - E3) * 512 + lane * 8; const f32x4 s0 = *(const GAS f32x4*)(sk + i), s1 = *(const GAS f32x4*)(sk + i + 4);
            v4u o; o.x = pk2(s0[0], s0[1]); o.y = pk2(s0[2], s0[3]); o.z = pk2(s1[0], s1[1]); o.w = pk2(s1[2], s1[3]);
            { const size_t hp = i >> 14; const int key = (int)(i >> 7) & 127, c8 = (int)(i >> 3) & 15; *(GAS v4u*)(skb + hp * 16384 + ((size_t)((((key >> 5) * 2 + (c8 & 1)) * 8 + (c8 >> 1)) * 32 + (key & 31))) * 8) = o; } continue; }
        { const int f = it - E5, ks = f & 3, n = (f >> 2) & 1, mat = (f >> 3) & 1, hh = f >> 4; const float* wsrc = mat ? a.in[7] : a.in[5];
          const size_t o = ((size_t)(hh * 64 + 16 * ks + 8 * (lane >> 5))) * 64 + 32 * n + (lane & 31);
          v4u pw; pw.x = pk2(wsrc[o], wsrc[o + 64]); pw.y = pk2(wsrc[o + 128], wsrc[o + 192]); pw.z = pk2(wsrc[o + 256], wsrc[o + 320]); pw.w = pk2(wsrc[o + 384], wsrc[o + 448]);
          *(GAS v4u*)((bf16*)(ws + WS_WAX) + (size_t)f * 512 + lane * 8) = pw; }
    }
    { f32x4 gg[4];
#pragma unroll
      for (int j = 0; j < 4; ++j) gg[j] = *(const GAS f32x4*)(g2 + 16 * lane + 4 * j);
      unsigned char* u4 = ws + WS_U8; unsigned char* v4 = ws + WS_V8; float* su = (float*)(ws + WS_SU);
      for (int e = gw; e < NEXP; e += NGW) {
        const GAS f32x4* ur = (const GAS f32x4*)(pu + (size_t)e * DMODEL + 16 * lane); const GAS f32x4* vr = (const GAS f32x4*)(pv + (size_t)e * DMODEL + 16 * lane);
        f32x4 uu[4], vv[4]; float mu = 0.f, mv = 0.f;
#pragma unroll
        for (int j = 0; j < 4; ++j) { uu[j] = ur[j] * gg[j]; vv[j] = vr[j];
#pragma unroll
            for (int c = 0; c < 4; ++c) { mu = fmaxf(mu, fabsf(uu[j][c])); mv = fmaxf(mv, fabsf(vv[j][c])); } }
#pragma unroll
        for (int o = 1; o < 64; o <<= 1) { mu = fmaxf(mu, __shfl_xor(mu, o)); mv = fmaxf(mv, __shfl_xor(mv, o)); }
        const float scu = mu > 0.f ? mu * (1.f / 6.f) : 1.f, scv = mv > 0.f ? mv * (1.f / 6.f) : 1.f, iu = 1.f / scu, iv = 1.f / scv;
        unsigned qu0 = 0u, qu1 = 0u, qv0 = 0u, qv1 = 0u;
#define P0_Q4(Q, X, INV, B0, B1) do { Q = __builtin_amdgcn_cvt_scalef32_pk_fp4_f32(Q, X[0] * INV, X[1] * INV, 1.0f, B0); Q = __builtin_amdgcn_cvt_scalef32_pk_fp4_f32(Q, X[2] * INV, X[3] * INV, 1.0f, B1); } while (0)
        P0_Q4(qu0, uu[0], iu, 0, 1); P0_Q4(qu0, uu[1], iu, 2, 3); P0_Q4(qu1, uu[2], iu, 0, 1); P0_Q4(qu1, uu[3], iu, 2, 3);
        P0_Q4(qv0, vv[0], iv, 0, 1); P0_Q4(qv0, vv[1], iv, 2, 3); P0_Q4(qv1, vv[2], iv, 0, 1); P0_Q4(qv1, vv[3], iv, 2, 3);
#undef P0_Q4
        *(GAS unsigned long long*)(u4 + (size_t)e * 512 + 8 * lane) = (unsigned long long)qu0 | ((unsigned long long)qu1 << 32);
        { unsigned char* vrow = v4 + (size_t)e * 512 + 2 * (lane >> 2);
          *(GAS unsigned short*)(vrow + 32 * (4 * (lane & 3) + 0)) = (unsigned short)(qv0 & 0xffffu); *(GAS unsigned short*)(vrow + 32 * (4 * (lane & 3) + 1)) = (unsigned short)(qv0 >> 16);
          *(GAS unsigned short*)(vrow + 32 * (4 * (lane & 3) + 2)) = (unsigned short)(qv1 & 0xffffu); *(GAS unsigned short*)(vrow + 32 * (4 * (lane & 3) + 3)) = (unsigned short)(qv1 >> 16); }
        if (lane == 0) { su[2 * e] = scu; su[2 * e + 1] = scv; }
      } }
    { f32x4 gg[4];
#pragma unroll
      for (int j = 0; j < 4; ++j) gg[j] = *(const GAS f32x4*)(g1 + 256 * j + 4 * lane);
      float fw[4][4][8];
#pragma unroll
      for (int j = 0; j < 4; ++j)
#pragma unroll
          for (int c = 0; c < 4; ++c) { const int k = 256 * j + 4 * lane + c; const GAS f32x4* wr = (const GAS f32x4*)(w_in + (size_t)k * INC + NG1); const f32x4 w0 = wr[0], w1 = wr[1];
#pragma unroll
              for (int e = 0; e < 4; ++e) { fw[j][c][e] = w0[e]; fw[j][c][4 + e] = w1[e]; } }
      for (int t0 = gw; t0 < T; t0 += 2 * NGW) {
        const int t1 = (t0 + NGW < T) ? t0 + NGW : t0;
        const GAS f32x4* xr0 = (const GAS f32x4*)(x + (size_t)t0 * DMODEL) + lane; const GAS f32x4* xr1 = (const GAS f32x4*)(x + (size_t)t1 * DMODEL) + lane;
        f32x4 va[4], vb[4]; float sa = 0.f, sb = 0.f;
#pragma unroll
        for (int j = 0; j < 4; ++j) { va[j] = xr0[64 * j]; vb[j] = xr1[64 * j]; }
#pragma unroll
        for (int j = 0; j < 4; ++j) { sa += (va[j][0] * va[j][0] + va[j][1] * va[j][1]) + (va[j][2] * va[j][2] + va[j][3] * va[j][3]); sb += (vb[j][0] * vb[j][0] + vb[j][1] * vb[j][1]) + (vb[j][2] * vb[j][2] + vb[j][3] * vb[j][3]); }
        const float ra = rsqrtf(wave_sum(sa) * (1.f / DMODEL) + RMS_EPS), rb = rsqrtf(wave_sum(sb) * (1.f / DMODEL) + RMS_EPS);
        GAS unsigned long long* ha = (GAS unsigned long long*)(h + (size_t)t0 * DMODEL) + lane; GAS unsigned long long* hb = (GAS unsigned long long*)(h + (size_t)t1 * DMODEL) + lane;
#pragma unroll
        for (int j = 0; j < 4; ++j) { va[j] = va[j] * ra * gg[j]; vb[j] = vb[j] * rb * gg[j];
            ha[64 * j] = (unsigned long long)pk2(va[j][0], va[j][1]) | ((unsigned long long)pk2(va[j][2], va[j][3]) << 32);
            hb[64 * j] = (unsigned long long)pk2(vb[j][0], vb[j][1]) | ((unsigned long long)pk2(vb[j][2], vb[j][3]) << 32); }
        float fa[8], fb[8];
#pragma unroll
        for (int hh = 0; hh < 8; ++hh) { fa[hh] = 0.f; fb[hh] = 0.f; }
#pragma unroll
        for (int j = 0; j < 4; ++j)
#pragma unroll
            for (int c = 0; c < 4; ++c) {
#pragma unroll
                for (int hh = 0; hh < 8; ++hh) { fa[hh] += va[j][c] * fw[j][c][hh]; fb[hh] += vb[j][c] * fw[j][c][hh]; } }
        const bool b0 = lane & 1, b1 = lane & 2, b2 = lane & 4;
        float ya[4], yb[4], za[2], zb[2];
#pragma unroll
        for (int j = 0; j < 4; ++j) { ya[j] = (b0 ? fa[j + 4] : fa[j]) + __shfl_xor(b0 ? fa[j] : fa[j + 4], 1); yb[j] = (b0 ? fb[j + 4] : fb[j]) + __shfl_xor(b0 ? fb[j] : fb[j + 4], 1); }
#pragma unroll
        for (int j = 0; j < 2; ++j) { za[j] = (b1 ? ya[j + 2] : ya[j]) + __shfl_xor(b1 ? ya[j] : ya[j + 2], 2); zb[j] = (b1 ? yb[j + 2] : yb[j]) + __shfl_xor(b1 ? yb[j] : yb[j + 2], 2); }
        float resa = (b2 ? za[1] : za[0]) + __shfl_xor(b2 ? za[0] : za[1], 4), resb = (b2 ? zb[1] : zb[0]) + __shfl_xor(b2 ? zb[0] : zb[1], 4);
#pragma unroll
        for (int o = 8; o < 64; o <<= 1) { resa += __shfl_xor(resa, o); resb += __shfl_xor(resb, o); }
        if (lane < 8) { const int hd = 4 * (lane & 1) + (lane & 2) + ((lane >> 2) & 1); logf[(size_t)t0 * 8 + hd] = log_sigmoid(resa + bfv[hd]); logf[(size_t)t1 * 8 + hd] = log_sigmoid(resb + bfv[hd]); }
      } }
}

__device__ __forceinline__ void fcum_unit(Frame& F, int bh, const float* logf, float* fcum) {
    const int b = bh / NHEADS, hh = bh % NHEADS, s0 = F.tid * 16;
    float v[16]; float loc = 0.f;
#pragma unroll
    for (int i = 0; i < 16; ++i) { v[i] = logf[((size_t)b * SEQ + s0 + i) * 8 + hh]; loc += v[i]; }
    float inc = loc;
#pragma unroll
    for (int o = 1; o < 64; o <<= 1) { const float n = __shfl_up(inc, o); if (F.lane >= o) inc += n; }
    if (F.lane == 63) F.MISC[16 + F.wave] = __float_as_uint(inc);
    __syncthreads();
    float run = inc - loc;
    for (int w = 0; w < F.wave; ++w) run += __uint_as_float(F.MISC[16 + w]);
#pragma unroll
    for (int i = 0; i < 16; ++i) { run += v[i]; fcum[(size_t)bh * SEQ + s0 + i] = run; }
    __syncthreads();
}


namespace peer {
typedef unsigned u32;
typedef float f32x16 __attribute__((ext_vector_type(16)));
constexpr int TOK = 128;
constexpr int EX_STRIDE = 136, GT_STRIDE = 136;
constexpr int L_EX = 0, L_GT = L_EX + TOK * EX_STRIDE * 2, L_IDX = L_GT + TOK * GT_STRIDE * 2, IDX_STRIDE = 36, L_RST = L_IDX + 512 * IDX_STRIDE, L_BI = L_RST + TOK * 4, BI_WAVE = 4352, L_END = L_BI + 8 * BI_WAVE;
static_assert(L_END <= RING_BYTES && L_GT % 16 == 0 && L_IDX % 16 == 0, "PEER LDS map");
__device__ __forceinline__ u32 ordmap(float f) { const u32 u = __float_as_uint(f); return u ^ ((u32)((int)u >> 31) | 0x80000000u); }
__device__ __forceinline__ float unordmap(u32 k) { const u32 u = (k & 0x80000000u) ? (k ^ 0x80000000u) : ~k; return __uint_as_float(u); }
__device__ __forceinline__ u32 umin_(u32 a, u32 b) { return a < b ? a : b; }
__device__ __forceinline__ u32 umax_(u32 a, u32 b) { return a > b ? a : b; }
template <bool DESC> __device__ __forceinline__ void sort16(u32 (&k)[16]) {
#define PEER_CE(I, J) do { const u32 a_ = k[I], b_ = k[J], lo_ = umin_(a_, b_), hi_ = umax_(a_, b_); k[I] = DESC ? hi_ : lo_; k[J] = DESC ? lo_ : hi_; } while (0)
    PEER_CE(0, 13); PEER_CE(1, 12); PEER_CE(2, 15); PEER_CE(3, 14); PEER_CE(4, 8); PEER_CE(5, 6); PEER_CE(7, 11); PEER_CE(9, 10);
    PEER_CE(0, 5); PEER_CE(1, 7); PEER_CE(2, 9); PEER_CE(3, 4); PEER_CE(6, 13); PEER_CE(8, 14); PEER_CE(10, 15); PEER_CE(11, 12);
    PEER_CE(0, 1); PEER_CE(2, 3); PEER_CE(4, 5); PEER_CE(6, 8); PEER_CE(7, 9); PEER_CE(10, 11); PEER_CE(12, 13); PEER_CE(14, 15);
    PEER_CE(0, 2); PEER_CE(1, 3); PEER_CE(4, 10); PEER_CE(5, 11); PEER_CE(6, 7); PEER_CE(8, 9); PEER_CE(12, 14); PEER_CE(13, 15);
    PEER_CE(1, 2); PEER_CE(3, 12); PEER_CE(4, 6); PEER_CE(5, 7); PEER_CE(8, 10); PEER_CE(9, 11); PEER_CE(13, 14);
    PEER_CE(1, 4); PEER_CE(2, 6); PEER_CE(5, 8); PEER_CE(7, 10); PEER_CE(9, 13); PEER_CE(11, 14);
    PEER_CE(2, 4); PEER_CE(3, 6); PEER_CE(9, 12); PEER_CE(11, 13);
    PEER_CE(3, 5); PEER_CE(6, 8); PEER_CE(7, 9); PEER_CE(10, 12);
    PEER_CE(3, 4); PEER_CE(5, 6); PEER_CE(7, 8); PEER_CE(9, 10); PEER_CE(11, 12);
    PEER_CE(6, 7); PEER_CE(8, 9);
#undef PEER_CE
}
template <bool DESC> __device__ __forceinline__ void merge16(u32 (&k)[16]) {
#pragma unroll
    for (int stride = 8; stride > 0; stride >>= 1)
#pragma unroll
        for (int i = 0; i < 16; ++i) { const int j = i ^ stride;
            if (j > i) { const u32 a = k[i], b = k[j], lo = umin_(a, b), hi = umax_(a, b); k[i] = DESC ? hi : lo; k[j] = DESC ? lo : hi; } }
}
__host__ __device__ constexpr int ccnt(int a) { return 16 / (a + 1); }
__host__ __device__ constexpr int cbase(int a) { int s = 0; for (int i = 0; i < a; ++i) s += ccnt(i); return s; }
static_assert(cbase(16) == 50, "hyperbola candidate count");
__device__ __forceinline__ int crow16(int r) { return (r & 3) + 8 * (r >> 2); }

__device__ __forceinline__ void route_tile(Frame& F, const bf16* qp, const bf16* skb, const float* sumsq, int t0) {
    int lane = F.lane; asm volatile("" : "+v"(lane));
    const int r32 = lane & 31, hi = lane >> 5, w = F.wave;
    LAS unsigned short* EXL = (LAS unsigned short*)(F.lds + RING_OFF + L_EX);
    LAS unsigned short* GTL = (LAS unsigned short*)(F.lds + RING_OFF + L_GT);
    LAS unsigned char* IDXB = F.lds + RING_OFF + L_IDX + (w * 64 + lane) * IDX_STRIDE;
    LAS float* RST = (LAS float*)(F.lds + RING_OFF + L_RST);
    for (int g = 0; g < 4; ++g) {
        const int tok = 32 * g + r32; const size_t trow = (size_t)(t0 + tok);
        const float rstd2 = rsqrtf(sumsq[trow] * (1.f / DMODEL) + RMS_EPS);
        if (w == 0 && hi == 0) RST[tok] = rstd2;
        u32 s0[16], s1[16];
#pragma unroll
        for (int p = 0; p < 2; ++p) {
            bf16x8 qf[8];
#pragma unroll
            for (int ks = 0; ks < 8; ++ks) qf[ks] = *(const GAS bf16x8*)(qp + ((size_t)((((trow >> 5) * 8 + w) * 2 + p) * 16 + 2 * ks + hi) * 32 + r32) * 8);
            u32 run[16];
#pragma unroll
            for (int nb = 0; nb < 4; ++nb) {
                f32x16 acc = {};
                const bf16* kr = skb + (size_t)(w * 2 + p) * 16384 + ((size_t)((nb * 2 + hi) * 8 * 32 + r32)) * 8;
#pragma unroll
                for (int ks = 0; ks < 8; ++ks) acc = __builtin_amdgcn_mfma_f32_32x32x16_bf16(*(const GAS bf16x8*)(kr + ks * 256), qf[ks], acc, 0, 0, 0);
                asm volatile("" ::: "memory");
                u32 blk[16];
#pragma unroll
                for (int r = 0; r < 16; ++r) blk[r] = (ordmap(acc[r]) & ~0x7Fu) | (u32)(127 - 32 * nb - crow16(r) - 4 * hi);
                if (nb == 0) { sort16<true>(blk);
#pragma unroll
                    for (int i = 0; i < 16; ++i) run[i] = blk[i]; }
                else { sort16<false>(blk);
#pragma unroll
                    for (int i = 0; i < 16; ++i) run[i] = umax_(run[i], blk[i]);
                    merge16<true>(run); }
            }
            u32 oth[16];
#pragma unroll
            for (int i = 0; i < 16; ++i) oth[i] = (u32)__shfl_xor((int)run[15 - i], 32);
#pragma unroll
            for (int i = 0; i < 16; ++i) run[i] = umax_(run[i], oth[i]);
            merge16<true>(run);
#pragma unroll
            for (int i = 0; i < 16; ++i) { if (p == 0) s0[i] = run[i]; else s1[i] = run[i]; }
        }
        { LAS u32* iw = (LAS u32*)IDXB;
#pragma unroll
          for (int j = 0; j < 4; ++j) {
              iw[j] = (127u - (s0[4 * j] & 127u)) | ((127u - (s0[4 * j + 1] & 127u)) << 8) | ((127u - (s0[4 * j + 2] & 127u)) << 16) | ((127u - (s0[4 * j + 3] & 127u)) << 24);
              iw[4 + j] = (127u - (s1[4 * j] & 127u)) | ((127u - (s1[4 * j + 1] & 127u)) << 8) | ((127u - (s1[4 * j + 2] & 127u)) << 16) | ((127u - (s1[4 * j + 3] & 127u)) << 24); } }
        float v1[16], v2[16];
#pragma unroll
        for (int i = 0; i < 16; ++i) { v1[i] = unordmap(s0[i] & ~0x7Fu); v2[i] = unordmap(s1[i] & ~0x7Fu); }
        u32 c0[16], c1[16], c2[16], c3[16];
#pragma unroll
        for (int a = 0; a < 16; ++a)
#pragma unroll
            for (int b = 0; b < ccnt(a); ++b) { const int pos = cbase(a) + b; const u32 key = (ordmap(v1[a] + v2[b]) & ~0xFFu) | (u32)(255 - (a * 16 + b));
                if (pos < 16) c0[pos] = key; else if (pos < 32) c1[pos - 16] = key; else if (pos < 48) c2[pos - 32] = key; else c3[pos - 48] = key; }
#pragma unroll
        for (int i = 2; i < 16; ++i) c3[i] = 0u;
        sort16<false>(c1);
#pragma unroll
        for (int i = 0; i < 16; ++i) c0[i] = umax_(c0[i], c1[i]);
        merge16<true>(c0);
        sort16<false>(c2);
#pragma unroll
        for (int i = 0; i < 16; ++i) c0[i] = umax_(c0[i], c2[i]);
        merge16<true>(c0);
        sort16<false>(c3);
#pragma unroll
        for (int i = 0; i < 16; ++i) c0[i] = umax_(c0[i], c3[i]);
        merge16<true>(c0);
        const float m = unordmap(c0[0] & ~0xFFu) * rstd2;
        float e[8]; float sum = 0.f; u32 ex[8];
#pragma unroll
        for (int k = 0; k < 8; ++k) { const u32 key = hi ? c0[k + 8] : c0[k]; const float ts = unordmap(key & ~0xFFu);
            e[k] = __builtin_amdgcn_exp2f((ts * rstd2 - m) * LOG2E); sum += e[k];
            const u32 flat = 255u - (key & 255u); ex[k] = (u32)IDXB[flat >> 4] * NKEY + (u32)IDXB[16 + (flat & 15u)]; }
        sum += __shfl_xor(sum, 32);
        const float inv = 1.f / sum;
        v4u exw; exw.x = ex[0] | (ex[1] << 16); exw.y = ex[2] | (ex[3] << 16); exw.z = ex[4] | (ex[5] << 16); exw.w = ex[6] | (ex[7] << 16);
        *(LAS v4u*)(EXL + tok * EX_STRIDE + w * 16 + hi * 8) = exw;
        *(LAS v4u*)(GTL + tok * GT_STRIDE + w * 16 + hi * 8) = (v4u){pk2(e[0] * inv, e[1] * inv), pk2(e[2] * inv, e[3] * inv), pk2(e[4] * inv, e[5] * inv), pk2(e[6] * inv, e[7] * inv)};
    }
}
__device__ __forceinline__ float gelu_fast(float x) {
    const float u2 = x * (1.5957691216057308f + 0.07135481627f * x * x);
    return x * __builtin_amdgcn_rcpf(1.f + __builtin_amdgcn_exp2f(-1.4426950408889634f * u2));
}
typedef float f32x2 __attribute__((ext_vector_type(2)));

__device__ __forceinline__ void sort128(u32 (&k)[8], int m) {
#pragma unroll
    for (int K = 2; K <= 128; K <<= 1) {
#pragma unroll
        for (int S = K >> 1; S > 0; S >>= 1) {
            if (S >= 8) {
                const int mm = S >> 3; const bool lower = (m & mm) == 0, up = (K == 128) ? true : ((m & (K >> 3)) == 0), keepmin = (lower == up);
#pragma unroll
                for (int r = 0; r < 8; ++r) { const u32 o = (u32)__shfl_xor((int)k[r], mm); const u32 mn = umin_(k[r], o), mx = umax_(k[r], o); k[r] = keepmin ? mn : mx; }
            } else {
#pragma unroll
                for (int r = 0; r < 8; ++r) { const int r2 = r ^ S;
                    if (r2 > r) { const u32 a = k[r], b = k[r2], mn = umin_(a, b), mx = umax_(a, b);
                        if (K < 8) { const bool up = (r & K) == 0; k[r] = up ? mn : mx; k[r2] = up ? mx : mn; }
                        else { const bool up = (K == 128) ? true : ((m & (K >> 3)) == 0); k[r] = up ? mn : mx; k[r2] = up ? mx : mn; } } }
            }
        }
    }
}
typedef int v8i __attribute__((ext_vector_type(8)));
typedef unsigned u2v __attribute__((ext_vector_type(2)));
__device__ __forceinline__ void eval_mf(Frame& F, const unsigned char* u4, const unsigned char* v4, const float* suv, const float* fg, const bf16* x1b, float* out, int t0) {
    int lane = F.lane; asm volatile("" : "+v"(lane));
    const int g = lane >> 4, m = lane & 15;
    LAS unsigned short* EXL = (LAS unsigned short*)(F.lds + RING_OFF + L_EX);
    LAS unsigned short* GTL = (LAS unsigned short*)(F.lds + RING_OFF + L_GT);
    LAS unsigned char* BI = F.lds + RING_OFF + L_BI + F.wave * BI_WAVE;
    const LAS float* RST = (const LAS float*)(F.lds + RING_OFF + L_RST);
    LAS u32* SKW = (LAS u32*)(F.lds + RING_OFF + L_IDX) + F.wave * 512;
    LAS u32* SK = SKW + g * 128;
    for (int pass = 0; pass < 4; ++pass) {
        const int tb4 = 32 * pass + 4 * F.wave, tok = tb4 + g;
        LAS unsigned short* exr = EXL + tok * EX_STRIDE; LAS unsigned short* gtr = GTL + tok * GT_STRIDE;
        { u32 k[8]; const v4u ev = *(const LAS v4u*)(exr + 8 * m); const u32 s0 = (u32)(8 * m);
          k[0] = ((ev.x & 0xffffu) << 7) | s0; k[1] = ((ev.x >> 16) << 7) | (s0 + 1); k[2] = ((ev.y & 0xffffu) << 7) | (s0 + 2); k[3] = ((ev.y >> 16) << 7) | (s0 + 3);
          k[4] = ((ev.z & 0xffffu) << 7) | (s0 + 4); k[5] = ((ev.z >> 16) << 7) | (s0 + 5); k[6] = ((ev.w & 0xffffu) << 7) | (s0 + 6); k[7] = ((ev.w >> 16) << 7) | (s0 + 7);
          sort128(k, m);
          u32 wv[8];
#pragma unroll
          for (int r = 0; r < 8; ++r) wv[r] = ((k[r] >> 7) << 16) | (u32)gtr[k[r] & 127u];
          *(LAS v4u*)(SK + m * 8) = (v4u){wv[0], wv[1], wv[2], wv[3]}; *(LAS v4u*)(SK + m * 8 + 4) = (v4u){wv[4], wv[5], wv[6], wv[7]};
          *(LAS v4u*)(exr + 8 * m) = (v4u){(k[0] >> 7) | ((k[1] >> 7) << 16), (k[2] >> 7) | ((k[3] >> 7) << 16), (k[4] >> 7) | ((k[5] >> 7) << 16), (k[6] >> 7) | ((k[7] >> 7) << 16)}; }
        asm volatile("" ::: "memory");
        {
#pragma unroll
            for (int tq = 0; tq < 4; ++tq) { const float rq = RST[tb4 + tq]; const bf16* xr = x1b + (size_t)(t0 + tb4 + tq) * DMODEL + 8 * lane;
#pragma unroll
                for (int c = 0; c < 2; ++c) { const v4u xa = *(const GAS v4u*)(xr + 512 * c); int w0 = 0, w1 = 0;
                    w0 = __builtin_amdgcn_cvt_pk_fp8_f32(__uint_as_float(xa.x << 16) * rq, __uint_as_float(xa.x & 0xffff0000u) * rq, w0, false); w0 = __builtin_amdgcn_cvt_pk_fp8_f32(__uint_as_float(xa.y << 16) * rq, __uint_as_float(xa.y & 0xffff0000u) * rq, w0, true);
                    w1 = __builtin_amdgcn_cvt_pk_fp8_f32(__uint_as_float(xa.z << 16) * rq, __uint_as_float(xa.z & 0xffff0000u) * rq, w1, false); w1 = __builtin_amdgcn_cvt_pk_fp8_f32(__uint_as_float(xa.w << 16) * rq, __uint_as_float(xa.w & 0xffff0000u) * rq, w1, true);
                    const int d = 512 * c + 8 * lane, st = d >> 7, dd = d & 127, hh = dd >> 6, e = dd & 63;
                    *(LAS u2v*)(BI + ((st * 4 + tq) * 4 + (e >> 4)) * 32 + hh * 16 + (e & 15)) = (u2v){(u32)w0, (u32)w1}; } }
        }
        asm volatile("" ::: "memory");
        v8i hb[8];
#pragma unroll
        for (int st = 0; st < 8; ++st) { v4u b0 = *(const LAS v4u*)(BI + ((st * 4 + (m & 3)) * 4 + g) * 32), b1 = *(const LAS v4u*)(BI + ((st * 4 + (m & 3)) * 4 + g) * 32 + 16);
            if (m >= 4) { b0 = (v4u){0u, 0u, 0u, 0u}; b1 = b0; }
            hb[st] = (v8i){(int)b0.x, (int)b0.y, (int)b0.z, (int)b0.w, (int)b1.x, (int)b1.y, (int)b1.z, (int)b1.w}; }
        asm volatile("" ::: "memory");
#define PEER_BAR() do { asm volatile("" ::: "memory"); __builtin_amdgcn_sched_barrier(0); } while (0)
#define PEER_LOADU(UA, KQ, SC, I) do { KQ = *(const LAS v4u*)(SK + (I)); _Pragma("unroll") for (int s4 = 0; s4 < 4; ++s4) { const u32 e_ = KQ[s4] >> 16; const u32 ro_ = e_ * 512u + 16u * (u32)m; \
            UA[s4][0] = *(const GAS v4u*)(u4 + ro_); UA[s4][1] = *(const GAS v4u*)(u4 + ro_ + 256); SC[s4] = *(const GAS f32x2*)(suv + 2 * e_); } } while (0)
#define PEER_TRANSP(UA) do { _Pragma("unroll") for (int hf = 0; hf < 2; ++hf) { \
                _Pragma("unroll") for (int s4 = 0; s4 < 4; ++s4) *(LAS v4u*)(BI + (4 * s4 + g) * 272 + 16 * m) = UA[s4][hf]; \
                asm volatile("" ::: "memory"); \
                _Pragma("unroll") for (int st = 0; st < 4; ++st) af[4 * hf + st] = *(const LAS v4u*)(BI + m * 272 + 64 * st + 16 * g); \
                asm volatile("" ::: "memory"); } } while (0)
#define PEER_DOTS(KQ, SC, I) do { f32x4 D = (f32x4){0.f, 0.f, 0.f, 0.f}; \
            _Pragma("unroll") for (int st = 0; st < 8; ++st) { const v8i a8 = (v8i){(int)af[st].x, (int)af[st].y, (int)af[st].z, (int)af[st].w, 0, 0, 0, 0}; \
                D = __builtin_amdgcn_mfma_scale_f32_16x16x128_f8f6f4(a8, hb[st], D, 4, 0, 0, 0x7f7f7f7f, 0, 0x7f7f7f7f); } \
            const int sel = lane & 3; const float mine = sel == 0 ? D[0] : sel == 1 ? D[1] : sel == 2 ? D[2] : D[3]; float act[4]; \
            _Pragma("unroll") for (int s4 = 0; s4 < 4; ++s4) { const float pre = __uint_as_float((unsigned)__builtin_amdgcn_ds_bpermute(4 * (g + 16 * s4), (int)__float_as_uint(mine))); \
                act[s4] = gelu_fast(pre * SC[s4][0]) * (__uint_as_float(KQ[s4] << 16) * SC[s4][1]); } \
            if (m == 0) *(LAS u2v*)(gtr + (I)) = (u2v){pk2(act[0], act[1]), pk2(act[2], act[3])}; } while (0)
        v4u kqA, kqB, uaA[4][2], uaB[4][2], af[8]; f32x2 scA[4], scB[4];
        PEER_LOADU(uaA, kqA, scA, 0);
        for (int i = 0; i < 128; i += 8) {
            PEER_TRANSP(uaA);
            PEER_LOADU(uaB, kqB, scB, i + 4);
            PEER_BAR();
            PEER_DOTS(kqA, scA, i);
            PEER_BAR();
            PEER_TRANSP(uaB);
            PEER_LOADU(uaA, kqA, scA, (i + 8 < 128) ? i + 8 : i + 4);
            PEER_BAR();
            PEER_DOTS(kqB, scB, i + 4);
            PEER_BAR();
        }
    }
    asm volatile("" ::: "memory");
    for (int pass = 0; pass < 4; ++pass) {
        const int tb4 = 32 * pass + 4 * F.wave, tok = tb4 + g;
        const LAS unsigned short* exr = EXL + tok * EX_STRIDE; const LAS unsigned short* acr = GTL + tok * GT_STRIDE;
        f32x2 y[32];
#pragma unroll
        for (int q = 0; q < 32; ++q) y[q] = (f32x2){0.f, 0.f};
        float* xrow = out + (size_t)(t0 + tok) * DMODEL + 4 * m; const bf16* xres = x1b + (size_t)(t0 + tok) * DMODEL + 4 * m;
#define PEER_LOADV(VB, I) do { const u2v e2_ = *(const LAS u2v*)(exr + (I)); _Pragma("unroll") for (int s4 = 0; s4 < 4; ++s4) { const u32 e_ = (s4 & 1) ? (e2_[s4 >> 1] >> 16) : (e2_[s4 >> 1] & 0xffffu); \
            const u32 ro_ = e_ * 512u + 32u * (u32)m; VB[s4][0] = *(const GAS v4u*)(v4 + ro_); VB[s4][1] = *(const GAS v4u*)(v4 + ro_ + 16); } } while (0)
#define PEER_FMAV(VB, I) do { const u2v a2_ = *(const LAS u2v*)(acr + (I)); _Pragma("unroll") for (int s4 = 0; s4 < 4; ++s4) { \
            const float act_ = (s4 & 1) ? __uint_as_float(a2_[s4 >> 1] & 0xffff0000u) : __uint_as_float(a2_[s4 >> 1] << 16); const f32x2 b2_ = (f32x2){act_, act_}; \
            _Pragma("unroll") for (int c = 0; c < 2; ++c) _Pragma("unroll") for (int d = 0; d < 4; ++d) { const unsigned w_ = VB[s4][c][d]; const int hq = 16 * c + 4 * d; \
                y[hq] = __builtin_elementwise_fma(__builtin_amdgcn_cvt_scalef32_pk_f32_fp4(w_, 1.0f, 0), b2_, y[hq]); y[hq + 1] = __builtin_elementwise_fma(__builtin_amdgcn_cvt_scalef32_pk_f32_fp4(w_, 1.0f, 1), b2_, y[hq + 1]); \
                y[hq + 2] = __builtin_elementwise_fma(__builtin_amdgcn_cvt_scalef32_pk_f32_fp4(w_, 1.0f, 2), b2_, y[hq + 2]); y[hq + 3] = __builtin_elementwise_fma(__builtin_amdgcn_cvt_scalef32_pk_f32_fp4(w_, 1.0f, 3), b2_, y[hq + 3]); } } } while (0)
        v4u vbA[4][2], vbB[4][2], vbC[4][2];
        PEER_LOADV(vbA, 0); PEER_LOADV(vbB, 4);
        PEER_BAR();
        for (int i = 0; i < 120; i += 12) {
            PEER_LOADV(vbC, i + 8);  PEER_BAR(); PEER_FMAV(vbA, i);     PEER_BAR();
            PEER_LOADV(vbA, i + 12); PEER_BAR(); PEER_FMAV(vbB, i + 4); PEER_BAR();
            PEER_LOADV(vbB, i + 16); PEER_BAR(); PEER_FMAV(vbC, i + 8); PEER_BAR();
        }
        PEER_FMAV(vbA, 120); PEER_FMAV(vbB, 124);
        float ss = 0.f;
#pragma unroll
        for (int q = 0; q < 16; ++q) { const u2v xa = *(const GAS u2v*)(xres + 64 * q); y[2 * q][0] += __uint_as_float(xa.x << 16); y[2 * q][1] += __uint_as_float(xa.x & 0xffff0000u); y[2 * q + 1][0] += __uint_as_float(xa.y << 16); y[2 * q + 1][1] += __uint_as_float(xa.y & 0xffff0000u);
            ss += (y[2 * q][0] * y[2 * q][0] + y[2 * q][1] * y[2 * q][1]) + (y[2 * q + 1][0] * y[2 * q + 1][0] + y[2 * q + 1][1] * y[2 * q + 1][1]); }
        ss += __shfl_xor(ss, 1); ss += __shfl_xor(ss, 2); ss += __shfl_xor(ss, 4); ss += __shfl_xor(ss, 8);
        const float rs = rsqrtf(ss * (1.f / DMODEL) + RMS_EPS);
        asm volatile("" ::: "memory");
#pragma unroll
        for (int q = 0; q < 16; ++q) { const f32x4 gq = *(const GAS f32x4*)(fg + 64 * q + 4 * m); f32x4 o; o[0] = y[2 * q][0] * rs * gq[0]; o[1] = y[2 * q][1] * rs * gq[1]; o[2] = y[2 * q + 1][0] * rs * gq[2]; o[3] = y[2 * q + 1][1] * rs * gq[3];
            *(GAS f32x4*)(xrow + 64 * q) = o; }
    }
}
__device__ __forceinline__ void peer_phase(Frame& F, const Args& a) {
    unsigned char* ws = a.ws;
    for (int tile = F.vcu; tile < T / TOK; tile += F.G) {
        route_tile(F, (const bf16*)(ws + WS_QP), (const bf16*)(ws + WS_SKB), (const float*)(ws + WS_SUMSQ), tile * TOK);
        __syncthreads();
        eval_mf(F, ws + WS_U8, ws + WS_V8, (const float*)(ws + WS_SU), a.in[19], (const bf16*)(ws + WS_X1B), a.out, tile * TOK);
        __syncthreads();
    }
}
}

namespace lru {
typedef float f32x16 __attribute__((ext_vector_type(16)));
constexpr int TOKT = 128, NTILE = SEQ / TOKT;
constexpr int WAVE_LDS = 14336, L_XS = 0, L_XC = 4608, L_GS = 9216, XC_STRIDE = 72  , L_SS = 8 * WAVE_LDS;
static_assert(L_SS + 32 * 8 * 4 <= RING_BYTES, "LRU LDS map");
__device__ __forceinline__ float bf2f(unsigned short h) { return __uint_as_float((unsigned)h << 16); }
__device__ __forceinline__ int crow16(int r) { return (r & 3) + 8 * (r >> 2); }
__device__ __forceinline__ float sigm(float x) { return __builtin_amdgcn_rcpf(1.f + __builtin_amdgcn_exp2f(-LOG2E * x)); }

template <bool FINAL> __device__ __forceinline__ void lru_tile(Frame& F, const Args& args, int tile) {
    int lane = F.lane; asm volatile("" : "+v"(lane));
    const int w = F.wave, j32 = lane & 31, hi = lane >> 5;
    unsigned char* ws = args.ws;
    const bf16* xr = (const bf16*)(ws + WS_XR); const bf16* gr = (const bf16*)(ws + WS_GR); float* carry = (float*)(ws + WS_CARRY);
    const float* cw = args.in[3]; const float* cb = args.in[4]; const float* ba = args.in[6]; const float* bx = args.in[8]; const float* lam = args.in[9];
    const int b = tile / NTILE, jt = tile % NTILE; const size_t trow0 = (size_t)b * SEQ + (size_t)jt * TOKT;
    LAS unsigned char* wl = F.lds + RING_OFF + w * WAVE_LDS;
    LAS unsigned short* XS = (LAS unsigned short*)(wl + L_XS); LAS unsigned short* XC = (LAS unsigned short*)(wl + L_XC); LAS unsigned short* GS = (LAS unsigned short*)(wl + L_GS);
    LAS float* SS = (LAS float*)(F.lds + RING_OFF + L_SS);
    float c_ba[2], c_bx[2], c_sp[2], c_cb[2], c_cw[2][4];
#pragma unroll
    for (int n = 0; n < 2; ++n) { const int c = 64 * w + 32 * n + j32; c_ba[n] = ba[c]; c_bx[n] = bx[c]; c_cb[n] = cb[c];
        const float l = lam[c]; c_sp[n] = 8.f * LOG2E * (fmaxf(-l, 0.f) + log1pf(expf(-fabsf(l))));
#pragma unroll
        for (int k = 0; k < 4; ++k) c_cw[n][k] = cw[k * LW + c]; }
    const bf16* wax = (const bf16*)(ws + WS_WAX);
    float hc[2] = {0.f, 0.f}, ap[2] = {1.f, 1.f};
    if (FINAL) { const float* cin = (const float*)(ws + WS_CIN) + (size_t)(b * NTILE + jt) * LW + 64 * w + j32; hc[0] = cin[0]; hc[1] = cin[32]; }
    v4u pfx[5], pfg[4], pce[2][2], pcu[2][2];
    unsigned char* cacheE = ws + WS_LA + ((size_t)(tile * 8 + w) * 4) * 4096; unsigned char* cacheU = ws + WS_LU + ((size_t)(tile * 8 + w) * 4) * 4096;
#define LRU_FETCH(B) do { const size_t tbn_ = trow0 + (B) * 32; \
        if (!FINAL) { _Pragma("unroll") for (int q_ = 0; q_ < 5; ++q_) { const int pc_ = lane + 64 * q_, row_ = pc_ >> 3, c8_ = pc_ & 7; \
            const bool z_ = (jt == 0 && (B) == 0 && row_ < 3) || pc_ >= 35 * 8; const v4u v_ = *(const GAS v4u*)(xr + (tbn_ + (z_ ? 3 : row_) - 3) * LW + w * 64 + c8_ * 8); pfx[q_] = z_ ? (v4u){0u, 0u, 0u, 0u} : v_; } } \
        if (FINAL) { _Pragma("unroll") for (int q_ = 0; q_ < 4; ++q_) { const int pc_ = lane + 64 * q_; pfg[q_] = *(const GAS v4u*)(gr + (tbn_ + (pc_ >> 3)) * LW + w * 64 + (pc_ & 7) * 8); } \
            _Pragma("unroll") for (int n_ = 0; n_ < 2; ++n_) _Pragma("unroll") for (int h_ = 0; h_ < 2; ++h_) { const size_t o_ = (size_t)(B) * 4096 + n_ * 2048 + h_ * 1024 + lane * 16; \
                pce[n_][h_] = *(const GAS v4u*)(cacheE + o_); pcu[n_][h_] = *(const GAS v4u*)(cacheU + o_); } } } while (0)
    LRU_FETCH(0);
    for (int blk = 0; blk < 4; ++blk) {
        const size_t tb = trow0 + blk * 32;
        int ln = lane; asm volatile("" : "+v"(ln));
        const int k32 = ln & 31;
        if (!FINAL) {
#pragma unroll
            for (int q = 0; q < 5; ++q) { const int pc = ln + 64 * q; if (pc < 35 * 8) *(LAS v4u*)((LAS unsigned char*)XS + (pc >> 3) * 128 + (pc & 7) * 16) = pfx[q]; } }
        v4u ce[2][2], cu[2][2];
        if (FINAL) {
#pragma unroll
            for (int n = 0; n < 2; ++n)
#pragma unroll
                for (int h = 0; h < 2; ++h) { ce[n][h] = pce[n][h]; cu[n][h] = pcu[n][h]; }
#pragma unroll
            for (int q = 0; q < 4; ++q) { const int pc = ln + 64 * q; *(LAS v4u*)((LAS unsigned char*)GS + (pc >> 3) * 128 + (pc & 7) * 16) = pfg[q]; } }
        if (blk < 3) { LRU_FETCH(blk + 1); }
        asm volatile("" ::: "memory");
        float xc[2][16];
        bf16x8 af[4];
        if (!FINAL) {
#pragma unroll
        for (int n = 0; n < 2; ++n)
#pragma unroll
            for (int g = 0; g < 4; ++g) { float xv[7];
#pragma unroll
                for (int q = 0; q < 7; ++q) xv[q] = bf2f(XS[(8 * g + 4 * hi + q) * 64 + 32 * n + j32]);
#pragma unroll
                for (int e = 0; e < 4; ++e) xc[n][4 * g + e] = c_cb[n] + ((c_cw[n][0] * xv[e] + c_cw[n][1] * xv[e + 1]) + (c_cw[n][2] * xv[e + 2] + c_cw[n][3] * xv[e + 3])); }
#pragma unroll
        for (int n = 0; n < 2; ++n)
#pragma unroll
            for (int r = 0; r < 16; ++r) XC[(crow16(r) + 4 * hi) * XC_STRIDE + 32 * n + j32] = (unsigned short)f2bf(xc[n][r]);
        asm volatile("" ::: "memory");
#pragma unroll
        for (int ks = 0; ks < 4; ++ks) af[ks] = *(const LAS bf16x8*)(XC + j32 * XC_STRIDE + 16 * ks + 8 * hi);
        asm volatile("" ::: "memory");
        }
        float yv[2][16];
#pragma unroll
        for (int n = 0; n < 2; ++n) {
            float av[16], uv[16];
            if (!FINAL) {
            f32x16 R = {}, I = {};
            bf16x8 fa[4], fx[4];
#pragma unroll
            for (int ks = 0; ks < 4; ++ks) { fa[ks] = *(const GAS bf16x8*)(wax + (size_t)(((w * 2 + 0) * 2 + n) * 4 + ks) * 512 + ln * 8); fx[ks] = *(const GAS bf16x8*)(wax + (size_t)(((w * 2 + 1) * 2 + n) * 4 + ks) * 512 + ln * 8); }
#pragma unroll
            for (int ks = 0; ks < 4; ++ks) { R = __builtin_amdgcn_mfma_f32_32x32x16_bf16(af[ks], fa[ks], R, 0, 0, 0); I = __builtin_amdgcn_mfma_f32_32x32x16_bf16(af[ks], fx[ks], I, 0, 0, 0); }
            unsigned we[8], wu[8];
#pragma unroll
            for (int k = 0; k < 8; ++k) { const float e0 = sigm(R[2 * k] + c_ba[n]) * c_sp[n], e1 = sigm(R[2 * k + 1] + c_ba[n]) * c_sp[n]; we[k] = pg8::cvt_pk_bf16(e0, e1);
                const float a0 = __builtin_amdgcn_exp2f(-__uint_as_float(we[k] << 16)), a1 = __builtin_amdgcn_exp2f(-__uint_as_float(we[k] & 0xffff0000u));
                const float u0 = __builtin_amdgcn_sqrtf(fmaxf(1.f - a0 * a0, 0.f)) * (sigm(I[2 * k] + c_bx[n]) * xc[n][2 * k]), u1 = __builtin_amdgcn_sqrtf(fmaxf(1.f - a1 * a1, 0.f)) * (sigm(I[2 * k + 1] + c_bx[n]) * xc[n][2 * k + 1]);
                wu[k] = pg8::cvt_pk_bf16(u0, u1);
                av[2 * k] = a0; av[2 * k + 1] = a1; uv[2 * k] = __uint_as_float(wu[k] << 16); uv[2 * k + 1] = __uint_as_float(wu[k] & 0xffff0000u); }
            { const size_t o = (size_t)blk * 4096 + n * 2048 + ln * 16;
              *(GAS v4u*)(cacheE + o) = (v4u){we[0], we[1], we[2], we[3]}; *(GAS v4u*)(cacheE + o + 1024) = (v4u){we[4], we[5], we[6], we[7]};
              *(GAS v4u*)(cacheU + o) = (v4u){wu[0], wu[1], wu[2], wu[3]}; *(GAS v4u*)(cacheU + o + 1024) = (v4u){wu[4], wu[5], wu[6], wu[7]}; }
            } else {
#pragma unroll
                for (int k = 0; k < 8; ++k) { const unsigned e2 = ce[n][k >> 2][k & 3], u2 = cu[n][k >> 2][k & 3];
                    av[2 * k] = __builtin_amdgcn_exp2f(-__uint_as_float(e2 << 16)); av[2 * k + 1] = __builtin_amdgcn_exp2f(-__uint_as_float(e2 & 0xffff0000u));
                    uv[2 * k] = __uint_as_float(u2 << 16); uv[2 * k + 1] = __uint_as_float(u2 & 0xffff0000u); }
            }
            float Ar[4], Hr[4], hst[4];
#pragma unroll
            for (int g = 0; g < 4; ++g) { Ar[g] = (av[4 * g] * av[4 * g + 1]) * (av[4 * g + 2] * av[4 * g + 3]);
                Hr[g] = ((uv[4 * g] * av[4 * g + 1] + uv[4 * g + 1]) * av[4 * g + 2] + uv[4 * g + 2]) * av[4 * g + 3] + uv[4 * g + 3]; }
            float hin = hc[n];
#pragma unroll
            for (int g = 0; g < 4; ++g) { float o1 = Ar[g] * hin + Hr[g]; const float x = __shfl_xor(o1, 32); const float hg = hi ? x : hin; o1 = Ar[g] * hg + Hr[g]; hst[g] = hg;
                const float y = __shfl_xor(o1, 32); hin = hi ? o1 : y;
                if (!FINAL) ap[n] *= Ar[g] * __shfl_xor(Ar[g], 32); }
            hc[n] = hin;
            if (FINAL) {
#pragma unroll
                for (int g = 0; g < 4; ++g) { float h = hst[g];
#pragma unroll
                    for (int e = 0; e < 4; ++e) { const int r = 4 * g + e; h = av[r] * h + uv[r]; yv[n][r] = h * bf2f(GS[(crow16(r) + 4 * hi) * 64 + 32 * n + j32]); } } }
        }
        if (FINAL) {
#pragma unroll
            for (int r = 0; r < 16; ++r) { float s = yv[0][r] * yv[0][r] + yv[1][r] * yv[1][r];
                s += __shfl_xor(s, 1); s += __shfl_xor(s, 2); s += __shfl_xor(s, 4); s += __shfl_xor(s, 8); s += __shfl_xor(s, 16);
                if (j32 == 0) SS[(crow16(r) + 4 * hi) * 8 + w] = s; }
            __syncthreads();
            bf16* ymix = (bf16*)(ws + WS_H);
#pragma unroll
            for (int r = 0; r < 16; ++r) { const int tk = crow16(r) + 4 * hi; const f32x4 s0 = *(const LAS f32x4*)(SS + tk * 8), s1 = *(const LAS f32x4*)(SS + tk * 8 + 4);
                const float rstd = rsqrtf(((s0[0] + s0[1]) + (s0[2] + s0[3]) + (s1[0] + s1[1]) + (s1[2] + s1[3])) * (1.f / LW) + RMS_EPS);
                bf16* yp = ymix + (tb + tk) * DMODEL + 64 * w + k32;
                yp[0] = (bf16)f2bf(yv[0][r] * rstd); yp[32] = (bf16)f2bf(yv[1][r] * rstd); }
            __syncthreads();
        }
    }
#undef LRU_FETCH
    if (!FINAL) { if (hi == 0) { float* cp = carry + ((size_t)(b * NTILE + jt) * 2) * LW + 64 * w + j32;
#pragma unroll
        for (int n = 0; n < 2; ++n) { cp[32 * n] = ap[n]; cp[LW + 32 * n] = hc[n]; } } }
    else {
        const bf16* ob = (const bf16*)(ws + WS_O); bf16* ymix = (bf16*)(ws + WS_H);
        for (int i0 = 0; i0 < 16; i0 += 4) {
            v4u vv[4];
#pragma unroll
            for (int i = 0; i < 4; ++i) vv[i] = *(const GAS v4u*)(ob + (trow0 + 16 * w + i0 + i) * AW + 8 * lane);
            float ssq[4];
#pragma unroll
            for (int i = 0; i < 4; ++i) { float s = 0.f;
#pragma unroll
                for (int c = 0; c < 4; ++c) { const float lo = __uint_as_float(vv[i][c] << 16), hi2 = __uint_as_float(vv[i][c] & 0xffff0000u); s += lo * lo + hi2 * hi2; }
                ssq[i] = s; }
#pragma unroll
            for (int o = 1; o < 64; o <<= 1) {
#pragma unroll
                for (int i = 0; i < 4; ++i) ssq[i] += __shfl_xor(ssq[i], o); }
#pragma unroll
            for (int i = 0; i < 4; ++i) { const float rstd = rsqrtf(ssq[i] * (1.f / AW) + RMS_EPS); v4u o;
#pragma unroll
                for (int c = 0; c < 4; ++c) o[c] = pk2(__uint_as_float(vv[i][c] << 16) * rstd, __uint_as_float(vv[i][c] & 0xffff0000u) * rstd);
                *(GAS v4u*)(ymix + (trow0 + 16 * w + i0 + i) * DMODEL + LW + 8 * lane) = o; } }
    }
}
__device__ __forceinline__ void norm_pass(Frame& F, const Args& a) {
    unsigned char* ws = a.ws; float* nrm = (float*)(ws + WS_NRM); const float* rn2 = (const float*)(ws + WS_RN2);
    const int gw = F.vcu * NWAVES + F.wave, NGW = F.G * NWAVES, lane = F.lane;
    for (int it = gw; it < 2 * BATCH * (SEQ / 64); it += NGW) {
        const int which = it / (BATCH * (SEQ / 64)), r = it % (BATCH * (SEQ / 64)), b = r / (SEQ / 64), t = r % (SEQ / 64);
        const float* src = rn2 + ((size_t)which * (T / 16) + (size_t)(b * SEQ + 64 * t) / 16) * 256 + lane;
        float v[16];
#pragma unroll
        for (int i = 0; i < 16; ++i) v[i] = src[64 * i];
        float mx[4] = {0.f, 0.f, 0.f, 0.f};
#pragma unroll
        for (int i = 0; i < 16; ++i) mx[i & 3] = fmaxf(mx[i & 3], v[i] + __shfl_xor(v[i], 16));
#pragma unroll
        for (int o = 1; o < 16; o <<= 1) {
#pragma unroll
            for (int j = 0; j < 4; ++j) mx[j] = fmaxf(mx[j], __shfl_xor(mx[j], o)); }
        if ((lane & 31) == 0) {
#pragma unroll
            for (int j = 0; j < 4; ++j) nrm[which * 4096 + (b * NHEADS + (lane >> 5) + 2 * j) * 128 + t] = sqrtf(mx[j]) * 1.0001f; }
    }
}
__device__ __forceinline__ void carry_prefix(Frame& F, const Args& a, int b) {
    const float* carry = (const float*)(a.ws + WS_CARRY) + (size_t)b * NTILE * 2 * LW + F.tid; float* cin = (float*)(a.ws + WS_CIN) + (size_t)b * NTILE * LW + F.tid;
    float c = 0.f;
    for (int j0 = 0; j0 < NTILE; j0 += 8) { float A[8], H[8];
#pragma unroll
        for (int j = 0; j < 8; ++j) { A[j] = carry[(size_t)(j0 + j) * 2 * LW]; H[j] = carry[(size_t)(j0 + j) * 2 * LW + LW]; }
#pragma unroll
        for (int j = 0; j < 8; ++j) { cin[(size_t)(j0 + j) * LW] = c; c = A[j] * c + H[j]; } }
}
template <bool FINAL> __device__ __forceinline__ void lru_phase(Frame& F, const Args& a) {
    for (int tile = F.vcu; tile < BATCH * NTILE; tile += F.G) { lru_tile<FINAL>(F, a, tile); __syncthreads(); }
}
}
__global__ void __launch_bounds__(NWAVES * 64, 2) mk_fwd(Args args) {
    extern __shared__ __attribute__((aligned(16))) unsigned char lds[];
    Frame F;
    F.lds = (LAS unsigned char*)lds;
    F.MISC = (volatile LAS unsigned*)(F.lds + MISC_OFF);
    F.wave = __builtin_amdgcn_readfirstlane((int)threadIdx.x >> 6); F.lane = (int)__builtin_amdgcn_mbcnt_hi(~0u, __builtin_amdgcn_mbcnt_lo(~0u, 0u)); F.tid = F.wave * 64 + F.lane;
    F.G = gridDim.x; { const int bx = blockIdx.x; F.vcu = (F.G % 8 == 0) ? (bx % 8) * (F.G / 8) + bx / 8 : bx; }
    unsigned char* ws = args.ws;
    F.ctl = (gu32*)(ws + WS_CTL);
    for (int u = F.tid; u < (LDS_BYTES - LDSCTL_OFF) / 4; u += NWAVES * 64) ((LAS unsigned*)(F.lds + LDSCTL_OFF))[u] = 0u;
    __syncthreads();
    XcdBarrier bar = xcd_barrier_post((unsigned*)(F.ctl + CW_BAR) + args.li * XCD_BAR_WORDS, F.MISC + 8, F.wave);
    const int lo = args.ph_lo, hi = args.ph_hi;
#define IN(k) (lo <= (k) && (k) < hi)
#define BOTH(k) (IN(k) && IN((k) + 1))
#define GRID_BAR() xcd_barrier(bar)

    if (IN(0)) { p0_prologue(F, args); if (BOTH(0)) GRID_BAR(); }

    if (IN(1)) {
        if (F.vcu < BATCH * NHEADS) fcum_unit(F, F.vcu, (const float*)(ws + WS_LOGF), (float*)(ws + WS_FCUM));
        pg8::Gemm g{(const pg8::bf16_t*)(ws + WS_H), (const pg8::bf16_t*)(ws + WS_WIN), T, NG1, DMODEL}; pg8::StaticOrder S; S.init(T, NG1, F.G, (int)blockIdx.x, 4);
        pg8::EpiG1 E{(pg8::bf16_t*)(ws + WS_XR), SPLIT_STRIDE, QSCALE, (float*)(ws + WS_RN2)};
        pg8::gemm_phase<pg8::EpiG1, pg8::StaticOrder, true, true>(F.lds + RING_OFF, g, S, E, F.wave);
        if (BOTH(1)) GRID_BAR();
    }
    if (IN(2)) { lru::lru_phase<false>(F, args); lru::norm_pass(F, args); if (BOTH(2)) GRID_BAR(); }
    if (IN(3)) {
        static_assert(attn_body::ATTN_LDS_BYTES <= RING_BYTES, "attention LDS vs frame");
        if (F.vcu < BATCH) lru::carry_prefix(F, args, F.vcu);
        const attn_body::AttnTensors AT{(const attn_body::bf16*)(ws + WS_Q), (const attn_body::bf16*)(ws + WS_K), (const attn_body::bf16*)(ws + WS_V), (attn_body::bf16*)(ws + WS_O), (const float*)(ws + WS_FCUM), (const float*)(ws + WS_NRM)};
        attn_body::attn_phase<8>((char*)lds + RING_OFF, AT, (unsigned*)(F.ctl + CW_ATTQ), F.MISC + 24, F.wave);
        if (BOTH(3)) GRID_BAR();
    }
    if (IN(4)) { lru::lru_phase<true>(F, args); if (BOTH(4)) GRID_BAR(); }
    if (IN(5)) {
        pg8::Gemm g{(const pg8::bf16_t*)(ws + WS_H), (const pg8::bf16_t*)(ws + WS_WOUT), T, DMODEL, DMODEL}; pg8::StaticOrder S; S.init(T, DMODEL, F.G, (int)blockIdx.x, 8);
        pg8::EpiG2 E{args.in[0], (pg8::bf16_t*)(ws + WS_X1B), (float*)(ws + WS_SUMSQ), DMODEL};
        pg8::gemm_phase<pg8::EpiG2, pg8::StaticOrder, true, true>(F.lds + RING_OFF, g, S, E, F.wave);
        if (BOTH(5)) GRID_BAR();
    }
    if (IN(6)) {
        pg8::Gemm g{(const pg8::bf16_t*)(ws + WS_X1B), (const pg8::bf16_t*)(ws + WS_WQ), T, QPW, DMODEL}; pg8::StaticOrder S; S.init(T, QPW, F.G, (int)blockIdx.x, 8);
        pg8::EpiG3 E{(pg8::bf16_t*)(ws + WS_QP), QPW};
        pg8::gemm_phase<pg8::EpiG3, pg8::StaticOrder, true, true>(F.lds + RING_OFF, g, S, E, F.wave);
        if (BOTH(6)) GRID_BAR();
    }
    if (IN(7)) { peer::peer_phase(F, args); }
#undef IN
#undef BOTH
#undef GRID_BAR
}

extern "C" void kernel_launch(void* const* d_in, const int* in_sizes, int n_in, void* d_out, int out_size, void* d_ws, size_t ws_size, hipStream_t stream) {
    static int grid = 0;
    if (grid == 0) {
        if (n_in != 20 || in_sizes[0] != T * DMODEL || out_size != T * DMODEL || ws_size < WS_END) { fprintf(stderr, "kernel_launch: unexpected shapes (n_in %d, ws %zu)\n", n_in, ws_size); grid = -1; return; }
        int dev = 0, cus = 0;
        if (hipGetDevice(&dev) != hipSuccess || hipDeviceGetAttribute(&cus, hipDeviceAttributeMultiprocessorCount, dev) != hipSuccess) { grid = -1; return; }
        if (hipFuncSetAttribute((const void*)mk_fwd, hipFuncAttributeMaxDynamicSharedMemorySize, LDS_BYTES) != hipSuccess) { fprintf(stderr, "kernel_launch: hipFuncSetAttribute failed\n"); grid = -1; return; }
        (void)hipGetLastError();
        grid = cus;
    }
    if (grid < 0) return;
    if (hipMemsetAsync((char*)d_ws + WS_CTL, 0, CTL_ZERO_BYTES, stream) != hipSuccess) return;
    Args a{};
    for (int i = 0; i < 20; ++i) a.in[i] = (const float*)d_in[i];
    a.out = (float*)d_out; a.ws = (unsigned char*)d_ws; a.ph_lo = 0; a.ph_hi = N_PHASES; a.li = 0;
    hipLaunchKernelGGL(mk_fwd, dim3(grid), dim3(NWAVES * 64), LDS_BYTES, stream, a);
}
```

```cpp
#include <hip/hip_runtime.h>
#include <hip/hip_bf16.h>
#include <cstdio>
#include <cstdint>
#include <cmath>

constexpr int BATCH = 4, SEQ = 8192, DMODEL = 1024, T = BATCH * SEQ;
constexpr int LW = 512, AW = 512, NHEADS = 8, HD = 64, INC = 2568, NG1 = 2560;
constexpr int PH = 8, NKEY = 128, PHALF = 128, TOPK = 16, NEXP = NKEY * NKEY, QPW = 2048;
constexpr float RMS_EPS = 1e-6f;
constexpr float LOG2E = 1.4426950408889634f;
constexpr float QSCALE = 0.125f * LOG2E;
constexpr size_t MiB = 1u << 20;
constexpr size_t WS_CTL = 0, CTL_ZERO_BYTES = 1 * MiB, WS_RN2 = 24 * MiB  ;
constexpr size_t WS_WIN = 2 * MiB, WS_WOUT = 8 * MiB, WS_WQ = 10 * MiB, WS_SKB = 14 * MiB, WS_WFL = 15 * MiB,
                 WS_LOGF = 16 * MiB, WS_FCUM = 17 * MiB, WS_CARRY = 18 * MiB, WS_SUMSQ = 512 * 1024  , WS_WAX = 20 * MiB, WS_CIN = 23 * MiB  , WS_NRM = 22 * MiB  ,
                 WS_H = 32 * MiB, WS_XR = 96 * MiB, WS_GR = 128 * MiB, WS_Q = 160 * MiB, WS_K = 192 * MiB, WS_V = 224 * MiB,
                 WS_X1B = 256 * MiB, WS_O = 256 * MiB  , WS_QP = 96 * MiB, WS_UT = 320 * MiB, WS_VT = 352 * MiB, WS_U8 = 320 * MiB, WS_V8 = 336 * MiB, WS_SU = 21 * MiB, WS_SV = 21 * MiB + 65536, WS_LA = 384 * MiB, WS_LU = 448 * MiB, WS_END = 512 * MiB;
constexpr size_t SPLIT_STRIDE = (WS_GR - WS_XR) / 2;
constexpr int CW_TMO = 0, CW_ATTQ = 2048, CW_BAR = 4096;

namespace pg8 {
constexpr int BATCH_T = 4 * 8192;
#define PG8_LAS __attribute__((address_space(3)))
typedef unsigned short bf16_t;
typedef short bf16x8 __attribute__((ext_vector_type(8)));
typedef float f32x4 __attribute__((ext_vector_type(4)));
typedef unsigned u32x4 __attribute__((ext_vector_type(4)));
constexpr int BM = 256, BK = 64, HALF = 128, HTB = HALF * BK * 2  , STAGE_BYTES = 8 * HTB, NXCD = 8, WGM = 8;

__host__ __device__ __forceinline__ int lds_byte(int r, int c) { const int st = (r >> 4) * 2 + (c >> 5), rr = r & 15, cc = c & 31, ob = rr * 64 + cc * 2; return st * 1024 + (ob ^ (((ob >> 9) & 1) << 5)); }
__host__ __device__ __forceinline__ void stage_rc(int b, int& R, int& C) { const int st = b / 1024, sb = b % 1024, swz = sb ^ (((sb >> 9) & 1) << 5); R = (st >> 1) * 16 + swz / 64; C = (st & 1) * 32 + (swz % 64) / 2; }
__host__ __device__ __forceinline__ int perm32(int rho) { const int n = rho >> 4, i = rho & 15; return 8 * (i >> 2) + 4 * n + (i & 3); }

struct Unit { int pm, pn; };
struct Gemm { const bf16_t* A; const bf16_t* Bt; int M, N, K; };

struct StaticOrder {
    int nM, nN, nwg, G, c;
    __host__ __device__ void init(int M, int N, int G_, int c_) { nM = M / BM; nN = N / BM; nwg = nM * nN; G = G_; c = c_; }
    __host__ __device__ bool next(int i, Unit& u) const {
        const long L = (long)i * G + c; if (L >= nwg) return false;
        int wgid = (int)L; { const int q = nwg / NXCD, r = nwg % NXCD, xcd = wgid % NXCD, off = wgid / NXCD; wgid = (xcd < r ? xcd * (q + 1) : r * (q + 1) + (xcd - r) * q) + off; }
        const int nig = WGM * nN, gid = wgid / nig, fm = gid * WGM, gsz = (nM - fm) < WGM ? (nM - fm) : WGM;
        u.pm = fm + ((wgid % nig) % gsz); u.pn = (wgid % nig) / gsz; return true;
    }
    __device__ __forceinline__ void a_ready(const Unit&) const {}
    __device__ __forceinline__ void done(const Unit&) const {}
};

__device__ __forceinline__ unsigned cvt_pk_bf16(float lo, float hi) { unsigned r; asm volatile("v_cvt_pk_bf16_f32 %0, %1, %2" : "=v"(r) : "v"(lo), "v"(hi)); return r; }
typedef unsigned u32x2 __attribute__((ext_vector_type(2)));
__device__ __forceinline__ float gelu_fast(float x) {
    const float u2 = x * (1.5957691216057308f + 0.07135481627f * x * x);
    return x * __builtin_amdgcn_rcpf(1.f + __builtin_amdgcn_exp2f(-1.4426950408889634f * u2));
}
struct EpiG1 {
    static constexpr bool PERM = true, AFTER_DRAIN = false;
    bf16_t* base0; size_t split_stride; float qscale; float* rn2;
    __device__ __forceinline__ void operator()(const f32x4 (&acc)[2][2][4][2], const Unit& u, int wr, int wc, int fr, int fq) const {
        const int s = u.pn >> 1; bf16_t* base = base0 + (size_t)s * split_stride;
        const int row0 = u.pm * BM + wr * 64 + fr, col0 = (u.pn & 1) * 256 + wc * 32 + 8 * fq;
#pragma unroll
        for (int ai = 0; ai < 2; ++ai)
#pragma unroll
            for (int m = 0; m < 4; ++m) { bf16_t* rowp = base + (size_t)(row0 + ai * HALF + m * 16) * 512 + col0;
#pragma unroll
                for (int bj = 0; bj < 2; ++bj) { f32x4 v0 = acc[ai][bj][m][0], v1 = acc[ai][bj][m][1];
                    if (s == 1) {
#pragma unroll
                        for (int e = 0; e < 4; ++e) { v0[e] = gelu_fast(v0[e]); v1[e] = gelu_fast(v1[e]); } }
                    else if (s == 2) { v0 = v0 * qscale; v1 = v1 * qscale; }
                    u32x4 w; w.x = cvt_pk_bf16(v0[0], v0[1]); w.y = cvt_pk_bf16(v0[2], v0[3]); w.z = cvt_pk_bf16(v1[0], v1[1]); w.w = cvt_pk_bf16(v1[2], v1[3]);
                    *(u32x4*)(rowp + bj * HALF) = w;
                    if (s == 2 || s == 3) {
                        float ss = 0.f;
#pragma unroll
                        for (int e = 0; e < 4; ++e) { const float lo = __uint_as_float(w[e] << 16), hi = __uint_as_float(w[e] & 0xffff0000u); ss += lo * lo + hi * hi; }
                        ss += __shfl_xor(ss, 16); ss += __shfl_xor(ss, 32);
                        if (fq == 0) { const int row = row0 + ai * HALF + m * 16; rn2[(((size_t)(s - 2) * (size_t)(BATCH_T / 16) + (size_t)(row >> 4)) * 16 + ((u.pn & 1) * 8 + bj * 4 + wc)) * 16 + (row & 15)] = ss; } } } }
    }
};
struct EpiG2 {
    static constexpr bool PERM = true, AFTER_DRAIN = false;
    const float* resid; bf16_t* xb; float* sumsq; int ldc;
    __device__ __forceinline__ void operator()(const f32x4 (&acc)[2][2][4][2], const Unit& u, int wr, int wc, int fr, int fq) const {
        const int row0 = u.pm * BM + wr * 64 + fr, col0 = u.pn * BM + wc * 32 + 8 * fq;
#pragma unroll
        for (int ai = 0; ai < 2; ++ai) {
            f32x4 rs[4][2][2];
#pragma unroll
            for (int m = 0; m < 4; ++m) { const size_t off = (size_t)(row0 + ai * HALF + m * 16) * ldc + col0;
#pragma unroll
                for (int bj = 0; bj < 2; ++bj)
#pragma unroll
                    for (int n = 0; n < 2; ++n) rs[m][bj][n] = *(const f32x4*)(resid + off + bj * HALF + n * 4); }
#pragma unroll
            for (int m = 0; m < 4; ++m) { const int r = row0 + ai * HALF + m * 16; const size_t off = (size_t)r * ldc + col0; float ss = 0.f;
#pragma unroll
                for (int bj = 0; bj < 2; ++bj) { const f32x4 x0 = rs[m][bj][0] + acc[ai][bj][m][0], x1 = rs[m][bj][1] + acc[ai][bj][m][1];
                    ss += ((x0[0] * x0[0] + x0[1] * x0[1]) + (x0[2] * x0[2] + x0[3] * x0[3])) + ((x1[0] * x1[0] + x1[1] * x1[1]) + (x1[2] * x1[2] + x1[3] * x1[3]));
                    u32x4 w; w.x = cvt_pk_bf16(x0[0], x0[1]); w.y = cvt_pk_bf16(x0[2], x0[3]); w.z = cvt_pk_bf16(x1[0], x1[1]); w.w = cvt_pk_bf16(x1[2], x1[3]);
                    *(u32x4*)(xb + off + bj * HALF) = w; }
                ss += __shfl_xor(ss, 16); ss += __shfl_xor(ss, 32);
                if (fq == 0) atomicAdd(sumsq + r, ss); }
            asm volatile("" ::: "memory"); }
    }
};
struct EpiG3 {
    static constexpr bool PERM = true, AFTER_DRAIN = false;
    bf16_t* O; int ldc;
    __device__ __forceinline__ void operator()(const f32x4 (&acc)[2][2][4][2], const Unit& u, int wr, int wc, int fr, int fq) const {
        const int row0 = u.pm * BM + wr * 64 + fr;
#pragma unroll
        for (int ai = 0; ai < 2; ++ai)
#pragma unroll
            for (int m = 0; m < 4; ++m) { const int t = row0 + ai * HALF + m * 16;
#pragma unroll
                for (int bj = 0; bj < 2; ++bj) { const f32x4 v0 = acc[ai][bj][m][0], v1 = acc[ai][bj][m][1];
                    u32x4 w; w.x = cvt_pk_bf16(v0[0], v0[1]); w.y = cvt_pk_bf16(v0[2], v0[3]); w.z = cvt_pk_bf16(v1[0], v1[1]); w.w = cvt_pk_bf16(v1[2], v1[3]);
                    *(u32x4*)(O + ((size_t)(((((t >> 5) * 8 + u.pn) * 2 + bj) * 16 + 4 * wc + fq) * 32 + (t & 31))) * 8) = w; } }
    }
};

template <class Epi, class Sched, bool ALIGN_EPI = false, bool SP2 = false>
__device__ __forceinline__ void gemm_phase(PG8_LAS unsigned char* lds, const Gemm g, const Sched& S, const Epi& E, int wid_in) {
    const int wid = __builtin_amdgcn_readfirstlane(wid_in), lane = (int)__builtin_amdgcn_mbcnt_hi(~0u, __builtin_amdgcn_mbcnt_lo(~0u, 0u)), tid = wid * 64 + lane, wr = wid >> 2, wc = wid & 3, fr = lane & 15, fq = lane >> 4;
    const int K = g.K, nt = K / BK;
    unsigned voffA[2], voffB[2];
#pragma unroll
    for (int i = 0; i < 2; ++i) { int R, C; stage_rc(tid * 16 + i * 8192, R, C); const int Rb = Epi::PERM ? ((R & ~31) + perm32(R & 31)) : R;
        voffA[i] = (unsigned)(R * K + C) * 2u; voffB[i] = (unsigned)(Rb * K + C) * 2u; }
    const size_t kstep = (size_t)(BK * 2);
    const size_t hstep = (size_t)HALF * K * 2;
    const size_t tstep = 2 * hstep;
    const unsigned ldsw = (unsigned)wid * 1024u;
    const int aoff = lds_byte(wr * 64 + fr, fq * 8), boff = lds_byte(wc * 32 + fr, fq * 8);
#define PG8_SA(b, h) (((b) * 2 + (h)) * HTB)
#define PG8_SB(b, h) ((4 + (b) * 2 + (h)) * HTB)
#define PG8_STAGE(bufoff, gbase, voff) do { _Pragma("unroll") for (int _i = 0; _i < 2; ++_i) \
        __builtin_amdgcn_global_load_lds((const unsigned*)((const char*)(gbase) + (voff)[_i]), (PG8_LAS unsigned*)(lds + (bufoff) + ldsw + _i * 8192), 16, 0, 0); } while (0)
#define PG8_LDA(dst, b, h) do { _Pragma("unroll") for (int m = 0; m < 4; ++m) _Pragma("unroll") for (int k = 0; k < 2; ++k) dst[m][k] = *(const PG8_LAS bf16x8*)(lds + PG8_SA(b, h) + aoff + m * 2048 + k * 1024); } while (0)
#define PG8_LDB(dst, b, h) do { _Pragma("unroll") for (int n = 0; n < 2; ++n) _Pragma("unroll") for (int k = 0; k < 2; ++k) dst[n][k] = *(const PG8_LAS bf16x8*)(lds + PG8_SB(b, h) + boff + n * 2048 + k * 1024); } while (0)
#define PG8_MMA(ai, bj, At, Bt) do { __builtin_amdgcn_s_setprio(1); _Pragma("unroll") for (int m = 0; m < 4; ++m) _Pragma("unroll") for (int n = 0; n < 2; ++n) _Pragma("unroll") for (int k = 0; k < 2; ++k) \
        acc[ai][bj][m][n] = __builtin_amdgcn_mfma_f32_16x16x32_bf16(Bt[n][k], At[m][k], acc[ai][bj][m][n], 0, 0, 0); __builtin_amdgcn_s_setprio(0); } while (0)
#define PG8_WAIT_V(n) asm volatile("s_waitcnt vmcnt(" #n ")" ::: "memory")
#define PG8_WAIT_L(n) asm volatile("s_waitcnt lgkmcnt(" #n ")" ::: "memory")
#define PG8_BAR __builtin_amdgcn_s_barrier()
#define PG8_SCHED __builtin_amdgcn_sched_barrier(0)
    Unit cur, nxt; int ui = 0;
    if (!S.next(0, cur)) return;
    f32x4 acc[2][2][4][2];
#pragma unroll
    for (int a = 0; a < 2; ++a)
#pragma unroll
        for (int b = 0; b < 2; ++b)
#pragma unroll
            for (int m = 0; m < 4; ++m)
#pragma unroll
                for (int n = 0; n < 2; ++n) acc[a][b][m][n] = (f32x4){0.f, 0.f, 0.f, 0.f};
    bf16x8 At[4][2], B0[2][2], B1[2][2];
    const char* cA = (const char*)g.A + (size_t)cur.pm * tstep; const char* cB = (const char*)g.Bt + (size_t)cur.pn * tstep;
    S.a_ready(cur);
    if constexpr (SP2) {
        PG8_STAGE(PG8_SB(0, 0), cB, voffB); PG8_STAGE(PG8_SB(0, 1), cB + hstep, voffB); PG8_STAGE(PG8_SA(0, 0), cA, voffA); PG8_STAGE(PG8_SA(0, 1), cA + hstep, voffA);
        if (wr == 1) PG8_BAR;
        PG8_WAIT_V(2); PG8_BAR;
        PG8_STAGE(PG8_SB(1, 0), cB + kstep, voffB); PG8_STAGE(PG8_SA(1, 0), cA + kstep, voffA); PG8_STAGE(PG8_SB(1, 1), cB + hstep + kstep, voffB);
        PG8_WAIT_V(6); PG8_BAR;
    } else {
        PG8_STAGE(PG8_SB(0, 0), cB, voffB); PG8_STAGE(PG8_SA(0, 0), cA, voffA); PG8_STAGE(PG8_SB(0, 1), cB + hstep, voffB); PG8_STAGE(PG8_SA(0, 1), cA + hstep, voffA);
        if (wr == 1) PG8_BAR;
        PG8_WAIT_V(4); PG8_BAR;
        PG8_STAGE(PG8_SB(1, 0), cB + kstep, voffB); PG8_STAGE(PG8_SA(1, 0), cA + kstep, voffA); PG8_STAGE(PG8_SB(1, 1), cB + hstep + kstep, voffB);
        PG8_WAIT_V(6); PG8_BAR;
    }
    for (;;) {
        const bool has_next = S.next(ui + 1, nxt);
        const char* nA = has_next ? (const char*)g.A + (size_t)nxt.pm * tstep : cA; const char* nB = has_next ? (const char*)g.Bt + (size_t)nxt.pn * tstep : cB;
        for (int t = 0; t < nt; t += 2) {
            const bool last = (t == nt - 2);
            const char* a1 = cA + (size_t)(t + 1) * kstep;
            const char* a2 = last ? nA : cA + (size_t)(t + 2) * kstep; const char* b2 = last ? nB : cB + (size_t)(t + 2) * kstep;
            const char* a3 = a2 + kstep; const char* b3 = b2 + kstep;
            if (last && has_next) S.a_ready(nxt);
            if constexpr (SP2) {
            PG8_LDB(B0, 0, 0); PG8_LDB(B1, 0, 1); PG8_SCHED; PG8_LDA(At, 0, 0); PG8_STAGE(PG8_SA(1, 1), a1 + hstep, voffA);
            PG8_WAIT_V(8); PG8_WAIT_L(0); PG8_BAR; PG8_MMA(0, 0, At, B0); PG8_MMA(0, 1, At, B1); PG8_BAR; PG8_SCHED;
            PG8_LDA(At, 0, 1); PG8_STAGE(PG8_SB(0, 0), b2, voffB); PG8_STAGE(PG8_SB(0, 1), b2 + hstep, voffB); PG8_STAGE(PG8_SA(0, 0), a2, voffA);
            PG8_WAIT_V(8); PG8_WAIT_L(0); PG8_BAR; PG8_MMA(1, 0, At, B0); PG8_MMA(1, 1, At, B1); PG8_BAR; PG8_SCHED;
            PG8_LDB(B0, 1, 0); PG8_LDB(B1, 1, 1); PG8_SCHED; PG8_LDA(At, 1, 0); PG8_STAGE(PG8_SA(0, 1), a2 + hstep, voffA);
            PG8_WAIT_V(8); PG8_WAIT_L(0); PG8_BAR; PG8_MMA(0, 0, At, B0); PG8_MMA(0, 1, At, B1); PG8_BAR; PG8_SCHED;
            PG8_LDA(At, 1, 1); PG8_STAGE(PG8_SB(1, 0), b3, voffB); PG8_STAGE(PG8_SB(1, 1), b3 + hstep, voffB); PG8_STAGE(PG8_SA(1, 0), a3, voffA);
            PG8_WAIT_V(8); PG8_WAIT_L(0); PG8_BAR; PG8_MMA(1, 0, At, B0); PG8_MMA(1, 1, At, B1); PG8_BAR; PG8_SCHED;
            } else {
            PG8_LDB(B0, 0, 0); PG8_SCHED; PG8_LDA(At, 0, 0); PG8_STAGE(PG8_SA(1, 1), a1 + hstep, voffA);
            PG8_WAIT_L(8); PG8_BAR; PG8_WAIT_L(0); PG8_MMA(0, 0, At, B0); PG8_BAR; PG8_SCHED;
            PG8_LDB(B1, 0, 1); PG8_STAGE(PG8_SB(0, 0), b2, voffB);
            PG8_BAR; PG8_WAIT_L(0); PG8_MMA(0, 1, At, B1); PG8_BAR;
            PG8_LDA(At, 0, 1); PG8_STAGE(PG8_SA(0, 0), a2, voffA);
            PG8_BAR; PG8_WAIT_L(0); PG8_MMA(1, 0, At, B0); PG8_BAR; PG8_SCHED;
            PG8_STAGE(PG8_SB(0, 1), b2 + hstep, voffB);
            PG8_WAIT_V(6); PG8_BAR; PG8_MMA(1, 1, At, B1); PG8_BAR;
            PG8_LDB(B0, 1, 0); PG8_SCHED; PG8_LDA(At, 1, 0); PG8_STAGE(PG8_SA(0, 1), a2 + hstep, voffA);
            PG8_WAIT_L(8); PG8_BAR; PG8_WAIT_L(0); PG8_MMA(0, 0, At, B0); PG8_BAR; PG8_SCHED;
            PG8_LDB(B1, 1, 1); PG8_STAGE(PG8_SB(1, 0), b3, voffB);
            PG8_BAR; PG8_WAIT_L(0); PG8_MMA(0, 1, At, B1); PG8_BAR;
            PG8_LDA(At, 1, 1); PG8_STAGE(PG8_SA(1, 0), a3, voffA);
            PG8_BAR; PG8_WAIT_L(0); PG8_MMA(1, 0, At, B0); PG8_BAR; PG8_SCHED;
            PG8_STAGE(PG8_SB(1, 1), b3 + hstep, voffB);
            PG8_WAIT_V(6); PG8_BAR; PG8_MMA(1, 1, At, B1); PG8_BAR;
            }
        }
        if constexpr (ALIGN_EPI) { if (wr == 0) PG8_BAR; }
        if constexpr (!Epi::AFTER_DRAIN) { E(acc, cur, wr, wc, fr, fq); S.done(cur); }
        if (!has_next) break;
#pragma unroll
        for (int a = 0; a < 2; ++a)
#pragma unroll
            for (int b = 0; b < 2; ++b)
#pragma unroll
                for (int m = 0; m < 4; ++m)
#pragma unroll
                    for (int n = 0; n < 2; ++n) acc[a][b][m][n] = (f32x4){0.f, 0.f, 0.f, 0.f};
        cur = nxt; cA = nA; cB = nB; ++ui;
        if constexpr (ALIGN_EPI) { if (wr == 1) PG8_BAR; }
    }
    PG8_WAIT_V(0);
    if constexpr (!ALIGN_EPI) { if (wr == 0) PG8_BAR; }
    PG8_BAR;
    if constexpr (Epi::AFTER_DRAIN) { E.fused(acc, cur, wr, wc, fr, fq, lds, wid, lane); S.done(cur); }
#undef PG8_SA
#undef PG8_SB
#undef PG8_STAGE
#undef PG8_LDA
#undef PG8_LDB
#undef PG8_MMA
#undef PG8_WAIT_V
#undef PG8_WAIT_L
#undef PG8_BAR
#undef PG8_SCHED
}
}
#include <hip/hip_bf16.h>
#include <cmath>
namespace attn_body {
using bf16=__hip_bfloat16;
using bf16x8=__attribute__((ext_vector_type(8)))short;
using s16x4=__attribute__((ext_vector_type(4)))short;
using f32x16=__attribute__((ext_vector_type(16)))float;
using u32x4=__attribute__((ext_vector_type(4)))unsigned;
constexpr int BATCH=4,NHEAD=8,SEQ=8192,D=64,DM=NHEAD*D;
constexpr int NW=8,QBLK=32,QB=QBLK*NW,KVBLK=64,NQB=SEQ/QB;
constexpr int ATTN_PITCH=DM, ATTN_UNIT_ROWS=QB;
__device__ __forceinline__ int crow(int r,int hi){return (r&3)+8*(r>>2)+4*hi;}
#define SBAR() __builtin_amdgcn_sched_barrier(0)
__device__ __forceinline__ void cmask(f32x16&p0,f32x16&p1,int jb,int qrel,int hi){
  const float NEG=-INFINITY; int kb=64*jb+4*hi;
  #pragma unroll
  for(int r=0;r<16;++r){int kv=kb+(r&3)+8*(r>>2); if(kv>qrel)p0[r]=NEG; if(kv+32>qrel)p1[r]=NEG;}
}

constexpr int NSLOT=3, SLOTB=8192;
constexpr int LDS_K=0, LDS_V=NSLOT*SLOTB, LDS_WS=2*NSLOT*SLOTB, LDS_OST=LDS_WS+NW*64*4, LDS_FK=LDS_OST+NW*4096, LDS_BYTES=LDS_FK+SEQ*4;
constexpr float C2=0.125f*1.4426950408889634f;
__device__ __forceinline__ void glds16(const void*gsrc,unsigned lds_dst){unsigned keep;
  asm volatile("s_mov_b32 %0, m0\n\ts_mov_b32 m0, %2\n\ts_nop 0\n\tglobal_load_lds_dwordx4 %1, off\n\ts_mov_b32 m0, %0":"=&s"(keep):"v"(gsrc),"s"(lds_dst):"memory");}
__device__ __forceinline__ float max3f(float a,float b,float c){float r;asm("v_max3_f32 %0, %1, %2, %3":"=v"(r):"v"(a),"v"(b),"v"(c));return r;}
__device__ __forceinline__ float max2f(float a,float b){float r;asm("v_max_f32_e32 %0, %1, %2":"=v"(r):"v"(a),"v"(b));return r;}
__device__ __forceinline__ float fadd_s(float a,float b){float r;asm("v_add_f32_e32 %0, %1, %2":"=v"(r):"v"(a),"v"(b));return r;}
__device__ __forceinline__ float fsub_s(float a,float b){float r;asm("v_sub_f32_e32 %0, %1, %2":"=v"(r):"v"(a),"v"(b));return r;}
typedef float f32x2_t __attribute__((ext_vector_type(2))); typedef __bf16 bf16x2_t __attribute__((ext_vector_type(2)));
__device__ __forceinline__ unsigned cvtpk_s(float lo,float hi){f32x2_t v={lo,hi};bf16x2_t b=__builtin_convertvector(v,bf16x2_t);return __builtin_bit_cast(unsigned,b);}
#define WAIT_BAR(N) asm volatile("s_waitcnt vmcnt(" #N ") lgkmcnt(0)\n\ts_barrier":::"memory")

__device__ __forceinline__ void qkt(f32x16&p0,f32x16&p1,const char*Kslot,const bf16x8*qr,int r32,int hi){
  const char*kb=Kslot+hi*1024+r32*16;
  #pragma unroll
  for(int d0=0;d0<4;++d0){
    const bf16x8 b0=*reinterpret_cast<const bf16x8*>(kb+d0*2048);
    const bf16x8 b1=*reinterpret_cast<const bf16x8*>(kb+d0*2048+512);
    p0=__builtin_amdgcn_mfma_f32_32x32x16_bf16(b0,qr[d0],p0,0,0,0);p1=__builtin_amdgcn_mfma_f32_32x32x16_bf16(b1,qr[d0],p1,0,0,0);}
}
typedef __attribute__((address_space(3))) const char* lds_cptr;
typedef short v4i16_t __attribute__((ext_vector_type(4)));
__device__ __forceinline__ void kload8(bf16x8*kf,lds_cptr kp){
  kf[0]=*(const __attribute__((address_space(3))) bf16x8*)(kp);      kf[1]=*(const __attribute__((address_space(3))) bf16x8*)(kp+512);
  kf[2]=*(const __attribute__((address_space(3))) bf16x8*)(kp+2048); kf[3]=*(const __attribute__((address_space(3))) bf16x8*)(kp+2560);
  kf[4]=*(const __attribute__((address_space(3))) bf16x8*)(kp+4096); kf[5]=*(const __attribute__((address_space(3))) bf16x8*)(kp+4608);
  kf[6]=*(const __attribute__((address_space(3))) bf16x8*)(kp+6144); kf[7]=*(const __attribute__((address_space(3))) bf16x8*)(kp+6656);
}
__device__ __forceinline__ void kload2(bf16x8*kf,lds_cptr kp,int j){ kf[2*j]=*(const __attribute__((address_space(3))) bf16x8*)(kp+j*2048); kf[2*j+1]=*(const __attribute__((address_space(3))) bf16x8*)(kp+j*2048+512); }
__device__ __forceinline__ s16x4 vtr(lds_cptr p){ return __builtin_bit_cast(s16x4,__builtin_amdgcn_ds_read_tr16_b64_v4i16((__attribute__((address_space(3))) v4i16_t*)p)); }
__device__ __forceinline__ float rowmax(const f32x16&p0,const f32x16&p1){
  float a=max3f(p0[0],p0[1],p1[0]),b=max3f(p0[2],p0[3],p1[1]);a=max3f(a,p1[2],p1[3]);
  #pragma unroll
  for(int r=4;r<16;r+=4){a=max3f(a,p0[r],p0[r+1]);b=max3f(b,p0[r+2],p0[r+3]);a=max3f(a,p1[r],p1[r+1]);b=max3f(b,p1[r+2],p1[r+3]);}
  const float m=max2f(a,b);
  auto rr=__builtin_amdgcn_permlane32_swap(__float_as_uint(m),__float_as_uint(m),false,false);
  return max2f(__uint_as_float(rr[0]),__uint_as_float(rr[1]));
}
__device__ __forceinline__ void pv(f32x16*o,int vb,bf16x8 pa0,bf16x8 pa1,bf16x8 pa2,bf16x8 pa3){
  #pragma unroll
  for(int d0=0;d0<2;++d0){s16x4 lo[4],hi[4];
    #pragma unroll
    for(int ks=0;ks<4;++ks){
      asm volatile("ds_read_b64_tr_b16 %0,%1 offset:%c2":"=&v"(lo[ks]):"v"(vb),"i"(d0*4096+ks*1024):"memory");
      asm volatile("ds_read_b64_tr_b16 %0,%1 offset:%c2":"=&v"(hi[ks]):"v"(vb),"i"(d0*4096+ks*1024+512):"memory");}
    asm volatile("s_waitcnt lgkmcnt(0)":::"memory");SBAR();
    #define PK(k) (bf16x8){lo[k][0],lo[k][1],lo[k][2],lo[k][3],hi[k][0],hi[k][1],hi[k][2],hi[k][3]}
    o[d0]=__builtin_amdgcn_mfma_f32_32x32x16_bf16(pa0,PK(0),o[d0],0,0,0);
    o[d0]=__builtin_amdgcn_mfma_f32_32x32x16_bf16(pa1,PK(1),o[d0],0,0,0);
    o[d0]=__builtin_amdgcn_mfma_f32_32x32x16_bf16(pa2,PK(2),o[d0],0,0,0);
    o[d0]=__builtin_amdgcn_mfma_f32_32x32x16_bf16(pa3,PK(3),o[d0],0,0,0);
    #undef PK
  }
}

#ifndef ATTN_STORE16
#define ATTN_STORE16(p,v) (*(u32x4*)(p)=(v))
#endif
template<int THRL> __device__ __forceinline__ void attn_unit(int b,int h,int qb,const bf16*Q,const bf16*__restrict__ K,const bf16*__restrict__ V,bf16*O,const float*__restrict__ Fc,const float*__restrict__ NRM,char*shm,int wid_in){
  const int wid=__builtin_amdgcn_readfirstlane(wid_in); int lane_=(int)__builtin_amdgcn_mbcnt_hi(~0u,__builtin_amdgcn_mbcnt_lo(~0u,0u)); asm volatile("":"+v"(lane_));
  const int lane=lane_,tid=wid*64+lane,r32=lane&31,hi=lane>>5;
  const long rowbase=(long)b*SEQ; const int q0=qb*QB;
  const float*Fbh=Fc+(long)(b*NHEAD+h)*SEQ;
  const int NTF=(q0+QB)/KVBLK; int t_start;
  { const float*QNb=NRM+(b*NHEAD+h)*128,*KNb=NRM+4096+(b*NHEAD+h)*128;
    const float qn=fmaxf(fmaxf(QNb[4*qb],QNb[4*qb+1]),fmaxf(QNb[4*qb+2],QNb[4*qb+3])),knb=fmaxf(fmaxf(KNb[4*qb],KNb[4*qb+1]),fmaxf(KNb[4*qb+2],KNb[4*qb+3]));
    const float fq0=Fbh[q0]*1.4426950408889634f; float e0=1e30f,e1=1e30f;
    if(lane<NTF-4)e0=__builtin_amdgcn_exp2f(fminf(qn*(KNb[lane]+knb)+(fq0-Fbh[64*lane+63]*1.4426950408889634f),90.f));
    if(lane+64<NTF-4)e1=__builtin_amdgcn_exp2f(fminf(qn*(KNb[lane+64]+knb)+(fq0-Fbh[64*(lane+64)+63]*1.4426950408889634f),90.f));
    #pragma unroll
    for(int o=1;o<64;o<<=1){ const float u0=__shfl_up(e0,o),u1=__shfl_up(e1,o); if(lane>=o){e0+=u0;e1+=u1;} }
    e1+=__shfl(e0,63);
    const float lim=0x1p-27f*(1.f/64.f); const bool k0=!(e0<lim),k1=!(e1<lim);
    const unsigned long long m0=__ballot(k0),m1=__ballot(k1);
    int tf=m0?(int)__builtin_ctzll(m0):64+(m1?(int)__builtin_ctzll(m1):64);
    tf=tf<NTF-4?tf:NTF-4; t_start=__builtin_amdgcn_readfirstlane(tf&~1); }
  { typedef float f32x4_t __attribute__((ext_vector_type(4))); __attribute__((address_space(3))) float*fk=(__attribute__((address_space(3))) float*)((__attribute__((address_space(3))) char*)shm+LDS_FK); const int n4=(q0+QB)/4;
    for(int i=16*t_start+tid;i<n4;i+=NW*64){ f32x4_t v=*(const f32x4_t*)(Fbh+4*i); v=v*(-1.4426950408889634f); *(__attribute__((address_space(3))) f32x4_t*)(fk+4*i)=v; } }
  float fq2=Fbh[q0+wid*QBLK+r32]*1.4426950408889634f; asm volatile("":"+v"(fq2));
  const bf16*Qw=Q+(rowbase+q0+wid*QBLK)*DM+h*D;
  const bf16*Kh=K+(rowbase+(long)t_start*KVBLK)*DM+h*D,*Vh=V+(rowbase+(long)t_start*KVBLK)*DM+h*D;
  const lds_cptr shm3=(lds_cptr)shm;
  const unsigned lds0=(unsigned)(uintptr_t)shm;
  float*wsf=(float*)(shm+LDS_WS)+wid*64;
  const bf16*ksrc=Kh+(long)lane*DM+wid*8;
  const bf16*vsrc=Vh+(long)(16*(wid&3)+(lane>>2))*DM+(wid>>2)*32+(lane&3)*8;
  const unsigned kdst=lds0+LDS_K+wid*1024, vdst=lds0+LDS_V+wid*1024;
  #define DMA_K(t,slot) glds16(ksrc+(long)(t)*KVBLK*DM,(unsigned)__builtin_amdgcn_readfirstlane(kdst+(slot)))
  #define DMA_V(t,slot) glds16(vsrc+(long)(t)*KVBLK*DM,(unsigned)__builtin_amdgcn_readfirstlane(vdst+(slot)))
  const int vb0=(int)(lds0+LDS_V)+((lane>>4)&1)*32+(lane&3)*8+(4*hi+((lane&15)>>2))*64;
  const char*Kbase=shm+LDS_K; bf16x8 kf[8];
  const lds_cptr kp0=shm3+LDS_K+hi*1024+r32*16; const lds_cptr vp0=shm3+LDS_V+((lane>>4)&1)*32+(lane&3)*8+(4*hi+((lane&15)>>2))*64;
  const int NT=NTF-t_start;
  DMA_K(0,0);DMA_V(0,0);DMA_K(1,SLOTB);
  bf16x8 qr[4];
  #pragma unroll
  for(int d0=0;d0<4;++d0)qr[d0]=*reinterpret_cast<const bf16x8*>(&Qw[(long)r32*DM+d0*16+hi*8]);
  float mhat=0.f,l_reg=0.f;f32x16 o[2];o[0]=f32x16{};o[1]=f32x16{};
  const __attribute__((address_space(3))) float*fkl=(const __attribute__((address_space(3))) float*)(shm3+LDS_FK)+64*t_start+4*hi;
  #define INITC(C0,C1,t) do{ const float nsc_=fq2-mhat; typedef float f32x4_t __attribute__((ext_vector_type(4))); const __attribute__((address_space(3))) float*kb_=fkl+64*(t); \
    _Pragma("unroll") for(int g_=0;g_<4;++g_){ const f32x4_t a_=*(const __attribute__((address_space(3))) f32x4_t*)(kb_+8*g_), b_=*(const __attribute__((address_space(3))) f32x4_t*)(kb_+32+8*g_); \
      _Pragma("unroll") for(int e_=0;e_<4;++e_){ C0[4*g_+e_]=nsc_+a_[e_]; C1[4*g_+e_]=nsc_+b_[e_]; } } }while(0)
  const int qrel=wid*QBLK+r32;
  #define CMASK(P0,P1,t) do{int jb_=(t)-(NT-4); if(jb_>=0)cmask(P0,P1,jb_,qrel,hi);}while(0)
  bool resc=false;
  #define START(P0,P1) do{ const float rm=rowmax(P0,P1); resc=false; \
    { const float dl=rm; mhat=fadd_s(mhat,dl); \
      _Pragma("unroll") for(int r=0;r<16;++r){P0[r]=fsub_s(P0[r],dl);P1[r]=fsub_s(P1[r],dl);} \
      } \
    _Pragma("unroll") for(int r=0;r<16;++r)P0[r]=__builtin_amdgcn_exp2f(P0[r]); }while(0)
  #define RESC() do{ if(resc){ asm volatile("s_waitcnt lgkmcnt(0)":::"memory"); \
      _Pragma("unroll") for(int d_=0;d_<2;++d_) _Pragma("unroll") for(int r=0;r<16;++r)o[d_][r]*=wsf[crow(r,hi)]; } }while(0)
  f32x16 pA0,pA1,pB0,pB1;
  int sl_prev=0,sl_cur=0,sl_next=SLOTB;
  #define ROT() do{sl_prev=sl_cur;sl_cur=sl_next;sl_next=(sl_next==(NSLOT-1)*SLOTB)?0:sl_next+SLOTB;}while(0)
  DMA_K(2,2*SLOTB);
  WAIT_BAR(3);
  INITC(pA0,pA1,0); qkt(pA0,pA1,Kbase,qr,r32,hi);asm volatile("s_nop 15\n\ts_nop 7":"+v"(pA0),"+v"(pA1));CMASK(pA0,pA1,0);
  START(pA0,pA1);
  _Pragma("unroll") for(int r=0;r<16;++r)pA1[r]=__builtin_amdgcn_exp2f(pA1[r]);
  WAIT_BAR(0);
  DMA_K(3,0);DMA_V(1,SLOTB);
  ROT();
  kload8(kf,kp0+sl_cur);
  WAIT_BAR(2);
  s16x4 vlo[8],vhi[8]; u32x4 pw0,pw1,pw2,pw3;
  #define PKW(P,B) cvtpk_s(P[B],P[B+1])
  #define PAF(k) __builtin_bit_cast(bf16x8,pw##k)
  #define VFR(i) (bf16x8){vlo[i][0],vlo[i][1],vlo[i][2],vlo[i][3],vhi[i][0],vhi[i][1],vhi[i][2],vhi[i][3]}
  #define PIN(x) asm volatile("":"+v"(x))
  #define MX3(a,b,c) __builtin_fmaxf(__builtin_fmaxf((a),(b)),(c))
  #define GAPA(MF,A0,A1,A2,A3,W0,W1,PW) do{ MF; sacc+=A0; sacc+=A1; sacc+=A2; sacc+=A3; PIN(sacc); W0; W1; PIN(PW); SBAR(); }while(0)
  #define EX(v) __builtin_amdgcn_exp2f(v)
  #define GAPB(MF,X,B) do{ MF; X[B]=EX(X[B]); X[B+1]=EX(X[B+1]); X[B+2]=EX(X[B+2]); X[B+3]=EX(X[B+3]); PIN(X); SBAR(); }while(0)
  #define VRD(i) do{ vlo[i]=vtr(vp_+(((i)>>2)*4096+((i)&3)*1024)); vhi[i]=vtr(vp_+(((i)>>2)*4096+((i)&3)*1024+512)); }while(0)
  #define KRD(G,j) do{ if(G){ kload2(kf,kp0+sl_next,j); SBAR(); } }while(0)
  #define STEP(C0,C1,P0,P1,t,GK,GV,GL) do{ SBAR(); INITC(C0,C1,t); PIN(C0); PIN(C1); SBAR(); \
    const lds_cptr vp_=vp0+sl_prev; \
    VRD(0); SBAR(); float sacc=(P0[0]+P0[1]); \
    GAPA(C0=__builtin_amdgcn_mfma_f32_32x32x16_bf16(kf[0],qr[0],C0,0,0,0), P0[2],P0[3],P0[4],P0[5],     pw0[0]=PKW(P0,0), pw0[1]=PKW(P0,2), pw0); \
    VRD(4); SBAR(); GAPA(C1=__builtin_amdgcn_mfma_f32_32x32x16_bf16(kf[1],qr[0],C1,0,0,0), P0[6],P0[7],P0[8],P0[9],     pw0[2]=PKW(P0,4), pw0[3]=PKW(P0,6), pw0); \
    VRD(1); SBAR(); GAPA(C0=__builtin_amdgcn_mfma_f32_32x32x16_bf16(kf[2],qr[1],C0,0,0,0),   P0[10],P0[11],P0[12],P0[13], pw1[0]=PKW(P0,8), pw1[1]=PKW(P0,10), pw1); \
    VRD(5); SBAR(); GAPA(C1=__builtin_amdgcn_mfma_f32_32x32x16_bf16(kf[3],qr[1],C1,0,0,0),   P0[14],P0[15],P1[0],P1[1],   pw1[2]=PKW(P0,12),pw1[3]=PKW(P0,14), pw1); \
    VRD(2); SBAR(); GAPA(C0=__builtin_amdgcn_mfma_f32_32x32x16_bf16(kf[4],qr[2],C0,0,0,0),   P1[2],P1[3],P1[4],P1[5],     pw2[0]=PKW(P1,0), pw2[1]=PKW(P1,2), pw2); \
    VRD(6); SBAR(); GAPA(C1=__builtin_amdgcn_mfma_f32_32x32x16_bf16(kf[5],qr[2],C1,0,0,0),   P1[6],P1[7],P1[8],P1[9],     pw2[2]=PKW(P1,4), pw2[3]=PKW(P1,6), pw2); \
    VRD(3); SBAR(); GAPA(C0=__builtin_amdgcn_mfma_f32_32x32x16_bf16(kf[6],qr[3],C0,0,0,0),   P1[10],P1[11],P1[12],P1[13], pw3[0]=PKW(P1,8), pw3[1]=PKW(P1,10), pw3); \
    VRD(7); SBAR(); GAPA(C1=__builtin_amdgcn_mfma_f32_32x32x16_bf16(kf[7],qr[3],C1,0,0,0),   P1[14],P1[15],0.f,0.f,       pw3[2]=PKW(P1,12),pw3[3]=PKW(P1,14), pw3); \
    l_reg+=sacc; \
    if(GK){DMA_K((t)+3,sl_cur);} if(GV){DMA_V((t)+1,sl_next);} \
    CMASK(C0,C1,t); \
    { float a=MX3(C0[0],C0[1],C1[0]),b=MX3(C0[2],C0[3],C1[1]); a=MX3(a,C1[2],C1[3]); \
      _Pragma("unroll") for(int r=4;r<16;r+=4){a=MX3(a,C0[r],C0[r+1]);b=MX3(b,C0[r+2],C0[r+3]);a=MX3(a,C1[r],C1[r+1]);b=MX3(b,C1[r+2],C1[r+3]);} \
      float rm=__builtin_fmaxf(a,b); { auto rr=__builtin_amdgcn_permlane32_swap(__float_as_uint(rm),__float_as_uint(rm),false,false); rm=__builtin_fmaxf(__uint_as_float(rr[0]),__uint_as_float(rr[1])); } \
      resc=false; \
      if(__builtin_expect(__any(rm>(float)THRL),0)){ const float dl=__builtin_fmaxf(rm,0.f); mhat+=dl; \
        _Pragma("unroll") for(int r=0;r<16;++r){C0[r]-=dl;C1[r]-=dl;} \
        const float f=__builtin_amdgcn_exp2f(-dl); l_reg*=f; if(hi==0)wsf[r32]=f; resc=true; } } \
    SBAR(); \
    GAPB(o[0]=__builtin_amdgcn_mfma_f32_32x32x16_bf16(PAF(0),VFR(0),o[0],0,0,0), C0,0); \
    GAPB(o[1]=__builtin_amdgcn_mfma_f32_32x32x16_bf16(PAF(0),VFR(4),o[1],0,0,0), C0,4); \
    KRD(GL,0); GAPB(o[0]=__builtin_amdgcn_mfma_f32_32x32x16_bf16(PAF(1),VFR(1),o[0],0,0,0), C0,8); \
    KRD(GL,1); GAPB(o[1]=__builtin_amdgcn_mfma_f32_32x32x16_bf16(PAF(1),VFR(5),o[1],0,0,0), C0,12); \
    KRD(GL,2); GAPB(o[0]=__builtin_amdgcn_mfma_f32_32x32x16_bf16(PAF(2),VFR(2),o[0],0,0,0), C1,0); \
    KRD(GL,3); GAPB(o[1]=__builtin_amdgcn_mfma_f32_32x32x16_bf16(PAF(2),VFR(6),o[1],0,0,0), C1,4); \
    GAPB(o[0]=__builtin_amdgcn_mfma_f32_32x32x16_bf16(PAF(3),VFR(3),o[0],0,0,0), C1,8); \
    GAPB(o[1]=__builtin_amdgcn_mfma_f32_32x32x16_bf16(PAF(3),VFR(7),o[1],0,0,0), C1,12); \
    }while(0)
  int t=1;
  #undef CMASK
  #define CMASK(P0,P1,t) do{}while(0)
  for(;t+5<NT;t+=2){
    STEP(pB0,pB1,pA0,pA1,t,true,true,true);     WAIT_BAR(2); RESC(); ROT();
    STEP(pA0,pA1,pB0,pB1,t+1,true,true,true);   WAIT_BAR(2); RESC(); ROT();
  }
  #undef CMASK
  #define CMASK(P0,P1,t) do{int jb_=(t)-(NT-4); if(jb_>=0)cmask(P0,P1,jb_,qrel,hi);}while(0)
  #define ENDW(tt) do{ if((tt)+3<NT){WAIT_BAR(2);} else if((tt)+2<NT){WAIT_BAR(1);} else {WAIT_BAR(0);} }while(0)
  for(;t+1<NT;t+=2){
    STEP(pB0,pB1,pA0,pA1,t,(t+3<NT),(t+1<NT),(t+1<NT));       ENDW(t);   RESC(); ROT();
    STEP(pA0,pA1,pB0,pB1,t+1,(t+4<NT),(t+2<NT),(t+2<NT));     ENDW(t+1); RESC(); ROT();
  }
  STEP(pB0,pB1,pA0,pA1,NT-1,false,false,false); RESC();
  { float sacc=pB0[0]+pB0[1]; _Pragma("unroll") for(int r=2;r<16;++r)sacc+=pB0[r]; _Pragma("unroll") for(int r=0;r<16;++r)sacc+=pB1[r]; l_reg+=sacc;
    pw0=(u32x4){PKW(pB0,0),PKW(pB0,2),PKW(pB0,4),PKW(pB0,6)};pw1=(u32x4){PKW(pB0,8),PKW(pB0,10),PKW(pB0,12),PKW(pB0,14)};pw2=(u32x4){PKW(pB1,0),PKW(pB1,2),PKW(pB1,4),PKW(pB1,6)};pw3=(u32x4){PKW(pB1,8),PKW(pB1,10),PKW(pB1,12),PKW(pB1,14)};
    SBAR(); pv(o,vb0+sl_cur,PAF(0),PAF(1),PAF(2),PAF(3)); }
  #undef PKW
  #undef PAF
  #undef VFR
  #undef PIN
  #undef MX3
  #undef GAPA
  #undef GAPB
  #undef EX
  #undef VRD
  #undef KRD
  #undef STEP
  #undef ENDW
  {auto rr=__builtin_amdgcn_permlane32_swap(__float_as_uint(l_reg),__float_as_uint(l_reg),false,false);l_reg=__uint_as_float(rr[0])+__uint_as_float(rr[1]);}
  if(hi==0)wsf[32+r32]=l_reg;asm volatile("s_waitcnt lgkmcnt(0)":::"memory");
  float rli[16];
  #pragma unroll
  for(int r=0;r<16;++r)rli[r]=__builtin_amdgcn_rcpf(wsf[32+crow(r,hi)]);
  bf16*Ow=O+(rowbase+q0+wid*QBLK)*DM+h*D;
  { bf16*stg=(bf16*)(shm+LDS_OST)+wid*2048;
    #pragma unroll
    for(int r=0;r<16;++r){const int orow=crow(r,hi);
      #pragma unroll
      for(int d0=0;d0<2;++d0)stg[orow*64+d0*32+r32]=__float2bfloat16(o[d0][r]*rli[r]);}
    asm volatile("s_waitcnt lgkmcnt(0)":::"memory");
    #pragma unroll
    for(int i=0;i<4;++i){const int row=i*8+(lane>>3),ch=lane&7; const u32x4 v=*(const u32x4*)(stg+row*64+ch*8); ATTN_STORE16(Ow+(long)row*DM+ch*8,v);} }
  asm volatile("s_waitcnt lgkmcnt(0)\n\ts_barrier":::"memory");
  #undef DMA_K
  #undef DMA_V
  #undef INITC
  #undef CMASK
  #undef START
  #undef RESC
  #undef ROT
}
constexpr int ATTN_LDS_BYTES=LDS_BYTES;
struct AttnTensors { const bf16* Q; const bf16* K; const bf16* V; bf16* O; const float* F; const float* NRM; };
struct AttnUnit { int bh; int qb; };
struct StaticOrder {
  int vcu;
  __device__ __forceinline__ explicit StaticOrder(int grid,int block):vcu((block%8)*(grid/8)+block/8){}
  __device__ __forceinline__ bool next(int i,AttnUnit&u)const{ if(i>=4)return false; const int s=vcu&7; u.bh=vcu>>3; u.qb=(i==0)?s:(i==1)?15-s:(i==2)?16+s:31-s; return true; }
  __device__ __forceinline__ void a_ready(const AttnUnit&)const{}
  __device__ __forceinline__ void done(const AttnUnit&)const{}
};
template<int THRL=8,int NX=0,class XF> __device__ __forceinline__ void attn_phase(char*lds,const AttnTensors&T,unsigned*qctr,volatile __attribute__((address_space(3))) unsigned*qword,int wid_in,const XF&xf){
  const int lane0=(int)__builtin_amdgcn_mbcnt_hi(~0u,__builtin_amdgcn_mbcnt_lo(~0u,0u));
  for(;;){
    if(wid_in==0&&lane0==0){ const unsigned n=__hip_atomic_fetch_add(qctr,1u,__ATOMIC_RELAXED,__HIP_MEMORY_SCOPE_AGENT); *qword=n; }
    asm volatile("s_waitcnt vmcnt(0) lgkmcnt(0)\n\ts_barrier":::"memory");
    int n=__builtin_amdgcn_readfirstlane((int)*qword);
    if(n>=BATCH*NHEAD*NQB+NX)break;
    if(n<3*NX){ const int g=n/3,r=n-3*g; if(r==2){ xf(g); asm volatile("s_waitcnt lgkmcnt(0)\n\ts_barrier":::"memory"); continue; } n=2*g+r; } else n-=NX;
    const int bh=n%(BATCH*NHEAD),qb=NQB-1-n/(BATCH*NHEAD);
    attn_unit<THRL>(bh/NHEAD,bh%NHEAD,qb,T.Q,T.K,T.V,T.O,T.F,T.NRM,lds,wid_in);
  }
}
#undef SBAR
#undef WAIT_BAR
}
#define GAS __attribute__((address_space(1)))
#define LAS __attribute__((address_space(3)))
typedef unsigned short bf16;
typedef unsigned v4u __attribute__((ext_vector_type(4)));
typedef float f32x4 __attribute__((ext_vector_type(4)));
typedef short bf16x8 __attribute__((ext_vector_type(8)));
typedef GAS unsigned gu32;
typedef GAS unsigned long long gu64;
#define RLX_AGENT __ATOMIC_RELAXED, __HIP_MEMORY_SCOPE_AGENT
#define LDS_WAIT() asm volatile("s_waitcnt lgkmcnt(0)" ::: "memory")
#define VM_WAIT() asm volatile("s_waitcnt vmcnt(0)" ::: "memory")
__device__ __forceinline__ unsigned long long rt() { return __builtin_amdgcn_s_memrealtime(); }
__device__ __forceinline__ unsigned f2bf(float f) { unsigned u = __builtin_bit_cast(unsigned, f); return (u + 0x7fffu + ((u >> 16) & 1u)) >> 16; }
__device__ __forceinline__ unsigned pk2(float lo, float hi) { return f2bf(lo) | (f2bf(hi) << 16); }

#define XB_TMO      128
#define XB_XCNT(j)  (256  + 64 * (j))
#define XB_XSUB(j)  (1280 + 64 * (j))
#define XB_XGEN(j)  (2304 + 64 * (j))
#define XB_TOP      3328
#define XB_TOPGEN   3392
#define XCD_BAR_WORDS 3456
#define XB_SPIN_CAP (1u << 18)

__device__ __forceinline__ unsigned xb_ld(unsigned* p)              { return __hip_atomic_load(p, __ATOMIC_RELAXED, __HIP_MEMORY_SCOPE_AGENT); }
__device__ __forceinline__ unsigned xb_add(unsigned* p, unsigned v) { return __hip_atomic_fetch_add(p, v, __ATOMIC_RELAXED, __HIP_MEMORY_SCOPE_AGENT); }
__device__ __forceinline__ unsigned xb_xcc_id() { return (unsigned)__builtin_amdgcn_s_getreg((3 << 11) | 20) & 0xFu; }
#define XB_SPIN(cond, bar) do { unsigned _sp = 0; while (cond) { __builtin_amdgcn_s_sleep(1); \
    if ((++_sp & 255u) == 0u) { if (xb_ld(&(bar)[XB_TMO])) break; if (_sp > XB_SPIN_CAP) { atomicAdd(&(bar)[XB_TMO], 1u); break; } } } } while (0)

struct XcdBarrier {
    unsigned* bar; unsigned x; int wv;
    volatile LAS unsigned* st;
};

__device__ __forceinline__ bool xb_t0(int wv) { return wv == 0 && __builtin_amdgcn_mbcnt_hi(~0u, __builtin_amdgcn_mbcnt_lo(~0u, 0u)) == 0u; }
__device__ __forceinline__ XcdBarrier xcd_barrier_post(unsigned* bar, volatile LAS unsigned* st, int wv) {
    XcdBarrier b; b.bar = bar; b.x = xb_xcc_id(); b.st = st; b.wv = wv;
    if (xb_t0(wv)) (void)xb_add(&bar[XB_XCNT(b.x)], 1u);
    return b;
}
__device__ __forceinline__ void xcd_barrier_complete(unsigned* bar, unsigned x, unsigned& nloc, unsigned& nx) {
    const unsigned G = gridDim.x * gridDim.y * gridDim.z;
    unsigned sum, cnt, mine, sp = 0u;
    for (;;) {
        sum = 0u; cnt = 0u; mine = 0u;
#pragma unroll
        for (unsigned j = 0; j < 16; ++j) { const unsigned c = xb_ld(&bar[XB_XCNT(j)]); sum += c; cnt += (c > 0u) ? 1u : 0u; mine = (j == x) ? c : mine; }
        if (sum == G) break;
        __builtin_amdgcn_s_sleep(1);
        if ((++sp & 255u) == 0u) { if (xb_ld(&bar[XB_TMO])) break; if (sp > XB_SPIN_CAP) { atomicAdd(&bar[XB_TMO], 1u); break; } }
    }
    nloc = mine > 0u ? mine : 1u; nx = cnt > 0u ? cnt : 1u;
}

__device__ __forceinline__ void xcd_barrier(const XcdBarrier& b) {
    asm volatile("s_waitcnt vmcnt(0)" ::: "memory");
    __syncthreads();
    if (xb_t0(b.wv)) {
        unsigned* bar = b.bar;
        __builtin_amdgcn_s_waitcnt(0);
        unsigned nloc = b.st[0], nx = b.st[1];
        if (nloc == 0u) { xcd_barrier_complete(bar, b.x, nloc, nx); b.st[0] = nloc; b.st[1] = nx; }
        const unsigned old = xb_add(&bar[XB_XSUB(b.x)], 1u);
        const unsigned gen = old / nloc;
        if (old + 1u == (gen + 1u) * nloc) {
            __builtin_amdgcn_fence(__ATOMIC_RELEASE, "agent");
            asm volatile("s_waitcnt vmcnt(0)" ::: "memory");
            const unsigned og = xb_add(&bar[XB_TOP], 1u);
            const unsigned tg = og / nx;
            if (og + 1u == (tg + 1u) * nx) xb_add(&bar[XB_TOPGEN], 1u);
            else XB_SPIN(xb_ld(&bar[XB_TOPGEN]) == tg, bar);
            __builtin_amdgcn_fence(__ATOMIC_ACQUIRE, "agent");
            xb_add(&bar[XB_XGEN(b.x)], 1u);
            asm volatile("s_waitcnt vmcnt(0)" ::: "memory");
        } else {
            XB_SPIN(xb_ld(&bar[XB_XGEN(b.x)]) == gen, bar);
            __builtin_amdgcn_fence(__ATOMIC_ACQUIRE, "agent");
            asm volatile("s_waitcnt vmcnt(0)" ::: "memory");
        }
    }
    __syncthreads();
}

constexpr int NWAVES = 8;
constexpr int RING_OFF = 0, RING_BYTES = 131072;
constexpr int LDSCTL_OFF = RING_BYTES, MISC_OFF = LDSCTL_OFF + 320;
constexpr int LDS_BYTES = 147456;
constexpr int N_PHASES = 8;

struct Frame {
    LAS unsigned char* lds;
    volatile LAS unsigned* MISC;
    gu32* ctl;
    int tid, lane, wave, vcu, G;
};
__device__ __forceinline__ float wave_sum(float v) {
#pragma unroll
    for (int o = 1; o < 64; o <<= 1) v += __shfl_xor(v, o);
    return v;
}
struct Args { const float* in[20]; float* out; unsigned char* ws; int ph_lo, ph_hi, li, pad; };

__device__ __forceinline__ void p0_transpose_item(const float* W, int ld, int nblk, const float* glo, const float* ghi, int K, bf16* WT, int item, int lane) {
    const int kb = item / nblk, nb = item % nblk, k0 = 64 * kb + 16 * (lane >> 4), n0 = 64 * nb + 4 * (lane & 15);
    f32x4 w[16];
#pragma unroll
    for (int j = 0; j < 16; ++j) w[j] = *(const GAS f32x4*)(W + (size_t)(k0 + j) * ld + n0);
    if (glo) { const float* gp = (k0 < K / 2) ? glo + k0 : ghi + (k0 - K / 2);
#pragma unroll
        for (int q = 0; q < 4; ++q) { const f32x4 g4 = *(const GAS f32x4*)(gp + 4 * q);
#pragma unroll
            for (int e = 0; e < 4; ++e) w[4 * q + e] = w[4 * q + e] * g4[e]; } }
#pragma unroll
    for (int c = 0; c < 4; ++c) { v4u o0, o1;
        o0.x = pk2(w[0][c], w[1][c]); o0.y = pk2(w[2][c], w[3][c]); o0.z = pk2(w[4][c], w[5][c]); o0.w = pk2(w[6][c], w[7][c]);
        o1.x = pk2(w[8][c], w[9][c]); o1.y = pk2(w[10][c], w[11][c]); o1.z = pk2(w[12][c], w[13][c]); o1.w = pk2(w[14][c], w[15][c]);
        bf16* dp = WT + (size_t)(n0 + c) * K + k0; *(GAS v4u*)dp = o0; *(GAS v4u*)(dp + 8) = o1; }
}
__device__ __forceinline__ float log_sigmoid(float z) { return fminf(z, 0.f) - log1pf(expf(-fabsf(z))); }

__device__ __forceinline__ void p0_rows(Frame& F, const Args& a);
__device__ __forceinline__ void p0_prologue(Frame& F, const Args& a) {
    unsigned char* ws = a.ws;
    const float* x = a.in[0]; const float* g1 = a.in[1]; const float* w_in = a.in[2]; const float* bfv = a.in[10];
    const float* gn_l = a.in[11]; const float* gn_f = a.in[12]; const float* w_out = a.in[13]; const float* g2 = a.in[14];
    const float* w_q = a.in[15]; const float* sk = a.in[16]; const float* pu = a.in[17]; const float* pv = a.in[18];
    bf16* win_t = (bf16*)(ws + WS_WIN); bf16* wout_t = (bf16*)(ws + WS_WOUT); bf16* wq_t = (bf16*)(ws + WS_WQ); bf16* skb = (bf16*)(ws + WS_SKB);
    float* logf = (float*)(ws + WS_LOGF); bf16* h = (bf16*)(ws + WS_H);
    const int gw = F.vcu * NWAVES + F.wave, NGW = F.G * NWAVES, lane = F.lane;
    constexpr int I_IN = (DMODEL / 64) * (NG1 / 64), I_OUT = (DMODEL / 64) * (DMODEL / 64), I_Q = (DMODEL / 64) * (QPW / 64);
    constexpr int I_SK = PH * 2 * NKEY * PHALF / 512, I_WAX = 8 * 2 * 2 * 4;
    constexpr int E0 = I_IN, E1 = E0 + I_OUT, E2 = E1 + I_Q, E3 = E2, E4 = E3 + I_SK, E5 = E4, E6 = E5 + I_WAX;
    for (int it = gw; it < E6; it += NGW) {
        if (it < E0) { p0_transpose_item(w_in, INC, NG1 / 64, nullptr, nullptr, DMODEL, win_t, it, lane); continue; }
        if (it < E1) { p0_transpose_item(w_out, DMODEL, DMODEL / 64, gn_l, gn_f, DMODEL, wout_t, it - E0, lane); continue; }
        if (it < E2) { p0_transpose_item(w_q, QPW, QPW / 64, g2, g2 + DMODEL / 2, DMODEL, wq_t, it - E1, lane); continue; }
        if (it < E4) { const size_t i = (size_t)(it - E3) * 512 + lane * 8; const f32x4 s0 = *(const GAS f32x4*)(sk + i), s1 = *(const GAS f32x4*)(sk + i + 4);
            v4u o; o.x = pk2(s0[0], s0[1]); o.y = pk2(s0[2], s0[3]); o.z = pk2(s1[0], s1[1]); o.w = pk2(s1[2], s1[3]);
            { const size_t hp = i >> 14; const int key = (int)(i >> 7) & 127, c8 = (int)(i >> 3) & 15; *(GAS v4u*)(skb + hp * 16384 + ((size_t)((((key >> 5) * 2 + (c8 & 1)) * 8 + (c8 >> 1)) * 32 + (key & 31))) * 8) = o; } continue; }
        { const int f = it - E5, ks = f & 3, n = (f >> 2) & 1, mat = (f >> 3) & 1, hh = f >> 4; const float* wsrc = mat ? a.in[7] : a.in[5];
          const size_t o = ((size_t)(hh * 64 + 16 * ks + 8 * (lane >> 5))) * 64 + 32 * n + (lane & 31);
          v4u pw; pw.x = pk2(wsrc[o], wsrc[o + 64]); pw.y = pk2(wsrc[o + 128], wsrc[o + 192]); pw.z = pk2(wsrc[o + 256], wsrc[o + 320]); pw.w = pk2(wsrc[o + 384], wsrc[o + 448]);
          *(GAS v4u*)((bf16*)(ws + WS_WAX) + (size_t)f * 512 + lane * 8) = pw; }
    }
    p0_rows(F, a);
}
constexpr int NCONV = 512;
__device__ __forceinline__ void peer_tables_item(const Args& a, int item, int wave, int lane) {
    unsigned char* ws = a.ws; const float* g2 = a.in[14]; const float* pu = a.in[17]; const float* pv = a.in[18];
    const int gw = item * NWAVES + wave, NGW = NCONV * NWAVES;
    { f32x4 gg[4];
#pragma unroll
      for (int j = 0; j < 4; ++j) gg[j] = *(const GAS f32x4*)(g2 + 16 * lane + 4 * j);
      unsigned char* u4 = ws + WS_U8; unsigned char* v4 = ws + WS_V8; float* su = (float*)(ws + WS_SU);
      for (int e = gw; e < NEXP; e += NGW) {
        const GAS f32x4* ur = (const GAS f32x4*)(pu + (size_t)e * DMODEL + 16 * lane); const GAS f32x4* vr = (const GAS f32x4*)(pv + (size_t)e * DMODEL + 16 * lane);
        f32x4 uu[4], vv[4]; float mu = 0.f, mv = 0.f;
#pragma unroll
        for (int j = 0; j < 4; ++j) { uu[j] = ur[j] * gg[j]; vv[j] = vr[j];
#pragma unroll
            for (int c = 0; c < 4; ++c) { mu = fmaxf(mu, fabsf(uu[j][c])); mv = fmaxf(mv, fabsf(vv[j][c])); } }
#pragma unroll
        for (int o = 1; o < 64; o <<= 1) { mu = fmaxf(mu, __shfl_xor(mu, o)); mv = fmaxf(mv, __shfl_xor(mv, o)); }
        const float scu = mu > 0.f ? mu * (1.f / 6.f) : 1.f, scv = mv > 0.f ? mv * (1.f / 6.f) : 1.f, iu = 1.f / scu, iv = 1.f / scv;
        unsigned qu0 = 0u, qu1 = 0u, qv0 = 0u, qv1 = 0u;
#define P0_Q4(Q, X, INV, B0, B1) do { Q = __builtin_amdgcn_cvt_scalef32_pk_fp4_f32(Q, X[0] * INV, X[1] * INV, 1.0f, B0); Q = __builtin_amdgcn_cvt_scalef32_pk_fp4_f32(Q, X[2] * INV, X[3] * INV, 1.0f, B1); } while (0)
        P0_Q4(qu0, uu[0], iu, 0, 1); P0_Q4(qu0, uu[1], iu, 2, 3); P0_Q4(qu1, uu[2], iu, 0, 1); P0_Q4(qu1, uu[3], iu, 2, 3);
        P0_Q4(qv0, vv[0], iv, 0, 1); P0_Q4(qv0, vv[1], iv, 2, 3); P0_Q4(qv1, vv[2], iv, 0, 1); P0_Q4(qv1, vv[3], iv, 2, 3);
#undef P0_Q4
        *(GAS unsigned long long*)(u4 + (size_t)e * 512 + 8 * lane) = (unsigned long long)qu0 | ((unsigned long long)qu1 << 32);
        { unsigned char* vrow = v4 + (size_t)e * 512 + 2 * (lane >> 2);
          *(GAS unsigned short*)(vrow + 32 * (4 * (lane & 3) + 0)) = (unsigned short)(qv0 & 0xffffu); *(GAS unsigned short*)(vrow + 32 * (4 * (lane & 3) + 1)) = (unsigned short)(qv0 >> 16);
          *(GAS unsigned short*)(vrow + 32 * (4 * (lane & 3) + 2)) = (unsigned short)(qv1 & 0xffffu); *(GAS unsigned short*)(vrow + 32 * (4 * (lane & 3) + 3)) = (unsigned short)(qv1 >> 16); }
        if (lane == 0) { su[2 * e] = scu; su[2 * e + 1] = scv; }
      } }
}
__device__ __forceinline__ void p0_rows(Frame& F, const Args& a) {
    unsigned char* ws = a.ws; const float* x = a.in[0]; const float* g1 = a.in[1]; const float* w_in = a.in[2]; const float* bfv = a.in[10];
    float* logf = (float*)(ws + WS_LOGF); bf16* h = (bf16*)(ws + WS_H);
    const int gw = F.vcu * NWAVES + F.wave, NGW = F.G * NWAVES, lane = F.lane;
    { f32x4 gg[4];
#pragma unroll
      for (int j = 0; j < 4; ++j) gg[j] = *(const GAS f32x4*)(g1 + 256 * j + 4 * lane);
      float fw[4][4][8];
#pragma unroll
      for (int j = 0; j < 4; ++j)
#pragma unroll
          for (int c = 0; c < 4; ++c) { const int k = 256 * j + 4 * lane + c; const GAS f32x4* wr = (const GAS f32x4*)(w_in + (size_t)k * INC + NG1); const f32x4 w0 = wr[0], w1 = wr[1];
#pragma unroll
              for (int e = 0; e < 4; ++e) { fw[j][c][e] = w0[e]; fw[j][c][4 + e] = w1[e]; } }
      for (int t0 = gw; t0 < T; t0 += 2 * NGW) {
        const int t1 = (t0 + NGW < T) ? t0 + NGW : t0;
        const GAS f32x4* xr0 = (const GAS f32x4*)(x + (size_t)t0 * DMODEL) + lane; const GAS f32x4* xr1 = (const GAS f32x4*)(x + (size_t)t1 * DMODEL) + lane;
        f32x4 va[4], vb[4]; float sa = 0.f, sb = 0.f;
#pragma unroll
        for (int j = 0; j < 4; ++j) { va[j] = xr0[64 * j]; vb[j] = xr1[64 * j]; }
#pragma unroll
        for (int j = 0; j < 4; ++j) { sa += (va[j][0] * va[j][0] + va[j][1] * va[j][1]) + (va[j][2] * va[j][2] + va[j][3] * va[j][3]); sb += (vb[j][0] * vb[j][0] + vb[j][1] * vb[j][1]) + (vb[j][2] * vb[j][2] + vb[j][3] * vb[j][3]); }
        const float ra = rsqrtf(wave_sum(sa) * (1.f / DMODEL) + RMS_EPS), rb = rsqrtf(wave_sum(sb) * (1.f / DMODEL) + RMS_EPS);
        GAS unsigned long long* ha = (GAS unsigned long long*)(h + (size_t)t0 * DMODEL) + lane; GAS unsigned long long* hb = (GAS unsigned long long*)(h + (size_t)t1 * DMODEL) + lane;
#pragma unroll
        for (int j = 0; j < 4; ++j) { va[j] = va[j] * ra * gg[j]; vb[j] = vb[j] * rb * gg[j];
            ha[64 * j] = (unsigned long long)pk2(va[j][0], va[j][1]) | ((unsigned long long)pk2(va[j][2], va[j][3]) << 32);
            hb[64 * j] = (unsigned long long)pk2(vb[j][0], vb[j][1]) | ((unsigned long long)pk2(vb[j][2], vb[j][3]) << 32); }
        float fa[8], fb[8];
#pragma unroll
        for (int hh = 0; hh < 8; ++hh) { fa[hh] = 0.f; fb[hh] = 0.f; }
#pragma unroll
        for (int j = 0; j < 4; ++j)
#pragma unroll
            for (int c = 0; c < 4; ++c) {
#pragma unroll
                for (int hh = 0; hh < 8; ++hh) { fa[hh] += va[j][c] * fw[j][c][hh]; fb[hh] += vb[j][c] * fw[j][c][hh]; } }
        const bool b0 = lane & 1, b1 = lane & 2, b2 = lane & 4;
        float ya[4], yb[4], za[2], zb[2];
#pragma unroll
        for (int j = 0; j < 4; ++j) { ya[j] = (b0 ? fa[j + 4] : fa[j]) + __shfl_xor(b0 ? fa[j] : fa[j + 4], 1); yb[j] = (b0 ? fb[j + 4] : fb[j]) + __shfl_xor(b0 ? fb[j] : fb[j + 4], 1); }
#pragma unroll
        for (int j = 0; j < 2; ++j) { za[j] = (b1 ? ya[j + 2] : ya[j]) + __shfl_xor(b1 ? ya[j] : ya[j + 2], 2); zb[j] = (b1 ? yb[j + 2] : yb[j]) + __shfl_xor(b1 ? yb[j] : yb[j + 2], 2); }
        float resa = (b2 ? za[1] : za[0]) + __shfl_xor(b2 ? za[0] : za[1], 4), resb = (b2 ? zb[1] : zb[0]) + __shfl_xor(b2 ? zb[0] : zb[1], 4);
#pragma unroll
        for (int o = 8; o < 64; o <<= 1) { resa += __shfl_xor(resa, o); resb += __shfl_xor(resb, o); }
        if (lane < 8) { const int hd = 4 * (lane & 1) + (lane & 2) + ((lane >> 2) & 1); logf[(size_t)t0 * 8 + hd] = log_sigmoid(resa + bfv[hd]); logf[(size_t)t1 * 8 + hd] = log_sigmoid(resb + bfv[hd]); }
      } }
}

__device__ __forceinline__ void fcum_unit(Frame& F, int bh, const float* logf, float* fcum) {
    const int b = bh / NHEADS, hh = bh % NHEADS, s0 = F.tid * 16;
    float v[16]; float loc = 0.f;
#pragma unroll
    for (int i = 0; i < 16; ++i) { v[i] = logf[((size_t)b * SEQ + s0 + i) * 8 + hh]; loc += v[i]; }
    float inc = loc;
#pragma unroll
    for (int o = 1; o < 64; o <<= 1) { const float n = __shfl_up(inc, o); if (F.lane >= o) inc += n; }
    if (F.lane == 63) F.MISC[16 + F.wave] = __float_as_uint(inc);
    __syncthreads();
    float run = inc - loc;
    for (int w = 0; w < F.wave; ++w) run += __uint_as_float(F.MISC[16 + w]);
#pragma unroll
    for (int i = 0; i < 16; ++i) { run += v[i]; fcum[(size_t)bh * SEQ + s0 + i] = run; }
    __syncthreads();
}


namespace peer {
typedef unsigned u32;
typedef float f32x16 __attribute__((ext_vector_type(16)));
constexpr int TOK = 128;
constexpr int EX_STRIDE = 136, GT_STRIDE = 136;
constexpr int L_EX = 0, L_GT = L_EX + TOK * EX_STRIDE * 2, L_IDX = L_GT + TOK * GT_STRIDE * 2, IDX_STRIDE = 36, L_RST = L_IDX + 512 * IDX_STRIDE, L_BI = L_RST + TOK * 4, BI_WAVE = 4352, L_END = L_BI + 8 * BI_WAVE;
static_assert(L_END <= RING_BYTES && L_GT % 16 == 0 && L_IDX % 16 == 0, "PEER LDS map");
__device__ __forceinline__ u32 ordmap(float f) { const u32 u = __float_as_uint(f); return u ^ ((u32)((int)u >> 31) | 0x80000000u); }
__device__ __forceinline__ float unordmap(u32 k) { const u32 u = (k & 0x80000000u) ? (k ^ 0x80000000u) : ~k; return __uint_as_float(u); }
__device__ __forceinline__ u32 umin_(u32 a, u32 b) { return a < b ? a : b; }
__device__ __forceinline__ u32 umax_(u32 a, u32 b) { return a > b ? a : b; }
template <bool DESC> __device__ __forceinline__ void sort16(u32 (&k)[16]) {
#define PEER_CE(I, J) do { const u32 a_ = k[I], b_ = k[J], lo_ = umin_(a_, b_), hi_ = umax_(a_, b_); k[I] = DESC ? hi_ : lo_; k[J] = DESC ? lo_ : hi_; } while (0)
    PEER_CE(0, 13); PEER_CE(1, 12); PEER_CE(2, 15); PEER_CE(3, 14); PEER_CE(4, 8); PEER_CE(5, 6); PEER_CE(7, 11); PEER_CE(9, 10);
    PEER_CE(0, 5); PEER_CE(1, 7); PEER_CE(2, 9); PEER_CE(3, 4); PEER_CE(6, 13); PEER_CE(8, 14); PEER_CE(10, 15); PEER_CE(11, 12);
    PEER_CE(0, 1); PEER_CE(2, 3); PEER_CE(4, 5); PEER_CE(6, 8); PEER_CE(7, 9); PEER_CE(10, 11); PEER_CE(12, 13); PEER_CE(14, 15);
    PEER_CE(0, 2); PEER_CE(1, 3); PEER_CE(4, 10); PEER_CE(5, 11); PEER_CE(6, 7); PEER_CE(8, 9); PEER_CE(12, 14); PEER_CE(13, 15);
    PEER_CE(1, 2); PEER_CE(3, 12); PEER_CE(4, 6); PEER_CE(5, 7); PEER_CE(8, 10); PEER_CE(9, 11); PEER_CE(13, 14);
    PEER_CE(1, 4); PEER_CE(2, 6); PEER_CE(5, 8); PEER_CE(7, 10); PEER_CE(9, 13); PEER_CE(11, 14);
    PEER_CE(2, 4); PEER_CE(3, 6); PEER_CE(9, 12); PEER_CE(11, 13);
    PEER_CE(3, 5); PEER_CE(6, 8); PEER_CE(7, 9); PEER_CE(10, 12);
    PEER_CE(3, 4); PEER_CE(5, 6); PEER_CE(7, 8); PEER_CE(9, 10); PEER_CE(11, 12);
    PEER_CE(6, 7); PEER_CE(8, 9);
#undef PEER_CE
}
template <bool DESC> __device__ __forceinline__ void merge16(u32 (&k)[16]) {
#pragma unroll
    for (int stride = 8; stride > 0; stride >>= 1)
#pragma unroll
        for (int i = 0; i < 16; ++i) { const int j = i ^ stride;
            if (j > i) { const u32 a = k[i], b = k[j], lo = umin_(a, b), hi = umax_(a, b); k[i] = DESC ? hi : lo; k[j] = DESC ? lo : hi; } }
}
__host__ __device__ constexpr int ccnt(int a) { return 16 / (a + 1); }
__host__ __device__ constexpr int cbase(int a) { int s = 0; for (int i = 0; i < a; ++i) s += ccnt(i); return s; }
static_assert(cbase(16) == 50, "hyperbola candidate count");
__device__ __forceinline__ int crow16(int r) { return (r & 3) + 8 * (r >> 2); }

__device__ __forceinline__ void route_tile(Frame& F, const bf16* qp, const bf16* skb, const float* sumsq, int t0) {
    int lane = F.lane; asm volatile("" : "+v"(lane));
    const int r32 = lane & 31, hi = lane >> 5, w = F.wave;
    LAS unsigned short* EXL = (LAS unsigned short*)(F.lds + RING_OFF + L_EX);
    LAS unsigned short* GTL = (LAS unsigned short*)(F.lds + RING_OFF + L_GT);
    LAS unsigned char* IDXB = F.lds + RING_OFF + L_IDX + (w * 64 + lane) * IDX_STRIDE;
    LAS float* RST = (LAS float*)(F.lds + RING_OFF + L_RST);
    for (int g = 0; g < 4; ++g) {
        const int tok = 32 * g + r32; const size_t trow = (size_t)(t0 + tok);
        const float rstd2 = rsqrtf(sumsq[trow] * (1.f / DMODEL) + RMS_EPS);
        if (w == 0 && hi == 0) RST[tok] = rstd2;
        u32 s0[16], s1[16];
#pragma unroll
        for (int p = 0; p < 2; ++p) {
            bf16x8 qf[8];
#pragma unroll
            for (int ks = 0; ks < 8; ++ks) qf[ks] = *(const GAS bf16x8*)(qp + ((size_t)((((trow >> 5) * 8 + w) * 2 + p) * 16 + 2 * ks + hi) * 32 + r32) * 8);
            u32 run[16];
            bf16x8 kf[8];
#define ROUTE_KLOAD(NB) do { const bf16* kr_ = skb + (size_t)(w * 2 + p) * 16384 + ((size_t)(((NB) * 2 + hi) * 8 * 32 + r32)) * 8;   \
                _Pragma("unroll") for (int ks = 0; ks < 8; ++ks) kf[ks] = *(const GAS bf16x8*)(kr_ + ks * 256); } while (0)
            ROUTE_KLOAD(0);
#pragma unroll
            for (int nb = 0; nb < 4; ++nb) {
                f32x16 acc = {};
#pragma unroll
                for (int ks = 0; ks < 8; ++ks) acc = __builtin_amdgcn_mfma_f32_32x32x16_bf16(kf[ks], qf[ks], acc, 0, 0, 0);
                asm volatile("" ::: "memory");
                if (nb < 3) { ROUTE_KLOAD(nb + 1); asm volatile("" ::: "memory"); }
                u32 blk[16];
#pragma unroll
                for (int r = 0; r < 16; ++r) blk[r] = (ordmap(acc[r]) & ~0x7Fu) | (u32)(127 - 32 * nb - crow16(r) - 4 * hi);
                if (nb == 0) { sort16<true>(blk);
#pragma unroll
                    for (int i = 0; i < 16; ++i) run[i] = blk[i]; }
                else { sort16<false>(blk);
#pragma unroll
                    for (int i = 0; i < 16; ++i) run[i] = umax_(run[i], blk[i]);
                    merge16<true>(run); }
            }
            u32 oth[16];
#pragma unroll
            for (int i = 0; i < 16; ++i) oth[i] = (u32)__shfl_xor((int)run[15 - i], 32);
#pragma unroll
            for (int i = 0; i < 16; ++i) run[i] = umax_(run[i], oth[i]);
            merge16<true>(run);
#pragma unroll
            for (int i = 0; i < 16; ++i) { if (p == 0) s0[i] = run[i]; else s1[i] = run[i]; }
        }
        { LAS u32* iw = (LAS u32*)IDXB;
#pragma unroll
          for (int j = 0; j < 4; ++j) {
              iw[j] = (127u - (s0[4 * j] & 127u)) | ((127u - (s0[4 * j + 1] & 127u)) << 8) | ((127u - (s0[4 * j + 2] & 127u)) << 16) | ((127u - (s0[4 * j + 3] & 127u)) << 24);
              iw[4 + j] = (127u - (s1[4 * j] & 127u)) | ((127u - (s1[4 * j + 1] & 127u)) << 8) | ((127u - (s1[4 * j + 2] & 127u)) << 16) | ((127u - (s1[4 * j + 3] & 127u)) << 24); } }
        float v1[16], v2[16];
#pragma unroll
        for (int i = 0; i < 16; ++i) { v1[i] = unordmap(s0[i] & ~0x7Fu); v2[i] = unordmap(s1[i] & ~0x7Fu); }
        u32 c0[16], c1[16], c2[16], c3[16];
#pragma unroll
        for (int a = 0; a < 16; ++a)
#pragma unroll
            for (int b = 0; b < ccnt(a); ++b) { const int pos = cbase(a) + b; const u32 key = (ordmap(v1[a] + v2[b]) & ~0xFFu) | (u32)(255 - (a * 16 + b));
                if (pos < 16) c0[pos] = key; else if (pos < 32) c1[pos - 16] = key; else if (pos < 48) c2[pos - 32] = key; else c3[pos - 48] = key; }
        sort16<false>(c1);
#pragma unroll
        for (int i = 0; i < 16; ++i) c0[i] = umax_(c0[i], c1[i]);
        merge16<true>(c0);
        sort16<false>(c2);
#pragma unroll
        for (int i = 0; i < 16; ++i) c0[i] = umax_(c0[i], c2[i]);
        merge16<true>(c0);
        { const u32 lo2 = umin_(c3[0], c3[1]), hi2 = umax_(c3[0], c3[1]); c0[14] = umax_(c0[14], lo2); c0[15] = umax_(c0[15], hi2); }
        const float m = unordmap(umax_(c0[0], c0[15]) & ~0xFFu) * rstd2;
        float e[8]; float sum = 0.f; u32 ex[8];
#pragma unroll
        for (int k = 0; k < 8; ++k) { const u32 key = hi ? c0[k + 8] : c0[k]; const float ts = unordmap(key & ~0xFFu);
            e[k] = __builtin_amdgcn_exp2f((ts * rstd2 - m) * LOG2E); sum += e[k];
            const u32 flat = 255u - (key & 255u); ex[k] = (u32)IDXB[flat >> 4] * NKEY + (u32)IDXB[16 + (flat & 15u)]; }
        sum += __shfl_xor(sum, 32);
        const float inv = 1.f / sum;
        v4u exw; exw.x = ex[0] | (ex[1] << 16); exw.y = ex[2] | (ex[3] << 16); exw.z = ex[4] | (ex[5] << 16); exw.w = ex[6] | (ex[7] << 16);
        *(LAS v4u*)(EXL + tok * EX_STRIDE + w * 16 + hi * 8) = exw;
        *(LAS v4u*)(GTL + tok * GT_STRIDE + w * 16 + hi * 8) = (v4u){pk2(e[0] * inv, e[1] * inv), pk2(e[2] * inv, e[3] * inv), pk2(e[4] * inv, e[5] * inv), pk2(e[6] * inv, e[7] * inv)};
    }
}
__device__ __forceinline__ float gelu_fast(float x) {
    const float u2 = x * (1.5957691216057308f + 0.07135481627f * x * x);
    return x * __builtin_amdgcn_rcpf(1.f + __builtin_amdgcn_exp2f(-1.4426950408889634f * u2));
}
typedef float f32x2 __attribute__((ext_vector_type(2)));

typedef int v8i __attribute__((ext_vector_type(8)));
typedef unsigned u2v __attribute__((ext_vector_type(2)));
__device__ __forceinline__ void eval_mf(Frame& F, const unsigned char* u4, const unsigned char* v4, const float* suv, const float* fg, const bf16* x1b, float* out, int t0) {
    int lane = F.lane; asm volatile("" : "+v"(lane));
    const int g = lane >> 4, m = lane & 15;
    LAS unsigned short* EXL = (LAS unsigned short*)(F.lds + RING_OFF + L_EX);
    LAS unsigned short* GTL = (LAS unsigned short*)(F.lds + RING_OFF + L_GT);
    LAS unsigned char* BI = F.lds + RING_OFF + L_BI + F.wave * BI_WAVE;
    const LAS float* RST = (const LAS float*)(F.lds + RING_OFF + L_RST);
    LAS u32* SKW = (LAS u32*)(F.lds + RING_OFF + L_IDX) + F.wave * 512;
    LAS u32* SK = SKW + g * 128;
    for (int pass = 0; pass < 4; ++pass) {
        const int tb4 = 32 * pass + 4 * F.wave, tok = tb4 + g;
        LAS unsigned short* exr = EXL + tok * EX_STRIDE; LAS unsigned short* gtr = GTL + tok * GT_STRIDE;
        v4u xrow[4][2];
#pragma unroll
        for (int tq = 0; tq < 4; ++tq) { const bf16* xr = x1b + (size_t)(t0 + tb4 + tq) * DMODEL + 8 * lane; xrow[tq][0] = *(const GAS v4u*)xr; xrow[tq][1] = *(const GAS v4u*)(xr + 512); }
        asm volatile("" ::: "memory");
        { const v4u ev = *(const LAS v4u*)(exr + 8 * m), gv = *(const LAS v4u*)(gtr + 8 * m);
          u32 e[8] = {ev.x & 0xffffu, ev.x >> 16, ev.y & 0xffffu, ev.y >> 16, ev.z & 0xffffu, ev.z >> 16, ev.w & 0xffffu, ev.w >> 16};
          const u32 gt[8] = {gv.x & 0xffffu, gv.x >> 16, gv.y & 0xffffu, gv.y >> 16, gv.z & 0xffffu, gv.z >> 16, gv.w & 0xffffu, gv.w >> 16};
          LAS u32* CNT = (LAS u32*)BI + g * 64;
          CNT[2 * m] = 0u; CNT[2 * m + 1] = 0u;
          asm volatile("" ::: "memory");
          u32 rk[8];
#pragma unroll
          for (int r = 0; r < 8; ++r) rk[r] = __hip_atomic_fetch_add(CNT + (e[r] >> 9), 1u, __ATOMIC_RELAXED, __HIP_MEMORY_SCOPE_WORKGROUP);
          asm volatile("s_waitcnt lgkmcnt(0)" ::: "memory");
          const u32 c0 = CNT[2 * m], c1 = CNT[2 * m + 1]; int sc = (int)(c0 + c1);
          sc += __builtin_amdgcn_update_dpp(0, sc, 0x111, 0xf, 0xf, true); sc += __builtin_amdgcn_update_dpp(0, sc, 0x112, 0xf, 0xf, true);
          sc += __builtin_amdgcn_update_dpp(0, sc, 0x114, 0xf, 0xf, true); sc += __builtin_amdgcn_update_dpp(0, sc, 0x118, 0xf, 0xf, true);
          const u32 ex0 = (u32)sc - (c0 + c1);
          CNT[32 + 2 * m] = ex0; CNT[32 + 2 * m + 1] = ex0 + c0;
          asm volatile("s_waitcnt lgkmcnt(0)" ::: "memory");
#pragma unroll
          for (int r = 0; r < 8; ++r) { const u32 pos = CNT[32 + (e[r] >> 9)] + rk[r]; SK[pos] = (e[r] << 16) | gt[r]; exr[pos] = (unsigned short)e[r]; }
          asm volatile("s_waitcnt lgkmcnt(0)" ::: "memory"); }
        asm volatile("" ::: "memory");
#define PEER_BAR() do { asm volatile("" ::: "memory"); __builtin_amdgcn_sched_barrier(0); } while (0)
#define PEER_LOADU(UA, KQ, SC, I) do { KQ = *(const LAS v4u*)(SK + (I)); _Pragma("unroll") for (int s4 = 0; s4 < 4; ++s4) { const u32 e_ = KQ[s4] >> 16; const u32 ro_ = e_ * 512u + 16u * (u32)m; \
            UA[s4][0] = *(const GAS v4u*)(u4 + ro_); UA[s4][1] = *(const GAS v4u*)(u4 + ro_ + 256); SC[s4] = *(const GAS f32x2*)(suv + 2 * e_); } } while (0)
        v4u kqA, kqB, uaA[4][2], uaB[4][2], af[8]; f32x2 scA[4], scB[4];
        PEER_LOADU(uaA, kqA, scA, 0);
        PEER_BAR();
        {
#pragma unroll
            for (int tq = 0; tq < 4; ++tq) { const float rq = RST[tb4 + tq];
#pragma unroll
                for (int c = 0; c < 2; ++c) { const v4u xa = xrow[tq][c]; int w0 = 0, w1 = 0;
                    w0 = __builtin_amdgcn_cvt_pk_fp8_f32(__uint_as_float(xa.x << 16) * rq, __uint_as_float(xa.x & 0xffff0000u) * rq, w0, false); w0 = __builtin_amdgcn_cvt_pk_fp8_f32(__uint_as_float(xa.y << 16) * rq, __uint_as_float(xa.y & 0xffff0000u) * rq, w0, true);
                    w1 = __builtin_amdgcn_cvt_pk_fp8_f32(__uint_as_float(xa.z << 16) * rq, __uint_as_float(xa.z & 0xffff0000u) * rq, w1, false); w1 = __builtin_amdgcn_cvt_pk_fp8_f32(__uint_as_float(xa.w << 16) * rq, __uint_as_float(xa.w & 0xffff0000u) * rq, w1, true);
                    const int d = 512 * c + 8 * lane, st = d >> 7, dd = d & 127, hh = dd >> 6, e = dd & 63;
                    *(LAS u2v*)(BI + ((st * 4 + tq) * 4 + (e >> 4)) * 32 + hh * 16 + (e & 15)) = (u2v){(u32)w0, (u32)w1}; } }
        }
        asm volatile("" ::: "memory");
        v8i hb[8];
#pragma unroll
        for (int st = 0; st < 8; ++st) { v4u b0 = *(const LAS v4u*)(BI + ((st * 4 + (m & 3)) * 4 + g) * 32), b1 = *(const LAS v4u*)(BI + ((st * 4 + (m & 3)) * 4 + g) * 32 + 16);
            if (m >= 4) { b0 = (v4u){0u, 0u, 0u, 0u}; b1 = b0; }
            hb[st] = (v8i){(int)b0.x, (int)b0.y, (int)b0.z, (int)b0.w, (int)b1.x, (int)b1.y, (int)b1.z, (int)b1.w}; }
        asm volatile("" ::: "memory");
#define PEER_TRANSP(UA) do { _Pragma("unroll") for (int hf = 0; hf < 2; ++hf) { \
                _Pragma("unroll") for (int s4 = 0; s4 < 4; ++s4) *(LAS v4u*)(BI + (4 * s4 + g) * 272 + 16 * m) = UA[s4][hf]; \
                asm volatile("" ::: "memory"); \
                _Pragma("unroll") for (int st = 0; st < 4; ++st) af[4 * hf + st] = *(const LAS v4u*)(BI + m * 272 + 64 * st + 16 * g); \
                asm volatile("" ::: "memory"); } } while (0)
#define PEER_DOTS(KQ, SC, I) do { f32x4 D = (f32x4){0.f, 0.f, 0.f, 0.f}; \
            _Pragma("unroll") for (int st = 0; st < 8; ++st) { const v8i a8 = (v8i){(int)af[st].x, (int)af[st].y, (int)af[st].z, (int)af[st].w, 0, 0, 0, 0}; \
                D = __builtin_amdgcn_mfma_scale_f32_16x16x128_f8f6f4(a8, hb[st], D, 4, 0, 0, 0x7f7f7f7f, 0, 0x7f7f7f7f); } \
            const int sel = lane & 3; const float mine = sel == 0 ? D[0] : sel == 1 ? D[1] : sel == 2 ? D[2] : D[3]; float act[4]; \
            _Pragma("unroll") for (int s4 = 0; s4 < 4; ++s4) { const float pre = __uint_as_float((unsigned)__builtin_amdgcn_ds_bpermute(4 * (g + 16 * s4), (int)__float_as_uint(mine))); \
                act[s4] = gelu_fast(pre * SC[s4][0]) * (__uint_as_float(KQ[s4] << 16) * SC[s4][1]); } \
            if (m == 0) *(LAS u2v*)(gtr + (I)) = (u2v){pk2(act[0], act[1]), pk2(act[2], act[3])}; } while (0)
        for (int i = 0; i < 128; i += 8) {
            PEER_TRANSP(uaA);
            PEER_LOADU(uaB, kqB, scB, i + 4);
            PEER_BAR();
            PEER_DOTS(kqA, scA, i);
            PEER_BAR();
            PEER_TRANSP(uaB);
            PEER_LOADU(uaA, kqA, scA, (i + 8 < 128) ? i + 8 : i + 4);
            PEER_BAR();
            PEER_DOTS(kqB, scB, i + 4);
            PEER_BAR();
        }
    }
    asm volatile("" ::: "memory");
    for (int pass = 0; pass < 4; ++pass) {
        const int tb4 = 32 * pass + 4 * F.wave, tok = tb4 + g;
        const LAS unsigned short* exr = EXL + tok * EX_STRIDE; const LAS unsigned short* acr = GTL + tok * GT_STRIDE;
        f32x2 y[32];
#pragma unroll
        for (int q = 0; q < 32; ++q) y[q] = (f32x2){0.f, 0.f};
        float* xrow = out + (size_t)(t0 + tok) * DMODEL + 4 * m; const bf16* xres = x1b + (size_t)(t0 + tok) * DMODEL + 4 * m;
#define PEER_LOADV(VB, I) do { const u2v e2_ = *(const LAS u2v*)(exr + (I)); _Pragma("unroll") for (int s4 = 0; s4 < 4; ++s4) { const u32 e_ = (s4 & 1) ? (e2_[s4 >> 1] >> 16) : (e2_[s4 >> 1] & 0xffffu); \
            const u32 ro_ = e_ * 512u + 32u * (u32)m; VB[s4][0] = *(const GAS v4u*)(v4 + ro_); VB[s4][1] = *(const GAS v4u*)(v4 + ro_ + 16); } } while (0)
#define PEER_FMAV(VB, I) do { const u2v a2_ = *(const LAS u2v*)(acr + (I)); _Pragma("unroll") for (int s4 = 0; s4 < 4; ++s4) { \
            const float act_ = (s4 & 1) ? __uint_as_float(a2_[s4 >> 1] & 0xffff0000u) : __uint_as_float(a2_[s4 >> 1] << 16); const f32x2 b2_ = (f32x2){act_, act_}; \
            _Pragma("unroll") for (int c = 0; c < 2; ++c) _Pragma("unroll") for (int d = 0; d < 4; ++d) { const unsigned w_ = VB[s4][c][d]; const int hq = 16 * c + 4 * d; \
                y[hq] = __builtin_elementwise_fma(__builtin_amdgcn_cvt_scalef32_pk_f32_fp4(w_, 1.0f, 0), b2_, y[hq]); y[hq + 1] = __builtin_elementwise_fma(__builtin_amdgcn_cvt_scalef32_pk_f32_fp4(w_, 1.0f, 1), b2_, y[hq + 1]); \
                y[hq + 2] = __builtin_elementwise_fma(__builtin_amdgcn_cvt_scalef32_pk_f32_fp4(w_, 1.0f, 2), b2_, y[hq + 2]); y[hq + 3] = __builtin_elementwise_fma(__builtin_amdgcn_cvt_scalef32_pk_f32_fp4(w_, 1.0f, 3), b2_, y[hq + 3]); } } } while (0)
        v4u vbA[4][2], vbB[4][2], vbC[4][2];
        PEER_LOADV(vbA, 0); PEER_LOADV(vbB, 4);
        PEER_BAR();
        for (int i = 0; i < 120; i += 12) {
            PEER_LOADV(vbC, i + 8);  PEER_BAR(); PEER_FMAV(vbA, i);     PEER_BAR();
            PEER_LOADV(vbA, i + 12); PEER_BAR(); PEER_FMAV(vbB, i + 4); PEER_BAR();
            PEER_LOADV(vbB, i + 16); PEER_BAR(); PEER_FMAV(vbC, i + 8); PEER_BAR();
        }
        u2v xav[16];
#pragma unroll
        for (int q = 0; q < 16; ++q) xav[q] = *(const GAS u2v*)(xres + 64 * q);
        PEER_BAR();
        PEER_FMAV(vbA, 120); PEER_FMAV(vbB, 124);
        f32x4 gqv[16];
#pragma unroll
        for (int q = 0; q < 16; ++q) gqv[q] = *(const GAS f32x4*)(fg + 64 * q + 4 * m);
        float ss = 0.f;
#pragma unroll
        for (int q = 0; q < 16; ++q) { const u2v xa = xav[q]; y[2 * q][0] += __uint_as_float(xa.x << 16); y[2 * q][1] += __uint_as_float(xa.x & 0xffff0000u); y[2 * q + 1][0] += __uint_as_float(xa.y << 16); y[2 * q + 1][1] += __uint_as_float(xa.y & 0xffff0000u);
            ss += (y[2 * q][0] * y[2 * q][0] + y[2 * q][1] * y[2 * q][1]) + (y[2 * q + 1][0] * y[2 * q + 1][0] + y[2 * q + 1][1] * y[2 * q + 1][1]); }
        ss += __shfl_xor(ss, 1); ss += __shfl_xor(ss, 2); ss += __shfl_xor(ss, 4); ss += __shfl_xor(ss, 8);
        const float rs = rsqrtf(ss * (1.f / DMODEL) + RMS_EPS);
        asm volatile("" ::: "memory");
#pragma unroll
        for (int q = 0; q < 16; ++q) { const f32x4 gq = gqv[q]; f32x4 o; o[0] = y[2 * q][0] * rs * gq[0]; o[1] = y[2 * q][1] * rs * gq[1]; o[2] = y[2 * q + 1][0] * rs * gq[2]; o[3] = y[2 * q + 1][1] * rs * gq[3];
            __builtin_nontemporal_store(o, (GAS f32x4*)(xrow + 64 * q)); }
    }
}
__device__ __forceinline__ void peer_phase(Frame& F, const Args& a) {
    unsigned char* ws = a.ws;
    for (int tile = F.vcu; tile < T / TOK; tile += F.G) {
        route_tile(F, (const bf16*)(ws + WS_QP), (const bf16*)(ws + WS_SKB), (const float*)(ws + WS_SUMSQ), tile * TOK);
        __syncthreads();
        eval_mf(F, ws + WS_U8, ws + WS_V8, (const float*)(ws + WS_SU), a.in[19], (const bf16*)(ws + WS_X1B), a.out, tile * TOK);
        __syncthreads();
    }
}
}

namespace lru {
typedef float f32x16 __attribute__((ext_vector_type(16)));
constexpr int TOKT = 128, NTILE = SEQ / TOKT;
constexpr int WAVE_LDS = 14336, L_XS = 0, L_XC = 4608, L_GS = 9216, XC_STRIDE = 72  , L_SS = 8 * WAVE_LDS;
static_assert(L_SS + 2 * 32 * 8 * 4 <= RING_BYTES, "LRU LDS map");
__device__ __forceinline__ float bf2f(unsigned short h) { return __uint_as_float((unsigned)h << 16); }
__device__ __forceinline__ int crow16(int r) { return (r & 3) + 8 * (r >> 2); }
__device__ __forceinline__ float sigm(float x) { return __builtin_amdgcn_rcpf(1.f + __builtin_amdgcn_exp2f(-LOG2E * x)); }

template <bool FINAL> __device__ __forceinline__ void lru_tile(Frame& F, const Args& args, int tile) {
    int lane = F.lane; asm volatile("" : "+v"(lane));
    const int w = F.wave, j32 = lane & 31, hi = lane >> 5;
    unsigned char* ws = args.ws;
    const bf16* xr = (const bf16*)(ws + WS_XR); const bf16* gr = (const bf16*)(ws + WS_GR); float* carry = (float*)(ws + WS_CARRY);
    const float* cw = args.in[3]; const float* cb = args.in[4]; const float* ba = args.in[6]; const float* bx = args.in[8]; const float* lam = args.in[9];
    const int b = tile / NTILE, jt = tile % NTILE; const size_t trow0 = (size_t)b * SEQ + (size_t)jt * TOKT;
    LAS unsigned char* wl = F.lds + RING_OFF + w * WAVE_LDS;
    LAS unsigned short* XS = (LAS unsigned short*)(wl + L_XS); LAS unsigned short* XC = (LAS unsigned short*)(wl + L_XC); LAS unsigned short* GS = (LAS unsigned short*)(wl + L_GS);
    LAS float* SS = (LAS float*)(F.lds + RING_OFF + L_SS);
    float c_ba[2], c_bx[2], c_sp[2], c_cb[2], c_cw[2][4];
#pragma unroll
    for (int n = 0; n < 2; ++n) { const int c = 64 * w + 32 * n + j32; c_ba[n] = ba[c]; c_bx[n] = bx[c]; c_cb[n] = cb[c];
        const float l = lam[c]; c_sp[n] = 8.f * LOG2E * (fmaxf(-l, 0.f) + log1pf(expf(-fabsf(l))));
#pragma unroll
        for (int k = 0; k < 4; ++k) c_cw[n][k] = cw[k * LW + c]; }
    const bf16* wax = (const bf16*)(ws + WS_WAX);
    float hc[2] = {0.f, 0.f}, ap[2] = {1.f, 1.f};
    if (FINAL) { const float* cin = (const float*)(ws + WS_CIN) + (size_t)(b * NTILE + jt) * LW + 64 * w + j32; hc[0] = cin[0]; hc[1] = cin[32]; }
    v4u pfx[5], pfg[4], pce[2][2], pcu[2][2];
    unsigned char* cacheE = ws + WS_LA + ((size_t)(tile * 8 + w) * 4) * 4096; unsigned char* cacheU = ws + WS_LU + ((size_t)(tile * 8 + w) * 4) * 4096;
#define LRU_FETCH(B) do { const size_t tbn_ = trow0 + (B) * 32; \
        if (!FINAL) { _Pragma("unroll") for (int q_ = 0; q_ < 5; ++q_) { const int pc_ = lane + 64 * q_, row_ = pc_ >> 3, c8_ = pc_ & 7; \
            const bool z_ = (jt == 0 && (B) == 0 && row_ < 3) || pc_ >= 35 * 8; const v4u v_ = *(const GAS v4u*)(xr + (tbn_ + (z_ ? 3 : row_) - 3) * LW + w * 64 + c8_ * 8); pfx[q_] = z_ ? (v4u){0u, 0u, 0u, 0u} : v_; } } \
        if (FINAL) { _Pragma("unroll") for (int q_ = 0; q_ < 4; ++q_) { const int pc_ = lane + 64 * q_; pfg[q_] = *(const GAS v4u*)(gr + (tbn_ + (pc_ >> 3)) * LW + w * 64 + (pc_ & 7) * 8); } \
            _Pragma("unroll") for (int n_ = 0; n_ < 2; ++n_) _Pragma("unroll") for (int h_ = 0; h_ < 2; ++h_) { const size_t o_ = (size_t)(B) * 4096 + n_ * 2048 + h_ * 1024 + lane * 16; \
                pce[n_][h_] = *(const GAS v4u*)(cacheE + o_); pcu[n_][h_] = *(const GAS v4u*)(cacheU + o_); } } } while (0)
    LRU_FETCH(0);
    for (int blk = 0; blk < 4; ++blk) {
        const size_t tb = trow0 + blk * 32;
        int ln = lane; asm volatile("" : "+v"(ln));
        const int k32 = ln & 31;
        if (!FINAL) {
#pragma unroll
            for (int q = 0; q < 5; ++q) { const int pc = ln + 64 * q; if (pc < 35 * 8) *(LAS v4u*)((LAS unsigned char*)XS + (pc >> 3) * 128 + (pc & 7) * 16) = pfx[q]; } }
        v4u ce[2][2], cu[2][2];
        if (FINAL) {
#pragma unroll
            for (int n = 0; n < 2; ++n)
#pragma unroll
                for (int h = 0; h < 2; ++h) { ce[n][h] = pce[n][h]; cu[n][h] = pcu[n][h]; }
#pragma unroll
            for (int q = 0; q < 4; ++q) { const int pc = ln + 64 * q; *(LAS v4u*)((LAS unsigned char*)GS + (pc >> 3) * 128 + (pc & 7) * 16) = pfg[q]; } }
        if (blk < 3) { LRU_FETCH(blk + 1); }
        v4u ovv[4];
        if (FINAL) {
#pragma unroll
            for (int i = 0; i < 4; ++i) ovv[i] = *(const GAS v4u*)((const bf16*)(ws + WS_O) + (trow0 + 16 * w + 4 * blk + i) * AW + 8 * ln); }
        asm volatile("" ::: "memory");
        bf16x8 faN[2][4], fxN[2][4];
#define LRU_WLOAD(N) do { _Pragma("unroll") for (int ks = 0; ks < 4; ++ks) { faN[N][ks] = *(const GAS bf16x8*)(wax + (size_t)(((w * 2 + 0) * 2 + (N)) * 4 + ks) * 512 + ln * 8); \
            fxN[N][ks] = *(const GAS bf16x8*)(wax + (size_t)(((w * 2 + 1) * 2 + (N)) * 4 + ks) * 512 + ln * 8); } } while (0)
        if (!FINAL) { LRU_WLOAD(0); asm volatile("" ::: "memory"); }
        float xc[2][16];
        bf16x8 af[4];
        if (!FINAL) {
#pragma unroll
        for (int n = 0; n < 2; ++n)
#pragma unroll
            for (int g = 0; g < 4; ++g) { float xv[7];
#pragma unroll
                for (int q = 0; q < 7; ++q) xv[q] = bf2f(XS[(8 * g + 4 * hi + q) * 64 + 32 * n + j32]);
#pragma unroll
                for (int e = 0; e < 4; ++e) xc[n][4 * g + e] = c_cb[n] + ((c_cw[n][0] * xv[e] + c_cw[n][1] * xv[e + 1]) + (c_cw[n][2] * xv[e + 2] + c_cw[n][3] * xv[e + 3])); }
#pragma unroll
        for (int n = 0; n < 2; ++n)
#pragma unroll
            for (int r = 0; r < 16; ++r) XC[(crow16(r) + 4 * hi) * XC_STRIDE + 32 * n + j32] = (unsigned short)f2bf(xc[n][r]);
        asm volatile("" ::: "memory");
#pragma unroll
        for (int ks = 0; ks < 4; ++ks) af[ks] = *(const LAS bf16x8*)(XC + j32 * XC_STRIDE + 16 * ks + 8 * hi);
        asm volatile("" ::: "memory");
        }
        float yv[2][16];
#pragma unroll
        for (int n = 0; n < 2; ++n) {
            float av[16], uv[16];
            if (!FINAL) {
            f32x16 R = {}, I = {};
#pragma unroll
            for (int ks = 0; ks < 4; ++ks) { R = __builtin_amdgcn_mfma_f32_32x32x16_bf16(af[ks], faN[n][ks], R, 0, 0, 0); I = __builtin_amdgcn_mfma_f32_32x32x16_bf16(af[ks], fxN[n][ks], I, 0, 0, 0); }
            if (n == 0) { LRU_WLOAD(1); asm volatile("" ::: "memory"); }
            unsigned we[8], wu[8];
#pragma unroll
            for (int k = 0; k < 8; ++k) { const float e0 = sigm(R[2 * k] + c_ba[n]) * c_sp[n], e1 = sigm(R[2 * k + 1] + c_ba[n]) * c_sp[n]; we[k] = pg8::cvt_pk_bf16(e0, e1);
                const float a0 = __builtin_amdgcn_exp2f(-__uint_as_float(we[k] << 16)), a1 = __builtin_amdgcn_exp2f(-__uint_as_float(we[k] & 0xffff0000u));
                const float u0 = __builtin_amdgcn_sqrtf(fmaxf(1.f - a0 * a0, 0.f)) * (sigm(I[2 * k] + c_bx[n]) * xc[n][2 * k]), u1 = __builtin_amdgcn_sqrtf(fmaxf(1.f - a1 * a1, 0.f)) * (sigm(I[2 * k + 1] + c_bx[n]) * xc[n][2 * k + 1]);
                wu[k] = pg8::cvt_pk_bf16(u0, u1);
                av[2 * k] = a0; av[2 * k + 1] = a1; uv[2 * k] = __uint_as_float(wu[k] << 16); uv[2 * k + 1] = __uint_as_float(wu[k] & 0xffff0000u); }
            { const size_t o = (size_t)blk * 4096 + n * 2048 + ln * 16;
              *(GAS v4u*)(cacheE + o) = (v4u){we[0], we[1], we[2], we[3]}; *(GAS v4u*)(cacheE + o + 1024) = (v4u){we[4], we[5], we[6], we[7]};
              *(GAS v4u*)(cacheU + o) = (v4u){wu[0], wu[1], wu[2], wu[3]}; *(GAS v4u*)(cacheU + o + 1024) = (v4u){wu[4], wu[5], wu[6], wu[7]}; }
            } else {
#pragma unroll
                for (int k = 0; k < 8; ++k) { const unsigned e2 = ce[n][k >> 2][k & 3], u2 = cu[n][k >> 2][k & 3];
                    av[2 * k] = __builtin_amdgcn_exp2f(-__uint_as_float(e2 << 16)); av[2 * k + 1] = __builtin_amdgcn_exp2f(-__uint_as_float(e2 & 0xffff0000u));
                    uv[2 * k] = __uint_as_float(u2 << 16); uv[2 * k + 1] = __uint_as_float(u2 & 0xffff0000u); }
            }
            float Ar[4], Hr[4], hst[4];
#pragma unroll
            for (int g = 0; g < 4; ++g) { Ar[g] = (av[4 * g] * av[4 * g + 1]) * (av[4 * g + 2] * av[4 * g + 3]);
                Hr[g] = ((uv[4 * g] * av[4 * g + 1] + uv[4 * g + 1]) * av[4 * g + 2] + uv[4 * g + 2]) * av[4 * g + 3] + uv[4 * g + 3]; }
            float hin = hc[n];
#pragma unroll
            for (int g = 0; g < 4; ++g) { float o1 = Ar[g] * hin + Hr[g]; const float x = __shfl_xor(o1, 32); const float hg = hi ? x : hin; o1 = Ar[g] * hg + Hr[g]; hst[g] = hg;
                const float y = __shfl_xor(o1, 32); hin = hi ? o1 : y;
                if (!FINAL) ap[n] *= Ar[g] * __shfl_xor(Ar[g], 32); }
            hc[n] = hin;
            if (FINAL) {
#pragma unroll
                for (int g = 0; g < 4; ++g) { float h = hst[g];
#pragma unroll
                    for (int e = 0; e < 4; ++e) { const int r = 4 * g + e; h = av[r] * h + uv[r]; yv[n][r] = h * bf2f(GS[(crow16(r) + 4 * hi) * 64 + 32 * n + j32]); } } }
        }
        if (FINAL) {
            LAS float* SSb = SS + (blk & 1) * 256;
#pragma unroll
            for (int r = 0; r < 16; ++r) { float s = yv[0][r] * yv[0][r] + yv[1][r] * yv[1][r];
                s += __shfl_xor(s, 1); s += __shfl_xor(s, 2); s += __shfl_xor(s, 4); s += __shfl_xor(s, 8); s += __shfl_xor(s, 16);
                if (j32 == 0) SSb[(crow16(r) + 4 * hi) * 8 + w] = s; }
            __syncthreads();
            bf16* ymix = (bf16*)(ws + WS_H);
#pragma unroll
            for (int r = 0; r < 16; ++r) { const int tk = crow16(r) + 4 * hi; const f32x4 s0 = *(const LAS f32x4*)(SSb + tk * 8), s1 = *(const LAS f32x4*)(SSb + tk * 8 + 4);
                const float rstd = rsqrtf(((s0[0] + s0[1]) + (s0[2] + s0[3]) + (s1[0] + s1[1]) + (s1[2] + s1[3])) * (1.f / LW) + RMS_EPS);
                bf16* yp = ymix + (tb + tk) * DMODEL + 64 * w + k32;
                yp[0] = (bf16)f2bf(yv[0][r] * rstd); yp[32] = (bf16)f2bf(yv[1][r] * rstd); }
            { float ssq[4];
#pragma unroll
              for (int i = 0; i < 4; ++i) { float s = 0.f;
#pragma unroll
                  for (int c = 0; c < 4; ++c) { const float lo = __uint_as_float(ovv[i][c] << 16), hi2 = __uint_as_float(ovv[i][c] & 0xffff0000u); s += lo * lo + hi2 * hi2; }
                  ssq[i] = s; }
#pragma unroll
              for (int o = 1; o < 64; o <<= 1) {
#pragma unroll
                  for (int i = 0; i < 4; ++i) ssq[i] += __shfl_xor(ssq[i], o); }
#pragma unroll
              for (int i = 0; i < 4; ++i) { const float rstd = rsqrtf(ssq[i] * (1.f / AW) + RMS_EPS); v4u o;
#pragma unroll
                  for (int c = 0; c < 4; ++c) o[c] = pk2(__uint_as_float(ovv[i][c] << 16) * rstd, __uint_as_float(ovv[i][c] & 0xffff0000u) * rstd);
                  *(GAS v4u*)(ymix + (trow0 + 16 * w + 4 * blk + i) * DMODEL + LW + 8 * ln) = o; } }
        }
    }
#undef LRU_FETCH
#undef LRU_WLOAD
    if (!FINAL) { if (hi == 0) { float* cp = carry + ((size_t)(b * NTILE + jt) * 2) * LW + 64 * w + j32;
#pragma unroll
        for (int n = 0; n < 2; ++n) { cp[32 * n] = ap[n]; cp[LW + 32 * n] = hc[n]; } } }
}
__device__ __forceinline__ const float* norm_src(const float* rn2, int it, int lane) {
    const int which = it / (BATCH * (SEQ / 64)), r = it % (BATCH * (SEQ / 64)), b = r / (SEQ / 64), t = r % (SEQ / 64);
    return rn2 + ((size_t)which * (T / 16) + (size_t)(b * SEQ + 64 * t) / 16) * 256 + lane; }
__device__ __forceinline__ void norm_issue(Frame& F, const Args& a, float (&v)[16]) {
    const int gw = F.vcu * NWAVES + F.wave; const int it = gw < 2 * BATCH * (SEQ / 64) ? gw : 0; const float* src = norm_src((const float*)(a.ws + WS_RN2), it, F.lane);
#pragma unroll
    for (int i = 0; i < 16; ++i) v[i] = src[64 * i];
}
template <bool PRE> __device__ __forceinline__ void norm_pass(Frame& F, const Args& a, float (&v)[16]) {
    unsigned char* ws = a.ws; float* nrm = (float*)(ws + WS_NRM); const float* rn2 = (const float*)(ws + WS_RN2);
    const int gw = F.vcu * NWAVES + F.wave, NGW = F.G * NWAVES, lane = F.lane;
    for (int it = gw; it < 2 * BATCH * (SEQ / 64); it += NGW) {
        const int which = it / (BATCH * (SEQ / 64)), r = it % (BATCH * (SEQ / 64)), b = r / (SEQ / 64), t = r % (SEQ / 64);
        const float* src = rn2 + ((size_t)which * (T / 16) + (size_t)(b * SEQ + 64 * t) / 16) * 256 + lane;
        if (!(PRE && it == gw)) {
#pragma unroll
        for (int i = 0; i < 16; ++i) v[i] = src[64 * i]; }
        float mx[4] = {0.f, 0.f, 0.f, 0.f};
#pragma unroll
        for (int i = 0; i < 16; ++i) mx[i & 3] = fmaxf(mx[i & 3], v[i] + __shfl_xor(v[i], 16));
#pragma unroll
        for (int o = 1; o < 16; o <<= 1) {
#pragma unroll
            for (int j = 0; j < 4; ++j) mx[j] = fmaxf(mx[j], __shfl_xor(mx[j], o)); }
        if ((lane & 31) == 0) {
#pragma unroll
            for (int j = 0; j < 4; ++j) nrm[which * 4096 + (b * NHEADS + (lane >> 5) + 2 * j) * 128 + t] = sqrtf(mx[j]) * 1.0001f; }
    }
}
__device__ __forceinline__ void carry_prefix(Frame& F, const Args& a, int b) {
    const float* carry = (const float*)(a.ws + WS_CARRY) + (size_t)b * NTILE * 2 * LW + F.tid; float* cin = (float*)(a.ws + WS_CIN) + (size_t)b * NTILE * LW + F.tid;
    float c = 0.f;
    for (int j0 = 0; j0 < NTILE; j0 += 8) { float A[8], H[8];
#pragma unroll
        for (int j = 0; j < 8; ++j) { A[j] = carry[(size_t)(j0 + j) * 2 * LW]; H[j] = carry[(size_t)(j0 + j) * 2 * LW + LW]; }
#pragma unroll
        for (int j = 0; j < 8; ++j) { cin[(size_t)(j0 + j) * LW] = c; c = A[j] * c + H[j]; } }
}
template <bool FINAL> __device__ __forceinline__ void lru_phase(Frame& F, const Args& a) {
    for (int tile = F.vcu; tile < BATCH * NTILE; tile += F.G) { lru_tile<FINAL>(F, a, tile); __syncthreads(); }
}
}
__global__ void __launch_bounds__(NWAVES * 64, 2) mk_fwd(Args args) {
    extern __shared__ __attribute__((aligned(16))) unsigned char lds[];
    Frame F;
    F.lds = (LAS unsigned char*)lds;
    F.MISC = (volatile LAS unsigned*)(F.lds + MISC_OFF);
    F.wave = __builtin_amdgcn_readfirstlane((int)threadIdx.x >> 6); F.lane = (int)__builtin_amdgcn_mbcnt_hi(~0u, __builtin_amdgcn_mbcnt_lo(~0u, 0u)); F.tid = F.wave * 64 + F.lane;
    F.G = gridDim.x; { const int bx = blockIdx.x; F.vcu = (F.G % 8 == 0) ? (bx % 8) * (F.G / 8) + bx / 8 : bx; }
    unsigned char* ws = args.ws;
    F.ctl = (gu32*)(ws + WS_CTL);
    for (int u = F.tid; u < (LDS_BYTES - LDSCTL_OFF) / 4; u += NWAVES * 64) ((LAS unsigned*)(F.lds + LDSCTL_OFF))[u] = 0u;
    __syncthreads();
    XcdBarrier bar = xcd_barrier_post((unsigned*)(F.ctl + CW_BAR) + args.li * XCD_BAR_WORDS, F.MISC + 8, F.wave);
    const int lo = args.ph_lo, hi = args.ph_hi;
#define IN(k) (lo <= (k) && (k) < hi)
#define BOTH(k) (IN(k) && IN((k) + 1))
#define GRID_BAR() xcd_barrier(bar)

    if (IN(0)) { p0_prologue(F, args); if (BOTH(0)) GRID_BAR(); }

    if (IN(1)) {
        if (F.vcu < BATCH * NHEADS) fcum_unit(F, F.vcu, (const float*)(ws + WS_LOGF), (float*)(ws + WS_FCUM));
        pg8::Gemm g{(const pg8::bf16_t*)(ws + WS_H), (const pg8::bf16_t*)(ws + WS_WIN), T, NG1, DMODEL}; pg8::StaticOrder S; S.init(T, NG1, F.G, (int)blockIdx.x);
        pg8::EpiG1 E{(pg8::bf16_t*)(ws + WS_XR), SPLIT_STRIDE, QSCALE, (float*)(ws + WS_RN2)};
        pg8::gemm_phase<pg8::EpiG1, pg8::StaticOrder, true, true>(F.lds + RING_OFF, g, S, E, F.wave);
        if (BOTH(1)) GRID_BAR();
    }
    if (IN(2)) { float nv[16]; lru::norm_issue(F, args, nv); asm volatile("" ::: "memory"); lru::lru_phase<false>(F, args); lru::norm_pass<true>(F, args, nv); if (BOTH(2)) GRID_BAR(); }
    if (IN(3)) {
        static_assert(attn_body::ATTN_LDS_BYTES <= RING_BYTES, "attention LDS vs frame");
        if (F.vcu < BATCH) lru::carry_prefix(F, args, F.vcu);
        const attn_body::AttnTensors AT{(const attn_body::bf16*)(ws + WS_Q), (const attn_body::bf16*)(ws + WS_K), (const attn_body::bf16*)(ws + WS_V), (attn_body::bf16*)(ws + WS_O), (const float*)(ws + WS_FCUM), (const float*)(ws + WS_NRM)};
        struct TabItem { const Args& a; int wave, lane; __device__ __forceinline__ void operator()(int c) const { peer_tables_item(a, c, wave, lane); } };
        attn_body::attn_phase<8, NCONV>((char*)lds + RING_OFF, AT, (unsigned*)(F.ctl + CW_ATTQ), F.MISC + 24, F.wave, TabItem{args, F.wave, F.lane});
        if (BOTH(3)) GRID_BAR();
    }
    if (IN(4)) { lru::lru_phase<true>(F, args); if (BOTH(4)) GRID_BAR(); }
    if (IN(5)) {
        pg8::Gemm g{(const pg8::bf16_t*)(ws + WS_H), (const pg8::bf16_t*)(ws + WS_WOUT), T, DMODEL, DMODEL}; pg8::StaticOrder S; S.init(T, DMODEL, F.G, (int)blockIdx.x);
        pg8::EpiG2 E{args.in[0], (pg8::bf16_t*)(ws + WS_X1B), (float*)(ws + WS_SUMSQ), DMODEL};
        pg8::gemm_phase<pg8::EpiG2, pg8::StaticOrder, true, true>(F.lds + RING_OFF, g, S, E, F.wave);
        if (BOTH(5)) GRID_BAR();
    }
    if (IN(6)) {
        pg8::Gemm g{(const pg8::bf16_t*)(ws + WS_X1B), (const pg8::bf16_t*)(ws + WS_WQ), T, QPW, DMODEL}; pg8::StaticOrder S; S.init(T, QPW, F.G, (int)blockIdx.x);
        pg8::EpiG3 E{(pg8::bf16_t*)(ws + WS_QP), QPW};
        pg8::gemm_phase<pg8::EpiG3, pg8::StaticOrder, true, true>(F.lds + RING_OFF, g, S, E, F.wave);
        if (BOTH(6)) GRID_BAR();
    }
    if (IN(7)) { peer::peer_phase(F, args); }
#undef IN
#undef BOTH
#undef GRID_BAR
}

extern "C" void kernel_launch(void* const* d_in, const int* in_sizes, int n_in, void* d_out, int out_size, void* d_ws, size_t ws_size, hipStream_t stream) {
    static int grid = 0;
    if (grid == 0) {
        if (n_in != 20 || in_sizes[0] != T * DMODEL || out_size != T * DMODEL || ws_size < WS_END) { fprintf(stderr, "kernel_launch: unexpected shapes (n_in %d, ws %zu)\n", n_in, ws_size); grid = -1; return; }
        int dev = 0, cus = 0;
        if (hipGetDevice(&dev) != hipSuccess || hipDeviceGetAttribute(&cus, hipDeviceAttributeMultiprocessorCount, dev) != hipSuccess) { grid = -1; return; }
        if (hipFuncSetAttribute((const void*)mk_fwd, hipFuncAttributeMaxDynamicSharedMemorySize, LDS_BYTES) != hipSuccess) { fprintf(stderr, "kernel_launch: hipFuncSetAttribute failed\n"); grid = -1; return; }
        (void)hipGetLastError();
        grid = cus;
    }
    if (grid < 0) return;
    if (hipMemsetAsync((char*)d_ws + WS_CTL, 0, CTL_ZERO_BYTES, stream) != hipSuccess) return;
    Args a{};
    for (int i = 0; i < 20; ++i) a.in[i] = (const float*)d_in[i];
    a.out = (float*)d_out; a.ws = (unsigned char*)d_ws; a.ph_lo = 0; a.ph_hi = N_PHASES; a.li = 0;
    hipLaunchKernelGGL(mk_fwd, dim3(grid), dim3(NWAVES * 64), LDS_BYTES, stream, a);
}
```
